# Optimizing an MI355X kernel written in HIP

```python
import jax, jax.numpy as jnp
from jax import lax
import numpy as np

D_MODEL = 1024
BATCH = 32
SEQ = 256
DEPTH = 4
DEC_BATCH = 4
DEC_SEQ = 1024
PAST_LEN = 512

GRID_W = 64
N_MIXERS = 4
N_HGRN = (DEPTH + 3) // 4
N_SCONV = (DEPTH + 2) // 4
N_RGLRU = (DEPTH + 1) // 4
N_MLA = DEPTH // 4
DEEPNORM_ALPHA = (2 * DEPTH) ** 0.25
DEEPNORM_BETA = (8 * DEPTH) ** -0.25

HG_HEADS = 8
HG_KDIM = 128
HG_VDIM = D_MODEL // HG_HEADS
HG_F = HG_HEADS * HG_KDIM
HG_V = HG_HEADS * HG_VDIM
HG_CHUNK = 32
SC_WIDTH = D_MODEL
SC_KERNEL = 3
RG_WIDTH = D_MODEL
RG_HEADS = 4
RG_BLOCK = RG_WIDTH // RG_HEADS
RG_KERNEL = 4
RG_C = 8.0
MLA_HEADS = 16
MLA_Q_RANK = 384
MLA_KV_RANK = 256
MLA_NOPE = 64
MLA_ROPE = 32
MLA_VDIM = 64
ROPE_BASE = 10000.0
Q_BLOCK = 128

kernel_name = 'hybrid_flow_backbone_step'

f32 = jnp.float32


def layer_norm(x, g, b, eps=1e-5):
    xf = x.astype(f32)
    mu = jnp.mean(xf, -1, keepdims=True)
    var = jnp.mean(jnp.square(xf - mu), -1, keepdims=True)
    return ((xf - mu) * lax.rsqrt(var + eps) * g.astype(f32) + b.astype(f32)).astype(x.dtype)


def rms_norm(x, g, eps=1e-6):
    xf = x.astype(f32)
    y = xf * lax.rsqrt(jnp.mean(xf * xf, -1, keepdims=True) + eps)
    return (y * g.astype(f32)).astype(x.dtype)


def modulation(cvec, w, b):
    return jnp.split(jax.nn.silu(cvec) @ w + b, 3, axis=-1)


def depthwise_conv(x, w, b, pad):
    y = lax.conv_general_dilated(x, w[:, None, :].astype(x.dtype), (1,), [pad],
                                 dimension_numbers=('NWC', 'WIO', 'NWC'),
                                 feature_group_count=x.shape[-1])
    return y + b


def axial_rope(x):
    n = x.shape[1]
    rows = n // GRID_W
    row = jnp.repeat(jnp.arange(rows), GRID_W).astype(f32)
    col = jnp.tile(jnp.arange(GRID_W), rows).astype(f32)
    half = MLA_ROPE // 2
    inv_freq = ROPE_BASE ** (-jnp.arange(0, half, 2, dtype=f32) / half)
    bshape = (n,) + (1,) * (x.ndim - 3) + (half // 2,)
    parts = []
    for pos, xa in ((row, x[..., :half]), (col, x[..., half:])):
        ang = (pos[:, None] * inv_freq[None]).reshape(bshape)
        cos, sin = jnp.cos(ang).astype(x.dtype), jnp.sin(ang).astype(x.dtype)
        x1, x2 = xa[..., :half // 2], xa[..., half // 2:]
        parts += [x1 * cos - x2 * sin, x1 * sin + x2 * cos]
    return jnp.concatenate(parts, -1)


def blocked_attention(q, k, v, scale):
    b_, nq, hh, dq = q.shape
    qb = q.reshape(b_, nq // Q_BLOCK, Q_BLOCK, hh, dq).swapaxes(0, 1)

    def one_block(qi):
        s = jnp.einsum('bqhd,bkhd->bhqk', qi, k).astype(f32) * scale
        p = jax.nn.softmax(s, axis=-1).astype(v.dtype)
        return jnp.einsum('bhqk,bkhd->bqhd', p, v)

    o = lax.map(one_block, qb)
    return o.swapaxes(0, 1).reshape(b_, nq, hh, v.shape[-1])


def gla_chunk(q, k, v, logf, s0):
    b_, n, hh, dk = q.shape
    dv = v.shape[-1]
    nc = n // HG_CHUNK
    q, k, v, logf = [t.reshape(b_, nc, HG_CHUNK, hh, t.shape[-1]) for t in (q, k, v, logf)]
    cum = jnp.cumsum(logf, axis=2)
    ref = cum[:, :, HG_CHUNK // 2 - 1:HG_CHUNK // 2]
    q_rel = q * jnp.exp(cum - ref)
    k_rel = k * jnp.exp(ref - cum)
    causal = jnp.tril(jnp.ones((HG_CHUNK, HG_CHUNK), dtype=bool))
    att = jnp.where(causal, jnp.einsum('bnthk,bnshk->bnhts', q_rel, k_rel), 0)
    o = jnp.einsum('bnhts,bnshv->bnthv', att.astype(v.dtype), v)
    total = cum[:, :, -1]
    upd = jnp.einsum('bnshk,bnshv->bnhkv', k * jnp.exp(total[:, :, None] - cum), v)

    def step(s, inp):
        dec, u = inp
        return dec[..., None] * s + u, s

    s_fin, s_prev = lax.scan(step, s0, (jnp.exp(total).swapaxes(0, 1), upd.swapaxes(0, 1)))
    o = o + jnp.einsum('bnthk,nbhkv->bnthv', q * jnp.exp(cum), s_prev)
    return o.reshape(b_, n, hh, dv), s_fin


def hgrn2_mixer(h, w_in, lb, norm_g, w_out, s0):
    b_, n, _ = h.shape
    q, f_fw, f_bw, i, g = jnp.split(h @ w_in, [HG_F, 2 * HG_F, 3 * HG_F, 3 * HG_F + HG_V], axis=-1)
    q = (jax.nn.silu(q) * HG_KDIM ** -0.5).reshape(b_, n, HG_HEADS, HG_KDIM)
    v = i.reshape(b_, n, HG_HEADS, HG_VDIM)
    outs, finals = [], []
    for d, fl in enumerate((f_fw, f_bw)):
        f = (lb[d] + (1 - lb[d]) * jax.nn.sigmoid(fl)).reshape(b_, n, HG_HEADS, HG_KDIM)
        args = (q, 1 - f, v, jnp.log(f))
        if d == 1:
            args = tuple(jnp.flip(t, 1) for t in args)
        o, s = gla_chunk(*args, s0[:, d])
        outs.append(jnp.flip(o, 1) if d == 1 else o)
        finals.append(s)
    o = rms_norm(outs[0] + outs[1], norm_g.reshape(HG_HEADS, HG_VDIM))
    y = (o.reshape(b_, n, HG_V) * jax.nn.silu(g)) @ w_out
    return y, jnp.stack(finals, axis=1)


def short_conv_mixer(h, w_in, conv_w, conv_b, w_out):
    bg, cg, v, g = jnp.split(h @ w_in, 4, axis=-1)
    z = depthwise_conv(cg * v, conv_w, conv_b, (SC_KERNEL // 2, SC_KERNEL // 2))
    return (jax.nn.silu(g) * bg * z) @ w_out


def rglru_mixer(h, w_in, conv_w, conv_b, w_gate, b_gate, lam, w_out, h0):
    b_, n, _ = h.shape
    u, g = jnp.split(h @ w_in, 2, axis=-1)
    u = depthwise_conv(u, conv_w, conv_b, (RG_KERNEL // 2, RG_KERNEL - 1 - RG_KERNEL // 2))
    ub = u.reshape(b_, n, RG_HEADS, RG_BLOCK)
    gates = jax.nn.sigmoid(jnp.einsum('bnhi,dhio->bndho', ub, w_gate) + b_gate)
    r = gates[..., :RG_BLOCK].reshape(b_, n, 2, RG_WIDTH)
    i = gates[..., RG_BLOCK:].reshape(b_, n, 2, RG_WIDTH)
    a = jnp.exp(-RG_C * jax.nn.softplus(-lam) * r)
    xin = jnp.sqrt(1 - a * a) * (i * u[:, :, None])

    def comb(lhs, rhs):
        return lhs[0] * rhs[0], rhs[0] * lhs[1] + rhs[1]

    hs = []
    for d in range(2):
        a_cum, b_cum = lax.associative_scan(comb, (a[:, :, d], xin[:, :, d]), axis=1, reverse=(d == 1))
        hs.append(a_cum * h0[:, d, None] + b_cum)
    y = ((hs[0] + hs[1]) * jax.nn.silu(g)) @ w_out
    return y, jnp.stack([hs[0][:, -1], hs[1][:, 0]], axis=1)


def mla_kv(ckv, kpe, w_kvb):
    b_, n, _ = ckv.shape
    kv = (ckv @ w_kvb).reshape(b_, n, MLA_HEADS, MLA_NOPE + MLA_VDIM)
    k = jnp.concatenate([kv[..., :MLA_NOPE],
                         jnp.broadcast_to(kpe[:, :, None], (b_, n, MLA_HEADS, MLA_ROPE))], -1)
    return k, kv[..., MLA_NOPE:]


def mla_mixer(h, w_in, q_norm, kv_norm, w_qb, w_kvb, w_out, ctx_ckv=None, ctx_kpe=None):
    b_, n, _ = h.shape
    cq, ckv, kpe, g = jnp.split(h @ w_in, [MLA_Q_RANK, MLA_Q_RANK + MLA_KV_RANK,
                                           MLA_Q_RANK + MLA_KV_RANK + MLA_ROPE], axis=-1)
    q = (rms_norm(cq, q_norm) @ w_qb).reshape(b_, n, MLA_HEADS, MLA_NOPE + MLA_ROPE)
    ckv = rms_norm(ckv, kv_norm)
    if ctx_ckv is None:
        k, v = mla_kv(ckv, kpe, w_kvb)
    else:
        q = jnp.concatenate([q[..., :MLA_NOPE], axial_rope(q[..., MLA_NOPE:])], -1)
        k_lat, v_lat = mla_kv(ckv, axial_rope(kpe), w_kvb)
        k_ctx, v_ctx = mla_kv(ctx_ckv, ctx_kpe, w_kvb)
        k = jnp.concatenate([k_ctx, k_lat], axis=1)
        v = jnp.concatenate([v_ctx, v_lat], axis=1)
    o = blocked_attention(q, k, v, (MLA_NOPE + MLA_ROPE) ** -0.5)
    y = (o.reshape(b_, n, MLA_HEADS * MLA_VDIM) * jax.nn.silu(g)) @ w_out
    return y, ckv, kpe


def setup_inputs(seed: int = 0) -> dict:
    key = jax.random.key(seed)
    ks = iter(jax.random.split(key, 48))
    D = D_MODEL

    def nrm(shape, s):
        return jax.random.normal(next(ks), shape, f32) * s

    u = jax.random.uniform(next(ks), (N_RGLRU, 2, RG_WIDTH), f32, 0.9, 0.999)
    base = u ** (1.0 / RG_C)
    rg_lambda = jnp.log(base) - jnp.log1p(-base)
    beta = DEEPNORM_BETA
    return {
        'x_prompt': nrm((BATCH, SEQ, D), 1.0),
        'x_sample': nrm((DEC_BATCH, DEC_SEQ, D), 1.0),
        'state_hgrn': nrm((DEC_BATCH, N_HGRN, 2, HG_HEADS, HG_KDIM, HG_VDIM), 0.5),
        'state_rglru': nrm((DEC_BATCH, N_RGLRU, 2, RG_WIDTH), 0.5),
        'cache_mla_ckv': nrm((DEC_BATCH, N_MLA, PAST_LEN, MLA_KV_RANK), 1.0),
        'cache_mla_kpe': nrm((DEC_BATCH, N_MLA, PAST_LEN, MLA_ROPE), 1.0),
        'c': nrm((DEC_BATCH, D), 1.0),
        'c_ctx': nrm((D,), 1.0),
        'ada_w': nrm((DEPTH, D, 3 * D), D ** -0.5),
        'ada_b': nrm((DEPTH, 3 * D), 0.02),
        'ln_g': 1.0 + nrm((DEPTH, D), 0.02),
        'ln_b': nrm((DEPTH, D), 0.02),
        'hg_w_in': nrm((N_HGRN, D, 3 * HG_F + 2 * HG_V), D ** -0.5),
        'hg_lb_logits': nrm((2, DEPTH + 1, HG_F), 0.1),
        'hg_norm_g': 1.0 + nrm((N_HGRN, HG_V), 0.02),
        'hg_w_out': nrm((N_HGRN, HG_V, D), beta * HG_V ** -0.5),
        'sc_w_in': nrm((N_SCONV, D, 4 * SC_WIDTH), D ** -0.5),
        'sc_conv_w': nrm((N_SCONV, SC_KERNEL, SC_WIDTH), SC_KERNEL ** -0.5),
        'sc_conv_b': nrm((N_SCONV, SC_WIDTH), 0.02),
        'sc_w_out': nrm((N_SCONV, SC_WIDTH, D), beta * SC_WIDTH ** -0.5),
        'rg_w_in': nrm((N_RGLRU, D, 2 * RG_WIDTH), D ** -0.5),
        'rg_conv_w': nrm((N_RGLRU, RG_KERNEL, RG_WIDTH), RG_KERNEL ** -0.5),
        'rg_conv_b': nrm((N_RGLRU, RG_WIDTH), 0.02),
        'rg_w_gate': nrm((N_RGLRU, 2, RG_HEADS, RG_BLOCK, 2 * RG_BLOCK), RG_BLOCK ** -0.5),
        'rg_b_gate': nrm((N_RGLRU, 2, RG_HEADS, 2 * RG_BLOCK), 0.02),
        'rg_lambda': rg_lambda,
        'rg_w_out': nrm((N_RGLRU, RG_WIDTH, D), beta * RG_WIDTH ** -0.5),
        'mla_w_in': nrm((N_MLA, D, MLA_Q_RANK + MLA_KV_RANK + MLA_ROPE + MLA_HEADS * MLA_VDIM), D ** -0.5),
        'mla_q_norm': 1.0 + nrm((N_MLA, MLA_Q_RANK), 0.02),
        'mla_kv_norm': 1.0 + nrm((N_MLA, MLA_KV_RANK), 0.02),
        'mla_w_qb': nrm((N_MLA, MLA_Q_RANK, MLA_HEADS * (MLA_NOPE + MLA_ROPE)), MLA_Q_RANK ** -0.5),
        'mla_w_kvb': nrm((N_MLA, MLA_KV_RANK, MLA_HEADS * (MLA_NOPE + MLA_VDIM)), MLA_KV_RANK ** -0.5),
        'mla_w_out': nrm((N_MLA, MLA_HEADS * MLA_VDIM, D), beta * (MLA_HEADS * MLA_VDIM) ** -0.5),
    }


def reference(x_prompt, x_sample, state_hgrn, state_rglru, cache_mla_ckv, cache_mla_kpe, c, c_ctx,
              ada_w, ada_b, ln_g, ln_b, hg_w_in, hg_lb_logits, hg_norm_g, hg_w_out,
              sc_w_in, sc_conv_w, sc_conv_b, sc_w_out,
              rg_w_in, rg_conv_w, rg_conv_b, rg_w_gate, rg_b_gate, rg_lambda, rg_w_out,
              mla_w_in, mla_q_norm, mla_kv_norm, mla_w_qb, mla_w_kvb, mla_w_out):
    hg_lb = jnp.cumsum(jax.nn.softmax(hg_lb_logits.astype(f32), axis=1), axis=1)

    x = x_prompt
    bsz = x.shape[0]
    hg_new, rg_new, ckv_new, kpe_new = [], [], [], []
    for l in range(DEPTH):
        m, j = l % N_MIXERS, l // N_MIXERS
        shift, scale, gate = modulation(c_ctx, ada_w[l], ada_b[l])
        h = x * (1 + scale) + shift
        if m == 0:
            s0 = jnp.zeros((bsz, 2, HG_HEADS, HG_KDIM, HG_VDIM), x.dtype)
            out, s = hgrn2_mixer(h, hg_w_in[j], hg_lb[:, l].astype(x.dtype), hg_norm_g[j], hg_w_out[j], s0)
            hg_new.append(s)
        elif m == 1:
            out = short_conv_mixer(h, sc_w_in[j], sc_conv_w[j], sc_conv_b[j], sc_w_out[j])
        elif m == 2:
            h0 = jnp.zeros((bsz, 2, RG_WIDTH), x.dtype)
            out, s = rglru_mixer(h, rg_w_in[j], rg_conv_w[j], rg_conv_b[j], rg_w_gate[j], rg_b_gate[j],
                                 rg_lambda[j], rg_w_out[j], h0)
            rg_new.append(s)
        else:
            out, ckv, kpe = mla_mixer(h, mla_w_in[j], mla_q_norm[j], mla_kv_norm[j], mla_w_qb[j],
                                      mla_w_kvb[j], mla_w_out[j])
            ckv_new.append(ckv)
            kpe_new.append(kpe)
        x = layer_norm(DEEPNORM_ALPHA * x + gate * out, ln_g[l], ln_b[l])
    y_prompt = x

    x = x_sample
    for l in range(DEPTH):
        m, j = l % N_MIXERS, l // N_MIXERS
        shift, scale, gate = [t[:, None] for t in modulation(c, ada_w[l], ada_b[l])]
        h = x * (1 + scale) + shift
        if m == 0:
            out, _ = hgrn2_mixer(h, hg_w_in[j], hg_lb[:, l].astype(x.dtype), hg_norm_g[j], hg_w_out[j],
                                 state_hgrn[:, j])
        elif m == 1:
            out = short_conv_mixer(h, sc_w_in[j], sc_conv_w[j], sc_conv_b[j], sc_w_out[j])
        elif m == 2:
            out, _ = rglru_mixer(h, rg_w_in[j], rg_conv_w[j], rg_conv_b[j], rg_w_gate[j], rg_b_gate[j],
                                 rg_lambda[j], rg_w_out[j], state_rglru[:, j])
        else:
            out, _, _ = mla_mixer(h, mla_w_in[j], mla_q_norm[j], mla_kv_norm[j], mla_w_qb[j],
                                  mla_w_kvb[j], mla_w_out[j], cache_mla_ckv[:, j], cache_mla_kpe[:, j])
        x = layer_norm(DEEPNORM_ALPHA * x + gate * out, ln_g[l], ln_b[l])
    y_sample = x

    new_state_hgrn = jnp.stack(hg_new, axis=1)
    new_state_rglru = jnp.stack(rg_new, axis=1)
    new_cache_mla_ckv = jnp.stack(ckv_new, axis=1)
    new_cache_mla_kpe = jnp.stack(kpe_new, axis=1)
    return (y_prompt, y_sample, new_state_hgrn, new_state_rglru, new_cache_mla_ckv, new_cache_mla_kpe)
```

```cpp
#include <hip/hip_runtime.h>
#include <hip/hip_cooperative_groups.h>
#include <cstdio>
namespace cg = cooperative_groups;

#ifndef MULTI_LAUNCH
#define MULTI_LAUNCH 0
#endif

typedef unsigned short u16;
using bf16x8 = __attribute__((ext_vector_type(8))) short;
using f32x4 = __attribute__((ext_vector_type(4))) float;
typedef _Float16 h4 __attribute__((ext_vector_type(4)));

#define TOK 12288
#define NPROMPT 8192
#define KVROWS 14336
#define NPHASES 23
#ifndef PHMASK
#define PHMASK 0x7fffff
#endif
#define PH_END if (ph + 1 < p.phase_hi) cg::this_grid().sync();
#define DN_ALPHA 1.6817928305074290f

#define WS_W_HG_IN 0ull
#define WS_W_HG_OUT (WS_W_HG_IN + 10485760ull)
#define WS_W_SC_IN (WS_W_HG_OUT + 2097152ull)
#define WS_W_SC_OUT (WS_W_SC_IN + 8388608ull)
#define WS_W_RG_IN (WS_W_SC_OUT + 2097152ull)
#define WS_W_RG_GATE (WS_W_RG_IN + 4194304ull)
#define WS_W_RG_OUT (WS_W_RG_GATE + 2097152ull)
#define WS_W_MLA_IN (WS_W_RG_OUT + 2097152ull)
#define WS_W_QB (WS_W_MLA_IN + 3670016ull)
#define WS_W_KVB (WS_W_QB + 1179648ull)
#define WS_W_MLA_OUT (WS_W_KVB + 1048576ull)
#define WS_MOD (WS_W_MLA_OUT + 2097152ull)
#define WS_LB (WS_MOD + 245760ull)
#define WS_CNT (WS_LB + 8192ull)
#define WS_R (WS_CNT + 4096ull)
#define BSZ 25165824ull
#define WS_H (WS_R)
#define WS_B(i) (WS_R + BSZ * (1 + (i)))
#define WS3_CQ (WS_R + 25165824ull)
#define WS3_CKVALL (WS_R + 34603008ull)
#define WS3_CKVRAW (WS_R + 41943040ull)
#define WS3_KPERAW (WS_R + 54525952ull)
#define WS3_SG (WS_R + 56098816ull)
#define WS3_Q (WS_R + 81264640ull)
#define WS3_K (WS_R + 119013376ull)
#define WS3_VT (WS_R + 163053568ull)

#define OUT_HG 12582912
#define OUT_RG 20971520
#define OUT_CKV 21037056
#define OUT_KPE 23134208

struct Params {
  const float* in[33];
  float* out;
  unsigned char* ws;
  int phase_lo, phase_hi;
};

__device__ __forceinline__ u16 f2bf(float f) {
  unsigned u = __float_as_uint(f);
  u += 0x7fffu + ((u >> 16) & 1u);
  return (u16)(u >> 16);
}
__device__ __forceinline__ float bf2f(u16 h) { return __uint_as_float(((unsigned)h) << 16); }
__device__ __forceinline__ unsigned pack2(float a, float b) { return (unsigned)f2bf(a) | ((unsigned)f2bf(b) << 16); }
__device__ __forceinline__ uint2 pack4(float a, float b, float c, float d) { return make_uint2(pack2(a, b), pack2(c, d)); }
__device__ __forceinline__ float lo16(unsigned u) { return __uint_as_float(u << 16); }
__device__ __forceinline__ float hi16(unsigned u) { return __uint_as_float(u & 0xffff0000u); }
__device__ __forceinline__ float sigmoidf_(float x) { return 1.0f / (1.0f + __expf(-x)); }
__device__ __forceinline__ float siluf_(float x) { return x / (1.0f + __expf(-x)); }
__device__ __forceinline__ int cond_of(int tok) { return tok < NPROMPT ? 0 : 1 + ((tok - NPROMPT) >> 10); }
__device__ __forceinline__ float wave_sum(float v) {
#pragma unroll
  for (int o = 32; o > 0; o >>= 1) v += __shfl_xor(v, o);
  return v;
}
__device__ __forceinline__ void rope_sincos(float pos, int fi, float& sn, float& cs) {
  float inv = exp2f(-(float)fi * 1.6609640474436813f);
  float ang = pos * inv;
  float k = rintf(ang * 0.15915494309189535f);
  float r = fmaf(-k, 6.2831854820251465f, ang);
  r = fmaf(-k, -1.7484555e-7f, r);
  sn = __sinf(r); cs = __cosf(r);
}

#define LSTR 72
struct AOffNone { __device__ __forceinline__ int operator()(int) const { return 0; } };
struct AOffGate { __device__ __forceinline__ int operator()(int n0) const { return ((n0 >> 9) & 3) * 256; } };

template <class Epi, class AOff>
__device__ __forceinline__ void gemm_tiles(const u16* __restrict__ A, int lda, const u16* __restrict__ Bt, int K,
                                           int Mtiles, int Ntiles, const Epi& epi, AOff aoff, u16* smem, int bid, int nb) {
  const int tid = threadIdx.x, lane = tid & 63, wave = tid >> 6;
  const int wm = wave >> 1, wn = wave & 1, fr = lane & 15, fq = lane >> 4;
  const int ntiles = Mtiles * Ntiles, nk = K >> 6;
  const int lrow = tid >> 3, lcol = (tid & 7) * 8;
  for (int t = bid; t < ntiles; t += nb) {
    const int nt = t / Mtiles, mt = t - nt * Mtiles;
    const int m0 = mt * 128, n0 = nt * 128;
    const u16* Ag = A + (size_t)(m0 + lrow) * lda + aoff(n0) + lcol;
    const u16* Bg = Bt + (size_t)(n0 + lrow) * K + lcol;
    uint4 ra[4], rb[4];
#pragma unroll
    for (int i = 0; i < 4; ++i) {
      ra[i] = *(const uint4*)(Ag + (size_t)i * 32 * lda);
      rb[i] = *(const uint4*)(Bg + (size_t)i * 32 * K);
    }
    f32x4 acc[4][4];
#pragma unroll
    for (int i = 0; i < 4; ++i)
#pragma unroll
      for (int j = 0; j < 4; ++j) acc[i][j] = f32x4{0.f, 0.f, 0.f, 0.f};
#pragma unroll
    for (int i = 0; i < 4; ++i) {
      *(uint4*)&smem[(lrow + i * 32) * LSTR + lcol] = ra[i];
      *(uint4*)&smem[(128 + lrow + i * 32) * LSTR + lcol] = rb[i];
    }
    __syncthreads();
    for (int kt = 0; kt < nk; ++kt) {
      const u16* ca = smem + (kt & 1) * (256 * LSTR);
      const u16* cb = ca + 128 * LSTR;
      const bool more = (kt + 1 < nk);
      if (more) {
#pragma unroll
        for (int i = 0; i < 4; ++i) {
          ra[i] = *(const uint4*)(Ag + (size_t)i * 32 * lda + (kt + 1) * 64);
          rb[i] = *(const uint4*)(Bg + (size_t)i * 32 * K + (kt + 1) * 64);
        }
      }
#pragma unroll
      for (int ks = 0; ks < 2; ++ks) {
        bf16x8 af[4], bfr[4];
#pragma unroll
        for (int mi = 0; mi < 4; ++mi) af[mi] = *(const bf16x8*)&ca[(wm * 64 + mi * 16 + fr) * LSTR + ks * 32 + fq * 8];
#pragma unroll
        for (int ni = 0; ni < 4; ++ni) bfr[ni] = *(const bf16x8*)&cb[(wn * 64 + ni * 16 + fr) * LSTR + ks * 32 + fq * 8];
#pragma unroll
        for (int mi = 0; mi < 4; ++mi)
#pragma unroll
          for (int ni = 0; ni < 4; ++ni)
            acc[mi][ni] = __builtin_amdgcn_mfma_f32_16x16x32_bf16(bfr[ni], af[mi], acc[mi][ni], 0, 0, 0);
      }
      if (more) {
        u16* na = smem + ((kt + 1) & 1) * (256 * LSTR);
#pragma unroll
        for (int i = 0; i < 4; ++i) {
          *(uint4*)&na[(lrow + i * 32) * LSTR + lcol] = ra[i];
          *(uint4*)&na[(128 + lrow + i * 32) * LSTR + lcol] = rb[i];
        }
      }
      __syncthreads();
    }
    epi(m0 + wm * 64, n0 + wn * 64, acc, lane);
  }
}

struct EpiHgIn {
  u16 *q, *v, *sg; _Float16* lf; const float* lb;
  __device__ __forceinline__ void operator()(int m0w, int n0w, f32x4 (&acc)[4][4], int lane) const {
    const int fr = lane & 15, fq = lane >> 4, region = n0w >> 10;
#pragma unroll
    for (int mi = 0; mi < 4; ++mi) {
      const size_t row = m0w + mi * 16 + fr;
#pragma unroll
      for (int ni = 0; ni < 4; ++ni) {
        const int c = (n0w & 1023) + ni * 16 + fq * 4;
        f32x4 a = acc[mi][ni];
        if (region == 0) {
          const float s = 0.08838834764831845f;
          *(uint2*)&q[row * 1024 + c] = pack4(siluf_(a[0]) * s, siluf_(a[1]) * s, siluf_(a[2]) * s, siluf_(a[3]) * s);
        } else if (region <= 2) {
          const int d = region - 1;
          f32x4 l4 = *(const f32x4*)&lb[d * 1024 + c];
          h4 o;
#pragma unroll
          for (int j = 0; j < 4; ++j) {
            float f = l4[j] + (1.0f - l4[j]) * sigmoidf_(a[j]);
            o[j] = (_Float16)__logf(f);
          }
          *(h4*)&lf[row * 2048 + d * 1024 + c] = o;
        } else if (region == 3) {
          *(uint2*)&v[row * 1024 + c] = pack4(a[0], a[1], a[2], a[3]);
        } else {
          *(uint2*)&sg[row * 1024 + c] = pack4(siluf_(a[0]), siluf_(a[1]), siluf_(a[2]), siluf_(a[3]));
        }
      }
    }
  }
};

struct EpiRes {
  const float* xin_p; const float* xin_s; float* Y; const float* gate;
  __device__ __forceinline__ void operator()(int m0w, int n0w, f32x4 (&acc)[4][4], int lane) const {
    const int fr = lane & 15, fq = lane >> 4;
#pragma unroll
    for (int mi = 0; mi < 4; ++mi) {
      const int row = m0w + mi * 16 + fr;
      const float* xr = row < NPROMPT ? xin_p + (size_t)row * 1024 : xin_s + (size_t)(row - NPROMPT) * 1024;
      const float* g = gate + cond_of(row) * 3072;
#pragma unroll
      for (int ni = 0; ni < 4; ++ni) {
        const int c = n0w + ni * 16 + fq * 4;
        f32x4 x = *(const f32x4*)&xr[c];
        f32x4 gg = *(const f32x4*)&g[c];
        f32x4 a = acc[mi][ni];
        f32x4 y;
#pragma unroll
        for (int j = 0; j < 4; ++j) y[j] = DN_ALPHA * x[j] + gg[j] * a[j];
        *(f32x4*)&Y[(size_t)row * 1024 + c] = y;
      }
    }
  }
};

struct EpiScIn {
  u16 *pb, *sb;
  __device__ __forceinline__ void operator()(int m0w, int n0w, f32x4 (&acc)[4][4], int lane) const {
    const int fr = lane & 15, fq = lane >> 4;
    const int c = (n0w >> 6) * 16 + fq * 4;
#pragma unroll
    for (int mi = 0; mi < 4; ++mi) {
      const size_t row = m0w + mi * 16 + fr;
      f32x4 bg = acc[mi][0], cgv = acc[mi][1], v = acc[mi][2], g = acc[mi][3];
      *(uint2*)&pb[row * 1024 + c] = pack4(cgv[0] * v[0], cgv[1] * v[1], cgv[2] * v[2], cgv[3] * v[3]);
      *(uint2*)&sb[row * 1024 + c] = pack4(siluf_(g[0]) * bg[0], siluf_(g[1]) * bg[1], siluf_(g[2]) * bg[2], siluf_(g[3]) * bg[3]);
    }
  }
};

struct EpiRgIn {
  u16 *ub, *sg;
  __device__ __forceinline__ void operator()(int m0w, int n0w, f32x4 (&acc)[4][4], int lane) const {
    const int fr = lane & 15, fq = lane >> 4, region = n0w >> 10;
#pragma unroll
    for (int mi = 0; mi < 4; ++mi) {
      const size_t row = m0w + mi * 16 + fr;
#pragma unroll
      for (int ni = 0; ni < 4; ++ni) {
        const int c = (n0w & 1023) + ni * 16 + fq * 4;
        f32x4 a = acc[mi][ni];
        if (region == 0) *(uint2*)&ub[row * 1024 + c] = pack4(a[0], a[1], a[2], a[3]);
        else *(uint2*)&sg[row * 1024 + c] = pack4(siluf_(a[0]), siluf_(a[1]), siluf_(a[2]), siluf_(a[3]));
      }
    }
  }
};

struct EpiRgGate {
  u16 *rb, *ib; const float* bgate;
  __device__ __forceinline__ void operator()(int m0w, int n0w, f32x4 (&acc)[4][4], int lane) const {
    const int fr = lane & 15, fq = lane >> 4;
    const int mat = n0w >> 9, d = mat >> 2, hd = mat & 3, off = n0w & 511;
#pragma unroll
    for (int mi = 0; mi < 4; ++mi) {
      const size_t row = m0w + mi * 16 + fr;
#pragma unroll
      for (int pr = 0; pr < 2; ++pr) {
        const int cc = (off >> 5) * 16 + pr * 16 + fq * 4;
        f32x4 br = *(const f32x4*)&bgate[mat * 512 + cc];
        f32x4 bi = *(const f32x4*)&bgate[mat * 512 + 256 + cc];
        f32x4 r = acc[mi][pr * 2], ii = acc[mi][pr * 2 + 1];
        const size_t o = ((size_t)d * TOK + row) * 1024 + hd * 256 + cc;
        *(uint2*)&rb[o] = pack4(sigmoidf_(r[0] + br[0]), sigmoidf_(r[1] + br[1]), sigmoidf_(r[2] + br[2]), sigmoidf_(r[3] + br[3]));
        *(uint2*)&ib[o] = pack4(sigmoidf_(ii[0] + bi[0]), sigmoidf_(ii[1] + bi[1]), sigmoidf_(ii[2] + bi[2]), sigmoidf_(ii[3] + bi[3]));
      }
    }
  }
};

struct EpiMlaIn {
  u16* cq; float* ckvraw; float* kperaw; u16* sg;
  __device__ __forceinline__ void operator()(int m0w, int n0w, f32x4 (&acc)[4][4], int lane) const {
    const int fr = lane & 15, fq = lane >> 4;
#pragma unroll
    for (int mi = 0; mi < 4; ++mi) {
      const size_t row = m0w + mi * 16 + fr;
#pragma unroll
      for (int ni = 0; ni < 4; ++ni) {
        const int cb = n0w + ni * 16;
        const int c = cb + fq * 4;
        f32x4 a = acc[mi][ni];
        if (cb < 384) *(uint2*)&cq[row * 384 + c] = pack4(a[0], a[1], a[2], a[3]);
        else if (cb < 640) *(f32x4*)&ckvraw[row * 256 + (c - 384)] = a;
        else if (cb < 672) *(f32x4*)&kperaw[row * 32 + (c - 640)] = a;
        else if (cb < 1696) *(uint2*)&sg[row * 1024 + (c - 672)] = pack4(siluf_(a[0]), siluf_(a[1]), siluf_(a[2]), siluf_(a[3]));
      }
    }
  }
};

struct EpiQ {
  u16* q;
  __device__ __forceinline__ void operator()(int m0w, int n0w, f32x4 (&acc)[4][4], int lane) const {
    const int fr = lane & 15, fq = lane >> 4;
    const float sc = 0.10206207261596575f;
    const bool sample = m0w >= NPROMPT;
#pragma unroll
    for (int mi = 0; mi < 4; ++mi) {
      const int row = m0w + mi * 16 + fr;
      const int n = (row - NPROMPT) & 1023;
#pragma unroll
      for (int ni = 0; ni < 4; ++ni) {
        const int cb = n0w + ni * 16;
        const int typ = (cb % 96) >> 4;
        f32x4 a = acc[mi][ni];
        if (sample && typ >= 4) {
          const float pos = (typ == 4) ? (float)(n >> 6) : (float)(n & 63);
#pragma unroll
          for (int j = 0; j < 4; ++j) {
            float partner = __shfl_xor(a[j], 32);
            float sn, cs;
            rope_sincos(pos, (fq & 1) * 4 + j, sn, cs);
            a[j] = (fq < 2) ? (a[j] * cs - partner * sn) : (partner * sn + a[j] * cs);
          }
        }
        *(uint2*)&q[(size_t)row * 1536 + cb + fq * 4] = pack4(a[0] * sc, a[1] * sc, a[2] * sc, a[3] * sc);
      }
    }
  }
};

struct EpiKV {
  u16 *Kb, *Vt;
  __device__ __forceinline__ void operator()(int m0w, int n0w, f32x4 (&acc)[4][4], int lane) const {
    const int fr = lane & 15, fq = lane >> 4;
    const int h = n0w >> 7, isv = (n0w >> 6) & 1;
#pragma unroll
    for (int mi = 0; mi < 4; ++mi) {
      const size_t row = m0w + mi * 16 + fr;
#pragma unroll
      for (int ni = 0; ni < 4; ++ni) {
        const int dd = ni * 16 + fq * 4;
        f32x4 a = acc[mi][ni];
        if (!isv) {
          *(uint2*)&Kb[(row * 16 + h) * 96 + dd] = pack4(a[0], a[1], a[2], a[3]);
        } else {
#pragma unroll
          for (int j = 0; j < 4; ++j) Vt[((size_t)(h * 64 + dd + j)) * KVROWS + row] = f2bf(a[j]);
        }
      }
    }
  }
};

__device__ __forceinline__ void wconv_tile(const float* __restrict__ src, int N, int K, u16* __restrict__ dst, int k0, int n0,
                                           int perm, int mat, float* tile) {
  const int tid = threadIdx.x;
  {
    const int r = tid >> 4, c4 = (tid & 15) * 4;
#pragma unroll
    for (int i = 0; i < 4; ++i) {
      const int k = r + i * 16;
      f32x4 v = f32x4{0.f, 0.f, 0.f, 0.f};
      if (n0 + c4 < N) v = *(const f32x4*)&src[(size_t)(k0 + k) * N + n0 + c4];
      tile[k * 65 + c4 + 0] = v[0]; tile[k * 65 + c4 + 1] = v[1]; tile[k * 65 + c4 + 2] = v[2]; tile[k * 65 + c4 + 3] = v[3];
    }
  }
  __syncthreads();
  {
    const int nl = tid >> 2, kq = (tid & 3) * 16;
    const int n = n0 + nl;
    int np = n;
    if (perm == 1) { int part = n >> 10, c = n & 1023; np = (c >> 4) * 64 + part * 16 + (c & 15); }
    else if (perm == 2) { int type = n >> 8, cc = n & 255; np = mat * 512 + (cc >> 4) * 32 + type * 16 + (cc & 15); }
    if (n < N) {
      unsigned w[8];
#pragma unroll
      for (int i = 0; i < 8; ++i) w[i] = pack2(tile[(kq + 2 * i) * 65 + nl], tile[(kq + 2 * i + 1) * 65 + nl]);
      uint4* d = (uint4*)&dst[(size_t)np * K + k0 + kq];
      d[0] = make_uint4(w[0], w[1], w[2], w[3]);
      d[1] = make_uint4(w[4], w[5], w[6], w[7]);
    }
  }
  __syncthreads();
}

__device__ void phase_prologue(const Params& p, unsigned char* smem_raw, int bid, int nb) {
  float* fs = (float*)smem_raw;
  const int tid = threadIdx.x;
  const int NMOD = 192, NW = 4800;
  for (int it = bid; it < NMOD + 1 + NW; it += nb) {
    if (it < NMOD) {
      const int l = it / 48, n0 = (it % 48) * 64;
      float* scond = fs;
      float* sred = fs + 5120;
      for (int i = tid; i < 5120; i += 256) {
        const int ci = i >> 10, k = i & 1023;
        float cv = ci == 0 ? p.in[7][k] : p.in[6][(ci - 1) * 1024 + k];
        scond[i] = siluf_(cv);
      }
      __syncthreads();
      const int col = tid & 63, kg = tid >> 6;
      const float* w = p.in[8] + (size_t)l * 1024 * 3072 + n0 + col;
      float a0 = 0, a1 = 0, a2 = 0, a3 = 0, a4 = 0;
#pragma unroll 8
      for (int k = kg * 256; k < kg * 256 + 256; ++k) {
        float wv = w[(size_t)k * 3072];
        a0 += scond[k] * wv; a1 += scond[1024 + k] * wv; a2 += scond[2048 + k] * wv; a3 += scond[3072 + k] * wv; a4 += scond[4096 + k] * wv;
      }
      sred[(kg * 5 + 0) * 64 + col] = a0; sred[(kg * 5 + 1) * 64 + col] = a1; sred[(kg * 5 + 2) * 64 + col] = a2;
      sred[(kg * 5 + 3) * 64 + col] = a3; sred[(kg * 5 + 4) * 64 + col] = a4;
      __syncthreads();
      float* mod = (float*)(p.ws + WS_MOD);
      for (int i = tid; i < 320; i += 256) {
        const int ci = i >> 6, cc = i & 63;
        float s = sred[(0 * 5 + ci) * 64 + cc] + sred[(1 * 5 + ci) * 64 + cc] + sred[(2 * 5 + ci) * 64 + cc] + sred[(3 * 5 + ci) * 64 + cc];
        mod[(l * 5 + ci) * 3072 + n0 + cc] = s + p.in[9][l * 3072 + n0 + cc];
      }
      __syncthreads();
    } else if (it == NMOD) {
      float* lb = (float*)(p.ws + WS_LB);
      for (int i = tid; i < 2048; i += 256) {
        const int d = i >> 10, c = i & 1023;
        const float* lg = p.in[13] + d * 5 * 1024 + c;
        float m = lg[0];
        for (int j = 1; j < 5; ++j) m = fmaxf(m, lg[j * 1024]);
        float s = 0;
        for (int j = 0; j < 5; ++j) s += expf(lg[j * 1024] - m);
        lb[i] = expf(lg[0] - m) / s;
      }
      int* cnt = (int*)(p.ws + WS_CNT);
      if (tid < 16) cnt[tid] = 0;
    } else {
      int t = it - NMOD - 1;
      const float* src; u16* dst; int N, K, perm = 0, mat = 0, ntn;
      if (t < 1280) { src = p.in[12]; dst = (u16*)(p.ws + WS_W_HG_IN); N = 5120; K = 1024; }
      else if ((t -= 1280) < 256) { src = p.in[15]; dst = (u16*)(p.ws + WS_W_HG_OUT); N = 1024; K = 1024; }
      else if ((t -= 256) < 1024) { src = p.in[16]; dst = (u16*)(p.ws + WS_W_SC_IN); N = 4096; K = 1024; perm = 1; }
      else if ((t -= 1024) < 256) { src = p.in[19]; dst = (u16*)(p.ws + WS_W_SC_OUT); N = 1024; K = 1024; }
      else if ((t -= 256) < 512) { src = p.in[20]; dst = (u16*)(p.ws + WS_W_RG_IN); N = 2048; K = 1024; }
      else if ((t -= 512) < 256) { mat = t >> 5; t &= 31; src = p.in[23] + (size_t)mat * 256 * 512; dst = (u16*)(p.ws + WS_W_RG_GATE); N = 512; K = 256; perm = 2; }
      else if ((t -= 256) < 256) { src = p.in[26]; dst = (u16*)(p.ws + WS_W_RG_OUT); N = 1024; K = 1024; }
      else if ((t -= 256) < 432) { src = p.in[27]; dst = (u16*)(p.ws + WS_W_MLA_IN); N = 1696; K = 1024; }
      else if ((t -= 432) < 144) { src = p.in[30]; dst = (u16*)(p.ws + WS_W_QB); N = 1536; K = 384; }
      else if ((t -= 144) < 128) { src = p.in[31]; dst = (u16*)(p.ws + WS_W_KVB); N = 2048; K = 256; }
      else { t -= 128; src = p.in[32]; dst = (u16*)(p.ws + WS_W_MLA_OUT); N = 1024; K = 1024; }
      ntn = (N + 63) >> 6;
      const int kt = t / ntn, ntl = t - kt * ntn;
      wconv_tile(src, N, K, dst, kt * 64, ntl * 64, perm, mat, fs);
    }
  }
}

__device__ void phase_h0(const Params& p, int bid, int nb) {
  const float* mod = (const float*)(p.ws + WS_MOD);
  u16* H = (u16*)(p.ws + WS_H);
  const size_t total = (size_t)TOK * 256;
  for (size_t i = (size_t)bid * 256 + threadIdx.x; i < total; i += (size_t)nb * 256) {
    const int row = (int)(i >> 8), c = ((int)i & 255) * 4;
    const float* xr = row < NPROMPT ? p.in[0] + (size_t)row * 1024 : p.in[1] + (size_t)(row - NPROMPT) * 1024;
    const float* m = mod + cond_of(row) * 3072;
    f32x4 x = *(const f32x4*)&xr[c];
    f32x4 sh = *(const f32x4*)&m[c];
    f32x4 sc = *(const f32x4*)&m[1024 + c];
    *(uint2*)&H[(size_t)row * 1024 + c] = pack4(x[0] * (1 + sc[0]) + sh[0], x[1] * (1 + sc[1]) + sh[1], x[2] * (1 + sc[2]) + sh[2], x[3] * (1 + sc[3]) + sh[3]);
  }
}

__device__ void phase_ln(const Params& p, int l, int bid, int nb) {
  float* X = p.out;
  const float* g = p.in[10] + l * 1024;
  const float* b = p.in[11] + l * 1024;
  const float* mod = (const float*)(p.ws + WS_MOD) + (l + 1) * 5 * 3072;
  u16* H = (u16*)(p.ws + WS_H);
  const int lane = threadIdx.x & 63, wave = threadIdx.x >> 6;
  for (int row = bid * 4 + wave; row < TOK; row += nb * 4) {
    float* xr = X + (size_t)row * 1024;
    f32x4 v[4];
    float s = 0;
#pragma unroll
    for (int i = 0; i < 4; ++i) { v[i] = *(const f32x4*)&xr[i * 256 + lane * 4]; s += v[i][0] + v[i][1] + v[i][2] + v[i][3]; }
    const float mu = wave_sum(s) * (1.0f / 1024.0f);
    float q = 0;
#pragma unroll
    for (int i = 0; i < 4; ++i)
#pragma unroll
      for (int j = 0; j < 4; ++j) { float dd = v[i][j] - mu; q += dd * dd; }
    const float rs = rsqrtf(wave_sum(q) * (1.0f / 1024.0f) + 1e-5f);
    const float* m = mod + cond_of(row) * 3072;
#pragma unroll
    for (int i = 0; i < 4; ++i) {
      const int c = i * 256 + lane * 4;
      f32x4 gg = *(const f32x4*)&g[c], bb = *(const f32x4*)&b[c];
      f32x4 y;
#pragma unroll
      for (int j = 0; j < 4; ++j) y[j] = (v[i][j] - mu) * rs * gg[j] + bb[j];
      *(f32x4*)&xr[c] = y;
      if (l < 3) {
        f32x4 sh = *(const f32x4*)&m[c], sc = *(const f32x4*)&m[1024 + c];
        *(uint2*)&H[(size_t)row * 1024 + c] = pack4(y[0] * (1 + sc[0]) + sh[0], y[1] * (1 + sc[1]) + sh[1], y[2] * (1 + sc[2]) + sh[2], y[3] * (1 + sc[3]) + sh[3]);
      }
    }
  }
}

__device__ void phase_gla(const Params& p, unsigned char* smem_raw) {
  u16* s_qrel = (u16*)smem_raw;
  u16* s_krel = s_qrel + 32 * 136;
  u16* s_qcum = s_krel + 32 * 136;
  u16* s_kdT = s_qcum + 32 * 136;
  u16* s_vT = s_kdT + 128 * 40;
  u16* s_att = s_vT + 32 * 40;
  u16* s_S = s_att + 32 * 40;
  float* s_dec = (float*)(s_S + 32 * 136);
  float* s_part = s_dec + 128;
  int* s_u = (int*)(s_part + 256);
  int* counter = (int*)(p.ws + WS_CNT);
  const u16* qg = (const u16*)(p.ws + WS_B(0));
  const u16* vg = (const u16*)(p.ws + WS_B(1));
  const _Float16* lfg = (const _Float16*)(p.ws + WS_B(3));
  u16* og = (u16*)(p.ws + WS_B(5));
  const int tid = threadIdx.x, lane = tid & 63, w = tid >> 6, fr = lane & 15, fq = lane >> 4;
  const int kk = tid & 127, th = tid >> 7;
  const int ti = w >> 1, vi = w & 1;
  while (true) {
    if (tid == 0) *s_u = atomicAdd(counter, 1);
    __syncthreads();
    const int u = *s_u;
    __syncthreads();
    if (u >= 2304) break;
    int b, rem, start, N, sample;
    if (u < 256) { sample = 1; b = u >> 6; rem = u & 63; start = NPROMPT + b * 1024; N = 1024; }
    else { sample = 0; b = (u - 256) >> 6; rem = (u - 256) & 63; start = b * 256; N = 256; }
    const int h = rem >> 3, d = (rem >> 2) & 1, vs = rem & 3;
    const int nc = N >> 5;
    f32x4 S[2][2];
#pragma unroll
    for (int mi = 0; mi < 2; ++mi)
#pragma unroll
      for (int ni = 0; ni < 2; ++ni) {
        f32x4 s4 = f32x4{0.f, 0.f, 0.f, 0.f};
        if (sample) {
          const float* s0 = p.in[2] + ((size_t)((b * 2 + d) * 8 + h)) * 16384;
#pragma unroll
          for (int j = 0; j < 4; ++j) s4[j] = s0[(w * 32 + mi * 16 + fq * 4 + j) * 128 + vs * 32 + ni * 16 + fr];
        }
        S[mi][ni] = s4;
        *(uint2*)&s_S[(ni * 16 + fr) * 136 + w * 32 + mi * 16 + fq * 4] = pack4(s4[0], s4[1], s4[2], s4[3]);
      }
    for (int c = 0; c < nc; ++c) {
      {
        float lfv[16], qv[16];
#pragma unroll
        for (int i = 0; i < 16; ++i) {
          const int tt = c * 32 + th * 16 + i;
          const size_t tok = start + (d ? (N - 1 - tt) : tt);
          lfv[i] = (float)lfg[tok * 2048 + d * 1024 + h * 128 + kk];
          qv[i] = bf2f(qg[tok * 1024 + h * 128 + kk]);
        }
        float run = 0;
        float cs[16];
#pragma unroll
        for (int i = 0; i < 16; ++i) { run += lfv[i]; cs[i] = run; }
        s_part[th * 128 + kk] = run;
        {
          const int s = tid >> 3, v4 = (tid & 7) * 4;
          const int tt = c * 32 + s;
          const size_t tok = start + (d ? (N - 1 - tt) : tt);
          uint2 vv = *(const uint2*)&vg[tok * 1024 + h * 128 + vs * 32 + v4];
          s_vT[(v4 + 0) * 40 + s] = (u16)(vv.x & 0xffff); s_vT[(v4 + 1) * 40 + s] = (u16)(vv.x >> 16);
          s_vT[(v4 + 2) * 40 + s] = (u16)(vv.y & 0xffff); s_vT[(v4 + 3) * 40 + s] = (u16)(vv.y >> 16);
        }
        __syncthreads();
        const float p0 = s_part[kk], p1 = s_part[128 + kk];
        const float off = th ? p0 : 0.f, ref = p0, total = p0 + p1;
        unsigned kd[8];
#pragma unroll
        for (int i = 0; i < 16; ++i) {
          const int t = th * 16 + i;
          const float cum = off + cs[i];
          const float kf = 1.0f - __expf(lfv[i]);
          s_qrel[t * 136 + kk] = f2bf(qv[i] * __expf(cum - ref));
          s_krel[t * 136 + kk] = f2bf(kf * __expf(ref - cum));
          s_qcum[t * 136 + kk] = f2bf(qv[i] * __expf(cum));
          const u16 kdv = f2bf(kf * __expf(total - cum));
          if (i & 1) kd[i >> 1] |= ((unsigned)kdv) << 16; else kd[i >> 1] = kdv;
        }
        uint4* kp = (uint4*)&s_kdT[kk * 40 + th * 16];
        kp[0] = make_uint4(kd[0], kd[1], kd[2], kd[3]);
        kp[1] = make_uint4(kd[4], kd[5], kd[6], kd[7]);
        if (th == 0) s_dec[kk] = __expf(total);
      }
      __syncthreads();
      f32x4 oacc = f32x4{0.f, 0.f, 0.f, 0.f};
      {
        f32x4 att = f32x4{0.f, 0.f, 0.f, 0.f};
#pragma unroll
        for (int ks = 0; ks < 4; ++ks) {
          bf16x8 a = *(const bf16x8*)&s_qrel[(ti * 16 + fr) * 136 + ks * 32 + fq * 8];
          bf16x8 bb = *(const bf16x8*)&s_krel[(vi * 16 + fr) * 136 + ks * 32 + fq * 8];
          att = __builtin_amdgcn_mfma_f32_16x16x32_bf16(a, bb, att, 0, 0, 0);
          bf16x8 a2 = *(const bf16x8*)&s_qcum[(ti * 16 + fr) * 136 + ks * 32 + fq * 8];
          bf16x8 b2 = *(const bf16x8*)&s_S[(vi * 16 + fr) * 136 + ks * 32 + fq * 8];
          oacc = __builtin_amdgcn_mfma_f32_16x16x32_bf16(a2, b2, oacc, 0, 0, 0);
        }
#pragma unroll
        for (int j = 0; j < 4; ++j) {
          const int t = ti * 16 + fq * 4 + j, s = vi * 16 + fr;
          s_att[t * 40 + s] = (s <= t) ? f2bf(att[j]) : (u16)0;
        }
      }
      __syncthreads();
      {
        bf16x8 a = *(const bf16x8*)&s_att[(ti * 16 + fr) * 40 + fq * 8];
        bf16x8 bb = *(const bf16x8*)&s_vT[(vi * 16 + fr) * 40 + fq * 8];
        oacc = __builtin_amdgcn_mfma_f32_16x16x32_bf16(a, bb, oacc, 0, 0, 0);
#pragma unroll
        for (int j = 0; j < 4; ++j) {
          const int tt = c * 32 + ti * 16 + fq * 4 + j;
          const size_t tok = start + (d ? (N - 1 - tt) : tt);
          og[((size_t)d * TOK + tok) * 1024 + h * 128 + vs * 32 + vi * 16 + fr] = f2bf(oacc[j]);
        }
        bf16x8 vf[2];
#pragma unroll
        for (int ni = 0; ni < 2; ++ni) vf[ni] = *(const bf16x8*)&s_vT[(ni * 16 + fr) * 40 + fq * 8];
#pragma unroll
        for (int mi = 0; mi < 2; ++mi) {
          bf16x8 kf = *(const bf16x8*)&s_kdT[(w * 32 + mi * 16 + fr) * 40 + fq * 8];
          f32x4 dc = *(const f32x4*)&s_dec[w * 32 + mi * 16 + fq * 4];
#pragma unroll
          for (int ni = 0; ni < 2; ++ni) {
            f32x4 s4 = S[mi][ni];
#pragma unroll
            for (int j = 0; j < 4; ++j) s4[j] *= dc[j];
            s4 = __builtin_amdgcn_mfma_f32_16x16x32_bf16(kf, vf[ni], s4, 0, 0, 0);
            S[mi][ni] = s4;
            *(uint2*)&s_S[(ni * 16 + fr) * 136 + w * 32 + mi * 16 + fq * 4] = pack4(s4[0], s4[1], s4[2], s4[3]);
          }
        }
      }
      __syncthreads();
    }
    if (!sample) {
      float* so = p.out + OUT_HG + ((size_t)((b * 2 + d) * 8 + h)) * 16384;
#pragma unroll
      for (int mi = 0; mi < 2; ++mi)
#pragma unroll
        for (int ni = 0; ni < 2; ++ni)
#pragma unroll
          for (int j = 0; j < 4; ++j) so[(w * 32 + mi * 16 + fq * 4 + j) * 128 + vs * 32 + ni * 16 + fr] = S[mi][ni][j];
    }
  }
}

__device__ void phase_hg_post(const Params& p, int bid, int nb) {
  const u16* og = (const u16*)(p.ws + WS_B(5));
  const u16* sg = (const u16*)(p.ws + WS_B(2));
  u16* a = (u16*)(p.ws + WS_B(0));
  const float* ng = p.in[14];
  const int lane = threadIdx.x & 63, wave = threadIdx.x >> 6;
  for (int row = bid * 4 + wave; row < TOK; row += nb * 4) {
    const size_t base = (size_t)row * 1024 + lane * 16;
    float o[16];
    float ss = 0;
#pragma unroll
    for (int hh = 0; hh < 2; ++hh) {
      uint4 f = *(const uint4*)&og[base + hh * 8];
      uint4 bw = *(const uint4*)&og[(size_t)TOK * 1024 + base + hh * 8];
      unsigned fa[4] = {f.x, f.y, f.z, f.w}, ba[4] = {bw.x, bw.y, bw.z, bw.w};
#pragma unroll
      for (int i = 0; i < 4; ++i) {
        o[hh * 8 + 2 * i] = lo16(fa[i]) + lo16(ba[i]);
        o[hh * 8 + 2 * i + 1] = hi16(fa[i]) + hi16(ba[i]);
      }
    }
#pragma unroll
    for (int i = 0; i < 16; ++i) ss += o[i] * o[i];
    ss += __shfl_xor(ss, 1); ss += __shfl_xor(ss, 2); ss += __shfl_xor(ss, 4);
    const float rs = rsqrtf(ss * (1.0f / 128.0f) + 1e-6f);
#pragma unroll
    for (int hh = 0; hh < 2; ++hh) {
      uint4 s = *(const uint4*)&sg[base + hh * 8];
      unsigned sa[4] = {s.x, s.y, s.z, s.w};
      unsigned r[4];
#pragma unroll
      for (int i = 0; i < 4; ++i) {
        const int c = lane * 16 + hh * 8 + 2 * i;
        r[i] = pack2(o[hh * 8 + 2 * i] * rs * ng[c] * lo16(sa[i]), o[hh * 8 + 2 * i + 1] * rs * ng[c + 1] * hi16(sa[i]));
      }
      *(uint4*)&a[base + hh * 8] = make_uint4(r[0], r[1], r[2], r[3]);
    }
  }
}

__device__ __forceinline__ void seq_pos(int tok, int& n, int& L) {
  if (tok < NPROMPT) { n = tok & 255; L = 256; } else { n = (tok - NPROMPT) & 1023; L = 1024; }
}
__device__ void phase_sc_conv(const Params& p, int bid, int nb) {
  const u16* pb = (const u16*)(p.ws + WS_B(0));
  const u16* sb = (const u16*)(p.ws + WS_B(1));
  u16* a = (u16*)(p.ws + WS_B(2));
  const float* cw = p.in[17]; const float* cbias = p.in[18];
  const size_t total = (size_t)TOK * 128;
  for (size_t i = (size_t)bid * 256 + threadIdx.x; i < total; i += (size_t)nb * 256) {
    const int tok = (int)(i >> 7), c = ((int)i & 127) * 8;
    int n, L; seq_pos(tok, n, L);
    const size_t base = (size_t)tok * 1024 + c;
    uint4 z = make_uint4(0, 0, 0, 0);
    uint4 pm = n > 0 ? *(const uint4*)&pb[base - 1024] : z;
    uint4 p0 = *(const uint4*)&pb[base];
    uint4 pp = n < L - 1 ? *(const uint4*)&pb[base + 1024] : z;
    uint4 s = *(const uint4*)&sb[base];
    unsigned am[4] = {pm.x, pm.y, pm.z, pm.w}, a0[4] = {p0.x, p0.y, p0.z, p0.w}, ap[4] = {pp.x, pp.y, pp.z, pp.w}, as[4] = {s.x, s.y, s.z, s.w};
    unsigned r[4];
#pragma unroll
    for (int k = 0; k < 4; ++k) {
      const int c0 = c + 2 * k, c1 = c0 + 1;
      float z0 = cw[c0] * lo16(am[k]) + cw[1024 + c0] * lo16(a0[k]) + cw[2048 + c0] * lo16(ap[k]) + cbias[c0];
      float z1 = cw[c1] * hi16(am[k]) + cw[1024 + c1] * hi16(a0[k]) + cw[2048 + c1] * hi16(ap[k]) + cbias[c1];
      r[k] = pack2(lo16(as[k]) * z0, hi16(as[k]) * z1);
    }
    *(uint4*)&a[base] = make_uint4(r[0], r[1], r[2], r[3]);
  }
}
__device__ void phase_rg_conv(const Params& p, int bid, int nb) {
  const u16* ub = (const u16*)(p.ws + WS_B(0));
  u16* uc = (u16*)(p.ws + WS_B(2));
  const float* cw = p.in[21]; const float* cbias = p.in[22];
  const size_t total = (size_t)TOK * 128;
  for (size_t i = (size_t)bid * 256 + threadIdx.x; i < total; i += (size_t)nb * 256) {
    const int tok = (int)(i >> 7), c = ((int)i & 127) * 8;
    int n, L; seq_pos(tok, n, L);
    const size_t base = (size_t)tok * 1024 + c;
    uint4 z = make_uint4(0, 0, 0, 0);
    uint4 q0 = n > 1 ? *(const uint4*)&ub[base - 2048] : z;
    uint4 q1 = n > 0 ? *(const uint4*)&ub[base - 1024] : z;
    uint4 q2 = *(const uint4*)&ub[base];
    uint4 q3 = n < L - 1 ? *(const uint4*)&ub[base + 1024] : z;
    unsigned a0[4] = {q0.x, q0.y, q0.z, q0.w}, a1[4] = {q1.x, q1.y, q1.z, q1.w}, a2[4] = {q2.x, q2.y, q2.z, q2.w}, a3[4] = {q3.x, q3.y, q3.z, q3.w};
    unsigned r[4];
#pragma unroll
    for (int k = 0; k < 4; ++k) {
      const int c0 = c + 2 * k, c1 = c0 + 1;
      float z0 = cw[c0] * lo16(a0[k]) + cw[1024 + c0] * lo16(a1[k]) + cw[2048 + c0] * lo16(a2[k]) + cw[3072 + c0] * lo16(a3[k]) + cbias[c0];
      float z1 = cw[c1] * hi16(a0[k]) + cw[1024 + c1] * hi16(a1[k]) + cw[2048 + c1] * hi16(a2[k]) + cw[3072 + c1] * hi16(a3[k]) + cbias[c1];
      r[k] = pack2(z0, z1);
    }
    *(uint4*)&uc[base] = make_uint4(r[0], r[1], r[2], r[3]);
  }
}

__device__ void phase_rg_scan(const Params& p, unsigned char* smem_raw, int bid, int nb) {
  float* sA = (float*)smem_raw;
  float* sB = sA + 1024;
  const u16* rb = (const u16*)(p.ws + WS_B(3));
  const u16* ib = (const u16*)(p.ws + WS_B(5));
  const u16* uc = (const u16*)(p.ws + WS_B(2));
  const u16* sg = (const u16*)(p.ws + WS_B(1));
  u16* hfw = (u16*)(p.ws + WS_H);
  u16* yp = (u16*)(p.ws + WS_B(0));
  const int tid = threadIdx.x;
  for (int u = bid; u < 768; u += nb) {
    int sample, b, c, seg, nseg, start, cstride;
    if (u < 256) { sample = 1; b = u >> 6; c = (u & 63) * 16 + (tid & 15); seg = tid >> 4; nseg = 16; start = NPROMPT + b * 1024; cstride = 16; }
    else { sample = 0; b = (u - 256) >> 4; c = ((u - 256) & 15) * 64 + (tid & 63); seg = tid >> 6; nseg = 4; start = b * 256; cstride = 64; }
    const int cl_ = tid & (cstride - 1);
    const int L = nseg * 64;
#pragma unroll 1
    for (int d = 0; d < 2; ++d) {
      const float lam = p.in[25][d * 1024 + c];
      const float cl = 8.0f * log1pf(__expf(-lam));
      const u16* rp = rb + (size_t)d * TOK * 1024;
      const u16* ip = ib + (size_t)d * TOK * 1024;
      float Aacc = 1.f, Bacc = 0.f;
#pragma unroll 4
      for (int s = 0; s < 64; ++s) {
        const int tt = seg * 64 + s;
        const size_t o = (size_t)(start + (d ? L - 1 - tt : tt)) * 1024 + c;
        const float r = bf2f(rp[o]), ig = bf2f(ip[o]), uu = bf2f(uc[o]);
        const float la = -cl * r;
        const float a = __expf(la);
        const float xin = sqrtf(fmaxf(1.0f - __expf(2.0f * la), 0.f)) * (ig * uu);
        Aacc *= a; Bacc = a * Bacc + xin;
      }
      sA[seg * 64 + cl_] = Aacc; sB[seg * 64 + cl_] = Bacc;
      __syncthreads();
      float h = sample ? p.in[3][(b * 2 + d) * 1024 + c] : 0.f;
      for (int s2 = 0; s2 < seg; ++s2) h = sA[s2 * 64 + cl_] * h + sB[s2 * 64 + cl_];
#pragma unroll 4
      for (int s = 0; s < 64; ++s) {
        const int tt = seg * 64 + s;
        const size_t o = (size_t)(start + (d ? L - 1 - tt : tt)) * 1024 + c;
        const float r = bf2f(rp[o]), ig = bf2f(ip[o]), uu = bf2f(uc[o]);
        const float la = -cl * r;
        const float a = __expf(la);
        const float xin = sqrtf(fmaxf(1.0f - __expf(2.0f * la), 0.f)) * (ig * uu);
        h = a * h + xin;
        if (d == 0) hfw[o] = f2bf(h);
        else yp[o] = f2bf((bf2f(hfw[o]) + h) * bf2f(sg[o]));
      }
      if (!sample && seg == nseg - 1) p.out[OUT_RG + (b * 2 + d) * 1024 + c] = h;
      __syncthreads();
    }
  }
}

__device__ void phase_mla_norm(const Params& p, int bid, int nb) {
  u16* cq = (u16*)(p.ws + WS3_CQ);
  u16* ckvall = (u16*)(p.ws + WS3_CKVALL);
  const float* ckvraw = (const float*)(p.ws + WS3_CKVRAW);
  const float* kperaw = (const float*)(p.ws + WS3_KPERAW);
  u16* Kb = (u16*)(p.ws + WS3_K);
  const float* qn = p.in[28]; const float* kvn = p.in[29];
  const int lane = threadIdx.x & 63, wave = threadIdx.x >> 6;
  for (int row = bid * 4 + wave; row < TOK + 2048; row += nb * 4) {
    if (row < TOK) {
      const int tok = row;
      const bool sample = tok >= NPROMPT;
      const int bs = (tok - NPROMPT) >> 10, n = (tok - NPROMPT) & 1023;
      const size_t kvrow = sample ? (size_t)(NPROMPT + bs * 1536 + 512 + n) : (size_t)tok;
      unsigned* cqr = (unsigned*)&cq[(size_t)tok * 384];
      unsigned cv[3]; float ss = 0;
#pragma unroll
      for (int i = 0; i < 3; ++i) { cv[i] = cqr[i * 64 + lane]; float a = lo16(cv[i]), b2 = hi16(cv[i]); ss += a * a + b2 * b2; }
      const float rsq = rsqrtf(wave_sum(ss) * (1.0f / 384.0f) + 1e-6f);
#pragma unroll
      for (int i = 0; i < 3; ++i) {
        const int k = (i * 64 + lane) * 2;
        cqr[i * 64 + lane] = pack2(lo16(cv[i]) * rsq * qn[k], hi16(cv[i]) * rsq * qn[k + 1]);
      }
      f32x4 kv = *(const f32x4*)&ckvraw[(size_t)tok * 256 + lane * 4];
      const float rsk = rsqrtf(wave_sum(kv[0] * kv[0] + kv[1] * kv[1] + kv[2] * kv[2] + kv[3] * kv[3]) * (1.0f / 256.0f) + 1e-6f);
      f32x4 g4 = *(const f32x4*)&kvn[lane * 4];
      f32x4 o4;
#pragma unroll
      for (int j = 0; j < 4; ++j) o4[j] = kv[j] * rsk * g4[j];
      *(uint2*)&ckvall[kvrow * 256 + lane * 4] = pack4(o4[0], o4[1], o4[2], o4[3]);
      if (!sample) *(f32x4*)&p.out[OUT_CKV + (size_t)tok * 256 + lane * 4] = o4;
      float v = kperaw[(size_t)tok * 32 + (lane & 31)];
      if (!sample) { if (lane < 32) p.out[OUT_KPE + (size_t)tok * 32 + lane] = v; }
      else {
        const float partner = __shfl_xor(v, 8);
        const int i16 = lane & 15;
        const float pos = (lane & 16) ? (float)(n & 63) : (float)(n >> 6);
        float sn, cs; rope_sincos(pos, i16 & 7, sn, cs);
        v = (i16 < 8) ? (v * cs - partner * sn) : (partner * sn + v * cs);
      }
      const u16 vb = f2bf(v);
#pragma unroll
      for (int i = 0; i < 8; ++i) Kb[(kvrow * 16 + (lane >> 5) + 2 * i) * 96 + 64 + (lane & 31)] = vb;
    } else {
      const int r = row - TOK, bs = r >> 9, j = r & 511;
      const size_t kvrow = (size_t)(NPROMPT + bs * 1536 + j);
      f32x4 kv = *(const f32x4*)&p.in[4][(size_t)r * 256 + lane * 4];
      *(uint2*)&ckvall[kvrow * 256 + lane * 4] = pack4(kv[0], kv[1], kv[2], kv[3]);
      const u16 vb = f2bf(p.in[5][(size_t)r * 32 + (lane & 31)]);
#pragma unroll
      for (int i = 0; i < 8; ++i) Kb[(kvrow * 16 + (lane >> 5) + 2 * i) * 96 + 64 + (lane & 31)] = vb;
    }
  }
}

__device__ void phase_attn(const Params& p, unsigned char* smem_raw, int bid, int nb) {
  u16* sK = (u16*)smem_raw;
  u16* sV = sK + 64 * 104;
  const u16* qg = (const u16*)(p.ws + WS3_Q);
  const u16* Kg = (const u16*)(p.ws + WS3_K);
  const u16* Vg = (const u16*)(p.ws + WS3_VT);
  const u16* sg = (const u16*)(p.ws + WS3_SG);
  u16* ao = (u16*)(p.ws + WS_H);
  const int tid = threadIdx.x, lane = tid & 63, w = tid >> 6, fr = lane & 15, fq = lane >> 4;
  for (int u = bid; u < 3072; u += nb) {
    int tok0, kvbase, nkeys, h;
    if (u < 1024) { const int b = u >> 8, r = u & 255; h = r >> 4; const int qb = r & 15; tok0 = NPROMPT + b * 1024 + qb * 64; kvbase = NPROMPT + b * 1536; nkeys = 1536; }
    else { const int uu = u - 1024; const int b = uu >> 6, r = uu & 63; h = r >> 2; const int qb = r & 3; tok0 = b * 256 + qb * 64; kvbase = b * 256; nkeys = 256; }
    const int tokq = tok0 + w * 16 + fr;
    bf16x8 qf[3];
#pragma unroll
    for (int ks = 0; ks < 3; ++ks) qf[ks] = *(const bf16x8*)&qg[(size_t)tokq * 1536 + h * 96 + ks * 32 + fq * 8];
    float m = -1e30f, l = 0.f;
    f32x4 oacc[4];
#pragma unroll
    for (int i = 0; i < 4; ++i) oacc[i] = f32x4{0.f, 0.f, 0.f, 0.f};
    const int ntile = nkeys >> 6;
    for (int kt = 0; kt < ntile; ++kt) {
      __syncthreads();
#pragma unroll
      for (int i = 0; i < 3; ++i) {
        const int cidx = tid + i * 256, key = cidx / 12, ch = cidx - key * 12;
        *(uint4*)&sK[key * 104 + ch * 8] = *(const uint4*)&Kg[((size_t)(kvbase + kt * 64 + key) * 16 + h) * 96 + ch * 8];
      }
#pragma unroll
      for (int i = 0; i < 2; ++i) {
        const int cidx = tid + i * 256, dv = cidx >> 3, ch = cidx & 7;
        *(uint4*)&sV[dv * 72 + ch * 8] = *(const uint4*)&Vg[(size_t)(h * 64 + dv) * KVROWS + kvbase + kt * 64 + ch * 8];
      }
      __syncthreads();
      f32x4 sacc[4];
#pragma unroll
      for (int ni = 0; ni < 4; ++ni) {
        sacc[ni] = f32x4{0.f, 0.f, 0.f, 0.f};
#pragma unroll
        for (int ks = 0; ks < 3; ++ks) {
          bf16x8 kf = *(const bf16x8*)&sK[(ni * 16 + fr) * 104 + ks * 32 + fq * 8];
          sacc[ni] = __builtin_amdgcn_mfma_f32_16x16x32_bf16(kf, qf[ks], sacc[ni], 0, 0, 0);
        }
      }
      float mx = -1e30f;
#pragma unroll
      for (int ni = 0; ni < 4; ++ni)
#pragma unroll
        for (int j = 0; j < 4; ++j) mx = fmaxf(mx, sacc[ni][j]);
      mx = fmaxf(mx, __shfl_xor(mx, 16));
      mx = fmaxf(mx, __shfl_xor(mx, 32));
      const float mnew = fmaxf(m, mx);
      const float alpha = __expf(m - mnew);
      m = mnew;
      float ls = 0.f;
#pragma unroll
      for (int ni = 0; ni < 4; ++ni)
#pragma unroll
        for (int j = 0; j < 4; ++j) { float e = __expf(sacc[ni][j] - mnew); sacc[ni][j] = e; ls += e; }
      l = l * alpha + ls;
      bf16x8 pf[2];
#pragma unroll
      for (int kk2 = 0; kk2 < 2; ++kk2) {
        uint2 lo = pack4(sacc[2 * kk2][0], sacc[2 * kk2][1], sacc[2 * kk2][2], sacc[2 * kk2][3]);
        uint2 hi = pack4(sacc[2 * kk2 + 1][0], sacc[2 * kk2 + 1][1], sacc[2 * kk2 + 1][2], sacc[2 * kk2 + 1][3]);
        uint4 pk = make_uint4(lo.x, lo.y, hi.x, hi.y);
        pf[kk2] = *(bf16x8*)&pk;
      }
#pragma unroll
      for (int di = 0; di < 4; ++di) {
#pragma unroll
        for (int j = 0; j < 4; ++j) oacc[di][j] *= alpha;
#pragma unroll
        for (int kk2 = 0; kk2 < 2; ++kk2) {
          uint2 v0 = *(const uint2*)&sV[(di * 16 + fr) * 72 + kk2 * 32 + fq * 4];
          uint2 v1 = *(const uint2*)&sV[(di * 16 + fr) * 72 + kk2 * 32 + 16 + fq * 4];
          uint4 vk = make_uint4(v0.x, v0.y, v1.x, v1.y);
          oacc[di] = __builtin_amdgcn_mfma_f32_16x16x32_bf16(*(bf16x8*)&vk, pf[kk2], oacc[di], 0, 0, 0);
        }
      }
    }
    l += __shfl_xor(l, 16);
    l += __shfl_xor(l, 32);
    const float inv = 1.0f / l;
#pragma unroll
    for (int di = 0; di < 4; ++di) {
      const size_t o = (size_t)tokq * 1024 + h * 64 + di * 16 + fq * 4;
      uint2 s = *(const uint2*)&sg[o];
      *(uint2*)&ao[o] = pack4(oacc[di][0] * inv * lo16(s.x), oacc[di][1] * inv * hi16(s.x), oacc[di][2] * inv * lo16(s.y), oacc[di][3] * inv * hi16(s.y));
    }
  }
}

__global__ void __launch_bounds__(256, 2) mega(Params p) {
  extern __shared__ __attribute__((aligned(16))) unsigned char smem_raw[];
  u16* smem = (u16*)smem_raw;
  const int bid = blockIdx.x, nb = gridDim.x;
  unsigned char* ws = p.ws;
  const float* mod = (const float*)(ws + WS_MOD);
  {
    {
      if ((PHMASK & (1u << 0)) && p.phase_lo <= 0 && 0 < p.phase_hi) { const int ph = 0; phase_prologue(p, smem_raw, bid, nb); PH_END }
      if ((PHMASK & (1u << 1)) && p.phase_lo <= 1 && 1 < p.phase_hi) { const int ph = 1; phase_h0(p, bid, nb); PH_END }
      if ((PHMASK & (1u << 2)) && p.phase_lo <= 2 && 2 < p.phase_hi) { const int ph = 2; {
        EpiHgIn e{(u16*)(ws + WS_B(0)), (u16*)(ws + WS_B(1)), (u16*)(ws + WS_B(2)), (_Float16*)(ws + WS_B(3)), (const float*)(ws + WS_LB)};
        gemm_tiles((const u16*)(ws + WS_H), 1024, (const u16*)(ws + WS_W_HG_IN), 1024, 96, 40, e, AOffNone(), smem, bid, nb);
      } PH_END }
      if ((PHMASK & (1u << 3)) && p.phase_lo <= 3 && 3 < p.phase_hi) { const int ph = 3; phase_gla(p, smem_raw); PH_END }
      if ((PHMASK & (1u << 4)) && p.phase_lo <= 4 && 4 < p.phase_hi) { const int ph = 4; phase_hg_post(p, bid, nb); PH_END }
      if ((PHMASK & (1u << 5)) && p.phase_lo <= 5 && 5 < p.phase_hi) { const int ph = 5; {
        EpiRes e{p.in[0], p.in[1], p.out, mod + 0 * 15360 + 2048};
        gemm_tiles((const u16*)(ws + WS_B(0)), 1024, (const u16*)(ws + WS_W_HG_OUT), 1024, 96, 8, e, AOffNone(), smem, bid, nb);
      } PH_END }
      if ((PHMASK & (1u << 6)) && p.phase_lo <= 6 && 6 < p.phase_hi) { const int ph = 6; phase_ln(p, 0, bid, nb); PH_END }
      if ((PHMASK & (1u << 7)) && p.phase_lo <= 7 && 7 < p.phase_hi) { const int ph = 7; {
        EpiScIn e{(u16*)(ws + WS_B(0)), (u16*)(ws + WS_B(1))};
        gemm_tiles((const u16*)(ws + WS_H), 1024, (const u16*)(ws + WS_W_SC_IN), 1024, 96, 32, e, AOffNone(), smem, bid, nb);
      } PH_END }
      if ((PHMASK & (1u << 8)) && p.phase_lo <= 8 && 8 < p.phase_hi) { const int ph = 8; phase_sc_conv(p, bid, nb); PH_END }
      if ((PHMASK & (1u << 9)) && p.phase_lo <= 9 && 9 < p.phase_hi) { const int ph = 9; {
        EpiRes e{p.out, p.out + (size_t)NPROMPT * 1024, p.out, mod + 1 * 15360 + 2048};
        gemm_tiles((const u16*)(ws + WS_B(2)), 1024, (const u16*)(ws + WS_W_SC_OUT), 1024, 96, 8, e, AOffNone(), smem, bid, nb);
      } PH_END }
      if ((PHMASK & (1u << 10)) && p.phase_lo <= 10 && 10 < p.phase_hi) { const int ph = 10; phase_ln(p, 1, bid, nb); PH_END }
      if ((PHMASK & (1u << 11)) && p.phase_lo <= 11 && 11 < p.phase_hi) { const int ph = 11; {
        EpiRgIn e{(u16*)(ws + WS_B(0)), (u16*)(ws + WS_B(1))};
        gemm_tiles((const u16*)(ws + WS_H), 1024, (const u16*)(ws + WS_W_RG_IN), 1024, 96, 16, e, AOffNone(), smem, bid, nb);
      } PH_END }
      if ((PHMASK & (1u << 12)) && p.phase_lo <= 12 && 12 < p.phase_hi) { const int ph = 12; phase_rg_conv(p, bid, nb); PH_END }
      if ((PHMASK & (1u << 13)) && p.phase_lo <= 13 && 13 < p.phase_hi) { const int ph = 13; {
        EpiRgGate e{(u16*)(ws + WS_B(3)), (u16*)(ws + WS_B(5)), p.in[24]};
        gemm_tiles((const u16*)(ws + WS_B(2)), 1024, (const u16*)(ws + WS_W_RG_GATE), 256, 96, 32, e, AOffGate(), smem, bid, nb);
      } PH_END }
      if ((PHMASK & (1u << 14)) && p.phase_lo <= 14 && 14 < p.phase_hi) { const int ph = 14; phase_rg_scan(p, smem_raw, bid, nb); PH_END }
      if ((PHMASK & (1u << 15)) && p.phase_lo <= 15 && 15 < p.phase_hi) { const int ph = 15; {
        EpiRes e{p.out, p.out + (size_t)NPROMPT * 1024, p.out, mod + 2 * 15360 + 2048};
        gemm_tiles((const u16*)(ws + WS_B(0)), 1024, (const u16*)(ws + WS_W_RG_OUT), 1024, 96, 8, e, AOffNone(), smem, bid, nb);
      } PH_END }
      if ((PHMASK & (1u << 16)) && p.phase_lo <= 16 && 16 < p.phase_hi) { const int ph = 16; phase_ln(p, 2, bid, nb); PH_END }
      if ((PHMASK & (1u << 17)) && p.phase_lo <= 17 && 17 < p.phase_hi) { const int ph = 17; {
        EpiMlaIn e{(u16*)(ws + WS3_CQ), (float*)(ws + WS3_CKVRAW), (float*)(ws + WS3_KPERAW), (u16*)(ws + WS3_SG)};
        gemm_tiles((const u16*)(ws + WS_H), 1024, (const u16*)(ws + WS_W_MLA_IN), 1024, 96, 14, e, AOffNone(), smem, bid, nb);
      } PH_END }
      if ((PHMASK & (1u << 18)) && p.phase_lo <= 18 && 18 < p.phase_hi) { const int ph = 18; phase_mla_norm(p, bid, nb); PH_END }
      if ((PHMASK & (1u << 19)) && p.phase_lo <= 19 && 19 < p.phase_hi) { const int ph = 19; {
        EpiQ eq{(u16*)(ws + WS3_Q)};
        gemm_tiles((const u16*)(ws + WS3_CQ), 384, (const u16*)(ws + WS_W_QB), 384, 96, 12, eq, AOffNone(), smem, bid, nb);
        EpiKV ek{(u16*)(ws + WS3_K), (u16*)(ws + WS3_VT)};
        gemm_tiles((const u16*)(ws + WS3_CKVALL), 256, (const u16*)(ws + WS_W_KVB), 256, 112, 16, ek, AOffNone(), smem, (bid + nb - (1152 % nb)) % nb, nb);
      } PH_END }
      if ((PHMASK & (1u << 20)) && p.phase_lo <= 20 && 20 < p.phase_hi) { const int ph = 20; phase_attn(p, smem_raw, bid, nb); PH_END }
      if ((PHMASK & (1u << 21)) && p.phase_lo <= 21 && 21 < p.phase_hi) { const int ph = 21; {
        EpiRes e{p.out, p.out + (size_t)NPROMPT * 1024, p.out, mod + 3 * 15360 + 2048};
        gemm_tiles((const u16*)(ws + WS_H), 1024, (const u16*)(ws + WS_W_MLA_OUT), 1024, 96, 8, e, AOffNone(), smem, bid, nb);
      } PH_END }
      if ((PHMASK & (1u << 22)) && p.phase_lo <= 22 && 22 < p.phase_hi) { const int ph = 22; phase_ln(p, 3, bid, nb); PH_END }
    }
  }
}

#define DYN_LDS 73728

extern "C" void kernel_launch(void* const* d_in, const int* in_sizes, int n_in, void* d_out, int out_size, void* d_ws, size_t ws_size,
                              hipStream_t stream) {
  static int grid_blocks = 0;
  if (!grid_blocks) {
    int dev = 0, cus = 0, per_cu = 0;
    hipGetDevice(&dev);
    hipDeviceGetAttribute(&cus, hipDeviceAttributeMultiprocessorCount, dev);
    hipFuncSetAttribute((const void*)mega, hipFuncAttributeMaxDynamicSharedMemorySize, DYN_LDS);
    hipOccupancyMaxActiveBlocksPerMultiprocessor(&per_cu, (const void*)mega, 256, DYN_LDS);
    if (per_cu < 1) per_cu = 1;
    if (per_cu > 2) per_cu = 2;
    grid_blocks = cus * per_cu;
  }
  Params p{};
  for (int i = 0; i < 33; ++i) p.in[i] = (const float*)d_in[i];
  p.out = (float*)d_out;
  p.ws = (unsigned char*)d_ws;
#if MULTI_LAUNCH
  for (int ph = 0; ph < NPHASES; ++ph) {
    p.phase_lo = ph; p.phase_hi = ph + 1;
    hipLaunchKernelGGL(mega, dim3(grid_blocks), dim3(256), DYN_LDS, stream, p);
  }
#else
  p.phase_lo = 0; p.phase_hi = NPHASES;
  void* args[] = {&p};
  hipError_t e = hipLaunchCooperativeKernel((const void*)mega, dim3(grid_blocks), dim3(256), args, DYN_LDS, stream);
  if (e != hipSuccess) fprintf(stderr, "cooperative launch failed: %s (grid %d)\n", hipGetErrorString(e), grid_blocks);
#endif
}
```

```cpp
#include <hip/hip_runtime.h>
#include <hip/hip_cooperative_groups.h>
#include <cstdio>
namespace cg = cooperative_groups;

#ifndef MULTI_LAUNCH
#define MULTI_LAUNCH 0
#endif

typedef unsigned short u16;
using bf16x8 = __attribute__((ext_vector_type(8))) short;
using f32x4 = __attribute__((ext_vector_type(4))) float;
typedef _Float16 h4 __attribute__((ext_vector_type(4)));

#define TOK 12288
#define NPROMPT 8192
#define KVROWS 14336
#define NPHASES 23
#ifndef PHMASK
#define PHMASK 0x7fffff
#endif
#define DN_ALPHA 1.6817928305074290f

#define WS_W_HG_IN 0ull
#define WS_W_HG_OUT (WS_W_HG_IN + 10485760ull)
#define WS_W_SC_IN (WS_W_HG_OUT + 2097152ull)
#define WS_W_SC_OUT (WS_W_SC_IN + 8388608ull)
#define WS_W_RG_IN (WS_W_SC_OUT + 2097152ull)
#define WS_W_RG_GATE (WS_W_RG_IN + 4194304ull)
#define WS_W_RG_OUT (WS_W_RG_GATE + 2097152ull)
#define WS_W_MLA_IN (WS_W_RG_OUT + 2097152ull)
#define WS_W_QB (WS_W_MLA_IN + 3670016ull)
#define WS_W_KVB (WS_W_QB + 1179648ull)
#define WS_W_MLA_OUT (WS_W_KVB + 1048576ull)
#define WS_MOD (WS_W_MLA_OUT + 2097152ull)
#define WS_LB (WS_MOD + 245760ull)
#define WS_CNT (WS_LB + 8192ull)
#define WS_R (WS_CNT + 4096ull + 16384ull)
#define BSZ 25165824ull
#define WS_H (WS_R)
#define WS_B(i) (WS_R + BSZ * (1 + (i)))
#define WS3_CQ (WS_R + 25165824ull)
#define WS3_CKVALL (WS_R + 34603008ull)
#define WS3_CKVRAW (WS_R + 41943040ull)
#define WS3_KPERAW (WS_R + 54525952ull)
#define WS3_SG (WS_R + 56098816ull)
#define WS3_Q (WS_R + 81264640ull)
#define WS3_K (WS_R + 119013376ull)
#define WS3_VT (WS_R + 163053568ull)

#define OUT_HG 12582912
#define OUT_RG 20971520
#define OUT_CKV 21037056
#define OUT_KPE 23134208

struct Params {
  const float* in[33];
  float* out;
  unsigned char* ws;
  int phase_lo, phase_hi;
};

__device__ __forceinline__ u16 f2bf(float f) {
  unsigned u = __float_as_uint(f);
  u += 0x7fffu + ((u >> 16) & 1u);
  return (u16)(u >> 16);
}
__device__ __forceinline__ float bf2f(u16 h) { return __uint_as_float(((unsigned)h) << 16); }
__device__ __forceinline__ unsigned pack2(float a, float b) { return (unsigned)f2bf(a) | ((unsigned)f2bf(b) << 16); }
__device__ __forceinline__ uint2 pack4(float a, float b, float c, float d) { return make_uint2(pack2(a, b), pack2(c, d)); }
__device__ __forceinline__ float lo16(unsigned u) { return __uint_as_float(u << 16); }
__device__ __forceinline__ float hi16(unsigned u) { return __uint_as_float(u & 0xffff0000u); }
__device__ __forceinline__ float sigmoidf_(float x) { return 1.0f / (1.0f + __expf(-x)); }
__device__ __forceinline__ float siluf_(float x) { return x / (1.0f + __expf(-x)); }
__device__ __forceinline__ int cond_of(int tok) { return tok < NPROMPT ? 0 : 1 + ((tok - NPROMPT) >> 10); }
__device__ __forceinline__ float wave_sum(float v) {
#pragma unroll
  for (int o = 32; o > 0; o >>= 1) v += __shfl_xor(v, o);
  return v;
}
__device__ __forceinline__ void rope_sincos(float pos, int fi, float& sn, float& cs) {
  float inv = exp2f(-(float)fi * 1.6609640474436813f);
  float ang = pos * inv;
  float k = rintf(ang * 0.15915494309189535f);
  float r = fmaf(-k, 6.2831854820251465f, ang);
  r = fmaf(-k, -1.7484555e-7f, r);
  sn = __sinf(r); cs = __cosf(r);
}

#define NT 512
#define NW 8
#define LAS __attribute__((address_space(3)))

namespace pg8 {
constexpr int BM = 256, BK = 64, HALF = 128, HTB = HALF * BK * 2, STAGE_BYTES = 8 * HTB, NXCD = 8, WGM = 8;
__device__ __forceinline__ int lds_byte(int r, int c) { const int st = (r >> 4) * 2 + (c >> 5), rr = r & 15, cc = c & 31, ob = rr * 64 + cc * 2; return st * 1024 + (ob ^ (((ob >> 9) & 1) << 5)); }
__device__ __forceinline__ void stage_rc(int b, int& R, int& C) { const int st = b / 1024, sb = b % 1024, swz = sb ^ (((sb >> 9) & 1) << 5); R = (st >> 1) * 16 + swz / 64; C = (st & 1) * 32 + (swz % 64) / 2; }
struct Unit { int pm, pn; };
struct Gemm { const u16* A; const u16* Bt; int M, N, K, lda, gate; };
struct StaticOrder {
  int nM, nN, nwg, G, c;
  __device__ void init(int M, int N, int G_, int c_) { nM = M / BM; nN = N / BM; nwg = nM * nN; G = G_; c = c_; }
  __device__ bool next(int i, Unit& u) const {
    const long L = (long)i * G + c; if (L >= nwg) return false;
    int wgid = (int)L; { const int q = nwg / NXCD, r = nwg % NXCD, xcd = wgid % NXCD, off = wgid / NXCD; wgid = (xcd < r ? xcd * (q + 1) : r * (q + 1) + (xcd - r) * q) + off; }
    const int nig = WGM * nN, gid = wgid / nig, fm = gid * WGM, gsz = (nM - fm) < WGM ? (nM - fm) : WGM;
    u.pm = fm + ((wgid % nig) % gsz); u.pn = (wgid % nig) / gsz; return true;
  }
};
template <class Epi>
__device__ __forceinline__ void gemm_phase(LAS unsigned char* lds, const Gemm g, const StaticOrder& S, const Epi& E) {
  const int tid = threadIdx.x, wid = __builtin_amdgcn_readfirstlane(tid >> 6), lane = tid & 63, wr = wid >> 2, wc = wid & 3, fr = lane & 15, fq = lane >> 4;
  const int K = g.K, nt = K / BK;
  unsigned voffA[2], voffB[2];
#pragma unroll
  for (int i = 0; i < 2; ++i) { int R, C; stage_rc(tid * 16 + i * 8192, R, C); voffA[i] = (unsigned)(R * g.lda + C) * 2u; voffB[i] = (unsigned)(R * K + C) * 2u; }
  const size_t kstep = (size_t)(BK * 2);
  const size_t hstepA = (size_t)HALF * g.lda * 2, hstepB = (size_t)HALF * K * 2;
  const size_t tstepA = 2 * hstepA, tstepB = 2 * hstepB;
  const unsigned ldsw = (unsigned)wid * 1024u;
  const int aoff = lds_byte(wr * 64 + fr, fq * 8), boff = lds_byte(wc * 32 + fr, fq * 8);
#define PG8_AOFF(pn) (g.gate ? (size_t)((((pn) >> 1) & 3) * 512) : (size_t)0)
#define PG8_SA(b, h) (((b) * 2 + (h)) * HTB)
#define PG8_SB(b, h) ((4 + (b) * 2 + (h)) * HTB)
#define PG8_STAGE(bufoff, gbase, voff) do { _Pragma("unroll") for (int _i = 0; _i < 2; ++_i) \
    __builtin_amdgcn_global_load_lds((const unsigned*)((const char*)(gbase) + (voff)[_i]), (LAS unsigned*)(lds + (bufoff) + ldsw + _i * 8192), 16, 0, 0); } while (0)
#define PG8_LDA(dst, b, h) do { _Pragma("unroll") for (int m = 0; m < 4; ++m) _Pragma("unroll") for (int k = 0; k < 2; ++k) dst[m][k] = *(const LAS bf16x8*)(lds + PG8_SA(b, h) + aoff + m * 2048 + k * 1024); } while (0)
#define PG8_LDB(dst, b, h) do { _Pragma("unroll") for (int n = 0; n < 2; ++n) _Pragma("unroll") for (int k = 0; k < 2; ++k) dst[n][k] = *(const LAS bf16x8*)(lds + PG8_SB(b, h) + boff + n * 2048 + k * 1024); } while (0)
#define PG8_MMA(ai, bj, At, Bt) do { __builtin_amdgcn_s_setprio(1); _Pragma("unroll") for (int m = 0; m < 4; ++m) _Pragma("unroll") for (int n = 0; n < 2; ++n) _Pragma("unroll") for (int k = 0; k < 2; ++k) \
    acc[ai][bj][m][n] = __builtin_amdgcn_mfma_f32_16x16x32_bf16(Bt[n][k], At[m][k], acc[ai][bj][m][n], 0, 0, 0); __builtin_amdgcn_s_setprio(0); } while (0)
#define PG8_WAIT_V(n) asm volatile("s_waitcnt vmcnt(" #n ")" ::: "memory")
#define PG8_WAIT_L(n) asm volatile("s_waitcnt lgkmcnt(" #n ")" ::: "memory")
#define PG8_BAR __builtin_amdgcn_s_barrier()
#define PG8_SCHED __builtin_amdgcn_sched_barrier(0)
  Unit cur, nxt; int ui = 0;
  if (!S.next(0, cur)) return;
  f32x4 acc[2][2][4][2];
#pragma unroll
  for (int a = 0; a < 2; ++a)
#pragma unroll
    for (int b = 0; b < 2; ++b)
#pragma unroll
      for (int m = 0; m < 4; ++m)
#pragma unroll
        for (int n = 0; n < 2; ++n) acc[a][b][m][n] = (f32x4){0.f, 0.f, 0.f, 0.f};
  bf16x8 At[4][2], B0[2][2], B1[2][2];
  const char* cA = (const char*)g.A + (size_t)cur.pm * tstepA + PG8_AOFF(cur.pn); const char* cB = (const char*)g.Bt + (size_t)cur.pn * tstepB;
  PG8_STAGE(PG8_SB(0, 0), cB, voffB); PG8_STAGE(PG8_SA(0, 0), cA, voffA); PG8_STAGE(PG8_SB(0, 1), cB + hstepB, voffB); PG8_STAGE(PG8_SA(0, 1), cA + hstepA, voffA);
  if (wr == 1) PG8_BAR;
  PG8_WAIT_V(4); PG8_BAR;
  PG8_STAGE(PG8_SB(1, 0), cB + kstep, voffB); PG8_STAGE(PG8_SA(1, 0), cA + kstep, voffA); PG8_STAGE(PG8_SB(1, 1), cB + hstepB + kstep, voffB);
  PG8_WAIT_V(6); PG8_BAR;
  for (;;) {
    const bool has_next = S.next(ui + 1, nxt);
    const char* nA = has_next ? (const char*)g.A + (size_t)nxt.pm * tstepA + PG8_AOFF(nxt.pn) : cA; const char* nB = has_next ? (const char*)g.Bt + (size_t)nxt.pn * tstepB : cB;
#pragma unroll 1
    for (int t = 0; t < nt; t += 2) {
      const bool last = (t == nt - 2);
      const char* a1 = cA + (size_t)(t + 1) * kstep;
      const char* a2 = last ? nA : cA + (size_t)(t + 2) * kstep; const char* b2 = last ? nB : cB + (size_t)(t + 2) * kstep;
      const char* a3 = a2 + kstep; const char* b3 = b2 + kstep;
      PG8_LDB(B0, 0, 0); PG8_SCHED; PG8_LDA(At, 0, 0); PG8_STAGE(PG8_SA(1, 1), a1 + hstepA, voffA);
      PG8_WAIT_L(8); PG8_BAR; PG8_WAIT_L(0); PG8_MMA(0, 0, At, B0); PG8_BAR; PG8_SCHED;
      PG8_LDB(B1, 0, 1); PG8_STAGE(PG8_SB(0, 0), b2, voffB);
      PG8_BAR; PG8_WAIT_L(0); PG8_MMA(0, 1, At, B1); PG8_BAR;
      PG8_LDA(At, 0, 1); PG8_STAGE(PG8_SA(0, 0), a2, voffA);
      PG8_BAR; PG8_WAIT_L(0); PG8_MMA(1, 0, At, B0); PG8_BAR; PG8_SCHED;
      PG8_STAGE(PG8_SB(0, 1), b2 + hstepB, voffB);
      PG8_WAIT_V(6); PG8_BAR; PG8_MMA(1, 1, At, B1); PG8_BAR;
      PG8_LDB(B0, 1, 0); PG8_SCHED; PG8_LDA(At, 1, 0); PG8_STAGE(PG8_SA(0, 1), a2 + hstepA, voffA);
      PG8_WAIT_L(8); PG8_BAR; PG8_WAIT_L(0); PG8_MMA(0, 0, At, B0); PG8_BAR; PG8_SCHED;
      PG8_LDB(B1, 1, 1); PG8_STAGE(PG8_SB(1, 0), b3, voffB);
      PG8_BAR; PG8_WAIT_L(0); PG8_MMA(0, 1, At, B1); PG8_BAR;
      PG8_LDA(At, 1, 1); PG8_STAGE(PG8_SA(1, 0), a3, voffA);
      PG8_BAR; PG8_WAIT_L(0); PG8_MMA(1, 0, At, B0); PG8_BAR; PG8_SCHED;
      PG8_STAGE(PG8_SB(1, 1), b3 + hstepB, voffB);
      PG8_WAIT_V(6); PG8_BAR; PG8_MMA(1, 1, At, B1); PG8_BAR;
    }
    E(acc, cur, wr, wc, fr, fq);
    if (!has_next) break;
#pragma unroll
    for (int a = 0; a < 2; ++a)
#pragma unroll
      for (int b = 0; b < 2; ++b)
#pragma unroll
        for (int m = 0; m < 4; ++m)
#pragma unroll
          for (int n = 0; n < 2; ++n) acc[a][b][m][n] = (f32x4){0.f, 0.f, 0.f, 0.f};
    cur = nxt; cA = nA; cB = nB; ++ui;
  }
  PG8_WAIT_V(0);
  if (wr == 0) PG8_BAR;
  PG8_BAR;
#undef PG8_AOFF
#undef PG8_SA
#undef PG8_SB
#undef PG8_STAGE
#undef PG8_LDA
#undef PG8_LDB
#undef PG8_MMA
#undef PG8_WAIT_V
#undef PG8_WAIT_L
#undef PG8_BAR
#undef PG8_SCHED
}
}
using pg8::Unit;
typedef const f32x4 (&AccRef)[2][2][4][2];

#define EPI_ROWS(...) _Pragma("unroll") for (int ai = 0; ai < 2; ++ai) _Pragma("unroll") for (int m = 0; m < 4; ++m) { const int row = u.pm * 256 + ai * 128 + wr * 64 + m * 16 + fr; __VA_ARGS__ }
#define EPI_COLS(...) _Pragma("unroll") for (int bj = 0; bj < 2; ++bj) _Pragma("unroll") for (int n = 0; n < 2; ++n) { const int cb = u.pn * 256 + bj * 128 + wc * 32 + n * 16; const f32x4 a = acc[ai][bj][m][n]; __VA_ARGS__ }

struct EpiHgIn {
  u16 *q, *v, *sg; _Float16* lf; const float* lb;
  __device__ __forceinline__ void operator()(AccRef acc, const Unit& u, int wr, int wc, int fr, int fq) const {
    const int region = u.pn >> 2;
    EPI_ROWS( EPI_COLS(
      const int c = (cb & 1023) + fq * 4;
      if (region == 0) {
        const float s = 0.08838834764831845f;
        *(uint2*)&q[(size_t)row * 1024 + c] = pack4(siluf_(a[0]) * s, siluf_(a[1]) * s, siluf_(a[2]) * s, siluf_(a[3]) * s);
      } else if (region <= 2) {
        const int d = region - 1;
        f32x4 l4 = *(const f32x4*)&lb[d * 1024 + c];
        h4 o;
        _Pragma("unroll") for (int j = 0; j < 4; ++j) { float f = l4[j] + (1.0f - l4[j]) * sigmoidf_(a[j]); o[j] = (_Float16)__logf(f); }
        *(h4*)&lf[(size_t)row * 2048 + d * 1024 + c] = o;
      } else if (region == 3) {
        *(uint2*)&v[(size_t)row * 1024 + c] = pack4(a[0], a[1], a[2], a[3]);
      } else {
        *(uint2*)&sg[(size_t)row * 1024 + c] = pack4(siluf_(a[0]), siluf_(a[1]), siluf_(a[2]), siluf_(a[3]));
      }
    ) )
  }
};

struct EpiRes {
  const float* xin_p; const float* xin_s; float* Y; const float* gate;
  __device__ __forceinline__ void operator()(AccRef acc, const Unit& u, int wr, int wc, int fr, int fq) const {
    EPI_ROWS(
      const float* xr = row < NPROMPT ? xin_p + (size_t)row * 1024 : xin_s + (size_t)(row - NPROMPT) * 1024;
      const float* g = gate + cond_of(row) * 3072;
      EPI_COLS(
        const int c = cb + fq * 4;
        f32x4 x = *(const f32x4*)&xr[c];
        f32x4 gg = *(const f32x4*)&g[c];
        f32x4 y;
        _Pragma("unroll") for (int j = 0; j < 4; ++j) y[j] = DN_ALPHA * x[j] + gg[j] * a[j];
        *(f32x4*)&Y[(size_t)row * 1024 + c] = y;
      ) )
  }
};

struct EpiScIn {
  u16 *pb, *sb;
  __device__ __forceinline__ void operator()(AccRef acc, const Unit& u, int wr, int wc, int fr, int fq) const {
    const int c = u.pn * 64 + wc * 16 + fq * 4;
    EPI_ROWS(
      const f32x4 bg = acc[ai][0][m][0], cgv = acc[ai][0][m][1], v = acc[ai][1][m][0], g = acc[ai][1][m][1];
      *(uint2*)&pb[(size_t)row * 1024 + c] = pack4(cgv[0] * v[0], cgv[1] * v[1], cgv[2] * v[2], cgv[3] * v[3]);
      *(uint2*)&sb[(size_t)row * 1024 + c] = pack4(siluf_(g[0]) * bg[0], siluf_(g[1]) * bg[1], siluf_(g[2]) * bg[2], siluf_(g[3]) * bg[3]);
    )
  }
};

struct EpiRgIn {
  u16 *ub, *sg;
  __device__ __forceinline__ void operator()(AccRef acc, const Unit& u, int wr, int wc, int fr, int fq) const {
    const int region = u.pn >> 2;
    EPI_ROWS( EPI_COLS(
      const int c = (cb & 1023) + fq * 4;
      if (region == 0) *(uint2*)&ub[(size_t)row * 1024 + c] = pack4(a[0], a[1], a[2], a[3]);
      else *(uint2*)&sg[(size_t)row * 1024 + c] = pack4(siluf_(a[0]), siluf_(a[1]), siluf_(a[2]), siluf_(a[3]));
    ) )
  }
};

struct EpiRgGate {
  u16 *rb, *ib; const float* bgate;
  __device__ __forceinline__ void operator()(AccRef acc, const Unit& u, int wr, int wc, int fr, int fq) const {
    const int mat = u.pn >> 1, d = mat >> 2, hd = mat & 3;
    EPI_ROWS(
      _Pragma("unroll") for (int bj = 0; bj < 2; ++bj) {
        const int off = ((u.pn & 1) * 256 + bj * 128 + wc * 32);
        const int cc = (off >> 5) * 16 + fq * 4;
        f32x4 br = *(const f32x4*)&bgate[mat * 512 + cc];
        f32x4 bi = *(const f32x4*)&bgate[mat * 512 + 256 + cc];
        const f32x4 r = acc[ai][bj][m][0], ii = acc[ai][bj][m][1];
        const size_t o = ((size_t)d * TOK + row) * 1024 + hd * 256 + cc;
        *(uint2*)&rb[o] = pack4(sigmoidf_(r[0] + br[0]), sigmoidf_(r[1] + br[1]), sigmoidf_(r[2] + br[2]), sigmoidf_(r[3] + br[3]));
        *(uint2*)&ib[o] = pack4(sigmoidf_(ii[0] + bi[0]), sigmoidf_(ii[1] + bi[1]), sigmoidf_(ii[2] + bi[2]), sigmoidf_(ii[3] + bi[3]));
      } )
  }
};

struct EpiMlaIn {
  u16* cq; float* ckvraw; float* kperaw; u16* sg;
  __device__ __forceinline__ void operator()(AccRef acc, const Unit& u, int wr, int wc, int fr, int fq) const {
    EPI_ROWS( EPI_COLS(
      const int c = cb + fq * 4;
      if (cb < 384) *(uint2*)&cq[(size_t)row * 384 + c] = pack4(a[0], a[1], a[2], a[3]);
      else if (cb < 640) *(f32x4*)&ckvraw[(size_t)row * 256 + (c - 384)] = a;
      else if (cb < 672) *(f32x4*)&kperaw[(size_t)row * 32 + (c - 640)] = a;
      else if (cb < 1696) *(uint2*)&sg[(size_t)row * 1024 + (c - 672)] = pack4(siluf_(a[0]), siluf_(a[1]), siluf_(a[2]), siluf_(a[3]));
    ) )
  }
};

struct EpiQ {
  u16* q;
  __device__ __forceinline__ void operator()(AccRef acc, const Unit& u, int wr, int wc, int fr, int fq) const {
    const float sc = 0.10206207261596575f;
    EPI_ROWS( EPI_COLS(
      *(uint2*)&q[(size_t)row * 1536 + cb + fq * 4] = pack4(a[0] * sc, a[1] * sc, a[2] * sc, a[3] * sc);
    ) )
  }
};

struct EpiKV {
  u16 *Kb, *Vt;
  __device__ __forceinline__ void operator()(AccRef acc, const Unit& u, int wr, int wc, int fr, int fq) const {
    EPI_ROWS( EPI_COLS(
      const int h = cb >> 7, d0 = cb & 127, dd = (d0 & 63) + fq * 4;
      if (d0 < 64) {
        *(uint2*)&Kb[((size_t)row * 16 + h) * 96 + dd] = pack4(a[0], a[1], a[2], a[3]);
      } else {
        _Pragma("unroll") for (int j = 0; j < 4; ++j) Vt[((size_t)(h * 64 + dd + j)) * KVROWS + row] = f2bf(a[j]);
      }
    ) )
  }
};

__device__ __forceinline__ void wconv_tile(const float* __restrict__ src, int N, int K, u16* __restrict__ dst, int k0, int n0,
                                           int perm, int mat, float* tile) {
  const int tid = threadIdx.x;
  {
    const int r = tid >> 4, c4 = (tid & 15) * 4;
#pragma unroll
    for (int i = 0; i < 2; ++i) {
      const int k = r + i * 32;
      f32x4 v = f32x4{0.f, 0.f, 0.f, 0.f};
      if (n0 + c4 < N) v = *(const f32x4*)&src[(size_t)(k0 + k) * N + n0 + c4];
      tile[k * 65 + c4 + 0] = v[0]; tile[k * 65 + c4 + 1] = v[1]; tile[k * 65 + c4 + 2] = v[2]; tile[k * 65 + c4 + 3] = v[3];
    }
  }
  __syncthreads();
  {
    const int nl = tid >> 3, kq = (tid & 7) * 8;
    const int n = n0 + nl;
    int np = n;
    if (perm == 1) { const int part = n >> 10, c = n & 1023; np = (c >> 6) * 256 + (part >> 1) * 128 + ((c >> 4) & 3) * 32 + (part & 1) * 16 + (c & 15); }
    else if (perm == 2) { const int type = n >> 8, cc = n & 255; np = mat * 512 + (cc >> 4) * 32 + type * 16 + (cc & 15); }
    if (n < N) {
      unsigned w[4];
#pragma unroll
      for (int i = 0; i < 4; ++i) w[i] = pack2(tile[(kq + 2 * i) * 65 + nl], tile[(kq + 2 * i + 1) * 65 + nl]);
      *(uint4*)&dst[(size_t)np * K + k0 + kq] = make_uint4(w[0], w[1], w[2], w[3]);
    }
  }
  __syncthreads();
}

__device__ __forceinline__ void phase_prologue(const Params& p, unsigned char* smem_raw, int bid, int nb) {
  float* fs = (float*)smem_raw;
  const int tid = threadIdx.x;
  const int NMOD = 192, NWT = 4800;
  for (int it = bid; it < NMOD + 1 + NWT; it += nb) {
    if (it < NMOD) {
      const int l = it / 48, n0 = (it % 48) * 64;
      float* scond = fs;
      float* sred = fs + 5120;
      for (int i = tid; i < 5120; i += NT) {
        const int ci = i >> 10, k = i & 1023;
        float cv = ci == 0 ? p.in[7][k] : p.in[6][(ci - 1) * 1024 + k];
        scond[i] = siluf_(cv);
      }
      __syncthreads();
      const int col = tid & 63, kg = tid >> 6;
      const float* w = p.in[8] + (size_t)l * 1024 * 3072 + n0 + col;
      float a0 = 0, a1 = 0, a2 = 0, a3 = 0, a4 = 0;
#pragma unroll 16
      for (int k = kg * 128; k < kg * 128 + 128; ++k) {
        float wv = w[(size_t)k * 3072];
        a0 += scond[k] * wv; a1 += scond[1024 + k] * wv; a2 += scond[2048 + k] * wv; a3 += scond[3072 + k] * wv; a4 += scond[4096 + k] * wv;
      }
      sred[(kg * 5 + 0) * 64 + col] = a0; sred[(kg * 5 + 1) * 64 + col] = a1; sred[(kg * 5 + 2) * 64 + col] = a2;
      sred[(kg * 5 + 3) * 64 + col] = a3; sred[(kg * 5 + 4) * 64 + col] = a4;
      __syncthreads();
      float* mod = (float*)(p.ws + WS_MOD);
      if (tid < 320) {
        const int ci = tid >> 6, cc = tid & 63;
        float s = 0;
#pragma unroll
        for (int g = 0; g < 8; ++g) s += sred[(g * 5 + ci) * 64 + cc];
        mod[(l * 5 + ci) * 3072 + n0 + cc] = s + p.in[9][l * 3072 + n0 + cc];
      }
      __syncthreads();
    } else if (it == NMOD) {
      float* lb = (float*)(p.ws + WS_LB);
      for (int i = tid; i < 2048; i += NT) {
        const int d = i >> 10, c = i & 1023;
        const float* lg = p.in[13] + d * 5 * 1024 + c;
        float m = lg[0];
        for (int j = 1; j < 5; ++j) m = fmaxf(m, lg[j * 1024]);
        float s = 0;
        for (int j = 0; j < 5; ++j) s += expf(lg[j * 1024] - m);
        lb[i] = expf(lg[0] - m) / s;
      }
      int* cnt = (int*)(p.ws + WS_CNT);
      if (tid < 16) cnt[tid] = 0;
    } else {
      int t = it - NMOD - 1;
      const float* src; u16* dst; int N, K, perm = 0, mat = 0, ntn;
      if (t < 1280) { src = p.in[12]; dst = (u16*)(p.ws + WS_W_HG_IN); N = 5120; K = 1024; }
      else if ((t -= 1280) < 256) { src = p.in[15]; dst = (u16*)(p.ws + WS_W_HG_OUT); N = 1024; K = 1024; }
      else if ((t -= 256) < 1024) { src = p.in[16]; dst = (u16*)(p.ws + WS_W_SC_IN); N = 4096; K = 1024; perm = 1; }
      else if ((t -= 1024) < 256) { src = p.in[19]; dst = (u16*)(p.ws + WS_W_SC_OUT); N = 1024; K = 1024; }
      else if ((t -= 256) < 512) { src = p.in[20]; dst = (u16*)(p.ws + WS_W_RG_IN); N = 2048; K = 1024; }
      else if ((t -= 512) < 256) { mat = t >> 5; t &= 31; src = p.in[23] + (size_t)mat * 256 * 512; dst = (u16*)(p.ws + WS_W_RG_GATE); N = 512; K = 256; perm = 2; }
      else if ((t -= 256) < 256) { src = p.in[26]; dst = (u16*)(p.ws + WS_W_RG_OUT); N = 1024; K = 1024; }
      else if ((t -= 256) < 432) { src = p.in[27]; dst = (u16*)(p.ws + WS_W_MLA_IN); N = 1696; K = 1024; }
      else if ((t -= 432) < 144) { src = p.in[30]; dst = (u16*)(p.ws + WS_W_QB); N = 1536; K = 384; }
      else if ((t -= 144) < 128) { src = p.in[31]; dst = (u16*)(p.ws + WS_W_KVB); N = 2048; K = 256; }
      else { t -= 128; src = p.in[32]; dst = (u16*)(p.ws + WS_W_MLA_OUT); N = 1024; K = 1024; }
      ntn = (N + 63) >> 6;
      const int kt = t / ntn, ntl = t - kt * ntn;
      wconv_tile(src, N, K, dst, kt * 64, ntl * 64, perm, mat, fs);
    }
  }
}

__device__ __forceinline__ void phase_h0(const Params& p, int bid, int nb) {
  const float* mod = (const float*)(p.ws + WS_MOD);
  u16* H = (u16*)(p.ws + WS_H);
  const size_t total = (size_t)TOK * 256;
  for (size_t i = (size_t)bid * NT + threadIdx.x; i < total; i += (size_t)nb * NT) {
    const int row = (int)(i >> 8), c = ((int)i & 255) * 4;
    const float* xr = row < NPROMPT ? p.in[0] + (size_t)row * 1024 : p.in[1] + (size_t)(row - NPROMPT) * 1024;
    const float* m = mod + cond_of(row) * 3072;
    f32x4 x = *(const f32x4*)&xr[c];
    f32x4 sh = *(const f32x4*)&m[c];
    f32x4 sc = *(const f32x4*)&m[1024 + c];
    *(uint2*)&H[(size_t)row * 1024 + c] = pack4(x[0] * (1 + sc[0]) + sh[0], x[1] * (1 + sc[1]) + sh[1], x[2] * (1 + sc[2]) + sh[2], x[3] * (1 + sc[3]) + sh[3]);
  }
}

__device__ __forceinline__ void phase_ln(const Params& p, int l, int bid, int nb) {
  float* X = p.out;
  const float* g = p.in[10] + l * 1024;
  const float* b = p.in[11] + l * 1024;
  const float* mod = (const float*)(p.ws + WS_MOD) + (l + 1) * 5 * 3072;
  u16* H = (u16*)(p.ws + WS_H);
  const int lane = threadIdx.x & 63, wave = threadIdx.x >> 6;
  for (int row = bid * NW + wave; row < TOK; row += nb * NW) {
    float* xr = X + (size_t)row * 1024;
    f32x4 v[4];
    float s = 0;
#pragma unroll
    for (int i = 0; i < 4; ++i) { v[i] = *(const f32x4*)&xr[i * 256 + lane * 4]; s += v[i][0] + v[i][1] + v[i][2] + v[i][3]; }
    const float mu = wave_sum(s) * (1.0f / 1024.0f);
    float q = 0;
#pragma unroll
    for (int i = 0; i < 4; ++i)
#pragma unroll
      for (int j = 0; j < 4; ++j) { float dd = v[i][j] - mu; q += dd * dd; }
    const float rs = rsqrtf(wave_sum(q) * (1.0f / 1024.0f) + 1e-5f);
    const float* m = mod + cond_of(row) * 3072;
#pragma unroll
    for (int i = 0; i < 4; ++i) {
      const int c = i * 256 + lane * 4;
      f32x4 gg = *(const f32x4*)&g[c], bb = *(const f32x4*)&b[c];
      f32x4 y;
#pragma unroll
      for (int j = 0; j < 4; ++j) y[j] = (v[i][j] - mu) * rs * gg[j] + bb[j];
      *(f32x4*)&xr[c] = y;
      if (l < 3) {
        f32x4 sh = *(const f32x4*)&m[c], sc = *(const f32x4*)&m[1024 + c];
        *(uint2*)&H[(size_t)row * 1024 + c] = pack4(y[0] * (1 + sc[0]) + sh[0], y[1] * (1 + sc[1]) + sh[1], y[2] * (1 + sc[2]) + sh[2], y[3] * (1 + sc[3]) + sh[3]);
      }
    }
  }
}

__device__ __forceinline__ void phase_gla(const Params& p, unsigned char* smem_raw) {
  u16* s_qrel = (u16*)smem_raw;
  u16* s_krel = s_qrel + 32 * 136;
  u16* s_qcum = s_krel + 32 * 136;
  u16* s_kdT = s_qcum + 32 * 136;
  u16* s_vT = s_kdT + 128 * 40;
  u16* s_att = s_vT + 64 * 40;
  u16* s_S = s_att + 32 * 40;
  float* s_dec = (float*)(s_S + 64 * 136);
  float* s_part = s_dec + 128;
  int* s_u = (int*)(s_part + 512);
  int* counter = (int*)(p.ws + WS_CNT);
  const u16* qg = (const u16*)(p.ws + WS_B(0));
  const u16* vg = (const u16*)(p.ws + WS_B(1));
  const _Float16* lfg = (const _Float16*)(p.ws + WS_B(3));
  u16* og = (u16*)(p.ws + WS_B(5));
  const int tid = threadIdx.x, lane = tid & 63, w = tid >> 6, fr = lane & 15, fq = lane >> 4;
  const int kk = tid & 127, th = tid >> 7;
  const int ti = w >> 2, vi = w & 3;
  const int wk = w & 3, wv = w >> 2;
  while (true) {
    if (tid == 0) *s_u = atomicAdd(counter, 1);
    __syncthreads();
    const int u = *s_u;
    __syncthreads();
    if (u >= 1152) break;
    int b, rem, start, N, sample;
    if (u < 128) { sample = 1; b = u >> 5; rem = u & 31; start = NPROMPT + b * 1024; N = 1024; }
    else { sample = 0; b = (u - 128) >> 5; rem = (u - 128) & 31; start = b * 256; N = 256; }
    const int h = rem >> 2, d = (rem >> 1) & 1, vs = rem & 1;
    const int nc = N >> 5;
    f32x4 S[2][2];
#pragma unroll
    for (int mi = 0; mi < 2; ++mi)
#pragma unroll
      for (int ni = 0; ni < 2; ++ni) {
        f32x4 s4 = f32x4{0.f, 0.f, 0.f, 0.f};
        if (sample) {
          const float* s0 = p.in[2] + ((size_t)((b * 2 + d) * 8 + h)) * 16384;
#pragma unroll
          for (int j = 0; j < 4; ++j) s4[j] = s0[(wk * 32 + mi * 16 + fq * 4 + j) * 128 + vs * 64 + wv * 32 + ni * 16 + fr];
        }
        S[mi][ni] = s4;
        *(uint2*)&s_S[(wv * 32 + ni * 16 + fr) * 136 + wk * 32 + mi * 16 + fq * 4] = pack4(s4[0], s4[1], s4[2], s4[3]);
      }
    for (int c = 0; c < nc; ++c) {
      {
        float lfv[8], qv[8];
#pragma unroll
        for (int i = 0; i < 8; ++i) {
          const int tt = c * 32 + th * 8 + i;
          const size_t tok = start + (d ? (N - 1 - tt) : tt);
          lfv[i] = (float)lfg[tok * 2048 + d * 1024 + h * 128 + kk];
          qv[i] = bf2f(qg[tok * 1024 + h * 128 + kk]);
        }
        float run = 0;
        float cs[8];
#pragma unroll
        for (int i = 0; i < 8; ++i) { run += lfv[i]; cs[i] = run; }
        s_part[th * 128 + kk] = run;
        {
          const int s = tid >> 4, v4 = (tid & 15) * 4;
          const int tt = c * 32 + s;
          const size_t tok = start + (d ? (N - 1 - tt) : tt);
          uint2 vv = *(const uint2*)&vg[tok * 1024 + h * 128 + vs * 64 + v4];
          s_vT[(v4 + 0) * 40 + s] = (u16)(vv.x & 0xffff); s_vT[(v4 + 1) * 40 + s] = (u16)(vv.x >> 16);
          s_vT[(v4 + 2) * 40 + s] = (u16)(vv.y & 0xffff); s_vT[(v4 + 3) * 40 + s] = (u16)(vv.y >> 16);
        }
        __syncthreads();
        const float p0 = s_part[kk], p1 = s_part[128 + kk], p2 = s_part[256 + kk], p3 = s_part[384 + kk];
        const float off = (th > 0 ? p0 : 0.f) + (th > 1 ? p1 : 0.f) + (th > 2 ? p2 : 0.f);
        const float ref = p0 + p1, total = p0 + p1 + p2 + p3;
        unsigned kd[4];
#pragma unroll
        for (int i = 0; i < 8; ++i) {
          const int t = th * 8 + i;
          const float cum = off + cs[i];
          const float kf = 1.0f - __expf(lfv[i]);
          s_qrel[t * 136 + kk] = f2bf(qv[i] * __expf(cum - ref));
          s_krel[t * 136 + kk] = f2bf(kf * __expf(ref - cum));
          s_qcum[t * 136 + kk] = f2bf(qv[i] * __expf(cum));
          const u16 kdv = f2bf(kf * __expf(total - cum));
          if (i & 1) kd[i >> 1] |= ((unsigned)kdv) << 16; else kd[i >> 1] = kdv;
        }
        *(uint4*)&s_kdT[kk * 40 + th * 8] = make_uint4(kd[0], kd[1], kd[2], kd[3]);
        if (th == 0) s_dec[kk] = __expf(total);
      }
      __syncthreads();
      f32x4 oacc = f32x4{0.f, 0.f, 0.f, 0.f};
      {
        f32x4 att = f32x4{0.f, 0.f, 0.f, 0.f};
        const int ati = w >> 1, asi = w & 1;
#pragma unroll
        for (int ks = 0; ks < 4; ++ks) {
          if (w < 4) {
            bf16x8 a = *(const bf16x8*)&s_qrel[(ati * 16 + fr) * 136 + ks * 32 + fq * 8];
            bf16x8 bb = *(const bf16x8*)&s_krel[(asi * 16 + fr) * 136 + ks * 32 + fq * 8];
            att = __builtin_amdgcn_mfma_f32_16x16x32_bf16(a, bb, att, 0, 0, 0);
          }
          bf16x8 a2 = *(const bf16x8*)&s_qcum[(ti * 16 + fr) * 136 + ks * 32 + fq * 8];
          bf16x8 b2 = *(const bf16x8*)&s_S[(vi * 16 + fr) * 136 + ks * 32 + fq * 8];
          oacc = __builtin_amdgcn_mfma_f32_16x16x32_bf16(a2, b2, oacc, 0, 0, 0);
        }
        if (w < 4) {
#pragma unroll
          for (int j = 0; j < 4; ++j) {
            const int t = ati * 16 + fq * 4 + j, s = asi * 16 + fr;
            s_att[t * 40 + s] = (s <= t) ? f2bf(att[j]) : (u16)0;
          }
        }
      }
      __syncthreads();
      {
        bf16x8 a = *(const bf16x8*)&s_att[(ti * 16 + fr) * 40 + fq * 8];
        bf16x8 bb = *(const bf16x8*)&s_vT[(vi * 16 + fr) * 40 + fq * 8];
        oacc = __builtin_amdgcn_mfma_f32_16x16x32_bf16(a, bb, oacc, 0, 0, 0);
#pragma unroll
        for (int j = 0; j < 4; ++j) {
          const int tt = c * 32 + ti * 16 + fq * 4 + j;
          const size_t tok = start + (d ? (N - 1 - tt) : tt);
          og[((size_t)d * TOK + tok) * 1024 + h * 128 + vs * 64 + vi * 16 + fr] = f2bf(oacc[j]);
        }
        bf16x8 vf[2];
#pragma unroll
        for (int ni = 0; ni < 2; ++ni) vf[ni] = *(const bf16x8*)&s_vT[(wv * 32 + ni * 16 + fr) * 40 + fq * 8];
#pragma unroll
        for (int mi = 0; mi < 2; ++mi) {
          bf16x8 kf = *(const bf16x8*)&s_kdT[(wk * 32 + mi * 16 + fr) * 40 + fq * 8];
          f32x4 dc = *(const f32x4*)&s_dec[wk * 32 + mi * 16 + fq * 4];
#pragma unroll
          for (int ni = 0; ni < 2; ++ni) {
            f32x4 s4 = S[mi][ni];
#pragma unroll
            for (int j = 0; j < 4; ++j) s4[j] *= dc[j];
            s4 = __builtin_amdgcn_mfma_f32_16x16x32_bf16(kf, vf[ni], s4, 0, 0, 0);
            S[mi][ni] = s4;
            *(uint2*)&s_S[(wv * 32 + ni * 16 + fr) * 136 + wk * 32 + mi * 16 + fq * 4] = pack4(s4[0], s4[1], s4[2], s4[3]);
          }
        }
      }
      __syncthreads();
    }
    if (!sample) {
      float* so = p.out + OUT_HG + ((size_t)((b * 2 + d) * 8 + h)) * 16384;
#pragma unroll
      for (int mi = 0; mi < 2; ++mi)
#pragma unroll
        for (int ni = 0; ni < 2; ++ni)
#pragma unroll
          for (int j = 0; j < 4; ++j) so[(wk * 32 + mi * 16 + fq * 4 + j) * 128 + vs * 64 + wv * 32 + ni * 16 + fr] = S[mi][ni][j];
    }
  }
}

__device__ __forceinline__ void phase_hg_post(const Params& p, int bid, int nb) {
  const u16* og = (const u16*)(p.ws + WS_B(5));
  const u16* sg = (const u16*)(p.ws + WS_B(2));
  u16* a = (u16*)(p.ws + WS_B(0));
  const float* ng = p.in[14];
  const int lane = threadIdx.x & 63, wave = threadIdx.x >> 6;
  for (int row = bid * NW + wave; row < TOK; row += nb * NW) {
    const size_t base = (size_t)row * 1024 + lane * 16;
    float o[16];
    float ss = 0;
#pragma unroll
    for (int hh = 0; hh < 2; ++hh) {
      uint4 f = *(const uint4*)&og[base + hh * 8];
      uint4 bw = *(const uint4*)&og[(size_t)TOK * 1024 + base + hh * 8];
      unsigned fa[4] = {f.x, f.y, f.z, f.w}, ba[4] = {bw.x, bw.y, bw.z, bw.w};
#pragma unroll
      for (int i = 0; i < 4; ++i) {
        o[hh * 8 + 2 * i] = lo16(fa[i]) + lo16(ba[i]);
        o[hh * 8 + 2 * i + 1] = hi16(fa[i]) + hi16(ba[i]);
      }
    }
#pragma unroll
    for (int i = 0; i < 16; ++i) ss += o[i] * o[i];
    ss += __shfl_xor(ss, 1); ss += __shfl_xor(ss, 2); ss += __shfl_xor(ss, 4);
    const float rs = rsqrtf(ss * (1.0f / 128.0f) + 1e-6f);
#pragma unroll
    for (int hh = 0; hh < 2; ++hh) {
      uint4 s = *(const uint4*)&sg[base + hh * 8];
      unsigned sa[4] = {s.x, s.y, s.z, s.w};
      unsigned r[4];
#pragma unroll
      for (int i = 0; i < 4; ++i) {
        const int c = lane * 16 + hh * 8 + 2 * i;
        r[i] = pack2(o[hh * 8 + 2 * i] * rs * ng[c] * lo16(sa[i]), o[hh * 8 + 2 * i + 1] * rs * ng[c + 1] * hi16(sa[i]));
      }
      *(uint4*)&a[base + hh * 8] = make_uint4(r[0], r[1], r[2], r[3]);
    }
  }
}

__device__ __forceinline__ void seq_pos(int tok, int& n, int& L) {
  if (tok < NPROMPT) { n = tok & 255; L = 256; } else { n = (tok - NPROMPT) & 1023; L = 1024; }
}
__device__ __forceinline__ void phase_sc_conv(const Params& p, int bid, int nb) {
  const u16* pb = (const u16*)(p.ws + WS_B(0));
  const u16* sb = (const u16*)(p.ws + WS_B(1));
  u16* a = (u16*)(p.ws + WS_B(2));
  const float* cw = p.in[17]; const float* cbias = p.in[18];
  const size_t total = (size_t)TOK * 128;
  for (size_t i = (size_t)bid * NT + threadIdx.x; i < total; i += (size_t)nb * NT) {
    const int tok = (int)(i >> 7), c = ((int)i & 127) * 8;
    int n, L; seq_pos(tok, n, L);
    const size_t base = (size_t)tok * 1024 + c;
    uint4 z = make_uint4(0, 0, 0, 0);
    uint4 pm = n > 0 ? *(const uint4*)&pb[base - 1024] : z;
    uint4 p0 = *(const uint4*)&pb[base];
    uint4 pp = n < L - 1 ? *(const uint4*)&pb[base + 1024] : z;
    uint4 s = *(const uint4*)&sb[base];
    unsigned am[4] = {pm.x, pm.y, pm.z, pm.w}, a0[4] = {p0.x, p0.y, p0.z, p0.w}, ap[4] = {pp.x, pp.y, pp.z, pp.w}, as[4] = {s.x, s.y, s.z, s.w};
    unsigned r[4];
#pragma unroll
    for (int k = 0; k < 4; ++k) {
      const int c0 = c + 2 * k, c1 = c0 + 1;
      float z0 = cw[c0] * lo16(am[k]) + cw[1024 + c0] * lo16(a0[k]) + cw[2048 + c0] * lo16(ap[k]) + cbias[c0];
      float z1 = cw[c1] * hi16(am[k]) + cw[1024 + c1] * hi16(a0[k]) + cw[2048 + c1] * hi16(ap[k]) + cbias[c1];
      r[k] = pack2(lo16(as[k]) * z0, hi16(as[k]) * z1);
    }
    *(uint4*)&a[base] = make_uint4(r[0], r[1], r[2], r[3]);
  }
}
__device__ __forceinline__ void phase_rg_conv(const Params& p, int bid, int nb) {
  const u16* ub = (const u16*)(p.ws + WS_B(0));
  u16* uc = (u16*)(p.ws + WS_B(2));
  const float* cw = p.in[21]; const float* cbias = p.in[22];
  const size_t total = (size_t)TOK * 128;
  for (size_t i = (size_t)bid * NT + threadIdx.x; i < total; i += (size_t)nb * NT) {
    const int tok = (int)(i >> 7), c = ((int)i & 127) * 8;
    int n, L; seq_pos(tok, n, L);
    const size_t base = (size_t)tok * 1024 + c;
    uint4 z = make_uint4(0, 0, 0, 0);
    uint4 q0 = n > 1 ? *(const uint4*)&ub[base - 2048] : z;
    uint4 q1 = n > 0 ? *(const uint4*)&ub[base - 1024] : z;
    uint4 q2 = *(const uint4*)&ub[base];
    uint4 q3 = n < L - 1 ? *(const uint4*)&ub[base + 1024] : z;
    unsigned a0[4] = {q0.x, q0.y, q0.z, q0.w}, a1[4] = {q1.x, q1.y, q1.z, q1.w}, a2[4] = {q2.x, q2.y, q2.z, q2.w}, a3[4] = {q3.x, q3.y, q3.z, q3.w};
    unsigned r[4];
#pragma unroll
    for (int k = 0; k < 4; ++k) {
      const int c0 = c + 2 * k, c1 = c0 + 1;
      float z0 = cw[c0] * lo16(a0[k]) + cw[1024 + c0] * lo16(a1[k]) + cw[2048 + c0] * lo16(a2[k]) + cw[3072 + c0] * lo16(a3[k]) + cbias[c0];
      float z1 = cw[c1] * hi16(a0[k]) + cw[1024 + c1] * hi16(a1[k]) + cw[2048 + c1] * hi16(a2[k]) + cw[3072 + c1] * hi16(a3[k]) + cbias[c1];
      r[k] = pack2(z0, z1);
    }
    *(uint4*)&uc[base] = make_uint4(r[0], r[1], r[2], r[3]);
  }
}

__device__ __forceinline__ void phase_rg_scan(const Params& p, unsigned char* smem_raw, int bid, int nb) {
  float* sA = (float*)smem_raw;
  float* sB = sA + 2048;
  const u16* rb = (const u16*)(p.ws + WS_B(3));
  const u16* ib = (const u16*)(p.ws + WS_B(5));
  const u16* uc = (const u16*)(p.ws + WS_B(2));
  const u16* sg = (const u16*)(p.ws + WS_B(1));
  u16* hfw = (u16*)(p.ws + WS_H);
  u16* yp = (u16*)(p.ws + WS_B(0));
  const int tid = threadIdx.x;
  for (int u = bid; u < 768; u += nb) {
    int sample, b, c, seg, nseg, start, cl_;
    if (u < 256) { sample = 1; b = u >> 6; cl_ = tid & 15; c = (u & 63) * 16 + cl_; seg = tid >> 4; nseg = 32; start = NPROMPT + b * 1024; }
    else { sample = 0; b = (u - 256) >> 4; cl_ = tid & 63; c = ((u - 256) & 15) * 64 + cl_; seg = tid >> 6; nseg = 8; start = b * 256; }
    const int L = nseg * 32;
#pragma unroll 1
    for (int d = 0; d < 2; ++d) {
      const float lam = p.in[25][d * 1024 + c];
      const float cl = 8.0f * log1pf(__expf(-lam));
      const u16* rp = rb + (size_t)d * TOK * 1024;
      const u16* ip = ib + (size_t)d * TOK * 1024;
      const size_t o0 = (size_t)(start + (d ? L - 1 - seg * 32 : seg * 32)) * 1024 + c;
      const long ostep = d ? -1024 : 1024;
      float av[32], xv[32];
      float Aacc = 1.f, Bacc = 0.f;
#pragma unroll
      for (int s = 0; s < 32; ++s) {
        const size_t o = o0 + s * ostep;
        const float r = bf2f(rp[o]), ig = bf2f(ip[o]), uu = bf2f(uc[o]);
        const float la = -cl * r;
        const float a = __expf(la);
        const float xin = sqrtf(fmaxf(1.0f - __expf(2.0f * la), 0.f)) * (ig * uu);
        av[s] = a; xv[s] = xin;
      }
#pragma unroll
      for (int s = 0; s < 32; ++s) { Aacc *= av[s]; Bacc = av[s] * Bacc + xv[s]; }
      sA[seg * 64 + cl_] = Aacc; sB[seg * 64 + cl_] = Bacc;
      __syncthreads();
      float h = sample ? p.in[3][(b * 2 + d) * 1024 + c] : 0.f;
      for (int s2 = 0; s2 < seg; ++s2) h = sA[s2 * 64 + cl_] * h + sB[s2 * 64 + cl_];
      if (d == 0) {
#pragma unroll
        for (int s = 0; s < 32; ++s) { h = av[s] * h + xv[s]; hfw[o0 + s * ostep] = f2bf(h); }
      } else {
        float hf[32], sgv[32];
#pragma unroll
        for (int s = 0; s < 32; ++s) { const size_t o = o0 + s * ostep; hf[s] = bf2f(hfw[o]); sgv[s] = bf2f(sg[o]); }
#pragma unroll
        for (int s = 0; s < 32; ++s) { h = av[s] * h + xv[s]; yp[o0 + s * ostep] = f2bf((hf[s] + h) * sgv[s]); }
      }
      if (!sample && seg == nseg - 1) p.out[OUT_RG + (b * 2 + d) * 1024 + c] = h;
      __syncthreads();
    }
  }
}

__device__ __forceinline__ void phase_mla_norm(const Params& p, int bid, int nb) {
  u16* cq = (u16*)(p.ws + WS3_CQ);
  u16* ckvall = (u16*)(p.ws + WS3_CKVALL);
  const float* ckvraw = (const float*)(p.ws + WS3_CKVRAW);
  const float* kperaw = (const float*)(p.ws + WS3_KPERAW);
  u16* Kb = (u16*)(p.ws + WS3_K);
  const float* qn = p.in[28]; const float* kvn = p.in[29];
  const int lane = threadIdx.x & 63, wave = threadIdx.x >> 6;
  for (int row = bid * NW + wave; row < TOK + 2048; row += nb * NW) {
    if (row < TOK) {
      const int tok = row;
      const bool sample = tok >= NPROMPT;
      const int bs = (tok - NPROMPT) >> 10, n = (tok - NPROMPT) & 1023;
      const size_t kvrow = sample ? (size_t)(NPROMPT + bs * 1536 + 512 + n) : (size_t)tok;
      unsigned* cqr = (unsigned*)&cq[(size_t)tok * 384];
      unsigned cv[3]; float ss = 0;
#pragma unroll
      for (int i = 0; i < 3; ++i) { cv[i] = cqr[i * 64 + lane]; float a = lo16(cv[i]), b2 = hi16(cv[i]); ss += a * a + b2 * b2; }
      const float rsq = rsqrtf(wave_sum(ss) * (1.0f / 384.0f) + 1e-6f);
#pragma unroll
      for (int i = 0; i < 3; ++i) {
        const int k = (i * 64 + lane) * 2;
        cqr[i * 64 + lane] = pack2(lo16(cv[i]) * rsq * qn[k], hi16(cv[i]) * rsq * qn[k + 1]);
      }
      f32x4 kv = *(const f32x4*)&ckvraw[(size_t)tok * 256 + lane * 4];
      const float rsk = rsqrtf(wave_sum(kv[0] * kv[0] + kv[1] * kv[1] + kv[2] * kv[2] + kv[3] * kv[3]) * (1.0f / 256.0f) + 1e-6f);
      f32x4 g4 = *(const f32x4*)&kvn[lane * 4];
      f32x4 o4;
#pragma unroll
      for (int j = 0; j < 4; ++j) o4[j] = kv[j] * rsk * g4[j];
      *(uint2*)&ckvall[kvrow * 256 + lane * 4] = pack4(o4[0], o4[1], o4[2], o4[3]);
      if (!sample) *(f32x4*)&p.out[OUT_CKV + (size_t)tok * 256 + lane * 4] = o4;
      float v = kperaw[(size_t)tok * 32 + (lane & 31)];
      if (!sample) { if (lane < 32) p.out[OUT_KPE + (size_t)tok * 32 + lane] = v; }
      else {
        const float partner = __shfl_xor(v, 8);
        const int i16 = lane & 15;
        const float pos = (lane & 16) ? (float)(n & 63) : (float)(n >> 6);
        float sn, cs; rope_sincos(pos, i16 & 7, sn, cs);
        v = (i16 < 8) ? (v * cs - partner * sn) : (partner * sn + v * cs);
      }
      const u16 vb = f2bf(v);
#pragma unroll
      for (int i = 0; i < 8; ++i) Kb[(kvrow * 16 + (lane >> 5) + 2 * i) * 96 + 64 + (lane & 31)] = vb;
    } else {
      const int r = row - TOK, bs = r >> 9, j = r & 511;
      const size_t kvrow = (size_t)(NPROMPT + bs * 1536 + j);
      f32x4 kv = *(const f32x4*)&p.in[4][(size_t)r * 256 + lane * 4];
      *(uint2*)&ckvall[kvrow * 256 + lane * 4] = pack4(kv[0], kv[1], kv[2], kv[3]);
      const u16 vb = f2bf(p.in[5][(size_t)r * 32 + (lane & 31)]);
#pragma unroll
      for (int i = 0; i < 8; ++i) Kb[(kvrow * 16 + (lane >> 5) + 2 * i) * 96 + 64 + (lane & 31)] = vb;
    }
  }
}

__device__ __forceinline__ void phase_attn(const Params& p, unsigned char* smem_raw, int bid, int nb) {
  u16* sK = (u16*)smem_raw;
  u16* sV = sK + 64 * 104;
  const u16* qg = (const u16*)(p.ws + WS3_Q);
  const u16* Kg = (const u16*)(p.ws + WS3_K);
  const u16* Vg = (const u16*)(p.ws + WS3_VT);
  const u16* sg = (const u16*)(p.ws + WS3_SG);
  u16* ao = (u16*)(p.ws + WS_H);
  const int tid = threadIdx.x, lane = tid & 63, w = tid >> 6, fr = lane & 15, fq = lane >> 4;
  for (int u = bid; u < 1536; u += nb) {
    int tok0, kvbase, nkeys, h;
    if (u < 512) { const int b = u >> 7, r = u & 127; h = r >> 3; const int qb = r & 7; tok0 = NPROMPT + b * 1024 + qb * 128; kvbase = NPROMPT + b * 1536; nkeys = 1536; }
    else { const int uu = u - 512; const int b = uu >> 5, r = uu & 31; h = r >> 1; const int qb = r & 1; tok0 = b * 256 + qb * 128; kvbase = b * 256; nkeys = 256; }
    const int tokq = tok0 + w * 16 + fr;
    bf16x8 qf[3];
#pragma unroll
    for (int ks = 0; ks < 3; ++ks) qf[ks] = *(const bf16x8*)&qg[(size_t)tokq * 1536 + h * 96 + ks * 32 + fq * 8];
    if (u < 512) {
      const int npos = (tokq - NPROMPT) & 1023;
      const float pos = (fq & 2) ? (float)(npos & 63) : (float)(npos >> 6);
      uint4 raw = *(uint4*)&qf[2];
      unsigned rw[4] = {raw.x, raw.y, raw.z, raw.w};
#pragma unroll
      for (int i = 0; i < 4; ++i) {
        float v0 = lo16(rw[i]), v1 = hi16(rw[i]);
        const float p0 = __shfl_xor(v0, 16), p1 = __shfl_xor(v1, 16);
        float sn0, cs0, sn1, cs1;
        rope_sincos(pos, 2 * i, sn0, cs0); rope_sincos(pos, 2 * i + 1, sn1, cs1);
        v0 = (fq & 1) ? (p0 * sn0 + v0 * cs0) : (v0 * cs0 - p0 * sn0);
        v1 = (fq & 1) ? (p1 * sn1 + v1 * cs1) : (v1 * cs1 - p1 * sn1);
        rw[i] = pack2(v0, v1);
      }
      raw = make_uint4(rw[0], rw[1], rw[2], rw[3]);
      qf[2] = *(bf16x8*)&raw;
    }
    float m = -1e30f, l = 0.f;
    f32x4 oacc[4];
#pragma unroll
    for (int i = 0; i < 4; ++i) oacc[i] = f32x4{0.f, 0.f, 0.f, 0.f};
    const int ntile = nkeys >> 6;
    for (int kt = 0; kt < ntile; ++kt) {
      __syncthreads();
#pragma unroll
      for (int i = 0; i < 2; ++i) {
        const int cidx = tid + i * NT;
        if (cidx < 768) {
          const int key = cidx / 12, ch = cidx - key * 12;
          *(uint4*)&sK[key * 104 + ch * 8] = *(const uint4*)&Kg[((size_t)(kvbase + kt * 64 + key) * 16 + h) * 96 + ch * 8];
        }
      }
      {
        const int dv = tid >> 3, ch = tid & 7;
        *(uint4*)&sV[dv * 72 + ch * 8] = *(const uint4*)&Vg[(size_t)(h * 64 + dv) * KVROWS + kvbase + kt * 64 + ch * 8];
      }
      __syncthreads();
      f32x4 sacc[4];
#pragma unroll
      for (int ni = 0; ni < 4; ++ni) {
        sacc[ni] = f32x4{0.f, 0.f, 0.f, 0.f};
#pragma unroll
        for (int ks = 0; ks < 3; ++ks) {
          bf16x8 kf = *(const bf16x8*)&sK[(ni * 16 + fr) * 104 + ks * 32 + fq * 8];
          sacc[ni] = __builtin_amdgcn_mfma_f32_16x16x32_bf16(kf, qf[ks], sacc[ni], 0, 0, 0);
        }
      }
      float mx = -1e30f;
#pragma unroll
      for (int ni = 0; ni < 4; ++ni)
#pragma unroll
        for (int j = 0; j < 4; ++j) mx = fmaxf(mx, sacc[ni][j]);
      mx = fmaxf(mx, __shfl_xor(mx, 16));
      mx = fmaxf(mx, __shfl_xor(mx, 32));
      const float mnew = fmaxf(m, mx);
      const float alpha = __expf(m - mnew);
      m = mnew;
      float ls = 0.f;
#pragma unroll
      for (int ni = 0; ni < 4; ++ni)
#pragma unroll
        for (int j = 0; j < 4; ++j) { float e = __expf(sacc[ni][j] - mnew); sacc[ni][j] = e; ls += e; }
      l = l * alpha + ls;
      bf16x8 pf[2];
#pragma unroll
      for (int kk2 = 0; kk2 < 2; ++kk2) {
        uint2 lo = pack4(sacc[2 * kk2][0], sacc[2 * kk2][1], sacc[2 * kk2][2], sacc[2 * kk2][3]);
        uint2 hi = pack4(sacc[2 * kk2 + 1][0], sacc[2 * kk2 + 1][1], sacc[2 * kk2 + 1][2], sacc[2 * kk2 + 1][3]);
        uint4 pk = make_uint4(lo.x, lo.y, hi.x, hi.y);
        pf[kk2] = *(bf16x8*)&pk;
      }
#pragma unroll
      for (int di = 0; di < 4; ++di) {
#pragma unroll
        for (int j = 0; j < 4; ++j) oacc[di][j] *= alpha;
#pragma unroll
        for (int kk2 = 0; kk2 < 2; ++kk2) {
          uint2 v0 = *(const uint2*)&sV[(di * 16 + fr) * 72 + kk2 * 32 + fq * 4];
          uint2 v1 = *(const uint2*)&sV[(di * 16 + fr) * 72 + kk2 * 32 + 16 + fq * 4];
          uint4 vk = make_uint4(v0.x, v0.y, v1.x, v1.y);
          oacc[di] = __builtin_amdgcn_mfma_f32_16x16x32_bf16(*(bf16x8*)&vk, pf[kk2], oacc[di], 0, 0, 0);
        }
      }
    }
    l += __shfl_xor(l, 16);
    l += __shfl_xor(l, 32);
    const float inv = 1.0f / l;
#pragma unroll
    for (int di = 0; di < 4; ++di) {
      const size_t o = (size_t)tokq * 1024 + h * 64 + di * 16 + fq * 4;
      uint2 s = *(const uint2*)&sg[o];
      *(uint2*)&ao[o] = pack4(oacc[di][0] * inv * lo16(s.x), oacc[di][1] * inv * hi16(s.x), oacc[di][2] * inv * lo16(s.y), oacc[di][3] * inv * hi16(s.y));
    }
  }
}

#define XB_TMO      128
#define XB_XCNT(j)  (256  + 64 * (j))
#define XB_XSUB(j)  (1280 + 64 * (j))
#define XB_XGEN(j)  (2304 + 64 * (j))
#define XB_TOP      3328
#define XB_TOPGEN   3392
#define XCD_BAR_WORDS 3456
#define XB_SPIN_CAP (1u << 22)
__device__ __forceinline__ unsigned xb_ld(unsigned* p)              { return __hip_atomic_load(p, __ATOMIC_RELAXED, __HIP_MEMORY_SCOPE_AGENT); }
__device__ __forceinline__ unsigned xb_add(unsigned* p, unsigned v) { return __hip_atomic_fetch_add(p, v, __ATOMIC_RELAXED, __HIP_MEMORY_SCOPE_AGENT); }
__device__ __forceinline__ unsigned xb_xcc_id() { return (unsigned)__builtin_amdgcn_s_getreg((3 << 11) | 20) & 0xFu; }
#define XB_SPIN(cond, bar) do { unsigned _sp = 0; while (cond) { __builtin_amdgcn_s_sleep(1); \
    if ((++_sp & 255u) == 0u) { if (xb_ld(&(bar)[XB_TMO])) break; if (_sp > XB_SPIN_CAP) { atomicAdd(&(bar)[XB_TMO], 1u); break; } } } } while (0)
struct XcdBarrier { unsigned* bar; unsigned x; volatile LAS unsigned* st; };
__device__ __forceinline__ XcdBarrier xcd_barrier_post(unsigned* bar, volatile LAS unsigned* st) {
  XcdBarrier b; b.bar = bar; b.x = xb_xcc_id(); b.st = st;
  if (threadIdx.x == 0) (void)xb_add(&bar[XB_XCNT(b.x)], 1u);
  return b;
}
__device__ __forceinline__ void xcd_barrier_complete(unsigned* bar, unsigned x, unsigned& nloc, unsigned& nx) {
  const unsigned G = gridDim.x * gridDim.y * gridDim.z;
  unsigned sum, cnt, mine, sp = 0u;
  for (;;) {
    sum = 0u; cnt = 0u; mine = 0u;
#pragma unroll
    for (unsigned j = 0; j < 16; ++j) { const unsigned c = xb_ld(&bar[XB_XCNT(j)]); sum += c; cnt += (c > 0u) ? 1u : 0u; mine = (j == x) ? c : mine; }
    if (sum == G) break;
    __builtin_amdgcn_s_sleep(1);
    if ((++sp & 255u) == 0u) { if (xb_ld(&bar[XB_TMO])) break; if (sp > XB_SPIN_CAP) { atomicAdd(&bar[XB_TMO], 1u); break; } }
  }
  nloc = mine > 0u ? mine : 1u; nx = cnt > 0u ? cnt : 1u;
}
__device__ __forceinline__ void xcd_barrier(const XcdBarrier& b) {
  asm volatile("s_waitcnt vmcnt(0)" ::: "memory");
  __syncthreads();
  if (threadIdx.x == 0) {
    unsigned* bar = b.bar;
    __builtin_amdgcn_s_waitcnt(0);
    unsigned nloc = b.st[0], nx = b.st[1];
    if (nloc == 0u) { xcd_barrier_complete(bar, b.x, nloc, nx); b.st[0] = nloc; b.st[1] = nx; }
    const unsigned old = xb_add(&bar[XB_XSUB(b.x)], 1u);
    const unsigned gen = old / nloc;
    if (old + 1u == (gen + 1u) * nloc) {
      __builtin_amdgcn_fence(__ATOMIC_RELEASE, "agent");
      asm volatile("s_waitcnt vmcnt(0)" ::: "memory");
      const unsigned og = xb_add(&bar[XB_TOP], 1u);
      const unsigned tg = og / nx;
      if (og + 1u == (tg + 1u) * nx) xb_add(&bar[XB_TOPGEN], 1u);
      else XB_SPIN(xb_ld(&bar[XB_TOPGEN]) == tg, bar);
      __builtin_amdgcn_fence(__ATOMIC_ACQUIRE, "agent");
      xb_add(&bar[XB_XGEN(b.x)], 1u);
      asm volatile("s_waitcnt vmcnt(0)" ::: "memory");
    } else {
      XB_SPIN(xb_ld(&bar[XB_XGEN(b.x)]) == gen, bar);
      __builtin_amdgcn_fence(__ATOMIC_ACQUIRE, "agent");
      asm volatile("s_waitcnt vmcnt(0)" ::: "memory");
    }
  }
  __syncthreads();
}

#define GEMM_LDS 131072
#define DYN_LDS (GEMM_LDS + 16)
#define WS_BAR (WS_CNT + 4096ull)

#define RUN_GEMM(Aptr, LDA, Bptr, MM, NN, KK, GATE, EPI, CID) do { pg8::Gemm g_{(const u16*)(Aptr), (const u16*)(Bptr), MM, NN, KK, LDA, GATE}; \
    pg8::StaticOrder S_; S_.init(MM, NN, nb, CID); pg8::gemm_phase((LAS unsigned char*)smem_raw, g_, S_, EPI); } while (0)

__global__ void __launch_bounds__(NT, 2) mega(Params p) {
  extern __shared__ __attribute__((aligned(16))) unsigned char smem_raw[];
  const int bid = blockIdx.x, nb = gridDim.x;
  unsigned char* ws = p.ws;
  const float* mod = (const float*)(ws + WS_MOD);
  volatile LAS unsigned* xst = (volatile LAS unsigned*)((LAS unsigned char*)smem_raw + GEMM_LDS);
  XcdBarrier xb;
  if (p.phase_hi - p.phase_lo > 1) {
    if (threadIdx.x == 0) { xst[0] = 0u; xst[1] = 0u; }
    __syncthreads();
    xb = xcd_barrier_post((unsigned*)(ws + WS_BAR), xst);
  }
#define PH_BEGIN(n) if ((PHMASK & (1u << n)) && p.phase_lo <= n && n < p.phase_hi) { const int ph = n;
#define PH_FIN if (ph + 1 < p.phase_hi) { if (ph == 0) cg::this_grid().sync(); else xcd_barrier(xb); } }
  PH_BEGIN(0) phase_prologue(p, smem_raw, bid, nb); PH_FIN
  PH_BEGIN(1) phase_h0(p, bid, nb); PH_FIN
  PH_BEGIN(2) {
    EpiHgIn e{(u16*)(ws + WS_B(0)), (u16*)(ws + WS_B(1)), (u16*)(ws + WS_B(2)), (_Float16*)(ws + WS_B(3)), (const float*)(ws + WS_LB)};
    RUN_GEMM(ws + WS_H, 1024, ws + WS_W_HG_IN, TOK, 5120, 1024, 0, e, bid);
  } PH_FIN
  PH_BEGIN(3) phase_gla(p, smem_raw); PH_FIN
  PH_BEGIN(4) phase_hg_post(p, bid, nb); PH_FIN
  PH_BEGIN(5) {
    EpiRes e{p.in[0], p.in[1], p.out, mod + 0 * 15360 + 2048};
    RUN_GEMM(ws + WS_B(0), 1024, ws + WS_W_HG_OUT, TOK, 1024, 1024, 0, e, bid);
  } PH_FIN
  PH_BEGIN(6) phase_ln(p, 0, bid, nb); PH_FIN
  PH_BEGIN(7) {
    EpiScIn e{(u16*)(ws + WS_B(0)), (u16*)(ws + WS_B(1))};
    RUN_GEMM(ws + WS_H, 1024, ws + WS_W_SC_IN, TOK, 4096, 1024, 0, e, bid);
  } PH_FIN
  PH_BEGIN(8) phase_sc_conv(p, bid, nb); PH_FIN
  PH_BEGIN(9) {
    EpiRes e{p.out, p.out + (size_t)NPROMPT * 1024, p.out, mod + 1 * 15360 + 2048};
    RUN_GEMM(ws + WS_B(2), 1024, ws + WS_W_SC_OUT, TOK, 1024, 1024, 0, e, bid);
  } PH_FIN
  PH_BEGIN(10) phase_ln(p, 1, bid, nb); PH_FIN
  PH_BEGIN(11) {
    EpiRgIn e{(u16*)(ws + WS_B(0)), (u16*)(ws + WS_B(1))};
    RUN_GEMM(ws + WS_H, 1024, ws + WS_W_RG_IN, TOK, 2048, 1024, 0, e, bid);
  } PH_FIN
  PH_BEGIN(12) phase_rg_conv(p, bid, nb); PH_FIN
  PH_BEGIN(13) {
    EpiRgGate e{(u16*)(ws + WS_B(3)), (u16*)(ws + WS_B(5)), p.in[24]};
    RUN_GEMM(ws + WS_B(2), 1024, ws + WS_W_RG_GATE, TOK, 4096, 256, 1, e, bid);
  } PH_FIN
  PH_BEGIN(14) phase_rg_scan(p, smem_raw, bid, nb); PH_FIN
  PH_BEGIN(15) {
    EpiRes e{p.out, p.out + (size_t)NPROMPT * 1024, p.out, mod + 2 * 15360 + 2048};
    RUN_GEMM(ws + WS_B(0), 1024, ws + WS_W_RG_OUT, TOK, 1024, 1024, 0, e, bid);
  } PH_FIN
  PH_BEGIN(16) phase_ln(p, 2, bid, nb); PH_FIN
  PH_BEGIN(17) {
    EpiMlaIn e{(u16*)(ws + WS3_CQ), (float*)(ws + WS3_CKVRAW), (float*)(ws + WS3_KPERAW), (u16*)(ws + WS3_SG)};
    RUN_GEMM(ws + WS_H, 1024, ws + WS_W_MLA_IN, TOK, 1792, 1024, 0, e, bid);
  } PH_FIN
  PH_BEGIN(18) phase_mla_norm(p, bid, nb); PH_FIN
  PH_BEGIN(19) {
    EpiQ eq{(u16*)(ws + WS3_Q)};
    RUN_GEMM(ws + WS3_CQ, 384, ws + WS_W_QB, TOK, 1536, 384, 0, eq, bid);
    EpiKV ek{(u16*)(ws + WS3_K), (u16*)(ws + WS3_VT)};
    RUN_GEMM(ws + WS3_CKVALL, 256, ws + WS_W_KVB, KVROWS, 2048, 256, 0, ek, nb - 1 - bid);
  } PH_FIN
  PH_BEGIN(20) phase_attn(p, smem_raw, bid, nb); PH_FIN
  PH_BEGIN(21) {
    EpiRes e{p.out, p.out + (size_t)NPROMPT * 1024, p.out, mod + 3 * 15360 + 2048};
    RUN_GEMM(ws + WS_H, 1024, ws + WS_W_MLA_OUT, TOK, 1024, 1024, 0, e, bid);
  } PH_FIN
  PH_BEGIN(22) phase_ln(p, 3, bid, nb); PH_FIN
}

extern "C" void kernel_launch(void* const* d_in, const int* in_sizes, int n_in, void* d_out, int out_size, void* d_ws, size_t ws_size,
                              hipStream_t stream) {
  static int grid_blocks = 0;
  if (!grid_blocks) {
    int dev = 0, cus = 0, per_cu = 0;
    (void)hipGetDevice(&dev);
    (void)hipDeviceGetAttribute(&cus, hipDeviceAttributeMultiprocessorCount, dev);
    (void)hipFuncSetAttribute((const void*)mega, hipFuncAttributeMaxDynamicSharedMemorySize, DYN_LDS);
    (void)hipOccupancyMaxActiveBlocksPerMultiprocessor(&per_cu, (const void*)mega, NT, DYN_LDS);
    if (per_cu < 1) per_cu = 1;
    if (per_cu > 1) per_cu = 1;
    grid_blocks = cus * per_cu;
  }
  Params p{};
  for (int i = 0; i < 33; ++i) p.in[i] = (const float*)d_in[i];
  p.out = (float*)d_out;
  p.ws = (unsigned char*)d_ws;
#if MULTI_LAUNCH
  for (int ph = 0; ph < NPHASES; ++ph) {
    p.phase_lo = ph; p.phase_hi = ph + 1;
    hipLaunchKernelGGL(mega, dim3(grid_blocks), dim3(NT), DYN_LDS, stream, p);
#ifdef PROBE_MASK
    if ((PROBE_MASK >> ph) & 1) for (int r = 0; r < 2; ++r) {
      if (ph == 3) (void)hipMemsetAsync((unsigned char*)d_ws + WS_CNT, 0, 64, stream);
      hipLaunchKernelGGL(mega, dim3(grid_blocks), dim3(NT), DYN_LDS, stream, p);
    }
#endif
  }
#else
  p.phase_lo = 0; p.phase_hi = NPHASES;
  (void)hipMemsetAsync((unsigned char*)d_ws + WS_CNT, 0, 4096 + XCD_BAR_WORDS * 4, stream);
  void* args[] = {&p};
  hipError_t e = hipLaunchCooperativeKernel((const void*)mega, dim3(grid_blocks), dim3(NT), args, DYN_LDS, stream);
  if (e != hipSuccess) fprintf(stderr, "cooperative launch failed: %s (grid %d)\n", hipGetErrorString(e), grid_blocks);
#endif
}
```

```cpp
#include <hip/hip_runtime.h>
#include <hip/hip_cooperative_groups.h>
#include <cstdio>
namespace cg = cooperative_groups;

#ifndef MULTI_LAUNCH
#define MULTI_LAUNCH 0
#endif

typedef unsigned short u16;
using bf16x8 = __attribute__((ext_vector_type(8))) short;
using f32x4 = __attribute__((ext_vector_type(4))) float;
typedef _Float16 h4 __attribute__((ext_vector_type(4)));

#define TOK 12288
#define NPROMPT 8192
#define KVROWS 14336
#define NPHASES 23
#ifndef PHMASK
#define PHMASK 0x7fffff
#endif
#define DN_ALPHA 1.6817928305074290f

#define WS_W_HG_IN 0ull
#define WS_W_HG_OUT (WS_W_HG_IN + 10485760ull)
#define WS_W_SC_IN (WS_W_HG_OUT + 2097152ull)
#define WS_W_SC_OUT (WS_W_SC_IN + 8388608ull)
#define WS_W_RG_IN (WS_W_SC_OUT + 2097152ull)
#define WS_W_RG_GATE (WS_W_RG_IN + 4194304ull)
#define WS_W_RG_OUT (WS_W_RG_GATE + 2097152ull)
#define WS_W_MLA_IN (WS_W_RG_OUT + 2097152ull)
#define WS_W_QB (WS_W_MLA_IN + 3670016ull)
#define WS_W_KVB (WS_W_QB + 1179648ull)
#define WS_W_MLA_OUT (WS_W_KVB + 1048576ull)
#define WS_MOD (WS_W_MLA_OUT + 2097152ull)
#define WS_LB (WS_MOD + 245760ull)
#define WS_CNT (WS_LB + 8192ull)
#define WS_R (WS_CNT + 4096ull + 16384ull)
#define BSZ 25165824ull
#define WS_H (WS_R)
#define WS_B(i) (WS_R + BSZ * (1 + (i)))
#define WS3_CQ (WS_R + 25165824ull)
#define WS3_CKVALL (WS_R + 34603008ull)
#define WS3_CKVRAW (WS_R + 41943040ull)
#define WS3_KPERAW (WS_R + 54525952ull)
#define WS3_SG (WS_R + 56098816ull)
#define WS3_Q (WS_R + 81264640ull)
#define WS3_K (WS_R + 119013376ull)
#define WS3_VT (WS_R + 163053568ull)

#define OUT_HG 12582912
#define OUT_RG 20971520
#define OUT_CKV 21037056
#define OUT_KPE 23134208

struct Params {
  const float* in[33];
  float* out;
  unsigned char* ws;
  int phase_lo, phase_hi;
};

__device__ __forceinline__ u16 f2bf(float f) { __bf16 r = (__bf16)f; return *(u16*)&r; }
__device__ __forceinline__ float bf2f(u16 h) { return __uint_as_float(((unsigned)h) << 16); }
typedef float f2v_ __attribute__((ext_vector_type(2)));
typedef __bf16 b2v_ __attribute__((ext_vector_type(2)));
__device__ __forceinline__ unsigned pack2(float a, float b) { f2v_ f = {a, b}; b2v_ r = __builtin_convertvector(f, b2v_); return *(unsigned*)&r; }
__device__ __forceinline__ uint2 pack4(float a, float b, float c, float d) { return make_uint2(pack2(a, b), pack2(c, d)); }
__device__ __forceinline__ float lo16(unsigned u) { return __uint_as_float(u << 16); }
__device__ __forceinline__ float hi16(unsigned u) { return __uint_as_float(u & 0xffff0000u); }
__device__ __forceinline__ float sigmoidf_(float x) { return __builtin_amdgcn_rcpf(1.0f + __expf(-x)); }
__device__ __forceinline__ float siluf_(float x) { return x * __builtin_amdgcn_rcpf(1.0f + __expf(-x)); }
__device__ __forceinline__ int cond_of(int tok) { return tok < NPROMPT ? 0 : 1 + ((tok - NPROMPT) >> 10); }
__device__ __forceinline__ float wave_sum(float v) {
#pragma unroll
  for (int o = 32; o > 0; o >>= 1) v += __shfl_xor(v, o);
  return v;
}
__device__ __forceinline__ void rope_sincos(float pos, int fi, float& sn, float& cs) {
  float inv = exp2f(-(float)fi * 1.6609640474436813f);
  float ang = pos * inv;
  float k = rintf(ang * 0.15915494309189535f);
  float r = fmaf(-k, 6.2831854820251465f, ang);
  r = fmaf(-k, -1.7484555e-7f, r);
  sn = __sinf(r); cs = __cosf(r);
}

#define NT 512
#define NW 8
#define LAS __attribute__((address_space(3)))

namespace pg8 {
constexpr int BM = 256, BK = 64, HALF = 128, HTB = HALF * BK * 2, STAGE_BYTES = 8 * HTB, NXCD = 8, WGM = 8;
__device__ __forceinline__ int lds_byte(int r, int c) { const int st = (r >> 4) * 2 + (c >> 5), rr = r & 15, cc = c & 31, ob = rr * 64 + cc * 2; return st * 1024 + (ob ^ (((ob >> 9) & 1) << 5)); }
__device__ __forceinline__ void stage_rc(int b, int& R, int& C) { const int st = b / 1024, sb = b % 1024, swz = sb ^ (((sb >> 9) & 1) << 5); R = (st >> 1) * 16 + swz / 64; C = (st & 1) * 32 + (swz % 64) / 2; }
struct Unit { int pm, pn; };
struct Gemm { const u16* A; const u16* Bt; int M, N, K, lda, gate; };
struct StaticOrder {
  int nM, nN, nwg, G, c;
  __device__ void init(int M, int N, int G_, int c_) { nM = M / BM; nN = N / BM; nwg = nM * nN; G = G_; c = c_; }
  __device__ bool next(int i, Unit& u) const {
    const long L = (long)i * G + c; if (L >= nwg) return false;
    int wgid = (int)L; { const int q = nwg / NXCD, r = nwg % NXCD, xcd = wgid % NXCD, off = wgid / NXCD; wgid = (xcd < r ? xcd * (q + 1) : r * (q + 1) + (xcd - r) * q) + off; }
    const int nig = WGM * nN, gid = wgid / nig, fm = gid * WGM, gsz = (nM - fm) < WGM ? (nM - fm) : WGM;
    u.pm = fm + ((wgid % nig) % gsz); u.pn = (wgid % nig) / gsz; return true;
  }
};
template <class Epi>
__device__ __forceinline__ void gemm_phase(LAS unsigned char* lds, const Gemm g, const StaticOrder& S, const Epi& E) {
  const int tid = threadIdx.x, wid = __builtin_amdgcn_readfirstlane(tid >> 6), lane = tid & 63, wr = wid >> 2, wc = wid & 3, fr = lane & 15, fq = lane >> 4;
  const int K = g.K, nt = K / BK;
  unsigned voffA[2], voffB[2];
#pragma unroll
  for (int i = 0; i < 2; ++i) { int R, C; stage_rc(tid * 16 + i * 8192, R, C); voffA[i] = (unsigned)(R * g.lda + C) * 2u; voffB[i] = (unsigned)(R * K + C) * 2u; }
  const size_t kstep = (size_t)(BK * 2);
  const size_t hstepA = (size_t)HALF * g.lda * 2, hstepB = (size_t)HALF * K * 2;
  const size_t tstepA = 2 * hstepA, tstepB = 2 * hstepB;
  const unsigned ldsw = (unsigned)wid * 1024u;
  const int aoff = lds_byte(wr * 64 + fr, fq * 8), boff = lds_byte(wc * 32 + fr, fq * 8);
#define PG8_AOFF(pn) (g.gate ? (size_t)((((pn) >> 1) & 3) * 512) : (size_t)0)
#define PG8_SA(b, h) (((b) * 2 + (h)) * HTB)
#define PG8_SB(b, h) ((4 + (b) * 2 + (h)) * HTB)
#define PG8_STAGE(bufoff, gbase, voff) do { _Pragma("unroll") for (int _i = 0; _i < 2; ++_i) \
    __builtin_amdgcn_global_load_lds((const unsigned*)((const char*)(gbase) + (voff)[_i]), (LAS unsigned*)(lds + (bufoff) + ldsw + _i * 8192), 16, 0, 0); } while (0)
#define PG8_LDA(dst, b, h) do { _Pragma("unroll") for (int m = 0; m < 4; ++m) _Pragma("unroll") for (int k = 0; k < 2; ++k) dst[m][k] = *(const LAS bf16x8*)(lds + PG8_SA(b, h) + aoff + m * 2048 + k * 1024); } while (0)
#define PG8_LDB(dst, b, h) do { _Pragma("unroll") for (int n = 0; n < 2; ++n) _Pragma("unroll") for (int k = 0; k < 2; ++k) dst[n][k] = *(const LAS bf16x8*)(lds + PG8_SB(b, h) + boff + n * 2048 + k * 1024); } while (0)
#define PG8_MMA(ai, bj, At, Bt) do { __builtin_amdgcn_s_setprio(1); _Pragma("unroll") for (int m = 0; m < 4; ++m) _Pragma("unroll") for (int n = 0; n < 2; ++n) _Pragma("unroll") for (int k = 0; k < 2; ++k) \
    acc[ai][bj][m][n] = __builtin_amdgcn_mfma_f32_16x16x32_bf16(Bt[n][k], At[m][k], acc[ai][bj][m][n], 0, 0, 0); __builtin_amdgcn_s_setprio(0); } while (0)
#define PG8_WAIT_V(n) asm volatile("s_waitcnt vmcnt(" #n ")" ::: "memory")
#define PG8_WAIT_L(n) asm volatile("s_waitcnt lgkmcnt(" #n ")" ::: "memory")
#define PG8_BAR __builtin_amdgcn_s_barrier()
#define PG8_SCHED __builtin_amdgcn_sched_barrier(0)
  Unit cur, nxt; int ui = 0;
  if (!S.next(0, cur)) return;
  f32x4 acc[2][2][4][2];
#pragma unroll
  for (int a = 0; a < 2; ++a)
#pragma unroll
    for (int b = 0; b < 2; ++b)
#pragma unroll
      for (int m = 0; m < 4; ++m)
#pragma unroll
        for (int n = 0; n < 2; ++n) acc[a][b][m][n] = (f32x4){0.f, 0.f, 0.f, 0.f};
  bf16x8 At[4][2], B0[2][2], B1[2][2];
  const char* cA = (const char*)g.A + (size_t)cur.pm * tstepA + PG8_AOFF(cur.pn); const char* cB = (const char*)g.Bt + (size_t)cur.pn * tstepB;
  PG8_STAGE(PG8_SB(0, 0), cB, voffB); PG8_STAGE(PG8_SA(0, 0), cA, voffA); PG8_STAGE(PG8_SB(0, 1), cB + hstepB, voffB); PG8_STAGE(PG8_SA(0, 1), cA + hstepA, voffA);
  if (wr == 1) PG8_BAR;
  PG8_WAIT_V(4); PG8_BAR;
  PG8_STAGE(PG8_SB(1, 0), cB + kstep, voffB); PG8_STAGE(PG8_SA(1, 0), cA + kstep, voffA); PG8_STAGE(PG8_SB(1, 1), cB + hstepB + kstep, voffB);
  PG8_WAIT_V(6); PG8_BAR;
  for (;;) {
    const bool has_next = S.next(ui + 1, nxt);
    const char* nA = has_next ? (const char*)g.A + (size_t)nxt.pm * tstepA + PG8_AOFF(nxt.pn) : cA; const char* nB = has_next ? (const char*)g.Bt + (size_t)nxt.pn * tstepB : cB;
#pragma unroll 1
    for (int t = 0; t < nt; t += 2) {
      const bool last = (t == nt - 2);
      const char* a1 = cA + (size_t)(t + 1) * kstep;
      const char* a2 = last ? nA : cA + (size_t)(t + 2) * kstep; const char* b2 = last ? nB : cB + (size_t)(t + 2) * kstep;
      const char* a3 = a2 + kstep; const char* b3 = b2 + kstep;
      PG8_LDB(B0, 0, 0); PG8_SCHED; PG8_LDA(At, 0, 0); PG8_STAGE(PG8_SA(1, 1), a1 + hstepA, voffA);
      PG8_WAIT_L(8); PG8_BAR; PG8_WAIT_L(0); PG8_MMA(0, 0, At, B0); PG8_BAR; PG8_SCHED;
      PG8_LDB(B1, 0, 1); PG8_STAGE(PG8_SB(0, 0), b2, voffB);
      PG8_BAR; PG8_WAIT_L(0); PG8_MMA(0, 1, At, B1); PG8_BAR;
      PG8_LDA(At, 0, 1); PG8_STAGE(PG8_SA(0, 0), a2, voffA);
      PG8_BAR; PG8_WAIT_L(0); PG8_MMA(1, 0, At, B0); PG8_BAR; PG8_SCHED;
      PG8_STAGE(PG8_SB(0, 1), b2 + hstepB, voffB);
      PG8_WAIT_V(6); PG8_BAR; PG8_MMA(1, 1, At, B1); PG8_BAR;
      PG8_LDB(B0, 1, 0); PG8_SCHED; PG8_LDA(At, 1, 0); PG8_STAGE(PG8_SA(0, 1), a2 + hstepA, voffA);
      PG8_WAIT_L(8); PG8_BAR; PG8_WAIT_L(0); PG8_MMA(0, 0, At, B0); PG8_BAR; PG8_SCHED;
      PG8_LDB(B1, 1, 1); PG8_STAGE(PG8_SB(1, 0), b3, voffB);
      PG8_BAR; PG8_WAIT_L(0); PG8_MMA(0, 1, At, B1); PG8_BAR;
      PG8_LDA(At, 1, 1); PG8_STAGE(PG8_SA(1, 0), a3, voffA);
      PG8_BAR; PG8_WAIT_L(0); PG8_MMA(1, 0, At, B0); PG8_BAR; PG8_SCHED;
      PG8_STAGE(PG8_SB(1, 1), b3 + hstepB, voffB);
      PG8_WAIT_V(6); PG8_BAR; PG8_MMA(1, 1, At, B1); PG8_BAR;
    }
    E(acc, cur, wr, wc, fr, fq);
    if (!has_next) break;
#pragma unroll
    for (int a = 0; a < 2; ++a)
#pragma unroll
      for (int b = 0; b < 2; ++b)
#pragma unroll
        for (int m = 0; m < 4; ++m)
#pragma unroll
          for (int n = 0; n < 2; ++n) acc[a][b][m][n] = (f32x4){0.f, 0.f, 0.f, 0.f};
    cur = nxt; cA = nA; cB = nB; ++ui;
  }
  PG8_WAIT_V(0);
  if (wr == 0) PG8_BAR;
  PG8_BAR;
#undef PG8_AOFF
#undef PG8_SA
#undef PG8_SB
#undef PG8_STAGE
#undef PG8_LDA
#undef PG8_LDB
#undef PG8_MMA
#undef PG8_WAIT_V
#undef PG8_WAIT_L
#undef PG8_BAR
#undef PG8_SCHED
}
}
using pg8::Unit;
typedef const f32x4 (&AccRef)[2][2][4][2];

#define EPI_ROWS(...) _Pragma("unroll") for (int ai = 0; ai < 2; ++ai) _Pragma("unroll") for (int m = 0; m < 4; ++m) { const int row = u.pm * 256 + ai * 128 + wr * 64 + m * 16 + fr; __VA_ARGS__ }
#define EPI_COLS(...) _Pragma("unroll") for (int bj = 0; bj < 2; ++bj) _Pragma("unroll") for (int n = 0; n < 2; ++n) { const int cb = u.pn * 256 + bj * 128 + wc * 32 + n * 16; const f32x4 a = acc[ai][bj][m][n]; __VA_ARGS__ }

struct EpiHgIn {
  u16 *q, *v, *sg; _Float16* lf; const float* lb;
  __device__ __forceinline__ void operator()(AccRef acc, const Unit& u, int wr, int wc, int fr, int fq) const {
    const int region = u.pn >> 2;
    EPI_ROWS( EPI_COLS(
      const int c = (cb & 1023) + fq * 4;
      if (region == 0) {
        const float s = 0.08838834764831845f;
        *(uint2*)&q[(size_t)row * 1024 + c] = pack4(siluf_(a[0]) * s, siluf_(a[1]) * s, siluf_(a[2]) * s, siluf_(a[3]) * s);
      } else if (region <= 2) {
        const int d = region - 1;
        f32x4 l4 = *(const f32x4*)&lb[d * 1024 + c];
        h4 o;
        _Pragma("unroll") for (int j = 0; j < 4; ++j) { float f = l4[j] + (1.0f - l4[j]) * sigmoidf_(a[j]); o[j] = (_Float16)__logf(f); }
        *(h4*)&lf[(size_t)row * 2048 + d * 1024 + c] = o;
      } else if (region == 3) {
        *(uint2*)&v[(size_t)row * 1024 + c] = pack4(a[0], a[1], a[2], a[3]);
      } else {
        *(uint2*)&sg[(size_t)row * 1024 + c] = pack4(siluf_(a[0]), siluf_(a[1]), siluf_(a[2]), siluf_(a[3]));
      }
    ) )
  }
};

struct EpiRes {
  const float* xin_p; const float* xin_s; float* Y; const float* gate;
  __device__ __forceinline__ void operator()(AccRef acc, const Unit& u, int wr, int wc, int fr, int fq) const {
    EPI_ROWS(
      const float* xr = row < NPROMPT ? xin_p + (size_t)row * 1024 : xin_s + (size_t)(row - NPROMPT) * 1024;
      const float* g = gate + cond_of(row) * 3072;
      EPI_COLS(
        const int c = cb + fq * 4;
        f32x4 x = *(const f32x4*)&xr[c];
        f32x4 gg = *(const f32x4*)&g[c];
        f32x4 y;
        _Pragma("unroll") for (int j = 0; j < 4; ++j) y[j] = DN_ALPHA * x[j] + gg[j] * a[j];
        *(f32x4*)&Y[(size_t)row * 1024 + c] = y;
      ) )
  }
};

struct EpiScIn {
  u16 *pb, *sb;
  __device__ __forceinline__ void operator()(AccRef acc, const Unit& u, int wr, int wc, int fr, int fq) const {
    const int c = u.pn * 64 + wc * 16 + fq * 4;
    EPI_ROWS(
      const f32x4 bg = acc[ai][0][m][0], cgv = acc[ai][0][m][1], v = acc[ai][1][m][0], g = acc[ai][1][m][1];
      *(uint2*)&pb[(size_t)row * 1024 + c] = pack4(cgv[0] * v[0], cgv[1] * v[1], cgv[2] * v[2], cgv[3] * v[3]);
      *(uint2*)&sb[(size_t)row * 1024 + c] = pack4(siluf_(g[0]) * bg[0], siluf_(g[1]) * bg[1], siluf_(g[2]) * bg[2], siluf_(g[3]) * bg[3]);
    )
  }
};

struct EpiRgIn {
  u16 *ub, *sg;
  __device__ __forceinline__ void operator()(AccRef acc, const Unit& u, int wr, int wc, int fr, int fq) const {
    const int region = u.pn >> 2;
    EPI_ROWS( EPI_COLS(
      const int c = (cb & 1023) + fq * 4;
      if (region == 0) *(uint2*)&ub[(size_t)row * 1024 + c] = pack4(a[0], a[1], a[2], a[3]);
      else *(uint2*)&sg[(size_t)row * 1024 + c] = pack4(siluf_(a[0]), siluf_(a[1]), siluf_(a[2]), siluf_(a[3]));
    ) )
  }
};

struct EpiRgGate {
  u16 *rb, *ib; const float* bgate;
  __device__ __forceinline__ void operator()(AccRef acc, const Unit& u, int wr, int wc, int fr, int fq) const {
    const int mat = u.pn >> 1, d = mat >> 2, hd = mat & 3;
    EPI_ROWS(
      _Pragma("unroll") for (int bj = 0; bj < 2; ++bj) {
        const int off = ((u.pn & 1) * 256 + bj * 128 + wc * 32);
        const int cc = (off >> 5) * 16 + fq * 4;
        f32x4 br = *(const f32x4*)&bgate[mat * 512 + cc];
        f32x4 bi = *(const f32x4*)&bgate[mat * 512 + 256 + cc];
        const f32x4 r = acc[ai][bj][m][0], ii = acc[ai][bj][m][1];
        const size_t o = ((size_t)d * TOK + row) * 1024 + hd * 256 + cc;
        *(uint2*)&rb[o] = pack4(sigmoidf_(r[0] + br[0]), sigmoidf_(r[1] + br[1]), sigmoidf_(r[2] + br[2]), sigmoidf_(r[3] + br[3]));
        *(uint2*)&ib[o] = pack4(sigmoidf_(ii[0] + bi[0]), sigmoidf_(ii[1] + bi[1]), sigmoidf_(ii[2] + bi[2]), sigmoidf_(ii[3] + bi[3]));
      } )
  }
};

struct EpiMlaIn {
  u16* cq; float* ckvraw; float* kperaw; u16* sg;
  __device__ __forceinline__ void operator()(AccRef acc, const Unit& u, int wr, int wc, int fr, int fq) const {
    EPI_ROWS( EPI_COLS(
      const int c = cb + fq * 4;
      if (cb < 384) *(uint2*)&cq[(size_t)row * 384 + c] = pack4(a[0], a[1], a[2], a[3]);
      else if (cb < 640) *(f32x4*)&ckvraw[(size_t)row * 256 + (c - 384)] = a;
      else if (cb < 672) *(f32x4*)&kperaw[(size_t)row * 32 + (c - 640)] = a;
      else if (cb < 1696) *(uint2*)&sg[(size_t)row * 1024 + (c - 672)] = pack4(siluf_(a[0]), siluf_(a[1]), siluf_(a[2]), siluf_(a[3]));
    ) )
  }
};

struct EpiQ {
  u16* q;
  __device__ __forceinline__ void operator()(AccRef acc, const Unit& u, int wr, int wc, int fr, int fq) const {
    const float sc = 0.10206207261596575f;
    EPI_ROWS( EPI_COLS(
      *(uint2*)&q[(size_t)row * 1536 + cb + fq * 4] = pack4(a[0] * sc, a[1] * sc, a[2] * sc, a[3] * sc);
    ) )
  }
};

struct EpiKV {
  u16 *Kb, *Vt;
  __device__ __forceinline__ void operator()(AccRef acc, const Unit& u, int wr, int wc, int fr, int fq) const {
    EPI_ROWS( EPI_COLS(
      const int h = cb >> 7, d0 = cb & 127, dd = (d0 & 63) + fq * 4;
      if (d0 < 64) {
        *(uint2*)&Kb[((size_t)row * 16 + h) * 96 + dd] = pack4(a[0], a[1], a[2], a[3]);
      } else {
        _Pragma("unroll") for (int j = 0; j < 4; ++j) Vt[((size_t)(h * 64 + dd + j)) * KVROWS + row] = f2bf(a[j]);
      }
    ) )
  }
};

__device__ __forceinline__ void wconv_tile(const float* __restrict__ src, int N, int K, u16* __restrict__ dst, int k0, int n0,
                                           int perm, int mat, float* tile) {
  const int tid = threadIdx.x;
  {
    const int r = tid >> 4, c4 = (tid & 15) * 4;
#pragma unroll
    for (int i = 0; i < 2; ++i) {
      const int k = r + i * 32;
      f32x4 v = f32x4{0.f, 0.f, 0.f, 0.f};
      if (n0 + c4 < N) v = *(const f32x4*)&src[(size_t)(k0 + k) * N + n0 + c4];
      tile[k * 65 + c4 + 0] = v[0]; tile[k * 65 + c4 + 1] = v[1]; tile[k * 65 + c4 + 2] = v[2]; tile[k * 65 + c4 + 3] = v[3];
    }
  }
  __syncthreads();
  {
    const int nl = tid >> 3, kq = (tid & 7) * 8;
    const int n = n0 + nl;
    int np = n;
    if (perm == 1) { const int part = n >> 10, c = n & 1023; np = (c >> 6) * 256 + (part >> 1) * 128 + ((c >> 4) & 3) * 32 + (part & 1) * 16 + (c & 15); }
    else if (perm == 2) { const int type = n >> 8, cc = n & 255; np = mat * 512 + (cc >> 4) * 32 + type * 16 + (cc & 15); }
    if (n < N) {
      unsigned w[4];
#pragma unroll
      for (int i = 0; i < 4; ++i) w[i] = pack2(tile[(kq + 2 * i) * 65 + nl], tile[(kq + 2 * i + 1) * 65 + nl]);
      *(uint4*)&dst[(size_t)np * K + k0 + kq] = make_uint4(w[0], w[1], w[2], w[3]);
    }
  }
  __syncthreads();
}

__device__ __forceinline__ void phase_prologue(const Params& p, unsigned char* smem_raw, int bid, int nb) {
  float* fs = (float*)smem_raw;
  const int tid = threadIdx.x;
  const int NMOD = 192, NWT = 4800;
  for (int it = bid; it < NMOD + 1 + NWT; it += nb) {
    if (it < NMOD) {
      const int l = it / 48, n0 = (it % 48) * 64;
      float* scond = fs;
      float* sred = fs + 5120;
      for (int i = tid; i < 5120; i += NT) {
        const int ci = i >> 10, k = i & 1023;
        float cv = ci == 0 ? p.in[7][k] : p.in[6][(ci - 1) * 1024 + k];
        scond[i] = siluf_(cv);
      }
      __syncthreads();
      const int col = tid & 63, kg = tid >> 6;
      const float* w = p.in[8] + (size_t)l * 1024 * 3072 + n0 + col;
      float a0 = 0, a1 = 0, a2 = 0, a3 = 0, a4 = 0;
#pragma unroll 16
      for (int k = kg * 128; k < kg * 128 + 128; ++k) {
        float wv = w[(size_t)k * 3072];
        a0 += scond[k] * wv; a1 += scond[1024 + k] * wv; a2 += scond[2048 + k] * wv; a3 += scond[3072 + k] * wv; a4 += scond[4096 + k] * wv;
      }
      sred[(kg * 5 + 0) * 64 + col] = a0; sred[(kg * 5 + 1) * 64 + col] = a1; sred[(kg * 5 + 2) * 64 + col] = a2;
      sred[(kg * 5 + 3) * 64 + col] = a3; sred[(kg * 5 + 4) * 64 + col] = a4;
      __syncthreads();
      float* mod = (float*)(p.ws + WS_MOD);
      if (tid < 320) {
        const int ci = tid >> 6, cc = tid & 63;
        float s = 0;
#pragma unroll
        for (int g = 0; g < 8; ++g) s += sred[(g * 5 + ci) * 64 + cc];
        mod[(l * 5 + ci) * 3072 + n0 + cc] = s + p.in[9][l * 3072 + n0 + cc];
      }
      __syncthreads();
    } else if (it == NMOD) {
      float* lb = (float*)(p.ws + WS_LB);
      for (int i = tid; i < 2048; i += NT) {
        const int d = i >> 10, c = i & 1023;
        const float* lg = p.in[13] + d * 5 * 1024 + c;
        float m = lg[0];
        for (int j = 1; j < 5; ++j) m = fmaxf(m, lg[j * 1024]);
        float s = 0;
        for (int j = 0; j < 5; ++j) s += expf(lg[j * 1024] - m);
        lb[i] = expf(lg[0] - m) / s;
      }
      int* cnt = (int*)(p.ws + WS_CNT);
      if (tid < 16) cnt[tid] = 0;
    } else {
      int t = it - NMOD - 1;
      const float* src; u16* dst; int N, K, perm = 0, mat = 0, ntn;
      if (t < 1280) { src = p.in[12]; dst = (u16*)(p.ws + WS_W_HG_IN); N = 5120; K = 1024; }
      else if ((t -= 1280) < 256) { src = p.in[15]; dst = (u16*)(p.ws + WS_W_HG_OUT); N = 1024; K = 1024; }
      else if ((t -= 256) < 1024) { src = p.in[16]; dst = (u16*)(p.ws + WS_W_SC_IN); N = 4096; K = 1024; perm = 1; }
      else if ((t -= 1024) < 256) { src = p.in[19]; dst = (u16*)(p.ws + WS_W_SC_OUT); N = 1024; K = 1024; }
      else if ((t -= 256) < 512) { src = p.in[20]; dst = (u16*)(p.ws + WS_W_RG_IN); N = 2048; K = 1024; }
      else if ((t -= 512) < 256) { mat = t >> 5; t &= 31; src = p.in[23] + (size_t)mat * 256 * 512; dst = (u16*)(p.ws + WS_W_RG_GATE); N = 512; K = 256; perm = 2; }
      else if ((t -= 256) < 256) { src = p.in[26]; dst = (u16*)(p.ws + WS_W_RG_OUT); N = 1024; K = 1024; }
      else if ((t -= 256) < 432) { src = p.in[27]; dst = (u16*)(p.ws + WS_W_MLA_IN); N = 1696; K = 1024; }
      else if ((t -= 432) < 144) { src = p.in[30]; dst = (u16*)(p.ws + WS_W_QB); N = 1536; K = 384; }
      else if ((t -= 144) < 128) { src = p.in[31]; dst = (u16*)(p.ws + WS_W_KVB); N = 2048; K = 256; }
      else { t -= 128; src = p.in[32]; dst = (u16*)(p.ws + WS_W_MLA_OUT); N = 1024; K = 1024; }
      ntn = (N + 63) >> 6;
      const int kt = t / ntn, ntl = t - kt * ntn;
      wconv_tile(src, N, K, dst, kt * 64, ntl * 64, perm, mat, fs);
    }
  }
}

__device__ __forceinline__ void phase_h0(const Params& p, int bid, int nb) {
  const float* mod = (const float*)(p.ws + WS_MOD);
  u16* H = (u16*)(p.ws + WS_H);
  const size_t total = (size_t)TOK * 256;
  for (size_t i = (size_t)bid * NT + threadIdx.x; i < total; i += (size_t)nb * NT) {
    const int row = (int)(i >> 8), c = ((int)i & 255) * 4;
    const float* xr = row < NPROMPT ? p.in[0] + (size_t)row * 1024 : p.in[1] + (size_t)(row - NPROMPT) * 1024;
    const float* m = mod + cond_of(row) * 3072;
    f32x4 x = *(const f32x4*)&xr[c];
    f32x4 sh = *(const f32x4*)&m[c];
    f32x4 sc = *(const f32x4*)&m[1024 + c];
    *(uint2*)&H[(size_t)row * 1024 + c] = pack4(x[0] * (1 + sc[0]) + sh[0], x[1] * (1 + sc[1]) + sh[1], x[2] * (1 + sc[2]) + sh[2], x[3] * (1 + sc[3]) + sh[3]);
  }
}

__device__ __forceinline__ void phase_ln(const Params& p, int l, int bid, int nb) {
  float* X = p.out;
  const float* g = p.in[10] + l * 1024;
  const float* b = p.in[11] + l * 1024;
  const float* mod = (const float*)(p.ws + WS_MOD) + (l + 1) * 5 * 3072;
  u16* H = (u16*)(p.ws + WS_H);
  const int lane = threadIdx.x & 63, wave = threadIdx.x >> 6;
  for (int row = bid * NW + wave; row < TOK; row += nb * NW) {
    float* xr = X + (size_t)row * 1024;
    f32x4 v[4];
    float s = 0;
#pragma unroll
    for (int i = 0; i < 4; ++i) { v[i] = *(const f32x4*)&xr[i * 256 + lane * 4]; s += v[i][0] + v[i][1] + v[i][2] + v[i][3]; }
    const float mu = wave_sum(s) * (1.0f / 1024.0f);
    float q = 0;
#pragma unroll
    for (int i = 0; i < 4; ++i)
#pragma unroll
      for (int j = 0; j < 4; ++j) { float dd = v[i][j] - mu; q += dd * dd; }
    const float rs = rsqrtf(wave_sum(q) * (1.0f / 1024.0f) + 1e-5f);
    const float* m = mod + cond_of(row) * 3072;
#pragma unroll
    for (int i = 0; i < 4; ++i) {
      const int c = i * 256 + lane * 4;
      f32x4 gg = *(const f32x4*)&g[c], bb = *(const f32x4*)&b[c];
      f32x4 y;
#pragma unroll
      for (int j = 0; j < 4; ++j) y[j] = (v[i][j] - mu) * rs * gg[j] + bb[j];
      *(f32x4*)&xr[c] = y;
      if (l < 3) {
        f32x4 sh = *(const f32x4*)&m[c], sc = *(const f32x4*)&m[1024 + c];
        *(uint2*)&H[(size_t)row * 1024 + c] = pack4(y[0] * (1 + sc[0]) + sh[0], y[1] * (1 + sc[1]) + sh[1], y[2] * (1 + sc[2]) + sh[2], y[3] * (1 + sc[3]) + sh[3]);
      }
    }
  }
}

__device__ __forceinline__ void phase_gla(const Params& p, unsigned char* smem_raw) {
  u16* s_qrel = (u16*)smem_raw;
  u16* s_krel = s_qrel + 32 * 136;
  u16* s_qcum = s_krel + 32 * 136;
  u16* s_kdT = s_qcum + 32 * 136;
  u16* s_vT = s_kdT + 128 * 40;
  u16* s_att = s_vT + 64 * 40;
  u16* s_S = s_att + 32 * 40;
  float* s_dec = (float*)(s_S + 64 * 136);
  float* s_part = s_dec + 128;
  int* s_u = (int*)(s_part + 512);
  int* counter = (int*)(p.ws + WS_CNT);
  const u16* qg = (const u16*)(p.ws + WS_B(0));
  const u16* vg = (const u16*)(p.ws + WS_B(1));
  const _Float16* lfg = (const _Float16*)(p.ws + WS_B(3));
  u16* og = (u16*)(p.ws + WS_B(5));
  const int tid = threadIdx.x, lane = tid & 63, w = tid >> 6, fr = lane & 15, fq = lane >> 4;
  const int kk = tid & 127, th = tid >> 7;
  const int ti = w >> 2, vi = w & 3;
  const int wk = w & 3, wv = w >> 2;
  while (true) {
    if (tid == 0) *s_u = atomicAdd(counter, 1);
    __syncthreads();
    const int u = *s_u;
    __syncthreads();
    if (u >= 1152) break;
    int b, rem, start, N, sample;
    if (u < 128) { sample = 1; b = u >> 5; rem = u & 31; start = NPROMPT + b * 1024; N = 1024; }
    else { sample = 0; b = (u - 128) >> 5; rem = (u - 128) & 31; start = b * 256; N = 256; }
    const int h = rem >> 2, d = (rem >> 1) & 1, vs = rem & 1;
    const int nc = N >> 5;
    f32x4 S[2][2];
#pragma unroll
    for (int mi = 0; mi < 2; ++mi)
#pragma unroll
      for (int ni = 0; ni < 2; ++ni) {
        f32x4 s4 = f32x4{0.f, 0.f, 0.f, 0.f};
        if (sample) {
          const float* s0 = p.in[2] + ((size_t)((b * 2 + d) * 8 + h)) * 16384;
#pragma unroll
          for (int j = 0; j < 4; ++j) s4[j] = s0[(wk * 32 + mi * 16 + fq * 4 + j) * 128 + vs * 64 + wv * 32 + ni * 16 + fr];
        }
        S[mi][ni] = s4;
        *(uint2*)&s_S[(wv * 32 + ni * 16 + fr) * 136 + wk * 32 + mi * 16 + fq * 4] = pack4(s4[0], s4[1], s4[2], s4[3]);
      }
    for (int c = 0; c < nc; ++c) {
      {
        float lfv[8], qv[8];
#pragma unroll
        for (int i = 0; i < 8; ++i) {
          const int tt = c * 32 + th * 8 + i;
          const size_t tok = start + (d ? (N - 1 - tt) : tt);
          lfv[i] = (float)lfg[tok * 2048 + d * 1024 + h * 128 + kk];
          qv[i] = bf2f(qg[tok * 1024 + h * 128 + kk]);
        }
        float run = 0;
        float cs[8];
#pragma unroll
        for (int i = 0; i < 8; ++i) { run += lfv[i]; cs[i] = run; }
        s_part[th * 128 + kk] = run;
        {
          const int s = tid >> 4, v4 = (tid & 15) * 4;
          const int tt = c * 32 + s;
          const size_t tok = start + (d ? (N - 1 - tt) : tt);
          uint2 vv = *(const uint2*)&vg[tok * 1024 + h * 128 + vs * 64 + v4];
          s_vT[(v4 + 0) * 40 + s] = (u16)(vv.x & 0xffff); s_vT[(v4 + 1) * 40 + s] = (u16)(vv.x >> 16);
          s_vT[(v4 + 2) * 40 + s] = (u16)(vv.y & 0xffff); s_vT[(v4 + 3) * 40 + s] = (u16)(vv.y >> 16);
        }
        __syncthreads();
        const float p0 = s_part[kk], p1 = s_part[128 + kk], p2 = s_part[256 + kk], p3 = s_part[384 + kk];
        const float off = (th > 0 ? p0 : 0.f) + (th > 1 ? p1 : 0.f) + (th > 2 ? p2 : 0.f);
        const float ref = p0 + p1, total = p0 + p1 + p2 + p3;
        unsigned kd[4];
#pragma unroll
        for (int i = 0; i < 8; ++i) {
          const int t = th * 8 + i;
          const float cum = off + cs[i];
          const float kf = 1.0f - __expf(lfv[i]);
          s_qrel[t * 136 + kk] = f2bf(qv[i] * __expf(cum - ref));
          s_krel[t * 136 + kk] = f2bf(kf * __expf(ref - cum));
          s_qcum[t * 136 + kk] = f2bf(qv[i] * __expf(cum));
          const u16 kdv = f2bf(kf * __expf(total - cum));
          if (i & 1) kd[i >> 1] |= ((unsigned)kdv) << 16; else kd[i >> 1] = kdv;
        }
        *(uint4*)&s_kdT[kk * 40 + th * 8] = make_uint4(kd[0], kd[1], kd[2], kd[3]);
        if (th == 0) s_dec[kk] = __expf(total);
      }
      __syncthreads();
      f32x4 oacc = f32x4{0.f, 0.f, 0.f, 0.f};
      {
        f32x4 att = f32x4{0.f, 0.f, 0.f, 0.f};
        const int ati = w >> 1, asi = w & 1;
#pragma unroll
        for (int ks = 0; ks < 4; ++ks) {
          if (w < 4) {
            bf16x8 a = *(const bf16x8*)&s_qrel[(ati * 16 + fr) * 136 + ks * 32 + fq * 8];
            bf16x8 bb = *(const bf16x8*)&s_krel[(asi * 16 + fr) * 136 + ks * 32 + fq * 8];
            att = __builtin_amdgcn_mfma_f32_16x16x32_bf16(a, bb, att, 0, 0, 0);
          }
          bf16x8 a2 = *(const bf16x8*)&s_qcum[(ti * 16 + fr) * 136 + ks * 32 + fq * 8];
          bf16x8 b2 = *(const bf16x8*)&s_S[(vi * 16 + fr) * 136 + ks * 32 + fq * 8];
          oacc = __builtin_amdgcn_mfma_f32_16x16x32_bf16(a2, b2, oacc, 0, 0, 0);
        }
        if (w < 4) {
#pragma unroll
          for (int j = 0; j < 4; ++j) {
            const int t = ati * 16 + fq * 4 + j, s = asi * 16 + fr;
            s_att[t * 40 + s] = (s <= t) ? f2bf(att[j]) : (u16)0;
          }
        }
      }
      __syncthreads();
      {
        bf16x8 a = *(const bf16x8*)&s_att[(ti * 16 + fr) * 40 + fq * 8];
        bf16x8 bb = *(const bf16x8*)&s_vT[(vi * 16 + fr) * 40 + fq * 8];
        oacc = __builtin_amdgcn_mfma_f32_16x16x32_bf16(a, bb, oacc, 0, 0, 0);
#pragma unroll
        for (int j = 0; j < 4; ++j) {
          const int tt = c * 32 + ti * 16 + fq * 4 + j;
          const size_t tok = start + (d ? (N - 1 - tt) : tt);
          og[((size_t)d * TOK + tok) * 1024 + h * 128 + vs * 64 + vi * 16 + fr] = f2bf(oacc[j]);
        }
        bf16x8 vf[2];
#pragma unroll
        for (int ni = 0; ni < 2; ++ni) vf[ni] = *(const bf16x8*)&s_vT[(wv * 32 + ni * 16 + fr) * 40 + fq * 8];
#pragma unroll
        for (int mi = 0; mi < 2; ++mi) {
          bf16x8 kf = *(const bf16x8*)&s_kdT[(wk * 32 + mi * 16 + fr) * 40 + fq * 8];
          f32x4 dc = *(const f32x4*)&s_dec[wk * 32 + mi * 16 + fq * 4];
#pragma unroll
          for (int ni = 0; ni < 2; ++ni) {
            f32x4 s4 = S[mi][ni];
#pragma unroll
            for (int j = 0; j < 4; ++j) s4[j] *= dc[j];
            s4 = __builtin_amdgcn_mfma_f32_16x16x32_bf16(kf, vf[ni], s4, 0, 0, 0);
            S[mi][ni] = s4;
            *(uint2*)&s_S[(wv * 32 + ni * 16 + fr) * 136 + wk * 32 + mi * 16 + fq * 4] = pack4(s4[0], s4[1], s4[2], s4[3]);
          }
        }
      }
      __syncthreads();
    }
    if (!sample) {
      float* so = p.out + OUT_HG + ((size_t)((b * 2 + d) * 8 + h)) * 16384;
#pragma unroll
      for (int mi = 0; mi < 2; ++mi)
#pragma unroll
        for (int ni = 0; ni < 2; ++ni)
#pragma unroll
          for (int j = 0; j < 4; ++j) so[(wk * 32 + mi * 16 + fq * 4 + j) * 128 + vs * 64 + wv * 32 + ni * 16 + fr] = S[mi][ni][j];
    }
  }
}

__device__ __forceinline__ void phase_hg_post(const Params& p, int bid, int nb) {
  const u16* og = (const u16*)(p.ws + WS_B(5));
  const u16* sg = (const u16*)(p.ws + WS_B(2));
  u16* a = (u16*)(p.ws + WS_B(0));
  const float* ng = p.in[14];
  const int lane = threadIdx.x & 63, wave = threadIdx.x >> 6;
  for (int row = bid * NW + wave; row < TOK; row += nb * NW) {
    const size_t base = (size_t)row * 1024 + lane * 16;
    float o[16];
    float ss = 0;
#pragma unroll
    for (int hh = 0; hh < 2; ++hh) {
      uint4 f = *(const uint4*)&og[base + hh * 8];
      uint4 bw = *(const uint4*)&og[(size_t)TOK * 1024 + base + hh * 8];
      unsigned fa[4] = {f.x, f.y, f.z, f.w}, ba[4] = {bw.x, bw.y, bw.z, bw.w};
#pragma unroll
      for (int i = 0; i < 4; ++i) {
        o[hh * 8 + 2 * i] = lo16(fa[i]) + lo16(ba[i]);
        o[hh * 8 + 2 * i + 1] = hi16(fa[i]) + hi16(ba[i]);
      }
    }
#pragma unroll
    for (int i = 0; i < 16; ++i) ss += o[i] * o[i];
    ss += __shfl_xor(ss, 1); ss += __shfl_xor(ss, 2); ss += __shfl_xor(ss, 4);
    const float rs = rsqrtf(ss * (1.0f / 128.0f) + 1e-6f);
#pragma unroll
    for (int hh = 0; hh < 2; ++hh) {
      uint4 s = *(const uint4*)&sg[base + hh * 8];
      unsigned sa[4] = {s.x, s.y, s.z, s.w};
      unsigned r[4];
#pragma unroll
      for (int i = 0; i < 4; ++i) {
        const int c = lane * 16 + hh * 8 + 2 * i;
        r[i] = pack2(o[hh * 8 + 2 * i] * rs * ng[c] * lo16(sa[i]), o[hh * 8 + 2 * i + 1] * rs * ng[c + 1] * hi16(sa[i]));
      }
      *(uint4*)&a[base + hh * 8] = make_uint4(r[0], r[1], r[2], r[3]);
    }
  }
}

__device__ __forceinline__ void seq_pos(int tok, int& n, int& L) {
  if (tok < NPROMPT) { n = tok & 255; L = 256; } else { n = (tok - NPROMPT) & 1023; L = 1024; }
}
__device__ __forceinline__ void phase_sc_conv(const Params& p, int bid, int nb) {
  const u16* pb = (const u16*)(p.ws + WS_B(0));
  const u16* sb = (const u16*)(p.ws + WS_B(1));
  u16* a = (u16*)(p.ws + WS_B(2));
  const float* cw = p.in[17]; const float* cbias = p.in[18];
  const size_t total = (size_t)TOK * 128;
  for (size_t i = (size_t)bid * NT + threadIdx.x; i < total; i += (size_t)nb * NT) {
    const int tok = (int)(i >> 7), c = ((int)i & 127) * 8;
    int n, L; seq_pos(tok, n, L);
    const size_t base = (size_t)tok * 1024 + c;
    uint4 z = make_uint4(0, 0, 0, 0);
    uint4 pm = n > 0 ? *(const uint4*)&pb[base - 1024] : z;
    uint4 p0 = *(const uint4*)&pb[base];
    uint4 pp = n < L - 1 ? *(const uint4*)&pb[base + 1024] : z;
    uint4 s = *(const uint4*)&sb[base];
    unsigned am[4] = {pm.x, pm.y, pm.z, pm.w}, a0[4] = {p0.x, p0.y, p0.z, p0.w}, ap[4] = {pp.x, pp.y, pp.z, pp.w}, as[4] = {s.x, s.y, s.z, s.w};
    unsigned r[4];
#pragma unroll
    for (int k = 0; k < 4; ++k) {
      const int c0 = c + 2 * k, c1 = c0 + 1;
      float z0 = cw[c0] * lo16(am[k]) + cw[1024 + c0] * lo16(a0[k]) + cw[2048 + c0] * lo16(ap[k]) + cbias[c0];
      float z1 = cw[c1] * hi16(am[k]) + cw[1024 + c1] * hi16(a0[k]) + cw[2048 + c1] * hi16(ap[k]) + cbias[c1];
      r[k] = pack2(lo16(as[k]) * z0, hi16(as[k]) * z1);
    }
    *(uint4*)&a[base] = make_uint4(r[0], r[1], r[2], r[3]);
  }
}
__device__ __forceinline__ void phase_rg_conv(const Params& p, int bid, int nb) {
  const u16* ub = (const u16*)(p.ws + WS_B(0));
  u16* uc = (u16*)(p.ws + WS_B(2));
  const float* cw = p.in[21]; const float* cbias = p.in[22];
  const size_t total = (size_t)TOK * 128;
  for (size_t i = (size_t)bid * NT + threadIdx.x; i < total; i += (size_t)nb * NT) {
    const int tok = (int)(i >> 7), c = ((int)i & 127) * 8;
    int n, L; seq_pos(tok, n, L);
    const size_t base = (size_t)tok * 1024 + c;
    uint4 z = make_uint4(0, 0, 0, 0);
    uint4 q0 = n > 1 ? *(const uint4*)&ub[base - 2048] : z;
    uint4 q1 = n > 0 ? *(const uint4*)&ub[base - 1024] : z;
    uint4 q2 = *(const uint4*)&ub[base];
    uint4 q3 = n < L - 1 ? *(const uint4*)&ub[base + 1024] : z;
    unsigned a0[4] = {q0.x, q0.y, q0.z, q0.w}, a1[4] = {q1.x, q1.y, q1.z, q1.w}, a2[4] = {q2.x, q2.y, q2.z, q2.w}, a3[4] = {q3.x, q3.y, q3.z, q3.w};
    unsigned r[4];
#pragma unroll
    for (int k = 0; k < 4; ++k) {
      const int c0 = c + 2 * k, c1 = c0 + 1;
      float z0 = cw[c0] * lo16(a0[k]) + cw[1024 + c0] * lo16(a1[k]) + cw[2048 + c0] * lo16(a2[k]) + cw[3072 + c0] * lo16(a3[k]) + cbias[c0];
      float z1 = cw[c1] * hi16(a0[k]) + cw[1024 + c1] * hi16(a1[k]) + cw[2048 + c1] * hi16(a2[k]) + cw[3072 + c1] * hi16(a3[k]) + cbias[c1];
      r[k] = pack2(z0, z1);
    }
    *(uint4*)&uc[base] = make_uint4(r[0], r[1], r[2], r[3]);
  }
}

__device__ __forceinline__ void phase_rg_scan(const Params& p, unsigned char* smem_raw, int bid, int nb) {
  float* sA = (float*)smem_raw;
  float* sB = sA + 2048;
  const u16* rb = (const u16*)(p.ws + WS_B(3));
  const u16* ib = (const u16*)(p.ws + WS_B(5));
  const u16* uc = (const u16*)(p.ws + WS_B(2));
  const u16* sg = (const u16*)(p.ws + WS_B(1));
  u16* hfw = (u16*)(p.ws + WS_H);
  u16* yp = (u16*)(p.ws + WS_B(0));
  const int tid = threadIdx.x;
  for (int u = bid; u < 768; u += nb) {
    int sample, b, c, seg, nseg, start, cl_;
    if (u < 256) { sample = 1; b = u >> 6; cl_ = tid & 15; c = (u & 63) * 16 + cl_; seg = tid >> 4; nseg = 32; start = NPROMPT + b * 1024; }
    else { sample = 0; b = (u - 256) >> 4; cl_ = tid & 63; c = ((u - 256) & 15) * 64 + cl_; seg = tid >> 6; nseg = 8; start = b * 256; }
    const int L = nseg * 32;
#pragma unroll 1
    for (int d = 0; d < 2; ++d) {
      const float lam = p.in[25][d * 1024 + c];
      const float cl = 8.0f * log1pf(__expf(-lam));
      const u16* rp = rb + (size_t)d * TOK * 1024;
      const u16* ip = ib + (size_t)d * TOK * 1024;
      const size_t o0 = (size_t)(start + (d ? L - 1 - seg * 32 : seg * 32)) * 1024 + c;
      const long ostep = d ? -1024 : 1024;
      float av[32], xv[32];
      float Aacc = 1.f, Bacc = 0.f;
#pragma unroll
      for (int s = 0; s < 32; ++s) {
        const size_t o = o0 + s * ostep;
        const float r = bf2f(rp[o]), ig = bf2f(ip[o]), uu = bf2f(uc[o]);
        const float la = -cl * r;
        const float a = __expf(la);
        const float xin = __builtin_amdgcn_sqrtf(fmaxf(1.0f - __expf(2.0f * la), 0.f)) * (ig * uu);
        av[s] = a; xv[s] = xin;
      }
#pragma unroll
      for (int s = 0; s < 32; ++s) { Aacc *= av[s]; Bacc = av[s] * Bacc + xv[s]; }
      sA[seg * 64 + cl_] = Aacc; sB[seg * 64 + cl_] = Bacc;
      __syncthreads();
      float h = sample ? p.in[3][(b * 2 + d) * 1024 + c] : 0.f;
      for (int s2 = 0; s2 < seg; ++s2) h = sA[s2 * 64 + cl_] * h + sB[s2 * 64 + cl_];
      if (d == 0) {
#pragma unroll
        for (int s = 0; s < 32; ++s) { h = av[s] * h + xv[s]; hfw[o0 + s * ostep] = f2bf(h); }
      } else {
        float hf[32], sgv[32];
#pragma unroll
        for (int s = 0; s < 32; ++s) { const size_t o = o0 + s * ostep; hf[s] = bf2f(hfw[o]); sgv[s] = bf2f(sg[o]); }
#pragma unroll
        for (int s = 0; s < 32; ++s) { h = av[s] * h + xv[s]; yp[o0 + s * ostep] = f2bf((hf[s] + h) * sgv[s]); }
      }
      if (!sample && seg == nseg - 1) p.out[OUT_RG + (b * 2 + d) * 1024 + c] = h;
      __syncthreads();
    }
  }
}

__device__ __forceinline__ void phase_mla_norm(const Params& p, int bid, int nb) {
  u16* cq = (u16*)(p.ws + WS3_CQ);
  u16* ckvall = (u16*)(p.ws + WS3_CKVALL);
  const float* ckvraw = (const float*)(p.ws + WS3_CKVRAW);
  const float* kperaw = (const float*)(p.ws + WS3_KPERAW);
  u16* Kb = (u16*)(p.ws + WS3_K);
  const float* qn = p.in[28]; const float* kvn = p.in[29];
  const int lane = threadIdx.x & 63, wave = threadIdx.x >> 6;
  for (int row = bid * NW + wave; row < TOK + 2048; row += nb * NW) {
    if (row < TOK) {
      const int tok = row;
      const bool sample = tok >= NPROMPT;
      const int bs = (tok - NPROMPT) >> 10, n = (tok - NPROMPT) & 1023;
      const size_t kvrow = sample ? (size_t)(NPROMPT + bs * 1536 + 512 + n) : (size_t)tok;
      unsigned* cqr = (unsigned*)&cq[(size_t)tok * 384];
      unsigned cv[3]; float ss = 0;
#pragma unroll
      for (int i = 0; i < 3; ++i) { cv[i] = cqr[i * 64 + lane]; float a = lo16(cv[i]), b2 = hi16(cv[i]); ss += a * a + b2 * b2; }
      const float rsq = rsqrtf(wave_sum(ss) * (1.0f / 384.0f) + 1e-6f);
#pragma unroll
      for (int i = 0; i < 3; ++i) {
        const int k = (i * 64 + lane) * 2;
        cqr[i * 64 + lane] = pack2(lo16(cv[i]) * rsq * qn[k], hi16(cv[i]) * rsq * qn[k + 1]);
      }
      f32x4 kv = *(const f32x4*)&ckvraw[(size_t)tok * 256 + lane * 4];
      const float rsk = rsqrtf(wave_sum(kv[0] * kv[0] + kv[1] * kv[1] + kv[2] * kv[2] + kv[3] * kv[3]) * (1.0f / 256.0f) + 1e-6f);
      f32x4 g4 = *(const f32x4*)&kvn[lane * 4];
      f32x4 o4;
#pragma unroll
      for (int j = 0; j < 4; ++j) o4[j] = kv[j] * rsk * g4[j];
      *(uint2*)&ckvall[kvrow * 256 + lane * 4] = pack4(o4[0], o4[1], o4[2], o4[3]);
      if (!sample) *(f32x4*)&p.out[OUT_CKV + (size_t)tok * 256 + lane * 4] = o4;
      float v = kperaw[(size_t)tok * 32 + (lane & 31)];
      if (!sample) { if (lane < 32) p.out[OUT_KPE + (size_t)tok * 32 + lane] = v; }
      else {
        const float partner = __shfl_xor(v, 8);
        const int i16 = lane & 15;
        const float pos = (lane & 16) ? (float)(n & 63) : (float)(n >> 6);
        float sn, cs; rope_sincos(pos, i16 & 7, sn, cs);
        v = (i16 < 8) ? (v * cs - partner * sn) : (partner * sn + v * cs);
      }
      const u16 vb = f2bf(v);
#pragma unroll
      for (int i = 0; i < 8; ++i) Kb[(kvrow * 16 + (lane >> 5) + 2 * i) * 96 + 64 + (lane & 31)] = vb;
    } else {
      const int r = row - TOK, bs = r >> 9, j = r & 511;
      const size_t kvrow = (size_t)(NPROMPT + bs * 1536 + j);
      f32x4 kv = *(const f32x4*)&p.in[4][(size_t)r * 256 + lane * 4];
      *(uint2*)&ckvall[kvrow * 256 + lane * 4] = pack4(kv[0], kv[1], kv[2], kv[3]);
      const u16 vb = f2bf(p.in[5][(size_t)r * 32 + (lane & 31)]);
#pragma unroll
      for (int i = 0; i < 8; ++i) Kb[(kvrow * 16 + (lane >> 5) + 2 * i) * 96 + 64 + (lane & 31)] = vb;
    }
  }
}

__device__ __forceinline__ void phase_attn(const Params& p, unsigned char* smem_raw, int bid, int nb) {
  u16* sK = (u16*)smem_raw;
  u16* sV = sK + 64 * 104;
  const u16* qg = (const u16*)(p.ws + WS3_Q);
  const u16* Kg = (const u16*)(p.ws + WS3_K);
  const u16* Vg = (const u16*)(p.ws + WS3_VT);
  const u16* sg = (const u16*)(p.ws + WS3_SG);
  u16* ao = (u16*)(p.ws + WS_H);
  const int tid = threadIdx.x, lane = tid & 63, w = tid >> 6, fr = lane & 15, fq = lane >> 4;
  for (int u = bid; u < 1536; u += nb) {
    int tok0, kvbase, nkeys, h;
    if (u < 512) { const int b = u >> 7, r = u & 127; h = r >> 3; const int qb = r & 7; tok0 = NPROMPT + b * 1024 + qb * 128; kvbase = NPROMPT + b * 1536; nkeys = 1536; }
    else { const int uu = u - 512; const int b = uu >> 5, r = uu & 31; h = r >> 1; const int qb = r & 1; tok0 = b * 256 + qb * 128; kvbase = b * 256; nkeys = 256; }
    const int tokq = tok0 + w * 16 + fr;
    bf16x8 qf[3];
#pragma unroll
    for (int ks = 0; ks < 3; ++ks) qf[ks] = *(const bf16x8*)&qg[(size_t)tokq * 1536 + h * 96 + ks * 32 + fq * 8];
    if (u < 512) {
      const int npos = (tokq - NPROMPT) & 1023;
      const float pos = (fq & 2) ? (float)(npos & 63) : (float)(npos >> 6);
      uint4 raw = *(uint4*)&qf[2];
      unsigned rw[4] = {raw.x, raw.y, raw.z, raw.w};
#pragma unroll
      for (int i = 0; i < 4; ++i) {
        float v0 = lo16(rw[i]), v1 = hi16(rw[i]);
        const float p0 = __shfl_xor(v0, 16), p1 = __shfl_xor(v1, 16);
        float sn0, cs0, sn1, cs1;
        rope_sincos(pos, 2 * i, sn0, cs0); rope_sincos(pos, 2 * i + 1, sn1, cs1);
        v0 = (fq & 1) ? (p0 * sn0 + v0 * cs0) : (v0 * cs0 - p0 * sn0);
        v1 = (fq & 1) ? (p1 * sn1 + v1 * cs1) : (v1 * cs1 - p1 * sn1);
        rw[i] = pack2(v0, v1);
      }
      raw = make_uint4(rw[0], rw[1], rw[2], rw[3]);
      qf[2] = *(bf16x8*)&raw;
    }
    float m = -1e30f, l = 0.f;
    f32x4 oacc[4];
#pragma unroll
    for (int i = 0; i < 4; ++i) oacc[i] = f32x4{0.f, 0.f, 0.f, 0.f};
    const int ntile = nkeys >> 6;
    for (int kt = 0; kt < ntile; ++kt) {
      __syncthreads();
#pragma unroll
      for (int i = 0; i < 2; ++i) {
        const int cidx = tid + i * NT;
        if (cidx < 768) {
          const int key = cidx / 12, ch = cidx - key * 12;
          *(uint4*)&sK[key * 104 + ch * 8] = *(const uint4*)&Kg[((size_t)(kvbase + kt * 64 + key) * 16 + h) * 96 + ch * 8];
        }
      }
      {
        const int dv = tid >> 3, ch = tid & 7;
        *(uint4*)&sV[dv * 72 + ch * 8] = *(const uint4*)&Vg[(size_t)(h * 64 + dv) * KVROWS + kvbase + kt * 64 + ch * 8];
      }
      __syncthreads();
      f32x4 sacc[4];
#pragma unroll
      for (int ni = 0; ni < 4; ++ni) {
        sacc[ni] = f32x4{0.f, 0.f, 0.f, 0.f};
#pragma unroll
        for (int ks = 0; ks < 3; ++ks) {
          bf16x8 kf = *(const bf16x8*)&sK[(ni * 16 + fr) * 104 + ks * 32 + fq * 8];
          sacc[ni] = __builtin_amdgcn_mfma_f32_16x16x32_bf16(kf, qf[ks], sacc[ni], 0, 0, 0);
        }
      }
      float mx = -1e30f;
#pragma unroll
      for (int ni = 0; ni < 4; ++ni)
#pragma unroll
        for (int j = 0; j < 4; ++j) mx = fmaxf(mx, sacc[ni][j]);
      mx = fmaxf(mx, __shfl_xor(mx, 16));
      mx = fmaxf(mx, __shfl_xor(mx, 32));
      const float mnew = fmaxf(m, mx);
      const float alpha = __expf(m - mnew);
      m = mnew;
      float ls = 0.f;
#pragma unroll
      for (int ni = 0; ni < 4; ++ni)
#pragma unroll
        for (int j = 0; j < 4; ++j) { float e = __expf(sacc[ni][j] - mnew); sacc[ni][j] = e; ls += e; }
      l = l * alpha + ls;
      bf16x8 pf[2];
#pragma unroll
      for (int kk2 = 0; kk2 < 2; ++kk2) {
        uint2 lo = pack4(sacc[2 * kk2][0], sacc[2 * kk2][1], sacc[2 * kk2][2], sacc[2 * kk2][3]);
        uint2 hi = pack4(sacc[2 * kk2 + 1][0], sacc[2 * kk2 + 1][1], sacc[2 * kk2 + 1][2], sacc[2 * kk2 + 1][3]);
        uint4 pk = make_uint4(lo.x, lo.y, hi.x, hi.y);
        pf[kk2] = *(bf16x8*)&pk;
      }
#pragma unroll
      for (int di = 0; di < 4; ++di) {
#pragma unroll
        for (int j = 0; j < 4; ++j) oacc[di][j] *= alpha;
#pragma unroll
        for (int kk2 = 0; kk2 < 2; ++kk2) {
          uint2 v0 = *(const uint2*)&sV[(di * 16 + fr) * 72 + kk2 * 32 + fq * 4];
          uint2 v1 = *(const uint2*)&sV[(di * 16 + fr) * 72 + kk2 * 32 + 16 + fq * 4];
          uint4 vk = make_uint4(v0.x, v0.y, v1.x, v1.y);
          oacc[di] = __builtin_amdgcn_mfma_f32_16x16x32_bf16(*(bf16x8*)&vk, pf[kk2], oacc[di], 0, 0, 0);
        }
      }
    }
    l += __shfl_xor(l, 16);
    l += __shfl_xor(l, 32);
    const float inv = 1.0f / l;
#pragma unroll
    for (int di = 0; di < 4; ++di) {
      const size_t o = (size_t)tokq * 1024 + h * 64 + di * 16 + fq * 4;
      uint2 s = *(const uint2*)&sg[o];
      *(uint2*)&ao[o] = pack4(oacc[di][0] * inv * lo16(s.x), oacc[di][1] * inv * hi16(s.x), oacc[di][2] * inv * lo16(s.y), oacc[di][3] * inv * hi16(s.y));
    }
  }
}

#define XB_TMO      128
#define XB_XCNT(j)  (256  + 64 * (j))
#define XB_XSUB(j)  (1280 + 64 * (j))
#define XB_XGEN(j)  (2304 + 64 * (j))
#define XB_TOP      3328
#define XB_TOPGEN   3392
#define XCD_BAR_WORDS 3456
#define XB_SPIN_CAP (1u << 22)
__device__ __forceinline__ unsigned xb_ld(unsigned* p)              { return __hip_atomic_load(p, __ATOMIC_RELAXED, __HIP_MEMORY_SCOPE_AGENT); }
__device__ __forceinline__ unsigned xb_add(unsigned* p, unsigned v) { return __hip_atomic_fetch_add(p, v, __ATOMIC_RELAXED, __HIP_MEMORY_SCOPE_AGENT); }
__device__ __forceinline__ unsigned xb_xcc_id() { return (unsigned)__builtin_amdgcn_s_getreg((3 << 11) | 20) & 0xFu; }
#define XB_SPIN(cond, bar) do { unsigned _sp = 0; while (cond) { __builtin_amdgcn_s_sleep(1); \
    if ((++_sp & 255u) == 0u) { if (xb_ld(&(bar)[XB_TMO])) break; if (_sp > XB_SPIN_CAP) { atomicAdd(&(bar)[XB_TMO], 1u); break; } } } } while (0)
struct XcdBarrier { unsigned* bar; unsigned x; volatile LAS unsigned* st; };
__device__ __forceinline__ XcdBarrier xcd_barrier_post(unsigned* bar, volatile LAS unsigned* st) {
  XcdBarrier b; b.bar = bar; b.x = xb_xcc_id(); b.st = st;
  if (threadIdx.x == 0) (void)xb_add(&bar[XB_XCNT(b.x)], 1u);
  return b;
}
__device__ __forceinline__ void xcd_barrier_complete(unsigned* bar, unsigned x, unsigned& nloc, unsigned& nx) {
  const unsigned G = gridDim.x * gridDim.y * gridDim.z;
  unsigned sum, cnt, mine, sp = 0u;
  for (;;) {
    sum = 0u; cnt = 0u; mine = 0u;
#pragma unroll
    for (unsigned j = 0; j < 16; ++j) { const unsigned c = xb_ld(&bar[XB_XCNT(j)]); sum += c; cnt += (c > 0u) ? 1u : 0u; mine = (j == x) ? c : mine; }
    if (sum == G) break;
    __builtin_amdgcn_s_sleep(1);
    if ((++sp & 255u) == 0u) { if (xb_ld(&bar[XB_TMO])) break; if (sp > XB_SPIN_CAP) { atomicAdd(&bar[XB_TMO], 1u); break; } }
  }
  nloc = mine > 0u ? mine : 1u; nx = cnt > 0u ? cnt : 1u;
}
__device__ __forceinline__ void xcd_barrier(const XcdBarrier& b) {
  asm volatile("s_waitcnt vmcnt(0)" ::: "memory");
  __syncthreads();
  if (threadIdx.x == 0) {
    unsigned* bar = b.bar;
    __builtin_amdgcn_s_waitcnt(0);
    unsigned nloc = b.st[0], nx = b.st[1];
    if (nloc == 0u) { xcd_barrier_complete(bar, b.x, nloc, nx); b.st[0] = nloc; b.st[1] = nx; }
    const unsigned old = xb_add(&bar[XB_XSUB(b.x)], 1u);
    const unsigned gen = old / nloc;
    if (old + 1u == (gen + 1u) * nloc) {
      __builtin_amdgcn_fence(__ATOMIC_RELEASE, "agent");
      asm volatile("s_waitcnt vmcnt(0)" ::: "memory");
      const unsigned og = xb_add(&bar[XB_TOP], 1u);
      const unsigned tg = og / nx;
      if (og + 1u == (tg + 1u) * nx) xb_add(&bar[XB_TOPGEN], 1u);
      else XB_SPIN(xb_ld(&bar[XB_TOPGEN]) == tg, bar);
      __builtin_amdgcn_fence(__ATOMIC_ACQUIRE, "agent");
      xb_add(&bar[XB_XGEN(b.x)], 1u);
      asm volatile("s_waitcnt vmcnt(0)" ::: "memory");
    } else {
      XB_SPIN(xb_ld(&bar[XB_XGEN(b.x)]) == gen, bar);
      __builtin_amdgcn_fence(__ATOMIC_ACQUIRE, "agent");
      asm volatile("s_waitcnt vmcnt(0)" ::: "memory");
    }
  }
  __syncthreads();
}

#define GEMM_LDS 131072
#define DYN_LDS (GEMM_LDS + 16)
#define WS_BAR (WS_CNT + 4096ull)

#define RUN_GEMM(Aptr, LDA, Bptr, MM, NN, KK, GATE, EPI, CID) do { pg8::Gemm g_{(const u16*)(Aptr), (const u16*)(Bptr), MM, NN, KK, LDA, GATE}; \
    pg8::StaticOrder S_; S_.init(MM, NN, nb, CID); pg8::gemm_phase((LAS unsigned char*)smem_raw, g_, S_, EPI); } while (0)

__global__ void __launch_bounds__(NT, 2) mega(Params p) {
  extern __shared__ __attribute__((aligned(16))) unsigned char smem_raw[];
  const int bid = blockIdx.x, nb = gridDim.x;
  unsigned char* ws = p.ws;
  const float* mod = (const float*)(ws + WS_MOD);
  volatile LAS unsigned* xst = (volatile LAS unsigned*)((LAS unsigned char*)smem_raw + GEMM_LDS);
  XcdBarrier xb;
  if (p.phase_hi - p.phase_lo > 1) {
    if (threadIdx.x == 0) { xst[0] = 0u; xst[1] = 0u; }
    __syncthreads();
    xb = xcd_barrier_post((unsigned*)(ws + WS_BAR), xst);
  }
#define PH_BEGIN(n) if ((PHMASK & (1u << n)) && p.phase_lo <= n && n < p.phase_hi) { const int ph = n;
#define PH_FIN if (ph + 1 < p.phase_hi) { if (p.phase_lo < 0) cg::this_grid().sync(); else xcd_barrier(xb); } }
  PH_BEGIN(0) phase_prologue(p, smem_raw, bid, nb); PH_FIN
  PH_BEGIN(1) phase_h0(p, bid, nb); PH_FIN
  PH_BEGIN(2) {
    EpiHgIn e{(u16*)(ws + WS_B(0)), (u16*)(ws + WS_B(1)), (u16*)(ws + WS_B(2)), (_Float16*)(ws + WS_B(3)), (const float*)(ws + WS_LB)};
    RUN_GEMM(ws + WS_H, 1024, ws + WS_W_HG_IN, TOK, 5120, 1024, 0, e, bid);
  } PH_FIN
  PH_BEGIN(3) phase_gla(p, smem_raw); PH_FIN
  PH_BEGIN(4) phase_hg_post(p, bid, nb); PH_FIN
  PH_BEGIN(5) {
    EpiRes e{p.in[0], p.in[1], p.out, mod + 0 * 15360 + 2048};
    RUN_GEMM(ws + WS_B(0), 1024, ws + WS_W_HG_OUT, TOK, 1024, 1024, 0, e, bid);
  } PH_FIN
  PH_BEGIN(6) phase_ln(p, 0, bid, nb); PH_FIN
  PH_BEGIN(7) {
    EpiScIn e{(u16*)(ws + WS_B(0)), (u16*)(ws + WS_B(1))};
    RUN_GEMM(ws + WS_H, 1024, ws + WS_W_SC_IN, TOK, 4096, 1024, 0, e, bid);
  } PH_FIN
  PH_BEGIN(8) phase_sc_conv(p, bid, nb); PH_FIN
  PH_BEGIN(9) {
    EpiRes e{p.out, p.out + (size_t)NPROMPT * 1024, p.out, mod + 1 * 15360 + 2048};
    RUN_GEMM(ws + WS_B(2), 1024, ws + WS_W_SC_OUT, TOK, 1024, 1024, 0, e, bid);
  } PH_FIN
  PH_BEGIN(10) phase_ln(p, 1, bid, nb); PH_FIN
  PH_BEGIN(11) {
    EpiRgIn e{(u16*)(ws + WS_B(0)), (u16*)(ws + WS_B(1))};
    RUN_GEMM(ws + WS_H, 1024, ws + WS_W_RG_IN, TOK, 2048, 1024, 0, e, bid);
  } PH_FIN
  PH_BEGIN(12) phase_rg_conv(p, bid, nb); PH_FIN
  PH_BEGIN(13) {
    EpiRgGate e{(u16*)(ws + WS_B(3)), (u16*)(ws + WS_B(5)), p.in[24]};
    RUN_GEMM(ws + WS_B(2), 1024, ws + WS_W_RG_GATE, TOK, 4096, 256, 1, e, bid);
  } PH_FIN
  PH_BEGIN(14) phase_rg_scan(p, smem_raw, bid, nb); PH_FIN
  PH_BEGIN(15) {
    EpiRes e{p.out, p.out + (size_t)NPROMPT * 1024, p.out, mod + 2 * 15360 + 2048};
    RUN_GEMM(ws + WS_B(0), 1024, ws + WS_W_RG_OUT, TOK, 1024, 1024, 0, e, bid);
  } PH_FIN
  PH_BEGIN(16) phase_ln(p, 2, bid, nb); PH_FIN
  PH_BEGIN(17) {
    EpiMlaIn e{(u16*)(ws + WS3_CQ), (float*)(ws + WS3_CKVRAW), (float*)(ws + WS3_KPERAW), (u16*)(ws + WS3_SG)};
    RUN_GEMM(ws + WS_H, 1024, ws + WS_W_MLA_IN, TOK, 1792, 1024, 0, e, bid);
  } PH_FIN
  PH_BEGIN(18) phase_mla_norm(p, bid, nb); PH_FIN
  PH_BEGIN(19) {
    EpiQ eq{(u16*)(ws + WS3_Q)};
    RUN_GEMM(ws + WS3_CQ, 384, ws + WS_W_QB, TOK, 1536, 384, 0, eq, bid);
    EpiKV ek{(u16*)(ws + WS3_K), (u16*)(ws + WS3_VT)};
    RUN_GEMM(ws + WS3_CKVALL, 256, ws + WS_W_KVB, KVROWS, 2048, 256, 0, ek, nb - 1 - bid);
  } PH_FIN
  PH_BEGIN(20) phase_attn(p, smem_raw, bid, nb); PH_FIN
  PH_BEGIN(21) {
    EpiRes e{p.out, p.out + (size_t)NPROMPT * 1024, p.out, mod + 3 * 15360 + 2048};
    RUN_GEMM(ws + WS_H, 1024, ws + WS_W_MLA_OUT, TOK, 1024, 1024, 0, e, bid);
  } PH_FIN
  PH_BEGIN(22) phase_ln(p, 3, bid, nb); PH_FIN
}

extern "C" void kernel_launch(void* const* d_in, const int* in_sizes, int n_in, void* d_out, int out_size, void* d_ws, size_t ws_size,
                              hipStream_t stream) {
  static int grid_blocks = 0;
  if (!grid_blocks) {
    int dev = 0, cus = 0, per_cu = 0;
    (void)hipGetDevice(&dev);
    (void)hipDeviceGetAttribute(&cus, hipDeviceAttributeMultiprocessorCount, dev);
    (void)hipFuncSetAttribute((const void*)mega, hipFuncAttributeMaxDynamicSharedMemorySize, DYN_LDS);
    (void)hipOccupancyMaxActiveBlocksPerMultiprocessor(&per_cu, (const void*)mega, NT, DYN_LDS);
    if (per_cu < 1) per_cu = 1;
    if (per_cu > 1) per_cu = 1;
    grid_blocks = cus * per_cu;
  }
  Params p{};
  for (int i = 0; i < 33; ++i) p.in[i] = (const float*)d_in[i];
  p.out = (float*)d_out;
  p.ws = (unsigned char*)d_ws;
#if MULTI_LAUNCH
  for (int ph = 0; ph < NPHASES; ++ph) {
    p.phase_lo = ph; p.phase_hi = ph + 1;
    hipLaunchKernelGGL(mega, dim3(grid_blocks), dim3(NT), DYN_LDS, stream, p);
#ifdef PROBE_MASK
    if ((PROBE_MASK >> ph) & 1) for (int r = 0; r < 2; ++r) {
      if (ph == 3) (void)hipMemsetAsync((unsigned char*)d_ws + WS_CNT, 0, 64, stream);
      hipLaunchKernelGGL(mega, dim3(grid_blocks), dim3(NT), DYN_LDS, stream, p);
    }
#endif
  }
#else
  p.phase_lo = 0; p.phase_hi = NPHASES;
  (void)hipMemsetAsync((unsigned char*)d_ws + WS_CNT, 0, 4096 + XCD_BAR_WORDS * 4, stream);
  void* args[] = {&p};
  hipError_t e = hipLaunchCooperativeKernel((const void*)mega, dim3(grid_blocks), dim3(NT), args, DYN_LDS, stream);
  if (e != hipSuccess) fprintf(stderr, "cooperative launch failed: %s (grid %d)\n", hipGetErrorString(e), grid_blocks);
#endif
}
```

```cpp
#include <hip/hip_runtime.h>
#include <hip/hip_cooperative_groups.h>
#include <cstdio>
namespace cg = cooperative_groups;

#ifndef MULTI_LAUNCH
#define MULTI_LAUNCH 0
#endif

typedef unsigned short u16;
using bf16x8 = __attribute__((ext_vector_type(8))) short;
using f32x4 = __attribute__((ext_vector_type(4))) float;
typedef _Float16 h4 __attribute__((ext_vector_type(4)));

#define TOK 12288
#define NPROMPT 8192
#define KVROWS 14336
#define NPHASES 23
#ifndef PHMASK
#define PHMASK 0x7fffff
#endif
#define DN_ALPHA 1.6817928305074290f

#define WS_W_HG_IN 0ull
#define WS_W_HG_OUT (WS_W_HG_IN + 10485760ull)
#define WS_W_SC_IN (WS_W_HG_OUT + 2097152ull)
#define WS_W_SC_OUT (WS_W_SC_IN + 8388608ull)
#define WS_W_RG_IN (WS_W_SC_OUT + 2097152ull)
#define WS_W_RG_GATE (WS_W_RG_IN + 4194304ull)
#define WS_W_RG_OUT (WS_W_RG_GATE + 2097152ull)
#define WS_W_MLA_IN (WS_W_RG_OUT + 2097152ull)
#define WS_W_QB (WS_W_MLA_IN + 3670016ull)
#define WS_W_KVB (WS_W_QB + 1179648ull)
#define WS_W_MLA_OUT (WS_W_KVB + 1048576ull)
#define WS_MOD (WS_W_MLA_OUT + 2097152ull)
#define WS_LB (WS_MOD + 245760ull)
#define WS_CNT (WS_LB + 8192ull)
#define WS_R (WS_CNT + 4096ull + 16384ull)
#define BSZ 25165824ull
#define WS_H (WS_R)
#define WS_B(i) (WS_R + BSZ * (1 + (i)))
#define WS3_CQ (WS_R + 25165824ull)
#define WS3_CKVALL (WS_R + 34603008ull)
#define WS3_CKVRAW (WS_R + 41943040ull)
#define WS3_KPERAW (WS_R + 54525952ull)
#define WS3_SG (WS_R + 56098816ull)
#define WS3_Q (WS_R + 81264640ull)
#define WS3_K (WS_R + 119013376ull)
#define WS3_VT (WS_R + 163053568ull)

#define OUT_HG 12582912
#define OUT_RG 20971520
#define OUT_CKV 21037056
#define OUT_KPE 23134208

struct Params {
  const float* in[33];
  float* out;
  unsigned char* ws;
  int phase_lo, phase_hi;
};

__device__ __forceinline__ u16 f2bf(float f) { __bf16 r = (__bf16)f; return *(u16*)&r; }
__device__ __forceinline__ float bf2f(u16 h) { return __uint_as_float(((unsigned)h) << 16); }
typedef float f2v_ __attribute__((ext_vector_type(2)));
typedef __bf16 b2v_ __attribute__((ext_vector_type(2)));
__device__ __forceinline__ unsigned pack2(float a, float b) { f2v_ f = {a, b}; b2v_ r = __builtin_convertvector(f, b2v_); return *(unsigned*)&r; }
__device__ __forceinline__ uint2 pack4(float a, float b, float c, float d) { return make_uint2(pack2(a, b), pack2(c, d)); }
__device__ __forceinline__ float lo16(unsigned u) { return __uint_as_float(u << 16); }
__device__ __forceinline__ float hi16(unsigned u) { return __uint_as_float(u & 0xffff0000u); }
__device__ __forceinline__ float sigmoidf_(float x) { return __builtin_amdgcn_rcpf(1.0f + __expf(-x)); }
__device__ __forceinline__ float siluf_(float x) { return x * __builtin_amdgcn_rcpf(1.0f + __expf(-x)); }
__device__ __forceinline__ int cond_of(int tok) { return tok < NPROMPT ? 0 : 1 + ((tok - NPROMPT) >> 10); }
__device__ __forceinline__ float wave_sum(float v) {
#pragma unroll
  for (int o = 32; o > 0; o >>= 1) v += __shfl_xor(v, o);
  return v;
}
__device__ __forceinline__ void rope_sincos(float pos, int fi, float& sn, float& cs) {
  float inv = exp2f(-(float)fi * 1.6609640474436813f);
  float ang = pos * inv;
  float k = rintf(ang * 0.15915494309189535f);
  float r = fmaf(-k, 6.2831854820251465f, ang);
  r = fmaf(-k, -1.7484555e-7f, r);
  sn = __sinf(r); cs = __cosf(r);
}

#define NT 512
#define NW 8
#define LAS __attribute__((address_space(3)))

namespace pg8 {
constexpr int BM = 256, BK = 64, HALF = 128, HTB = HALF * BK * 2, STAGE_BYTES = 8 * HTB, NXCD = 8, WGM = 8;
__device__ __forceinline__ int lds_byte(int r, int c) { const int st = (r >> 4) * 2 + (c >> 5), rr = r & 15, cc = c & 31, ob = rr * 64 + cc * 2; return st * 1024 + (ob ^ (((ob >> 9) & 1) << 5)); }
__device__ __forceinline__ void stage_rc(int b, int& R, int& C) { const int st = b / 1024, sb = b % 1024, swz = sb ^ (((sb >> 9) & 1) << 5); R = (st >> 1) * 16 + swz / 64; C = (st & 1) * 32 + (swz % 64) / 2; }
struct Unit { int pm, pn; };
struct Gemm { const u16* A; const u16* Bt; int M, N, K, lda, gate; };
struct StaticOrder {
  int nM, nN, nwg, G, c;
  __device__ void init(int M, int N, int G_, int c_) { nM = M / BM; nN = N / BM; nwg = nM * nN; G = G_; c = c_; }
  __device__ bool next(int i, Unit& u) const {
    const long L = (long)i * G + c; if (L >= nwg) return false;
    int wgid = (int)L; { const int q = nwg / NXCD, r = nwg % NXCD, xcd = wgid % NXCD, off = wgid / NXCD; wgid = (xcd < r ? xcd * (q + 1) : r * (q + 1) + (xcd - r) * q) + off; }
    const int nig = WGM * nN, gid = wgid / nig, fm = gid * WGM, gsz = (nM - fm) < WGM ? (nM - fm) : WGM;
    u.pm = fm + ((wgid % nig) % gsz); u.pn = (wgid % nig) / gsz; return true;
  }
};
template <class Epi>
__device__ __forceinline__ void gemm_phase(LAS unsigned char* lds, const Gemm g, const StaticOrder& S, const Epi& E) {
  const int tid = threadIdx.x, wid = __builtin_amdgcn_readfirstlane(tid >> 6), lane = tid & 63, wr = wid >> 2, wc = wid & 3, fr = lane & 15, fq = lane >> 4;
  const int K = g.K, nt = K / BK;
  unsigned voffA[2], voffB[2];
#pragma unroll
  for (int i = 0; i < 2; ++i) { int R, C; stage_rc(tid * 16 + i * 8192, R, C); voffA[i] = (unsigned)(R * g.lda + C) * 2u; voffB[i] = (unsigned)(R * K + C) * 2u; }
  const size_t kstep = (size_t)(BK * 2);
  const size_t hstepA = (size_t)HALF * g.lda * 2, hstepB = (size_t)HALF * K * 2;
  const size_t tstepA = 2 * hstepA, tstepB = 2 * hstepB;
  const unsigned ldsw = (unsigned)wid * 1024u;
  const int aoff = lds_byte(wr * 64 + fr, fq * 8), boff = lds_byte(wc * 32 + fr, fq * 8);
#define PG8_AOFF(pn) (g.gate ? (size_t)((((pn) >> 1) & 3) * 512) : (size_t)0)
#define PG8_SA(b, h) (((b) * 2 + (h)) * HTB)
#define PG8_SB(b, h) ((4 + (b) * 2 + (h)) * HTB)
#define PG8_STAGE(bufoff, gbase, voff) do { _Pragma("unroll") for (int _i = 0; _i < 2; ++_i) \
    __builtin_amdgcn_global_load_lds((const unsigned*)((const char*)(gbase) + (voff)[_i]), (LAS unsigned*)(lds + (bufoff) + ldsw + _i * 8192), 16, 0, 0); } while (0)
#define PG8_LDA(dst, b, h) do { _Pragma("unroll") for (int m = 0; m < 4; ++m) _Pragma("unroll") for (int k = 0; k < 2; ++k) dst[m][k] = *(const LAS bf16x8*)(lds + PG8_SA(b, h) + aoff + m * 2048 + k * 1024); } while (0)
#define PG8_LDB(dst, b, h) do { _Pragma("unroll") for (int n = 0; n < 2; ++n) _Pragma("unroll") for (int k = 0; k < 2; ++k) dst[n][k] = *(const LAS bf16x8*)(lds + PG8_SB(b, h) + boff + n * 2048 + k * 1024); } while (0)
#define PG8_MMA(ai, bj, At, Bt) do { __builtin_amdgcn_s_setprio(1); _Pragma("unroll") for (int m = 0; m < 4; ++m) _Pragma("unroll") for (int n = 0; n < 2; ++n) _Pragma("unroll") for (int k = 0; k < 2; ++k) \
    acc[ai][bj][m][n] = __builtin_amdgcn_mfma_f32_16x16x32_bf16(Bt[n][k], At[m][k], acc[ai][bj][m][n], 0, 0, 0); __builtin_amdgcn_s_setprio(0); } while (0)
#define PG8_WAIT_V(n) asm volatile("s_waitcnt vmcnt(" #n ")" ::: "memory")
#define PG8_WAIT_L(n) asm volatile("s_waitcnt lgkmcnt(" #n ")" ::: "memory")
#define PG8_BAR __builtin_amdgcn_s_barrier()
#define PG8_SCHED __builtin_amdgcn_sched_barrier(0)
  Unit cur, nxt; int ui = 0;
  if (!S.next(0, cur)) return;
  f32x4 acc[2][2][4][2];
#pragma unroll
  for (int a = 0; a < 2; ++a)
#pragma unroll
    for (int b = 0; b < 2; ++b)
#pragma unroll
      for (int m = 0; m < 4; ++m)
#pragma unroll
        for (int n = 0; n < 2; ++n) acc[a][b][m][n] = (f32x4){0.f, 0.f, 0.f, 0.f};
  bf16x8 At[4][2], B0[2][2], B1[2][2];
  const char* cA = (const char*)g.A + (size_t)cur.pm * tstepA + PG8_AOFF(cur.pn); const char* cB = (const char*)g.Bt + (size_t)cur.pn * tstepB;
  PG8_STAGE(PG8_SB(0, 0), cB, voffB); PG8_STAGE(PG8_SA(0, 0), cA, voffA); PG8_STAGE(PG8_SB(0, 1), cB + hstepB, voffB); PG8_STAGE(PG8_SA(0, 1), cA + hstepA, voffA);
  if (wr == 1) PG8_BAR;
  PG8_WAIT_V(4); PG8_BAR;
  PG8_STAGE(PG8_SB(1, 0), cB + kstep, voffB); PG8_STAGE(PG8_SA(1, 0), cA + kstep, voffA); PG8_STAGE(PG8_SB(1, 1), cB + hstepB + kstep, voffB);
  PG8_WAIT_V(6); PG8_BAR;
  for (;;) {
    const bool has_next = S.next(ui + 1, nxt);
    const char* nA = has_next ? (const char*)g.A + (size_t)nxt.pm * tstepA + PG8_AOFF(nxt.pn) : cA; const char* nB = has_next ? (const char*)g.Bt + (size_t)nxt.pn * tstepB : cB;
#pragma unroll 1
    for (int t = 0; t < nt; t += 2) {
      const bool last = (t == nt - 2);
      const char* a1 = cA + (size_t)(t + 1) * kstep;
      const char* a2 = last ? nA : cA + (size_t)(t + 2) * kstep; const char* b2 = last ? nB : cB + (size_t)(t + 2) * kstep;
      const char* a3 = a2 + kstep; const char* b3 = b2 + kstep;
      PG8_LDB(B0, 0, 0); PG8_SCHED; PG8_LDA(At, 0, 0); PG8_STAGE(PG8_SA(1, 1), a1 + hstepA, voffA);
      PG8_WAIT_L(8); PG8_BAR; PG8_WAIT_L(0); PG8_MMA(0, 0, At, B0); PG8_BAR; PG8_SCHED;
      PG8_LDB(B1, 0, 1); PG8_STAGE(PG8_SB(0, 0), b2, voffB);
      PG8_BAR; PG8_WAIT_L(0); PG8_MMA(0, 1, At, B1); PG8_BAR;
      PG8_LDA(At, 0, 1); PG8_STAGE(PG8_SA(0, 0), a2, voffA);
      PG8_BAR; PG8_WAIT_L(0); PG8_MMA(1, 0, At, B0); PG8_BAR; PG8_SCHED;
      PG8_STAGE(PG8_SB(0, 1), b2 + hstepB, voffB);
      PG8_WAIT_V(6); PG8_BAR; PG8_MMA(1, 1, At, B1); PG8_BAR;
      PG8_LDB(B0, 1, 0); PG8_SCHED; PG8_LDA(At, 1, 0); PG8_STAGE(PG8_SA(0, 1), a2 + hstepA, voffA);
      PG8_WAIT_L(8); PG8_BAR; PG8_WAIT_L(0); PG8_MMA(0, 0, At, B0); PG8_BAR; PG8_SCHED;
      PG8_LDB(B1, 1, 1); PG8_STAGE(PG8_SB(1, 0), b3, voffB);
      PG8_BAR; PG8_WAIT_L(0); PG8_MMA(0, 1, At, B1); PG8_BAR;
      PG8_LDA(At, 1, 1); PG8_STAGE(PG8_SA(1, 0), a3, voffA);
      PG8_BAR; PG8_WAIT_L(0); PG8_MMA(1, 0, At, B0); PG8_BAR; PG8_SCHED;
      PG8_STAGE(PG8_SB(1, 1), b3 + hstepB, voffB);
      PG8_WAIT_V(6); PG8_BAR; PG8_MMA(1, 1, At, B1); PG8_BAR;
    }
    E(acc, cur, wr, wc, fr, fq);
    if (!has_next) break;
#pragma unroll
    for (int a = 0; a < 2; ++a)
#pragma unroll
      for (int b = 0; b < 2; ++b)
#pragma unroll
        for (int m = 0; m < 4; ++m)
#pragma unroll
          for (int n = 0; n < 2; ++n) acc[a][b][m][n] = (f32x4){0.f, 0.f, 0.f, 0.f};
    cur = nxt; cA = nA; cB = nB; ++ui;
  }
  PG8_WAIT_V(0);
  if (wr == 0) PG8_BAR;
  PG8_BAR;
#undef PG8_AOFF
#undef PG8_SA
#undef PG8_SB
#undef PG8_STAGE
#undef PG8_LDA
#undef PG8_LDB
#undef PG8_MMA
#undef PG8_WAIT_V
#undef PG8_WAIT_L
#undef PG8_BAR
#undef PG8_SCHED
}
}
using pg8::Unit;
typedef const f32x4 (&AccRef)[2][2][4][2];

#define EPI_ROWS(...) _Pragma("unroll") for (int ai = 0; ai < 2; ++ai) _Pragma("unroll") for (int m = 0; m < 4; ++m) { const int row = u.pm * 256 + ai * 128 + wr * 64 + m * 16 + fr; __VA_ARGS__ }
#define EPI_COLS(...) _Pragma("unroll") for (int bj = 0; bj < 2; ++bj) _Pragma("unroll") for (int n = 0; n < 2; ++n) { const int cb = u.pn * 256 + bj * 128 + wc * 32 + n * 16; const f32x4 a = acc[ai][bj][m][n]; __VA_ARGS__ }

struct EpiHgIn {
  u16 *q, *v, *sg; _Float16* lf; const float* lb;
  __device__ __forceinline__ void operator()(AccRef acc, const Unit& u, int wr, int wc, int fr, int fq) const {
    const int region = u.pn >> 2;
    EPI_ROWS( EPI_COLS(
      const int c = (cb & 1023) + fq * 4;
      if (region == 0) {
        const float s = 0.08838834764831845f;
        *(uint2*)&q[(size_t)row * 1024 + c] = pack4(siluf_(a[0]) * s, siluf_(a[1]) * s, siluf_(a[2]) * s, siluf_(a[3]) * s);
      } else if (region <= 2) {
        const int d = region - 1;
        f32x4 l4 = *(const f32x4*)&lb[d * 1024 + c];
        h4 o;
        _Pragma("unroll") for (int j = 0; j < 4; ++j) { float f = l4[j] + (1.0f - l4[j]) * sigmoidf_(a[j]); o[j] = (_Float16)__logf(f); }
        *(h4*)&lf[(size_t)row * 2048 + d * 1024 + c] = o;
      } else if (region == 3) {
        *(uint2*)&v[(size_t)row * 1024 + c] = pack4(a[0], a[1], a[2], a[3]);
      } else {
        *(uint2*)&sg[(size_t)row * 1024 + c] = pack4(siluf_(a[0]), siluf_(a[1]), siluf_(a[2]), siluf_(a[3]));
      }
    ) )
  }
};

struct EpiRes {
  const float* xin_p; const float* xin_s; float* Y; const float* gate;
  __device__ __forceinline__ void operator()(AccRef acc, const Unit& u, int wr, int wc, int fr, int fq) const {
    EPI_ROWS(
      const float* xr = row < NPROMPT ? xin_p + (size_t)row * 1024 : xin_s + (size_t)(row - NPROMPT) * 1024;
      const float* g = gate + cond_of(row) * 3072;
      EPI_COLS(
        const int c = cb + fq * 4;
        f32x4 x = *(const f32x4*)&xr[c];
        f32x4 gg = *(const f32x4*)&g[c];
        f32x4 y;
        _Pragma("unroll") for (int j = 0; j < 4; ++j) y[j] = DN_ALPHA * x[j] + gg[j] * a[j];
        *(f32x4*)&Y[(size_t)row * 1024 + c] = y;
      ) )
  }
};

struct EpiScIn {
  u16 *pb, *sb;
  __device__ __forceinline__ void operator()(AccRef acc, const Unit& u, int wr, int wc, int fr, int fq) const {
    const int c = u.pn * 64 + wc * 16 + fq * 4;
    EPI_ROWS(
      const f32x4 bg = acc[ai][0][m][0], cgv = acc[ai][0][m][1], v = acc[ai][1][m][0], g = acc[ai][1][m][1];
      *(uint2*)&pb[(size_t)row * 1024 + c] = pack4(cgv[0] * v[0], cgv[1] * v[1], cgv[2] * v[2], cgv[3] * v[3]);
      *(uint2*)&sb[(size_t)row * 1024 + c] = pack4(siluf_(g[0]) * bg[0], siluf_(g[1]) * bg[1], siluf_(g[2]) * bg[2], siluf_(g[3]) * bg[3]);
    )
  }
};

struct EpiRgIn {
  u16 *ub, *sg;
  __device__ __forceinline__ void operator()(AccRef acc, const Unit& u, int wr, int wc, int fr, int fq) const {
    const int region = u.pn >> 2;
    EPI_ROWS( EPI_COLS(
      const int c = (cb & 1023) + fq * 4;
      if (region == 0) *(uint2*)&ub[(size_t)row * 1024 + c] = pack4(a[0], a[1], a[2], a[3]);
      else *(uint2*)&sg[(size_t)row * 1024 + c] = pack4(siluf_(a[0]), siluf_(a[1]), siluf_(a[2]), siluf_(a[3]));
    ) )
  }
};

struct EpiRgGate {
  u16 *rb, *ib; const float* bgate;
  __device__ __forceinline__ void operator()(AccRef acc, const Unit& u, int wr, int wc, int fr, int fq) const {
    const int mat = u.pn >> 1, d = mat >> 2, hd = mat & 3;
    EPI_ROWS(
      _Pragma("unroll") for (int bj = 0; bj < 2; ++bj) {
        const int off = ((u.pn & 1) * 256 + bj * 128 + wc * 32);
        const int cc = (off >> 5) * 16 + fq * 4;
        f32x4 br = *(const f32x4*)&bgate[mat * 512 + cc];
        f32x4 bi = *(const f32x4*)&bgate[mat * 512 + 256 + cc];
        const f32x4 r = acc[ai][bj][m][0], ii = acc[ai][bj][m][1];
        const size_t o = ((size_t)d * TOK + row) * 1024 + hd * 256 + cc;
        *(uint2*)&rb[o] = pack4(sigmoidf_(r[0] + br[0]), sigmoidf_(r[1] + br[1]), sigmoidf_(r[2] + br[2]), sigmoidf_(r[3] + br[3]));
        *(uint2*)&ib[o] = pack4(sigmoidf_(ii[0] + bi[0]), sigmoidf_(ii[1] + bi[1]), sigmoidf_(ii[2] + bi[2]), sigmoidf_(ii[3] + bi[3]));
      } )
  }
};

struct EpiMlaIn {
  u16* cq; float* ckvraw; float* kperaw; u16* sg;
  __device__ __forceinline__ void operator()(AccRef acc, const Unit& u, int wr, int wc, int fr, int fq) const {
    EPI_ROWS( EPI_COLS(
      const int c = cb + fq * 4;
      if (cb < 384) *(uint2*)&cq[(size_t)row * 384 + c] = pack4(a[0], a[1], a[2], a[3]);
      else if (cb < 640) *(f32x4*)&ckvraw[(size_t)row * 256 + (c - 384)] = a;
      else if (cb < 672) *(f32x4*)&kperaw[(size_t)row * 32 + (c - 640)] = a;
      else if (cb < 1696) *(uint2*)&sg[(size_t)row * 1024 + (c - 672)] = pack4(siluf_(a[0]), siluf_(a[1]), siluf_(a[2]), siluf_(a[3]));
    ) )
  }
};

struct EpiQ {
  u16* q;
  __device__ __forceinline__ void operator()(AccRef acc, const Unit& u, int wr, int wc, int fr, int fq) const {
    const float sc = 0.10206207261596575f;
    EPI_ROWS( EPI_COLS(
      *(uint2*)&q[(size_t)row * 1536 + cb + fq * 4] = pack4(a[0] * sc, a[1] * sc, a[2] * sc, a[3] * sc);
    ) )
  }
};

struct EpiKV {
  u16 *Kb, *Vt;
  __device__ __forceinline__ void operator()(AccRef acc, const Unit& u, int wr, int wc, int fr, int fq) const {
    EPI_ROWS( EPI_COLS(
      const int h = cb >> 7, d0 = cb & 127, dd = (d0 & 63) + fq * 4;
      if (d0 < 64) {
        *(uint2*)&Kb[((size_t)row * 16 + h) * 96 + dd] = pack4(a[0], a[1], a[2], a[3]);
      } else {
        _Pragma("unroll") for (int j = 0; j < 4; ++j) Vt[((size_t)(h * 64 + dd + j)) * KVROWS + row] = f2bf(a[j]);
      }
    ) )
  }
};

__device__ __forceinline__ void wconv_tile(const float* __restrict__ src, int N, int K, u16* __restrict__ dst, int k0, int n0,
                                           int perm, int mat, float* tile) {
  const int tid = threadIdx.x;
  {
    const int r = tid >> 4, c4 = (tid & 15) * 4;
#pragma unroll
    for (int i = 0; i < 2; ++i) {
      const int k = r + i * 32;
      f32x4 v = f32x4{0.f, 0.f, 0.f, 0.f};
      if (n0 + c4 < N) v = *(const f32x4*)&src[(size_t)(k0 + k) * N + n0 + c4];
      tile[k * 65 + c4 + 0] = v[0]; tile[k * 65 + c4 + 1] = v[1]; tile[k * 65 + c4 + 2] = v[2]; tile[k * 65 + c4 + 3] = v[3];
    }
  }
  __syncthreads();
  {
    const int nl = tid >> 3, kq = (tid & 7) * 8;
    const int n = n0 + nl;
    int np = n;
    if (perm == 1) { const int part = n >> 10, c = n & 1023; np = (c >> 6) * 256 + (part >> 1) * 128 + ((c >> 4) & 3) * 32 + (part & 1) * 16 + (c & 15); }
    else if (perm == 2) { const int type = n >> 8, cc = n & 255; np = mat * 512 + (cc >> 4) * 32 + type * 16 + (cc & 15); }
    if (n < N) {
      unsigned w[4];
#pragma unroll
      for (int i = 0; i < 4; ++i) w[i] = pack2(tile[(kq + 2 * i) * 65 + nl], tile[(kq + 2 * i + 1) * 65 + nl]);
      *(uint4*)&dst[(size_t)np * K + k0 + kq] = make_uint4(w[0], w[1], w[2], w[3]);
    }
  }
  __syncthreads();
}

__device__ __forceinline__ void phase_prologue(const Params& p, unsigned char* smem_raw, int bid, int nb) {
  float* fs = (float*)smem_raw;
  const int tid = threadIdx.x;
  const int NMOD = 192, NWT = 4800;
  for (int it = bid; it < NMOD + 1 + NWT; it += nb) {
    if (it < NMOD) {
      const int l = it / 48, n0 = (it % 48) * 64;
      float* scond = fs;
      float* sred = fs + 5120;
      for (int i = tid; i < 5120; i += NT) {
        const int ci = i >> 10, k = i & 1023;
        float cv = ci == 0 ? p.in[7][k] : p.in[6][(ci - 1) * 1024 + k];
        scond[i] = siluf_(cv);
      }
      __syncthreads();
      const int col = tid & 63, kg = tid >> 6;
      const float* w = p.in[8] + (size_t)l * 1024 * 3072 + n0 + col;
      float a0 = 0, a1 = 0, a2 = 0, a3 = 0, a4 = 0;
#pragma unroll 16
      for (int k = kg * 128; k < kg * 128 + 128; ++k) {
        float wv = w[(size_t)k * 3072];
        a0 += scond[k] * wv; a1 += scond[1024 + k] * wv; a2 += scond[2048 + k] * wv; a3 += scond[3072 + k] * wv; a4 += scond[4096 + k] * wv;
      }
      sred[(kg * 5 + 0) * 64 + col] = a0; sred[(kg * 5 + 1) * 64 + col] = a1; sred[(kg * 5 + 2) * 64 + col] = a2;
      sred[(kg * 5 + 3) * 64 + col] = a3; sred[(kg * 5 + 4) * 64 + col] = a4;
      __syncthreads();
      float* mod = (float*)(p.ws + WS_MOD);
      if (tid < 320) {
        const int ci = tid >> 6, cc = tid & 63;
        float s = 0;
#pragma unroll
        for (int g = 0; g < 8; ++g) s += sred[(g * 5 + ci) * 64 + cc];
        mod[(l * 5 + ci) * 3072 + n0 + cc] = s + p.in[9][l * 3072 + n0 + cc];
      }
      __syncthreads();
    } else if (it == NMOD) {
      float* lb = (float*)(p.ws + WS_LB);
      for (int i = tid; i < 2048; i += NT) {
        const int d = i >> 10, c = i & 1023;
        const float* lg = p.in[13] + d * 5 * 1024 + c;
        float m = lg[0];
        for (int j = 1; j < 5; ++j) m = fmaxf(m, lg[j * 1024]);
        float s = 0;
        for (int j = 0; j < 5; ++j) s += expf(lg[j * 1024] - m);
        lb[i] = expf(lg[0] - m) / s;
      }
      int* cnt = (int*)(p.ws + WS_CNT);
      if (tid < 16) cnt[tid] = 0;
    } else {
      int t = it - NMOD - 1;
      const float* src; u16* dst; int N, K, perm = 0, mat = 0, ntn;
      if (t < 1280) { src = p.in[12]; dst = (u16*)(p.ws + WS_W_HG_IN); N = 5120; K = 1024; }
      else if ((t -= 1280) < 256) { src = p.in[15]; dst = (u16*)(p.ws + WS_W_HG_OUT); N = 1024; K = 1024; }
      else if ((t -= 256) < 1024) { src = p.in[16]; dst = (u16*)(p.ws + WS_W_SC_IN); N = 4096; K = 1024; perm = 1; }
      else if ((t -= 1024) < 256) { src = p.in[19]; dst = (u16*)(p.ws + WS_W_SC_OUT); N = 1024; K = 1024; }
      else if ((t -= 256) < 512) { src = p.in[20]; dst = (u16*)(p.ws + WS_W_RG_IN); N = 2048; K = 1024; }
      else if ((t -= 512) < 256) { mat = t >> 5; t &= 31; src = p.in[23] + (size_t)mat * 256 * 512; dst = (u16*)(p.ws + WS_W_RG_GATE); N = 512; K = 256; perm = 2; }
      else if ((t -= 256) < 256) { src = p.in[26]; dst = (u16*)(p.ws + WS_W_RG_OUT); N = 1024; K = 1024; }
      else if ((t -= 256) < 432) { src = p.in[27]; dst = (u16*)(p.ws + WS_W_MLA_IN); N = 1696; K = 1024; }
      else if ((t -= 432) < 144) { src = p.in[30]; dst = (u16*)(p.ws + WS_W_QB); N = 1536; K = 384; }
      else if ((t -= 144) < 128) { src = p.in[31]; dst = (u16*)(p.ws + WS_W_KVB); N = 2048; K = 256; }
      else { t -= 128; src = p.in[32]; dst = (u16*)(p.ws + WS_W_MLA_OUT); N = 1024; K = 1024; }
      ntn = (N + 63) >> 6;
      const int kt = t / ntn, ntl = t - kt * ntn;
      wconv_tile(src, N, K, dst, kt * 64, ntl * 64, perm, mat, fs);
    }
  }
}

__device__ __forceinline__ void phase_h0(const Params& p, int bid, int nb) {
  const float* mod = (const float*)(p.ws + WS_MOD);
  u16* H = (u16*)(p.ws + WS_H);
  const size_t total = (size_t)TOK * 256;
  for (size_t i = (size_t)bid * NT + threadIdx.x; i < total; i += (size_t)nb * NT) {
    const int row = (int)(i >> 8), c = ((int)i & 255) * 4;
    const float* xr = row < NPROMPT ? p.in[0] + (size_t)row * 1024 : p.in[1] + (size_t)(row - NPROMPT) * 1024;
    const float* m = mod + cond_of(row) * 3072;
    f32x4 x = *(const f32x4*)&xr[c];
    f32x4 sh = *(const f32x4*)&m[c];
    f32x4 sc = *(const f32x4*)&m[1024 + c];
    *(uint2*)&H[(size_t)row * 1024 + c] = pack4(x[0] * (1 + sc[0]) + sh[0], x[1] * (1 + sc[1]) + sh[1], x[2] * (1 + sc[2]) + sh[2], x[3] * (1 + sc[3]) + sh[3]);
  }
}

__device__ __forceinline__ void phase_ln(const Params& p, int l, int bid, int nb) {
  float* X = p.out;
  const float* g = p.in[10] + l * 1024;
  const float* b = p.in[11] + l * 1024;
  const float* mod = (const float*)(p.ws + WS_MOD) + (l + 1) * 5 * 3072;
  u16* H = (u16*)(p.ws + WS_H);
  const int lane = threadIdx.x & 63, wave = threadIdx.x >> 6;
  for (int row = bid * NW + wave; row < TOK; row += nb * NW) {
    float* xr = X + (size_t)row * 1024;
    f32x4 v[4];
    float s = 0;
#pragma unroll
    for (int i = 0; i < 4; ++i) { v[i] = *(const f32x4*)&xr[i * 256 + lane * 4]; s += v[i][0] + v[i][1] + v[i][2] + v[i][3]; }
    const float mu = wave_sum(s) * (1.0f / 1024.0f);
    float q = 0;
#pragma unroll
    for (int i = 0; i < 4; ++i)
#pragma unroll
      for (int j = 0; j < 4; ++j) { float dd = v[i][j] - mu; q += dd * dd; }
    const float rs = rsqrtf(wave_sum(q) * (1.0f / 1024.0f) + 1e-5f);
    const float* m = mod + cond_of(row) * 3072;
#pragma unroll
    for (int i = 0; i < 4; ++i) {
      const int c = i * 256 + lane * 4;
      f32x4 gg = *(const f32x4*)&g[c], bb = *(const f32x4*)&b[c];
      f32x4 y;
#pragma unroll
      for (int j = 0; j < 4; ++j) y[j] = (v[i][j] - mu) * rs * gg[j] + bb[j];
      *(f32x4*)&xr[c] = y;
      if (l < 3) {
        f32x4 sh = *(const f32x4*)&m[c], sc = *(const f32x4*)&m[1024 + c];
        *(uint2*)&H[(size_t)row * 1024 + c] = pack4(y[0] * (1 + sc[0]) + sh[0], y[1] * (1 + sc[1]) + sh[1], y[2] * (1 + sc[2]) + sh[2], y[3] * (1 + sc[3]) + sh[3]);
      }
    }
  }
}

__device__ __forceinline__ void phase_gla(const Params& p, unsigned char* smem_raw) {
  u16* s_qrel = (u16*)smem_raw;
  u16* s_krel = s_qrel + 32 * 136;
  u16* s_qcum = s_krel + 32 * 136;
  u16* s_kdT = s_qcum + 32 * 136;
  u16* s_vT = s_kdT + 128 * 40;
  u16* s_att = s_vT + 64 * 40;
  u16* s_S = s_att + 32 * 40;
  float* s_dec = (float*)(s_S + 64 * 136);
  float* s_part = s_dec + 128;
  int* s_u = (int*)(s_part + 512);
  int* counter = (int*)(p.ws + WS_CNT);
  const u16* qg = (const u16*)(p.ws + WS_B(0));
  const u16* vg = (const u16*)(p.ws + WS_B(1));
  const _Float16* lfg = (const _Float16*)(p.ws + WS_B(3));
  u16* og = (u16*)(p.ws + WS_B(5));
  const int tid = threadIdx.x, lane = tid & 63, w = tid >> 6, fr = lane & 15, fq = lane >> 4;
  const int kk = tid & 127, th = tid >> 7;
  const int ti = w >> 2, vi = w & 3;
  const int wk = w & 3, wv = w >> 2;
  while (true) {
    if (tid == 0) *s_u = atomicAdd(counter, 1);
    __syncthreads();
    const int u = *s_u;
    __syncthreads();
    if (u >= 1152) break;
    int b, rem, start, N, sample;
    if (u < 128) { sample = 1; b = u >> 5; rem = u & 31; start = NPROMPT + b * 1024; N = 1024; }
    else { sample = 0; b = (u - 128) >> 5; rem = (u - 128) & 31; start = b * 256; N = 256; }
    const int h = rem >> 2, d = (rem >> 1) & 1, vs = rem & 1;
    const int nc = N >> 5;
    f32x4 S[2][2];
#pragma unroll
    for (int mi = 0; mi < 2; ++mi)
#pragma unroll
      for (int ni = 0; ni < 2; ++ni) {
        f32x4 s4 = f32x4{0.f, 0.f, 0.f, 0.f};
        if (sample) {
          const float* s0 = p.in[2] + ((size_t)((b * 2 + d) * 8 + h)) * 16384;
#pragma unroll
          for (int j = 0; j < 4; ++j) s4[j] = s0[(wk * 32 + mi * 16 + fq * 4 + j) * 128 + vs * 64 + wv * 32 + ni * 16 + fr];
        }
        S[mi][ni] = s4;
        *(uint2*)&s_S[(wv * 32 + ni * 16 + fr) * 136 + wk * 32 + mi * 16 + fq * 4] = pack4(s4[0], s4[1], s4[2], s4[3]);
      }
    _Float16 lfraw[8]; u16 qraw[8]; uint2 vraw;
#define GLA_LOAD(cc) do { _Pragma("unroll") for (int i = 0; i < 8; ++i) { const int tt = (cc) * 32 + th * 8 + i; const size_t tok = start + (d ? (N - 1 - tt) : tt); \
      lfraw[i] = lfg[tok * 2048 + d * 1024 + h * 128 + kk]; qraw[i] = qg[tok * 1024 + h * 128 + kk]; } \
      { const int tt = (cc) * 32 + (tid >> 4); const size_t tok = start + (d ? (N - 1 - tt) : tt); vraw = *(const uint2*)&vg[tok * 1024 + h * 128 + vs * 64 + (tid & 15) * 4]; } } while (0)
    GLA_LOAD(0);
    for (int c = 0; c < nc; ++c) {
      {
        float lfv[8], qv[8];
#pragma unroll
        for (int i = 0; i < 8; ++i) { lfv[i] = (float)lfraw[i]; qv[i] = bf2f(qraw[i]); }
        const uint2 vv = vraw;
        if (c + 1 < nc) GLA_LOAD(c + 1);
        float run = 0;
        float cs[8];
#pragma unroll
        for (int i = 0; i < 8; ++i) { run += lfv[i]; cs[i] = run; }
        s_part[th * 128 + kk] = run;
        {
          const int s = tid >> 4, v4 = (tid & 15) * 4;
          s_vT[(v4 + 0) * 40 + s] = (u16)(vv.x & 0xffff); s_vT[(v4 + 1) * 40 + s] = (u16)(vv.x >> 16);
          s_vT[(v4 + 2) * 40 + s] = (u16)(vv.y & 0xffff); s_vT[(v4 + 3) * 40 + s] = (u16)(vv.y >> 16);
        }
        __syncthreads();
        const float p0 = s_part[kk], p1 = s_part[128 + kk], p2 = s_part[256 + kk], p3 = s_part[384 + kk];
        const float off = (th > 0 ? p0 : 0.f) + (th > 1 ? p1 : 0.f) + (th > 2 ? p2 : 0.f);
        const float ref = p0 + p1, total = p0 + p1 + p2 + p3;
        unsigned kd[4];
#pragma unroll
        for (int i = 0; i < 8; ++i) {
          const int t = th * 8 + i;
          const float cum = off + cs[i];
          const float kf = 1.0f - __expf(lfv[i]);
          s_qrel[t * 136 + kk] = f2bf(qv[i] * __expf(cum - ref));
          s_krel[t * 136 + kk] = f2bf(kf * __expf(ref - cum));
          s_qcum[t * 136 + kk] = f2bf(qv[i] * __expf(cum));
          const u16 kdv = f2bf(kf * __expf(total - cum));
          if (i & 1) kd[i >> 1] |= ((unsigned)kdv) << 16; else kd[i >> 1] = kdv;
        }
        *(uint4*)&s_kdT[kk * 40 + th * 8] = make_uint4(kd[0], kd[1], kd[2], kd[3]);
        if (th == 0) s_dec[kk] = __expf(total);
      }
      __syncthreads();
      f32x4 oacc = f32x4{0.f, 0.f, 0.f, 0.f};
      {
        f32x4 att = f32x4{0.f, 0.f, 0.f, 0.f};
        const int ati = w >> 1, asi = w & 1;
#pragma unroll
        for (int ks = 0; ks < 4; ++ks) {
          if (w < 4) {
            bf16x8 a = *(const bf16x8*)&s_qrel[(ati * 16 + fr) * 136 + ks * 32 + fq * 8];
            bf16x8 bb = *(const bf16x8*)&s_krel[(asi * 16 + fr) * 136 + ks * 32 + fq * 8];
            att = __builtin_amdgcn_mfma_f32_16x16x32_bf16(a, bb, att, 0, 0, 0);
          }
          bf16x8 a2 = *(const bf16x8*)&s_qcum[(ti * 16 + fr) * 136 + ks * 32 + fq * 8];
          bf16x8 b2 = *(const bf16x8*)&s_S[(vi * 16 + fr) * 136 + ks * 32 + fq * 8];
          oacc = __builtin_amdgcn_mfma_f32_16x16x32_bf16(a2, b2, oacc, 0, 0, 0);
        }
        if (w < 4) {
#pragma unroll
          for (int j = 0; j < 4; ++j) {
            const int t = ati * 16 + fq * 4 + j, s = asi * 16 + fr;
            s_att[t * 40 + s] = (s <= t) ? f2bf(att[j]) : (u16)0;
          }
        }
      }
      __syncthreads();
      {
        bf16x8 a = *(const bf16x8*)&s_att[(ti * 16 + fr) * 40 + fq * 8];
        bf16x8 bb = *(const bf16x8*)&s_vT[(vi * 16 + fr) * 40 + fq * 8];
        oacc = __builtin_amdgcn_mfma_f32_16x16x32_bf16(a, bb, oacc, 0, 0, 0);
#pragma unroll
        for (int j = 0; j < 4; ++j) {
          const int tt = c * 32 + ti * 16 + fq * 4 + j;
          const size_t tok = start + (d ? (N - 1 - tt) : tt);
          og[((size_t)d * TOK + tok) * 1024 + h * 128 + vs * 64 + vi * 16 + fr] = f2bf(oacc[j]);
        }
        bf16x8 vf[2];
#pragma unroll
        for (int ni = 0; ni < 2; ++ni) vf[ni] = *(const bf16x8*)&s_vT[(wv * 32 + ni * 16 + fr) * 40 + fq * 8];
#pragma unroll
        for (int mi = 0; mi < 2; ++mi) {
          bf16x8 kf = *(const bf16x8*)&s_kdT[(wk * 32 + mi * 16 + fr) * 40 + fq * 8];
          f32x4 dc = *(const f32x4*)&s_dec[wk * 32 + mi * 16 + fq * 4];
#pragma unroll
          for (int ni = 0; ni < 2; ++ni) {
            f32x4 s4 = S[mi][ni];
#pragma unroll
            for (int j = 0; j < 4; ++j) s4[j] *= dc[j];
            s4 = __builtin_amdgcn_mfma_f32_16x16x32_bf16(kf, vf[ni], s4, 0, 0, 0);
            S[mi][ni] = s4;
            *(uint2*)&s_S[(wv * 32 + ni * 16 + fr) * 136 + wk * 32 + mi * 16 + fq * 4] = pack4(s4[0], s4[1], s4[2], s4[3]);
          }
        }
      }
      __syncthreads();
    }
    if (!sample) {
      float* so = p.out + OUT_HG + ((size_t)((b * 2 + d) * 8 + h)) * 16384;
#pragma unroll
      for (int mi = 0; mi < 2; ++mi)
#pragma unroll
        for (int ni = 0; ni < 2; ++ni)
#pragma unroll
          for (int j = 0; j < 4; ++j) so[(wk * 32 + mi * 16 + fq * 4 + j) * 128 + vs * 64 + wv * 32 + ni * 16 + fr] = S[mi][ni][j];
    }
  }
}

__device__ __forceinline__ void phase_hg_post(const Params& p, int bid, int nb) {
  const u16* og = (const u16*)(p.ws + WS_B(5));
  const u16* sg = (const u16*)(p.ws + WS_B(2));
  u16* a = (u16*)(p.ws + WS_B(0));
  const float* ng = p.in[14];
  const int lane = threadIdx.x & 63, wave = threadIdx.x >> 6;
  for (int row = bid * NW + wave; row < TOK; row += nb * NW) {
    const size_t base = (size_t)row * 1024 + lane * 16;
    float o[16];
    float ss = 0;
#pragma unroll
    for (int hh = 0; hh < 2; ++hh) {
      uint4 f = *(const uint4*)&og[base + hh * 8];
      uint4 bw = *(const uint4*)&og[(size_t)TOK * 1024 + base + hh * 8];
      unsigned fa[4] = {f.x, f.y, f.z, f.w}, ba[4] = {bw.x, bw.y, bw.z, bw.w};
#pragma unroll
      for (int i = 0; i < 4; ++i) {
        o[hh * 8 + 2 * i] = lo16(fa[i]) + lo16(ba[i]);
        o[hh * 8 + 2 * i + 1] = hi16(fa[i]) + hi16(ba[i]);
      }
    }
#pragma unroll
    for (int i = 0; i < 16; ++i) ss += o[i] * o[i];
    ss += __shfl_xor(ss, 1); ss += __shfl_xor(ss, 2); ss += __shfl_xor(ss, 4);
    const float rs = rsqrtf(ss * (1.0f / 128.0f) + 1e-6f);
#pragma unroll
    for (int hh = 0; hh < 2; ++hh) {
      uint4 s = *(const uint4*)&sg[base + hh * 8];
      unsigned sa[4] = {s.x, s.y, s.z, s.w};
      unsigned r[4];
#pragma unroll
      for (int i = 0; i < 4; ++i) {
        const int c = lane * 16 + hh * 8 + 2 * i;
        r[i] = pack2(o[hh * 8 + 2 * i] * rs * ng[c] * lo16(sa[i]), o[hh * 8 + 2 * i + 1] * rs * ng[c + 1] * hi16(sa[i]));
      }
      *(uint4*)&a[base + hh * 8] = make_uint4(r[0], r[1], r[2], r[3]);
    }
  }
}

__device__ __forceinline__ void seq_pos(int tok, int& n, int& L) {
  if (tok < NPROMPT) { n = tok & 255; L = 256; } else { n = (tok - NPROMPT) & 1023; L = 1024; }
}
__device__ __forceinline__ void phase_sc_conv(const Params& p, int bid, int nb) {
  const u16* pb = (const u16*)(p.ws + WS_B(0));
  const u16* sb = (const u16*)(p.ws + WS_B(1));
  u16* a = (u16*)(p.ws + WS_B(2));
  const float* cw = p.in[17]; const float* cbias = p.in[18];
  const size_t total = (size_t)TOK * 128;
  for (size_t i = (size_t)bid * NT + threadIdx.x; i < total; i += (size_t)nb * NT) {
    const int tok = (int)(i >> 7), c = ((int)i & 127) * 8;
    int n, L; seq_pos(tok, n, L);
    const size_t base = (size_t)tok * 1024 + c;
    uint4 z = make_uint4(0, 0, 0, 0);
    uint4 pm = n > 0 ? *(const uint4*)&pb[base - 1024] : z;
    uint4 p0 = *(const uint4*)&pb[base];
    uint4 pp = n < L - 1 ? *(const uint4*)&pb[base + 1024] : z;
    uint4 s = *(const uint4*)&sb[base];
    unsigned am[4] = {pm.x, pm.y, pm.z, pm.w}, a0[4] = {p0.x, p0.y, p0.z, p0.w}, ap[4] = {pp.x, pp.y, pp.z, pp.w}, as[4] = {s.x, s.y, s.z, s.w};
    unsigned r[4];
#pragma unroll
    for (int k = 0; k < 4; ++k) {
      const int c0 = c + 2 * k, c1 = c0 + 1;
      float z0 = cw[c0] * lo16(am[k]) + cw[1024 + c0] * lo16(a0[k]) + cw[2048 + c0] * lo16(ap[k]) + cbias[c0];
      float z1 = cw[c1] * hi16(am[k]) + cw[1024 + c1] * hi16(a0[k]) + cw[2048 + c1] * hi16(ap[k]) + cbias[c1];
      r[k] = pack2(lo16(as[k]) * z0, hi16(as[k]) * z1);
    }
    *(uint4*)&a[base] = make_uint4(r[0], r[1], r[2], r[3]);
  }
}
__device__ __forceinline__ void phase_rg_conv(const Params& p, int bid, int nb) {
  const u16* ub = (const u16*)(p.ws + WS_B(0));
  u16* uc = (u16*)(p.ws + WS_B(2));
  const float* cw = p.in[21]; const float* cbias = p.in[22];
  const size_t total = (size_t)TOK * 128;
  for (size_t i = (size_t)bid * NT + threadIdx.x; i < total; i += (size_t)nb * NT) {
    const int tok = (int)(i >> 7), c = ((int)i & 127) * 8;
    int n, L; seq_pos(tok, n, L);
    const size_t base = (size_t)tok * 1024 + c;
    uint4 z = make_uint4(0, 0, 0, 0);
    uint4 q0 = n > 1 ? *(const uint4*)&ub[base - 2048] : z;
    uint4 q1 = n > 0 ? *(const uint4*)&ub[base - 1024] : z;
    uint4 q2 = *(const uint4*)&ub[base];
    uint4 q3 = n < L - 1 ? *(const uint4*)&ub[base + 1024] : z;
    unsigned a0[4] = {q0.x, q0.y, q0.z, q0.w}, a1[4] = {q1.x, q1.y, q1.z, q1.w}, a2[4] = {q2.x, q2.y, q2.z, q2.w}, a3[4] = {q3.x, q3.y, q3.z, q3.w};
    unsigned r[4];
#pragma unroll
    for (int k = 0; k < 4; ++k) {
      const int c0 = c + 2 * k, c1 = c0 + 1;
      float z0 = cw[c0] * lo16(a0[k]) + cw[1024 + c0] * lo16(a1[k]) + cw[2048 + c0] * lo16(a2[k]) + cw[3072 + c0] * lo16(a3[k]) + cbias[c0];
      float z1 = cw[c1] * hi16(a0[k]) + cw[1024 + c1] * hi16(a1[k]) + cw[2048 + c1] * hi16(a2[k]) + cw[3072 + c1] * hi16(a3[k]) + cbias[c1];
      r[k] = pack2(z0, z1);
    }
    *(uint4*)&uc[base] = make_uint4(r[0], r[1], r[2], r[3]);
  }
}

__device__ __forceinline__ void phase_rg_scan(const Params& p, unsigned char* smem_raw, int bid, int nb) {
  float* sA = (float*)smem_raw;
  float* sB = sA + 2048;
  const u16* rb = (const u16*)(p.ws + WS_B(3));
  const u16* ib = (const u16*)(p.ws + WS_B(5));
  const u16* uc = (const u16*)(p.ws + WS_B(2));
  const u16* sg = (const u16*)(p.ws + WS_B(1));
  u16* hfw = (u16*)(p.ws + WS_H);
  u16* yp = (u16*)(p.ws + WS_B(0));
  const int tid = threadIdx.x;
  for (int u = bid; u < 768; u += nb) {
    int sample, b, c, seg, nseg, start, cl_;
    if (u < 256) { sample = 1; b = u >> 6; cl_ = tid & 15; c = (u & 63) * 16 + cl_; seg = tid >> 4; nseg = 32; start = NPROMPT + b * 1024; }
    else { sample = 0; b = (u - 256) >> 4; cl_ = tid & 63; c = ((u - 256) & 15) * 64 + cl_; seg = tid >> 6; nseg = 8; start = b * 256; }
    const int L = nseg * 32;
#pragma unroll 1
    for (int d = 0; d < 2; ++d) {
      const float lam = p.in[25][d * 1024 + c];
      const float cl = 8.0f * log1pf(__expf(-lam));
      const u16* rp = rb + (size_t)d * TOK * 1024;
      const u16* ip = ib + (size_t)d * TOK * 1024;
      const size_t o0 = (size_t)(start + (d ? L - 1 - seg * 32 : seg * 32)) * 1024 + c;
      const long ostep = d ? -1024 : 1024;
      float av[32], xv[32];
      float Aacc = 1.f, Bacc = 0.f;
#pragma unroll
      for (int s = 0; s < 32; ++s) {
        const size_t o = o0 + s * ostep;
        const float r = bf2f(rp[o]), ig = bf2f(ip[o]), uu = bf2f(uc[o]);
        const float la = -cl * r;
        const float a = __expf(la);
        const float xin = __builtin_amdgcn_sqrtf(fmaxf(1.0f - __expf(2.0f * la), 0.f)) * (ig * uu);
        av[s] = a; xv[s] = xin;
      }
#pragma unroll
      for (int s = 0; s < 32; ++s) { Aacc *= av[s]; Bacc = av[s] * Bacc + xv[s]; }
      sA[seg * 64 + cl_] = Aacc; sB[seg * 64 + cl_] = Bacc;
      __syncthreads();
      float h = sample ? p.in[3][(b * 2 + d) * 1024 + c] : 0.f;
      for (int s2 = 0; s2 < seg; ++s2) h = sA[s2 * 64 + cl_] * h + sB[s2 * 64 + cl_];
      if (d == 0) {
#pragma unroll
        for (int s = 0; s < 32; ++s) { h = av[s] * h + xv[s]; hfw[o0 + s * ostep] = f2bf(h); }
      } else {
        float hf[32], sgv[32];
#pragma unroll
        for (int s = 0; s < 32; ++s) { const size_t o = o0 + s * ostep; hf[s] = bf2f(hfw[o]); sgv[s] = bf2f(sg[o]); }
#pragma unroll
        for (int s = 0; s < 32; ++s) { h = av[s] * h + xv[s]; yp[o0 + s * ostep] = f2bf((hf[s] + h) * sgv[s]); }
      }
      if (!sample && seg == nseg - 1) p.out[OUT_RG + (b * 2 + d) * 1024 + c] = h;
      __syncthreads();
    }
  }
}

__device__ __forceinline__ void phase_mla_norm(const Params& p, int bid, int nb) {
  u16* cq = (u16*)(p.ws + WS3_CQ);
  u16* ckvall = (u16*)(p.ws + WS3_CKVALL);
  const float* ckvraw = (const float*)(p.ws + WS3_CKVRAW);
  const float* kperaw = (const float*)(p.ws + WS3_KPERAW);
  u16* Kb = (u16*)(p.ws + WS3_K);
  const float* qn = p.in[28]; const float* kvn = p.in[29];
  const int lane = threadIdx.x & 63, wave = threadIdx.x >> 6;
  for (int row = bid * NW + wave; row < TOK + 2048; row += nb * NW) {
    if (row < TOK) {
      const int tok = row;
      const bool sample = tok >= NPROMPT;
      const int bs = (tok - NPROMPT) >> 10, n = (tok - NPROMPT) & 1023;
      const size_t kvrow = sample ? (size_t)(NPROMPT + bs * 1536 + 512 + n) : (size_t)tok;
      unsigned* cqr = (unsigned*)&cq[(size_t)tok * 384];
      unsigned cv[3]; float ss = 0;
#pragma unroll
      for (int i = 0; i < 3; ++i) { cv[i] = cqr[i * 64 + lane]; float a = lo16(cv[i]), b2 = hi16(cv[i]); ss += a * a + b2 * b2; }
      const float rsq = rsqrtf(wave_sum(ss) * (1.0f / 384.0f) + 1e-6f);
#pragma unroll
      for (int i = 0; i < 3; ++i) {
        const int k = (i * 64 + lane) * 2;
        cqr[i * 64 + lane] = pack2(lo16(cv[i]) * rsq * qn[k], hi16(cv[i]) * rsq * qn[k + 1]);
      }
      f32x4 kv = *(const f32x4*)&ckvraw[(size_t)tok * 256 + lane * 4];
      const float rsk = rsqrtf(wave_sum(kv[0] * kv[0] + kv[1] * kv[1] + kv[2] * kv[2] + kv[3] * kv[3]) * (1.0f / 256.0f) + 1e-6f);
      f32x4 g4 = *(const f32x4*)&kvn[lane * 4];
      f32x4 o4;
#pragma unroll
      for (int j = 0; j < 4; ++j) o4[j] = kv[j] * rsk * g4[j];
      *(uint2*)&ckvall[kvrow * 256 + lane * 4] = pack4(o4[0], o4[1], o4[2], o4[3]);
      if (!sample) *(f32x4*)&p.out[OUT_CKV + (size_t)tok * 256 + lane * 4] = o4;
      float v = kperaw[(size_t)tok * 32 + (lane & 31)];
      if (!sample) { if (lane < 32) p.out[OUT_KPE + (size_t)tok * 32 + lane] = v; }
      else {
        const float partner = __shfl_xor(v, 8);
        const int i16 = lane & 15;
        const float pos = (lane & 16) ? (float)(n & 63) : (float)(n >> 6);
        float sn, cs; rope_sincos(pos, i16 & 7, sn, cs);
        v = (i16 < 8) ? (v * cs - partner * sn) : (partner * sn + v * cs);
      }
      const u16 vb = f2bf(v);
#pragma unroll
      for (int i = 0; i < 8; ++i) Kb[(kvrow * 16 + (lane >> 5) + 2 * i) * 96 + 64 + (lane & 31)] = vb;
    } else {
      const int r = row - TOK, bs = r >> 9, j = r & 511;
      const size_t kvrow = (size_t)(NPROMPT + bs * 1536 + j);
      f32x4 kv = *(const f32x4*)&p.in[4][(size_t)r * 256 + lane * 4];
      *(uint2*)&ckvall[kvrow * 256 + lane * 4] = pack4(kv[0], kv[1], kv[2], kv[3]);
      const u16 vb = f2bf(p.in[5][(size_t)r * 32 + (lane & 31)]);
#pragma unroll
      for (int i = 0; i < 8; ++i) Kb[(kvrow * 16 + (lane >> 5) + 2 * i) * 96 + 64 + (lane & 31)] = vb;
    }
  }
}

__device__ __forceinline__ void phase_attn(const Params& p, unsigned char* smem_raw, int bid, int nb) {
  u16* sK = (u16*)smem_raw;
  u16* sV = sK + 64 * 104;
  const u16* qg = (const u16*)(p.ws + WS3_Q);
  const u16* Kg = (const u16*)(p.ws + WS3_K);
  const u16* Vg = (const u16*)(p.ws + WS3_VT);
  const u16* sg = (const u16*)(p.ws + WS3_SG);
  u16* ao = (u16*)(p.ws + WS_H);
  const int tid = threadIdx.x, lane = tid & 63, w = tid >> 6, fr = lane & 15, fq = lane >> 4;
  for (int u = bid; u < 1536; u += nb) {
    int tok0, kvbase, nkeys, h;
    if (u < 512) { const int b = u >> 7, r = u & 127; h = r >> 3; const int qb = r & 7; tok0 = NPROMPT + b * 1024 + qb * 128; kvbase = NPROMPT + b * 1536; nkeys = 1536; }
    else { const int uu = u - 512; const int b = uu >> 5, r = uu & 31; h = r >> 1; const int qb = r & 1; tok0 = b * 256 + qb * 128; kvbase = b * 256; nkeys = 256; }
    const int tokq = tok0 + w * 16 + fr;
    bf16x8 qf[3];
#pragma unroll
    for (int ks = 0; ks < 3; ++ks) qf[ks] = *(const bf16x8*)&qg[(size_t)tokq * 1536 + h * 96 + ks * 32 + fq * 8];
    if (u < 512) {
      const int npos = (tokq - NPROMPT) & 1023;
      const float pos = (fq & 2) ? (float)(npos & 63) : (float)(npos >> 6);
      uint4 raw = *(uint4*)&qf[2];
      unsigned rw[4] = {raw.x, raw.y, raw.z, raw.w};
#pragma unroll
      for (int i = 0; i < 4; ++i) {
        float v0 = lo16(rw[i]), v1 = hi16(rw[i]);
        const float p0 = __shfl_xor(v0, 16), p1 = __shfl_xor(v1, 16);
        float sn0, cs0, sn1, cs1;
        rope_sincos(pos, 2 * i, sn0, cs0); rope_sincos(pos, 2 * i + 1, sn1, cs1);
        v0 = (fq & 1) ? (p0 * sn0 + v0 * cs0) : (v0 * cs0 - p0 * sn0);
        v1 = (fq & 1) ? (p1 * sn1 + v1 * cs1) : (v1 * cs1 - p1 * sn1);
        rw[i] = pack2(v0, v1);
      }
      raw = make_uint4(rw[0], rw[1], rw[2], rw[3]);
      qf[2] = *(bf16x8*)&raw;
    }
    float m = -1e30f, l = 0.f;
    f32x4 oacc[4];
#pragma unroll
    for (int i = 0; i < 4; ++i) oacc[i] = f32x4{0.f, 0.f, 0.f, 0.f};
    const int ntile = nkeys >> 6;
    const int k0key = tid / 12, k0ch = tid - k0key * 12;
    const int k1key = (tid + NT) / 12, k1ch = (tid + NT) - k1key * 12;
    const int vdv = tid >> 3, vch = tid & 7;
    const u16* Kp0 = &Kg[((size_t)(kvbase + k0key) * 16 + h) * 96 + k0ch * 8];
    const u16* Kp1 = &Kg[((size_t)(kvbase + k1key) * 16 + h) * 96 + k1ch * 8];
    const u16* Vp = &Vg[(size_t)(h * 64 + vdv) * KVROWS + kvbase + vch * 8];
    uint4 kr0 = *(const uint4*)Kp0, kr1 = make_uint4(0, 0, 0, 0), vr = *(const uint4*)Vp;
    if (tid < 256) kr1 = *(const uint4*)Kp1;
    for (int kt = 0; kt < ntile; ++kt) {
      __syncthreads();
      *(uint4*)&sK[k0key * 104 + k0ch * 8] = kr0;
      if (tid < 256) *(uint4*)&sK[k1key * 104 + k1ch * 8] = kr1;
      *(uint4*)&sV[vdv * 72 + vch * 8] = vr;
      if (kt + 1 < ntile) {
        kr0 = *(const uint4*)(Kp0 + (size_t)(kt + 1) * 64 * 1536);
        if (tid < 256) kr1 = *(const uint4*)(Kp1 + (size_t)(kt + 1) * 64 * 1536);
        vr = *(const uint4*)(Vp + (kt + 1) * 64);
      }
      __syncthreads();
      f32x4 sacc[4];
#pragma unroll
      for (int ni = 0; ni < 4; ++ni) {
        sacc[ni] = f32x4{0.f, 0.f, 0.f, 0.f};
#pragma unroll
        for (int ks = 0; ks < 3; ++ks) {
          bf16x8 kf = *(const bf16x8*)&sK[(ni * 16 + fr) * 104 + ks * 32 + fq * 8];
          sacc[ni] = __builtin_amdgcn_mfma_f32_16x16x32_bf16(kf, qf[ks], sacc[ni], 0, 0, 0);
        }
      }
      float mx = -1e30f;
#pragma unroll
      for (int ni = 0; ni < 4; ++ni)
#pragma unroll
        for (int j = 0; j < 4; ++j) mx = fmaxf(mx, sacc[ni][j]);
      mx = fmaxf(mx, __shfl_xor(mx, 16));
      mx = fmaxf(mx, __shfl_xor(mx, 32));
      const float mnew = fmaxf(m, mx);
      const float alpha = __expf(m - mnew);
      m = mnew;
      float ls = 0.f;
#pragma unroll
      for (int ni = 0; ni < 4; ++ni)
#pragma unroll
        for (int j = 0; j < 4; ++j) { float e = __expf(sacc[ni][j] - mnew); sacc[ni][j] = e; ls += e; }
      l = l * alpha + ls;
      bf16x8 pf[2];
#pragma unroll
      for (int kk2 = 0; kk2 < 2; ++kk2) {
        uint2 lo = pack4(sacc[2 * kk2][0], sacc[2 * kk2][1], sacc[2 * kk2][2], sacc[2 * kk2][3]);
        uint2 hi = pack4(sacc[2 * kk2 + 1][0], sacc[2 * kk2 + 1][1], sacc[2 * kk2 + 1][2], sacc[2 * kk2 + 1][3]);
        uint4 pk = make_uint4(lo.x, lo.y, hi.x, hi.y);
        pf[kk2] = *(bf16x8*)&pk;
      }
#pragma unroll
      for (int di = 0; di < 4; ++di) {
#pragma unroll
        for (int j = 0; j < 4; ++j) oacc[di][j] *= alpha;
#pragma unroll
        for (int kk2 = 0; kk2 < 2; ++kk2) {
          uint2 v0 = *(const uint2*)&sV[(di * 16 + fr) * 72 + kk2 * 32 + fq * 4];
          uint2 v1 = *(const uint2*)&sV[(di * 16 + fr) * 72 + kk2 * 32 + 16 + fq * 4];
          uint4 vk = make_uint4(v0.x, v0.y, v1.x, v1.y);
          oacc[di] = __builtin_amdgcn_mfma_f32_16x16x32_bf16(*(bf16x8*)&vk, pf[kk2], oacc[di], 0, 0, 0);
        }
      }
    }
    l += __shfl_xor(l, 16);
    l += __shfl_xor(l, 32);
    const float inv = 1.0f / l;
#pragma unroll
    for (int di = 0; di < 4; ++di) {
      const size_t o = (size_t)tokq * 1024 + h * 64 + di * 16 + fq * 4;
      uint2 s = *(const uint2*)&sg[o];
      *(uint2*)&ao[o] = pack4(oacc[di][0] * inv * lo16(s.x), oacc[di][1] * inv * hi16(s.x), oacc[di][2] * inv * lo16(s.y), oacc[di][3] * inv * hi16(s.y));
    }
  }
}

#define XB_TMO      128
#define XB_XCNT(j)  (256  + 64 * (j))
#define XB_XSUB(j)  (1280 + 64 * (j))
#define XB_XGEN(j)  (2304 + 64 * (j))
#define XB_TOP      3328
#define XB_TOPGEN   3392
#define XCD_BAR_WORDS 3456
#define XB_SPIN_CAP (1u << 22)
__device__ __forceinline__ unsigned xb_ld(unsigned* p)              { return __hip_atomic_load(p, __ATOMIC_RELAXED, __HIP_MEMORY_SCOPE_AGENT); }
__device__ __forceinline__ unsigned xb_add(unsigned* p, unsigned v) { return __hip_atomic_fetch_add(p, v, __ATOMIC_RELAXED, __HIP_MEMORY_SCOPE_AGENT); }
__device__ __forceinline__ unsigned xb_xcc_id() { return (unsigned)__builtin_amdgcn_s_getreg((3 << 11) | 20) & 0xFu; }
#define XB_SPIN(cond, bar) do { unsigned _sp = 0; while (cond) { __builtin_amdgcn_s_sleep(1); \
    if ((++_sp & 255u) == 0u) { if (xb_ld(&(bar)[XB_TMO])) break; if (_sp > XB_SPIN_CAP) { atomicAdd(&(bar)[XB_TMO], 1u); break; } } } } while (0)
struct XcdBarrier { unsigned* bar; unsigned x; volatile LAS unsigned* st; };
__device__ __forceinline__ XcdBarrier xcd_barrier_post(unsigned* bar, volatile LAS unsigned* st) {
  XcdBarrier b; b.bar = bar; b.x = xb_xcc_id(); b.st = st;
  if (threadIdx.x == 0) (void)xb_add(&bar[XB_XCNT(b.x)], 1u);
  return b;
}
__device__ __forceinline__ void xcd_barrier_complete(unsigned* bar, unsigned x, unsigned& nloc, unsigned& nx) {
  const unsigned G = gridDim.x * gridDim.y * gridDim.z;
  unsigned sum, cnt, mine, sp = 0u;
  for (;;) {
    sum = 0u; cnt = 0u; mine = 0u;
#pragma unroll
    for (unsigned j = 0; j < 16; ++j) { const unsigned c = xb_ld(&bar[XB_XCNT(j)]); sum += c; cnt += (c > 0u) ? 1u : 0u; mine = (j == x) ? c : mine; }
    if (sum == G) break;
    __builtin_amdgcn_s_sleep(1);
    if ((++sp & 255u) == 0u) { if (xb_ld(&bar[XB_TMO])) break; if (sp > XB_SPIN_CAP) { atomicAdd(&bar[XB_TMO], 1u); break; } }
  }
  nloc = mine > 0u ? mine : 1u; nx = cnt > 0u ? cnt : 1u;
}
__device__ __forceinline__ void xcd_barrier(const XcdBarrier& b) {
  asm volatile("s_waitcnt vmcnt(0)" ::: "memory");
  __syncthreads();
  if (threadIdx.x == 0) {
    unsigned* bar = b.bar;
    __builtin_amdgcn_s_waitcnt(0);
    unsigned nloc = b.st[0], nx = b.st[1];
    if (nloc == 0u) { xcd_barrier_complete(bar, b.x, nloc, nx); b.st[0] = nloc; b.st[1] = nx; }
    const unsigned old = xb_add(&bar[XB_XSUB(b.x)], 1u);
    const unsigned gen = old / nloc;
    if (old + 1u == (gen + 1u) * nloc) {
      __builtin_amdgcn_fence(__ATOMIC_RELEASE, "agent");
      asm volatile("s_waitcnt vmcnt(0)" ::: "memory");
      const unsigned og = xb_add(&bar[XB_TOP], 1u);
      const unsigned tg = og / nx;
      if (og + 1u == (tg + 1u) * nx) xb_add(&bar[XB_TOPGEN], 1u);
      else XB_SPIN(xb_ld(&bar[XB_TOPGEN]) == tg, bar);
      __builtin_amdgcn_fence(__ATOMIC_ACQUIRE, "agent");
      xb_add(&bar[XB_XGEN(b.x)], 1u);
      asm volatile("s_waitcnt vmcnt(0)" ::: "memory");
    } else {
      XB_SPIN(xb_ld(&bar[XB_XGEN(b.x)]) == gen, bar);
      __builtin_amdgcn_fence(__ATOMIC_ACQUIRE, "agent");
      asm volatile("s_waitcnt vmcnt(0)" ::: "memory");
    }
  }
  __syncthreads();
}

#define GEMM_LDS 131072
#define DYN_LDS (GEMM_LDS + 16)
#define WS_BAR (WS_CNT + 4096ull)

#define RUN_GEMM(Aptr, LDA, Bptr, MM, NN, KK, GATE, EPI, CID) do { pg8::Gemm g_{(const u16*)(Aptr), (const u16*)(Bptr), MM, NN, KK, LDA, GATE}; \
    pg8::StaticOrder S_; S_.init(MM, NN, nb, CID); pg8::gemm_phase((LAS unsigned char*)smem_raw, g_, S_, EPI); } while (0)

__global__ void __launch_bounds__(NT, 2) mega(Params p) {
  extern __shared__ __attribute__((aligned(16))) unsigned char smem_raw[];
  const int bid = blockIdx.x, nb = gridDim.x;
  unsigned char* ws = p.ws;
  const float* mod = (const float*)(ws + WS_MOD);
  volatile LAS unsigned* xst = (volatile LAS unsigned*)((LAS unsigned char*)smem_raw + GEMM_LDS);
  XcdBarrier xb;
  if (p.phase_hi - p.phase_lo > 1) {
    if (threadIdx.x == 0) { xst[0] = 0u; xst[1] = 0u; }
    __syncthreads();
    xb = xcd_barrier_post((unsigned*)(ws + WS_BAR), xst);
  }
#define PH_BEGIN(n) if ((PHMASK & (1u << n)) && p.phase_lo <= n && n < p.phase_hi) { const int ph = n;
#define PH_FIN if (ph + 1 < p.phase_hi) { if (p.phase_lo < 0) cg::this_grid().sync(); else xcd_barrier(xb); } }
  PH_BEGIN(0) phase_prologue(p, smem_raw, bid, nb); PH_FIN
  PH_BEGIN(1) phase_h0(p, bid, nb); PH_FIN
  PH_BEGIN(2) {
    EpiHgIn e{(u16*)(ws + WS_B(0)), (u16*)(ws + WS_B(1)), (u16*)(ws + WS_B(2)), (_Float16*)(ws + WS_B(3)), (const float*)(ws + WS_LB)};
    RUN_GEMM(ws + WS_H, 1024, ws + WS_W_HG_IN, TOK, 5120, 1024, 0, e, bid);
  } PH_FIN
  PH_BEGIN(3) phase_gla(p, smem_raw); PH_FIN
  PH_BEGIN(4) phase_hg_post(p, bid, nb); PH_FIN
  PH_BEGIN(5) {
    EpiRes e{p.in[0], p.in[1], p.out, mod + 0 * 15360 + 2048};
    RUN_GEMM(ws + WS_B(0), 1024, ws + WS_W_HG_OUT, TOK, 1024, 1024, 0, e, bid);
  } PH_FIN
  PH_BEGIN(6) phase_ln(p, 0, bid, nb); PH_FIN
  PH_BEGIN(7) {
    EpiScIn e{(u16*)(ws + WS_B(0)), (u16*)(ws + WS_B(1))};
    RUN_GEMM(ws + WS_H, 1024, ws + WS_W_SC_IN, TOK, 4096, 1024, 0, e, bid);
  } PH_FIN
  PH_BEGIN(8) phase_sc_conv(p, bid, nb); PH_FIN
  PH_BEGIN(9) {
    EpiRes e{p.out, p.out + (size_t)NPROMPT * 1024, p.out, mod + 1 * 15360 + 2048};
    RUN_GEMM(ws + WS_B(2), 1024, ws + WS_W_SC_OUT, TOK, 1024, 1024, 0, e, bid);
  } PH_FIN
  PH_BEGIN(10) phase_ln(p, 1, bid, nb); PH_FIN
  PH_BEGIN(11) {
    EpiRgIn e{(u16*)(ws + WS_B(0)), (u16*)(ws + WS_B(1))};
    RUN_GEMM(ws + WS_H, 1024, ws + WS_W_RG_IN, TOK, 2048, 1024, 0, e, bid);
  } PH_FIN
  PH_BEGIN(12) phase_rg_conv(p, bid, nb); PH_FIN
  PH_BEGIN(13) {
    EpiRgGate e{(u16*)(ws + WS_B(3)), (u16*)(ws + WS_B(5)), p.in[24]};
    RUN_GEMM(ws + WS_B(2), 1024, ws + WS_W_RG_GATE, TOK, 4096, 256, 1, e, bid);
  } PH_FIN
  PH_BEGIN(14) phase_rg_scan(p, smem_raw, bid, nb); PH_FIN
  PH_BEGIN(15) {
    EpiRes e{p.out, p.out + (size_t)NPROMPT * 1024, p.out, mod + 2 * 15360 + 2048};
    RUN_GEMM(ws + WS_B(0), 1024, ws + WS_W_RG_OUT, TOK, 1024, 1024, 0, e, bid);
  } PH_FIN
  PH_BEGIN(16) phase_ln(p, 2, bid, nb); PH_FIN
  PH_BEGIN(17) {
    EpiMlaIn e{(u16*)(ws + WS3_CQ), (float*)(ws + WS3_CKVRAW), (float*)(ws + WS3_KPERAW), (u16*)(ws + WS3_SG)};
    RUN_GEMM(ws + WS_H, 1024, ws + WS_W_MLA_IN, TOK, 1792, 1024, 0, e, bid);
  } PH_FIN
  PH_BEGIN(18) phase_mla_norm(p, bid, nb); PH_FIN
  PH_BEGIN(19) {
    EpiQ eq{(u16*)(ws + WS3_Q)};
    RUN_GEMM(ws + WS3_CQ, 384, ws + WS_W_QB, TOK, 1536, 384, 0, eq, bid);
    EpiKV ek{(u16*)(ws + WS3_K), (u16*)(ws + WS3_VT)};
    RUN_GEMM(ws + WS3_CKVALL, 256, ws + WS_W_KVB, KVROWS, 2048, 256, 0, ek, nb - 1 - bid);
  } PH_FIN
  PH_BEGIN(20) phase_attn(p, smem_raw, bid, nb); PH_FIN
  PH_BEGIN(21) {
    EpiRes e{p.out, p.out + (size_t)NPROMPT * 1024, p.out, mod + 3 * 15360 + 2048};
    RUN_GEMM(ws + WS_H, 1024, ws + WS_W_MLA_OUT, TOK, 1024, 1024, 0, e, bid);
  } PH_FIN
  PH_BEGIN(22) phase_ln(p, 3, bid, nb); PH_FIN
}

extern "C" void kernel_launch(void* const* d_in, const int* in_sizes, int n_in, void* d_out, int out_size, void* d_ws, size_t ws_size,
                              hipStream_t stream) {
  static int grid_blocks = 0;
  if (!grid_blocks) {
    int dev = 0, cus = 0, per_cu = 0;
    (void)hipGetDevice(&dev);
    (void)hipDeviceGetAttribute(&cus, hipDeviceAttributeMultiprocessorCount, dev);
    (void)hipFuncSetAttribute((const void*)mega, hipFuncAttributeMaxDynamicSharedMemorySize, DYN_LDS);
    (void)hipOccupancyMaxActiveBlocksPerMultiprocessor(&per_cu, (const void*)mega, NT, DYN_LDS);
    if (per_cu < 1) per_cu = 1;
    if (per_cu > 1) per_cu = 1;
    grid_blocks = cus * per_cu;
  }
  Params p{};
  for (int i = 0; i < 33; ++i) p.in[i] = (const float*)d_in[i];
  p.out = (float*)d_out;
  p.ws = (unsigned char*)d_ws;
#if MULTI_LAUNCH
  for (int ph = 0; ph < NPHASES; ++ph) {
    p.phase_lo = ph; p.phase_hi = ph + 1;
    hipLaunchKernelGGL(mega, dim3(grid_blocks), dim3(NT), DYN_LDS, stream, p);
#ifdef PROBE_MASK
    if ((PROBE_MASK >> ph) & 1) for (int r = 0; r < 2; ++r) {
      if (ph == 3) (void)hipMemsetAsync((unsigned char*)d_ws + WS_CNT, 0, 64, stream);
      hipLaunchKernelGGL(mega, dim3(grid_blocks), dim3(NT), DYN_LDS, stream, p);
    }
#endif
  }
#else
  p.phase_lo = 0; p.phase_hi = NPHASES;
  (void)hipMemsetAsync((unsigned char*)d_ws + WS_CNT, 0, 4096 + XCD_BAR_WORDS * 4, stream);
  void* args[] = {&p};
  hipError_t e = hipLaunchCooperativeKernel((const void*)mega, dim3(grid_blocks), dim3(NT), args, DYN_LDS, stream);
  if (e != hipSuccess) fprintf(stderr, "cooperative launch failed: %s (grid %d)\n", hipGetErrorString(e), grid_blocks);
#endif
}
```

```cpp
#include <hip/hip_runtime.h>
#include <hip/hip_cooperative_groups.h>
#include <cstdio>
namespace cg = cooperative_groups;

#ifndef MULTI_LAUNCH
#define MULTI_LAUNCH 0
#endif

typedef unsigned short u16;
using bf16x8 = __attribute__((ext_vector_type(8))) short;
using f32x4 = __attribute__((ext_vector_type(4))) float;
typedef _Float16 h4 __attribute__((ext_vector_type(4)));

#define TOK 12288
#define NPROMPT 8192
#define KVROWS 14336
#define NPHASES 23
#ifndef PHMASK
#define PHMASK 0x7fffff
#endif
#define DN_ALPHA 1.6817928305074290f

#define WS_W_HG_IN 0ull
#define WS_W_HG_OUT (WS_W_HG_IN + 10485760ull)
#define WS_W_SC_IN (WS_W_HG_OUT + 2097152ull)
#define WS_W_SC_OUT (WS_W_SC_IN + 8388608ull)
#define WS_W_RG_IN (WS_W_SC_OUT + 2097152ull)
#define WS_W_RG_GATE (WS_W_RG_IN + 4194304ull)
#define WS_W_RG_OUT (WS_W_RG_GATE + 2097152ull)
#define WS_W_MLA_IN (WS_W_RG_OUT + 2097152ull)
#define WS_W_QB (WS_W_MLA_IN + 3670016ull)
#define WS_W_KVB (WS_W_QB + 1179648ull)
#define WS_W_MLA_OUT (WS_W_KVB + 1048576ull)
#define WS_MOD (WS_W_MLA_OUT + 2097152ull)
#define WS_LB (WS_MOD + 245760ull)
#define WS_CNT (WS_LB + 8192ull)
#define WS_R (WS_CNT + 4096ull + 16384ull)
#define BSZ 25165824ull
#define WS_H (WS_R)
#define WS_B(i) (WS_R + BSZ * (1 + (i)))
#define WS_SLOT (WS_R + 201326592ull)
#define WS3_CQ (WS_R + 25165824ull)
#define WS3_CKVALL (WS_R + 34603008ull)
#define WS3_CKVRAW (WS_R + 41943040ull)
#define WS3_KPERAW (WS_R + 54525952ull)
#define WS3_SG (WS_R + 56098816ull)
#define WS3_Q (WS_R + 81264640ull)
#define WS3_K (WS_R + 119013376ull)
#define WS3_VT (WS_R + 163053568ull)

#define OUT_HG 12582912
#define OUT_RG 20971520
#define OUT_CKV 21037056
#define OUT_KPE 23134208

struct Params {
  const float* in[33];
  float* out;
  unsigned char* ws;
  int phase_lo, phase_hi;
};

__device__ __forceinline__ u16 f2bf(float f) { __bf16 r = (__bf16)f; return *(u16*)&r; }
__device__ __forceinline__ float bf2f(u16 h) { return __uint_as_float(((unsigned)h) << 16); }
typedef float f2v_ __attribute__((ext_vector_type(2)));
typedef __bf16 b2v_ __attribute__((ext_vector_type(2)));
__device__ __forceinline__ unsigned pack2(float a, float b) { f2v_ f = {a, b}; b2v_ r = __builtin_convertvector(f, b2v_); return *(unsigned*)&r; }
__device__ __forceinline__ uint2 pack4(float a, float b, float c, float d) { return make_uint2(pack2(a, b), pack2(c, d)); }
__device__ __forceinline__ float lo16(unsigned u) { return __uint_as_float(u << 16); }
__device__ __forceinline__ float hi16(unsigned u) { return __uint_as_float(u & 0xffff0000u); }
__device__ __forceinline__ float sigmoidf_(float x) { return __builtin_amdgcn_rcpf(1.0f + __expf(-x)); }
__device__ __forceinline__ float siluf_(float x) { return x * __builtin_amdgcn_rcpf(1.0f + __expf(-x)); }
__device__ __forceinline__ int cond_of(int tok) { return tok < NPROMPT ? 0 : 1 + ((tok - NPROMPT) >> 10); }
__device__ __forceinline__ float wave_sum(float v) {
#pragma unroll
  for (int o = 32; o > 0; o >>= 1) v += __shfl_xor(v, o);
  return v;
}
__device__ __forceinline__ void rope_sincos(float pos, int fi, float& sn, float& cs) {
  float inv = exp2f(-(float)fi * 1.6609640474436813f);
  float ang = pos * inv;
  float k = rintf(ang * 0.15915494309189535f);
  float r = fmaf(-k, 6.2831854820251465f, ang);
  r = fmaf(-k, -1.7484555e-7f, r);
  sn = __sinf(r); cs = __cosf(r);
}

#define NT 512
#define NW 8
#define LAS __attribute__((address_space(3)))

namespace pg8 {
constexpr int BM = 256, BK = 64, HALF = 128, HTB = HALF * BK * 2, STAGE_BYTES = 8 * HTB, NXCD = 8, WGM = 8;
__device__ __forceinline__ int lds_byte(int r, int c) { const int st = (r >> 4) * 2 + (c >> 5), rr = r & 15, cc = c & 31, ob = rr * 64 + cc * 2; return st * 1024 + (ob ^ (((ob >> 9) & 1) << 5)); }
__device__ __forceinline__ void stage_rc(int b, int& R, int& C) { const int st = b / 1024, sb = b % 1024, swz = sb ^ (((sb >> 9) & 1) << 5); R = (st >> 1) * 16 + swz / 64; C = (st & 1) * 32 + (swz % 64) / 2; }
struct Unit { int pm, pn; };
struct Gemm { const u16* A; const u16* Bt; int M, N, K, lda, gate; };
struct StaticOrder {
  int nM, nN, nwg, G, c;
  __device__ void init(int M, int N, int G_, int c_) { nM = M / BM; nN = N / BM; nwg = nM * nN; G = G_; c = c_; }
  __device__ bool next(int i, Unit& u) const {
    const long L = (long)i * G + c; if (L >= nwg) return false;
    int wgid = (int)L; { const int q = nwg / NXCD, r = nwg % NXCD, xcd = wgid % NXCD, off = wgid / NXCD; wgid = (xcd < r ? xcd * (q + 1) : r * (q + 1) + (xcd - r) * q) + off; }
    const int nig = WGM * nN, gid = wgid / nig, fm = gid * WGM, gsz = (nM - fm) < WGM ? (nM - fm) : WGM;
    u.pm = fm + ((wgid % nig) % gsz); u.pn = (wgid % nig) / gsz; return true;
  }
};
template <class Epi>
__device__ __forceinline__ void gemm_phase(LAS unsigned char* lds, const Gemm g, const StaticOrder& S, const Epi& E) {
  const int tid = threadIdx.x, wid = __builtin_amdgcn_readfirstlane(tid >> 6), lane = tid & 63, wr = wid >> 2, wc = wid & 3, fr = lane & 15, fq = lane >> 4;
  const int K = g.K, nt = K / BK;
  unsigned voffA[2], voffB[2];
#pragma unroll
  for (int i = 0; i < 2; ++i) { int R, C; stage_rc(tid * 16 + i * 8192, R, C); voffA[i] = (unsigned)(R * g.lda + C) * 2u; voffB[i] = (unsigned)(R * K + C) * 2u; }
  const size_t kstep = (size_t)(BK * 2);
  const size_t hstepA = (size_t)HALF * g.lda * 2, hstepB = (size_t)HALF * K * 2;
  const size_t tstepA = 2 * hstepA, tstepB = 2 * hstepB;
  const unsigned ldsw = (unsigned)wid * 1024u;
  const int aoff = lds_byte(wr * 64 + fr, fq * 8), boff = lds_byte(wc * 32 + fr, fq * 8);
#define PG8_AOFF(pn) (g.gate ? (size_t)((((pn) >> 1) & 3) * 512) : (size_t)0)
#define PG8_SA(b, h) (((b) * 2 + (h)) * HTB)
#define PG8_SB(b, h) ((4 + (b) * 2 + (h)) * HTB)
#define PG8_STAGE(bufoff, gbase, voff) do { _Pragma("unroll") for (int _i = 0; _i < 2; ++_i) \
    __builtin_amdgcn_global_load_lds((const unsigned*)((const char*)(gbase) + (voff)[_i]), (LAS unsigned*)(lds + (bufoff) + ldsw + _i * 8192), 16, 0, 0); } while (0)
#define PG8_LDA(dst, b, h) do { _Pragma("unroll") for (int m = 0; m < 4; ++m) _Pragma("unroll") for (int k = 0; k < 2; ++k) dst[m][k] = *(const LAS bf16x8*)(lds + PG8_SA(b, h) + aoff + m * 2048 + k * 1024); } while (0)
#define PG8_LDB(dst, b, h) do { _Pragma("unroll") for (int n = 0; n < 2; ++n) _Pragma("unroll") for (int k = 0; k < 2; ++k) dst[n][k] = *(const LAS bf16x8*)(lds + PG8_SB(b, h) + boff + n * 2048 + k * 1024); } while (0)
#define PG8_MMA(ai, bj, At, Bt) do { __builtin_amdgcn_s_setprio(1); _Pragma("unroll") for (int m = 0; m < 4; ++m) _Pragma("unroll") for (int n = 0; n < 2; ++n) _Pragma("unroll") for (int k = 0; k < 2; ++k) \
    acc[ai][bj][m][n] = __builtin_amdgcn_mfma_f32_16x16x32_bf16(Bt[n][k], At[m][k], acc[ai][bj][m][n], 0, 0, 0); __builtin_amdgcn_s_setprio(0); } while (0)
#define PG8_WAIT_V(n) asm volatile("s_waitcnt vmcnt(" #n ")" ::: "memory")
#define PG8_WAIT_L(n) asm volatile("s_waitcnt lgkmcnt(" #n ")" ::: "memory")
#define PG8_BAR __builtin_amdgcn_s_barrier()
#define PG8_SCHED __builtin_amdgcn_sched_barrier(0)
  Unit cur, nxt; int ui = 0;
  if (!S.next(0, cur)) return;
  f32x4 acc[2][2][4][2];
#pragma unroll
  for (int a = 0; a < 2; ++a)
#pragma unroll
    for (int b = 0; b < 2; ++b)
#pragma unroll
      for (int m = 0; m < 4; ++m)
#pragma unroll
        for (int n = 0; n < 2; ++n) acc[a][b][m][n] = (f32x4){0.f, 0.f, 0.f, 0.f};
  bf16x8 At[4][2], B0[2][2], B1[2][2];
  const char* cA = (const char*)g.A + (size_t)cur.pm * tstepA + PG8_AOFF(cur.pn); const char* cB = (const char*)g.Bt + (size_t)cur.pn * tstepB;
  PG8_STAGE(PG8_SB(0, 0), cB, voffB); PG8_STAGE(PG8_SA(0, 0), cA, voffA); PG8_STAGE(PG8_SB(0, 1), cB + hstepB, voffB); PG8_STAGE(PG8_SA(0, 1), cA + hstepA, voffA);
  if (wr == 1) PG8_BAR;
  PG8_WAIT_V(4); PG8_BAR;
  PG8_STAGE(PG8_SB(1, 0), cB + kstep, voffB); PG8_STAGE(PG8_SA(1, 0), cA + kstep, voffA); PG8_STAGE(PG8_SB(1, 1), cB + hstepB + kstep, voffB);
  PG8_WAIT_V(6); PG8_BAR;
  for (;;) {
    const bool has_next = S.next(ui + 1, nxt);
    const char* nA = has_next ? (const char*)g.A + (size_t)nxt.pm * tstepA + PG8_AOFF(nxt.pn) : cA; const char* nB = has_next ? (const char*)g.Bt + (size_t)nxt.pn * tstepB : cB;
#pragma unroll 1
    for (int t = 0; t < nt; t += 2) {
      const bool last = (t == nt - 2);
      const char* a1 = cA + (size_t)(t + 1) * kstep;
      const char* a2 = last ? nA : cA + (size_t)(t + 2) * kstep; const char* b2 = last ? nB : cB + (size_t)(t + 2) * kstep;
      const char* a3 = a2 + kstep; const char* b3 = b2 + kstep;
      PG8_LDB(B0, 0, 0); PG8_SCHED; PG8_LDA(At, 0, 0); PG8_STAGE(PG8_SA(1, 1), a1 + hstepA, voffA);
      PG8_WAIT_L(8); PG8_BAR; PG8_WAIT_L(0); PG8_MMA(0, 0, At, B0); PG8_BAR; PG8_SCHED;
      PG8_LDB(B1, 0, 1); PG8_STAGE(PG8_SB(0, 0), b2, voffB);
      PG8_BAR; PG8_WAIT_L(0); PG8_MMA(0, 1, At, B1); PG8_BAR;
      PG8_LDA(At, 0, 1); PG8_STAGE(PG8_SA(0, 0), a2, voffA);
      PG8_BAR; PG8_WAIT_L(0); PG8_MMA(1, 0, At, B0); PG8_BAR; PG8_SCHED;
      PG8_STAGE(PG8_SB(0, 1), b2 + hstepB, voffB);
      PG8_WAIT_V(6); PG8_BAR; PG8_MMA(1, 1, At, B1); PG8_BAR;
      PG8_LDB(B0, 1, 0); PG8_SCHED; PG8_LDA(At, 1, 0); PG8_STAGE(PG8_SA(0, 1), a2 + hstepA, voffA);
      PG8_WAIT_L(8); PG8_BAR; PG8_WAIT_L(0); PG8_MMA(0, 0, At, B0); PG8_BAR; PG8_SCHED;
      PG8_LDB(B1, 1, 1); PG8_STAGE(PG8_SB(1, 0), b3, voffB);
      PG8_BAR; PG8_WAIT_L(0); PG8_MMA(0, 1, At, B1); PG8_BAR;
      PG8_LDA(At, 1, 1); PG8_STAGE(PG8_SA(1, 0), a3, voffA);
      PG8_BAR; PG8_WAIT_L(0); PG8_MMA(1, 0, At, B0); PG8_BAR; PG8_SCHED;
      PG8_STAGE(PG8_SB(1, 1), b3 + hstepB, voffB);
      PG8_WAIT_V(6); PG8_BAR; PG8_MMA(1, 1, At, B1); PG8_BAR;
    }
    if constexpr (!Epi::AFTER_DRAIN) E(acc, cur, wr, wc, fr, fq);
    if (!has_next) break;
#pragma unroll
    for (int a = 0; a < 2; ++a)
#pragma unroll
      for (int b = 0; b < 2; ++b)
#pragma unroll
        for (int m = 0; m < 4; ++m)
#pragma unroll
          for (int n = 0; n < 2; ++n) acc[a][b][m][n] = (f32x4){0.f, 0.f, 0.f, 0.f};
    cur = nxt; cA = nA; cB = nB; ++ui;
  }
  PG8_WAIT_V(0);
  if (wr == 0) PG8_BAR;
  PG8_BAR;
  if constexpr (Epi::AFTER_DRAIN) E.fused(acc, cur, wr, wc, fr, fq, lds);
#undef PG8_AOFF
#undef PG8_SA
#undef PG8_SB
#undef PG8_STAGE
#undef PG8_LDA
#undef PG8_LDB
#undef PG8_MMA
#undef PG8_WAIT_V
#undef PG8_WAIT_L
#undef PG8_BAR
#undef PG8_SCHED
}
}
using pg8::Unit;
typedef const f32x4 (&AccRef)[2][2][4][2];

#define EPI_ROWS(...) _Pragma("unroll") for (int ai = 0; ai < 2; ++ai) _Pragma("unroll") for (int m = 0; m < 4; ++m) { const int row = u.pm * 256 + ai * 128 + wr * 64 + m * 16 + fr; __VA_ARGS__ }
#define EPI_COLS(...) _Pragma("unroll") for (int bj = 0; bj < 2; ++bj) _Pragma("unroll") for (int n = 0; n < 2; ++n) { const int cb = u.pn * 256 + bj * 128 + wc * 32 + n * 16; const f32x4 a = acc[ai][bj][m][n]; __VA_ARGS__ }

struct EpiHgIn {
  static constexpr bool AFTER_DRAIN = false;
  u16 *q, *v, *sg; _Float16* lf; const float* lb;
  __device__ __forceinline__ void operator()(AccRef acc, const Unit& u, int wr, int wc, int fr, int fq) const {
    const int region = u.pn >> 2;
    EPI_ROWS( EPI_COLS(
      const int c = (cb & 1023) + fq * 4;
      if (region == 0) {
        const float s = 0.08838834764831845f;
        *(uint2*)&q[(size_t)row * 1024 + c] = pack4(siluf_(a[0]) * s, siluf_(a[1]) * s, siluf_(a[2]) * s, siluf_(a[3]) * s);
      } else if (region <= 2) {
        const int d = region - 1;
        f32x4 l4 = *(const f32x4*)&lb[d * 1024 + c];
        h4 o;
        _Pragma("unroll") for (int j = 0; j < 4; ++j) { float f = l4[j] + (1.0f - l4[j]) * sigmoidf_(a[j]); o[j] = (_Float16)__logf(f); }
        *(h4*)&lf[(size_t)row * 2048 + d * 1024 + c] = o;
      } else if (region == 3) {
        *(uint2*)&v[(size_t)row * 1024 + c] = pack4(a[0], a[1], a[2], a[3]);
      } else {
        *(uint2*)&sg[(size_t)row * 1024 + c] = pack4(siluf_(a[0]), siluf_(a[1]), siluf_(a[2]), siluf_(a[3]));
      }
    ) )
  }
};

struct EpiRes {
  static constexpr bool AFTER_DRAIN = false;
  const float* xin_p; const float* xin_s; float* Y; const float* gate;
  __device__ __forceinline__ void operator()(AccRef acc, const Unit& u, int wr, int wc, int fr, int fq) const {
    EPI_ROWS(
      const float* xr = row < NPROMPT ? xin_p + (size_t)row * 1024 : xin_s + (size_t)(row - NPROMPT) * 1024;
      const float* g = gate + cond_of(row) * 3072;
      EPI_COLS(
        const int c = cb + fq * 4;
        f32x4 x = *(const f32x4*)&xr[c];
        f32x4 gg = *(const f32x4*)&g[c];
        f32x4 y;
        _Pragma("unroll") for (int j = 0; j < 4; ++j) y[j] = DN_ALPHA * x[j] + gg[j] * a[j];
        *(f32x4*)&Y[(size_t)row * 1024 + c] = y;
      ) )
  }
};

struct EpiResLn {
  static constexpr bool AFTER_DRAIN = true;
  const float* xin_p; const float* xin_s; float* X; const float* gate; const float* lg; const float* lbias; const float* modn; u16* H;
  unsigned long long* slots; unsigned* cnt;
  __device__ __forceinline__ void fused(f32x4 (&acc)[2][2][4][2], const Unit& u, int wr, int wc, int fr, int fq, LAS unsigned char* lds) const {
    LAS float* part = (LAS float*)lds;
    LAS float* stat = part + 2048;
    const int tid = threadIdx.x;
#pragma unroll
    for (int ai = 0; ai < 2; ++ai)
#pragma unroll
      for (int m = 0; m < 4; ++m) {
        const int rl = ai * 128 + wr * 64 + m * 16 + fr;
        const int row = u.pm * 256 + rl;
        const float* xr = row < NPROMPT ? xin_p + (size_t)row * 1024 : xin_s + (size_t)(row - NPROMPT) * 1024;
        const float* g = gate + cond_of(row) * 3072;
        float s1 = 0.f, s2 = 0.f;
#pragma unroll
        for (int bj = 0; bj < 2; ++bj)
#pragma unroll
          for (int n = 0; n < 2; ++n) {
            const int c = u.pn * 256 + bj * 128 + wc * 32 + n * 16 + fq * 4;
            const f32x4 x = *(const f32x4*)&xr[c];
            const f32x4 gg = *(const f32x4*)&g[c];
            f32x4 y;
#pragma unroll
            for (int j = 0; j < 4; ++j) { y[j] = DN_ALPHA * x[j] + gg[j] * acc[ai][bj][m][n][j]; s1 += y[j]; s2 += y[j] * y[j]; }
            acc[ai][bj][m][n] = y;
          }
        s1 += __shfl_xor(s1, 16); s1 += __shfl_xor(s1, 32);
        s2 += __shfl_xor(s2, 16); s2 += __shfl_xor(s2, 32);
        if (fq == 0) { part[(rl * 4 + wc) * 2] = s1; part[(rl * 4 + wc) * 2 + 1] = s2; }
      }
    __syncthreads();
    if (tid < 256) {
      float S1 = 0.f, S2 = 0.f;
#pragma unroll
      for (int w2 = 0; w2 < 4; ++w2) { S1 += part[(tid * 4 + w2) * 2]; S2 += part[(tid * 4 + w2) * 2 + 1]; }
      const unsigned long long v = (unsigned long long)__float_as_uint(S1) | ((unsigned long long)__float_as_uint(S2) << 32);
      __hip_atomic_store(&slots[(size_t)(u.pm * 4 + u.pn) * 256 + tid], v, __ATOMIC_RELAXED, __HIP_MEMORY_SCOPE_AGENT);
    }
    asm volatile("s_waitcnt vmcnt(0)" ::: "memory");
    __syncthreads();
    if (tid == 0) {
      __hip_atomic_fetch_add(&cnt[u.pm], 1u, __ATOMIC_RELAXED, __HIP_MEMORY_SCOPE_AGENT);
      unsigned sp = 0;
      while (__hip_atomic_load(&cnt[u.pm], __ATOMIC_RELAXED, __HIP_MEMORY_SCOPE_AGENT) < 4u) { __builtin_amdgcn_s_sleep(1); if (++sp > (1u << 24)) break; }
    }
    __syncthreads();
    if (tid < 256) {
      float T1 = 0.f, T2 = 0.f;
#pragma unroll
      for (int o = 0; o < 4; ++o) {
        const unsigned long long v = __hip_atomic_load(&slots[(size_t)(u.pm * 4 + o) * 256 + tid], __ATOMIC_RELAXED, __HIP_MEMORY_SCOPE_AGENT);
        T1 += __uint_as_float((unsigned)(v & 0xffffffffull)); T2 += __uint_as_float((unsigned)(v >> 32));
      }
      const float mu = T1 * (1.0f / 1024.0f);
      const float var = fmaxf(T2 * (1.0f / 1024.0f) - mu * mu, 0.f);
      stat[tid * 2] = mu; stat[tid * 2 + 1] = rsqrtf(var + 1e-5f);
    }
    __syncthreads();
#pragma unroll
    for (int ai = 0; ai < 2; ++ai)
#pragma unroll
      for (int m = 0; m < 4; ++m) {
        const int rl = ai * 128 + wr * 64 + m * 16 + fr;
        const int row = u.pm * 256 + rl;
        const float mu = stat[rl * 2], rs = stat[rl * 2 + 1];
        const float* mn = modn + cond_of(row) * 3072;
#pragma unroll
        for (int bj = 0; bj < 2; ++bj)
#pragma unroll
          for (int n = 0; n < 2; ++n) {
            const int c = u.pn * 256 + bj * 128 + wc * 32 + n * 16 + fq * 4;
            const f32x4 gg = *(const f32x4*)&lg[c], bb = *(const f32x4*)&lbias[c];
            const f32x4 y = acc[ai][bj][m][n];
            f32x4 xo;
#pragma unroll
            for (int j = 0; j < 4; ++j) xo[j] = (y[j] - mu) * rs * gg[j] + bb[j];
            *(f32x4*)&X[(size_t)row * 1024 + c] = xo;
            if (H) {
              const f32x4 sh = *(const f32x4*)&mn[c], sc = *(const f32x4*)&mn[1024 + c];
              *(uint2*)&H[(size_t)row * 1024 + c] = pack4(xo[0] * (1 + sc[0]) + sh[0], xo[1] * (1 + sc[1]) + sh[1], xo[2] * (1 + sc[2]) + sh[2], xo[3] * (1 + sc[3]) + sh[3]);
            }
          }
      }
  }
};

struct EpiScIn {
  static constexpr bool AFTER_DRAIN = false;
  u16 *pb, *sb;
  __device__ __forceinline__ void operator()(AccRef acc, const Unit& u, int wr, int wc, int fr, int fq) const {
    const int c = u.pn * 64 + wc * 16 + fq * 4;
    EPI_ROWS(
      const f32x4 bg = acc[ai][0][m][0], cgv = acc[ai][0][m][1], v = acc[ai][1][m][0], g = acc[ai][1][m][1];
      *(uint2*)&pb[(size_t)row * 1024 + c] = pack4(cgv[0] * v[0], cgv[1] * v[1], cgv[2] * v[2], cgv[3] * v[3]);
      *(uint2*)&sb[(size_t)row * 1024 + c] = pack4(siluf_(g[0]) * bg[0], siluf_(g[1]) * bg[1], siluf_(g[2]) * bg[2], siluf_(g[3]) * bg[3]);
    )
  }
};

struct EpiRgIn {
  static constexpr bool AFTER_DRAIN = false;
  u16 *ub, *sg;
  __device__ __forceinline__ void operator()(AccRef acc, const Unit& u, int wr, int wc, int fr, int fq) const {
    const int region = u.pn >> 2;
    EPI_ROWS( EPI_COLS(
      const int c = (cb & 1023) + fq * 4;
      if (region == 0) *(uint2*)&ub[(size_t)row * 1024 + c] = pack4(a[0], a[1], a[2], a[3]);
      else *(uint2*)&sg[(size_t)row * 1024 + c] = pack4(siluf_(a[0]), siluf_(a[1]), siluf_(a[2]), siluf_(a[3]));
    ) )
  }
};

struct EpiRgGate {
  static constexpr bool AFTER_DRAIN = false;
  u16 *rb, *ib; const float* bgate;
  __device__ __forceinline__ void operator()(AccRef acc, const Unit& u, int wr, int wc, int fr, int fq) const {
    const int mat = u.pn >> 1, d = mat >> 2, hd = mat & 3;
    EPI_ROWS(
      _Pragma("unroll") for (int bj = 0; bj < 2; ++bj) {
        const int off = ((u.pn & 1) * 256 + bj * 128 + wc * 32);
        const int cc = (off >> 5) * 16 + fq * 4;
        f32x4 br = *(const f32x4*)&bgate[mat * 512 + cc];
        f32x4 bi = *(const f32x4*)&bgate[mat * 512 + 256 + cc];
        const f32x4 r = acc[ai][bj][m][0], ii = acc[ai][bj][m][1];
        const size_t o = ((size_t)d * TOK + row) * 1024 + hd * 256 + cc;
        *(uint2*)&rb[o] = pack4(sigmoidf_(r[0] + br[0]), sigmoidf_(r[1] + br[1]), sigmoidf_(r[2] + br[2]), sigmoidf_(r[3] + br[3]));
        *(uint2*)&ib[o] = pack4(sigmoidf_(ii[0] + bi[0]), sigmoidf_(ii[1] + bi[1]), sigmoidf_(ii[2] + bi[2]), sigmoidf_(ii[3] + bi[3]));
      } )
  }
};

struct EpiMlaIn {
  static constexpr bool AFTER_DRAIN = false;
  u16* cq; float* ckvraw; float* kperaw; u16* sg;
  __device__ __forceinline__ void operator()(AccRef acc, const Unit& u, int wr, int wc, int fr, int fq) const {
    EPI_ROWS( EPI_COLS(
      const int c = cb + fq * 4;
      if (cb < 384) *(uint2*)&cq[(size_t)row * 384 + c] = pack4(a[0], a[1], a[2], a[3]);
      else if (cb < 640) *(f32x4*)&ckvraw[(size_t)row * 256 + (c - 384)] = a;
      else if (cb < 672) *(f32x4*)&kperaw[(size_t)row * 32 + (c - 640)] = a;
      else if (cb < 1696) *(uint2*)&sg[(size_t)row * 1024 + (c - 672)] = pack4(siluf_(a[0]), siluf_(a[1]), siluf_(a[2]), siluf_(a[3]));
    ) )
  }
};

struct EpiQ {
  static constexpr bool AFTER_DRAIN = false;
  u16* q;
  __device__ __forceinline__ void operator()(AccRef acc, const Unit& u, int wr, int wc, int fr, int fq) const {
    const float sc = 0.10206207261596575f;
    EPI_ROWS( EPI_COLS(
      *(uint2*)&q[(size_t)row * 1536 + cb + fq * 4] = pack4(a[0] * sc, a[1] * sc, a[2] * sc, a[3] * sc);
    ) )
  }
};

struct EpiKV {
  static constexpr bool AFTER_DRAIN = false;
  u16 *Kb, *Vt;
  __device__ __forceinline__ void operator()(AccRef acc, const Unit& u, int wr, int wc, int fr, int fq) const {
    EPI_ROWS( EPI_COLS(
      const int h = cb >> 7, d0 = cb & 127, dd = (d0 & 63) + fq * 4;
      if (d0 < 64) {
        *(uint2*)&Kb[((size_t)row * 16 + h) * 96 + dd] = pack4(a[0], a[1], a[2], a[3]);
      } else {
        _Pragma("unroll") for (int j = 0; j < 4; ++j) Vt[((size_t)(h * 64 + dd + j)) * KVROWS + row] = f2bf(a[j]);
      }
    ) )
  }
};

__device__ __forceinline__ void wconv_tile(const float* __restrict__ src, int N, int K, u16* __restrict__ dst, int k0, int n0,
                                           int perm, int mat, float* tile) {
  const int tid = threadIdx.x;
  {
    const int r = tid >> 4, c4 = (tid & 15) * 4;
#pragma unroll
    for (int i = 0; i < 2; ++i) {
      const int k = r + i * 32;
      f32x4 v = f32x4{0.f, 0.f, 0.f, 0.f};
      if (n0 + c4 < N) v = *(const f32x4*)&src[(size_t)(k0 + k) * N + n0 + c4];
      tile[k * 65 + c4 + 0] = v[0]; tile[k * 65 + c4 + 1] = v[1]; tile[k * 65 + c4 + 2] = v[2]; tile[k * 65 + c4 + 3] = v[3];
    }
  }
  __syncthreads();
  {
    const int nl = tid >> 3, kq = (tid & 7) * 8;
    const int n = n0 + nl;
    int np = n;
    if (perm == 1) { const int part = n >> 10, c = n & 1023; np = (c >> 6) * 256 + (part >> 1) * 128 + ((c >> 4) & 3) * 32 + (part & 1) * 16 + (c & 15); }
    else if (perm == 2) { const int type = n >> 8, cc = n & 255; np = mat * 512 + (cc >> 4) * 32 + type * 16 + (cc & 15); }
    if (n < N) {
      unsigned w[4];
#pragma unroll
      for (int i = 0; i < 4; ++i) w[i] = pack2(tile[(kq + 2 * i) * 65 + nl], tile[(kq + 2 * i + 1) * 65 + nl]);
      *(uint4*)&dst[(size_t)np * K + k0 + kq] = make_uint4(w[0], w[1], w[2], w[3]);
    }
  }
  __syncthreads();
}

__device__ __forceinline__ void phase_prologue(const Params& p, unsigned char* smem_raw, int bid, int nb) {
  float* fs = (float*)smem_raw;
  const int tid = threadIdx.x;
  const int NMOD = 192, NWT = 4800;
  for (int it = bid; it < NMOD + 1 + NWT; it += nb) {
    if (it < NMOD) {
      const int l = it / 48, n0 = (it % 48) * 64;
      float* scond = fs;
      float* sred = fs + 5120;
      for (int i = tid; i < 5120; i += NT) {
        const int ci = i >> 10, k = i & 1023;
        float cv = ci == 0 ? p.in[7][k] : p.in[6][(ci - 1) * 1024 + k];
        scond[i] = siluf_(cv);
      }
      __syncthreads();
      const int col = tid & 63, kg = tid >> 6;
      const float* w = p.in[8] + (size_t)l * 1024 * 3072 + n0 + col;
      float a0 = 0, a1 = 0, a2 = 0, a3 = 0, a4 = 0;
#pragma unroll 16
      for (int k = kg * 128; k < kg * 128 + 128; ++k) {
        float wv = w[(size_t)k * 3072];
        a0 += scond[k] * wv; a1 += scond[1024 + k] * wv; a2 += scond[2048 + k] * wv; a3 += scond[3072 + k] * wv; a4 += scond[4096 + k] * wv;
      }
      sred[(kg * 5 + 0) * 64 + col] = a0; sred[(kg * 5 + 1) * 64 + col] = a1; sred[(kg * 5 + 2) * 64 + col] = a2;
      sred[(kg * 5 + 3) * 64 + col] = a3; sred[(kg * 5 + 4) * 64 + col] = a4;
      __syncthreads();
      float* mod = (float*)(p.ws + WS_MOD);
      if (tid < 320) {
        const int ci = tid >> 6, cc = tid & 63;
        float s = 0;
#pragma unroll
        for (int g = 0; g < 8; ++g) s += sred[(g * 5 + ci) * 64 + cc];
        mod[(l * 5 + ci) * 3072 + n0 + cc] = s + p.in[9][l * 3072 + n0 + cc];
      }
      __syncthreads();
    } else if (it == NMOD) {
      float* lb = (float*)(p.ws + WS_LB);
      for (int i = tid; i < 2048; i += NT) {
        const int d = i >> 10, c = i & 1023;
        const float* lg = p.in[13] + d * 5 * 1024 + c;
        float m = lg[0];
        for (int j = 1; j < 5; ++j) m = fmaxf(m, lg[j * 1024]);
        float s = 0;
        for (int j = 0; j < 5; ++j) s += expf(lg[j * 1024] - m);
        lb[i] = expf(lg[0] - m) / s;
      }
      int* cnt = (int*)(p.ws + WS_CNT);
      if (tid < 16) cnt[tid] = 0;
    } else {
      int t = it - NMOD - 1;
      const float* src; u16* dst; int N, K, perm = 0, mat = 0, ntn;
      if (t < 1280) { src = p.in[12]; dst = (u16*)(p.ws + WS_W_HG_IN); N = 5120; K = 1024; }
      else if ((t -= 1280) < 256) { src = p.in[15]; dst = (u16*)(p.ws + WS_W_HG_OUT); N = 1024; K = 1024; }
      else if ((t -= 256) < 1024) { src = p.in[16]; dst = (u16*)(p.ws + WS_W_SC_IN); N = 4096; K = 1024; perm = 1; }
      else if ((t -= 1024) < 256) { src = p.in[19]; dst = (u16*)(p.ws + WS_W_SC_OUT); N = 1024; K = 1024; }
      else if ((t -= 256) < 512) { src = p.in[20]; dst = (u16*)(p.ws + WS_W_RG_IN); N = 2048; K = 1024; }
      else if ((t -= 512) < 256) { mat = t >> 5; t &= 31; src = p.in[23] + (size_t)mat * 256 * 512; dst = (u16*)(p.ws + WS_W_RG_GATE); N = 512; K = 256; perm = 2; }
      else if ((t -= 256) < 256) { src = p.in[26]; dst = (u16*)(p.ws + WS_W_RG_OUT); N = 1024; K = 1024; }
      else if ((t -= 256) < 432) { src = p.in[27]; dst = (u16*)(p.ws + WS_W_MLA_IN); N = 1696; K = 1024; }
      else if ((t -= 432) < 144) { src = p.in[30]; dst = (u16*)(p.ws + WS_W_QB); N = 1536; K = 384; }
      else if ((t -= 144) < 128) { src = p.in[31]; dst = (u16*)(p.ws + WS_W_KVB); N = 2048; K = 256; }
      else { t -= 128; src = p.in[32]; dst = (u16*)(p.ws + WS_W_MLA_OUT); N = 1024; K = 1024; }
      ntn = (N + 63) >> 6;
      const int kt = t / ntn, ntl = t - kt * ntn;
      wconv_tile(src, N, K, dst, kt * 64, ntl * 64, perm, mat, fs);
    }
  }
}

__device__ __forceinline__ void phase_h0(const Params& p, int bid, int nb) {
  const float* mod = (const float*)(p.ws + WS_MOD);
  u16* H = (u16*)(p.ws + WS_H);
  const size_t total = (size_t)TOK * 256;
  for (size_t i = (size_t)bid * NT + threadIdx.x; i < total; i += (size_t)nb * NT) {
    const int row = (int)(i >> 8), c = ((int)i & 255) * 4;
    const float* xr = row < NPROMPT ? p.in[0] + (size_t)row * 1024 : p.in[1] + (size_t)(row - NPROMPT) * 1024;
    const float* m = mod + cond_of(row) * 3072;
    f32x4 x = *(const f32x4*)&xr[c];
    f32x4 sh = *(const f32x4*)&m[c];
    f32x4 sc = *(const f32x4*)&m[1024 + c];
    *(uint2*)&H[(size_t)row * 1024 + c] = pack4(x[0] * (1 + sc[0]) + sh[0], x[1] * (1 + sc[1]) + sh[1], x[2] * (1 + sc[2]) + sh[2], x[3] * (1 + sc[3]) + sh[3]);
  }
}

__device__ __forceinline__ void phase_ln(const Params& p, int l, int bid, int nb) {
  float* X = p.out;
  const float* g = p.in[10] + l * 1024;
  const float* b = p.in[11] + l * 1024;
  const float* mod = (const float*)(p.ws + WS_MOD) + (l + 1) * 5 * 3072;
  u16* H = (u16*)(p.ws + WS_H);
  const int lane = threadIdx.x & 63, wave = threadIdx.x >> 6;
  for (int row = bid * NW + wave; row < TOK; row += nb * NW) {
    float* xr = X + (size_t)row * 1024;
    f32x4 v[4];
    float s = 0;
#pragma unroll
    for (int i = 0; i < 4; ++i) { v[i] = *(const f32x4*)&xr[i * 256 + lane * 4]; s += v[i][0] + v[i][1] + v[i][2] + v[i][3]; }
    const float mu = wave_sum(s) * (1.0f / 1024.0f);
    float q = 0;
#pragma unroll
    for (int i = 0; i < 4; ++i)
#pragma unroll
      for (int j = 0; j < 4; ++j) { float dd = v[i][j] - mu; q += dd * dd; }
    const float rs = rsqrtf(wave_sum(q) * (1.0f / 1024.0f) + 1e-5f);
    const float* m = mod + cond_of(row) * 3072;
#pragma unroll
    for (int i = 0; i < 4; ++i) {
      const int c = i * 256 + lane * 4;
      f32x4 gg = *(const f32x4*)&g[c], bb = *(const f32x4*)&b[c];
      f32x4 y;
#pragma unroll
      for (int j = 0; j < 4; ++j) y[j] = (v[i][j] - mu) * rs * gg[j] + bb[j];
      *(f32x4*)&xr[c] = y;
      if (l < 3) {
        f32x4 sh = *(const f32x4*)&m[c], sc = *(const f32x4*)&m[1024 + c];
        *(uint2*)&H[(size_t)row * 1024 + c] = pack4(y[0] * (1 + sc[0]) + sh[0], y[1] * (1 + sc[1]) + sh[1], y[2] * (1 + sc[2]) + sh[2], y[3] * (1 + sc[3]) + sh[3]);
      }
    }
  }
}

__device__ __forceinline__ void phase_gla(const Params& p, unsigned char* smem_raw) {
  u16* s_qrel = (u16*)smem_raw;
  u16* s_krel = s_qrel + 32 * 136;
  u16* s_qcum = s_krel + 32 * 136;
  u16* s_kdT = s_qcum + 32 * 136;
  u16* s_vT = s_kdT + 128 * 40;
  u16* s_att = s_vT + 64 * 40;
  u16* s_S = s_att + 32 * 40;
  float* s_dec = (float*)(s_S + 64 * 136);
  float* s_part = s_dec + 128;
  int* s_u = (int*)(s_part + 512);
  int* counter = (int*)(p.ws + WS_CNT);
  const u16* qg = (const u16*)(p.ws + WS_B(0));
  const u16* vg = (const u16*)(p.ws + WS_B(1));
  const _Float16* lfg = (const _Float16*)(p.ws + WS_B(3));
  u16* og = (u16*)(p.ws + WS_B(5));
  const int tid = threadIdx.x, lane = tid & 63, w = tid >> 6, fr = lane & 15, fq = lane >> 4;
  const int kk = tid & 127, th = tid >> 7;
  const int ti = w >> 2, vi = w & 3;
  const int wk = w & 3, wv = w >> 2;
  while (true) {
    if (tid == 0) *s_u = atomicAdd(counter, 1);
    __syncthreads();
    const int u = *s_u;
    __syncthreads();
    if (u >= 1152) break;
    int b, rem, start, N, sample;
    if (u < 128) { sample = 1; b = u >> 5; rem = u & 31; start = NPROMPT + b * 1024; N = 1024; }
    else { sample = 0; b = (u - 128) >> 5; rem = (u - 128) & 31; start = b * 256; N = 256; }
    const int h = rem >> 2, d = (rem >> 1) & 1, vs = rem & 1;
    const int nc = N >> 5;
    f32x4 S[2][2];
#pragma unroll
    for (int mi = 0; mi < 2; ++mi)
#pragma unroll
      for (int ni = 0; ni < 2; ++ni) {
        f32x4 s4 = f32x4{0.f, 0.f, 0.f, 0.f};
        if (sample) {
          const float* s0 = p.in[2] + ((size_t)((b * 2 + d) * 8 + h)) * 16384;
#pragma unroll
          for (int j = 0; j < 4; ++j) s4[j] = s0[(wk * 32 + mi * 16 + fq * 4 + j) * 128 + vs * 64 + wv * 32 + ni * 16 + fr];
        }
        S[mi][ni] = s4;
        *(uint2*)&s_S[(wv * 32 + ni * 16 + fr) * 136 + wk * 32 + mi * 16 + fq * 4] = pack4(s4[0], s4[1], s4[2], s4[3]);
      }
    _Float16 lfraw[8]; u16 qraw[8]; uint2 vraw;
#define GLA_LOAD(cc) do { _Pragma("unroll") for (int i = 0; i < 8; ++i) { const int tt = (cc) * 32 + th * 8 + i; const size_t tok = start + (d ? (N - 1 - tt) : tt); \
      lfraw[i] = lfg[tok * 2048 + d * 1024 + h * 128 + kk]; qraw[i] = qg[tok * 1024 + h * 128 + kk]; } \
      { const int tt = (cc) * 32 + (tid >> 4); const size_t tok = start + (d ? (N - 1 - tt) : tt); vraw = *(const uint2*)&vg[tok * 1024 + h * 128 + vs * 64 + (tid & 15) * 4]; } } while (0)
    GLA_LOAD(0);
    for (int c = 0; c < nc; ++c) {
      {
        float lfv[8], qv[8];
#pragma unroll
        for (int i = 0; i < 8; ++i) { lfv[i] = (float)lfraw[i]; qv[i] = bf2f(qraw[i]); }
        const uint2 vv = vraw;
        if (c + 1 < nc) GLA_LOAD(c + 1);
        float run = 0;
        float cs[8];
#pragma unroll
        for (int i = 0; i < 8; ++i) { run += lfv[i]; cs[i] = run; }
        s_part[th * 128 + kk] = run;
        {
          const int s = tid >> 4, v4 = (tid & 15) * 4;
          s_vT[(v4 + 0) * 40 + s] = (u16)(vv.x & 0xffff); s_vT[(v4 + 1) * 40 + s] = (u16)(vv.x >> 16);
          s_vT[(v4 + 2) * 40 + s] = (u16)(vv.y & 0xffff); s_vT[(v4 + 3) * 40 + s] = (u16)(vv.y >> 16);
        }
        __syncthreads();
        const float p0 = s_part[kk], p1 = s_part[128 + kk], p2 = s_part[256 + kk], p3 = s_part[384 + kk];
        const float off = (th > 0 ? p0 : 0.f) + (th > 1 ? p1 : 0.f) + (th > 2 ? p2 : 0.f);
        const float ref = p0 + p1, total = p0 + p1 + p2 + p3;
        unsigned kd[4];
#pragma unroll
        for (int i = 0; i < 8; ++i) {
          const int t = th * 8 + i;
          const float cum = off + cs[i];
          const float kf = 1.0f - __expf(lfv[i]);
          s_qrel[t * 136 + kk] = f2bf(qv[i] * __expf(cum - ref));
          s_krel[t * 136 + kk] = f2bf(kf * __expf(ref - cum));
          s_qcum[t * 136 + kk] = f2bf(qv[i] * __expf(cum));
          const u16 kdv = f2bf(kf * __expf(total - cum));
          if (i & 1) kd[i >> 1] |= ((unsigned)kdv) << 16; else kd[i >> 1] = kdv;
        }
        *(uint4*)&s_kdT[kk * 40 + th * 8] = make_uint4(kd[0], kd[1], kd[2], kd[3]);
        if (th == 0) s_dec[kk] = __expf(total);
      }
      __syncthreads();
      f32x4 oacc = f32x4{0.f, 0.f, 0.f, 0.f};
      {
        f32x4 att = f32x4{0.f, 0.f, 0.f, 0.f};
        const int ati = w >> 1, asi = w & 1;
#pragma unroll
        for (int ks = 0; ks < 4; ++ks) {
          if (w < 4) {
            bf16x8 a = *(const bf16x8*)&s_qrel[(ati * 16 + fr) * 136 + ks * 32 + fq * 8];
            bf16x8 bb = *(const bf16x8*)&s_krel[(asi * 16 + fr) * 136 + ks * 32 + fq * 8];
            att = __builtin_amdgcn_mfma_f32_16x16x32_bf16(a, bb, att, 0, 0, 0);
          }
          bf16x8 a2 = *(const bf16x8*)&s_qcum[(ti * 16 + fr) * 136 + ks * 32 + fq * 8];
          bf16x8 b2 = *(const bf16x8*)&s_S[(vi * 16 + fr) * 136 + ks * 32 + fq * 8];
          oacc = __builtin_amdgcn_mfma_f32_16x16x32_bf16(a2, b2, oacc, 0, 0, 0);
        }
        if (w < 4) {
#pragma unroll
          for (int j = 0; j < 4; ++j) {
            const int t = ati * 16 + fq * 4 + j, s = asi * 16 + fr;
            s_att[t * 40 + s] = (s <= t) ? f2bf(att[j]) : (u16)0;
          }
        }
      }
      __syncthreads();
      {
        bf16x8 a = *(const bf16x8*)&s_att[(ti * 16 + fr) * 40 + fq * 8];
        bf16x8 bb = *(const bf16x8*)&s_vT[(vi * 16 + fr) * 40 + fq * 8];
        oacc = __builtin_amdgcn_mfma_f32_16x16x32_bf16(a, bb, oacc, 0, 0, 0);
#pragma unroll
        for (int j = 0; j < 4; ++j) {
          const int tt = c * 32 + ti * 16 + fq * 4 + j;
          const size_t tok = start + (d ? (N - 1 - tt) : tt);
          og[((size_t)d * TOK + tok) * 1024 + h * 128 + vs * 64 + vi * 16 + fr] = f2bf(oacc[j]);
        }
        bf16x8 vf[2];
#pragma unroll
        for (int ni = 0; ni < 2; ++ni) vf[ni] = *(const bf16x8*)&s_vT[(wv * 32 + ni * 16 + fr) * 40 + fq * 8];
#pragma unroll
        for (int mi = 0; mi < 2; ++mi) {
          bf16x8 kf = *(const bf16x8*)&s_kdT[(wk * 32 + mi * 16 + fr) * 40 + fq * 8];
          f32x4 dc = *(const f32x4*)&s_dec[wk * 32 + mi * 16 + fq * 4];
#pragma unroll
          for (int ni = 0; ni < 2; ++ni) {
            f32x4 s4 = S[mi][ni];
#pragma unroll
            for (int j = 0; j < 4; ++j) s4[j] *= dc[j];
            s4 = __builtin_amdgcn_mfma_f32_16x16x32_bf16(kf, vf[ni], s4, 0, 0, 0);
            S[mi][ni] = s4;
            *(uint2*)&s_S[(wv * 32 + ni * 16 + fr) * 136 + wk * 32 + mi * 16 + fq * 4] = pack4(s4[0], s4[1], s4[2], s4[3]);
          }
        }
      }
      __syncthreads();
    }
    if (!sample) {
      float* so = p.out + OUT_HG + ((size_t)((b * 2 + d) * 8 + h)) * 16384;
#pragma unroll
      for (int mi = 0; mi < 2; ++mi)
#pragma unroll
        for (int ni = 0; ni < 2; ++ni)
#pragma unroll
          for (int j = 0; j < 4; ++j) so[(wk * 32 + mi * 16 + fq * 4 + j) * 128 + vs * 64 + wv * 32 + ni * 16 + fr] = S[mi][ni][j];
    }
  }
}

__device__ __forceinline__ void phase_hg_post(const Params& p, int bid, int nb) {
  const u16* og = (const u16*)(p.ws + WS_B(5));
  const u16* sg = (const u16*)(p.ws + WS_B(2));
  u16* a = (u16*)(p.ws + WS_B(0));
  const float* ng = p.in[14];
  const int lane = threadIdx.x & 63, wave = threadIdx.x >> 6;
  for (int row = bid * NW + wave; row < TOK; row += nb * NW) {
    const size_t base = (size_t)row * 1024 + lane * 16;
    float o[16];
    float ss = 0;
#pragma unroll
    for (int hh = 0; hh < 2; ++hh) {
      uint4 f = *(const uint4*)&og[base + hh * 8];
      uint4 bw = *(const uint4*)&og[(size_t)TOK * 1024 + base + hh * 8];
      unsigned fa[4] = {f.x, f.y, f.z, f.w}, ba[4] = {bw.x, bw.y, bw.z, bw.w};
#pragma unroll
      for (int i = 0; i < 4; ++i) {
        o[hh * 8 + 2 * i] = lo16(fa[i]) + lo16(ba[i]);
        o[hh * 8 + 2 * i + 1] = hi16(fa[i]) + hi16(ba[i]);
      }
    }
#pragma unroll
    for (int i = 0; i < 16; ++i) ss += o[i] * o[i];
    ss += __shfl_xor(ss, 1); ss += __shfl_xor(ss, 2); ss += __shfl_xor(ss, 4);
    const float rs = rsqrtf(ss * (1.0f / 128.0f) + 1e-6f);
#pragma unroll
    for (int hh = 0; hh < 2; ++hh) {
      uint4 s = *(const uint4*)&sg[base + hh * 8];
      unsigned sa[4] = {s.x, s.y, s.z, s.w};
      unsigned r[4];
#pragma unroll
      for (int i = 0; i < 4; ++i) {
        const int c = lane * 16 + hh * 8 + 2 * i;
        r[i] = pack2(o[hh * 8 + 2 * i] * rs * ng[c] * lo16(sa[i]), o[hh * 8 + 2 * i + 1] * rs * ng[c + 1] * hi16(sa[i]));
      }
      *(uint4*)&a[base + hh * 8] = make_uint4(r[0], r[1], r[2], r[3]);
    }
  }
}

__device__ __forceinline__ void seq_pos(int tok, int& n, int& L) {
  if (tok < NPROMPT) { n = tok & 255; L = 256; } else { n = (tok - NPROMPT) & 1023; L = 1024; }
}
__device__ __forceinline__ void phase_sc_conv(const Params& p, int bid, int nb) {
  const u16* pb = (const u16*)(p.ws + WS_B(0));
  const u16* sb = (const u16*)(p.ws + WS_B(1));
  u16* a = (u16*)(p.ws + WS_B(2));
  const float* cw = p.in[17]; const float* cbias = p.in[18];
  const size_t total = (size_t)TOK * 128;
  for (size_t i = (size_t)bid * NT + threadIdx.x; i < total; i += (size_t)nb * NT) {
    const int tok = (int)(i >> 7), c = ((int)i & 127) * 8;
    int n, L; seq_pos(tok, n, L);
    const size_t base = (size_t)tok * 1024 + c;
    uint4 z = make_uint4(0, 0, 0, 0);
    uint4 pm = n > 0 ? *(const uint4*)&pb[base - 1024] : z;
    uint4 p0 = *(const uint4*)&pb[base];
    uint4 pp = n < L - 1 ? *(const uint4*)&pb[base + 1024] : z;
    uint4 s = *(const uint4*)&sb[base];
    unsigned am[4] = {pm.x, pm.y, pm.z, pm.w}, a0[4] = {p0.x, p0.y, p0.z, p0.w}, ap[4] = {pp.x, pp.y, pp.z, pp.w}, as[4] = {s.x, s.y, s.z, s.w};
    unsigned r[4];
#pragma unroll
    for (int k = 0; k < 4; ++k) {
      const int c0 = c + 2 * k, c1 = c0 + 1;
      float z0 = cw[c0] * lo16(am[k]) + cw[1024 + c0] * lo16(a0[k]) + cw[2048 + c0] * lo16(ap[k]) + cbias[c0];
      float z1 = cw[c1] * hi16(am[k]) + cw[1024 + c1] * hi16(a0[k]) + cw[2048 + c1] * hi16(ap[k]) + cbias[c1];
      r[k] = pack2(lo16(as[k]) * z0, hi16(as[k]) * z1);
    }
    *(uint4*)&a[base] = make_uint4(r[0], r[1], r[2], r[3]);
  }
}
__device__ __forceinline__ void phase_rg_conv(const Params& p, int bid, int nb) {
  const u16* ub = (const u16*)(p.ws + WS_B(0));
  u16* uc = (u16*)(p.ws + WS_B(2));
  const float* cw = p.in[21]; const float* cbias = p.in[22];
  const size_t total = (size_t)TOK * 128;
  for (size_t i = (size_t)bid * NT + threadIdx.x; i < total; i += (size_t)nb * NT) {
    const int tok = (int)(i >> 7), c = ((int)i & 127) * 8;
    int n, L; seq_pos(tok, n, L);
    const size_t base = (size_t)tok * 1024 + c;
    uint4 z = make_uint4(0, 0, 0, 0);
    uint4 q0 = n > 1 ? *(const uint4*)&ub[base - 2048] : z;
    uint4 q1 = n > 0 ? *(const uint4*)&ub[base - 1024] : z;
    uint4 q2 = *(const uint4*)&ub[base];
    uint4 q3 = n < L - 1 ? *(const uint4*)&ub[base + 1024] : z;
    unsigned a0[4] = {q0.x, q0.y, q0.z, q0.w}, a1[4] = {q1.x, q1.y, q1.z, q1.w}, a2[4] = {q2.x, q2.y, q2.z, q2.w}, a3[4] = {q3.x, q3.y, q3.z, q3.w};
    unsigned r[4];
#pragma unroll
    for (int k = 0; k < 4; ++k) {
      const int c0 = c + 2 * k, c1 = c0 + 1;
      float z0 = cw[c0] * lo16(a0[k]) + cw[1024 + c0] * lo16(a1[k]) + cw[2048 + c0] * lo16(a2[k]) + cw[3072 + c0] * lo16(a3[k]) + cbias[c0];
      float z1 = cw[c1] * hi16(a0[k]) + cw[1024 + c1] * hi16(a1[k]) + cw[2048 + c1] * hi16(a2[k]) + cw[3072 + c1] * hi16(a3[k]) + cbias[c1];
      r[k] = pack2(z0, z1);
    }
    *(uint4*)&uc[base] = make_uint4(r[0], r[1], r[2], r[3]);
  }
}

__device__ __forceinline__ void phase_rg_scan(const Params& p, unsigned char* smem_raw, int bid, int nb) {
  float* sA = (float*)smem_raw;
  float* sB = sA + 2048;
  const u16* rb = (const u16*)(p.ws + WS_B(3));
  const u16* ib = (const u16*)(p.ws + WS_B(5));
  const u16* uc = (const u16*)(p.ws + WS_B(2));
  const u16* sg = (const u16*)(p.ws + WS_B(1));
  u16* hfw = (u16*)(p.ws + WS_H);
  u16* yp = (u16*)(p.ws + WS_B(0));
  const int tid = threadIdx.x;
  for (int u = bid; u < 768; u += nb) {
    int sample, b, c, seg, nseg, start, cl_;
    if (u < 256) { sample = 1; b = u >> 6; cl_ = tid & 15; c = (u & 63) * 16 + cl_; seg = tid >> 4; nseg = 32; start = NPROMPT + b * 1024; }
    else { sample = 0; b = (u - 256) >> 4; cl_ = tid & 63; c = ((u - 256) & 15) * 64 + cl_; seg = tid >> 6; nseg = 8; start = b * 256; }
    const int L = nseg * 32;
#pragma unroll 1
    for (int d = 0; d < 2; ++d) {
      const float lam = p.in[25][d * 1024 + c];
      const float cl = 8.0f * log1pf(__expf(-lam));
      const u16* rp = rb + (size_t)d * TOK * 1024;
      const u16* ip = ib + (size_t)d * TOK * 1024;
      const size_t o0 = (size_t)(start + (d ? L - 1 - seg * 32 : seg * 32)) * 1024 + c;
      const long ostep = d ? -1024 : 1024;
      float av[32], xv[32];
      float Aacc = 1.f, Bacc = 0.f;
#pragma unroll
      for (int s = 0; s < 32; ++s) {
        const size_t o = o0 + s * ostep;
        const float r = bf2f(rp[o]), ig = bf2f(ip[o]), uu = bf2f(uc[o]);
        const float la = -cl * r;
        const float a = __expf(la);
        const float xin = __builtin_amdgcn_sqrtf(fmaxf(1.0f - __expf(2.0f * la), 0.f)) * (ig * uu);
        av[s] = a; xv[s] = xin;
      }
#pragma unroll
      for (int s = 0; s < 32; ++s) { Aacc *= av[s]; Bacc = av[s] * Bacc + xv[s]; }
      sA[seg * 64 + cl_] = Aacc; sB[seg * 64 + cl_] = Bacc;
      __syncthreads();
      float h = sample ? p.in[3][(b * 2 + d) * 1024 + c] : 0.f;
      for (int s2 = 0; s2 < seg; ++s2) h = sA[s2 * 64 + cl_] * h + sB[s2 * 64 + cl_];
      if (d == 0) {
#pragma unroll
        for (int s = 0; s < 32; ++s) { h = av[s] * h + xv[s]; hfw[o0 + s * ostep] = f2bf(h); }
      } else {
        float hf[32], sgv[32];
#pragma unroll
        for (int s = 0; s < 32; ++s) { const size_t o = o0 + s * ostep; hf[s] = bf2f(hfw[o]); sgv[s] = bf2f(sg[o]); }
#pragma unroll
        for (int s = 0; s < 32; ++s) { h = av[s] * h + xv[s]; yp[o0 + s * ostep] = f2bf((hf[s] + h) * sgv[s]); }
      }
      if (!sample && seg == nseg - 1) p.out[OUT_RG + (b * 2 + d) * 1024 + c] = h;
      __syncthreads();
    }
  }
}

__device__ __forceinline__ void phase_mla_norm(const Params& p, int bid, int nb) {
  u16* cq = (u16*)(p.ws + WS3_CQ);
  u16* ckvall = (u16*)(p.ws + WS3_CKVALL);
  const float* ckvraw = (const float*)(p.ws + WS3_CKVRAW);
  const float* kperaw = (const float*)(p.ws + WS3_KPERAW);
  u16* Kb = (u16*)(p.ws + WS3_K);
  const float* qn = p.in[28]; const float* kvn = p.in[29];
  const int lane = threadIdx.x & 63, wave = threadIdx.x >> 6;
  for (int row = bid * NW + wave; row < TOK + 2048; row += nb * NW) {
    if (row < TOK) {
      const int tok = row;
      const bool sample = tok >= NPROMPT;
      const int bs = (tok - NPROMPT) >> 10, n = (tok - NPROMPT) & 1023;
      const size_t kvrow = sample ? (size_t)(NPROMPT + bs * 1536 + 512 + n) : (size_t)tok;
      unsigned* cqr = (unsigned*)&cq[(size_t)tok * 384];
      unsigned cv[3]; float ss = 0;
#pragma unroll
      for (int i = 0; i < 3; ++i) { cv[i] = cqr[i * 64 + lane]; float a = lo16(cv[i]), b2 = hi16(cv[i]); ss += a * a + b2 * b2; }
      const float rsq = rsqrtf(wave_sum(ss) * (1.0f / 384.0f) + 1e-6f);
#pragma unroll
      for (int i = 0; i < 3; ++i) {
        const int k = (i * 64 + lane) * 2;
        cqr[i * 64 + lane] = pack2(lo16(cv[i]) * rsq * qn[k], hi16(cv[i]) * rsq * qn[k + 1]);
      }
      f32x4 kv = *(const f32x4*)&ckvraw[(size_t)tok * 256 + lane * 4];
      const float rsk = rsqrtf(wave_sum(kv[0] * kv[0] + kv[1] * kv[1] + kv[2] * kv[2] + kv[3] * kv[3]) * (1.0f / 256.0f) + 1e-6f);
      f32x4 g4 = *(const f32x4*)&kvn[lane * 4];
      f32x4 o4;
#pragma unroll
      for (int j = 0; j < 4; ++j) o4[j] = kv[j] * rsk * g4[j];
      *(uint2*)&ckvall[kvrow * 256 + lane * 4] = pack4(o4[0], o4[1], o4[2], o4[3]);
      if (!sample) *(f32x4*)&p.out[OUT_CKV + (size_t)tok * 256 + lane * 4] = o4;
      float v = kperaw[(size_t)tok * 32 + (lane & 31)];
      if (!sample) { if (lane < 32) p.out[OUT_KPE + (size_t)tok * 32 + lane] = v; }
      else {
        const float partner = __shfl_xor(v, 8);
        const int i16 = lane & 15;
        const float pos = (lane & 16) ? (float)(n & 63) : (float)(n >> 6);
        float sn, cs; rope_sincos(pos, i16 & 7, sn, cs);
        v = (i16 < 8) ? (v * cs - partner * sn) : (partner * sn + v * cs);
      }
      const u16 vb = f2bf(v);
#pragma unroll
      for (int i = 0; i < 8; ++i) Kb[(kvrow * 16 + (lane >> 5) + 2 * i) * 96 + 64 + (lane & 31)] = vb;
    } else {
      const int r = row - TOK, bs = r >> 9, j = r & 511;
      const size_t kvrow = (size_t)(NPROMPT + bs * 1536 + j);
      f32x4 kv = *(const f32x4*)&p.in[4][(size_t)r * 256 + lane * 4];
      *(uint2*)&ckvall[kvrow * 256 + lane * 4] = pack4(kv[0], kv[1], kv[2], kv[3]);
      const u16 vb = f2bf(p.in[5][(size_t)r * 32 + (lane & 31)]);
#pragma unroll
      for (int i = 0; i < 8; ++i) Kb[(kvrow * 16 + (lane >> 5) + 2 * i) * 96 + 64 + (lane & 31)] = vb;
    }
  }
}

__device__ __forceinline__ void phase_attn(const Params& p, unsigned char* smem_raw, int bid, int nb) {
  u16* sK = (u16*)smem_raw;
  u16* sV = sK + 64 * 104;
  const u16* qg = (const u16*)(p.ws + WS3_Q);
  const u16* Kg = (const u16*)(p.ws + WS3_K);
  const u16* Vg = (const u16*)(p.ws + WS3_VT);
  const u16* sg = (const u16*)(p.ws + WS3_SG);
  u16* ao = (u16*)(p.ws + WS_H);
  const int tid = threadIdx.x, lane = tid & 63, w = tid >> 6, fr = lane & 15, fq = lane >> 4;
  for (int u = bid; u < 1536; u += nb) {
    int tok0, kvbase, nkeys, h;
    if (u < 512) { const int b = u >> 7, r = u & 127; h = r >> 3; const int qb = r & 7; tok0 = NPROMPT + b * 1024 + qb * 128; kvbase = NPROMPT + b * 1536; nkeys = 1536; }
    else { const int uu = u - 512; const int b = uu >> 5, r = uu & 31; h = r >> 1; const int qb = r & 1; tok0 = b * 256 + qb * 128; kvbase = b * 256; nkeys = 256; }
    const int tokq = tok0 + w * 16 + fr;
    bf16x8 qf[3];
#pragma unroll
    for (int ks = 0; ks < 3; ++ks) qf[ks] = *(const bf16x8*)&qg[(size_t)tokq * 1536 + h * 96 + ks * 32 + fq * 8];
    if (u < 512) {
      const int npos = (tokq - NPROMPT) & 1023;
      const float pos = (fq & 2) ? (float)(npos & 63) : (float)(npos >> 6);
      uint4 raw = *(uint4*)&qf[2];
      unsigned rw[4] = {raw.x, raw.y, raw.z, raw.w};
#pragma unroll
      for (int i = 0; i < 4; ++i) {
        float v0 = lo16(rw[i]), v1 = hi16(rw[i]);
        const float p0 = __shfl_xor(v0, 16), p1 = __shfl_xor(v1, 16);
        float sn0, cs0, sn1, cs1;
        rope_sincos(pos, 2 * i, sn0, cs0); rope_sincos(pos, 2 * i + 1, sn1, cs1);
        v0 = (fq & 1) ? (p0 * sn0 + v0 * cs0) : (v0 * cs0 - p0 * sn0);
        v1 = (fq & 1) ? (p1 * sn1 + v1 * cs1) : (v1 * cs1 - p1 * sn1);
        rw[i] = pack2(v0, v1);
      }
      raw = make_uint4(rw[0], rw[1], rw[2], rw[3]);
      qf[2] = *(bf16x8*)&raw;
    }
    float m = -1e30f, l = 0.f;
    f32x4 oacc[4];
#pragma unroll
    for (int i = 0; i < 4; ++i) oacc[i] = f32x4{0.f, 0.f, 0.f, 0.f};
    const int ntile = nkeys >> 6;
    const int k0key = tid / 12, k0ch = tid - k0key * 12;
    const int k1key = (tid + NT) / 12, k1ch = (tid + NT) - k1key * 12;
    const int vdv = tid >> 3, vch = tid & 7;
    const u16* Kp0 = &Kg[((size_t)(kvbase + k0key) * 16 + h) * 96 + k0ch * 8];
    const u16* Kp1 = &Kg[((size_t)(kvbase + k1key) * 16 + h) * 96 + k1ch * 8];
    const u16* Vp = &Vg[(size_t)(h * 64 + vdv) * KVROWS + kvbase + vch * 8];
    uint4 kr0 = *(const uint4*)Kp0, kr1 = make_uint4(0, 0, 0, 0), vr = *(const uint4*)Vp;
    if (tid < 256) kr1 = *(const uint4*)Kp1;
    for (int kt = 0; kt < ntile; ++kt) {
      __syncthreads();
      *(uint4*)&sK[k0key * 104 + k0ch * 8] = kr0;
      if (tid < 256) *(uint4*)&sK[k1key * 104 + k1ch * 8] = kr1;
      *(uint4*)&sV[vdv * 72 + vch * 8] = vr;
      if (kt + 1 < ntile) {
        kr0 = *(const uint4*)(Kp0 + (size_t)(kt + 1) * 64 * 1536);
        if (tid < 256) kr1 = *(const uint4*)(Kp1 + (size_t)(kt + 1) * 64 * 1536);
        vr = *(const uint4*)(Vp + (kt + 1) * 64);
      }
      __syncthreads();
      f32x4 sacc[4];
#pragma unroll
      for (int ni = 0; ni < 4; ++ni) {
        sacc[ni] = f32x4{0.f, 0.f, 0.f, 0.f};
#pragma unroll
        for (int ks = 0; ks < 3; ++ks) {
          bf16x8 kf = *(const bf16x8*)&sK[(ni * 16 + fr) * 104 + ks * 32 + fq * 8];
          sacc[ni] = __builtin_amdgcn_mfma_f32_16x16x32_bf16(kf, qf[ks], sacc[ni], 0, 0, 0);
        }
      }
      float mx = -1e30f;
#pragma unroll
      for (int ni = 0; ni < 4; ++ni)
#pragma unroll
        for (int j = 0; j < 4; ++j) mx = fmaxf(mx, sacc[ni][j]);
      mx = fmaxf(mx, __shfl_xor(mx, 16));
      mx = fmaxf(mx, __shfl_xor(mx, 32));
      const float mnew = fmaxf(m, mx);
      const float alpha = __expf(m - mnew);
      m = mnew;
      float ls = 0.f;
#pragma unroll
      for (int ni = 0; ni < 4; ++ni)
#pragma unroll
        for (int j = 0; j < 4; ++j) { float e = __expf(sacc[ni][j] - mnew); sacc[ni][j] = e; ls += e; }
      l = l * alpha + ls;
      bf16x8 pf[2];
#pragma unroll
      for (int kk2 = 0; kk2 < 2; ++kk2) {
        uint2 lo = pack4(sacc[2 * kk2][0], sacc[2 * kk2][1], sacc[2 * kk2][2], sacc[2 * kk2][3]);
        uint2 hi = pack4(sacc[2 * kk2 + 1][0], sacc[2 * kk2 + 1][1], sacc[2 * kk2 + 1][2], sacc[2 * kk2 + 1][3]);
        uint4 pk = make_uint4(lo.x, lo.y, hi.x, hi.y);
        pf[kk2] = *(bf16x8*)&pk;
      }
#pragma unroll
      for (int di = 0; di < 4; ++di) {
#pragma unroll
        for (int j = 0; j < 4; ++j) oacc[di][j] *= alpha;
#pragma unroll
        for (int kk2 = 0; kk2 < 2; ++kk2) {
          uint2 v0 = *(const uint2*)&sV[(di * 16 + fr) * 72 + kk2 * 32 + fq * 4];
          uint2 v1 = *(const uint2*)&sV[(di * 16 + fr) * 72 + kk2 * 32 + 16 + fq * 4];
          uint4 vk = make_uint4(v0.x, v0.y, v1.x, v1.y);
          oacc[di] = __builtin_amdgcn_mfma_f32_16x16x32_bf16(*(bf16x8*)&vk, pf[kk2], oacc[di], 0, 0, 0);
        }
      }
    }
    l += __shfl_xor(l, 16);
    l += __shfl_xor(l, 32);
    const float inv = 1.0f / l;
#pragma unroll
    for (int di = 0; di < 4; ++di) {
      const size_t o = (size_t)tokq * 1024 + h * 64 + di * 16 + fq * 4;
      uint2 s = *(const uint2*)&sg[o];
      *(uint2*)&ao[o] = pack4(oacc[di][0] * inv * lo16(s.x), oacc[di][1] * inv * hi16(s.x), oacc[di][2] * inv * lo16(s.y), oacc[di][3] * inv * hi16(s.y));
    }
  }
}

#define XB_TMO      128
#define XB_XCNT(j)  (256  + 64 * (j))
#define XB_XSUB(j)  (1280 + 64 * (j))
#define XB_XGEN(j)  (2304 + 64 * (j))
#define XB_TOP      3328
#define XB_TOPGEN   3392
#define XCD_BAR_WORDS 3456
#define XB_SPIN_CAP (1u << 22)
__device__ __forceinline__ unsigned xb_ld(unsigned* p)              { return __hip_atomic_load(p, __ATOMIC_RELAXED, __HIP_MEMORY_SCOPE_AGENT); }
__device__ __forceinline__ unsigned xb_add(unsigned* p, unsigned v) { return __hip_atomic_fetch_add(p, v, __ATOMIC_RELAXED, __HIP_MEMORY_SCOPE_AGENT); }
__device__ __forceinline__ unsigned xb_xcc_id() { return (unsigned)__builtin_amdgcn_s_getreg((3 << 11) | 20) & 0xFu; }
#define XB_SPIN(cond, bar) do { unsigned _sp = 0; while (cond) { __builtin_amdgcn_s_sleep(1); \
    if ((++_sp & 255u) == 0u) { if (xb_ld(&(bar)[XB_TMO])) break; if (_sp > XB_SPIN_CAP) { atomicAdd(&(bar)[XB_TMO], 1u); break; } } } } while (0)
struct XcdBarrier { unsigned* bar; unsigned x; volatile LAS unsigned* st; };
__device__ __forceinline__ XcdBarrier xcd_barrier_post(unsigned* bar, volatile LAS unsigned* st) {
  XcdBarrier b; b.bar = bar; b.x = xb_xcc_id(); b.st = st;
  if (threadIdx.x == 0) (void)xb_add(&bar[XB_XCNT(b.x)], 1u);
  return b;
}
__device__ __forceinline__ void xcd_barrier_complete(unsigned* bar, unsigned x, unsigned& nloc, unsigned& nx) {
  const unsigned G = gridDim.x * gridDim.y * gridDim.z;
  unsigned sum, cnt, mine, sp = 0u;
  for (;;) {
    sum = 0u; cnt = 0u; mine = 0u;
#pragma unroll
    for (unsigned j = 0; j < 16; ++j) { const unsigned c = xb_ld(&bar[XB_XCNT(j)]); sum += c; cnt += (c > 0u) ? 1u : 0u; mine = (j == x) ? c : mine; }
    if (sum == G) break;
    __builtin_amdgcn_s_sleep(1);
    if ((++sp & 255u) == 0u) { if (xb_ld(&bar[XB_TMO])) break; if (sp > XB_SPIN_CAP) { atomicAdd(&bar[XB_TMO], 1u); break; } }
  }
  nloc = mine > 0u ? mine : 1u; nx = cnt > 0u ? cnt : 1u;
}
__device__ __forceinline__ void xcd_barrier(const XcdBarrier& b) {
  asm volatile("s_waitcnt vmcnt(0)" ::: "memory");
  __syncthreads();
  if (threadIdx.x == 0) {
    unsigned* bar = b.bar;
    __builtin_amdgcn_s_waitcnt(0);
    unsigned nloc = b.st[0], nx = b.st[1];
    if (nloc == 0u) { xcd_barrier_complete(bar, b.x, nloc, nx); b.st[0] = nloc; b.st[1] = nx; }
    const unsigned old = xb_add(&bar[XB_XSUB(b.x)], 1u);
    const unsigned gen = old / nloc;
    if (old + 1u == (gen + 1u) * nloc) {
      __builtin_amdgcn_fence(__ATOMIC_RELEASE, "agent");
      asm volatile("s_waitcnt vmcnt(0)" ::: "memory");
      const unsigned og = xb_add(&bar[XB_TOP], 1u);
      const unsigned tg = og / nx;
      if (og + 1u == (tg + 1u) * nx) xb_add(&bar[XB_TOPGEN], 1u);
      else XB_SPIN(xb_ld(&bar[XB_TOPGEN]) == tg, bar);
      __builtin_amdgcn_fence(__ATOMIC_ACQUIRE, "agent");
      xb_add(&bar[XB_XGEN(b.x)], 1u);
      asm volatile("s_waitcnt vmcnt(0)" ::: "memory");
    } else {
      XB_SPIN(xb_ld(&bar[XB_XGEN(b.x)]) == gen, bar);
      __builtin_amdgcn_fence(__ATOMIC_ACQUIRE, "agent");
      asm volatile("s_waitcnt vmcnt(0)" ::: "memory");
    }
  }
  __syncthreads();
}

#define GEMM_LDS 131072
#define DYN_LDS (GEMM_LDS + 16)
#define WS_BAR (WS_CNT + 4096ull)

#define RUN_GEMM(Aptr, LDA, Bptr, MM, NN, KK, GATE, EPI, CID) do { pg8::Gemm g_{(const u16*)(Aptr), (const u16*)(Bptr), MM, NN, KK, LDA, GATE}; \
    pg8::StaticOrder S_; S_.init(MM, NN, nb, CID); pg8::gemm_phase((LAS unsigned char*)smem_raw, g_, S_, EPI); } while (0)

__global__ void __launch_bounds__(NT, 2) mega(Params p) {
  extern __shared__ __attribute__((aligned(16))) unsigned char smem_raw[];
  const int bid = blockIdx.x, nb = gridDim.x;
  unsigned char* ws = p.ws;
  const float* mod = (const float*)(ws + WS_MOD);
  volatile LAS unsigned* xst = (volatile LAS unsigned*)((LAS unsigned char*)smem_raw + GEMM_LDS);
  XcdBarrier xb;
  if (p.phase_hi - p.phase_lo > 1) {
    if (threadIdx.x == 0) { xst[0] = 0u; xst[1] = 0u; }
    __syncthreads();
    xb = xcd_barrier_post((unsigned*)(ws + WS_BAR), xst);
  }
#define PH_BEGIN(n) if ((PHMASK & (1u << n)) && p.phase_lo <= n && n < p.phase_hi) { const int ph = n;
#define PH_FIN if (ph + 1 < p.phase_hi) { if (p.phase_lo < 0) cg::this_grid().sync(); else xcd_barrier(xb); } }
  PH_BEGIN(0) phase_prologue(p, smem_raw, bid, nb); PH_FIN
  PH_BEGIN(1) phase_h0(p, bid, nb); PH_FIN
  PH_BEGIN(2) {
    EpiHgIn e{(u16*)(ws + WS_B(0)), (u16*)(ws + WS_B(1)), (u16*)(ws + WS_B(2)), (_Float16*)(ws + WS_B(3)), (const float*)(ws + WS_LB)};
    RUN_GEMM(ws + WS_H, 1024, ws + WS_W_HG_IN, TOK, 5120, 1024, 0, e, bid);
  } PH_FIN
  PH_BEGIN(3) phase_gla(p, smem_raw); PH_FIN
  PH_BEGIN(4) phase_hg_post(p, bid, nb); PH_FIN
  PH_BEGIN(5) {
    EpiResLn e{p.in[0], p.in[1], p.out, mod + 0 * 15360 + 2048, p.in[10] + 0 * 1024, p.in[11] + 0 * 1024, mod + 1 * 15360, (u16*)(ws + WS_H),
               (unsigned long long*)(ws + WS_SLOT) + 0 * 49152, (unsigned*)(ws + WS_CNT + 256) + 0 * 48};
    RUN_GEMM(ws + WS_B(0), 1024, ws + WS_W_HG_OUT, TOK, 1024, 1024, 0, e, bid);
  } PH_FIN
  PH_BEGIN(7) {
    EpiScIn e{(u16*)(ws + WS_B(0)), (u16*)(ws + WS_B(1))};
    RUN_GEMM(ws + WS_H, 1024, ws + WS_W_SC_IN, TOK, 4096, 1024, 0, e, bid);
  } PH_FIN
  PH_BEGIN(8) phase_sc_conv(p, bid, nb); PH_FIN
  PH_BEGIN(9) {
    EpiResLn e{p.out, p.out + (size_t)NPROMPT * 1024, p.out, mod + 1 * 15360 + 2048, p.in[10] + 1 * 1024, p.in[11] + 1 * 1024, mod + 2 * 15360, (u16*)(ws + WS_H),
               (unsigned long long*)(ws + WS_SLOT) + 1 * 49152, (unsigned*)(ws + WS_CNT + 256) + 1 * 48};
    RUN_GEMM(ws + WS_B(2), 1024, ws + WS_W_SC_OUT, TOK, 1024, 1024, 0, e, bid);
  } PH_FIN
  PH_BEGIN(11) {
    EpiRgIn e{(u16*)(ws + WS_B(0)), (u16*)(ws + WS_B(1))};
    RUN_GEMM(ws + WS_H, 1024, ws + WS_W_RG_IN, TOK, 2048, 1024, 0, e, bid);
  } PH_FIN
  PH_BEGIN(12) phase_rg_conv(p, bid, nb); PH_FIN
  PH_BEGIN(13) {
    EpiRgGate e{(u16*)(ws + WS_B(3)), (u16*)(ws + WS_B(5)), p.in[24]};
    RUN_GEMM(ws + WS_B(2), 1024, ws + WS_W_RG_GATE, TOK, 4096, 256, 1, e, bid);
  } PH_FIN
  PH_BEGIN(14) phase_rg_scan(p, smem_raw, bid, nb); PH_FIN
  PH_BEGIN(15) {
    EpiResLn e{p.out, p.out + (size_t)NPROMPT * 1024, p.out, mod + 2 * 15360 + 2048, p.in[10] + 2 * 1024, p.in[11] + 2 * 1024, mod + 3 * 15360, (u16*)(ws + WS_H),
               (unsigned long long*)(ws + WS_SLOT) + 2 * 49152, (unsigned*)(ws + WS_CNT + 256) + 2 * 48};
    RUN_GEMM(ws + WS_B(0), 1024, ws + WS_W_RG_OUT, TOK, 1024, 1024, 0, e, bid);
  } PH_FIN
  PH_BEGIN(17) {
    EpiMlaIn e{(u16*)(ws + WS3_CQ), (float*)(ws + WS3_CKVRAW), (float*)(ws + WS3_KPERAW), (u16*)(ws + WS3_SG)};
    RUN_GEMM(ws + WS_H, 1024, ws + WS_W_MLA_IN, TOK, 1792, 1024, 0, e, bid);
  } PH_FIN
  PH_BEGIN(18) phase_mla_norm(p, bid, nb); PH_FIN
  PH_BEGIN(19) {
    EpiQ eq{(u16*)(ws + WS3_Q)};
    RUN_GEMM(ws + WS3_CQ, 384, ws + WS_W_QB, TOK, 1536, 384, 0, eq, bid);
    EpiKV ek{(u16*)(ws + WS3_K), (u16*)(ws + WS3_VT)};
    RUN_GEMM(ws + WS3_CKVALL, 256, ws + WS_W_KVB, KVROWS, 2048, 256, 0, ek, nb - 1 - bid);
  } PH_FIN
  PH_BEGIN(20) phase_attn(p, smem_raw, bid, nb); PH_FIN
  PH_BEGIN(21) {
    EpiResLn e{p.out, p.out + (size_t)NPROMPT * 1024, p.out, mod + 3 * 15360 + 2048, p.in[10] + 3 * 1024, p.in[11] + 3 * 1024, mod + 3 * 15360, (u16*)nullptr,
               (unsigned long long*)(ws + WS_SLOT) + 3 * 49152, (unsigned*)(ws + WS_CNT + 256) + 3 * 48};
    RUN_GEMM(ws + WS_H, 1024, ws + WS_W_MLA_OUT, TOK, 1024, 1024, 0, e, bid);
  } PH_FIN
}

extern "C" void kernel_launch(void* const* d_in, const int* in_sizes, int n_in, void* d_out, int out_size, void* d_ws, size_t ws_size,
                              hipStream_t stream) {
  static int grid_blocks = 0;
  if (!grid_blocks) {
    int dev = 0, cus = 0, per_cu = 0;
    (void)hipGetDevice(&dev);
    (void)hipDeviceGetAttribute(&cus, hipDeviceAttributeMultiprocessorCount, dev);
    (void)hipFuncSetAttribute((const void*)mega, hipFuncAttributeMaxDynamicSharedMemorySize, DYN_LDS);
    (void)hipOccupancyMaxActiveBlocksPerMultiprocessor(&per_cu, (const void*)mega, NT, DYN_LDS);
    if (per_cu < 1) per_cu = 1;
    if (per_cu > 1) per_cu = 1;
    grid_blocks = cus * per_cu;
  }
  Params p{};
  for (int i = 0; i < 33; ++i) p.in[i] = (const float*)d_in[i];
  p.out = (float*)d_out;
  p.ws = (unsigned char*)d_ws;
#if MULTI_LAUNCH
  (void)hipMemsetAsync((unsigned char*)d_ws + WS_CNT, 0, 4096 + XCD_BAR_WORDS * 4, stream);
  for (int ph = 0; ph < NPHASES; ++ph) {
    p.phase_lo = ph; p.phase_hi = ph + 1;
    hipLaunchKernelGGL(mega, dim3(grid_blocks), dim3(NT), DYN_LDS, stream, p);
#ifdef PROBE_MASK
    if ((PROBE_MASK >> ph) & 1) for (int r = 0; r < 2; ++r) {
      if (ph == 3) (void)hipMemsetAsync((unsigned char*)d_ws + WS_CNT, 0, 64, stream);
      hipLaunchKernelGGL(mega, dim3(grid_blocks), dim3(NT), DYN_LDS, stream, p);
    }
#endif
  }
#else
  p.phase_lo = 0; p.phase_hi = NPHASES;
  (void)hipMemsetAsync((unsigned char*)d_ws + WS_CNT, 0, 4096 + XCD_BAR_WORDS * 4, stream);
  void* args[] = {&p};
  hipError_t e = hipLaunchCooperativeKernel((const void*)mega, dim3(grid_blocks), dim3(NT), args, DYN_LDS, stream);
  if (e != hipSuccess) fprintf(stderr, "cooperative launch failed: %s (grid %d)\n", hipGetErrorString(e), grid_blocks);
#endif
}
```

```cpp
#include <hip/hip_runtime.h>
#include <hip/hip_cooperative_groups.h>
#include <cstdio>
namespace cg = cooperative_groups;

#ifndef MULTI_LAUNCH
#define MULTI_LAUNCH 0
#endif

typedef unsigned short u16;
using bf16x8 = __attribute__((ext_vector_type(8))) short;
using f32x4 = __attribute__((ext_vector_type(4))) float;
typedef _Float16 h4 __attribute__((ext_vector_type(4)));

#define TOK 12288
#define NPROMPT 8192
#define KVROWS 14336
#define NPHASES 23
#ifndef PHMASK
#define PHMASK 0x7fffff
#endif
#define DN_ALPHA 1.6817928305074290f

#define WS_W_HG_IN 0ull
#define WS_W_HG_OUT (WS_W_HG_IN + 10485760ull)
#define WS_W_SC_IN (WS_W_HG_OUT + 2097152ull)
#define WS_W_SC_OUT (WS_W_SC_IN + 8388608ull)
#define WS_W_RG_IN (WS_W_SC_OUT + 2097152ull)
#define WS_W_RG_GATE (WS_W_RG_IN + 4194304ull)
#define WS_W_RG_OUT (WS_W_RG_GATE + 2097152ull)
#define WS_W_MLA_IN (WS_W_RG_OUT + 2097152ull)
#define WS_W_QB (WS_W_MLA_IN + 3670016ull)
#define WS_W_KVB (WS_W_QB + 1179648ull)
#define WS_W_MLA_OUT (WS_W_KVB + 1048576ull)
#define WS_MOD (WS_W_MLA_OUT + 2097152ull)
#define WS_LB (WS_MOD + 245760ull)
#define WS_CNT (WS_LB + 8192ull)
#define WS_R (WS_CNT + 4096ull + 16384ull)
#define BSZ 25165824ull
#define WS_H (WS_R)
#define WS_B(i) (WS_R + BSZ * (1 + (i)))
#define WS_SLOT (WS_R + 201326592ull)
#define WS_XB (WS_SLOT + 1572864ull)
#define WS3_CQ (WS_R + 25165824ull)
#define WS3_CKVALL (WS_R + 34603008ull)
#define WS3_CKVRAW (WS_R + 41943040ull)
#define WS3_KPERAW (WS_R + 54525952ull)
#define WS3_SG (WS_R + 56098816ull)
#define WS3_Q (WS_R + 81264640ull)
#define WS3_K (WS_R + 119013376ull)
#define WS3_VT (WS_R + 163053568ull)

#define OUT_HG 12582912
#define OUT_RG 20971520
#define OUT_CKV 21037056
#define OUT_KPE 23134208

struct Params {
  const float* in[33];
  float* out;
  unsigned char* ws;
  int phase_lo, phase_hi;
};

__device__ __forceinline__ u16 f2bf(float f) { __bf16 r = (__bf16)f; return *(u16*)&r; }
__device__ __forceinline__ float bf2f(u16 h) { return __uint_as_float(((unsigned)h) << 16); }
typedef float f2v_ __attribute__((ext_vector_type(2)));
typedef __bf16 b2v_ __attribute__((ext_vector_type(2)));
__device__ __forceinline__ unsigned pack2(float a, float b) { f2v_ f = {a, b}; b2v_ r = __builtin_convertvector(f, b2v_); return *(unsigned*)&r; }
__device__ __forceinline__ uint2 pack4(float a, float b, float c, float d) { return make_uint2(pack2(a, b), pack2(c, d)); }
__device__ __forceinline__ float lo16(unsigned u) { return __uint_as_float(u << 16); }
__device__ __forceinline__ float hi16(unsigned u) { return __uint_as_float(u & 0xffff0000u); }
__device__ __forceinline__ float sigmoidf_(float x) { return __builtin_amdgcn_rcpf(1.0f + __expf(-x)); }
__device__ __forceinline__ float siluf_(float x) { return x * __builtin_amdgcn_rcpf(1.0f + __expf(-x)); }
__device__ __forceinline__ int cond_of(int tok) { return tok < NPROMPT ? 0 : 1 + ((tok - NPROMPT) >> 10); }
__device__ __forceinline__ float wave_sum(float v) {
#pragma unroll
  for (int o = 32; o > 0; o >>= 1) v += __shfl_xor(v, o);
  return v;
}
__device__ __forceinline__ void rope_sincos(float pos, int fi, float& sn, float& cs) {
  float inv = exp2f(-(float)fi * 1.6609640474436813f);
  float ang = pos * inv;
  float k = rintf(ang * 0.15915494309189535f);
  float r = fmaf(-k, 6.2831854820251465f, ang);
  r = fmaf(-k, -1.7484555e-7f, r);
  sn = __sinf(r); cs = __cosf(r);
}

#define NT 512
#define NW 8
#define LAS __attribute__((address_space(3)))

namespace pg8 {
constexpr int BM = 256, BK = 64, HALF = 128, HTB = HALF * BK * 2, STAGE_BYTES = 8 * HTB, NXCD = 8, WGM = 8;
__device__ __forceinline__ int lds_byte(int r, int c) { const int st = (r >> 4) * 2 + (c >> 5), rr = r & 15, cc = c & 31, ob = rr * 64 + cc * 2; return st * 1024 + (ob ^ (((ob >> 9) & 1) << 5)); }
__device__ __forceinline__ void stage_rc(int b, int& R, int& C) { const int st = b / 1024, sb = b % 1024, swz = sb ^ (((sb >> 9) & 1) << 5); R = (st >> 1) * 16 + swz / 64; C = (st & 1) * 32 + (swz % 64) / 2; }
struct Unit { int pm, pn; };
struct Gemm { const u16* A; const u16* Bt; int M, N, K, lda, gate; };
struct StaticOrder {
  int nM, nN, nwg, G, c;
  __device__ void init(int M, int N, int G_, int c_) { nM = M / BM; nN = N / BM; nwg = nM * nN; G = G_; c = c_; }
  __device__ bool next(int i, Unit& u) const {
    const long L = (long)i * G + c; if (L >= nwg) return false;
    int wgid = (int)L; { const int q = nwg / NXCD, r = nwg % NXCD, xcd = wgid % NXCD, off = wgid / NXCD; wgid = (xcd < r ? xcd * (q + 1) : r * (q + 1) + (xcd - r) * q) + off; }
    const int nig = WGM * nN, gid = wgid / nig, fm = gid * WGM, gsz = (nM - fm) < WGM ? (nM - fm) : WGM;
    u.pm = fm + ((wgid % nig) % gsz); u.pn = (wgid % nig) / gsz; return true;
  }
};
template <class Epi>
__device__ __forceinline__ void gemm_phase(LAS unsigned char* lds, const Gemm g, const StaticOrder& S, const Epi& E) {
  const int tid = threadIdx.x, wid = __builtin_amdgcn_readfirstlane(tid >> 6), lane = tid & 63, wr = wid >> 2, wc = wid & 3, fr = lane & 15, fq = lane >> 4;
  const int K = g.K, nt = K / BK;
  unsigned voffA[2], voffB[2];
#pragma unroll
  for (int i = 0; i < 2; ++i) { int R, C; stage_rc(tid * 16 + i * 8192, R, C); voffA[i] = (unsigned)(R * g.lda + C) * 2u; voffB[i] = (unsigned)(R * K + C) * 2u; }
  const size_t kstep = (size_t)(BK * 2);
  const size_t hstepA = (size_t)HALF * g.lda * 2, hstepB = (size_t)HALF * K * 2;
  const size_t tstepA = 2 * hstepA, tstepB = 2 * hstepB;
  const unsigned ldsw = (unsigned)wid * 1024u;
  const int aoff = lds_byte(wr * 64 + fr, fq * 8), boff = lds_byte(wc * 32 + fr, fq * 8);
#define PG8_AOFF(pn) (g.gate ? (size_t)((((pn) >> 1) & 3) * 512) : (size_t)0)
#define PG8_SA(b, h) (((b) * 2 + (h)) * HTB)
#define PG8_SB(b, h) ((4 + (b) * 2 + (h)) * HTB)
#define PG8_STAGE(bufoff, gbase, voff) do { _Pragma("unroll") for (int _i = 0; _i < 2; ++_i) \
    __builtin_amdgcn_global_load_lds((const unsigned*)((const char*)(gbase) + (voff)[_i]), (LAS unsigned*)(lds + (bufoff) + ldsw + _i * 8192), 16, 0, 0); } while (0)
#define PG8_LDA(dst, b, h) do { _Pragma("unroll") for (int m = 0; m < 4; ++m) _Pragma("unroll") for (int k = 0; k < 2; ++k) dst[m][k] = *(const LAS bf16x8*)(lds + PG8_SA(b, h) + aoff + m * 2048 + k * 1024); } while (0)
#define PG8_LDB(dst, b, h) do { _Pragma("unroll") for (int n = 0; n < 2; ++n) _Pragma("unroll") for (int k = 0; k < 2; ++k) dst[n][k] = *(const LAS bf16x8*)(lds + PG8_SB(b, h) + boff + n * 2048 + k * 1024); } while (0)
#define PG8_MMA(ai, bj, At, Bt) do { __builtin_amdgcn_s_setprio(1); _Pragma("unroll") for (int m = 0; m < 4; ++m) _Pragma("unroll") for (int n = 0; n < 2; ++n) _Pragma("unroll") for (int k = 0; k < 2; ++k) \
    acc[ai][bj][m][n] = __builtin_amdgcn_mfma_f32_16x16x32_bf16(Bt[n][k], At[m][k], acc[ai][bj][m][n], 0, 0, 0); __builtin_amdgcn_s_setprio(0); } while (0)
#define PG8_WAIT_V(n) asm volatile("s_waitcnt vmcnt(" #n ")" ::: "memory")
#define PG8_WAIT_L(n) asm volatile("s_waitcnt lgkmcnt(" #n ")" ::: "memory")
#define PG8_BAR __builtin_amdgcn_s_barrier()
#define PG8_SCHED __builtin_amdgcn_sched_barrier(0)
  Unit cur, nxt; int ui = 0;
  if (!S.next(0, cur)) return;
  f32x4 acc[2][2][4][2];
#pragma unroll
  for (int a = 0; a < 2; ++a)
#pragma unroll
    for (int b = 0; b < 2; ++b)
#pragma unroll
      for (int m = 0; m < 4; ++m)
#pragma unroll
        for (int n = 0; n < 2; ++n) acc[a][b][m][n] = (f32x4){0.f, 0.f, 0.f, 0.f};
  bf16x8 At[4][2], B0[2][2], B1[2][2];
  const char* cA = (const char*)g.A + (size_t)cur.pm * tstepA + PG8_AOFF(cur.pn); const char* cB = (const char*)g.Bt + (size_t)cur.pn * tstepB;
  PG8_STAGE(PG8_SB(0, 0), cB, voffB); PG8_STAGE(PG8_SA(0, 0), cA, voffA); PG8_STAGE(PG8_SB(0, 1), cB + hstepB, voffB); PG8_STAGE(PG8_SA(0, 1), cA + hstepA, voffA);
  if (wr == 1) PG8_BAR;
  PG8_WAIT_V(4); PG8_BAR;
  PG8_STAGE(PG8_SB(1, 0), cB + kstep, voffB); PG8_STAGE(PG8_SA(1, 0), cA + kstep, voffA); PG8_STAGE(PG8_SB(1, 1), cB + hstepB + kstep, voffB);
  PG8_WAIT_V(6); PG8_BAR;
  for (;;) {
    const bool has_next = S.next(ui + 1, nxt);
    const char* nA = has_next ? (const char*)g.A + (size_t)nxt.pm * tstepA + PG8_AOFF(nxt.pn) : cA; const char* nB = has_next ? (const char*)g.Bt + (size_t)nxt.pn * tstepB : cB;
#pragma unroll 1
    for (int t = 0; t < nt; t += 2) {
      const bool last = (t == nt - 2);
      const char* a1 = cA + (size_t)(t + 1) * kstep;
      const char* a2 = last ? nA : cA + (size_t)(t + 2) * kstep; const char* b2 = last ? nB : cB + (size_t)(t + 2) * kstep;
      const char* a3 = a2 + kstep; const char* b3 = b2 + kstep;
      PG8_LDB(B0, 0, 0); PG8_SCHED; PG8_LDA(At, 0, 0); PG8_STAGE(PG8_SA(1, 1), a1 + hstepA, voffA);
      PG8_WAIT_L(8); PG8_BAR; PG8_WAIT_L(0); PG8_MMA(0, 0, At, B0); PG8_BAR; PG8_SCHED;
      PG8_LDB(B1, 0, 1); PG8_STAGE(PG8_SB(0, 0), b2, voffB);
      PG8_BAR; PG8_WAIT_L(0); PG8_MMA(0, 1, At, B1); PG8_BAR;
      PG8_LDA(At, 0, 1); PG8_STAGE(PG8_SA(0, 0), a2, voffA);
      PG8_BAR; PG8_WAIT_L(0); PG8_MMA(1, 0, At, B0); PG8_BAR; PG8_SCHED;
      PG8_STAGE(PG8_SB(0, 1), b2 + hstepB, voffB);
      PG8_WAIT_V(6); PG8_BAR; PG8_MMA(1, 1, At, B1); PG8_BAR;
      PG8_LDB(B0, 1, 0); PG8_SCHED; PG8_LDA(At, 1, 0); PG8_STAGE(PG8_SA(0, 1), a2 + hstepA, voffA);
      PG8_WAIT_L(8); PG8_BAR; PG8_WAIT_L(0); PG8_MMA(0, 0, At, B0); PG8_BAR; PG8_SCHED;
      PG8_LDB(B1, 1, 1); PG8_STAGE(PG8_SB(1, 0), b3, voffB);
      PG8_BAR; PG8_WAIT_L(0); PG8_MMA(0, 1, At, B1); PG8_BAR;
      PG8_LDA(At, 1, 1); PG8_STAGE(PG8_SA(1, 0), a3, voffA);
      PG8_BAR; PG8_WAIT_L(0); PG8_MMA(1, 0, At, B0); PG8_BAR; PG8_SCHED;
      PG8_STAGE(PG8_SB(1, 1), b3 + hstepB, voffB);
      PG8_WAIT_V(6); PG8_BAR; PG8_MMA(1, 1, At, B1); PG8_BAR;
    }
    if constexpr (!Epi::AFTER_DRAIN) E(acc, cur, wr, wc, fr, fq);
    if (!has_next) break;
#pragma unroll
    for (int a = 0; a < 2; ++a)
#pragma unroll
      for (int b = 0; b < 2; ++b)
#pragma unroll
        for (int m = 0; m < 4; ++m)
#pragma unroll
          for (int n = 0; n < 2; ++n) acc[a][b][m][n] = (f32x4){0.f, 0.f, 0.f, 0.f};
    cur = nxt; cA = nA; cB = nB; ++ui;
  }
  PG8_WAIT_V(0);
  if (wr == 0) PG8_BAR;
  PG8_BAR;
  if constexpr (Epi::AFTER_DRAIN) E.fused(acc, cur, wr, wc, fr, fq, lds);
#undef PG8_AOFF
#undef PG8_SA
#undef PG8_SB
#undef PG8_STAGE
#undef PG8_LDA
#undef PG8_LDB
#undef PG8_MMA
#undef PG8_WAIT_V
#undef PG8_WAIT_L
#undef PG8_BAR
#undef PG8_SCHED
}
}
using pg8::Unit;
typedef const f32x4 (&AccRef)[2][2][4][2];

#define EPI_ROWS(...) _Pragma("unroll") for (int ai = 0; ai < 2; ++ai) _Pragma("unroll") for (int m = 0; m < 4; ++m) { const int row = u.pm * 256 + ai * 128 + wr * 64 + m * 16 + fr; __VA_ARGS__ }
#define EPI_COLS(...) _Pragma("unroll") for (int bj = 0; bj < 2; ++bj) _Pragma("unroll") for (int n = 0; n < 2; ++n) { const int cb = u.pn * 256 + bj * 128 + wc * 32 + n * 16; const f32x4 a = acc[ai][bj][m][n]; __VA_ARGS__ }

struct EpiHgIn {
  static constexpr bool AFTER_DRAIN = false;
  u16 *q, *v, *sg; _Float16* lf; const float* lb;
  __device__ __forceinline__ void operator()(AccRef acc, const Unit& u, int wr, int wc, int fr, int fq) const {
    const int region = u.pn >> 2;
    f32x4 l4[2][2];
    if (region == 1 || region == 2) {
#pragma unroll
      for (int bj = 0; bj < 2; ++bj)
#pragma unroll
        for (int n = 0; n < 2; ++n) l4[bj][n] = *(const f32x4*)&lb[(region - 1) * 1024 + ((u.pn * 256 + bj * 128 + wc * 32 + n * 16) & 1023) + fq * 4];
    }
    EPI_ROWS( EPI_COLS(
      const int c = (cb & 1023) + fq * 4;
      if (region == 0) {
        const float s = 0.08838834764831845f;
        *(uint2*)&q[(size_t)row * 1024 + c] = pack4(siluf_(a[0]) * s, siluf_(a[1]) * s, siluf_(a[2]) * s, siluf_(a[3]) * s);
      } else if (region <= 2) {
        const int d = region - 1;
        h4 o;
        _Pragma("unroll") for (int j = 0; j < 4; ++j) { float f = l4[bj][n][j] + (1.0f - l4[bj][n][j]) * sigmoidf_(a[j]); o[j] = (_Float16)__logf(f); }
        *(h4*)&lf[(size_t)row * 2048 + d * 1024 + c] = o;
      } else if (region == 3) {
        *(uint2*)&v[(size_t)row * 1024 + c] = pack4(a[0], a[1], a[2], a[3]);
      } else {
        *(uint2*)&sg[(size_t)row * 1024 + c] = pack4(siluf_(a[0]), siluf_(a[1]), siluf_(a[2]), siluf_(a[3]));
      }
    ) )
  }
};

struct EpiRes {
  static constexpr bool AFTER_DRAIN = false;
  const float* xin_p; const float* xin_s; float* Y; const float* gate;
  __device__ __forceinline__ void operator()(AccRef acc, const Unit& u, int wr, int wc, int fr, int fq) const {
    EPI_ROWS(
      const float* xr = row < NPROMPT ? xin_p + (size_t)row * 1024 : xin_s + (size_t)(row - NPROMPT) * 1024;
      const float* g = gate + cond_of(row) * 3072;
      EPI_COLS(
        const int c = cb + fq * 4;
        f32x4 x = *(const f32x4*)&xr[c];
        f32x4 gg = *(const f32x4*)&g[c];
        f32x4 y;
        _Pragma("unroll") for (int j = 0; j < 4; ++j) y[j] = DN_ALPHA * x[j] + gg[j] * a[j];
        *(f32x4*)&Y[(size_t)row * 1024 + c] = y;
      ) )
  }
};

template <bool XIN_BF, bool XOUT_BF>
struct EpiResLn {
  static constexpr bool AFTER_DRAIN = true;
  const float* xin_p; const float* xin_s; const u16* xin_b; float* X; u16* XB; const float* gate; const float* lg; const float* lbias; const float* modn; u16* H;
  unsigned long long* slots; unsigned* cnt;
  __device__ __forceinline__ void fused(f32x4 (&acc)[2][2][4][2], const Unit& u, int wr, int wc, int fr, int fq, LAS unsigned char* lds) const {
    LAS float* part = (LAS float*)lds;
    LAS float* stat = part + 2048;
    const int tid = threadIdx.x;
    const int cnd = cond_of(u.pm * 256);
    f32x4 gv[2][2];
#pragma unroll
    for (int bj = 0; bj < 2; ++bj)
#pragma unroll
      for (int n = 0; n < 2; ++n) gv[bj][n] = *(const f32x4*)&gate[cnd * 3072 + u.pn * 256 + bj * 128 + wc * 32 + n * 16 + fq * 4];
#pragma unroll
    for (int ai = 0; ai < 2; ++ai)
#pragma unroll
      for (int m = 0; m < 4; ++m) {
        const int rl = ai * 128 + wr * 64 + m * 16 + fr;
        const int row = u.pm * 256 + rl;
        const float* xr = row < NPROMPT ? xin_p + (size_t)row * 1024 : xin_s + (size_t)(row - NPROMPT) * 1024;
        float s1 = 0.f, s2 = 0.f;
#pragma unroll
        for (int bj = 0; bj < 2; ++bj)
#pragma unroll
          for (int n = 0; n < 2; ++n) {
            const int c = u.pn * 256 + bj * 128 + wc * 32 + n * 16 + fq * 4;
            f32x4 x;
            if constexpr (XIN_BF) { const uint2 xb2 = *(const uint2*)&xin_b[(size_t)row * 1024 + c]; x = f32x4{lo16(xb2.x), hi16(xb2.x), lo16(xb2.y), hi16(xb2.y)}; }
            else x = *(const f32x4*)&xr[c];
            const f32x4 gg = gv[bj][n];
            f32x4 y;
#pragma unroll
            for (int j = 0; j < 4; ++j) { y[j] = DN_ALPHA * x[j] + gg[j] * acc[ai][bj][m][n][j]; s1 += y[j]; s2 += y[j] * y[j]; }
            acc[ai][bj][m][n] = y;
          }
        s1 += __shfl_xor(s1, 16); s1 += __shfl_xor(s1, 32);
        s2 += __shfl_xor(s2, 16); s2 += __shfl_xor(s2, 32);
        if (fq == 0) { part[(rl * 4 + wc) * 2] = s1; part[(rl * 4 + wc) * 2 + 1] = s2; }
      }
    __syncthreads();
    if (tid < 256) {
      float S1 = 0.f, S2 = 0.f;
#pragma unroll
      for (int w2 = 0; w2 < 4; ++w2) { S1 += part[(tid * 4 + w2) * 2]; S2 += part[(tid * 4 + w2) * 2 + 1]; }
      const unsigned long long v = (unsigned long long)__float_as_uint(S1) | ((unsigned long long)__float_as_uint(S2) << 32);
      __hip_atomic_store(&slots[(size_t)(u.pm * 4 + u.pn) * 256 + tid], v, __ATOMIC_RELAXED, __HIP_MEMORY_SCOPE_AGENT);
    }
    asm volatile("s_waitcnt vmcnt(0)" ::: "memory");
    __syncthreads();
    if (tid == 0) {
      __hip_atomic_fetch_add(&cnt[u.pm], 1u, __ATOMIC_RELAXED, __HIP_MEMORY_SCOPE_AGENT);
      unsigned sp = 0;
      while (__hip_atomic_load(&cnt[u.pm], __ATOMIC_RELAXED, __HIP_MEMORY_SCOPE_AGENT) < 4u) { __builtin_amdgcn_s_sleep(1); if (++sp > (1u << 24)) break; }
    }
    __syncthreads();
    if (tid < 256) {
      float T1 = 0.f, T2 = 0.f;
#pragma unroll
      for (int o = 0; o < 4; ++o) {
        const unsigned long long v = __hip_atomic_load(&slots[(size_t)(u.pm * 4 + o) * 256 + tid], __ATOMIC_RELAXED, __HIP_MEMORY_SCOPE_AGENT);
        T1 += __uint_as_float((unsigned)(v & 0xffffffffull)); T2 += __uint_as_float((unsigned)(v >> 32));
      }
      const float mu = T1 * (1.0f / 1024.0f);
      const float var = fmaxf(T2 * (1.0f / 1024.0f) - mu * mu, 0.f);
      stat[tid * 2] = mu; stat[tid * 2 + 1] = rsqrtf(var + 1e-5f);
    }
    __syncthreads();
#pragma unroll
    for (int bj = 0; bj < 2; ++bj) {
      f32x4 lgv[2], lbv[2], shv[2], scv[2];
#pragma unroll
      for (int n = 0; n < 2; ++n) {
        const int c = u.pn * 256 + bj * 128 + wc * 32 + n * 16 + fq * 4;
        lgv[n] = *(const f32x4*)&lg[c]; lbv[n] = *(const f32x4*)&lbias[c];
        shv[n] = *(const f32x4*)&modn[cnd * 3072 + c]; scv[n] = *(const f32x4*)&modn[cnd * 3072 + 1024 + c];
      }
#pragma unroll
      for (int ai = 0; ai < 2; ++ai)
#pragma unroll
        for (int m = 0; m < 4; ++m) {
          const int rl = ai * 128 + wr * 64 + m * 16 + fr;
          const int row = u.pm * 256 + rl;
          const float mu = stat[rl * 2], rs = stat[rl * 2 + 1];
#pragma unroll
          for (int n = 0; n < 2; ++n) {
            const int c = u.pn * 256 + bj * 128 + wc * 32 + n * 16 + fq * 4;
            const f32x4 y = acc[ai][bj][m][n];
            f32x4 xo;
#pragma unroll
            for (int j = 0; j < 4; ++j) xo[j] = (y[j] - mu) * rs * lgv[n][j] + lbv[n][j];
            if constexpr (XOUT_BF) *(uint2*)&XB[(size_t)row * 1024 + c] = pack4(xo[0], xo[1], xo[2], xo[3]);
            else *(f32x4*)&X[(size_t)row * 1024 + c] = xo;
            if (H) {
              *(uint2*)&H[(size_t)row * 1024 + c] = pack4(xo[0] * (1 + scv[n][0]) + shv[n][0], xo[1] * (1 + scv[n][1]) + shv[n][1], xo[2] * (1 + scv[n][2]) + shv[n][2], xo[3] * (1 + scv[n][3]) + shv[n][3]);
            }
          }
        }
    }
  }
};

struct EpiScIn {
  static constexpr bool AFTER_DRAIN = false;
  u16 *pb, *sb;
  __device__ __forceinline__ void operator()(AccRef acc, const Unit& u, int wr, int wc, int fr, int fq) const {
    const int c = u.pn * 64 + wc * 16 + fq * 4;
    EPI_ROWS(
      const f32x4 bg = acc[ai][0][m][0], cgv = acc[ai][0][m][1], v = acc[ai][1][m][0], g = acc[ai][1][m][1];
      *(uint2*)&pb[(size_t)row * 1024 + c] = pack4(cgv[0] * v[0], cgv[1] * v[1], cgv[2] * v[2], cgv[3] * v[3]);
      *(uint2*)&sb[(size_t)row * 1024 + c] = pack4(siluf_(g[0]) * bg[0], siluf_(g[1]) * bg[1], siluf_(g[2]) * bg[2], siluf_(g[3]) * bg[3]);
    )
  }
};

struct EpiRgIn {
  static constexpr bool AFTER_DRAIN = false;
  u16 *ub, *sg;
  __device__ __forceinline__ void operator()(AccRef acc, const Unit& u, int wr, int wc, int fr, int fq) const {
    const int region = u.pn >> 2;
    EPI_ROWS( EPI_COLS(
      const int c = (cb & 1023) + fq * 4;
      if (region == 0) *(uint2*)&ub[(size_t)row * 1024 + c] = pack4(a[0], a[1], a[2], a[3]);
      else *(uint2*)&sg[(size_t)row * 1024 + c] = pack4(siluf_(a[0]), siluf_(a[1]), siluf_(a[2]), siluf_(a[3]));
    ) )
  }
};

struct EpiRgGate {
  static constexpr bool AFTER_DRAIN = false;
  u16 *rb, *ib; const float* bgate;
  __device__ __forceinline__ void operator()(AccRef acc, const Unit& u, int wr, int wc, int fr, int fq) const {
    const int mat = u.pn >> 1, d = mat >> 2, hd = mat & 3;
    f32x4 br[2], bi[2]; int ccs[2];
#pragma unroll
    for (int bj = 0; bj < 2; ++bj) {
      const int off = ((u.pn & 1) * 256 + bj * 128 + wc * 32);
      ccs[bj] = (off >> 5) * 16 + fq * 4;
      br[bj] = *(const f32x4*)&bgate[mat * 512 + ccs[bj]];
      bi[bj] = *(const f32x4*)&bgate[mat * 512 + 256 + ccs[bj]];
    }
    EPI_ROWS(
      _Pragma("unroll") for (int bj = 0; bj < 2; ++bj) {
        const f32x4 r = acc[ai][bj][m][0], ii = acc[ai][bj][m][1];
        const size_t o = ((size_t)d * TOK + row) * 1024 + hd * 256 + ccs[bj];
        *(uint2*)&rb[o] = pack4(sigmoidf_(r[0] + br[bj][0]), sigmoidf_(r[1] + br[bj][1]), sigmoidf_(r[2] + br[bj][2]), sigmoidf_(r[3] + br[bj][3]));
        *(uint2*)&ib[o] = pack4(sigmoidf_(ii[0] + bi[bj][0]), sigmoidf_(ii[1] + bi[bj][1]), sigmoidf_(ii[2] + bi[bj][2]), sigmoidf_(ii[3] + bi[bj][3]));
      } )
  }
};

struct EpiMlaIn {
  static constexpr bool AFTER_DRAIN = false;
  u16* cq; float* ckvraw; float* kperaw; u16* sg;
  __device__ __forceinline__ void operator()(AccRef acc, const Unit& u, int wr, int wc, int fr, int fq) const {
    EPI_ROWS( EPI_COLS(
      const int c = cb + fq * 4;
      if (cb < 384) *(uint2*)&cq[(size_t)row * 384 + c] = pack4(a[0], a[1], a[2], a[3]);
      else if (cb < 640) *(f32x4*)&ckvraw[(size_t)row * 256 + (c - 384)] = a;
      else if (cb < 672) *(f32x4*)&kperaw[(size_t)row * 32 + (c - 640)] = a;
      else if (cb < 1696) *(uint2*)&sg[(size_t)row * 1024 + (c - 672)] = pack4(siluf_(a[0]), siluf_(a[1]), siluf_(a[2]), siluf_(a[3]));
    ) )
  }
};

struct EpiQ {
  static constexpr bool AFTER_DRAIN = false;
  u16* q;
  __device__ __forceinline__ void operator()(AccRef acc, const Unit& u, int wr, int wc, int fr, int fq) const {
    const float sc = 0.14724444500602648f;
    EPI_ROWS( EPI_COLS(
      *(uint2*)&q[(size_t)row * 1536 + cb + fq * 4] = pack4(a[0] * sc, a[1] * sc, a[2] * sc, a[3] * sc);
    ) )
  }
};

struct EpiK {
  static constexpr bool AFTER_DRAIN = false;
  u16* Kb;
  __device__ __forceinline__ void operator()(AccRef acc, const Unit& u, int wr, int wc, int fr, int fq) const {
    EPI_ROWS( EPI_COLS(
      const int h = cb >> 6, dd = (cb & 63) + fq * 4;
      *(uint2*)&Kb[((size_t)row * 16 + h) * 96 + dd] = pack4(a[0], a[1], a[2], a[3]);
    ) )
  }
};
struct EpiV {
  static constexpr bool AFTER_DRAIN = false;
  u16* Vt;
  __device__ __forceinline__ void operator()(AccRef acc, const Unit& u, int wr, int wc, int fr, int fq) const {
    EPI_ROWS( EPI_COLS(
      *(uint2*)&Vt[(size_t)row * KVROWS + cb + fq * 4] = pack4(a[0], a[1], a[2], a[3]);
    ) )
  }
};

__device__ __forceinline__ void wconv_tile(const float* __restrict__ src, int N, int K, u16* __restrict__ dst, int k0, int n0,
                                           int perm, int mat, float* tile) {
  const int tid = threadIdx.x;
  {
    const int r = tid >> 4, c4 = (tid & 15) * 4;
#pragma unroll
    for (int i = 0; i < 2; ++i) {
      const int k = r + i * 32;
      f32x4 v = f32x4{0.f, 0.f, 0.f, 0.f};
      if (n0 + c4 < N) v = *(const f32x4*)&src[(size_t)(k0 + k) * N + n0 + c4];
      tile[k * 65 + c4 + 0] = v[0]; tile[k * 65 + c4 + 1] = v[1]; tile[k * 65 + c4 + 2] = v[2]; tile[k * 65 + c4 + 3] = v[3];
    }
  }
  __syncthreads();
  {
    const int nl = tid >> 3, kq = (tid & 7) * 8;
    const int n = n0 + nl;
    int np = n;
    if (perm == 1) { const int part = n >> 10, c = n & 1023; np = (c >> 6) * 256 + (part >> 1) * 128 + ((c >> 4) & 3) * 32 + (part & 1) * 16 + (c & 15); }
    else if (perm == 2) { const int type = n >> 8, cc = n & 255; np = mat * 512 + (cc >> 4) * 32 + type * 16 + (cc & 15); }
    else if (perm == 3) { const int hh = n >> 7, dd = n & 127; np = (dd >= 64 ? 1024 : 0) + hh * 64 + (dd & 63); }
    if (n < N) {
      unsigned w[4];
#pragma unroll
      for (int i = 0; i < 4; ++i) w[i] = pack2(tile[(kq + 2 * i) * 65 + nl], tile[(kq + 2 * i + 1) * 65 + nl]);
      *(uint4*)&dst[(size_t)np * K + k0 + kq] = make_uint4(w[0], w[1], w[2], w[3]);
    }
  }
  __syncthreads();
}

__device__ __forceinline__ void phase_prologue(const Params& p, unsigned char* smem_raw, int bid, int nb) {
  float* fs = (float*)smem_raw;
  const int tid = threadIdx.x;
  const int NMOD = 192, NWT = 4800;
  for (int it = bid; it < NMOD + 1 + NWT; it += nb) {
    if (it < NMOD) {
      const int l = it / 48, n0 = (it % 48) * 64;
      float* scond = fs;
      float* sred = fs + 5120;
      for (int i = tid; i < 5120; i += NT) {
        const int ci = i >> 10, k = i & 1023;
        float cv = ci == 0 ? p.in[7][k] : p.in[6][(ci - 1) * 1024 + k];
        scond[i] = siluf_(cv);
      }
      __syncthreads();
      const int col = tid & 63, kg = tid >> 6;
      const float* w = p.in[8] + (size_t)l * 1024 * 3072 + n0 + col;
      float a0 = 0, a1 = 0, a2 = 0, a3 = 0, a4 = 0;
#pragma unroll 16
      for (int k = kg * 128; k < kg * 128 + 128; ++k) {
        float wv = w[(size_t)k * 3072];
        a0 += scond[k] * wv; a1 += scond[1024 + k] * wv; a2 += scond[2048 + k] * wv; a3 += scond[3072 + k] * wv; a4 += scond[4096 + k] * wv;
      }
      sred[(kg * 5 + 0) * 64 + col] = a0; sred[(kg * 5 + 1) * 64 + col] = a1; sred[(kg * 5 + 2) * 64 + col] = a2;
      sred[(kg * 5 + 3) * 64 + col] = a3; sred[(kg * 5 + 4) * 64 + col] = a4;
      __syncthreads();
      float* mod = (float*)(p.ws + WS_MOD);
      if (tid < 320) {
        const int ci = tid >> 6, cc = tid & 63;
        float s = 0;
#pragma unroll
        for (int g = 0; g < 8; ++g) s += sred[(g * 5 + ci) * 64 + cc];
        mod[(l * 5 + ci) * 3072 + n0 + cc] = s + p.in[9][l * 3072 + n0 + cc];
      }
      __syncthreads();
    } else if (it == NMOD) {
      float* lb = (float*)(p.ws + WS_LB);
      for (int i = tid; i < 2048; i += NT) {
        const int d = i >> 10, c = i & 1023;
        const float* lg = p.in[13] + d * 5 * 1024 + c;
        float m = lg[0];
        for (int j = 1; j < 5; ++j) m = fmaxf(m, lg[j * 1024]);
        float s = 0;
        for (int j = 0; j < 5; ++j) s += expf(lg[j * 1024] - m);
        lb[i] = expf(lg[0] - m) / s;
      }
      int* cnt = (int*)(p.ws + WS_CNT);
      if (tid < 16) cnt[tid] = 0;
    } else {
      int t = it - NMOD - 1;
      const float* src; u16* dst; int N, K, perm = 0, mat = 0, ntn;
      if (t < 1280) { src = p.in[12]; dst = (u16*)(p.ws + WS_W_HG_IN); N = 5120; K = 1024; }
      else if ((t -= 1280) < 256) { src = p.in[15]; dst = (u16*)(p.ws + WS_W_HG_OUT); N = 1024; K = 1024; }
      else if ((t -= 256) < 1024) { src = p.in[16]; dst = (u16*)(p.ws + WS_W_SC_IN); N = 4096; K = 1024; perm = 1; }
      else if ((t -= 1024) < 256) { src = p.in[19]; dst = (u16*)(p.ws + WS_W_SC_OUT); N = 1024; K = 1024; }
      else if ((t -= 256) < 512) { src = p.in[20]; dst = (u16*)(p.ws + WS_W_RG_IN); N = 2048; K = 1024; }
      else if ((t -= 512) < 256) { mat = t >> 5; t &= 31; src = p.in[23] + (size_t)mat * 256 * 512; dst = (u16*)(p.ws + WS_W_RG_GATE); N = 512; K = 256; perm = 2; }
      else if ((t -= 256) < 256) { src = p.in[26]; dst = (u16*)(p.ws + WS_W_RG_OUT); N = 1024; K = 1024; }
      else if ((t -= 256) < 432) { src = p.in[27]; dst = (u16*)(p.ws + WS_W_MLA_IN); N = 1696; K = 1024; }
      else if ((t -= 432) < 144) { src = p.in[30]; dst = (u16*)(p.ws + WS_W_QB); N = 1536; K = 384; }
      else if ((t -= 144) < 128) { src = p.in[31]; dst = (u16*)(p.ws + WS_W_KVB); N = 2048; K = 256; perm = 3; }
      else { t -= 128; src = p.in[32]; dst = (u16*)(p.ws + WS_W_MLA_OUT); N = 1024; K = 1024; }
      ntn = (N + 63) >> 6;
      const int kt = t / ntn, ntl = t - kt * ntn;
      wconv_tile(src, N, K, dst, kt * 64, ntl * 64, perm, mat, fs);
    }
  }
}

__device__ __forceinline__ void phase_h0(const Params& p, int bid, int nb) {
  const float* mod = (const float*)(p.ws + WS_MOD);
  u16* H = (u16*)(p.ws + WS_H);
  const size_t total = (size_t)TOK * 256;
  for (size_t i = (size_t)bid * NT + threadIdx.x; i < total; i += (size_t)nb * NT) {
    const int row = (int)(i >> 8), c = ((int)i & 255) * 4;
    const float* xr = row < NPROMPT ? p.in[0] + (size_t)row * 1024 : p.in[1] + (size_t)(row - NPROMPT) * 1024;
    const float* m = mod + cond_of(row) * 3072;
    f32x4 x = *(const f32x4*)&xr[c];
    f32x4 sh = *(const f32x4*)&m[c];
    f32x4 sc = *(const f32x4*)&m[1024 + c];
    *(uint2*)&H[(size_t)row * 1024 + c] = pack4(x[0] * (1 + sc[0]) + sh[0], x[1] * (1 + sc[1]) + sh[1], x[2] * (1 + sc[2]) + sh[2], x[3] * (1 + sc[3]) + sh[3]);
  }
}

__device__ __forceinline__ void phase_ln(const Params& p, int l, int bid, int nb) {
  float* X = p.out;
  const float* g = p.in[10] + l * 1024;
  const float* b = p.in[11] + l * 1024;
  const float* mod = (const float*)(p.ws + WS_MOD) + (l + 1) * 5 * 3072;
  u16* H = (u16*)(p.ws + WS_H);
  const int lane = threadIdx.x & 63, wave = threadIdx.x >> 6;
  for (int row = bid * NW + wave; row < TOK; row += nb * NW) {
    float* xr = X + (size_t)row * 1024;
    f32x4 v[4];
    float s = 0;
#pragma unroll
    for (int i = 0; i < 4; ++i) { v[i] = *(const f32x4*)&xr[i * 256 + lane * 4]; s += v[i][0] + v[i][1] + v[i][2] + v[i][3]; }
    const float mu = wave_sum(s) * (1.0f / 1024.0f);
    float q = 0;
#pragma unroll
    for (int i = 0; i < 4; ++i)
#pragma unroll
      for (int j = 0; j < 4; ++j) { float dd = v[i][j] - mu; q += dd * dd; }
    const float rs = rsqrtf(wave_sum(q) * (1.0f / 1024.0f) + 1e-5f);
    const float* m = mod + cond_of(row) * 3072;
#pragma unroll
    for (int i = 0; i < 4; ++i) {
      const int c = i * 256 + lane * 4;
      f32x4 gg = *(const f32x4*)&g[c], bb = *(const f32x4*)&b[c];
      f32x4 y;
#pragma unroll
      for (int j = 0; j < 4; ++j) y[j] = (v[i][j] - mu) * rs * gg[j] + bb[j];
      *(f32x4*)&xr[c] = y;
      if (l < 3) {
        f32x4 sh = *(const f32x4*)&m[c], sc = *(const f32x4*)&m[1024 + c];
        *(uint2*)&H[(size_t)row * 1024 + c] = pack4(y[0] * (1 + sc[0]) + sh[0], y[1] * (1 + sc[1]) + sh[1], y[2] * (1 + sc[2]) + sh[2], y[3] * (1 + sc[3]) + sh[3]);
      }
    }
  }
}

__device__ __forceinline__ void phase_gla(const Params& p, unsigned char* smem_raw) {
  u16* s_qrel = (u16*)smem_raw;
  u16* s_krel = s_qrel + 32 * 136;
  u16* s_qcum = s_krel + 32 * 136;
  u16* s_kdT = s_qcum + 32 * 136;
  u16* s_vT = s_kdT + 128 * 40;
  u16* s_att = s_vT + 64 * 40;
  u16* s_S = s_att + 32 * 40;
  float* s_dec = (float*)(s_S + 64 * 136);
  float* s_part = s_dec + 128;
  int* s_u = (int*)(s_part + 512);
  int* counter = (int*)(p.ws + WS_CNT);
  const u16* qg = (const u16*)(p.ws + WS_B(0));
  const u16* vg = (const u16*)(p.ws + WS_B(1));
  const _Float16* lfg = (const _Float16*)(p.ws + WS_B(3));
  u16* og = (u16*)(p.ws + WS_B(5));
  const int tid = threadIdx.x, lane = tid & 63, w = tid >> 6, fr = lane & 15, fq = lane >> 4;
  const int kk = tid & 127, th = tid >> 7;
  const int ti = w >> 2, vi = w & 3;
  const int wk = w & 3, wv = w >> 2;
  while (true) {
    if (tid == 0) *s_u = atomicAdd(counter, 1);
    __syncthreads();
    const int u = *s_u;
    __syncthreads();
    if (u >= 1152) break;
    int b, rem, start, N, sample;
    if (u < 128) { sample = 1; b = u >> 5; rem = u & 31; start = NPROMPT + b * 1024; N = 1024; }
    else { sample = 0; b = (u - 128) >> 5; rem = (u - 128) & 31; start = b * 256; N = 256; }
    const int h = rem >> 2, d = (rem >> 1) & 1, vs = rem & 1;
    const int nc = N >> 5;
    f32x4 S[2][2];
#pragma unroll
    for (int mi = 0; mi < 2; ++mi)
#pragma unroll
      for (int ni = 0; ni < 2; ++ni) {
        f32x4 s4 = f32x4{0.f, 0.f, 0.f, 0.f};
        if (sample) {
          const float* s0 = p.in[2] + ((size_t)((b * 2 + d) * 8 + h)) * 16384;
#pragma unroll
          for (int j = 0; j < 4; ++j) s4[j] = s0[(wk * 32 + mi * 16 + fq * 4 + j) * 128 + vs * 64 + wv * 32 + ni * 16 + fr];
        }
        S[mi][ni] = s4;
        *(uint2*)&s_S[(wv * 32 + ni * 16 + fr) * 136 + wk * 32 + mi * 16 + fq * 4] = pack4(s4[0], s4[1], s4[2], s4[3]);
      }
    _Float16 lfraw[8]; u16 qraw[8]; uint2 vraw;
#define GLA_LOAD(cc) do { _Pragma("unroll") for (int i = 0; i < 8; ++i) { const int tt = (cc) * 32 + th * 8 + i; const size_t tok = start + (d ? (N - 1 - tt) : tt); \
      lfraw[i] = lfg[tok * 2048 + d * 1024 + h * 128 + kk]; qraw[i] = qg[tok * 1024 + h * 128 + kk]; } \
      { const int tt = (cc) * 32 + (tid >> 4); const size_t tok = start + (d ? (N - 1 - tt) : tt); vraw = *(const uint2*)&vg[tok * 1024 + h * 128 + vs * 64 + (tid & 15) * 4]; } } while (0)
    GLA_LOAD(0);
    for (int c = 0; c < nc; ++c) {
      {
        float lfv[8], qv[8];
#pragma unroll
        for (int i = 0; i < 8; ++i) { lfv[i] = (float)lfraw[i]; qv[i] = bf2f(qraw[i]); }
        const uint2 vv = vraw;
        if (c + 1 < nc) GLA_LOAD(c + 1);
        float run = 0;
        float cs[8];
#pragma unroll
        for (int i = 0; i < 8; ++i) { run += lfv[i]; cs[i] = run; }
        s_part[th * 128 + kk] = run;
        {
          const int s = tid >> 4, v4 = (tid & 15) * 4;
          s_vT[(v4 + 0) * 40 + s] = (u16)(vv.x & 0xffff); s_vT[(v4 + 1) * 40 + s] = (u16)(vv.x >> 16);
          s_vT[(v4 + 2) * 40 + s] = (u16)(vv.y & 0xffff); s_vT[(v4 + 3) * 40 + s] = (u16)(vv.y >> 16);
        }
        __syncthreads();
        const float p0 = s_part[kk], p1 = s_part[128 + kk], p2 = s_part[256 + kk], p3 = s_part[384 + kk];
        const float off = (th > 0 ? p0 : 0.f) + (th > 1 ? p1 : 0.f) + (th > 2 ? p2 : 0.f);
        const float ref = p0 + p1, total = p0 + p1 + p2 + p3;
        unsigned kd[4];
        const float eref = __expf(ref), etr = __expf(total - ref);
#pragma unroll
        for (int i = 0; i < 8; ++i) {
          const int t = th * 8 + i;
          const float cum = off + cs[i];
          const float kf = 1.0f - __expf(lfv[i]);
          const float e1 = __expf(cum - ref), e2 = __builtin_amdgcn_rcpf(e1);
          const float qe = qv[i] * e1, ke = kf * e2;
          s_qrel[t * 136 + kk] = f2bf(qe);
          s_krel[t * 136 + kk] = f2bf(ke);
          s_qcum[t * 136 + kk] = f2bf(qe * eref);
          const u16 kdv = f2bf(ke * etr);
          if (i & 1) kd[i >> 1] |= ((unsigned)kdv) << 16; else kd[i >> 1] = kdv;
        }
        *(uint4*)&s_kdT[kk * 40 + th * 8] = make_uint4(kd[0], kd[1], kd[2], kd[3]);
        if (th == 0) s_dec[kk] = __expf(total);
      }
      __syncthreads();
      f32x4 oacc = f32x4{0.f, 0.f, 0.f, 0.f};
      {
        f32x4 att = f32x4{0.f, 0.f, 0.f, 0.f};
        const int ati = w >> 1, asi = w & 1;
#pragma unroll
        for (int ks = 0; ks < 4; ++ks) {
          if (w < 4) {
            bf16x8 a = *(const bf16x8*)&s_qrel[(ati * 16 + fr) * 136 + ks * 32 + fq * 8];
            bf16x8 bb = *(const bf16x8*)&s_krel[(asi * 16 + fr) * 136 + ks * 32 + fq * 8];
            att = __builtin_amdgcn_mfma_f32_16x16x32_bf16(a, bb, att, 0, 0, 0);
          }
          bf16x8 a2 = *(const bf16x8*)&s_qcum[(ti * 16 + fr) * 136 + ks * 32 + fq * 8];
          bf16x8 b2 = *(const bf16x8*)&s_S[(vi * 16 + fr) * 136 + ks * 32 + fq * 8];
          oacc = __builtin_amdgcn_mfma_f32_16x16x32_bf16(a2, b2, oacc, 0, 0, 0);
        }
        if (w < 4) {
#pragma unroll
          for (int j = 0; j < 4; ++j) {
            const int t = ati * 16 + fq * 4 + j, s = asi * 16 + fr;
            s_att[t * 40 + s] = (s <= t) ? f2bf(att[j]) : (u16)0;
          }
        }
      }
      __syncthreads();
      {
        bf16x8 a = *(const bf16x8*)&s_att[(ti * 16 + fr) * 40 + fq * 8];
        bf16x8 bb = *(const bf16x8*)&s_vT[(vi * 16 + fr) * 40 + fq * 8];
        oacc = __builtin_amdgcn_mfma_f32_16x16x32_bf16(a, bb, oacc, 0, 0, 0);
#pragma unroll
        for (int j = 0; j < 4; ++j) {
          const int tt = c * 32 + ti * 16 + fq * 4 + j;
          const size_t tok = start + (d ? (N - 1 - tt) : tt);
          og[((size_t)d * TOK + tok) * 1024 + h * 128 + vs * 64 + vi * 16 + fr] = f2bf(oacc[j]);
        }
        bf16x8 vf[2];
#pragma unroll
        for (int ni = 0; ni < 2; ++ni) vf[ni] = *(const bf16x8*)&s_vT[(wv * 32 + ni * 16 + fr) * 40 + fq * 8];
#pragma unroll
        for (int mi = 0; mi < 2; ++mi) {
          bf16x8 kf = *(const bf16x8*)&s_kdT[(wk * 32 + mi * 16 + fr) * 40 + fq * 8];
          f32x4 dc = *(const f32x4*)&s_dec[wk * 32 + mi * 16 + fq * 4];
#pragma unroll
          for (int ni = 0; ni < 2; ++ni) {
            f32x4 s4 = S[mi][ni];
#pragma unroll
            for (int j = 0; j < 4; ++j) s4[j] *= dc[j];
            s4 = __builtin_amdgcn_mfma_f32_16x16x32_bf16(kf, vf[ni], s4, 0, 0, 0);
            S[mi][ni] = s4;
            *(uint2*)&s_S[(wv * 32 + ni * 16 + fr) * 136 + wk * 32 + mi * 16 + fq * 4] = pack4(s4[0], s4[1], s4[2], s4[3]);
          }
        }
      }
      __syncthreads();
    }
    if (!sample) {
      float* so = p.out + OUT_HG + ((size_t)((b * 2 + d) * 8 + h)) * 16384;
#pragma unroll
      for (int mi = 0; mi < 2; ++mi)
#pragma unroll
        for (int ni = 0; ni < 2; ++ni)
#pragma unroll
          for (int j = 0; j < 4; ++j) so[(wk * 32 + mi * 16 + fq * 4 + j) * 128 + vs * 64 + wv * 32 + ni * 16 + fr] = S[mi][ni][j];
    }
  }
}

__device__ __forceinline__ void phase_hg_post(const Params& p, int bid, int nb) {
  const u16* og = (const u16*)(p.ws + WS_B(5));
  const u16* sg = (const u16*)(p.ws + WS_B(2));
  u16* a = (u16*)(p.ws + WS_B(0));
  const float* ng = p.in[14];
  const int lane = threadIdx.x & 63, wave = threadIdx.x >> 6;
  for (int row = bid * NW + wave; row < TOK; row += nb * NW) {
    const size_t base = (size_t)row * 1024 + lane * 16;
    float o[16];
    float ss = 0;
#pragma unroll
    for (int hh = 0; hh < 2; ++hh) {
      uint4 f = *(const uint4*)&og[base + hh * 8];
      uint4 bw = *(const uint4*)&og[(size_t)TOK * 1024 + base + hh * 8];
      unsigned fa[4] = {f.x, f.y, f.z, f.w}, ba[4] = {bw.x, bw.y, bw.z, bw.w};
#pragma unroll
      for (int i = 0; i < 4; ++i) {
        o[hh * 8 + 2 * i] = lo16(fa[i]) + lo16(ba[i]);
        o[hh * 8 + 2 * i + 1] = hi16(fa[i]) + hi16(ba[i]);
      }
    }
#pragma unroll
    for (int i = 0; i < 16; ++i) ss += o[i] * o[i];
    ss += __shfl_xor(ss, 1); ss += __shfl_xor(ss, 2); ss += __shfl_xor(ss, 4);
    const float rs = rsqrtf(ss * (1.0f / 128.0f) + 1e-6f);
#pragma unroll
    for (int hh = 0; hh < 2; ++hh) {
      uint4 s = *(const uint4*)&sg[base + hh * 8];
      unsigned sa[4] = {s.x, s.y, s.z, s.w};
      unsigned r[4];
#pragma unroll
      for (int i = 0; i < 4; ++i) {
        const int c = lane * 16 + hh * 8 + 2 * i;
        r[i] = pack2(o[hh * 8 + 2 * i] * rs * ng[c] * lo16(sa[i]), o[hh * 8 + 2 * i + 1] * rs * ng[c + 1] * hi16(sa[i]));
      }
      *(uint4*)&a[base + hh * 8] = make_uint4(r[0], r[1], r[2], r[3]);
    }
  }
}

__device__ __forceinline__ void seq_pos(int tok, int& n, int& L) {
  if (tok < NPROMPT) { n = tok & 255; L = 256; } else { n = (tok - NPROMPT) & 1023; L = 1024; }
}
__device__ __forceinline__ void phase_sc_conv(const Params& p, int bid, int nb) {
  const u16* pb = (const u16*)(p.ws + WS_B(0));
  const u16* sb = (const u16*)(p.ws + WS_B(1));
  u16* a = (u16*)(p.ws + WS_B(2));
  const float* cw = p.in[17]; const float* cbias = p.in[18];
  const size_t total = (size_t)TOK * 128;
  for (size_t i = (size_t)bid * NT + threadIdx.x; i < total; i += (size_t)nb * NT) {
    const int tok = (int)(i >> 7), c = ((int)i & 127) * 8;
    int n, L; seq_pos(tok, n, L);
    const size_t base = (size_t)tok * 1024 + c;
    uint4 z = make_uint4(0, 0, 0, 0);
    uint4 pm = n > 0 ? *(const uint4*)&pb[base - 1024] : z;
    uint4 p0 = *(const uint4*)&pb[base];
    uint4 pp = n < L - 1 ? *(const uint4*)&pb[base + 1024] : z;
    uint4 s = *(const uint4*)&sb[base];
    unsigned am[4] = {pm.x, pm.y, pm.z, pm.w}, a0[4] = {p0.x, p0.y, p0.z, p0.w}, ap[4] = {pp.x, pp.y, pp.z, pp.w}, as[4] = {s.x, s.y, s.z, s.w};
    unsigned r[4];
#pragma unroll
    for (int k = 0; k < 4; ++k) {
      const int c0 = c + 2 * k, c1 = c0 + 1;
      float z0 = cw[c0] * lo16(am[k]) + cw[1024 + c0] * lo16(a0[k]) + cw[2048 + c0] * lo16(ap[k]) + cbias[c0];
      float z1 = cw[c1] * hi16(am[k]) + cw[1024 + c1] * hi16(a0[k]) + cw[2048 + c1] * hi16(ap[k]) + cbias[c1];
      r[k] = pack2(lo16(as[k]) * z0, hi16(as[k]) * z1);
    }
    *(uint4*)&a[base] = make_uint4(r[0], r[1], r[2], r[3]);
  }
}
__device__ __forceinline__ void phase_rg_conv(const Params& p, int bid, int nb) {
  const u16* ub = (const u16*)(p.ws + WS_B(0));
  u16* uc = (u16*)(p.ws + WS_B(2));
  const float* cw = p.in[21]; const float* cbias = p.in[22];
  const size_t total = (size_t)TOK * 128;
  for (size_t i = (size_t)bid * NT + threadIdx.x; i < total; i += (size_t)nb * NT) {
    const int tok = (int)(i >> 7), c = ((int)i & 127) * 8;
    int n, L; seq_pos(tok, n, L);
    const size_t base = (size_t)tok * 1024 + c;
    uint4 z = make_uint4(0, 0, 0, 0);
    uint4 q0 = n > 1 ? *(const uint4*)&ub[base - 2048] : z;
    uint4 q1 = n > 0 ? *(const uint4*)&ub[base - 1024] : z;
    uint4 q2 = *(const uint4*)&ub[base];
    uint4 q3 = n < L - 1 ? *(const uint4*)&ub[base + 1024] : z;
    unsigned a0[4] = {q0.x, q0.y, q0.z, q0.w}, a1[4] = {q1.x, q1.y, q1.z, q1.w}, a2[4] = {q2.x, q2.y, q2.z, q2.w}, a3[4] = {q3.x, q3.y, q3.z, q3.w};
    unsigned r[4];
#pragma unroll
    for (int k = 0; k < 4; ++k) {
      const int c0 = c + 2 * k, c1 = c0 + 1;
      float z0 = cw[c0] * lo16(a0[k]) + cw[1024 + c0] * lo16(a1[k]) + cw[2048 + c0] * lo16(a2[k]) + cw[3072 + c0] * lo16(a3[k]) + cbias[c0];
      float z1 = cw[c1] * hi16(a0[k]) + cw[1024 + c1] * hi16(a1[k]) + cw[2048 + c1] * hi16(a2[k]) + cw[3072 + c1] * hi16(a3[k]) + cbias[c1];
      r[k] = pack2(z0, z1);
    }
    *(uint4*)&uc[base] = make_uint4(r[0], r[1], r[2], r[3]);
  }
}

__device__ __forceinline__ void phase_rg_scan(const Params& p, unsigned char* smem_raw, int bid, int nb) {
  float* sA = (float*)smem_raw;
  float* sB = sA + 2048;
  const u16* rb = (const u16*)(p.ws + WS_B(3));
  const u16* ib = (const u16*)(p.ws + WS_B(5));
  const u16* uc = (const u16*)(p.ws + WS_B(2));
  const u16* sg = (const u16*)(p.ws + WS_B(1));
  u16* hfw = (u16*)(p.ws + WS_H);
  u16* yp = (u16*)(p.ws + WS_B(0));
  const int tid = threadIdx.x;
  for (int u = bid; u < 768; u += nb) {
    int sample, b, c, seg, nseg, start, cl_;
    if (u < 256) { sample = 1; b = u >> 6; cl_ = tid & 15; c = (u & 63) * 16 + cl_; seg = tid >> 4; nseg = 32; start = NPROMPT + b * 1024; }
    else { sample = 0; b = (u - 256) >> 4; cl_ = tid & 63; c = ((u - 256) & 15) * 64 + cl_; seg = tid >> 6; nseg = 8; start = b * 256; }
    const int L = nseg * 32;
#pragma unroll 1
    for (int d = 0; d < 2; ++d) {
      const float lam = p.in[25][d * 1024 + c];
      const float cl = 8.0f * log1pf(__expf(-lam));
      const u16* rp = rb + (size_t)d * TOK * 1024;
      const u16* ip = ib + (size_t)d * TOK * 1024;
      const size_t o0 = (size_t)(start + (d ? L - 1 - seg * 32 : seg * 32)) * 1024 + c;
      const long ostep = d ? -1024 : 1024;
      float av[32], xv[32];
      float Aacc = 1.f, Bacc = 0.f;
#pragma unroll
      for (int s = 0; s < 32; ++s) {
        const size_t o = o0 + s * ostep;
        const float r = bf2f(rp[o]), ig = bf2f(ip[o]), uu = bf2f(uc[o]);
        const float la = -cl * r;
        const float a = __expf(la);
        const float xin = __builtin_amdgcn_sqrtf(fmaxf(1.0f - __expf(2.0f * la), 0.f)) * (ig * uu);
        av[s] = a; xv[s] = xin;
      }
#pragma unroll
      for (int s = 0; s < 32; ++s) { Aacc *= av[s]; Bacc = av[s] * Bacc + xv[s]; }
      sA[seg * 64 + cl_] = Aacc; sB[seg * 64 + cl_] = Bacc;
      __syncthreads();
      float h = sample ? p.in[3][(b * 2 + d) * 1024 + c] : 0.f;
      for (int s2 = 0; s2 < seg; ++s2) h = sA[s2 * 64 + cl_] * h + sB[s2 * 64 + cl_];
      if (d == 0) {
#pragma unroll
        for (int s = 0; s < 32; ++s) { h = av[s] * h + xv[s]; hfw[o0 + s * ostep] = f2bf(h); }
      } else {
        float hf[32], sgv[32];
#pragma unroll
        for (int s = 0; s < 32; ++s) { const size_t o = o0 + s * ostep; hf[s] = bf2f(hfw[o]); sgv[s] = bf2f(sg[o]); }
#pragma unroll
        for (int s = 0; s < 32; ++s) { h = av[s] * h + xv[s]; yp[o0 + s * ostep] = f2bf((hf[s] + h) * sgv[s]); }
      }
      if (!sample && seg == nseg - 1) p.out[OUT_RG + (b * 2 + d) * 1024 + c] = h;
      __syncthreads();
    }
  }
}

__device__ __forceinline__ void phase_mla_norm(const Params& p, int bid, int nb) {
  u16* cq = (u16*)(p.ws + WS3_CQ);
  u16* ckvall = (u16*)(p.ws + WS3_CKVALL);
  const float* ckvraw = (const float*)(p.ws + WS3_CKVRAW);
  const float* kperaw = (const float*)(p.ws + WS3_KPERAW);
  u16* Kb = (u16*)(p.ws + WS3_K);
  const float* qn = p.in[28]; const float* kvn = p.in[29];
  const int lane = threadIdx.x & 63, wave = threadIdx.x >> 6;
  for (int row = bid * NW + wave; row < TOK + 2048; row += nb * NW) {
    if (row < TOK) {
      const int tok = row;
      const bool sample = tok >= NPROMPT;
      const int bs = (tok - NPROMPT) >> 10, n = (tok - NPROMPT) & 1023;
      const size_t kvrow = sample ? (size_t)(NPROMPT + bs * 1536 + 512 + n) : (size_t)tok;
      unsigned* cqr = (unsigned*)&cq[(size_t)tok * 384];
      unsigned cv[3]; float ss = 0;
#pragma unroll
      for (int i = 0; i < 3; ++i) { cv[i] = cqr[i * 64 + lane]; float a = lo16(cv[i]), b2 = hi16(cv[i]); ss += a * a + b2 * b2; }
      const float rsq = rsqrtf(wave_sum(ss) * (1.0f / 384.0f) + 1e-6f);
#pragma unroll
      for (int i = 0; i < 3; ++i) {
        const int k = (i * 64 + lane) * 2;
        cqr[i * 64 + lane] = pack2(lo16(cv[i]) * rsq * qn[k], hi16(cv[i]) * rsq * qn[k + 1]);
      }
      f32x4 kv = *(const f32x4*)&ckvraw[(size_t)tok * 256 + lane * 4];
      const float rsk = rsqrtf(wave_sum(kv[0] * kv[0] + kv[1] * kv[1] + kv[2] * kv[2] + kv[3] * kv[3]) * (1.0f / 256.0f) + 1e-6f);
      f32x4 g4 = *(const f32x4*)&kvn[lane * 4];
      f32x4 o4;
#pragma unroll
      for (int j = 0; j < 4; ++j) o4[j] = kv[j] * rsk * g4[j];
      *(uint2*)&ckvall[kvrow * 256 + lane * 4] = pack4(o4[0], o4[1], o4[2], o4[3]);
      if (!sample) *(f32x4*)&p.out[OUT_CKV + (size_t)tok * 256 + lane * 4] = o4;
      float v = kperaw[(size_t)tok * 32 + (lane & 31)];
      if (!sample) { if (lane < 32) p.out[OUT_KPE + (size_t)tok * 32 + lane] = v; }
      else {
        const float partner = __shfl_xor(v, 8);
        const int i16 = lane & 15;
        const float pos = (lane & 16) ? (float)(n & 63) : (float)(n >> 6);
        float sn, cs; rope_sincos(pos, i16 & 7, sn, cs);
        v = (i16 < 8) ? (v * cs - partner * sn) : (partner * sn + v * cs);
      }
      const u16 vb = f2bf(v);
#pragma unroll
      for (int i = 0; i < 8; ++i) Kb[(kvrow * 16 + (lane >> 5) + 2 * i) * 96 + 64 + (lane & 31)] = vb;
    } else {
      const int r = row - TOK, bs = r >> 9, j = r & 511;
      const size_t kvrow = (size_t)(NPROMPT + bs * 1536 + j);
      f32x4 kv = *(const f32x4*)&p.in[4][(size_t)r * 256 + lane * 4];
      *(uint2*)&ckvall[kvrow * 256 + lane * 4] = pack4(kv[0], kv[1], kv[2], kv[3]);
      const u16 vb = f2bf(p.in[5][(size_t)r * 32 + (lane & 31)]);
#pragma unroll
      for (int i = 0; i < 8; ++i) Kb[(kvrow * 16 + (lane >> 5) + 2 * i) * 96 + 64 + (lane & 31)] = vb;
    }
  }
}

__device__ __forceinline__ void phase_attn(const Params& p, unsigned char* smem_raw, int bid, int nb) {
  u16* sK = (u16*)smem_raw;
  u16* sV = sK + 64 * 104;
  const u16* qg = (const u16*)(p.ws + WS3_Q);
  const u16* Kg = (const u16*)(p.ws + WS3_K);
  const u16* Vg = (const u16*)(p.ws + WS3_VT);
  const u16* sg = (const u16*)(p.ws + WS3_SG);
  u16* ao = (u16*)(p.ws + WS_H);
  const int tid = threadIdx.x, lane = tid & 63, w = tid >> 6, fr = lane & 15, fq = lane >> 4;
  for (int u = bid; u < 1536; u += nb) {
    int tok0, kvbase, nkeys, h;
    if (u < 512) { const int b = u >> 7, r = u & 127; h = r >> 3; const int qb = r & 7; tok0 = NPROMPT + b * 1024 + qb * 128; kvbase = NPROMPT + b * 1536; nkeys = 1536; }
    else { const int uu = u - 512; const int b = uu >> 5, r = uu & 31; h = r >> 1; const int qb = r & 1; tok0 = b * 256 + qb * 128; kvbase = b * 256; nkeys = 256; }
    const int tokq = tok0 + w * 16 + fr;
    bf16x8 qf[3];
#pragma unroll
    for (int ks = 0; ks < 3; ++ks) qf[ks] = *(const bf16x8*)&qg[(size_t)tokq * 1536 + h * 96 + ks * 32 + fq * 8];
    if (u < 512) {
      const int npos = (tokq - NPROMPT) & 1023;
      const float pos = (fq & 2) ? (float)(npos & 63) : (float)(npos >> 6);
      uint4 raw = *(uint4*)&qf[2];
      unsigned rw[4] = {raw.x, raw.y, raw.z, raw.w};
#pragma unroll
      for (int i = 0; i < 4; ++i) {
        float v0 = lo16(rw[i]), v1 = hi16(rw[i]);
        const float p0 = __shfl_xor(v0, 16), p1 = __shfl_xor(v1, 16);
        float sn0, cs0, sn1, cs1;
        rope_sincos(pos, 2 * i, sn0, cs0); rope_sincos(pos, 2 * i + 1, sn1, cs1);
        v0 = (fq & 1) ? (p0 * sn0 + v0 * cs0) : (v0 * cs0 - p0 * sn0);
        v1 = (fq & 1) ? (p1 * sn1 + v1 * cs1) : (v1 * cs1 - p1 * sn1);
        rw[i] = pack2(v0, v1);
      }
      raw = make_uint4(rw[0], rw[1], rw[2], rw[3]);
      qf[2] = *(bf16x8*)&raw;
    }
    float m = -1e30f, l = 0.f;
    f32x4 oacc[4];
#pragma unroll
    for (int i = 0; i < 4; ++i) oacc[i] = f32x4{0.f, 0.f, 0.f, 0.f};
    const int ntile = nkeys >> 6;
    const int k0key = tid / 12, k0ch = tid - k0key * 12;
    const int k1key = (tid + NT) / 12, k1ch = (tid + NT) - k1key * 12;
    const int vdv = tid >> 3, vch = tid & 7;
    const u16* Kp0 = &Kg[((size_t)(kvbase + k0key) * 16 + h) * 96 + k0ch * 8];
    const u16* Kp1 = &Kg[((size_t)(kvbase + k1key) * 16 + h) * 96 + k1ch * 8];
    const u16* Vp = &Vg[(size_t)(h * 64 + vdv) * KVROWS + kvbase + vch * 8];
    uint4 kr0 = *(const uint4*)Kp0, kr1 = make_uint4(0, 0, 0, 0), vr = *(const uint4*)Vp;
    if (tid < 256) kr1 = *(const uint4*)Kp1;
    for (int kt = 0; kt < ntile; ++kt) {
      __syncthreads();
      *(uint4*)&sK[k0key * 104 + k0ch * 8] = kr0;
      if (tid < 256) *(uint4*)&sK[k1key * 104 + k1ch * 8] = kr1;
      *(uint4*)&sV[vdv * 72 + vch * 8] = vr;
      if (kt + 1 < ntile) {
        kr0 = *(const uint4*)(Kp0 + (size_t)(kt + 1) * 64 * 1536);
        if (tid < 256) kr1 = *(const uint4*)(Kp1 + (size_t)(kt + 1) * 64 * 1536);
        vr = *(const uint4*)(Vp + (kt + 1) * 64);
      }
      __syncthreads();
      f32x4 sacc[4];
#pragma unroll
      for (int ni = 0; ni < 4; ++ni) {
        sacc[ni] = f32x4{0.f, 0.f, 0.f, 0.f};
#pragma unroll
        for (int ks = 0; ks < 3; ++ks) {
          bf16x8 kf = *(const bf16x8*)&sK[(ni * 16 + fr) * 104 + ks * 32 + fq * 8];
          sacc[ni] = __builtin_amdgcn_mfma_f32_16x16x32_bf16(kf, qf[ks], sacc[ni], 0, 0, 0);
        }
      }
      float mx = -1e30f;
#pragma unroll
      for (int ni = 0; ni < 4; ++ni)
#pragma unroll
        for (int j = 0; j < 4; ++j) mx = fmaxf(mx, sacc[ni][j]);
      mx = fmaxf(mx, __shfl_xor(mx, 16));
      mx = fmaxf(mx, __shfl_xor(mx, 32));
      const float mnew = fmaxf(m, mx);
      const float alpha = __builtin_amdgcn_exp2f(m - mnew);
      m = mnew;
      float ls = 0.f;
#pragma unroll
      for (int ni = 0; ni < 4; ++ni)
#pragma unroll
        for (int j = 0; j < 4; ++j) { float e = __builtin_amdgcn_exp2f(sacc[ni][j] - mnew); sacc[ni][j] = e; ls += e; }
      l = l * alpha + ls;
      bf16x8 pf[2];
#pragma unroll
      for (int kk2 = 0; kk2 < 2; ++kk2) {
        uint2 lo = pack4(sacc[2 * kk2][0], sacc[2 * kk2][1], sacc[2 * kk2][2], sacc[2 * kk2][3]);
        uint2 hi = pack4(sacc[2 * kk2 + 1][0], sacc[2 * kk2 + 1][1], sacc[2 * kk2 + 1][2], sacc[2 * kk2 + 1][3]);
        uint4 pk = make_uint4(lo.x, lo.y, hi.x, hi.y);
        pf[kk2] = *(bf16x8*)&pk;
      }
#pragma unroll
      for (int di = 0; di < 4; ++di) {
#pragma unroll
        for (int j = 0; j < 4; ++j) oacc[di][j] *= alpha;
#pragma unroll
        for (int kk2 = 0; kk2 < 2; ++kk2) {
          uint2 v0 = *(const uint2*)&sV[(di * 16 + fr) * 72 + kk2 * 32 + fq * 4];
          uint2 v1 = *(const uint2*)&sV[(di * 16 + fr) * 72 + kk2 * 32 + 16 + fq * 4];
          uint4 vk = make_uint4(v0.x, v0.y, v1.x, v1.y);
          oacc[di] = __builtin_amdgcn_mfma_f32_16x16x32_bf16(*(bf16x8*)&vk, pf[kk2], oacc[di], 0, 0, 0);
        }
      }
    }
    l += __shfl_xor(l, 16);
    l += __shfl_xor(l, 32);
    const float inv = 1.0f / l;
#pragma unroll
    for (int di = 0; di < 4; ++di) {
      const size_t o = (size_t)tokq * 1024 + h * 64 + di * 16 + fq * 4;
      uint2 s = *(const uint2*)&sg[o];
      *(uint2*)&ao[o] = pack4(oacc[di][0] * inv * lo16(s.x), oacc[di][1] * inv * hi16(s.x), oacc[di][2] * inv * lo16(s.y), oacc[di][3] * inv * hi16(s.y));
    }
  }
}

#define XB_TMO      128
#define XB_XCNT(j)  (256  + 64 * (j))
#define XB_XSUB(j)  (1280 + 64 * (j))
#define XB_XGEN(j)  (2304 + 64 * (j))
#define XB_TOP      3328
#define XB_TOPGEN   3392
#define XCD_BAR_WORDS 3456
#define XB_SPIN_CAP (1u << 22)
__device__ __forceinline__ unsigned xb_ld(unsigned* p)              { return __hip_atomic_load(p, __ATOMIC_RELAXED, __HIP_MEMORY_SCOPE_AGENT); }
__device__ __forceinline__ unsigned xb_add(unsigned* p, unsigned v) { return __hip_atomic_fetch_add(p, v, __ATOMIC_RELAXED, __HIP_MEMORY_SCOPE_AGENT); }
__device__ __forceinline__ unsigned xb_xcc_id() { return (unsigned)__builtin_amdgcn_s_getreg((3 << 11) | 20) & 0xFu; }
#define XB_SPIN(cond, bar) do { unsigned _sp = 0; while (cond) { __builtin_amdgcn_s_sleep(1); \
    if ((++_sp & 255u) == 0u) { if (xb_ld(&(bar)[XB_TMO])) break; if (_sp > XB_SPIN_CAP) { atomicAdd(&(bar)[XB_TMO], 1u); break; } } } } while (0)
struct XcdBarrier { unsigned* bar; unsigned x; volatile LAS unsigned* st; };
__device__ __forceinline__ XcdBarrier xcd_barrier_post(unsigned* bar, volatile LAS unsigned* st) {
  XcdBarrier b; b.bar = bar; b.x = xb_xcc_id(); b.st = st;
  if (threadIdx.x == 0) (void)xb_add(&bar[XB_XCNT(b.x)], 1u);
  return b;
}
__device__ __forceinline__ void xcd_barrier_complete(unsigned* bar, unsigned x, unsigned& nloc, unsigned& nx) {
  const unsigned G = gridDim.x * gridDim.y * gridDim.z;
  unsigned sum, cnt, mine, sp = 0u;
  for (;;) {
    sum = 0u; cnt = 0u; mine = 0u;
#pragma unroll
    for (unsigned j = 0; j < 16; ++j) { const unsigned c = xb_ld(&bar[XB_XCNT(j)]); sum += c; cnt += (c > 0u) ? 1u : 0u; mine = (j == x) ? c : mine; }
    if (sum == G) break;
    __builtin_amdgcn_s_sleep(1);
    if ((++sp & 255u) == 0u) { if (xb_ld(&bar[XB_TMO])) break; if (sp > XB_SPIN_CAP) { atomicAdd(&bar[XB_TMO], 1u); break; } }
  }
  nloc = mine > 0u ? mine : 1u; nx = cnt > 0u ? cnt : 1u;
}
__device__ __forceinline__ void xcd_barrier(const XcdBarrier& b) {
  asm volatile("s_waitcnt vmcnt(0)" ::: "memory");
  __syncthreads();
  if (threadIdx.x == 0) {
    unsigned* bar = b.bar;
    __builtin_amdgcn_s_waitcnt(0);
    unsigned nloc = b.st[0], nx = b.st[1];
    if (nloc == 0u) { xcd_barrier_complete(bar, b.x, nloc, nx); b.st[0] = nloc; b.st[1] = nx; }
    const unsigned old = xb_add(&bar[XB_XSUB(b.x)], 1u);
    const unsigned gen = old / nloc;
    if (old + 1u == (gen + 1u) * nloc) {
      __builtin_amdgcn_fence(__ATOMIC_RELEASE, "agent");
      asm volatile("s_waitcnt vmcnt(0)" ::: "memory");
      const unsigned og = xb_add(&bar[XB_TOP], 1u);
      const unsigned tg = og / nx;
      if (og + 1u == (tg + 1u) * nx) xb_add(&bar[XB_TOPGEN], 1u);
      else XB_SPIN(xb_ld(&bar[XB_TOPGEN]) == tg, bar);
      __builtin_amdgcn_fence(__ATOMIC_ACQUIRE, "agent");
      xb_add(&bar[XB_XGEN(b.x)], 1u);
      asm volatile("s_waitcnt vmcnt(0)" ::: "memory");
    } else {
      XB_SPIN(xb_ld(&bar[XB_XGEN(b.x)]) == gen, bar);
      __builtin_amdgcn_fence(__ATOMIC_ACQUIRE, "agent");
      asm volatile("s_waitcnt vmcnt(0)" ::: "memory");
    }
  }
  __syncthreads();
}

#define GEMM_LDS 131072
#define DYN_LDS (GEMM_LDS + 16)
#define WS_BAR (WS_CNT + 4096ull)

#define RUN_GEMM(Aptr, LDA, Bptr, MM, NN, KK, GATE, EPI, CID) do { pg8::Gemm g_{(const u16*)(Aptr), (const u16*)(Bptr), MM, NN, KK, LDA, GATE}; \
    pg8::StaticOrder S_; S_.init(MM, NN, nb, CID); pg8::gemm_phase((LAS unsigned char*)smem_raw, g_, S_, EPI); } while (0)

__global__ void __launch_bounds__(NT, 2) mega(Params p) {
  extern __shared__ __attribute__((aligned(16))) unsigned char smem_raw[];
  const int bid = blockIdx.x, nb = gridDim.x;
  unsigned char* ws = p.ws;
  const float* mod = (const float*)(ws + WS_MOD);
  volatile LAS unsigned* xst = (volatile LAS unsigned*)((LAS unsigned char*)smem_raw + GEMM_LDS);
  XcdBarrier xb;
  if (p.phase_hi - p.phase_lo > 1) {
    if (threadIdx.x == 0) { xst[0] = 0u; xst[1] = 0u; }
    __syncthreads();
    xb = xcd_barrier_post((unsigned*)(ws + WS_BAR), xst);
  }
#define PH_BEGIN(n) if ((PHMASK & (1u << n)) && p.phase_lo <= n && n < p.phase_hi) { const int ph = n;
#define PH_FIN if (ph + 1 < p.phase_hi) { if (p.phase_lo < 0) cg::this_grid().sync(); else xcd_barrier(xb); } }
  PH_BEGIN(0) phase_prologue(p, smem_raw, bid, nb); PH_FIN
  PH_BEGIN(1) phase_h0(p, bid, nb); PH_FIN
  PH_BEGIN(2) {
    EpiHgIn e{(u16*)(ws + WS_B(0)), (u16*)(ws + WS_B(1)), (u16*)(ws + WS_B(2)), (_Float16*)(ws + WS_B(3)), (const float*)(ws + WS_LB)};
    RUN_GEMM(ws + WS_H, 1024, ws + WS_W_HG_IN, TOK, 5120, 1024, 0, e, bid);
  } PH_FIN
  PH_BEGIN(3) phase_gla(p, smem_raw); PH_FIN
  PH_BEGIN(4) phase_hg_post(p, bid, nb); PH_FIN
  PH_BEGIN(5) {
    EpiResLn<false, true> e{p.in[0], p.in[1], (const u16*)nullptr, p.out, (u16*)(ws + WS_XB), mod + 0 * 15360 + 2048, p.in[10] + 0 * 1024, p.in[11] + 0 * 1024, mod + 1 * 15360, (u16*)(ws + WS_H),
               (unsigned long long*)(ws + WS_SLOT) + 0 * 49152, (unsigned*)(ws + WS_CNT + 256) + 0 * 48};
    RUN_GEMM(ws + WS_B(0), 1024, ws + WS_W_HG_OUT, TOK, 1024, 1024, 0, e, bid);
  } PH_FIN
  PH_BEGIN(7) {
    EpiScIn e{(u16*)(ws + WS_B(0)), (u16*)(ws + WS_B(1))};
    RUN_GEMM(ws + WS_H, 1024, ws + WS_W_SC_IN, TOK, 4096, 1024, 0, e, bid);
  } PH_FIN
  PH_BEGIN(8) phase_sc_conv(p, bid, nb); PH_FIN
  PH_BEGIN(9) {
    EpiResLn<true, true> e{p.out, p.out, (const u16*)(ws + WS_XB), p.out, (u16*)(ws + WS_XB), mod + 1 * 15360 + 2048, p.in[10] + 1 * 1024, p.in[11] + 1 * 1024, mod + 2 * 15360, (u16*)(ws + WS_H),
               (unsigned long long*)(ws + WS_SLOT) + 1 * 49152, (unsigned*)(ws + WS_CNT + 256) + 1 * 48};
    RUN_GEMM(ws + WS_B(2), 1024, ws + WS_W_SC_OUT, TOK, 1024, 1024, 0, e, bid);
  } PH_FIN
  PH_BEGIN(11) {
    EpiRgIn e{(u16*)(ws + WS_B(0)), (u16*)(ws + WS_B(1))};
    RUN_GEMM(ws + WS_H, 1024, ws + WS_W_RG_IN, TOK, 2048, 1024, 0, e, bid);
  } PH_FIN
  PH_BEGIN(12) phase_rg_conv(p, bid, nb); PH_FIN
  PH_BEGIN(13) {
    EpiRgGate e{(u16*)(ws + WS_B(3)), (u16*)(ws + WS_B(5)), p.in[24]};
    RUN_GEMM(ws + WS_B(2), 1024, ws + WS_W_RG_GATE, TOK, 4096, 256, 1, e, bid);
  } PH_FIN
  PH_BEGIN(14) phase_rg_scan(p, smem_raw, bid, nb); PH_FIN
  PH_BEGIN(15) {
    EpiResLn<true, true> e{p.out, p.out, (const u16*)(ws + WS_XB), p.out, (u16*)(ws + WS_XB), mod + 2 * 15360 + 2048, p.in[10] + 2 * 1024, p.in[11] + 2 * 1024, mod + 3 * 15360, (u16*)(ws + WS_H),
               (unsigned long long*)(ws + WS_SLOT) + 2 * 49152, (unsigned*)(ws + WS_CNT + 256) + 2 * 48};
    RUN_GEMM(ws + WS_B(0), 1024, ws + WS_W_RG_OUT, TOK, 1024, 1024, 0, e, bid);
  } PH_FIN
  PH_BEGIN(17) {
    EpiMlaIn e{(u16*)(ws + WS3_CQ), (float*)(ws + WS3_CKVRAW), (float*)(ws + WS3_KPERAW), (u16*)(ws + WS3_SG)};
    RUN_GEMM(ws + WS_H, 1024, ws + WS_W_MLA_IN, TOK, 1792, 1024, 0, e, bid);
  } PH_FIN
  PH_BEGIN(18) phase_mla_norm(p, bid, nb); PH_FIN
  PH_BEGIN(19) {
    EpiQ eq{(u16*)(ws + WS3_Q)};
    RUN_GEMM(ws + WS3_CQ, 384, ws + WS_W_QB, TOK, 1536, 384, 0, eq, bid);
    EpiK ek{(u16*)(ws + WS3_K)};
    RUN_GEMM(ws + WS3_CKVALL, 256, ws + WS_W_KVB, KVROWS, 1024, 256, 0, ek, nb - 1 - bid);
    EpiV ev{(u16*)(ws + WS3_VT)};
    RUN_GEMM(ws + WS_W_KVB + 1024 * 256 * 2, 256, ws + WS3_CKVALL, 1024, KVROWS, 256, 0, ev, bid);
  } PH_FIN
  PH_BEGIN(20) phase_attn(p, smem_raw, bid, nb); PH_FIN
  PH_BEGIN(21) {
    EpiResLn<true, false> e{p.out, p.out, (const u16*)(ws + WS_XB), p.out, (u16*)nullptr, mod + 3 * 15360 + 2048, p.in[10] + 3 * 1024, p.in[11] + 3 * 1024, mod + 3 * 15360, (u16*)nullptr,
               (unsigned long long*)(ws + WS_SLOT) + 3 * 49152, (unsigned*)(ws + WS_CNT + 256) + 3 * 48};
    RUN_GEMM(ws + WS_H, 1024, ws + WS_W_MLA_OUT, TOK, 1024, 1024, 0, e, bid);
  } PH_FIN
}

extern "C" void kernel_launch(void* const* d_in, const int* in_sizes, int n_in, void* d_out, int out_size, void* d_ws, size_t ws_size,
                              hipStream_t stream) {
  static int grid_blocks = 0;
  if (!grid_blocks) {
    int dev = 0, cus = 0, per_cu = 0;
    (void)hipGetDevice(&dev);
    (void)hipDeviceGetAttribute(&cus, hipDeviceAttributeMultiprocessorCount, dev);
    (void)hipFuncSetAttribute((const void*)mega, hipFuncAttributeMaxDynamicSharedMemorySize, DYN_LDS);
    (void)hipOccupancyMaxActiveBlocksPerMultiprocessor(&per_cu, (const void*)mega, NT, DYN_LDS);
    if (per_cu < 1) per_cu = 1;
    if (per_cu > 1) per_cu = 1;
    grid_blocks = cus * per_cu;
  }
  Params p{};
  for (int i = 0; i < 33; ++i) p.in[i] = (const float*)d_in[i];
  p.out = (float*)d_out;
  p.ws = (unsigned char*)d_ws;
#if MULTI_LAUNCH
  (void)hipMemsetAsync((unsigned char*)d_ws + WS_CNT, 0, 4096 + XCD_BAR_WORDS * 4, stream);
  for (int ph = 0; ph < NPHASES; ++ph) {
    p.phase_lo = ph; p.phase_hi = ph + 1;
    hipLaunchKernelGGL(mega, dim3(grid_blocks), dim3(NT), DYN_LDS, stream, p);
#ifdef PROBE_MASK
    if ((PROBE_MASK >> ph) & 1) for (int r = 0; r < 2; ++r) {
      if (ph == 3) (void)hipMemsetAsync((unsigned char*)d_ws + WS_CNT, 0, 64, stream);
      hipLaunchKernelGGL(mega, dim3(grid_blocks), dim3(NT), DYN_LDS, stream, p);
    }
#endif
  }
#else
  p.phase_lo = 0; p.phase_hi = NPHASES;
  (void)hipMemsetAsync((unsigned char*)d_ws + WS_CNT, 0, 4096 + XCD_BAR_WORDS * 4, stream);
  void* args[] = {&p};
  hipError_t e = hipLaunchCooperativeKernel((const void*)mega, dim3(grid_blocks), dim3(NT), args, DYN_LDS, stream);
  if (e != hipSuccess) fprintf(stderr, "cooperative launch failed: %s (grid %d)\n", hipGetErrorString(e), grid_blocks);
#endif
}
```

```cpp
#include <hip/hip_runtime.h>
#include <hip/hip_cooperative_groups.h>
#include <cstdio>
namespace cg = cooperative_groups;

#ifndef MULTI_LAUNCH
#define MULTI_LAUNCH 0
#endif

typedef unsigned short u16;
using bf16x8 = __attribute__((ext_vector_type(8))) short;
using f32x4 = __attribute__((ext_vector_type(4))) float;
typedef _Float16 h4 __attribute__((ext_vector_type(4)));

#define TOK 12288
#define NPROMPT 8192
#define KVROWS 14336
#define NPHASES 23
#ifndef PHMASK
#define PHMASK 0x7fffff
#endif
#define DN_ALPHA 1.6817928305074290f

#define WS_W_HG_IN 0ull
#define WS_W_HG_OUT (WS_W_HG_IN + 10485760ull)
#define WS_W_SC_IN (WS_W_HG_OUT + 2097152ull)
#define WS_W_SC_OUT (WS_W_SC_IN + 8388608ull)
#define WS_W_RG_IN (WS_W_SC_OUT + 2097152ull)
#define WS_W_RG_GATE (WS_W_RG_IN + 4194304ull)
#define WS_W_RG_OUT (WS_W_RG_GATE + 2097152ull)
#define WS_W_MLA_IN (WS_W_RG_OUT + 2097152ull)
#define WS_W_QB (WS_W_MLA_IN + 3670016ull)
#define WS_W_KVB (WS_W_QB + 1179648ull)
#define WS_W_MLA_OUT (WS_W_KVB + 1048576ull)
#define WS_MOD (WS_W_MLA_OUT + 2097152ull)
#define WS_LB (WS_MOD + 245760ull)
#define WS_CNT (WS_LB + 8192ull)
#define WS_R (WS_CNT + 4096ull + 16384ull)
#define BSZ 25165824ull
#define WS_H (WS_R)
#define WS_B(i) (WS_R + BSZ * (1 + (i)))
#define WS_SLOT (WS_R + 201326592ull)
#define WS_XB (WS_SLOT + 1572864ull)
#define WS3_CQ (WS_R + 25165824ull)
#define WS3_CKVALL (WS_R + 34603008ull)
#define WS3_CKVRAW (WS_R + 41943040ull)
#define WS3_KPERAW (WS_R + 54525952ull)
#define WS3_SG (WS_R + 56098816ull)
#define WS3_Q (WS_R + 81264640ull)
#define WS3_K (WS_R + 119013376ull)
#define WS3_VT (WS_R + 163053568ull)

#define OUT_HG 12582912
#define OUT_RG 20971520
#define OUT_CKV 21037056
#define OUT_KPE 23134208

struct Params {
  const float* in[33];
  float* out;
  unsigned char* ws;
  int phase_lo, phase_hi, flags, pad_;
};

__device__ __forceinline__ u16 f2bf(float f) { __bf16 r = (__bf16)f; return *(u16*)&r; }
__device__ __forceinline__ float bf2f(u16 h) { return __uint_as_float(((unsigned)h) << 16); }
typedef float f2v_ __attribute__((ext_vector_type(2)));
typedef __bf16 b2v_ __attribute__((ext_vector_type(2)));
__device__ __forceinline__ unsigned pack2(float a, float b) { f2v_ f = {a, b}; b2v_ r = __builtin_convertvector(f, b2v_); return *(unsigned*)&r; }
__device__ __forceinline__ uint2 pack4(float a, float b, float c, float d) { return make_uint2(pack2(a, b), pack2(c, d)); }
__device__ __forceinline__ float lo16(unsigned u) { return __uint_as_float(u << 16); }
__device__ __forceinline__ float hi16(unsigned u) { return __uint_as_float(u & 0xffff0000u); }
__device__ __forceinline__ float sigmoidf_(float x) { return __builtin_amdgcn_rcpf(1.0f + __expf(-x)); }
__device__ __forceinline__ float siluf_(float x) { return x * __builtin_amdgcn_rcpf(1.0f + __expf(-x)); }
__device__ __forceinline__ int cond_of(int tok) { return tok < NPROMPT ? 0 : 1 + ((tok - NPROMPT) >> 10); }
__device__ __forceinline__ float wave_sum(float v) {
#pragma unroll
  for (int o = 32; o > 0; o >>= 1) v += __shfl_xor(v, o);
  return v;
}
__device__ __forceinline__ void rope_sincos(float pos, int fi, float& sn, float& cs) {
  float inv = exp2f(-(float)fi * 1.6609640474436813f);
  float ang = pos * inv;
  float k = rintf(ang * 0.15915494309189535f);
  float r = fmaf(-k, 6.2831854820251465f, ang);
  r = fmaf(-k, -1.7484555e-7f, r);
  sn = __sinf(r); cs = __cosf(r);
}

#define NT 512
#define NW 8
#define LAS __attribute__((address_space(3)))

namespace pg8 {
constexpr int BM = 256, BK = 64, HALF = 128, HTB = HALF * BK * 2, STAGE_BYTES = 8 * HTB, NXCD = 8, WGM = 8;
__device__ __forceinline__ int lds_byte(int r, int c) { const int st = (r >> 4) * 2 + (c >> 5), rr = r & 15, cc = c & 31, ob = rr * 64 + cc * 2; return st * 1024 + (ob ^ (((ob >> 9) & 1) << 5)); }
__device__ __forceinline__ void stage_rc(int b, int& R, int& C) { const int st = b / 1024, sb = b % 1024, swz = sb ^ (((sb >> 9) & 1) << 5); R = (st >> 1) * 16 + swz / 64; C = (st & 1) * 32 + (swz % 64) / 2; }
struct Unit { int pm, pn; };
struct Gemm { const u16* A; const u16* Bt; int M, N, K, lda, gate, noepi; };
struct StaticOrder {
  int nM, nN, nwg, G, c;
  __device__ void init(int M, int N, int G_, int c_) { nM = M / BM; nN = N / BM; nwg = nM * nN; G = G_; c = c_; }
  __device__ bool next(int i, Unit& u) const {
    const long L = (long)i * G + c; if (L >= nwg) return false;
    int wgid = (int)L; { const int q = nwg / NXCD, r = nwg % NXCD, xcd = wgid % NXCD, off = wgid / NXCD; wgid = (xcd < r ? xcd * (q + 1) : r * (q + 1) + (xcd - r) * q) + off; }
    const int nig = WGM * nN, gid = wgid / nig, fm = gid * WGM, gsz = (nM - fm) < WGM ? (nM - fm) : WGM;
    u.pm = fm + ((wgid % nig) % gsz); u.pn = (wgid % nig) / gsz; return true;
  }
};
template <class Epi>
__device__ __forceinline__ void gemm_phase(LAS unsigned char* lds, const Gemm g, const StaticOrder& S, const Epi& E) {
  const int tid = threadIdx.x, wid = __builtin_amdgcn_readfirstlane(tid >> 6), lane = tid & 63, wr = wid >> 2, wc = wid & 3, fr = lane & 15, fq = lane >> 4;
  const int K = g.K, nt = K / BK;
  unsigned voffA[2], voffB[2];
#pragma unroll
  for (int i = 0; i < 2; ++i) { int R, C; stage_rc(tid * 16 + i * 8192, R, C); voffA[i] = (unsigned)(R * g.lda + C) * 2u; voffB[i] = (unsigned)(R * K + C) * 2u; }
  const size_t kstep = (size_t)(BK * 2);
  const size_t hstepA = (size_t)HALF * g.lda * 2, hstepB = (size_t)HALF * K * 2;
  const size_t tstepA = 2 * hstepA, tstepB = 2 * hstepB;
  const unsigned ldsw = (unsigned)wid * 1024u;
  const int aoff = lds_byte(wr * 64 + fr, fq * 8), boff = lds_byte(wc * 32 + fr, fq * 8);
#define PG8_AOFF(pn) (g.gate ? (size_t)((((pn) >> 1) & 3) * 512) : (size_t)0)
#define PG8_SA(b, h) (((b) * 2 + (h)) * HTB)
#define PG8_SB(b, h) ((4 + (b) * 2 + (h)) * HTB)
#define PG8_STAGE(bufoff, gbase, voff) do { _Pragma("unroll") for (int _i = 0; _i < 2; ++_i) \
    __builtin_amdgcn_global_load_lds((const unsigned*)((const char*)(gbase) + (voff)[_i]), (LAS unsigned*)(lds + (bufoff) + ldsw + _i * 8192), 16, 0, 0); } while (0)
#define PG8_LDA(dst, b, h) do { _Pragma("unroll") for (int m = 0; m < 4; ++m) _Pragma("unroll") for (int k = 0; k < 2; ++k) dst[m][k] = *(const LAS bf16x8*)(lds + PG8_SA(b, h) + aoff + m * 2048 + k * 1024); } while (0)
#define PG8_LDB(dst, b, h) do { _Pragma("unroll") for (int n = 0; n < 2; ++n) _Pragma("unroll") for (int k = 0; k < 2; ++k) dst[n][k] = *(const LAS bf16x8*)(lds + PG8_SB(b, h) + boff + n * 2048 + k * 1024); } while (0)
#define PG8_MMA(ai, bj, At, Bt) do { __builtin_amdgcn_s_setprio(1); _Pragma("unroll") for (int m = 0; m < 4; ++m) _Pragma("unroll") for (int n = 0; n < 2; ++n) _Pragma("unroll") for (int k = 0; k < 2; ++k) \
    acc[ai][bj][m][n] = __builtin_amdgcn_mfma_f32_16x16x32_bf16(Bt[n][k], At[m][k], acc[ai][bj][m][n], 0, 0, 0); __builtin_amdgcn_s_setprio(0); } while (0)
#define PG8_WAIT_V(n) asm volatile("s_waitcnt vmcnt(" #n ")" ::: "memory")
#define PG8_WAIT_L(n) asm volatile("s_waitcnt lgkmcnt(" #n ")" ::: "memory")
#define PG8_BAR __builtin_amdgcn_s_barrier()
#define PG8_SCHED __builtin_amdgcn_sched_barrier(0)
  Unit cur, nxt; int ui = 0;
  if (!S.next(0, cur)) return;
  f32x4 acc[2][2][4][2];
#pragma unroll
  for (int a = 0; a < 2; ++a)
#pragma unroll
    for (int b = 0; b < 2; ++b)
#pragma unroll
      for (int m = 0; m < 4; ++m)
#pragma unroll
        for (int n = 0; n < 2; ++n) acc[a][b][m][n] = (f32x4){0.f, 0.f, 0.f, 0.f};
  bf16x8 At[4][2], B0[2][2], B1[2][2];
  const char* cA = (const char*)g.A + (size_t)cur.pm * tstepA + PG8_AOFF(cur.pn); const char* cB = (const char*)g.Bt + (size_t)cur.pn * tstepB;
  PG8_STAGE(PG8_SB(0, 0), cB, voffB); PG8_STAGE(PG8_SA(0, 0), cA, voffA); PG8_STAGE(PG8_SB(0, 1), cB + hstepB, voffB); PG8_STAGE(PG8_SA(0, 1), cA + hstepA, voffA);
  if (wr == 1) PG8_BAR;
  PG8_WAIT_V(4); PG8_BAR;
  PG8_STAGE(PG8_SB(1, 0), cB + kstep, voffB); PG8_STAGE(PG8_SA(1, 0), cA + kstep, voffA); PG8_STAGE(PG8_SB(1, 1), cB + hstepB + kstep, voffB);
  PG8_WAIT_V(6); PG8_BAR;
  for (;;) {
    const bool has_next = S.next(ui + 1, nxt);
    const char* nA = has_next ? (const char*)g.A + (size_t)nxt.pm * tstepA + PG8_AOFF(nxt.pn) : cA; const char* nB = has_next ? (const char*)g.Bt + (size_t)nxt.pn * tstepB : cB;
#pragma unroll 1
    for (int t = 0; t < nt; t += 2) {
      const bool last = (t == nt - 2);
      const char* a1 = cA + (size_t)(t + 1) * kstep;
      const char* a2 = last ? nA : cA + (size_t)(t + 2) * kstep; const char* b2 = last ? nB : cB + (size_t)(t + 2) * kstep;
      const char* a3 = a2 + kstep; const char* b3 = b2 + kstep;
      PG8_LDB(B0, 0, 0); PG8_SCHED; PG8_LDA(At, 0, 0); PG8_STAGE(PG8_SA(1, 1), a1 + hstepA, voffA);
      PG8_WAIT_L(8); PG8_BAR; PG8_WAIT_L(0); PG8_MMA(0, 0, At, B0); PG8_BAR; PG8_SCHED;
      PG8_LDB(B1, 0, 1); PG8_STAGE(PG8_SB(0, 0), b2, voffB);
      PG8_BAR; PG8_WAIT_L(0); PG8_MMA(0, 1, At, B1); PG8_BAR;
      PG8_LDA(At, 0, 1); PG8_STAGE(PG8_SA(0, 0), a2, voffA);
      PG8_BAR; PG8_WAIT_L(0); PG8_MMA(1, 0, At, B0); PG8_BAR; PG8_SCHED;
      PG8_STAGE(PG8_SB(0, 1), b2 + hstepB, voffB);
      PG8_WAIT_V(6); PG8_BAR; PG8_MMA(1, 1, At, B1); PG8_BAR;
      PG8_LDB(B0, 1, 0); PG8_SCHED; PG8_LDA(At, 1, 0); PG8_STAGE(PG8_SA(0, 1), a2 + hstepA, voffA);
      PG8_WAIT_L(8); PG8_BAR; PG8_WAIT_L(0); PG8_MMA(0, 0, At, B0); PG8_BAR; PG8_SCHED;
      PG8_LDB(B1, 1, 1); PG8_STAGE(PG8_SB(1, 0), b3, voffB);
      PG8_BAR; PG8_WAIT_L(0); PG8_MMA(0, 1, At, B1); PG8_BAR;
      PG8_LDA(At, 1, 1); PG8_STAGE(PG8_SA(1, 0), a3, voffA);
      PG8_BAR; PG8_WAIT_L(0); PG8_MMA(1, 0, At, B0); PG8_BAR; PG8_SCHED;
      PG8_STAGE(PG8_SB(1, 1), b3 + hstepB, voffB);
      PG8_WAIT_V(6); PG8_BAR; PG8_MMA(1, 1, At, B1); PG8_BAR;
    }
    if constexpr (!Epi::AFTER_DRAIN) { if (!g.noepi) E(acc, cur, wr, wc, fr, fq); }
    if (!has_next) break;
#pragma unroll
    for (int a = 0; a < 2; ++a)
#pragma unroll
      for (int b = 0; b < 2; ++b)
#pragma unroll
        for (int m = 0; m < 4; ++m)
#pragma unroll
          for (int n = 0; n < 2; ++n) acc[a][b][m][n] = (f32x4){0.f, 0.f, 0.f, 0.f};
    cur = nxt; cA = nA; cB = nB; ++ui;
  }
  PG8_WAIT_V(0);
  if (wr == 0) PG8_BAR;
  PG8_BAR;
  if constexpr (Epi::AFTER_DRAIN) { if (!g.noepi) E.fused(acc, cur, wr, wc, fr, fq, lds); }
#undef PG8_AOFF
#undef PG8_SA
#undef PG8_SB
#undef PG8_STAGE
#undef PG8_LDA
#undef PG8_LDB
#undef PG8_MMA
#undef PG8_WAIT_V
#undef PG8_WAIT_L
#undef PG8_BAR
#undef PG8_SCHED
}
}
using pg8::Unit;
typedef const f32x4 (&AccRef)[2][2][4][2];

#define EPI_ROWS(...) _Pragma("unroll") for (int ai = 0; ai < 2; ++ai) _Pragma("unroll") for (int m = 0; m < 4; ++m) { const int row = u.pm * 256 + ai * 128 + wr * 64 + m * 16 + fr; __VA_ARGS__ }
#define EPI_COLS(...) _Pragma("unroll") for (int bj = 0; bj < 2; ++bj) _Pragma("unroll") for (int n = 0; n < 2; ++n) { const int cb = u.pn * 256 + bj * 128 + wc * 32 + n * 16; const f32x4 a = acc[ai][bj][m][n]; __VA_ARGS__ }

struct EpiHgIn {
  static constexpr bool AFTER_DRAIN = false;
  u16 *q, *v, *sg; _Float16* lf; const float* lb;
  __device__ __forceinline__ void operator()(AccRef acc, const Unit& u, int wr, int wc, int fr, int fq) const {
    const int region = u.pn >> 2;
    f32x4 l4[2][2];
    if (region == 1 || region == 2) {
#pragma unroll
      for (int bj = 0; bj < 2; ++bj)
#pragma unroll
        for (int n = 0; n < 2; ++n) l4[bj][n] = *(const f32x4*)&lb[(region - 1) * 1024 + ((u.pn * 256 + bj * 128 + wc * 32 + n * 16) & 1023) + fq * 4];
    }
    EPI_ROWS( EPI_COLS(
      const int c = (cb & 1023) + fq * 4;
      if (region == 0) {
        const float s = 0.08838834764831845f;
        *(uint2*)&q[(size_t)row * 1024 + c] = pack4(siluf_(a[0]) * s, siluf_(a[1]) * s, siluf_(a[2]) * s, siluf_(a[3]) * s);
      } else if (region <= 2) {
        const int d = region - 1;
        h4 o;
        _Pragma("unroll") for (int j = 0; j < 4; ++j) { float f = l4[bj][n][j] + (1.0f - l4[bj][n][j]) * sigmoidf_(a[j]); o[j] = (_Float16)__logf(f); }
        *(h4*)&lf[(size_t)row * 2048 + d * 1024 + c] = o;
      } else if (region == 3) {
        *(uint2*)&v[(size_t)row * 1024 + c] = pack4(a[0], a[1], a[2], a[3]);
      } else {
        *(uint2*)&sg[(size_t)row * 1024 + c] = pack4(siluf_(a[0]), siluf_(a[1]), siluf_(a[2]), siluf_(a[3]));
      }
    ) )
  }
};

struct EpiRes {
  static constexpr bool AFTER_DRAIN = false;
  const float* xin_p; const float* xin_s; float* Y; const float* gate;
  __device__ __forceinline__ void operator()(AccRef acc, const Unit& u, int wr, int wc, int fr, int fq) const {
    EPI_ROWS(
      const float* xr = row < NPROMPT ? xin_p + (size_t)row * 1024 : xin_s + (size_t)(row - NPROMPT) * 1024;
      const float* g = gate + cond_of(row) * 3072;
      EPI_COLS(
        const int c = cb + fq * 4;
        f32x4 x = *(const f32x4*)&xr[c];
        f32x4 gg = *(const f32x4*)&g[c];
        f32x4 y;
        _Pragma("unroll") for (int j = 0; j < 4; ++j) y[j] = DN_ALPHA * x[j] + gg[j] * a[j];
        *(f32x4*)&Y[(size_t)row * 1024 + c] = y;
      ) )
  }
};

template <bool XIN_BF, bool XOUT_BF>
struct EpiResLn {
  static constexpr bool AFTER_DRAIN = true;
  const float* xin_p; const float* xin_s; const u16* xin_b; float* X; u16* XB; const float* gate; const float* lg; const float* lbias; const float* modn; u16* H;
  unsigned long long* slots; unsigned* cnt;
  __device__ __forceinline__ void fused(f32x4 (&acc)[2][2][4][2], const Unit& u, int wr, int wc, int fr, int fq, LAS unsigned char* lds) const {
    LAS float* part = (LAS float*)lds;
    LAS float* stat = part + 2048;
    const int tid = threadIdx.x;
    const int cnd = cond_of(u.pm * 256);
    f32x4 gv[2][2];
#pragma unroll
    for (int bj = 0; bj < 2; ++bj)
#pragma unroll
      for (int n = 0; n < 2; ++n) gv[bj][n] = *(const f32x4*)&gate[cnd * 3072 + u.pn * 256 + bj * 128 + wc * 32 + n * 16 + fq * 4];
#pragma unroll
    for (int ai = 0; ai < 2; ++ai)
#pragma unroll
      for (int m = 0; m < 4; ++m) {
        const int rl = ai * 128 + wr * 64 + m * 16 + fr;
        const int row = u.pm * 256 + rl;
        const float* xr = row < NPROMPT ? xin_p + (size_t)row * 1024 : xin_s + (size_t)(row - NPROMPT) * 1024;
        float s1 = 0.f, s2 = 0.f;
#pragma unroll
        for (int bj = 0; bj < 2; ++bj)
#pragma unroll
          for (int n = 0; n < 2; ++n) {
            const int c = u.pn * 256 + bj * 128 + wc * 32 + n * 16 + fq * 4;
            f32x4 x;
            if constexpr (XIN_BF) { const uint2 xb2 = *(const uint2*)&xin_b[(size_t)row * 1024 + c]; x = f32x4{lo16(xb2.x), hi16(xb2.x), lo16(xb2.y), hi16(xb2.y)}; }
            else x = *(const f32x4*)&xr[c];
            const f32x4 gg = gv[bj][n];
            f32x4 y;
#pragma unroll
            for (int j = 0; j < 4; ++j) { y[j] = DN_ALPHA * x[j] + gg[j] * acc[ai][bj][m][n][j]; s1 += y[j]; s2 += y[j] * y[j]; }
            acc[ai][bj][m][n] = y;
          }
        s1 += __shfl_xor(s1, 16); s1 += __shfl_xor(s1, 32);
        s2 += __shfl_xor(s2, 16); s2 += __shfl_xor(s2, 32);
        if (fq == 0) { part[(rl * 4 + wc) * 2] = s1; part[(rl * 4 + wc) * 2 + 1] = s2; }
      }
    __syncthreads();
    if (tid < 256) {
      float S1 = 0.f, S2 = 0.f;
#pragma unroll
      for (int w2 = 0; w2 < 4; ++w2) { S1 += part[(tid * 4 + w2) * 2]; S2 += part[(tid * 4 + w2) * 2 + 1]; }
      const unsigned long long v = (unsigned long long)__float_as_uint(S1) | ((unsigned long long)__float_as_uint(S2) << 32);
      __hip_atomic_store(&slots[(size_t)(u.pm * 4 + u.pn) * 256 + tid], v, __ATOMIC_RELAXED, __HIP_MEMORY_SCOPE_AGENT);
    }
    asm volatile("s_waitcnt vmcnt(0)" ::: "memory");
    __syncthreads();
    if (tid == 0) {
      __hip_atomic_fetch_add(&cnt[u.pm], 1u, __ATOMIC_RELAXED, __HIP_MEMORY_SCOPE_AGENT);
      unsigned sp = 0;
      while (__hip_atomic_load(&cnt[u.pm], __ATOMIC_RELAXED, __HIP_MEMORY_SCOPE_AGENT) < 4u) { __builtin_amdgcn_s_sleep(1); if (++sp > (1u << 24)) break; }
    }
    __syncthreads();
    if (tid < 256) {
      float T1 = 0.f, T2 = 0.f;
#pragma unroll
      for (int o = 0; o < 4; ++o) {
        const unsigned long long v = __hip_atomic_load(&slots[(size_t)(u.pm * 4 + o) * 256 + tid], __ATOMIC_RELAXED, __HIP_MEMORY_SCOPE_AGENT);
        T1 += __uint_as_float((unsigned)(v & 0xffffffffull)); T2 += __uint_as_float((unsigned)(v >> 32));
      }
      const float mu = T1 * (1.0f / 1024.0f);
      const float var = fmaxf(T2 * (1.0f / 1024.0f) - mu * mu, 0.f);
      stat[tid * 2] = mu; stat[tid * 2 + 1] = rsqrtf(var + 1e-5f);
    }
    __syncthreads();
#pragma unroll
    for (int bj = 0; bj < 2; ++bj) {
      f32x4 lgv[2], lbv[2], shv[2], scv[2];
#pragma unroll
      for (int n = 0; n < 2; ++n) {
        const int c = u.pn * 256 + bj * 128 + wc * 32 + n * 16 + fq * 4;
        lgv[n] = *(const f32x4*)&lg[c]; lbv[n] = *(const f32x4*)&lbias[c];
        shv[n] = *(const f32x4*)&modn[cnd * 3072 + c]; scv[n] = *(const f32x4*)&modn[cnd * 3072 + 1024 + c];
      }
#pragma unroll
      for (int ai = 0; ai < 2; ++ai)
#pragma unroll
        for (int m = 0; m < 4; ++m) {
          const int rl = ai * 128 + wr * 64 + m * 16 + fr;
          const int row = u.pm * 256 + rl;
          const float mu = stat[rl * 2], rs = stat[rl * 2 + 1];
#pragma unroll
          for (int n = 0; n < 2; ++n) {
            const int c = u.pn * 256 + bj * 128 + wc * 32 + n * 16 + fq * 4;
            const f32x4 y = acc[ai][bj][m][n];
            f32x4 xo;
#pragma unroll
            for (int j = 0; j < 4; ++j) xo[j] = (y[j] - mu) * rs * lgv[n][j] + lbv[n][j];
            if constexpr (XOUT_BF) *(uint2*)&XB[(size_t)row * 1024 + c] = pack4(xo[0], xo[1], xo[2], xo[3]);
            else *(f32x4*)&X[(size_t)row * 1024 + c] = xo;
            if (H) {
              *(uint2*)&H[(size_t)row * 1024 + c] = pack4(xo[0] * (1 + scv[n][0]) + shv[n][0], xo[1] * (1 + scv[n][1]) + shv[n][1], xo[2] * (1 + scv[n][2]) + shv[n][2], xo[3] * (1 + scv[n][3]) + shv[n][3]);
            }
          }
        }
    }
  }
};

struct EpiScIn {
  static constexpr bool AFTER_DRAIN = false;
  u16 *pb, *sb;
  __device__ __forceinline__ void operator()(AccRef acc, const Unit& u, int wr, int wc, int fr, int fq) const {
    const int c = u.pn * 64 + wc * 16 + fq * 4;
    EPI_ROWS(
      const f32x4 bg = acc[ai][0][m][0], cgv = acc[ai][0][m][1], v = acc[ai][1][m][0], g = acc[ai][1][m][1];
      *(uint2*)&pb[(size_t)row * 1024 + c] = pack4(cgv[0] * v[0], cgv[1] * v[1], cgv[2] * v[2], cgv[3] * v[3]);
      *(uint2*)&sb[(size_t)row * 1024 + c] = pack4(siluf_(g[0]) * bg[0], siluf_(g[1]) * bg[1], siluf_(g[2]) * bg[2], siluf_(g[3]) * bg[3]);
    )
  }
};

struct EpiRgIn {
  static constexpr bool AFTER_DRAIN = false;
  u16 *ub, *sg;
  __device__ __forceinline__ void operator()(AccRef acc, const Unit& u, int wr, int wc, int fr, int fq) const {
    const int region = u.pn >> 2;
    EPI_ROWS( EPI_COLS(
      const int c = (cb & 1023) + fq * 4;
      if (region == 0) *(uint2*)&ub[(size_t)row * 1024 + c] = pack4(a[0], a[1], a[2], a[3]);
      else *(uint2*)&sg[(size_t)row * 1024 + c] = pack4(siluf_(a[0]), siluf_(a[1]), siluf_(a[2]), siluf_(a[3]));
    ) )
  }
};

struct EpiRgGate {
  static constexpr bool AFTER_DRAIN = false;
  u16 *rb, *ib; const float* bgate;
  __device__ __forceinline__ void operator()(AccRef acc, const Unit& u, int wr, int wc, int fr, int fq) const {
    const int mat = u.pn >> 1, d = mat >> 2, hd = mat & 3;
    f32x4 br[2], bi[2]; int ccs[2];
#pragma unroll
    for (int bj = 0; bj < 2; ++bj) {
      const int off = ((u.pn & 1) * 256 + bj * 128 + wc * 32);
      ccs[bj] = (off >> 5) * 16 + fq * 4;
      br[bj] = *(const f32x4*)&bgate[mat * 512 + ccs[bj]];
      bi[bj] = *(const f32x4*)&bgate[mat * 512 + 256 + ccs[bj]];
    }
    EPI_ROWS(
      _Pragma("unroll") for (int bj = 0; bj < 2; ++bj) {
        const f32x4 r = acc[ai][bj][m][0], ii = acc[ai][bj][m][1];
        const size_t o = ((size_t)d * TOK + row) * 1024 + hd * 256 + ccs[bj];
        *(uint2*)&rb[o] = pack4(sigmoidf_(r[0] + br[bj][0]), sigmoidf_(r[1] + br[bj][1]), sigmoidf_(r[2] + br[bj][2]), sigmoidf_(r[3] + br[bj][3]));
        *(uint2*)&ib[o] = pack4(sigmoidf_(ii[0] + bi[bj][0]), sigmoidf_(ii[1] + bi[bj][1]), sigmoidf_(ii[2] + bi[bj][2]), sigmoidf_(ii[3] + bi[bj][3]));
      } )
  }
};

struct EpiMlaIn {
  static constexpr bool AFTER_DRAIN = false;
  u16* cq; float* ckvraw; float* kperaw; u16* sg;
  __device__ __forceinline__ void operator()(AccRef acc, const Unit& u, int wr, int wc, int fr, int fq) const {
    EPI_ROWS( EPI_COLS(
      const int c = cb + fq * 4;
      if (cb < 384) *(uint2*)&cq[(size_t)row * 384 + c] = pack4(a[0], a[1], a[2], a[3]);
      else if (cb < 640) *(f32x4*)&ckvraw[(size_t)row * 256 + (c - 384)] = a;
      else if (cb < 672) *(f32x4*)&kperaw[(size_t)row * 32 + (c - 640)] = a;
    ) )
  }
};

struct EpiSg {
  static constexpr bool AFTER_DRAIN = false;
  u16* sg;
  __device__ __forceinline__ void operator()(AccRef acc, const Unit& u, int wr, int wc, int fr, int fq) const {
    EPI_ROWS( EPI_COLS(
      *(uint2*)&sg[(size_t)row * 1024 + cb + fq * 4] = pack4(siluf_(a[0]), siluf_(a[1]), siluf_(a[2]), siluf_(a[3]));
    ) )
  }
};

struct EpiQ {
  static constexpr bool AFTER_DRAIN = false;
  u16* q;
  __device__ __forceinline__ void operator()(AccRef acc, const Unit& u, int wr, int wc, int fr, int fq) const {
    const float sc = 0.14724444500602648f;
    EPI_ROWS( EPI_COLS(
      *(uint2*)&q[(size_t)row * 1536 + cb + fq * 4] = pack4(a[0] * sc, a[1] * sc, a[2] * sc, a[3] * sc);
    ) )
  }
};

struct EpiK {
  static constexpr bool AFTER_DRAIN = false;
  u16* Kb;
  __device__ __forceinline__ void operator()(AccRef acc, const Unit& u, int wr, int wc, int fr, int fq) const {
    EPI_ROWS( EPI_COLS(
      const int h = cb >> 6, dd = (cb & 63) + fq * 4;
      *(uint2*)&Kb[((size_t)row * 16 + h) * 96 + dd] = pack4(a[0], a[1], a[2], a[3]);
    ) )
  }
};
struct EpiV {
  static constexpr bool AFTER_DRAIN = false;
  u16* Vt;
  __device__ __forceinline__ void operator()(AccRef acc, const Unit& u, int wr, int wc, int fr, int fq) const {
    EPI_ROWS( EPI_COLS(
      *(uint2*)&Vt[(size_t)row * KVROWS + cb + fq * 4] = pack4(a[0], a[1], a[2], a[3]);
    ) )
  }
};

__device__ __forceinline__ void wconv_tile(const float* __restrict__ src, int N, int K, u16* __restrict__ dst, int k0, int n0,
                                           int perm, int mat, float* tile) {
  const int tid = threadIdx.x;
  {
    const int r = tid >> 4, c4 = (tid & 15) * 4;
#pragma unroll
    for (int i = 0; i < 2; ++i) {
      const int k = r + i * 32;
      f32x4 v = f32x4{0.f, 0.f, 0.f, 0.f};
      if (n0 + c4 < N) v = *(const f32x4*)&src[(size_t)(k0 + k) * N + n0 + c4];
      tile[k * 65 + c4 + 0] = v[0]; tile[k * 65 + c4 + 1] = v[1]; tile[k * 65 + c4 + 2] = v[2]; tile[k * 65 + c4 + 3] = v[3];
    }
  }
  __syncthreads();
  {
    const int nl = tid >> 3, kq = (tid & 7) * 8;
    const int n = n0 + nl;
    int np = n;
    if (perm == 1) { const int part = n >> 10, c = n & 1023; np = (c >> 6) * 256 + (part >> 1) * 128 + ((c >> 4) & 3) * 32 + (part & 1) * 16 + (c & 15); }
    else if (perm == 2) { const int type = n >> 8, cc = n & 255; np = mat * 512 + (cc >> 4) * 32 + type * 16 + (cc & 15); }
    else if (perm == 3) { const int hh = n >> 7, dd = n & 127; np = (dd >= 64 ? 1024 : 0) + hh * 64 + (dd & 63); }
    if (n < N) {
      unsigned w[4];
#pragma unroll
      for (int i = 0; i < 4; ++i) w[i] = pack2(tile[(kq + 2 * i) * 65 + nl], tile[(kq + 2 * i + 1) * 65 + nl]);
      *(uint4*)&dst[(size_t)np * K + k0 + kq] = make_uint4(w[0], w[1], w[2], w[3]);
    }
  }
  __syncthreads();
}

__device__ __forceinline__ void phase_prologue(const Params& p, unsigned char* smem_raw, int bid, int nb) {
  float* fs = (float*)smem_raw;
  const int tid = threadIdx.x;
  const int NMOD = 192, NWT = 4800;
  for (int it = bid; it < NMOD + 1 + NWT; it += nb) {
    if (it < NMOD) {
      const int l = it / 48, n0 = (it % 48) * 64;
      float* scond = fs;
      float* sred = fs + 5120;
      for (int i = tid; i < 5120; i += NT) {
        const int ci = i >> 10, k = i & 1023;
        float cv = ci == 0 ? p.in[7][k] : p.in[6][(ci - 1) * 1024 + k];
        scond[i] = siluf_(cv);
      }
      __syncthreads();
      const int col = tid & 63, kg = tid >> 6;
      const float* w = p.in[8] + (size_t)l * 1024 * 3072 + n0 + col;
      float a0 = 0, a1 = 0, a2 = 0, a3 = 0, a4 = 0;
#pragma unroll 16
      for (int k = kg * 128; k < kg * 128 + 128; ++k) {
        float wv = w[(size_t)k * 3072];
        a0 += scond[k] * wv; a1 += scond[1024 + k] * wv; a2 += scond[2048 + k] * wv; a3 += scond[3072 + k] * wv; a4 += scond[4096 + k] * wv;
      }
      sred[(kg * 5 + 0) * 64 + col] = a0; sred[(kg * 5 + 1) * 64 + col] = a1; sred[(kg * 5 + 2) * 64 + col] = a2;
      sred[(kg * 5 + 3) * 64 + col] = a3; sred[(kg * 5 + 4) * 64 + col] = a4;
      __syncthreads();
      float* mod = (float*)(p.ws + WS_MOD);
      if (tid < 320) {
        const int ci = tid >> 6, cc = tid & 63;
        float s = 0;
#pragma unroll
        for (int g = 0; g < 8; ++g) s += sred[(g * 5 + ci) * 64 + cc];
        mod[(l * 5 + ci) * 3072 + n0 + cc] = s + p.in[9][l * 3072 + n0 + cc];
      }
      __syncthreads();
    } else if (it == NMOD) {
      float* lb = (float*)(p.ws + WS_LB);
      for (int i = tid; i < 2048; i += NT) {
        const int d = i >> 10, c = i & 1023;
        const float* lg = p.in[13] + d * 5 * 1024 + c;
        float m = lg[0];
        for (int j = 1; j < 5; ++j) m = fmaxf(m, lg[j * 1024]);
        float s = 0;
        for (int j = 0; j < 5; ++j) s += expf(lg[j * 1024] - m);
        lb[i] = expf(lg[0] - m) / s;
      }
      int* cnt = (int*)(p.ws + WS_CNT);
      if (tid < 16) cnt[tid] = 0;
    } else {
      int t = it - NMOD - 1;
      const float* src; u16* dst; int N, K, perm = 0, mat = 0, ntn;
      if (t < 1280) { src = p.in[12]; dst = (u16*)(p.ws + WS_W_HG_IN); N = 5120; K = 1024; }
      else if ((t -= 1280) < 256) { src = p.in[15]; dst = (u16*)(p.ws + WS_W_HG_OUT); N = 1024; K = 1024; }
      else if ((t -= 256) < 1024) { src = p.in[16]; dst = (u16*)(p.ws + WS_W_SC_IN); N = 4096; K = 1024; perm = 1; }
      else if ((t -= 1024) < 256) { src = p.in[19]; dst = (u16*)(p.ws + WS_W_SC_OUT); N = 1024; K = 1024; }
      else if ((t -= 256) < 512) { src = p.in[20]; dst = (u16*)(p.ws + WS_W_RG_IN); N = 2048; K = 1024; }
      else if ((t -= 512) < 256) { mat = t >> 5; t &= 31; src = p.in[23] + (size_t)mat * 256 * 512; dst = (u16*)(p.ws + WS_W_RG_GATE); N = 512; K = 256; perm = 2; }
      else if ((t -= 256) < 256) { src = p.in[26]; dst = (u16*)(p.ws + WS_W_RG_OUT); N = 1024; K = 1024; }
      else if ((t -= 256) < 432) { src = p.in[27]; dst = (u16*)(p.ws + WS_W_MLA_IN); N = 1696; K = 1024; }
      else if ((t -= 432) < 144) { src = p.in[30]; dst = (u16*)(p.ws + WS_W_QB); N = 1536; K = 384; }
      else if ((t -= 144) < 128) { src = p.in[31]; dst = (u16*)(p.ws + WS_W_KVB); N = 2048; K = 256; perm = 3; }
      else { t -= 128; src = p.in[32]; dst = (u16*)(p.ws + WS_W_MLA_OUT); N = 1024; K = 1024; }
      ntn = (N + 63) >> 6;
      const int kt = t / ntn, ntl = t - kt * ntn;
      wconv_tile(src, N, K, dst, kt * 64, ntl * 64, perm, mat, fs);
    }
  }
}

__device__ __forceinline__ void phase_h0(const Params& p, int bid, int nb) {
  const float* mod = (const float*)(p.ws + WS_MOD);
  u16* H = (u16*)(p.ws + WS_H);
  const size_t total = (size_t)(TOK / 4) * 256;
  for (size_t i = (size_t)bid * NT + threadIdx.x; i < total; i += (size_t)nb * NT) {
    const int row = (int)(i >> 8) * 4, c = ((int)i & 255) * 4;
    const float* xr = row < NPROMPT ? p.in[0] + (size_t)row * 1024 : p.in[1] + (size_t)(row - NPROMPT) * 1024;
    const float* m = mod + cond_of(row) * 3072;
    f32x4 x[4];
#pragma unroll
    for (int t = 0; t < 4; ++t) x[t] = *(const f32x4*)&xr[t * 1024 + c];
    const f32x4 sh = *(const f32x4*)&m[c];
    const f32x4 sc = *(const f32x4*)&m[1024 + c];
#pragma unroll
    for (int t = 0; t < 4; ++t)
      *(uint2*)&H[(size_t)(row + t) * 1024 + c] = pack4(x[t][0] * (1 + sc[0]) + sh[0], x[t][1] * (1 + sc[1]) + sh[1], x[t][2] * (1 + sc[2]) + sh[2], x[t][3] * (1 + sc[3]) + sh[3]);
  }
}

__device__ __forceinline__ void phase_ln(const Params& p, int l, int bid, int nb) {
  float* X = p.out;
  const float* g = p.in[10] + l * 1024;
  const float* b = p.in[11] + l * 1024;
  const float* mod = (const float*)(p.ws + WS_MOD) + (l + 1) * 5 * 3072;
  u16* H = (u16*)(p.ws + WS_H);
  const int lane = threadIdx.x & 63, wave = threadIdx.x >> 6;
  for (int row = bid * NW + wave; row < TOK; row += nb * NW) {
    float* xr = X + (size_t)row * 1024;
    f32x4 v[4];
    float s = 0;
#pragma unroll
    for (int i = 0; i < 4; ++i) { v[i] = *(const f32x4*)&xr[i * 256 + lane * 4]; s += v[i][0] + v[i][1] + v[i][2] + v[i][3]; }
    const float mu = wave_sum(s) * (1.0f / 1024.0f);
    float q = 0;
#pragma unroll
    for (int i = 0; i < 4; ++i)
#pragma unroll
      for (int j = 0; j < 4; ++j) { float dd = v[i][j] - mu; q += dd * dd; }
    const float rs = rsqrtf(wave_sum(q) * (1.0f / 1024.0f) + 1e-5f);
    const float* m = mod + cond_of(row) * 3072;
#pragma unroll
    for (int i = 0; i < 4; ++i) {
      const int c = i * 256 + lane * 4;
      f32x4 gg = *(const f32x4*)&g[c], bb = *(const f32x4*)&b[c];
      f32x4 y;
#pragma unroll
      for (int j = 0; j < 4; ++j) y[j] = (v[i][j] - mu) * rs * gg[j] + bb[j];
      *(f32x4*)&xr[c] = y;
      if (l < 3) {
        f32x4 sh = *(const f32x4*)&m[c], sc = *(const f32x4*)&m[1024 + c];
        *(uint2*)&H[(size_t)row * 1024 + c] = pack4(y[0] * (1 + sc[0]) + sh[0], y[1] * (1 + sc[1]) + sh[1], y[2] * (1 + sc[2]) + sh[2], y[3] * (1 + sc[3]) + sh[3]);
      }
    }
  }
}

__device__ __forceinline__ void phase_gla(const Params& p, unsigned char* smem_raw) {
  u16* s_qrel = (u16*)smem_raw;
  u16* s_krel = s_qrel + 32 * 136;
  u16* s_qcum = s_krel + 32 * 136;
  u16* s_kdT = s_qcum + 32 * 136;
  u16* s_vT = s_kdT + 128 * 40;
  u16* s_att = s_vT + 64 * 40;
  u16* s_S = s_att + 32 * 40;
  float* s_dec = (float*)(s_S + 64 * 136);
  float* s_part = s_dec + 128;
  int* s_u = (int*)(s_part + 512);
  int* counter = (int*)(p.ws + WS_CNT);
  const u16* qg = (const u16*)(p.ws + WS_B(0));
  const u16* vg = (const u16*)(p.ws + WS_B(1));
  const _Float16* lfg = (const _Float16*)(p.ws + WS_B(3));
  u16* og = (u16*)(p.ws + WS_B(5));
  const int tid = threadIdx.x, lane = tid & 63, w = tid >> 6, fr = lane & 15, fq = lane >> 4;
  const int kk = tid & 127, th = tid >> 7;
  const int ti = w >> 2, vi = w & 3;
  const int wk = w & 3, wv = w >> 2;
  while (true) {
    if (tid == 0) *s_u = atomicAdd(counter, 1);
    __syncthreads();
    const int u = *s_u;
    __syncthreads();
    if (u >= 1152) break;
    int b, rem, start, N, sample;
    if (u < 128) { sample = 1; b = u >> 5; rem = u & 31; start = NPROMPT + b * 1024; N = 1024; }
    else { sample = 0; b = (u - 128) >> 5; rem = (u - 128) & 31; start = b * 256; N = 256; }
    const int h = rem >> 2, d = (rem >> 1) & 1, vs = rem & 1;
    const int nc = N >> 5;
    f32x4 S[2][2];
#pragma unroll
    for (int mi = 0; mi < 2; ++mi)
#pragma unroll
      for (int ni = 0; ni < 2; ++ni) {
        f32x4 s4 = f32x4{0.f, 0.f, 0.f, 0.f};
        if (sample) {
          const float* s0 = p.in[2] + ((size_t)((b * 2 + d) * 8 + h)) * 16384;
#pragma unroll
          for (int j = 0; j < 4; ++j) s4[j] = s0[(wk * 32 + mi * 16 + fq * 4 + j) * 128 + vs * 64 + wv * 32 + ni * 16 + fr];
        }
        S[mi][ni] = s4;
        *(uint2*)&s_S[(wv * 32 + ni * 16 + fr) * 136 + wk * 32 + mi * 16 + fq * 4] = pack4(s4[0], s4[1], s4[2], s4[3]);
      }
    _Float16 lfraw[8]; u16 qraw[8]; uint2 vraw;
#define GLA_LOAD(cc) do { _Pragma("unroll") for (int i = 0; i < 8; ++i) { const int tt = (cc) * 32 + th * 8 + i; const size_t tok = start + (d ? (N - 1 - tt) : tt); \
      lfraw[i] = lfg[tok * 2048 + d * 1024 + h * 128 + kk]; qraw[i] = qg[tok * 1024 + h * 128 + kk]; } \
      { const int tt = (cc) * 32 + (tid >> 4); const size_t tok = start + (d ? (N - 1 - tt) : tt); vraw = *(const uint2*)&vg[tok * 1024 + h * 128 + vs * 64 + (tid & 15) * 4]; } } while (0)
    GLA_LOAD(0);
    for (int c = 0; c < nc; ++c) {
      {
        float lfv[8], qv[8];
#pragma unroll
        for (int i = 0; i < 8; ++i) { lfv[i] = (float)lfraw[i]; qv[i] = bf2f(qraw[i]); }
        const uint2 vv = vraw;
        if (c + 1 < nc) GLA_LOAD(c + 1);
        float run = 0;
        float cs[8];
#pragma unroll
        for (int i = 0; i < 8; ++i) { run += lfv[i]; cs[i] = run; }
        s_part[th * 128 + kk] = run;
        {
          const int s = tid >> 4, v4 = (tid & 15) * 4;
          s_vT[(v4 + 0) * 40 + s] = (u16)(vv.x & 0xffff); s_vT[(v4 + 1) * 40 + s] = (u16)(vv.x >> 16);
          s_vT[(v4 + 2) * 40 + s] = (u16)(vv.y & 0xffff); s_vT[(v4 + 3) * 40 + s] = (u16)(vv.y >> 16);
        }
        __syncthreads();
        const float p0 = s_part[kk], p1 = s_part[128 + kk], p2 = s_part[256 + kk], p3 = s_part[384 + kk];
        const float off = (th > 0 ? p0 : 0.f) + (th > 1 ? p1 : 0.f) + (th > 2 ? p2 : 0.f);
        const float ref = p0 + p1, total = p0 + p1 + p2 + p3;
        unsigned kd[4];
        const float eref = __expf(ref), etr = __expf(total - ref);
#pragma unroll
        for (int i = 0; i < 8; ++i) {
          const int t = th * 8 + i;
          const float cum = off + cs[i];
          const float kf = 1.0f - __expf(lfv[i]);
          const float e1 = __expf(cum - ref), e2 = __builtin_amdgcn_rcpf(e1);
          const float qe = qv[i] * e1, ke = kf * e2;
          s_qrel[t * 136 + kk] = f2bf(qe);
          s_krel[t * 136 + kk] = f2bf(ke);
          s_qcum[t * 136 + kk] = f2bf(qe * eref);
          const u16 kdv = f2bf(ke * etr);
          if (i & 1) kd[i >> 1] |= ((unsigned)kdv) << 16; else kd[i >> 1] = kdv;
        }
        *(uint4*)&s_kdT[kk * 40 + th * 8] = make_uint4(kd[0], kd[1], kd[2], kd[3]);
        if (th == 0) s_dec[kk] = __expf(total);
      }
      __syncthreads();
      f32x4 oacc = f32x4{0.f, 0.f, 0.f, 0.f};
      {
        f32x4 att = f32x4{0.f, 0.f, 0.f, 0.f};
        const int ati = w >> 1, asi = w & 1;
#pragma unroll
        for (int ks = 0; ks < 4; ++ks) {
          if (w < 4) {
            bf16x8 a = *(const bf16x8*)&s_qrel[(ati * 16 + fr) * 136 + ks * 32 + fq * 8];
            bf16x8 bb = *(const bf16x8*)&s_krel[(asi * 16 + fr) * 136 + ks * 32 + fq * 8];
            att = __builtin_amdgcn_mfma_f32_16x16x32_bf16(a, bb, att, 0, 0, 0);
          }
          bf16x8 a2 = *(const bf16x8*)&s_qcum[(ti * 16 + fr) * 136 + ks * 32 + fq * 8];
          bf16x8 b2 = *(const bf16x8*)&s_S[(vi * 16 + fr) * 136 + ks * 32 + fq * 8];
          oacc = __builtin_amdgcn_mfma_f32_16x16x32_bf16(a2, b2, oacc, 0, 0, 0);
        }
        if (w < 4) {
#pragma unroll
          for (int j = 0; j < 4; ++j) {
            const int t = ati * 16 + fq * 4 + j, s = asi * 16 + fr;
            s_att[t * 40 + s] = (s <= t) ? f2bf(att[j]) : (u16)0;
          }
        }
      }
      __syncthreads();
      {
        bf16x8 a = *(const bf16x8*)&s_att[(ti * 16 + fr) * 40 + fq * 8];
        bf16x8 bb = *(const bf16x8*)&s_vT[(vi * 16 + fr) * 40 + fq * 8];
        oacc = __builtin_amdgcn_mfma_f32_16x16x32_bf16(a, bb, oacc, 0, 0, 0);
#pragma unroll
        for (int j = 0; j < 4; ++j) {
          const int tt = c * 32 + ti * 16 + fq * 4 + j;
          const size_t tok = start + (d ? (N - 1 - tt) : tt);
          og[((size_t)d * TOK + tok) * 1024 + h * 128 + vs * 64 + vi * 16 + fr] = f2bf(oacc[j]);
        }
        bf16x8 vf[2];
#pragma unroll
        for (int ni = 0; ni < 2; ++ni) vf[ni] = *(const bf16x8*)&s_vT[(wv * 32 + ni * 16 + fr) * 40 + fq * 8];
#pragma unroll
        for (int mi = 0; mi < 2; ++mi) {
          bf16x8 kf = *(const bf16x8*)&s_kdT[(wk * 32 + mi * 16 + fr) * 40 + fq * 8];
          f32x4 dc = *(const f32x4*)&s_dec[wk * 32 + mi * 16 + fq * 4];
#pragma unroll
          for (int ni = 0; ni < 2; ++ni) {
            f32x4 s4 = S[mi][ni];
#pragma unroll
            for (int j = 0; j < 4; ++j) s4[j] *= dc[j];
            s4 = __builtin_amdgcn_mfma_f32_16x16x32_bf16(kf, vf[ni], s4, 0, 0, 0);
            S[mi][ni] = s4;
            *(uint2*)&s_S[(wv * 32 + ni * 16 + fr) * 136 + wk * 32 + mi * 16 + fq * 4] = pack4(s4[0], s4[1], s4[2], s4[3]);
          }
        }
      }
      __syncthreads();
    }
    if (!sample) {
      float* so = p.out + OUT_HG + ((size_t)((b * 2 + d) * 8 + h)) * 16384;
#pragma unroll
      for (int mi = 0; mi < 2; ++mi)
#pragma unroll
        for (int ni = 0; ni < 2; ++ni)
#pragma unroll
          for (int j = 0; j < 4; ++j) so[(wk * 32 + mi * 16 + fq * 4 + j) * 128 + vs * 64 + wv * 32 + ni * 16 + fr] = S[mi][ni][j];
    }
  }
}

__device__ __forceinline__ void phase_hg_post(const Params& p, int bid, int nb) {
  const u16* og = (const u16*)(p.ws + WS_B(5));
  const u16* sg = (const u16*)(p.ws + WS_B(2));
  u16* a = (u16*)(p.ws + WS_B(0));
  const float* ng = p.in[14];
  const int lane = threadIdx.x & 63, wave = threadIdx.x >> 6;
  float ngv[16];
#pragma unroll
  for (int k = 0; k < 4; ++k) { const f32x4 t = *(const f32x4*)&ng[lane * 16 + 4 * k]; ngv[4 * k] = t[0]; ngv[4 * k + 1] = t[1]; ngv[4 * k + 2] = t[2]; ngv[4 * k + 3] = t[3]; }
  for (int row0 = (bid * NW + wave) * 2; row0 < TOK; row0 += nb * NW * 2) {
    uint4 f[2][2], bw[2][2], sv[2][2];
#pragma unroll
    for (int r = 0; r < 2; ++r)
#pragma unroll
      for (int hh = 0; hh < 2; ++hh) {
        const size_t base = (size_t)(row0 + r) * 1024 + lane * 16 + hh * 8;
        f[r][hh] = *(const uint4*)&og[base];
        bw[r][hh] = *(const uint4*)&og[(size_t)TOK * 1024 + base];
        sv[r][hh] = *(const uint4*)&sg[base];
      }
#pragma unroll
    for (int r = 0; r < 2; ++r) {
      float o[16];
      float ss = 0;
#pragma unroll
      for (int hh = 0; hh < 2; ++hh) {
        const unsigned fa[4] = {f[r][hh].x, f[r][hh].y, f[r][hh].z, f[r][hh].w}, ba[4] = {bw[r][hh].x, bw[r][hh].y, bw[r][hh].z, bw[r][hh].w};
#pragma unroll
        for (int i = 0; i < 4; ++i) {
          o[hh * 8 + 2 * i] = lo16(fa[i]) + lo16(ba[i]);
          o[hh * 8 + 2 * i + 1] = hi16(fa[i]) + hi16(ba[i]);
        }
      }
#pragma unroll
      for (int i = 0; i < 16; ++i) ss += o[i] * o[i];
      ss += __shfl_xor(ss, 1); ss += __shfl_xor(ss, 2); ss += __shfl_xor(ss, 4);
      const float rs = rsqrtf(ss * (1.0f / 128.0f) + 1e-6f);
#pragma unroll
      for (int hh = 0; hh < 2; ++hh) {
        const unsigned sa[4] = {sv[r][hh].x, sv[r][hh].y, sv[r][hh].z, sv[r][hh].w};
        unsigned rr[4];
#pragma unroll
        for (int i = 0; i < 4; ++i)
          rr[i] = pack2(o[hh * 8 + 2 * i] * rs * ngv[hh * 8 + 2 * i] * lo16(sa[i]), o[hh * 8 + 2 * i + 1] * rs * ngv[hh * 8 + 2 * i + 1] * hi16(sa[i]));
        *(uint4*)&a[(size_t)(row0 + r) * 1024 + lane * 16 + hh * 8] = make_uint4(rr[0], rr[1], rr[2], rr[3]);
      }
    }
  }
}

__device__ __forceinline__ void seq_pos(int tok, int& n, int& L) {
  if (tok < NPROMPT) { n = tok & 255; L = 256; } else { n = (tok - NPROMPT) & 1023; L = 1024; }
}
__device__ __forceinline__ void phase_sc_conv(const Params& p, int bid, int nb) {
  const u16* pb = (const u16*)(p.ws + WS_B(0));
  const u16* sb = (const u16*)(p.ws + WS_B(1));
  u16* a = (u16*)(p.ws + WS_B(2));
  const float* cw = p.in[17]; const float* cbias = p.in[18];
  const size_t total = (size_t)TOK * 128;
  const size_t i0 = (size_t)bid * NT + threadIdx.x;
  const int c = ((int)i0 & 127) * 8;
  float w0[8], w1[8], w2[8], wb[8];
#pragma unroll
  for (int k = 0; k < 2; ++k) {
    const f32x4 t0 = *(const f32x4*)&cw[c + 4 * k], t1 = *(const f32x4*)&cw[1024 + c + 4 * k], t2 = *(const f32x4*)&cw[2048 + c + 4 * k], tb = *(const f32x4*)&cbias[c + 4 * k];
#pragma unroll
    for (int j = 0; j < 4; ++j) { w0[4 * k + j] = t0[j]; w1[4 * k + j] = t1[j]; w2[4 * k + j] = t2[j]; wb[4 * k + j] = tb[j]; }
  }
  const uint4 z = make_uint4(0, 0, 0, 0);
  for (size_t i = i0; i < total / 4; i += (size_t)nb * NT) {
    const int tok = (int)(i >> 7) * 4;
    int n, L; seq_pos(tok, n, L);
    const size_t base = (size_t)tok * 1024 + c;
    uint4 q[6], sv[4];
    q[0] = n > 0 ? *(const uint4*)&pb[base - 1024] : z;
#pragma unroll
    for (int t = 0; t < 4; ++t) { q[1 + t] = *(const uint4*)&pb[base + t * 1024]; sv[t] = *(const uint4*)&sb[base + t * 1024]; }
    q[5] = n + 4 < L ? *(const uint4*)&pb[base + 4096] : z;
#pragma unroll
    for (int t = 0; t < 4; ++t) {
      const unsigned am[4] = {q[t].x, q[t].y, q[t].z, q[t].w}, a0[4] = {q[t + 1].x, q[t + 1].y, q[t + 1].z, q[t + 1].w};
      const unsigned ap[4] = {q[t + 2].x, q[t + 2].y, q[t + 2].z, q[t + 2].w}, as[4] = {sv[t].x, sv[t].y, sv[t].z, sv[t].w};
      unsigned r[4];
#pragma unroll
      for (int k = 0; k < 4; ++k) {
        float z0 = w0[2 * k] * lo16(am[k]) + w1[2 * k] * lo16(a0[k]) + w2[2 * k] * lo16(ap[k]) + wb[2 * k];
        float z1 = w0[2 * k + 1] * hi16(am[k]) + w1[2 * k + 1] * hi16(a0[k]) + w2[2 * k + 1] * hi16(ap[k]) + wb[2 * k + 1];
        r[k] = pack2(lo16(as[k]) * z0, hi16(as[k]) * z1);
      }
      *(uint4*)&a[base + t * 1024] = make_uint4(r[0], r[1], r[2], r[3]);
    }
  }
}
__device__ __forceinline__ void phase_rg_conv(const Params& p, int bid, int nb) {
  const u16* ub = (const u16*)(p.ws + WS_B(0));
  u16* uc = (u16*)(p.ws + WS_B(2));
  const float* cw = p.in[21]; const float* cbias = p.in[22];
  const size_t total = (size_t)TOK * 128;
  const size_t i0 = (size_t)bid * NT + threadIdx.x;
  const int c = ((int)i0 & 127) * 8;
  float w0[8], w1[8], w2[8], w3[8], wb[8];
#pragma unroll
  for (int k = 0; k < 2; ++k) {
    const f32x4 t0 = *(const f32x4*)&cw[c + 4 * k], t1 = *(const f32x4*)&cw[1024 + c + 4 * k], t2 = *(const f32x4*)&cw[2048 + c + 4 * k], t3 = *(const f32x4*)&cw[3072 + c + 4 * k], tb = *(const f32x4*)&cbias[c + 4 * k];
#pragma unroll
    for (int j = 0; j < 4; ++j) { w0[4 * k + j] = t0[j]; w1[4 * k + j] = t1[j]; w2[4 * k + j] = t2[j]; w3[4 * k + j] = t3[j]; wb[4 * k + j] = tb[j]; }
  }
  const uint4 z = make_uint4(0, 0, 0, 0);
  for (size_t i = i0; i < total / 4; i += (size_t)nb * NT) {
    const int tok = (int)(i >> 7) * 4;
    int n, L; seq_pos(tok, n, L);
    const size_t base = (size_t)tok * 1024 + c;
    uint4 q[7];
    q[0] = n > 1 ? *(const uint4*)&ub[base - 2048] : z;
    q[1] = n > 0 ? *(const uint4*)&ub[base - 1024] : z;
#pragma unroll
    for (int t = 0; t < 4; ++t) q[2 + t] = *(const uint4*)&ub[base + t * 1024];
    q[6] = n + 4 < L ? *(const uint4*)&ub[base + 4096] : z;
#pragma unroll
    for (int t = 0; t < 4; ++t) {
      const unsigned a0[4] = {q[t].x, q[t].y, q[t].z, q[t].w}, a1[4] = {q[t + 1].x, q[t + 1].y, q[t + 1].z, q[t + 1].w};
      const unsigned a2[4] = {q[t + 2].x, q[t + 2].y, q[t + 2].z, q[t + 2].w}, a3[4] = {q[t + 3].x, q[t + 3].y, q[t + 3].z, q[t + 3].w};
      unsigned r[4];
#pragma unroll
      for (int k = 0; k < 4; ++k) {
        float z0 = w0[2 * k] * lo16(a0[k]) + w1[2 * k] * lo16(a1[k]) + w2[2 * k] * lo16(a2[k]) + w3[2 * k] * lo16(a3[k]) + wb[2 * k];
        float z1 = w0[2 * k + 1] * hi16(a0[k]) + w1[2 * k + 1] * hi16(a1[k]) + w2[2 * k + 1] * hi16(a2[k]) + w3[2 * k + 1] * hi16(a3[k]) + wb[2 * k + 1];
        r[k] = pack2(z0, z1);
      }
      *(uint4*)&uc[base + t * 1024] = make_uint4(r[0], r[1], r[2], r[3]);
    }
  }
}

__device__ __forceinline__ void phase_rg_scan(const Params& p, unsigned char* smem_raw, int bid, int nb) {
  float* sA = (float*)smem_raw;
  float* sB = sA + 2048;
  const u16* rb = (const u16*)(p.ws + WS_B(3));
  const u16* ib = (const u16*)(p.ws + WS_B(5));
  const u16* uc = (const u16*)(p.ws + WS_B(2));
  const u16* sg = (const u16*)(p.ws + WS_B(1));
  u16* hfw = (u16*)(p.ws + WS_H);
  u16* yp = (u16*)(p.ws + WS_B(0));
  const int tid = threadIdx.x;
  for (int u = bid; u < 768; u += nb) {
    int sample, b, c, seg, nseg, start, cl_;
    if (u < 256) { sample = 1; b = u >> 6; cl_ = tid & 15; c = (u & 63) * 16 + cl_; seg = tid >> 4; nseg = 32; start = NPROMPT + b * 1024; }
    else { sample = 0; b = (u - 256) >> 4; cl_ = tid & 63; c = ((u - 256) & 15) * 64 + cl_; seg = tid >> 6; nseg = 8; start = b * 256; }
    const int L = nseg * 32;
#pragma unroll 1
    for (int d = 0; d < 2; ++d) {
      const float lam = p.in[25][d * 1024 + c];
      const float cl = 8.0f * log1pf(__expf(-lam));
      const u16* rp = rb + (size_t)d * TOK * 1024;
      const u16* ip = ib + (size_t)d * TOK * 1024;
      const size_t o0 = (size_t)(start + (d ? L - 1 - seg * 32 : seg * 32)) * 1024 + c;
      const long ostep = d ? -1024 : 1024;
      float av[32], xv[32];
      float Aacc = 1.f, Bacc = 0.f;
#pragma unroll
      for (int s = 0; s < 32; ++s) {
        const size_t o = o0 + s * ostep;
        const float r = bf2f(rp[o]), ig = bf2f(ip[o]), uu = bf2f(uc[o]);
        const float la = -cl * r;
        const float a = __expf(la);
        const float xin = __builtin_amdgcn_sqrtf(fmaxf(1.0f - __expf(2.0f * la), 0.f)) * (ig * uu);
        av[s] = a; xv[s] = xin;
      }
#pragma unroll
      for (int s = 0; s < 32; ++s) { Aacc *= av[s]; Bacc = av[s] * Bacc + xv[s]; }
      sA[seg * 64 + cl_] = Aacc; sB[seg * 64 + cl_] = Bacc;
      __syncthreads();
      float h = sample ? p.in[3][(b * 2 + d) * 1024 + c] : 0.f;
      for (int s2 = 0; s2 < seg; ++s2) h = sA[s2 * 64 + cl_] * h + sB[s2 * 64 + cl_];
      if (d == 0) {
#pragma unroll
        for (int s = 0; s < 32; ++s) { h = av[s] * h + xv[s]; hfw[o0 + s * ostep] = f2bf(h); }
      } else {
        float hf[32], sgv[32];
#pragma unroll
        for (int s = 0; s < 32; ++s) { const size_t o = o0 + s * ostep; hf[s] = bf2f(hfw[o]); sgv[s] = bf2f(sg[o]); }
#pragma unroll
        for (int s = 0; s < 32; ++s) { h = av[s] * h + xv[s]; yp[o0 + s * ostep] = f2bf((hf[s] + h) * sgv[s]); }
      }
      if (!sample && seg == nseg - 1) p.out[OUT_RG + (b * 2 + d) * 1024 + c] = h;
      __syncthreads();
    }
  }
}

__device__ __forceinline__ void phase_mla_norm(const Params& p, int bid, int nb) {
  u16* cq = (u16*)(p.ws + WS3_CQ);
  u16* ckvall = (u16*)(p.ws + WS3_CKVALL);
  const float* ckvraw = (const float*)(p.ws + WS3_CKVRAW);
  const float* kperaw = (const float*)(p.ws + WS3_KPERAW);
  u16* Kb = (u16*)(p.ws + WS3_K);
  const float* qn = p.in[28]; const float* kvn = p.in[29];
  const int lane = threadIdx.x & 63, wave = threadIdx.x >> 6;
  float qnv[6];
#pragma unroll
  for (int i = 0; i < 3; ++i) { qnv[2 * i] = qn[(i * 64 + lane) * 2]; qnv[2 * i + 1] = qn[(i * 64 + lane) * 2 + 1]; }
  const f32x4 g4 = *(const f32x4*)&kvn[lane * 4];
  for (int row = bid * NW + wave; row < TOK + 2048; row += nb * NW) {
    if (row < TOK) {
      const int tok = row;
      const bool sample = tok >= NPROMPT;
      const int bs = (tok - NPROMPT) >> 10, n = (tok - NPROMPT) & 1023;
      const size_t kvrow = sample ? (size_t)(NPROMPT + bs * 1536 + 512 + n) : (size_t)tok;
      unsigned* cqr = (unsigned*)&cq[(size_t)tok * 384];
      unsigned cv[3]; float ss = 0;
#pragma unroll
      for (int i = 0; i < 3; ++i) { cv[i] = cqr[i * 64 + lane]; float a = lo16(cv[i]), b2 = hi16(cv[i]); ss += a * a + b2 * b2; }
      const float rsq = rsqrtf(wave_sum(ss) * (1.0f / 384.0f) + 1e-6f);
#pragma unroll
      for (int i = 0; i < 3; ++i) {
        cqr[i * 64 + lane] = pack2(lo16(cv[i]) * rsq * qnv[2 * i], hi16(cv[i]) * rsq * qnv[2 * i + 1]);
      }
      f32x4 kv = *(const f32x4*)&ckvraw[(size_t)tok * 256 + lane * 4];
      const float rsk = rsqrtf(wave_sum(kv[0] * kv[0] + kv[1] * kv[1] + kv[2] * kv[2] + kv[3] * kv[3]) * (1.0f / 256.0f) + 1e-6f);
      f32x4 o4;
#pragma unroll
      for (int j = 0; j < 4; ++j) o4[j] = kv[j] * rsk * g4[j];
      *(uint2*)&ckvall[kvrow * 256 + lane * 4] = pack4(o4[0], o4[1], o4[2], o4[3]);
      if (!sample) *(f32x4*)&p.out[OUT_CKV + (size_t)tok * 256 + lane * 4] = o4;
      float v = kperaw[(size_t)tok * 32 + (lane & 31)];
      if (!sample) { if (lane < 32) p.out[OUT_KPE + (size_t)tok * 32 + lane] = v; }
      else {
        const float partner = __shfl_xor(v, 8);
        const int i16 = lane & 15;
        const float pos = (lane & 16) ? (float)(n & 63) : (float)(n >> 6);
        float sn, cs; rope_sincos(pos, i16 & 7, sn, cs);
        v = (i16 < 8) ? (v * cs - partner * sn) : (partner * sn + v * cs);
      }
      const u16 vb = f2bf(v);
#pragma unroll
      for (int i = 0; i < 8; ++i) Kb[(kvrow * 16 + (lane >> 5) + 2 * i) * 96 + 64 + (lane & 31)] = vb;
    } else {
      const int r = row - TOK, bs = r >> 9, j = r & 511;
      const size_t kvrow = (size_t)(NPROMPT + bs * 1536 + j);
      f32x4 kv = *(const f32x4*)&p.in[4][(size_t)r * 256 + lane * 4];
      *(uint2*)&ckvall[kvrow * 256 + lane * 4] = pack4(kv[0], kv[1], kv[2], kv[3]);
      const u16 vb = f2bf(p.in[5][(size_t)r * 32 + (lane & 31)]);
#pragma unroll
      for (int i = 0; i < 8; ++i) Kb[(kvrow * 16 + (lane >> 5) + 2 * i) * 96 + 64 + (lane & 31)] = vb;
    }
  }
}

__device__ __forceinline__ void phase_attn(const Params& p, unsigned char* smem_raw, int bid, int nb) {
  u16* sK = (u16*)smem_raw;
  u16* sV = sK + 64 * 104;
  const u16* qg = (const u16*)(p.ws + WS3_Q);
  const u16* Kg = (const u16*)(p.ws + WS3_K);
  const u16* Vg = (const u16*)(p.ws + WS3_VT);
  const u16* sg = (const u16*)(p.ws + WS3_SG);
  u16* ao = (u16*)(p.ws + WS_H);
  const int tid = threadIdx.x, lane = tid & 63, w = tid >> 6, fr = lane & 15, fq = lane >> 4;
  for (int u = bid; u < 1536; u += nb) {
    int tok0, kvbase, nkeys, h;
    if (u < 512) { const int b = u >> 7, r = u & 127; h = r >> 3; const int qb = r & 7; tok0 = NPROMPT + b * 1024 + qb * 128; kvbase = NPROMPT + b * 1536; nkeys = 1536; }
    else { const int uu = u - 512; const int b = uu >> 5, r = uu & 31; h = r >> 1; const int qb = r & 1; tok0 = b * 256 + qb * 128; kvbase = b * 256; nkeys = 256; }
    const int tokq = tok0 + w * 16 + fr;
    bf16x8 qf[3];
#pragma unroll
    for (int ks = 0; ks < 3; ++ks) qf[ks] = *(const bf16x8*)&qg[(size_t)tokq * 1536 + h * 96 + ks * 32 + fq * 8];
    if (u < 512) {
      const int npos = (tokq - NPROMPT) & 1023;
      const float pos = (fq & 2) ? (float)(npos & 63) : (float)(npos >> 6);
      uint4 raw = *(uint4*)&qf[2];
      unsigned rw[4] = {raw.x, raw.y, raw.z, raw.w};
#pragma unroll
      for (int i = 0; i < 4; ++i) {
        float v0 = lo16(rw[i]), v1 = hi16(rw[i]);
        const float p0 = __shfl_xor(v0, 16), p1 = __shfl_xor(v1, 16);
        float sn0, cs0, sn1, cs1;
        rope_sincos(pos, 2 * i, sn0, cs0); rope_sincos(pos, 2 * i + 1, sn1, cs1);
        v0 = (fq & 1) ? (p0 * sn0 + v0 * cs0) : (v0 * cs0 - p0 * sn0);
        v1 = (fq & 1) ? (p1 * sn1 + v1 * cs1) : (v1 * cs1 - p1 * sn1);
        rw[i] = pack2(v0, v1);
      }
      raw = make_uint4(rw[0], rw[1], rw[2], rw[3]);
      qf[2] = *(bf16x8*)&raw;
    }
    float m = -1e30f, l = 0.f;
    f32x4 oacc[4];
#pragma unroll
    for (int i = 0; i < 4; ++i) oacc[i] = f32x4{0.f, 0.f, 0.f, 0.f};
    const int ntile = nkeys >> 6;
    const int k0key = tid / 12, k0ch = tid - k0key * 12;
    const int k1key = (tid + NT) / 12, k1ch = (tid + NT) - k1key * 12;
    const int vdv = tid >> 3, vch = tid & 7;
    const u16* Kp0 = &Kg[((size_t)(kvbase + k0key) * 16 + h) * 96 + k0ch * 8];
    const u16* Kp1 = &Kg[((size_t)(kvbase + k1key) * 16 + h) * 96 + k1ch * 8];
    const u16* Vp = &Vg[(size_t)(h * 64 + vdv) * KVROWS + kvbase + vch * 8];
    uint4 kr0 = *(const uint4*)Kp0, kr1 = make_uint4(0, 0, 0, 0), vr = *(const uint4*)Vp;
    if (tid < 256) kr1 = *(const uint4*)Kp1;
    for (int kt = 0; kt < ntile; ++kt) {
      __syncthreads();
      *(uint4*)&sK[k0key * 104 + k0ch * 8] = kr0;
      if (tid < 256) *(uint4*)&sK[k1key * 104 + k1ch * 8] = kr1;
      *(uint4*)&sV[vdv * 72 + vch * 8] = vr;
      if (kt + 1 < ntile) {
        kr0 = *(const uint4*)(Kp0 + (size_t)(kt + 1) * 64 * 1536);
        if (tid < 256) kr1 = *(const uint4*)(Kp1 + (size_t)(kt + 1) * 64 * 1536);
        vr = *(const uint4*)(Vp + (kt + 1) * 64);
      }
      __syncthreads();
      f32x4 sacc[4];
#pragma unroll
      for (int ni = 0; ni < 4; ++ni) {
        sacc[ni] = f32x4{0.f, 0.f, 0.f, 0.f};
#pragma unroll
        for (int ks = 0; ks < 3; ++ks) {
          bf16x8 kf = *(const bf16x8*)&sK[(ni * 16 + fr) * 104 + ks * 32 + fq * 8];
          sacc[ni] = __builtin_amdgcn_mfma_f32_16x16x32_bf16(kf, qf[ks], sacc[ni], 0, 0, 0);
        }
      }
      float mx = -1e30f;
#pragma unroll
      for (int ni = 0; ni < 4; ++ni)
#pragma unroll
        for (int j = 0; j < 4; ++j) mx = fmaxf(mx, sacc[ni][j]);
      mx = fmaxf(mx, __shfl_xor(mx, 16));
      mx = fmaxf(mx, __shfl_xor(mx, 32));
      const float mnew = fmaxf(m, mx);
      const float alpha = __builtin_amdgcn_exp2f(m - mnew);
      m = mnew;
      float ls = 0.f;
#pragma unroll
      for (int ni = 0; ni < 4; ++ni)
#pragma unroll
        for (int j = 0; j < 4; ++j) { float e = __builtin_amdgcn_exp2f(sacc[ni][j] - mnew); sacc[ni][j] = e; ls += e; }
      l = l * alpha + ls;
      bf16x8 pf[2];
#pragma unroll
      for (int kk2 = 0; kk2 < 2; ++kk2) {
        uint2 lo = pack4(sacc[2 * kk2][0], sacc[2 * kk2][1], sacc[2 * kk2][2], sacc[2 * kk2][3]);
        uint2 hi = pack4(sacc[2 * kk2 + 1][0], sacc[2 * kk2 + 1][1], sacc[2 * kk2 + 1][2], sacc[2 * kk2 + 1][3]);
        uint4 pk = make_uint4(lo.x, lo.y, hi.x, hi.y);
        pf[kk2] = *(bf16x8*)&pk;
      }
#pragma unroll
      for (int di = 0; di < 4; ++di) {
#pragma unroll
        for (int j = 0; j < 4; ++j) oacc[di][j] *= alpha;
#pragma unroll
        for (int kk2 = 0; kk2 < 2; ++kk2) {
          uint2 v0 = *(const uint2*)&sV[(di * 16 + fr) * 72 + kk2 * 32 + fq * 4];
          uint2 v1 = *(const uint2*)&sV[(di * 16 + fr) * 72 + kk2 * 32 + 16 + fq * 4];
          uint4 vk = make_uint4(v0.x, v0.y, v1.x, v1.y);
          oacc[di] = __builtin_amdgcn_mfma_f32_16x16x32_bf16(*(bf16x8*)&vk, pf[kk2], oacc[di], 0, 0, 0);
        }
      }
    }
    l += __shfl_xor(l, 16);
    l += __shfl_xor(l, 32);
    const float inv = 1.0f / l;
#pragma unroll
    for (int di = 0; di < 4; ++di) {
      const size_t o = (size_t)tokq * 1024 + h * 64 + di * 16 + fq * 4;
      uint2 s = *(const uint2*)&sg[o];
      *(uint2*)&ao[o] = pack4(oacc[di][0] * inv * lo16(s.x), oacc[di][1] * inv * hi16(s.x), oacc[di][2] * inv * lo16(s.y), oacc[di][3] * inv * hi16(s.y));
    }
  }
}

#define XB_TMO      128
#define XB_XCNT(j)  (256  + 64 * (j))
#define XB_XSUB(j)  (1280 + 64 * (j))
#define XB_XGEN(j)  (2304 + 64 * (j))
#define XB_TOP      3328
#define XB_TOPGEN   3392
#define XCD_BAR_WORDS 3456
#define XB_SPIN_CAP (1u << 22)
__device__ __forceinline__ unsigned xb_ld(unsigned* p)              { return __hip_atomic_load(p, __ATOMIC_RELAXED, __HIP_MEMORY_SCOPE_AGENT); }
__device__ __forceinline__ unsigned xb_add(unsigned* p, unsigned v) { return __hip_atomic_fetch_add(p, v, __ATOMIC_RELAXED, __HIP_MEMORY_SCOPE_AGENT); }
__device__ __forceinline__ unsigned xb_xcc_id() { return (unsigned)__builtin_amdgcn_s_getreg((3 << 11) | 20) & 0xFu; }
#define XB_SPIN(cond, bar) do { unsigned _sp = 0; while (cond) { __builtin_amdgcn_s_sleep(1); \
    if ((++_sp & 255u) == 0u) { if (xb_ld(&(bar)[XB_TMO])) break; if (_sp > XB_SPIN_CAP) { atomicAdd(&(bar)[XB_TMO], 1u); break; } } } } while (0)
struct XcdBarrier { unsigned* bar; unsigned x; volatile LAS unsigned* st; };
__device__ __forceinline__ XcdBarrier xcd_barrier_post(unsigned* bar, volatile LAS unsigned* st) {
  XcdBarrier b; b.bar = bar; b.x = xb_xcc_id(); b.st = st;
  if (threadIdx.x == 0) (void)xb_add(&bar[XB_XCNT(b.x)], 1u);
  return b;
}
__device__ __forceinline__ void xcd_barrier_complete(unsigned* bar, unsigned x, unsigned& nloc, unsigned& nx) {
  const unsigned G = gridDim.x * gridDim.y * gridDim.z;
  unsigned sum, cnt, mine, sp = 0u;
  for (;;) {
    sum = 0u; cnt = 0u; mine = 0u;
#pragma unroll
    for (unsigned j = 0; j < 16; ++j) { const unsigned c = xb_ld(&bar[XB_XCNT(j)]); sum += c; cnt += (c > 0u) ? 1u : 0u; mine = (j == x) ? c : mine; }
    if (sum == G) break;
    __builtin_amdgcn_s_sleep(1);
    if ((++sp & 255u) == 0u) { if (xb_ld(&bar[XB_TMO])) break; if (sp > XB_SPIN_CAP) { atomicAdd(&bar[XB_TMO], 1u); break; } }
  }
  nloc = mine > 0u ? mine : 1u; nx = cnt > 0u ? cnt : 1u;
}
__device__ __forceinline__ void xcd_barrier(const XcdBarrier& b) {
  asm volatile("s_waitcnt vmcnt(0)" ::: "memory");
  __syncthreads();
  if (threadIdx.x == 0) {
    unsigned* bar = b.bar;
    __builtin_amdgcn_s_waitcnt(0);
    unsigned nloc = b.st[0], nx = b.st[1];
    if (nloc == 0u) { xcd_barrier_complete(bar, b.x, nloc, nx); b.st[0] = nloc; b.st[1] = nx; }
    const unsigned old = xb_add(&bar[XB_XSUB(b.x)], 1u);
    const unsigned gen = old / nloc;
    if (old + 1u == (gen + 1u) * nloc) {
      __builtin_amdgcn_fence(__ATOMIC_RELEASE, "agent");
      asm volatile("s_waitcnt vmcnt(0)" ::: "memory");
      const unsigned og = xb_add(&bar[XB_TOP], 1u);
      const unsigned tg = og / nx;
      if (og + 1u == (tg + 1u) * nx) xb_add(&bar[XB_TOPGEN], 1u);
      else XB_SPIN(xb_ld(&bar[XB_TOPGEN]) == tg, bar);
      __builtin_amdgcn_fence(__ATOMIC_ACQUIRE, "agent");
      xb_add(&bar[XB_XGEN(b.x)], 1u);
      asm volatile("s_waitcnt vmcnt(0)" ::: "memory");
    } else {
      XB_SPIN(xb_ld(&bar[XB_XGEN(b.x)]) == gen, bar);
      __builtin_amdgcn_fence(__ATOMIC_ACQUIRE, "agent");
      asm volatile("s_waitcnt vmcnt(0)" ::: "memory");
    }
  }
  __syncthreads();
}

#define GEMM_LDS 131072
#define DYN_LDS (GEMM_LDS + 16)
#define WS_BAR (WS_CNT + 4096ull)

#define RUN_GEMM(Aptr, LDA, Bptr, MM, NN, KK, GATE, EPI, CID) RUN_GEMM_G(Aptr, LDA, Bptr, MM, NN, KK, GATE, EPI, nb, CID)
#define RUN_GEMM_G(Aptr, LDA, Bptr, MM, NN, KK, GATE, EPI, GG, CID) do { pg8::Gemm g_{(const u16*)(Aptr), (const u16*)(Bptr), MM, NN, KK, LDA, GATE, p.flags}; \
    pg8::StaticOrder S_; S_.init(MM, NN, GG, CID); pg8::gemm_phase((LAS unsigned char*)smem_raw, g_, S_, EPI); } while (0)

__global__ void __launch_bounds__(NT, 2) mega(Params p) {
  extern __shared__ __attribute__((aligned(16))) unsigned char smem_raw[];
  const int bid = blockIdx.x, nb = gridDim.x;
  unsigned char* ws = p.ws;
  const float* mod = (const float*)(ws + WS_MOD);
  volatile LAS unsigned* xst = (volatile LAS unsigned*)((LAS unsigned char*)smem_raw + GEMM_LDS);
  XcdBarrier xb;
  if (p.phase_hi - p.phase_lo > 1) {
    if (threadIdx.x == 0) { xst[0] = 0u; xst[1] = 0u; }
    __syncthreads();
    xb = xcd_barrier_post((unsigned*)(ws + WS_BAR), xst);
  }
#define PH_BEGIN(n) if ((PHMASK & (1u << n)) && p.phase_lo <= n && n < p.phase_hi) { const int ph = n;
#define PH_FIN if (ph + 1 < p.phase_hi) { if (p.phase_lo < 0) cg::this_grid().sync(); else xcd_barrier(xb); } }
  PH_BEGIN(0) phase_prologue(p, smem_raw, bid, nb); PH_FIN
  PH_BEGIN(1) phase_h0(p, bid, nb); PH_FIN
  PH_BEGIN(2) {
    EpiHgIn e{(u16*)(ws + WS_B(0)), (u16*)(ws + WS_B(1)), (u16*)(ws + WS_B(2)), (_Float16*)(ws + WS_B(3)), (const float*)(ws + WS_LB)};
    RUN_GEMM(ws + WS_H, 1024, ws + WS_W_HG_IN, TOK, 5120, 1024, 0, e, bid);
  } PH_FIN
  PH_BEGIN(3) phase_gla(p, smem_raw); PH_FIN
  PH_BEGIN(4) phase_hg_post(p, bid, nb); PH_FIN
  PH_BEGIN(5) {
    EpiResLn<false, true> e{p.in[0], p.in[1], (const u16*)nullptr, p.out, (u16*)(ws + WS_XB), mod + 0 * 15360 + 2048, p.in[10] + 0 * 1024, p.in[11] + 0 * 1024, mod + 1 * 15360, (u16*)(ws + WS_H),
               (unsigned long long*)(ws + WS_SLOT) + 0 * 49152, (unsigned*)(ws + WS_CNT + 256) + 0 * 48};
    RUN_GEMM(ws + WS_B(0), 1024, ws + WS_W_HG_OUT, TOK, 1024, 1024, 0, e, bid);
  } PH_FIN
  PH_BEGIN(7) {
    EpiScIn e{(u16*)(ws + WS_B(0)), (u16*)(ws + WS_B(1))};
    RUN_GEMM(ws + WS_H, 1024, ws + WS_W_SC_IN, TOK, 4096, 1024, 0, e, bid);
  } PH_FIN
  PH_BEGIN(8) phase_sc_conv(p, bid, nb); PH_FIN
  PH_BEGIN(9) {
    EpiResLn<true, true> e{p.out, p.out, (const u16*)(ws + WS_XB), p.out, (u16*)(ws + WS_XB), mod + 1 * 15360 + 2048, p.in[10] + 1 * 1024, p.in[11] + 1 * 1024, mod + 2 * 15360, (u16*)(ws + WS_H),
               (unsigned long long*)(ws + WS_SLOT) + 1 * 49152, (unsigned*)(ws + WS_CNT + 256) + 1 * 48};
    RUN_GEMM(ws + WS_B(2), 1024, ws + WS_W_SC_OUT, TOK, 1024, 1024, 0, e, bid);
  } PH_FIN
  PH_BEGIN(11) {
    EpiRgIn e{(u16*)(ws + WS_B(0)), (u16*)(ws + WS_B(1))};
    RUN_GEMM(ws + WS_H, 1024, ws + WS_W_RG_IN, TOK, 2048, 1024, 0, e, bid);
  } PH_FIN
  PH_BEGIN(12) phase_rg_conv(p, bid, nb); PH_FIN
  PH_BEGIN(13) {
    EpiRgGate e{(u16*)(ws + WS_B(3)), (u16*)(ws + WS_B(5)), p.in[24]};
    RUN_GEMM(ws + WS_B(2), 1024, ws + WS_W_RG_GATE, TOK, 4096, 256, 1, e, bid);
  } PH_FIN
  PH_BEGIN(14) phase_rg_scan(p, smem_raw, bid, nb); PH_FIN
  PH_BEGIN(15) {
    EpiResLn<true, true> e{p.out, p.out, (const u16*)(ws + WS_XB), p.out, (u16*)(ws + WS_XB), mod + 2 * 15360 + 2048, p.in[10] + 2 * 1024, p.in[11] + 2 * 1024, mod + 3 * 15360, (u16*)(ws + WS_H),
               (unsigned long long*)(ws + WS_SLOT) + 2 * 49152, (unsigned*)(ws + WS_CNT + 256) + 2 * 48};
    RUN_GEMM(ws + WS_B(0), 1024, ws + WS_W_RG_OUT, TOK, 1024, 1024, 0, e, bid);
  } PH_FIN
  PH_BEGIN(17) {
    EpiMlaIn e{(u16*)(ws + WS3_CQ), (float*)(ws + WS3_CKVRAW), (float*)(ws + WS3_KPERAW), (u16*)(ws + WS3_SG)};
    RUN_GEMM(ws + WS_H, 1024, ws + WS_W_MLA_IN, TOK, 768, 1024, 0, e, bid);
  } PH_FIN
  PH_BEGIN(18) phase_mla_norm(p, bid, nb); PH_FIN
  PH_BEGIN(19) {
    const bool bal = (nb == 256);
    EpiSg eg{(u16*)(ws + WS3_SG)};
    RUN_GEMM(ws + WS_H, 1024, ws + WS_W_MLA_IN + 672 * 1024 * 2, TOK, 1024, 1024, 0, eg, bid);
    EpiQ eq{(u16*)(ws + WS3_Q)};
    RUN_GEMM(ws + WS3_CQ, 384, ws + WS_W_QB, TOK, 1536, 384, 0, eq, bal ? ((bid + 64) & 255) : bid);
    EpiK ek{(u16*)(ws + WS3_K)};
    RUN_GEMM(ws + WS3_CKVALL, 256, ws + WS_W_KVB, KVROWS, 1024, 256, 0, ek, bal ? ((bid + 32) & 255) : bid);
    EpiV ev{(u16*)(ws + WS3_VT)};
    RUN_GEMM_G(ws + WS_W_KVB + 1024 * 256 * 2, 256, ws + WS3_CKVALL, 1024, KVROWS, 256, 0, ev, bal ? 64 : nb, bal ? (bid >= 192 ? bid - 192 : (1 << 20)) : bid);
  } PH_FIN
  PH_BEGIN(20) phase_attn(p, smem_raw, bid, nb); PH_FIN
  PH_BEGIN(21) {
    EpiResLn<true, false> e{p.out, p.out, (const u16*)(ws + WS_XB), p.out, (u16*)nullptr, mod + 3 * 15360 + 2048, p.in[10] + 3 * 1024, p.in[11] + 3 * 1024, mod + 3 * 15360, (u16*)nullptr,
               (unsigned long long*)(ws + WS_SLOT) + 3 * 49152, (unsigned*)(ws + WS_CNT + 256) + 3 * 48};
    RUN_GEMM(ws + WS_H, 1024, ws + WS_W_MLA_OUT, TOK, 1024, 1024, 0, e, bid);
  } PH_FIN
}

extern "C" void kernel_launch(void* const* d_in, const int* in_sizes, int n_in, void* d_out, int out_size, void* d_ws, size_t ws_size,
                              hipStream_t stream) {
  static int grid_blocks = 0;
  if (!grid_blocks) {
    int dev = 0, cus = 0, per_cu = 0;
    (void)hipGetDevice(&dev);
    (void)hipDeviceGetAttribute(&cus, hipDeviceAttributeMultiprocessorCount, dev);
    (void)hipFuncSetAttribute((const void*)mega, hipFuncAttributeMaxDynamicSharedMemorySize, DYN_LDS);
    (void)hipOccupancyMaxActiveBlocksPerMultiprocessor(&per_cu, (const void*)mega, NT, DYN_LDS);
    if (per_cu < 1) per_cu = 1;
    if (per_cu > 1) per_cu = 1;
    grid_blocks = cus * per_cu;
  }
  Params p{};
  for (int i = 0; i < 33; ++i) p.in[i] = (const float*)d_in[i];
  p.out = (float*)d_out;
  p.ws = (unsigned char*)d_ws;
#if MULTI_LAUNCH
  (void)hipMemsetAsync((unsigned char*)d_ws + WS_CNT, 0, 4096 + XCD_BAR_WORDS * 4, stream);
  for (int ph = 0; ph < NPHASES; ++ph) {
    p.phase_lo = ph; p.phase_hi = ph + 1;
    hipLaunchKernelGGL(mega, dim3(grid_blocks), dim3(NT), DYN_LDS, stream, p);
#ifdef PROBE_MASK
    if ((PROBE_MASK >> ph) & 1) { p.flags = PROBE_FLAGS; for (int r = 0; r < 2; ++r) {
      if (ph == 3) (void)hipMemsetAsync((unsigned char*)d_ws + WS_CNT, 0, 64, stream);
      hipLaunchKernelGGL(mega, dim3(grid_blocks), dim3(NT), DYN_LDS, stream, p);
    } p.flags = 0; }
#endif
  }
#else
  p.phase_lo = 0; p.phase_hi = NPHASES;
  (void)hipMemsetAsync((unsigned char*)d_ws + WS_CNT, 0, 4096 + XCD_BAR_WORDS * 4, stream);
  void* args[] = {&p};
  hipError_t e = hipLaunchCooperativeKernel((const void*)mega, dim3(grid_blocks), dim3(NT), args, DYN_LDS, stream);
  if (e != hipSuccess) fprintf(stderr, "cooperative launch failed: %s (grid %d)\n", hipGetErrorString(e), grid_blocks);
#endif
}
```

```cpp
#include <hip/hip_runtime.h>
#include <hip/hip_cooperative_groups.h>
#include <cstdio>
namespace cg = cooperative_groups;

#ifndef MULTI_LAUNCH
#define MULTI_LAUNCH 0
#endif

typedef unsigned short u16;
using bf16x8 = __attribute__((ext_vector_type(8))) short;
using f32x4 = __attribute__((ext_vector_type(4))) float;
typedef _Float16 h4 __attribute__((ext_vector_type(4)));

#define TOK 12288
#define NPROMPT 8192
#define KVROWS 14336
#define NPHASES 23
#ifndef PHMASK
#define PHMASK 0x7fffff
#endif
#define DN_ALPHA 1.6817928305074290f

#define WS_W_HG_IN 0ull
#define WS_W_HG_OUT (WS_W_HG_IN + 10485760ull)
#define WS_W_SC_IN (WS_W_HG_OUT + 2097152ull)
#define WS_W_SC_OUT (WS_W_SC_IN + 8388608ull)
#define WS_W_RG_IN (WS_W_SC_OUT + 2097152ull)
#define WS_W_RG_GATE (WS_W_RG_IN + 4194304ull)
#define WS_W_RG_OUT (WS_W_RG_GATE + 2097152ull)
#define WS_W_MLA_IN (WS_W_RG_OUT + 2097152ull)
#define WS_W_QB (WS_W_MLA_IN + 3670016ull)
#define WS_W_KVB (WS_W_QB + 1179648ull)
#define WS_W_MLA_OUT (WS_W_KVB + 1048576ull)
#define WS_MOD (WS_W_MLA_OUT + 2097152ull)
#define WS_LB (WS_MOD + 245760ull)
#define WS_CNT (WS_LB + 8192ull)
#define WS_R (WS_CNT + 4096ull + 16384ull)
#define BSZ 25165824ull
#define WS_H (WS_R)
#define WS_B(i) (WS_R + BSZ * (1 + (i)))
#define WS_SLOT (WS_R + 201326592ull)
#define WS_XB (WS_SLOT + 1572864ull)
#define WS3_CQ (WS_R + 25165824ull)
#define WS3_CKVALL (WS_R + 34603008ull)
#define WS3_CKVRAW (WS_R + 41943040ull)
#define WS3_KPERAW (WS_R + 54525952ull)
#define WS3_SG (WS_R + 56098816ull)
#define WS3_Q (WS_R + 81264640ull)
#define WS3_K (WS_R + 119013376ull)
#define WS3_VT (WS_R + 163053568ull)

#define OUT_HG 12582912
#define OUT_RG 20971520
#define OUT_CKV 21037056
#define OUT_KPE 23134208

struct Params {
  const float* in[33];
  float* out;
  unsigned char* ws;
  int phase_lo, phase_hi, flags, pad_;
};

__device__ __forceinline__ u16 f2bf(float f) { __bf16 r = (__bf16)f; return *(u16*)&r; }
__device__ __forceinline__ float bf2f(u16 h) { return __uint_as_float(((unsigned)h) << 16); }
typedef float f2v_ __attribute__((ext_vector_type(2)));
typedef __bf16 b2v_ __attribute__((ext_vector_type(2)));
__device__ __forceinline__ unsigned pack2(float a, float b) { f2v_ f = {a, b}; b2v_ r = __builtin_convertvector(f, b2v_); return *(unsigned*)&r; }
__device__ __forceinline__ uint2 pack4(float a, float b, float c, float d) { return make_uint2(pack2(a, b), pack2(c, d)); }
__device__ __forceinline__ float lo16(unsigned u) { return __uint_as_float(u << 16); }
__device__ __forceinline__ float hi16(unsigned u) { return __uint_as_float(u & 0xffff0000u); }
__device__ __forceinline__ float sigmoidf_(float x) { return __builtin_amdgcn_rcpf(1.0f + __expf(-x)); }
__device__ __forceinline__ float siluf_(float x) { return x * __builtin_amdgcn_rcpf(1.0f + __expf(-x)); }
__device__ __forceinline__ int cond_of(int tok) { return tok < NPROMPT ? 0 : 1 + ((tok - NPROMPT) >> 10); }
__device__ __forceinline__ float wave_sum(float v) {
#pragma unroll
  for (int o = 32; o > 0; o >>= 1) v += __shfl_xor(v, o);
  return v;
}
__device__ __forceinline__ void rope_sincos(float pos, int fi, float& sn, float& cs) {
  float inv = exp2f(-(float)fi * 1.6609640474436813f);
  float ang = pos * inv;
  float k = rintf(ang * 0.15915494309189535f);
  float r = fmaf(-k, 6.2831854820251465f, ang);
  r = fmaf(-k, -1.7484555e-7f, r);
  sn = __sinf(r); cs = __cosf(r);
}

#define NT 512
#define NW 8
#define LAS __attribute__((address_space(3)))

namespace pg8 {
constexpr int BM = 256, BK = 64, HALF = 128, HTB = HALF * BK * 2, STAGE_BYTES = 8 * HTB, NXCD = 8, WGM = 8;
__device__ __forceinline__ int lds_byte(int r, int c) { const int st = (r >> 4) * 2 + (c >> 5), rr = r & 15, cc = c & 31, ob = rr * 64 + cc * 2; return st * 1024 + (ob ^ (((ob >> 9) & 1) << 5)); }
__device__ __forceinline__ void stage_rc(int b, int& R, int& C) { const int st = b / 1024, sb = b % 1024, swz = sb ^ (((sb >> 9) & 1) << 5); R = (st >> 1) * 16 + swz / 64; C = (st & 1) * 32 + (swz % 64) / 2; }
struct Unit { int pm, pn; };
struct Gemm { const u16* A; const u16* Bt; int M, N, K, lda, gate, noepi; };
struct StaticOrder {
  int nM, nN, nwg, G, c;
  __device__ void init(int M, int N, int G_, int c_) { nM = M / BM; nN = N / BM; nwg = nM * nN; G = G_; c = c_; }
  __device__ bool next(int i, Unit& u) const {
    const long L = (long)i * G + c; if (L >= nwg) return false;
    int wgid = (int)L; { const int q = nwg / NXCD, r = nwg % NXCD, xcd = wgid % NXCD, off = wgid / NXCD; wgid = (xcd < r ? xcd * (q + 1) : r * (q + 1) + (xcd - r) * q) + off; }
    const int nig = WGM * nN, gid = wgid / nig, fm = gid * WGM, gsz = (nM - fm) < WGM ? (nM - fm) : WGM;
    u.pm = fm + ((wgid % nig) % gsz); u.pn = (wgid % nig) / gsz; return true;
  }
};
template <class Epi>
__device__ __forceinline__ void gemm_phase(LAS unsigned char* lds, const Gemm g, const StaticOrder& S, const Epi& E) {
  const int tid = threadIdx.x, wid = __builtin_amdgcn_readfirstlane(tid >> 6), lane = tid & 63, wr = wid >> 2, wc = wid & 3, fr = lane & 15, fq = lane >> 4;
  const int K = g.K, nt = K / BK;
  unsigned voffA[2], voffB[2];
#pragma unroll
  for (int i = 0; i < 2; ++i) { int R, C; stage_rc(tid * 16 + i * 8192, R, C); voffA[i] = (unsigned)(R * g.lda + C) * 2u; voffB[i] = (unsigned)(R * K + C) * 2u; }
  const size_t kstep = (size_t)(BK * 2);
  const size_t hstepA = (size_t)HALF * g.lda * 2, hstepB = (size_t)HALF * K * 2;
  const size_t tstepA = 2 * hstepA, tstepB = 2 * hstepB;
  const unsigned ldsw = (unsigned)wid * 1024u;
  const int aoff = lds_byte(wr * 64 + fr, fq * 8), boff = lds_byte(wc * 32 + fr, fq * 8);
#define PG8_AOFF(pn) (g.gate ? (size_t)((((pn) >> 1) & 3) * 512) : (size_t)0)
#define PG8_SA(b, h) (((b) * 2 + (h)) * HTB)
#define PG8_SB(b, h) ((4 + (b) * 2 + (h)) * HTB)
#define PG8_STAGE(bufoff, gbase, voff) do { _Pragma("unroll") for (int _i = 0; _i < 2; ++_i) \
    __builtin_amdgcn_global_load_lds((const unsigned*)((const char*)(gbase) + (voff)[_i]), (LAS unsigned*)(lds + (bufoff) + ldsw + _i * 8192), 16, 0, 0); } while (0)
#define PG8_LDA(dst, b, h) do { _Pragma("unroll") for (int m = 0; m < 4; ++m) _Pragma("unroll") for (int k = 0; k < 2; ++k) dst[m][k] = *(const LAS bf16x8*)(lds + PG8_SA(b, h) + aoff + m * 2048 + k * 1024); } while (0)
#define PG8_LDB(dst, b, h) do { _Pragma("unroll") for (int n = 0; n < 2; ++n) _Pragma("unroll") for (int k = 0; k < 2; ++k) dst[n][k] = *(const LAS bf16x8*)(lds + PG8_SB(b, h) + boff + n * 2048 + k * 1024); } while (0)
#define PG8_MMA(ai, bj, At, Bt) do { __builtin_amdgcn_s_setprio(1); _Pragma("unroll") for (int m = 0; m < 4; ++m) _Pragma("unroll") for (int n = 0; n < 2; ++n) _Pragma("unroll") for (int k = 0; k < 2; ++k) \
    acc[ai][bj][m][n] = __builtin_amdgcn_mfma_f32_16x16x32_bf16(Bt[n][k], At[m][k], acc[ai][bj][m][n], 0, 0, 0); __builtin_amdgcn_s_setprio(0); } while (0)
#define PG8_WAIT_V(n) asm volatile("s_waitcnt vmcnt(" #n ")" ::: "memory")
#define PG8_WAIT_L(n) asm volatile("s_waitcnt lgkmcnt(" #n ")" ::: "memory")
#define PG8_BAR __builtin_amdgcn_s_barrier()
#define PG8_SCHED __builtin_amdgcn_sched_barrier(0)
  Unit cur, nxt; int ui = 0;
  if (!S.next(0, cur)) return;
  f32x4 acc[2][2][4][2];
#pragma unroll
  for (int a = 0; a < 2; ++a)
#pragma unroll
    for (int b = 0; b < 2; ++b)
#pragma unroll
      for (int m = 0; m < 4; ++m)
#pragma unroll
        for (int n = 0; n < 2; ++n) acc[a][b][m][n] = (f32x4){0.f, 0.f, 0.f, 0.f};
  bf16x8 At[4][2], B0[2][2], B1[2][2];
  const char* cA = (const char*)g.A + (size_t)cur.pm * tstepA + PG8_AOFF(cur.pn); const char* cB = (const char*)g.Bt + (size_t)cur.pn * tstepB;
  PG8_STAGE(PG8_SB(0, 0), cB, voffB); PG8_STAGE(PG8_SA(0, 0), cA, voffA); PG8_STAGE(PG8_SB(0, 1), cB + hstepB, voffB); PG8_STAGE(PG8_SA(0, 1), cA + hstepA, voffA);
  if (wr == 1) PG8_BAR;
  PG8_WAIT_V(4); PG8_BAR;
  PG8_STAGE(PG8_SB(1, 0), cB + kstep, voffB); PG8_STAGE(PG8_SA(1, 0), cA + kstep, voffA); PG8_STAGE(PG8_SB(1, 1), cB + hstepB + kstep, voffB);
  PG8_WAIT_V(6); PG8_BAR;
  for (;;) {
    const bool has_next = S.next(ui + 1, nxt);
    const char* nA = has_next ? (const char*)g.A + (size_t)nxt.pm * tstepA + PG8_AOFF(nxt.pn) : cA; const char* nB = has_next ? (const char*)g.Bt + (size_t)nxt.pn * tstepB : cB;
#pragma unroll 1
    for (int t = 0; t < nt; t += 2) {
      const bool last = (t == nt - 2);
      const char* a1 = cA + (size_t)(t + 1) * kstep;
      const char* a2 = last ? nA : cA + (size_t)(t + 2) * kstep; const char* b2 = last ? nB : cB + (size_t)(t + 2) * kstep;
      const char* a3 = a2 + kstep; const char* b3 = b2 + kstep;
      PG8_LDB(B0, 0, 0); PG8_SCHED; PG8_LDA(At, 0, 0); PG8_STAGE(PG8_SA(1, 1), a1 + hstepA, voffA);
      PG8_WAIT_L(8); PG8_BAR; PG8_WAIT_L(0); PG8_MMA(0, 0, At, B0); PG8_BAR; PG8_SCHED;
      PG8_LDB(B1, 0, 1); PG8_STAGE(PG8_SB(0, 0), b2, voffB);
      PG8_BAR; PG8_WAIT_L(0); PG8_MMA(0, 1, At, B1); PG8_BAR;
      PG8_LDA(At, 0, 1); PG8_STAGE(PG8_SA(0, 0), a2, voffA);
      PG8_BAR; PG8_WAIT_L(0); PG8_MMA(1, 0, At, B0); PG8_BAR; PG8_SCHED;
      PG8_STAGE(PG8_SB(0, 1), b2 + hstepB, voffB);
      PG8_WAIT_V(6); PG8_BAR; PG8_MMA(1, 1, At, B1); PG8_BAR;
      PG8_LDB(B0, 1, 0); PG8_SCHED; PG8_LDA(At, 1, 0); PG8_STAGE(PG8_SA(0, 1), a2 + hstepA, voffA);
      PG8_WAIT_L(8); PG8_BAR; PG8_WAIT_L(0); PG8_MMA(0, 0, At, B0); PG8_BAR; PG8_SCHED;
      PG8_LDB(B1, 1, 1); PG8_STAGE(PG8_SB(1, 0), b3, voffB);
      PG8_BAR; PG8_WAIT_L(0); PG8_MMA(0, 1, At, B1); PG8_BAR;
      PG8_LDA(At, 1, 1); PG8_STAGE(PG8_SA(1, 0), a3, voffA);
      PG8_BAR; PG8_WAIT_L(0); PG8_MMA(1, 0, At, B0); PG8_BAR; PG8_SCHED;
      PG8_STAGE(PG8_SB(1, 1), b3 + hstepB, voffB);
      PG8_WAIT_V(6); PG8_BAR; PG8_MMA(1, 1, At, B1); PG8_BAR;
    }
    if constexpr (!Epi::AFTER_DRAIN) { if (!g.noepi) E(acc, cur, wr, wc, fr, fq); }
    if (!has_next) break;
#pragma unroll
    for (int a = 0; a < 2; ++a)
#pragma unroll
      for (int b = 0; b < 2; ++b)
#pragma unroll
        for (int m = 0; m < 4; ++m)
#pragma unroll
          for (int n = 0; n < 2; ++n) acc[a][b][m][n] = (f32x4){0.f, 0.f, 0.f, 0.f};
    cur = nxt; cA = nA; cB = nB; ++ui;
  }
  PG8_WAIT_V(0);
  if (wr == 0) PG8_BAR;
  PG8_BAR;
  if constexpr (Epi::AFTER_DRAIN) { if (!g.noepi) E.fused(acc, cur, wr, wc, fr, fq, lds); }
#undef PG8_AOFF
#undef PG8_SA
#undef PG8_SB
#undef PG8_STAGE
#undef PG8_LDA
#undef PG8_LDB
#undef PG8_MMA
#undef PG8_WAIT_V
#undef PG8_WAIT_L
#undef PG8_BAR
#undef PG8_SCHED
}
}
using pg8::Unit;
typedef const f32x4 (&AccRef)[2][2][4][2];

#define EPI_ROWS(...) _Pragma("unroll") for (int ai = 0; ai < 2; ++ai) _Pragma("unroll") for (int m = 0; m < 4; ++m) { const int row = u.pm * 256 + ai * 128 + wr * 64 + m * 16 + fr; __VA_ARGS__ }
#define EPI_COLS(...) _Pragma("unroll") for (int bj = 0; bj < 2; ++bj) _Pragma("unroll") for (int n = 0; n < 2; ++n) { const int cb = u.pn * 256 + bj * 128 + wc * 32 + n * 16; const f32x4 a = acc[ai][bj][m][n]; __VA_ARGS__ }

struct EpiHgIn {
  static constexpr bool AFTER_DRAIN = false;
  u16 *q, *v, *sg; _Float16* lf; const float* lb;
  __device__ __forceinline__ void operator()(AccRef acc, const Unit& u, int wr, int wc, int fr, int fq) const {
    const int region = u.pn >> 2;
    f32x4 l4[2][2];
    if (region == 1 || region == 2) {
#pragma unroll
      for (int bj = 0; bj < 2; ++bj)
#pragma unroll
        for (int n = 0; n < 2; ++n) l4[bj][n] = *(const f32x4*)&lb[(region - 1) * 1024 + ((u.pn * 256 + bj * 128 + wc * 32 + n * 16) & 1023) + fq * 4];
    }
    EPI_ROWS( EPI_COLS(
      const int c = (cb & 1023) + fq * 4;
      if (region == 0) {
        const float s = 0.08838834764831845f;
        *(uint2*)&q[(size_t)row * 1024 + c] = pack4(siluf_(a[0]) * s, siluf_(a[1]) * s, siluf_(a[2]) * s, siluf_(a[3]) * s);
      } else if (region <= 2) {
        const int d = region - 1;
        h4 o;
        _Pragma("unroll") for (int j = 0; j < 4; ++j) { float f = l4[bj][n][j] + (1.0f - l4[bj][n][j]) * sigmoidf_(a[j]); o[j] = (_Float16)__logf(f); }
        *(h4*)&lf[(size_t)row * 2048 + d * 1024 + c] = o;
      } else if (region == 3) {
        *(uint2*)&v[(size_t)row * 1024 + c] = pack4(a[0], a[1], a[2], a[3]);
      } else {
        *(uint2*)&sg[(size_t)row * 1024 + c] = pack4(a[0], a[1], a[2], a[3]);
      }
    ) )
  }
};

struct EpiRes {
  static constexpr bool AFTER_DRAIN = false;
  const float* xin_p; const float* xin_s; float* Y; const float* gate;
  __device__ __forceinline__ void operator()(AccRef acc, const Unit& u, int wr, int wc, int fr, int fq) const {
    EPI_ROWS(
      const float* xr = row < NPROMPT ? xin_p + (size_t)row * 1024 : xin_s + (size_t)(row - NPROMPT) * 1024;
      const float* g = gate + cond_of(row) * 3072;
      EPI_COLS(
        const int c = cb + fq * 4;
        f32x4 x = *(const f32x4*)&xr[c];
        f32x4 gg = *(const f32x4*)&g[c];
        f32x4 y;
        _Pragma("unroll") for (int j = 0; j < 4; ++j) y[j] = DN_ALPHA * x[j] + gg[j] * a[j];
        *(f32x4*)&Y[(size_t)row * 1024 + c] = y;
      ) )
  }
};

template <bool XIN_BF, bool XOUT_BF>
struct EpiResLn {
  static constexpr bool AFTER_DRAIN = true;
  const float* xin_p; const float* xin_s; const u16* xin_b; float* X; u16* XB; const float* gate; const float* lg; const float* lbias; const float* modn; u16* H;
  unsigned long long* slots; unsigned* cnt;
  __device__ __forceinline__ void fused(f32x4 (&acc)[2][2][4][2], const Unit& u, int wr, int wc, int fr, int fq, LAS unsigned char* lds) const {
    LAS float* part = (LAS float*)lds;
    LAS float* stat = part + 2048;
    const int tid = threadIdx.x;
    const int cnd = cond_of(u.pm * 256);
    f32x4 gv[2][2];
#pragma unroll
    for (int bj = 0; bj < 2; ++bj)
#pragma unroll
      for (int n = 0; n < 2; ++n) gv[bj][n] = *(const f32x4*)&gate[cnd * 3072 + u.pn * 256 + bj * 128 + wc * 32 + n * 16 + fq * 4];
#pragma unroll
    for (int ai = 0; ai < 2; ++ai)
#pragma unroll
      for (int m = 0; m < 4; ++m) {
        const int rl = ai * 128 + wr * 64 + m * 16 + fr;
        const int row = u.pm * 256 + rl;
        const float* xr = row < NPROMPT ? xin_p + (size_t)row * 1024 : xin_s + (size_t)(row - NPROMPT) * 1024;
        float s1 = 0.f, s2 = 0.f;
#pragma unroll
        for (int bj = 0; bj < 2; ++bj)
#pragma unroll
          for (int n = 0; n < 2; ++n) {
            const int c = u.pn * 256 + bj * 128 + wc * 32 + n * 16 + fq * 4;
            f32x4 x;
            if constexpr (XIN_BF) { const uint2 xb2 = *(const uint2*)&xin_b[(size_t)row * 1024 + c]; x = f32x4{lo16(xb2.x), hi16(xb2.x), lo16(xb2.y), hi16(xb2.y)}; }
            else x = *(const f32x4*)&xr[c];
            const f32x4 gg = gv[bj][n];
            f32x4 y;
#pragma unroll
            for (int j = 0; j < 4; ++j) { y[j] = DN_ALPHA * x[j] + gg[j] * acc[ai][bj][m][n][j]; s1 += y[j]; s2 += y[j] * y[j]; }
            acc[ai][bj][m][n] = y;
          }
        s1 += __shfl_xor(s1, 16); s1 += __shfl_xor(s1, 32);
        s2 += __shfl_xor(s2, 16); s2 += __shfl_xor(s2, 32);
        if (fq == 0) { part[(rl * 4 + wc) * 2] = s1; part[(rl * 4 + wc) * 2 + 1] = s2; }
      }
    __syncthreads();
    if (tid < 256) {
      float S1 = 0.f, S2 = 0.f;
#pragma unroll
      for (int w2 = 0; w2 < 4; ++w2) { S1 += part[(tid * 4 + w2) * 2]; S2 += part[(tid * 4 + w2) * 2 + 1]; }
      const unsigned long long v = (unsigned long long)__float_as_uint(S1) | ((unsigned long long)__float_as_uint(S2) << 32);
      __hip_atomic_store(&slots[(size_t)(u.pm * 4 + u.pn) * 256 + tid], v, __ATOMIC_RELAXED, __HIP_MEMORY_SCOPE_AGENT);
    }
    asm volatile("s_waitcnt vmcnt(0)" ::: "memory");
    __syncthreads();
    if (tid == 0) {
      __hip_atomic_fetch_add(&cnt[u.pm], 1u, __ATOMIC_RELAXED, __HIP_MEMORY_SCOPE_AGENT);
      unsigned sp = 0;
      while (__hip_atomic_load(&cnt[u.pm], __ATOMIC_RELAXED, __HIP_MEMORY_SCOPE_AGENT) < 4u) { __builtin_amdgcn_s_sleep(1); if (++sp > (1u << 24)) break; }
    }
    __syncthreads();
    if (tid < 256) {
      float T1 = 0.f, T2 = 0.f;
#pragma unroll
      for (int o = 0; o < 4; ++o) {
        const unsigned long long v = __hip_atomic_load(&slots[(size_t)(u.pm * 4 + o) * 256 + tid], __ATOMIC_RELAXED, __HIP_MEMORY_SCOPE_AGENT);
        T1 += __uint_as_float((unsigned)(v & 0xffffffffull)); T2 += __uint_as_float((unsigned)(v >> 32));
      }
      const float mu = T1 * (1.0f / 1024.0f);
      const float var = fmaxf(T2 * (1.0f / 1024.0f) - mu * mu, 0.f);
      stat[tid * 2] = mu; stat[tid * 2 + 1] = rsqrtf(var + 1e-5f);
    }
    __syncthreads();
#pragma unroll
    for (int bj = 0; bj < 2; ++bj) {
      f32x4 lgv[2], lbv[2], shv[2], scv[2];
#pragma unroll
      for (int n = 0; n < 2; ++n) {
        const int c = u.pn * 256 + bj * 128 + wc * 32 + n * 16 + fq * 4;
        lgv[n] = *(const f32x4*)&lg[c]; lbv[n] = *(const f32x4*)&lbias[c];
        shv[n] = *(const f32x4*)&modn[cnd * 3072 + c]; scv[n] = *(const f32x4*)&modn[cnd * 3072 + 1024 + c];
      }
#pragma unroll
      for (int ai = 0; ai < 2; ++ai)
#pragma unroll
        for (int m = 0; m < 4; ++m) {
          const int rl = ai * 128 + wr * 64 + m * 16 + fr;
          const int row = u.pm * 256 + rl;
          const float mu = stat[rl * 2], rs = stat[rl * 2 + 1];
#pragma unroll
          for (int n = 0; n < 2; ++n) {
            const int c = u.pn * 256 + bj * 128 + wc * 32 + n * 16 + fq * 4;
            const f32x4 y = acc[ai][bj][m][n];
            f32x4 xo;
#pragma unroll
            for (int j = 0; j < 4; ++j) xo[j] = (y[j] - mu) * rs * lgv[n][j] + lbv[n][j];
            if constexpr (XOUT_BF) *(uint2*)&XB[(size_t)row * 1024 + c] = pack4(xo[0], xo[1], xo[2], xo[3]);
            else *(f32x4*)&X[(size_t)row * 1024 + c] = xo;
            if (H) {
              *(uint2*)&H[(size_t)row * 1024 + c] = pack4(xo[0] * (1 + scv[n][0]) + shv[n][0], xo[1] * (1 + scv[n][1]) + shv[n][1], xo[2] * (1 + scv[n][2]) + shv[n][2], xo[3] * (1 + scv[n][3]) + shv[n][3]);
            }
          }
        }
    }
  }
};

struct EpiScIn {
  static constexpr bool AFTER_DRAIN = false;
  u16 *pb, *sb;
  __device__ __forceinline__ void operator()(AccRef acc, const Unit& u, int wr, int wc, int fr, int fq) const {
    const int c = u.pn * 64 + wc * 16 + fq * 4;
    EPI_ROWS(
      const f32x4 bg = acc[ai][0][m][0], cgv = acc[ai][0][m][1], v = acc[ai][1][m][0], g = acc[ai][1][m][1];
      *(uint2*)&pb[(size_t)row * 1024 + c] = pack4(cgv[0] * v[0], cgv[1] * v[1], cgv[2] * v[2], cgv[3] * v[3]);
      *(uint2*)&sb[(size_t)row * 1024 + c] = pack4(siluf_(g[0]) * bg[0], siluf_(g[1]) * bg[1], siluf_(g[2]) * bg[2], siluf_(g[3]) * bg[3]);
    )
  }
};

struct EpiRgIn {
  static constexpr bool AFTER_DRAIN = false;
  u16 *ub, *sg;
  __device__ __forceinline__ void operator()(AccRef acc, const Unit& u, int wr, int wc, int fr, int fq) const {
    const int region = u.pn >> 2;
    EPI_ROWS( EPI_COLS(
      const int c = (cb & 1023) + fq * 4;
      if (region == 0) *(uint2*)&ub[(size_t)row * 1024 + c] = pack4(a[0], a[1], a[2], a[3]);
      else *(uint2*)&sg[(size_t)row * 1024 + c] = pack4(siluf_(a[0]), siluf_(a[1]), siluf_(a[2]), siluf_(a[3]));
    ) )
  }
};

struct EpiRgGate {
  static constexpr bool AFTER_DRAIN = false;
  u16 *rb, *ib; const float* bgate;
  __device__ __forceinline__ void operator()(AccRef acc, const Unit& u, int wr, int wc, int fr, int fq) const {
    const int mat = u.pn >> 1, d = mat >> 2, hd = mat & 3;
    f32x4 br[2], bi[2]; int ccs[2];
#pragma unroll
    for (int bj = 0; bj < 2; ++bj) {
      const int off = ((u.pn & 1) * 256 + bj * 128 + wc * 32);
      ccs[bj] = (off >> 5) * 16 + fq * 4;
      br[bj] = *(const f32x4*)&bgate[mat * 512 + ccs[bj]];
      bi[bj] = *(const f32x4*)&bgate[mat * 512 + 256 + ccs[bj]];
    }
    EPI_ROWS(
      _Pragma("unroll") for (int bj = 0; bj < 2; ++bj) {
        const f32x4 r = acc[ai][bj][m][0], ii = acc[ai][bj][m][1];
        const size_t o = ((size_t)d * TOK + row) * 1024 + hd * 256 + ccs[bj];
        *(uint2*)&rb[o] = pack4(sigmoidf_(r[0] + br[bj][0]), sigmoidf_(r[1] + br[bj][1]), sigmoidf_(r[2] + br[bj][2]), sigmoidf_(r[3] + br[bj][3]));
        *(uint2*)&ib[o] = pack4(sigmoidf_(ii[0] + bi[bj][0]), sigmoidf_(ii[1] + bi[bj][1]), sigmoidf_(ii[2] + bi[bj][2]), sigmoidf_(ii[3] + bi[bj][3]));
      } )
  }
};

struct EpiMlaIn {
  static constexpr bool AFTER_DRAIN = false;
  u16* cq; float* ckvraw; float* kperaw; u16* sg;
  __device__ __forceinline__ void operator()(AccRef acc, const Unit& u, int wr, int wc, int fr, int fq) const {
    EPI_ROWS( EPI_COLS(
      const int c = cb + fq * 4;
      if (cb < 384) *(uint2*)&cq[(size_t)row * 384 + c] = pack4(a[0], a[1], a[2], a[3]);
      else if (cb < 640) *(f32x4*)&ckvraw[(size_t)row * 256 + (c - 384)] = a;
      else if (cb < 672) *(f32x4*)&kperaw[(size_t)row * 32 + (c - 640)] = a;
    ) )
  }
};

struct EpiSg {
  static constexpr bool AFTER_DRAIN = false;
  u16* sg;
  __device__ __forceinline__ void operator()(AccRef acc, const Unit& u, int wr, int wc, int fr, int fq) const {
    EPI_ROWS( EPI_COLS(
      *(uint2*)&sg[(size_t)row * 1024 + cb + fq * 4] = pack4(a[0], a[1], a[2], a[3]);
    ) )
  }
};

struct EpiQ {
  static constexpr bool AFTER_DRAIN = false;
  u16* q;
  __device__ __forceinline__ void operator()(AccRef acc, const Unit& u, int wr, int wc, int fr, int fq) const {
    const float sc = 0.14724444500602648f;
    EPI_ROWS( EPI_COLS(
      *(uint2*)&q[(size_t)row * 1536 + cb + fq * 4] = pack4(a[0] * sc, a[1] * sc, a[2] * sc, a[3] * sc);
    ) )
  }
};

struct EpiK {
  static constexpr bool AFTER_DRAIN = false;
  u16* Kb;
  __device__ __forceinline__ void operator()(AccRef acc, const Unit& u, int wr, int wc, int fr, int fq) const {
    EPI_ROWS( EPI_COLS(
      const int h = cb >> 6, dd = (cb & 63) + fq * 4;
      *(uint2*)&Kb[((size_t)row * 16 + h) * 96 + dd] = pack4(a[0], a[1], a[2], a[3]);
    ) )
  }
};
struct EpiV {
  static constexpr bool AFTER_DRAIN = false;
  u16* Vt;
  __device__ __forceinline__ void operator()(AccRef acc, const Unit& u, int wr, int wc, int fr, int fq) const {
    EPI_ROWS( EPI_COLS(
      *(uint2*)&Vt[(size_t)row * KVROWS + cb + fq * 4] = pack4(a[0], a[1], a[2], a[3]);
    ) )
  }
};

__device__ __forceinline__ void wconv_tile(const float* __restrict__ src, int N, int K, u16* __restrict__ dst, int k0, int n0,
                                           int perm, int mat, float* tile) {
  const int tid = threadIdx.x;
  {
    const int r = tid >> 4, c4 = (tid & 15) * 4;
#pragma unroll
    for (int i = 0; i < 2; ++i) {
      const int k = r + i * 32;
      f32x4 v = f32x4{0.f, 0.f, 0.f, 0.f};
      if (n0 + c4 < N) v = *(const f32x4*)&src[(size_t)(k0 + k) * N + n0 + c4];
      tile[k * 65 + c4 + 0] = v[0]; tile[k * 65 + c4 + 1] = v[1]; tile[k * 65 + c4 + 2] = v[2]; tile[k * 65 + c4 + 3] = v[3];
    }
  }
  __syncthreads();
  {
    const int nl = tid >> 3, kq = (tid & 7) * 8;
    const int n = n0 + nl;
    int np = n;
    if (perm == 1) { const int part = n >> 10, c = n & 1023; np = (c >> 6) * 256 + (part >> 1) * 128 + ((c >> 4) & 3) * 32 + (part & 1) * 16 + (c & 15); }
    else if (perm == 2) { const int type = n >> 8, cc = n & 255; np = mat * 512 + (cc >> 4) * 32 + type * 16 + (cc & 15); }
    else if (perm == 3) { const int hh = n >> 7, dd = n & 127; np = (dd >= 64 ? 1024 : 0) + hh * 64 + (dd & 63); }
    if (n < N) {
      unsigned w[4];
#pragma unroll
      for (int i = 0; i < 4; ++i) w[i] = pack2(tile[(kq + 2 * i) * 65 + nl], tile[(kq + 2 * i + 1) * 65 + nl]);
      *(uint4*)&dst[(size_t)np * K + k0 + kq] = make_uint4(w[0], w[1], w[2], w[3]);
    }
  }
  __syncthreads();
}

__device__ __forceinline__ void wconv_item(const Params& p, int t, float* fs) {
  const float* src; u16* dst; int N, K, perm = 0, mat = 0, ntn;
  if (t < 1280) { src = p.in[12]; dst = (u16*)(p.ws + WS_W_HG_IN); N = 5120; K = 1024; }
  else if ((t -= 1280) < 256) { src = p.in[15]; dst = (u16*)(p.ws + WS_W_HG_OUT); N = 1024; K = 1024; }
  else if ((t -= 256) < 1024) { src = p.in[16]; dst = (u16*)(p.ws + WS_W_SC_IN); N = 4096; K = 1024; perm = 1; }
  else if ((t -= 1024) < 256) { src = p.in[19]; dst = (u16*)(p.ws + WS_W_SC_OUT); N = 1024; K = 1024; }
  else if ((t -= 256) < 512) { src = p.in[20]; dst = (u16*)(p.ws + WS_W_RG_IN); N = 2048; K = 1024; }
  else if ((t -= 512) < 256) { mat = t >> 5; t &= 31; src = p.in[23] + (size_t)mat * 256 * 512; dst = (u16*)(p.ws + WS_W_RG_GATE); N = 512; K = 256; perm = 2; }
  else if ((t -= 256) < 256) { src = p.in[26]; dst = (u16*)(p.ws + WS_W_RG_OUT); N = 1024; K = 1024; }
  else if ((t -= 256) < 432) { src = p.in[27]; dst = (u16*)(p.ws + WS_W_MLA_IN); N = 1696; K = 1024; }
  else if ((t -= 432) < 144) { src = p.in[30]; dst = (u16*)(p.ws + WS_W_QB); N = 1536; K = 384; }
  else if ((t -= 144) < 128) { src = p.in[31]; dst = (u16*)(p.ws + WS_W_KVB); N = 2048; K = 256; perm = 3; }
  else { t -= 128; src = p.in[32]; dst = (u16*)(p.ws + WS_W_MLA_OUT); N = 1024; K = 1024; }
  ntn = (N + 63) >> 6;
  const int kt = t / ntn, ntl = t - kt * ntn;
  wconv_tile(src, N, K, dst, kt * 64, ntl * 64, perm, mat, fs);
}
__device__ __forceinline__ void wconv_idle(const Params& p, unsigned char* smem_raw, int bid, int nb, int t0, int t1) {
  if (nb == 256 && bid >= 192) for (int t = t0 + (bid - 192); t < t1; t += 64) wconv_item(p, t, (float*)smem_raw);
}

__device__ __forceinline__ void phase_prologue(const Params& p, unsigned char* smem_raw, int bid, int nb) {
  float* fs = (float*)smem_raw;
  const int tid = threadIdx.x;
  const int NMOD = 192, NWT = (nb == 256) ? 1536 : 4800;
  for (int it = bid; it < NMOD + 1 + NWT; it += nb) {
    if (it < NMOD) {
      const int l = it / 48, n0 = (it % 48) * 64;
      float* scond = fs;
      float* sred = fs + 5120;
      for (int i = tid; i < 5120; i += NT) {
        const int ci = i >> 10, k = i & 1023;
        float cv = ci == 0 ? p.in[7][k] : p.in[6][(ci - 1) * 1024 + k];
        scond[i] = siluf_(cv);
      }
      __syncthreads();
      const int col = tid & 63, kg = tid >> 6;
      const float* w = p.in[8] + (size_t)l * 1024 * 3072 + n0 + col;
      float a0 = 0, a1 = 0, a2 = 0, a3 = 0, a4 = 0;
#pragma unroll 16
      for (int k = kg * 128; k < kg * 128 + 128; ++k) {
        float wv = w[(size_t)k * 3072];
        a0 += scond[k] * wv; a1 += scond[1024 + k] * wv; a2 += scond[2048 + k] * wv; a3 += scond[3072 + k] * wv; a4 += scond[4096 + k] * wv;
      }
      sred[(kg * 5 + 0) * 64 + col] = a0; sred[(kg * 5 + 1) * 64 + col] = a1; sred[(kg * 5 + 2) * 64 + col] = a2;
      sred[(kg * 5 + 3) * 64 + col] = a3; sred[(kg * 5 + 4) * 64 + col] = a4;
      __syncthreads();
      float* mod = (float*)(p.ws + WS_MOD);
      if (tid < 320) {
        const int ci = tid >> 6, cc = tid & 63;
        float s = 0;
#pragma unroll
        for (int g = 0; g < 8; ++g) s += sred[(g * 5 + ci) * 64 + cc];
        mod[(l * 5 + ci) * 3072 + n0 + cc] = s + p.in[9][l * 3072 + n0 + cc];
      }
      __syncthreads();
    } else if (it == NMOD) {
      float* lb = (float*)(p.ws + WS_LB);
      for (int i = tid; i < 2048; i += NT) {
        const int d = i >> 10, c = i & 1023;
        const float* lg = p.in[13] + d * 5 * 1024 + c;
        float m = lg[0];
        for (int j = 1; j < 5; ++j) m = fmaxf(m, lg[j * 1024]);
        float s = 0;
        for (int j = 0; j < 5; ++j) s += expf(lg[j * 1024] - m);
        lb[i] = expf(lg[0] - m) / s;
      }
      int* cnt = (int*)(p.ws + WS_CNT);
      if (tid < 16) cnt[tid] = 0;
    } else {
      wconv_item(p, it - NMOD - 1, fs);
    }
  }
}

__device__ __forceinline__ void phase_h0(const Params& p, int bid, int nb) {
  const float* mod = (const float*)(p.ws + WS_MOD);
  u16* H = (u16*)(p.ws + WS_H);
  const size_t total = (size_t)(TOK / 4) * 256;
  for (size_t i = (size_t)bid * NT + threadIdx.x; i < total; i += (size_t)nb * NT) {
    const int row = (int)(i >> 8) * 4, c = ((int)i & 255) * 4;
    const float* xr = row < NPROMPT ? p.in[0] + (size_t)row * 1024 : p.in[1] + (size_t)(row - NPROMPT) * 1024;
    const float* m = mod + cond_of(row) * 3072;
    f32x4 x[4];
#pragma unroll
    for (int t = 0; t < 4; ++t) x[t] = *(const f32x4*)&xr[t * 1024 + c];
    const f32x4 sh = *(const f32x4*)&m[c];
    const f32x4 sc = *(const f32x4*)&m[1024 + c];
#pragma unroll
    for (int t = 0; t < 4; ++t)
      *(uint2*)&H[(size_t)(row + t) * 1024 + c] = pack4(x[t][0] * (1 + sc[0]) + sh[0], x[t][1] * (1 + sc[1]) + sh[1], x[t][2] * (1 + sc[2]) + sh[2], x[t][3] * (1 + sc[3]) + sh[3]);
  }
}

__device__ __forceinline__ void phase_ln(const Params& p, int l, int bid, int nb) {
  float* X = p.out;
  const float* g = p.in[10] + l * 1024;
  const float* b = p.in[11] + l * 1024;
  const float* mod = (const float*)(p.ws + WS_MOD) + (l + 1) * 5 * 3072;
  u16* H = (u16*)(p.ws + WS_H);
  const int lane = threadIdx.x & 63, wave = threadIdx.x >> 6;
  for (int row = bid * NW + wave; row < TOK; row += nb * NW) {
    float* xr = X + (size_t)row * 1024;
    f32x4 v[4];
    float s = 0;
#pragma unroll
    for (int i = 0; i < 4; ++i) { v[i] = *(const f32x4*)&xr[i * 256 + lane * 4]; s += v[i][0] + v[i][1] + v[i][2] + v[i][3]; }
    const float mu = wave_sum(s) * (1.0f / 1024.0f);
    float q = 0;
#pragma unroll
    for (int i = 0; i < 4; ++i)
#pragma unroll
      for (int j = 0; j < 4; ++j) { float dd = v[i][j] - mu; q += dd * dd; }
    const float rs = rsqrtf(wave_sum(q) * (1.0f / 1024.0f) + 1e-5f);
    const float* m = mod + cond_of(row) * 3072;
#pragma unroll
    for (int i = 0; i < 4; ++i) {
      const int c = i * 256 + lane * 4;
      f32x4 gg = *(const f32x4*)&g[c], bb = *(const f32x4*)&b[c];
      f32x4 y;
#pragma unroll
      for (int j = 0; j < 4; ++j) y[j] = (v[i][j] - mu) * rs * gg[j] + bb[j];
      *(f32x4*)&xr[c] = y;
      if (l < 3) {
        f32x4 sh = *(const f32x4*)&m[c], sc = *(const f32x4*)&m[1024 + c];
        *(uint2*)&H[(size_t)row * 1024 + c] = pack4(y[0] * (1 + sc[0]) + sh[0], y[1] * (1 + sc[1]) + sh[1], y[2] * (1 + sc[2]) + sh[2], y[3] * (1 + sc[3]) + sh[3]);
      }
    }
  }
}

__device__ __forceinline__ void phase_gla(const Params& p, unsigned char* smem_raw) {
  u16* s_qrel = (u16*)smem_raw;
  u16* s_krel = s_qrel + 32 * 136;
  u16* s_qcum = s_krel + 32 * 136;
  u16* s_kdT = s_qcum + 32 * 136;
  u16* s_vT = s_kdT + 128 * 40;
  u16* s_att = s_vT + 64 * 40;
  u16* s_S = s_att + 32 * 40;
  float* s_dec = (float*)(s_S + 64 * 136);
  float* s_part = s_dec + 128;
  int* s_u = (int*)(s_part + 512);
  int* counter = (int*)(p.ws + WS_CNT);
  const u16* qg = (const u16*)(p.ws + WS_B(0));
  const u16* vg = (const u16*)(p.ws + WS_B(1));
  const _Float16* lfg = (const _Float16*)(p.ws + WS_B(3));
  u16* og = (u16*)(p.ws + WS_B(5));
  const int tid = threadIdx.x, lane = tid & 63, w = tid >> 6, fr = lane & 15, fq = lane >> 4;
  const int kk = tid & 127, th = tid >> 7;
  const int ti = w >> 2, vi = w & 3;
  const int wk = w & 3, wv = w >> 2;
  while (true) {
    if (tid == 0) *s_u = atomicAdd(counter, 1);
    __syncthreads();
    const int u = *s_u;
    __syncthreads();
    if (u >= 1152) break;
    int b, rem, start, N, sample;
    if (u < 128) { sample = 1; b = u >> 5; rem = u & 31; start = NPROMPT + b * 1024; N = 1024; }
    else { sample = 0; b = (u - 128) >> 5; rem = (u - 128) & 31; start = b * 256; N = 256; }
    const int h = rem >> 2, d = (rem >> 1) & 1, vs = rem & 1;
    const int nc = N >> 5;
    f32x4 S[2][2];
#pragma unroll
    for (int mi = 0; mi < 2; ++mi)
#pragma unroll
      for (int ni = 0; ni < 2; ++ni) {
        f32x4 s4 = f32x4{0.f, 0.f, 0.f, 0.f};
        if (sample) {
          const float* s0 = p.in[2] + ((size_t)((b * 2 + d) * 8 + h)) * 16384;
#pragma unroll
          for (int j = 0; j < 4; ++j) s4[j] = s0[(wk * 32 + mi * 16 + fq * 4 + j) * 128 + vs * 64 + wv * 32 + ni * 16 + fr];
        }
        S[mi][ni] = s4;
        *(uint2*)&s_S[(wv * 32 + ni * 16 + fr) * 136 + wk * 32 + mi * 16 + fq * 4] = pack4(s4[0], s4[1], s4[2], s4[3]);
      }
    _Float16 lfraw[8]; u16 qraw[8]; uint2 vraw;
#define GLA_LOAD(cc) do { _Pragma("unroll") for (int i = 0; i < 8; ++i) { const int tt = (cc) * 32 + th * 8 + i; const size_t tok = start + (d ? (N - 1 - tt) : tt); \
      lfraw[i] = lfg[tok * 2048 + d * 1024 + h * 128 + kk]; qraw[i] = qg[tok * 1024 + h * 128 + kk]; } \
      { const int tt = (cc) * 32 + (tid >> 4); const size_t tok = start + (d ? (N - 1 - tt) : tt); vraw = *(const uint2*)&vg[tok * 1024 + h * 128 + vs * 64 + (tid & 15) * 4]; } } while (0)
    GLA_LOAD(0);
    for (int c = 0; c < nc; ++c) {
      {
        float lfv[8], qv[8];
#pragma unroll
        for (int i = 0; i < 8; ++i) { lfv[i] = (float)lfraw[i]; qv[i] = bf2f(qraw[i]); }
        const uint2 vv = vraw;
        if (c + 1 < nc) GLA_LOAD(c + 1);
        float run = 0;
        float cs[8];
#pragma unroll
        for (int i = 0; i < 8; ++i) { run += lfv[i]; cs[i] = run; }
        s_part[th * 128 + kk] = run;
        {
          const int s = tid >> 4, v4 = (tid & 15) * 4;
          s_vT[(v4 + 0) * 40 + s] = (u16)(vv.x & 0xffff); s_vT[(v4 + 1) * 40 + s] = (u16)(vv.x >> 16);
          s_vT[(v4 + 2) * 40 + s] = (u16)(vv.y & 0xffff); s_vT[(v4 + 3) * 40 + s] = (u16)(vv.y >> 16);
        }
        __syncthreads();
        const float p0 = s_part[kk], p1 = s_part[128 + kk], p2 = s_part[256 + kk], p3 = s_part[384 + kk];
        const float off = (th > 0 ? p0 : 0.f) + (th > 1 ? p1 : 0.f) + (th > 2 ? p2 : 0.f);
        const float ref = p0 + p1, total = p0 + p1 + p2 + p3;
        unsigned kd[4];
        const float eref = __expf(ref), etr = __expf(total - ref);
#pragma unroll
        for (int i = 0; i < 8; ++i) {
          const int t = th * 8 + i;
          const float cum = off + cs[i];
          const float kf = 1.0f - __expf(lfv[i]);
          const float e1 = __expf(cum - ref), e2 = __builtin_amdgcn_rcpf(e1);
          const float qe = qv[i] * e1, ke = kf * e2;
          s_qrel[t * 136 + kk] = f2bf(qe);
          s_krel[t * 136 + kk] = f2bf(ke);
          s_qcum[t * 136 + kk] = f2bf(qe * eref);
          const u16 kdv = f2bf(ke * etr);
          if (i & 1) kd[i >> 1] |= ((unsigned)kdv) << 16; else kd[i >> 1] = kdv;
        }
        *(uint4*)&s_kdT[kk * 40 + th * 8] = make_uint4(kd[0], kd[1], kd[2], kd[3]);
        if (th == 0) s_dec[kk] = __expf(total);
      }
      __syncthreads();
      f32x4 oacc = f32x4{0.f, 0.f, 0.f, 0.f};
      {
        f32x4 att = f32x4{0.f, 0.f, 0.f, 0.f};
        const int ati = w >> 1, asi = w & 1;
#pragma unroll
        for (int ks = 0; ks < 4; ++ks) {
          if (w < 4) {
            bf16x8 a = *(const bf16x8*)&s_qrel[(ati * 16 + fr) * 136 + ks * 32 + fq * 8];
            bf16x8 bb = *(const bf16x8*)&s_krel[(asi * 16 + fr) * 136 + ks * 32 + fq * 8];
            att = __builtin_amdgcn_mfma_f32_16x16x32_bf16(a, bb, att, 0, 0, 0);
          }
          bf16x8 a2 = *(const bf16x8*)&s_qcum[(ti * 16 + fr) * 136 + ks * 32 + fq * 8];
          bf16x8 b2 = *(const bf16x8*)&s_S[(vi * 16 + fr) * 136 + ks * 32 + fq * 8];
          oacc = __builtin_amdgcn_mfma_f32_16x16x32_bf16(a2, b2, oacc, 0, 0, 0);
        }
        if (w < 4) {
#pragma unroll
          for (int j = 0; j < 4; ++j) {
            const int t = ati * 16 + fq * 4 + j, s = asi * 16 + fr;
            s_att[t * 40 + s] = (s <= t) ? f2bf(att[j]) : (u16)0;
          }
        }
      }
      __syncthreads();
      {
        bf16x8 a = *(const bf16x8*)&s_att[(ti * 16 + fr) * 40 + fq * 8];
        bf16x8 bb = *(const bf16x8*)&s_vT[(vi * 16 + fr) * 40 + fq * 8];
        oacc = __builtin_amdgcn_mfma_f32_16x16x32_bf16(a, bb, oacc, 0, 0, 0);
#pragma unroll
        for (int j = 0; j < 4; ++j) {
          const int tt = c * 32 + ti * 16 + fq * 4 + j;
          const size_t tok = start + (d ? (N - 1 - tt) : tt);
          og[((size_t)d * TOK + tok) * 1024 + h * 128 + vs * 64 + vi * 16 + fr] = f2bf(oacc[j]);
        }
        bf16x8 vf[2];
#pragma unroll
        for (int ni = 0; ni < 2; ++ni) vf[ni] = *(const bf16x8*)&s_vT[(wv * 32 + ni * 16 + fr) * 40 + fq * 8];
#pragma unroll
        for (int mi = 0; mi < 2; ++mi) {
          bf16x8 kf = *(const bf16x8*)&s_kdT[(wk * 32 + mi * 16 + fr) * 40 + fq * 8];
          f32x4 dc = *(const f32x4*)&s_dec[wk * 32 + mi * 16 + fq * 4];
#pragma unroll
          for (int ni = 0; ni < 2; ++ni) {
            f32x4 s4 = S[mi][ni];
#pragma unroll
            for (int j = 0; j < 4; ++j) s4[j] *= dc[j];
            s4 = __builtin_amdgcn_mfma_f32_16x16x32_bf16(kf, vf[ni], s4, 0, 0, 0);
            S[mi][ni] = s4;
            *(uint2*)&s_S[(wv * 32 + ni * 16 + fr) * 136 + wk * 32 + mi * 16 + fq * 4] = pack4(s4[0], s4[1], s4[2], s4[3]);
          }
        }
      }
      __syncthreads();
    }
    if (!sample) {
      float* so = p.out + OUT_HG + ((size_t)((b * 2 + d) * 8 + h)) * 16384;
#pragma unroll
      for (int mi = 0; mi < 2; ++mi)
#pragma unroll
        for (int ni = 0; ni < 2; ++ni)
#pragma unroll
          for (int j = 0; j < 4; ++j) so[(wk * 32 + mi * 16 + fq * 4 + j) * 128 + vs * 64 + wv * 32 + ni * 16 + fr] = S[mi][ni][j];
    }
  }
}

__device__ __forceinline__ void phase_hg_post(const Params& p, int bid, int nb) {
  const u16* og = (const u16*)(p.ws + WS_B(5));
  const u16* sg = (const u16*)(p.ws + WS_B(2));
  u16* a = (u16*)(p.ws + WS_B(0));
  const float* ng = p.in[14];
  const int lane = threadIdx.x & 63, wave = threadIdx.x >> 6;
  float ngv[16];
#pragma unroll
  for (int k = 0; k < 4; ++k) { const f32x4 t = *(const f32x4*)&ng[lane * 16 + 4 * k]; ngv[4 * k] = t[0]; ngv[4 * k + 1] = t[1]; ngv[4 * k + 2] = t[2]; ngv[4 * k + 3] = t[3]; }
  for (int row0 = (bid * NW + wave) * 2; row0 < TOK; row0 += nb * NW * 2) {
    uint4 f[2][2], bw[2][2], sv[2][2];
#pragma unroll
    for (int r = 0; r < 2; ++r)
#pragma unroll
      for (int hh = 0; hh < 2; ++hh) {
        const size_t base = (size_t)(row0 + r) * 1024 + lane * 16 + hh * 8;
        f[r][hh] = *(const uint4*)&og[base];
        bw[r][hh] = *(const uint4*)&og[(size_t)TOK * 1024 + base];
        sv[r][hh] = *(const uint4*)&sg[base];
      }
#pragma unroll
    for (int r = 0; r < 2; ++r) {
      float o[16];
      float ss = 0;
#pragma unroll
      for (int hh = 0; hh < 2; ++hh) {
        const unsigned fa[4] = {f[r][hh].x, f[r][hh].y, f[r][hh].z, f[r][hh].w}, ba[4] = {bw[r][hh].x, bw[r][hh].y, bw[r][hh].z, bw[r][hh].w};
#pragma unroll
        for (int i = 0; i < 4; ++i) {
          o[hh * 8 + 2 * i] = lo16(fa[i]) + lo16(ba[i]);
          o[hh * 8 + 2 * i + 1] = hi16(fa[i]) + hi16(ba[i]);
        }
      }
#pragma unroll
      for (int i = 0; i < 16; ++i) ss += o[i] * o[i];
      ss += __shfl_xor(ss, 1); ss += __shfl_xor(ss, 2); ss += __shfl_xor(ss, 4);
      const float rs = rsqrtf(ss * (1.0f / 128.0f) + 1e-6f);
#pragma unroll
      for (int hh = 0; hh < 2; ++hh) {
        const unsigned sa[4] = {sv[r][hh].x, sv[r][hh].y, sv[r][hh].z, sv[r][hh].w};
        unsigned rr[4];
#pragma unroll
        for (int i = 0; i < 4; ++i)
          rr[i] = pack2(o[hh * 8 + 2 * i] * rs * ngv[hh * 8 + 2 * i] * siluf_(lo16(sa[i])), o[hh * 8 + 2 * i + 1] * rs * ngv[hh * 8 + 2 * i + 1] * siluf_(hi16(sa[i])));
        *(uint4*)&a[(size_t)(row0 + r) * 1024 + lane * 16 + hh * 8] = make_uint4(rr[0], rr[1], rr[2], rr[3]);
      }
    }
  }
}

__device__ __forceinline__ void seq_pos(int tok, int& n, int& L) {
  if (tok < NPROMPT) { n = tok & 255; L = 256; } else { n = (tok - NPROMPT) & 1023; L = 1024; }
}
__device__ __forceinline__ void phase_sc_conv(const Params& p, int bid, int nb) {
  const u16* pb = (const u16*)(p.ws + WS_B(0));
  const u16* sb = (const u16*)(p.ws + WS_B(1));
  u16* a = (u16*)(p.ws + WS_B(2));
  const float* cw = p.in[17]; const float* cbias = p.in[18];
  const size_t total = (size_t)TOK * 128;
  const size_t i0 = (size_t)bid * NT + threadIdx.x;
  const int c = ((int)i0 & 127) * 8;
  float w0[8], w1[8], w2[8], wb[8];
#pragma unroll
  for (int k = 0; k < 2; ++k) {
    const f32x4 t0 = *(const f32x4*)&cw[c + 4 * k], t1 = *(const f32x4*)&cw[1024 + c + 4 * k], t2 = *(const f32x4*)&cw[2048 + c + 4 * k], tb = *(const f32x4*)&cbias[c + 4 * k];
#pragma unroll
    for (int j = 0; j < 4; ++j) { w0[4 * k + j] = t0[j]; w1[4 * k + j] = t1[j]; w2[4 * k + j] = t2[j]; wb[4 * k + j] = tb[j]; }
  }
  const uint4 z = make_uint4(0, 0, 0, 0);
  for (size_t i = i0; i < total / 4; i += (size_t)nb * NT) {
    const int tok = (int)(i >> 7) * 4;
    int n, L; seq_pos(tok, n, L);
    const size_t base = (size_t)tok * 1024 + c;
    uint4 q[6], sv[4];
    q[0] = n > 0 ? *(const uint4*)&pb[base - 1024] : z;
#pragma unroll
    for (int t = 0; t < 4; ++t) { q[1 + t] = *(const uint4*)&pb[base + t * 1024]; sv[t] = *(const uint4*)&sb[base + t * 1024]; }
    q[5] = n + 4 < L ? *(const uint4*)&pb[base + 4096] : z;
#pragma unroll
    for (int t = 0; t < 4; ++t) {
      const unsigned am[4] = {q[t].x, q[t].y, q[t].z, q[t].w}, a0[4] = {q[t + 1].x, q[t + 1].y, q[t + 1].z, q[t + 1].w};
      const unsigned ap[4] = {q[t + 2].x, q[t + 2].y, q[t + 2].z, q[t + 2].w}, as[4] = {sv[t].x, sv[t].y, sv[t].z, sv[t].w};
      unsigned r[4];
#pragma unroll
      for (int k = 0; k < 4; ++k) {
        float z0 = w0[2 * k] * lo16(am[k]) + w1[2 * k] * lo16(a0[k]) + w2[2 * k] * lo16(ap[k]) + wb[2 * k];
        float z1 = w0[2 * k + 1] * hi16(am[k]) + w1[2 * k + 1] * hi16(a0[k]) + w2[2 * k + 1] * hi16(ap[k]) + wb[2 * k + 1];
        r[k] = pack2(lo16(as[k]) * z0, hi16(as[k]) * z1);
      }
      *(uint4*)&a[base + t * 1024] = make_uint4(r[0], r[1], r[2], r[3]);
    }
  }
}
__device__ __forceinline__ void phase_rg_conv(const Params& p, int bid, int nb) {
  const u16* ub = (const u16*)(p.ws + WS_B(0));
  u16* uc = (u16*)(p.ws + WS_B(2));
  const float* cw = p.in[21]; const float* cbias = p.in[22];
  const size_t total = (size_t)TOK * 128;
  const size_t i0 = (size_t)bid * NT + threadIdx.x;
  const int c = ((int)i0 & 127) * 8;
  float w0[8], w1[8], w2[8], w3[8], wb[8];
#pragma unroll
  for (int k = 0; k < 2; ++k) {
    const f32x4 t0 = *(const f32x4*)&cw[c + 4 * k], t1 = *(const f32x4*)&cw[1024 + c + 4 * k], t2 = *(const f32x4*)&cw[2048 + c + 4 * k], t3 = *(const f32x4*)&cw[3072 + c + 4 * k], tb = *(const f32x4*)&cbias[c + 4 * k];
#pragma unroll
    for (int j = 0; j < 4; ++j) { w0[4 * k + j] = t0[j]; w1[4 * k + j] = t1[j]; w2[4 * k + j] = t2[j]; w3[4 * k + j] = t3[j]; wb[4 * k + j] = tb[j]; }
  }
  const uint4 z = make_uint4(0, 0, 0, 0);
  for (size_t i = i0; i < total / 4; i += (size_t)nb * NT) {
    const int tok = (int)(i >> 7) * 4;
    int n, L; seq_pos(tok, n, L);
    const size_t base = (size_t)tok * 1024 + c;
    uint4 q[7];
    q[0] = n > 1 ? *(const uint4*)&ub[base - 2048] : z;
    q[1] = n > 0 ? *(const uint4*)&ub[base - 1024] : z;
#pragma unroll
    for (int t = 0; t < 4; ++t) q[2 + t] = *(const uint4*)&ub[base + t * 1024];
    q[6] = n + 4 < L ? *(const uint4*)&ub[base + 4096] : z;
#pragma unroll
    for (int t = 0; t < 4; ++t) {
      const unsigned a0[4] = {q[t].x, q[t].y, q[t].z, q[t].w}, a1[4] = {q[t + 1].x, q[t + 1].y, q[t + 1].z, q[t + 1].w};
      const unsigned a2[4] = {q[t + 2].x, q[t + 2].y, q[t + 2].z, q[t + 2].w}, a3[4] = {q[t + 3].x, q[t + 3].y, q[t + 3].z, q[t + 3].w};
      unsigned r[4];
#pragma unroll
      for (int k = 0; k < 4; ++k) {
        float z0 = w0[2 * k] * lo16(a0[k]) + w1[2 * k] * lo16(a1[k]) + w2[2 * k] * lo16(a2[k]) + w3[2 * k] * lo16(a3[k]) + wb[2 * k];
        float z1 = w0[2 * k + 1] * hi16(a0[k]) + w1[2 * k + 1] * hi16(a1[k]) + w2[2 * k + 1] * hi16(a2[k]) + w3[2 * k + 1] * hi16(a3[k]) + wb[2 * k + 1];
        r[k] = pack2(z0, z1);
      }
      *(uint4*)&uc[base + t * 1024] = make_uint4(r[0], r[1], r[2], r[3]);
    }
  }
}

__device__ __forceinline__ void phase_rg_scan(const Params& p, unsigned char* smem_raw, int bid, int nb) {
  float* sA = (float*)smem_raw;
  float* sB = sA + 2048;
  const u16* rb = (const u16*)(p.ws + WS_B(3));
  const u16* ib = (const u16*)(p.ws + WS_B(5));
  const u16* uc = (const u16*)(p.ws + WS_B(2));
  const u16* sg = (const u16*)(p.ws + WS_B(1));
  u16* hfw = (u16*)(p.ws + WS_H);
  u16* yp = (u16*)(p.ws + WS_B(0));
  const int tid = threadIdx.x;
  for (int u = bid; u < 768; u += nb) {
    int sample, b, c, seg, nseg, start, cl_;
    if (u < 256) { sample = 1; b = u >> 6; cl_ = tid & 15; c = (u & 63) * 16 + cl_; seg = tid >> 4; nseg = 32; start = NPROMPT + b * 1024; }
    else { sample = 0; b = (u - 256) >> 4; cl_ = tid & 63; c = ((u - 256) & 15) * 64 + cl_; seg = tid >> 6; nseg = 8; start = b * 256; }
    const int L = nseg * 32;
#pragma unroll 1
    for (int d = 0; d < 2; ++d) {
      const float lam = p.in[25][d * 1024 + c];
      const float cl = 8.0f * log1pf(__expf(-lam));
      const u16* rp = rb + (size_t)d * TOK * 1024;
      const u16* ip = ib + (size_t)d * TOK * 1024;
      const size_t o0 = (size_t)(start + (d ? L - 1 - seg * 32 : seg * 32)) * 1024 + c;
      const long ostep = d ? -1024 : 1024;
      float av[32], xv[32];
      float Aacc = 1.f, Bacc = 0.f;
#pragma unroll
      for (int s = 0; s < 32; ++s) {
        const size_t o = o0 + s * ostep;
        const float r = bf2f(rp[o]), ig = bf2f(ip[o]), uu = bf2f(uc[o]);
        const float la = -cl * r;
        const float a = __expf(la);
        const float xin = __builtin_amdgcn_sqrtf(fmaxf(1.0f - __expf(2.0f * la), 0.f)) * (ig * uu);
        av[s] = a; xv[s] = xin;
      }
#pragma unroll
      for (int s = 0; s < 32; ++s) { Aacc *= av[s]; Bacc = av[s] * Bacc + xv[s]; }
      sA[seg * 64 + cl_] = Aacc; sB[seg * 64 + cl_] = Bacc;
      __syncthreads();
      float h = sample ? p.in[3][(b * 2 + d) * 1024 + c] : 0.f;
      for (int s2 = 0; s2 < seg; ++s2) h = sA[s2 * 64 + cl_] * h + sB[s2 * 64 + cl_];
      if (d == 0) {
#pragma unroll
        for (int s = 0; s < 32; ++s) { h = av[s] * h + xv[s]; hfw[o0 + s * ostep] = f2bf(h); }
      } else {
        float hf[32], sgv[32];
#pragma unroll
        for (int s = 0; s < 32; ++s) { const size_t o = o0 + s * ostep; hf[s] = bf2f(hfw[o]); sgv[s] = bf2f(sg[o]); }
#pragma unroll
        for (int s = 0; s < 32; ++s) { h = av[s] * h + xv[s]; yp[o0 + s * ostep] = f2bf((hf[s] + h) * sgv[s]); }
      }
      if (!sample && seg == nseg - 1) p.out[OUT_RG + (b * 2 + d) * 1024 + c] = h;
      __syncthreads();
    }
  }
}

__device__ __forceinline__ void phase_mla_norm(const Params& p, int bid, int nb) {
  u16* cq = (u16*)(p.ws + WS3_CQ);
  u16* ckvall = (u16*)(p.ws + WS3_CKVALL);
  const float* ckvraw = (const float*)(p.ws + WS3_CKVRAW);
  const float* kperaw = (const float*)(p.ws + WS3_KPERAW);
  u16* Kb = (u16*)(p.ws + WS3_K);
  const float* qn = p.in[28]; const float* kvn = p.in[29];
  const int lane = threadIdx.x & 63, wave = threadIdx.x >> 6;
  float qnv[6];
#pragma unroll
  for (int i = 0; i < 3; ++i) { qnv[2 * i] = qn[(i * 64 + lane) * 2]; qnv[2 * i + 1] = qn[(i * 64 + lane) * 2 + 1]; }
  const f32x4 g4 = *(const f32x4*)&kvn[lane * 4];
  for (int row = bid * NW + wave; row < TOK + 2048; row += nb * NW) {
    if (row < TOK) {
      const int tok = row;
      const bool sample = tok >= NPROMPT;
      const int bs = (tok - NPROMPT) >> 10, n = (tok - NPROMPT) & 1023;
      const size_t kvrow = sample ? (size_t)(NPROMPT + bs * 1536 + 512 + n) : (size_t)tok;
      unsigned* cqr = (unsigned*)&cq[(size_t)tok * 384];
      unsigned cv[3]; float ss = 0;
#pragma unroll
      for (int i = 0; i < 3; ++i) { cv[i] = cqr[i * 64 + lane]; float a = lo16(cv[i]), b2 = hi16(cv[i]); ss += a * a + b2 * b2; }
      const float rsq = rsqrtf(wave_sum(ss) * (1.0f / 384.0f) + 1e-6f);
#pragma unroll
      for (int i = 0; i < 3; ++i) {
        cqr[i * 64 + lane] = pack2(lo16(cv[i]) * rsq * qnv[2 * i], hi16(cv[i]) * rsq * qnv[2 * i + 1]);
      }
      f32x4 kv = *(const f32x4*)&ckvraw[(size_t)tok * 256 + lane * 4];
      const float rsk = rsqrtf(wave_sum(kv[0] * kv[0] + kv[1] * kv[1] + kv[2] * kv[2] + kv[3] * kv[3]) * (1.0f / 256.0f) + 1e-6f);
      f32x4 o4;
#pragma unroll
      for (int j = 0; j < 4; ++j) o4[j] = kv[j] * rsk * g4[j];
      *(uint2*)&ckvall[kvrow * 256 + lane * 4] = pack4(o4[0], o4[1], o4[2], o4[3]);
      if (!sample) *(f32x4*)&p.out[OUT_CKV + (size_t)tok * 256 + lane * 4] = o4;
      float v = kperaw[(size_t)tok * 32 + (lane & 31)];
      if (!sample) { if (lane < 32) p.out[OUT_KPE + (size_t)tok * 32 + lane] = v; }
      else {
        const float partner = __shfl_xor(v, 8);
        const int i16 = lane & 15;
        const float pos = (lane & 16) ? (float)(n & 63) : (float)(n >> 6);
        float sn, cs; rope_sincos(pos, i16 & 7, sn, cs);
        v = (i16 < 8) ? (v * cs - partner * sn) : (partner * sn + v * cs);
      }
      const u16 vb = f2bf(v);
#pragma unroll
      for (int i = 0; i < 8; ++i) Kb[(kvrow * 16 + (lane >> 5) + 2 * i) * 96 + 64 + (lane & 31)] = vb;
    } else {
      const int r = row - TOK, bs = r >> 9, j = r & 511;
      const size_t kvrow = (size_t)(NPROMPT + bs * 1536 + j);
      f32x4 kv = *(const f32x4*)&p.in[4][(size_t)r * 256 + lane * 4];
      *(uint2*)&ckvall[kvrow * 256 + lane * 4] = pack4(kv[0], kv[1], kv[2], kv[3]);
      const u16 vb = f2bf(p.in[5][(size_t)r * 32 + (lane & 31)]);
#pragma unroll
      for (int i = 0; i < 8; ++i) Kb[(kvrow * 16 + (lane >> 5) + 2 * i) * 96 + 64 + (lane & 31)] = vb;
    }
  }
}

__device__ __forceinline__ void phase_attn(const Params& p, unsigned char* smem_raw, int bid, int nb) {
  u16* sK = (u16*)smem_raw;
  u16* sV = sK + 128 * 104;
  const u16* qg = (const u16*)(p.ws + WS3_Q);
  const u16* Kg = (const u16*)(p.ws + WS3_K);
  const u16* Vg = (const u16*)(p.ws + WS3_VT);
  const u16* sg = (const u16*)(p.ws + WS3_SG);
  u16* ao = (u16*)(p.ws + WS_H);
  const int tid = threadIdx.x, lane = tid & 63, w = tid >> 6, fr = lane & 15, fq = lane >> 4;
  for (int u = bid; u < 1536; u += nb) {
    int tok0, kvbase, nkeys, h;
    if (u < 512) { const int b = u >> 7, r = u & 127; h = r >> 3; const int qb = r & 7; tok0 = NPROMPT + b * 1024 + qb * 128; kvbase = NPROMPT + b * 1536; nkeys = 1536; }
    else { const int uu = u - 512; const int b = uu >> 5, r = uu & 31; h = r >> 1; const int qb = r & 1; tok0 = b * 256 + qb * 128; kvbase = b * 256; nkeys = 256; }
    const int tokq = tok0 + w * 16 + fr;
    bf16x8 qf[3];
#pragma unroll
    for (int ks = 0; ks < 3; ++ks) qf[ks] = *(const bf16x8*)&qg[(size_t)tokq * 1536 + h * 96 + ks * 32 + fq * 8];
    if (u < 512) {
      const int npos = (tokq - NPROMPT) & 1023;
      const float pos = (fq & 2) ? (float)(npos & 63) : (float)(npos >> 6);
      uint4 raw = *(uint4*)&qf[2];
      unsigned rw[4] = {raw.x, raw.y, raw.z, raw.w};
#pragma unroll
      for (int i = 0; i < 4; ++i) {
        float v0 = lo16(rw[i]), v1 = hi16(rw[i]);
        const float p0 = __shfl_xor(v0, 16), p1 = __shfl_xor(v1, 16);
        float sn0, cs0, sn1, cs1;
        rope_sincos(pos, 2 * i, sn0, cs0); rope_sincos(pos, 2 * i + 1, sn1, cs1);
        v0 = (fq & 1) ? (p0 * sn0 + v0 * cs0) : (v0 * cs0 - p0 * sn0);
        v1 = (fq & 1) ? (p1 * sn1 + v1 * cs1) : (v1 * cs1 - p1 * sn1);
        rw[i] = pack2(v0, v1);
      }
      raw = make_uint4(rw[0], rw[1], rw[2], rw[3]);
      qf[2] = *(bf16x8*)&raw;
    }
    float m = -1e30f, l = 0.f;
    f32x4 oacc[4];
#pragma unroll
    for (int i = 0; i < 4; ++i) oacc[i] = f32x4{0.f, 0.f, 0.f, 0.f};
    const int kk0 = tid / 12, kc0 = tid - kk0 * 12;
    const int kk1 = (tid + NT) / 12, kc1 = (tid + NT) - kk1 * 12;
    const int kk2_ = (tid + 2 * NT) / 12, kc2 = (tid + 2 * NT) - kk2_ * 12;
    const u16* Kp0 = &Kg[((size_t)(kvbase + kk0) * 16 + h) * 96 + kc0 * 8];
    const u16* Kp1 = &Kg[((size_t)(kvbase + kk1) * 16 + h) * 96 + kc1 * 8];
    const u16* Kp2 = &Kg[((size_t)(kvbase + kk2_) * 16 + h) * 96 + kc2 * 8];
    const int vd0 = tid >> 4, vc0 = tid & 15, vd1 = (tid + NT) >> 4;
    const u16* Vp0 = &Vg[(size_t)(h * 64 + vd0) * KVROWS + kvbase + vc0 * 8];
    const u16* Vp1 = &Vg[(size_t)(h * 64 + vd1) * KVROWS + kvbase + vc0 * 8];
    uint4 kr0 = *(const uint4*)Kp0, kr1 = *(const uint4*)Kp1, kr2 = *(const uint4*)Kp2, vr0 = *(const uint4*)Vp0, vr1 = *(const uint4*)Vp1;
    const int ntile2 = nkeys >> 7;
    for (int kt = 0; kt < ntile2; ++kt) {
      __syncthreads();
      *(uint4*)&sK[kk0 * 104 + kc0 * 8] = kr0; *(uint4*)&sK[kk1 * 104 + kc1 * 8] = kr1; *(uint4*)&sK[kk2_ * 104 + kc2 * 8] = kr2;
      *(uint4*)&sV[vd0 * 136 + vc0 * 8] = vr0; *(uint4*)&sV[vd1 * 136 + vc0 * 8] = vr1;
      if (kt + 1 < ntile2) {
        const size_t ko = (size_t)(kt + 1) * 128 * 1536; const int vo = (kt + 1) * 128;
        kr0 = *(const uint4*)(Kp0 + ko); kr1 = *(const uint4*)(Kp1 + ko); kr2 = *(const uint4*)(Kp2 + ko);
        vr0 = *(const uint4*)(Vp0 + vo); vr1 = *(const uint4*)(Vp1 + vo);
      }
      __syncthreads();
      f32x4 sacc[8];
#pragma unroll
      for (int ni = 0; ni < 8; ++ni) {
        sacc[ni] = f32x4{0.f, 0.f, 0.f, 0.f};
#pragma unroll
        for (int ks = 0; ks < 3; ++ks) {
          bf16x8 kf = *(const bf16x8*)&sK[(ni * 16 + fr) * 104 + ks * 32 + fq * 8];
          sacc[ni] = __builtin_amdgcn_mfma_f32_16x16x32_bf16(kf, qf[ks], sacc[ni], 0, 0, 0);
        }
      }
      float mx = -1e30f;
#pragma unroll
      for (int ni = 0; ni < 8; ++ni)
#pragma unroll
        for (int j = 0; j < 4; ++j) mx = fmaxf(mx, sacc[ni][j]);
      mx = fmaxf(mx, __shfl_xor(mx, 16));
      mx = fmaxf(mx, __shfl_xor(mx, 32));
      const float mnew = fmaxf(m, mx);
      const float alpha = __builtin_amdgcn_exp2f(m - mnew);
      m = mnew;
      float ls = 0.f;
#pragma unroll
      for (int ni = 0; ni < 8; ++ni)
#pragma unroll
        for (int j = 0; j < 4; ++j) { float e = __builtin_amdgcn_exp2f(sacc[ni][j] - mnew); sacc[ni][j] = e; ls += e; }
      l = l * alpha + ls;
      bf16x8 pf[4];
#pragma unroll
      for (int kk2 = 0; kk2 < 4; ++kk2) {
        uint2 lo = pack4(sacc[2 * kk2][0], sacc[2 * kk2][1], sacc[2 * kk2][2], sacc[2 * kk2][3]);
        uint2 hi = pack4(sacc[2 * kk2 + 1][0], sacc[2 * kk2 + 1][1], sacc[2 * kk2 + 1][2], sacc[2 * kk2 + 1][3]);
        uint4 pk = make_uint4(lo.x, lo.y, hi.x, hi.y);
        pf[kk2] = *(bf16x8*)&pk;
      }
#pragma unroll
      for (int di = 0; di < 4; ++di) {
#pragma unroll
        for (int j = 0; j < 4; ++j) oacc[di][j] *= alpha;
#pragma unroll
        for (int kk2 = 0; kk2 < 4; ++kk2) {
          uint2 v0 = *(const uint2*)&sV[(di * 16 + fr) * 136 + kk2 * 32 + fq * 4];
          uint2 v1 = *(const uint2*)&sV[(di * 16 + fr) * 136 + kk2 * 32 + 16 + fq * 4];
          uint4 vk = make_uint4(v0.x, v0.y, v1.x, v1.y);
          oacc[di] = __builtin_amdgcn_mfma_f32_16x16x32_bf16(*(bf16x8*)&vk, pf[kk2], oacc[di], 0, 0, 0);
        }
      }
    }
    l += __shfl_xor(l, 16);
    l += __shfl_xor(l, 32);
    const float inv = 1.0f / l;
#pragma unroll
    for (int di = 0; di < 4; ++di) {
      const size_t o = (size_t)tokq * 1024 + h * 64 + di * 16 + fq * 4;
      uint2 s = *(const uint2*)&sg[o];
      *(uint2*)&ao[o] = pack4(oacc[di][0] * inv * siluf_(lo16(s.x)), oacc[di][1] * inv * siluf_(hi16(s.x)), oacc[di][2] * inv * siluf_(lo16(s.y)), oacc[di][3] * inv * siluf_(hi16(s.y)));
    }
  }
}

#define XB_TMO      128
#define XB_XCNT(j)  (256  + 64 * (j))
#define XB_XSUB(j)  (1280 + 64 * (j))
#define XB_XGEN(j)  (2304 + 64 * (j))
#define XB_TOP      3328
#define XB_TOPGEN   3392
#define XCD_BAR_WORDS 3456
#define XB_SPIN_CAP (1u << 22)
__device__ __forceinline__ unsigned xb_ld(unsigned* p)              { return __hip_atomic_load(p, __ATOMIC_RELAXED, __HIP_MEMORY_SCOPE_AGENT); }
__device__ __forceinline__ unsigned xb_add(unsigned* p, unsigned v) { return __hip_atomic_fetch_add(p, v, __ATOMIC_RELAXED, __HIP_MEMORY_SCOPE_AGENT); }
__device__ __forceinline__ unsigned xb_xcc_id() { return (unsigned)__builtin_amdgcn_s_getreg((3 << 11) | 20) & 0xFu; }
#define XB_SPIN(cond, bar) do { unsigned _sp = 0; while (cond) { __builtin_amdgcn_s_sleep(1); \
    if ((++_sp & 255u) == 0u) { if (xb_ld(&(bar)[XB_TMO])) break; if (_sp > XB_SPIN_CAP) { atomicAdd(&(bar)[XB_TMO], 1u); break; } } } } while (0)
struct XcdBarrier { unsigned* bar; unsigned x; volatile LAS unsigned* st; };
__device__ __forceinline__ XcdBarrier xcd_barrier_post(unsigned* bar, volatile LAS unsigned* st) {
  XcdBarrier b; b.bar = bar; b.x = xb_xcc_id(); b.st = st;
  if (threadIdx.x == 0) (void)xb_add(&bar[XB_XCNT(b.x)], 1u);
  return b;
}
__device__ __forceinline__ void xcd_barrier_complete(unsigned* bar, unsigned x, unsigned& nloc, unsigned& nx) {
  const unsigned G = gridDim.x * gridDim.y * gridDim.z;
  unsigned sum, cnt, mine, sp = 0u;
  for (;;) {
    sum = 0u; cnt = 0u; mine = 0u;
#pragma unroll
    for (unsigned j = 0; j < 16; ++j) { const unsigned c = xb_ld(&bar[XB_XCNT(j)]); sum += c; cnt += (c > 0u) ? 1u : 0u; mine = (j == x) ? c : mine; }
    if (sum == G) break;
    __builtin_amdgcn_s_sleep(1);
    if ((++sp & 255u) == 0u) { if (xb_ld(&bar[XB_TMO])) break; if (sp > XB_SPIN_CAP) { atomicAdd(&bar[XB_TMO], 1u); break; } }
  }
  nloc = mine > 0u ? mine : 1u; nx = cnt > 0u ? cnt : 1u;
}
__device__ __forceinline__ void xcd_barrier(const XcdBarrier& b) {
  asm volatile("s_waitcnt vmcnt(0)" ::: "memory");
  __syncthreads();
  if (threadIdx.x == 0) {
    unsigned* bar = b.bar;
    __builtin_amdgcn_s_waitcnt(0);
    unsigned nloc = b.st[0], nx = b.st[1];
    if (nloc == 0u) { xcd_barrier_complete(bar, b.x, nloc, nx); b.st[0] = nloc; b.st[1] = nx; }
    const unsigned old = xb_add(&bar[XB_XSUB(b.x)], 1u);
    const unsigned gen = old / nloc;
    if (old + 1u == (gen + 1u) * nloc) {
      __builtin_amdgcn_fence(__ATOMIC_RELEASE, "agent");
      asm volatile("s_waitcnt vmcnt(0)" ::: "memory");
      const unsigned og = xb_add(&bar[XB_TOP], 1u);
      const unsigned tg = og / nx;
      if (og + 1u == (tg + 1u) * nx) xb_add(&bar[XB_TOPGEN], 1u);
      else XB_SPIN(xb_ld(&bar[XB_TOPGEN]) == tg, bar);
      __builtin_amdgcn_fence(__ATOMIC_ACQUIRE, "agent");
      xb_add(&bar[XB_XGEN(b.x)], 1u);
      asm volatile("s_waitcnt vmcnt(0)" ::: "memory");
    } else {
      XB_SPIN(xb_ld(&bar[XB_XGEN(b.x)]) == gen, bar);
      __builtin_amdgcn_fence(__ATOMIC_ACQUIRE, "agent");
      asm volatile("s_waitcnt vmcnt(0)" ::: "memory");
    }
  }
  __syncthreads();
}

#define GEMM_LDS 131072
#define DYN_LDS (GEMM_LDS + 16)
#define WS_BAR (WS_CNT + 4096ull)

#define RUN_GEMM(Aptr, LDA, Bptr, MM, NN, KK, GATE, EPI, CID) RUN_GEMM_G(Aptr, LDA, Bptr, MM, NN, KK, GATE, EPI, nb, CID)
#define RUN_GEMM_G(Aptr, LDA, Bptr, MM, NN, KK, GATE, EPI, GG, CID) do { pg8::Gemm g_{(const u16*)(Aptr), (const u16*)(Bptr), MM, NN, KK, LDA, GATE, p.flags}; \
    pg8::StaticOrder S_; S_.init(MM, NN, GG, CID); pg8::gemm_phase((LAS unsigned char*)smem_raw, g_, S_, EPI); } while (0)

__global__ void __launch_bounds__(NT, 2) mega(Params p) {
  extern __shared__ __attribute__((aligned(16))) unsigned char smem_raw[];
  const int bid = blockIdx.x, nb = gridDim.x;
  unsigned char* ws = p.ws;
  const float* mod = (const float*)(ws + WS_MOD);
  volatile LAS unsigned* xst = (volatile LAS unsigned*)((LAS unsigned char*)smem_raw + GEMM_LDS);
  XcdBarrier xb;
  if (p.phase_hi - p.phase_lo > 1) {
    if (threadIdx.x == 0) { xst[0] = 0u; xst[1] = 0u; }
    __syncthreads();
    xb = xcd_barrier_post((unsigned*)(ws + WS_BAR), xst);
  }
#define PH_BEGIN(n) if ((PHMASK & (1u << n)) && p.phase_lo <= n && n < p.phase_hi) { const int ph = n;
#define PH_FIN if (ph + 1 < p.phase_hi) { if (p.phase_lo < 0) cg::this_grid().sync(); else xcd_barrier(xb); } }
  PH_BEGIN(0) phase_prologue(p, smem_raw, bid, nb); PH_FIN
  PH_BEGIN(1) phase_h0(p, bid, nb); PH_FIN
  PH_BEGIN(2) {
    EpiHgIn e{(u16*)(ws + WS_B(0)), (u16*)(ws + WS_B(1)), (u16*)(ws + WS_B(2)), (_Float16*)(ws + WS_B(3)), (const float*)(ws + WS_LB)};
    RUN_GEMM(ws + WS_H, 1024, ws + WS_W_HG_IN, TOK, 5120, 1024, 0, e, bid);
  } PH_FIN
  PH_BEGIN(3) phase_gla(p, smem_raw); PH_FIN
  PH_BEGIN(4) phase_hg_post(p, bid, nb); PH_FIN
  PH_BEGIN(5) {
    EpiResLn<false, true> e{p.in[0], p.in[1], (const u16*)nullptr, p.out, (u16*)(ws + WS_XB), mod + 0 * 15360 + 2048, p.in[10] + 0 * 1024, p.in[11] + 0 * 1024, mod + 1 * 15360, (u16*)(ws + WS_H),
               (unsigned long long*)(ws + WS_SLOT) + 0 * 49152, (unsigned*)(ws + WS_CNT + 256) + 0 * 48};
    RUN_GEMM(ws + WS_B(0), 1024, ws + WS_W_HG_OUT, TOK, 1024, 1024, 0, e, bid);
    wconv_idle(p, smem_raw, bid, nb, 1536, 2816);
  } PH_FIN
  PH_BEGIN(7) {
    EpiScIn e{(u16*)(ws + WS_B(0)), (u16*)(ws + WS_B(1))};
    RUN_GEMM(ws + WS_H, 1024, ws + WS_W_SC_IN, TOK, 4096, 1024, 0, e, bid);
  } PH_FIN
  PH_BEGIN(8) phase_sc_conv(p, bid, nb); PH_FIN
  PH_BEGIN(9) {
    EpiResLn<true, true> e{p.out, p.out, (const u16*)(ws + WS_XB), p.out, (u16*)(ws + WS_XB), mod + 1 * 15360 + 2048, p.in[10] + 1 * 1024, p.in[11] + 1 * 1024, mod + 2 * 15360, (u16*)(ws + WS_H),
               (unsigned long long*)(ws + WS_SLOT) + 1 * 49152, (unsigned*)(ws + WS_CNT + 256) + 1 * 48};
    RUN_GEMM(ws + WS_B(2), 1024, ws + WS_W_SC_OUT, TOK, 1024, 1024, 0, e, bid);
    wconv_idle(p, smem_raw, bid, nb, 2816, 3840);
  } PH_FIN
  PH_BEGIN(11) {
    EpiRgIn e{(u16*)(ws + WS_B(0)), (u16*)(ws + WS_B(1))};
    RUN_GEMM(ws + WS_H, 1024, ws + WS_W_RG_IN, TOK, 2048, 1024, 0, e, bid);
  } PH_FIN
  PH_BEGIN(12) phase_rg_conv(p, bid, nb); PH_FIN
  PH_BEGIN(13) {
    EpiRgGate e{(u16*)(ws + WS_B(3)), (u16*)(ws + WS_B(5)), p.in[24]};
    RUN_GEMM(ws + WS_B(2), 1024, ws + WS_W_RG_GATE, TOK, 4096, 256, 1, e, bid);
  } PH_FIN
  PH_BEGIN(14) phase_rg_scan(p, smem_raw, bid, nb); PH_FIN
  PH_BEGIN(15) {
    EpiResLn<true, true> e{p.out, p.out, (const u16*)(ws + WS_XB), p.out, (u16*)(ws + WS_XB), mod + 2 * 15360 + 2048, p.in[10] + 2 * 1024, p.in[11] + 2 * 1024, mod + 3 * 15360, (u16*)(ws + WS_H),
               (unsigned long long*)(ws + WS_SLOT) + 2 * 49152, (unsigned*)(ws + WS_CNT + 256) + 2 * 48};
    RUN_GEMM(ws + WS_B(0), 1024, ws + WS_W_RG_OUT, TOK, 1024, 1024, 0, e, bid);
    wconv_idle(p, smem_raw, bid, nb, 3840, 4800);
  } PH_FIN
  PH_BEGIN(17) {
    EpiMlaIn e{(u16*)(ws + WS3_CQ), (float*)(ws + WS3_CKVRAW), (float*)(ws + WS3_KPERAW), (u16*)(ws + WS3_SG)};
    RUN_GEMM(ws + WS_H, 1024, ws + WS_W_MLA_IN, TOK, 768, 1024, 0, e, bid);
  } PH_FIN
  PH_BEGIN(18) phase_mla_norm(p, bid, nb); PH_FIN
  PH_BEGIN(19) {
    const bool bal = (nb == 256);
    EpiSg eg{(u16*)(ws + WS3_SG)};
    RUN_GEMM(ws + WS_H, 1024, ws + WS_W_MLA_IN + 672 * 1024 * 2, TOK, 1024, 1024, 0, eg, bid);
    EpiQ eq{(u16*)(ws + WS3_Q)};
    RUN_GEMM(ws + WS3_CQ, 384, ws + WS_W_QB, TOK, 1536, 384, 0, eq, bal ? ((bid + 64) & 255) : bid);
    EpiK ek{(u16*)(ws + WS3_K)};
    RUN_GEMM(ws + WS3_CKVALL, 256, ws + WS_W_KVB, KVROWS, 1024, 256, 0, ek, bal ? ((bid + 32) & 255) : bid);
    EpiV ev{(u16*)(ws + WS3_VT)};
    RUN_GEMM_G(ws + WS_W_KVB + 1024 * 256 * 2, 256, ws + WS3_CKVALL, 1024, KVROWS, 256, 0, ev, bal ? 64 : nb, bal ? (bid >= 192 ? bid - 192 : (1 << 20)) : bid);
  } PH_FIN
  PH_BEGIN(20) phase_attn(p, smem_raw, bid, nb); PH_FIN
  PH_BEGIN(21) {
    EpiResLn<true, false> e{p.out, p.out, (const u16*)(ws + WS_XB), p.out, (u16*)nullptr, mod + 3 * 15360 + 2048, p.in[10] + 3 * 1024, p.in[11] + 3 * 1024, mod + 3 * 15360, (u16*)nullptr,
               (unsigned long long*)(ws + WS_SLOT) + 3 * 49152, (unsigned*)(ws + WS_CNT + 256) + 3 * 48};
    RUN_GEMM(ws + WS_H, 1024, ws + WS_W_MLA_OUT, TOK, 1024, 1024, 0, e, bid);
  } PH_FIN
}

extern "C" void kernel_launch(void* const* d_in, const int* in_sizes, int n_in, void* d_out, int out_size, void* d_ws, size_t ws_size,
                              hipStream_t stream) {
  static int grid_blocks = 0;
  if (!grid_blocks) {
    int dev = 0, cus = 0, per_cu = 0;
    (void)hipGetDevice(&dev);
    (void)hipDeviceGetAttribute(&cus, hipDeviceAttributeMultiprocessorCount, dev);
    (void)hipFuncSetAttribute((const void*)mega, hipFuncAttributeMaxDynamicSharedMemorySize, DYN_LDS);
    (void)hipOccupancyMaxActiveBlocksPerMultiprocessor(&per_cu, (const void*)mega, NT, DYN_LDS);
    if (per_cu < 1) per_cu = 1;
    if (per_cu > 1) per_cu = 1;
    grid_blocks = cus * per_cu;
  }
  Params p{};
  for (int i = 0; i < 33; ++i) p.in[i] = (const float*)d_in[i];
  p.out = (float*)d_out;
  p.ws = (unsigned char*)d_ws;
#if MULTI_LAUNCH
  (void)hipMemsetAsync((unsigned char*)d_ws + WS_CNT, 0, 4096 + XCD_BAR_WORDS * 4, stream);
  for (int ph = 0; ph < NPHASES; ++ph) {
    p.phase_lo = ph; p.phase_hi = ph + 1;
    hipLaunchKernelGGL(mega, dim3(grid_blocks), dim3(NT), DYN_LDS, stream, p);
#ifdef PROBE_MASK
    if ((PROBE_MASK >> ph) & 1) { p.flags = PROBE_FLAGS; for (int r = 0; r < 2; ++r) {
      if (ph == 3) (void)hipMemsetAsync((unsigned char*)d_ws + WS_CNT, 0, 64, stream);
      hipLaunchKernelGGL(mega, dim3(grid_blocks), dim3(NT), DYN_LDS, stream, p);
    } p.flags = 0; }
#endif
  }
#else
  p.phase_lo = 0; p.phase_hi = NPHASES;
  (void)hipMemsetAsync((unsigned char*)d_ws + WS_CNT, 0, 4096 + XCD_BAR_WORDS * 4, stream);
  void* args[] = {&p};
  hipError_t e = hipLaunchCooperativeKernel((const void*)mega, dim3(grid_blocks), dim3(NT), args, DYN_LDS, stream);
  if (e != hipSuccess) fprintf(stderr, "cooperative launch failed: %s (grid %d)\n", hipGetErrorString(e), grid_blocks);
#endif
}
```

```cpp
#include <hip/hip_runtime.h>
#include <hip/hip_cooperative_groups.h>
#include <cstdio>
namespace cg = cooperative_groups;

#ifndef MULTI_LAUNCH
#define MULTI_LAUNCH 0
#endif

typedef unsigned short u16;
using bf16x8 = __attribute__((ext_vector_type(8))) short;
using f32x4 = __attribute__((ext_vector_type(4))) float;
typedef _Float16 h4 __attribute__((ext_vector_type(4)));

#define TOK 12288
#define NPROMPT 8192
#define KVROWS 14336
#define NPHASES 23
#ifndef PHMASK
#define PHMASK 0x7fffff
#endif
#define DN_ALPHA 1.6817928305074290f

#define WS_W_HG_IN 0ull
#define WS_W_HG_OUT (WS_W_HG_IN + 10485760ull)
#define WS_W_SC_IN (WS_W_HG_OUT + 2097152ull)
#define WS_W_SC_OUT (WS_W_SC_IN + 8388608ull)
#define WS_W_RG_IN (WS_W_SC_OUT + 2097152ull)
#define WS_W_RG_GATE (WS_W_RG_IN + 4194304ull)
#define WS_W_RG_OUT (WS_W_RG_GATE + 2097152ull)
#define WS_W_MLA_IN (WS_W_RG_OUT + 2097152ull)
#define WS_W_QB (WS_W_MLA_IN + 3670016ull)
#define WS_W_KVB (WS_W_QB + 1179648ull)
#define WS_W_MLA_OUT (WS_W_KVB + 1048576ull)
#define WS_MOD (WS_W_MLA_OUT + 2097152ull)
#define WS_LB (WS_MOD + 245760ull)
#define WS_CNT (WS_LB + 8192ull)
#define WS_R (WS_CNT + 4096ull + 16384ull)
#define BSZ 25165824ull
#define WS_H (WS_R)
#define WS_B(i) (WS_R + BSZ * (1 + (i)))
#define WS_SLOT (WS_R + 201326592ull)
#define WS_XB (WS_SLOT + 1572864ull)
#define WS3_CQ (WS_R + 25165824ull)
#define WS3_CKVALL (WS_R + 34603008ull)
#define WS3_CKVRAW (WS_R + 41943040ull)
#define WS3_KPERAW (WS_R + 54525952ull)
#define WS3_SG (WS_R + 56098816ull)
#define WS3_Q (WS_R + 81264640ull)
#define WS3_K (WS_R + 119013376ull)
#define WS3_VT (WS_R + 163053568ull)

#define OUT_HG 12582912
#define OUT_RG 20971520
#define OUT_CKV 21037056
#define OUT_KPE 23134208

struct Params {
  const float* in[33];
  float* out;
  unsigned char* ws;
  int phase_lo, phase_hi, flags, pad_;
};

__device__ __forceinline__ u16 f2bf(float f) { __bf16 r = (__bf16)f; return *(u16*)&r; }
__device__ __forceinline__ float bf2f(u16 h) { return __uint_as_float(((unsigned)h) << 16); }
typedef float f2v_ __attribute__((ext_vector_type(2)));
typedef __bf16 b2v_ __attribute__((ext_vector_type(2)));
__device__ __forceinline__ unsigned pack2(float a, float b) { f2v_ f = {a, b}; b2v_ r = __builtin_convertvector(f, b2v_); return *(unsigned*)&r; }
__device__ __forceinline__ uint2 pack4(float a, float b, float c, float d) { return make_uint2(pack2(a, b), pack2(c, d)); }
__device__ __forceinline__ float lo16(unsigned u) { return __uint_as_float(u << 16); }
__device__ __forceinline__ float hi16(unsigned u) { return __uint_as_float(u & 0xffff0000u); }
__device__ __forceinline__ float sigmoidf_(float x) { return __builtin_amdgcn_rcpf(1.0f + __expf(-x)); }
__device__ __forceinline__ float siluf_(float x) { return x * __builtin_amdgcn_rcpf(1.0f + __expf(-x)); }
__device__ __forceinline__ int cond_of(int tok) { return tok < NPROMPT ? 0 : 1 + ((tok - NPROMPT) >> 10); }
__device__ __forceinline__ float wave_sum(float v) {
#pragma unroll
  for (int o = 32; o > 0; o >>= 1) v += __shfl_xor(v, o);
  return v;
}
__device__ __forceinline__ void rope_sincos(float pos, int fi, float& sn, float& cs) {
  float inv = exp2f(-(float)fi * 1.6609640474436813f);
  float ang = pos * inv;
  float k = rintf(ang * 0.15915494309189535f);
  float r = fmaf(-k, 6.2831854820251465f, ang);
  r = fmaf(-k, -1.7484555e-7f, r);
  sn = __sinf(r); cs = __cosf(r);
}

#define NT 512
#define NW 8
#define LAS __attribute__((address_space(3)))

namespace pg8 {
constexpr int BM = 256, BK = 64, HALF = 128, HTB = HALF * BK * 2, STAGE_BYTES = 8 * HTB, NXCD = 8, WGM = 8;
__device__ __forceinline__ int lds_byte(int r, int c) { const int st = (r >> 4) * 2 + (c >> 5), rr = r & 15, cc = c & 31, ob = rr * 64 + cc * 2; return st * 1024 + (ob ^ (((ob >> 9) & 1) << 5)); }
__device__ __forceinline__ void stage_rc(int b, int& R, int& C) { const int st = b / 1024, sb = b % 1024, swz = sb ^ (((sb >> 9) & 1) << 5); R = (st >> 1) * 16 + swz / 64; C = (st & 1) * 32 + (swz % 64) / 2; }
struct Unit { int pm, pn; };
struct Gemm { const u16* A; const u16* Bt; int M, N, K, lda, gate, noepi; };
struct StaticOrder {
  int nM, nN, nwg, G, c;
  __device__ void init(int M, int N, int G_, int c_) { nM = M / BM; nN = N / BM; nwg = nM * nN; G = G_; c = c_; }
  __device__ bool next(int i, Unit& u) const {
    const long L = (long)i * G + c; if (L >= nwg) return false;
    int wgid = (int)L; { const int q = nwg / NXCD, r = nwg % NXCD, xcd = wgid % NXCD, off = wgid / NXCD; wgid = (xcd < r ? xcd * (q + 1) : r * (q + 1) + (xcd - r) * q) + off; }
    const int nig = WGM * nN, gid = wgid / nig, fm = gid * WGM, gsz = (nM - fm) < WGM ? (nM - fm) : WGM;
    u.pm = fm + ((wgid % nig) % gsz); u.pn = (wgid % nig) / gsz; return true;
  }
};
template <class Epi>
__device__ __forceinline__ void gemm_phase(LAS unsigned char* lds, const Gemm g, const StaticOrder& S, const Epi& E) {
  const int tid = threadIdx.x, wid = __builtin_amdgcn_readfirstlane(tid >> 6), lane = tid & 63, wr = wid >> 2, wc = wid & 3, fr = lane & 15, fq = lane >> 4;
  const int K = g.K, nt = K / BK;
  unsigned voffA[2], voffB[2];
#pragma unroll
  for (int i = 0; i < 2; ++i) { int R, C; stage_rc(tid * 16 + i * 8192, R, C); voffA[i] = (unsigned)(R * g.lda + C) * 2u; voffB[i] = (unsigned)(R * K + C) * 2u; }
  const size_t kstep = (size_t)(BK * 2);
  const size_t hstepA = (size_t)HALF * g.lda * 2, hstepB = (size_t)HALF * K * 2;
  const size_t tstepA = 2 * hstepA, tstepB = 2 * hstepB;
  const unsigned ldsw = (unsigned)wid * 1024u;
  const int aoff = lds_byte(wr * 64 + fr, fq * 8), boff = lds_byte(wc * 32 + fr, fq * 8);
#define PG8_AOFF(pn) (g.gate ? (size_t)((((pn) >> 1) & 3) * 512) : (size_t)0)
#define PG8_SA(b, h) (((b) * 2 + (h)) * HTB)
#define PG8_SB(b, h) ((4 + (b) * 2 + (h)) * HTB)
#define PG8_STAGE(bufoff, gbase, voff) do { _Pragma("unroll") for (int _i = 0; _i < 2; ++_i) \
    __builtin_amdgcn_global_load_lds((const unsigned*)((const char*)(gbase) + (voff)[_i]), (LAS unsigned*)(lds + (bufoff) + ldsw + _i * 8192), 16, 0, 0); } while (0)
#define PG8_LDA(dst, b, h) do { _Pragma("unroll") for (int m = 0; m < 4; ++m) _Pragma("unroll") for (int k = 0; k < 2; ++k) dst[m][k] = *(const LAS bf16x8*)(lds + PG8_SA(b, h) + aoff + m * 2048 + k * 1024); } while (0)
#define PG8_LDB(dst, b, h) do { _Pragma("unroll") for (int n = 0; n < 2; ++n) _Pragma("unroll") for (int k = 0; k < 2; ++k) dst[n][k] = *(const LAS bf16x8*)(lds + PG8_SB(b, h) + boff + n * 2048 + k * 1024); } while (0)
#define PG8_MMA(ai, bj, At, Bt) do { __builtin_amdgcn_s_setprio(1); _Pragma("unroll") for (int m = 0; m < 4; ++m) _Pragma("unroll") for (int n = 0; n < 2; ++n) _Pragma("unroll") for (int k = 0; k < 2; ++k) \
    acc[ai][bj][m][n] = __builtin_amdgcn_mfma_f32_16x16x32_bf16(Bt[n][k], At[m][k], acc[ai][bj][m][n], 0, 0, 0); __builtin_amdgcn_s_setprio(0); } while (0)
#define PG8_WAIT_V(n) asm volatile("s_waitcnt vmcnt(" #n ")" ::: "memory")
#define PG8_WAIT_L(n) asm volatile("s_waitcnt lgkmcnt(" #n ")" ::: "memory")
#define PG8_BAR __builtin_amdgcn_s_barrier()
#define PG8_SCHED __builtin_amdgcn_sched_barrier(0)
  Unit cur, nxt; int ui = 0;
  if (!S.next(0, cur)) return;
  f32x4 acc[2][2][4][2];
#pragma unroll
  for (int a = 0; a < 2; ++a)
#pragma unroll
    for (int b = 0; b < 2; ++b)
#pragma unroll
      for (int m = 0; m < 4; ++m)
#pragma unroll
        for (int n = 0; n < 2; ++n) acc[a][b][m][n] = (f32x4){0.f, 0.f, 0.f, 0.f};
  bf16x8 At[4][2], B0[2][2], B1[2][2];
  const char* cA = (const char*)g.A + (size_t)cur.pm * tstepA + PG8_AOFF(cur.pn); const char* cB = (const char*)g.Bt + (size_t)cur.pn * tstepB;
  PG8_STAGE(PG8_SB(0, 0), cB, voffB); PG8_STAGE(PG8_SA(0, 0), cA, voffA); PG8_STAGE(PG8_SB(0, 1), cB + hstepB, voffB); PG8_STAGE(PG8_SA(0, 1), cA + hstepA, voffA);
  if (wr == 1) PG8_BAR;
  PG8_WAIT_V(4); PG8_BAR;
  PG8_STAGE(PG8_SB(1, 0), cB + kstep, voffB); PG8_STAGE(PG8_SA(1, 0), cA + kstep, voffA); PG8_STAGE(PG8_SB(1, 1), cB + hstepB + kstep, voffB);
  PG8_WAIT_V(6); PG8_BAR;
  for (;;) {
    const bool has_next = S.next(ui + 1, nxt);
    const char* nA = has_next ? (const char*)g.A + (size_t)nxt.pm * tstepA + PG8_AOFF(nxt.pn) : cA; const char* nB = has_next ? (const char*)g.Bt + (size_t)nxt.pn * tstepB : cB;
#pragma unroll 1
    for (int t = 0; t < nt; t += 2) {
      const bool last = (t == nt - 2);
      const char* a1 = cA + (size_t)(t + 1) * kstep;
      const char* a2 = last ? nA : cA + (size_t)(t + 2) * kstep; const char* b2 = last ? nB : cB + (size_t)(t + 2) * kstep;
      const char* a3 = a2 + kstep; const char* b3 = b2 + kstep;
      PG8_LDB(B0, 0, 0); PG8_SCHED; PG8_LDA(At, 0, 0); PG8_STAGE(PG8_SA(1, 1), a1 + hstepA, voffA);
      PG8_WAIT_L(8); PG8_BAR; PG8_WAIT_L(0); PG8_MMA(0, 0, At, B0); PG8_BAR; PG8_SCHED;
      PG8_LDB(B1, 0, 1); PG8_STAGE(PG8_SB(0, 0), b2, voffB);
      PG8_BAR; PG8_WAIT_L(0); PG8_MMA(0, 1, At, B1); PG8_BAR;
      PG8_LDA(At, 0, 1); PG8_STAGE(PG8_SA(0, 0), a2, voffA);
      PG8_BAR; PG8_WAIT_L(0); PG8_MMA(1, 0, At, B0); PG8_BAR; PG8_SCHED;
      PG8_STAGE(PG8_SB(0, 1), b2 + hstepB, voffB);
      PG8_WAIT_V(6); PG8_BAR; PG8_MMA(1, 1, At, B1); PG8_BAR;
      PG8_LDB(B0, 1, 0); PG8_SCHED; PG8_LDA(At, 1, 0); PG8_STAGE(PG8_SA(0, 1), a2 + hstepA, voffA);
      PG8_WAIT_L(8); PG8_BAR; PG8_WAIT_L(0); PG8_MMA(0, 0, At, B0); PG8_BAR; PG8_SCHED;
      PG8_LDB(B1, 1, 1); PG8_STAGE(PG8_SB(1, 0), b3, voffB);
      PG8_BAR; PG8_WAIT_L(0); PG8_MMA(0, 1, At, B1); PG8_BAR;
      PG8_LDA(At, 1, 1); PG8_STAGE(PG8_SA(1, 0), a3, voffA);
      PG8_BAR; PG8_WAIT_L(0); PG8_MMA(1, 0, At, B0); PG8_BAR; PG8_SCHED;
      PG8_STAGE(PG8_SB(1, 1), b3 + hstepB, voffB);
      PG8_WAIT_V(6); PG8_BAR; PG8_MMA(1, 1, At, B1); PG8_BAR;
    }
    if constexpr (!Epi::AFTER_DRAIN) { if (!g.noepi) E(acc, cur, wr, wc, fr, fq); }
    if (!has_next) break;
#pragma unroll
    for (int a = 0; a < 2; ++a)
#pragma unroll
      for (int b = 0; b < 2; ++b)
#pragma unroll
        for (int m = 0; m < 4; ++m)
#pragma unroll
          for (int n = 0; n < 2; ++n) acc[a][b][m][n] = (f32x4){0.f, 0.f, 0.f, 0.f};
    cur = nxt; cA = nA; cB = nB; ++ui;
  }
  PG8_WAIT_V(0);
  if (wr == 0) PG8_BAR;
  PG8_BAR;
  if constexpr (Epi::AFTER_DRAIN) { if (!g.noepi) E.fused(acc, cur, wr, wc, fr, fq, lds); }
#undef PG8_AOFF
#undef PG8_SA
#undef PG8_SB
#undef PG8_STAGE
#undef PG8_LDA
#undef PG8_LDB
#undef PG8_MMA
#undef PG8_WAIT_V
#undef PG8_WAIT_L
#undef PG8_BAR
#undef PG8_SCHED
}
}
using pg8::Unit;
typedef const f32x4 (&AccRef)[2][2][4][2];

#define EPI_ROWS(...) _Pragma("unroll") for (int ai = 0; ai < 2; ++ai) _Pragma("unroll") for (int m = 0; m < 4; ++m) { const int row = u.pm * 256 + ai * 128 + wr * 64 + m * 16 + fr; __VA_ARGS__ }
#define EPI_COLS(...) _Pragma("unroll") for (int bj = 0; bj < 2; ++bj) _Pragma("unroll") for (int n = 0; n < 2; ++n) { const int cb = u.pn * 256 + bj * 128 + wc * 32 + n * 16; const f32x4 a = acc[ai][bj][m][n]; __VA_ARGS__ }

struct EpiHgIn {
  static constexpr bool AFTER_DRAIN = false;
  u16 *q, *v, *sg; _Float16* lf; const float* lb;
  __device__ __forceinline__ void operator()(AccRef acc, const Unit& u, int wr, int wc, int fr, int fq) const {
    const int region = u.pn >> 2;
    f32x4 l4[2][2];
    if (region == 1 || region == 2) {
#pragma unroll
      for (int bj = 0; bj < 2; ++bj)
#pragma unroll
        for (int n = 0; n < 2; ++n) l4[bj][n] = *(const f32x4*)&lb[(region - 1) * 1024 + ((u.pn * 256 + bj * 128 + wc * 32 + n * 16) & 1023) + fq * 4];
    }
    EPI_ROWS( EPI_COLS(
      const int c = (cb & 1023) + fq * 4;
      if (region == 0) {
        const float s = 0.08838834764831845f;
        *(uint2*)&q[(size_t)row * 1024 + c] = pack4(siluf_(a[0]) * s, siluf_(a[1]) * s, siluf_(a[2]) * s, siluf_(a[3]) * s);
      } else if (region <= 2) {
        const int d = region - 1;
        h4 o;
        _Pragma("unroll") for (int j = 0; j < 4; ++j) { float f = l4[bj][n][j] + (1.0f - l4[bj][n][j]) * sigmoidf_(a[j]); o[j] = (_Float16)__logf(f); }
        *(h4*)&lf[(size_t)row * 2048 + d * 1024 + c] = o;
      } else if (region == 3) {
        *(uint2*)&v[(size_t)row * 1024 + c] = pack4(a[0], a[1], a[2], a[3]);
      } else {
        *(uint2*)&sg[(size_t)row * 1024 + c] = pack4(a[0], a[1], a[2], a[3]);
      }
    ) )
  }
};

struct EpiRes {
  static constexpr bool AFTER_DRAIN = false;
  const float* xin_p; const float* xin_s; float* Y; const float* gate;
  __device__ __forceinline__ void operator()(AccRef acc, const Unit& u, int wr, int wc, int fr, int fq) const {
    EPI_ROWS(
      const float* xr = row < NPROMPT ? xin_p + (size_t)row * 1024 : xin_s + (size_t)(row - NPROMPT) * 1024;
      const float* g = gate + cond_of(row) * 3072;
      EPI_COLS(
        const int c = cb + fq * 4;
        f32x4 x = *(const f32x4*)&xr[c];
        f32x4 gg = *(const f32x4*)&g[c];
        f32x4 y;
        _Pragma("unroll") for (int j = 0; j < 4; ++j) y[j] = DN_ALPHA * x[j] + gg[j] * a[j];
        *(f32x4*)&Y[(size_t)row * 1024 + c] = y;
      ) )
  }
};

template <bool XIN_BF, bool XOUT_BF>
struct EpiResLn {
  static constexpr bool AFTER_DRAIN = true;
  const float* xin_p; const float* xin_s; const u16* xin_b; float* X; u16* XB; const float* gate; const float* lg; const float* lbias; const float* modn; u16* H;
  unsigned long long* slots; unsigned* cnt;
  __device__ __forceinline__ void fused(f32x4 (&acc)[2][2][4][2], const Unit& u, int wr, int wc, int fr, int fq, LAS unsigned char* lds) const {
    LAS float* part = (LAS float*)lds;
    LAS float* stat = part + 2048;
    const int tid = threadIdx.x;
    const int cnd = cond_of(u.pm * 256);
    f32x4 gv[2][2];
#pragma unroll
    for (int bj = 0; bj < 2; ++bj)
#pragma unroll
      for (int n = 0; n < 2; ++n) gv[bj][n] = *(const f32x4*)&gate[cnd * 3072 + u.pn * 256 + bj * 128 + wc * 32 + n * 16 + fq * 4];
#pragma unroll
    for (int ai = 0; ai < 2; ++ai)
#pragma unroll
      for (int m = 0; m < 4; ++m) {
        const int rl = ai * 128 + wr * 64 + m * 16 + fr;
        const int row = u.pm * 256 + rl;
        const float* xr = row < NPROMPT ? xin_p + (size_t)row * 1024 : xin_s + (size_t)(row - NPROMPT) * 1024;
        float s1 = 0.f, s2 = 0.f;
#pragma unroll
        for (int bj = 0; bj < 2; ++bj)
#pragma unroll
          for (int n = 0; n < 2; ++n) {
            const int c = u.pn * 256 + bj * 128 + wc * 32 + n * 16 + fq * 4;
            f32x4 x;
            if constexpr (XIN_BF) { const uint2 xb2 = *(const uint2*)&xin_b[(size_t)row * 1024 + c]; x = f32x4{lo16(xb2.x), hi16(xb2.x), lo16(xb2.y), hi16(xb2.y)}; }
            else x = *(const f32x4*)&xr[c];
            const f32x4 gg = gv[bj][n];
            f32x4 y;
#pragma unroll
            for (int j = 0; j < 4; ++j) { y[j] = DN_ALPHA * x[j] + gg[j] * acc[ai][bj][m][n][j]; s1 += y[j]; s2 += y[j] * y[j]; }
            acc[ai][bj][m][n] = y;
          }
        s1 += __shfl_xor(s1, 16); s1 += __shfl_xor(s1, 32);
        s2 += __shfl_xor(s2, 16); s2 += __shfl_xor(s2, 32);
        if (fq == 0) { part[(rl * 4 + wc) * 2] = s1; part[(rl * 4 + wc) * 2 + 1] = s2; }
      }
    __syncthreads();
    if (tid < 256) {
      float S1 = 0.f, S2 = 0.f;
#pragma unroll
      for (int w2 = 0; w2 < 4; ++w2) { S1 += part[(tid * 4 + w2) * 2]; S2 += part[(tid * 4 + w2) * 2 + 1]; }
      const unsigned long long v = (unsigned long long)__float_as_uint(S1) | ((unsigned long long)__float_as_uint(S2) << 32);
      __hip_atomic_store(&slots[(size_t)(u.pm * 4 + u.pn) * 256 + tid], v, __ATOMIC_RELAXED, __HIP_MEMORY_SCOPE_AGENT);
    }
    asm volatile("s_waitcnt vmcnt(0)" ::: "memory");
    __syncthreads();
    if (tid == 0) {
      __hip_atomic_fetch_add(&cnt[u.pm], 1u, __ATOMIC_RELAXED, __HIP_MEMORY_SCOPE_AGENT);
      unsigned sp = 0;
      while (__hip_atomic_load(&cnt[u.pm], __ATOMIC_RELAXED, __HIP_MEMORY_SCOPE_AGENT) < 4u) { __builtin_amdgcn_s_sleep(1); if (++sp > (1u << 24)) break; }
    }
    __syncthreads();
    if (tid < 256) {
      float T1 = 0.f, T2 = 0.f;
#pragma unroll
      for (int o = 0; o < 4; ++o) {
        const unsigned long long v = __hip_atomic_load(&slots[(size_t)(u.pm * 4 + o) * 256 + tid], __ATOMIC_RELAXED, __HIP_MEMORY_SCOPE_AGENT);
        T1 += __uint_as_float((unsigned)(v & 0xffffffffull)); T2 += __uint_as_float((unsigned)(v >> 32));
      }
      const float mu = T1 * (1.0f / 1024.0f);
      const float var = fmaxf(T2 * (1.0f / 1024.0f) - mu * mu, 0.f);
      stat[tid * 2] = mu; stat[tid * 2 + 1] = rsqrtf(var + 1e-5f);
    }
    __syncthreads();
#pragma unroll
    for (int bj = 0; bj < 2; ++bj) {
      f32x4 lgv[2], lbv[2], shv[2], scv[2];
#pragma unroll
      for (int n = 0; n < 2; ++n) {
        const int c = u.pn * 256 + bj * 128 + wc * 32 + n * 16 + fq * 4;
        lgv[n] = *(const f32x4*)&lg[c]; lbv[n] = *(const f32x4*)&lbias[c];
        shv[n] = *(const f32x4*)&modn[cnd * 3072 + c]; scv[n] = *(const f32x4*)&modn[cnd * 3072 + 1024 + c];
      }
#pragma unroll
      for (int ai = 0; ai < 2; ++ai)
#pragma unroll
        for (int m = 0; m < 4; ++m) {
          const int rl = ai * 128 + wr * 64 + m * 16 + fr;
          const int row = u.pm * 256 + rl;
          const float mu = stat[rl * 2], rs = stat[rl * 2 + 1];
#pragma unroll
          for (int n = 0; n < 2; ++n) {
            const int c = u.pn * 256 + bj * 128 + wc * 32 + n * 16 + fq * 4;
            const f32x4 y = acc[ai][bj][m][n];
            f32x4 xo;
#pragma unroll
            for (int j = 0; j < 4; ++j) xo[j] = (y[j] - mu) * rs * lgv[n][j] + lbv[n][j];
            if constexpr (XOUT_BF) *(uint2*)&XB[(size_t)row * 1024 + c] = pack4(xo[0], xo[1], xo[2], xo[3]);
            else *(f32x4*)&X[(size_t)row * 1024 + c] = xo;
            if (H) {
              *(uint2*)&H[(size_t)row * 1024 + c] = pack4(xo[0] * (1 + scv[n][0]) + shv[n][0], xo[1] * (1 + scv[n][1]) + shv[n][1], xo[2] * (1 + scv[n][2]) + shv[n][2], xo[3] * (1 + scv[n][3]) + shv[n][3]);
            }
          }
        }
    }
  }
};

struct EpiScIn {
  static constexpr bool AFTER_DRAIN = false;
  u16 *pb, *sb;
  __device__ __forceinline__ void operator()(AccRef acc, const Unit& u, int wr, int wc, int fr, int fq) const {
    const int c = u.pn * 64 + wc * 16 + fq * 4;
    EPI_ROWS(
      const f32x4 bg = acc[ai][0][m][0], cgv = acc[ai][0][m][1], v = acc[ai][1][m][0], g = acc[ai][1][m][1];
      *(uint2*)&pb[(size_t)row * 1024 + c] = pack4(cgv[0] * v[0], cgv[1] * v[1], cgv[2] * v[2], cgv[3] * v[3]);
      *(uint2*)&sb[(size_t)row * 1024 + c] = pack4(siluf_(g[0]) * bg[0], siluf_(g[1]) * bg[1], siluf_(g[2]) * bg[2], siluf_(g[3]) * bg[3]);
    )
  }
};

struct EpiRgIn {
  static constexpr bool AFTER_DRAIN = false;
  u16 *ub, *sg;
  __device__ __forceinline__ void operator()(AccRef acc, const Unit& u, int wr, int wc, int fr, int fq) const {
    const int region = u.pn >> 2;
    EPI_ROWS( EPI_COLS(
      const int c = (cb & 1023) + fq * 4;
      if (region == 0) *(uint2*)&ub[(size_t)row * 1024 + c] = pack4(a[0], a[1], a[2], a[3]);
      else *(uint2*)&sg[((size_t)(c >> 6) * TOK + row) * 64 + (c & 63)] = pack4(siluf_(a[0]), siluf_(a[1]), siluf_(a[2]), siluf_(a[3]));
    ) )
  }
};

struct EpiRgGate {
  static constexpr bool AFTER_DRAIN = false;
  u16 *rb, *ib; const float* bgate;
  __device__ __forceinline__ void operator()(AccRef acc, const Unit& u, int wr, int wc, int fr, int fq) const {
    const int mat = u.pn >> 1, d = mat >> 2, hd = mat & 3;
    f32x4 br[2], bi[2]; int ccs[2];
#pragma unroll
    for (int bj = 0; bj < 2; ++bj) {
      const int off = ((u.pn & 1) * 256 + bj * 128 + wc * 32);
      ccs[bj] = (off >> 5) * 16 + fq * 4;
      br[bj] = *(const f32x4*)&bgate[mat * 512 + ccs[bj]];
      bi[bj] = *(const f32x4*)&bgate[mat * 512 + 256 + ccs[bj]];
    }
    EPI_ROWS(
      _Pragma("unroll") for (int bj = 0; bj < 2; ++bj) {
        const f32x4 r = acc[ai][bj][m][0], ii = acc[ai][bj][m][1];
        const int cch = hd * 256 + ccs[bj];
        const size_t o = (size_t)d * TOK * 1024 + ((size_t)(cch >> 6) * TOK + row) * 64 + (cch & 63);
        *(uint2*)&rb[o] = pack4(sigmoidf_(r[0] + br[bj][0]), sigmoidf_(r[1] + br[bj][1]), sigmoidf_(r[2] + br[bj][2]), sigmoidf_(r[3] + br[bj][3]));
        *(uint2*)&ib[o] = pack4(sigmoidf_(ii[0] + bi[bj][0]), sigmoidf_(ii[1] + bi[bj][1]), sigmoidf_(ii[2] + bi[bj][2]), sigmoidf_(ii[3] + bi[bj][3]));
      } )
  }
};

struct EpiMlaIn {
  static constexpr bool AFTER_DRAIN = false;
  u16* cq; float* ckvraw; float* kperaw; u16* sg;
  __device__ __forceinline__ void operator()(AccRef acc, const Unit& u, int wr, int wc, int fr, int fq) const {
    EPI_ROWS( EPI_COLS(
      const int c = cb + fq * 4;
      if (cb < 384) *(uint2*)&cq[(size_t)row * 384 + c] = pack4(a[0], a[1], a[2], a[3]);
      else if (cb < 640) *(f32x4*)&ckvraw[(size_t)row * 256 + (c - 384)] = a;
      else if (cb < 672) *(f32x4*)&kperaw[(size_t)row * 32 + (c - 640)] = a;
    ) )
  }
};

struct EpiSg {
  static constexpr bool AFTER_DRAIN = false;
  u16* sg;
  __device__ __forceinline__ void operator()(AccRef acc, const Unit& u, int wr, int wc, int fr, int fq) const {
    EPI_ROWS( EPI_COLS(
      *(uint2*)&sg[(size_t)row * 1024 + cb + fq * 4] = pack4(a[0], a[1], a[2], a[3]);
    ) )
  }
};

struct EpiQ {
  static constexpr bool AFTER_DRAIN = false;
  u16* q;
  __device__ __forceinline__ void operator()(AccRef acc, const Unit& u, int wr, int wc, int fr, int fq) const {
    const float sc = 0.14724444500602648f;
    EPI_ROWS( EPI_COLS(
      *(uint2*)&q[(size_t)row * 1536 + cb + fq * 4] = pack4(a[0] * sc, a[1] * sc, a[2] * sc, a[3] * sc);
    ) )
  }
};

struct EpiK {
  static constexpr bool AFTER_DRAIN = false;
  u16* Kb;
  __device__ __forceinline__ void operator()(AccRef acc, const Unit& u, int wr, int wc, int fr, int fq) const {
    EPI_ROWS( EPI_COLS(
      const int h = cb >> 6, dd = (cb & 63) + fq * 4;
      *(uint2*)&Kb[((size_t)row * 16 + h) * 96 + dd] = pack4(a[0], a[1], a[2], a[3]);
    ) )
  }
};
struct EpiV {
  static constexpr bool AFTER_DRAIN = false;
  u16* Vt;
  __device__ __forceinline__ void operator()(AccRef acc, const Unit& u, int wr, int wc, int fr, int fq) const {
    EPI_ROWS( EPI_COLS(
      *(uint2*)&Vt[(size_t)row * KVROWS + cb + fq * 4] = pack4(a[0], a[1], a[2], a[3]);
    ) )
  }
};

__device__ __forceinline__ void wconv_tile(const float* __restrict__ src, int N, int K, u16* __restrict__ dst, int k0, int n0,
                                           int perm, int mat, float* tile) {
  const int tid = threadIdx.x;
  {
    const int r = tid >> 4, c4 = (tid & 15) * 4;
#pragma unroll
    for (int i = 0; i < 2; ++i) {
      const int k = r + i * 32;
      f32x4 v = f32x4{0.f, 0.f, 0.f, 0.f};
      if (n0 + c4 < N) v = *(const f32x4*)&src[(size_t)(k0 + k) * N + n0 + c4];
      tile[k * 65 + c4 + 0] = v[0]; tile[k * 65 + c4 + 1] = v[1]; tile[k * 65 + c4 + 2] = v[2]; tile[k * 65 + c4 + 3] = v[3];
    }
  }
  __syncthreads();
  {
    const int nl = tid >> 3, kq = (tid & 7) * 8;
    const int n = n0 + nl;
    int np = n;
    if (perm == 1) { const int part = n >> 10, c = n & 1023; np = (c >> 6) * 256 + (part >> 1) * 128 + ((c >> 4) & 3) * 32 + (part & 1) * 16 + (c & 15); }
    else if (perm == 2) { const int type = n >> 8, cc = n & 255; np = mat * 512 + (cc >> 4) * 32 + type * 16 + (cc & 15); }
    else if (perm == 3) { const int hh = n >> 7, dd = n & 127; np = (dd >= 64 ? 1024 : 0) + hh * 64 + (dd & 63); }
    if (n < N) {
      unsigned w[4];
#pragma unroll
      for (int i = 0; i < 4; ++i) w[i] = pack2(tile[(kq + 2 * i) * 65 + nl], tile[(kq + 2 * i + 1) * 65 + nl]);
      *(uint4*)&dst[(size_t)np * K + k0 + kq] = make_uint4(w[0], w[1], w[2], w[3]);
    }
  }
  __syncthreads();
}

__device__ __forceinline__ void wconv_item(const Params& p, int t, float* fs) {
  const float* src; u16* dst; int N, K, perm = 0, mat = 0, ntn;
  if (t < 1280) { src = p.in[12]; dst = (u16*)(p.ws + WS_W_HG_IN); N = 5120; K = 1024; }
  else if ((t -= 1280) < 256) { src = p.in[15]; dst = (u16*)(p.ws + WS_W_HG_OUT); N = 1024; K = 1024; }
  else if ((t -= 256) < 1024) { src = p.in[16]; dst = (u16*)(p.ws + WS_W_SC_IN); N = 4096; K = 1024; perm = 1; }
  else if ((t -= 1024) < 256) { src = p.in[19]; dst = (u16*)(p.ws + WS_W_SC_OUT); N = 1024; K = 1024; }
  else if ((t -= 256) < 512) { src = p.in[20]; dst = (u16*)(p.ws + WS_W_RG_IN); N = 2048; K = 1024; }
  else if ((t -= 512) < 256) { mat = t >> 5; t &= 31; src = p.in[23] + (size_t)mat * 256 * 512; dst = (u16*)(p.ws + WS_W_RG_GATE); N = 512; K = 256; perm = 2; }
  else if ((t -= 256) < 256) { src = p.in[26]; dst = (u16*)(p.ws + WS_W_RG_OUT); N = 1024; K = 1024; }
  else if ((t -= 256) < 432) { src = p.in[27]; dst = (u16*)(p.ws + WS_W_MLA_IN); N = 1696; K = 1024; }
  else if ((t -= 432) < 144) { src = p.in[30]; dst = (u16*)(p.ws + WS_W_QB); N = 1536; K = 384; }
  else if ((t -= 144) < 128) { src = p.in[31]; dst = (u16*)(p.ws + WS_W_KVB); N = 2048; K = 256; perm = 3; }
  else { t -= 128; src = p.in[32]; dst = (u16*)(p.ws + WS_W_MLA_OUT); N = 1024; K = 1024; }
  ntn = (N + 63) >> 6;
  const int kt = t / ntn, ntl = t - kt * ntn;
  wconv_tile(src, N, K, dst, kt * 64, ntl * 64, perm, mat, fs);
}
__device__ __forceinline__ void wconv_idle(const Params& p, unsigned char* smem_raw, int bid, int nb, int t0, int t1) {
  if (nb == 256 && bid >= 192) for (int t = t0 + (bid - 192); t < t1; t += 64) wconv_item(p, t, (float*)smem_raw);
}

__device__ __forceinline__ void phase_prologue(const Params& p, unsigned char* smem_raw, int bid, int nb) {
  float* fs = (float*)smem_raw;
  const int tid = threadIdx.x;
  const int NMOD = 192, NWT = (nb == 256) ? 1536 : 4800;
  for (int it = bid; it < NMOD + 1 + NWT; it += nb) {
    if (it < NMOD) {
      const int l = it / 48, n0 = (it % 48) * 64;
      float* scond = fs;
      float* sred = fs + 5120;
      for (int i = tid; i < 5120; i += NT) {
        const int ci = i >> 10, k = i & 1023;
        float cv = ci == 0 ? p.in[7][k] : p.in[6][(ci - 1) * 1024 + k];
        scond[i] = siluf_(cv);
      }
      __syncthreads();
      const int col = tid & 63, kg = tid >> 6;
      const float* w = p.in[8] + (size_t)l * 1024 * 3072 + n0 + col;
      float a0 = 0, a1 = 0, a2 = 0, a3 = 0, a4 = 0;
#pragma unroll 16
      for (int k = kg * 128; k < kg * 128 + 128; ++k) {
        float wv = w[(size_t)k * 3072];
        a0 += scond[k] * wv; a1 += scond[1024 + k] * wv; a2 += scond[2048 + k] * wv; a3 += scond[3072 + k] * wv; a4 += scond[4096 + k] * wv;
      }
      sred[(kg * 5 + 0) * 64 + col] = a0; sred[(kg * 5 + 1) * 64 + col] = a1; sred[(kg * 5 + 2) * 64 + col] = a2;
      sred[(kg * 5 + 3) * 64 + col] = a3; sred[(kg * 5 + 4) * 64 + col] = a4;
      __syncthreads();
      float* mod = (float*)(p.ws + WS_MOD);
      if (tid < 320) {
        const int ci = tid >> 6, cc = tid & 63;
        float s = 0;
#pragma unroll
        for (int g = 0; g < 8; ++g) s += sred[(g * 5 + ci) * 64 + cc];
        mod[(l * 5 + ci) * 3072 + n0 + cc] = s + p.in[9][l * 3072 + n0 + cc];
      }
      __syncthreads();
    } else if (it == NMOD) {
      float* lb = (float*)(p.ws + WS_LB);
      for (int i = tid; i < 2048; i += NT) {
        const int d = i >> 10, c = i & 1023;
        const float* lg = p.in[13] + d * 5 * 1024 + c;
        float m = lg[0];
        for (int j = 1; j < 5; ++j) m = fmaxf(m, lg[j * 1024]);
        float s = 0;
        for (int j = 0; j < 5; ++j) s += expf(lg[j * 1024] - m);
        lb[i] = expf(lg[0] - m) / s;
      }
      int* cnt = (int*)(p.ws + WS_CNT);
      if (tid < 16) cnt[tid] = 0;
    } else {
      wconv_item(p, it - NMOD - 1, fs);
    }
  }
}

__device__ __forceinline__ void phase_h0(const Params& p, int bid, int nb) {
  const float* mod = (const float*)(p.ws + WS_MOD);
  u16* H = (u16*)(p.ws + WS_H);
  const size_t total = (size_t)(TOK / 4) * 256;
  for (size_t i = (size_t)bid * NT + threadIdx.x; i < total; i += (size_t)nb * NT) {
    const int row = (int)(i >> 8) * 4, c = ((int)i & 255) * 4;
    const float* xr = row < NPROMPT ? p.in[0] + (size_t)row * 1024 : p.in[1] + (size_t)(row - NPROMPT) * 1024;
    const float* m = mod + cond_of(row) * 3072;
    f32x4 x[4];
#pragma unroll
    for (int t = 0; t < 4; ++t) x[t] = *(const f32x4*)&xr[t * 1024 + c];
    const f32x4 sh = *(const f32x4*)&m[c];
    const f32x4 sc = *(const f32x4*)&m[1024 + c];
#pragma unroll
    for (int t = 0; t < 4; ++t)
      *(uint2*)&H[(size_t)(row + t) * 1024 + c] = pack4(x[t][0] * (1 + sc[0]) + sh[0], x[t][1] * (1 + sc[1]) + sh[1], x[t][2] * (1 + sc[2]) + sh[2], x[t][3] * (1 + sc[3]) + sh[3]);
  }
}

__device__ __forceinline__ void phase_ln(const Params& p, int l, int bid, int nb) {
  float* X = p.out;
  const float* g = p.in[10] + l * 1024;
  const float* b = p.in[11] + l * 1024;
  const float* mod = (const float*)(p.ws + WS_MOD) + (l + 1) * 5 * 3072;
  u16* H = (u16*)(p.ws + WS_H);
  const int lane = threadIdx.x & 63, wave = threadIdx.x >> 6;
  for (int row = bid * NW + wave; row < TOK; row += nb * NW) {
    float* xr = X + (size_t)row * 1024;
    f32x4 v[4];
    float s = 0;
#pragma unroll
    for (int i = 0; i < 4; ++i) { v[i] = *(const f32x4*)&xr[i * 256 + lane * 4]; s += v[i][0] + v[i][1] + v[i][2] + v[i][3]; }
    const float mu = wave_sum(s) * (1.0f / 1024.0f);
    float q = 0;
#pragma unroll
    for (int i = 0; i < 4; ++i)
#pragma unroll
      for (int j = 0; j < 4; ++j) { float dd = v[i][j] - mu; q += dd * dd; }
    const float rs = rsqrtf(wave_sum(q) * (1.0f / 1024.0f) + 1e-5f);
    const float* m = mod + cond_of(row) * 3072;
#pragma unroll
    for (int i = 0; i < 4; ++i) {
      const int c = i * 256 + lane * 4;
      f32x4 gg = *(const f32x4*)&g[c], bb = *(const f32x4*)&b[c];
      f32x4 y;
#pragma unroll
      for (int j = 0; j < 4; ++j) y[j] = (v[i][j] - mu) * rs * gg[j] + bb[j];
      *(f32x4*)&xr[c] = y;
      if (l < 3) {
        f32x4 sh = *(const f32x4*)&m[c], sc = *(const f32x4*)&m[1024 + c];
        *(uint2*)&H[(size_t)row * 1024 + c] = pack4(y[0] * (1 + sc[0]) + sh[0], y[1] * (1 + sc[1]) + sh[1], y[2] * (1 + sc[2]) + sh[2], y[3] * (1 + sc[3]) + sh[3]);
      }
    }
  }
}

__device__ __forceinline__ void phase_gla(const Params& p, unsigned char* smem_raw) {
  u16* s_qrel = (u16*)smem_raw;
  u16* s_krel = s_qrel + 32 * 136;
  u16* s_qcum = s_krel + 32 * 136;
  u16* s_kdT = s_qcum + 32 * 136;
  u16* s_vT = s_kdT + 128 * 40;
  u16* s_att = s_vT + 64 * 40;
  u16* s_S = s_att + 32 * 40;
  float* s_dec = (float*)(s_S + 64 * 136);
  float* s_part = s_dec + 128;
  int* s_u = (int*)(s_part + 512);
  int* counter = (int*)(p.ws + WS_CNT);
  const u16* qg = (const u16*)(p.ws + WS_B(0));
  const u16* vg = (const u16*)(p.ws + WS_B(1));
  const _Float16* lfg = (const _Float16*)(p.ws + WS_B(3));
  u16* og = (u16*)(p.ws + WS_B(5));
  const int tid = threadIdx.x, lane = tid & 63, w = tid >> 6, fr = lane & 15, fq = lane >> 4;
  const int kk = tid & 127, th = tid >> 7;
  const int ti = w >> 2, vi = w & 3;
  const int wk = w & 3, wv = w >> 2;
  while (true) {
    if (tid == 0) *s_u = atomicAdd(counter, 1);
    __syncthreads();
    const int u = *s_u;
    __syncthreads();
    if (u >= 1152) break;
    int b, rem, start, N, sample;
    if (u < 128) { sample = 1; b = u >> 5; rem = u & 31; start = NPROMPT + b * 1024; N = 1024; }
    else { sample = 0; b = (u - 128) >> 5; rem = (u - 128) & 31; start = b * 256; N = 256; }
    const int h = rem >> 2, d = (rem >> 1) & 1, vs = rem & 1;
    const int nc = N >> 5;
    f32x4 S[2][2];
#pragma unroll
    for (int mi = 0; mi < 2; ++mi)
#pragma unroll
      for (int ni = 0; ni < 2; ++ni) {
        f32x4 s4 = f32x4{0.f, 0.f, 0.f, 0.f};
        if (sample) {
          const float* s0 = p.in[2] + ((size_t)((b * 2 + d) * 8 + h)) * 16384;
#pragma unroll
          for (int j = 0; j < 4; ++j) s4[j] = s0[(wk * 32 + mi * 16 + fq * 4 + j) * 128 + vs * 64 + wv * 32 + ni * 16 + fr];
        }
        S[mi][ni] = s4;
        *(uint2*)&s_S[(wv * 32 + ni * 16 + fr) * 136 + wk * 32 + mi * 16 + fq * 4] = pack4(s4[0], s4[1], s4[2], s4[3]);
      }
    _Float16 lfraw[8]; u16 qraw[8]; uint2 vraw;
#define GLA_LOAD(cc) do { _Pragma("unroll") for (int i = 0; i < 8; ++i) { const int tt = (cc) * 32 + th * 8 + i; const size_t tok = start + (d ? (N - 1 - tt) : tt); \
      lfraw[i] = lfg[tok * 2048 + d * 1024 + h * 128 + kk]; qraw[i] = qg[tok * 1024 + h * 128 + kk]; } \
      { const int tt = (cc) * 32 + (tid >> 4); const size_t tok = start + (d ? (N - 1 - tt) : tt); vraw = *(const uint2*)&vg[tok * 1024 + h * 128 + vs * 64 + (tid & 15) * 4]; } } while (0)
    GLA_LOAD(0);
    for (int c = 0; c < nc; ++c) {
      {
        float lfv[8], qv[8];
#pragma unroll
        for (int i = 0; i < 8; ++i) { lfv[i] = (float)lfraw[i]; qv[i] = bf2f(qraw[i]); }
        const uint2 vv = vraw;
        if (c + 1 < nc) GLA_LOAD(c + 1);
        float run = 0;
        float cs[8];
#pragma unroll
        for (int i = 0; i < 8; ++i) { run += lfv[i]; cs[i] = run; }
        s_part[th * 128 + kk] = run;
        {
          const int s = tid >> 4, v4 = (tid & 15) * 4;
          s_vT[(v4 + 0) * 40 + s] = (u16)(vv.x & 0xffff); s_vT[(v4 + 1) * 40 + s] = (u16)(vv.x >> 16);
          s_vT[(v4 + 2) * 40 + s] = (u16)(vv.y & 0xffff); s_vT[(v4 + 3) * 40 + s] = (u16)(vv.y >> 16);
        }
        __syncthreads();
        const float p0 = s_part[kk], p1 = s_part[128 + kk], p2 = s_part[256 + kk], p3 = s_part[384 + kk];
        const float off = (th > 0 ? p0 : 0.f) + (th > 1 ? p1 : 0.f) + (th > 2 ? p2 : 0.f);
        const float ref = p0 + p1, total = p0 + p1 + p2 + p3;
        unsigned kd[4];
        const float eref = __expf(ref), etr = __expf(total - ref);
#pragma unroll
        for (int i = 0; i < 8; ++i) {
          const int t = th * 8 + i;
          const float cum = off + cs[i];
          const float kf = 1.0f - __expf(lfv[i]);
          const float e1 = __expf(cum - ref), e2 = __builtin_amdgcn_rcpf(e1);
          const float qe = qv[i] * e1, ke = kf * e2;
          s_qrel[t * 136 + kk] = f2bf(qe);
          s_krel[t * 136 + kk] = f2bf(ke);
          s_qcum[t * 136 + kk] = f2bf(qe * eref);
          const u16 kdv = f2bf(ke * etr);
          if (i & 1) kd[i >> 1] |= ((unsigned)kdv) << 16; else kd[i >> 1] = kdv;
        }
        *(uint4*)&s_kdT[kk * 40 + th * 8] = make_uint4(kd[0], kd[1], kd[2], kd[3]);
        if (th == 0) s_dec[kk] = __expf(total);
      }
      __syncthreads();
      f32x4 oacc = f32x4{0.f, 0.f, 0.f, 0.f};
      {
        f32x4 att = f32x4{0.f, 0.f, 0.f, 0.f};
        const int ati = w >> 1, asi = w & 1;
#pragma unroll
        for (int ks = 0; ks < 4; ++ks) {
          if (w < 4) {
            bf16x8 a = *(const bf16x8*)&s_qrel[(ati * 16 + fr) * 136 + ks * 32 + fq * 8];
            bf16x8 bb = *(const bf16x8*)&s_krel[(asi * 16 + fr) * 136 + ks * 32 + fq * 8];
            att = __builtin_amdgcn_mfma_f32_16x16x32_bf16(a, bb, att, 0, 0, 0);
          }
          bf16x8 a2 = *(const bf16x8*)&s_qcum[(ti * 16 + fr) * 136 + ks * 32 + fq * 8];
          bf16x8 b2 = *(const bf16x8*)&s_S[(vi * 16 + fr) * 136 + ks * 32 + fq * 8];
          oacc = __builtin_amdgcn_mfma_f32_16x16x32_bf16(a2, b2, oacc, 0, 0, 0);
        }
        if (w < 4) {
#pragma unroll
          for (int j = 0; j < 4; ++j) {
            const int t = ati * 16 + fq * 4 + j, s = asi * 16 + fr;
            s_att[t * 40 + s] = (s <= t) ? f2bf(att[j]) : (u16)0;
          }
        }
      }
      __syncthreads();
      {
        bf16x8 a = *(const bf16x8*)&s_att[(ti * 16 + fr) * 40 + fq * 8];
        bf16x8 bb = *(const bf16x8*)&s_vT[(vi * 16 + fr) * 40 + fq * 8];
        oacc = __builtin_amdgcn_mfma_f32_16x16x32_bf16(a, bb, oacc, 0, 0, 0);
#pragma unroll
        for (int j = 0; j < 4; ++j) {
          const int tt = c * 32 + ti * 16 + fq * 4 + j;
          const size_t tok = start + (d ? (N - 1 - tt) : tt);
          og[((size_t)d * TOK + tok) * 1024 + h * 128 + vs * 64 + vi * 16 + fr] = f2bf(oacc[j]);
        }
        bf16x8 vf[2];
#pragma unroll
        for (int ni = 0; ni < 2; ++ni) vf[ni] = *(const bf16x8*)&s_vT[(wv * 32 + ni * 16 + fr) * 40 + fq * 8];
#pragma unroll
        for (int mi = 0; mi < 2; ++mi) {
          bf16x8 kf = *(const bf16x8*)&s_kdT[(wk * 32 + mi * 16 + fr) * 40 + fq * 8];
          f32x4 dc = *(const f32x4*)&s_dec[wk * 32 + mi * 16 + fq * 4];
#pragma unroll
          for (int ni = 0; ni < 2; ++ni) {
            f32x4 s4 = S[mi][ni];
#pragma unroll
            for (int j = 0; j < 4; ++j) s4[j] *= dc[j];
            s4 = __builtin_amdgcn_mfma_f32_16x16x32_bf16(kf, vf[ni], s4, 0, 0, 0);
            S[mi][ni] = s4;
            *(uint2*)&s_S[(wv * 32 + ni * 16 + fr) * 136 + wk * 32 + mi * 16 + fq * 4] = pack4(s4[0], s4[1], s4[2], s4[3]);
          }
        }
      }
      __syncthreads();
    }
    if (!sample) {
      float* so = p.out + OUT_HG + ((size_t)((b * 2 + d) * 8 + h)) * 16384;
#pragma unroll
      for (int mi = 0; mi < 2; ++mi)
#pragma unroll
        for (int ni = 0; ni < 2; ++ni)
#pragma unroll
          for (int j = 0; j < 4; ++j) so[(wk * 32 + mi * 16 + fq * 4 + j) * 128 + vs * 64 + wv * 32 + ni * 16 + fr] = S[mi][ni][j];
    }
  }
}

__device__ __forceinline__ void phase_hg_post(const Params& p, int bid, int nb) {
  const u16* og = (const u16*)(p.ws + WS_B(5));
  const u16* sg = (const u16*)(p.ws + WS_B(2));
  u16* a = (u16*)(p.ws + WS_B(0));
  const float* ng = p.in[14];
  const int lane = threadIdx.x & 63, wave = threadIdx.x >> 6;
  float ngv[16];
#pragma unroll
  for (int k = 0; k < 4; ++k) { const f32x4 t = *(const f32x4*)&ng[lane * 16 + 4 * k]; ngv[4 * k] = t[0]; ngv[4 * k + 1] = t[1]; ngv[4 * k + 2] = t[2]; ngv[4 * k + 3] = t[3]; }
  for (int row0 = (bid * NW + wave) * 2; row0 < TOK; row0 += nb * NW * 2) {
    uint4 f[2][2], bw[2][2], sv[2][2];
#pragma unroll
    for (int r = 0; r < 2; ++r)
#pragma unroll
      for (int hh = 0; hh < 2; ++hh) {
        const size_t base = (size_t)(row0 + r) * 1024 + lane * 16 + hh * 8;
        f[r][hh] = *(const uint4*)&og[base];
        bw[r][hh] = *(const uint4*)&og[(size_t)TOK * 1024 + base];
        sv[r][hh] = *(const uint4*)&sg[base];
      }
#pragma unroll
    for (int r = 0; r < 2; ++r) {
      float o[16];
      float ss = 0;
#pragma unroll
      for (int hh = 0; hh < 2; ++hh) {
        const unsigned fa[4] = {f[r][hh].x, f[r][hh].y, f[r][hh].z, f[r][hh].w}, ba[4] = {bw[r][hh].x, bw[r][hh].y, bw[r][hh].z, bw[r][hh].w};
#pragma unroll
        for (int i = 0; i < 4; ++i) {
          o[hh * 8 + 2 * i] = lo16(fa[i]) + lo16(ba[i]);
          o[hh * 8 + 2 * i + 1] = hi16(fa[i]) + hi16(ba[i]);
        }
      }
#pragma unroll
      for (int i = 0; i < 16; ++i) ss += o[i] * o[i];
      ss += __shfl_xor(ss, 1); ss += __shfl_xor(ss, 2); ss += __shfl_xor(ss, 4);
      const float rs = rsqrtf(ss * (1.0f / 128.0f) + 1e-6f);
#pragma unroll
      for (int hh = 0; hh < 2; ++hh) {
        const unsigned sa[4] = {sv[r][hh].x, sv[r][hh].y, sv[r][hh].z, sv[r][hh].w};
        unsigned rr[4];
#pragma unroll
        for (int i = 0; i < 4; ++i)
          rr[i] = pack2(o[hh * 8 + 2 * i] * rs * ngv[hh * 8 + 2 * i] * siluf_(lo16(sa[i])), o[hh * 8 + 2 * i + 1] * rs * ngv[hh * 8 + 2 * i + 1] * siluf_(hi16(sa[i])));
        *(uint4*)&a[(size_t)(row0 + r) * 1024 + lane * 16 + hh * 8] = make_uint4(rr[0], rr[1], rr[2], rr[3]);
      }
    }
  }
}

__device__ __forceinline__ void seq_pos(int tok, int& n, int& L) {
  if (tok < NPROMPT) { n = tok & 255; L = 256; } else { n = (tok - NPROMPT) & 1023; L = 1024; }
}
__device__ __forceinline__ void phase_sc_conv(const Params& p, int bid, int nb) {
  const u16* pb = (const u16*)(p.ws + WS_B(0));
  const u16* sb = (const u16*)(p.ws + WS_B(1));
  u16* a = (u16*)(p.ws + WS_B(2));
  const float* cw = p.in[17]; const float* cbias = p.in[18];
  const size_t total = (size_t)TOK * 128;
  const size_t i0 = (size_t)bid * NT + threadIdx.x;
  const int c = ((int)i0 & 127) * 8;
  float w0[8], w1[8], w2[8], wb[8];
#pragma unroll
  for (int k = 0; k < 2; ++k) {
    const f32x4 t0 = *(const f32x4*)&cw[c + 4 * k], t1 = *(const f32x4*)&cw[1024 + c + 4 * k], t2 = *(const f32x4*)&cw[2048 + c + 4 * k], tb = *(const f32x4*)&cbias[c + 4 * k];
#pragma unroll
    for (int j = 0; j < 4; ++j) { w0[4 * k + j] = t0[j]; w1[4 * k + j] = t1[j]; w2[4 * k + j] = t2[j]; wb[4 * k + j] = tb[j]; }
  }
  const uint4 z = make_uint4(0, 0, 0, 0);
  for (size_t i = i0; i < total / 4; i += (size_t)nb * NT) {
    const int tok = (int)(i >> 7) * 4;
    int n, L; seq_pos(tok, n, L);
    const size_t base = (size_t)tok * 1024 + c;
    uint4 q[6], sv[4];
    q[0] = n > 0 ? *(const uint4*)&pb[base - 1024] : z;
#pragma unroll
    for (int t = 0; t < 4; ++t) { q[1 + t] = *(const uint4*)&pb[base + t * 1024]; sv[t] = *(const uint4*)&sb[base + t * 1024]; }
    q[5] = n + 4 < L ? *(const uint4*)&pb[base + 4096] : z;
#pragma unroll
    for (int t = 0; t < 4; ++t) {
      const unsigned am[4] = {q[t].x, q[t].y, q[t].z, q[t].w}, a0[4] = {q[t + 1].x, q[t + 1].y, q[t + 1].z, q[t + 1].w};
      const unsigned ap[4] = {q[t + 2].x, q[t + 2].y, q[t + 2].z, q[t + 2].w}, as[4] = {sv[t].x, sv[t].y, sv[t].z, sv[t].w};
      unsigned r[4];
#pragma unroll
      for (int k = 0; k < 4; ++k) {
        float z0 = w0[2 * k] * lo16(am[k]) + w1[2 * k] * lo16(a0[k]) + w2[2 * k] * lo16(ap[k]) + wb[2 * k];
        float z1 = w0[2 * k + 1] * hi16(am[k]) + w1[2 * k + 1] * hi16(a0[k]) + w2[2 * k + 1] * hi16(ap[k]) + wb[2 * k + 1];
        r[k] = pack2(lo16(as[k]) * z0, hi16(as[k]) * z1);
      }
      *(uint4*)&a[base + t * 1024] = make_uint4(r[0], r[1], r[2], r[3]);
    }
  }
}
__device__ __forceinline__ void phase_rg_conv(const Params& p, int bid, int nb) {
  const u16* ub = (const u16*)(p.ws + WS_B(0));
  u16* uc = (u16*)(p.ws + WS_B(2));
  const float* cw = p.in[21]; const float* cbias = p.in[22];
  const size_t total = (size_t)TOK * 128;
  const size_t i0 = (size_t)bid * NT + threadIdx.x;
  const int c = ((int)i0 & 127) * 8;
  float w0[8], w1[8], w2[8], w3[8], wb[8];
#pragma unroll
  for (int k = 0; k < 2; ++k) {
    const f32x4 t0 = *(const f32x4*)&cw[c + 4 * k], t1 = *(const f32x4*)&cw[1024 + c + 4 * k], t2 = *(const f32x4*)&cw[2048 + c + 4 * k], t3 = *(const f32x4*)&cw[3072 + c + 4 * k], tb = *(const f32x4*)&cbias[c + 4 * k];
#pragma unroll
    for (int j = 0; j < 4; ++j) { w0[4 * k + j] = t0[j]; w1[4 * k + j] = t1[j]; w2[4 * k + j] = t2[j]; w3[4 * k + j] = t3[j]; wb[4 * k + j] = tb[j]; }
  }
  const uint4 z = make_uint4(0, 0, 0, 0);
  for (size_t i = i0; i < total / 4; i += (size_t)nb * NT) {
    const int tok = (int)(i >> 7) * 4;
    int n, L; seq_pos(tok, n, L);
    const size_t base = (size_t)tok * 1024 + c;
    uint4 q[7];
    q[0] = n > 1 ? *(const uint4*)&ub[base - 2048] : z;
    q[1] = n > 0 ? *(const uint4*)&ub[base - 1024] : z;
#pragma unroll
    for (int t = 0; t < 4; ++t) q[2 + t] = *(const uint4*)&ub[base + t * 1024];
    q[6] = n + 4 < L ? *(const uint4*)&ub[base + 4096] : z;
#pragma unroll
    for (int t = 0; t < 4; ++t) {
      const unsigned a0[4] = {q[t].x, q[t].y, q[t].z, q[t].w}, a1[4] = {q[t + 1].x, q[t + 1].y, q[t + 1].z, q[t + 1].w};
      const unsigned a2[4] = {q[t + 2].x, q[t + 2].y, q[t + 2].z, q[t + 2].w}, a3[4] = {q[t + 3].x, q[t + 3].y, q[t + 3].z, q[t + 3].w};
      unsigned r[4];
#pragma unroll
      for (int k = 0; k < 4; ++k) {
        float z0 = w0[2 * k] * lo16(a0[k]) + w1[2 * k] * lo16(a1[k]) + w2[2 * k] * lo16(a2[k]) + w3[2 * k] * lo16(a3[k]) + wb[2 * k];
        float z1 = w0[2 * k + 1] * hi16(a0[k]) + w1[2 * k + 1] * hi16(a1[k]) + w2[2 * k + 1] * hi16(a2[k]) + w3[2 * k + 1] * hi16(a3[k]) + wb[2 * k + 1];
        r[k] = pack2(z0, z1);
      }
      *(uint4*)&uc[base + t * 1024] = make_uint4(r[0], r[1], r[2], r[3]);
    }
  }
}

__device__ __forceinline__ void phase_rg_scan(const Params& p, unsigned char* smem_raw, int bid, int nb) {
  float* sA = (float*)smem_raw;
  float* sB = sA + 2048;
  const u16* rb = (const u16*)(p.ws + WS_B(3));
  const u16* ib = (const u16*)(p.ws + WS_B(5));
  const u16* uc = (const u16*)(p.ws + WS_B(2));
  const u16* sg = (const u16*)(p.ws + WS_B(1));
  u16* hfw = (u16*)(p.ws + WS_H);
  u16* yp = (u16*)(p.ws + WS_B(0));
  const int tid = threadIdx.x;
  for (int u = bid; u < 768; u += nb) {
    int sample, b, c, seg, nseg, start, chs, slot;
    if (u < 256) {
      const int xq = u & 7, yq = u >> 3, gid = (yq >> 2) * 8 + xq, sub = yq & 3;
      sample = 1; b = gid >> 4; slot = (tid & 3) * 4; c = (gid & 15) * 64 + sub * 16 + slot; seg = tid >> 2; nseg = 128; start = NPROMPT + b * 1024; chs = 16; }
    else { sample = 0; b = (u - 256) >> 4; slot = (tid & 15) * 4; c = ((u - 256) & 15) * 64 + slot; seg = tid >> 4; nseg = 32; start = b * 256; chs = 64; }
    const int L = nseg * 8;
#pragma unroll 1
    for (int d = 0; d < 2; ++d) {
      const f32x4 lam = *(const f32x4*)&p.in[25][d * 1024 + c];
      float cl[4];
#pragma unroll
      for (int j = 0; j < 4; ++j) cl[j] = 8.0f * log1pf(__expf(-lam[j]));
      const u16* rp = rb + (size_t)d * TOK * 1024;
      const u16* ip = ib + (size_t)d * TOK * 1024;
      const int tok0 = start + (d ? L - 1 - seg * 8 : seg * 8);
      const size_t o0 = (size_t)tok0 * 1024 + c;
      const long ostep = d ? -1024 : 1024;
      const size_t g0 = ((size_t)(c >> 6) * TOK + tok0) * 64 + (c & 63);
      const long gstep = d ? -64 : 64;
      uint2 rr[8], ii[8], uu[8];
#pragma unroll
      for (int s8 = 0; s8 < 8; ++s8) { rr[s8] = *(const uint2*)&rp[g0 + s8 * gstep]; ii[s8] = *(const uint2*)&ip[g0 + s8 * gstep]; uu[s8] = *(const uint2*)&uc[o0 + s8 * ostep]; }
      uint2 hf[8], sgv[8];
      if (d == 1) {
#pragma unroll
        for (int s8 = 0; s8 < 8; ++s8) { hf[s8] = *(const uint2*)&hfw[g0 + s8 * gstep]; sgv[s8] = *(const uint2*)&sg[g0 + s8 * gstep]; }
      }
      float av[8][4], xv[8][4];
      float A[4] = {1.f, 1.f, 1.f, 1.f}, B[4] = {0.f, 0.f, 0.f, 0.f};
#pragma unroll
      for (int s8 = 0; s8 < 8; ++s8) {
        const float r4[4] = {lo16(rr[s8].x), hi16(rr[s8].x), lo16(rr[s8].y), hi16(rr[s8].y)};
        const float i4[4] = {lo16(ii[s8].x), hi16(ii[s8].x), lo16(ii[s8].y), hi16(ii[s8].y)};
        const float u4[4] = {lo16(uu[s8].x), hi16(uu[s8].x), lo16(uu[s8].y), hi16(uu[s8].y)};
#pragma unroll
        for (int j = 0; j < 4; ++j) {
          const float la = -cl[j] * r4[j];
          const float a = __expf(la);
          const float xin = __builtin_amdgcn_sqrtf(fmaxf(1.0f - __expf(2.0f * la), 0.f)) * (i4[j] * u4[j]);
          av[s8][j] = a; xv[s8][j] = xin;
          A[j] *= a; B[j] = a * B[j] + xin;
        }
      }
      *(f32x4*)&sA[seg * chs + slot] = f32x4{A[0], A[1], A[2], A[3]};
      *(f32x4*)&sB[seg * chs + slot] = f32x4{B[0], B[1], B[2], B[3]};
      for (int k = 1; k < nseg; k <<= 1) {
        __syncthreads();
        f32x4 pa = f32x4{1.f, 1.f, 1.f, 1.f}, pb2 = f32x4{0.f, 0.f, 0.f, 0.f};
        if (seg >= k) { pa = *(const f32x4*)&sA[(seg - k) * chs + slot]; pb2 = *(const f32x4*)&sB[(seg - k) * chs + slot]; }
        __syncthreads();
        if (seg >= k) {
#pragma unroll
          for (int j = 0; j < 4; ++j) { B[j] = A[j] * pb2[j] + B[j]; A[j] = A[j] * pa[j]; }
          *(f32x4*)&sA[seg * chs + slot] = f32x4{A[0], A[1], A[2], A[3]};
          *(f32x4*)&sB[seg * chs + slot] = f32x4{B[0], B[1], B[2], B[3]};
        }
      }
      __syncthreads();
      float h[4];
      {
        f32x4 h0v = f32x4{0.f, 0.f, 0.f, 0.f};
        if (sample) h0v = *(const f32x4*)&p.in[3][(b * 2 + d) * 1024 + c];
        if (seg > 0) {
          const f32x4 pa = *(const f32x4*)&sA[(seg - 1) * chs + slot], pb2 = *(const f32x4*)&sB[(seg - 1) * chs + slot];
#pragma unroll
          for (int j = 0; j < 4; ++j) h[j] = pa[j] * h0v[j] + pb2[j];
        } else {
#pragma unroll
          for (int j = 0; j < 4; ++j) h[j] = h0v[j];
        }
      }
#pragma unroll
      for (int s8 = 0; s8 < 8; ++s8) {
#pragma unroll
        for (int j = 0; j < 4; ++j) h[j] = av[s8][j] * h[j] + xv[s8][j];
        const size_t o = o0 + s8 * ostep;
        if (d == 0) *(uint2*)&hfw[g0 + s8 * gstep] = pack4(h[0], h[1], h[2], h[3]);
        else *(uint2*)&yp[o] = pack4((lo16(hf[s8].x) + h[0]) * lo16(sgv[s8].x), (hi16(hf[s8].x) + h[1]) * hi16(sgv[s8].x),
                                     (lo16(hf[s8].y) + h[2]) * lo16(sgv[s8].y), (hi16(hf[s8].y) + h[3]) * hi16(sgv[s8].y));
      }
      if (!sample && seg == nseg - 1) *(f32x4*)&p.out[OUT_RG + (b * 2 + d) * 1024 + c] = f32x4{h[0], h[1], h[2], h[3]};
      __syncthreads();
    }
  }
}

__device__ __forceinline__ void phase_mla_norm(const Params& p, int bid, int nb) {
  u16* cq = (u16*)(p.ws + WS3_CQ);
  u16* ckvall = (u16*)(p.ws + WS3_CKVALL);
  const float* ckvraw = (const float*)(p.ws + WS3_CKVRAW);
  const float* kperaw = (const float*)(p.ws + WS3_KPERAW);
  u16* Kb = (u16*)(p.ws + WS3_K);
  const float* qn = p.in[28]; const float* kvn = p.in[29];
  const int lane = threadIdx.x & 63, wave = threadIdx.x >> 6;
  float qnv[6];
#pragma unroll
  for (int i = 0; i < 3; ++i) { qnv[2 * i] = qn[(i * 64 + lane) * 2]; qnv[2 * i + 1] = qn[(i * 64 + lane) * 2 + 1]; }
  const f32x4 g4 = *(const f32x4*)&kvn[lane * 4];
  for (int row = bid * NW + wave; row < TOK + 2048; row += nb * NW) {
    if (row < TOK) {
      const int tok = row;
      const bool sample = tok >= NPROMPT;
      const int bs = (tok - NPROMPT) >> 10, n = (tok - NPROMPT) & 1023;
      const size_t kvrow = sample ? (size_t)(NPROMPT + bs * 1536 + 512 + n) : (size_t)tok;
      unsigned* cqr = (unsigned*)&cq[(size_t)tok * 384];
      unsigned cv[3]; float ss = 0;
#pragma unroll
      for (int i = 0; i < 3; ++i) { cv[i] = cqr[i * 64 + lane]; float a = lo16(cv[i]), b2 = hi16(cv[i]); ss += a * a + b2 * b2; }
      const float rsq = rsqrtf(wave_sum(ss) * (1.0f / 384.0f) + 1e-6f);
#pragma unroll
      for (int i = 0; i < 3; ++i) {
        cqr[i * 64 + lane] = pack2(lo16(cv[i]) * rsq * qnv[2 * i], hi16(cv[i]) * rsq * qnv[2 * i + 1]);
      }
      f32x4 kv = *(const f32x4*)&ckvraw[(size_t)tok * 256 + lane * 4];
      const float rsk = rsqrtf(wave_sum(kv[0] * kv[0] + kv[1] * kv[1] + kv[2] * kv[2] + kv[3] * kv[3]) * (1.0f / 256.0f) + 1e-6f);
      f32x4 o4;
#pragma unroll
      for (int j = 0; j < 4; ++j) o4[j] = kv[j] * rsk * g4[j];
      *(uint2*)&ckvall[kvrow * 256 + lane * 4] = pack4(o4[0], o4[1], o4[2], o4[3]);
      if (!sample) *(f32x4*)&p.out[OUT_CKV + (size_t)tok * 256 + lane * 4] = o4;
      float v = kperaw[(size_t)tok * 32 + (lane & 31)];
      if (!sample) { if (lane < 32) p.out[OUT_KPE + (size_t)tok * 32 + lane] = v; }
      else {
        const float partner = __shfl_xor(v, 8);
        const int i16 = lane & 15;
        const float pos = (lane & 16) ? (float)(n & 63) : (float)(n >> 6);
        float sn, cs; rope_sincos(pos, i16 & 7, sn, cs);
        v = (i16 < 8) ? (v * cs - partner * sn) : (partner * sn + v * cs);
      }
      const u16 vb = f2bf(v);
#pragma unroll
      for (int i = 0; i < 8; ++i) Kb[(kvrow * 16 + (lane >> 5) + 2 * i) * 96 + 64 + (lane & 31)] = vb;
    } else {
      const int r = row - TOK, bs = r >> 9, j = r & 511;
      const size_t kvrow = (size_t)(NPROMPT + bs * 1536 + j);
      f32x4 kv = *(const f32x4*)&p.in[4][(size_t)r * 256 + lane * 4];
      *(uint2*)&ckvall[kvrow * 256 + lane * 4] = pack4(kv[0], kv[1], kv[2], kv[3]);
      const u16 vb = f2bf(p.in[5][(size_t)r * 32 + (lane & 31)]);
#pragma unroll
      for (int i = 0; i < 8; ++i) Kb[(kvrow * 16 + (lane >> 5) + 2 * i) * 96 + 64 + (lane & 31)] = vb;
    }
  }
}

__device__ __forceinline__ void phase_attn(const Params& p, unsigned char* smem_raw, int bid, int nb) {
  u16* sK = (u16*)smem_raw;
  u16* sV = sK + 128 * 104;
  const u16* qg = (const u16*)(p.ws + WS3_Q);
  const u16* Kg = (const u16*)(p.ws + WS3_K);
  const u16* Vg = (const u16*)(p.ws + WS3_VT);
  const u16* sg = (const u16*)(p.ws + WS3_SG);
  u16* ao = (u16*)(p.ws + WS_H);
  const int tid = threadIdx.x, lane = tid & 63, w = tid >> 6, fr = lane & 15, fq = lane >> 4;
  for (int u = bid; u < 1536; u += nb) {
    int tok0, kvbase, nkeys, h;
    if (u < 512) { const int b = u >> 7, r = u & 127; h = r >> 3; const int qb = r & 7; tok0 = NPROMPT + b * 1024 + qb * 128; kvbase = NPROMPT + b * 1536; nkeys = 1536; }
    else { const int uu = u - 512; const int b = uu >> 5, r = uu & 31; h = r >> 1; const int qb = r & 1; tok0 = b * 256 + qb * 128; kvbase = b * 256; nkeys = 256; }
    const int tokq = tok0 + w * 16 + fr;
    bf16x8 qf[3];
#pragma unroll
    for (int ks = 0; ks < 3; ++ks) qf[ks] = *(const bf16x8*)&qg[(size_t)tokq * 1536 + h * 96 + ks * 32 + fq * 8];
    if (u < 512) {
      const int npos = (tokq - NPROMPT) & 1023;
      const float pos = (fq & 2) ? (float)(npos & 63) : (float)(npos >> 6);
      uint4 raw = *(uint4*)&qf[2];
      unsigned rw[4] = {raw.x, raw.y, raw.z, raw.w};
#pragma unroll
      for (int i = 0; i < 4; ++i) {
        float v0 = lo16(rw[i]), v1 = hi16(rw[i]);
        const float p0 = __shfl_xor(v0, 16), p1 = __shfl_xor(v1, 16);
        float sn0, cs0, sn1, cs1;
        rope_sincos(pos, 2 * i, sn0, cs0); rope_sincos(pos, 2 * i + 1, sn1, cs1);
        v0 = (fq & 1) ? (p0 * sn0 + v0 * cs0) : (v0 * cs0 - p0 * sn0);
        v1 = (fq & 1) ? (p1 * sn1 + v1 * cs1) : (v1 * cs1 - p1 * sn1);
        rw[i] = pack2(v0, v1);
      }
      raw = make_uint4(rw[0], rw[1], rw[2], rw[3]);
      qf[2] = *(bf16x8*)&raw;
    }
    float m = -1e30f, l = 0.f;
    f32x4 oacc[4];
#pragma unroll
    for (int i = 0; i < 4; ++i) oacc[i] = f32x4{0.f, 0.f, 0.f, 0.f};
    const int kk0 = tid / 12, kc0 = tid - kk0 * 12;
    const int kk1 = (tid + NT) / 12, kc1 = (tid + NT) - kk1 * 12;
    const int kk2_ = (tid + 2 * NT) / 12, kc2 = (tid + 2 * NT) - kk2_ * 12;
    const u16* Kp0 = &Kg[((size_t)(kvbase + kk0) * 16 + h) * 96 + kc0 * 8];
    const u16* Kp1 = &Kg[((size_t)(kvbase + kk1) * 16 + h) * 96 + kc1 * 8];
    const u16* Kp2 = &Kg[((size_t)(kvbase + kk2_) * 16 + h) * 96 + kc2 * 8];
    const int vd0 = tid >> 4, vc0 = tid & 15, vd1 = (tid + NT) >> 4;
    const u16* Vp0 = &Vg[(size_t)(h * 64 + vd0) * KVROWS + kvbase + vc0 * 8];
    const u16* Vp1 = &Vg[(size_t)(h * 64 + vd1) * KVROWS + kvbase + vc0 * 8];
    uint4 kr0 = *(const uint4*)Kp0, kr1 = *(const uint4*)Kp1, kr2 = *(const uint4*)Kp2, vr0 = *(const uint4*)Vp0, vr1 = *(const uint4*)Vp1;
    const int ntile2 = nkeys >> 7;
    for (int kt = 0; kt < ntile2; ++kt) {
      __syncthreads();
      *(uint4*)&sK[kk0 * 104 + kc0 * 8] = kr0; *(uint4*)&sK[kk1 * 104 + kc1 * 8] = kr1; *(uint4*)&sK[kk2_ * 104 + kc2 * 8] = kr2;
      *(uint4*)&sV[vd0 * 136 + vc0 * 8] = vr0; *(uint4*)&sV[vd1 * 136 + vc0 * 8] = vr1;
      if (kt + 1 < ntile2) {
        const size_t ko = (size_t)(kt + 1) * 128 * 1536; const int vo = (kt + 1) * 128;
        kr0 = *(const uint4*)(Kp0 + ko); kr1 = *(const uint4*)(Kp1 + ko); kr2 = *(const uint4*)(Kp2 + ko);
        vr0 = *(const uint4*)(Vp0 + vo); vr1 = *(const uint4*)(Vp1 + vo);
      }
      __syncthreads();
      f32x4 sacc[8];
#pragma unroll
      for (int ni = 0; ni < 8; ++ni) {
        sacc[ni] = f32x4{0.f, 0.f, 0.f, 0.f};
#pragma unroll
        for (int ks = 0; ks < 3; ++ks) {
          bf16x8 kf = *(const bf16x8*)&sK[(ni * 16 + fr) * 104 + ks * 32 + fq * 8];
          sacc[ni] = __builtin_amdgcn_mfma_f32_16x16x32_bf16(kf, qf[ks], sacc[ni], 0, 0, 0);
        }
      }
      float mx = -1e30f;
#pragma unroll
      for (int ni = 0; ni < 8; ++ni)
#pragma unroll
        for (int j = 0; j < 4; ++j) mx = fmaxf(mx, sacc[ni][j]);
      mx = fmaxf(mx, __shfl_xor(mx, 16));
      mx = fmaxf(mx, __shfl_xor(mx, 32));
      const float mnew = fmaxf(m, mx);
      const float alpha = __builtin_amdgcn_exp2f(m - mnew);
      m = mnew;
      float ls = 0.f;
#pragma unroll
      for (int ni = 0; ni < 8; ++ni)
#pragma unroll
        for (int j = 0; j < 4; ++j) { float e = __builtin_amdgcn_exp2f(sacc[ni][j] - mnew); sacc[ni][j] = e; ls += e; }
      l = l * alpha + ls;
      bf16x8 pf[4];
#pragma unroll
      for (int kk2 = 0; kk2 < 4; ++kk2) {
        uint2 lo = pack4(sacc[2 * kk2][0], sacc[2 * kk2][1], sacc[2 * kk2][2], sacc[2 * kk2][3]);
        uint2 hi = pack4(sacc[2 * kk2 + 1][0], sacc[2 * kk2 + 1][1], sacc[2 * kk2 + 1][2], sacc[2 * kk2 + 1][3]);
        uint4 pk = make_uint4(lo.x, lo.y, hi.x, hi.y);
        pf[kk2] = *(bf16x8*)&pk;
      }
#pragma unroll
      for (int di = 0; di < 4; ++di) {
#pragma unroll
        for (int j = 0; j < 4; ++j) oacc[di][j] *= alpha;
#pragma unroll
        for (int kk2 = 0; kk2 < 4; ++kk2) {
          uint2 v0 = *(const uint2*)&sV[(di * 16 + fr) * 136 + kk2 * 32 + fq * 4];
          uint2 v1 = *(const uint2*)&sV[(di * 16 + fr) * 136 + kk2 * 32 + 16 + fq * 4];
          uint4 vk = make_uint4(v0.x, v0.y, v1.x, v1.y);
          oacc[di] = __builtin_amdgcn_mfma_f32_16x16x32_bf16(*(bf16x8*)&vk, pf[kk2], oacc[di], 0, 0, 0);
        }
      }
    }
    l += __shfl_xor(l, 16);
    l += __shfl_xor(l, 32);
    const float inv = 1.0f / l;
#pragma unroll
    for (int di = 0; di < 4; ++di) {
      const size_t o = (size_t)tokq * 1024 + h * 64 + di * 16 + fq * 4;
      uint2 s = *(const uint2*)&sg[o];
      *(uint2*)&ao[o] = pack4(oacc[di][0] * inv * siluf_(lo16(s.x)), oacc[di][1] * inv * siluf_(hi16(s.x)), oacc[di][2] * inv * siluf_(lo16(s.y)), oacc[di][3] * inv * siluf_(hi16(s.y)));
    }
  }
}

#define XB_TMO      128
#define XB_XCNT(j)  (256  + 64 * (j))
#define XB_XSUB(j)  (1280 + 64 * (j))
#define XB_XGEN(j)  (2304 + 64 * (j))
#define XB_TOP      3328
#define XB_TOPGEN   3392
#define XCD_BAR_WORDS 3456
#define XB_SPIN_CAP (1u << 22)
__device__ __forceinline__ unsigned xb_ld(unsigned* p)              { return __hip_atomic_load(p, __ATOMIC_RELAXED, __HIP_MEMORY_SCOPE_AGENT); }
__device__ __forceinline__ unsigned xb_add(unsigned* p, unsigned v) { return __hip_atomic_fetch_add(p, v, __ATOMIC_RELAXED, __HIP_MEMORY_SCOPE_AGENT); }
__device__ __forceinline__ unsigned xb_xcc_id() { return (unsigned)__builtin_amdgcn_s_getreg((3 << 11) | 20) & 0xFu; }
#define XB_SPIN(cond, bar) do { unsigned _sp = 0; while (cond) { __builtin_amdgcn_s_sleep(1); \
    if ((++_sp & 255u) == 0u) { if (xb_ld(&(bar)[XB_TMO])) break; if (_sp > XB_SPIN_CAP) { atomicAdd(&(bar)[XB_TMO], 1u); break; } } } } while (0)
struct XcdBarrier { unsigned* bar; unsigned x; volatile LAS unsigned* st; };
__device__ __forceinline__ XcdBarrier xcd_barrier_post(unsigned* bar, volatile LAS unsigned* st) {
  XcdBarrier b; b.bar = bar; b.x = xb_xcc_id(); b.st = st;
  if (threadIdx.x == 0) (void)xb_add(&bar[XB_XCNT(b.x)], 1u);
  return b;
}
__device__ __forceinline__ void xcd_barrier_complete(unsigned* bar, unsigned x, unsigned& nloc, unsigned& nx) {
  const unsigned G = gridDim.x * gridDim.y * gridDim.z;
  unsigned sum, cnt, mine, sp = 0u;
  for (;;) {
    sum = 0u; cnt = 0u; mine = 0u;
#pragma unroll
    for (unsigned j = 0; j < 16; ++j) { const unsigned c = xb_ld(&bar[XB_XCNT(j)]); sum += c; cnt += (c > 0u) ? 1u : 0u; mine = (j == x) ? c : mine; }
    if (sum == G) break;
    __builtin_amdgcn_s_sleep(1);
    if ((++sp & 255u) == 0u) { if (xb_ld(&bar[XB_TMO])) break; if (sp > XB_SPIN_CAP) { atomicAdd(&bar[XB_TMO], 1u); break; } }
  }
  nloc = mine > 0u ? mine : 1u; nx = cnt > 0u ? cnt : 1u;
}
__device__ __forceinline__ void xcd_barrier(const XcdBarrier& b) {
  asm volatile("s_waitcnt vmcnt(0)" ::: "memory");
  __syncthreads();
  if (threadIdx.x == 0) {
    unsigned* bar = b.bar;
    __builtin_amdgcn_s_waitcnt(0);
    unsigned nloc = b.st[0], nx = b.st[1];
    if (nloc == 0u) { xcd_barrier_complete(bar, b.x, nloc, nx); b.st[0] = nloc; b.st[1] = nx; }
    const unsigned old = xb_add(&bar[XB_XSUB(b.x)], 1u);
    const unsigned gen = old / nloc;
    if (old + 1u == (gen + 1u) * nloc) {
      __builtin_amdgcn_fence(__ATOMIC_RELEASE, "agent");
      asm volatile("s_waitcnt vmcnt(0)" ::: "memory");
      const unsigned og = xb_add(&bar[XB_TOP], 1u);
      const unsigned tg = og / nx;
      if (og + 1u == (tg + 1u) * nx) xb_add(&bar[XB_TOPGEN], 1u);
      else XB_SPIN(xb_ld(&bar[XB_TOPGEN]) == tg, bar);
      __builtin_amdgcn_fence(__ATOMIC_ACQUIRE, "agent");
      xb_add(&bar[XB_XGEN(b.x)], 1u);
      asm volatile("s_waitcnt vmcnt(0)" ::: "memory");
    } else {
      XB_SPIN(xb_ld(&bar[XB_XGEN(b.x)]) == gen, bar);
      __builtin_amdgcn_fence(__ATOMIC_ACQUIRE, "agent");
      asm volatile("s_waitcnt vmcnt(0)" ::: "memory");
    }
  }
  __syncthreads();
}

#define GEMM_LDS 131072
#define DYN_LDS (GEMM_LDS + 16)
#define WS_BAR (WS_CNT + 4096ull)

#define RUN_GEMM(Aptr, LDA, Bptr, MM, NN, KK, GATE, EPI, CID) RUN_GEMM_G(Aptr, LDA, Bptr, MM, NN, KK, GATE, EPI, nb, CID)
#define RUN_GEMM_G(Aptr, LDA, Bptr, MM, NN, KK, GATE, EPI, GG, CID) do { pg8::Gemm g_{(const u16*)(Aptr), (const u16*)(Bptr), MM, NN, KK, LDA, GATE, p.flags}; \
    pg8::StaticOrder S_; S_.init(MM, NN, GG, CID); pg8::gemm_phase((LAS unsigned char*)smem_raw, g_, S_, EPI); } while (0)

__global__ void __launch_bounds__(NT, 2) mega(Params p) {
  extern __shared__ __attribute__((aligned(16))) unsigned char smem_raw[];
  const int bid = blockIdx.x, nb = gridDim.x;
  unsigned char* ws = p.ws;
  const float* mod = (const float*)(ws + WS_MOD);
  volatile LAS unsigned* xst = (volatile LAS unsigned*)((LAS unsigned char*)smem_raw + GEMM_LDS);
  XcdBarrier xb;
  if (p.phase_hi - p.phase_lo > 1) {
    if (threadIdx.x == 0) { xst[0] = 0u; xst[1] = 0u; }
    __syncthreads();
    xb = xcd_barrier_post((unsigned*)(ws + WS_BAR), xst);
  }
#define PH_BEGIN(n) if ((PHMASK & (1u << n)) && p.phase_lo <= n && n < p.phase_hi) { const int ph = n;
#define PH_FIN if (ph + 1 < p.phase_hi) { if (p.phase_lo < 0) cg::this_grid().sync(); else xcd_barrier(xb); } }
  PH_BEGIN(0) phase_prologue(p, smem_raw, bid, nb); PH_FIN
  PH_BEGIN(1) phase_h0(p, bid, nb); PH_FIN
  PH_BEGIN(2) {
    EpiHgIn e{(u16*)(ws + WS_B(0)), (u16*)(ws + WS_B(1)), (u16*)(ws + WS_B(2)), (_Float16*)(ws + WS_B(3)), (const float*)(ws + WS_LB)};
    RUN_GEMM(ws + WS_H, 1024, ws + WS_W_HG_IN, TOK, 5120, 1024, 0, e, bid);
  } PH_FIN
  PH_BEGIN(3) phase_gla(p, smem_raw); PH_FIN
  PH_BEGIN(4) phase_hg_post(p, bid, nb); PH_FIN
  PH_BEGIN(5) {
    EpiResLn<false, true> e{p.in[0], p.in[1], (const u16*)nullptr, p.out, (u16*)(ws + WS_XB), mod + 0 * 15360 + 2048, p.in[10] + 0 * 1024, p.in[11] + 0 * 1024, mod + 1 * 15360, (u16*)(ws + WS_H),
               (unsigned long long*)(ws + WS_SLOT) + 0 * 49152, (unsigned*)(ws + WS_CNT + 256) + 0 * 48};
    RUN_GEMM(ws + WS_B(0), 1024, ws + WS_W_HG_OUT, TOK, 1024, 1024, 0, e, bid);
    wconv_idle(p, smem_raw, bid, nb, 1536, 2816);
  } PH_FIN
  PH_BEGIN(7) {
    EpiScIn e{(u16*)(ws + WS_B(0)), (u16*)(ws + WS_B(1))};
    RUN_GEMM(ws + WS_H, 1024, ws + WS_W_SC_IN, TOK, 4096, 1024, 0, e, bid);
  } PH_FIN
  PH_BEGIN(8) phase_sc_conv(p, bid, nb); PH_FIN
  PH_BEGIN(9) {
    EpiResLn<true, true> e{p.out, p.out, (const u16*)(ws + WS_XB), p.out, (u16*)(ws + WS_XB), mod + 1 * 15360 + 2048, p.in[10] + 1 * 1024, p.in[11] + 1 * 1024, mod + 2 * 15360, (u16*)(ws + WS_H),
               (unsigned long long*)(ws + WS_SLOT) + 1 * 49152, (unsigned*)(ws + WS_CNT + 256) + 1 * 48};
    RUN_GEMM(ws + WS_B(2), 1024, ws + WS_W_SC_OUT, TOK, 1024, 1024, 0, e, bid);
    wconv_idle(p, smem_raw, bid, nb, 2816, 3840);
  } PH_FIN
  PH_BEGIN(11) {
    EpiRgIn e{(u16*)(ws + WS_B(0)), (u16*)(ws + WS_B(1))};
    RUN_GEMM(ws + WS_H, 1024, ws + WS_W_RG_IN, TOK, 2048, 1024, 0, e, bid);
  } PH_FIN
  PH_BEGIN(12) phase_rg_conv(p, bid, nb); PH_FIN
  PH_BEGIN(13) {
    EpiRgGate e{(u16*)(ws + WS_B(3)), (u16*)(ws + WS_B(5)), p.in[24]};
    RUN_GEMM(ws + WS_B(2), 1024, ws + WS_W_RG_GATE, TOK, 4096, 256, 1, e, bid);
  } PH_FIN
  PH_BEGIN(14) phase_rg_scan(p, smem_raw, bid, nb); PH_FIN
  PH_BEGIN(15) {
    EpiResLn<true, true> e{p.out, p.out, (const u16*)(ws + WS_XB), p.out, (u16*)(ws + WS_XB), mod + 2 * 15360 + 2048, p.in[10] + 2 * 1024, p.in[11] + 2 * 1024, mod + 3 * 15360, (u16*)(ws + WS_H),
               (unsigned long long*)(ws + WS_SLOT) + 2 * 49152, (unsigned*)(ws + WS_CNT + 256) + 2 * 48};
    RUN_GEMM(ws + WS_B(0), 1024, ws + WS_W_RG_OUT, TOK, 1024, 1024, 0, e, bid);
    wconv_idle(p, smem_raw, bid, nb, 3840, 4800);
  } PH_FIN
  PH_BEGIN(17) {
    EpiMlaIn e{(u16*)(ws + WS3_CQ), (float*)(ws + WS3_CKVRAW), (float*)(ws + WS3_KPERAW), (u16*)(ws + WS3_SG)};
    RUN_GEMM(ws + WS_H, 1024, ws + WS_W_MLA_IN, TOK, 768, 1024, 0, e, bid);
  } PH_FIN
  PH_BEGIN(18) phase_mla_norm(p, bid, nb); PH_FIN
  PH_BEGIN(19) {
    const bool bal = (nb == 256);
    EpiSg eg{(u16*)(ws + WS3_SG)};
    RUN_GEMM(ws + WS_H, 1024, ws + WS_W_MLA_IN + 672 * 1024 * 2, TOK, 1024, 1024, 0, eg, bid);
    EpiQ eq{(u16*)(ws + WS3_Q)};
    RUN_GEMM(ws + WS3_CQ, 384, ws + WS_W_QB, TOK, 1536, 384, 0, eq, bal ? ((bid + 64) & 255) : bid);
    EpiK ek{(u16*)(ws + WS3_K)};
    RUN_GEMM(ws + WS3_CKVALL, 256, ws + WS_W_KVB, KVROWS, 1024, 256, 0, ek, bal ? ((bid + 32) & 255) : bid);
    EpiV ev{(u16*)(ws + WS3_VT)};
    RUN_GEMM_G(ws + WS_W_KVB + 1024 * 256 * 2, 256, ws + WS3_CKVALL, 1024, KVROWS, 256, 0, ev, bal ? 64 : nb, bal ? (bid >= 192 ? bid - 192 : (1 << 20)) : bid);
  } PH_FIN
  PH_BEGIN(20) phase_attn(p, smem_raw, bid, nb); PH_FIN
  PH_BEGIN(21) {
    EpiResLn<true, false> e{p.out, p.out, (const u16*)(ws + WS_XB), p.out, (u16*)nullptr, mod + 3 * 15360 + 2048, p.in[10] + 3 * 1024, p.in[11] + 3 * 1024, mod + 3 * 15360, (u16*)nullptr,
               (unsigned long long*)(ws + WS_SLOT) + 3 * 49152, (unsigned*)(ws + WS_CNT + 256) + 3 * 48};
    RUN_GEMM(ws + WS_H, 1024, ws + WS_W_MLA_OUT, TOK, 1024, 1024, 0, e, bid);
  } PH_FIN
}

extern "C" void kernel_launch(void* const* d_in, const int* in_sizes, int n_in, void* d_out, int out_size, void* d_ws, size_t ws_size,
                              hipStream_t stream) {
  static int grid_blocks = 0;
  if (!grid_blocks) {
    int dev = 0, cus = 0, per_cu = 0;
    (void)hipGetDevice(&dev);
    (void)hipDeviceGetAttribute(&cus, hipDeviceAttributeMultiprocessorCount, dev);
    (void)hipFuncSetAttribute((const void*)mega, hipFuncAttributeMaxDynamicSharedMemorySize, DYN_LDS);
    (void)hipOccupancyMaxActiveBlocksPerMultiprocessor(&per_cu, (const void*)mega, NT, DYN_LDS);
    if (per_cu < 1) per_cu = 1;
    if (per_cu > 1) per_cu = 1;
    grid_blocks = cus * per_cu;
  }
  Params p{};
  for (int i = 0; i < 33; ++i) p.in[i] = (const float*)d_in[i];
  p.out = (float*)d_out;
  p.ws = (unsigned char*)d_ws;
#if MULTI_LAUNCH
  (void)hipMemsetAsync((unsigned char*)d_ws + WS_CNT, 0, 4096 + XCD_BAR_WORDS * 4, stream);
  for (int ph = 0; ph < NPHASES; ++ph) {
    p.phase_lo = ph; p.phase_hi = ph + 1;
    hipLaunchKernelGGL(mega, dim3(grid_blocks), dim3(NT), DYN_LDS, stream, p);
#ifdef PROBE_MASK
    if ((PROBE_MASK >> ph) & 1) { p.flags = PROBE_FLAGS; for (int r = 0; r < 2; ++r) {
      if (ph == 3) (void)hipMemsetAsync((unsigned char*)d_ws + WS_CNT, 0, 64, stream);
      hipLaunchKernelGGL(mega, dim3(grid_blocks), dim3(NT), DYN_LDS, stream, p);
    } p.flags = 0; }
#endif
  }
#else
  p.phase_lo = 0; p.phase_hi = NPHASES;
  (void)hipMemsetAsync((unsigned char*)d_ws + WS_CNT, 0, 4096 + XCD_BAR_WORDS * 4, stream);
  void* args[] = {&p};
  hipError_t e = hipLaunchCooperativeKernel((const void*)mega, dim3(grid_blocks), dim3(NT), args, DYN_LDS, stream);
  if (e != hipSuccess) fprintf(stderr, "cooperative launch failed: %s (grid %d)\n", hipGetErrorString(e), grid_blocks);
#endif
}
```

```cpp
#include <hip/hip_runtime.h>
#include <hip/hip_cooperative_groups.h>
#include <cstdio>
namespace cg = cooperative_groups;

#ifndef MULTI_LAUNCH
#define MULTI_LAUNCH 0
#endif

typedef unsigned short u16;
using bf16x8 = __attribute__((ext_vector_type(8))) short;
using f32x4 = __attribute__((ext_vector_type(4))) float;
typedef _Float16 h4 __attribute__((ext_vector_type(4)));

#define TOK 12288
#define NPROMPT 8192
#define KVROWS 14336
#define NPHASES 23
#ifndef PHMASK
#define PHMASK 0x7fffff
#endif
#define DN_ALPHA 1.6817928305074290f

#define WS_W_HG_IN 0ull
#define WS_W_HG_OUT (WS_W_HG_IN + 10485760ull)
#define WS_W_SC_IN (WS_W_HG_OUT + 2097152ull)
#define WS_W_SC_OUT (WS_W_SC_IN + 8388608ull)
#define WS_W_RG_IN (WS_W_SC_OUT + 2097152ull)
#define WS_W_RG_GATE (WS_W_RG_IN + 4194304ull)
#define WS_W_RG_OUT (WS_W_RG_GATE + 2097152ull)
#define WS_W_MLA_IN (WS_W_RG_OUT + 2097152ull)
#define WS_W_QB (WS_W_MLA_IN + 3670016ull)
#define WS_W_KVB (WS_W_QB + 1179648ull)
#define WS_W_MLA_OUT (WS_W_KVB + 1048576ull)
#define WS_MOD (WS_W_MLA_OUT + 2097152ull)
#define WS_LB (WS_MOD + 245760ull)
#define WS_CNT (WS_LB + 8192ull)
#define WS_R (WS_CNT + 4096ull + 16384ull)
#define BSZ 25165824ull
#define WS_H (WS_R)
#define WS_B(i) (WS_R + BSZ * (1 + (i)))
#define WS_SLOT (WS_R + 201326592ull)
#define WS_XB (WS_SLOT + 1572864ull)
#define WS3_CQ (WS_R + 25165824ull)
#define WS3_CKVALL (WS_R + 34603008ull)
#define WS3_CKVRAW (WS_R + 41943040ull)
#define WS3_KPERAW (WS_R + 54525952ull)
#define WS3_SG (WS_R + 56098816ull)
#define WS3_Q (WS_R + 81264640ull)
#define WS3_K (WS_R + 119013376ull)
#define WS3_VT (WS_R + 163053568ull)

#define OUT_HG 12582912
#define OUT_RG 20971520
#define OUT_CKV 21037056
#define OUT_KPE 23134208

struct Params {
  const float* in[33];
  float* out;
  unsigned char* ws;
  int phase_lo, phase_hi, flags, pad_;
};

__device__ __forceinline__ u16 f2bf(float f) { __bf16 r = (__bf16)f; return *(u16*)&r; }
__device__ __forceinline__ float bf2f(u16 h) { return __uint_as_float(((unsigned)h) << 16); }
typedef float f2v_ __attribute__((ext_vector_type(2)));
typedef __bf16 b2v_ __attribute__((ext_vector_type(2)));
__device__ __forceinline__ unsigned pack2(float a, float b) { f2v_ f = {a, b}; b2v_ r = __builtin_convertvector(f, b2v_); return *(unsigned*)&r; }
__device__ __forceinline__ uint2 pack4(float a, float b, float c, float d) { return make_uint2(pack2(a, b), pack2(c, d)); }
__device__ __forceinline__ float lo16(unsigned u) { return __uint_as_float(u << 16); }
__device__ __forceinline__ float hi16(unsigned u) { return __uint_as_float(u & 0xffff0000u); }
__device__ __forceinline__ float sigmoidf_(float x) { return __builtin_amdgcn_rcpf(1.0f + __expf(-x)); }
__device__ __forceinline__ float siluf_(float x) { return x * __builtin_amdgcn_rcpf(1.0f + __expf(-x)); }
__device__ __forceinline__ int cond_of(int tok) { return tok < NPROMPT ? 0 : 1 + ((tok - NPROMPT) >> 10); }
__device__ __forceinline__ float wave_sum(float v) {
#pragma unroll
  for (int o = 32; o > 0; o >>= 1) v += __shfl_xor(v, o);
  return v;
}
__device__ __forceinline__ void rope_sincos(float pos, int fi, float& sn, float& cs) {
  float inv = exp2f(-(float)fi * 1.6609640474436813f);
  float ang = pos * inv;
  float k = rintf(ang * 0.15915494309189535f);
  float r = fmaf(-k, 6.2831854820251465f, ang);
  r = fmaf(-k, -1.7484555e-7f, r);
  sn = __sinf(r); cs = __cosf(r);
}

#define NT 512
#define NW 8
#define LAS __attribute__((address_space(3)))

namespace pg8 {
constexpr int BM = 256, BK = 64, HALF = 128, HTB = HALF * BK * 2, STAGE_BYTES = 8 * HTB, NXCD = 8, WGM = 8;
__device__ __forceinline__ int lds_byte(int r, int c) { const int st = (r >> 4) * 2 + (c >> 5), rr = r & 15, cc = c & 31, ob = rr * 64 + cc * 2; return st * 1024 + (ob ^ (((ob >> 9) & 1) << 5)); }
__device__ __forceinline__ void stage_rc(int b, int& R, int& C) { const int st = b / 1024, sb = b % 1024, swz = sb ^ (((sb >> 9) & 1) << 5); R = (st >> 1) * 16 + swz / 64; C = (st & 1) * 32 + (swz % 64) / 2; }
struct Unit { int pm, pn; };
struct Gemm { const u16* A; const u16* Bt; int M, N, K, lda, gate, noepi; size_t kstepA, gstride; };
struct StaticOrder {
  int nM, nN, nwg, G, c;
  __device__ void init(int M, int N, int G_, int c_) { nM = M / BM; nN = N / BM; nwg = nM * nN; G = G_; c = c_; }
  __device__ bool next(int i, Unit& u) const {
    const long L = (long)i * G + c; if (L >= nwg) return false;
    int wgid = (int)L; { const int q = nwg / NXCD, r = nwg % NXCD, xcd = wgid % NXCD, off = wgid / NXCD; wgid = (xcd < r ? xcd * (q + 1) : r * (q + 1) + (xcd - r) * q) + off; }
    const int nig = WGM * nN, gid = wgid / nig, fm = gid * WGM, gsz = (nM - fm) < WGM ? (nM - fm) : WGM;
    u.pm = fm + ((wgid % nig) % gsz); u.pn = (wgid % nig) / gsz; return true;
  }
};
template <class Epi>
__device__ __forceinline__ void gemm_phase(LAS unsigned char* lds, const Gemm g, const StaticOrder& S, const Epi& E) {
  const int tid = threadIdx.x, wid = __builtin_amdgcn_readfirstlane(tid >> 6), lane = tid & 63, wr = wid >> 2, wc = wid & 3, fr = lane & 15, fq = lane >> 4;
  const int K = g.K, nt = K / BK;
  unsigned voffA[2], voffB[2];
#pragma unroll
  for (int i = 0; i < 2; ++i) { int R, C; stage_rc(tid * 16 + i * 8192, R, C); voffA[i] = (unsigned)(R * g.lda + C) * 2u; voffB[i] = (unsigned)(R * K + C) * 2u; }
  const size_t kstep = (size_t)(BK * 2);
  const size_t kstepA = g.kstepA;
  const size_t hstepA = (size_t)HALF * g.lda * 2, hstepB = (size_t)HALF * K * 2;
  const size_t tstepA = 2 * hstepA, tstepB = 2 * hstepB;
  const unsigned ldsw = (unsigned)wid * 1024u;
  const int aoff = lds_byte(wr * 64 + fr, fq * 8), boff = lds_byte(wc * 32 + fr, fq * 8);
#define PG8_AOFF(pn) (g.gate ? (size_t)(((pn) >> 1) & 3) * g.gstride : (size_t)0)
#define PG8_SA(b, h) (((b) * 2 + (h)) * HTB)
#define PG8_SB(b, h) ((4 + (b) * 2 + (h)) * HTB)
#define PG8_STAGE(bufoff, gbase, voff) do { _Pragma("unroll") for (int _i = 0; _i < 2; ++_i) \
    __builtin_amdgcn_global_load_lds((const unsigned*)((const char*)(gbase) + (voff)[_i]), (LAS unsigned*)(lds + (bufoff) + ldsw + _i * 8192), 16, 0, 0); } while (0)
#define PG8_LDA(dst, b, h) do { _Pragma("unroll") for (int m = 0; m < 4; ++m) _Pragma("unroll") for (int k = 0; k < 2; ++k) dst[m][k] = *(const LAS bf16x8*)(lds + PG8_SA(b, h) + aoff + m * 2048 + k * 1024); } while (0)
#define PG8_LDB(dst, b, h) do { _Pragma("unroll") for (int n = 0; n < 2; ++n) _Pragma("unroll") for (int k = 0; k < 2; ++k) dst[n][k] = *(const LAS bf16x8*)(lds + PG8_SB(b, h) + boff + n * 2048 + k * 1024); } while (0)
#define PG8_MMA(ai, bj, At, Bt) do { __builtin_amdgcn_s_setprio(1); _Pragma("unroll") for (int m = 0; m < 4; ++m) _Pragma("unroll") for (int n = 0; n < 2; ++n) _Pragma("unroll") for (int k = 0; k < 2; ++k) \
    acc[ai][bj][m][n] = __builtin_amdgcn_mfma_f32_16x16x32_bf16(Bt[n][k], At[m][k], acc[ai][bj][m][n], 0, 0, 0); __builtin_amdgcn_s_setprio(0); } while (0)
#define PG8_WAIT_V(n) asm volatile("s_waitcnt vmcnt(" #n ")" ::: "memory")
#define PG8_WAIT_L(n) asm volatile("s_waitcnt lgkmcnt(" #n ")" ::: "memory")
#define PG8_BAR __builtin_amdgcn_s_barrier()
#define PG8_SCHED __builtin_amdgcn_sched_barrier(0)
  Unit cur, nxt; int ui = 0;
  if (!S.next(0, cur)) return;
  f32x4 acc[2][2][4][2];
#pragma unroll
  for (int a = 0; a < 2; ++a)
#pragma unroll
    for (int b = 0; b < 2; ++b)
#pragma unroll
      for (int m = 0; m < 4; ++m)
#pragma unroll
        for (int n = 0; n < 2; ++n) acc[a][b][m][n] = (f32x4){0.f, 0.f, 0.f, 0.f};
  bf16x8 At[4][2], B0[2][2], B1[2][2];
  const char* cA = (const char*)g.A + (size_t)cur.pm * tstepA + PG8_AOFF(cur.pn); const char* cB = (const char*)g.Bt + (size_t)cur.pn * tstepB;
  PG8_STAGE(PG8_SB(0, 0), cB, voffB); PG8_STAGE(PG8_SA(0, 0), cA, voffA); PG8_STAGE(PG8_SB(0, 1), cB + hstepB, voffB); PG8_STAGE(PG8_SA(0, 1), cA + hstepA, voffA);
  if (wr == 1) PG8_BAR;
  PG8_WAIT_V(4); PG8_BAR;
  PG8_STAGE(PG8_SB(1, 0), cB + kstep, voffB); PG8_STAGE(PG8_SA(1, 0), cA + kstepA, voffA); PG8_STAGE(PG8_SB(1, 1), cB + hstepB + kstep, voffB);
  PG8_WAIT_V(6); PG8_BAR;
  for (;;) {
    const bool has_next = S.next(ui + 1, nxt);
    const char* nA = has_next ? (const char*)g.A + (size_t)nxt.pm * tstepA + PG8_AOFF(nxt.pn) : cA; const char* nB = has_next ? (const char*)g.Bt + (size_t)nxt.pn * tstepB : cB;
#pragma unroll 1
    for (int t = 0; t < nt; t += 2) {
      const bool last = (t == nt - 2);
      const char* a1 = cA + (size_t)(t + 1) * kstepA;
      const char* a2 = last ? nA : cA + (size_t)(t + 2) * kstepA; const char* b2 = last ? nB : cB + (size_t)(t + 2) * kstep;
      const char* a3 = a2 + kstepA; const char* b3 = b2 + kstep;
      PG8_LDB(B0, 0, 0); PG8_SCHED; PG8_LDA(At, 0, 0); PG8_STAGE(PG8_SA(1, 1), a1 + hstepA, voffA);
      PG8_WAIT_L(8); PG8_BAR; PG8_WAIT_L(0); PG8_MMA(0, 0, At, B0); PG8_BAR; PG8_SCHED;
      PG8_LDB(B1, 0, 1); PG8_STAGE(PG8_SB(0, 0), b2, voffB);
      PG8_BAR; PG8_WAIT_L(0); PG8_MMA(0, 1, At, B1); PG8_BAR;
      PG8_LDA(At, 0, 1); PG8_STAGE(PG8_SA(0, 0), a2, voffA);
      PG8_BAR; PG8_WAIT_L(0); PG8_MMA(1, 0, At, B0); PG8_BAR; PG8_SCHED;
      PG8_STAGE(PG8_SB(0, 1), b2 + hstepB, voffB);
      PG8_WAIT_V(6); PG8_BAR; PG8_MMA(1, 1, At, B1); PG8_BAR;
      PG8_LDB(B0, 1, 0); PG8_SCHED; PG8_LDA(At, 1, 0); PG8_STAGE(PG8_SA(0, 1), a2 + hstepA, voffA);
      PG8_WAIT_L(8); PG8_BAR; PG8_WAIT_L(0); PG8_MMA(0, 0, At, B0); PG8_BAR; PG8_SCHED;
      PG8_LDB(B1, 1, 1); PG8_STAGE(PG8_SB(1, 0), b3, voffB);
      PG8_BAR; PG8_WAIT_L(0); PG8_MMA(0, 1, At, B1); PG8_BAR;
      PG8_LDA(At, 1, 1); PG8_STAGE(PG8_SA(1, 0), a3, voffA);
      PG8_BAR; PG8_WAIT_L(0); PG8_MMA(1, 0, At, B0); PG8_BAR; PG8_SCHED;
      PG8_STAGE(PG8_SB(1, 1), b3 + hstepB, voffB);
      PG8_WAIT_V(6); PG8_BAR; PG8_MMA(1, 1, At, B1); PG8_BAR;
    }
    if constexpr (!Epi::AFTER_DRAIN) { if (!g.noepi) E(acc, cur, wr, wc, fr, fq); }
    if (!has_next) break;
#pragma unroll
    for (int a = 0; a < 2; ++a)
#pragma unroll
      for (int b = 0; b < 2; ++b)
#pragma unroll
        for (int m = 0; m < 4; ++m)
#pragma unroll
          for (int n = 0; n < 2; ++n) acc[a][b][m][n] = (f32x4){0.f, 0.f, 0.f, 0.f};
    cur = nxt; cA = nA; cB = nB; ++ui;
  }
  PG8_WAIT_V(0);
  if (wr == 0) PG8_BAR;
  PG8_BAR;
  if constexpr (Epi::AFTER_DRAIN) { if (!g.noepi) E.fused(acc, cur, wr, wc, fr, fq, lds); }
#undef PG8_AOFF
#undef PG8_SA
#undef PG8_SB
#undef PG8_STAGE
#undef PG8_LDA
#undef PG8_LDB
#undef PG8_MMA
#undef PG8_WAIT_V
#undef PG8_WAIT_L
#undef PG8_BAR
#undef PG8_SCHED
}
}
using pg8::Unit;
typedef const f32x4 (&AccRef)[2][2][4][2];

#define EPI_ROWS(...) _Pragma("unroll") for (int ai = 0; ai < 2; ++ai) _Pragma("unroll") for (int m = 0; m < 4; ++m) { const int row = u.pm * 256 + ai * 128 + wr * 64 + m * 16 + fr; __VA_ARGS__ }
#define EPI_COLS(...) _Pragma("unroll") for (int bj = 0; bj < 2; ++bj) _Pragma("unroll") for (int n = 0; n < 2; ++n) { const int cb = u.pn * 256 + bj * 128 + wc * 32 + n * 16; const f32x4 a = acc[ai][bj][m][n]; __VA_ARGS__ }

struct EpiHgIn {
  static constexpr bool AFTER_DRAIN = false;
  u16 *q, *v, *sg; _Float16* lf; const float* lb;
  __device__ __forceinline__ void operator()(AccRef acc, const Unit& u, int wr, int wc, int fr, int fq) const {
    const int region = u.pn >> 2;
    f32x4 l4[2][2];
    if (region == 1 || region == 2) {
#pragma unroll
      for (int bj = 0; bj < 2; ++bj)
#pragma unroll
        for (int n = 0; n < 2; ++n) l4[bj][n] = *(const f32x4*)&lb[(region - 1) * 1024 + ((u.pn * 256 + bj * 128 + wc * 32 + n * 16) & 1023) + fq * 4];
    }
    EPI_ROWS( EPI_COLS(
      const int c = (cb & 1023) + fq * 4;
      if (region == 0) {
        const float s = 0.08838834764831845f;
        *(uint2*)&q[(size_t)row * 1024 + c] = pack4(siluf_(a[0]) * s, siluf_(a[1]) * s, siluf_(a[2]) * s, siluf_(a[3]) * s);
      } else if (region <= 2) {
        const int d = region - 1;
        h4 o;
        _Pragma("unroll") for (int j = 0; j < 4; ++j) { float f = l4[bj][n][j] + (1.0f - l4[bj][n][j]) * sigmoidf_(a[j]); o[j] = (_Float16)__logf(f); }
        *(h4*)&lf[(size_t)row * 2048 + d * 1024 + c] = o;
      } else if (region == 3) {
        *(uint2*)&v[(size_t)row * 1024 + c] = pack4(a[0], a[1], a[2], a[3]);
      } else {
        *(uint2*)&sg[(size_t)row * 1024 + c] = pack4(a[0], a[1], a[2], a[3]);
      }
    ) )
  }
};

struct EpiRes {
  static constexpr bool AFTER_DRAIN = false;
  const float* xin_p; const float* xin_s; float* Y; const float* gate;
  __device__ __forceinline__ void operator()(AccRef acc, const Unit& u, int wr, int wc, int fr, int fq) const {
    EPI_ROWS(
      const float* xr = row < NPROMPT ? xin_p + (size_t)row * 1024 : xin_s + (size_t)(row - NPROMPT) * 1024;
      const float* g = gate + cond_of(row) * 3072;
      EPI_COLS(
        const int c = cb + fq * 4;
        f32x4 x = *(const f32x4*)&xr[c];
        f32x4 gg = *(const f32x4*)&g[c];
        f32x4 y;
        _Pragma("unroll") for (int j = 0; j < 4; ++j) y[j] = DN_ALPHA * x[j] + gg[j] * a[j];
        *(f32x4*)&Y[(size_t)row * 1024 + c] = y;
      ) )
  }
};

template <bool XIN_BF, bool XOUT_BF>
struct EpiResLn {
  static constexpr bool AFTER_DRAIN = true;
  const float* xin_p; const float* xin_s; const u16* xin_b; float* X; u16* XB; const float* gate; const float* lg; const float* lbias; const float* modn; u16* H;
  unsigned long long* slots; unsigned* cnt;
  __device__ __forceinline__ void fused(f32x4 (&acc)[2][2][4][2], const Unit& u, int wr, int wc, int fr, int fq, LAS unsigned char* lds) const {
    LAS float* part = (LAS float*)lds;
    LAS float* stat = part + 2048;
    const int tid = threadIdx.x;
    const int cnd = cond_of(u.pm * 256);
    f32x4 gv[2][2];
#pragma unroll
    for (int bj = 0; bj < 2; ++bj)
#pragma unroll
      for (int n = 0; n < 2; ++n) gv[bj][n] = *(const f32x4*)&gate[cnd * 3072 + u.pn * 256 + bj * 128 + wc * 32 + n * 16 + fq * 4];
#pragma unroll
    for (int ai = 0; ai < 2; ++ai)
#pragma unroll
      for (int m = 0; m < 4; ++m) {
        const int rl = ai * 128 + wr * 64 + m * 16 + fr;
        const int row = u.pm * 256 + rl;
        const float* xr = row < NPROMPT ? xin_p + (size_t)row * 1024 : xin_s + (size_t)(row - NPROMPT) * 1024;
        float s1 = 0.f, s2 = 0.f;
#pragma unroll
        for (int bj = 0; bj < 2; ++bj)
#pragma unroll
          for (int n = 0; n < 2; ++n) {
            const int c = u.pn * 256 + bj * 128 + wc * 32 + n * 16 + fq * 4;
            f32x4 x;
            if constexpr (XIN_BF) { const uint2 xb2 = *(const uint2*)&xin_b[(size_t)row * 1024 + c]; x = f32x4{lo16(xb2.x), hi16(xb2.x), lo16(xb2.y), hi16(xb2.y)}; }
            else x = *(const f32x4*)&xr[c];
            const f32x4 gg = gv[bj][n];
            f32x4 y;
#pragma unroll
            for (int j = 0; j < 4; ++j) { y[j] = DN_ALPHA * x[j] + gg[j] * acc[ai][bj][m][n][j]; s1 += y[j]; s2 += y[j] * y[j]; }
            acc[ai][bj][m][n] = y;
          }
        s1 += __shfl_xor(s1, 16); s1 += __shfl_xor(s1, 32);
        s2 += __shfl_xor(s2, 16); s2 += __shfl_xor(s2, 32);
        if (fq == 0) { part[(rl * 4 + wc) * 2] = s1; part[(rl * 4 + wc) * 2 + 1] = s2; }
      }
    __syncthreads();
    if (tid < 256) {
      float S1 = 0.f, S2 = 0.f;
#pragma unroll
      for (int w2 = 0; w2 < 4; ++w2) { S1 += part[(tid * 4 + w2) * 2]; S2 += part[(tid * 4 + w2) * 2 + 1]; }
      const unsigned long long v = (unsigned long long)__float_as_uint(S1) | ((unsigned long long)__float_as_uint(S2) << 32);
      __hip_atomic_store(&slots[(size_t)(u.pm * 4 + u.pn) * 256 + tid], v, __ATOMIC_RELAXED, __HIP_MEMORY_SCOPE_AGENT);
    }
    asm volatile("s_waitcnt vmcnt(0)" ::: "memory");
    __syncthreads();
    if (tid == 0) {
      __hip_atomic_fetch_add(&cnt[u.pm], 1u, __ATOMIC_RELAXED, __HIP_MEMORY_SCOPE_AGENT);
      unsigned sp = 0;
      while (__hip_atomic_load(&cnt[u.pm], __ATOMIC_RELAXED, __HIP_MEMORY_SCOPE_AGENT) < 4u) { __builtin_amdgcn_s_sleep(1); if (++sp > (1u << 24)) break; }
    }
    __syncthreads();
    if (tid < 256) {
      float T1 = 0.f, T2 = 0.f;
#pragma unroll
      for (int o = 0; o < 4; ++o) {
        const unsigned long long v = __hip_atomic_load(&slots[(size_t)(u.pm * 4 + o) * 256 + tid], __ATOMIC_RELAXED, __HIP_MEMORY_SCOPE_AGENT);
        T1 += __uint_as_float((unsigned)(v & 0xffffffffull)); T2 += __uint_as_float((unsigned)(v >> 32));
      }
      const float mu = T1 * (1.0f / 1024.0f);
      const float var = fmaxf(T2 * (1.0f / 1024.0f) - mu * mu, 0.f);
      stat[tid * 2] = mu; stat[tid * 2 + 1] = rsqrtf(var + 1e-5f);
    }
    __syncthreads();
#pragma unroll
    for (int bj = 0; bj < 2; ++bj) {
      f32x4 lgv[2], lbv[2], shv[2], scv[2];
#pragma unroll
      for (int n = 0; n < 2; ++n) {
        const int c = u.pn * 256 + bj * 128 + wc * 32 + n * 16 + fq * 4;
        lgv[n] = *(const f32x4*)&lg[c]; lbv[n] = *(const f32x4*)&lbias[c];
        shv[n] = *(const f32x4*)&modn[cnd * 3072 + c]; scv[n] = *(const f32x4*)&modn[cnd * 3072 + 1024 + c];
      }
#pragma unroll
      for (int ai = 0; ai < 2; ++ai)
#pragma unroll
        for (int m = 0; m < 4; ++m) {
          const int rl = ai * 128 + wr * 64 + m * 16 + fr;
          const int row = u.pm * 256 + rl;
          const float mu = stat[rl * 2], rs = stat[rl * 2 + 1];
#pragma unroll
          for (int n = 0; n < 2; ++n) {
            const int c = u.pn * 256 + bj * 128 + wc * 32 + n * 16 + fq * 4;
            const f32x4 y = acc[ai][bj][m][n];
            f32x4 xo;
#pragma unroll
            for (int j = 0; j < 4; ++j) xo[j] = (y[j] - mu) * rs * lgv[n][j] + lbv[n][j];
            if constexpr (XOUT_BF) *(uint2*)&XB[(size_t)row * 1024 + c] = pack4(xo[0], xo[1], xo[2], xo[3]);
            else *(f32x4*)&X[(size_t)row * 1024 + c] = xo;
            if (H) {
              *(uint2*)&H[(size_t)row * 1024 + c] = pack4(xo[0] * (1 + scv[n][0]) + shv[n][0], xo[1] * (1 + scv[n][1]) + shv[n][1], xo[2] * (1 + scv[n][2]) + shv[n][2], xo[3] * (1 + scv[n][3]) + shv[n][3]);
            }
          }
        }
    }
  }
};

struct EpiScIn {
  static constexpr bool AFTER_DRAIN = false;
  u16 *pb, *sb;
  __device__ __forceinline__ void operator()(AccRef acc, const Unit& u, int wr, int wc, int fr, int fq) const {
    const int c = u.pn * 64 + wc * 16 + fq * 4;
    EPI_ROWS(
      const f32x4 bg = acc[ai][0][m][0], cgv = acc[ai][0][m][1], v = acc[ai][1][m][0], g = acc[ai][1][m][1];
      *(uint2*)&pb[(size_t)row * 1024 + c] = pack4(cgv[0] * v[0], cgv[1] * v[1], cgv[2] * v[2], cgv[3] * v[3]);
      *(uint2*)&sb[(size_t)row * 1024 + c] = pack4(siluf_(g[0]) * bg[0], siluf_(g[1]) * bg[1], siluf_(g[2]) * bg[2], siluf_(g[3]) * bg[3]);
    )
  }
};

struct EpiRgIn {
  static constexpr bool AFTER_DRAIN = false;
  u16 *ub, *sg;
  __device__ __forceinline__ void operator()(AccRef acc, const Unit& u, int wr, int wc, int fr, int fq) const {
    const int region = u.pn >> 2;
    EPI_ROWS( EPI_COLS(
      const int c = (cb & 1023) + fq * 4;
      if (region == 0) *(uint2*)&ub[(size_t)row * 1024 + c] = pack4(a[0], a[1], a[2], a[3]);
      else *(uint2*)&sg[((size_t)(c >> 6) * TOK + row) * 64 + (c & 63)] = pack4(siluf_(a[0]), siluf_(a[1]), siluf_(a[2]), siluf_(a[3]));
    ) )
  }
};

struct EpiRgGate {
  static constexpr bool AFTER_DRAIN = false;
  u16 *rb, *ib; const float* bgate;
  __device__ __forceinline__ void operator()(AccRef acc, const Unit& u, int wr, int wc, int fr, int fq) const {
    const int mat = u.pn >> 1, d = mat >> 2, hd = mat & 3;
    f32x4 br[2], bi[2]; int ccs[2];
#pragma unroll
    for (int bj = 0; bj < 2; ++bj) {
      const int off = ((u.pn & 1) * 256 + bj * 128 + wc * 32);
      ccs[bj] = (off >> 5) * 16 + fq * 4;
      br[bj] = *(const f32x4*)&bgate[mat * 512 + ccs[bj]];
      bi[bj] = *(const f32x4*)&bgate[mat * 512 + 256 + ccs[bj]];
    }
    EPI_ROWS(
      _Pragma("unroll") for (int bj = 0; bj < 2; ++bj) {
        const f32x4 r = acc[ai][bj][m][0], ii = acc[ai][bj][m][1];
        const int cch = hd * 256 + ccs[bj];
        const size_t o = (size_t)d * TOK * 1024 + ((size_t)(cch >> 6) * TOK + row) * 64 + (cch & 63);
        *(uint2*)&rb[o] = pack4(sigmoidf_(r[0] + br[bj][0]), sigmoidf_(r[1] + br[bj][1]), sigmoidf_(r[2] + br[bj][2]), sigmoidf_(r[3] + br[bj][3]));
        *(uint2*)&ib[o] = pack4(sigmoidf_(ii[0] + bi[bj][0]), sigmoidf_(ii[1] + bi[bj][1]), sigmoidf_(ii[2] + bi[bj][2]), sigmoidf_(ii[3] + bi[bj][3]));
      } )
  }
};

struct EpiMlaIn {
  static constexpr bool AFTER_DRAIN = false;
  u16* cq; float* ckvraw; float* kperaw; u16* sg;
  __device__ __forceinline__ void operator()(AccRef acc, const Unit& u, int wr, int wc, int fr, int fq) const {
    EPI_ROWS( EPI_COLS(
      const int c = cb + fq * 4;
      if (cb < 384) *(uint2*)&cq[(size_t)row * 384 + c] = pack4(a[0], a[1], a[2], a[3]);
      else if (cb < 640) *(f32x4*)&ckvraw[(size_t)row * 256 + (c - 384)] = a;
      else if (cb < 672) *(f32x4*)&kperaw[(size_t)row * 32 + (c - 640)] = a;
    ) )
  }
};

struct EpiSg {
  static constexpr bool AFTER_DRAIN = false;
  u16* sg;
  __device__ __forceinline__ void operator()(AccRef acc, const Unit& u, int wr, int wc, int fr, int fq) const {
    EPI_ROWS( EPI_COLS(
      *(uint2*)&sg[(size_t)row * 1024 + cb + fq * 4] = pack4(a[0], a[1], a[2], a[3]);
    ) )
  }
};

struct EpiQ {
  static constexpr bool AFTER_DRAIN = false;
  u16* q;
  __device__ __forceinline__ void operator()(AccRef acc, const Unit& u, int wr, int wc, int fr, int fq) const {
    const float sc = 0.14724444500602648f;
    EPI_ROWS( EPI_COLS(
      *(uint2*)&q[(size_t)row * 1536 + cb + fq * 4] = pack4(a[0] * sc, a[1] * sc, a[2] * sc, a[3] * sc);
    ) )
  }
};

struct EpiK {
  static constexpr bool AFTER_DRAIN = false;
  u16* Kb;
  __device__ __forceinline__ void operator()(AccRef acc, const Unit& u, int wr, int wc, int fr, int fq) const {
    EPI_ROWS( EPI_COLS(
      const int h = cb >> 6, dd = (cb & 63) + fq * 4;
      *(uint2*)&Kb[((size_t)row * 16 + h) * 96 + dd] = pack4(a[0], a[1], a[2], a[3]);
    ) )
  }
};
struct EpiV {
  static constexpr bool AFTER_DRAIN = false;
  u16* Vt;
  __device__ __forceinline__ void operator()(AccRef acc, const Unit& u, int wr, int wc, int fr, int fq) const {
    EPI_ROWS( EPI_COLS(
      *(uint2*)&Vt[(size_t)row * KVROWS + cb + fq * 4] = pack4(a[0], a[1], a[2], a[3]);
    ) )
  }
};

__device__ __forceinline__ void wconv_tile(const float* __restrict__ src, int N, int K, u16* __restrict__ dst, int k0, int n0,
                                           int perm, int mat, float* tile) {
  const int tid = threadIdx.x;
  {
    const int r = tid >> 4, c4 = (tid & 15) * 4;
#pragma unroll
    for (int i = 0; i < 2; ++i) {
      const int k = r + i * 32;
      f32x4 v = f32x4{0.f, 0.f, 0.f, 0.f};
      if (n0 + c4 < N) v = *(const f32x4*)&src[(size_t)(k0 + k) * N + n0 + c4];
      tile[k * 65 + c4 + 0] = v[0]; tile[k * 65 + c4 + 1] = v[1]; tile[k * 65 + c4 + 2] = v[2]; tile[k * 65 + c4 + 3] = v[3];
    }
  }
  __syncthreads();
  {
    const int nl = tid >> 3, kq = (tid & 7) * 8;
    const int n = n0 + nl;
    int np = n;
    if (perm == 1) { const int part = n >> 10, c = n & 1023; np = (c >> 6) * 256 + (part >> 1) * 128 + ((c >> 4) & 3) * 32 + (part & 1) * 16 + (c & 15); }
    else if (perm == 2) { const int type = n >> 8, cc = n & 255; np = mat * 512 + (cc >> 4) * 32 + type * 16 + (cc & 15); }
    else if (perm == 3) { const int hh = n >> 7, dd = n & 127; np = (dd >= 64 ? 1024 : 0) + hh * 64 + (dd & 63); }
    if (n < N) {
      unsigned w[4];
#pragma unroll
      for (int i = 0; i < 4; ++i) w[i] = pack2(tile[(kq + 2 * i) * 65 + nl], tile[(kq + 2 * i + 1) * 65 + nl]);
      *(uint4*)&dst[(size_t)np * K + k0 + kq] = make_uint4(w[0], w[1], w[2], w[3]);
    }
  }
  __syncthreads();
}

__device__ __forceinline__ void wconv_item(const Params& p, int t, float* fs) {
  const float* src; u16* dst; int N, K, perm = 0, mat = 0, ntn;
  if (t < 1280) { src = p.in[12]; dst = (u16*)(p.ws + WS_W_HG_IN); N = 5120; K = 1024; }
  else if ((t -= 1280) < 256) { src = p.in[15]; dst = (u16*)(p.ws + WS_W_HG_OUT); N = 1024; K = 1024; }
  else if ((t -= 256) < 1024) { src = p.in[16]; dst = (u16*)(p.ws + WS_W_SC_IN); N = 4096; K = 1024; perm = 1; }
  else if ((t -= 1024) < 256) { src = p.in[19]; dst = (u16*)(p.ws + WS_W_SC_OUT); N = 1024; K = 1024; }
  else if ((t -= 256) < 512) { src = p.in[20]; dst = (u16*)(p.ws + WS_W_RG_IN); N = 2048; K = 1024; }
  else if ((t -= 512) < 256) { mat = t >> 5; t &= 31; src = p.in[23] + (size_t)mat * 256 * 512; dst = (u16*)(p.ws + WS_W_RG_GATE); N = 512; K = 256; perm = 2; }
  else if ((t -= 256) < 256) { src = p.in[26]; dst = (u16*)(p.ws + WS_W_RG_OUT); N = 1024; K = 1024; }
  else if ((t -= 256) < 432) { src = p.in[27]; dst = (u16*)(p.ws + WS_W_MLA_IN); N = 1696; K = 1024; }
  else if ((t -= 432) < 144) { src = p.in[30]; dst = (u16*)(p.ws + WS_W_QB); N = 1536; K = 384; }
  else if ((t -= 144) < 128) { src = p.in[31]; dst = (u16*)(p.ws + WS_W_KVB); N = 2048; K = 256; perm = 3; }
  else { t -= 128; src = p.in[32]; dst = (u16*)(p.ws + WS_W_MLA_OUT); N = 1024; K = 1024; }
  ntn = (N + 63) >> 6;
  const int kt = t / ntn, ntl = t - kt * ntn;
  wconv_tile(src, N, K, dst, kt * 64, ntl * 64, perm, mat, fs);
}
__device__ __forceinline__ void wconv_idle(const Params& p, unsigned char* smem_raw, int bid, int nb, int t0, int t1) {
  if (nb == 256 && bid >= 192) for (int t = t0 + (bid - 192); t < t1; t += 64) wconv_item(p, t, (float*)smem_raw);
}

__device__ __forceinline__ void phase_prologue(const Params& p, unsigned char* smem_raw, int bid, int nb) {
  float* fs = (float*)smem_raw;
  const int tid = threadIdx.x;
  const int NMOD = 192, NWT = (nb == 256) ? 1536 : 4800;
  for (int it = bid; it < NMOD + 1 + NWT; it += nb) {
    if (it < NMOD) {
      const int l = it / 48, n0 = (it % 48) * 64;
      float* scond = fs;
      float* sred = fs + 5120;
      for (int i = tid; i < 5120; i += NT) {
        const int ci = i >> 10, k = i & 1023;
        float cv = ci == 0 ? p.in[7][k] : p.in[6][(ci - 1) * 1024 + k];
        scond[i] = siluf_(cv);
      }
      __syncthreads();
      const int col = tid & 63, kg = tid >> 6;
      const float* w = p.in[8] + (size_t)l * 1024 * 3072 + n0 + col;
      float a0 = 0, a1 = 0, a2 = 0, a3 = 0, a4 = 0;
#pragma unroll 16
      for (int k = kg * 128; k < kg * 128 + 128; ++k) {
        float wv = w[(size_t)k * 3072];
        a0 += scond[k] * wv; a1 += scond[1024 + k] * wv; a2 += scond[2048 + k] * wv; a3 += scond[3072 + k] * wv; a4 += scond[4096 + k] * wv;
      }
      sred[(kg * 5 + 0) * 64 + col] = a0; sred[(kg * 5 + 1) * 64 + col] = a1; sred[(kg * 5 + 2) * 64 + col] = a2;
      sred[(kg * 5 + 3) * 64 + col] = a3; sred[(kg * 5 + 4) * 64 + col] = a4;
      __syncthreads();
      float* mod = (float*)(p.ws + WS_MOD);
      if (tid < 320) {
        const int ci = tid >> 6, cc = tid & 63;
        float s = 0;
#pragma unroll
        for (int g = 0; g < 8; ++g) s += sred[(g * 5 + ci) * 64 + cc];
        mod[(l * 5 + ci) * 3072 + n0 + cc] = s + p.in[9][l * 3072 + n0 + cc];
      }
      __syncthreads();
    } else if (it == NMOD) {
      float* lb = (float*)(p.ws + WS_LB);
      for (int i = tid; i < 2048; i += NT) {
        const int d = i >> 10, c = i & 1023;
        const float* lg = p.in[13] + d * 5 * 1024 + c;
        float m = lg[0];
        for (int j = 1; j < 5; ++j) m = fmaxf(m, lg[j * 1024]);
        float s = 0;
        for (int j = 0; j < 5; ++j) s += expf(lg[j * 1024] - m);
        lb[i] = expf(lg[0] - m) / s;
      }
      int* cnt = (int*)(p.ws + WS_CNT);
      if (tid < 16) cnt[tid] = 0;
    } else {
      wconv_item(p, it - NMOD - 1, fs);
    }
  }
}

__device__ __forceinline__ void phase_h0(const Params& p, int bid, int nb) {
  const float* mod = (const float*)(p.ws + WS_MOD);
  u16* H = (u16*)(p.ws + WS_H);
  const size_t total = (size_t)(TOK / 4) * 256;
  for (size_t i = (size_t)bid * NT + threadIdx.x; i < total; i += (size_t)nb * NT) {
    const int row = (int)(i >> 8) * 4, c = ((int)i & 255) * 4;
    const float* xr = row < NPROMPT ? p.in[0] + (size_t)row * 1024 : p.in[1] + (size_t)(row - NPROMPT) * 1024;
    const float* m = mod + cond_of(row) * 3072;
    f32x4 x[4];
#pragma unroll
    for (int t = 0; t < 4; ++t) x[t] = *(const f32x4*)&xr[t * 1024 + c];
    const f32x4 sh = *(const f32x4*)&m[c];
    const f32x4 sc = *(const f32x4*)&m[1024 + c];
#pragma unroll
    for (int t = 0; t < 4; ++t)
      *(uint2*)&H[(size_t)(row + t) * 1024 + c] = pack4(x[t][0] * (1 + sc[0]) + sh[0], x[t][1] * (1 + sc[1]) + sh[1], x[t][2] * (1 + sc[2]) + sh[2], x[t][3] * (1 + sc[3]) + sh[3]);
  }
}

__device__ __forceinline__ void phase_ln(const Params& p, int l, int bid, int nb) {
  float* X = p.out;
  const float* g = p.in[10] + l * 1024;
  const float* b = p.in[11] + l * 1024;
  const float* mod = (const float*)(p.ws + WS_MOD) + (l + 1) * 5 * 3072;
  u16* H = (u16*)(p.ws + WS_H);
  const int lane = threadIdx.x & 63, wave = threadIdx.x >> 6;
  for (int row = bid * NW + wave; row < TOK; row += nb * NW) {
    float* xr = X + (size_t)row * 1024;
    f32x4 v[4];
    float s = 0;
#pragma unroll
    for (int i = 0; i < 4; ++i) { v[i] = *(const f32x4*)&xr[i * 256 + lane * 4]; s += v[i][0] + v[i][1] + v[i][2] + v[i][3]; }
    const float mu = wave_sum(s) * (1.0f / 1024.0f);
    float q = 0;
#pragma unroll
    for (int i = 0; i < 4; ++i)
#pragma unroll
      for (int j = 0; j < 4; ++j) { float dd = v[i][j] - mu; q += dd * dd; }
    const float rs = rsqrtf(wave_sum(q) * (1.0f / 1024.0f) + 1e-5f);
    const float* m = mod + cond_of(row) * 3072;
#pragma unroll
    for (int i = 0; i < 4; ++i) {
      const int c = i * 256 + lane * 4;
      f32x4 gg = *(const f32x4*)&g[c], bb = *(const f32x4*)&b[c];
      f32x4 y;
#pragma unroll
      for (int j = 0; j < 4; ++j) y[j] = (v[i][j] - mu) * rs * gg[j] + bb[j];
      *(f32x4*)&xr[c] = y;
      if (l < 3) {
        f32x4 sh = *(const f32x4*)&m[c], sc = *(const f32x4*)&m[1024 + c];
        *(uint2*)&H[(size_t)row * 1024 + c] = pack4(y[0] * (1 + sc[0]) + sh[0], y[1] * (1 + sc[1]) + sh[1], y[2] * (1 + sc[2]) + sh[2], y[3] * (1 + sc[3]) + sh[3]);
      }
    }
  }
}

__device__ __forceinline__ void phase_gla(const Params& p, unsigned char* smem_raw) {
  u16* s_qrel = (u16*)smem_raw;
  u16* s_krel = s_qrel + 32 * 136;
  u16* s_qcum = s_krel + 32 * 136;
  u16* s_kdT = s_qcum + 32 * 136;
  u16* s_vT = s_kdT + 128 * 40;
  u16* s_att = s_vT + 64 * 40;
  u16* s_S = s_att + 32 * 40;
  float* s_dec = (float*)(s_S + 64 * 136);
  float* s_part = s_dec + 128;
  int* s_u = (int*)(s_part + 512);
  int* counter = (int*)(p.ws + WS_CNT);
  const u16* qg = (const u16*)(p.ws + WS_B(0));
  const u16* vg = (const u16*)(p.ws + WS_B(1));
  const _Float16* lfg = (const _Float16*)(p.ws + WS_B(3));
  u16* og = (u16*)(p.ws + WS_B(5));
  const int tid = threadIdx.x, lane = tid & 63, w = tid >> 6, fr = lane & 15, fq = lane >> 4;
  const int kk = tid & 127, th = tid >> 7;
  const int ti = w >> 2, vi = w & 3;
  const int wk = w & 3, wv = w >> 2;
  while (true) {
    if (tid == 0) *s_u = atomicAdd(counter, 1);
    __syncthreads();
    const int u = *s_u;
    __syncthreads();
    if (u >= 1152) break;
    int b, rem, start, N, sample;
    if (u < 128) { sample = 1; b = u >> 5; rem = u & 31; start = NPROMPT + b * 1024; N = 1024; }
    else { sample = 0; b = (u - 128) >> 5; rem = (u - 128) & 31; start = b * 256; N = 256; }
    const int h = rem >> 2, d = (rem >> 1) & 1, vs = rem & 1;
    const int nc = N >> 5;
    f32x4 S[2][2];
#pragma unroll
    for (int mi = 0; mi < 2; ++mi)
#pragma unroll
      for (int ni = 0; ni < 2; ++ni) {
        f32x4 s4 = f32x4{0.f, 0.f, 0.f, 0.f};
        if (sample) {
          const float* s0 = p.in[2] + ((size_t)((b * 2 + d) * 8 + h)) * 16384;
#pragma unroll
          for (int j = 0; j < 4; ++j) s4[j] = s0[(wk * 32 + mi * 16 + fq * 4 + j) * 128 + vs * 64 + wv * 32 + ni * 16 + fr];
        }
        S[mi][ni] = s4;
        *(uint2*)&s_S[(wv * 32 + ni * 16 + fr) * 136 + wk * 32 + mi * 16 + fq * 4] = pack4(s4[0], s4[1], s4[2], s4[3]);
      }
    _Float16 lfraw[8]; u16 qraw[8]; uint2 vraw;
#define GLA_LOAD(cc) do { _Pragma("unroll") for (int i = 0; i < 8; ++i) { const int tt = (cc) * 32 + th * 8 + i; const size_t tok = start + (d ? (N - 1 - tt) : tt); \
      lfraw[i] = lfg[tok * 2048 + d * 1024 + h * 128 + kk]; qraw[i] = qg[tok * 1024 + h * 128 + kk]; } \
      { const int tt = (cc) * 32 + (tid >> 4); const size_t tok = start + (d ? (N - 1 - tt) : tt); vraw = *(const uint2*)&vg[tok * 1024 + h * 128 + vs * 64 + (tid & 15) * 4]; } } while (0)
    GLA_LOAD(0);
    for (int c = 0; c < nc; ++c) {
      {
        float lfv[8], qv[8];
#pragma unroll
        for (int i = 0; i < 8; ++i) { lfv[i] = (float)lfraw[i]; qv[i] = bf2f(qraw[i]); }
        const uint2 vv = vraw;
        if (c + 1 < nc) GLA_LOAD(c + 1);
        float run = 0;
        float cs[8];
#pragma unroll
        for (int i = 0; i < 8; ++i) { run += lfv[i]; cs[i] = run; }
        s_part[th * 128 + kk] = run;
        {
          const int s = tid >> 4, v4 = (tid & 15) * 4;
          s_vT[(v4 + 0) * 40 + s] = (u16)(vv.x & 0xffff); s_vT[(v4 + 1) * 40 + s] = (u16)(vv.x >> 16);
          s_vT[(v4 + 2) * 40 + s] = (u16)(vv.y & 0xffff); s_vT[(v4 + 3) * 40 + s] = (u16)(vv.y >> 16);
        }
        __syncthreads();
        const float p0 = s_part[kk], p1 = s_part[128 + kk], p2 = s_part[256 + kk], p3 = s_part[384 + kk];
        const float off = (th > 0 ? p0 : 0.f) + (th > 1 ? p1 : 0.f) + (th > 2 ? p2 : 0.f);
        const float ref = p0 + p1, total = p0 + p1 + p2 + p3;
        unsigned kd[4];
        const float eref = __expf(ref), etr = __expf(total - ref);
#pragma unroll
        for (int i = 0; i < 8; ++i) {
          const int t = th * 8 + i;
          const float cum = off + cs[i];
          const float kf = 1.0f - __expf(lfv[i]);
          const float e1 = __expf(cum - ref), e2 = __builtin_amdgcn_rcpf(e1);
          const float qe = qv[i] * e1, ke = kf * e2;
          s_qrel[t * 136 + kk] = f2bf(qe);
          s_krel[t * 136 + kk] = f2bf(ke);
          s_qcum[t * 136 + kk] = f2bf(qe * eref);
          const u16 kdv = f2bf(ke * etr);
          if (i & 1) kd[i >> 1] |= ((unsigned)kdv) << 16; else kd[i >> 1] = kdv;
        }
        *(uint4*)&s_kdT[kk * 40 + th * 8] = make_uint4(kd[0], kd[1], kd[2], kd[3]);
        if (th == 0) s_dec[kk] = __expf(total);
      }
      __syncthreads();
      f32x4 oacc = f32x4{0.f, 0.f, 0.f, 0.f};
      {
        f32x4 att = f32x4{0.f, 0.f, 0.f, 0.f};
        const int ati = w >> 1, asi = w & 1;
#pragma unroll
        for (int ks = 0; ks < 4; ++ks) {
          if (w < 4) {
            bf16x8 a = *(const bf16x8*)&s_qrel[(ati * 16 + fr) * 136 + ks * 32 + fq * 8];
            bf16x8 bb = *(const bf16x8*)&s_krel[(asi * 16 + fr) * 136 + ks * 32 + fq * 8];
            att = __builtin_amdgcn_mfma_f32_16x16x32_bf16(a, bb, att, 0, 0, 0);
          }
          bf16x8 a2 = *(const bf16x8*)&s_qcum[(ti * 16 + fr) * 136 + ks * 32 + fq * 8];
          bf16x8 b2 = *(const bf16x8*)&s_S[(vi * 16 + fr) * 136 + ks * 32 + fq * 8];
          oacc = __builtin_amdgcn_mfma_f32_16x16x32_bf16(a2, b2, oacc, 0, 0, 0);
        }
        if (w < 4) {
#pragma unroll
          for (int j = 0; j < 4; ++j) {
            const int t = ati * 16 + fq * 4 + j, s = asi * 16 + fr;
            s_att[t * 40 + s] = (s <= t) ? f2bf(att[j]) : (u16)0;
          }
        }
      }
      __syncthreads();
      {
        bf16x8 a = *(const bf16x8*)&s_att[(ti * 16 + fr) * 40 + fq * 8];
        bf16x8 bb = *(const bf16x8*)&s_vT[(vi * 16 + fr) * 40 + fq * 8];
        oacc = __builtin_amdgcn_mfma_f32_16x16x32_bf16(a, bb, oacc, 0, 0, 0);
#pragma unroll
        for (int j = 0; j < 4; ++j) {
          const int tt = c * 32 + ti * 16 + fq * 4 + j;
          const size_t tok = start + (d ? (N - 1 - tt) : tt);
          og[((size_t)d * TOK + tok) * 1024 + h * 128 + vs * 64 + vi * 16 + fr] = f2bf(oacc[j]);
        }
        bf16x8 vf[2];
#pragma unroll
        for (int ni = 0; ni < 2; ++ni) vf[ni] = *(const bf16x8*)&s_vT[(wv * 32 + ni * 16 + fr) * 40 + fq * 8];
#pragma unroll
        for (int mi = 0; mi < 2; ++mi) {
          bf16x8 kf = *(const bf16x8*)&s_kdT[(wk * 32 + mi * 16 + fr) * 40 + fq * 8];
          f32x4 dc = *(const f32x4*)&s_dec[wk * 32 + mi * 16 + fq * 4];
#pragma unroll
          for (int ni = 0; ni < 2; ++ni) {
            f32x4 s4 = S[mi][ni];
#pragma unroll
            for (int j = 0; j < 4; ++j) s4[j] *= dc[j];
            s4 = __builtin_amdgcn_mfma_f32_16x16x32_bf16(kf, vf[ni], s4, 0, 0, 0);
            S[mi][ni] = s4;
            *(uint2*)&s_S[(wv * 32 + ni * 16 + fr) * 136 + wk * 32 + mi * 16 + fq * 4] = pack4(s4[0], s4[1], s4[2], s4[3]);
          }
        }
      }
      __syncthreads();
    }
    if (!sample) {
      float* so = p.out + OUT_HG + ((size_t)((b * 2 + d) * 8 + h)) * 16384;
#pragma unroll
      for (int mi = 0; mi < 2; ++mi)
#pragma unroll
        for (int ni = 0; ni < 2; ++ni)
#pragma unroll
          for (int j = 0; j < 4; ++j) so[(wk * 32 + mi * 16 + fq * 4 + j) * 128 + vs * 64 + wv * 32 + ni * 16 + fr] = S[mi][ni][j];
    }
  }
}

__device__ __forceinline__ void phase_hg_post(const Params& p, int bid, int nb) {
  const u16* og = (const u16*)(p.ws + WS_B(5));
  const u16* sg = (const u16*)(p.ws + WS_B(2));
  u16* a = (u16*)(p.ws + WS_B(0));
  const float* ng = p.in[14];
  const int lane = threadIdx.x & 63, wave = threadIdx.x >> 6;
  float ngv[16];
#pragma unroll
  for (int k = 0; k < 4; ++k) { const f32x4 t = *(const f32x4*)&ng[lane * 16 + 4 * k]; ngv[4 * k] = t[0]; ngv[4 * k + 1] = t[1]; ngv[4 * k + 2] = t[2]; ngv[4 * k + 3] = t[3]; }
  for (int row0 = (bid * NW + wave) * 2; row0 < TOK; row0 += nb * NW * 2) {
    uint4 f[2][2], bw[2][2], sv[2][2];
#pragma unroll
    for (int r = 0; r < 2; ++r)
#pragma unroll
      for (int hh = 0; hh < 2; ++hh) {
        const size_t base = (size_t)(row0 + r) * 1024 + lane * 16 + hh * 8;
        f[r][hh] = *(const uint4*)&og[base];
        bw[r][hh] = *(const uint4*)&og[(size_t)TOK * 1024 + base];
        sv[r][hh] = *(const uint4*)&sg[base];
      }
#pragma unroll
    for (int r = 0; r < 2; ++r) {
      float o[16];
      float ss = 0;
#pragma unroll
      for (int hh = 0; hh < 2; ++hh) {
        const unsigned fa[4] = {f[r][hh].x, f[r][hh].y, f[r][hh].z, f[r][hh].w}, ba[4] = {bw[r][hh].x, bw[r][hh].y, bw[r][hh].z, bw[r][hh].w};
#pragma unroll
        for (int i = 0; i < 4; ++i) {
          o[hh * 8 + 2 * i] = lo16(fa[i]) + lo16(ba[i]);
          o[hh * 8 + 2 * i + 1] = hi16(fa[i]) + hi16(ba[i]);
        }
      }
#pragma unroll
      for (int i = 0; i < 16; ++i) ss += o[i] * o[i];
      ss += __shfl_xor(ss, 1); ss += __shfl_xor(ss, 2); ss += __shfl_xor(ss, 4);
      const float rs = rsqrtf(ss * (1.0f / 128.0f) + 1e-6f);
#pragma unroll
      for (int hh = 0; hh < 2; ++hh) {
        const unsigned sa[4] = {sv[r][hh].x, sv[r][hh].y, sv[r][hh].z, sv[r][hh].w};
        unsigned rr[4];
#pragma unroll
        for (int i = 0; i < 4; ++i)
          rr[i] = pack2(o[hh * 8 + 2 * i] * rs * ngv[hh * 8 + 2 * i] * siluf_(lo16(sa[i])), o[hh * 8 + 2 * i + 1] * rs * ngv[hh * 8 + 2 * i + 1] * siluf_(hi16(sa[i])));
        *(uint4*)&a[(size_t)(row0 + r) * 1024 + lane * 16 + hh * 8] = make_uint4(rr[0], rr[1], rr[2], rr[3]);
      }
    }
  }
}

__device__ __forceinline__ void seq_pos(int tok, int& n, int& L) {
  if (tok < NPROMPT) { n = tok & 255; L = 256; } else { n = (tok - NPROMPT) & 1023; L = 1024; }
}
__device__ __forceinline__ void phase_sc_conv(const Params& p, int bid, int nb) {
  const u16* pb = (const u16*)(p.ws + WS_B(0));
  const u16* sb = (const u16*)(p.ws + WS_B(1));
  u16* a = (u16*)(p.ws + WS_B(2));
  const float* cw = p.in[17]; const float* cbias = p.in[18];
  const size_t total = (size_t)TOK * 128;
  const size_t i0 = (size_t)bid * NT + threadIdx.x;
  const int c = ((int)i0 & 127) * 8;
  float w0[8], w1[8], w2[8], wb[8];
#pragma unroll
  for (int k = 0; k < 2; ++k) {
    const f32x4 t0 = *(const f32x4*)&cw[c + 4 * k], t1 = *(const f32x4*)&cw[1024 + c + 4 * k], t2 = *(const f32x4*)&cw[2048 + c + 4 * k], tb = *(const f32x4*)&cbias[c + 4 * k];
#pragma unroll
    for (int j = 0; j < 4; ++j) { w0[4 * k + j] = t0[j]; w1[4 * k + j] = t1[j]; w2[4 * k + j] = t2[j]; wb[4 * k + j] = tb[j]; }
  }
  const uint4 z = make_uint4(0, 0, 0, 0);
  for (size_t i = i0; i < total / 4; i += (size_t)nb * NT) {
    const int tok = (int)(i >> 7) * 4;
    int n, L; seq_pos(tok, n, L);
    const size_t base = (size_t)tok * 1024 + c;
    uint4 q[6], sv[4];
    q[0] = n > 0 ? *(const uint4*)&pb[base - 1024] : z;
#pragma unroll
    for (int t = 0; t < 4; ++t) { q[1 + t] = *(const uint4*)&pb[base + t * 1024]; sv[t] = *(const uint4*)&sb[base + t * 1024]; }
    q[5] = n + 4 < L ? *(const uint4*)&pb[base + 4096] : z;
#pragma unroll
    for (int t = 0; t < 4; ++t) {
      const unsigned am[4] = {q[t].x, q[t].y, q[t].z, q[t].w}, a0[4] = {q[t + 1].x, q[t + 1].y, q[t + 1].z, q[t + 1].w};
      const unsigned ap[4] = {q[t + 2].x, q[t + 2].y, q[t + 2].z, q[t + 2].w}, as[4] = {sv[t].x, sv[t].y, sv[t].z, sv[t].w};
      unsigned r[4];
#pragma unroll
      for (int k = 0; k < 4; ++k) {
        float z0 = w0[2 * k] * lo16(am[k]) + w1[2 * k] * lo16(a0[k]) + w2[2 * k] * lo16(ap[k]) + wb[2 * k];
        float z1 = w0[2 * k + 1] * hi16(am[k]) + w1[2 * k + 1] * hi16(a0[k]) + w2[2 * k + 1] * hi16(ap[k]) + wb[2 * k + 1];
        r[k] = pack2(lo16(as[k]) * z0, hi16(as[k]) * z1);
      }
      *(uint4*)&a[base + t * 1024] = make_uint4(r[0], r[1], r[2], r[3]);
    }
  }
}
__device__ __forceinline__ void phase_rg_conv(const Params& p, int bid, int nb) {
  const u16* ub = (const u16*)(p.ws + WS_B(0));
  u16* uc = (u16*)(p.ws + WS_B(2));
  const float* cw = p.in[21]; const float* cbias = p.in[22];
  const size_t total = (size_t)TOK * 128;
  const size_t i0 = (size_t)bid * NT + threadIdx.x;
  const int c = ((int)i0 & 127) * 8;
  float w0[8], w1[8], w2[8], w3[8], wb[8];
#pragma unroll
  for (int k = 0; k < 2; ++k) {
    const f32x4 t0 = *(const f32x4*)&cw[c + 4 * k], t1 = *(const f32x4*)&cw[1024 + c + 4 * k], t2 = *(const f32x4*)&cw[2048 + c + 4 * k], t3 = *(const f32x4*)&cw[3072 + c + 4 * k], tb = *(const f32x4*)&cbias[c + 4 * k];
#pragma unroll
    for (int j = 0; j < 4; ++j) { w0[4 * k + j] = t0[j]; w1[4 * k + j] = t1[j]; w2[4 * k + j] = t2[j]; w3[4 * k + j] = t3[j]; wb[4 * k + j] = tb[j]; }
  }
  const uint4 z = make_uint4(0, 0, 0, 0);
  for (size_t i = i0; i < total / 4; i += (size_t)nb * NT) {
    const int tok = (int)(i >> 7) * 4;
    int n, L; seq_pos(tok, n, L);
    const size_t base = (size_t)tok * 1024 + c;
    uint4 q[7];
    q[0] = n > 1 ? *(const uint4*)&ub[base - 2048] : z;
    q[1] = n > 0 ? *(const uint4*)&ub[base - 1024] : z;
#pragma unroll
    for (int t = 0; t < 4; ++t) q[2 + t] = *(const uint4*)&ub[base + t * 1024];
    q[6] = n + 4 < L ? *(const uint4*)&ub[base + 4096] : z;
#pragma unroll
    for (int t = 0; t < 4; ++t) {
      const unsigned a0[4] = {q[t].x, q[t].y, q[t].z, q[t].w}, a1[4] = {q[t + 1].x, q[t + 1].y, q[t + 1].z, q[t + 1].w};
      const unsigned a2[4] = {q[t + 2].x, q[t + 2].y, q[t + 2].z, q[t + 2].w}, a3[4] = {q[t + 3].x, q[t + 3].y, q[t + 3].z, q[t + 3].w};
      unsigned r[4];
#pragma unroll
      for (int k = 0; k < 4; ++k) {
        float z0 = w0[2 * k] * lo16(a0[k]) + w1[2 * k] * lo16(a1[k]) + w2[2 * k] * lo16(a2[k]) + w3[2 * k] * lo16(a3[k]) + wb[2 * k];
        float z1 = w0[2 * k + 1] * hi16(a0[k]) + w1[2 * k + 1] * hi16(a1[k]) + w2[2 * k + 1] * hi16(a2[k]) + w3[2 * k + 1] * hi16(a3[k]) + wb[2 * k + 1];
        r[k] = pack2(z0, z1);
      }
      *(uint4*)&uc[((size_t)(c >> 6) * TOK + tok + t) * 64 + (c & 63)] = make_uint4(r[0], r[1], r[2], r[3]);
    }
  }
}

__device__ __forceinline__ void phase_rg_scan(const Params& p, unsigned char* smem_raw, int bid, int nb) {
  float* sA = (float*)smem_raw;
  float* sB = sA + 2048;
  const u16* rb = (const u16*)(p.ws + WS_B(3));
  const u16* ib = (const u16*)(p.ws + WS_B(5));
  const u16* uc = (const u16*)(p.ws + WS_B(2));
  const u16* sg = (const u16*)(p.ws + WS_B(1));
  u16* hfw = (u16*)(p.ws + WS_H);
  u16* yp = (u16*)(p.ws + WS_B(0));
  const int tid = threadIdx.x;
  for (int u = bid; u < 768; u += nb) {
    int sample, b, c, seg, nseg, start, chs, slot;
    if (u < 256) {
      const int xq = u & 7, yq = u >> 3, gid = (yq >> 2) * 8 + xq, sub = yq & 3;
      sample = 1; b = gid >> 4; slot = (tid & 3) * 4; c = (gid & 15) * 64 + sub * 16 + slot; seg = tid >> 2; nseg = 128; start = NPROMPT + b * 1024; chs = 16; }
    else { sample = 0; b = (u - 256) >> 4; slot = (tid & 15) * 4; c = ((u - 256) & 15) * 64 + slot; seg = tid >> 4; nseg = 32; start = b * 256; chs = 64; }
    const int L = nseg * 8;
#pragma unroll 1
    for (int d = 0; d < 2; ++d) {
      const f32x4 lam = *(const f32x4*)&p.in[25][d * 1024 + c];
      float cl[4];
#pragma unroll
      for (int j = 0; j < 4; ++j) cl[j] = 8.0f * log1pf(__expf(-lam[j]));
      const u16* rp = rb + (size_t)d * TOK * 1024;
      const u16* ip = ib + (size_t)d * TOK * 1024;
      const int tok0 = start + (d ? L - 1 - seg * 8 : seg * 8);
      const size_t o0 = (size_t)tok0 * 1024 + c;
      const long ostep = d ? -1024 : 1024;
      const size_t g0 = ((size_t)(c >> 6) * TOK + tok0) * 64 + (c & 63);
      const long gstep = d ? -64 : 64;
      uint2 rr[8], ii[8], uu[8];
#pragma unroll
      for (int s8 = 0; s8 < 8; ++s8) { rr[s8] = *(const uint2*)&rp[g0 + s8 * gstep]; ii[s8] = *(const uint2*)&ip[g0 + s8 * gstep]; uu[s8] = *(const uint2*)&uc[g0 + s8 * gstep]; }
      uint2 hf[8], sgv[8];
      if (d == 1) {
#pragma unroll
        for (int s8 = 0; s8 < 8; ++s8) { hf[s8] = *(const uint2*)&hfw[g0 + s8 * gstep]; sgv[s8] = *(const uint2*)&sg[g0 + s8 * gstep]; }
      }
      float av[8][4], xv[8][4];
      float A[4] = {1.f, 1.f, 1.f, 1.f}, B[4] = {0.f, 0.f, 0.f, 0.f};
#pragma unroll
      for (int s8 = 0; s8 < 8; ++s8) {
        const float r4[4] = {lo16(rr[s8].x), hi16(rr[s8].x), lo16(rr[s8].y), hi16(rr[s8].y)};
        const float i4[4] = {lo16(ii[s8].x), hi16(ii[s8].x), lo16(ii[s8].y), hi16(ii[s8].y)};
        const float u4[4] = {lo16(uu[s8].x), hi16(uu[s8].x), lo16(uu[s8].y), hi16(uu[s8].y)};
#pragma unroll
        for (int j = 0; j < 4; ++j) {
          const float la = -cl[j] * r4[j];
          const float a = __expf(la);
          const float xin = __builtin_amdgcn_sqrtf(fmaxf(1.0f - __expf(2.0f * la), 0.f)) * (i4[j] * u4[j]);
          av[s8][j] = a; xv[s8][j] = xin;
          A[j] *= a; B[j] = a * B[j] + xin;
        }
      }
      *(f32x4*)&sA[seg * chs + slot] = f32x4{A[0], A[1], A[2], A[3]};
      *(f32x4*)&sB[seg * chs + slot] = f32x4{B[0], B[1], B[2], B[3]};
      for (int k = 1; k < nseg; k <<= 1) {
        __syncthreads();
        f32x4 pa = f32x4{1.f, 1.f, 1.f, 1.f}, pb2 = f32x4{0.f, 0.f, 0.f, 0.f};
        if (seg >= k) { pa = *(const f32x4*)&sA[(seg - k) * chs + slot]; pb2 = *(const f32x4*)&sB[(seg - k) * chs + slot]; }
        __syncthreads();
        if (seg >= k) {
#pragma unroll
          for (int j = 0; j < 4; ++j) { B[j] = A[j] * pb2[j] + B[j]; A[j] = A[j] * pa[j]; }
          *(f32x4*)&sA[seg * chs + slot] = f32x4{A[0], A[1], A[2], A[3]};
          *(f32x4*)&sB[seg * chs + slot] = f32x4{B[0], B[1], B[2], B[3]};
        }
      }
      __syncthreads();
      float h[4];
      {
        f32x4 h0v = f32x4{0.f, 0.f, 0.f, 0.f};
        if (sample) h0v = *(const f32x4*)&p.in[3][(b * 2 + d) * 1024 + c];
        if (seg > 0) {
          const f32x4 pa = *(const f32x4*)&sA[(seg - 1) * chs + slot], pb2 = *(const f32x4*)&sB[(seg - 1) * chs + slot];
#pragma unroll
          for (int j = 0; j < 4; ++j) h[j] = pa[j] * h0v[j] + pb2[j];
        } else {
#pragma unroll
          for (int j = 0; j < 4; ++j) h[j] = h0v[j];
        }
      }
#pragma unroll
      for (int s8 = 0; s8 < 8; ++s8) {
#pragma unroll
        for (int j = 0; j < 4; ++j) h[j] = av[s8][j] * h[j] + xv[s8][j];
        const size_t o = o0 + s8 * ostep;
        if (d == 0) *(uint2*)&hfw[g0 + s8 * gstep] = pack4(h[0], h[1], h[2], h[3]);
        else *(uint2*)&yp[g0 + s8 * gstep] = pack4((lo16(hf[s8].x) + h[0]) * lo16(sgv[s8].x), (hi16(hf[s8].x) + h[1]) * hi16(sgv[s8].x),
                                     (lo16(hf[s8].y) + h[2]) * lo16(sgv[s8].y), (hi16(hf[s8].y) + h[3]) * hi16(sgv[s8].y));
      }
      if (!sample && seg == nseg - 1) *(f32x4*)&p.out[OUT_RG + (b * 2 + d) * 1024 + c] = f32x4{h[0], h[1], h[2], h[3]};
      __syncthreads();
    }
  }
}

__device__ __forceinline__ void phase_mla_norm(const Params& p, int bid, int nb) {
  u16* cq = (u16*)(p.ws + WS3_CQ);
  u16* ckvall = (u16*)(p.ws + WS3_CKVALL);
  const float* ckvraw = (const float*)(p.ws + WS3_CKVRAW);
  const float* kperaw = (const float*)(p.ws + WS3_KPERAW);
  u16* Kb = (u16*)(p.ws + WS3_K);
  const float* qn = p.in[28]; const float* kvn = p.in[29];
  const int lane = threadIdx.x & 63, wave = threadIdx.x >> 6;
  float qnv[6];
#pragma unroll
  for (int i = 0; i < 3; ++i) { qnv[2 * i] = qn[(i * 64 + lane) * 2]; qnv[2 * i + 1] = qn[(i * 64 + lane) * 2 + 1]; }
  const f32x4 g4 = *(const f32x4*)&kvn[lane * 4];
  for (int row = bid * NW + wave; row < TOK + 2048; row += nb * NW) {
    if (row < TOK) {
      const int tok = row;
      const bool sample = tok >= NPROMPT;
      const int bs = (tok - NPROMPT) >> 10, n = (tok - NPROMPT) & 1023;
      const size_t kvrow = sample ? (size_t)(NPROMPT + bs * 1536 + 512 + n) : (size_t)tok;
      unsigned* cqr = (unsigned*)&cq[(size_t)tok * 384];
      unsigned cv[3]; float ss = 0;
#pragma unroll
      for (int i = 0; i < 3; ++i) { cv[i] = cqr[i * 64 + lane]; float a = lo16(cv[i]), b2 = hi16(cv[i]); ss += a * a + b2 * b2; }
      const float rsq = rsqrtf(wave_sum(ss) * (1.0f / 384.0f) + 1e-6f);
#pragma unroll
      for (int i = 0; i < 3; ++i) {
        cqr[i * 64 + lane] = pack2(lo16(cv[i]) * rsq * qnv[2 * i], hi16(cv[i]) * rsq * qnv[2 * i + 1]);
      }
      f32x4 kv = *(const f32x4*)&ckvraw[(size_t)tok * 256 + lane * 4];
      const float rsk = rsqrtf(wave_sum(kv[0] * kv[0] + kv[1] * kv[1] + kv[2] * kv[2] + kv[3] * kv[3]) * (1.0f / 256.0f) + 1e-6f);
      f32x4 o4;
#pragma unroll
      for (int j = 0; j < 4; ++j) o4[j] = kv[j] * rsk * g4[j];
      *(uint2*)&ckvall[kvrow * 256 + lane * 4] = pack4(o4[0], o4[1], o4[2], o4[3]);
      if (!sample) *(f32x4*)&p.out[OUT_CKV + (size_t)tok * 256 + lane * 4] = o4;
      float v = kperaw[(size_t)tok * 32 + (lane & 31)];
      if (!sample) { if (lane < 32) p.out[OUT_KPE + (size_t)tok * 32 + lane] = v; }
      else {
        const float partner = __shfl_xor(v, 8);
        const int i16 = lane & 15;
        const float pos = (lane & 16) ? (float)(n & 63) : (float)(n >> 6);
        float sn, cs; rope_sincos(pos, i16 & 7, sn, cs);
        v = (i16 < 8) ? (v * cs - partner * sn) : (partner * sn + v * cs);
      }
      const u16 vb = f2bf(v);
#pragma unroll
      for (int i = 0; i < 8; ++i) Kb[(kvrow * 16 + (lane >> 5) + 2 * i) * 96 + 64 + (lane & 31)] = vb;
    } else {
      const int r = row - TOK, bs = r >> 9, j = r & 511;
      const size_t kvrow = (size_t)(NPROMPT + bs * 1536 + j);
      f32x4 kv = *(const f32x4*)&p.in[4][(size_t)r * 256 + lane * 4];
      *(uint2*)&ckvall[kvrow * 256 + lane * 4] = pack4(kv[0], kv[1], kv[2], kv[3]);
      const u16 vb = f2bf(p.in[5][(size_t)r * 32 + (lane & 31)]);
#pragma unroll
      for (int i = 0; i < 8; ++i) Kb[(kvrow * 16 + (lane >> 5) + 2 * i) * 96 + 64 + (lane & 31)] = vb;
    }
  }
}

__device__ __forceinline__ void phase_attn(const Params& p, unsigned char* smem_raw, int bid, int nb) {
  u16* sK = (u16*)smem_raw;
  u16* sV = sK + 128 * 104;
  const u16* qg = (const u16*)(p.ws + WS3_Q);
  const u16* Kg = (const u16*)(p.ws + WS3_K);
  const u16* Vg = (const u16*)(p.ws + WS3_VT);
  const u16* sg = (const u16*)(p.ws + WS3_SG);
  u16* ao = (u16*)(p.ws + WS_H);
  const int tid = threadIdx.x, lane = tid & 63, w = tid >> 6, fr = lane & 15, fq = lane >> 4;
  for (int u = bid; u < 1536; u += nb) {
    int tok0, kvbase, nkeys, h;
    if (u < 512) { const int b = u >> 7, r = u & 127; h = r >> 3; const int qb = r & 7; tok0 = NPROMPT + b * 1024 + qb * 128; kvbase = NPROMPT + b * 1536; nkeys = 1536; }
    else { const int uu = u - 512; const int b = uu >> 5, r = uu & 31; h = r >> 1; const int qb = r & 1; tok0 = b * 256 + qb * 128; kvbase = b * 256; nkeys = 256; }
    const int tokq = tok0 + w * 16 + fr;
    bf16x8 qf[3];
#pragma unroll
    for (int ks = 0; ks < 3; ++ks) qf[ks] = *(const bf16x8*)&qg[(size_t)tokq * 1536 + h * 96 + ks * 32 + fq * 8];
    if (u < 512) {
      const int npos = (tokq - NPROMPT) & 1023;
      const float pos = (fq & 2) ? (float)(npos & 63) : (float)(npos >> 6);
      uint4 raw = *(uint4*)&qf[2];
      unsigned rw[4] = {raw.x, raw.y, raw.z, raw.w};
#pragma unroll
      for (int i = 0; i < 4; ++i) {
        float v0 = lo16(rw[i]), v1 = hi16(rw[i]);
        const float p0 = __shfl_xor(v0, 16), p1 = __shfl_xor(v1, 16);
        float sn0, cs0, sn1, cs1;
        rope_sincos(pos, 2 * i, sn0, cs0); rope_sincos(pos, 2 * i + 1, sn1, cs1);
        v0 = (fq & 1) ? (p0 * sn0 + v0 * cs0) : (v0 * cs0 - p0 * sn0);
        v1 = (fq & 1) ? (p1 * sn1 + v1 * cs1) : (v1 * cs1 - p1 * sn1);
        rw[i] = pack2(v0, v1);
      }
      raw = make_uint4(rw[0], rw[1], rw[2], rw[3]);
      qf[2] = *(bf16x8*)&raw;
    }
    float m = -1e30f, l = 0.f;
    f32x4 oacc[4];
#pragma unroll
    for (int i = 0; i < 4; ++i) oacc[i] = f32x4{0.f, 0.f, 0.f, 0.f};
    const int kk0 = tid / 12, kc0 = tid - kk0 * 12;
    const int kk1 = (tid + NT) / 12, kc1 = (tid + NT) - kk1 * 12;
    const int kk2_ = (tid + 2 * NT) / 12, kc2 = (tid + 2 * NT) - kk2_ * 12;
    const u16* Kp0 = &Kg[((size_t)(kvbase + kk0) * 16 + h) * 96 + kc0 * 8];
    const u16* Kp1 = &Kg[((size_t)(kvbase + kk1) * 16 + h) * 96 + kc1 * 8];
    const u16* Kp2 = &Kg[((size_t)(kvbase + kk2_) * 16 + h) * 96 + kc2 * 8];
    const int vd0 = tid >> 4, vc0 = tid & 15, vd1 = (tid + NT) >> 4;
    const u16* Vp0 = &Vg[(size_t)(h * 64 + vd0) * KVROWS + kvbase + vc0 * 8];
    const u16* Vp1 = &Vg[(size_t)(h * 64 + vd1) * KVROWS + kvbase + vc0 * 8];
    uint4 kr0 = *(const uint4*)Kp0, kr1 = *(const uint4*)Kp1, kr2 = *(const uint4*)Kp2, vr0 = *(const uint4*)Vp0, vr1 = *(const uint4*)Vp1;
    const int ntile2 = nkeys >> 7;
    for (int kt = 0; kt < ntile2; ++kt) {
      __syncthreads();
      *(uint4*)&sK[kk0 * 104 + kc0 * 8] = kr0; *(uint4*)&sK[kk1 * 104 + kc1 * 8] = kr1; *(uint4*)&sK[kk2_ * 104 + kc2 * 8] = kr2;
      *(uint4*)&sV[vd0 * 136 + vc0 * 8] = vr0; *(uint4*)&sV[vd1 * 136 + vc0 * 8] = vr1;
      if (kt + 1 < ntile2) {
        const size_t ko = (size_t)(kt + 1) * 128 * 1536; const int vo = (kt + 1) * 128;
        kr0 = *(const uint4*)(Kp0 + ko); kr1 = *(const uint4*)(Kp1 + ko); kr2 = *(const uint4*)(Kp2 + ko);
        vr0 = *(const uint4*)(Vp0 + vo); vr1 = *(const uint4*)(Vp1 + vo);
      }
      __syncthreads();
      f32x4 sacc[8];
#pragma unroll
      for (int ni = 0; ni < 8; ++ni) {
        sacc[ni] = f32x4{0.f, 0.f, 0.f, 0.f};
#pragma unroll
        for (int ks = 0; ks < 3; ++ks) {
          bf16x8 kf = *(const bf16x8*)&sK[(ni * 16 + fr) * 104 + ks * 32 + fq * 8];
          sacc[ni] = __builtin_amdgcn_mfma_f32_16x16x32_bf16(kf, qf[ks], sacc[ni], 0, 0, 0);
        }
      }
      float mx = -1e30f;
#pragma unroll
      for (int ni = 0; ni < 8; ++ni)
#pragma unroll
        for (int j = 0; j < 4; ++j) mx = fmaxf(mx, sacc[ni][j]);
      mx = fmaxf(mx, __shfl_xor(mx, 16));
      mx = fmaxf(mx, __shfl_xor(mx, 32));
      const float mnew = fmaxf(m, mx);
      const float alpha = __builtin_amdgcn_exp2f(m - mnew);
      m = mnew;
      float ls = 0.f;
#pragma unroll
      for (int ni = 0; ni < 8; ++ni)
#pragma unroll
        for (int j = 0; j < 4; ++j) { float e = __builtin_amdgcn_exp2f(sacc[ni][j] - mnew); sacc[ni][j] = e; ls += e; }
      l = l * alpha + ls;
      bf16x8 pf[4];
#pragma unroll
      for (int kk2 = 0; kk2 < 4; ++kk2) {
        uint2 lo = pack4(sacc[2 * kk2][0], sacc[2 * kk2][1], sacc[2 * kk2][2], sacc[2 * kk2][3]);
        uint2 hi = pack4(sacc[2 * kk2 + 1][0], sacc[2 * kk2 + 1][1], sacc[2 * kk2 + 1][2], sacc[2 * kk2 + 1][3]);
        uint4 pk = make_uint4(lo.x, lo.y, hi.x, hi.y);
        pf[kk2] = *(bf16x8*)&pk;
      }
#pragma unroll
      for (int di = 0; di < 4; ++di) {
#pragma unroll
        for (int j = 0; j < 4; ++j) oacc[di][j] *= alpha;
#pragma unroll
        for (int kk2 = 0; kk2 < 4; ++kk2) {
          uint2 v0 = *(const uint2*)&sV[(di * 16 + fr) * 136 + kk2 * 32 + fq * 4];
          uint2 v1 = *(const uint2*)&sV[(di * 16 + fr) * 136 + kk2 * 32 + 16 + fq * 4];
          uint4 vk = make_uint4(v0.x, v0.y, v1.x, v1.y);
          oacc[di] = __builtin_amdgcn_mfma_f32_16x16x32_bf16(*(bf16x8*)&vk, pf[kk2], oacc[di], 0, 0, 0);
        }
      }
    }
    l += __shfl_xor(l, 16);
    l += __shfl_xor(l, 32);
    const float inv = 1.0f / l;
#pragma unroll
    for (int di = 0; di < 4; ++di) {
      const size_t o = (size_t)tokq * 1024 + h * 64 + di * 16 + fq * 4;
      uint2 s = *(const uint2*)&sg[o];
      *(uint2*)&ao[o] = pack4(oacc[di][0] * inv * siluf_(lo16(s.x)), oacc[di][1] * inv * siluf_(hi16(s.x)), oacc[di][2] * inv * siluf_(lo16(s.y)), oacc[di][3] * inv * siluf_(hi16(s.y)));
    }
  }
}

#define XB_TMO      128
#define XB_XCNT(j)  (256  + 64 * (j))
#define XB_XSUB(j)  (1280 + 64 * (j))
#define XB_XGEN(j)  (2304 + 64 * (j))
#define XB_TOP      3328
#define XB_TOPGEN   3392
#define XCD_BAR_WORDS 3456
#define XB_SPIN_CAP (1u << 22)
__device__ __forceinline__ unsigned xb_ld(unsigned* p)              { return __hip_atomic_load(p, __ATOMIC_RELAXED, __HIP_MEMORY_SCOPE_AGENT); }
__device__ __forceinline__ unsigned xb_add(unsigned* p, unsigned v) { return __hip_atomic_fetch_add(p, v, __ATOMIC_RELAXED, __HIP_MEMORY_SCOPE_AGENT); }
__device__ __forceinline__ unsigned xb_xcc_id() { return (unsigned)__builtin_amdgcn_s_getreg((3 << 11) | 20) & 0xFu; }
#define XB_SPIN(cond, bar) do { unsigned _sp = 0; while (cond) { __builtin_amdgcn_s_sleep(1); \
    if ((++_sp & 255u) == 0u) { if (xb_ld(&(bar)[XB_TMO])) break; if (_sp > XB_SPIN_CAP) { atomicAdd(&(bar)[XB_TMO], 1u); break; } } } } while (0)
struct XcdBarrier { unsigned* bar; unsigned x; volatile LAS unsigned* st; };
__device__ __forceinline__ XcdBarrier xcd_barrier_post(unsigned* bar, volatile LAS unsigned* st) {
  XcdBarrier b; b.bar = bar; b.x = xb_xcc_id(); b.st = st;
  if (threadIdx.x == 0) (void)xb_add(&bar[XB_XCNT(b.x)], 1u);
  return b;
}
__device__ __forceinline__ void xcd_barrier_complete(unsigned* bar, unsigned x, unsigned& nloc, unsigned& nx) {
  const unsigned G = gridDim.x * gridDim.y * gridDim.z;
  unsigned sum, cnt, mine, sp = 0u;
  for (;;) {
    sum = 0u; cnt = 0u; mine = 0u;
#pragma unroll
    for (unsigned j = 0; j < 16; ++j) { const unsigned c = xb_ld(&bar[XB_XCNT(j)]); sum += c; cnt += (c > 0u) ? 1u : 0u; mine = (j == x) ? c : mine; }
    if (sum == G) break;
    __builtin_amdgcn_s_sleep(1);
    if ((++sp & 255u) == 0u) { if (xb_ld(&bar[XB_TMO])) break; if (sp > XB_SPIN_CAP) { atomicAdd(&bar[XB_TMO], 1u); break; } }
  }
  nloc = mine > 0u ? mine : 1u; nx = cnt > 0u ? cnt : 1u;
}
__device__ __forceinline__ void xcd_barrier(const XcdBarrier& b) {
  asm volatile("s_waitcnt vmcnt(0)" ::: "memory");
  __syncthreads();
  if (threadIdx.x == 0) {
    unsigned* bar = b.bar;
    __builtin_amdgcn_s_waitcnt(0);
    unsigned nloc = b.st[0], nx = b.st[1];
    if (nloc == 0u) { xcd_barrier_complete(bar, b.x, nloc, nx); b.st[0] = nloc; b.st[1] = nx; }
    const unsigned old = xb_add(&bar[XB_XSUB(b.x)], 1u);
    const unsigned gen = old / nloc;
    if (old + 1u == (gen + 1u) * nloc) {
      __builtin_amdgcn_fence(__ATOMIC_RELEASE, "agent");
      asm volatile("s_waitcnt vmcnt(0)" ::: "memory");
      const unsigned og = xb_add(&bar[XB_TOP], 1u);
      const unsigned tg = og / nx;
      if (og + 1u == (tg + 1u) * nx) xb_add(&bar[XB_TOPGEN], 1u);
      else XB_SPIN(xb_ld(&bar[XB_TOPGEN]) == tg, bar);
      __builtin_amdgcn_fence(__ATOMIC_ACQUIRE, "agent");
      xb_add(&bar[XB_XGEN(b.x)], 1u);
      asm volatile("s_waitcnt vmcnt(0)" ::: "memory");
    } else {
      XB_SPIN(xb_ld(&bar[XB_XGEN(b.x)]) == gen, bar);
      __builtin_amdgcn_fence(__ATOMIC_ACQUIRE, "agent");
      asm volatile("s_waitcnt vmcnt(0)" ::: "memory");
    }
  }
  __syncthreads();
}

#define GEMM_LDS 131072
#define DYN_LDS (GEMM_LDS + 16)
#define WS_BAR (WS_CNT + 4096ull)

#define RUN_GEMM(Aptr, LDA, Bptr, MM, NN, KK, GATE, EPI, CID) RUN_GEMM_G(Aptr, LDA, Bptr, MM, NN, KK, GATE, EPI, nb, CID)
#define RUN_GEMM_G(Aptr, LDA, Bptr, MM, NN, KK, GATE, EPI, GG, CID) RUN_GEMM_X(Aptr, LDA, (size_t)128, (size_t)0, Bptr, MM, NN, KK, GATE, EPI, GG, CID)
#define GM_KSTEP ((size_t)TOK * 128)
#define RUN_GEMM_X(Aptr, LDA, KSA, GST, Bptr, MM, NN, KK, GATE, EPI, GG, CID) do { pg8::Gemm g_{(const u16*)(Aptr), (const u16*)(Bptr), MM, NN, KK, LDA, GATE, p.flags, KSA, GST}; \
    pg8::StaticOrder S_; S_.init(MM, NN, GG, CID); pg8::gemm_phase((LAS unsigned char*)smem_raw, g_, S_, EPI); } while (0)

__global__ void __launch_bounds__(NT, 2) mega(Params p) {
  extern __shared__ __attribute__((aligned(16))) unsigned char smem_raw[];
  const int bid = blockIdx.x, nb = gridDim.x;
  unsigned char* ws = p.ws;
  const float* mod = (const float*)(ws + WS_MOD);
  volatile LAS unsigned* xst = (volatile LAS unsigned*)((LAS unsigned char*)smem_raw + GEMM_LDS);
  XcdBarrier xb;
  if (p.phase_hi - p.phase_lo > 1) {
    if (threadIdx.x == 0) { xst[0] = 0u; xst[1] = 0u; }
    __syncthreads();
    xb = xcd_barrier_post((unsigned*)(ws + WS_BAR), xst);
  }
#define PH_BEGIN(n) if ((PHMASK & (1u << n)) && p.phase_lo <= n && n < p.phase_hi) { const int ph = n;
#define PH_FIN if (ph + 1 < p.phase_hi) { if (p.phase_lo < 0) cg::this_grid().sync(); else xcd_barrier(xb); } }
  PH_BEGIN(0) phase_prologue(p, smem_raw, bid, nb); PH_FIN
  PH_BEGIN(1) phase_h0(p, bid, nb); PH_FIN
  PH_BEGIN(2) {
    EpiHgIn e{(u16*)(ws + WS_B(0)), (u16*)(ws + WS_B(1)), (u16*)(ws + WS_B(2)), (_Float16*)(ws + WS_B(3)), (const float*)(ws + WS_LB)};
    RUN_GEMM(ws + WS_H, 1024, ws + WS_W_HG_IN, TOK, 5120, 1024, 0, e, bid);
  } PH_FIN
  PH_BEGIN(3) phase_gla(p, smem_raw); PH_FIN
  PH_BEGIN(4) phase_hg_post(p, bid, nb); PH_FIN
  PH_BEGIN(5) {
    EpiResLn<false, true> e{p.in[0], p.in[1], (const u16*)nullptr, p.out, (u16*)(ws + WS_XB), mod + 0 * 15360 + 2048, p.in[10] + 0 * 1024, p.in[11] + 0 * 1024, mod + 1 * 15360, (u16*)(ws + WS_H),
               (unsigned long long*)(ws + WS_SLOT) + 0 * 49152, (unsigned*)(ws + WS_CNT + 256) + 0 * 48};
    RUN_GEMM(ws + WS_B(0), 1024, ws + WS_W_HG_OUT, TOK, 1024, 1024, 0, e, bid);
    wconv_idle(p, smem_raw, bid, nb, 1536, 2816);
  } PH_FIN
  PH_BEGIN(7) {
    EpiScIn e{(u16*)(ws + WS_B(0)), (u16*)(ws + WS_B(1))};
    RUN_GEMM(ws + WS_H, 1024, ws + WS_W_SC_IN, TOK, 4096, 1024, 0, e, bid);
  } PH_FIN
  PH_BEGIN(8) phase_sc_conv(p, bid, nb); PH_FIN
  PH_BEGIN(9) {
    EpiResLn<true, true> e{p.out, p.out, (const u16*)(ws + WS_XB), p.out, (u16*)(ws + WS_XB), mod + 1 * 15360 + 2048, p.in[10] + 1 * 1024, p.in[11] + 1 * 1024, mod + 2 * 15360, (u16*)(ws + WS_H),
               (unsigned long long*)(ws + WS_SLOT) + 1 * 49152, (unsigned*)(ws + WS_CNT + 256) + 1 * 48};
    RUN_GEMM(ws + WS_B(2), 1024, ws + WS_W_SC_OUT, TOK, 1024, 1024, 0, e, bid);
    wconv_idle(p, smem_raw, bid, nb, 2816, 3840);
  } PH_FIN
  PH_BEGIN(11) {
    EpiRgIn e{(u16*)(ws + WS_B(0)), (u16*)(ws + WS_B(1))};
    RUN_GEMM(ws + WS_H, 1024, ws + WS_W_RG_IN, TOK, 2048, 1024, 0, e, bid);
  } PH_FIN
  PH_BEGIN(12) phase_rg_conv(p, bid, nb); PH_FIN
  PH_BEGIN(13) {
    EpiRgGate e{(u16*)(ws + WS_B(3)), (u16*)(ws + WS_B(5)), p.in[24]};
    RUN_GEMM_X(ws + WS_B(2), 64, GM_KSTEP, 4 * GM_KSTEP, ws + WS_W_RG_GATE, TOK, 4096, 256, 1, e, nb, bid);
  } PH_FIN
  PH_BEGIN(14) phase_rg_scan(p, smem_raw, bid, nb); PH_FIN
  PH_BEGIN(15) {
    EpiResLn<true, true> e{p.out, p.out, (const u16*)(ws + WS_XB), p.out, (u16*)(ws + WS_XB), mod + 2 * 15360 + 2048, p.in[10] + 2 * 1024, p.in[11] + 2 * 1024, mod + 3 * 15360, (u16*)(ws + WS_H),
               (unsigned long long*)(ws + WS_SLOT) + 2 * 49152, (unsigned*)(ws + WS_CNT + 256) + 2 * 48};
    RUN_GEMM_X(ws + WS_B(0), 64, GM_KSTEP, (size_t)0, ws + WS_W_RG_OUT, TOK, 1024, 1024, 0, e, nb, bid);
    wconv_idle(p, smem_raw, bid, nb, 3840, 4800);
  } PH_FIN
  PH_BEGIN(17) {
    EpiMlaIn e{(u16*)(ws + WS3_CQ), (float*)(ws + WS3_CKVRAW), (float*)(ws + WS3_KPERAW), (u16*)(ws + WS3_SG)};
    RUN_GEMM(ws + WS_H, 1024, ws + WS_W_MLA_IN, TOK, 768, 1024, 0, e, bid);
  } PH_FIN
  PH_BEGIN(18) phase_mla_norm(p, bid, nb); PH_FIN
  PH_BEGIN(19) {
    const bool bal = (nb == 256);
    EpiSg eg{(u16*)(ws + WS3_SG)};
    RUN_GEMM(ws + WS_H, 1024, ws + WS_W_MLA_IN + 672 * 1024 * 2, TOK, 1024, 1024, 0, eg, bid);
    EpiQ eq{(u16*)(ws + WS3_Q)};
    RUN_GEMM(ws + WS3_CQ, 384, ws + WS_W_QB, TOK, 1536, 384, 0, eq, bal ? ((bid + 64) & 255) : bid);
    EpiK ek{(u16*)(ws + WS3_K)};
    RUN_GEMM(ws + WS3_CKVALL, 256, ws + WS_W_KVB, KVROWS, 1024, 256, 0, ek, bal ? ((bid + 32) & 255) : bid);
    EpiV ev{(u16*)(ws + WS3_VT)};
    RUN_GEMM_G(ws + WS_W_KVB + 1024 * 256 * 2, 256, ws + WS3_CKVALL, 1024, KVROWS, 256, 0, ev, bal ? 64 : nb, bal ? (bid >= 192 ? bid - 192 : (1 << 20)) : bid);
  } PH_FIN
  PH_BEGIN(20) phase_attn(p, smem_raw, bid, nb); PH_FIN
  PH_BEGIN(21) {
    EpiResLn<true, false> e{p.out, p.out, (const u16*)(ws + WS_XB), p.out, (u16*)nullptr, mod + 3 * 15360 + 2048, p.in[10] + 3 * 1024, p.in[11] + 3 * 1024, mod + 3 * 15360, (u16*)nullptr,
               (unsigned long long*)(ws + WS_SLOT) + 3 * 49152, (unsigned*)(ws + WS_CNT + 256) + 3 * 48};
    RUN_GEMM(ws + WS_H, 1024, ws + WS_W_MLA_OUT, TOK, 1024, 1024, 0, e, bid);
  } PH_FIN
}

extern "C" void kernel_launch(void* const* d_in, const int* in_sizes, int n_in, void* d_out, int out_size, void* d_ws, size_t ws_size,
                              hipStream_t stream) {
  static int grid_blocks = 0;
  if (!grid_blocks) {
    int dev = 0, cus = 0, per_cu = 0;
    (void)hipGetDevice(&dev);
    (void)hipDeviceGetAttribute(&cus, hipDeviceAttributeMultiprocessorCount, dev);
    (void)hipFuncSetAttribute((const void*)mega, hipFuncAttributeMaxDynamicSharedMemorySize, DYN_LDS);
    (void)hipOccupancyMaxActiveBlocksPerMultiprocessor(&per_cu, (const void*)mega, NT, DYN_LDS);
    if (per_cu < 1) per_cu = 1;
    if (per_cu > 1) per_cu = 1;
    grid_blocks = cus * per_cu;
  }
  Params p{};
  for (int i = 0; i < 33; ++i) p.in[i] = (const float*)d_in[i];
  p.out = (float*)d_out;
  p.ws = (unsigned char*)d_ws;
#if MULTI_LAUNCH
  (void)hipMemsetAsync((unsigned char*)d_ws + WS_CNT, 0, 4096 + XCD_BAR_WORDS * 4, stream);
  for (int ph = 0; ph < NPHASES; ++ph) {
    p.phase_lo = ph; p.phase_hi = ph + 1;
    hipLaunchKernelGGL(mega, dim3(grid_blocks), dim3(NT), DYN_LDS, stream, p);
#ifdef PROBE_MASK
    if ((PROBE_MASK >> ph) & 1) { p.flags = PROBE_FLAGS; for (int r = 0; r < 2; ++r) {
      if (ph == 3) (void)hipMemsetAsync((unsigned char*)d_ws + WS_CNT, 0, 64, stream);
      hipLaunchKernelGGL(mega, dim3(grid_blocks), dim3(NT), DYN_LDS, stream, p);
    } p.flags = 0; }
#endif
  }
#else
  p.phase_lo = 0; p.phase_hi = NPHASES;
  (void)hipMemsetAsync((unsigned char*)d_ws + WS_CNT, 0, 4096 + XCD_BAR_WORDS * 4, stream);
  void* args[] = {&p};
  hipError_t e = hipLaunchCooperativeKernel((const void*)mega, dim3(grid_blocks), dim3(NT), args, DYN_LDS, stream);
  if (e != hipSuccess) fprintf(stderr, "cooperative launch failed: %s (grid %d)\n", hipGetErrorString(e), grid_blocks);
#endif
}
```

```cpp
#include <hip/hip_runtime.h>
#include <hip/hip_cooperative_groups.h>
#include <cstdio>
namespace cg = cooperative_groups;

#ifndef MULTI_LAUNCH
#define MULTI_LAUNCH 0
#endif

typedef unsigned short u16;
using bf16x8 = __attribute__((ext_vector_type(8))) short;
using f32x4 = __attribute__((ext_vector_type(4))) float;
typedef _Float16 h4 __attribute__((ext_vector_type(4)));

#define TOK 12288
#define NPROMPT 8192
#define KVROWS 14336
#define NPHASES 23
#ifndef PHMASK
#define PHMASK 0x7fffff
#endif
#define DN_ALPHA 1.6817928305074290f

#define WS_W_HG_IN 0ull
#define WS_W_HG_OUT (WS_W_HG_IN + 10485760ull)
#define WS_W_SC_IN (WS_W_HG_OUT + 2097152ull)
#define WS_W_SC_OUT (WS_W_SC_IN + 8388608ull)
#define WS_W_RG_IN (WS_W_SC_OUT + 2097152ull)
#define WS_W_RG_GATE (WS_W_RG_IN + 4194304ull)
#define WS_W_RG_OUT (WS_W_RG_GATE + 2097152ull)
#define WS_W_MLA_IN (WS_W_RG_OUT + 2097152ull)
#define WS_W_QB (WS_W_MLA_IN + 3670016ull)
#define WS_W_KVB (WS_W_QB + 1179648ull)
#define WS_W_MLA_OUT (WS_W_KVB + 1048576ull)
#define WS_MOD (WS_W_MLA_OUT + 2097152ull)
#define WS_LB (WS_MOD + 245760ull)
#define WS_CNT (WS_LB + 8192ull)
#define WS_R (WS_CNT + 4096ull + 16384ull)
#define BSZ 25165824ull
#define WS_H (WS_R)
#define WS_B(i) (WS_R + BSZ * (1 + (i)))
#define WS_SLOT (WS_R + 201326592ull)
#define WS_XB (WS_SLOT + 1572864ull)
#define WS3_CQ (WS_R + 25165824ull)
#define WS3_CKVALL (WS_R + 34603008ull)
#define WS3_CKVRAW (WS_R + 41943040ull)
#define WS3_KPERAW (WS_R + 54525952ull)
#define WS3_SG (WS_R + 56098816ull)
#define WS3_Q (WS_R + 81264640ull)
#define WS3_K (WS_R + 119013376ull)
#define WS3_VT (WS_R + 163053568ull)

#define OUT_HG 12582912
#define OUT_RG 20971520
#define OUT_CKV 21037056
#define OUT_KPE 23134208

struct Params {
  const float* in[33];
  float* out;
  unsigned char* ws;
  int phase_lo, phase_hi, flags, pad_;
};

__device__ __forceinline__ u16 f2bf(float f) { __bf16 r = (__bf16)f; return *(u16*)&r; }
__device__ __forceinline__ float bf2f(u16 h) { return __uint_as_float(((unsigned)h) << 16); }
typedef float f2v_ __attribute__((ext_vector_type(2)));
typedef __bf16 b2v_ __attribute__((ext_vector_type(2)));
__device__ __forceinline__ unsigned pack2(float a, float b) { f2v_ f = {a, b}; b2v_ r = __builtin_convertvector(f, b2v_); return *(unsigned*)&r; }
__device__ __forceinline__ uint2 pack4(float a, float b, float c, float d) { return make_uint2(pack2(a, b), pack2(c, d)); }
__device__ __forceinline__ float lo16(unsigned u) { return __uint_as_float(u << 16); }
__device__ __forceinline__ float hi16(unsigned u) { return __uint_as_float(u & 0xffff0000u); }
__device__ __forceinline__ float sigmoidf_(float x) { return __builtin_amdgcn_rcpf(1.0f + __expf(-x)); }
__device__ __forceinline__ float siluf_(float x) { return x * __builtin_amdgcn_rcpf(1.0f + __expf(-x)); }
__device__ __forceinline__ int cond_of(int tok) { return tok < NPROMPT ? 0 : 1 + ((tok - NPROMPT) >> 10); }
__device__ __forceinline__ float wave_sum(float v) {
#pragma unroll
  for (int o = 32; o > 0; o >>= 1) v += __shfl_xor(v, o);
  return v;
}
__device__ __forceinline__ void rope_sincos(float pos, int fi, float& sn, float& cs) {
  float inv = exp2f(-(float)fi * 1.6609640474436813f);
  float ang = pos * inv;
  float k = rintf(ang * 0.15915494309189535f);
  float r = fmaf(-k, 6.2831854820251465f, ang);
  r = fmaf(-k, -1.7484555e-7f, r);
  sn = __sinf(r); cs = __cosf(r);
}

#define NT 512
#define NW 8
#define LAS __attribute__((address_space(3)))

namespace pg8 {
constexpr int BM = 256, BK = 64, HALF = 128, HTB = HALF * BK * 2, STAGE_BYTES = 8 * HTB, NXCD = 8, WGM = 8;
__device__ __forceinline__ int lds_byte(int r, int c) { const int st = (r >> 4) * 2 + (c >> 5), rr = r & 15, cc = c & 31, ob = rr * 64 + cc * 2; return st * 1024 + (ob ^ (((ob >> 9) & 1) << 5)); }
__device__ __forceinline__ void stage_rc(int b, int& R, int& C) { const int st = b / 1024, sb = b % 1024, swz = sb ^ (((sb >> 9) & 1) << 5); R = (st >> 1) * 16 + swz / 64; C = (st & 1) * 32 + (swz % 64) / 2; }
struct Unit { int pm, pn; };
struct Gemm { const u16* A; const u16* Bt; int M, N, K, lda, gate, noepi; size_t kstepA, gstride; };
struct StaticOrder {
  int nM, nN, nwg, G, c;
  __device__ void init(int M, int N, int G_, int c_) { nM = M / BM; nN = N / BM; nwg = nM * nN; G = G_; c = c_; }
  __device__ bool next(int i, Unit& u) const {
    const long L = (long)i * G + c; if (L >= nwg) return false;
    int wgid = (int)L; { const int q = nwg / NXCD, r = nwg % NXCD, xcd = wgid % NXCD, off = wgid / NXCD; wgid = (xcd < r ? xcd * (q + 1) : r * (q + 1) + (xcd - r) * q) + off; }
    const int nig = WGM * nN, gid = wgid / nig, fm = gid * WGM, gsz = (nM - fm) < WGM ? (nM - fm) : WGM;
    u.pm = fm + ((wgid % nig) % gsz); u.pn = (wgid % nig) / gsz; return true;
  }
};
template <class Epi>
__device__ __forceinline__ void gemm_phase(LAS unsigned char* lds, const Gemm g, const StaticOrder& S, const Epi& E) {
  const int tid = threadIdx.x, wid = __builtin_amdgcn_readfirstlane(tid >> 6), lane = tid & 63, wr = wid >> 2, wc = wid & 3, fr = lane & 15, fq = lane >> 4;
  const int K = g.K, nt = K / BK;
  unsigned voffA[2], voffB[2];
#pragma unroll
  for (int i = 0; i < 2; ++i) { int R, C; stage_rc(tid * 16 + i * 8192, R, C); voffA[i] = (unsigned)(R * g.lda + C) * 2u; voffB[i] = (unsigned)(R * K + C) * 2u; }
  const size_t kstep = (size_t)(BK * 2);
  const size_t kstepA = g.kstepA;
  const size_t hstepA = (size_t)HALF * g.lda * 2, hstepB = (size_t)HALF * K * 2;
  const size_t tstepA = 2 * hstepA, tstepB = 2 * hstepB;
  const unsigned ldsw = (unsigned)wid * 1024u;
  const int aoff = lds_byte(wr * 64 + fr, fq * 8), boff = lds_byte(wc * 32 + fr, fq * 8);
#define PG8_AOFF(pn) (g.gate ? (size_t)(((pn) >> 1) & 3) * g.gstride : (size_t)0)
#define PG8_SA(b, h) (((b) * 2 + (h)) * HTB)
#define PG8_SB(b, h) ((4 + (b) * 2 + (h)) * HTB)
#define PG8_STAGE(bufoff, gbase, voff) do { _Pragma("unroll") for (int _i = 0; _i < 2; ++_i) \
    __builtin_amdgcn_global_load_lds((const unsigned*)((const char*)(gbase) + (voff)[_i]), (LAS unsigned*)(lds + (bufoff) + ldsw + _i * 8192), 16, 0, 0); } while (0)
#define PG8_LDA(dst, b, h) do { _Pragma("unroll") for (int m = 0; m < 4; ++m) _Pragma("unroll") for (int k = 0; k < 2; ++k) dst[m][k] = *(const LAS bf16x8*)(lds + PG8_SA(b, h) + aoff + m * 2048 + k * 1024); } while (0)
#define PG8_LDB(dst, b, h) do { _Pragma("unroll") for (int n = 0; n < 2; ++n) _Pragma("unroll") for (int k = 0; k < 2; ++k) dst[n][k] = *(const LAS bf16x8*)(lds + PG8_SB(b, h) + boff + n * 2048 + k * 1024); } while (0)
#define PG8_MMA(ai, bj, At, Bt) do { __builtin_amdgcn_s_setprio(1); _Pragma("unroll") for (int m = 0; m < 4; ++m) _Pragma("unroll") for (int n = 0; n < 2; ++n) _Pragma("unroll") for (int k = 0; k < 2; ++k) \
    acc[ai][bj][m][n] = __builtin_amdgcn_mfma_f32_16x16x32_bf16(Bt[n][k], At[m][k], acc[ai][bj][m][n], 0, 0, 0); __builtin_amdgcn_s_setprio(0); } while (0)
#define PG8_WAIT_V(n) asm volatile("s_waitcnt vmcnt(" #n ")" ::: "memory")
#define PG8_WAIT_L(n) asm volatile("s_waitcnt lgkmcnt(" #n ")" ::: "memory")
#define PG8_BAR __builtin_amdgcn_s_barrier()
#define PG8_SCHED __builtin_amdgcn_sched_barrier(0)
  Unit cur, nxt; int ui = 0;
  if (!S.next(0, cur)) return;
  f32x4 acc[2][2][4][2];
#pragma unroll
  for (int a = 0; a < 2; ++a)
#pragma unroll
    for (int b = 0; b < 2; ++b)
#pragma unroll
      for (int m = 0; m < 4; ++m)
#pragma unroll
        for (int n = 0; n < 2; ++n) acc[a][b][m][n] = (f32x4){0.f, 0.f, 0.f, 0.f};
  bf16x8 At[4][2], B0[2][2], B1[2][2];
  const char* cA = (const char*)g.A + (size_t)cur.pm * tstepA + PG8_AOFF(cur.pn); const char* cB = (const char*)g.Bt + (size_t)cur.pn * tstepB;
  PG8_STAGE(PG8_SB(0, 0), cB, voffB); PG8_STAGE(PG8_SA(0, 0), cA, voffA); PG8_STAGE(PG8_SB(0, 1), cB + hstepB, voffB); PG8_STAGE(PG8_SA(0, 1), cA + hstepA, voffA);
  if (wr == 1) PG8_BAR;
  PG8_WAIT_V(4); PG8_BAR;
  PG8_STAGE(PG8_SB(1, 0), cB + kstep, voffB); PG8_STAGE(PG8_SA(1, 0), cA + kstepA, voffA); PG8_STAGE(PG8_SB(1, 1), cB + hstepB + kstep, voffB);
  PG8_WAIT_V(6); PG8_BAR;
  for (;;) {
    const bool has_next = S.next(ui + 1, nxt);
    const char* nA = has_next ? (const char*)g.A + (size_t)nxt.pm * tstepA + PG8_AOFF(nxt.pn) : cA; const char* nB = has_next ? (const char*)g.Bt + (size_t)nxt.pn * tstepB : cB;
#pragma unroll 1
    for (int t = 0; t < nt; t += 2) {
      const bool last = (t == nt - 2);
      const char* a1 = cA + (size_t)(t + 1) * kstepA;
      const char* a2 = last ? nA : cA + (size_t)(t + 2) * kstepA; const char* b2 = last ? nB : cB + (size_t)(t + 2) * kstep;
      const char* a3 = a2 + kstepA; const char* b3 = b2 + kstep;
      PG8_LDB(B0, 0, 0); PG8_SCHED; PG8_LDA(At, 0, 0); PG8_STAGE(PG8_SA(1, 1), a1 + hstepA, voffA);
      PG8_WAIT_L(8); PG8_BAR; PG8_WAIT_L(0); PG8_MMA(0, 0, At, B0); PG8_BAR; PG8_SCHED;
      PG8_LDB(B1, 0, 1); PG8_STAGE(PG8_SB(0, 0), b2, voffB);
      PG8_BAR; PG8_WAIT_L(0); PG8_MMA(0, 1, At, B1); PG8_BAR;
      PG8_LDA(At, 0, 1); PG8_STAGE(PG8_SA(0, 0), a2, voffA);
      PG8_BAR; PG8_WAIT_L(0); PG8_MMA(1, 0, At, B0); PG8_BAR; PG8_SCHED;
      PG8_STAGE(PG8_SB(0, 1), b2 + hstepB, voffB);
      PG8_WAIT_V(6); PG8_BAR; PG8_MMA(1, 1, At, B1); PG8_BAR;
      PG8_LDB(B0, 1, 0); PG8_SCHED; PG8_LDA(At, 1, 0); PG8_STAGE(PG8_SA(0, 1), a2 + hstepA, voffA);
      PG8_WAIT_L(8); PG8_BAR; PG8_WAIT_L(0); PG8_MMA(0, 0, At, B0); PG8_BAR; PG8_SCHED;
      PG8_LDB(B1, 1, 1); PG8_STAGE(PG8_SB(1, 0), b3, voffB);
      PG8_BAR; PG8_WAIT_L(0); PG8_MMA(0, 1, At, B1); PG8_BAR;
      PG8_LDA(At, 1, 1); PG8_STAGE(PG8_SA(1, 0), a3, voffA);
      PG8_BAR; PG8_WAIT_L(0); PG8_MMA(1, 0, At, B0); PG8_BAR; PG8_SCHED;
      PG8_STAGE(PG8_SB(1, 1), b3 + hstepB, voffB);
      PG8_WAIT_V(6); PG8_BAR; PG8_MMA(1, 1, At, B1); PG8_BAR;
    }
    if constexpr (!Epi::AFTER_DRAIN) { if (!g.noepi) E(acc, cur, wr, wc, fr, fq); }
    if (!has_next) break;
#pragma unroll
    for (int a = 0; a < 2; ++a)
#pragma unroll
      for (int b = 0; b < 2; ++b)
#pragma unroll
        for (int m = 0; m < 4; ++m)
#pragma unroll
          for (int n = 0; n < 2; ++n) acc[a][b][m][n] = (f32x4){0.f, 0.f, 0.f, 0.f};
    cur = nxt; cA = nA; cB = nB; ++ui;
  }
  PG8_WAIT_V(0);
  if (wr == 0) PG8_BAR;
  PG8_BAR;
  if constexpr (Epi::AFTER_DRAIN) { if (!g.noepi) E.fused(acc, cur, wr, wc, fr, fq, lds); }
#undef PG8_AOFF
#undef PG8_SA
#undef PG8_SB
#undef PG8_STAGE
#undef PG8_LDA
#undef PG8_LDB
#undef PG8_MMA
#undef PG8_WAIT_V
#undef PG8_WAIT_L
#undef PG8_BAR
#undef PG8_SCHED
}
}
using pg8::Unit;
typedef const f32x4 (&AccRef)[2][2][4][2];

#define EPI_ROWS(...) _Pragma("unroll") for (int ai = 0; ai < 2; ++ai) _Pragma("unroll") for (int m = 0; m < 4; ++m) { const int row = u.pm * 256 + ai * 128 + wr * 64 + m * 16 + fr; __VA_ARGS__ }
#define EPI_COLS(...) _Pragma("unroll") for (int bj = 0; bj < 2; ++bj) _Pragma("unroll") for (int n = 0; n < 2; ++n) { const int cb = u.pn * 256 + bj * 128 + wc * 32 + n * 16; const f32x4 a = acc[ai][bj][m][n]; __VA_ARGS__ }

struct EpiHgIn {
  static constexpr bool AFTER_DRAIN = false;
  u16 *q, *v, *sg; _Float16* lf; const float* lb;
  __device__ __forceinline__ void operator()(AccRef acc, const Unit& u, int wr, int wc, int fr, int fq) const {
    const int region = u.pn >> 2;
    f32x4 l4[2][2];
    if (region == 1 || region == 2) {
#pragma unroll
      for (int bj = 0; bj < 2; ++bj)
#pragma unroll
        for (int n = 0; n < 2; ++n) l4[bj][n] = *(const f32x4*)&lb[(region - 1) * 1024 + ((u.pn * 256 + bj * 128 + wc * 32 + n * 16) & 1023) + fq * 4];
    }
    EPI_ROWS( EPI_COLS(
      const int c = (cb & 1023) + fq * 4;
      if (region == 0) {
        const float s = 0.08838834764831845f;
        *(uint2*)&q[(size_t)row * 1024 + c] = pack4(siluf_(a[0]) * s, siluf_(a[1]) * s, siluf_(a[2]) * s, siluf_(a[3]) * s);
      } else if (region <= 2) {
        const int d = region - 1;
        h4 o;
        _Pragma("unroll") for (int j = 0; j < 4; ++j) { float f = l4[bj][n][j] + (1.0f - l4[bj][n][j]) * sigmoidf_(a[j]); o[j] = (_Float16)__logf(f); }
        *(h4*)&lf[(size_t)row * 2048 + d * 1024 + c] = o;
      } else if (region == 3) {
        *(uint2*)&v[(size_t)row * 1024 + c] = pack4(a[0], a[1], a[2], a[3]);
      } else {
        *(uint2*)&sg[(size_t)row * 1024 + c] = pack4(a[0], a[1], a[2], a[3]);
      }
    ) )
  }
};

struct EpiRes {
  static constexpr bool AFTER_DRAIN = false;
  const float* xin_p; const float* xin_s; float* Y; const float* gate;
  __device__ __forceinline__ void operator()(AccRef acc, const Unit& u, int wr, int wc, int fr, int fq) const {
    EPI_ROWS(
      const float* xr = row < NPROMPT ? xin_p + (size_t)row * 1024 : xin_s + (size_t)(row - NPROMPT) * 1024;
      const float* g = gate + cond_of(row) * 3072;
      EPI_COLS(
        const int c = cb + fq * 4;
        f32x4 x = *(const f32x4*)&xr[c];
        f32x4 gg = *(const f32x4*)&g[c];
        f32x4 y;
        _Pragma("unroll") for (int j = 0; j < 4; ++j) y[j] = DN_ALPHA * x[j] + gg[j] * a[j];
        *(f32x4*)&Y[(size_t)row * 1024 + c] = y;
      ) )
  }
};

template <bool XIN_BF, bool XOUT_BF>
struct EpiResLn {
  static constexpr bool AFTER_DRAIN = true;
  const float* xin_p; const float* xin_s; const u16* xin_b; float* X; u16* XB; const float* gate; const float* lg; const float* lbias; const float* modn; u16* H;
  unsigned long long* slots; unsigned* cnt;
  __device__ __forceinline__ void fused(f32x4 (&acc)[2][2][4][2], const Unit& u, int wr, int wc, int fr, int fq, LAS unsigned char* lds) const {
    LAS float* part = (LAS float*)lds;
    LAS float* stat = part + 2048;
    const int tid = threadIdx.x;
    const int cnd = cond_of(u.pm * 256);
    f32x4 gv[2][2];
#pragma unroll
    for (int bj = 0; bj < 2; ++bj)
#pragma unroll
      for (int n = 0; n < 2; ++n) gv[bj][n] = *(const f32x4*)&gate[cnd * 3072 + u.pn * 256 + bj * 128 + wc * 32 + n * 16 + fq * 4];
#pragma unroll
    for (int ai = 0; ai < 2; ++ai)
#pragma unroll
      for (int m = 0; m < 4; ++m) {
        const int rl = ai * 128 + wr * 64 + m * 16 + fr;
        const int row = u.pm * 256 + rl;
        const float* xr = row < NPROMPT ? xin_p + (size_t)row * 1024 : xin_s + (size_t)(row - NPROMPT) * 1024;
        float s1 = 0.f, s2 = 0.f;
#pragma unroll
        for (int bj = 0; bj < 2; ++bj)
#pragma unroll
          for (int n = 0; n < 2; ++n) {
            const int c = u.pn * 256 + bj * 128 + wc * 32 + n * 16 + fq * 4;
            f32x4 x;
            if constexpr (XIN_BF) { const uint2 xb2 = *(const uint2*)&xin_b[(size_t)row * 1024 + c]; x = f32x4{lo16(xb2.x), hi16(xb2.x), lo16(xb2.y), hi16(xb2.y)}; }
            else x = *(const f32x4*)&xr[c];
            const f32x4 gg = gv[bj][n];
            f32x4 y;
#pragma unroll
            for (int j = 0; j < 4; ++j) { y[j] = DN_ALPHA * x[j] + gg[j] * acc[ai][bj][m][n][j]; s1 += y[j]; s2 += y[j] * y[j]; }
            acc[ai][bj][m][n] = y;
          }
        s1 += __shfl_xor(s1, 16); s1 += __shfl_xor(s1, 32);
        s2 += __shfl_xor(s2, 16); s2 += __shfl_xor(s2, 32);
        if (fq == 0) { part[(rl * 4 + wc) * 2] = s1; part[(rl * 4 + wc) * 2 + 1] = s2; }
      }
    __syncthreads();
    if (tid < 256) {
      float S1 = 0.f, S2 = 0.f;
#pragma unroll
      for (int w2 = 0; w2 < 4; ++w2) { S1 += part[(tid * 4 + w2) * 2]; S2 += part[(tid * 4 + w2) * 2 + 1]; }
      const unsigned long long v = (unsigned long long)__float_as_uint(S1) | ((unsigned long long)__float_as_uint(S2) << 32);
      __hip_atomic_store(&slots[(size_t)(u.pm * 4 + u.pn) * 256 + tid], v, __ATOMIC_RELAXED, __HIP_MEMORY_SCOPE_AGENT);
    }
    asm volatile("s_waitcnt vmcnt(0)" ::: "memory");
    __syncthreads();
    if (tid == 0) {
      __hip_atomic_fetch_add(&cnt[u.pm], 1u, __ATOMIC_RELAXED, __HIP_MEMORY_SCOPE_AGENT);
      unsigned sp = 0;
      while (__hip_atomic_load(&cnt[u.pm], __ATOMIC_RELAXED, __HIP_MEMORY_SCOPE_AGENT) < 4u) { __builtin_amdgcn_s_sleep(1); if (++sp > (1u << 24)) break; }
    }
    __syncthreads();
    if (tid < 256) {
      float T1 = 0.f, T2 = 0.f;
#pragma unroll
      for (int o = 0; o < 4; ++o) {
        const unsigned long long v = __hip_atomic_load(&slots[(size_t)(u.pm * 4 + o) * 256 + tid], __ATOMIC_RELAXED, __HIP_MEMORY_SCOPE_AGENT);
        T1 += __uint_as_float((unsigned)(v & 0xffffffffull)); T2 += __uint_as_float((unsigned)(v >> 32));
      }
      const float mu = T1 * (1.0f / 1024.0f);
      const float var = fmaxf(T2 * (1.0f / 1024.0f) - mu * mu, 0.f);
      stat[tid * 2] = mu; stat[tid * 2 + 1] = rsqrtf(var + 1e-5f);
    }
    __syncthreads();
#pragma unroll
    for (int bj = 0; bj < 2; ++bj) {
      f32x4 lgv[2], lbv[2], shv[2], scv[2];
#pragma unroll
      for (int n = 0; n < 2; ++n) {
        const int c = u.pn * 256 + bj * 128 + wc * 32 + n * 16 + fq * 4;
        lgv[n] = *(const f32x4*)&lg[c]; lbv[n] = *(const f32x4*)&lbias[c];
        shv[n] = *(const f32x4*)&modn[cnd * 3072 + c]; scv[n] = *(const f32x4*)&modn[cnd * 3072 + 1024 + c];
      }
#pragma unroll
      for (int ai = 0; ai < 2; ++ai)
#pragma unroll
        for (int m = 0; m < 4; ++m) {
          const int rl = ai * 128 + wr * 64 + m * 16 + fr;
          const int row = u.pm * 256 + rl;
          const float mu = stat[rl * 2], rs = stat[rl * 2 + 1];
#pragma unroll
          for (int n = 0; n < 2; ++n) {
            const int c = u.pn * 256 + bj * 128 + wc * 32 + n * 16 + fq * 4;
            const f32x4 y = acc[ai][bj][m][n];
            f32x4 xo;
#pragma unroll
            for (int j = 0; j < 4; ++j) xo[j] = (y[j] - mu) * rs * lgv[n][j] + lbv[n][j];
            if constexpr (XOUT_BF) *(uint2*)&XB[(size_t)row * 1024 + c] = pack4(xo[0], xo[1], xo[2], xo[3]);
            else *(f32x4*)&X[(size_t)row * 1024 + c] = xo;
            if (H) {
              *(uint2*)&H[(size_t)row * 1024 + c] = pack4(xo[0] * (1 + scv[n][0]) + shv[n][0], xo[1] * (1 + scv[n][1]) + shv[n][1], xo[2] * (1 + scv[n][2]) + shv[n][2], xo[3] * (1 + scv[n][3]) + shv[n][3]);
            }
          }
        }
    }
  }
};

struct EpiScIn {
  static constexpr bool AFTER_DRAIN = false;
  u16 *pb, *sb;
  __device__ __forceinline__ void operator()(AccRef acc, const Unit& u, int wr, int wc, int fr, int fq) const {
    const int c = u.pn * 64 + wc * 16 + fq * 4;
    EPI_ROWS(
      const f32x4 bg = acc[ai][0][m][0], cgv = acc[ai][0][m][1], v = acc[ai][1][m][0], g = acc[ai][1][m][1];
      *(uint2*)&pb[(size_t)row * 1024 + c] = pack4(cgv[0] * v[0], cgv[1] * v[1], cgv[2] * v[2], cgv[3] * v[3]);
      *(uint2*)&sb[(size_t)row * 1024 + c] = pack4(siluf_(g[0]) * bg[0], siluf_(g[1]) * bg[1], siluf_(g[2]) * bg[2], siluf_(g[3]) * bg[3]);
    )
  }
};

struct EpiRgIn {
  static constexpr bool AFTER_DRAIN = false;
  u16 *ub, *sg;
  __device__ __forceinline__ void operator()(AccRef acc, const Unit& u, int wr, int wc, int fr, int fq) const {
    const int region = u.pn >> 2;
    EPI_ROWS( EPI_COLS(
      const int c = (cb & 1023) + fq * 4;
      if (region == 0) *(uint2*)&ub[(size_t)row * 1024 + c] = pack4(a[0], a[1], a[2], a[3]);
      else *(uint2*)&sg[((size_t)(c >> 6) * TOK + row) * 64 + (c & 63)] = pack4(siluf_(a[0]), siluf_(a[1]), siluf_(a[2]), siluf_(a[3]));
    ) )
  }
};

struct EpiRgGate {
  static constexpr bool AFTER_DRAIN = false;
  u16 *rb, *ib; const float* bgate;
  __device__ __forceinline__ void operator()(AccRef acc, const Unit& u, int wr, int wc, int fr, int fq) const {
    const int mat = u.pn >> 1, d = mat >> 2, hd = mat & 3;
    f32x4 br[2], bi[2]; int ccs[2];
#pragma unroll
    for (int bj = 0; bj < 2; ++bj) {
      const int off = ((u.pn & 1) * 256 + bj * 128 + wc * 32);
      ccs[bj] = (off >> 5) * 16 + fq * 4;
      br[bj] = *(const f32x4*)&bgate[mat * 512 + ccs[bj]];
      bi[bj] = *(const f32x4*)&bgate[mat * 512 + 256 + ccs[bj]];
    }
    EPI_ROWS(
      _Pragma("unroll") for (int bj = 0; bj < 2; ++bj) {
        const f32x4 r = acc[ai][bj][m][0], ii = acc[ai][bj][m][1];
        const int cch = hd * 256 + ccs[bj];
        const size_t o = (size_t)d * TOK * 1024 + ((size_t)(cch >> 6) * TOK + row) * 64 + (cch & 63);
        *(uint2*)&rb[o] = pack4(sigmoidf_(r[0] + br[bj][0]), sigmoidf_(r[1] + br[bj][1]), sigmoidf_(r[2] + br[bj][2]), sigmoidf_(r[3] + br[bj][3]));
        *(uint2*)&ib[o] = pack4(sigmoidf_(ii[0] + bi[bj][0]), sigmoidf_(ii[1] + bi[bj][1]), sigmoidf_(ii[2] + bi[bj][2]), sigmoidf_(ii[3] + bi[bj][3]));
      } )
  }
};

struct EpiMlaIn {
  static constexpr bool AFTER_DRAIN = false;
  u16* cq; float* ckvraw; float* kperaw; u16* sg;
  __device__ __forceinline__ void operator()(AccRef acc, const Unit& u, int wr, int wc, int fr, int fq) const {
    EPI_ROWS( EPI_COLS(
      const int c = cb + fq * 4;
      if (cb < 384) *(uint2*)&cq[(size_t)row * 384 + c] = pack4(a[0], a[1], a[2], a[3]);
      else if (cb < 640) *(f32x4*)&ckvraw[(size_t)row * 256 + (c - 384)] = a;
      else if (cb < 672) *(f32x4*)&kperaw[(size_t)row * 32 + (c - 640)] = a;
    ) )
  }
};

struct EpiSg {
  static constexpr bool AFTER_DRAIN = false;
  u16* sg;
  __device__ __forceinline__ void operator()(AccRef acc, const Unit& u, int wr, int wc, int fr, int fq) const {
    EPI_ROWS( EPI_COLS(
      *(uint2*)&sg[(size_t)row * 1024 + cb + fq * 4] = pack4(a[0], a[1], a[2], a[3]);
    ) )
  }
};

struct EpiQ {
  static constexpr bool AFTER_DRAIN = false;
  u16* q;
  __device__ __forceinline__ void operator()(AccRef acc, const Unit& u, int wr, int wc, int fr, int fq) const {
    const float sc = 0.14724444500602648f;
    EPI_ROWS( EPI_COLS(
      *(uint2*)&q[(size_t)row * 1536 + cb + fq * 4] = pack4(a[0] * sc, a[1] * sc, a[2] * sc, a[3] * sc);
    ) )
  }
};

struct EpiK {
  static constexpr bool AFTER_DRAIN = false;
  u16* Kb;
  __device__ __forceinline__ void operator()(AccRef acc, const Unit& u, int wr, int wc, int fr, int fq) const {
    EPI_ROWS( EPI_COLS(
      const int h = cb >> 6, dd = (cb & 63) + fq * 4;
      *(uint2*)&Kb[((size_t)row * 16 + h) * 96 + dd] = pack4(a[0], a[1], a[2], a[3]);
    ) )
  }
};
struct EpiV {
  static constexpr bool AFTER_DRAIN = false;
  u16* Vt;
  __device__ __forceinline__ void operator()(AccRef acc, const Unit& u, int wr, int wc, int fr, int fq) const {
    EPI_ROWS( EPI_COLS(
      *(uint2*)&Vt[(size_t)row * KVROWS + cb + fq * 4] = pack4(a[0], a[1], a[2], a[3]);
    ) )
  }
};

__device__ __forceinline__ void wconv_tile(const float* __restrict__ src, int N, int K, u16* __restrict__ dst, int k0, int n0,
                                           int perm, int mat, float* tile) {
  const int tid = threadIdx.x;
  {
    const int r = tid >> 4, c4 = (tid & 15) * 4;
#pragma unroll
    for (int i = 0; i < 2; ++i) {
      const int k = r + i * 32;
      f32x4 v = f32x4{0.f, 0.f, 0.f, 0.f};
      if (n0 + c4 < N) v = *(const f32x4*)&src[(size_t)(k0 + k) * N + n0 + c4];
      tile[k * 65 + c4 + 0] = v[0]; tile[k * 65 + c4 + 1] = v[1]; tile[k * 65 + c4 + 2] = v[2]; tile[k * 65 + c4 + 3] = v[3];
    }
  }
  __syncthreads();
  {
    const int nl = tid >> 3, kq = (tid & 7) * 8;
    const int n = n0 + nl;
    int np = n;
    if (perm == 1) { const int part = n >> 10, c = n & 1023; np = (c >> 6) * 256 + (part >> 1) * 128 + ((c >> 4) & 3) * 32 + (part & 1) * 16 + (c & 15); }
    else if (perm == 2) { const int type = n >> 8, cc = n & 255; np = mat * 512 + (cc >> 4) * 32 + type * 16 + (cc & 15); }
    else if (perm == 3) { const int hh = n >> 7, dd = n & 127; np = (dd >= 64 ? 1024 : 0) + hh * 64 + (dd & 63); }
    if (n < N) {
      unsigned w[4];
#pragma unroll
      for (int i = 0; i < 4; ++i) w[i] = pack2(tile[(kq + 2 * i) * 65 + nl], tile[(kq + 2 * i + 1) * 65 + nl]);
      *(uint4*)&dst[(size_t)np * K + k0 + kq] = make_uint4(w[0], w[1], w[2], w[3]);
    }
  }
  __syncthreads();
}

__device__ __forceinline__ void wconv_item(const Params& p, int t, float* fs) {
  const float* src; u16* dst; int N, K, perm = 0, mat = 0, ntn;
  if (t < 1280) { src = p.in[12]; dst = (u16*)(p.ws + WS_W_HG_IN); N = 5120; K = 1024; }
  else if ((t -= 1280) < 256) { src = p.in[15]; dst = (u16*)(p.ws + WS_W_HG_OUT); N = 1024; K = 1024; }
  else if ((t -= 256) < 1024) { src = p.in[16]; dst = (u16*)(p.ws + WS_W_SC_IN); N = 4096; K = 1024; perm = 1; }
  else if ((t -= 1024) < 256) { src = p.in[19]; dst = (u16*)(p.ws + WS_W_SC_OUT); N = 1024; K = 1024; }
  else if ((t -= 256) < 512) { src = p.in[20]; dst = (u16*)(p.ws + WS_W_RG_IN); N = 2048; K = 1024; }
  else if ((t -= 512) < 256) { mat = t >> 5; t &= 31; src = p.in[23] + (size_t)mat * 256 * 512; dst = (u16*)(p.ws + WS_W_RG_GATE); N = 512; K = 256; perm = 2; }
  else if ((t -= 256) < 256) { src = p.in[26]; dst = (u16*)(p.ws + WS_W_RG_OUT); N = 1024; K = 1024; }
  else if ((t -= 256) < 432) { src = p.in[27]; dst = (u16*)(p.ws + WS_W_MLA_IN); N = 1696; K = 1024; }
  else if ((t -= 432) < 144) { src = p.in[30]; dst = (u16*)(p.ws + WS_W_QB); N = 1536; K = 384; }
  else if ((t -= 144) < 128) { src = p.in[31]; dst = (u16*)(p.ws + WS_W_KVB); N = 2048; K = 256; perm = 3; }
  else { t -= 128; src = p.in[32]; dst = (u16*)(p.ws + WS_W_MLA_OUT); N = 1024; K = 1024; }
  ntn = (N + 63) >> 6;
  const int kt = t / ntn, ntl = t - kt * ntn;
  wconv_tile(src, N, K, dst, kt * 64, ntl * 64, perm, mat, fs);
}
__device__ __forceinline__ void wconv_idle(const Params& p, unsigned char* smem_raw, int bid, int nb, int t0, int t1) {
  if (nb == 256 && bid >= 192) for (int t = t0 + (bid - 192); t < t1; t += 64) wconv_item(p, t, (float*)smem_raw);
}

__device__ __forceinline__ void phase_prologue(const Params& p, unsigned char* smem_raw, int bid, int nb) {
  float* fs = (float*)smem_raw;
  const int tid = threadIdx.x;
  const int NMOD = 192, NWT = (nb == 256) ? 1536 : 4800;
  for (int it = bid; it < NMOD + 1 + NWT; it += nb) {
    if (it < NMOD) {
      const int l = it / 48, n0 = (it % 48) * 64;
      float* scond = fs;
      float* sred = fs + 5120;
      for (int i = tid; i < 5120; i += NT) {
        const int ci = i >> 10, k = i & 1023;
        float cv = ci == 0 ? p.in[7][k] : p.in[6][(ci - 1) * 1024 + k];
        scond[i] = siluf_(cv);
      }
      __syncthreads();
      const int col = tid & 63, kg = tid >> 6;
      const float* w = p.in[8] + (size_t)l * 1024 * 3072 + n0 + col;
      float a0 = 0, a1 = 0, a2 = 0, a3 = 0, a4 = 0;
#pragma unroll 16
      for (int k = kg * 128; k < kg * 128 + 128; ++k) {
        float wv = w[(size_t)k * 3072];
        a0 += scond[k] * wv; a1 += scond[1024 + k] * wv; a2 += scond[2048 + k] * wv; a3 += scond[3072 + k] * wv; a4 += scond[4096 + k] * wv;
      }
      sred[(kg * 5 + 0) * 64 + col] = a0; sred[(kg * 5 + 1) * 64 + col] = a1; sred[(kg * 5 + 2) * 64 + col] = a2;
      sred[(kg * 5 + 3) * 64 + col] = a3; sred[(kg * 5 + 4) * 64 + col] = a4;
      __syncthreads();
      float* mod = (float*)(p.ws + WS_MOD);
      if (tid < 320) {
        const int ci = tid >> 6, cc = tid & 63;
        float s = 0;
#pragma unroll
        for (int g = 0; g < 8; ++g) s += sred[(g * 5 + ci) * 64 + cc];
        mod[(l * 5 + ci) * 3072 + n0 + cc] = s + p.in[9][l * 3072 + n0 + cc];
      }
      __syncthreads();
    } else if (it == NMOD) {
      float* lb = (float*)(p.ws + WS_LB);
      for (int i = tid; i < 2048; i += NT) {
        const int d = i >> 10, c = i & 1023;
        const float* lg = p.in[13] + d * 5 * 1024 + c;
        float m = lg[0];
        for (int j = 1; j < 5; ++j) m = fmaxf(m, lg[j * 1024]);
        float s = 0;
        for (int j = 0; j < 5; ++j) s += expf(lg[j * 1024] - m);
        lb[i] = expf(lg[0] - m) / s;
      }
      int* cnt = (int*)(p.ws + WS_CNT);
      if (tid < 16) cnt[tid] = 0;
    } else {
      wconv_item(p, it - NMOD - 1, fs);
    }
  }
}

__device__ __forceinline__ void phase_h0(const Params& p, int bid, int nb) {
  const float* mod = (const float*)(p.ws + WS_MOD);
  u16* H = (u16*)(p.ws + WS_H);
  const size_t total = (size_t)(TOK / 4) * 256;
  for (size_t i = (size_t)bid * NT + threadIdx.x; i < total; i += (size_t)nb * NT) {
    const int row = (int)(i >> 8) * 4, c = ((int)i & 255) * 4;
    const float* xr = row < NPROMPT ? p.in[0] + (size_t)row * 1024 : p.in[1] + (size_t)(row - NPROMPT) * 1024;
    const float* m = mod + cond_of(row) * 3072;
    f32x4 x[4];
#pragma unroll
    for (int t = 0; t < 4; ++t) x[t] = *(const f32x4*)&xr[t * 1024 + c];
    const f32x4 sh = *(const f32x4*)&m[c];
    const f32x4 sc = *(const f32x4*)&m[1024 + c];
#pragma unroll
    for (int t = 0; t < 4; ++t)
      *(uint2*)&H[(size_t)(row + t) * 1024 + c] = pack4(x[t][0] * (1 + sc[0]) + sh[0], x[t][1] * (1 + sc[1]) + sh[1], x[t][2] * (1 + sc[2]) + sh[2], x[t][3] * (1 + sc[3]) + sh[3]);
  }
}

__device__ __forceinline__ void phase_ln(const Params& p, int l, int bid, int nb) {
  float* X = p.out;
  const float* g = p.in[10] + l * 1024;
  const float* b = p.in[11] + l * 1024;
  const float* mod = (const float*)(p.ws + WS_MOD) + (l + 1) * 5 * 3072;
  u16* H = (u16*)(p.ws + WS_H);
  const int lane = threadIdx.x & 63, wave = threadIdx.x >> 6;
  for (int row = bid * NW + wave; row < TOK; row += nb * NW) {
    float* xr = X + (size_t)row * 1024;
    f32x4 v[4];
    float s = 0;
#pragma unroll
    for (int i = 0; i < 4; ++i) { v[i] = *(const f32x4*)&xr[i * 256 + lane * 4]; s += v[i][0] + v[i][1] + v[i][2] + v[i][3]; }
    const float mu = wave_sum(s) * (1.0f / 1024.0f);
    float q = 0;
#pragma unroll
    for (int i = 0; i < 4; ++i)
#pragma unroll
      for (int j = 0; j < 4; ++j) { float dd = v[i][j] - mu; q += dd * dd; }
    const float rs = rsqrtf(wave_sum(q) * (1.0f / 1024.0f) + 1e-5f);
    const float* m = mod + cond_of(row) * 3072;
#pragma unroll
    for (int i = 0; i < 4; ++i) {
      const int c = i * 256 + lane * 4;
      f32x4 gg = *(const f32x4*)&g[c], bb = *(const f32x4*)&b[c];
      f32x4 y;
#pragma unroll
      for (int j = 0; j < 4; ++j) y[j] = (v[i][j] - mu) * rs * gg[j] + bb[j];
      *(f32x4*)&xr[c] = y;
      if (l < 3) {
        f32x4 sh = *(const f32x4*)&m[c], sc = *(const f32x4*)&m[1024 + c];
        *(uint2*)&H[(size_t)row * 1024 + c] = pack4(y[0] * (1 + sc[0]) + sh[0], y[1] * (1 + sc[1]) + sh[1], y[2] * (1 + sc[2]) + sh[2], y[3] * (1 + sc[3]) + sh[3]);
      }
    }
  }
}

__device__ __forceinline__ void phase_gla(const Params& p, unsigned char* smem_raw) {
  u16* s_qrel = (u16*)smem_raw;
  u16* s_krel = s_qrel + 32 * 136;
  u16* s_qcum = s_krel + 32 * 136;
  u16* s_kdT = s_qcum + 32 * 136;
  u16* s_vT = s_kdT + 128 * 40;
  u16* s_att = s_vT + 64 * 40;
  u16* s_S = s_att + 32 * 40;
  float* s_dec = (float*)(s_S + 64 * 136);
  float* s_part = s_dec + 128;
  int* s_u = (int*)(s_part + 512);
  int* counter = (int*)(p.ws + WS_CNT);
  const u16* qg = (const u16*)(p.ws + WS_B(0));
  const u16* vg = (const u16*)(p.ws + WS_B(1));
  const _Float16* lfg = (const _Float16*)(p.ws + WS_B(3));
  u16* og = (u16*)(p.ws + WS_B(5));
  const int tid = threadIdx.x, lane = tid & 63, w = tid >> 6, fr = lane & 15, fq = lane >> 4;
  const int kk = tid & 127, th = tid >> 7;
  const int ti = w >> 2, vi = w & 3;
  const int wk = w & 3, wv = w >> 2;
  while (true) {
    if (tid == 0) *s_u = atomicAdd(counter, 1);
    __syncthreads();
    const int u = *s_u;
    __syncthreads();
    if (u >= 1152) break;
    int b, rem, start, N, sample;
    if (u < 128) { sample = 1; b = u >> 5; rem = u & 31; start = NPROMPT + b * 1024; N = 1024; }
    else { sample = 0; b = (u - 128) >> 5; rem = (u - 128) & 31; start = b * 256; N = 256; }
    const int h = rem >> 2, d = (rem >> 1) & 1, vs = rem & 1;
    const int nc = N >> 5;
    f32x4 S[2][2];
#pragma unroll
    for (int mi = 0; mi < 2; ++mi)
#pragma unroll
      for (int ni = 0; ni < 2; ++ni) {
        f32x4 s4 = f32x4{0.f, 0.f, 0.f, 0.f};
        if (sample) {
          const float* s0 = p.in[2] + ((size_t)((b * 2 + d) * 8 + h)) * 16384;
#pragma unroll
          for (int j = 0; j < 4; ++j) s4[j] = s0[(wk * 32 + mi * 16 + fq * 4 + j) * 128 + vs * 64 + wv * 32 + ni * 16 + fr];
        }
        S[mi][ni] = s4;
        *(uint2*)&s_S[(wv * 32 + ni * 16 + fr) * 136 + wk * 32 + mi * 16 + fq * 4] = pack4(s4[0], s4[1], s4[2], s4[3]);
      }
    _Float16 lfraw[8]; u16 qraw[8]; uint2 vraw;
#define GLA_LOAD(cc) do { _Pragma("unroll") for (int i = 0; i < 8; ++i) { const int tt = (cc) * 32 + th * 8 + i; const size_t tok = start + (d ? (N - 1 - tt) : tt); \
      lfraw[i] = lfg[tok * 2048 + d * 1024 + h * 128 + kk]; qraw[i] = qg[tok * 1024 + h * 128 + kk]; } \
      { const int tt = (cc) * 32 + (tid >> 4); const size_t tok = start + (d ? (N - 1 - tt) : tt); vraw = *(const uint2*)&vg[tok * 1024 + h * 128 + vs * 64 + (tid & 15) * 4]; } } while (0)
    GLA_LOAD(0);
    for (int c = 0; c < nc; ++c) {
      {
        float lfv[8], qv[8];
#pragma unroll
        for (int i = 0; i < 8; ++i) { lfv[i] = (float)lfraw[i]; qv[i] = bf2f(qraw[i]); }
        const uint2 vv = vraw;
        if (c + 1 < nc) GLA_LOAD(c + 1);
        float run = 0;
        float cs[8];
#pragma unroll
        for (int i = 0; i < 8; ++i) { run += lfv[i]; cs[i] = run; }
        s_part[th * 128 + kk] = run;
        {
          const int s = tid >> 4, v4 = (tid & 15) * 4;
          s_vT[(v4 + 0) * 40 + s] = (u16)(vv.x & 0xffff); s_vT[(v4 + 1) * 40 + s] = (u16)(vv.x >> 16);
          s_vT[(v4 + 2) * 40 + s] = (u16)(vv.y & 0xffff); s_vT[(v4 + 3) * 40 + s] = (u16)(vv.y >> 16);
        }
        __syncthreads();
        const float p0 = s_part[kk], p1 = s_part[128 + kk], p2 = s_part[256 + kk], p3 = s_part[384 + kk];
        const float off = (th > 0 ? p0 : 0.f) + (th > 1 ? p1 : 0.f) + (th > 2 ? p2 : 0.f);
        const float ref = p0 + p1, total = p0 + p1 + p2 + p3;
        unsigned kd[4];
        const float eref = __expf(ref), etr = __expf(total - ref);
#pragma unroll
        for (int i = 0; i < 8; ++i) {
          const int t = th * 8 + i;
          const float cum = off + cs[i];
          const float kf = 1.0f - __expf(lfv[i]);
          const float e1 = __expf(cum - ref), e2 = __builtin_amdgcn_rcpf(e1);
          const float qe = qv[i] * e1, ke = kf * e2;
          s_qrel[t * 136 + kk] = f2bf(qe);
          s_krel[t * 136 + kk] = f2bf(ke);
          s_qcum[t * 136 + kk] = f2bf(qe * eref);
          const u16 kdv = f2bf(ke * etr);
          if (i & 1) kd[i >> 1] |= ((unsigned)kdv) << 16; else kd[i >> 1] = kdv;
        }
        *(uint4*)&s_kdT[kk * 40 + th * 8] = make_uint4(kd[0], kd[1], kd[2], kd[3]);
        if (th == 0) s_dec[kk] = __expf(total);
      }
      __syncthreads();
      f32x4 oacc = f32x4{0.f, 0.f, 0.f, 0.f};
      {
        f32x4 att = f32x4{0.f, 0.f, 0.f, 0.f};
        const int ati = w >> 1, asi = w & 1;
#pragma unroll
        for (int ks = 0; ks < 4; ++ks) {
          if (w < 4) {
            bf16x8 a = *(const bf16x8*)&s_qrel[(ati * 16 + fr) * 136 + ks * 32 + fq * 8];
            bf16x8 bb = *(const bf16x8*)&s_krel[(asi * 16 + fr) * 136 + ks * 32 + fq * 8];
            att = __builtin_amdgcn_mfma_f32_16x16x32_bf16(a, bb, att, 0, 0, 0);
          }
          bf16x8 a2 = *(const bf16x8*)&s_qcum[(ti * 16 + fr) * 136 + ks * 32 + fq * 8];
          bf16x8 b2 = *(const bf16x8*)&s_S[(vi * 16 + fr) * 136 + ks * 32 + fq * 8];
          oacc = __builtin_amdgcn_mfma_f32_16x16x32_bf16(b2, a2, oacc, 0, 0, 0);
        }
        if (w < 4) {
#pragma unroll
          for (int j = 0; j < 4; ++j) {
            const int t = ati * 16 + fq * 4 + j, s = asi * 16 + fr;
            s_att[t * 40 + s] = (s <= t) ? f2bf(att[j]) : (u16)0;
          }
        }
      }
      __syncthreads();
      {
        bf16x8 a = *(const bf16x8*)&s_att[(ti * 16 + fr) * 40 + fq * 8];
        bf16x8 bb = *(const bf16x8*)&s_vT[(vi * 16 + fr) * 40 + fq * 8];
        oacc = __builtin_amdgcn_mfma_f32_16x16x32_bf16(bb, a, oacc, 0, 0, 0);
        {
          const int tt = c * 32 + ti * 16 + fr;
          const size_t tok = start + (d ? (N - 1 - tt) : tt);
          *(uint2*)&og[((size_t)d * TOK + tok) * 1024 + h * 128 + vs * 64 + vi * 16 + fq * 4] = pack4(oacc[0], oacc[1], oacc[2], oacc[3]);
        }
        bf16x8 vf[2];
#pragma unroll
        for (int ni = 0; ni < 2; ++ni) vf[ni] = *(const bf16x8*)&s_vT[(wv * 32 + ni * 16 + fr) * 40 + fq * 8];
#pragma unroll
        for (int mi = 0; mi < 2; ++mi) {
          bf16x8 kf = *(const bf16x8*)&s_kdT[(wk * 32 + mi * 16 + fr) * 40 + fq * 8];
          f32x4 dc = *(const f32x4*)&s_dec[wk * 32 + mi * 16 + fq * 4];
#pragma unroll
          for (int ni = 0; ni < 2; ++ni) {
            f32x4 s4 = S[mi][ni];
#pragma unroll
            for (int j = 0; j < 4; ++j) s4[j] *= dc[j];
            s4 = __builtin_amdgcn_mfma_f32_16x16x32_bf16(kf, vf[ni], s4, 0, 0, 0);
            S[mi][ni] = s4;
            *(uint2*)&s_S[(wv * 32 + ni * 16 + fr) * 136 + wk * 32 + mi * 16 + fq * 4] = pack4(s4[0], s4[1], s4[2], s4[3]);
          }
        }
      }
      __syncthreads();
    }
    if (!sample) {
      float* so = p.out + OUT_HG + ((size_t)((b * 2 + d) * 8 + h)) * 16384;
#pragma unroll
      for (int mi = 0; mi < 2; ++mi)
#pragma unroll
        for (int ni = 0; ni < 2; ++ni)
#pragma unroll
          for (int j = 0; j < 4; ++j) so[(wk * 32 + mi * 16 + fq * 4 + j) * 128 + vs * 64 + wv * 32 + ni * 16 + fr] = S[mi][ni][j];
    }
  }
}

__device__ __forceinline__ void phase_hg_post(const Params& p, int bid, int nb) {
  const u16* og = (const u16*)(p.ws + WS_B(5));
  const u16* sg = (const u16*)(p.ws + WS_B(2));
  u16* a = (u16*)(p.ws + WS_B(0));
  const float* ng = p.in[14];
  const int lane = threadIdx.x & 63, wave = threadIdx.x >> 6;
  float ngv[16];
#pragma unroll
  for (int k = 0; k < 4; ++k) { const f32x4 t = *(const f32x4*)&ng[lane * 16 + 4 * k]; ngv[4 * k] = t[0]; ngv[4 * k + 1] = t[1]; ngv[4 * k + 2] = t[2]; ngv[4 * k + 3] = t[3]; }
  for (int row0 = (bid * NW + wave) * 2; row0 < TOK; row0 += nb * NW * 2) {
    uint4 f[2][2], bw[2][2], sv[2][2];
#pragma unroll
    for (int r = 0; r < 2; ++r)
#pragma unroll
      for (int hh = 0; hh < 2; ++hh) {
        const size_t base = (size_t)(row0 + r) * 1024 + lane * 16 + hh * 8;
        f[r][hh] = *(const uint4*)&og[base];
        bw[r][hh] = *(const uint4*)&og[(size_t)TOK * 1024 + base];
        sv[r][hh] = *(const uint4*)&sg[base];
      }
#pragma unroll
    for (int r = 0; r < 2; ++r) {
      float o[16];
      float ss = 0;
#pragma unroll
      for (int hh = 0; hh < 2; ++hh) {
        const unsigned fa[4] = {f[r][hh].x, f[r][hh].y, f[r][hh].z, f[r][hh].w}, ba[4] = {bw[r][hh].x, bw[r][hh].y, bw[r][hh].z, bw[r][hh].w};
#pragma unroll
        for (int i = 0; i < 4; ++i) {
          o[hh * 8 + 2 * i] = lo16(fa[i]) + lo16(ba[i]);
          o[hh * 8 + 2 * i + 1] = hi16(fa[i]) + hi16(ba[i]);
        }
      }
#pragma unroll
      for (int i = 0; i < 16; ++i) ss += o[i] * o[i];
      ss += __shfl_xor(ss, 1); ss += __shfl_xor(ss, 2); ss += __shfl_xor(ss, 4);
      const float rs = rsqrtf(ss * (1.0f / 128.0f) + 1e-6f);
#pragma unroll
      for (int hh = 0; hh < 2; ++hh) {
        const unsigned sa[4] = {sv[r][hh].x, sv[r][hh].y, sv[r][hh].z, sv[r][hh].w};
        unsigned rr[4];
#pragma unroll
        for (int i = 0; i < 4; ++i)
          rr[i] = pack2(o[hh * 8 + 2 * i] * rs * ngv[hh * 8 + 2 * i] * siluf_(lo16(sa[i])), o[hh * 8 + 2 * i + 1] * rs * ngv[hh * 8 + 2 * i + 1] * siluf_(hi16(sa[i])));
        *(uint4*)&a[(size_t)(row0 + r) * 1024 + lane * 16 + hh * 8] = make_uint4(rr[0], rr[1], rr[2], rr[3]);
      }
    }
  }
}

__device__ __forceinline__ void seq_pos(int tok, int& n, int& L) {
  if (tok < NPROMPT) { n = tok & 255; L = 256; } else { n = (tok - NPROMPT) & 1023; L = 1024; }
}
__device__ __forceinline__ void phase_sc_conv(const Params& p, int bid, int nb) {
  const u16* pb = (const u16*)(p.ws + WS_B(0));
  const u16* sb = (const u16*)(p.ws + WS_B(1));
  u16* a = (u16*)(p.ws + WS_B(2));
  const float* cw = p.in[17]; const float* cbias = p.in[18];
  const size_t total = (size_t)TOK * 128;
  const size_t i0 = (size_t)bid * NT + threadIdx.x;
  const int c = ((int)i0 & 127) * 8;
  float w0[8], w1[8], w2[8], wb[8];
#pragma unroll
  for (int k = 0; k < 2; ++k) {
    const f32x4 t0 = *(const f32x4*)&cw[c + 4 * k], t1 = *(const f32x4*)&cw[1024 + c + 4 * k], t2 = *(const f32x4*)&cw[2048 + c + 4 * k], tb = *(const f32x4*)&cbias[c + 4 * k];
#pragma unroll
    for (int j = 0; j < 4; ++j) { w0[4 * k + j] = t0[j]; w1[4 * k + j] = t1[j]; w2[4 * k + j] = t2[j]; wb[4 * k + j] = tb[j]; }
  }
  const uint4 z = make_uint4(0, 0, 0, 0);
  for (size_t i = i0; i < total / 4; i += (size_t)nb * NT) {
    const int tok = (int)(i >> 7) * 4;
    int n, L; seq_pos(tok, n, L);
    const size_t base = (size_t)tok * 1024 + c;
    uint4 q[6], sv[4];
    q[0] = n > 0 ? *(const uint4*)&pb[base - 1024] : z;
#pragma unroll
    for (int t = 0; t < 4; ++t) { q[1 + t] = *(const uint4*)&pb[base + t * 1024]; sv[t] = *(const uint4*)&sb[base + t * 1024]; }
    q[5] = n + 4 < L ? *(const uint4*)&pb[base + 4096] : z;
#pragma unroll
    for (int t = 0; t < 4; ++t) {
      const unsigned am[4] = {q[t].x, q[t].y, q[t].z, q[t].w}, a0[4] = {q[t + 1].x, q[t + 1].y, q[t + 1].z, q[t + 1].w};
      const unsigned ap[4] = {q[t + 2].x, q[t + 2].y, q[t + 2].z, q[t + 2].w}, as[4] = {sv[t].x, sv[t].y, sv[t].z, sv[t].w};
      unsigned r[4];
#pragma unroll
      for (int k = 0; k < 4; ++k) {
        float z0 = w0[2 * k] * lo16(am[k]) + w1[2 * k] * lo16(a0[k]) + w2[2 * k] * lo16(ap[k]) + wb[2 * k];
        float z1 = w0[2 * k + 1] * hi16(am[k]) + w1[2 * k + 1] * hi16(a0[k]) + w2[2 * k + 1] * hi16(ap[k]) + wb[2 * k + 1];
        r[k] = pack2(lo16(as[k]) * z0, hi16(as[k]) * z1);
      }
      *(uint4*)&a[base + t * 1024] = make_uint4(r[0], r[1], r[2], r[3]);
    }
  }
}
__device__ __forceinline__ void phase_rg_conv(const Params& p, int bid, int nb) {
  const u16* ub = (const u16*)(p.ws + WS_B(0));
  u16* uc = (u16*)(p.ws + WS_B(2));
  const float* cw = p.in[21]; const float* cbias = p.in[22];
  const size_t total = (size_t)TOK * 128;
  const size_t i0 = (size_t)bid * NT + threadIdx.x;
  const int c = ((int)i0 & 127) * 8;
  float w0[8], w1[8], w2[8], w3[8], wb[8];
#pragma unroll
  for (int k = 0; k < 2; ++k) {
    const f32x4 t0 = *(const f32x4*)&cw[c + 4 * k], t1 = *(const f32x4*)&cw[1024 + c + 4 * k], t2 = *(const f32x4*)&cw[2048 + c + 4 * k], t3 = *(const f32x4*)&cw[3072 + c + 4 * k], tb = *(const f32x4*)&cbias[c + 4 * k];
#pragma unroll
    for (int j = 0; j < 4; ++j) { w0[4 * k + j] = t0[j]; w1[4 * k + j] = t1[j]; w2[4 * k + j] = t2[j]; w3[4 * k + j] = t3[j]; wb[4 * k + j] = tb[j]; }
  }
  const uint4 z = make_uint4(0, 0, 0, 0);
  for (size_t i = i0; i < total / 4; i += (size_t)nb * NT) {
    const int tok = (int)(i >> 7) * 4;
    int n, L; seq_pos(tok, n, L);
    const size_t base = (size_t)tok * 1024 + c;
    uint4 q[7];
    q[0] = n > 1 ? *(const uint4*)&ub[base - 2048] : z;
    q[1] = n > 0 ? *(const uint4*)&ub[base - 1024] : z;
#pragma unroll
    for (int t = 0; t < 4; ++t) q[2 + t] = *(const uint4*)&ub[base + t * 1024];
    q[6] = n + 4 < L ? *(const uint4*)&ub[base + 4096] : z;
#pragma unroll
    for (int t = 0; t < 4; ++t) {
      const unsigned a0[4] = {q[t].x, q[t].y, q[t].z, q[t].w}, a1[4] = {q[t + 1].x, q[t + 1].y, q[t + 1].z, q[t + 1].w};
      const unsigned a2[4] = {q[t + 2].x, q[t + 2].y, q[t + 2].z, q[t + 2].w}, a3[4] = {q[t + 3].x, q[t + 3].y, q[t + 3].z, q[t + 3].w};
      unsigned r[4];
#pragma unroll
      for (int k = 0; k < 4; ++k) {
        float z0 = w0[2 * k] * lo16(a0[k]) + w1[2 * k] * lo16(a1[k]) + w2[2 * k] * lo16(a2[k]) + w3[2 * k] * lo16(a3[k]) + wb[2 * k];
        float z1 = w0[2 * k + 1] * hi16(a0[k]) + w1[2 * k + 1] * hi16(a1[k]) + w2[2 * k + 1] * hi16(a2[k]) + w3[2 * k + 1] * hi16(a3[k]) + wb[2 * k + 1];
        r[k] = pack2(z0, z1);
      }
      *(uint4*)&uc[((size_t)(c >> 6) * TOK + tok + t) * 64 + (c & 63)] = make_uint4(r[0], r[1], r[2], r[3]);
    }
  }
}

__device__ __forceinline__ void phase_rg_scan(const Params& p, unsigned char* smem_raw, int bid, int nb) {
  float* sA = (float*)smem_raw;
  float* sB = sA + 2048;
  const u16* rb = (const u16*)(p.ws + WS_B(3));
  const u16* ib = (const u16*)(p.ws + WS_B(5));
  const u16* uc = (const u16*)(p.ws + WS_B(2));
  const u16* sg = (const u16*)(p.ws + WS_B(1));
  u16* hfw = (u16*)(p.ws + WS_H);
  u16* yp = (u16*)(p.ws + WS_B(0));
  const int tid = threadIdx.x;
  for (int u = bid; u < 768; u += nb) {
    int sample, b, c, seg, nseg, start, chs, slot;
    if (u < 256) {
      const int xq = u & 7, yq = u >> 3, gid = (yq >> 2) * 8 + xq, sub = yq & 3;
      sample = 1; b = gid >> 4; slot = (tid & 3) * 4; c = (gid & 15) * 64 + sub * 16 + slot; seg = tid >> 2; nseg = 128; start = NPROMPT + b * 1024; chs = 16; }
    else { sample = 0; b = (u - 256) >> 4; slot = (tid & 15) * 4; c = ((u - 256) & 15) * 64 + slot; seg = tid >> 4; nseg = 32; start = b * 256; chs = 64; }
    const int L = nseg * 8;
#pragma unroll 1
    for (int d = 0; d < 2; ++d) {
      const f32x4 lam = *(const f32x4*)&p.in[25][d * 1024 + c];
      float cl[4];
#pragma unroll
      for (int j = 0; j < 4; ++j) cl[j] = 8.0f * log1pf(__expf(-lam[j]));
      const u16* rp = rb + (size_t)d * TOK * 1024;
      const u16* ip = ib + (size_t)d * TOK * 1024;
      const int tok0 = start + (d ? L - 1 - seg * 8 : seg * 8);
      const size_t o0 = (size_t)tok0 * 1024 + c;
      const long ostep = d ? -1024 : 1024;
      const size_t g0 = ((size_t)(c >> 6) * TOK + tok0) * 64 + (c & 63);
      const long gstep = d ? -64 : 64;
      uint2 rr[8], ii[8], uu[8];
#pragma unroll
      for (int s8 = 0; s8 < 8; ++s8) { rr[s8] = *(const uint2*)&rp[g0 + s8 * gstep]; ii[s8] = *(const uint2*)&ip[g0 + s8 * gstep]; uu[s8] = *(const uint2*)&uc[g0 + s8 * gstep]; }
      uint2 hf[8], sgv[8];
      if (d == 1) {
#pragma unroll
        for (int s8 = 0; s8 < 8; ++s8) { hf[s8] = *(const uint2*)&hfw[g0 + s8 * gstep]; sgv[s8] = *(const uint2*)&sg[g0 + s8 * gstep]; }
      }
      float av[8][4], xv[8][4];
      float A[4] = {1.f, 1.f, 1.f, 1.f}, B[4] = {0.f, 0.f, 0.f, 0.f};
#pragma unroll
      for (int s8 = 0; s8 < 8; ++s8) {
        const float r4[4] = {lo16(rr[s8].x), hi16(rr[s8].x), lo16(rr[s8].y), hi16(rr[s8].y)};
        const float i4[4] = {lo16(ii[s8].x), hi16(ii[s8].x), lo16(ii[s8].y), hi16(ii[s8].y)};
        const float u4[4] = {lo16(uu[s8].x), hi16(uu[s8].x), lo16(uu[s8].y), hi16(uu[s8].y)};
#pragma unroll
        for (int j = 0; j < 4; ++j) {
          const float la = -cl[j] * r4[j];
          const float a = __expf(la);
          const float xin = __builtin_amdgcn_sqrtf(fmaxf(1.0f - __expf(2.0f * la), 0.f)) * (i4[j] * u4[j]);
          av[s8][j] = a; xv[s8][j] = xin;
          A[j] *= a; B[j] = a * B[j] + xin;
        }
      }
      *(f32x4*)&sA[seg * chs + slot] = f32x4{A[0], A[1], A[2], A[3]};
      *(f32x4*)&sB[seg * chs + slot] = f32x4{B[0], B[1], B[2], B[3]};
      for (int k = 1; k < nseg; k <<= 1) {
        __syncthreads();
        f32x4 pa = f32x4{1.f, 1.f, 1.f, 1.f}, pb2 = f32x4{0.f, 0.f, 0.f, 0.f};
        if (seg >= k) { pa = *(const f32x4*)&sA[(seg - k) * chs + slot]; pb2 = *(const f32x4*)&sB[(seg - k) * chs + slot]; }
        __syncthreads();
        if (seg >= k) {
#pragma unroll
          for (int j = 0; j < 4; ++j) { B[j] = A[j] * pb2[j] + B[j]; A[j] = A[j] * pa[j]; }
          *(f32x4*)&sA[seg * chs + slot] = f32x4{A[0], A[1], A[2], A[3]};
          *(f32x4*)&sB[seg * chs + slot] = f32x4{B[0], B[1], B[2], B[3]};
        }
      }
      __syncthreads();
      float h[4];
      {
        f32x4 h0v = f32x4{0.f, 0.f, 0.f, 0.f};
        if (sample) h0v = *(const f32x4*)&p.in[3][(b * 2 + d) * 1024 + c];
        if (seg > 0) {
          const f32x4 pa = *(const f32x4*)&sA[(seg - 1) * chs + slot], pb2 = *(const f32x4*)&sB[(seg - 1) * chs + slot];
#pragma unroll
          for (int j = 0; j < 4; ++j) h[j] = pa[j] * h0v[j] + pb2[j];
        } else {
#pragma unroll
          for (int j = 0; j < 4; ++j) h[j] = h0v[j];
        }
      }
#pragma unroll
      for (int s8 = 0; s8 < 8; ++s8) {
#pragma unroll
        for (int j = 0; j < 4; ++j) h[j] = av[s8][j] * h[j] + xv[s8][j];
        const size_t o = o0 + s8 * ostep;
        if (d == 0) *(uint2*)&hfw[g0 + s8 * gstep] = pack4(h[0], h[1], h[2], h[3]);
        else *(uint2*)&yp[g0 + s8 * gstep] = pack4((lo16(hf[s8].x) + h[0]) * lo16(sgv[s8].x), (hi16(hf[s8].x) + h[1]) * hi16(sgv[s8].x),
                                     (lo16(hf[s8].y) + h[2]) * lo16(sgv[s8].y), (hi16(hf[s8].y) + h[3]) * hi16(sgv[s8].y));
      }
      if (!sample && seg == nseg - 1) *(f32x4*)&p.out[OUT_RG + (b * 2 + d) * 1024 + c] = f32x4{h[0], h[1], h[2], h[3]};
      __syncthreads();
    }
  }
}

__device__ __forceinline__ void phase_mla_norm(const Params& p, int bid, int nb) {
  u16* cq = (u16*)(p.ws + WS3_CQ);
  u16* ckvall = (u16*)(p.ws + WS3_CKVALL);
  const float* ckvraw = (const float*)(p.ws + WS3_CKVRAW);
  const float* kperaw = (const float*)(p.ws + WS3_KPERAW);
  u16* Kb = (u16*)(p.ws + WS3_K);
  const float* qn = p.in[28]; const float* kvn = p.in[29];
  const int lane = threadIdx.x & 63, wave = threadIdx.x >> 6;
  float qnv[6];
#pragma unroll
  for (int i = 0; i < 3; ++i) { qnv[2 * i] = qn[(i * 64 + lane) * 2]; qnv[2 * i + 1] = qn[(i * 64 + lane) * 2 + 1]; }
  const f32x4 g4 = *(const f32x4*)&kvn[lane * 4];
  for (int row = bid * NW + wave; row < TOK + 2048; row += nb * NW) {
    if (row < TOK) {
      const int tok = row;
      const bool sample = tok >= NPROMPT;
      const int bs = (tok - NPROMPT) >> 10, n = (tok - NPROMPT) & 1023;
      const size_t kvrow = sample ? (size_t)(NPROMPT + bs * 1536 + 512 + n) : (size_t)tok;
      unsigned* cqr = (unsigned*)&cq[(size_t)tok * 384];
      unsigned cv[3]; float ss = 0;
#pragma unroll
      for (int i = 0; i < 3; ++i) { cv[i] = cqr[i * 64 + lane]; float a = lo16(cv[i]), b2 = hi16(cv[i]); ss += a * a + b2 * b2; }
      const float rsq = rsqrtf(wave_sum(ss) * (1.0f / 384.0f) + 1e-6f);
#pragma unroll
      for (int i = 0; i < 3; ++i) {
        cqr[i * 64 + lane] = pack2(lo16(cv[i]) * rsq * qnv[2 * i], hi16(cv[i]) * rsq * qnv[2 * i + 1]);
      }
      f32x4 kv = *(const f32x4*)&ckvraw[(size_t)tok * 256 + lane * 4];
      const float rsk = rsqrtf(wave_sum(kv[0] * kv[0] + kv[1] * kv[1] + kv[2] * kv[2] + kv[3] * kv[3]) * (1.0f / 256.0f) + 1e-6f);
      f32x4 o4;
#pragma unroll
      for (int j = 0; j < 4; ++j) o4[j] = kv[j] * rsk * g4[j];
      *(uint2*)&ckvall[kvrow * 256 + lane * 4] = pack4(o4[0], o4[1], o4[2], o4[3]);
      if (!sample) *(f32x4*)&p.out[OUT_CKV + (size_t)tok * 256 + lane * 4] = o4;
      float v = kperaw[(size_t)tok * 32 + (lane & 31)];
      if (!sample) { if (lane < 32) p.out[OUT_KPE + (size_t)tok * 32 + lane] = v; }
      else {
        const float partner = __shfl_xor(v, 8);
        const int i16 = lane & 15;
        const float pos = (lane & 16) ? (float)(n & 63) : (float)(n >> 6);
        float sn, cs; rope_sincos(pos, i16 & 7, sn, cs);
        v = (i16 < 8) ? (v * cs - partner * sn) : (partner * sn + v * cs);
      }
      const u16 vb = f2bf(v);
#pragma unroll
      for (int i = 0; i < 8; ++i) Kb[(kvrow * 16 + (lane >> 5) + 2 * i) * 96 + 64 + (lane & 31)] = vb;
    } else {
      const int r = row - TOK, bs = r >> 9, j = r & 511;
      const size_t kvrow = (size_t)(NPROMPT + bs * 1536 + j);
      f32x4 kv = *(const f32x4*)&p.in[4][(size_t)r * 256 + lane * 4];
      *(uint2*)&ckvall[kvrow * 256 + lane * 4] = pack4(kv[0], kv[1], kv[2], kv[3]);
      const u16 vb = f2bf(p.in[5][(size_t)r * 32 + (lane & 31)]);
#pragma unroll
      for (int i = 0; i < 8; ++i) Kb[(kvrow * 16 + (lane >> 5) + 2 * i) * 96 + 64 + (lane & 31)] = vb;
    }
  }
}

__device__ __forceinline__ void phase_attn(const Params& p, unsigned char* smem_raw, int bid, int nb) {
  u16* sK = (u16*)smem_raw;
  u16* sV = sK + 128 * 104;
  const u16* qg = (const u16*)(p.ws + WS3_Q);
  const u16* Kg = (const u16*)(p.ws + WS3_K);
  const u16* Vg = (const u16*)(p.ws + WS3_VT);
  const u16* sg = (const u16*)(p.ws + WS3_SG);
  u16* ao = (u16*)(p.ws + WS_H);
  const int tid = threadIdx.x, lane = tid & 63, w = tid >> 6, fr = lane & 15, fq = lane >> 4;
  for (int u = bid; u < 1536; u += nb) {
    int tok0, kvbase, nkeys, h;
    if (u < 512) { const int b = u >> 7, r = u & 127; h = r >> 3; const int qb = r & 7; tok0 = NPROMPT + b * 1024 + qb * 128; kvbase = NPROMPT + b * 1536; nkeys = 1536; }
    else { const int uu = u - 512; const int b = uu >> 5, r = uu & 31; h = r >> 1; const int qb = r & 1; tok0 = b * 256 + qb * 128; kvbase = b * 256; nkeys = 256; }
    const int tokq = tok0 + w * 16 + fr;
    bf16x8 qf[3];
#pragma unroll
    for (int ks = 0; ks < 3; ++ks) qf[ks] = *(const bf16x8*)&qg[(size_t)tokq * 1536 + h * 96 + ks * 32 + fq * 8];
    if (u < 512) {
      const int npos = (tokq - NPROMPT) & 1023;
      const float pos = (fq & 2) ? (float)(npos & 63) : (float)(npos >> 6);
      uint4 raw = *(uint4*)&qf[2];
      unsigned rw[4] = {raw.x, raw.y, raw.z, raw.w};
#pragma unroll
      for (int i = 0; i < 4; ++i) {
        float v0 = lo16(rw[i]), v1 = hi16(rw[i]);
        const float p0 = __shfl_xor(v0, 16), p1 = __shfl_xor(v1, 16);
        float sn0, cs0, sn1, cs1;
        rope_sincos(pos, 2 * i, sn0, cs0); rope_sincos(pos, 2 * i + 1, sn1, cs1);
        v0 = (fq & 1) ? (p0 * sn0 + v0 * cs0) : (v0 * cs0 - p0 * sn0);
        v1 = (fq & 1) ? (p1 * sn1 + v1 * cs1) : (v1 * cs1 - p1 * sn1);
        rw[i] = pack2(v0, v1);
      }
      raw = make_uint4(rw[0], rw[1], rw[2], rw[3]);
      qf[2] = *(bf16x8*)&raw;
    }
    float m = -1e30f, l = 0.f;
    f32x4 oacc[4];
#pragma unroll
    for (int i = 0; i < 4; ++i) oacc[i] = f32x4{0.f, 0.f, 0.f, 0.f};
    const int kk0 = tid / 12, kc0 = tid - kk0 * 12;
    const int kk1 = (tid + NT) / 12, kc1 = (tid + NT) - kk1 * 12;
    const int kk2_ = (tid + 2 * NT) / 12, kc2 = (tid + 2 * NT) - kk2_ * 12;
    const u16* Kp0 = &Kg[((size_t)(kvbase + kk0) * 16 + h) * 96 + kc0 * 8];
    const u16* Kp1 = &Kg[((size_t)(kvbase + kk1) * 16 + h) * 96 + kc1 * 8];
    const u16* Kp2 = &Kg[((size_t)(kvbase + kk2_) * 16 + h) * 96 + kc2 * 8];
    const int vd0 = tid >> 4, vc0 = tid & 15, vd1 = (tid + NT) >> 4;
    const u16* Vp0 = &Vg[(size_t)(h * 64 + vd0) * KVROWS + kvbase + vc0 * 8];
    const u16* Vp1 = &Vg[(size_t)(h * 64 + vd1) * KVROWS + kvbase + vc0 * 8];
    uint4 kr0 = *(const uint4*)Kp0, kr1 = *(const uint4*)Kp1, kr2 = *(const uint4*)Kp2, vr0 = *(const uint4*)Vp0, vr1 = *(const uint4*)Vp1;
    const int ntile2 = nkeys >> 7;
    for (int kt = 0; kt < ntile2; ++kt) {
      __syncthreads();
      *(uint4*)&sK[kk0 * 104 + kc0 * 8] = kr0; *(uint4*)&sK[kk1 * 104 + kc1 * 8] = kr1; *(uint4*)&sK[kk2_ * 104 + kc2 * 8] = kr2;
      *(uint4*)&sV[vd0 * 136 + vc0 * 8] = vr0; *(uint4*)&sV[vd1 * 136 + vc0 * 8] = vr1;
      if (kt + 1 < ntile2) {
        const size_t ko = (size_t)(kt + 1) * 128 * 1536; const int vo = (kt + 1) * 128;
        kr0 = *(const uint4*)(Kp0 + ko); kr1 = *(const uint4*)(Kp1 + ko); kr2 = *(const uint4*)(Kp2 + ko);
        vr0 = *(const uint4*)(Vp0 + vo); vr1 = *(const uint4*)(Vp1 + vo);
      }
      __syncthreads();
      f32x4 sacc[8];
#pragma unroll
      for (int ni = 0; ni < 8; ++ni) {
        sacc[ni] = f32x4{0.f, 0.f, 0.f, 0.f};
#pragma unroll
        for (int ks = 0; ks < 3; ++ks) {
          bf16x8 kf = *(const bf16x8*)&sK[(ni * 16 + fr) * 104 + ks * 32 + fq * 8];
          sacc[ni] = __builtin_amdgcn_mfma_f32_16x16x32_bf16(kf, qf[ks], sacc[ni], 0, 0, 0);
        }
      }
      float mx = -1e30f;
#pragma unroll
      for (int ni = 0; ni < 8; ++ni)
#pragma unroll
        for (int j = 0; j < 4; ++j) mx = fmaxf(mx, sacc[ni][j]);
      mx = fmaxf(mx, __shfl_xor(mx, 16));
      mx = fmaxf(mx, __shfl_xor(mx, 32));
      const float mnew = fmaxf(m, mx);
      const float alpha = __builtin_amdgcn_exp2f(m - mnew);
      m = mnew;
      float ls = 0.f;
#pragma unroll
      for (int ni = 0; ni < 8; ++ni)
#pragma unroll
        for (int j = 0; j < 4; ++j) { float e = __builtin_amdgcn_exp2f(sacc[ni][j] - mnew); sacc[ni][j] = e; ls += e; }
      l = l * alpha + ls;
      bf16x8 pf[4];
#pragma unroll
      for (int kk2 = 0; kk2 < 4; ++kk2) {
        uint2 lo = pack4(sacc[2 * kk2][0], sacc[2 * kk2][1], sacc[2 * kk2][2], sacc[2 * kk2][3]);
        uint2 hi = pack4(sacc[2 * kk2 + 1][0], sacc[2 * kk2 + 1][1], sacc[2 * kk2 + 1][2], sacc[2 * kk2 + 1][3]);
        uint4 pk = make_uint4(lo.x, lo.y, hi.x, hi.y);
        pf[kk2] = *(bf16x8*)&pk;
      }
#pragma unroll
      for (int di = 0; di < 4; ++di) {
#pragma unroll
        for (int j = 0; j < 4; ++j) oacc[di][j] *= alpha;
#pragma unroll
        for (int kk2 = 0; kk2 < 4; ++kk2) {
          uint2 v0 = *(const uint2*)&sV[(di * 16 + fr) * 136 + kk2 * 32 + fq * 4];
          uint2 v1 = *(const uint2*)&sV[(di * 16 + fr) * 136 + kk2 * 32 + 16 + fq * 4];
          uint4 vk = make_uint4(v0.x, v0.y, v1.x, v1.y);
          oacc[di] = __builtin_amdgcn_mfma_f32_16x16x32_bf16(*(bf16x8*)&vk, pf[kk2], oacc[di], 0, 0, 0);
        }
      }
    }
    l += __shfl_xor(l, 16);
    l += __shfl_xor(l, 32);
    const float inv = 1.0f / l;
#pragma unroll
    for (int di = 0; di < 4; ++di) {
      const size_t o = (size_t)tokq * 1024 + h * 64 + di * 16 + fq * 4;
      uint2 s = *(const uint2*)&sg[o];
      *(uint2*)&ao[o] = pack4(oacc[di][0] * inv * siluf_(lo16(s.x)), oacc[di][1] * inv * siluf_(hi16(s.x)), oacc[di][2] * inv * siluf_(lo16(s.y)), oacc[di][3] * inv * siluf_(hi16(s.y)));
    }
  }
}

#define XB_TMO      128
#define XB_XCNT(j)  (256  + 64 * (j))
#define XB_XSUB(j)  (1280 + 64 * (j))
#define XB_XGEN(j)  (2304 + 64 * (j))
#define XB_TOP      3328
#define XB_TOPGEN   3392
#define XCD_BAR_WORDS 3456
#define XB_SPIN_CAP (1u << 22)
__device__ __forceinline__ unsigned xb_ld(unsigned* p)              { return __hip_atomic_load(p, __ATOMIC_RELAXED, __HIP_MEMORY_SCOPE_AGENT); }
__device__ __forceinline__ unsigned xb_add(unsigned* p, unsigned v) { return __hip_atomic_fetch_add(p, v, __ATOMIC_RELAXED, __HIP_MEMORY_SCOPE_AGENT); }
__device__ __forceinline__ unsigned xb_xcc_id() { return (unsigned)__builtin_amdgcn_s_getreg((3 << 11) | 20) & 0xFu; }
#define XB_SPIN(cond, bar) do { unsigned _sp = 0; while (cond) { __builtin_amdgcn_s_sleep(1); \
    if ((++_sp & 255u) == 0u) { if (xb_ld(&(bar)[XB_TMO])) break; if (_sp > XB_SPIN_CAP) { atomicAdd(&(bar)[XB_TMO], 1u); break; } } } } while (0)
struct XcdBarrier { unsigned* bar; unsigned x; volatile LAS unsigned* st; };
__device__ __forceinline__ XcdBarrier xcd_barrier_post(unsigned* bar, volatile LAS unsigned* st) {
  XcdBarrier b; b.bar = bar; b.x = xb_xcc_id(); b.st = st;
  if (threadIdx.x == 0) (void)xb_add(&bar[XB_XCNT(b.x)], 1u);
  return b;
}
__device__ __forceinline__ void xcd_barrier_complete(unsigned* bar, unsigned x, unsigned& nloc, unsigned& nx) {
  const unsigned G = gridDim.x * gridDim.y * gridDim.z;
  unsigned sum, cnt, mine, sp = 0u;
  for (;;) {
    sum = 0u; cnt = 0u; mine = 0u;
#pragma unroll
    for (unsigned j = 0; j < 16; ++j) { const unsigned c = xb_ld(&bar[XB_XCNT(j)]); sum += c; cnt += (c > 0u) ? 1u : 0u; mine = (j == x) ? c : mine; }
    if (sum == G) break;
    __builtin_amdgcn_s_sleep(1);
    if ((++sp & 255u) == 0u) { if (xb_ld(&bar[XB_TMO])) break; if (sp > XB_SPIN_CAP) { atomicAdd(&bar[XB_TMO], 1u); break; } }
  }
  nloc = mine > 0u ? mine : 1u; nx = cnt > 0u ? cnt : 1u;
}
__device__ __forceinline__ void xcd_barrier(const XcdBarrier& b) {
  asm volatile("s_waitcnt vmcnt(0)" ::: "memory");
  __syncthreads();
  if (threadIdx.x == 0) {
    unsigned* bar = b.bar;
    __builtin_amdgcn_s_waitcnt(0);
    unsigned nloc = b.st[0], nx = b.st[1];
    if (nloc == 0u) { xcd_barrier_complete(bar, b.x, nloc, nx); b.st[0] = nloc; b.st[1] = nx; }
    const unsigned old = xb_add(&bar[XB_XSUB(b.x)], 1u);
    const unsigned gen = old / nloc;
    if (old + 1u == (gen + 1u) * nloc) {
      __builtin_amdgcn_fence(__ATOMIC_RELEASE, "agent");
      asm volatile("s_waitcnt vmcnt(0)" ::: "memory");
      const unsigned og = xb_add(&bar[XB_TOP], 1u);
      const unsigned tg = og / nx;
      if (og + 1u == (tg + 1u) * nx) xb_add(&bar[XB_TOPGEN], 1u);
      else XB_SPIN(xb_ld(&bar[XB_TOPGEN]) == tg, bar);
      __builtin_amdgcn_fence(__ATOMIC_ACQUIRE, "agent");
      xb_add(&bar[XB_XGEN(b.x)], 1u);
      asm volatile("s_waitcnt vmcnt(0)" ::: "memory");
    } else {
      XB_SPIN(xb_ld(&bar[XB_XGEN(b.x)]) == gen, bar);
      __builtin_amdgcn_fence(__ATOMIC_ACQUIRE, "agent");
      asm volatile("s_waitcnt vmcnt(0)" ::: "memory");
    }
  }
  __syncthreads();
}

#define GEMM_LDS 131072
#define DYN_LDS (GEMM_LDS + 16)
#define WS_BAR (WS_CNT + 4096ull)

#define RUN_GEMM(Aptr, LDA, Bptr, MM, NN, KK, GATE, EPI, CID) RUN_GEMM_G(Aptr, LDA, Bptr, MM, NN, KK, GATE, EPI, nb, CID)
#define RUN_GEMM_G(Aptr, LDA, Bptr, MM, NN, KK, GATE, EPI, GG, CID) RUN_GEMM_X(Aptr, LDA, (size_t)128, (size_t)0, Bptr, MM, NN, KK, GATE, EPI, GG, CID)
#define GM_KSTEP ((size_t)TOK * 128)
#define RUN_GEMM_X(Aptr, LDA, KSA, GST, Bptr, MM, NN, KK, GATE, EPI, GG, CID) do { pg8::Gemm g_{(const u16*)(Aptr), (const u16*)(Bptr), MM, NN, KK, LDA, GATE, p.flags, KSA, GST}; \
    pg8::StaticOrder S_; S_.init(MM, NN, GG, CID); pg8::gemm_phase((LAS unsigned char*)smem_raw, g_, S_, EPI); } while (0)

__global__ void __launch_bounds__(NT, 2) mega(Params p) {
  extern __shared__ __attribute__((aligned(16))) unsigned char smem_raw[];
  const int bid = blockIdx.x, nb = gridDim.x;
  unsigned char* ws = p.ws;
  const float* mod = (const float*)(ws + WS_MOD);
  volatile LAS unsigned* xst = (volatile LAS unsigned*)((LAS unsigned char*)smem_raw + GEMM_LDS);
  XcdBarrier xb;
  if (p.phase_hi - p.phase_lo > 1) {
    if (threadIdx.x == 0) { xst[0] = 0u; xst[1] = 0u; }
    __syncthreads();
    xb = xcd_barrier_post((unsigned*)(ws + WS_BAR), xst);
  }
#define PH_BEGIN(n) if ((PHMASK & (1u << n)) && p.phase_lo <= n && n < p.phase_hi) { const int ph = n;
#define PH_FIN if (ph + 1 < p.phase_hi) { if (p.phase_lo < 0) cg::this_grid().sync(); else xcd_barrier(xb); } }
  PH_BEGIN(0) phase_prologue(p, smem_raw, bid, nb); PH_FIN
  PH_BEGIN(1) phase_h0(p, bid, nb); PH_FIN
  PH_BEGIN(2) {
    EpiHgIn e{(u16*)(ws + WS_B(0)), (u16*)(ws + WS_B(1)), (u16*)(ws + WS_B(2)), (_Float16*)(ws + WS_B(3)), (const float*)(ws + WS_LB)};
    RUN_GEMM(ws + WS_H, 1024, ws + WS_W_HG_IN, TOK, 5120, 1024, 0, e, bid);
  } PH_FIN
  PH_BEGIN(3) phase_gla(p, smem_raw); PH_FIN
  PH_BEGIN(4) phase_hg_post(p, bid, nb); PH_FIN
  PH_BEGIN(5) {
    EpiResLn<false, true> e{p.in[0], p.in[1], (const u16*)nullptr, p.out, (u16*)(ws + WS_XB), mod + 0 * 15360 + 2048, p.in[10] + 0 * 1024, p.in[11] + 0 * 1024, mod + 1 * 15360, (u16*)(ws + WS_H),
               (unsigned long long*)(ws + WS_SLOT) + 0 * 49152, (unsigned*)(ws + WS_CNT + 256) + 0 * 48};
    RUN_GEMM(ws + WS_B(0), 1024, ws + WS_W_HG_OUT, TOK, 1024, 1024, 0, e, bid);
    wconv_idle(p, smem_raw, bid, nb, 1536, 2816);
  } PH_FIN
  PH_BEGIN(7) {
    EpiScIn e{(u16*)(ws + WS_B(0)), (u16*)(ws + WS_B(1))};
    RUN_GEMM(ws + WS_H, 1024, ws + WS_W_SC_IN, TOK, 4096, 1024, 0, e, bid);
  } PH_FIN
  PH_BEGIN(8) phase_sc_conv(p, bid, nb); PH_FIN
  PH_BEGIN(9) {
    EpiResLn<true, true> e{p.out, p.out, (const u16*)(ws + WS_XB), p.out, (u16*)(ws + WS_XB), mod + 1 * 15360 + 2048, p.in[10] + 1 * 1024, p.in[11] + 1 * 1024, mod + 2 * 15360, (u16*)(ws + WS_H),
               (unsigned long long*)(ws + WS_SLOT) + 1 * 49152, (unsigned*)(ws + WS_CNT + 256) + 1 * 48};
    RUN_GEMM(ws + WS_B(2), 1024, ws + WS_W_SC_OUT, TOK, 1024, 1024, 0, e, bid);
    wconv_idle(p, smem_raw, bid, nb, 2816, 3840);
  } PH_FIN
  PH_BEGIN(11) {
    EpiRgIn e{(u16*)(ws + WS_B(0)), (u16*)(ws + WS_B(1))};
    RUN_GEMM(ws + WS_H, 1024, ws + WS_W_RG_IN, TOK, 2048, 1024, 0, e, bid);
  } PH_FIN
  PH_BEGIN(12) phase_rg_conv(p, bid, nb); PH_FIN
  PH_BEGIN(13) {
    EpiRgGate e{(u16*)(ws + WS_B(3)), (u16*)(ws + WS_B(5)), p.in[24]};
    RUN_GEMM_X(ws + WS_B(2), 64, GM_KSTEP, 4 * GM_KSTEP, ws + WS_W_RG_GATE, TOK, 4096, 256, 1, e, nb, bid);
  } PH_FIN
  PH_BEGIN(14) phase_rg_scan(p, smem_raw, bid, nb); PH_FIN
  PH_BEGIN(15) {
    EpiResLn<true, true> e{p.out, p.out, (const u16*)(ws + WS_XB), p.out, (u16*)(ws + WS_XB), mod + 2 * 15360 + 2048, p.in[10] + 2 * 1024, p.in[11] + 2 * 1024, mod + 3 * 15360, (u16*)(ws + WS_H),
               (unsigned long long*)(ws + WS_SLOT) + 2 * 49152, (unsigned*)(ws + WS_CNT + 256) + 2 * 48};
    RUN_GEMM_X(ws + WS_B(0), 64, GM_KSTEP, (size_t)0, ws + WS_W_RG_OUT, TOK, 1024, 1024, 0, e, nb, bid);
    wconv_idle(p, smem_raw, bid, nb, 3840, 4800);
  } PH_FIN
  PH_BEGIN(17) {
    EpiMlaIn e{(u16*)(ws + WS3_CQ), (float*)(ws + WS3_CKVRAW), (float*)(ws + WS3_KPERAW), (u16*)(ws + WS3_SG)};
    RUN_GEMM(ws + WS_H, 1024, ws + WS_W_MLA_IN, TOK, 768, 1024, 0, e, bid);
  } PH_FIN
  PH_BEGIN(18) phase_mla_norm(p, bid, nb); PH_FIN
  PH_BEGIN(19) {
    const bool bal = (nb == 256);
    EpiSg eg{(u16*)(ws + WS3_SG)};
    RUN_GEMM(ws + WS_H, 1024, ws + WS_W_MLA_IN + 672 * 1024 * 2, TOK, 1024, 1024, 0, eg, bid);
    EpiQ eq{(u16*)(ws + WS3_Q)};
    RUN_GEMM(ws + WS3_CQ, 384, ws + WS_W_QB, TOK, 1536, 384, 0, eq, bal ? ((bid + 64) & 255) : bid);
    EpiK ek{(u16*)(ws + WS3_K)};
    RUN_GEMM(ws + WS3_CKVALL, 256, ws + WS_W_KVB, KVROWS, 1024, 256, 0, ek, bal ? ((bid + 32) & 255) : bid);
    EpiV ev{(u16*)(ws + WS3_VT)};
    RUN_GEMM_G(ws + WS_W_KVB + 1024 * 256 * 2, 256, ws + WS3_CKVALL, 1024, KVROWS, 256, 0, ev, bal ? 64 : nb, bal ? (bid >= 192 ? bid - 192 : (1 << 20)) : bid);
  } PH_FIN
  PH_BEGIN(20) phase_attn(p, smem_raw, bid, nb); PH_FIN
  PH_BEGIN(21) {
    EpiResLn<true, false> e{p.out, p.out, (const u16*)(ws + WS_XB), p.out, (u16*)nullptr, mod + 3 * 15360 + 2048, p.in[10] + 3 * 1024, p.in[11] + 3 * 1024, mod + 3 * 15360, (u16*)nullptr,
               (unsigned long long*)(ws + WS_SLOT) + 3 * 49152, (unsigned*)(ws + WS_CNT + 256) + 3 * 48};
    RUN_GEMM(ws + WS_H, 1024, ws + WS_W_MLA_OUT, TOK, 1024, 1024, 0, e, bid);
  } PH_FIN
}

extern "C" void kernel_launch(void* const* d_in, const int* in_sizes, int n_in, void* d_out, int out_size, void* d_ws, size_t ws_size,
                              hipStream_t stream) {
  static int grid_blocks = 0;
  if (!grid_blocks) {
    int dev = 0, cus = 0, per_cu = 0;
    (void)hipGetDevice(&dev);
    (void)hipDeviceGetAttribute(&cus, hipDeviceAttributeMultiprocessorCount, dev);
    (void)hipFuncSetAttribute((const void*)mega, hipFuncAttributeMaxDynamicSharedMemorySize, DYN_LDS);
    (void)hipOccupancyMaxActiveBlocksPerMultiprocessor(&per_cu, (const void*)mega, NT, DYN_LDS);
    if (per_cu < 1) per_cu = 1;
    if (per_cu > 1) per_cu = 1;
    grid_blocks = cus * per_cu;
  }
  Params p{};
  for (int i = 0; i < 33; ++i) p.in[i] = (const float*)d_in[i];
  p.out = (float*)d_out;
  p.ws = (unsigned char*)d_ws;
#if MULTI_LAUNCH
  (void)hipMemsetAsync((unsigned char*)d_ws + WS_CNT, 0, 4096 + XCD_BAR_WORDS * 4, stream);
  for (int ph = 0; ph < NPHASES; ++ph) {
    p.phase_lo = ph; p.phase_hi = ph + 1;
    hipLaunchKernelGGL(mega, dim3(grid_blocks), dim3(NT), DYN_LDS, stream, p);
#ifdef PROBE_MASK
    if ((PROBE_MASK >> ph) & 1) { p.flags = PROBE_FLAGS; for (int r = 0; r < 2; ++r) {
      if (ph == 3) (void)hipMemsetAsync((unsigned char*)d_ws + WS_CNT, 0, 64, stream);
      hipLaunchKernelGGL(mega, dim3(grid_blocks), dim3(NT), DYN_LDS, stream, p);
    } p.flags = 0; }
#endif
  }
#else
  p.phase_lo = 0; p.phase_hi = NPHASES;
  (void)hipMemsetAsync((unsigned char*)d_ws + WS_CNT, 0, 4096 + XCD_BAR_WORDS * 4, stream);
  void* args[] = {&p};
  hipError_t e = hipLaunchCooperativeKernel((const void*)mega, dim3(grid_blocks), dim3(NT), args, DYN_LDS, stream);
  if (e != hipSuccess) fprintf(stderr, "cooperative launch failed: %s (grid %d)\n", hipGetErrorString(e), grid_blocks);
#endif
}
```

```cpp
#include <hip/hip_runtime.h>
#include <hip/hip_cooperative_groups.h>
#include <cstdio>
namespace cg = cooperative_groups;

#ifndef MULTI_LAUNCH
#define MULTI_LAUNCH 0
#endif

typedef unsigned short u16;
using bf16x8 = __attribute__((ext_vector_type(8))) short;
using f32x4 = __attribute__((ext_vector_type(4))) float;
typedef _Float16 h4 __attribute__((ext_vector_type(4)));

#define TOK 12288
#define NPROMPT 8192
#define KVROWS 14336
#define NPHASES 23
#ifndef PHMASK
#define PHMASK 0x7fffff
#endif
#define DN_ALPHA 1.6817928305074290f

#define WS_W_HG_IN 0ull
#define WS_W_HG_OUT (WS_W_HG_IN + 10485760ull)
#define WS_W_SC_IN (WS_W_HG_OUT + 2097152ull)
#define WS_W_SC_OUT (WS_W_SC_IN + 8388608ull)
#define WS_W_RG_IN (WS_W_SC_OUT + 2097152ull)
#define WS_W_RG_GATE (WS_W_RG_IN + 4194304ull)
#define WS_W_RG_OUT (WS_W_RG_GATE + 2097152ull)
#define WS_W_MLA_IN (WS_W_RG_OUT + 2097152ull)
#define WS_W_QB (WS_W_MLA_IN + 3670016ull)
#define WS_W_KVB (WS_W_QB + 1179648ull)
#define WS_W_MLA_OUT (WS_W_KVB + 1048576ull)
#define WS_MOD (WS_W_MLA_OUT + 2097152ull)
#define WS_LB (WS_MOD + 245760ull)
#define WS_CNT (WS_LB + 8192ull)
#define WS_R (WS_CNT + 4096ull + 16384ull)
#define BSZ 25165824ull
#define WS_H (WS_R)
#define WS_B(i) (WS_R + BSZ * (1 + (i)))
#define WS_SLOT (WS_R + 201326592ull)
#define WS_XB (WS_SLOT + 1572864ull)
#define WS3_CQ (WS_R + 25165824ull)
#define WS3_CKVALL (WS_R + 34603008ull)
#define WS3_CKVRAW (WS_R + 41943040ull)
#define WS3_KPERAW (WS_R + 54525952ull)
#define WS3_SG (WS_R + 56098816ull)
#define WS3_Q (WS_R + 81264640ull)
#define WS3_K (WS_R + 119013376ull)
#define WS3_VT (WS_R + 163053568ull)

#define OUT_HG 12582912
#define OUT_RG 20971520
#define OUT_CKV 21037056
#define OUT_KPE 23134208

struct Params {
  const float* in[33];
  float* out;
  unsigned char* ws;
  int phase_lo, phase_hi, flags, pad_;
};

__device__ __forceinline__ u16 f2bf(float f) { __bf16 r = (__bf16)f; return *(u16*)&r; }
__device__ __forceinline__ float bf2f(u16 h) { return __uint_as_float(((unsigned)h) << 16); }
typedef float f2v_ __attribute__((ext_vector_type(2)));
typedef __bf16 b2v_ __attribute__((ext_vector_type(2)));
__device__ __forceinline__ unsigned pack2(float a, float b) { f2v_ f = {a, b}; b2v_ r = __builtin_convertvector(f, b2v_); return *(unsigned*)&r; }
__device__ __forceinline__ uint2 pack4(float a, float b, float c, float d) { return make_uint2(pack2(a, b), pack2(c, d)); }
__device__ __forceinline__ float lo16(unsigned u) { return __uint_as_float(u << 16); }
__device__ __forceinline__ float hi16(unsigned u) { return __uint_as_float(u & 0xffff0000u); }
__device__ __forceinline__ float sigmoidf_(float x) { return __builtin_amdgcn_rcpf(1.0f + __expf(-x)); }
__device__ __forceinline__ float siluf_(float x) { return x * __builtin_amdgcn_rcpf(1.0f + __expf(-x)); }
__device__ __forceinline__ int cond_of(int tok) { return tok < NPROMPT ? 0 : 1 + ((tok - NPROMPT) >> 10); }
__device__ __forceinline__ float wave_sum(float v) {
#pragma unroll
  for (int o = 32; o > 0; o >>= 1) v += __shfl_xor(v, o);
  return v;
}
__device__ __forceinline__ void rope_sincos(float pos, int fi, float& sn, float& cs) {
  float inv = exp2f(-(float)fi * 1.6609640474436813f);
  float ang = pos * inv;
  float k = rintf(ang * 0.15915494309189535f);
  float r = fmaf(-k, 6.2831854820251465f, ang);
  r = fmaf(-k, -1.7484555e-7f, r);
  sn = __sinf(r); cs = __cosf(r);
}

#define NT 512
#define NW 8
#define LAS __attribute__((address_space(3)))

namespace pg8 {
constexpr int BM = 256, BK = 64, HALF = 128, HTB = HALF * BK * 2, STAGE_BYTES = 8 * HTB, NXCD = 8, WGM = 8;
__device__ __forceinline__ int lds_byte(int r, int c) { const int st = (r >> 4) * 2 + (c >> 5), rr = r & 15, cc = c & 31, ob = rr * 64 + cc * 2; return st * 1024 + (ob ^ (((ob >> 9) & 1) << 5)); }
__device__ __forceinline__ void stage_rc(int b, int& R, int& C) { const int st = b / 1024, sb = b % 1024, swz = sb ^ (((sb >> 9) & 1) << 5); R = (st >> 1) * 16 + swz / 64; C = (st & 1) * 32 + (swz % 64) / 2; }
struct Unit { int pm, pn; };
struct Gemm { const u16* A; const u16* Bt; int M, N, K, lda, gate, noepi; size_t kstepA, gstride; };
struct StaticOrder {
  int nM, nN, nwg, G, c;
  __device__ void init(int M, int N, int G_, int c_) { nM = M / BM; nN = N / BM; nwg = nM * nN; G = G_; c = c_; }
  __device__ bool next(int i, Unit& u) const {
    const long L = (long)i * G + c; if (L >= nwg) return false;
    int wgid = (int)L; { const int q = nwg / NXCD, r = nwg % NXCD, xcd = wgid % NXCD, off = wgid / NXCD; wgid = (xcd < r ? xcd * (q + 1) : r * (q + 1) + (xcd - r) * q) + off; }
    const int nig = WGM * nN, gid = wgid / nig, fm = gid * WGM, gsz = (nM - fm) < WGM ? (nM - fm) : WGM;
    u.pm = fm + ((wgid % nig) % gsz); u.pn = (wgid % nig) / gsz; return true;
  }
};
template <class Epi>
__device__ __forceinline__ void gemm_phase(LAS unsigned char* lds, const Gemm g, const StaticOrder& S, const Epi& E) {
  const int tid = threadIdx.x, wid = __builtin_amdgcn_readfirstlane(tid >> 6), lane = tid & 63, wr = wid >> 2, wc = wid & 3, fr = lane & 15, fq = lane >> 4;
  const int K = g.K, nt = K / BK;
  unsigned voffA[2], voffB[2];
#pragma unroll
  for (int i = 0; i < 2; ++i) { int R, C; stage_rc(tid * 16 + i * 8192, R, C); voffA[i] = (unsigned)(R * g.lda + C) * 2u; voffB[i] = (unsigned)(R * K + C) * 2u; }
  const size_t kstep = (size_t)(BK * 2);
  const size_t kstepA = g.kstepA;
  const size_t hstepA = (size_t)HALF * g.lda * 2, hstepB = (size_t)HALF * K * 2;
  const size_t tstepA = 2 * hstepA, tstepB = 2 * hstepB;
  const unsigned ldsw = (unsigned)wid * 1024u;
  const int aoff = lds_byte(wr * 64 + fr, fq * 8), boff = lds_byte(wc * 32 + fr, fq * 8);
#define PG8_AOFF(pn) (g.gate ? (size_t)(((pn) >> 1) & 3) * g.gstride : (size_t)0)
#define PG8_SA(b, h) (((b) * 2 + (h)) * HTB)
#define PG8_SB(b, h) ((4 + (b) * 2 + (h)) * HTB)
#define PG8_STAGE(bufoff, gbase, voff) do { _Pragma("unroll") for (int _i = 0; _i < 2; ++_i) \
    __builtin_amdgcn_global_load_lds((const unsigned*)((const char*)(gbase) + (voff)[_i]), (LAS unsigned*)(lds + (bufoff) + ldsw + _i * 8192), 16, 0, 0); } while (0)
#define PG8_LDA(dst, b, h) do { _Pragma("unroll") for (int m = 0; m < 4; ++m) _Pragma("unroll") for (int k = 0; k < 2; ++k) dst[m][k] = *(const LAS bf16x8*)(lds + PG8_SA(b, h) + aoff + m * 2048 + k * 1024); } while (0)
#define PG8_LDB(dst, b, h) do { _Pragma("unroll") for (int n = 0; n < 2; ++n) _Pragma("unroll") for (int k = 0; k < 2; ++k) dst[n][k] = *(const LAS bf16x8*)(lds + PG8_SB(b, h) + boff + n * 2048 + k * 1024); } while (0)
#define PG8_MMA(ai, bj, At, Bt) do { __builtin_amdgcn_s_setprio(1); _Pragma("unroll") for (int m = 0; m < 4; ++m) _Pragma("unroll") for (int n = 0; n < 2; ++n) _Pragma("unroll") for (int k = 0; k < 2; ++k) \
    acc[ai][bj][m][n] = __builtin_amdgcn_mfma_f32_16x16x32_bf16(Bt[n][k], At[m][k], acc[ai][bj][m][n], 0, 0, 0); __builtin_amdgcn_s_setprio(0); } while (0)
#define PG8_WAIT_V(n) asm volatile("s_waitcnt vmcnt(" #n ")" ::: "memory")
#define PG8_WAIT_L(n) asm volatile("s_waitcnt lgkmcnt(" #n ")" ::: "memory")
#define PG8_BAR __builtin_amdgcn_s_barrier()
#define PG8_SCHED __builtin_amdgcn_sched_barrier(0)
  Unit cur, nxt; int ui = 0;
  if (!S.next(0, cur)) return;
  f32x4 acc[2][2][4][2];
#pragma unroll
  for (int a = 0; a < 2; ++a)
#pragma unroll
    for (int b = 0; b < 2; ++b)
#pragma unroll
      for (int m = 0; m < 4; ++m)
#pragma unroll
        for (int n = 0; n < 2; ++n) acc[a][b][m][n] = (f32x4){0.f, 0.f, 0.f, 0.f};
  bf16x8 At[4][2], B0[2][2], B1[2][2];
  const char* cA = (const char*)g.A + (size_t)cur.pm * tstepA + PG8_AOFF(cur.pn); const char* cB = (const char*)g.Bt + (size_t)cur.pn * tstepB;
  PG8_STAGE(PG8_SB(0, 0), cB, voffB); PG8_STAGE(PG8_SA(0, 0), cA, voffA); PG8_STAGE(PG8_SB(0, 1), cB + hstepB, voffB); PG8_STAGE(PG8_SA(0, 1), cA + hstepA, voffA);
  if (wr == 1) PG8_BAR;
  PG8_WAIT_V(4); PG8_BAR;
  PG8_STAGE(PG8_SB(1, 0), cB + kstep, voffB); PG8_STAGE(PG8_SA(1, 0), cA + kstepA, voffA); PG8_STAGE(PG8_SB(1, 1), cB + hstepB + kstep, voffB);
  PG8_WAIT_V(6); PG8_BAR;
  for (;;) {
    const bool has_next = S.next(ui + 1, nxt);
    const char* nA = has_next ? (const char*)g.A + (size_t)nxt.pm * tstepA + PG8_AOFF(nxt.pn) : cA; const char* nB = has_next ? (const char*)g.Bt + (size_t)nxt.pn * tstepB : cB;
#pragma unroll 1
    for (int t = 0; t < nt; t += 2) {
      const bool last = (t == nt - 2);
      const char* a1 = cA + (size_t)(t + 1) * kstepA;
      const char* a2 = last ? nA : cA + (size_t)(t + 2) * kstepA; const char* b2 = last ? nB : cB + (size_t)(t + 2) * kstep;
      const char* a3 = a2 + kstepA; const char* b3 = b2 + kstep;
      PG8_LDB(B0, 0, 0); PG8_SCHED; PG8_LDA(At, 0, 0); PG8_STAGE(PG8_SA(1, 1), a1 + hstepA, voffA);
      PG8_WAIT_L(8); PG8_BAR; PG8_WAIT_L(0); PG8_MMA(0, 0, At, B0); PG8_BAR; PG8_SCHED;
      PG8_LDB(B1, 0, 1); PG8_STAGE(PG8_SB(0, 0), b2, voffB);
      PG8_BAR; PG8_WAIT_L(0); PG8_MMA(0, 1, At, B1); PG8_BAR;
      PG8_LDA(At, 0, 1); PG8_STAGE(PG8_SA(0, 0), a2, voffA);
      PG8_BAR; PG8_WAIT_L(0); PG8_MMA(1, 0, At, B0); PG8_BAR; PG8_SCHED;
      PG8_STAGE(PG8_SB(0, 1), b2 + hstepB, voffB);
      PG8_WAIT_V(6); PG8_BAR; PG8_MMA(1, 1, At, B1); PG8_BAR;
      PG8_LDB(B0, 1, 0); PG8_SCHED; PG8_LDA(At, 1, 0); PG8_STAGE(PG8_SA(0, 1), a2 + hstepA, voffA);
      PG8_WAIT_L(8); PG8_BAR; PG8_WAIT_L(0); PG8_MMA(0, 0, At, B0); PG8_BAR; PG8_SCHED;
      PG8_LDB(B1, 1, 1); PG8_STAGE(PG8_SB(1, 0), b3, voffB);
      PG8_BAR; PG8_WAIT_L(0); PG8_MMA(0, 1, At, B1); PG8_BAR;
      PG8_LDA(At, 1, 1); PG8_STAGE(PG8_SA(1, 0), a3, voffA);
      PG8_BAR; PG8_WAIT_L(0); PG8_MMA(1, 0, At, B0); PG8_BAR; PG8_SCHED;
      PG8_STAGE(PG8_SB(1, 1), b3 + hstepB, voffB);
      PG8_WAIT_V(6); PG8_BAR; PG8_MMA(1, 1, At, B1); PG8_BAR;
    }
    if constexpr (!Epi::AFTER_DRAIN) { if (!g.noepi) E(acc, cur, wr, wc, fr, fq); }
    if (!has_next) break;
#pragma unroll
    for (int a = 0; a < 2; ++a)
#pragma unroll
      for (int b = 0; b < 2; ++b)
#pragma unroll
        for (int m = 0; m < 4; ++m)
#pragma unroll
          for (int n = 0; n < 2; ++n) acc[a][b][m][n] = (f32x4){0.f, 0.f, 0.f, 0.f};
    cur = nxt; cA = nA; cB = nB; ++ui;
  }
  PG8_WAIT_V(0);
  if (wr == 0) PG8_BAR;
  PG8_BAR;
  if constexpr (Epi::AFTER_DRAIN) { if (!g.noepi) E.fused(acc, cur, wr, wc, fr, fq, lds); }
#undef PG8_AOFF
#undef PG8_SA
#undef PG8_SB
#undef PG8_STAGE
#undef PG8_LDA
#undef PG8_LDB
#undef PG8_MMA
#undef PG8_WAIT_V
#undef PG8_WAIT_L
#undef PG8_BAR
#undef PG8_SCHED
}
}
using pg8::Unit;
typedef const f32x4 (&AccRef)[2][2][4][2];

#define EPI_ROWS(...) _Pragma("unroll") for (int ai = 0; ai < 2; ++ai) _Pragma("unroll") for (int m = 0; m < 4; ++m) { const int row = u.pm * 256 + ai * 128 + wr * 64 + m * 16 + fr; __VA_ARGS__ }
#define EPI_COLS(...) _Pragma("unroll") for (int bj = 0; bj < 2; ++bj) _Pragma("unroll") for (int n = 0; n < 2; ++n) { const int cb = u.pn * 256 + bj * 128 + wc * 32 + n * 16; const f32x4 a = acc[ai][bj][m][n]; __VA_ARGS__ }

struct EpiHgIn {
  static constexpr bool AFTER_DRAIN = false;
  u16 *q, *v, *sg; _Float16* lf; const float* lb;
  __device__ __forceinline__ void operator()(AccRef acc, const Unit& u, int wr, int wc, int fr, int fq) const {
    const int region = u.pn >> 2;
    f32x4 l4[2][2];
    if (region == 1 || region == 2) {
#pragma unroll
      for (int bj = 0; bj < 2; ++bj)
#pragma unroll
        for (int n = 0; n < 2; ++n) l4[bj][n] = *(const f32x4*)&lb[(region - 1) * 1024 + ((u.pn * 256 + bj * 128 + wc * 32 + n * 16) & 1023) + fq * 4];
    }
    EPI_ROWS( EPI_COLS(
      const int c = (cb & 1023) + fq * 4;
      if (region == 0) {
        const float s = 0.08838834764831845f;
        *(uint2*)&q[(size_t)row * 1024 + c] = pack4(siluf_(a[0]) * s, siluf_(a[1]) * s, siluf_(a[2]) * s, siluf_(a[3]) * s);
      } else if (region <= 2) {
        const int d = region - 1;
        h4 o;
        _Pragma("unroll") for (int j = 0; j < 4; ++j) { float f = l4[bj][n][j] + (1.0f - l4[bj][n][j]) * sigmoidf_(a[j]); o[j] = (_Float16)__logf(f); }
        *(h4*)&lf[(size_t)row * 2048 + d * 1024 + c] = o;
      } else if (region == 3) {
        *(uint2*)&v[(size_t)row * 1024 + c] = pack4(a[0], a[1], a[2], a[3]);
      } else {
        *(uint2*)&sg[(size_t)row * 1024 + c] = pack4(a[0], a[1], a[2], a[3]);
      }
    ) )
  }
};

struct EpiRes {
  static constexpr bool AFTER_DRAIN = false;
  const float* xin_p; const float* xin_s; float* Y; const float* gate;
  __device__ __forceinline__ void operator()(AccRef acc, const Unit& u, int wr, int wc, int fr, int fq) const {
    EPI_ROWS(
      const float* xr = row < NPROMPT ? xin_p + (size_t)row * 1024 : xin_s + (size_t)(row - NPROMPT) * 1024;
      const float* g = gate + cond_of(row) * 3072;
      EPI_COLS(
        const int c = cb + fq * 4;
        f32x4 x = *(const f32x4*)&xr[c];
        f32x4 gg = *(const f32x4*)&g[c];
        f32x4 y;
        _Pragma("unroll") for (int j = 0; j < 4; ++j) y[j] = DN_ALPHA * x[j] + gg[j] * a[j];
        *(f32x4*)&Y[(size_t)row * 1024 + c] = y;
      ) )
  }
};

template <bool XIN_BF, bool XOUT_BF>
struct EpiResLn {
  static constexpr bool AFTER_DRAIN = true;
  const float* xin_p; const float* xin_s; const u16* xin_b; float* X; u16* XB; const float* gate; const float* lg; const float* lbias; const float* modn; u16* H;
  unsigned long long* slots; unsigned* cnt;
  __device__ __forceinline__ void fused(f32x4 (&acc)[2][2][4][2], const Unit& u, int wr, int wc, int fr, int fq, LAS unsigned char* lds) const {
    LAS float* part = (LAS float*)lds;
    LAS float* stat = part + 2048;
    const int tid = threadIdx.x;
    const int cnd = cond_of(u.pm * 256);
    f32x4 gv[2][2];
#pragma unroll
    for (int bj = 0; bj < 2; ++bj)
#pragma unroll
      for (int n = 0; n < 2; ++n) gv[bj][n] = *(const f32x4*)&gate[cnd * 3072 + u.pn * 256 + bj * 128 + wc * 32 + n * 16 + fq * 4];
#pragma unroll
    for (int ai = 0; ai < 2; ++ai)
#pragma unroll
      for (int m = 0; m < 4; ++m) {
        const int rl = ai * 128 + wr * 64 + m * 16 + fr;
        const int row = u.pm * 256 + rl;
        const float* xr = row < NPROMPT ? xin_p + (size_t)row * 1024 : xin_s + (size_t)(row - NPROMPT) * 1024;
        float s1 = 0.f, s2 = 0.f;
#pragma unroll
        for (int bj = 0; bj < 2; ++bj)
#pragma unroll
          for (int n = 0; n < 2; ++n) {
            const int c = u.pn * 256 + bj * 128 + wc * 32 + n * 16 + fq * 4;
            f32x4 x;
            if constexpr (XIN_BF) { const uint2 xb2 = *(const uint2*)&xin_b[(size_t)row * 1024 + c]; x = f32x4{lo16(xb2.x), hi16(xb2.x), lo16(xb2.y), hi16(xb2.y)}; }
            else x = *(const f32x4*)&xr[c];
            const f32x4 gg = gv[bj][n];
            f32x4 y;
#pragma unroll
            for (int j = 0; j < 4; ++j) { y[j] = DN_ALPHA * x[j] + gg[j] * acc[ai][bj][m][n][j]; s1 += y[j]; s2 += y[j] * y[j]; }
            acc[ai][bj][m][n] = y;
          }
        s1 += __shfl_xor(s1, 16); s1 += __shfl_xor(s1, 32);
        s2 += __shfl_xor(s2, 16); s2 += __shfl_xor(s2, 32);
        if (fq == 0) { part[(rl * 4 + wc) * 2] = s1; part[(rl * 4 + wc) * 2 + 1] = s2; }
      }
    __syncthreads();
    if (tid < 256) {
      float S1 = 0.f, S2 = 0.f;
#pragma unroll
      for (int w2 = 0; w2 < 4; ++w2) { S1 += part[(tid * 4 + w2) * 2]; S2 += part[(tid * 4 + w2) * 2 + 1]; }
      const unsigned long long v = (unsigned long long)__float_as_uint(S1) | ((unsigned long long)__float_as_uint(S2) << 32);
      __hip_atomic_store(&slots[(size_t)(u.pm * 4 + u.pn) * 256 + tid], v, __ATOMIC_RELAXED, __HIP_MEMORY_SCOPE_AGENT);
    }
    asm volatile("s_waitcnt vmcnt(0)" ::: "memory");
    __syncthreads();
    if (tid == 0) {
      __hip_atomic_fetch_add(&cnt[u.pm], 1u, __ATOMIC_RELAXED, __HIP_MEMORY_SCOPE_AGENT);
      unsigned sp = 0;
      while (__hip_atomic_load(&cnt[u.pm], __ATOMIC_RELAXED, __HIP_MEMORY_SCOPE_AGENT) < 4u) { __builtin_amdgcn_s_sleep(1); if (++sp > (1u << 24)) break; }
    }
    __syncthreads();
    if (tid < 256) {
      float T1 = 0.f, T2 = 0.f;
#pragma unroll
      for (int o = 0; o < 4; ++o) {
        const unsigned long long v = __hip_atomic_load(&slots[(size_t)(u.pm * 4 + o) * 256 + tid], __ATOMIC_RELAXED, __HIP_MEMORY_SCOPE_AGENT);
        T1 += __uint_as_float((unsigned)(v & 0xffffffffull)); T2 += __uint_as_float((unsigned)(v >> 32));
      }
      const float mu = T1 * (1.0f / 1024.0f);
      const float var = fmaxf(T2 * (1.0f / 1024.0f) - mu * mu, 0.f);
      stat[tid * 2] = mu; stat[tid * 2 + 1] = rsqrtf(var + 1e-5f);
    }
    __syncthreads();
#pragma unroll
    for (int bj = 0; bj < 2; ++bj) {
      f32x4 lgv[2], lbv[2], shv[2], scv[2];
#pragma unroll
      for (int n = 0; n < 2; ++n) {
        const int c = u.pn * 256 + bj * 128 + wc * 32 + n * 16 + fq * 4;
        lgv[n] = *(const f32x4*)&lg[c]; lbv[n] = *(const f32x4*)&lbias[c];
        shv[n] = *(const f32x4*)&modn[cnd * 3072 + c]; scv[n] = *(const f32x4*)&modn[cnd * 3072 + 1024 + c];
      }
#pragma unroll
      for (int ai = 0; ai < 2; ++ai)
#pragma unroll
        for (int m = 0; m < 4; ++m) {
          const int rl = ai * 128 + wr * 64 + m * 16 + fr;
          const int row = u.pm * 256 + rl;
          const float mu = stat[rl * 2], rs = stat[rl * 2 + 1];
#pragma unroll
          for (int n = 0; n < 2; ++n) {
            const int c = u.pn * 256 + bj * 128 + wc * 32 + n * 16 + fq * 4;
            const f32x4 y = acc[ai][bj][m][n];
            f32x4 xo;
#pragma unroll
            for (int j = 0; j < 4; ++j) xo[j] = (y[j] - mu) * rs * lgv[n][j] + lbv[n][j];
            if constexpr (XOUT_BF) *(uint2*)&XB[(size_t)row * 1024 + c] = pack4(xo[0], xo[1], xo[2], xo[3]);
            else *(f32x4*)&X[(size_t)row * 1024 + c] = xo;
            if (H) {
              *(uint2*)&H[(size_t)row * 1024 + c] = pack4(xo[0] * (1 + scv[n][0]) + shv[n][0], xo[1] * (1 + scv[n][1]) + shv[n][1], xo[2] * (1 + scv[n][2]) + shv[n][2], xo[3] * (1 + scv[n][3]) + shv[n][3]);
            }
          }
        }
    }
  }
};

struct EpiScIn {
  static constexpr bool AFTER_DRAIN = false;
  u16 *pb, *sb;
  __device__ __forceinline__ void operator()(AccRef acc, const Unit& u, int wr, int wc, int fr, int fq) const {
    const int c = u.pn * 64 + wc * 16 + fq * 4;
    EPI_ROWS(
      const f32x4 bg = acc[ai][0][m][0], cgv = acc[ai][0][m][1], v = acc[ai][1][m][0], g = acc[ai][1][m][1];
      *(uint2*)&pb[(size_t)row * 1024 + c] = pack4(cgv[0] * v[0], cgv[1] * v[1], cgv[2] * v[2], cgv[3] * v[3]);
      *(uint2*)&sb[(size_t)row * 1024 + c] = pack4(siluf_(g[0]) * bg[0], siluf_(g[1]) * bg[1], siluf_(g[2]) * bg[2], siluf_(g[3]) * bg[3]);
    )
  }
};

struct EpiRgIn {
  static constexpr bool AFTER_DRAIN = false;
  u16 *ub, *sg;
  __device__ __forceinline__ void operator()(AccRef acc, const Unit& u, int wr, int wc, int fr, int fq) const {
    const int region = u.pn >> 2;
    EPI_ROWS( EPI_COLS(
      const int c = (cb & 1023) + fq * 4;
      if (region == 0) *(uint2*)&ub[(size_t)row * 1024 + c] = pack4(a[0], a[1], a[2], a[3]);
      else *(uint2*)&sg[((size_t)(c >> 6) * TOK + row) * 64 + (c & 63)] = pack4(siluf_(a[0]), siluf_(a[1]), siluf_(a[2]), siluf_(a[3]));
    ) )
  }
};

struct EpiRgGate {
  static constexpr bool AFTER_DRAIN = false;
  u16 *rb, *ib; const float* bgate;
  __device__ __forceinline__ void operator()(AccRef acc, const Unit& u, int wr, int wc, int fr, int fq) const {
    const int mat = u.pn >> 1, d = mat >> 2, hd = mat & 3;
    f32x4 br[2], bi[2]; int ccs[2];
#pragma unroll
    for (int bj = 0; bj < 2; ++bj) {
      const int off = ((u.pn & 1) * 256 + bj * 128 + wc * 32);
      ccs[bj] = (off >> 5) * 16 + fq * 4;
      br[bj] = *(const f32x4*)&bgate[mat * 512 + ccs[bj]];
      bi[bj] = *(const f32x4*)&bgate[mat * 512 + 256 + ccs[bj]];
    }
    EPI_ROWS(
      _Pragma("unroll") for (int bj = 0; bj < 2; ++bj) {
        const f32x4 r = acc[ai][bj][m][0], ii = acc[ai][bj][m][1];
        const int cch = hd * 256 + ccs[bj];
        const size_t o = (size_t)d * TOK * 1024 + ((size_t)(cch >> 6) * TOK + row) * 64 + (cch & 63);
        *(uint2*)&rb[o] = pack4(sigmoidf_(r[0] + br[bj][0]), sigmoidf_(r[1] + br[bj][1]), sigmoidf_(r[2] + br[bj][2]), sigmoidf_(r[3] + br[bj][3]));
        *(uint2*)&ib[o] = pack4(sigmoidf_(ii[0] + bi[bj][0]), sigmoidf_(ii[1] + bi[bj][1]), sigmoidf_(ii[2] + bi[bj][2]), sigmoidf_(ii[3] + bi[bj][3]));
      } )
  }
};

struct EpiMlaIn {
  static constexpr bool AFTER_DRAIN = false;
  u16* cq; float* ckvraw; float* kperaw; u16* sg;
  __device__ __forceinline__ void operator()(AccRef acc, const Unit& u, int wr, int wc, int fr, int fq) const {
    EPI_ROWS( EPI_COLS(
      const int c = cb + fq * 4;
      if (cb < 384) *(uint2*)&cq[(size_t)row * 384 + c] = pack4(a[0], a[1], a[2], a[3]);
      else if (cb < 640) *(f32x4*)&ckvraw[(size_t)row * 256 + (c - 384)] = a;
      else if (cb < 672) *(f32x4*)&kperaw[(size_t)row * 32 + (c - 640)] = a;
    ) )
  }
};

struct EpiSg {
  static constexpr bool AFTER_DRAIN = false;
  u16* sg;
  __device__ __forceinline__ void operator()(AccRef acc, const Unit& u, int wr, int wc, int fr, int fq) const {
    EPI_ROWS( EPI_COLS(
      *(uint2*)&sg[(size_t)row * 1024 + cb + fq * 4] = pack4(a[0], a[1], a[2], a[3]);
    ) )
  }
};

struct EpiQ {
  static constexpr bool AFTER_DRAIN = false;
  u16* q;
  __device__ __forceinline__ void operator()(AccRef acc, const Unit& u, int wr, int wc, int fr, int fq) const {
    const float sc = 0.14724444500602648f;
    EPI_ROWS( EPI_COLS(
      *(uint2*)&q[(size_t)row * 1536 + cb + fq * 4] = pack4(a[0] * sc, a[1] * sc, a[2] * sc, a[3] * sc);
    ) )
  }
};

struct EpiK {
  static constexpr bool AFTER_DRAIN = false;
  u16* Kb;
  __device__ __forceinline__ void operator()(AccRef acc, const Unit& u, int wr, int wc, int fr, int fq) const {
    EPI_ROWS( EPI_COLS(
      const int h = cb >> 6, dd = (cb & 63) + fq * 4;
      *(uint2*)&Kb[((size_t)row * 16 + h) * 96 + dd] = pack4(a[0], a[1], a[2], a[3]);
    ) )
  }
};
struct EpiV {
  static constexpr bool AFTER_DRAIN = false;
  u16* Vt;
  __device__ __forceinline__ void operator()(AccRef acc, const Unit& u, int wr, int wc, int fr, int fq) const {
    EPI_ROWS( EPI_COLS(
      *(uint2*)&Vt[(size_t)row * KVROWS + cb + fq * 4] = pack4(a[0], a[1], a[2], a[3]);
    ) )
  }
};

__device__ __forceinline__ void wconv_tile(const float* __restrict__ src, int N, int K, u16* __restrict__ dst, int k0, int n0,
                                           int perm, int mat, float* tile) {
  const int tid = threadIdx.x;
  {
    const int r = tid >> 4, c4 = (tid & 15) * 4;
#pragma unroll
    for (int i = 0; i < 2; ++i) {
      const int k = r + i * 32;
      f32x4 v = f32x4{0.f, 0.f, 0.f, 0.f};
      if (n0 + c4 < N) v = *(const f32x4*)&src[(size_t)(k0 + k) * N + n0 + c4];
      tile[k * 65 + c4 + 0] = v[0]; tile[k * 65 + c4 + 1] = v[1]; tile[k * 65 + c4 + 2] = v[2]; tile[k * 65 + c4 + 3] = v[3];
    }
  }
  __syncthreads();
  {
    const int nl = tid >> 3, kq = (tid & 7) * 8;
    const int n = n0 + nl;
    int np = n;
    if (perm == 1) { const int part = n >> 10, c = n & 1023; np = (c >> 6) * 256 + (part >> 1) * 128 + ((c >> 4) & 3) * 32 + (part & 1) * 16 + (c & 15); }
    else if (perm == 2) { const int type = n >> 8, cc = n & 255; np = mat * 512 + (cc >> 4) * 32 + type * 16 + (cc & 15); }
    else if (perm == 3) { const int hh = n >> 7, dd = n & 127; np = (dd >= 64 ? 1024 : 0) + hh * 64 + (dd & 63); }
    if (n < N) {
      unsigned w[4];
#pragma unroll
      for (int i = 0; i < 4; ++i) w[i] = pack2(tile[(kq + 2 * i) * 65 + nl], tile[(kq + 2 * i + 1) * 65 + nl]);
      *(uint4*)&dst[(size_t)np * K + k0 + kq] = make_uint4(w[0], w[1], w[2], w[3]);
    }
  }
  __syncthreads();
}

__device__ __forceinline__ void wconv_item(const Params& p, int t, float* fs) {
  const float* src; u16* dst; int N, K, perm = 0, mat = 0, ntn;
  if (t < 1280) { src = p.in[12]; dst = (u16*)(p.ws + WS_W_HG_IN); N = 5120; K = 1024; }
  else if ((t -= 1280) < 256) { src = p.in[15]; dst = (u16*)(p.ws + WS_W_HG_OUT); N = 1024; K = 1024; }
  else if ((t -= 256) < 1024) { src = p.in[16]; dst = (u16*)(p.ws + WS_W_SC_IN); N = 4096; K = 1024; perm = 1; }
  else if ((t -= 1024) < 256) { src = p.in[19]; dst = (u16*)(p.ws + WS_W_SC_OUT); N = 1024; K = 1024; }
  else if ((t -= 256) < 512) { src = p.in[20]; dst = (u16*)(p.ws + WS_W_RG_IN); N = 2048; K = 1024; }
  else if ((t -= 512) < 256) { mat = t >> 5; t &= 31; src = p.in[23] + (size_t)mat * 256 * 512; dst = (u16*)(p.ws + WS_W_RG_GATE); N = 512; K = 256; perm = 2; }
  else if ((t -= 256) < 256) { src = p.in[26]; dst = (u16*)(p.ws + WS_W_RG_OUT); N = 1024; K = 1024; }
  else if ((t -= 256) < 432) { src = p.in[27]; dst = (u16*)(p.ws + WS_W_MLA_IN); N = 1696; K = 1024; }
  else if ((t -= 432) < 144) { src = p.in[30]; dst = (u16*)(p.ws + WS_W_QB); N = 1536; K = 384; }
  else if ((t -= 144) < 128) { src = p.in[31]; dst = (u16*)(p.ws + WS_W_KVB); N = 2048; K = 256; perm = 3; }
  else { t -= 128; src = p.in[32]; dst = (u16*)(p.ws + WS_W_MLA_OUT); N = 1024; K = 1024; }
  ntn = (N + 63) >> 6;
  const int kt = t / ntn, ntl = t - kt * ntn;
  wconv_tile(src, N, K, dst, kt * 64, ntl * 64, perm, mat, fs);
}
__device__ __forceinline__ void wconv_idle(const Params& p, unsigned char* smem_raw, int bid, int nb, int t0, int t1) {
  if (nb == 256 && bid >= 192) for (int t = t0 + (bid - 192); t < t1; t += 64) wconv_item(p, t, (float*)smem_raw);
}

__device__ __forceinline__ void phase_prologue(const Params& p, unsigned char* smem_raw, int bid, int nb) {
  float* fs = (float*)smem_raw;
  const int tid = threadIdx.x;
  const int NMOD = 192, NWT = (nb == 256) ? 1536 : 4800;
  for (int it = bid; it < NMOD + 1 + NWT; it += nb) {
    if (it < NMOD) {
      const int l = it / 48, n0 = (it % 48) * 64;
      float* scond = fs;
      float* sred = fs + 5120;
      for (int i = tid; i < 5120; i += NT) {
        const int ci = i >> 10, k = i & 1023;
        float cv = ci == 0 ? p.in[7][k] : p.in[6][(ci - 1) * 1024 + k];
        scond[i] = siluf_(cv);
      }
      __syncthreads();
      const int col = tid & 63, kg = tid >> 6;
      const float* w = p.in[8] + (size_t)l * 1024 * 3072 + n0 + col;
      float a0 = 0, a1 = 0, a2 = 0, a3 = 0, a4 = 0;
#pragma unroll 16
      for (int k = kg * 128; k < kg * 128 + 128; ++k) {
        float wv = w[(size_t)k * 3072];
        a0 += scond[k] * wv; a1 += scond[1024 + k] * wv; a2 += scond[2048 + k] * wv; a3 += scond[3072 + k] * wv; a4 += scond[4096 + k] * wv;
      }
      sred[(kg * 5 + 0) * 64 + col] = a0; sred[(kg * 5 + 1) * 64 + col] = a1; sred[(kg * 5 + 2) * 64 + col] = a2;
      sred[(kg * 5 + 3) * 64 + col] = a3; sred[(kg * 5 + 4) * 64 + col] = a4;
      __syncthreads();
      float* mod = (float*)(p.ws + WS_MOD);
      if (tid < 320) {
        const int ci = tid >> 6, cc = tid & 63;
        float s = 0;
#pragma unroll
        for (int g = 0; g < 8; ++g) s += sred[(g * 5 + ci) * 64 + cc];
        mod[(l * 5 + ci) * 3072 + n0 + cc] = s + p.in[9][l * 3072 + n0 + cc];
      }
      __syncthreads();
    } else if (it == NMOD) {
      float* lb = (float*)(p.ws + WS_LB);
      for (int i = tid; i < 2048; i += NT) {
        const int d = i >> 10, c = i & 1023;
        const float* lg = p.in[13] + d * 5 * 1024 + c;
        float m = lg[0];
        for (int j = 1; j < 5; ++j) m = fmaxf(m, lg[j * 1024]);
        float s = 0;
        for (int j = 0; j < 5; ++j) s += expf(lg[j * 1024] - m);
        lb[i] = expf(lg[0] - m) / s;
      }
      int* cnt = (int*)(p.ws + WS_CNT);
      if (tid < 16) cnt[tid] = 0;
    } else {
      wconv_item(p, it - NMOD - 1, fs);
    }
  }
}

__device__ __forceinline__ void phase_h0(const Params& p, int bid, int nb) {
  const float* mod = (const float*)(p.ws + WS_MOD);
  u16* H = (u16*)(p.ws + WS_H);
  const size_t total = (size_t)(TOK / 4) * 256;
  for (size_t i = (size_t)bid * NT + threadIdx.x; i < total; i += (size_t)nb * NT) {
    const int row = (int)(i >> 8) * 4, c = ((int)i & 255) * 4;
    const float* xr = row < NPROMPT ? p.in[0] + (size_t)row * 1024 : p.in[1] + (size_t)(row - NPROMPT) * 1024;
    const float* m = mod + cond_of(row) * 3072;
    f32x4 x[4];
#pragma unroll
    for (int t = 0; t < 4; ++t) x[t] = *(const f32x4*)&xr[t * 1024 + c];
    const f32x4 sh = *(const f32x4*)&m[c];
    const f32x4 sc = *(const f32x4*)&m[1024 + c];
#pragma unroll
    for (int t = 0; t < 4; ++t)
      *(uint2*)&H[(size_t)(row + t) * 1024 + c] = pack4(x[t][0] * (1 + sc[0]) + sh[0], x[t][1] * (1 + sc[1]) + sh[1], x[t][2] * (1 + sc[2]) + sh[2], x[t][3] * (1 + sc[3]) + sh[3]);
  }
}

__device__ __forceinline__ void phase_ln(const Params& p, int l, int bid, int nb) {
  float* X = p.out;
  const float* g = p.in[10] + l * 1024;
  const float* b = p.in[11] + l * 1024;
  const float* mod = (const float*)(p.ws + WS_MOD) + (l + 1) * 5 * 3072;
  u16* H = (u16*)(p.ws + WS_H);
  const int lane = threadIdx.x & 63, wave = threadIdx.x >> 6;
  for (int row = bid * NW + wave; row < TOK; row += nb * NW) {
    float* xr = X + (size_t)row * 1024;
    f32x4 v[4];
    float s = 0;
#pragma unroll
    for (int i = 0; i < 4; ++i) { v[i] = *(const f32x4*)&xr[i * 256 + lane * 4]; s += v[i][0] + v[i][1] + v[i][2] + v[i][3]; }
    const float mu = wave_sum(s) * (1.0f / 1024.0f);
    float q = 0;
#pragma unroll
    for (int i = 0; i < 4; ++i)
#pragma unroll
      for (int j = 0; j < 4; ++j) { float dd = v[i][j] - mu; q += dd * dd; }
    const float rs = rsqrtf(wave_sum(q) * (1.0f / 1024.0f) + 1e-5f);
    const float* m = mod + cond_of(row) * 3072;
#pragma unroll
    for (int i = 0; i < 4; ++i) {
      const int c = i * 256 + lane * 4;
      f32x4 gg = *(const f32x4*)&g[c], bb = *(const f32x4*)&b[c];
      f32x4 y;
#pragma unroll
      for (int j = 0; j < 4; ++j) y[j] = (v[i][j] - mu) * rs * gg[j] + bb[j];
      *(f32x4*)&xr[c] = y;
      if (l < 3) {
        f32x4 sh = *(const f32x4*)&m[c], sc = *(const f32x4*)&m[1024 + c];
        *(uint2*)&H[(size_t)row * 1024 + c] = pack4(y[0] * (1 + sc[0]) + sh[0], y[1] * (1 + sc[1]) + sh[1], y[2] * (1 + sc[2]) + sh[2], y[3] * (1 + sc[3]) + sh[3]);
      }
    }
  }
}

__device__ __forceinline__ void phase_gla(const Params& p, unsigned char* smem_raw) {
  u16* s_qrel = (u16*)smem_raw;
  u16* s_krel = s_qrel + 32 * 136;
  u16* s_qcum = s_krel + 32 * 136;
  u16* s_kdT = s_qcum + 32 * 136;
  u16* s_vT = s_kdT + 128 * 40;
  u16* s_att = s_vT + 64 * 40;
  u16* s_S = s_att + 32 * 40;
  float* s_dec = (float*)(s_S + 64 * 136);
  float* s_part = s_dec + 128;
  int* s_u = (int*)(s_part + 512);
  int* counter = (int*)(p.ws + WS_CNT);
  const u16* qg = (const u16*)(p.ws + WS_B(0));
  const u16* vg = (const u16*)(p.ws + WS_B(1));
  const _Float16* lfg = (const _Float16*)(p.ws + WS_B(3));
  u16* og = (u16*)(p.ws + WS_B(5));
  const int tid = threadIdx.x, lane = tid & 63, w = tid >> 6, fr = lane & 15, fq = lane >> 4;
  const int kk = tid & 127, th = tid >> 7;
  const int ti = w >> 2, vi = w & 3;
  const int wk = w & 3, wv = w >> 2;
  while (true) {
    if (tid == 0) *s_u = atomicAdd(counter, 1);
    __syncthreads();
    const int u = *s_u;
    __syncthreads();
    if (u >= 1152) break;
    int b, rem, start, N, sample;
    if (u < 128) { sample = 1; b = u >> 5; rem = u & 31; start = NPROMPT + b * 1024; N = 1024; }
    else { sample = 0; b = (u - 128) >> 5; rem = (u - 128) & 31; start = b * 256; N = 256; }
    const int h = rem >> 2, d = (rem >> 1) & 1, vs = rem & 1;
    const int nc = N >> 5;
    f32x4 S[2][2];
#pragma unroll
    for (int mi = 0; mi < 2; ++mi)
#pragma unroll
      for (int ni = 0; ni < 2; ++ni) {
        f32x4 s4 = f32x4{0.f, 0.f, 0.f, 0.f};
        if (sample) {
          const float* s0 = p.in[2] + ((size_t)((b * 2 + d) * 8 + h)) * 16384;
#pragma unroll
          for (int j = 0; j < 4; ++j) s4[j] = s0[(wk * 32 + mi * 16 + fq * 4 + j) * 128 + vs * 64 + wv * 32 + ni * 16 + fr];
        }
        S[mi][ni] = s4;
        *(uint2*)&s_S[(wv * 32 + ni * 16 + fr) * 136 + wk * 32 + mi * 16 + fq * 4] = pack4(s4[0], s4[1], s4[2], s4[3]);
      }
    _Float16 lfraw[8]; u16 qraw[8]; uint2 vraw;
#define GLA_LOAD(cc) do { _Pragma("unroll") for (int i = 0; i < 8; ++i) { const int tt = (cc) * 32 + th * 8 + i; const size_t tok = start + (d ? (N - 1 - tt) : tt); \
      lfraw[i] = lfg[tok * 2048 + d * 1024 + h * 128 + kk]; qraw[i] = qg[tok * 1024 + h * 128 + kk]; } \
      { const int tt = (cc) * 32 + (tid >> 4); const size_t tok = start + (d ? (N - 1 - tt) : tt); vraw = *(const uint2*)&vg[tok * 1024 + h * 128 + vs * 64 + (tid & 15) * 4]; } } while (0)
    GLA_LOAD(0);
    for (int c = 0; c < nc; ++c) {
      {
        float lfv[8], qv[8];
#pragma unroll
        for (int i = 0; i < 8; ++i) { lfv[i] = (float)lfraw[i]; qv[i] = bf2f(qraw[i]); }
        const uint2 vv = vraw;
        if (c + 1 < nc) GLA_LOAD(c + 1);
        float run = 0;
        float cs[8];
#pragma unroll
        for (int i = 0; i < 8; ++i) { run += lfv[i]; cs[i] = run; }
        s_part[th * 128 + kk] = run;
        {
          const int s = tid >> 4, v4 = (tid & 15) * 4;
          s_vT[(v4 + 0) * 40 + s] = (u16)(vv.x & 0xffff); s_vT[(v4 + 1) * 40 + s] = (u16)(vv.x >> 16);
          s_vT[(v4 + 2) * 40 + s] = (u16)(vv.y & 0xffff); s_vT[(v4 + 3) * 40 + s] = (u16)(vv.y >> 16);
        }
        __syncthreads();
        const float p0 = s_part[kk], p1 = s_part[128 + kk], p2 = s_part[256 + kk], p3 = s_part[384 + kk];
        const float off = (th > 0 ? p0 : 0.f) + (th > 1 ? p1 : 0.f) + (th > 2 ? p2 : 0.f);
        const float ref = p0 + p1, total = p0 + p1 + p2 + p3;
        unsigned kd[4];
        const float eref = __expf(ref), etr = __expf(total - ref);
#pragma unroll
        for (int i = 0; i < 8; ++i) {
          const int t = th * 8 + i;
          const float cum = off + cs[i];
          const float kf = 1.0f - __expf(lfv[i]);
          const float e1 = __expf(cum - ref), e2 = __builtin_amdgcn_rcpf(e1);
          const float qe = qv[i] * e1, ke = kf * e2;
          s_qrel[t * 136 + kk] = f2bf(qe);
          s_krel[t * 136 + kk] = f2bf(ke);
          s_qcum[t * 136 + kk] = f2bf(qe * eref);
          const u16 kdv = f2bf(ke * etr);
          if (i & 1) kd[i >> 1] |= ((unsigned)kdv) << 16; else kd[i >> 1] = kdv;
        }
        *(uint4*)&s_kdT[kk * 40 + th * 8] = make_uint4(kd[0], kd[1], kd[2], kd[3]);
        if (th == 0) s_dec[kk] = __expf(total);
      }
      __syncthreads();
      f32x4 oacc = f32x4{0.f, 0.f, 0.f, 0.f};
      {
        f32x4 att = f32x4{0.f, 0.f, 0.f, 0.f};
        const int ati = w >> 1, asi = w & 1;
#pragma unroll
        for (int ks = 0; ks < 4; ++ks) {
          if (w < 4) {
            bf16x8 a = *(const bf16x8*)&s_qrel[(ati * 16 + fr) * 136 + ks * 32 + fq * 8];
            bf16x8 bb = *(const bf16x8*)&s_krel[(asi * 16 + fr) * 136 + ks * 32 + fq * 8];
            att = __builtin_amdgcn_mfma_f32_16x16x32_bf16(a, bb, att, 0, 0, 0);
          }
          bf16x8 a2 = *(const bf16x8*)&s_qcum[(ti * 16 + fr) * 136 + ks * 32 + fq * 8];
          bf16x8 b2 = *(const bf16x8*)&s_S[(vi * 16 + fr) * 136 + ks * 32 + fq * 8];
          oacc = __builtin_amdgcn_mfma_f32_16x16x32_bf16(b2, a2, oacc, 0, 0, 0);
        }
        if (w < 4) {
#pragma unroll
          for (int j = 0; j < 4; ++j) {
            const int t = ati * 16 + fq * 4 + j, s = asi * 16 + fr;
            s_att[t * 40 + s] = (s <= t) ? f2bf(att[j]) : (u16)0;
          }
        }
      }
      __syncthreads();
      {
        bf16x8 a = *(const bf16x8*)&s_att[(ti * 16 + fr) * 40 + fq * 8];
        bf16x8 bb = *(const bf16x8*)&s_vT[(vi * 16 + fr) * 40 + fq * 8];
        oacc = __builtin_amdgcn_mfma_f32_16x16x32_bf16(bb, a, oacc, 0, 0, 0);
        {
          const int tt = c * 32 + ti * 16 + fr;
          const size_t tok = start + (d ? (N - 1 - tt) : tt);
          *(uint2*)&og[((size_t)d * TOK + tok) * 1024 + h * 128 + vs * 64 + vi * 16 + fq * 4] = pack4(oacc[0], oacc[1], oacc[2], oacc[3]);
        }
        bf16x8 vf[2];
#pragma unroll
        for (int ni = 0; ni < 2; ++ni) vf[ni] = *(const bf16x8*)&s_vT[(wv * 32 + ni * 16 + fr) * 40 + fq * 8];
#pragma unroll
        for (int mi = 0; mi < 2; ++mi) {
          bf16x8 kf = *(const bf16x8*)&s_kdT[(wk * 32 + mi * 16 + fr) * 40 + fq * 8];
          f32x4 dc = *(const f32x4*)&s_dec[wk * 32 + mi * 16 + fq * 4];
#pragma unroll
          for (int ni = 0; ni < 2; ++ni) {
            f32x4 s4 = S[mi][ni];
#pragma unroll
            for (int j = 0; j < 4; ++j) s4[j] *= dc[j];
            s4 = __builtin_amdgcn_mfma_f32_16x16x32_bf16(kf, vf[ni], s4, 0, 0, 0);
            S[mi][ni] = s4;
            *(uint2*)&s_S[(wv * 32 + ni * 16 + fr) * 136 + wk * 32 + mi * 16 + fq * 4] = pack4(s4[0], s4[1], s4[2], s4[3]);
          }
        }
      }
      __syncthreads();
    }
    if (!sample) {
      float* so = p.out + OUT_HG + ((size_t)((b * 2 + d) * 8 + h)) * 16384;
#pragma unroll
      for (int mi = 0; mi < 2; ++mi)
#pragma unroll
        for (int ni = 0; ni < 2; ++ni)
#pragma unroll
          for (int j = 0; j < 4; ++j) so[(wk * 32 + mi * 16 + fq * 4 + j) * 128 + vs * 64 + wv * 32 + ni * 16 + fr] = S[mi][ni][j];
    }
  }
}

__device__ __forceinline__ void phase_hg_post(const Params& p, int bid, int nb) {
  const u16* og = (const u16*)(p.ws + WS_B(5));
  const u16* sg = (const u16*)(p.ws + WS_B(2));
  u16* a = (u16*)(p.ws + WS_B(0));
  const float* ng = p.in[14];
  const int lane = threadIdx.x & 63, wave = threadIdx.x >> 6;
  float ngv[16];
#pragma unroll
  for (int k = 0; k < 4; ++k) { const f32x4 t = *(const f32x4*)&ng[lane * 16 + 4 * k]; ngv[4 * k] = t[0]; ngv[4 * k + 1] = t[1]; ngv[4 * k + 2] = t[2]; ngv[4 * k + 3] = t[3]; }
  for (int row0 = (bid * NW + wave) * 2; row0 < TOK; row0 += nb * NW * 2) {
    uint4 f[2][2], bw[2][2], sv[2][2];
#pragma unroll
    for (int r = 0; r < 2; ++r)
#pragma unroll
      for (int hh = 0; hh < 2; ++hh) {
        const size_t base = (size_t)(row0 + r) * 1024 + lane * 16 + hh * 8;
        f[r][hh] = *(const uint4*)&og[base];
        bw[r][hh] = *(const uint4*)&og[(size_t)TOK * 1024 + base];
        sv[r][hh] = *(const uint4*)&sg[base];
      }
#pragma unroll
    for (int r = 0; r < 2; ++r) {
      float o[16];
      float ss = 0;
#pragma unroll
      for (int hh = 0; hh < 2; ++hh) {
        const unsigned fa[4] = {f[r][hh].x, f[r][hh].y, f[r][hh].z, f[r][hh].w}, ba[4] = {bw[r][hh].x, bw[r][hh].y, bw[r][hh].z, bw[r][hh].w};
#pragma unroll
        for (int i = 0; i < 4; ++i) {
          o[hh * 8 + 2 * i] = lo16(fa[i]) + lo16(ba[i]);
          o[hh * 8 + 2 * i + 1] = hi16(fa[i]) + hi16(ba[i]);
        }
      }
#pragma unroll
      for (int i = 0; i < 16; ++i) ss += o[i] * o[i];
      ss += __shfl_xor(ss, 1); ss += __shfl_xor(ss, 2); ss += __shfl_xor(ss, 4);
      const float rs = rsqrtf(ss * (1.0f / 128.0f) + 1e-6f);
#pragma unroll
      for (int hh = 0; hh < 2; ++hh) {
        const unsigned sa[4] = {sv[r][hh].x, sv[r][hh].y, sv[r][hh].z, sv[r][hh].w};
        unsigned rr[4];
#pragma unroll
        for (int i = 0; i < 4; ++i)
          rr[i] = pack2(o[hh * 8 + 2 * i] * rs * ngv[hh * 8 + 2 * i] * siluf_(lo16(sa[i])), o[hh * 8 + 2 * i + 1] * rs * ngv[hh * 8 + 2 * i + 1] * siluf_(hi16(sa[i])));
        *(uint4*)&a[(size_t)(row0 + r) * 1024 + lane * 16 + hh * 8] = make_uint4(rr[0], rr[1], rr[2], rr[3]);
      }
    }
  }
}

__device__ __forceinline__ void seq_pos(int tok, int& n, int& L) {
  if (tok < NPROMPT) { n = tok & 255; L = 256; } else { n = (tok - NPROMPT) & 1023; L = 1024; }
}
__device__ __forceinline__ void phase_sc_conv(const Params& p, int bid, int nb) {
  const u16* pb = (const u16*)(p.ws + WS_B(0));
  const u16* sb = (const u16*)(p.ws + WS_B(1));
  u16* a = (u16*)(p.ws + WS_B(2));
  const float* cw = p.in[17]; const float* cbias = p.in[18];
  const size_t total = (size_t)TOK * 128;
  const size_t i0 = (size_t)bid * NT + threadIdx.x;
  const int c = ((int)i0 & 127) * 8;
  float w0[8], w1[8], w2[8], wb[8];
#pragma unroll
  for (int k = 0; k < 2; ++k) {
    const f32x4 t0 = *(const f32x4*)&cw[c + 4 * k], t1 = *(const f32x4*)&cw[1024 + c + 4 * k], t2 = *(const f32x4*)&cw[2048 + c + 4 * k], tb = *(const f32x4*)&cbias[c + 4 * k];
#pragma unroll
    for (int j = 0; j < 4; ++j) { w0[4 * k + j] = t0[j]; w1[4 * k + j] = t1[j]; w2[4 * k + j] = t2[j]; wb[4 * k + j] = tb[j]; }
  }
  const uint4 z = make_uint4(0, 0, 0, 0);
  for (size_t i = i0; i < total / 4; i += (size_t)nb * NT) {
    const int tok = (int)(i >> 7) * 4;
    int n, L; seq_pos(tok, n, L);
    const size_t base = (size_t)tok * 1024 + c;
    uint4 q[6], sv[4];
    q[0] = n > 0 ? *(const uint4*)&pb[base - 1024] : z;
#pragma unroll
    for (int t = 0; t < 4; ++t) { q[1 + t] = *(const uint4*)&pb[base + t * 1024]; sv[t] = *(const uint4*)&sb[base + t * 1024]; }
    q[5] = n + 4 < L ? *(const uint4*)&pb[base + 4096] : z;
#pragma unroll
    for (int t = 0; t < 4; ++t) {
      const unsigned am[4] = {q[t].x, q[t].y, q[t].z, q[t].w}, a0[4] = {q[t + 1].x, q[t + 1].y, q[t + 1].z, q[t + 1].w};
      const unsigned ap[4] = {q[t + 2].x, q[t + 2].y, q[t + 2].z, q[t + 2].w}, as[4] = {sv[t].x, sv[t].y, sv[t].z, sv[t].w};
      unsigned r[4];
#pragma unroll
      for (int k = 0; k < 4; ++k) {
        float z0 = w0[2 * k] * lo16(am[k]) + w1[2 * k] * lo16(a0[k]) + w2[2 * k] * lo16(ap[k]) + wb[2 * k];
        float z1 = w0[2 * k + 1] * hi16(am[k]) + w1[2 * k + 1] * hi16(a0[k]) + w2[2 * k + 1] * hi16(ap[k]) + wb[2 * k + 1];
        r[k] = pack2(lo16(as[k]) * z0, hi16(as[k]) * z1);
      }
      *(uint4*)&a[base + t * 1024] = make_uint4(r[0], r[1], r[2], r[3]);
    }
  }
}
__device__ __forceinline__ void phase_rg_conv(const Params& p, int bid, int nb) {
  const u16* ub = (const u16*)(p.ws + WS_B(0));
  u16* uc = (u16*)(p.ws + WS_B(2));
  const float* cw = p.in[21]; const float* cbias = p.in[22];
  const size_t total = (size_t)TOK * 128;
  const size_t i0 = (size_t)bid * NT + threadIdx.x;
  const int c = ((int)i0 & 127) * 8;
  float w0[8], w1[8], w2[8], w3[8], wb[8];
#pragma unroll
  for (int k = 0; k < 2; ++k) {
    const f32x4 t0 = *(const f32x4*)&cw[c + 4 * k], t1 = *(const f32x4*)&cw[1024 + c + 4 * k], t2 = *(const f32x4*)&cw[2048 + c + 4 * k], t3 = *(const f32x4*)&cw[3072 + c + 4 * k], tb = *(const f32x4*)&cbias[c + 4 * k];
#pragma unroll
    for (int j = 0; j < 4; ++j) { w0[4 * k + j] = t0[j]; w1[4 * k + j] = t1[j]; w2[4 * k + j] = t2[j]; w3[4 * k + j] = t3[j]; wb[4 * k + j] = tb[j]; }
  }
  const uint4 z = make_uint4(0, 0, 0, 0);
  for (size_t i = i0; i < total / 4; i += (size_t)nb * NT) {
    const int tok = (int)(i >> 7) * 4;
    int n, L; seq_pos(tok, n, L);
    const size_t base = (size_t)tok * 1024 + c;
    uint4 q[7];
    q[0] = n > 1 ? *(const uint4*)&ub[base - 2048] : z;
    q[1] = n > 0 ? *(const uint4*)&ub[base - 1024] : z;
#pragma unroll
    for (int t = 0; t < 4; ++t) q[2 + t] = *(const uint4*)&ub[base + t * 1024];
    q[6] = n + 4 < L ? *(const uint4*)&ub[base + 4096] : z;
#pragma unroll
    for (int t = 0; t < 4; ++t) {
      const unsigned a0[4] = {q[t].x, q[t].y, q[t].z, q[t].w}, a1[4] = {q[t + 1].x, q[t + 1].y, q[t + 1].z, q[t + 1].w};
      const unsigned a2[4] = {q[t + 2].x, q[t + 2].y, q[t + 2].z, q[t + 2].w}, a3[4] = {q[t + 3].x, q[t + 3].y, q[t + 3].z, q[t + 3].w};
      unsigned r[4];
#pragma unroll
      for (int k = 0; k < 4; ++k) {
        float z0 = w0[2 * k] * lo16(a0[k]) + w1[2 * k] * lo16(a1[k]) + w2[2 * k] * lo16(a2[k]) + w3[2 * k] * lo16(a3[k]) + wb[2 * k];
        float z1 = w0[2 * k + 1] * hi16(a0[k]) + w1[2 * k + 1] * hi16(a1[k]) + w2[2 * k + 1] * hi16(a2[k]) + w3[2 * k + 1] * hi16(a3[k]) + wb[2 * k + 1];
        r[k] = pack2(z0, z1);
      }
      *(uint4*)&uc[((size_t)(c >> 6) * TOK + tok + t) * 64 + (c & 63)] = make_uint4(r[0], r[1], r[2], r[3]);
    }
  }
}

__device__ __forceinline__ void phase_rg_scan(const Params& p, unsigned char* smem_raw, int bid, int nb) {
  float* sA = (float*)smem_raw;
  float* sB = sA + 2048;
  const u16* rb = (const u16*)(p.ws + WS_B(3));
  const u16* ib = (const u16*)(p.ws + WS_B(5));
  const u16* uc = (const u16*)(p.ws + WS_B(2));
  const u16* sg = (const u16*)(p.ws + WS_B(1));
  u16* hfw = (u16*)(p.ws + WS_H);
  u16* yp = (u16*)(p.ws + WS_B(0));
  const int tid = threadIdx.x;
  for (int u = bid; u < 768; u += nb) {
    int sample, b, c, seg, nseg, start, chs, slot;
    if (u < 256) {
      const int xq = u & 7, yq = u >> 3, gid = (yq >> 2) * 8 + xq, sub = yq & 3;
      sample = 1; b = gid >> 4; slot = (tid & 3) * 4; c = (gid & 15) * 64 + sub * 16 + slot; seg = tid >> 2; nseg = 128; start = NPROMPT + b * 1024; chs = 16; }
    else { sample = 0; b = (u - 256) >> 4; slot = (tid & 15) * 4; c = ((u - 256) & 15) * 64 + slot; seg = tid >> 4; nseg = 32; start = b * 256; chs = 64; }
    const int L = nseg * 8;
#pragma unroll 1
    for (int d = 0; d < 2; ++d) {
      const f32x4 lam = *(const f32x4*)&p.in[25][d * 1024 + c];
      float cl[4];
#pragma unroll
      for (int j = 0; j < 4; ++j) cl[j] = 8.0f * log1pf(__expf(-lam[j]));
      const u16* rp = rb + (size_t)d * TOK * 1024;
      const u16* ip = ib + (size_t)d * TOK * 1024;
      const int tok0 = start + (d ? L - 1 - seg * 8 : seg * 8);
      const size_t o0 = (size_t)tok0 * 1024 + c;
      const long ostep = d ? -1024 : 1024;
      const size_t g0 = ((size_t)(c >> 6) * TOK + tok0) * 64 + (c & 63);
      const long gstep = d ? -64 : 64;
      uint2 rr[8], ii[8], uu[8];
#pragma unroll
      for (int s8 = 0; s8 < 8; ++s8) { rr[s8] = *(const uint2*)&rp[g0 + s8 * gstep]; ii[s8] = *(const uint2*)&ip[g0 + s8 * gstep]; uu[s8] = *(const uint2*)&uc[g0 + s8 * gstep]; }
      uint2 hf[8], sgv[8];
      if (d == 1) {
#pragma unroll
        for (int s8 = 0; s8 < 8; ++s8) { hf[s8] = *(const uint2*)&hfw[g0 + s8 * gstep]; sgv[s8] = *(const uint2*)&sg[g0 + s8 * gstep]; }
      }
      float av[8][4], xv[8][4];
      float A[4] = {1.f, 1.f, 1.f, 1.f}, B[4] = {0.f, 0.f, 0.f, 0.f};
#pragma unroll
      for (int s8 = 0; s8 < 8; ++s8) {
        const float r4[4] = {lo16(rr[s8].x), hi16(rr[s8].x), lo16(rr[s8].y), hi16(rr[s8].y)};
        const float i4[4] = {lo16(ii[s8].x), hi16(ii[s8].x), lo16(ii[s8].y), hi16(ii[s8].y)};
        const float u4[4] = {lo16(uu[s8].x), hi16(uu[s8].x), lo16(uu[s8].y), hi16(uu[s8].y)};
#pragma unroll
        for (int j = 0; j < 4; ++j) {
          const float la = -cl[j] * r4[j];
          const float a = __expf(la);
          const float xin = __builtin_amdgcn_sqrtf(fmaxf(1.0f - __expf(2.0f * la), 0.f)) * (i4[j] * u4[j]);
          av[s8][j] = a; xv[s8][j] = xin;
          A[j] *= a; B[j] = a * B[j] + xin;
        }
      }
      *(f32x4*)&sA[seg * chs + slot] = f32x4{A[0], A[1], A[2], A[3]};
      *(f32x4*)&sB[seg * chs + slot] = f32x4{B[0], B[1], B[2], B[3]};
      for (int k = 1; k < nseg; k <<= 1) {
        __syncthreads();
        f32x4 pa = f32x4{1.f, 1.f, 1.f, 1.f}, pb2 = f32x4{0.f, 0.f, 0.f, 0.f};
        if (seg >= k) { pa = *(const f32x4*)&sA[(seg - k) * chs + slot]; pb2 = *(const f32x4*)&sB[(seg - k) * chs + slot]; }
        __syncthreads();
        if (seg >= k) {
#pragma unroll
          for (int j = 0; j < 4; ++j) { B[j] = A[j] * pb2[j] + B[j]; A[j] = A[j] * pa[j]; }
          *(f32x4*)&sA[seg * chs + slot] = f32x4{A[0], A[1], A[2], A[3]};
          *(f32x4*)&sB[seg * chs + slot] = f32x4{B[0], B[1], B[2], B[3]};
        }
      }
      __syncthreads();
      float h[4];
      {
        f32x4 h0v = f32x4{0.f, 0.f, 0.f, 0.f};
        if (sample) h0v = *(const f32x4*)&p.in[3][(b * 2 + d) * 1024 + c];
        if (seg > 0) {
          const f32x4 pa = *(const f32x4*)&sA[(seg - 1) * chs + slot], pb2 = *(const f32x4*)&sB[(seg - 1) * chs + slot];
#pragma unroll
          for (int j = 0; j < 4; ++j) h[j] = pa[j] * h0v[j] + pb2[j];
        } else {
#pragma unroll
          for (int j = 0; j < 4; ++j) h[j] = h0v[j];
        }
      }
#pragma unroll
      for (int s8 = 0; s8 < 8; ++s8) {
#pragma unroll
        for (int j = 0; j < 4; ++j) h[j] = av[s8][j] * h[j] + xv[s8][j];
        const size_t o = o0 + s8 * ostep;
        if (d == 0) *(uint2*)&hfw[g0 + s8 * gstep] = pack4(h[0], h[1], h[2], h[3]);
        else *(uint2*)&yp[g0 + s8 * gstep] = pack4((lo16(hf[s8].x) + h[0]) * lo16(sgv[s8].x), (hi16(hf[s8].x) + h[1]) * hi16(sgv[s8].x),
                                     (lo16(hf[s8].y) + h[2]) * lo16(sgv[s8].y), (hi16(hf[s8].y) + h[3]) * hi16(sgv[s8].y));
      }
      if (!sample && seg == nseg - 1) *(f32x4*)&p.out[OUT_RG + (b * 2 + d) * 1024 + c] = f32x4{h[0], h[1], h[2], h[3]};
      __syncthreads();
    }
  }
}

__device__ __forceinline__ void phase_mla_norm(const Params& p, int bid, int nb) {
  u16* cq = (u16*)(p.ws + WS3_CQ);
  u16* ckvall = (u16*)(p.ws + WS3_CKVALL);
  const float* ckvraw = (const float*)(p.ws + WS3_CKVRAW);
  const float* kperaw = (const float*)(p.ws + WS3_KPERAW);
  u16* Kb = (u16*)(p.ws + WS3_K);
  const float* qn = p.in[28]; const float* kvn = p.in[29];
  const int lane = threadIdx.x & 63, wave = threadIdx.x >> 6;
  float qnv[6];
#pragma unroll
  for (int i = 0; i < 3; ++i) { qnv[2 * i] = qn[(i * 64 + lane) * 2]; qnv[2 * i + 1] = qn[(i * 64 + lane) * 2 + 1]; }
  const f32x4 g4 = *(const f32x4*)&kvn[lane * 4];
  unsigned cvn[3] = {0u, 0u, 0u}; f32x4 kvnx = f32x4{0.f, 0.f, 0.f, 0.f}; float vnx = 0.f;
  {
    const int r0 = bid * NW + wave;
    if (r0 < TOK) {
#pragma unroll
      for (int i = 0; i < 3; ++i) cvn[i] = ((const unsigned*)&cq[(size_t)r0 * 384])[i * 64 + lane];
      kvnx = *(const f32x4*)&ckvraw[(size_t)r0 * 256 + lane * 4]; vnx = kperaw[(size_t)r0 * 32 + (lane & 31)];
    }
  }
  for (int row = bid * NW + wave; row < TOK + 2048; row += nb * NW) {
    if (row < TOK) {
      const int tok = row;
      const bool sample = tok >= NPROMPT;
      unsigned cv[3] = {cvn[0], cvn[1], cvn[2]}; const f32x4 kv = kvnx; float v = vnx;
      {
        const int rn = row + nb * NW;
        if (rn < TOK) {
#pragma unroll
          for (int i = 0; i < 3; ++i) cvn[i] = ((const unsigned*)&cq[(size_t)rn * 384])[i * 64 + lane];
          kvnx = *(const f32x4*)&ckvraw[(size_t)rn * 256 + lane * 4]; vnx = kperaw[(size_t)rn * 32 + (lane & 31)];
        }
      }
      const int bs = (tok - NPROMPT) >> 10, n = (tok - NPROMPT) & 1023;
      const size_t kvrow = sample ? (size_t)(NPROMPT + bs * 1536 + 512 + n) : (size_t)tok;
      unsigned* cqr = (unsigned*)&cq[(size_t)tok * 384];
      float ss = 0;
#pragma unroll
      for (int i = 0; i < 3; ++i) { float a = lo16(cv[i]), b2 = hi16(cv[i]); ss += a * a + b2 * b2; }
      const float rsq = rsqrtf(wave_sum(ss) * (1.0f / 384.0f) + 1e-6f);
#pragma unroll
      for (int i = 0; i < 3; ++i) {
        cqr[i * 64 + lane] = pack2(lo16(cv[i]) * rsq * qnv[2 * i], hi16(cv[i]) * rsq * qnv[2 * i + 1]);
      }
      const float rsk = rsqrtf(wave_sum(kv[0] * kv[0] + kv[1] * kv[1] + kv[2] * kv[2] + kv[3] * kv[3]) * (1.0f / 256.0f) + 1e-6f);
      f32x4 o4;
#pragma unroll
      for (int j = 0; j < 4; ++j) o4[j] = kv[j] * rsk * g4[j];
      *(uint2*)&ckvall[kvrow * 256 + lane * 4] = pack4(o4[0], o4[1], o4[2], o4[3]);
      if (!sample) *(f32x4*)&p.out[OUT_CKV + (size_t)tok * 256 + lane * 4] = o4;
      if (!sample) { if (lane < 32) p.out[OUT_KPE + (size_t)tok * 32 + lane] = v; }
      else {
        const float partner = __shfl_xor(v, 8);
        const int i16 = lane & 15;
        const float pos = (lane & 16) ? (float)(n & 63) : (float)(n >> 6);
        float sn, cs; rope_sincos(pos, i16 & 7, sn, cs);
        v = (i16 < 8) ? (v * cs - partner * sn) : (partner * sn + v * cs);
      }
      const u16 vb = f2bf(v);
#pragma unroll
      for (int i = 0; i < 8; ++i) Kb[(kvrow * 16 + (lane >> 5) + 2 * i) * 96 + 64 + (lane & 31)] = vb;
    } else {
      const int r = row - TOK, bs = r >> 9, j = r & 511;
      const size_t kvrow = (size_t)(NPROMPT + bs * 1536 + j);
      f32x4 kv = *(const f32x4*)&p.in[4][(size_t)r * 256 + lane * 4];
      *(uint2*)&ckvall[kvrow * 256 + lane * 4] = pack4(kv[0], kv[1], kv[2], kv[3]);
      const u16 vb = f2bf(p.in[5][(size_t)r * 32 + (lane & 31)]);
#pragma unroll
      for (int i = 0; i < 8; ++i) Kb[(kvrow * 16 + (lane >> 5) + 2 * i) * 96 + 64 + (lane & 31)] = vb;
    }
  }
}

__device__ __forceinline__ void phase_attn(const Params& p, unsigned char* smem_raw, int bid, int nb) {
  u16* sK = (u16*)smem_raw;
  u16* sV = sK + 128 * 104;
  const u16* qg = (const u16*)(p.ws + WS3_Q);
  const u16* Kg = (const u16*)(p.ws + WS3_K);
  const u16* Vg = (const u16*)(p.ws + WS3_VT);
  const u16* sg = (const u16*)(p.ws + WS3_SG);
  u16* ao = (u16*)(p.ws + WS_H);
  const int tid = threadIdx.x, lane = tid & 63, w = tid >> 6, fr = lane & 15, fq = lane >> 4;
  for (int u = bid; u < 1536; u += nb) {
    int tok0, kvbase, nkeys, h;
    if (u < 512) { const int b = u >> 7, r = u & 127; h = r >> 3; const int qb = r & 7; tok0 = NPROMPT + b * 1024 + qb * 128; kvbase = NPROMPT + b * 1536; nkeys = 1536; }
    else { const int uu = u - 512; const int b = uu >> 5, r = uu & 31; h = r >> 1; const int qb = r & 1; tok0 = b * 256 + qb * 128; kvbase = b * 256; nkeys = 256; }
    const int tokq = tok0 + w * 16 + fr;
    bf16x8 qf[3];
#pragma unroll
    for (int ks = 0; ks < 3; ++ks) qf[ks] = *(const bf16x8*)&qg[(size_t)tokq * 1536 + h * 96 + ks * 32 + fq * 8];
    if (u < 512) {
      const int npos = (tokq - NPROMPT) & 1023;
      const float pos = (fq & 2) ? (float)(npos & 63) : (float)(npos >> 6);
      uint4 raw = *(uint4*)&qf[2];
      unsigned rw[4] = {raw.x, raw.y, raw.z, raw.w};
#pragma unroll
      for (int i = 0; i < 4; ++i) {
        float v0 = lo16(rw[i]), v1 = hi16(rw[i]);
        const float p0 = __shfl_xor(v0, 16), p1 = __shfl_xor(v1, 16);
        float sn0, cs0, sn1, cs1;
        rope_sincos(pos, 2 * i, sn0, cs0); rope_sincos(pos, 2 * i + 1, sn1, cs1);
        v0 = (fq & 1) ? (p0 * sn0 + v0 * cs0) : (v0 * cs0 - p0 * sn0);
        v1 = (fq & 1) ? (p1 * sn1 + v1 * cs1) : (v1 * cs1 - p1 * sn1);
        rw[i] = pack2(v0, v1);
      }
      raw = make_uint4(rw[0], rw[1], rw[2], rw[3]);
      qf[2] = *(bf16x8*)&raw;
    }
    float m = -1e30f, l = 0.f;
    f32x4 oacc[4];
#pragma unroll
    for (int i = 0; i < 4; ++i) oacc[i] = f32x4{0.f, 0.f, 0.f, 0.f};
    const int kk0 = tid / 12, kc0 = tid - kk0 * 12;
    const int kk1 = (tid + NT) / 12, kc1 = (tid + NT) - kk1 * 12;
    const int kk2_ = (tid + 2 * NT) / 12, kc2 = (tid + 2 * NT) - kk2_ * 12;
    const u16* Kp0 = &Kg[((size_t)(kvbase + kk0) * 16 + h) * 96 + kc0 * 8];
    const u16* Kp1 = &Kg[((size_t)(kvbase + kk1) * 16 + h) * 96 + kc1 * 8];
    const u16* Kp2 = &Kg[((size_t)(kvbase + kk2_) * 16 + h) * 96 + kc2 * 8];
    const int vd0 = tid >> 4, vc0 = tid & 15, vd1 = (tid + NT) >> 4;
    const u16* Vp0 = &Vg[(size_t)(h * 64 + vd0) * KVROWS + kvbase + vc0 * 8];
    const u16* Vp1 = &Vg[(size_t)(h * 64 + vd1) * KVROWS + kvbase + vc0 * 8];
    uint4 kr0 = *(const uint4*)Kp0, kr1 = *(const uint4*)Kp1, kr2 = *(const uint4*)Kp2, vr0 = *(const uint4*)Vp0, vr1 = *(const uint4*)Vp1;
    const int ntile2 = nkeys >> 7;
    for (int kt = 0; kt < ntile2; ++kt) {
      __syncthreads();
      *(uint4*)&sK[kk0 * 104 + kc0 * 8] = kr0; *(uint4*)&sK[kk1 * 104 + kc1 * 8] = kr1; *(uint4*)&sK[kk2_ * 104 + kc2 * 8] = kr2;
      *(uint4*)&sV[vd0 * 136 + vc0 * 8] = vr0; *(uint4*)&sV[vd1 * 136 + vc0 * 8] = vr1;
      if (kt + 1 < ntile2) {
        const size_t ko = (size_t)(kt + 1) * 128 * 1536; const int vo = (kt + 1) * 128;
        kr0 = *(const uint4*)(Kp0 + ko); kr1 = *(const uint4*)(Kp1 + ko); kr2 = *(const uint4*)(Kp2 + ko);
        vr0 = *(const uint4*)(Vp0 + vo); vr1 = *(const uint4*)(Vp1 + vo);
      }
      __syncthreads();
      f32x4 sacc[8];
#pragma unroll
      for (int ni = 0; ni < 8; ++ni) {
        sacc[ni] = f32x4{0.f, 0.f, 0.f, 0.f};
#pragma unroll
        for (int ks = 0; ks < 3; ++ks) {
          bf16x8 kf = *(const bf16x8*)&sK[(ni * 16 + fr) * 104 + ks * 32 + fq * 8];
          sacc[ni] = __builtin_amdgcn_mfma_f32_16x16x32_bf16(kf, qf[ks], sacc[ni], 0, 0, 0);
        }
      }
      float mx = -1e30f;
#pragma unroll
      for (int ni = 0; ni < 8; ++ni)
#pragma unroll
        for (int j = 0; j < 4; ++j) mx = fmaxf(mx, sacc[ni][j]);
      mx = fmaxf(mx, __shfl_xor(mx, 16));
      mx = fmaxf(mx, __shfl_xor(mx, 32));
      const float mnew = fmaxf(m, mx);
      const float alpha = __builtin_amdgcn_exp2f(m - mnew);
      m = mnew;
      float ls = 0.f;
#pragma unroll
      for (int ni = 0; ni < 8; ++ni)
#pragma unroll
        for (int j = 0; j < 4; ++j) { float e = __builtin_amdgcn_exp2f(sacc[ni][j] - mnew); sacc[ni][j] = e; ls += e; }
      l = l * alpha + ls;
      bf16x8 pf[4];
#pragma unroll
      for (int kk2 = 0; kk2 < 4; ++kk2) {
        uint2 lo = pack4(sacc[2 * kk2][0], sacc[2 * kk2][1], sacc[2 * kk2][2], sacc[2 * kk2][3]);
        uint2 hi = pack4(sacc[2 * kk2 + 1][0], sacc[2 * kk2 + 1][1], sacc[2 * kk2 + 1][2], sacc[2 * kk2 + 1][3]);
        uint4 pk = make_uint4(lo.x, lo.y, hi.x, hi.y);
        pf[kk2] = *(bf16x8*)&pk;
      }
#pragma unroll
      for (int di = 0; di < 4; ++di) {
#pragma unroll
        for (int j = 0; j < 4; ++j) oacc[di][j] *= alpha;
#pragma unroll
        for (int kk2 = 0; kk2 < 4; ++kk2) {
          uint2 v0 = *(const uint2*)&sV[(di * 16 + fr) * 136 + kk2 * 32 + fq * 4];
          uint2 v1 = *(const uint2*)&sV[(di * 16 + fr) * 136 + kk2 * 32 + 16 + fq * 4];
          uint4 vk = make_uint4(v0.x, v0.y, v1.x, v1.y);
          oacc[di] = __builtin_amdgcn_mfma_f32_16x16x32_bf16(*(bf16x8*)&vk, pf[kk2], oacc[di], 0, 0, 0);
        }
      }
    }
    l += __shfl_xor(l, 16);
    l += __shfl_xor(l, 32);
    const float inv = 1.0f / l;
#pragma unroll
    for (int di = 0; di < 4; ++di) {
      const size_t o = (size_t)tokq * 1024 + h * 64 + di * 16 + fq * 4;
      uint2 s = *(const uint2*)&sg[o];
      *(uint2*)&ao[o] = pack4(oacc[di][0] * inv * siluf_(lo16(s.x)), oacc[di][1] * inv * siluf_(hi16(s.x)), oacc[di][2] * inv * siluf_(lo16(s.y)), oacc[di][3] * inv * siluf_(hi16(s.y)));
    }
  }
}

#define XB_TMO      128
#define XB_XCNT(j)  (256  + 64 * (j))
#define XB_XSUB(j)  (1280 + 64 * (j))
#define XB_XGEN(j)  (2304 + 64 * (j))
#define XB_TOP      3328
#define XB_TOPGEN   3392
#define XCD_BAR_WORDS 3456
#define XB_SPIN_CAP (1u << 22)
__device__ __forceinline__ unsigned xb_ld(unsigned* p)              { return __hip_atomic_load(p, __ATOMIC_RELAXED, __HIP_MEMORY_SCOPE_AGENT); }
__device__ __forceinline__ unsigned xb_add(unsigned* p, unsigned v) { return __hip_atomic_fetch_add(p, v, __ATOMIC_RELAXED, __HIP_MEMORY_SCOPE_AGENT); }
__device__ __forceinline__ unsigned xb_xcc_id() { return (unsigned)__builtin_amdgcn_s_getreg((3 << 11) | 20) & 0xFu; }
#define XB_SPIN(cond, bar) do { unsigned _sp = 0; while (cond) { __builtin_amdgcn_s_sleep(1); \
    if ((++_sp & 255u) == 0u) { if (xb_ld(&(bar)[XB_TMO])) break; if (_sp > XB_SPIN_CAP) { atomicAdd(&(bar)[XB_TMO], 1u); break; } } } } while (0)
struct XcdBarrier { unsigned* bar; unsigned x; volatile LAS unsigned* st; };
__device__ __forceinline__ XcdBarrier xcd_barrier_post(unsigned* bar, volatile LAS unsigned* st) {
  XcdBarrier b; b.bar = bar; b.x = xb_xcc_id(); b.st = st;
  if (threadIdx.x == 0) (void)xb_add(&bar[XB_XCNT(b.x)], 1u);
  return b;
}
__device__ __forceinline__ void xcd_barrier_complete(unsigned* bar, unsigned x, unsigned& nloc, unsigned& nx) {
  const unsigned G = gridDim.x * gridDim.y * gridDim.z;
  unsigned sum, cnt, mine, sp = 0u;
  for (;;) {
    sum = 0u; cnt = 0u; mine = 0u;
#pragma unroll
    for (unsigned j = 0; j < 16; ++j) { const unsigned c = xb_ld(&bar[XB_XCNT(j)]); sum += c; cnt += (c > 0u) ? 1u : 0u; mine = (j == x) ? c : mine; }
    if (sum == G) break;
    __builtin_amdgcn_s_sleep(1);
    if ((++sp & 255u) == 0u) { if (xb_ld(&bar[XB_TMO])) break; if (sp > XB_SPIN_CAP) { atomicAdd(&bar[XB_TMO], 1u); break; } }
  }
  nloc = mine > 0u ? mine : 1u; nx = cnt > 0u ? cnt : 1u;
}
__device__ __forceinline__ void xcd_barrier(const XcdBarrier& b) {
  asm volatile("s_waitcnt vmcnt(0)" ::: "memory");
  __syncthreads();
  if (threadIdx.x == 0) {
    unsigned* bar = b.bar;
    __builtin_amdgcn_s_waitcnt(0);
    unsigned nloc = b.st[0], nx = b.st[1];
    if (nloc == 0u) { xcd_barrier_complete(bar, b.x, nloc, nx); b.st[0] = nloc; b.st[1] = nx; }
    const unsigned old = xb_add(&bar[XB_XSUB(b.x)], 1u);
    const unsigned gen = old / nloc;
    if (old + 1u == (gen + 1u) * nloc) {
      __builtin_amdgcn_fence(__ATOMIC_RELEASE, "agent");
      asm volatile("s_waitcnt vmcnt(0)" ::: "memory");
      const unsigned og = xb_add(&bar[XB_TOP], 1u);
      const unsigned tg = og / nx;
      if (og + 1u == (tg + 1u) * nx) xb_add(&bar[XB_TOPGEN], 1u);
      else XB_SPIN(xb_ld(&bar[XB_TOPGEN]) == tg, bar);
      __builtin_amdgcn_fence(__ATOMIC_ACQUIRE, "agent");
      xb_add(&bar[XB_XGEN(b.x)], 1u);
      asm volatile("s_waitcnt vmcnt(0)" ::: "memory");
    } else {
      XB_SPIN(xb_ld(&bar[XB_XGEN(b.x)]) == gen, bar);
      __builtin_amdgcn_fence(__ATOMIC_ACQUIRE, "agent");
      asm volatile("s_waitcnt vmcnt(0)" ::: "memory");
    }
  }
  __syncthreads();
}

#define GEMM_LDS 131072
#define DYN_LDS (GEMM_LDS + 16)
#define WS_BAR (WS_CNT + 4096ull)

#define RUN_GEMM(Aptr, LDA, Bptr, MM, NN, KK, GATE, EPI, CID) RUN_GEMM_G(Aptr, LDA, Bptr, MM, NN, KK, GATE, EPI, nb, CID)
#define RUN_GEMM_G(Aptr, LDA, Bptr, MM, NN, KK, GATE, EPI, GG, CID) RUN_GEMM_X(Aptr, LDA, (size_t)128, (size_t)0, Bptr, MM, NN, KK, GATE, EPI, GG, CID)
#define GM_KSTEP ((size_t)TOK * 128)
#define RUN_GEMM_X(Aptr, LDA, KSA, GST, Bptr, MM, NN, KK, GATE, EPI, GG, CID) do { pg8::Gemm g_{(const u16*)(Aptr), (const u16*)(Bptr), MM, NN, KK, LDA, GATE, p.flags, KSA, GST}; \
    pg8::StaticOrder S_; S_.init(MM, NN, GG, CID); pg8::gemm_phase((LAS unsigned char*)smem_raw, g_, S_, EPI); } while (0)

__global__ void __launch_bounds__(NT, 2) mega(Params p) {
  extern __shared__ __attribute__((aligned(16))) unsigned char smem_raw[];
  const int bid = blockIdx.x, nb = gridDim.x;
  unsigned char* ws = p.ws;
  const float* mod = (const float*)(ws + WS_MOD);
  volatile LAS unsigned* xst = (volatile LAS unsigned*)((LAS unsigned char*)smem_raw + GEMM_LDS);
  XcdBarrier xb;
  if (p.phase_hi - p.phase_lo > 1) {
    if (threadIdx.x == 0) { xst[0] = 0u; xst[1] = 0u; }
    __syncthreads();
    xb = xcd_barrier_post((unsigned*)(ws + WS_BAR), xst);
  }
#define PH_BEGIN(n) if ((PHMASK & (1u << n)) && p.phase_lo <= n && n < p.phase_hi) { const int ph = n;
#define PH_FIN if (ph + 1 < p.phase_hi) { if (p.phase_lo < 0) cg::this_grid().sync(); else xcd_barrier(xb); } }
  PH_BEGIN(0) phase_prologue(p, smem_raw, bid, nb); PH_FIN
  PH_BEGIN(1) phase_h0(p, bid, nb); PH_FIN
  PH_BEGIN(2) {
    EpiHgIn e{(u16*)(ws + WS_B(0)), (u16*)(ws + WS_B(1)), (u16*)(ws + WS_B(2)), (_Float16*)(ws + WS_B(3)), (const float*)(ws + WS_LB)};
    RUN_GEMM(ws + WS_H, 1024, ws + WS_W_HG_IN, TOK, 5120, 1024, 0, e, bid);
  } PH_FIN
  PH_BEGIN(3) phase_gla(p, smem_raw); PH_FIN
  PH_BEGIN(4) phase_hg_post(p, bid, nb); PH_FIN
  PH_BEGIN(5) {
    EpiResLn<false, true> e{p.in[0], p.in[1], (const u16*)nullptr, p.out, (u16*)(ws + WS_XB), mod + 0 * 15360 + 2048, p.in[10] + 0 * 1024, p.in[11] + 0 * 1024, mod + 1 * 15360, (u16*)(ws + WS_H),
               (unsigned long long*)(ws + WS_SLOT) + 0 * 49152, (unsigned*)(ws + WS_CNT + 256) + 0 * 48};
    RUN_GEMM(ws + WS_B(0), 1024, ws + WS_W_HG_OUT, TOK, 1024, 1024, 0, e, bid);
    wconv_idle(p, smem_raw, bid, nb, 1536, 2816);
  } PH_FIN
  PH_BEGIN(7) {
    EpiScIn e{(u16*)(ws + WS_B(0)), (u16*)(ws + WS_B(1))};
    RUN_GEMM(ws + WS_H, 1024, ws + WS_W_SC_IN, TOK, 4096, 1024, 0, e, bid);
  } PH_FIN
  PH_BEGIN(8) phase_sc_conv(p, bid, nb); PH_FIN
  PH_BEGIN(9) {
    EpiResLn<true, true> e{p.out, p.out, (const u16*)(ws + WS_XB), p.out, (u16*)(ws + WS_XB), mod + 1 * 15360 + 2048, p.in[10] + 1 * 1024, p.in[11] + 1 * 1024, mod + 2 * 15360, (u16*)(ws + WS_H),
               (unsigned long long*)(ws + WS_SLOT) + 1 * 49152, (unsigned*)(ws + WS_CNT + 256) + 1 * 48};
    RUN_GEMM(ws + WS_B(2), 1024, ws + WS_W_SC_OUT, TOK, 1024, 1024, 0, e, bid);
    wconv_idle(p, smem_raw, bid, nb, 2816, 3840);
  } PH_FIN
  PH_BEGIN(11) {
    EpiRgIn e{(u16*)(ws + WS_B(0)), (u16*)(ws + WS_B(1))};
    RUN_GEMM(ws + WS_H, 1024, ws + WS_W_RG_IN, TOK, 2048, 1024, 0, e, bid);
  } PH_FIN
  PH_BEGIN(12) phase_rg_conv(p, bid, nb); PH_FIN
  PH_BEGIN(13) {
    EpiRgGate e{(u16*)(ws + WS_B(3)), (u16*)(ws + WS_B(5)), p.in[24]};
    RUN_GEMM_X(ws + WS_B(2), 64, GM_KSTEP, 4 * GM_KSTEP, ws + WS_W_RG_GATE, TOK, 4096, 256, 1, e, nb, bid);
  } PH_FIN
  PH_BEGIN(14) phase_rg_scan(p, smem_raw, bid, nb); PH_FIN
  PH_BEGIN(15) {
    EpiResLn<true, true> e{p.out, p.out, (const u16*)(ws + WS_XB), p.out, (u16*)(ws + WS_XB), mod + 2 * 15360 + 2048, p.in[10] + 2 * 1024, p.in[11] + 2 * 1024, mod + 3 * 15360, (u16*)(ws + WS_H),
               (unsigned long long*)(ws + WS_SLOT) + 2 * 49152, (unsigned*)(ws + WS_CNT + 256) + 2 * 48};
    RUN_GEMM_X(ws + WS_B(0), 64, GM_KSTEP, (size_t)0, ws + WS_W_RG_OUT, TOK, 1024, 1024, 0, e, nb, bid);
    wconv_idle(p, smem_raw, bid, nb, 3840, 4800);
  } PH_FIN
  PH_BEGIN(17) {
    EpiMlaIn e{(u16*)(ws + WS3_CQ), (float*)(ws + WS3_CKVRAW), (float*)(ws + WS3_KPERAW), (u16*)(ws + WS3_SG)};
    RUN_GEMM(ws + WS_H, 1024, ws + WS_W_MLA_IN, TOK, 768, 1024, 0, e, bid);
  } PH_FIN
  PH_BEGIN(18) phase_mla_norm(p, bid, nb); PH_FIN
  PH_BEGIN(19) {
    const bool bal = (nb == 256);
    EpiSg eg{(u16*)(ws + WS3_SG)};
    RUN_GEMM(ws + WS_H, 1024, ws + WS_W_MLA_IN + 672 * 1024 * 2, TOK, 1024, 1024, 0, eg, bid);
    EpiQ eq{(u16*)(ws + WS3_Q)};
    RUN_GEMM(ws + WS3_CQ, 384, ws + WS_W_QB, TOK, 1536, 384, 0, eq, bal ? ((bid + 64) & 255) : bid);
    EpiK ek{(u16*)(ws + WS3_K)};
    RUN_GEMM(ws + WS3_CKVALL, 256, ws + WS_W_KVB, KVROWS, 1024, 256, 0, ek, bal ? ((bid + 32) & 255) : bid);
    EpiV ev{(u16*)(ws + WS3_VT)};
    RUN_GEMM_G(ws + WS_W_KVB + 1024 * 256 * 2, 256, ws + WS3_CKVALL, 1024, KVROWS, 256, 0, ev, bal ? 64 : nb, bal ? (bid >= 192 ? bid - 192 : (1 << 20)) : bid);
  } PH_FIN
  PH_BEGIN(20) phase_attn(p, smem_raw, bid, nb); PH_FIN
  PH_BEGIN(21) {
    EpiResLn<true, false> e{p.out, p.out, (const u16*)(ws + WS_XB), p.out, (u16*)nullptr, mod + 3 * 15360 + 2048, p.in[10] + 3 * 1024, p.in[11] + 3 * 1024, mod + 3 * 15360, (u16*)nullptr,
               (unsigned long long*)(ws + WS_SLOT) + 3 * 49152, (unsigned*)(ws + WS_CNT + 256) + 3 * 48};
    RUN_GEMM(ws + WS_H, 1024, ws + WS_W_MLA_OUT, TOK, 1024, 1024, 0, e, bid);
  } PH_FIN
}

extern "C" void kernel_launch(void* const* d_in, const int* in_sizes, int n_in, void* d_out, int out_size, void* d_ws, size_t ws_size,
                              hipStream_t stream) {
  static int grid_blocks = 0;
  if (!grid_blocks) {
    int dev = 0, cus = 0, per_cu = 0;
    (void)hipGetDevice(&dev);
    (void)hipDeviceGetAttribute(&cus, hipDeviceAttributeMultiprocessorCount, dev);
    (void)hipFuncSetAttribute((const void*)mega, hipFuncAttributeMaxDynamicSharedMemorySize, DYN_LDS);
    (void)hipOccupancyMaxActiveBlocksPerMultiprocessor(&per_cu, (const void*)mega, NT, DYN_LDS);
    if (per_cu < 1) per_cu = 1;
    if (per_cu > 1) per_cu = 1;
    grid_blocks = cus * per_cu;
  }
  Params p{};
  for (int i = 0; i < 33; ++i) p.in[i] = (const float*)d_in[i];
  p.out = (float*)d_out;
  p.ws = (unsigned char*)d_ws;
#if MULTI_LAUNCH
  (void)hipMemsetAsync((unsigned char*)d_ws + WS_CNT, 0, 4096 + XCD_BAR_WORDS * 4, stream);
  for (int ph = 0; ph < NPHASES; ++ph) {
    p.phase_lo = ph; p.phase_hi = ph + 1;
    hipLaunchKernelGGL(mega, dim3(grid_blocks), dim3(NT), DYN_LDS, stream, p);
#ifdef PROBE_MASK
    if ((PROBE_MASK >> ph) & 1) { p.flags = PROBE_FLAGS; for (int r = 0; r < 2; ++r) {
      if (ph == 3) (void)hipMemsetAsync((unsigned char*)d_ws + WS_CNT, 0, 64, stream);
      hipLaunchKernelGGL(mega, dim3(grid_blocks), dim3(NT), DYN_LDS, stream, p);
    } p.flags = 0; }
#endif
  }
#else
  p.phase_lo = 0; p.phase_hi = NPHASES;
  (void)hipMemsetAsync((unsigned char*)d_ws + WS_CNT, 0, 4096 + XCD_BAR_WORDS * 4, stream);
  void* args[] = {&p};
  hipError_t e = hipLaunchCooperativeKernel((const void*)mega, dim3(grid_blocks), dim3(NT), args, DYN_LDS, stream);
  if (e != hipSuccess) fprintf(stderr, "cooperative launch failed: %s (grid %d)\n", hipGetErrorString(e), grid_blocks);
#endif
}
```

```cpp
#include <hip/hip_runtime.h>
#include <hip/hip_cooperative_groups.h>
#include <cstdio>
namespace cg = cooperative_groups;

#ifndef MULTI_LAUNCH
#define MULTI_LAUNCH 0
#endif

typedef unsigned short u16;
using bf16x8 = __attribute__((ext_vector_type(8))) short;
using f32x4 = __attribute__((ext_vector_type(4))) float;
typedef _Float16 h4 __attribute__((ext_vector_type(4)));

#define TOK 12288
#define NPROMPT 8192
#define KVROWS 14336
#define NPHASES 23
#ifndef PHMASK
#define PHMASK 0x7fffff
#endif
#define DN_ALPHA 1.6817928305074290f

#define WS_W_HG_IN 0ull
#define WS_W_HG_OUT (WS_W_HG_IN + 10485760ull)
#define WS_W_SC_IN (WS_W_HG_OUT + 2097152ull)
#define WS_W_SC_OUT (WS_W_SC_IN + 8388608ull)
#define WS_W_RG_IN (WS_W_SC_OUT + 2097152ull)
#define WS_W_RG_GATE (WS_W_RG_IN + 4194304ull)
#define WS_W_RG_OUT (WS_W_RG_GATE + 2097152ull)
#define WS_W_MLA_IN (WS_W_RG_OUT + 2097152ull)
#define WS_W_QB (WS_W_MLA_IN + 3670016ull)
#define WS_W_KVB (WS_W_QB + 1179648ull)
#define WS_W_MLA_OUT (WS_W_KVB + 1048576ull)
#define WS_MOD (WS_W_MLA_OUT + 2097152ull)
#define WS_LB (WS_MOD + 245760ull)
#define WS_CNT (WS_LB + 8192ull)
#define WS_R (WS_CNT + 4096ull + 16384ull)
#define BSZ 25165824ull
#define WS_H (WS_R)
#define WS_B(i) (WS_R + BSZ * (1 + (i)))
#define WS_SLOT (WS_R + 201326592ull)
#define WS_XB (WS_SLOT + 1572864ull)
#define WS3_CQ (WS_R + 25165824ull)
#define WS3_CKVALL (WS_R + 34603008ull)
#define WS3_CKVRAW (WS_R + 41943040ull)
#define WS3_KPERAW (WS_R + 54525952ull)
#define WS3_SG (WS_R + 56098816ull)
#define WS3_Q (WS_R + 81264640ull)
#define WS3_K (WS_R + 119013376ull)
#define WS3_VT (WS_R + 163053568ull)

#define OUT_HG 12582912
#define OUT_RG 20971520
#define OUT_CKV 21037056
#define OUT_KPE 23134208

struct Params {
  const float* in[33];
  float* out;
  unsigned char* ws;
  int phase_lo, phase_hi, flags, pad_;
};

__device__ __forceinline__ u16 f2bf(float f) { __bf16 r = (__bf16)f; return *(u16*)&r; }
__device__ __forceinline__ float bf2f(u16 h) { return __uint_as_float(((unsigned)h) << 16); }
typedef float f2v_ __attribute__((ext_vector_type(2)));
typedef __bf16 b2v_ __attribute__((ext_vector_type(2)));
__device__ __forceinline__ unsigned pack2(float a, float b) { f2v_ f = {a, b}; b2v_ r = __builtin_convertvector(f, b2v_); return *(unsigned*)&r; }
__device__ __forceinline__ uint2 pack4(float a, float b, float c, float d) { return make_uint2(pack2(a, b), pack2(c, d)); }
__device__ __forceinline__ float lo16(unsigned u) { return __uint_as_float(u << 16); }
__device__ __forceinline__ float hi16(unsigned u) { return __uint_as_float(u & 0xffff0000u); }
__device__ __forceinline__ float sigmoidf_(float x) { return __builtin_amdgcn_rcpf(1.0f + __expf(-x)); }
__device__ __forceinline__ float siluf_(float x) { return x * __builtin_amdgcn_rcpf(1.0f + __expf(-x)); }
__device__ __forceinline__ int cond_of(int tok) { return tok < NPROMPT ? 0 : 1 + ((tok - NPROMPT) >> 10); }
__device__ __forceinline__ float wave_sum(float v) {
#pragma unroll
  for (int o = 32; o > 0; o >>= 1) v += __shfl_xor(v, o);
  return v;
}
__device__ __forceinline__ void rope_sincos(float pos, int fi, float& sn, float& cs) {
  float inv = exp2f(-(float)fi * 1.6609640474436813f);
  float ang = pos * inv;
  float k = rintf(ang * 0.15915494309189535f);
  float r = fmaf(-k, 6.2831854820251465f, ang);
  r = fmaf(-k, -1.7484555e-7f, r);
  sn = __sinf(r); cs = __cosf(r);
}

#define NT 512
#define NW 8
#define LAS __attribute__((address_space(3)))

namespace pg8 {
constexpr int BM = 256, BK = 64, HALF = 128, HTB = HALF * BK * 2, STAGE_BYTES = 8 * HTB, NXCD = 8, WGM = 8;
__device__ __forceinline__ int lds_byte(int r, int c) { const int st = (r >> 4) * 2 + (c >> 5), rr = r & 15, cc = c & 31, ob = rr * 64 + cc * 2; return st * 1024 + (ob ^ (((ob >> 9) & 1) << 5)); }
__device__ __forceinline__ void stage_rc(int b, int& R, int& C) { const int st = b / 1024, sb = b % 1024, swz = sb ^ (((sb >> 9) & 1) << 5); R = (st >> 1) * 16 + swz / 64; C = (st & 1) * 32 + (swz % 64) / 2; }
struct Unit { int pm, pn; };
struct Gemm { const u16* A; const u16* Bt; int M, N, K, lda, gate, noepi; size_t kstepA, gstride; };
struct StaticOrder {
  int nM, nN, nwg, G, c;
  __device__ void init(int M, int N, int G_, int c_) { nM = M / BM; nN = N / BM; nwg = nM * nN; G = G_; c = c_; }
  __device__ bool next(int i, Unit& u) const {
    const long L = (long)i * G + c; if (L >= nwg) return false;
    int wgid = (int)L; { const int q = nwg / NXCD, r = nwg % NXCD, xcd = wgid % NXCD, off = wgid / NXCD; wgid = (xcd < r ? xcd * (q + 1) : r * (q + 1) + (xcd - r) * q) + off; }
    const int nig = WGM * nN, gid = wgid / nig, fm = gid * WGM, gsz = (nM - fm) < WGM ? (nM - fm) : WGM;
    u.pm = fm + ((wgid % nig) % gsz); u.pn = (wgid % nig) / gsz; return true;
  }
};
template <class Epi>
__device__ __forceinline__ void gemm_phase(LAS unsigned char* lds, const Gemm g, const StaticOrder& S, const Epi& E) {
  const int tid = threadIdx.x, wid = __builtin_amdgcn_readfirstlane(tid >> 6), lane = tid & 63, wr = wid >> 2, wc = wid & 3, fr = lane & 15, fq = lane >> 4;
  const int K = g.K, nt = K / BK;
  unsigned voffA[2], voffB[2];
#pragma unroll
  for (int i = 0; i < 2; ++i) { int R, C; stage_rc(tid * 16 + i * 8192, R, C); voffA[i] = (unsigned)(R * g.lda + C) * 2u; voffB[i] = (unsigned)(R * K + C) * 2u; }
  const size_t kstep = (size_t)(BK * 2);
  const size_t kstepA = g.kstepA;
  const size_t hstepA = (size_t)HALF * g.lda * 2, hstepB = (size_t)HALF * K * 2;
  const size_t tstepA = 2 * hstepA, tstepB = 2 * hstepB;
  const unsigned ldsw = (unsigned)wid * 1024u;
  const int aoff = lds_byte(wr * 64 + fr, fq * 8), boff = lds_byte(wc * 32 + fr, fq * 8);
#define PG8_AOFF(pn) (g.gate ? (size_t)(((pn) >> 1) & 3) * g.gstride : (size_t)0)
#define PG8_SA(b, h) (((b) * 2 + (h)) * HTB)
#define PG8_SB(b, h) ((4 + (b) * 2 + (h)) * HTB)
#define PG8_STAGE(bufoff, gbase, voff) do { _Pragma("unroll") for (int _i = 0; _i < 2; ++_i) \
    __builtin_amdgcn_global_load_lds((const unsigned*)((const char*)(gbase) + (voff)[_i]), (LAS unsigned*)(lds + (bufoff) + ldsw + _i * 8192), 16, 0, 0); } while (0)
#define PG8_LDA(dst, b, h) do { _Pragma("unroll") for (int m = 0; m < 4; ++m) _Pragma("unroll") for (int k = 0; k < 2; ++k) dst[m][k] = *(const LAS bf16x8*)(lds + PG8_SA(b, h) + aoff + m * 2048 + k * 1024); } while (0)
#define PG8_LDB(dst, b, h) do { _Pragma("unroll") for (int n = 0; n < 2; ++n) _Pragma("unroll") for (int k = 0; k < 2; ++k) dst[n][k] = *(const LAS bf16x8*)(lds + PG8_SB(b, h) + boff + n * 2048 + k * 1024); } while (0)
#define PG8_MMA(ai, bj, At, Bt) do { __builtin_amdgcn_s_setprio(1); _Pragma("unroll") for (int m = 0; m < 4; ++m) _Pragma("unroll") for (int n = 0; n < 2; ++n) _Pragma("unroll") for (int k = 0; k < 2; ++k) \
    acc[ai][bj][m][n] = __builtin_amdgcn_mfma_f32_16x16x32_bf16(Bt[n][k], At[m][k], acc[ai][bj][m][n], 0, 0, 0); __builtin_amdgcn_s_setprio(0); } while (0)
#define PG8_WAIT_V(n) asm volatile("s_waitcnt vmcnt(" #n ")" ::: "memory")
#define PG8_WAIT_L(n) asm volatile("s_waitcnt lgkmcnt(" #n ")" ::: "memory")
#define PG8_BAR __builtin_amdgcn_s_barrier()
#define PG8_SCHED __builtin_amdgcn_sched_barrier(0)
  Unit cur, nxt; int ui = 0;
  if (!S.next(0, cur)) return;
  f32x4 acc[2][2][4][2];
#pragma unroll
  for (int a = 0; a < 2; ++a)
#pragma unroll
    for (int b = 0; b < 2; ++b)
#pragma unroll
      for (int m = 0; m < 4; ++m)
#pragma unroll
        for (int n = 0; n < 2; ++n) acc[a][b][m][n] = (f32x4){0.f, 0.f, 0.f, 0.f};
  bf16x8 At[4][2], B0[2][2], B1[2][2];
  const char* cA = (const char*)g.A + (size_t)cur.pm * tstepA + PG8_AOFF(cur.pn); const char* cB = (const char*)g.Bt + (size_t)cur.pn * tstepB;
  PG8_STAGE(PG8_SB(0, 0), cB, voffB); PG8_STAGE(PG8_SA(0, 0), cA, voffA); PG8_STAGE(PG8_SB(0, 1), cB + hstepB, voffB); PG8_STAGE(PG8_SA(0, 1), cA + hstepA, voffA);
  if (wr == 1) PG8_BAR;
  PG8_WAIT_V(4); PG8_BAR;
  PG8_STAGE(PG8_SB(1, 0), cB + kstep, voffB); PG8_STAGE(PG8_SA(1, 0), cA + kstepA, voffA); PG8_STAGE(PG8_SB(1, 1), cB + hstepB + kstep, voffB);
  PG8_WAIT_V(6); PG8_BAR;
  for (;;) {
    const bool has_next = S.next(ui + 1, nxt);
    const char* nA = has_next ? (const char*)g.A + (size_t)nxt.pm * tstepA + PG8_AOFF(nxt.pn) : cA; const char* nB = has_next ? (const char*)g.Bt + (size_t)nxt.pn * tstepB : cB;
#pragma unroll 1
    for (int t = 0; t < nt; t += 2) {
      const bool last = (t == nt - 2);
      const char* a1 = cA + (size_t)(t + 1) * kstepA;
      const char* a2 = last ? nA : cA + (size_t)(t + 2) * kstepA; const char* b2 = last ? nB : cB + (size_t)(t + 2) * kstep;
      const char* a3 = a2 + kstepA; const char* b3 = b2 + kstep;
      PG8_LDB(B0, 0, 0); PG8_SCHED; PG8_LDA(At, 0, 0); PG8_STAGE(PG8_SA(1, 1), a1 + hstepA, voffA);
      PG8_WAIT_L(8); PG8_BAR; PG8_WAIT_L(0); PG8_MMA(0, 0, At, B0); PG8_BAR; PG8_SCHED;
      PG8_LDB(B1, 0, 1); PG8_STAGE(PG8_SB(0, 0), b2, voffB);
      PG8_BAR; PG8_WAIT_L(0); PG8_MMA(0, 1, At, B1); PG8_BAR;
      PG8_LDA(At, 0, 1); PG8_STAGE(PG8_SA(0, 0), a2, voffA);
      PG8_BAR; PG8_WAIT_L(0); PG8_MMA(1, 0, At, B0); PG8_BAR; PG8_SCHED;
      PG8_STAGE(PG8_SB(0, 1), b2 + hstepB, voffB);
      PG8_WAIT_V(6); PG8_BAR; PG8_MMA(1, 1, At, B1); PG8_BAR;
      PG8_LDB(B0, 1, 0); PG8_SCHED; PG8_LDA(At, 1, 0); PG8_STAGE(PG8_SA(0, 1), a2 + hstepA, voffA);
      PG8_WAIT_L(8); PG8_BAR; PG8_WAIT_L(0); PG8_MMA(0, 0, At, B0); PG8_BAR; PG8_SCHED;
      PG8_LDB(B1, 1, 1); PG8_STAGE(PG8_SB(1, 0), b3, voffB);
      PG8_BAR; PG8_WAIT_L(0); PG8_MMA(0, 1, At, B1); PG8_BAR;
      PG8_LDA(At, 1, 1); PG8_STAGE(PG8_SA(1, 0), a3, voffA);
      PG8_BAR; PG8_WAIT_L(0); PG8_MMA(1, 0, At, B0); PG8_BAR; PG8_SCHED;
      PG8_STAGE(PG8_SB(1, 1), b3 + hstepB, voffB);
      PG8_WAIT_V(6); PG8_BAR; PG8_MMA(1, 1, At, B1); PG8_BAR;
    }
    if constexpr (!Epi::AFTER_DRAIN) { if (!g.noepi) E(acc, cur, wr, wc, fr, fq); }
    if (!has_next) break;
#pragma unroll
    for (int a = 0; a < 2; ++a)
#pragma unroll
      for (int b = 0; b < 2; ++b)
#pragma unroll
        for (int m = 0; m < 4; ++m)
#pragma unroll
          for (int n = 0; n < 2; ++n) acc[a][b][m][n] = (f32x4){0.f, 0.f, 0.f, 0.f};
    cur = nxt; cA = nA; cB = nB; ++ui;
  }
  PG8_WAIT_V(0);
  if (wr == 0) PG8_BAR;
  PG8_BAR;
  if constexpr (Epi::AFTER_DRAIN) { if (!g.noepi) E.fused(acc, cur, wr, wc, fr, fq, lds); }
#undef PG8_AOFF
#undef PG8_SA
#undef PG8_SB
#undef PG8_STAGE
#undef PG8_LDA
#undef PG8_LDB
#undef PG8_MMA
#undef PG8_WAIT_V
#undef PG8_WAIT_L
#undef PG8_BAR
#undef PG8_SCHED
}
}
using pg8::Unit;
typedef const f32x4 (&AccRef)[2][2][4][2];

#define EPI_ROWS(...) _Pragma("unroll") for (int ai = 0; ai < 2; ++ai) _Pragma("unroll") for (int m = 0; m < 4; ++m) { const int row = u.pm * 256 + ai * 128 + wr * 64 + m * 16 + fr; __VA_ARGS__ }
#define EPI_COLS(...) _Pragma("unroll") for (int bj = 0; bj < 2; ++bj) _Pragma("unroll") for (int n = 0; n < 2; ++n) { const int cb = u.pn * 256 + bj * 128 + wc * 32 + n * 16; const f32x4 a = acc[ai][bj][m][n]; __VA_ARGS__ }

struct EpiHgIn {
  static constexpr bool AFTER_DRAIN = false;
  u16 *q, *v, *sg; _Float16* lf; const float* lb;
  __device__ __forceinline__ void operator()(AccRef acc, const Unit& u, int wr, int wc, int fr, int fq) const {
    const int region = u.pn >> 2;
    f32x4 l4[2][2];
    if (region == 1 || region == 2) {
#pragma unroll
      for (int bj = 0; bj < 2; ++bj)
#pragma unroll
        for (int n = 0; n < 2; ++n) l4[bj][n] = *(const f32x4*)&lb[(region - 1) * 1024 + ((u.pn * 256 + bj * 128 + wc * 32 + n * 16) & 1023) + fq * 4];
    }
    EPI_ROWS( EPI_COLS(
      const int c = (cb & 1023) + fq * 4;
      if (region == 0) {
        const float s = 0.08838834764831845f;
        *(uint2*)&q[(size_t)row * 1024 + c] = pack4(siluf_(a[0]) * s, siluf_(a[1]) * s, siluf_(a[2]) * s, siluf_(a[3]) * s);
      } else if (region <= 2) {
        const int d = region - 1;
        h4 o;
        _Pragma("unroll") for (int j = 0; j < 4; ++j) { float f = l4[bj][n][j] + (1.0f - l4[bj][n][j]) * sigmoidf_(a[j]); o[j] = (_Float16)__logf(f); }
        *(h4*)&lf[(size_t)row * 2048 + d * 1024 + c] = o;
      } else if (region == 3) {
        *(uint2*)&v[(size_t)row * 1024 + c] = pack4(a[0], a[1], a[2], a[3]);
      } else {
        *(uint2*)&sg[(size_t)row * 1024 + c] = pack4(a[0], a[1], a[2], a[3]);
      }
    ) )
  }
};

struct EpiRes {
  static constexpr bool AFTER_DRAIN = false;
  const float* xin_p; const float* xin_s; float* Y; const float* gate;
  __device__ __forceinline__ void operator()(AccRef acc, const Unit& u, int wr, int wc, int fr, int fq) const {
    EPI_ROWS(
      const float* xr = row < NPROMPT ? xin_p + (size_t)row * 1024 : xin_s + (size_t)(row - NPROMPT) * 1024;
      const float* g = gate + cond_of(row) * 3072;
      EPI_COLS(
        const int c = cb + fq * 4;
        f32x4 x = *(const f32x4*)&xr[c];
        f32x4 gg = *(const f32x4*)&g[c];
        f32x4 y;
        _Pragma("unroll") for (int j = 0; j < 4; ++j) y[j] = DN_ALPHA * x[j] + gg[j] * a[j];
        *(f32x4*)&Y[(size_t)row * 1024 + c] = y;
      ) )
  }
};

template <bool XIN_BF, bool XOUT_BF>
struct EpiResLn {
  static constexpr bool AFTER_DRAIN = true;
  const float* xin_p; const float* xin_s; const u16* xin_b; float* X; u16* XB; const float* gate; const float* lg; const float* lbias; const float* modn; u16* H;
  unsigned long long* slots; unsigned* cnt;
  __device__ __forceinline__ void fused(f32x4 (&acc)[2][2][4][2], const Unit& u, int wr, int wc, int fr, int fq, LAS unsigned char* lds) const {
    LAS float* part = (LAS float*)lds;
    LAS float* stat = part + 2048;
    const int tid = threadIdx.x;
    const int cnd = cond_of(u.pm * 256);
    f32x4 gv[2][2];
#pragma unroll
    for (int bj = 0; bj < 2; ++bj)
#pragma unroll
      for (int n = 0; n < 2; ++n) gv[bj][n] = *(const f32x4*)&gate[cnd * 3072 + u.pn * 256 + bj * 128 + wc * 32 + n * 16 + fq * 4];
#pragma unroll
    for (int ai = 0; ai < 2; ++ai)
#pragma unroll
      for (int m = 0; m < 4; ++m) {
        const int rl = ai * 128 + wr * 64 + m * 16 + fr;
        const int row = u.pm * 256 + rl;
        const float* xr = row < NPROMPT ? xin_p + (size_t)row * 1024 : xin_s + (size_t)(row - NPROMPT) * 1024;
        float s1 = 0.f, s2 = 0.f;
#pragma unroll
        for (int bj = 0; bj < 2; ++bj)
#pragma unroll
          for (int n = 0; n < 2; ++n) {
            const int c = u.pn * 256 + bj * 128 + wc * 32 + n * 16 + fq * 4;
            f32x4 x;
            if constexpr (XIN_BF) { const uint2 xb2 = *(const uint2*)&xin_b[(size_t)row * 1024 + c]; x = f32x4{lo16(xb2.x), hi16(xb2.x), lo16(xb2.y), hi16(xb2.y)}; }
            else x = *(const f32x4*)&xr[c];
            const f32x4 gg = gv[bj][n];
            f32x4 y;
#pragma unroll
            for (int j = 0; j < 4; ++j) { y[j] = DN_ALPHA * x[j] + gg[j] * acc[ai][bj][m][n][j]; s1 += y[j]; s2 += y[j] * y[j]; }
            acc[ai][bj][m][n] = y;
          }
        s1 += __shfl_xor(s1, 16); s1 += __shfl_xor(s1, 32);
        s2 += __shfl_xor(s2, 16); s2 += __shfl_xor(s2, 32);
        if (fq == 0) { part[(rl * 4 + wc) * 2] = s1; part[(rl * 4 + wc) * 2 + 1] = s2; }
      }
    __syncthreads();
    if (tid < 256) {
      float S1 = 0.f, S2 = 0.f;
#pragma unroll
      for (int w2 = 0; w2 < 4; ++w2) { S1 += part[(tid * 4 + w2) * 2]; S2 += part[(tid * 4 + w2) * 2 + 1]; }
      const unsigned long long v = (unsigned long long)__float_as_uint(S1) | ((unsigned long long)__float_as_uint(S2) << 32);
      __hip_atomic_store(&slots[(size_t)(u.pm * 4 + u.pn) * 256 + tid], v, __ATOMIC_RELAXED, __HIP_MEMORY_SCOPE_AGENT);
    }
    asm volatile("s_waitcnt vmcnt(0)" ::: "memory");
    __syncthreads();
    if (tid == 0) {
      __hip_atomic_fetch_add(&cnt[u.pm], 1u, __ATOMIC_RELAXED, __HIP_MEMORY_SCOPE_AGENT);
      unsigned sp = 0;
      while (__hip_atomic_load(&cnt[u.pm], __ATOMIC_RELAXED, __HIP_MEMORY_SCOPE_AGENT) < 4u) { __builtin_amdgcn_s_sleep(1); if (++sp > (1u << 24)) break; }
    }
    __syncthreads();
    if (tid < 256) {
      float T1 = 0.f, T2 = 0.f;
#pragma unroll
      for (int o = 0; o < 4; ++o) {
        const unsigned long long v = __hip_atomic_load(&slots[(size_t)(u.pm * 4 + o) * 256 + tid], __ATOMIC_RELAXED, __HIP_MEMORY_SCOPE_AGENT);
        T1 += __uint_as_float((unsigned)(v & 0xffffffffull)); T2 += __uint_as_float((unsigned)(v >> 32));
      }
      const float mu = T1 * (1.0f / 1024.0f);
      const float var = fmaxf(T2 * (1.0f / 1024.0f) - mu * mu, 0.f);
      stat[tid * 2] = mu; stat[tid * 2 + 1] = rsqrtf(var + 1e-5f);
    }
    __syncthreads();
#pragma unroll
    for (int bj = 0; bj < 2; ++bj) {
      f32x4 lgv[2], lbv[2], shv[2], scv[2];
#pragma unroll
      for (int n = 0; n < 2; ++n) {
        const int c = u.pn * 256 + bj * 128 + wc * 32 + n * 16 + fq * 4;
        lgv[n] = *(const f32x4*)&lg[c]; lbv[n] = *(const f32x4*)&lbias[c];
        shv[n] = *(const f32x4*)&modn[cnd * 3072 + c]; scv[n] = *(const f32x4*)&modn[cnd * 3072 + 1024 + c];
      }
#pragma unroll
      for (int ai = 0; ai < 2; ++ai)
#pragma unroll
        for (int m = 0; m < 4; ++m) {
          const int rl = ai * 128 + wr * 64 + m * 16 + fr;
          const int row = u.pm * 256 + rl;
          const float mu = stat[rl * 2], rs = stat[rl * 2 + 1];
#pragma unroll
          for (int n = 0; n < 2; ++n) {
            const int c = u.pn * 256 + bj * 128 + wc * 32 + n * 16 + fq * 4;
            const f32x4 y = acc[ai][bj][m][n];
            f32x4 xo;
#pragma unroll
            for (int j = 0; j < 4; ++j) xo[j] = (y[j] - mu) * rs * lgv[n][j] + lbv[n][j];
            if constexpr (XOUT_BF) *(uint2*)&XB[(size_t)row * 1024 + c] = pack4(xo[0], xo[1], xo[2], xo[3]);
            else *(f32x4*)&X[(size_t)row * 1024 + c] = xo;
            if (H) {
              *(uint2*)&H[(size_t)row * 1024 + c] = pack4(xo[0] * (1 + scv[n][0]) + shv[n][0], xo[1] * (1 + scv[n][1]) + shv[n][1], xo[2] * (1 + scv[n][2]) + shv[n][2], xo[3] * (1 + scv[n][3]) + shv[n][3]);
            }
          }
        }
    }
  }
};

struct EpiScIn {
  static constexpr bool AFTER_DRAIN = false;
  u16 *pb, *sb;
  __device__ __forceinline__ void operator()(AccRef acc, const Unit& u, int wr, int wc, int fr, int fq) const {
    const int c = u.pn * 64 + wc * 16 + fq * 4;
    EPI_ROWS(
      const f32x4 bg = acc[ai][0][m][0], cgv = acc[ai][0][m][1], v = acc[ai][1][m][0], g = acc[ai][1][m][1];
      *(uint2*)&pb[(size_t)row * 1024 + c] = pack4(cgv[0] * v[0], cgv[1] * v[1], cgv[2] * v[2], cgv[3] * v[3]);
      *(uint2*)&sb[(size_t)row * 1024 + c] = pack4(siluf_(g[0]) * bg[0], siluf_(g[1]) * bg[1], siluf_(g[2]) * bg[2], siluf_(g[3]) * bg[3]);
    )
  }
};

struct EpiRgIn {
  static constexpr bool AFTER_DRAIN = false;
  u16 *ub, *sg;
  __device__ __forceinline__ void operator()(AccRef acc, const Unit& u, int wr, int wc, int fr, int fq) const {
    const int region = u.pn >> 2;
    EPI_ROWS( EPI_COLS(
      const int c = (cb & 1023) + fq * 4;
      if (region == 0) *(uint2*)&ub[(size_t)row * 1024 + c] = pack4(a[0], a[1], a[2], a[3]);
      else *(uint2*)&sg[((size_t)(c >> 6) * TOK + row) * 64 + (c & 63)] = pack4(siluf_(a[0]), siluf_(a[1]), siluf_(a[2]), siluf_(a[3]));
    ) )
  }
};

struct EpiRgGate {
  static constexpr bool AFTER_DRAIN = false;
  u16 *rb, *ib; const float* bgate;
  __device__ __forceinline__ void operator()(AccRef acc, const Unit& u, int wr, int wc, int fr, int fq) const {
    const int mat = u.pn >> 1, d = mat >> 2, hd = mat & 3;
    f32x4 br[2], bi[2]; int ccs[2];
#pragma unroll
    for (int bj = 0; bj < 2; ++bj) {
      const int off = ((u.pn & 1) * 256 + bj * 128 + wc * 32);
      ccs[bj] = (off >> 5) * 16 + fq * 4;
      br[bj] = *(const f32x4*)&bgate[mat * 512 + ccs[bj]];
      bi[bj] = *(const f32x4*)&bgate[mat * 512 + 256 + ccs[bj]];
    }
    EPI_ROWS(
      _Pragma("unroll") for (int bj = 0; bj < 2; ++bj) {
        const f32x4 r = acc[ai][bj][m][0], ii = acc[ai][bj][m][1];
        const int cch = hd * 256 + ccs[bj];
        const size_t o = (size_t)d * TOK * 1024 + ((size_t)(cch >> 6) * TOK + row) * 64 + (cch & 63);
        *(uint2*)&rb[o] = pack4(sigmoidf_(r[0] + br[bj][0]), sigmoidf_(r[1] + br[bj][1]), sigmoidf_(r[2] + br[bj][2]), sigmoidf_(r[3] + br[bj][3]));
        *(uint2*)&ib[o] = pack4(sigmoidf_(ii[0] + bi[bj][0]), sigmoidf_(ii[1] + bi[bj][1]), sigmoidf_(ii[2] + bi[bj][2]), sigmoidf_(ii[3] + bi[bj][3]));
      } )
  }
};

struct EpiMlaIn {
  static constexpr bool AFTER_DRAIN = false;
  u16* cq; float* ckvraw; float* kperaw; u16* sg;
  __device__ __forceinline__ void operator()(AccRef acc, const Unit& u, int wr, int wc, int fr, int fq) const {
    EPI_ROWS( EPI_COLS(
      const int c = cb + fq * 4;
      if (cb < 384) *(uint2*)&cq[(size_t)row * 384 + c] = pack4(a[0], a[1], a[2], a[3]);
      else if (cb < 640) *(f32x4*)&ckvraw[(size_t)row * 256 + (c - 384)] = a;
      else if (cb < 672) *(f32x4*)&kperaw[(size_t)row * 32 + (c - 640)] = a;
    ) )
  }
};

struct EpiSg {
  static constexpr bool AFTER_DRAIN = false;
  u16* sg;
  __device__ __forceinline__ void operator()(AccRef acc, const Unit& u, int wr, int wc, int fr, int fq) const {
    EPI_ROWS( EPI_COLS(
      *(uint2*)&sg[(size_t)row * 1024 + cb + fq * 4] = pack4(a[0], a[1], a[2], a[3]);
    ) )
  }
};

struct EpiQ {
  static constexpr bool AFTER_DRAIN = false;
  u16* q;
  __device__ __forceinline__ void operator()(AccRef acc, const Unit& u, int wr, int wc, int fr, int fq) const {
    const float sc = 0.14724444500602648f;
    EPI_ROWS( EPI_COLS(
      *(uint2*)&q[(size_t)row * 1536 + cb + fq * 4] = pack4(a[0] * sc, a[1] * sc, a[2] * sc, a[3] * sc);
    ) )
  }
};

struct EpiK {
  static constexpr bool AFTER_DRAIN = false;
  u16* Kb;
  __device__ __forceinline__ void operator()(AccRef acc, const Unit& u, int wr, int wc, int fr, int fq) const {
    EPI_ROWS( EPI_COLS(
      const int h = cb >> 6, dd = (cb & 63) + fq * 4;
      *(uint2*)&Kb[((size_t)row * 16 + h) * 96 + dd] = pack4(a[0], a[1], a[2], a[3]);
    ) )
  }
};
struct EpiV {
  static constexpr bool AFTER_DRAIN = false;
  u16* Vt;
  __device__ __forceinline__ void operator()(AccRef acc, const Unit& u, int wr, int wc, int fr, int fq) const {
    EPI_ROWS( EPI_COLS(
      *(uint2*)&Vt[(size_t)row * KVROWS + cb + fq * 4] = pack4(a[0], a[1], a[2], a[3]);
    ) )
  }
};

__device__ __forceinline__ void wconv_tile(const float* __restrict__ src, int N, int K, u16* __restrict__ dst, int k0, int n0,
                                           int perm, int mat, float* tile) {
  const int tid = threadIdx.x;
  {
    const int r = tid >> 4, c4 = (tid & 15) * 4;
#pragma unroll
    for (int i = 0; i < 2; ++i) {
      const int k = r + i * 32;
      f32x4 v = f32x4{0.f, 0.f, 0.f, 0.f};
      if (n0 + c4 < N) v = *(const f32x4*)&src[(size_t)(k0 + k) * N + n0 + c4];
      tile[k * 65 + c4 + 0] = v[0]; tile[k * 65 + c4 + 1] = v[1]; tile[k * 65 + c4 + 2] = v[2]; tile[k * 65 + c4 + 3] = v[3];
    }
  }
  __syncthreads();
  {
    const int nl = tid >> 3, kq = (tid & 7) * 8;
    const int n = n0 + nl;
    int np = n;
    if (perm == 1) { const int part = n >> 10, c = n & 1023; np = (c >> 6) * 256 + (part >> 1) * 128 + ((c >> 4) & 3) * 32 + (part & 1) * 16 + (c & 15); }
    else if (perm == 2) { const int type = n >> 8, cc = n & 255; np = mat * 512 + (cc >> 4) * 32 + type * 16 + (cc & 15); }
    else if (perm == 3) { const int hh = n >> 7, dd = n & 127; np = (dd >= 64 ? 1024 : 0) + hh * 64 + (dd & 63); }
    if (n < N) {
      unsigned w[4];
#pragma unroll
      for (int i = 0; i < 4; ++i) w[i] = pack2(tile[(kq + 2 * i) * 65 + nl], tile[(kq + 2 * i + 1) * 65 + nl]);
      *(uint4*)&dst[(size_t)np * K + k0 + kq] = make_uint4(w[0], w[1], w[2], w[3]);
    }
  }
  __syncthreads();
}

__device__ __forceinline__ void wconv_item(const Params& p, int t, float* fs) {
  const float* src; u16* dst; int N, K, perm = 0, mat = 0, ntn;
  if (t < 1280) { src = p.in[12]; dst = (u16*)(p.ws + WS_W_HG_IN); N = 5120; K = 1024; }
  else if ((t -= 1280) < 256) { src = p.in[15]; dst = (u16*)(p.ws + WS_W_HG_OUT); N = 1024; K = 1024; }
  else if ((t -= 256) < 1024) { src = p.in[16]; dst = (u16*)(p.ws + WS_W_SC_IN); N = 4096; K = 1024; perm = 1; }
  else if ((t -= 1024) < 256) { src = p.in[19]; dst = (u16*)(p.ws + WS_W_SC_OUT); N = 1024; K = 1024; }
  else if ((t -= 256) < 512) { src = p.in[20]; dst = (u16*)(p.ws + WS_W_RG_IN); N = 2048; K = 1024; }
  else if ((t -= 512) < 256) { mat = t >> 5; t &= 31; src = p.in[23] + (size_t)mat * 256 * 512; dst = (u16*)(p.ws + WS_W_RG_GATE); N = 512; K = 256; perm = 2; }
  else if ((t -= 256) < 256) { src = p.in[26]; dst = (u16*)(p.ws + WS_W_RG_OUT); N = 1024; K = 1024; }
  else if ((t -= 256) < 432) { src = p.in[27]; dst = (u16*)(p.ws + WS_W_MLA_IN); N = 1696; K = 1024; }
  else if ((t -= 432) < 144) { src = p.in[30]; dst = (u16*)(p.ws + WS_W_QB); N = 1536; K = 384; }
  else if ((t -= 144) < 128) { src = p.in[31]; dst = (u16*)(p.ws + WS_W_KVB); N = 2048; K = 256; perm = 3; }
  else { t -= 128; src = p.in[32]; dst = (u16*)(p.ws + WS_W_MLA_OUT); N = 1024; K = 1024; }
  ntn = (N + 63) >> 6;
  const int kt = t / ntn, ntl = t - kt * ntn;
  wconv_tile(src, N, K, dst, kt * 64, ntl * 64, perm, mat, fs);
}
__device__ __forceinline__ void wconv_idle(const Params& p, unsigned char* smem_raw, int bid, int nb, int t0, int t1) {
  if (nb == 256 && bid >= 192) for (int t = t0 + (bid - 192); t < t1; t += 64) wconv_item(p, t, (float*)smem_raw);
}

__device__ __forceinline__ void phase_prologue(const Params& p, unsigned char* smem_raw, int bid, int nb) {
  float* fs = (float*)smem_raw;
  const int tid = threadIdx.x;
  const int NMOD = 192, NWT = (nb == 256) ? 1536 : 4800;
  for (int it = bid; it < NMOD + 1 + NWT; it += nb) {
    if (it < NMOD) {
      const int l = it / 48, n0 = (it % 48) * 64;
      float* scond = fs;
      float* sred = fs + 5120;
      for (int i = tid; i < 5120; i += NT) {
        const int ci = i >> 10, k = i & 1023;
        float cv = ci == 0 ? p.in[7][k] : p.in[6][(ci - 1) * 1024 + k];
        scond[i] = siluf_(cv);
      }
      __syncthreads();
      const int col = tid & 63, kg = tid >> 6;
      const float* w = p.in[8] + (size_t)l * 1024 * 3072 + n0 + col;
      float a0 = 0, a1 = 0, a2 = 0, a3 = 0, a4 = 0;
#pragma unroll 16
      for (int k = kg * 128; k < kg * 128 + 128; ++k) {
        float wv = w[(size_t)k * 3072];
        a0 += scond[k] * wv; a1 += scond[1024 + k] * wv; a2 += scond[2048 + k] * wv; a3 += scond[3072 + k] * wv; a4 += scond[4096 + k] * wv;
      }
      sred[(kg * 5 + 0) * 64 + col] = a0; sred[(kg * 5 + 1) * 64 + col] = a1; sred[(kg * 5 + 2) * 64 + col] = a2;
      sred[(kg * 5 + 3) * 64 + col] = a3; sred[(kg * 5 + 4) * 64 + col] = a4;
      __syncthreads();
      float* mod = (float*)(p.ws + WS_MOD);
      if (tid < 320) {
        const int ci = tid >> 6, cc = tid & 63;
        float s = 0;
#pragma unroll
        for (int g = 0; g < 8; ++g) s += sred[(g * 5 + ci) * 64 + cc];
        mod[(l * 5 + ci) * 3072 + n0 + cc] = s + p.in[9][l * 3072 + n0 + cc];
      }
      __syncthreads();
    } else if (it == NMOD) {
      float* lb = (float*)(p.ws + WS_LB);
      for (int i = tid; i < 2048; i += NT) {
        const int d = i >> 10, c = i & 1023;
        const float* lg = p.in[13] + d * 5 * 1024 + c;
        float m = lg[0];
        for (int j = 1; j < 5; ++j) m = fmaxf(m, lg[j * 1024]);
        float s = 0;
        for (int j = 0; j < 5; ++j) s += expf(lg[j * 1024] - m);
        lb[i] = expf(lg[0] - m) / s;
      }
      int* cnt = (int*)(p.ws + WS_CNT);
      if (tid < 16) cnt[tid] = 0;
    } else {
      wconv_item(p, it - NMOD - 1, fs);
    }
  }
}

__device__ __forceinline__ void phase_h0(const Params& p, int bid, int nb) {
  const float* mod = (const float*)(p.ws + WS_MOD);
  u16* H = (u16*)(p.ws + WS_H);
  const size_t total = (size_t)(TOK / 4) * 256;
  for (size_t i = (size_t)bid * NT + threadIdx.x; i < total; i += (size_t)nb * NT) {
    const int row = (int)(i >> 8) * 4, c = ((int)i & 255) * 4;
    const float* xr = row < NPROMPT ? p.in[0] + (size_t)row * 1024 : p.in[1] + (size_t)(row - NPROMPT) * 1024;
    const float* m = mod + cond_of(row) * 3072;
    f32x4 x[4];
#pragma unroll
    for (int t = 0; t < 4; ++t) x[t] = *(const f32x4*)&xr[t * 1024 + c];
    const f32x4 sh = *(const f32x4*)&m[c];
    const f32x4 sc = *(const f32x4*)&m[1024 + c];
#pragma unroll
    for (int t = 0; t < 4; ++t)
      *(uint2*)&H[(size_t)(row + t) * 1024 + c] = pack4(x[t][0] * (1 + sc[0]) + sh[0], x[t][1] * (1 + sc[1]) + sh[1], x[t][2] * (1 + sc[2]) + sh[2], x[t][3] * (1 + sc[3]) + sh[3]);
  }
}

__device__ __forceinline__ void phase_ln(const Params& p, int l, int bid, int nb) {
  float* X = p.out;
  const float* g = p.in[10] + l * 1024;
  const float* b = p.in[11] + l * 1024;
  const float* mod = (const float*)(p.ws + WS_MOD) + (l + 1) * 5 * 3072;
  u16* H = (u16*)(p.ws + WS_H);
  const int lane = threadIdx.x & 63, wave = threadIdx.x >> 6;
  for (int row = bid * NW + wave; row < TOK; row += nb * NW) {
    float* xr = X + (size_t)row * 1024;
    f32x4 v[4];
    float s = 0;
#pragma unroll
    for (int i = 0; i < 4; ++i) { v[i] = *(const f32x4*)&xr[i * 256 + lane * 4]; s += v[i][0] + v[i][1] + v[i][2] + v[i][3]; }
    const float mu = wave_sum(s) * (1.0f / 1024.0f);
    float q = 0;
#pragma unroll
    for (int i = 0; i < 4; ++i)
#pragma unroll
      for (int j = 0; j < 4; ++j) { float dd = v[i][j] - mu; q += dd * dd; }
    const float rs = rsqrtf(wave_sum(q) * (1.0f / 1024.0f) + 1e-5f);
    const float* m = mod + cond_of(row) * 3072;
#pragma unroll
    for (int i = 0; i < 4; ++i) {
      const int c = i * 256 + lane * 4;
      f32x4 gg = *(const f32x4*)&g[c], bb = *(const f32x4*)&b[c];
      f32x4 y;
#pragma unroll
      for (int j = 0; j < 4; ++j) y[j] = (v[i][j] - mu) * rs * gg[j] + bb[j];
      *(f32x4*)&xr[c] = y;
      if (l < 3) {
        f32x4 sh = *(const f32x4*)&m[c], sc = *(const f32x4*)&m[1024 + c];
        *(uint2*)&H[(size_t)row * 1024 + c] = pack4(y[0] * (1 + sc[0]) + sh[0], y[1] * (1 + sc[1]) + sh[1], y[2] * (1 + sc[2]) + sh[2], y[3] * (1 + sc[3]) + sh[3]);
      }
    }
  }
}

__device__ __forceinline__ void phase_gla(const Params& p, unsigned char* smem_raw) {
  u16* s_qrel = (u16*)smem_raw;
  u16* s_krel = s_qrel + 32 * 136;
  u16* s_qcum = s_krel + 32 * 136;
  u16* s_kdT = s_qcum + 32 * 136;
  u16* s_vT = s_kdT + 128 * 40;
  u16* s_att = s_vT + 128 * 40;
  u16* s_S = s_att + 32 * 40;
  float* s_dec = (float*)(s_S + 128 * 136);
  float* s_part = s_dec + 128;
  int* s_u = (int*)(s_part + 512);
  int* counter = (int*)(p.ws + WS_CNT);
  const u16* qg = (const u16*)(p.ws + WS_B(0));
  const u16* vg = (const u16*)(p.ws + WS_B(1));
  const _Float16* lfg = (const _Float16*)(p.ws + WS_B(3));
  u16* og = (u16*)(p.ws + WS_B(5));
  const int tid = threadIdx.x, lane = tid & 63, w = tid >> 6, fr = lane & 15, fq = lane >> 4;
  const int kk = tid & 127, th = tid >> 7;
  const int ti = w >> 2, vi = w & 3;
  const int wk = w & 3, wv = w >> 2;
  while (true) {
    if (tid == 0) *s_u = atomicAdd(counter, 1);
    __syncthreads();
    const int u = *s_u;
    __syncthreads();
    if (u >= 576) break;
    int b, rem, start, N, sample;
    if (u < 64) { sample = 1; b = u >> 4; rem = u & 15; start = NPROMPT + b * 1024; N = 1024; }
    else { sample = 0; b = (u - 64) >> 4; rem = (u - 64) & 15; start = b * 256; N = 256; }
    const int h = rem >> 1, d = rem & 1;
    const int nc = N >> 5;
    f32x4 S[2][4];
#pragma unroll
    for (int mi = 0; mi < 2; ++mi)
#pragma unroll
      for (int ni = 0; ni < 4; ++ni) {
        f32x4 s4 = f32x4{0.f, 0.f, 0.f, 0.f};
        if (sample) {
          const float* s0 = p.in[2] + ((size_t)((b * 2 + d) * 8 + h)) * 16384;
#pragma unroll
          for (int j = 0; j < 4; ++j) s4[j] = s0[(wk * 32 + mi * 16 + fq * 4 + j) * 128 + wv * 64 + ni * 16 + fr];
        }
        S[mi][ni] = s4;
        *(uint2*)&s_S[(wv * 64 + ni * 16 + fr) * 136 + wk * 32 + mi * 16 + fq * 4] = pack4(s4[0], s4[1], s4[2], s4[3]);
      }
    _Float16 lfraw[8]; u16 qraw[8]; uint4 vraw;
#define GLA_LOAD(cc) do { _Pragma("unroll") for (int i = 0; i < 8; ++i) { const int tt = (cc) * 32 + th * 8 + i; const size_t tok = start + (d ? (N - 1 - tt) : tt); \
      lfraw[i] = lfg[tok * 2048 + d * 1024 + h * 128 + kk]; qraw[i] = qg[tok * 1024 + h * 128 + kk]; } \
      { const int tt = (cc) * 32 + (tid >> 4); const size_t tok = start + (d ? (N - 1 - tt) : tt); vraw = *(const uint4*)&vg[tok * 1024 + h * 128 + (tid & 15) * 8]; } } while (0)
    GLA_LOAD(0);
    for (int c = 0; c < nc; ++c) {
      {
        float lfv[8], qv[8];
#pragma unroll
        for (int i = 0; i < 8; ++i) { lfv[i] = (float)lfraw[i]; qv[i] = bf2f(qraw[i]); }
        const uint4 vv = vraw;
        if (c + 1 < nc) GLA_LOAD(c + 1);
        float run = 0;
        float cs[8];
#pragma unroll
        for (int i = 0; i < 8; ++i) { run += lfv[i]; cs[i] = run; }
        s_part[th * 128 + kk] = run;
        {
          const int s = tid >> 4, v8 = (tid & 15) * 8;
          const unsigned vw[4] = {vv.x, vv.y, vv.z, vv.w};
#pragma unroll
          for (int i = 0; i < 4; ++i) { s_vT[(v8 + 2 * i) * 40 + s] = (u16)(vw[i] & 0xffff); s_vT[(v8 + 2 * i + 1) * 40 + s] = (u16)(vw[i] >> 16); }
        }
        __syncthreads();
        const float p0 = s_part[kk], p1 = s_part[128 + kk], p2 = s_part[256 + kk], p3 = s_part[384 + kk];
        const float off = (th > 0 ? p0 : 0.f) + (th > 1 ? p1 : 0.f) + (th > 2 ? p2 : 0.f);
        const float ref = p0 + p1, total = p0 + p1 + p2 + p3;
        unsigned kd[4];
        const float eref = __expf(ref), etr = __expf(total - ref);
#pragma unroll
        for (int i = 0; i < 8; ++i) {
          const int t = th * 8 + i;
          const float cum = off + cs[i];
          const float kf = 1.0f - __expf(lfv[i]);
          const float e1 = __expf(cum - ref), e2 = __builtin_amdgcn_rcpf(e1);
          const float qe = qv[i] * e1, ke = kf * e2;
          s_qrel[t * 136 + kk] = f2bf(qe);
          s_krel[t * 136 + kk] = f2bf(ke);
          s_qcum[t * 136 + kk] = f2bf(qe * eref);
          const u16 kdv = f2bf(ke * etr);
          if (i & 1) kd[i >> 1] |= ((unsigned)kdv) << 16; else kd[i >> 1] = kdv;
        }
        *(uint4*)&s_kdT[kk * 40 + th * 8] = make_uint4(kd[0], kd[1], kd[2], kd[3]);
        if (th == 0) s_dec[kk] = eref * etr;
      }
      __syncthreads();
      f32x4 oacc[2] = {f32x4{0.f, 0.f, 0.f, 0.f}, f32x4{0.f, 0.f, 0.f, 0.f}};
      {
        f32x4 att = f32x4{0.f, 0.f, 0.f, 0.f};
        const int ati = w >> 1, asi = w & 1;
#pragma unroll
        for (int ks = 0; ks < 4; ++ks) {
          if (w < 4) {
            bf16x8 a = *(const bf16x8*)&s_qrel[(ati * 16 + fr) * 136 + ks * 32 + fq * 8];
            bf16x8 bb = *(const bf16x8*)&s_krel[(asi * 16 + fr) * 136 + ks * 32 + fq * 8];
            att = __builtin_amdgcn_mfma_f32_16x16x32_bf16(a, bb, att, 0, 0, 0);
          }
          bf16x8 a2 = *(const bf16x8*)&s_qcum[(ti * 16 + fr) * 136 + ks * 32 + fq * 8];
#pragma unroll
          for (int e = 0; e < 2; ++e) {
            bf16x8 b2 = *(const bf16x8*)&s_S[((vi * 2 + e) * 16 + fr) * 136 + ks * 32 + fq * 8];
            oacc[e] = __builtin_amdgcn_mfma_f32_16x16x32_bf16(b2, a2, oacc[e], 0, 0, 0);
          }
        }
        if (w < 4) {
#pragma unroll
          for (int j = 0; j < 4; ++j) {
            const int t = ati * 16 + fq * 4 + j, s = asi * 16 + fr;
            s_att[t * 40 + s] = (s <= t) ? f2bf(att[j]) : (u16)0;
          }
        }
      }
      __syncthreads();
      {
        bf16x8 a = *(const bf16x8*)&s_att[(ti * 16 + fr) * 40 + fq * 8];
        const int tt = c * 32 + ti * 16 + fr;
        const size_t tok = start + (d ? (N - 1 - tt) : tt);
#pragma unroll
        for (int e = 0; e < 2; ++e) {
          bf16x8 bb = *(const bf16x8*)&s_vT[((vi * 2 + e) * 16 + fr) * 40 + fq * 8];
          oacc[e] = __builtin_amdgcn_mfma_f32_16x16x32_bf16(bb, a, oacc[e], 0, 0, 0);
          *(uint2*)&og[((size_t)d * TOK + tok) * 1024 + h * 128 + (vi * 2 + e) * 16 + fq * 4] = pack4(oacc[e][0], oacc[e][1], oacc[e][2], oacc[e][3]);
        }
        bf16x8 vf[4];
#pragma unroll
        for (int ni = 0; ni < 4; ++ni) vf[ni] = *(const bf16x8*)&s_vT[(wv * 64 + ni * 16 + fr) * 40 + fq * 8];
#pragma unroll
        for (int mi = 0; mi < 2; ++mi) {
          bf16x8 kf = *(const bf16x8*)&s_kdT[(wk * 32 + mi * 16 + fr) * 40 + fq * 8];
          f32x4 dc = *(const f32x4*)&s_dec[wk * 32 + mi * 16 + fq * 4];
#pragma unroll
          for (int ni = 0; ni < 4; ++ni) {
            f32x4 s4 = S[mi][ni];
#pragma unroll
            for (int j = 0; j < 4; ++j) s4[j] *= dc[j];
            s4 = __builtin_amdgcn_mfma_f32_16x16x32_bf16(kf, vf[ni], s4, 0, 0, 0);
            S[mi][ni] = s4;
            *(uint2*)&s_S[(wv * 64 + ni * 16 + fr) * 136 + wk * 32 + mi * 16 + fq * 4] = pack4(s4[0], s4[1], s4[2], s4[3]);
          }
        }
      }
      __syncthreads();
    }
    if (!sample) {
      float* so = p.out + OUT_HG + ((size_t)((b * 2 + d) * 8 + h)) * 16384;
#pragma unroll
      for (int mi = 0; mi < 2; ++mi)
#pragma unroll
        for (int ni = 0; ni < 4; ++ni)
#pragma unroll
          for (int j = 0; j < 4; ++j) so[(wk * 32 + mi * 16 + fq * 4 + j) * 128 + wv * 64 + ni * 16 + fr] = S[mi][ni][j];
    }
  }
#undef GLA_LOAD
}

__device__ __forceinline__ void phase_hg_post(const Params& p, int bid, int nb) {
  const u16* og = (const u16*)(p.ws + WS_B(5));
  const u16* sg = (const u16*)(p.ws + WS_B(2));
  u16* a = (u16*)(p.ws + WS_B(0));
  const float* ng = p.in[14];
  const int lane = threadIdx.x & 63, wave = threadIdx.x >> 6;
  float ngv[16];
#pragma unroll
  for (int k = 0; k < 4; ++k) { const f32x4 t = *(const f32x4*)&ng[lane * 16 + 4 * k]; ngv[4 * k] = t[0]; ngv[4 * k + 1] = t[1]; ngv[4 * k + 2] = t[2]; ngv[4 * k + 3] = t[3]; }
  for (int row0 = (bid * NW + wave) * 2; row0 < TOK; row0 += nb * NW * 2) {
    uint4 f[2][2], bw[2][2], sv[2][2];
#pragma unroll
    for (int r = 0; r < 2; ++r)
#pragma unroll
      for (int hh = 0; hh < 2; ++hh) {
        const size_t base = (size_t)(row0 + r) * 1024 + lane * 16 + hh * 8;
        f[r][hh] = *(const uint4*)&og[base];
        bw[r][hh] = *(const uint4*)&og[(size_t)TOK * 1024 + base];
        sv[r][hh] = *(const uint4*)&sg[base];
      }
#pragma unroll
    for (int r = 0; r < 2; ++r) {
      float o[16];
      float ss = 0;
#pragma unroll
      for (int hh = 0; hh < 2; ++hh) {
        const unsigned fa[4] = {f[r][hh].x, f[r][hh].y, f[r][hh].z, f[r][hh].w}, ba[4] = {bw[r][hh].x, bw[r][hh].y, bw[r][hh].z, bw[r][hh].w};
#pragma unroll
        for (int i = 0; i < 4; ++i) {
          o[hh * 8 + 2 * i] = lo16(fa[i]) + lo16(ba[i]);
          o[hh * 8 + 2 * i + 1] = hi16(fa[i]) + hi16(ba[i]);
        }
      }
#pragma unroll
      for (int i = 0; i < 16; ++i) ss += o[i] * o[i];
      ss += __shfl_xor(ss, 1); ss += __shfl_xor(ss, 2); ss += __shfl_xor(ss, 4);
      const float rs = rsqrtf(ss * (1.0f / 128.0f) + 1e-6f);
#pragma unroll
      for (int hh = 0; hh < 2; ++hh) {
        const unsigned sa[4] = {sv[r][hh].x, sv[r][hh].y, sv[r][hh].z, sv[r][hh].w};
        unsigned rr[4];
#pragma unroll
        for (int i = 0; i < 4; ++i)
          rr[i] = pack2(o[hh * 8 + 2 * i] * rs * ngv[hh * 8 + 2 * i] * siluf_(lo16(sa[i])), o[hh * 8 + 2 * i + 1] * rs * ngv[hh * 8 + 2 * i + 1] * siluf_(hi16(sa[i])));
        *(uint4*)&a[(size_t)(row0 + r) * 1024 + lane * 16 + hh * 8] = make_uint4(rr[0], rr[1], rr[2], rr[3]);
      }
    }
  }
}

__device__ __forceinline__ void seq_pos(int tok, int& n, int& L) {
  if (tok < NPROMPT) { n = tok & 255; L = 256; } else { n = (tok - NPROMPT) & 1023; L = 1024; }
}
__device__ __forceinline__ void phase_sc_conv(const Params& p, int bid, int nb) {
  const u16* pb = (const u16*)(p.ws + WS_B(0));
  const u16* sb = (const u16*)(p.ws + WS_B(1));
  u16* a = (u16*)(p.ws + WS_B(2));
  const float* cw = p.in[17]; const float* cbias = p.in[18];
  const size_t total = (size_t)TOK * 128;
  const size_t i0 = (size_t)bid * NT + threadIdx.x;
  const int c = ((int)i0 & 127) * 8;
  float w0[8], w1[8], w2[8], wb[8];
#pragma unroll
  for (int k = 0; k < 2; ++k) {
    const f32x4 t0 = *(const f32x4*)&cw[c + 4 * k], t1 = *(const f32x4*)&cw[1024 + c + 4 * k], t2 = *(const f32x4*)&cw[2048 + c + 4 * k], tb = *(const f32x4*)&cbias[c + 4 * k];
#pragma unroll
    for (int j = 0; j < 4; ++j) { w0[4 * k + j] = t0[j]; w1[4 * k + j] = t1[j]; w2[4 * k + j] = t2[j]; wb[4 * k + j] = tb[j]; }
  }
  const uint4 z = make_uint4(0, 0, 0, 0);
  for (size_t i = i0; i < total / 4; i += (size_t)nb * NT) {
    const int tok = (int)(i >> 7) * 4;
    int n, L; seq_pos(tok, n, L);
    const size_t base = (size_t)tok * 1024 + c;
    uint4 q[6], sv[4];
    q[0] = n > 0 ? *(const uint4*)&pb[base - 1024] : z;
#pragma unroll
    for (int t = 0; t < 4; ++t) { q[1 + t] = *(const uint4*)&pb[base + t * 1024]; sv[t] = *(const uint4*)&sb[base + t * 1024]; }
    q[5] = n + 4 < L ? *(const uint4*)&pb[base + 4096] : z;
#pragma unroll
    for (int t = 0; t < 4; ++t) {
      const unsigned am[4] = {q[t].x, q[t].y, q[t].z, q[t].w}, a0[4] = {q[t + 1].x, q[t + 1].y, q[t + 1].z, q[t + 1].w};
      const unsigned ap[4] = {q[t + 2].x, q[t + 2].y, q[t + 2].z, q[t + 2].w}, as[4] = {sv[t].x, sv[t].y, sv[t].z, sv[t].w};
      unsigned r[4];
#pragma unroll
      for (int k = 0; k < 4; ++k) {
        float z0 = w0[2 * k] * lo16(am[k]) + w1[2 * k] * lo16(a0[k]) + w2[2 * k] * lo16(ap[k]) + wb[2 * k];
        float z1 = w0[2 * k + 1] * hi16(am[k]) + w1[2 * k + 1] * hi16(a0[k]) + w2[2 * k + 1] * hi16(ap[k]) + wb[2 * k + 1];
        r[k] = pack2(lo16(as[k]) * z0, hi16(as[k]) * z1);
      }
      *(uint4*)&a[base + t * 1024] = make_uint4(r[0], r[1], r[2], r[3]);
    }
  }
}
__device__ __forceinline__ void phase_rg_conv(const Params& p, int bid, int nb) {
  const u16* ub = (const u16*)(p.ws + WS_B(0));
  u16* uc = (u16*)(p.ws + WS_B(2));
  const float* cw = p.in[21]; const float* cbias = p.in[22];
  const size_t total = (size_t)TOK * 128;
  const size_t i0 = (size_t)bid * NT + threadIdx.x;
  const int c = ((int)i0 & 127) * 8;
  float w0[8], w1[8], w2[8], w3[8], wb[8];
#pragma unroll
  for (int k = 0; k < 2; ++k) {
    const f32x4 t0 = *(const f32x4*)&cw[c + 4 * k], t1 = *(const f32x4*)&cw[1024 + c + 4 * k], t2 = *(const f32x4*)&cw[2048 + c + 4 * k], t3 = *(const f32x4*)&cw[3072 + c + 4 * k], tb = *(const f32x4*)&cbias[c + 4 * k];
#pragma unroll
    for (int j = 0; j < 4; ++j) { w0[4 * k + j] = t0[j]; w1[4 * k + j] = t1[j]; w2[4 * k + j] = t2[j]; w3[4 * k + j] = t3[j]; wb[4 * k + j] = tb[j]; }
  }
  const uint4 z = make_uint4(0, 0, 0, 0);
  for (size_t i = i0; i < total / 4; i += (size_t)nb * NT) {
    const int tok = (int)(i >> 7) * 4;
    int n, L; seq_pos(tok, n, L);
    const size_t base = (size_t)tok * 1024 + c;
    uint4 q[7];
    q[0] = n > 1 ? *(const uint4*)&ub[base - 2048] : z;
    q[1] = n > 0 ? *(const uint4*)&ub[base - 1024] : z;
#pragma unroll
    for (int t = 0; t < 4; ++t) q[2 + t] = *(const uint4*)&ub[base + t * 1024];
    q[6] = n + 4 < L ? *(const uint4*)&ub[base + 4096] : z;
#pragma unroll
    for (int t = 0; t < 4; ++t) {
      const unsigned a0[4] = {q[t].x, q[t].y, q[t].z, q[t].w}, a1[4] = {q[t + 1].x, q[t + 1].y, q[t + 1].z, q[t + 1].w};
      const unsigned a2[4] = {q[t + 2].x, q[t + 2].y, q[t + 2].z, q[t + 2].w}, a3[4] = {q[t + 3].x, q[t + 3].y, q[t + 3].z, q[t + 3].w};
      unsigned r[4];
#pragma unroll
      for (int k = 0; k < 4; ++k) {
        float z0 = w0[2 * k] * lo16(a0[k]) + w1[2 * k] * lo16(a1[k]) + w2[2 * k] * lo16(a2[k]) + w3[2 * k] * lo16(a3[k]) + wb[2 * k];
        float z1 = w0[2 * k + 1] * hi16(a0[k]) + w1[2 * k + 1] * hi16(a1[k]) + w2[2 * k + 1] * hi16(a2[k]) + w3[2 * k + 1] * hi16(a3[k]) + wb[2 * k + 1];
        r[k] = pack2(z0, z1);
      }
      *(uint4*)&uc[((size_t)(c >> 6) * TOK + tok + t) * 64 + (c & 63)] = make_uint4(r[0], r[1], r[2], r[3]);
    }
  }
}

__device__ __forceinline__ void phase_rg_scan(const Params& p, unsigned char* smem_raw, int bid, int nb) {
  float* sA = (float*)smem_raw;
  float* sB = sA + 2048;
  const u16* rb = (const u16*)(p.ws + WS_B(3));
  const u16* ib = (const u16*)(p.ws + WS_B(5));
  const u16* uc = (const u16*)(p.ws + WS_B(2));
  const u16* sg = (const u16*)(p.ws + WS_B(1));
  u16* hfw = (u16*)(p.ws + WS_H);
  u16* yp = (u16*)(p.ws + WS_B(0));
  const int tid = threadIdx.x;
  for (int u = bid; u < 768; u += nb) {
    int sample, b, c, seg, nseg, start, chs, slot;
    if (u < 256) {
      const int xq = u & 7, yq = u >> 3, gid = (yq >> 2) * 8 + xq, sub = yq & 3;
      sample = 1; b = gid >> 4; slot = (tid & 3) * 4; c = (gid & 15) * 64 + sub * 16 + slot; seg = tid >> 2; nseg = 128; start = NPROMPT + b * 1024; chs = 16; }
    else { sample = 0; b = (u - 256) >> 4; slot = (tid & 15) * 4; c = ((u - 256) & 15) * 64 + slot; seg = tid >> 4; nseg = 32; start = b * 256; chs = 64; }
    const int L = nseg * 8;
#pragma unroll 1
    for (int d = 0; d < 2; ++d) {
      const f32x4 lam = *(const f32x4*)&p.in[25][d * 1024 + c];
      float cl[4];
#pragma unroll
      for (int j = 0; j < 4; ++j) cl[j] = 8.0f * log1pf(__expf(-lam[j]));
      const u16* rp = rb + (size_t)d * TOK * 1024;
      const u16* ip = ib + (size_t)d * TOK * 1024;
      const int tok0 = start + (d ? L - 1 - seg * 8 : seg * 8);
      const size_t o0 = (size_t)tok0 * 1024 + c;
      const long ostep = d ? -1024 : 1024;
      const size_t g0 = ((size_t)(c >> 6) * TOK + tok0) * 64 + (c & 63);
      const long gstep = d ? -64 : 64;
      uint2 rr[8], ii[8], uu[8];
#pragma unroll
      for (int s8 = 0; s8 < 8; ++s8) { rr[s8] = *(const uint2*)&rp[g0 + s8 * gstep]; ii[s8] = *(const uint2*)&ip[g0 + s8 * gstep]; uu[s8] = *(const uint2*)&uc[g0 + s8 * gstep]; }
      uint2 hf[8], sgv[8];
      if (d == 1) {
#pragma unroll
        for (int s8 = 0; s8 < 8; ++s8) { hf[s8] = *(const uint2*)&hfw[g0 + s8 * gstep]; sgv[s8] = *(const uint2*)&sg[g0 + s8 * gstep]; }
      }
      float av[8][4], xv[8][4];
      float A[4] = {1.f, 1.f, 1.f, 1.f}, B[4] = {0.f, 0.f, 0.f, 0.f};
#pragma unroll
      for (int s8 = 0; s8 < 8; ++s8) {
        const float r4[4] = {lo16(rr[s8].x), hi16(rr[s8].x), lo16(rr[s8].y), hi16(rr[s8].y)};
        const float i4[4] = {lo16(ii[s8].x), hi16(ii[s8].x), lo16(ii[s8].y), hi16(ii[s8].y)};
        const float u4[4] = {lo16(uu[s8].x), hi16(uu[s8].x), lo16(uu[s8].y), hi16(uu[s8].y)};
#pragma unroll
        for (int j = 0; j < 4; ++j) {
          const float la = -cl[j] * r4[j];
          const float a = __expf(la);
          const float xin = __builtin_amdgcn_sqrtf(fmaxf(1.0f - __expf(2.0f * la), 0.f)) * (i4[j] * u4[j]);
          av[s8][j] = a; xv[s8][j] = xin;
          A[j] *= a; B[j] = a * B[j] + xin;
        }
      }
      *(f32x4*)&sA[seg * chs + slot] = f32x4{A[0], A[1], A[2], A[3]};
      *(f32x4*)&sB[seg * chs + slot] = f32x4{B[0], B[1], B[2], B[3]};
      for (int k = 1; k < nseg; k <<= 1) {
        __syncthreads();
        f32x4 pa = f32x4{1.f, 1.f, 1.f, 1.f}, pb2 = f32x4{0.f, 0.f, 0.f, 0.f};
        if (seg >= k) { pa = *(const f32x4*)&sA[(seg - k) * chs + slot]; pb2 = *(const f32x4*)&sB[(seg - k) * chs + slot]; }
        __syncthreads();
        if (seg >= k) {
#pragma unroll
          for (int j = 0; j < 4; ++j) { B[j] = A[j] * pb2[j] + B[j]; A[j] = A[j] * pa[j]; }
          *(f32x4*)&sA[seg * chs + slot] = f32x4{A[0], A[1], A[2], A[3]};
          *(f32x4*)&sB[seg * chs + slot] = f32x4{B[0], B[1], B[2], B[3]};
        }
      }
      __syncthreads();
      float h[4];
      {
        f32x4 h0v = f32x4{0.f, 0.f, 0.f, 0.f};
        if (sample) h0v = *(const f32x4*)&p.in[3][(b * 2 + d) * 1024 + c];
        if (seg > 0) {
          const f32x4 pa = *(const f32x4*)&sA[(seg - 1) * chs + slot], pb2 = *(const f32x4*)&sB[(seg - 1) * chs + slot];
#pragma unroll
          for (int j = 0; j < 4; ++j) h[j] = pa[j] * h0v[j] + pb2[j];
        } else {
#pragma unroll
          for (int j = 0; j < 4; ++j) h[j] = h0v[j];
        }
      }
#pragma unroll
      for (int s8 = 0; s8 < 8; ++s8) {
#pragma unroll
        for (int j = 0; j < 4; ++j) h[j] = av[s8][j] * h[j] + xv[s8][j];
        const size_t o = o0 + s8 * ostep;
        if (d == 0) *(uint2*)&hfw[g0 + s8 * gstep] = pack4(h[0], h[1], h[2], h[3]);
        else *(uint2*)&yp[g0 + s8 * gstep] = pack4((lo16(hf[s8].x) + h[0]) * lo16(sgv[s8].x), (hi16(hf[s8].x) + h[1]) * hi16(sgv[s8].x),
                                     (lo16(hf[s8].y) + h[2]) * lo16(sgv[s8].y), (hi16(hf[s8].y) + h[3]) * hi16(sgv[s8].y));
      }
      if (!sample && seg == nseg - 1) *(f32x4*)&p.out[OUT_RG + (b * 2 + d) * 1024 + c] = f32x4{h[0], h[1], h[2], h[3]};
      __syncthreads();
    }
  }
}

__device__ __forceinline__ void phase_mla_norm(const Params& p, int bid, int nb) {
  u16* cq = (u16*)(p.ws + WS3_CQ);
  u16* ckvall = (u16*)(p.ws + WS3_CKVALL);
  const float* ckvraw = (const float*)(p.ws + WS3_CKVRAW);
  const float* kperaw = (const float*)(p.ws + WS3_KPERAW);
  u16* Kb = (u16*)(p.ws + WS3_K);
  const float* qn = p.in[28]; const float* kvn = p.in[29];
  const int lane = threadIdx.x & 63, wave = threadIdx.x >> 6;
  float qnv[6];
#pragma unroll
  for (int i = 0; i < 3; ++i) { qnv[2 * i] = qn[(i * 64 + lane) * 2]; qnv[2 * i + 1] = qn[(i * 64 + lane) * 2 + 1]; }
  const f32x4 g4 = *(const f32x4*)&kvn[lane * 4];
  unsigned cvn[3] = {0u, 0u, 0u}; f32x4 kvnx = f32x4{0.f, 0.f, 0.f, 0.f}; float vnx = 0.f;
  {
    const int r0 = bid * NW + wave;
    if (r0 < TOK) {
#pragma unroll
      for (int i = 0; i < 3; ++i) cvn[i] = ((const unsigned*)&cq[(size_t)r0 * 384])[i * 64 + lane];
      kvnx = *(const f32x4*)&ckvraw[(size_t)r0 * 256 + lane * 4]; vnx = kperaw[(size_t)r0 * 32 + (lane & 31)];
    }
  }
  for (int row = bid * NW + wave; row < TOK + 2048; row += nb * NW) {
    if (row < TOK) {
      const int tok = row;
      const bool sample = tok >= NPROMPT;
      unsigned cv[3] = {cvn[0], cvn[1], cvn[2]}; const f32x4 kv = kvnx; float v = vnx;
      {
        const int rn = row + nb * NW;
        if (rn < TOK) {
#pragma unroll
          for (int i = 0; i < 3; ++i) cvn[i] = ((const unsigned*)&cq[(size_t)rn * 384])[i * 64 + lane];
          kvnx = *(const f32x4*)&ckvraw[(size_t)rn * 256 + lane * 4]; vnx = kperaw[(size_t)rn * 32 + (lane & 31)];
        }
      }
      const int bs = (tok - NPROMPT) >> 10, n = (tok - NPROMPT) & 1023;
      const size_t kvrow = sample ? (size_t)(NPROMPT + bs * 1536 + 512 + n) : (size_t)tok;
      unsigned* cqr = (unsigned*)&cq[(size_t)tok * 384];
      float ss = 0;
#pragma unroll
      for (int i = 0; i < 3; ++i) { float a = lo16(cv[i]), b2 = hi16(cv[i]); ss += a * a + b2 * b2; }
      const float rsq = rsqrtf(wave_sum(ss) * (1.0f / 384.0f) + 1e-6f);
#pragma unroll
      for (int i = 0; i < 3; ++i) {
        cqr[i * 64 + lane] = pack2(lo16(cv[i]) * rsq * qnv[2 * i], hi16(cv[i]) * rsq * qnv[2 * i + 1]);
      }
      const float rsk = rsqrtf(wave_sum(kv[0] * kv[0] + kv[1] * kv[1] + kv[2] * kv[2] + kv[3] * kv[3]) * (1.0f / 256.0f) + 1e-6f);
      f32x4 o4;
#pragma unroll
      for (int j = 0; j < 4; ++j) o4[j] = kv[j] * rsk * g4[j];
      *(uint2*)&ckvall[kvrow * 256 + lane * 4] = pack4(o4[0], o4[1], o4[2], o4[3]);
      if (!sample) *(f32x4*)&p.out[OUT_CKV + (size_t)tok * 256 + lane * 4] = o4;
      if (!sample) { if (lane < 32) p.out[OUT_KPE + (size_t)tok * 32 + lane] = v; }
      else {
        const float partner = __shfl_xor(v, 8);
        const int i16 = lane & 15;
        const float pos = (lane & 16) ? (float)(n & 63) : (float)(n >> 6);
        float sn, cs; rope_sincos(pos, i16 & 7, sn, cs);
        v = (i16 < 8) ? (v * cs - partner * sn) : (partner * sn + v * cs);
      }
      const u16 vb = f2bf(v);
#pragma unroll
      for (int i = 0; i < 8; ++i) Kb[(kvrow * 16 + (lane >> 5) + 2 * i) * 96 + 64 + (lane & 31)] = vb;
    } else {
      const int r = row - TOK, bs = r >> 9, j = r & 511;
      const size_t kvrow = (size_t)(NPROMPT + bs * 1536 + j);
      f32x4 kv = *(const f32x4*)&p.in[4][(size_t)r * 256 + lane * 4];
      *(uint2*)&ckvall[kvrow * 256 + lane * 4] = pack4(kv[0], kv[1], kv[2], kv[3]);
      const u16 vb = f2bf(p.in[5][(size_t)r * 32 + (lane & 31)]);
#pragma unroll
      for (int i = 0; i < 8; ++i) Kb[(kvrow * 16 + (lane >> 5) + 2 * i) * 96 + 64 + (lane & 31)] = vb;
    }
  }
}

__device__ __forceinline__ void phase_attn(const Params& p, unsigned char* smem_raw, int bid, int nb) {
  u16* sK = (u16*)smem_raw;
  u16* sV = sK + 128 * 104;
  const u16* qg = (const u16*)(p.ws + WS3_Q);
  const u16* Kg = (const u16*)(p.ws + WS3_K);
  const u16* Vg = (const u16*)(p.ws + WS3_VT);
  const u16* sg = (const u16*)(p.ws + WS3_SG);
  u16* ao = (u16*)(p.ws + WS_H);
  const int tid = threadIdx.x, lane = tid & 63, w = tid >> 6, fr = lane & 15, fq = lane >> 4;
  for (int u = bid; u < 1536; u += nb) {
    int tok0, kvbase, nkeys, h;
    if (u < 512) { const int b = u >> 7, r = u & 127; h = r >> 3; const int qb = r & 7; tok0 = NPROMPT + b * 1024 + qb * 128; kvbase = NPROMPT + b * 1536; nkeys = 1536; }
    else { const int uu = u - 512; const int b = uu >> 5, r = uu & 31; h = r >> 1; const int qb = r & 1; tok0 = b * 256 + qb * 128; kvbase = b * 256; nkeys = 256; }
    const int tokq = tok0 + w * 16 + fr;
    bf16x8 qf[3];
#pragma unroll
    for (int ks = 0; ks < 3; ++ks) qf[ks] = *(const bf16x8*)&qg[(size_t)tokq * 1536 + h * 96 + ks * 32 + fq * 8];
    if (u < 512) {
      const int npos = (tokq - NPROMPT) & 1023;
      const float pos = (fq & 2) ? (float)(npos & 63) : (float)(npos >> 6);
      uint4 raw = *(uint4*)&qf[2];
      unsigned rw[4] = {raw.x, raw.y, raw.z, raw.w};
#pragma unroll
      for (int i = 0; i < 4; ++i) {
        float v0 = lo16(rw[i]), v1 = hi16(rw[i]);
        const float p0 = __shfl_xor(v0, 16), p1 = __shfl_xor(v1, 16);
        float sn0, cs0, sn1, cs1;
        rope_sincos(pos, 2 * i, sn0, cs0); rope_sincos(pos, 2 * i + 1, sn1, cs1);
        v0 = (fq & 1) ? (p0 * sn0 + v0 * cs0) : (v0 * cs0 - p0 * sn0);
        v1 = (fq & 1) ? (p1 * sn1 + v1 * cs1) : (v1 * cs1 - p1 * sn1);
        rw[i] = pack2(v0, v1);
      }
      raw = make_uint4(rw[0], rw[1], rw[2], rw[3]);
      qf[2] = *(bf16x8*)&raw;
    }
    float m = -1e30f, l = 0.f;
    f32x4 oacc[4];
#pragma unroll
    for (int i = 0; i < 4; ++i) oacc[i] = f32x4{0.f, 0.f, 0.f, 0.f};
    const int kk0 = tid / 12, kc0 = tid - kk0 * 12;
    const int kk1 = (tid + NT) / 12, kc1 = (tid + NT) - kk1 * 12;
    const int kk2_ = (tid + 2 * NT) / 12, kc2 = (tid + 2 * NT) - kk2_ * 12;
    const u16* Kp0 = &Kg[((size_t)(kvbase + kk0) * 16 + h) * 96 + kc0 * 8];
    const u16* Kp1 = &Kg[((size_t)(kvbase + kk1) * 16 + h) * 96 + kc1 * 8];
    const u16* Kp2 = &Kg[((size_t)(kvbase + kk2_) * 16 + h) * 96 + kc2 * 8];
    const int vd0 = tid >> 4, vc0 = tid & 15, vd1 = (tid + NT) >> 4;
    const u16* Vp0 = &Vg[(size_t)(h * 64 + vd0) * KVROWS + kvbase + vc0 * 8];
    const u16* Vp1 = &Vg[(size_t)(h * 64 + vd1) * KVROWS + kvbase + vc0 * 8];
    uint4 kr0 = *(const uint4*)Kp0, kr1 = *(const uint4*)Kp1, kr2 = *(const uint4*)Kp2, vr0 = *(const uint4*)Vp0, vr1 = *(const uint4*)Vp1;
    const int ntile2 = nkeys >> 7;
    for (int kt = 0; kt < ntile2; ++kt) {
      __syncthreads();
      *(uint4*)&sK[kk0 * 104 + kc0 * 8] = kr0; *(uint4*)&sK[kk1 * 104 + kc1 * 8] = kr1; *(uint4*)&sK[kk2_ * 104 + kc2 * 8] = kr2;
      *(uint4*)&sV[vd0 * 136 + vc0 * 8] = vr0; *(uint4*)&sV[vd1 * 136 + vc0 * 8] = vr1;
      if (kt + 1 < ntile2) {
        const size_t ko = (size_t)(kt + 1) * 128 * 1536; const int vo = (kt + 1) * 128;
        kr0 = *(const uint4*)(Kp0 + ko); kr1 = *(const uint4*)(Kp1 + ko); kr2 = *(const uint4*)(Kp2 + ko);
        vr0 = *(const uint4*)(Vp0 + vo); vr1 = *(const uint4*)(Vp1 + vo);
      }
      __syncthreads();
      f32x4 sacc[8];
#pragma unroll
      for (int ni = 0; ni < 8; ++ni) {
        sacc[ni] = f32x4{0.f, 0.f, 0.f, 0.f};
#pragma unroll
        for (int ks = 0; ks < 3; ++ks) {
          bf16x8 kf = *(const bf16x8*)&sK[(ni * 16 + fr) * 104 + ks * 32 + fq * 8];
          sacc[ni] = __builtin_amdgcn_mfma_f32_16x16x32_bf16(kf, qf[ks], sacc[ni], 0, 0, 0);
        }
      }
      float mx = -1e30f;
#pragma unroll
      for (int ni = 0; ni < 8; ++ni)
#pragma unroll
        for (int j = 0; j < 4; ++j) mx = fmaxf(mx, sacc[ni][j]);
      mx = fmaxf(mx, __shfl_xor(mx, 16));
      mx = fmaxf(mx, __shfl_xor(mx, 32));
      const float mnew = fmaxf(m, mx);
      const float alpha = __builtin_amdgcn_exp2f(m - mnew);
      m = mnew;
      float ls = 0.f;
#pragma unroll
      for (int ni = 0; ni < 8; ++ni)
#pragma unroll
        for (int j = 0; j < 4; ++j) { float e = __builtin_amdgcn_exp2f(sacc[ni][j] - mnew); sacc[ni][j] = e; ls += e; }
      l = l * alpha + ls;
      bf16x8 pf[4];
#pragma unroll
      for (int kk2 = 0; kk2 < 4; ++kk2) {
        uint2 lo = pack4(sacc[2 * kk2][0], sacc[2 * kk2][1], sacc[2 * kk2][2], sacc[2 * kk2][3]);
        uint2 hi = pack4(sacc[2 * kk2 + 1][0], sacc[2 * kk2 + 1][1], sacc[2 * kk2 + 1][2], sacc[2 * kk2 + 1][3]);
        uint4 pk = make_uint4(lo.x, lo.y, hi.x, hi.y);
        pf[kk2] = *(bf16x8*)&pk;
      }
#pragma unroll
      for (int di = 0; di < 4; ++di) {
#pragma unroll
        for (int j = 0; j < 4; ++j) oacc[di][j] *= alpha;
#pragma unroll
        for (int kk2 = 0; kk2 < 4; ++kk2) {
          uint2 v0 = *(const uint2*)&sV[(di * 16 + fr) * 136 + kk2 * 32 + fq * 4];
          uint2 v1 = *(const uint2*)&sV[(di * 16 + fr) * 136 + kk2 * 32 + 16 + fq * 4];
          uint4 vk = make_uint4(v0.x, v0.y, v1.x, v1.y);
          oacc[di] = __builtin_amdgcn_mfma_f32_16x16x32_bf16(*(bf16x8*)&vk, pf[kk2], oacc[di], 0, 0, 0);
        }
      }
    }
    l += __shfl_xor(l, 16);
    l += __shfl_xor(l, 32);
    const float inv = 1.0f / l;
#pragma unroll
    for (int di = 0; di < 4; ++di) {
      const size_t o = (size_t)tokq * 1024 + h * 64 + di * 16 + fq * 4;
      uint2 s = *(const uint2*)&sg[o];
      *(uint2*)&ao[o] = pack4(oacc[di][0] * inv * siluf_(lo16(s.x)), oacc[di][1] * inv * siluf_(hi16(s.x)), oacc[di][2] * inv * siluf_(lo16(s.y)), oacc[di][3] * inv * siluf_(hi16(s.y)));
    }
  }
}

#define XB_TMO      128
#define XB_XCNT(j)  (256  + 64 * (j))
#define XB_XSUB(j)  (1280 + 64 * (j))
#define XB_XGEN(j)  (2304 + 64 * (j))
#define XB_TOP      3328
#define XB_TOPGEN   3392
#define XCD_BAR_WORDS 3456
#define XB_SPIN_CAP (1u << 22)
__device__ __forceinline__ unsigned xb_ld(unsigned* p)              { return __hip_atomic_load(p, __ATOMIC_RELAXED, __HIP_MEMORY_SCOPE_AGENT); }
__device__ __forceinline__ unsigned xb_add(unsigned* p, unsigned v) { return __hip_atomic_fetch_add(p, v, __ATOMIC_RELAXED, __HIP_MEMORY_SCOPE_AGENT); }
__device__ __forceinline__ unsigned xb_xcc_id() { return (unsigned)__builtin_amdgcn_s_getreg((3 << 11) | 20) & 0xFu; }
#define XB_SPIN(cond, bar) do { unsigned _sp = 0; while (cond) { __builtin_amdgcn_s_sleep(1); \
    if ((++_sp & 255u) == 0u) { if (xb_ld(&(bar)[XB_TMO])) break; if (_sp > XB_SPIN_CAP) { atomicAdd(&(bar)[XB_TMO], 1u); break; } } } } while (0)
struct XcdBarrier { unsigned* bar; unsigned x; volatile LAS unsigned* st; };
__device__ __forceinline__ XcdBarrier xcd_barrier_post(unsigned* bar, volatile LAS unsigned* st) {
  XcdBarrier b; b.bar = bar; b.x = xb_xcc_id(); b.st = st;
  if (threadIdx.x == 0) (void)xb_add(&bar[XB_XCNT(b.x)], 1u);
  return b;
}
__device__ __forceinline__ void xcd_barrier_complete(unsigned* bar, unsigned x, unsigned& nloc, unsigned& nx) {
  const unsigned G = gridDim.x * gridDim.y * gridDim.z;
  unsigned sum, cnt, mine, sp = 0u;
  for (;;) {
    sum = 0u; cnt = 0u; mine = 0u;
#pragma unroll
    for (unsigned j = 0; j < 16; ++j) { const unsigned c = xb_ld(&bar[XB_XCNT(j)]); sum += c; cnt += (c > 0u) ? 1u : 0u; mine = (j == x) ? c : mine; }
    if (sum == G) break;
    __builtin_amdgcn_s_sleep(1);
    if ((++sp & 255u) == 0u) { if (xb_ld(&bar[XB_TMO])) break; if (sp > XB_SPIN_CAP) { atomicAdd(&bar[XB_TMO], 1u); break; } }
  }
  nloc = mine > 0u ? mine : 1u; nx = cnt > 0u ? cnt : 1u;
}
__device__ __forceinline__ void xcd_barrier(const XcdBarrier& b) {
  asm volatile("s_waitcnt vmcnt(0)" ::: "memory");
  __syncthreads();
  if (threadIdx.x == 0) {
    unsigned* bar = b.bar;
    __builtin_amdgcn_s_waitcnt(0);
    unsigned nloc = b.st[0], nx = b.st[1];
    if (nloc == 0u) { xcd_barrier_complete(bar, b.x, nloc, nx); b.st[0] = nloc; b.st[1] = nx; }
    const unsigned old = xb_add(&bar[XB_XSUB(b.x)], 1u);
    const unsigned gen = old / nloc;
    if (old + 1u == (gen + 1u) * nloc) {
      __builtin_amdgcn_fence(__ATOMIC_RELEASE, "agent");
      asm volatile("s_waitcnt vmcnt(0)" ::: "memory");
      const unsigned og = xb_add(&bar[XB_TOP], 1u);
      const unsigned tg = og / nx;
      if (og + 1u == (tg + 1u) * nx) xb_add(&bar[XB_TOPGEN], 1u);
      else XB_SPIN(xb_ld(&bar[XB_TOPGEN]) == tg, bar);
      __builtin_amdgcn_fence(__ATOMIC_ACQUIRE, "agent");
      xb_add(&bar[XB_XGEN(b.x)], 1u);
      asm volatile("s_waitcnt vmcnt(0)" ::: "memory");
    } else {
      XB_SPIN(xb_ld(&bar[XB_XGEN(b.x)]) == gen, bar);
      __builtin_amdgcn_fence(__ATOMIC_ACQUIRE, "agent");
      asm volatile("s_waitcnt vmcnt(0)" ::: "memory");
    }
  }
  __syncthreads();
}

#define GEMM_LDS 131072
#define DYN_LDS (GEMM_LDS + 16)
#define WS_BAR (WS_CNT + 4096ull)

#define RUN_GEMM(Aptr, LDA, Bptr, MM, NN, KK, GATE, EPI, CID) RUN_GEMM_G(Aptr, LDA, Bptr, MM, NN, KK, GATE, EPI, nb, CID)
#define RUN_GEMM_G(Aptr, LDA, Bptr, MM, NN, KK, GATE, EPI, GG, CID) RUN_GEMM_X(Aptr, LDA, (size_t)128, (size_t)0, Bptr, MM, NN, KK, GATE, EPI, GG, CID)
#define GM_KSTEP ((size_t)TOK * 128)
#define RUN_GEMM_X(Aptr, LDA, KSA, GST, Bptr, MM, NN, KK, GATE, EPI, GG, CID) do { pg8::Gemm g_{(const u16*)(Aptr), (const u16*)(Bptr), MM, NN, KK, LDA, GATE, p.flags, KSA, GST}; \
    pg8::StaticOrder S_; S_.init(MM, NN, GG, CID); pg8::gemm_phase((LAS unsigned char*)smem_raw, g_, S_, EPI); } while (0)

__global__ void __launch_bounds__(NT, 2) mega(Params p) {
  extern __shared__ __attribute__((aligned(16))) unsigned char smem_raw[];
  const int bid = blockIdx.x, nb = gridDim.x;
  unsigned char* ws = p.ws;
  const float* mod = (const float*)(ws + WS_MOD);
  volatile LAS unsigned* xst = (volatile LAS unsigned*)((LAS unsigned char*)smem_raw + GEMM_LDS);
  XcdBarrier xb;
  if (p.phase_hi - p.phase_lo > 1) {
    if (threadIdx.x == 0) { xst[0] = 0u; xst[1] = 0u; }
    __syncthreads();
    xb = xcd_barrier_post((unsigned*)(ws + WS_BAR), xst);
  }
#define PH_BEGIN(n) if ((PHMASK & (1u << n)) && p.phase_lo <= n && n < p.phase_hi) { const int ph = n;
#define PH_FIN if (ph + 1 < p.phase_hi) { if (p.phase_lo < 0) cg::this_grid().sync(); else xcd_barrier(xb); } }
  PH_BEGIN(0) phase_prologue(p, smem_raw, bid, nb); PH_FIN
  PH_BEGIN(1) phase_h0(p, bid, nb); PH_FIN
  PH_BEGIN(2) {
    EpiHgIn e{(u16*)(ws + WS_B(0)), (u16*)(ws + WS_B(1)), (u16*)(ws + WS_B(2)), (_Float16*)(ws + WS_B(3)), (const float*)(ws + WS_LB)};
    RUN_GEMM(ws + WS_H, 1024, ws + WS_W_HG_IN, TOK, 5120, 1024, 0, e, bid);
  } PH_FIN
  PH_BEGIN(3) phase_gla(p, smem_raw); PH_FIN
  PH_BEGIN(4) phase_hg_post(p, bid, nb); PH_FIN
  PH_BEGIN(5) {
    EpiResLn<false, true> e{p.in[0], p.in[1], (const u16*)nullptr, p.out, (u16*)(ws + WS_XB), mod + 0 * 15360 + 2048, p.in[10] + 0 * 1024, p.in[11] + 0 * 1024, mod + 1 * 15360, (u16*)(ws + WS_H),
               (unsigned long long*)(ws + WS_SLOT) + 0 * 49152, (unsigned*)(ws + WS_CNT + 256) + 0 * 48};
    RUN_GEMM(ws + WS_B(0), 1024, ws + WS_W_HG_OUT, TOK, 1024, 1024, 0, e, bid);
    wconv_idle(p, smem_raw, bid, nb, 1536, 2816);
  } PH_FIN
  PH_BEGIN(7) {
    EpiScIn e{(u16*)(ws + WS_B(0)), (u16*)(ws + WS_B(1))};
    RUN_GEMM(ws + WS_H, 1024, ws + WS_W_SC_IN, TOK, 4096, 1024, 0, e, bid);
  } PH_FIN
  PH_BEGIN(8) phase_sc_conv(p, bid, nb); PH_FIN
  PH_BEGIN(9) {
    EpiResLn<true, true> e{p.out, p.out, (const u16*)(ws + WS_XB), p.out, (u16*)(ws + WS_XB), mod + 1 * 15360 + 2048, p.in[10] + 1 * 1024, p.in[11] + 1 * 1024, mod + 2 * 15360, (u16*)(ws + WS_H),
               (unsigned long long*)(ws + WS_SLOT) + 1 * 49152, (unsigned*)(ws + WS_CNT + 256) + 1 * 48};
    RUN_GEMM(ws + WS_B(2), 1024, ws + WS_W_SC_OUT, TOK, 1024, 1024, 0, e, bid);
    wconv_idle(p, smem_raw, bid, nb, 2816, 3840);
  } PH_FIN
  PH_BEGIN(11) {
    EpiRgIn e{(u16*)(ws + WS_B(0)), (u16*)(ws + WS_B(1))};
    RUN_GEMM(ws + WS_H, 1024, ws + WS_W_RG_IN, TOK, 2048, 1024, 0, e, bid);
  } PH_FIN
  PH_BEGIN(12) phase_rg_conv(p, bid, nb); PH_FIN
  PH_BEGIN(13) {
    EpiRgGate e{(u16*)(ws + WS_B(3)), (u16*)(ws + WS_B(5)), p.in[24]};
    RUN_GEMM_X(ws + WS_B(2), 64, GM_KSTEP, 4 * GM_KSTEP, ws + WS_W_RG_GATE, TOK, 4096, 256, 1, e, nb, bid);
  } PH_FIN
  PH_BEGIN(14) phase_rg_scan(p, smem_raw, bid, nb); PH_FIN
  PH_BEGIN(15) {
    EpiResLn<true, true> e{p.out, p.out, (const u16*)(ws + WS_XB), p.out, (u16*)(ws + WS_XB), mod + 2 * 15360 + 2048, p.in[10] + 2 * 1024, p.in[11] + 2 * 1024, mod + 3 * 15360, (u16*)(ws + WS_H),
               (unsigned long long*)(ws + WS_SLOT) + 2 * 49152, (unsigned*)(ws + WS_CNT + 256) + 2 * 48};
    RUN_GEMM_X(ws + WS_B(0), 64, GM_KSTEP, (size_t)0, ws + WS_W_RG_OUT, TOK, 1024, 1024, 0, e, nb, bid);
    wconv_idle(p, smem_raw, bid, nb, 3840, 4800);
  } PH_FIN
  PH_BEGIN(17) {
    EpiMlaIn e{(u16*)(ws + WS3_CQ), (float*)(ws + WS3_CKVRAW), (float*)(ws + WS3_KPERAW), (u16*)(ws + WS3_SG)};
    RUN_GEMM(ws + WS_H, 1024, ws + WS_W_MLA_IN, TOK, 768, 1024, 0, e, bid);
  } PH_FIN
  PH_BEGIN(18) phase_mla_norm(p, bid, nb); PH_FIN
  PH_BEGIN(19) {
    const bool bal = (nb == 256);
    EpiSg eg{(u16*)(ws + WS3_SG)};
    RUN_GEMM(ws + WS_H, 1024, ws + WS_W_MLA_IN + 672 * 1024 * 2, TOK, 1024, 1024, 0, eg, bid);
    EpiQ eq{(u16*)(ws + WS3_Q)};
    RUN_GEMM(ws + WS3_CQ, 384, ws + WS_W_QB, TOK, 1536, 384, 0, eq, bal ? ((bid + 64) & 255) : bid);
    EpiK ek{(u16*)(ws + WS3_K)};
    RUN_GEMM(ws + WS3_CKVALL, 256, ws + WS_W_KVB, KVROWS, 1024, 256, 0, ek, bal ? ((bid + 32) & 255) : bid);
    EpiV ev{(u16*)(ws + WS3_VT)};
    RUN_GEMM_G(ws + WS_W_KVB + 1024 * 256 * 2, 256, ws + WS3_CKVALL, 1024, KVROWS, 256, 0, ev, bal ? 64 : nb, bal ? (bid >= 192 ? bid - 192 : (1 << 20)) : bid);
  } PH_FIN
  PH_BEGIN(20) phase_attn(p, smem_raw, bid, nb); PH_FIN
  PH_BEGIN(21) {
    EpiResLn<true, false> e{p.out, p.out, (const u16*)(ws + WS_XB), p.out, (u16*)nullptr, mod + 3 * 15360 + 2048, p.in[10] + 3 * 1024, p.in[11] + 3 * 1024, mod + 3 * 15360, (u16*)nullptr,
               (unsigned long long*)(ws + WS_SLOT) + 3 * 49152, (unsigned*)(ws + WS_CNT + 256) + 3 * 48};
    RUN_GEMM(ws + WS_H, 1024, ws + WS_W_MLA_OUT, TOK, 1024, 1024, 0, e, bid);
  } PH_FIN
}

extern "C" void kernel_launch(void* const* d_in, const int* in_sizes, int n_in, void* d_out, int out_size, void* d_ws, size_t ws_size,
                              hipStream_t stream) {
  static int grid_blocks = 0;
  if (!grid_blocks) {
    int dev = 0, cus = 0, per_cu = 0;
    (void)hipGetDevice(&dev);
    (void)hipDeviceGetAttribute(&cus, hipDeviceAttributeMultiprocessorCount, dev);
    (void)hipFuncSetAttribute((const void*)mega, hipFuncAttributeMaxDynamicSharedMemorySize, DYN_LDS);
    (void)hipOccupancyMaxActiveBlocksPerMultiprocessor(&per_cu, (const void*)mega, NT, DYN_LDS);
    if (per_cu < 1) per_cu = 1;
    if (per_cu > 1) per_cu = 1;
    grid_blocks = cus * per_cu;
  }
  Params p{};
  for (int i = 0; i < 33; ++i) p.in[i] = (const float*)d_in[i];
  p.out = (float*)d_out;
  p.ws = (unsigned char*)d_ws;
#if MULTI_LAUNCH
  (void)hipMemsetAsync((unsigned char*)d_ws + WS_CNT, 0, 4096 + XCD_BAR_WORDS * 4, stream);
  for (int ph = 0; ph < NPHASES; ++ph) {
    p.phase_lo = ph; p.phase_hi = ph + 1;
    hipLaunchKernelGGL(mega, dim3(grid_blocks), dim3(NT), DYN_LDS, stream, p);
#ifdef PROBE_MASK
    if ((PROBE_MASK >> ph) & 1) { p.flags = PROBE_FLAGS; for (int r = 0; r < 2; ++r) {
      if (ph == 3) (void)hipMemsetAsync((unsigned char*)d_ws + WS_CNT, 0, 64, stream);
      hipLaunchKernelGGL(mega, dim3(grid_blocks), dim3(NT), DYN_LDS, stream, p);
    } p.flags = 0; }
#endif
  }
#else
  p.phase_lo = 0; p.phase_hi = NPHASES;
  (void)hipMemsetAsync((unsigned char*)d_ws + WS_CNT, 0, 4096 + XCD_BAR_WORDS * 4, stream);
  void* args[] = {&p};
  hipError_t e = hipLaunchCooperativeKernel((const void*)mega, dim3(grid_blocks), dim3(NT), args, DYN_LDS, stream);
  if (e != hipSuccess) fprintf(stderr, "cooperative launch failed: %s (grid %d)\n", hipGetErrorString(e), grid_blocks);
#endif
}
```

```cpp
#include <hip/hip_runtime.h>
#include <hip/hip_cooperative_groups.h>
#include <cstdio>
namespace cg = cooperative_groups;

#ifndef MULTI_LAUNCH
#define MULTI_LAUNCH 0
#endif

typedef unsigned short u16;
using bf16x8 = __attribute__((ext_vector_type(8))) short;
using f32x4 = __attribute__((ext_vector_type(4))) float;
typedef _Float16 h4 __attribute__((ext_vector_type(4)));

#define TOK 12288
#define NPROMPT 8192
#define KVROWS 14336
#define NPHASES 23
#ifndef PHMASK
#define PHMASK 0x7fffff
#endif
#define DN_ALPHA 1.6817928305074290f

#define WS_W_HG_IN 0ull
#define WS_W_HG_OUT (WS_W_HG_IN + 10485760ull)
#define WS_W_SC_IN (WS_W_HG_OUT + 2097152ull)
#define WS_W_SC_OUT (WS_W_SC_IN + 8388608ull)
#define WS_W_RG_IN (WS_W_SC_OUT + 2097152ull)
#define WS_W_RG_GATE (WS_W_RG_IN + 4194304ull)
#define WS_W_RG_OUT (WS_W_RG_GATE + 2097152ull)
#define WS_W_MLA_IN (WS_W_RG_OUT + 2097152ull)
#define WS_W_QB (WS_W_MLA_IN + 3670016ull)
#define WS_W_KVB (WS_W_QB + 1179648ull)
#define WS_W_MLA_OUT (WS_W_KVB + 1048576ull)
#define WS_MOD (WS_W_MLA_OUT + 2097152ull)
#define WS_LB (WS_MOD + 245760ull)
#define WS_CNT (WS_LB + 8192ull)
#define WS_R (WS_CNT + 4096ull + 16384ull)
#define BSZ 25165824ull
#define WS_H (WS_R)
#define WS_B(i) (WS_R + BSZ * (1 + (i)))
#define WS_SLOT (WS_R + 201326592ull)
#define WS_XB (WS_SLOT + 1572864ull)
#define WS3_CQ (WS_R + 25165824ull)
#define WS3_CKVALL (WS_R + 34603008ull)
#define WS3_CKVRAW (WS_R + 41943040ull)
#define WS3_KPERAW (WS_R + 54525952ull)
#define WS3_SG (WS_R + 56098816ull)
#define WS3_Q (WS_R + 81264640ull)
#define WS3_K (WS_R + 119013376ull)
#define WS3_VT (WS_R + 163053568ull)

#define OUT_HG 12582912
#define OUT_RG 20971520
#define OUT_CKV 21037056
#define OUT_KPE 23134208

struct Params {
  const float* in[33];
  float* out;
  unsigned char* ws;
  int phase_lo, phase_hi, flags, pad_;
};

__device__ __forceinline__ u16 f2bf(float f) { __bf16 r = (__bf16)f; return *(u16*)&r; }
__device__ __forceinline__ float bf2f(u16 h) { return __uint_as_float(((unsigned)h) << 16); }
typedef float f2v_ __attribute__((ext_vector_type(2)));
typedef __bf16 b2v_ __attribute__((ext_vector_type(2)));
__device__ __forceinline__ unsigned pack2(float a, float b) { f2v_ f = {a, b}; b2v_ r = __builtin_convertvector(f, b2v_); return *(unsigned*)&r; }
__device__ __forceinline__ uint2 pack4(float a, float b, float c, float d) { return make_uint2(pack2(a, b), pack2(c, d)); }
__device__ __forceinline__ float lo16(unsigned u) { return __uint_as_float(u << 16); }
__device__ __forceinline__ float hi16(unsigned u) { return __uint_as_float(u & 0xffff0000u); }
__device__ __forceinline__ float sigmoidf_(float x) { return __builtin_amdgcn_rcpf(1.0f + __expf(-x)); }
__device__ __forceinline__ float siluf_(float x) { return x * __builtin_amdgcn_rcpf(1.0f + __expf(-x)); }
__device__ __forceinline__ int cond_of(int tok) { return tok < NPROMPT ? 0 : 1 + ((tok - NPROMPT) >> 10); }
__device__ __forceinline__ float wave_sum(float v) {
#pragma unroll
  for (int o = 32; o > 0; o >>= 1) v += __shfl_xor(v, o);
  return v;
}
__device__ __forceinline__ void rope_sincos(float pos, int fi, float& sn, float& cs) {
  float inv = exp2f(-(float)fi * 1.6609640474436813f);
  float ang = pos * inv;
  float k = rintf(ang * 0.15915494309189535f);
  float r = fmaf(-k, 6.2831854820251465f, ang);
  r = fmaf(-k, -1.7484555e-7f, r);
  sn = __sinf(r); cs = __cosf(r);
}

#define NT 512
#define NW 8
#define LAS __attribute__((address_space(3)))

namespace pg8 {
constexpr int BM = 256, BK = 64, HALF = 128, HTB = HALF * BK * 2, STAGE_BYTES = 8 * HTB, NXCD = 8, WGM = 8;
__device__ __forceinline__ int lds_byte(int r, int c) { const int st = (r >> 4) * 2 + (c >> 5), rr = r & 15, cc = c & 31, ob = rr * 64 + cc * 2; return st * 1024 + (ob ^ (((ob >> 9) & 1) << 5)); }
__device__ __forceinline__ void stage_rc(int b, int& R, int& C) { const int st = b / 1024, sb = b % 1024, swz = sb ^ (((sb >> 9) & 1) << 5); R = (st >> 1) * 16 + swz / 64; C = (st & 1) * 32 + (swz % 64) / 2; }
struct Unit { int pm, pn; };
struct Gemm { const u16* A; const u16* Bt; int M, N, K, lda, gate, noepi; size_t kstepA, gstride; };
struct StaticOrder {
  int nM, nN, nwg, G, c;
  __device__ void init(int M, int N, int G_, int c_) { nM = M / BM; nN = N / BM; nwg = nM * nN; G = G_; c = c_; }
  __device__ bool next(int i, Unit& u) const {
    const long L = (long)i * G + c; if (L >= nwg) return false;
    int wgid = (int)L; { const int q = nwg / NXCD, r = nwg % NXCD, xcd = wgid % NXCD, off = wgid / NXCD; wgid = (xcd < r ? xcd * (q + 1) : r * (q + 1) + (xcd - r) * q) + off; }
    const int nig = WGM * nN, gid = wgid / nig, fm = gid * WGM, gsz = (nM - fm) < WGM ? (nM - fm) : WGM;
    u.pm = fm + ((wgid % nig) % gsz); u.pn = (wgid % nig) / gsz; return true;
  }
};
template <class Epi>
__device__ __forceinline__ void gemm_phase(LAS unsigned char* lds, const Gemm g, const StaticOrder& S, const Epi& E) {
  const int tid = threadIdx.x, wid = __builtin_amdgcn_readfirstlane(tid >> 6), lane = tid & 63, wr = wid >> 2, wc = wid & 3, fr = lane & 15, fq = lane >> 4;
  const int K = g.K, nt = K / BK;
  unsigned voffA[2], voffB[2];
#pragma unroll
  for (int i = 0; i < 2; ++i) { int R, C; stage_rc(tid * 16 + i * 8192, R, C); voffA[i] = (unsigned)(R * g.lda + C) * 2u; voffB[i] = (unsigned)(R * K + C) * 2u; }
  const size_t kstep = (size_t)(BK * 2);
  const size_t kstepA = g.kstepA;
  const size_t hstepA = (size_t)HALF * g.lda * 2, hstepB = (size_t)HALF * K * 2;
  const size_t tstepA = 2 * hstepA, tstepB = 2 * hstepB;
  const unsigned ldsw = (unsigned)wid * 1024u;
  const int aoff = lds_byte(wr * 64 + fr, fq * 8), boff = lds_byte(wc * 32 + fr, fq * 8);
#define PG8_AOFF(pn) (g.gate ? (size_t)(((pn) >> 1) & 3) * g.gstride : (size_t)0)
#define PG8_SA(b, h) (((b) * 2 + (h)) * HTB)
#define PG8_SB(b, h) ((4 + (b) * 2 + (h)) * HTB)
#define PG8_STAGE(bufoff, gbase, voff) do { _Pragma("unroll") for (int _i = 0; _i < 2; ++_i) \
    __builtin_amdgcn_global_load_lds((const unsigned*)((const char*)(gbase) + (voff)[_i]), (LAS unsigned*)(lds + (bufoff) + ldsw + _i * 8192), 16, 0, 0); } while (0)
#define PG8_LDA(dst, b, h) do { _Pragma("unroll") for (int m = 0; m < 4; ++m) _Pragma("unroll") for (int k = 0; k < 2; ++k) dst[m][k] = *(const LAS bf16x8*)(lds + PG8_SA(b, h) + aoff + m * 2048 + k * 1024); } while (0)
#define PG8_LDB(dst, b, h) do { _Pragma("unroll") for (int n = 0; n < 2; ++n) _Pragma("unroll") for (int k = 0; k < 2; ++k) dst[n][k] = *(const LAS bf16x8*)(lds + PG8_SB(b, h) + boff + n * 2048 + k * 1024); } while (0)
#define PG8_MMA(ai, bj, At, Bt) do { __builtin_amdgcn_s_setprio(1); _Pragma("unroll") for (int m = 0; m < 4; ++m) _Pragma("unroll") for (int n = 0; n < 2; ++n) _Pragma("unroll") for (int k = 0; k < 2; ++k) \
    acc[ai][bj][m][n] = __builtin_amdgcn_mfma_f32_16x16x32_bf16(Bt[n][k], At[m][k], acc[ai][bj][m][n], 0, 0, 0); __builtin_amdgcn_s_setprio(0); } while (0)
#define PG8_WAIT_V(n) asm volatile("s_waitcnt vmcnt(" #n ")" ::: "memory")
#define PG8_WAIT_L(n) asm volatile("s_waitcnt lgkmcnt(" #n ")" ::: "memory")
#define PG8_BAR __builtin_amdgcn_s_barrier()
#define PG8_SCHED __builtin_amdgcn_sched_barrier(0)
  Unit cur, nxt; int ui = 0;
  if (!S.next(0, cur)) return;
  f32x4 acc[2][2][4][2];
#pragma unroll
  for (int a = 0; a < 2; ++a)
#pragma unroll
    for (int b = 0; b < 2; ++b)
#pragma unroll
      for (int m = 0; m < 4; ++m)
#pragma unroll
        for (int n = 0; n < 2; ++n) acc[a][b][m][n] = (f32x4){0.f, 0.f, 0.f, 0.f};
  bf16x8 At[4][2], B0[2][2], B1[2][2];
  const char* cA = (const char*)g.A + (size_t)cur.pm * tstepA + PG8_AOFF(cur.pn); const char* cB = (const char*)g.Bt + (size_t)cur.pn * tstepB;
  PG8_STAGE(PG8_SB(0, 0), cB, voffB); PG8_STAGE(PG8_SA(0, 0), cA, voffA); PG8_STAGE(PG8_SB(0, 1), cB + hstepB, voffB); PG8_STAGE(PG8_SA(0, 1), cA + hstepA, voffA);
  if (wr == 1) PG8_BAR;
  PG8_WAIT_V(4); PG8_BAR;
  PG8_STAGE(PG8_SB(1, 0), cB + kstep, voffB); PG8_STAGE(PG8_SA(1, 0), cA + kstepA, voffA); PG8_STAGE(PG8_SB(1, 1), cB + hstepB + kstep, voffB);
  PG8_WAIT_V(6); PG8_BAR;
  for (;;) {
    const bool has_next = S.next(ui + 1, nxt);
    const char* nA = has_next ? (const char*)g.A + (size_t)nxt.pm * tstepA + PG8_AOFF(nxt.pn) : cA; const char* nB = has_next ? (const char*)g.Bt + (size_t)nxt.pn * tstepB : cB;
#pragma unroll 1
    for (int t = 0; t < nt; t += 2) {
      const bool last = (t == nt - 2);
      const char* a1 = cA + (size_t)(t + 1) * kstepA;
      const char* a2 = last ? nA : cA + (size_t)(t + 2) * kstepA; const char* b2 = last ? nB : cB + (size_t)(t + 2) * kstep;
      const char* a3 = a2 + kstepA; const char* b3 = b2 + kstep;
      PG8_LDB(B0, 0, 0); PG8_SCHED; PG8_LDA(At, 0, 0); PG8_STAGE(PG8_SA(1, 1), a1 + hstepA, voffA);
      PG8_WAIT_L(8); PG8_BAR; PG8_WAIT_L(0); PG8_MMA(0, 0, At, B0); PG8_BAR; PG8_SCHED;
      PG8_LDB(B1, 0, 1); PG8_STAGE(PG8_SB(0, 0), b2, voffB);
      PG8_BAR; PG8_WAIT_L(0); PG8_MMA(0, 1, At, B1); PG8_BAR;
      PG8_LDA(At, 0, 1); PG8_STAGE(PG8_SA(0, 0), a2, voffA);
      PG8_BAR; PG8_WAIT_L(0); PG8_MMA(1, 0, At, B0); PG8_BAR; PG8_SCHED;
      PG8_STAGE(PG8_SB(0, 1), b2 + hstepB, voffB);
      PG8_WAIT_V(6); PG8_BAR; PG8_MMA(1, 1, At, B1); PG8_BAR;
      PG8_LDB(B0, 1, 0); PG8_SCHED; PG8_LDA(At, 1, 0); PG8_STAGE(PG8_SA(0, 1), a2 + hstepA, voffA);
      PG8_WAIT_L(8); PG8_BAR; PG8_WAIT_L(0); PG8_MMA(0, 0, At, B0); PG8_BAR; PG8_SCHED;
      PG8_LDB(B1, 1, 1); PG8_STAGE(PG8_SB(1, 0), b3, voffB);
      PG8_BAR; PG8_WAIT_L(0); PG8_MMA(0, 1, At, B1); PG8_BAR;
      PG8_LDA(At, 1, 1); PG8_STAGE(PG8_SA(1, 0), a3, voffA);
      PG8_BAR; PG8_WAIT_L(0); PG8_MMA(1, 0, At, B0); PG8_BAR; PG8_SCHED;
      PG8_STAGE(PG8_SB(1, 1), b3 + hstepB, voffB);
      PG8_WAIT_V(6); PG8_BAR; PG8_MMA(1, 1, At, B1); PG8_BAR;
    }
    if constexpr (!Epi::AFTER_DRAIN) { if (!g.noepi) E(acc, cur, wr, wc, fr, fq); }
    if (!has_next) break;
#pragma unroll
    for (int a = 0; a < 2; ++a)
#pragma unroll
      for (int b = 0; b < 2; ++b)
#pragma unroll
        for (int m = 0; m < 4; ++m)
#pragma unroll
          for (int n = 0; n < 2; ++n) acc[a][b][m][n] = (f32x4){0.f, 0.f, 0.f, 0.f};
    cur = nxt; cA = nA; cB = nB; ++ui;
  }
  PG8_WAIT_V(0);
  if (wr == 0) PG8_BAR;
  PG8_BAR;
  if constexpr (Epi::AFTER_DRAIN) { if (!g.noepi) E.fused(acc, cur, wr, wc, fr, fq, lds); }
#undef PG8_AOFF
#undef PG8_SA
#undef PG8_SB
#undef PG8_STAGE
#undef PG8_LDA
#undef PG8_LDB
#undef PG8_MMA
#undef PG8_WAIT_V
#undef PG8_WAIT_L
#undef PG8_BAR
#undef PG8_SCHED
}
}
using pg8::Unit;
typedef const f32x4 (&AccRef)[2][2][4][2];

#define EPI_ROWS(...) _Pragma("unroll") for (int ai = 0; ai < 2; ++ai) _Pragma("unroll") for (int m = 0; m < 4; ++m) { const int row = u.pm * 256 + ai * 128 + wr * 64 + m * 16 + fr; __VA_ARGS__ }
#define EPI_COLS(...) _Pragma("unroll") for (int bj = 0; bj < 2; ++bj) _Pragma("unroll") for (int n = 0; n < 2; ++n) { const int cb = u.pn * 256 + bj * 128 + wc * 32 + n * 16; const f32x4 a = acc[ai][bj][m][n]; __VA_ARGS__ }

struct EpiHgIn {
  static constexpr bool AFTER_DRAIN = false;
  u16 *q, *v, *sg; _Float16* lf; const float* lb;
  __device__ __forceinline__ void operator()(AccRef acc, const Unit& u, int wr, int wc, int fr, int fq) const {
    const int region = u.pn >> 2;
    f32x4 l4[2][2];
    if (region == 1 || region == 2) {
#pragma unroll
      for (int bj = 0; bj < 2; ++bj)
#pragma unroll
        for (int n = 0; n < 2; ++n) l4[bj][n] = *(const f32x4*)&lb[(region - 1) * 1024 + ((u.pn * 256 + bj * 128 + wc * 32 + n * 16) & 1023) + fq * 4];
    }
    EPI_ROWS( EPI_COLS(
      const int c = (cb & 1023) + fq * 4;
      if (region == 0) {
        const float s = 0.08838834764831845f;
        *(uint2*)&q[(size_t)row * 1024 + c] = pack4(siluf_(a[0]) * s, siluf_(a[1]) * s, siluf_(a[2]) * s, siluf_(a[3]) * s);
      } else if (region <= 2) {
        const int d = region - 1;
        h4 o;
        _Pragma("unroll") for (int j = 0; j < 4; ++j) { float f = l4[bj][n][j] + (1.0f - l4[bj][n][j]) * sigmoidf_(a[j]); o[j] = (_Float16)__builtin_amdgcn_logf(f); }
        *(h4*)&lf[(size_t)row * 2048 + d * 1024 + c] = o;
      } else if (region == 3) {
        *(uint2*)&v[(size_t)row * 1024 + c] = pack4(a[0], a[1], a[2], a[3]);
      } else {
        *(uint2*)&sg[(size_t)row * 1024 + c] = pack4(a[0], a[1], a[2], a[3]);
      }
    ) )
  }
};

struct EpiRes {
  static constexpr bool AFTER_DRAIN = false;
  const float* xin_p; const float* xin_s; float* Y; const float* gate;
  __device__ __forceinline__ void operator()(AccRef acc, const Unit& u, int wr, int wc, int fr, int fq) const {
    EPI_ROWS(
      const float* xr = row < NPROMPT ? xin_p + (size_t)row * 1024 : xin_s + (size_t)(row - NPROMPT) * 1024;
      const float* g = gate + cond_of(row) * 3072;
      EPI_COLS(
        const int c = cb + fq * 4;
        f32x4 x = *(const f32x4*)&xr[c];
        f32x4 gg = *(const f32x4*)&g[c];
        f32x4 y;
        _Pragma("unroll") for (int j = 0; j < 4; ++j) y[j] = DN_ALPHA * x[j] + gg[j] * a[j];
        *(f32x4*)&Y[(size_t)row * 1024 + c] = y;
      ) )
  }
};

template <bool XIN_BF, bool XOUT_BF>
struct EpiResLn {
  static constexpr bool AFTER_DRAIN = true;
  const float* xin_p; const float* xin_s; const u16* xin_b; float* X; u16* XB; const float* gate; const float* lg; const float* lbias; const float* modn; u16* H;
  unsigned long long* slots; unsigned* cnt;
  __device__ __forceinline__ void fused(f32x4 (&acc)[2][2][4][2], const Unit& u, int wr, int wc, int fr, int fq, LAS unsigned char* lds) const {
    LAS float* part = (LAS float*)lds;
    LAS float* stat = part + 2048;
    const int tid = threadIdx.x;
    const int cnd = cond_of(u.pm * 256);
    f32x4 gv[2][2];
#pragma unroll
    for (int bj = 0; bj < 2; ++bj)
#pragma unroll
      for (int n = 0; n < 2; ++n) gv[bj][n] = *(const f32x4*)&gate[cnd * 3072 + u.pn * 256 + bj * 128 + wc * 32 + n * 16 + fq * 4];
#pragma unroll
    for (int ai = 0; ai < 2; ++ai)
#pragma unroll
      for (int m = 0; m < 4; ++m) {
        const int rl = ai * 128 + wr * 64 + m * 16 + fr;
        const int row = u.pm * 256 + rl;
        const float* xr = row < NPROMPT ? xin_p + (size_t)row * 1024 : xin_s + (size_t)(row - NPROMPT) * 1024;
        float s1 = 0.f, s2 = 0.f;
#pragma unroll
        for (int bj = 0; bj < 2; ++bj)
#pragma unroll
          for (int n = 0; n < 2; ++n) {
            const int c = u.pn * 256 + bj * 128 + wc * 32 + n * 16 + fq * 4;
            f32x4 x;
            if constexpr (XIN_BF) { const uint2 xb2 = *(const uint2*)&xin_b[(size_t)row * 1024 + c]; x = f32x4{lo16(xb2.x), hi16(xb2.x), lo16(xb2.y), hi16(xb2.y)}; }
            else x = *(const f32x4*)&xr[c];
            const f32x4 gg = gv[bj][n];
            f32x4 y;
#pragma unroll
            for (int j = 0; j < 4; ++j) { y[j] = DN_ALPHA * x[j] + gg[j] * acc[ai][bj][m][n][j]; s1 += y[j]; s2 += y[j] * y[j]; }
            acc[ai][bj][m][n] = y;
          }
        s1 += __shfl_xor(s1, 16); s1 += __shfl_xor(s1, 32);
        s2 += __shfl_xor(s2, 16); s2 += __shfl_xor(s2, 32);
        if (fq == 0) { part[(rl * 4 + wc) * 2] = s1; part[(rl * 4 + wc) * 2 + 1] = s2; }
      }
    __syncthreads();
    if (tid < 256) {
      float S1 = 0.f, S2 = 0.f;
#pragma unroll
      for (int w2 = 0; w2 < 4; ++w2) { S1 += part[(tid * 4 + w2) * 2]; S2 += part[(tid * 4 + w2) * 2 + 1]; }
      const unsigned long long v = (unsigned long long)__float_as_uint(S1) | ((unsigned long long)__float_as_uint(S2) << 32);
      __hip_atomic_store(&slots[(size_t)(u.pm * 4 + u.pn) * 256 + tid], v, __ATOMIC_RELAXED, __HIP_MEMORY_SCOPE_AGENT);
    }
    asm volatile("s_waitcnt vmcnt(0)" ::: "memory");
    __syncthreads();
    if (tid == 0) {
      __hip_atomic_fetch_add(&cnt[u.pm], 1u, __ATOMIC_RELAXED, __HIP_MEMORY_SCOPE_AGENT);
      unsigned sp = 0;
      while (__hip_atomic_load(&cnt[u.pm], __ATOMIC_RELAXED, __HIP_MEMORY_SCOPE_AGENT) < 4u) { __builtin_amdgcn_s_sleep(1); if (++sp > (1u << 24)) break; }
    }
    __syncthreads();
    if (tid < 256) {
      float T1 = 0.f, T2 = 0.f;
#pragma unroll
      for (int o = 0; o < 4; ++o) {
        const unsigned long long v = __hip_atomic_load(&slots[(size_t)(u.pm * 4 + o) * 256 + tid], __ATOMIC_RELAXED, __HIP_MEMORY_SCOPE_AGENT);
        T1 += __uint_as_float((unsigned)(v & 0xffffffffull)); T2 += __uint_as_float((unsigned)(v >> 32));
      }
      const float mu = T1 * (1.0f / 1024.0f);
      const float var = fmaxf(T2 * (1.0f / 1024.0f) - mu * mu, 0.f);
      stat[tid * 2] = mu; stat[tid * 2 + 1] = rsqrtf(var + 1e-5f);
    }
    __syncthreads();
#pragma unroll
    for (int bj = 0; bj < 2; ++bj) {
      f32x4 lgv[2], lbv[2], shv[2], scv[2];
#pragma unroll
      for (int n = 0; n < 2; ++n) {
        const int c = u.pn * 256 + bj * 128 + wc * 32 + n * 16 + fq * 4;
        lgv[n] = *(const f32x4*)&lg[c]; lbv[n] = *(const f32x4*)&lbias[c];
        shv[n] = *(const f32x4*)&modn[cnd * 3072 + c]; scv[n] = *(const f32x4*)&modn[cnd * 3072 + 1024 + c];
      }
#pragma unroll
      for (int ai = 0; ai < 2; ++ai)
#pragma unroll
        for (int m = 0; m < 4; ++m) {
          const int rl = ai * 128 + wr * 64 + m * 16 + fr;
          const int row = u.pm * 256 + rl;
          const float mu = stat[rl * 2], rs = stat[rl * 2 + 1];
#pragma unroll
          for (int n = 0; n < 2; ++n) {
            const int c = u.pn * 256 + bj * 128 + wc * 32 + n * 16 + fq * 4;
            const f32x4 y = acc[ai][bj][m][n];
            f32x4 xo;
#pragma unroll
            for (int j = 0; j < 4; ++j) xo[j] = (y[j] - mu) * rs * lgv[n][j] + lbv[n][j];
            if constexpr (XOUT_BF) *(uint2*)&XB[(size_t)row * 1024 + c] = pack4(xo[0], xo[1], xo[2], xo[3]);
            else *(f32x4*)&X[(size_t)row * 1024 + c] = xo;
            if (H) {
              *(uint2*)&H[(size_t)row * 1024 + c] = pack4(xo[0] * (1 + scv[n][0]) + shv[n][0], xo[1] * (1 + scv[n][1]) + shv[n][1], xo[2] * (1 + scv[n][2]) + shv[n][2], xo[3] * (1 + scv[n][3]) + shv[n][3]);
            }
          }
        }
    }
  }
};

struct EpiScIn {
  static constexpr bool AFTER_DRAIN = false;
  u16 *pb, *sb;
  __device__ __forceinline__ void operator()(AccRef acc, const Unit& u, int wr, int wc, int fr, int fq) const {
    const int c = u.pn * 64 + wc * 16 + fq * 4;
    EPI_ROWS(
      const f32x4 bg = acc[ai][0][m][0], cgv = acc[ai][0][m][1], v = acc[ai][1][m][0], g = acc[ai][1][m][1];
      *(uint2*)&pb[(size_t)row * 1024 + c] = pack4(cgv[0] * v[0], cgv[1] * v[1], cgv[2] * v[2], cgv[3] * v[3]);
      *(uint2*)&sb[(size_t)row * 1024 + c] = pack4(siluf_(g[0]) * bg[0], siluf_(g[1]) * bg[1], siluf_(g[2]) * bg[2], siluf_(g[3]) * bg[3]);
    )
  }
};

struct EpiRgIn {
  static constexpr bool AFTER_DRAIN = false;
  u16 *ub, *sg;
  __device__ __forceinline__ void operator()(AccRef acc, const Unit& u, int wr, int wc, int fr, int fq) const {
    const int region = u.pn >> 2;
    EPI_ROWS( EPI_COLS(
      const int c = (cb & 1023) + fq * 4;
      if (region == 0) *(uint2*)&ub[(size_t)row * 1024 + c] = pack4(a[0], a[1], a[2], a[3]);
      else *(uint2*)&sg[((size_t)(c >> 6) * TOK + row) * 64 + (c & 63)] = pack4(siluf_(a[0]), siluf_(a[1]), siluf_(a[2]), siluf_(a[3]));
    ) )
  }
};

struct EpiRgGate {
  static constexpr bool AFTER_DRAIN = false;
  u16 *rb, *ib; const float* bgate;
  __device__ __forceinline__ void operator()(AccRef acc, const Unit& u, int wr, int wc, int fr, int fq) const {
    const int mat = u.pn >> 1, d = mat >> 2, hd = mat & 3;
    f32x4 br[2], bi[2]; int ccs[2];
#pragma unroll
    for (int bj = 0; bj < 2; ++bj) {
      const int off = ((u.pn & 1) * 256 + bj * 128 + wc * 32);
      ccs[bj] = (off >> 5) * 16 + fq * 4;
      br[bj] = *(const f32x4*)&bgate[mat * 512 + ccs[bj]];
      bi[bj] = *(const f32x4*)&bgate[mat * 512 + 256 + ccs[bj]];
    }
    EPI_ROWS(
      _Pragma("unroll") for (int bj = 0; bj < 2; ++bj) {
        const f32x4 r = acc[ai][bj][m][0], ii = acc[ai][bj][m][1];
        const int cch = hd * 256 + ccs[bj];
        const size_t o = (size_t)d * TOK * 1024 + ((size_t)(cch >> 6) * TOK + row) * 64 + (cch & 63);
        *(uint2*)&rb[o] = pack4(sigmoidf_(r[0] + br[bj][0]), sigmoidf_(r[1] + br[bj][1]), sigmoidf_(r[2] + br[bj][2]), sigmoidf_(r[3] + br[bj][3]));
        *(uint2*)&ib[o] = pack4(sigmoidf_(ii[0] + bi[bj][0]), sigmoidf_(ii[1] + bi[bj][1]), sigmoidf_(ii[2] + bi[bj][2]), sigmoidf_(ii[3] + bi[bj][3]));
      } )
  }
};

struct EpiMlaIn {
  static constexpr bool AFTER_DRAIN = false;
  u16* cq; float* ckvraw; float* kperaw; u16* sg;
  __device__ __forceinline__ void operator()(AccRef acc, const Unit& u, int wr, int wc, int fr, int fq) const {
    EPI_ROWS( EPI_COLS(
      const int c = cb + fq * 4;
      if (cb < 384) *(uint2*)&cq[(size_t)row * 384 + c] = pack4(a[0], a[1], a[2], a[3]);
      else if (cb < 640) *(f32x4*)&ckvraw[(size_t)row * 256 + (c - 384)] = a;
      else if (cb < 672) *(f32x4*)&kperaw[(size_t)row * 32 + (c - 640)] = a;
    ) )
  }
};

struct EpiSg {
  static constexpr bool AFTER_DRAIN = false;
  u16* sg;
  __device__ __forceinline__ void operator()(AccRef acc, const Unit& u, int wr, int wc, int fr, int fq) const {
    EPI_ROWS( EPI_COLS(
      *(uint2*)&sg[(size_t)row * 1024 + cb + fq * 4] = pack4(a[0], a[1], a[2], a[3]);
    ) )
  }
};

struct EpiQ {
  static constexpr bool AFTER_DRAIN = false;
  u16* q;
  __device__ __forceinline__ void operator()(AccRef acc, const Unit& u, int wr, int wc, int fr, int fq) const {
    const float sc = 0.14724444500602648f;
    EPI_ROWS( EPI_COLS(
      *(uint2*)&q[(size_t)row * 1536 + cb + fq * 4] = pack4(a[0] * sc, a[1] * sc, a[2] * sc, a[3] * sc);
    ) )
  }
};

struct EpiK {
  static constexpr bool AFTER_DRAIN = false;
  u16* Kb;
  __device__ __forceinline__ void operator()(AccRef acc, const Unit& u, int wr, int wc, int fr, int fq) const {
    EPI_ROWS( EPI_COLS(
      const int h = cb >> 6, dd = (cb & 63) + fq * 4;
      *(uint2*)&Kb[((size_t)row * 16 + h) * 96 + dd] = pack4(a[0], a[1], a[2], a[3]);
    ) )
  }
};
struct EpiV {
  static constexpr bool AFTER_DRAIN = false;
  u16* Vt;
  __device__ __forceinline__ void operator()(AccRef acc, const Unit& u, int wr, int wc, int fr, int fq) const {
    EPI_ROWS( EPI_COLS(
      *(uint2*)&Vt[(size_t)row * KVROWS + cb + fq * 4] = pack4(a[0], a[1], a[2], a[3]);
    ) )
  }
};

__device__ __forceinline__ void wconv_tile(const float* __restrict__ src, int N, int K, u16* __restrict__ dst, int k0, int n0,
                                           int perm, int mat, float* tile) {
  const int tid = threadIdx.x;
  {
    const int r = tid >> 4, c4 = (tid & 15) * 4;
#pragma unroll
    for (int i = 0; i < 2; ++i) {
      const int k = r + i * 32;
      f32x4 v = f32x4{0.f, 0.f, 0.f, 0.f};
      if (n0 + c4 < N) v = *(const f32x4*)&src[(size_t)(k0 + k) * N + n0 + c4];
      tile[k * 65 + c4 + 0] = v[0]; tile[k * 65 + c4 + 1] = v[1]; tile[k * 65 + c4 + 2] = v[2]; tile[k * 65 + c4 + 3] = v[3];
    }
  }
  __syncthreads();
  {
    const int nl = tid >> 3, kq = (tid & 7) * 8;
    const int n = n0 + nl;
    int np = n;
    if (perm == 1) { const int part = n >> 10, c = n & 1023; np = (c >> 6) * 256 + (part >> 1) * 128 + ((c >> 4) & 3) * 32 + (part & 1) * 16 + (c & 15); }
    else if (perm == 2) { const int type = n >> 8, cc = n & 255; np = mat * 512 + (cc >> 4) * 32 + type * 16 + (cc & 15); }
    else if (perm == 3) { const int hh = n >> 7, dd = n & 127; np = (dd >= 64 ? 1024 : 0) + hh * 64 + (dd & 63); }
    if (n < N) {
      unsigned w[4];
#pragma unroll
      for (int i = 0; i < 4; ++i) w[i] = pack2(tile[(kq + 2 * i) * 65 + nl], tile[(kq + 2 * i + 1) * 65 + nl]);
      *(uint4*)&dst[(size_t)np * K + k0 + kq] = make_uint4(w[0], w[1], w[2], w[3]);
    }
  }
  __syncthreads();
}

__device__ __forceinline__ void wconv_item(const Params& p, int t, float* fs) {
  const float* src; u16* dst; int N, K, perm = 0, mat = 0, ntn;
  if (t < 1280) { src = p.in[12]; dst = (u16*)(p.ws + WS_W_HG_IN); N = 5120; K = 1024; }
  else if ((t -= 1280) < 256) { src = p.in[15]; dst = (u16*)(p.ws + WS_W_HG_OUT); N = 1024; K = 1024; }
  else if ((t -= 256) < 1024) { src = p.in[16]; dst = (u16*)(p.ws + WS_W_SC_IN); N = 4096; K = 1024; perm = 1; }
  else if ((t -= 1024) < 256) { src = p.in[19]; dst = (u16*)(p.ws + WS_W_SC_OUT); N = 1024; K = 1024; }
  else if ((t -= 256) < 512) { src = p.in[20]; dst = (u16*)(p.ws + WS_W_RG_IN); N = 2048; K = 1024; }
  else if ((t -= 512) < 256) { mat = t >> 5; t &= 31; src = p.in[23] + (size_t)mat * 256 * 512; dst = (u16*)(p.ws + WS_W_RG_GATE); N = 512; K = 256; perm = 2; }
  else if ((t -= 256) < 256) { src = p.in[26]; dst = (u16*)(p.ws + WS_W_RG_OUT); N = 1024; K = 1024; }
  else if ((t -= 256) < 432) { src = p.in[27]; dst = (u16*)(p.ws + WS_W_MLA_IN); N = 1696; K = 1024; }
  else if ((t -= 432) < 144) { src = p.in[30]; dst = (u16*)(p.ws + WS_W_QB); N = 1536; K = 384; }
  else if ((t -= 144) < 128) { src = p.in[31]; dst = (u16*)(p.ws + WS_W_KVB); N = 2048; K = 256; perm = 3; }
  else { t -= 128; src = p.in[32]; dst = (u16*)(p.ws + WS_W_MLA_OUT); N = 1024; K = 1024; }
  ntn = (N + 63) >> 6;
  const int kt = t / ntn, ntl = t - kt * ntn;
  wconv_tile(src, N, K, dst, kt * 64, ntl * 64, perm, mat, fs);
}
__device__ __forceinline__ void wconv_idle(const Params& p, unsigned char* smem_raw, int bid, int nb, int t0, int t1) {
  if (nb == 256 && bid >= 192) for (int t = t0 + (bid - 192); t < t1; t += 64) wconv_item(p, t, (float*)smem_raw);
}

__device__ __forceinline__ void phase_prologue(const Params& p, unsigned char* smem_raw, int bid, int nb) {
  float* fs = (float*)smem_raw;
  const int tid = threadIdx.x;
  const int NMOD = 192, NWT = (nb == 256) ? 1536 : 4800;
  for (int it = bid; it < NMOD + 1 + NWT; it += nb) {
    if (it < NMOD) {
      const int l = it / 48, n0 = (it % 48) * 64;
      float* scond = fs;
      float* sred = fs + 5120;
      for (int i = tid; i < 5120; i += NT) {
        const int ci = i >> 10, k = i & 1023;
        float cv = ci == 0 ? p.in[7][k] : p.in[6][(ci - 1) * 1024 + k];
        scond[i] = siluf_(cv);
      }
      __syncthreads();
      const int col = tid & 63, kg = tid >> 6;
      const float* w = p.in[8] + (size_t)l * 1024 * 3072 + n0 + col;
      float a0 = 0, a1 = 0, a2 = 0, a3 = 0, a4 = 0;
#pragma unroll 16
      for (int k = kg * 128; k < kg * 128 + 128; ++k) {
        float wv = w[(size_t)k * 3072];
        a0 += scond[k] * wv; a1 += scond[1024 + k] * wv; a2 += scond[2048 + k] * wv; a3 += scond[3072 + k] * wv; a4 += scond[4096 + k] * wv;
      }
      sred[(kg * 5 + 0) * 64 + col] = a0; sred[(kg * 5 + 1) * 64 + col] = a1; sred[(kg * 5 + 2) * 64 + col] = a2;
      sred[(kg * 5 + 3) * 64 + col] = a3; sred[(kg * 5 + 4) * 64 + col] = a4;
      __syncthreads();
      float* mod = (float*)(p.ws + WS_MOD);
      if (tid < 320) {
        const int ci = tid >> 6, cc = tid & 63;
        float s = 0;
#pragma unroll
        for (int g = 0; g < 8; ++g) s += sred[(g * 5 + ci) * 64 + cc];
        mod[(l * 5 + ci) * 3072 + n0 + cc] = s + p.in[9][l * 3072 + n0 + cc];
      }
      __syncthreads();
    } else if (it == NMOD) {
      float* lb = (float*)(p.ws + WS_LB);
      for (int i = tid; i < 2048; i += NT) {
        const int d = i >> 10, c = i & 1023;
        const float* lg = p.in[13] + d * 5 * 1024 + c;
        float m = lg[0];
        for (int j = 1; j < 5; ++j) m = fmaxf(m, lg[j * 1024]);
        float s = 0;
        for (int j = 0; j < 5; ++j) s += expf(lg[j * 1024] - m);
        lb[i] = expf(lg[0] - m) / s;
      }
      int* cnt = (int*)(p.ws + WS_CNT);
      if (tid < 16) cnt[tid] = 0;
    } else {
      wconv_item(p, it - NMOD - 1, fs);
    }
  }
}

__device__ __forceinline__ void phase_h0(const Params& p, int bid, int nb) {
  const float* mod = (const float*)(p.ws + WS_MOD);
  u16* H = (u16*)(p.ws + WS_H);
  const size_t total = (size_t)(TOK / 4) * 256;
  for (size_t i = (size_t)bid * NT + threadIdx.x; i < total; i += (size_t)nb * NT) {
    const int row = (int)(i >> 8) * 4, c = ((int)i & 255) * 4;
    const float* xr = row < NPROMPT ? p.in[0] + (size_t)row * 1024 : p.in[1] + (size_t)(row - NPROMPT) * 1024;
    const float* m = mod + cond_of(row) * 3072;
    f32x4 x[4];
#pragma unroll
    for (int t = 0; t < 4; ++t) x[t] = *(const f32x4*)&xr[t * 1024 + c];
    const f32x4 sh = *(const f32x4*)&m[c];
    const f32x4 sc = *(const f32x4*)&m[1024 + c];
#pragma unroll
    for (int t = 0; t < 4; ++t)
      *(uint2*)&H[(size_t)(row + t) * 1024 + c] = pack4(x[t][0] * (1 + sc[0]) + sh[0], x[t][1] * (1 + sc[1]) + sh[1], x[t][2] * (1 + sc[2]) + sh[2], x[t][3] * (1 + sc[3]) + sh[3]);
  }
}

__device__ __forceinline__ void phase_ln(const Params& p, int l, int bid, int nb) {
  float* X = p.out;
  const float* g = p.in[10] + l * 1024;
  const float* b = p.in[11] + l * 1024;
  const float* mod = (const float*)(p.ws + WS_MOD) + (l + 1) * 5 * 3072;
  u16* H = (u16*)(p.ws + WS_H);
  const int lane = threadIdx.x & 63, wave = threadIdx.x >> 6;
  for (int row = bid * NW + wave; row < TOK; row += nb * NW) {
    float* xr = X + (size_t)row * 1024;
    f32x4 v[4];
    float s = 0;
#pragma unroll
    for (int i = 0; i < 4; ++i) { v[i] = *(const f32x4*)&xr[i * 256 + lane * 4]; s += v[i][0] + v[i][1] + v[i][2] + v[i][3]; }
    const float mu = wave_sum(s) * (1.0f / 1024.0f);
    float q = 0;
#pragma unroll
    for (int i = 0; i < 4; ++i)
#pragma unroll
      for (int j = 0; j < 4; ++j) { float dd = v[i][j] - mu; q += dd * dd; }
    const float rs = rsqrtf(wave_sum(q) * (1.0f / 1024.0f) + 1e-5f);
    const float* m = mod + cond_of(row) * 3072;
#pragma unroll
    for (int i = 0; i < 4; ++i) {
      const int c = i * 256 + lane * 4;
      f32x4 gg = *(const f32x4*)&g[c], bb = *(const f32x4*)&b[c];
      f32x4 y;
#pragma unroll
      for (int j = 0; j < 4; ++j) y[j] = (v[i][j] - mu) * rs * gg[j] + bb[j];
      *(f32x4*)&xr[c] = y;
      if (l < 3) {
        f32x4 sh = *(const f32x4*)&m[c], sc = *(const f32x4*)&m[1024 + c];
        *(uint2*)&H[(size_t)row * 1024 + c] = pack4(y[0] * (1 + sc[0]) + sh[0], y[1] * (1 + sc[1]) + sh[1], y[2] * (1 + sc[2]) + sh[2], y[3] * (1 + sc[3]) + sh[3]);
      }
    }
  }
}

__device__ __forceinline__ void phase_gla(const Params& p, unsigned char* smem_raw) {
  u16* s_qrel = (u16*)smem_raw;
  u16* s_krel = s_qrel + 32 * 136;
  u16* s_qcum = s_krel + 32 * 136;
  u16* s_kdT = s_qcum + 32 * 136;
  u16* s_vT = s_kdT + 128 * 40;
  u16* s_att = s_vT + 128 * 40;
  u16* s_S = s_att + 32 * 40;
  float* s_dec = (float*)(s_S + 128 * 136);
  float* s_part = s_dec + 128;
  int* s_u = (int*)(s_part + 512);
  int* counter = (int*)(p.ws + WS_CNT);
  const u16* qg = (const u16*)(p.ws + WS_B(0));
  const u16* vg = (const u16*)(p.ws + WS_B(1));
  const _Float16* lfg = (const _Float16*)(p.ws + WS_B(3));
  u16* og = (u16*)(p.ws + WS_B(5));
  const int tid = threadIdx.x, lane = tid & 63, w = tid >> 6, fr = lane & 15, fq = lane >> 4;
  const int kk = tid & 127, th = tid >> 7;
  const int ti = w >> 2, vi = w & 3;
  const int wk = w & 3, wv = w >> 2;
  while (true) {
    if (tid == 0) *s_u = atomicAdd(counter, 1);
    __syncthreads();
    const int u = *s_u;
    __syncthreads();
    if (u >= 576) break;
    int b, rem, start, N, sample;
    if (u < 64) { sample = 1; b = u >> 4; rem = u & 15; start = NPROMPT + b * 1024; N = 1024; }
    else { sample = 0; b = (u - 64) >> 4; rem = (u - 64) & 15; start = b * 256; N = 256; }
    const int h = rem >> 1, d = rem & 1;
    const int nc = N >> 5;
    f32x4 S[2][4];
#pragma unroll
    for (int mi = 0; mi < 2; ++mi)
#pragma unroll
      for (int ni = 0; ni < 4; ++ni) {
        f32x4 s4 = f32x4{0.f, 0.f, 0.f, 0.f};
        if (sample) {
          const float* s0 = p.in[2] + ((size_t)((b * 2 + d) * 8 + h)) * 16384;
#pragma unroll
          for (int j = 0; j < 4; ++j) s4[j] = s0[(wk * 32 + mi * 16 + fq * 4 + j) * 128 + wv * 64 + ni * 16 + fr];
        }
        S[mi][ni] = s4;
        *(uint2*)&s_S[(wv * 64 + ni * 16 + fr) * 136 + wk * 32 + mi * 16 + fq * 4] = pack4(s4[0], s4[1], s4[2], s4[3]);
      }
    _Float16 lfraw[8]; u16 qraw[8]; uint4 vraw;
#define GLA_LOAD(cc) do { _Pragma("unroll") for (int i = 0; i < 8; ++i) { const int tt = (cc) * 32 + th * 8 + i; const size_t tok = start + (d ? (N - 1 - tt) : tt); \
      lfraw[i] = lfg[tok * 2048 + d * 1024 + h * 128 + kk]; qraw[i] = qg[tok * 1024 + h * 128 + kk]; } \
      { const int tt = (cc) * 32 + (tid >> 4); const size_t tok = start + (d ? (N - 1 - tt) : tt); vraw = *(const uint4*)&vg[tok * 1024 + h * 128 + (tid & 15) * 8]; } } while (0)
    GLA_LOAD(0);
    for (int c = 0; c < nc; ++c) {
      {
        float lfv[8], qv[8];
#pragma unroll
        for (int i = 0; i < 8; ++i) { lfv[i] = (float)lfraw[i]; qv[i] = bf2f(qraw[i]); }
        const uint4 vv = vraw;
        if (c + 1 < nc) GLA_LOAD(c + 1);
        float run = 0;
        float cs[8];
#pragma unroll
        for (int i = 0; i < 8; ++i) { run += lfv[i]; cs[i] = run; }
        s_part[th * 128 + kk] = run;
        {
          const int s = tid >> 4, v8 = (tid & 15) * 8;
          const unsigned vw[4] = {vv.x, vv.y, vv.z, vv.w};
#pragma unroll
          for (int i = 0; i < 4; ++i) { s_vT[(v8 + 2 * i) * 40 + s] = (u16)(vw[i] & 0xffff); s_vT[(v8 + 2 * i + 1) * 40 + s] = (u16)(vw[i] >> 16); }
        }
        __syncthreads();
        const float p0 = s_part[kk], p1 = s_part[128 + kk], p2 = s_part[256 + kk], p3 = s_part[384 + kk];
        const float off = (th > 0 ? p0 : 0.f) + (th > 1 ? p1 : 0.f) + (th > 2 ? p2 : 0.f);
        const float ref = p0 + p1, total = p0 + p1 + p2 + p3;
        unsigned kd[4];
        const float eref = __builtin_amdgcn_exp2f(ref), etr = __builtin_amdgcn_exp2f(total - ref);
#pragma unroll
        for (int i = 0; i < 8; ++i) {
          const int t = th * 8 + i;
          const float cum = off + cs[i];
          const float kf = 1.0f - __builtin_amdgcn_exp2f(lfv[i]);
          const float e1 = __builtin_amdgcn_exp2f(cum - ref), e2 = __builtin_amdgcn_rcpf(e1);
          const float qe = qv[i] * e1, ke = kf * e2;
          s_qrel[t * 136 + kk] = f2bf(qe);
          s_krel[t * 136 + kk] = f2bf(ke);
          s_qcum[t * 136 + kk] = f2bf(qe * eref);
          const u16 kdv = f2bf(ke * etr);
          if (i & 1) kd[i >> 1] |= ((unsigned)kdv) << 16; else kd[i >> 1] = kdv;
        }
        *(uint4*)&s_kdT[kk * 40 + th * 8] = make_uint4(kd[0], kd[1], kd[2], kd[3]);
        if (th == 0) s_dec[kk] = eref * etr;
      }
      __syncthreads();
      f32x4 oacc[2] = {f32x4{0.f, 0.f, 0.f, 0.f}, f32x4{0.f, 0.f, 0.f, 0.f}};
      {
        f32x4 att = f32x4{0.f, 0.f, 0.f, 0.f};
        const int ati = w >> 1, asi = w & 1;
#pragma unroll
        for (int ks = 0; ks < 4; ++ks) {
          if (w < 4) {
            bf16x8 a = *(const bf16x8*)&s_qrel[(ati * 16 + fr) * 136 + ks * 32 + fq * 8];
            bf16x8 bb = *(const bf16x8*)&s_krel[(asi * 16 + fr) * 136 + ks * 32 + fq * 8];
            att = __builtin_amdgcn_mfma_f32_16x16x32_bf16(a, bb, att, 0, 0, 0);
          }
          bf16x8 a2 = *(const bf16x8*)&s_qcum[(ti * 16 + fr) * 136 + ks * 32 + fq * 8];
#pragma unroll
          for (int e = 0; e < 2; ++e) {
            bf16x8 b2 = *(const bf16x8*)&s_S[((vi * 2 + e) * 16 + fr) * 136 + ks * 32 + fq * 8];
            oacc[e] = __builtin_amdgcn_mfma_f32_16x16x32_bf16(b2, a2, oacc[e], 0, 0, 0);
          }
        }
        if (w < 4) {
#pragma unroll
          for (int j = 0; j < 4; ++j) {
            const int t = ati * 16 + fq * 4 + j, s = asi * 16 + fr;
            s_att[t * 40 + s] = (s <= t) ? f2bf(att[j]) : (u16)0;
          }
        }
      }
      __syncthreads();
      {
        bf16x8 a = *(const bf16x8*)&s_att[(ti * 16 + fr) * 40 + fq * 8];
        const int tt = c * 32 + ti * 16 + fr;
        const size_t tok = start + (d ? (N - 1 - tt) : tt);
#pragma unroll
        for (int e = 0; e < 2; ++e) {
          bf16x8 bb = *(const bf16x8*)&s_vT[((vi * 2 + e) * 16 + fr) * 40 + fq * 8];
          oacc[e] = __builtin_amdgcn_mfma_f32_16x16x32_bf16(bb, a, oacc[e], 0, 0, 0);
          *(uint2*)&og[((size_t)d * TOK + tok) * 1024 + h * 128 + (vi * 2 + e) * 16 + fq * 4] = pack4(oacc[e][0], oacc[e][1], oacc[e][2], oacc[e][3]);
        }
        bf16x8 vf[4];
#pragma unroll
        for (int ni = 0; ni < 4; ++ni) vf[ni] = *(const bf16x8*)&s_vT[(wv * 64 + ni * 16 + fr) * 40 + fq * 8];
#pragma unroll
        for (int mi = 0; mi < 2; ++mi) {
          bf16x8 kf = *(const bf16x8*)&s_kdT[(wk * 32 + mi * 16 + fr) * 40 + fq * 8];
          f32x4 dc = *(const f32x4*)&s_dec[wk * 32 + mi * 16 + fq * 4];
#pragma unroll
          for (int ni = 0; ni < 4; ++ni) {
            f32x4 s4 = S[mi][ni];
#pragma unroll
            for (int j = 0; j < 4; ++j) s4[j] *= dc[j];
            s4 = __builtin_amdgcn_mfma_f32_16x16x32_bf16(kf, vf[ni], s4, 0, 0, 0);
            S[mi][ni] = s4;
            *(uint2*)&s_S[(wv * 64 + ni * 16 + fr) * 136 + wk * 32 + mi * 16 + fq * 4] = pack4(s4[0], s4[1], s4[2], s4[3]);
          }
        }
      }
      __syncthreads();
    }
    if (!sample) {
      float* so = p.out + OUT_HG + ((size_t)((b * 2 + d) * 8 + h)) * 16384;
#pragma unroll
      for (int mi = 0; mi < 2; ++mi)
#pragma unroll
        for (int ni = 0; ni < 4; ++ni)
#pragma unroll
          for (int j = 0; j < 4; ++j) so[(wk * 32 + mi * 16 + fq * 4 + j) * 128 + wv * 64 + ni * 16 + fr] = S[mi][ni][j];
    }
  }
#undef GLA_LOAD
}

__device__ __forceinline__ void phase_hg_post(const Params& p, int bid, int nb) {
  const u16* og = (const u16*)(p.ws + WS_B(5));
  const u16* sg = (const u16*)(p.ws + WS_B(2));
  u16* a = (u16*)(p.ws + WS_B(0));
  const float* ng = p.in[14];
  const int lane = threadIdx.x & 63, wave = threadIdx.x >> 6;
  float ngv[16];
#pragma unroll
  for (int k = 0; k < 4; ++k) { const f32x4 t = *(const f32x4*)&ng[lane * 16 + 4 * k]; ngv[4 * k] = t[0]; ngv[4 * k + 1] = t[1]; ngv[4 * k + 2] = t[2]; ngv[4 * k + 3] = t[3]; }
  for (int row0 = (bid * NW + wave) * 2; row0 < TOK; row0 += nb * NW * 2) {
    uint4 f[2][2], bw[2][2], sv[2][2];
#pragma unroll
    for (int r = 0; r < 2; ++r)
#pragma unroll
      for (int hh = 0; hh < 2; ++hh) {
        const size_t base = (size_t)(row0 + r) * 1024 + lane * 16 + hh * 8;
        f[r][hh] = *(const uint4*)&og[base];
        bw[r][hh] = *(const uint4*)&og[(size_t)TOK * 1024 + base];
        sv[r][hh] = *(const uint4*)&sg[base];
      }
#pragma unroll
    for (int r = 0; r < 2; ++r) {
      float o[16];
      float ss = 0;
#pragma unroll
      for (int hh = 0; hh < 2; ++hh) {
        const unsigned fa[4] = {f[r][hh].x, f[r][hh].y, f[r][hh].z, f[r][hh].w}, ba[4] = {bw[r][hh].x, bw[r][hh].y, bw[r][hh].z, bw[r][hh].w};
#pragma unroll
        for (int i = 0; i < 4; ++i) {
          o[hh * 8 + 2 * i] = lo16(fa[i]) + lo16(ba[i]);
          o[hh * 8 + 2 * i + 1] = hi16(fa[i]) + hi16(ba[i]);
        }
      }
#pragma unroll
      for (int i = 0; i < 16; ++i) ss += o[i] * o[i];
      ss += __shfl_xor(ss, 1); ss += __shfl_xor(ss, 2); ss += __shfl_xor(ss, 4);
      const float rs = rsqrtf(ss * (1.0f / 128.0f) + 1e-6f);
#pragma unroll
      for (int hh = 0; hh < 2; ++hh) {
        const unsigned sa[4] = {sv[r][hh].x, sv[r][hh].y, sv[r][hh].z, sv[r][hh].w};
        unsigned rr[4];
#pragma unroll
        for (int i = 0; i < 4; ++i)
          rr[i] = pack2(o[hh * 8 + 2 * i] * rs * ngv[hh * 8 + 2 * i] * siluf_(lo16(sa[i])), o[hh * 8 + 2 * i + 1] * rs * ngv[hh * 8 + 2 * i + 1] * siluf_(hi16(sa[i])));
        *(uint4*)&a[(size_t)(row0 + r) * 1024 + lane * 16 + hh * 8] = make_uint4(rr[0], rr[1], rr[2], rr[3]);
      }
    }
  }
}

__device__ __forceinline__ void seq_pos(int tok, int& n, int& L) {
  if (tok < NPROMPT) { n = tok & 255; L = 256; } else { n = (tok - NPROMPT) & 1023; L = 1024; }
}
__device__ __forceinline__ void phase_sc_conv(const Params& p, int bid, int nb) {
  const u16* pb = (const u16*)(p.ws + WS_B(0));
  const u16* sb = (const u16*)(p.ws + WS_B(1));
  u16* a = (u16*)(p.ws + WS_B(2));
  const float* cw = p.in[17]; const float* cbias = p.in[18];
  const size_t total = (size_t)TOK * 128;
  const size_t i0 = (size_t)bid * NT + threadIdx.x;
  const int c = ((int)i0 & 127) * 8;
  float w0[8], w1[8], w2[8], wb[8];
#pragma unroll
  for (int k = 0; k < 2; ++k) {
    const f32x4 t0 = *(const f32x4*)&cw[c + 4 * k], t1 = *(const f32x4*)&cw[1024 + c + 4 * k], t2 = *(const f32x4*)&cw[2048 + c + 4 * k], tb = *(const f32x4*)&cbias[c + 4 * k];
#pragma unroll
    for (int j = 0; j < 4; ++j) { w0[4 * k + j] = t0[j]; w1[4 * k + j] = t1[j]; w2[4 * k + j] = t2[j]; wb[4 * k + j] = tb[j]; }
  }
  const uint4 z = make_uint4(0, 0, 0, 0);
  for (size_t i = i0; i < total / 4; i += (size_t)nb * NT) {
    const int tok = (int)(i >> 7) * 4;
    int n, L; seq_pos(tok, n, L);
    const size_t base = (size_t)tok * 1024 + c;
    uint4 q[6], sv[4];
    q[0] = n > 0 ? *(const uint4*)&pb[base - 1024] : z;
#pragma unroll
    for (int t = 0; t < 4; ++t) { q[1 + t] = *(const uint4*)&pb[base + t * 1024]; sv[t] = *(const uint4*)&sb[base + t * 1024]; }
    q[5] = n + 4 < L ? *(const uint4*)&pb[base + 4096] : z;
#pragma unroll
    for (int t = 0; t < 4; ++t) {
      const unsigned am[4] = {q[t].x, q[t].y, q[t].z, q[t].w}, a0[4] = {q[t + 1].x, q[t + 1].y, q[t + 1].z, q[t + 1].w};
      const unsigned ap[4] = {q[t + 2].x, q[t + 2].y, q[t + 2].z, q[t + 2].w}, as[4] = {sv[t].x, sv[t].y, sv[t].z, sv[t].w};
      unsigned r[4];
#pragma unroll
      for (int k = 0; k < 4; ++k) {
        float z0 = w0[2 * k] * lo16(am[k]) + w1[2 * k] * lo16(a0[k]) + w2[2 * k] * lo16(ap[k]) + wb[2 * k];
        float z1 = w0[2 * k + 1] * hi16(am[k]) + w1[2 * k + 1] * hi16(a0[k]) + w2[2 * k + 1] * hi16(ap[k]) + wb[2 * k + 1];
        r[k] = pack2(lo16(as[k]) * z0, hi16(as[k]) * z1);
      }
      *(uint4*)&a[base + t * 1024] = make_uint4(r[0], r[1], r[2], r[3]);
    }
  }
}
__device__ __forceinline__ void phase_rg_conv(const Params& p, int bid, int nb) {
  const u16* ub = (const u16*)(p.ws + WS_B(0));
  u16* uc = (u16*)(p.ws + WS_B(2));
  const float* cw = p.in[21]; const float* cbias = p.in[22];
  const size_t total = (size_t)TOK * 128;
  const size_t i0 = (size_t)bid * NT + threadIdx.x;
  const int c = ((int)i0 & 127) * 8;
  float w0[8], w1[8], w2[8], w3[8], wb[8];
#pragma unroll
  for (int k = 0; k < 2; ++k) {
    const f32x4 t0 = *(const f32x4*)&cw[c + 4 * k], t1 = *(const f32x4*)&cw[1024 + c + 4 * k], t2 = *(const f32x4*)&cw[2048 + c + 4 * k], t3 = *(const f32x4*)&cw[3072 + c + 4 * k], tb = *(const f32x4*)&cbias[c + 4 * k];
#pragma unroll
    for (int j = 0; j < 4; ++j) { w0[4 * k + j] = t0[j]; w1[4 * k + j] = t1[j]; w2[4 * k + j] = t2[j]; w3[4 * k + j] = t3[j]; wb[4 * k + j] = tb[j]; }
  }
  const uint4 z = make_uint4(0, 0, 0, 0);
  for (size_t i = i0; i < total / 4; i += (size_t)nb * NT) {
    const int tok = (int)(i >> 7) * 4;
    int n, L; seq_pos(tok, n, L);
    const size_t base = (size_t)tok * 1024 + c;
    uint4 q[7];
    q[0] = n > 1 ? *(const uint4*)&ub[base - 2048] : z;
    q[1] = n > 0 ? *(const uint4*)&ub[base - 1024] : z;
#pragma unroll
    for (int t = 0; t < 4; ++t) q[2 + t] = *(const uint4*)&ub[base + t * 1024];
    q[6] = n + 4 < L ? *(const uint4*)&ub[base + 4096] : z;
#pragma unroll
    for (int t = 0; t < 4; ++t) {
      const unsigned a0[4] = {q[t].x, q[t].y, q[t].z, q[t].w}, a1[4] = {q[t + 1].x, q[t + 1].y, q[t + 1].z, q[t + 1].w};
      const unsigned a2[4] = {q[t + 2].x, q[t + 2].y, q[t + 2].z, q[t + 2].w}, a3[4] = {q[t + 3].x, q[t + 3].y, q[t + 3].z, q[t + 3].w};
      unsigned r[4];
#pragma unroll
      for (int k = 0; k < 4; ++k) {
        float z0 = w0[2 * k] * lo16(a0[k]) + w1[2 * k] * lo16(a1[k]) + w2[2 * k] * lo16(a2[k]) + w3[2 * k] * lo16(a3[k]) + wb[2 * k];
        float z1 = w0[2 * k + 1] * hi16(a0[k]) + w1[2 * k + 1] * hi16(a1[k]) + w2[2 * k + 1] * hi16(a2[k]) + w3[2 * k + 1] * hi16(a3[k]) + wb[2 * k + 1];
        r[k] = pack2(z0, z1);
      }
      *(uint4*)&uc[((size_t)(c >> 6) * TOK + tok + t) * 64 + (c & 63)] = make_uint4(r[0], r[1], r[2], r[3]);
    }
  }
}

__device__ __forceinline__ void phase_rg_scan(const Params& p, unsigned char* smem_raw, int bid, int nb) {
  float* sA = (float*)smem_raw;
  float* sB = sA + 2048;
  const u16* rb = (const u16*)(p.ws + WS_B(3));
  const u16* ib = (const u16*)(p.ws + WS_B(5));
  const u16* uc = (const u16*)(p.ws + WS_B(2));
  const u16* sg = (const u16*)(p.ws + WS_B(1));
  u16* hfw = (u16*)(p.ws + WS_H);
  u16* yp = (u16*)(p.ws + WS_B(0));
  const int tid = threadIdx.x;
  for (int u = bid; u < 768; u += nb) {
    int sample, b, c, seg, nseg, start, chs, slot;
    if (u < 256) {
      const int xq = u & 7, yq = u >> 3, gid = (yq >> 2) * 8 + xq, sub = yq & 3;
      sample = 1; b = gid >> 4; slot = (tid & 3) * 4; c = (gid & 15) * 64 + sub * 16 + slot; seg = tid >> 2; nseg = 128; start = NPROMPT + b * 1024; chs = 16; }
    else { sample = 0; b = (u - 256) >> 4; slot = (tid & 15) * 4; c = ((u - 256) & 15) * 64 + slot; seg = tid >> 4; nseg = 32; start = b * 256; chs = 64; }
    const int L = nseg * 8;
#pragma unroll 1
    for (int d = 0; d < 2; ++d) {
      const f32x4 lam = *(const f32x4*)&p.in[25][d * 1024 + c];
      float cl[4];
#pragma unroll
      for (int j = 0; j < 4; ++j) cl[j] = 8.0f * 1.4426950408889634f * log1pf(__expf(-lam[j]))    ;
      const u16* rp = rb + (size_t)d * TOK * 1024;
      const u16* ip = ib + (size_t)d * TOK * 1024;
      const int tok0 = start + (d ? L - 1 - seg * 8 : seg * 8);
      const size_t o0 = (size_t)tok0 * 1024 + c;
      const long ostep = d ? -1024 : 1024;
      const size_t g0 = ((size_t)(c >> 6) * TOK + tok0) * 64 + (c & 63);
      const long gstep = d ? -64 : 64;
      uint2 rr[8], ii[8], uu[8];
#pragma unroll
      for (int s8 = 0; s8 < 8; ++s8) { rr[s8] = *(const uint2*)&rp[g0 + s8 * gstep]; ii[s8] = *(const uint2*)&ip[g0 + s8 * gstep]; uu[s8] = *(const uint2*)&uc[g0 + s8 * gstep]; }
      uint2 hf[8], sgv[8];
      if (d == 1) {
#pragma unroll
        for (int s8 = 0; s8 < 8; ++s8) { hf[s8] = *(const uint2*)&hfw[g0 + s8 * gstep]; sgv[s8] = *(const uint2*)&sg[g0 + s8 * gstep]; }
      }
      float av[8][4], xv[8][4];
      float A[4] = {1.f, 1.f, 1.f, 1.f}, B[4] = {0.f, 0.f, 0.f, 0.f};
#pragma unroll
      for (int s8 = 0; s8 < 8; ++s8) {
        const float r4[4] = {lo16(rr[s8].x), hi16(rr[s8].x), lo16(rr[s8].y), hi16(rr[s8].y)};
        const float i4[4] = {lo16(ii[s8].x), hi16(ii[s8].x), lo16(ii[s8].y), hi16(ii[s8].y)};
        const float u4[4] = {lo16(uu[s8].x), hi16(uu[s8].x), lo16(uu[s8].y), hi16(uu[s8].y)};
#pragma unroll
        for (int j = 0; j < 4; ++j) {
          const float la = -cl[j] * r4[j];
          const float a = __builtin_amdgcn_exp2f(la);
          const float xin = __builtin_amdgcn_sqrtf(fmaxf(1.0f - __builtin_amdgcn_exp2f(2.0f * la), 0.f)) * (i4[j] * u4[j]);
          av[s8][j] = a; xv[s8][j] = xin;
          A[j] *= a; B[j] = a * B[j] + xin;
        }
      }
      *(f32x4*)&sA[seg * chs + slot] = f32x4{A[0], A[1], A[2], A[3]};
      *(f32x4*)&sB[seg * chs + slot] = f32x4{B[0], B[1], B[2], B[3]};
      for (int k = 1; k < nseg; k <<= 1) {
        __syncthreads();
        f32x4 pa = f32x4{1.f, 1.f, 1.f, 1.f}, pb2 = f32x4{0.f, 0.f, 0.f, 0.f};
        if (seg >= k) { pa = *(const f32x4*)&sA[(seg - k) * chs + slot]; pb2 = *(const f32x4*)&sB[(seg - k) * chs + slot]; }
        __syncthreads();
        if (seg >= k) {
#pragma unroll
          for (int j = 0; j < 4; ++j) { B[j] = A[j] * pb2[j] + B[j]; A[j] = A[j] * pa[j]; }
          *(f32x4*)&sA[seg * chs + slot] = f32x4{A[0], A[1], A[2], A[3]};
          *(f32x4*)&sB[seg * chs + slot] = f32x4{B[0], B[1], B[2], B[3]};
        }
      }
      __syncthreads();
      float h[4];
      {
        f32x4 h0v = f32x4{0.f, 0.f, 0.f, 0.f};
        if (sample) h0v = *(const f32x4*)&p.in[3][(b * 2 + d) * 1024 + c];
        if (seg > 0) {
          const f32x4 pa = *(const f32x4*)&sA[(seg - 1) * chs + slot], pb2 = *(const f32x4*)&sB[(seg - 1) * chs + slot];
#pragma unroll
          for (int j = 0; j < 4; ++j) h[j] = pa[j] * h0v[j] + pb2[j];
        } else {
#pragma unroll
          for (int j = 0; j < 4; ++j) h[j] = h0v[j];
        }
      }
#pragma unroll
      for (int s8 = 0; s8 < 8; ++s8) {
#pragma unroll
        for (int j = 0; j < 4; ++j) h[j] = av[s8][j] * h[j] + xv[s8][j];
        const size_t o = o0 + s8 * ostep;
        if (d == 0) *(uint2*)&hfw[g0 + s8 * gstep] = pack4(h[0], h[1], h[2], h[3]);
        else *(uint2*)&yp[g0 + s8 * gstep] = pack4((lo16(hf[s8].x) + h[0]) * lo16(sgv[s8].x), (hi16(hf[s8].x) + h[1]) * hi16(sgv[s8].x),
                                     (lo16(hf[s8].y) + h[2]) * lo16(sgv[s8].y), (hi16(hf[s8].y) + h[3]) * hi16(sgv[s8].y));
      }
      if (!sample && seg == nseg - 1) *(f32x4*)&p.out[OUT_RG + (b * 2 + d) * 1024 + c] = f32x4{h[0], h[1], h[2], h[3]};
      __syncthreads();
    }
  }
}

__device__ __forceinline__ void phase_mla_norm(const Params& p, int bid, int nb) {
  u16* cq = (u16*)(p.ws + WS3_CQ);
  u16* ckvall = (u16*)(p.ws + WS3_CKVALL);
  const float* ckvraw = (const float*)(p.ws + WS3_CKVRAW);
  const float* kperaw = (const float*)(p.ws + WS3_KPERAW);
  u16* Kb = (u16*)(p.ws + WS3_K);
  const float* qn = p.in[28]; const float* kvn = p.in[29];
  const int lane = threadIdx.x & 63, wave = threadIdx.x >> 6;
  float qnv[6];
#pragma unroll
  for (int i = 0; i < 3; ++i) { qnv[2 * i] = qn[(i * 64 + lane) * 2]; qnv[2 * i + 1] = qn[(i * 64 + lane) * 2 + 1]; }
  const f32x4 g4 = *(const f32x4*)&kvn[lane * 4];
  unsigned cvn[3] = {0u, 0u, 0u}; f32x4 kvnx = f32x4{0.f, 0.f, 0.f, 0.f}; float vnx = 0.f;
  {
    const int r0 = bid * NW + wave;
    if (r0 < TOK) {
#pragma unroll
      for (int i = 0; i < 3; ++i) cvn[i] = ((const unsigned*)&cq[(size_t)r0 * 384])[i * 64 + lane];
      kvnx = *(const f32x4*)&ckvraw[(size_t)r0 * 256 + lane * 4]; vnx = kperaw[(size_t)r0 * 32 + (lane & 31)];
    }
  }
  for (int row = bid * NW + wave; row < TOK + 2048; row += nb * NW) {
    if (row < TOK) {
      const int tok = row;
      const bool sample = tok >= NPROMPT;
      unsigned cv[3] = {cvn[0], cvn[1], cvn[2]}; const f32x4 kv = kvnx; float v = vnx;
      {
        const int rn = row + nb * NW;
        if (rn < TOK) {
#pragma unroll
          for (int i = 0; i < 3; ++i) cvn[i] = ((const unsigned*)&cq[(size_t)rn * 384])[i * 64 + lane];
          kvnx = *(const f32x4*)&ckvraw[(size_t)rn * 256 + lane * 4]; vnx = kperaw[(size_t)rn * 32 + (lane & 31)];
        }
      }
      const int bs = (tok - NPROMPT) >> 10, n = (tok - NPROMPT) & 1023;
      const size_t kvrow = sample ? (size_t)(NPROMPT + bs * 1536 + 512 + n) : (size_t)tok;
      unsigned* cqr = (unsigned*)&cq[(size_t)tok * 384];
      float ss = 0;
#pragma unroll
      for (int i = 0; i < 3; ++i) { float a = lo16(cv[i]), b2 = hi16(cv[i]); ss += a * a + b2 * b2; }
      const float rsq = rsqrtf(wave_sum(ss) * (1.0f / 384.0f) + 1e-6f);
#pragma unroll
      for (int i = 0; i < 3; ++i) {
        cqr[i * 64 + lane] = pack2(lo16(cv[i]) * rsq * qnv[2 * i], hi16(cv[i]) * rsq * qnv[2 * i + 1]);
      }
      const float rsk = rsqrtf(wave_sum(kv[0] * kv[0] + kv[1] * kv[1] + kv[2] * kv[2] + kv[3] * kv[3]) * (1.0f / 256.0f) + 1e-6f);
      f32x4 o4;
#pragma unroll
      for (int j = 0; j < 4; ++j) o4[j] = kv[j] * rsk * g4[j];
      *(uint2*)&ckvall[kvrow * 256 + lane * 4] = pack4(o4[0], o4[1], o4[2], o4[3]);
      if (!sample) *(f32x4*)&p.out[OUT_CKV + (size_t)tok * 256 + lane * 4] = o4;
      if (!sample) { if (lane < 32) p.out[OUT_KPE + (size_t)tok * 32 + lane] = v; }
      else {
        const float partner = __shfl_xor(v, 8);
        const int i16 = lane & 15;
        const float pos = (lane & 16) ? (float)(n & 63) : (float)(n >> 6);
        float sn, cs; rope_sincos(pos, i16 & 7, sn, cs);
        v = (i16 < 8) ? (v * cs - partner * sn) : (partner * sn + v * cs);
      }
      const u16 vb = f2bf(v);
#pragma unroll
      for (int i = 0; i < 8; ++i) Kb[(kvrow * 16 + (lane >> 5) + 2 * i) * 96 + 64 + (lane & 31)] = vb;
    } else {
      const int r = row - TOK, bs = r >> 9, j = r & 511;
      const size_t kvrow = (size_t)(NPROMPT + bs * 1536 + j);
      f32x4 kv = *(const f32x4*)&p.in[4][(size_t)r * 256 + lane * 4];
      *(uint2*)&ckvall[kvrow * 256 + lane * 4] = pack4(kv[0], kv[1], kv[2], kv[3]);
      const u16 vb = f2bf(p.in[5][(size_t)r * 32 + (lane & 31)]);
#pragma unroll
      for (int i = 0; i < 8; ++i) Kb[(kvrow * 16 + (lane >> 5) + 2 * i) * 96 + 64 + (lane & 31)] = vb;
    }
  }
}

__device__ __forceinline__ void phase_attn(const Params& p, unsigned char* smem_raw, int bid, int nb) {
  u16* sK = (u16*)smem_raw;
  u16* sV = sK + 128 * 104;
  const u16* qg = (const u16*)(p.ws + WS3_Q);
  const u16* Kg = (const u16*)(p.ws + WS3_K);
  const u16* Vg = (const u16*)(p.ws + WS3_VT);
  const u16* sg = (const u16*)(p.ws + WS3_SG);
  u16* ao = (u16*)(p.ws + WS_H);
  const int tid = threadIdx.x, lane = tid & 63, w = tid >> 6, fr = lane & 15, fq = lane >> 4;
  for (int u = bid; u < 1536; u += nb) {
    int tok0, kvbase, nkeys, h;
    if (u < 512) { const int b = u >> 7, r = u & 127; h = r >> 3; const int qb = r & 7; tok0 = NPROMPT + b * 1024 + qb * 128; kvbase = NPROMPT + b * 1536; nkeys = 1536; }
    else { const int uu = u - 512; const int b = uu >> 5, r = uu & 31; h = r >> 1; const int qb = r & 1; tok0 = b * 256 + qb * 128; kvbase = b * 256; nkeys = 256; }
    const int tokq = tok0 + w * 16 + fr;
    bf16x8 qf[3];
#pragma unroll
    for (int ks = 0; ks < 3; ++ks) qf[ks] = *(const bf16x8*)&qg[(size_t)tokq * 1536 + h * 96 + ks * 32 + fq * 8];
    if (u < 512) {
      const int npos = (tokq - NPROMPT) & 1023;
      const float pos = (fq & 2) ? (float)(npos & 63) : (float)(npos >> 6);
      uint4 raw = *(uint4*)&qf[2];
      unsigned rw[4] = {raw.x, raw.y, raw.z, raw.w};
#pragma unroll
      for (int i = 0; i < 4; ++i) {
        float v0 = lo16(rw[i]), v1 = hi16(rw[i]);
        const float p0 = __shfl_xor(v0, 16), p1 = __shfl_xor(v1, 16);
        float sn0, cs0, sn1, cs1;
        rope_sincos(pos, 2 * i, sn0, cs0); rope_sincos(pos, 2 * i + 1, sn1, cs1);
        v0 = (fq & 1) ? (p0 * sn0 + v0 * cs0) : (v0 * cs0 - p0 * sn0);
        v1 = (fq & 1) ? (p1 * sn1 + v1 * cs1) : (v1 * cs1 - p1 * sn1);
        rw[i] = pack2(v0, v1);
      }
      raw = make_uint4(rw[0], rw[1], rw[2], rw[3]);
      qf[2] = *(bf16x8*)&raw;
    }
    float m = -1e30f, l = 0.f;
    f32x4 oacc[4];
#pragma unroll
    for (int i = 0; i < 4; ++i) oacc[i] = f32x4{0.f, 0.f, 0.f, 0.f};
    const int kk0 = tid / 12, kc0 = tid - kk0 * 12;
    const int kk1 = (tid + NT) / 12, kc1 = (tid + NT) - kk1 * 12;
    const int kk2_ = (tid + 2 * NT) / 12, kc2 = (tid + 2 * NT) - kk2_ * 12;
    const u16* Kp0 = &Kg[((size_t)(kvbase + kk0) * 16 + h) * 96 + kc0 * 8];
    const u16* Kp1 = &Kg[((size_t)(kvbase + kk1) * 16 + h) * 96 + kc1 * 8];
    const u16* Kp2 = &Kg[((size_t)(kvbase + kk2_) * 16 + h) * 96 + kc2 * 8];
    const int vd0 = tid >> 4, vc0 = tid & 15, vd1 = (tid + NT) >> 4;
    const u16* Vp0 = &Vg[(size_t)(h * 64 + vd0) * KVROWS + kvbase + vc0 * 8];
    const u16* Vp1 = &Vg[(size_t)(h * 64 + vd1) * KVROWS + kvbase + vc0 * 8];
    uint4 kr0 = *(const uint4*)Kp0, kr1 = *(const uint4*)Kp1, kr2 = *(const uint4*)Kp2, vr0 = *(const uint4*)Vp0, vr1 = *(const uint4*)Vp1;
    const int ntile2 = nkeys >> 7;
    for (int kt = 0; kt < ntile2; ++kt) {
      __syncthreads();
      *(uint4*)&sK[kk0 * 104 + kc0 * 8] = kr0; *(uint4*)&sK[kk1 * 104 + kc1 * 8] = kr1; *(uint4*)&sK[kk2_ * 104 + kc2 * 8] = kr2;
      *(uint4*)&sV[vd0 * 136 + vc0 * 8] = vr0; *(uint4*)&sV[vd1 * 136 + vc0 * 8] = vr1;
      if (kt + 1 < ntile2) {
        const size_t ko = (size_t)(kt + 1) * 128 * 1536; const int vo = (kt + 1) * 128;
        kr0 = *(const uint4*)(Kp0 + ko); kr1 = *(const uint4*)(Kp1 + ko); kr2 = *(const uint4*)(Kp2 + ko);
        vr0 = *(const uint4*)(Vp0 + vo); vr1 = *(const uint4*)(Vp1 + vo);
      }
      __syncthreads();
      f32x4 sacc[8];
#pragma unroll
      for (int ni = 0; ni < 8; ++ni) {
        sacc[ni] = f32x4{0.f, 0.f, 0.f, 0.f};
#pragma unroll
        for (int ks = 0; ks < 3; ++ks) {
          bf16x8 kf = *(const bf16x8*)&sK[(ni * 16 + fr) * 104 + ks * 32 + fq * 8];
          sacc[ni] = __builtin_amdgcn_mfma_f32_16x16x32_bf16(kf, qf[ks], sacc[ni], 0, 0, 0);
        }
      }
      float mx = -1e30f;
#pragma unroll
      for (int ni = 0; ni < 8; ++ni)
#pragma unroll
        for (int j = 0; j < 4; ++j) mx = fmaxf(mx, sacc[ni][j]);
      mx = fmaxf(mx, __shfl_xor(mx, 16));
      mx = fmaxf(mx, __shfl_xor(mx, 32));
      const float mnew = fmaxf(m, mx);
      const float alpha = __builtin_amdgcn_exp2f(m - mnew);
      m = mnew;
      float ls = 0.f;
#pragma unroll
      for (int ni = 0; ni < 8; ++ni)
#pragma unroll
        for (int j = 0; j < 4; ++j) { float e = __builtin_amdgcn_exp2f(sacc[ni][j] - mnew); sacc[ni][j] = e; ls += e; }
      l = l * alpha + ls;
      bf16x8 pf[4];
#pragma unroll
      for (int kk2 = 0; kk2 < 4; ++kk2) {
        uint2 lo = pack4(sacc[2 * kk2][0], sacc[2 * kk2][1], sacc[2 * kk2][2], sacc[2 * kk2][3]);
        uint2 hi = pack4(sacc[2 * kk2 + 1][0], sacc[2 * kk2 + 1][1], sacc[2 * kk2 + 1][2], sacc[2 * kk2 + 1][3]);
        uint4 pk = make_uint4(lo.x, lo.y, hi.x, hi.y);
        pf[kk2] = *(bf16x8*)&pk;
      }
#pragma unroll
      for (int di = 0; di < 4; ++di) {
#pragma unroll
        for (int j = 0; j < 4; ++j) oacc[di][j] *= alpha;
#pragma unroll
        for (int kk2 = 0; kk2 < 4; ++kk2) {
          uint2 v0 = *(const uint2*)&sV[(di * 16 + fr) * 136 + kk2 * 32 + fq * 4];
          uint2 v1 = *(const uint2*)&sV[(di * 16 + fr) * 136 + kk2 * 32 + 16 + fq * 4];
          uint4 vk = make_uint4(v0.x, v0.y, v1.x, v1.y);
          oacc[di] = __builtin_amdgcn_mfma_f32_16x16x32_bf16(*(bf16x8*)&vk, pf[kk2], oacc[di], 0, 0, 0);
        }
      }
    }
    l += __shfl_xor(l, 16);
    l += __shfl_xor(l, 32);
    const float inv = 1.0f / l;
#pragma unroll
    for (int di = 0; di < 4; ++di) {
      const size_t o = (size_t)tokq * 1024 + h * 64 + di * 16 + fq * 4;
      uint2 s = *(const uint2*)&sg[o];
      *(uint2*)&ao[o] = pack4(oacc[di][0] * inv * siluf_(lo16(s.x)), oacc[di][1] * inv * siluf_(hi16(s.x)), oacc[di][2] * inv * siluf_(lo16(s.y)), oacc[di][3] * inv * siluf_(hi16(s.y)));
    }
  }
}

#define XB_TMO      128
#define XB_XCNT(j)  (256  + 64 * (j))
#define XB_XSUB(j)  (1280 + 64 * (j))
#define XB_XGEN(j)  (2304 + 64 * (j))
#define XB_TOP      3328
#define XB_TOPGEN   3392
#define XCD_BAR_WORDS 3456
#define XB_SPIN_CAP (1u << 22)
__device__ __forceinline__ unsigned xb_ld(unsigned* p)              { return __hip_atomic_load(p, __ATOMIC_RELAXED, __HIP_MEMORY_SCOPE_AGENT); }
__device__ __forceinline__ unsigned xb_add(unsigned* p, unsigned v) { return __hip_atomic_fetch_add(p, v, __ATOMIC_RELAXED, __HIP_MEMORY_SCOPE_AGENT); }
__device__ __forceinline__ unsigned xb_xcc_id() { return (unsigned)__builtin_amdgcn_s_getreg((3 << 11) | 20) & 0xFu; }
#define XB_SPIN(cond, bar) do { unsigned _sp = 0; while (cond) { __builtin_amdgcn_s_sleep(1); \
    if ((++_sp & 255u) == 0u) { if (xb_ld(&(bar)[XB_TMO])) break; if (_sp > XB_SPIN_CAP) { atomicAdd(&(bar)[XB_TMO], 1u); break; } } } } while (0)
struct XcdBarrier { unsigned* bar; unsigned x; volatile LAS unsigned* st; };
__device__ __forceinline__ XcdBarrier xcd_barrier_post(unsigned* bar, volatile LAS unsigned* st) {
  XcdBarrier b; b.bar = bar; b.x = xb_xcc_id(); b.st = st;
  if (threadIdx.x == 0) (void)xb_add(&bar[XB_XCNT(b.x)], 1u);
  return b;
}
__device__ __forceinline__ void xcd_barrier_complete(unsigned* bar, unsigned x, unsigned& nloc, unsigned& nx) {
  const unsigned G = gridDim.x * gridDim.y * gridDim.z;
  unsigned sum, cnt, mine, sp = 0u;
  for (;;) {
    sum = 0u; cnt = 0u; mine = 0u;
#pragma unroll
    for (unsigned j = 0; j < 16; ++j) { const unsigned c = xb_ld(&bar[XB_XCNT(j)]); sum += c; cnt += (c > 0u) ? 1u : 0u; mine = (j == x) ? c : mine; }
    if (sum == G) break;
    __builtin_amdgcn_s_sleep(1);
    if ((++sp & 255u) == 0u) { if (xb_ld(&bar[XB_TMO])) break; if (sp > XB_SPIN_CAP) { atomicAdd(&bar[XB_TMO], 1u); break; } }
  }
  nloc = mine > 0u ? mine : 1u; nx = cnt > 0u ? cnt : 1u;
}
__device__ __forceinline__ void xcd_barrier(const XcdBarrier& b) {
  asm volatile("s_waitcnt vmcnt(0)" ::: "memory");
  __syncthreads();
  if (threadIdx.x == 0) {
    unsigned* bar = b.bar;
    __builtin_amdgcn_s_waitcnt(0);
    unsigned nloc = b.st[0], nx = b.st[1];
    if (nloc == 0u) { xcd_barrier_complete(bar, b.x, nloc, nx); b.st[0] = nloc; b.st[1] = nx; }
    const unsigned old = xb_add(&bar[XB_XSUB(b.x)], 1u);
    const unsigned gen = old / nloc;
    if (old + 1u == (gen + 1u) * nloc) {
      __builtin_amdgcn_fence(__ATOMIC_RELEASE, "agent");
      asm volatile("s_waitcnt vmcnt(0)" ::: "memory");
      const unsigned og = xb_add(&bar[XB_TOP], 1u);
      const unsigned tg = og / nx;
      if (og + 1u == (tg + 1u) * nx) xb_add(&bar[XB_TOPGEN], 1u);
      else XB_SPIN(xb_ld(&bar[XB_TOPGEN]) == tg, bar);
      __builtin_amdgcn_fence(__ATOMIC_ACQUIRE, "agent");
      xb_add(&bar[XB_XGEN(b.x)], 1u);
      asm volatile("s_waitcnt vmcnt(0)" ::: "memory");
    } else {
      XB_SPIN(xb_ld(&bar[XB_XGEN(b.x)]) == gen, bar);
      __builtin_amdgcn_fence(__ATOMIC_ACQUIRE, "agent");
      asm volatile("s_waitcnt vmcnt(0)" ::: "memory");
    }
  }
  __syncthreads();
}

#define GEMM_LDS 131072
#define DYN_LDS (GEMM_LDS + 16)
#define WS_BAR (WS_CNT + 4096ull)

#define RUN_GEMM(Aptr, LDA, Bptr, MM, NN, KK, GATE, EPI, CID) RUN_GEMM_G(Aptr, LDA, Bptr, MM, NN, KK, GATE, EPI, nb, CID)
#define RUN_GEMM_G(Aptr, LDA, Bptr, MM, NN, KK, GATE, EPI, GG, CID) RUN_GEMM_X(Aptr, LDA, (size_t)128, (size_t)0, Bptr, MM, NN, KK, GATE, EPI, GG, CID)
#define GM_KSTEP ((size_t)TOK * 128)
#define RUN_GEMM_X(Aptr, LDA, KSA, GST, Bptr, MM, NN, KK, GATE, EPI, GG, CID) do { pg8::Gemm g_{(const u16*)(Aptr), (const u16*)(Bptr), MM, NN, KK, LDA, GATE, p.flags, KSA, GST}; \
    pg8::StaticOrder S_; S_.init(MM, NN, GG, CID); pg8::gemm_phase((LAS unsigned char*)smem_raw, g_, S_, EPI); } while (0)

__global__ void __launch_bounds__(NT, 2) mega(Params p) {
  extern __shared__ __attribute__((aligned(16))) unsigned char smem_raw[];
  const int bid = blockIdx.x, nb = gridDim.x;
  unsigned char* ws = p.ws;
  const float* mod = (const float*)(ws + WS_MOD);
  volatile LAS unsigned* xst = (volatile LAS unsigned*)((LAS unsigned char*)smem_raw + GEMM_LDS);
  XcdBarrier xb;
  if (p.phase_hi - p.phase_lo > 1) {
    if (threadIdx.x == 0) { xst[0] = 0u; xst[1] = 0u; }
    __syncthreads();
    xb = xcd_barrier_post((unsigned*)(ws + WS_BAR), xst);
  }
#define PH_BEGIN(n) if ((PHMASK & (1u << n)) && p.phase_lo <= n && n < p.phase_hi) { const int ph = n;
#define PH_FIN if (ph + 1 < p.phase_hi) { if (p.phase_lo < 0) cg::this_grid().sync(); else xcd_barrier(xb); } }
  PH_BEGIN(0) phase_prologue(p, smem_raw, bid, nb); PH_FIN
  PH_BEGIN(1) phase_h0(p, bid, nb); PH_FIN
  PH_BEGIN(2) {
    EpiHgIn e{(u16*)(ws + WS_B(0)), (u16*)(ws + WS_B(1)), (u16*)(ws + WS_B(2)), (_Float16*)(ws + WS_B(3)), (const float*)(ws + WS_LB)};
    RUN_GEMM(ws + WS_H, 1024, ws + WS_W_HG_IN, TOK, 5120, 1024, 0, e, bid);
  } PH_FIN
  PH_BEGIN(3) phase_gla(p, smem_raw); PH_FIN
  PH_BEGIN(4) phase_hg_post(p, bid, nb); PH_FIN
  PH_BEGIN(5) {
    EpiResLn<false, true> e{p.in[0], p.in[1], (const u16*)nullptr, p.out, (u16*)(ws + WS_XB), mod + 0 * 15360 + 2048, p.in[10] + 0 * 1024, p.in[11] + 0 * 1024, mod + 1 * 15360, (u16*)(ws + WS_H),
               (unsigned long long*)(ws + WS_SLOT) + 0 * 49152, (unsigned*)(ws + WS_CNT + 256) + 0 * 48};
    RUN_GEMM(ws + WS_B(0), 1024, ws + WS_W_HG_OUT, TOK, 1024, 1024, 0, e, bid);
    wconv_idle(p, smem_raw, bid, nb, 1536, 2816);
  } PH_FIN
  PH_BEGIN(7) {
    EpiScIn e{(u16*)(ws + WS_B(0)), (u16*)(ws + WS_B(1))};
    RUN_GEMM(ws + WS_H, 1024, ws + WS_W_SC_IN, TOK, 4096, 1024, 0, e, bid);
  } PH_FIN
  PH_BEGIN(8) phase_sc_conv(p, bid, nb); PH_FIN
  PH_BEGIN(9) {
    EpiResLn<true, true> e{p.out, p.out, (const u16*)(ws + WS_XB), p.out, (u16*)(ws + WS_XB), mod + 1 * 15360 + 2048, p.in[10] + 1 * 1024, p.in[11] + 1 * 1024, mod + 2 * 15360, (u16*)(ws + WS_H),
               (unsigned long long*)(ws + WS_SLOT) + 1 * 49152, (unsigned*)(ws + WS_CNT + 256) + 1 * 48};
    RUN_GEMM(ws + WS_B(2), 1024, ws + WS_W_SC_OUT, TOK, 1024, 1024, 0, e, bid);
    wconv_idle(p, smem_raw, bid, nb, 2816, 3840);
  } PH_FIN
  PH_BEGIN(11) {
    EpiRgIn e{(u16*)(ws + WS_B(0)), (u16*)(ws + WS_B(1))};
    RUN_GEMM(ws + WS_H, 1024, ws + WS_W_RG_IN, TOK, 2048, 1024, 0, e, bid);
  } PH_FIN
  PH_BEGIN(12) phase_rg_conv(p, bid, nb); PH_FIN
  PH_BEGIN(13) {
    EpiRgGate e{(u16*)(ws + WS_B(3)), (u16*)(ws + WS_B(5)), p.in[24]};
    RUN_GEMM_X(ws + WS_B(2), 64, GM_KSTEP, 4 * GM_KSTEP, ws + WS_W_RG_GATE, TOK, 4096, 256, 1, e, nb, bid);
  } PH_FIN
  PH_BEGIN(14) phase_rg_scan(p, smem_raw, bid, nb); PH_FIN
  PH_BEGIN(15) {
    EpiResLn<true, true> e{p.out, p.out, (const u16*)(ws + WS_XB), p.out, (u16*)(ws + WS_XB), mod + 2 * 15360 + 2048, p.in[10] + 2 * 1024, p.in[11] + 2 * 1024, mod + 3 * 15360, (u16*)(ws + WS_H),
               (unsigned long long*)(ws + WS_SLOT) + 2 * 49152, (unsigned*)(ws + WS_CNT + 256) + 2 * 48};
    RUN_GEMM_X(ws + WS_B(0), 64, GM_KSTEP, (size_t)0, ws + WS_W_RG_OUT, TOK, 1024, 1024, 0, e, nb, bid);
    wconv_idle(p, smem_raw, bid, nb, 3840, 4800);
  } PH_FIN
  PH_BEGIN(17) {
    EpiMlaIn e{(u16*)(ws + WS3_CQ), (float*)(ws + WS3_CKVRAW), (float*)(ws + WS3_KPERAW), (u16*)(ws + WS3_SG)};
    RUN_GEMM(ws + WS_H, 1024, ws + WS_W_MLA_IN, TOK, 768, 1024, 0, e, bid);
  } PH_FIN
  PH_BEGIN(18) phase_mla_norm(p, bid, nb); PH_FIN
  PH_BEGIN(19) {
    const bool bal = (nb == 256);
    EpiSg eg{(u16*)(ws + WS3_SG)};
    RUN_GEMM(ws + WS_H, 1024, ws + WS_W_MLA_IN + 672 * 1024 * 2, TOK, 1024, 1024, 0, eg, bid);
    EpiQ eq{(u16*)(ws + WS3_Q)};
    RUN_GEMM(ws + WS3_CQ, 384, ws + WS_W_QB, TOK, 1536, 384, 0, eq, bal ? ((bid + 64) & 255) : bid);
    EpiK ek{(u16*)(ws + WS3_K)};
    RUN_GEMM(ws + WS3_CKVALL, 256, ws + WS_W_KVB, KVROWS, 1024, 256, 0, ek, bal ? ((bid + 32) & 255) : bid);
    EpiV ev{(u16*)(ws + WS3_VT)};
    RUN_GEMM_G(ws + WS_W_KVB + 1024 * 256 * 2, 256, ws + WS3_CKVALL, 1024, KVROWS, 256, 0, ev, bal ? 64 : nb, bal ? (bid >= 192 ? bid - 192 : (1 << 20)) : bid);
  } PH_FIN
  PH_BEGIN(20) phase_attn(p, smem_raw, bid, nb); PH_FIN
  PH_BEGIN(21) {
    EpiResLn<true, false> e{p.out, p.out, (const u16*)(ws + WS_XB), p.out, (u16*)nullptr, mod + 3 * 15360 + 2048, p.in[10] + 3 * 1024, p.in[11] + 3 * 1024, mod + 3 * 15360, (u16*)nullptr,
               (unsigned long long*)(ws + WS_SLOT) + 3 * 49152, (unsigned*)(ws + WS_CNT + 256) + 3 * 48};
    RUN_GEMM(ws + WS_H, 1024, ws + WS_W_MLA_OUT, TOK, 1024, 1024, 0, e, bid);
  } PH_FIN
}

extern "C" void kernel_launch(void* const* d_in, const int* in_sizes, int n_in, void* d_out, int out_size, void* d_ws, size_t ws_size,
                              hipStream_t stream) {
  static int grid_blocks = 0;
  if (!grid_blocks) {
    int dev = 0, cus = 0, per_cu = 0;
    (void)hipGetDevice(&dev);
    (void)hipDeviceGetAttribute(&cus, hipDeviceAttributeMultiprocessorCount, dev);
    (void)hipFuncSetAttribute((const void*)mega, hipFuncAttributeMaxDynamicSharedMemorySize, DYN_LDS);
    (void)hipOccupancyMaxActiveBlocksPerMultiprocessor(&per_cu, (const void*)mega, NT, DYN_LDS);
    if (per_cu < 1) per_cu = 1;
    if (per_cu > 1) per_cu = 1;
    grid_blocks = cus * per_cu;
  }
  Params p{};
  for (int i = 0; i < 33; ++i) p.in[i] = (const float*)d_in[i];
  p.out = (float*)d_out;
  p.ws = (unsigned char*)d_ws;
#if MULTI_LAUNCH
  (void)hipMemsetAsync((unsigned char*)d_ws + WS_CNT, 0, 4096 + XCD_BAR_WORDS * 4, stream);
  for (int ph = 0; ph < NPHASES; ++ph) {
    p.phase_lo = ph; p.phase_hi = ph + 1;
    hipLaunchKernelGGL(mega, dim3(grid_blocks), dim3(NT), DYN_LDS, stream, p);
#ifdef PROBE_MASK
    if ((PROBE_MASK >> ph) & 1) { p.flags = PROBE_FLAGS; for (int r = 0; r < 2; ++r) {
      if (ph == 3) (void)hipMemsetAsync((unsigned char*)d_ws + WS_CNT, 0, 64, stream);
      hipLaunchKernelGGL(mega, dim3(grid_blocks), dim3(NT), DYN_LDS, stream, p);
    } p.flags = 0; }
#endif
  }
#else
  p.phase_lo = 0; p.phase_hi = NPHASES;
  (void)hipMemsetAsync((unsigned char*)d_ws + WS_CNT, 0, 4096 + XCD_BAR_WORDS * 4, stream);
  void* args[] = {&p};
  hipError_t e = hipLaunchCooperativeKernel((const void*)mega, dim3(grid_blocks), dim3(NT), args, DYN_LDS, stream);
  if (e != hipSuccess) fprintf(stderr, "cooperative launch failed: %s (grid %d)\n", hipGetErrorString(e), grid_blocks);
#endif
}
```

```cpp
#include <hip/hip_runtime.h>
#include <hip/hip_cooperative_groups.h>
#include <cstdio>
namespace cg = cooperative_groups;

#ifndef MULTI_LAUNCH
#define MULTI_LAUNCH 0
#endif

typedef unsigned short u16;
using bf16x8 = __attribute__((ext_vector_type(8))) short;
using f32x4 = __attribute__((ext_vector_type(4))) float;
typedef _Float16 h4 __attribute__((ext_vector_type(4)));

#define TOK 12288
#define NPROMPT 8192
#define KVROWS 14336
#define NPHASES 23
#ifndef PHMASK
#define PHMASK 0x7fffff
#endif
#define DN_ALPHA 1.6817928305074290f

#define WS_W_HG_IN 0ull
#define WS_W_HG_OUT (WS_W_HG_IN + 10485760ull)
#define WS_W_SC_IN (WS_W_HG_OUT + 2097152ull)
#define WS_W_SC_OUT (WS_W_SC_IN + 8388608ull)
#define WS_W_RG_IN (WS_W_SC_OUT + 2097152ull)
#define WS_W_RG_GATE (WS_W_RG_IN + 4194304ull)
#define WS_W_RG_OUT (WS_W_RG_GATE + 2097152ull)
#define WS_W_MLA_IN (WS_W_RG_OUT + 2097152ull)
#define WS_W_QB (WS_W_MLA_IN + 3670016ull)
#define WS_W_KVB (WS_W_QB + 1179648ull)
#define WS_W_MLA_OUT (WS_W_KVB + 1048576ull)
#define WS_MOD (WS_W_MLA_OUT + 2097152ull)
#define WS_LB (WS_MOD + 245760ull)
#define WS_CNT (WS_LB + 8192ull)
#define WS_R (WS_CNT + 4096ull + 16384ull)
#define BSZ 25165824ull
#define WS_H (WS_R)
#define WS_B(i) (WS_R + BSZ * (1 + (i)))
#define WS_SLOT (WS_R + 201326592ull)
#define WS_XB (WS_SLOT + 1572864ull)
#define WS3_CQ (WS_R + 25165824ull)
#define WS3_CKVALL (WS_R + 34603008ull)
#define WS3_CKVRAW (WS_R + 41943040ull)
#define WS3_KPERAW (WS_R + 54525952ull)
#define WS3_SG (WS_R + 56098816ull)
#define WS3_Q (WS_R + 81264640ull)
#define WS3_K (WS_R + 119013376ull)
#define WS3_VT (WS_R + 163053568ull)

#define OUT_HG 12582912
#define OUT_RG 20971520
#define OUT_CKV 21037056
#define OUT_KPE 23134208

struct Params {
  const float* in[33];
  float* out;
  unsigned char* ws;
  int phase_lo, phase_hi, flags, pad_;
};

__device__ __forceinline__ u16 f2bf(float f) { __bf16 r = (__bf16)f; return *(u16*)&r; }
__device__ __forceinline__ float bf2f(u16 h) { return __uint_as_float(((unsigned)h) << 16); }
typedef float f2v_ __attribute__((ext_vector_type(2)));
typedef __bf16 b2v_ __attribute__((ext_vector_type(2)));
__device__ __forceinline__ unsigned pack2(float a, float b) { f2v_ f = {a, b}; b2v_ r = __builtin_convertvector(f, b2v_); return *(unsigned*)&r; }
__device__ __forceinline__ uint2 pack4(float a, float b, float c, float d) { return make_uint2(pack2(a, b), pack2(c, d)); }
__device__ __forceinline__ float lo16(unsigned u) { return __uint_as_float(u << 16); }
__device__ __forceinline__ float hi16(unsigned u) { return __uint_as_float(u & 0xffff0000u); }
__device__ __forceinline__ float sigmoidf_(float x) { return __builtin_amdgcn_rcpf(1.0f + __expf(-x)); }
__device__ __forceinline__ float siluf_(float x) { return x * __builtin_amdgcn_rcpf(1.0f + __expf(-x)); }
__device__ __forceinline__ int cond_of(int tok) { return tok < NPROMPT ? 0 : 1 + ((tok - NPROMPT) >> 10); }
__device__ __forceinline__ float wave_sum(float v) {
#pragma unroll
  for (int o = 32; o > 0; o >>= 1) v += __shfl_xor(v, o);
  return v;
}
__device__ __forceinline__ void rope_sincos(float pos, int fi, float& sn, float& cs) {
  float inv = exp2f(-(float)fi * 1.6609640474436813f);
  float ang = pos * inv;
  float k = rintf(ang * 0.15915494309189535f);
  float r = fmaf(-k, 6.2831854820251465f, ang);
  r = fmaf(-k, -1.7484555e-7f, r);
  sn = __sinf(r); cs = __cosf(r);
}

#define NT 512
#define NW 8
#define LAS __attribute__((address_space(3)))

namespace pg8 {
constexpr int BM = 256, BK = 64, HALF = 128, HTB = HALF * BK * 2, STAGE_BYTES = 8 * HTB, NXCD = 8, WGM = 8;
__device__ __forceinline__ int lds_byte(int r, int c) { const int st = (r >> 4) * 2 + (c >> 5), rr = r & 15, cc = c & 31, ob = rr * 64 + cc * 2; return st * 1024 + (ob ^ (((ob >> 9) & 1) << 5)); }
__device__ __forceinline__ void stage_rc(int b, int& R, int& C) { const int st = b / 1024, sb = b % 1024, swz = sb ^ (((sb >> 9) & 1) << 5); R = (st >> 1) * 16 + swz / 64; C = (st & 1) * 32 + (swz % 64) / 2; }
struct Unit { int pm, pn; };
struct Gemm { const u16* A; const u16* Bt; int M, N, K, lda, gate, noepi; size_t kstepA, gstride; };
struct StaticOrder {
  int nM, nN, nwg, G, c, ubeg, uend;
  __device__ void init(int M, int N, int G_, int c_) { nM = M / BM; nN = N / BM; nwg = nM * nN; G = G_; c = c_; ubeg = 0; uend = nwg; }
  __device__ bool next(int i, Unit& u) const {
    const long L = (long)ubeg + (long)i * G + c; if (L >= uend) return false;
    int wgid = (int)L; { const int q = nwg / NXCD, r = nwg % NXCD, xcd = wgid % NXCD, off = wgid / NXCD; wgid = (xcd < r ? xcd * (q + 1) : r * (q + 1) + (xcd - r) * q) + off; }
    const int nig = WGM * nN, gid = wgid / nig, fm = gid * WGM, gsz = (nM - fm) < WGM ? (nM - fm) : WGM;
    u.pm = fm + ((wgid % nig) % gsz); u.pn = (wgid % nig) / gsz; return true;
  }
};
template <class Epi>
__device__ __forceinline__ void gemm_phase(LAS unsigned char* lds, const Gemm g, const StaticOrder& S, const Epi& E) {
  const int tid = threadIdx.x, wid = __builtin_amdgcn_readfirstlane(tid >> 6), lane = tid & 63, wr = wid >> 2, wc = wid & 3, fr = lane & 15, fq = lane >> 4;
  const int K = g.K, nt = K / BK;
  unsigned voffA[2], voffB[2];
#pragma unroll
  for (int i = 0; i < 2; ++i) { int R, C; stage_rc(tid * 16 + i * 8192, R, C); voffA[i] = (unsigned)(R * g.lda + C) * 2u; voffB[i] = (unsigned)(R * K + C) * 2u; }
  const size_t kstep = (size_t)(BK * 2);
  const size_t kstepA = g.kstepA;
  const size_t hstepA = (size_t)HALF * g.lda * 2, hstepB = (size_t)HALF * K * 2;
  const size_t tstepA = 2 * hstepA, tstepB = 2 * hstepB;
  const unsigned ldsw = (unsigned)wid * 1024u;
  const int aoff = lds_byte(wr * 64 + fr, fq * 8), boff = lds_byte(wc * 32 + fr, fq * 8);
#define PG8_AOFF(pn) (g.gate ? (size_t)(((pn) >> 1) & 3) * g.gstride : (size_t)0)
#define PG8_SA(b, h) (((b) * 2 + (h)) * HTB)
#define PG8_SB(b, h) ((4 + (b) * 2 + (h)) * HTB)
#define PG8_STAGE(bufoff, gbase, voff) do { _Pragma("unroll") for (int _i = 0; _i < 2; ++_i) \
    __builtin_amdgcn_global_load_lds((const unsigned*)((const char*)(gbase) + (voff)[_i]), (LAS unsigned*)(lds + (bufoff) + ldsw + _i * 8192), 16, 0, 0); } while (0)
#define PG8_LDA(dst, b, h) do { _Pragma("unroll") for (int m = 0; m < 4; ++m) _Pragma("unroll") for (int k = 0; k < 2; ++k) dst[m][k] = *(const LAS bf16x8*)(lds + PG8_SA(b, h) + aoff + m * 2048 + k * 1024); } while (0)
#define PG8_LDB(dst, b, h) do { _Pragma("unroll") for (int n = 0; n < 2; ++n) _Pragma("unroll") for (int k = 0; k < 2; ++k) dst[n][k] = *(const LAS bf16x8*)(lds + PG8_SB(b, h) + boff + n * 2048 + k * 1024); } while (0)
#define PG8_MMA(ai, bj, At, Bt) do { __builtin_amdgcn_s_setprio(1); _Pragma("unroll") for (int m = 0; m < 4; ++m) _Pragma("unroll") for (int n = 0; n < 2; ++n) _Pragma("unroll") for (int k = 0; k < 2; ++k) \
    acc[ai][bj][m][n] = __builtin_amdgcn_mfma_f32_16x16x32_bf16(Bt[n][k], At[m][k], acc[ai][bj][m][n], 0, 0, 0); __builtin_amdgcn_s_setprio(0); } while (0)
#define PG8_WAIT_V(n) asm volatile("s_waitcnt vmcnt(" #n ")" ::: "memory")
#define PG8_WAIT_L(n) asm volatile("s_waitcnt lgkmcnt(" #n ")" ::: "memory")
#define PG8_BAR __builtin_amdgcn_s_barrier()
#define PG8_SCHED __builtin_amdgcn_sched_barrier(0)
  Unit cur, nxt; int ui = 0;
  if (!S.next(0, cur)) return;
  f32x4 acc[2][2][4][2];
#pragma unroll
  for (int a = 0; a < 2; ++a)
#pragma unroll
    for (int b = 0; b < 2; ++b)
#pragma unroll
      for (int m = 0; m < 4; ++m)
#pragma unroll
        for (int n = 0; n < 2; ++n) acc[a][b][m][n] = (f32x4){0.f, 0.f, 0.f, 0.f};
  bf16x8 At[4][2], B0[2][2], B1[2][2];
  const char* cA = (const char*)g.A + (size_t)cur.pm * tstepA + PG8_AOFF(cur.pn); const char* cB = (const char*)g.Bt + (size_t)cur.pn * tstepB;
  PG8_STAGE(PG8_SB(0, 0), cB, voffB); PG8_STAGE(PG8_SA(0, 0), cA, voffA); PG8_STAGE(PG8_SB(0, 1), cB + hstepB, voffB); PG8_STAGE(PG8_SA(0, 1), cA + hstepA, voffA);
  if (wr == 1) PG8_BAR;
  PG8_WAIT_V(4); PG8_BAR;
  PG8_STAGE(PG8_SB(1, 0), cB + kstep, voffB); PG8_STAGE(PG8_SA(1, 0), cA + kstepA, voffA); PG8_STAGE(PG8_SB(1, 1), cB + hstepB + kstep, voffB);
  PG8_WAIT_V(6); PG8_BAR;
  for (;;) {
    const bool has_next = S.next(ui + 1, nxt);
    const char* nA = has_next ? (const char*)g.A + (size_t)nxt.pm * tstepA + PG8_AOFF(nxt.pn) : cA; const char* nB = has_next ? (const char*)g.Bt + (size_t)nxt.pn * tstepB : cB;
#pragma unroll 1
    for (int t = 0; t < nt; t += 2) {
      const bool last = (t == nt - 2);
      const char* a1 = cA + (size_t)(t + 1) * kstepA;
      const char* a2 = last ? nA : cA + (size_t)(t + 2) * kstepA; const char* b2 = last ? nB : cB + (size_t)(t + 2) * kstep;
      const char* a3 = a2 + kstepA; const char* b3 = b2 + kstep;
      PG8_LDB(B0, 0, 0); PG8_SCHED; PG8_LDA(At, 0, 0); PG8_STAGE(PG8_SA(1, 1), a1 + hstepA, voffA);
      PG8_WAIT_L(8); PG8_BAR; PG8_WAIT_L(0); PG8_MMA(0, 0, At, B0); PG8_BAR; PG8_SCHED;
      PG8_LDB(B1, 0, 1); PG8_STAGE(PG8_SB(0, 0), b2, voffB);
      PG8_BAR; PG8_WAIT_L(0); PG8_MMA(0, 1, At, B1); PG8_BAR;
      PG8_LDA(At, 0, 1); PG8_STAGE(PG8_SA(0, 0), a2, voffA);
      PG8_BAR; PG8_WAIT_L(0); PG8_MMA(1, 0, At, B0); PG8_BAR; PG8_SCHED;
      PG8_STAGE(PG8_SB(0, 1), b2 + hstepB, voffB);
      PG8_WAIT_V(6); PG8_BAR; PG8_MMA(1, 1, At, B1); PG8_BAR;
      PG8_LDB(B0, 1, 0); PG8_SCHED; PG8_LDA(At, 1, 0); PG8_STAGE(PG8_SA(0, 1), a2 + hstepA, voffA);
      PG8_WAIT_L(8); PG8_BAR; PG8_WAIT_L(0); PG8_MMA(0, 0, At, B0); PG8_BAR; PG8_SCHED;
      PG8_LDB(B1, 1, 1); PG8_STAGE(PG8_SB(1, 0), b3, voffB);
      PG8_BAR; PG8_WAIT_L(0); PG8_MMA(0, 1, At, B1); PG8_BAR;
      PG8_LDA(At, 1, 1); PG8_STAGE(PG8_SA(1, 0), a3, voffA);
      PG8_BAR; PG8_WAIT_L(0); PG8_MMA(1, 0, At, B0); PG8_BAR; PG8_SCHED;
      PG8_STAGE(PG8_SB(1, 1), b3 + hstepB, voffB);
      PG8_WAIT_V(6); PG8_BAR; PG8_MMA(1, 1, At, B1); PG8_BAR;
    }
    if constexpr (!Epi::AFTER_DRAIN) { if (!g.noepi) E(acc, cur, wr, wc, fr, fq); }
    if (!has_next) break;
#pragma unroll
    for (int a = 0; a < 2; ++a)
#pragma unroll
      for (int b = 0; b < 2; ++b)
#pragma unroll
        for (int m = 0; m < 4; ++m)
#pragma unroll
          for (int n = 0; n < 2; ++n) acc[a][b][m][n] = (f32x4){0.f, 0.f, 0.f, 0.f};
    cur = nxt; cA = nA; cB = nB; ++ui;
  }
  PG8_WAIT_V(0);
  if (wr == 0) PG8_BAR;
  PG8_BAR;
  if constexpr (Epi::AFTER_DRAIN) { if (!g.noepi) E.fused(acc, cur, wr, wc, fr, fq, lds); }
#undef PG8_AOFF
#undef PG8_SA
#undef PG8_SB
#undef PG8_STAGE
#undef PG8_LDA
#undef PG8_LDB
#undef PG8_MMA
#undef PG8_WAIT_V
#undef PG8_WAIT_L
#undef PG8_BAR
#undef PG8_SCHED
}
}
using pg8::Unit;
typedef const f32x4 (&AccRef)[2][2][4][2];

#define EPI_ROWS(...) _Pragma("unroll") for (int ai = 0; ai < 2; ++ai) _Pragma("unroll") for (int m = 0; m < 4; ++m) { const int row = u.pm * 256 + ai * 128 + wr * 64 + m * 16 + fr; __VA_ARGS__ }
#define EPI_COLS(...) _Pragma("unroll") for (int bj = 0; bj < 2; ++bj) _Pragma("unroll") for (int n = 0; n < 2; ++n) { const int cb = u.pn * 256 + bj * 128 + wc * 32 + n * 16; const f32x4 a = acc[ai][bj][m][n]; __VA_ARGS__ }

struct EpiHgIn {
  static constexpr bool AFTER_DRAIN = false;
  u16 *q, *v, *sg; _Float16* lf; const float* lb;
  __device__ __forceinline__ void operator()(AccRef acc, const Unit& u, int wr, int wc, int fr, int fq) const {
    const int region = u.pn >> 2;
    f32x4 l4[2][2];
    if (region == 1 || region == 2) {
#pragma unroll
      for (int bj = 0; bj < 2; ++bj)
#pragma unroll
        for (int n = 0; n < 2; ++n) l4[bj][n] = *(const f32x4*)&lb[(region - 1) * 1024 + ((u.pn * 256 + bj * 128 + wc * 32 + n * 16) & 1023) + fq * 4];
    }
    EPI_ROWS( EPI_COLS(
      const int c = (cb & 1023) + fq * 4;
      if (region == 0) {
        const float s = 0.08838834764831845f;
        *(uint2*)&q[(size_t)row * 1024 + c] = pack4(siluf_(a[0]) * s, siluf_(a[1]) * s, siluf_(a[2]) * s, siluf_(a[3]) * s);
      } else if (region <= 2) {
        const int d = region - 1;
        h4 o;
        _Pragma("unroll") for (int j = 0; j < 4; ++j) { float f = l4[bj][n][j] + (1.0f - l4[bj][n][j]) * sigmoidf_(a[j]); o[j] = (_Float16)__builtin_amdgcn_logf(f); }
        *(h4*)&lf[(size_t)row * 2048 + d * 1024 + c] = o;
      } else if (region == 3) {
        *(uint2*)&v[(size_t)row * 1024 + c] = pack4(a[0], a[1], a[2], a[3]);
      } else {
        *(uint2*)&sg[(size_t)row * 1024 + c] = pack4(a[0], a[1], a[2], a[3]);
      }
    ) )
  }
};

struct EpiRes {
  static constexpr bool AFTER_DRAIN = false;
  const float* xin_p; const float* xin_s; float* Y; const float* gate;
  __device__ __forceinline__ void operator()(AccRef acc, const Unit& u, int wr, int wc, int fr, int fq) const {
    EPI_ROWS(
      const float* xr = row < NPROMPT ? xin_p + (size_t)row * 1024 : xin_s + (size_t)(row - NPROMPT) * 1024;
      const float* g = gate + cond_of(row) * 3072;
      EPI_COLS(
        const int c = cb + fq * 4;
        f32x4 x = *(const f32x4*)&xr[c];
        f32x4 gg = *(const f32x4*)&g[c];
        f32x4 y;
        _Pragma("unroll") for (int j = 0; j < 4; ++j) y[j] = DN_ALPHA * x[j] + gg[j] * a[j];
        *(f32x4*)&Y[(size_t)row * 1024 + c] = y;
      ) )
  }
};

template <bool XIN_BF, bool XOUT_BF>
struct EpiResLn {
  static constexpr bool AFTER_DRAIN = true;
  const float* xin_p; const float* xin_s; const u16* xin_b; float* X; u16* XB; const float* gate; const float* lg; const float* lbias; const float* modn; u16* H;
  unsigned long long* slots; unsigned* cnt;
  __device__ __forceinline__ void fused(f32x4 (&acc)[2][2][4][2], const Unit& u, int wr, int wc, int fr, int fq, LAS unsigned char* lds) const {
    LAS float* part = (LAS float*)lds;
    LAS float* stat = part + 2048;
    const int tid = threadIdx.x;
    const int cnd = cond_of(u.pm * 256);
    f32x4 gv[2][2];
#pragma unroll
    for (int bj = 0; bj < 2; ++bj)
#pragma unroll
      for (int n = 0; n < 2; ++n) gv[bj][n] = *(const f32x4*)&gate[cnd * 3072 + u.pn * 256 + bj * 128 + wc * 32 + n * 16 + fq * 4];
#pragma unroll
    for (int ai = 0; ai < 2; ++ai)
#pragma unroll
      for (int m = 0; m < 4; ++m) {
        const int rl = ai * 128 + wr * 64 + m * 16 + fr;
        const int row = u.pm * 256 + rl;
        const float* xr = row < NPROMPT ? xin_p + (size_t)row * 1024 : xin_s + (size_t)(row - NPROMPT) * 1024;
        float s1 = 0.f, s2 = 0.f;
#pragma unroll
        for (int bj = 0; bj < 2; ++bj)
#pragma unroll
          for (int n = 0; n < 2; ++n) {
            const int c = u.pn * 256 + bj * 128 + wc * 32 + n * 16 + fq * 4;
            f32x4 x;
            if constexpr (XIN_BF) { const uint2 xb2 = *(const uint2*)&xin_b[(size_t)row * 1024 + c]; x = f32x4{lo16(xb2.x), hi16(xb2.x), lo16(xb2.y), hi16(xb2.y)}; }
            else x = *(const f32x4*)&xr[c];
            const f32x4 gg = gv[bj][n];
            f32x4 y;
#pragma unroll
            for (int j = 0; j < 4; ++j) { y[j] = DN_ALPHA * x[j] + gg[j] * acc[ai][bj][m][n][j]; s1 += y[j]; s2 += y[j] * y[j]; }
            acc[ai][bj][m][n] = y;
          }
        s1 += __shfl_xor(s1, 16); s1 += __shfl_xor(s1, 32);
        s2 += __shfl_xor(s2, 16); s2 += __shfl_xor(s2, 32);
        if (fq == 0) { part[(rl * 4 + wc) * 2] = s1; part[(rl * 4 + wc) * 2 + 1] = s2; }
      }
    __syncthreads();
    if (tid < 256) {
      float S1 = 0.f, S2 = 0.f;
#pragma unroll
      for (int w2 = 0; w2 < 4; ++w2) { S1 += part[(tid * 4 + w2) * 2]; S2 += part[(tid * 4 + w2) * 2 + 1]; }
      const unsigned long long v = (unsigned long long)__float_as_uint(S1) | ((unsigned long long)__float_as_uint(S2) << 32);
      __hip_atomic_store(&slots[(size_t)(u.pm * 4 + u.pn) * 256 + tid], v, __ATOMIC_RELAXED, __HIP_MEMORY_SCOPE_AGENT);
    }
    asm volatile("s_waitcnt vmcnt(0)" ::: "memory");
    __syncthreads();
    if (tid == 0) {
      __hip_atomic_fetch_add(&cnt[u.pm], 1u, __ATOMIC_RELAXED, __HIP_MEMORY_SCOPE_AGENT);
      unsigned sp = 0;
      while (__hip_atomic_load(&cnt[u.pm], __ATOMIC_RELAXED, __HIP_MEMORY_SCOPE_AGENT) < 4u) { __builtin_amdgcn_s_sleep(1); if (++sp > (1u << 24)) break; }
    }
    __syncthreads();
    if (tid < 256) {
      float T1 = 0.f, T2 = 0.f;
#pragma unroll
      for (int o = 0; o < 4; ++o) {
        const unsigned long long v = __hip_atomic_load(&slots[(size_t)(u.pm * 4 + o) * 256 + tid], __ATOMIC_RELAXED, __HIP_MEMORY_SCOPE_AGENT);
        T1 += __uint_as_float((unsigned)(v & 0xffffffffull)); T2 += __uint_as_float((unsigned)(v >> 32));
      }
      const float mu = T1 * (1.0f / 1024.0f);
      const float var = fmaxf(T2 * (1.0f / 1024.0f) - mu * mu, 0.f);
      stat[tid * 2] = mu; stat[tid * 2 + 1] = rsqrtf(var + 1e-5f);
    }
    __syncthreads();
#pragma unroll
    for (int bj = 0; bj < 2; ++bj) {
      f32x4 lgv[2], lbv[2], shv[2], scv[2];
#pragma unroll
      for (int n = 0; n < 2; ++n) {
        const int c = u.pn * 256 + bj * 128 + wc * 32 + n * 16 + fq * 4;
        lgv[n] = *(const f32x4*)&lg[c]; lbv[n] = *(const f32x4*)&lbias[c];
        shv[n] = *(const f32x4*)&modn[cnd * 3072 + c]; scv[n] = *(const f32x4*)&modn[cnd * 3072 + 1024 + c];
      }
#pragma unroll
      for (int ai = 0; ai < 2; ++ai)
#pragma unroll
        for (int m = 0; m < 4; ++m) {
          const int rl = ai * 128 + wr * 64 + m * 16 + fr;
          const int row = u.pm * 256 + rl;
          const float mu = stat[rl * 2], rs = stat[rl * 2 + 1];
#pragma unroll
          for (int n = 0; n < 2; ++n) {
            const int c = u.pn * 256 + bj * 128 + wc * 32 + n * 16 + fq * 4;
            const f32x4 y = acc[ai][bj][m][n];
            f32x4 xo;
#pragma unroll
            for (int j = 0; j < 4; ++j) xo[j] = (y[j] - mu) * rs * lgv[n][j] + lbv[n][j];
            if constexpr (XOUT_BF) *(uint2*)&XB[(size_t)row * 1024 + c] = pack4(xo[0], xo[1], xo[2], xo[3]);
            else *(f32x4*)&X[(size_t)row * 1024 + c] = xo;
            if (H) {
              *(uint2*)&H[(size_t)row * 1024 + c] = pack4(xo[0] * (1 + scv[n][0]) + shv[n][0], xo[1] * (1 + scv[n][1]) + shv[n][1], xo[2] * (1 + scv[n][2]) + shv[n][2], xo[3] * (1 + scv[n][3]) + shv[n][3]);
            }
          }
        }
    }
  }
};

struct EpiScIn {
  static constexpr bool AFTER_DRAIN = false;
  u16 *pb, *sb;
  __device__ __forceinline__ void operator()(AccRef acc, const Unit& u, int wr, int wc, int fr, int fq) const {
    const int c = u.pn * 64 + wc * 16 + fq * 4;
    EPI_ROWS(
      const f32x4 bg = acc[ai][0][m][0], cgv = acc[ai][0][m][1], v = acc[ai][1][m][0], g = acc[ai][1][m][1];
      *(uint2*)&pb[(size_t)row * 1024 + c] = pack4(cgv[0] * v[0], cgv[1] * v[1], cgv[2] * v[2], cgv[3] * v[3]);
      *(uint2*)&sb[(size_t)row * 1024 + c] = pack4(siluf_(g[0]) * bg[0], siluf_(g[1]) * bg[1], siluf_(g[2]) * bg[2], siluf_(g[3]) * bg[3]);
    )
  }
};

struct EpiRgIn {
  static constexpr bool AFTER_DRAIN = false;
  u16 *ub, *sg;
  __device__ __forceinline__ void operator()(AccRef acc, const Unit& u, int wr, int wc, int fr, int fq) const {
    const int region = u.pn >> 2;
    EPI_ROWS( EPI_COLS(
      const int c = (cb & 1023) + fq * 4;
      if (region == 0) *(uint2*)&ub[(size_t)row * 1024 + c] = pack4(a[0], a[1], a[2], a[3]);
      else *(uint2*)&sg[((size_t)(c >> 6) * TOK + row) * 64 + (c & 63)] = pack4(siluf_(a[0]), siluf_(a[1]), siluf_(a[2]), siluf_(a[3]));
    ) )
  }
};

struct EpiRgGate {
  static constexpr bool AFTER_DRAIN = false;
  u16 *rb, *ib; const float* bgate;
  __device__ __forceinline__ void operator()(AccRef acc, const Unit& u, int wr, int wc, int fr, int fq) const {
    const int mat = u.pn >> 1, d = mat >> 2, hd = mat & 3;
    f32x4 br[2], bi[2]; int ccs[2];
#pragma unroll
    for (int bj = 0; bj < 2; ++bj) {
      const int off = ((u.pn & 1) * 256 + bj * 128 + wc * 32);
      ccs[bj] = (off >> 5) * 16 + fq * 4;
      br[bj] = *(const f32x4*)&bgate[mat * 512 + ccs[bj]];
      bi[bj] = *(const f32x4*)&bgate[mat * 512 + 256 + ccs[bj]];
    }
    EPI_ROWS(
      _Pragma("unroll") for (int bj = 0; bj < 2; ++bj) {
        const f32x4 r = acc[ai][bj][m][0], ii = acc[ai][bj][m][1];
        const int cch = hd * 256 + ccs[bj];
        const size_t o = (size_t)d * TOK * 1024 + ((size_t)(cch >> 6) * TOK + row) * 64 + (cch & 63);
        *(uint2*)&rb[o] = pack4(sigmoidf_(r[0] + br[bj][0]), sigmoidf_(r[1] + br[bj][1]), sigmoidf_(r[2] + br[bj][2]), sigmoidf_(r[3] + br[bj][3]));
        *(uint2*)&ib[o] = pack4(sigmoidf_(ii[0] + bi[bj][0]), sigmoidf_(ii[1] + bi[bj][1]), sigmoidf_(ii[2] + bi[bj][2]), sigmoidf_(ii[3] + bi[bj][3]));
      } )
  }
};

struct EpiMlaIn {
  static constexpr bool AFTER_DRAIN = false;
  u16* cq; float* ckvraw; float* kperaw; u16* sg;
  __device__ __forceinline__ void operator()(AccRef acc, const Unit& u, int wr, int wc, int fr, int fq) const {
    EPI_ROWS( EPI_COLS(
      const int c = cb + fq * 4;
      if (cb < 384) *(uint2*)&cq[(size_t)row * 384 + c] = pack4(a[0], a[1], a[2], a[3]);
      else if (cb < 640) *(f32x4*)&ckvraw[(size_t)row * 256 + (c - 384)] = a;
      else if (cb < 672) *(f32x4*)&kperaw[(size_t)row * 32 + (c - 640)] = a;
    ) )
  }
};

struct EpiSg {
  static constexpr bool AFTER_DRAIN = false;
  u16* sg;
  __device__ __forceinline__ void operator()(AccRef acc, const Unit& u, int wr, int wc, int fr, int fq) const {
    EPI_ROWS( EPI_COLS(
      *(uint2*)&sg[(size_t)row * 1024 + cb + fq * 4] = pack4(a[0], a[1], a[2], a[3]);
    ) )
  }
};

struct EpiQ {
  static constexpr bool AFTER_DRAIN = false;
  u16* q;
  __device__ __forceinline__ void operator()(AccRef acc, const Unit& u, int wr, int wc, int fr, int fq) const {
    const float sc = 0.14724444500602648f;
    EPI_ROWS( EPI_COLS(
      *(uint2*)&q[(size_t)row * 1536 + cb + fq * 4] = pack4(a[0] * sc, a[1] * sc, a[2] * sc, a[3] * sc);
    ) )
  }
};

struct EpiK {
  static constexpr bool AFTER_DRAIN = false;
  u16* Kb;
  __device__ __forceinline__ void operator()(AccRef acc, const Unit& u, int wr, int wc, int fr, int fq) const {
    EPI_ROWS( EPI_COLS(
      const int h = cb >> 6, dd = (cb & 63) + fq * 4;
      *(uint2*)&Kb[((size_t)row * 16 + h) * 96 + dd] = pack4(a[0], a[1], a[2], a[3]);
    ) )
  }
};
struct EpiV {
  static constexpr bool AFTER_DRAIN = false;
  u16* Vt;
  __device__ __forceinline__ void operator()(AccRef acc, const Unit& u, int wr, int wc, int fr, int fq) const {
    EPI_ROWS( EPI_COLS(
      *(uint2*)&Vt[(size_t)row * KVROWS + cb + fq * 4] = pack4(a[0], a[1], a[2], a[3]);
    ) )
  }
};

__device__ __forceinline__ void wconv_tile(const float* __restrict__ src, int N, int K, u16* __restrict__ dst, int k0, int n0,
                                           int perm, int mat, float* tile) {
  const int tid = threadIdx.x;
  {
    const int r = tid >> 4, c4 = (tid & 15) * 4;
#pragma unroll
    for (int i = 0; i < 2; ++i) {
      const int k = r + i * 32;
      f32x4 v = f32x4{0.f, 0.f, 0.f, 0.f};
      if (n0 + c4 < N) v = *(const f32x4*)&src[(size_t)(k0 + k) * N + n0 + c4];
      tile[k * 65 + c4 + 0] = v[0]; tile[k * 65 + c4 + 1] = v[1]; tile[k * 65 + c4 + 2] = v[2]; tile[k * 65 + c4 + 3] = v[3];
    }
  }
  __syncthreads();
  {
    const int nl = tid >> 3, kq = (tid & 7) * 8;
    const int n = n0 + nl;
    int np = n;
    if (perm == 1) { const int part = n >> 10, c = n & 1023; np = (c >> 6) * 256 + (part >> 1) * 128 + ((c >> 4) & 3) * 32 + (part & 1) * 16 + (c & 15); }
    else if (perm == 2) { const int type = n >> 8, cc = n & 255; np = mat * 512 + (cc >> 4) * 32 + type * 16 + (cc & 15); }
    else if (perm == 3) { const int hh = n >> 7, dd = n & 127; np = (dd >= 64 ? 1024 : 0) + hh * 64 + (dd & 63); }
    if (n < N) {
      unsigned w[4];
#pragma unroll
      for (int i = 0; i < 4; ++i) w[i] = pack2(tile[(kq + 2 * i) * 65 + nl], tile[(kq + 2 * i + 1) * 65 + nl]);
      *(uint4*)&dst[(size_t)np * K + k0 + kq] = make_uint4(w[0], w[1], w[2], w[3]);
    }
  }
  __syncthreads();
}

__device__ __forceinline__ void wconv_item(const Params& p, int t, float* fs) {
  const float* src; u16* dst; int N, K, perm = 0, mat = 0, ntn;
  if (t < 1280) { src = p.in[12]; dst = (u16*)(p.ws + WS_W_HG_IN); N = 5120; K = 1024; }
  else if ((t -= 1280) < 256) { src = p.in[15]; dst = (u16*)(p.ws + WS_W_HG_OUT); N = 1024; K = 1024; }
  else if ((t -= 256) < 1024) { src = p.in[16]; dst = (u16*)(p.ws + WS_W_SC_IN); N = 4096; K = 1024; perm = 1; }
  else if ((t -= 1024) < 256) { src = p.in[19]; dst = (u16*)(p.ws + WS_W_SC_OUT); N = 1024; K = 1024; }
  else if ((t -= 256) < 512) { src = p.in[20]; dst = (u16*)(p.ws + WS_W_RG_IN); N = 2048; K = 1024; }
  else if ((t -= 512) < 256) { mat = t >> 5; t &= 31; src = p.in[23] + (size_t)mat * 256 * 512; dst = (u16*)(p.ws + WS_W_RG_GATE); N = 512; K = 256; perm = 2; }
  else if ((t -= 256) < 256) { src = p.in[26]; dst = (u16*)(p.ws + WS_W_RG_OUT); N = 1024; K = 1024; }
  else if ((t -= 256) < 432) { src = p.in[27]; dst = (u16*)(p.ws + WS_W_MLA_IN); N = 1696; K = 1024; }
  else if ((t -= 432) < 144) { src = p.in[30]; dst = (u16*)(p.ws + WS_W_QB); N = 1536; K = 384; }
  else if ((t -= 144) < 128) { src = p.in[31]; dst = (u16*)(p.ws + WS_W_KVB); N = 2048; K = 256; perm = 3; }
  else { t -= 128; src = p.in[32]; dst = (u16*)(p.ws + WS_W_MLA_OUT); N = 1024; K = 1024; }
  ntn = (N + 63) >> 6;
  const int kt = t / ntn, ntl = t - kt * ntn;
  wconv_tile(src, N, K, dst, kt * 64, ntl * 64, perm, mat, fs);
}
__device__ __forceinline__ void wconv_idle(const Params& p, unsigned char* smem_raw, int bid, int nb, int t0, int t1) {
  if (nb == 256 && bid >= 192) for (int t = t0 + (bid - 192); t < t1; t += 64) wconv_item(p, t, (float*)smem_raw);
}

__device__ __forceinline__ void phase_prologue(const Params& p, unsigned char* smem_raw, int bid, int nb) {
  float* fs = (float*)smem_raw;
  const int tid = threadIdx.x;
  const int NMOD = 192, NWT = (nb == 256) ? 1536 : 4800;
  for (int it = bid; it < NMOD + 1 + NWT; it += nb) {
    if (it < NMOD) {
      const int l = it / 48, n0 = (it % 48) * 64;
      float* scond = fs;
      float* sred = fs + 5120;
      for (int i = tid; i < 5120; i += NT) {
        const int ci = i >> 10, k = i & 1023;
        float cv = ci == 0 ? p.in[7][k] : p.in[6][(ci - 1) * 1024 + k];
        scond[i] = siluf_(cv);
      }
      __syncthreads();
      const int col = tid & 63, kg = tid >> 6;
      const float* w = p.in[8] + (size_t)l * 1024 * 3072 + n0 + col;
      float a0 = 0, a1 = 0, a2 = 0, a3 = 0, a4 = 0;
#pragma unroll 16
      for (int k = kg * 128; k < kg * 128 + 128; ++k) {
        float wv = w[(size_t)k * 3072];
        a0 += scond[k] * wv; a1 += scond[1024 + k] * wv; a2 += scond[2048 + k] * wv; a3 += scond[3072 + k] * wv; a4 += scond[4096 + k] * wv;
      }
      sred[(kg * 5 + 0) * 64 + col] = a0; sred[(kg * 5 + 1) * 64 + col] = a1; sred[(kg * 5 + 2) * 64 + col] = a2;
      sred[(kg * 5 + 3) * 64 + col] = a3; sred[(kg * 5 + 4) * 64 + col] = a4;
      __syncthreads();
      float* mod = (float*)(p.ws + WS_MOD);
      if (tid < 320) {
        const int ci = tid >> 6, cc = tid & 63;
        float s = 0;
#pragma unroll
        for (int g = 0; g < 8; ++g) s += sred[(g * 5 + ci) * 64 + cc];
        mod[(l * 5 + ci) * 3072 + n0 + cc] = s + p.in[9][l * 3072 + n0 + cc];
      }
      __syncthreads();
    } else if (it == NMOD) {
      float* lb = (float*)(p.ws + WS_LB);
      for (int i = tid; i < 2048; i += NT) {
        const int d = i >> 10, c = i & 1023;
        const float* lg = p.in[13] + d * 5 * 1024 + c;
        float m = lg[0];
        for (int j = 1; j < 5; ++j) m = fmaxf(m, lg[j * 1024]);
        float s = 0;
        for (int j = 0; j < 5; ++j) s += expf(lg[j * 1024] - m);
        lb[i] = expf(lg[0] - m) / s;
      }
      int* cnt = (int*)(p.ws + WS_CNT);
      if (tid < 16) cnt[tid] = 0;
    } else {
      wconv_item(p, it - NMOD - 1, fs);
    }
  }
}

__device__ __forceinline__ void phase_h0(const Params& p, int bid, int nb) {
  const float* mod = (const float*)(p.ws + WS_MOD);
  u16* H = (u16*)(p.ws + WS_H);
  const size_t total = (size_t)(TOK / 4) * 256;
  for (size_t i = (size_t)bid * NT + threadIdx.x; i < total; i += (size_t)nb * NT) {
    const int row = (int)(i >> 8) * 4, c = ((int)i & 255) * 4;
    const float* xr = row < NPROMPT ? p.in[0] + (size_t)row * 1024 : p.in[1] + (size_t)(row - NPROMPT) * 1024;
    const float* m = mod + cond_of(row) * 3072;
    f32x4 x[4];
#pragma unroll
    for (int t = 0; t < 4; ++t) x[t] = *(const f32x4*)&xr[t * 1024 + c];
    const f32x4 sh = *(const f32x4*)&m[c];
    const f32x4 sc = *(const f32x4*)&m[1024 + c];
#pragma unroll
    for (int t = 0; t < 4; ++t)
      *(uint2*)&H[(size_t)(row + t) * 1024 + c] = pack4(x[t][0] * (1 + sc[0]) + sh[0], x[t][1] * (1 + sc[1]) + sh[1], x[t][2] * (1 + sc[2]) + sh[2], x[t][3] * (1 + sc[3]) + sh[3]);
  }
}

__device__ __forceinline__ void phase_ln(const Params& p, int l, int bid, int nb) {
  float* X = p.out;
  const float* g = p.in[10] + l * 1024;
  const float* b = p.in[11] + l * 1024;
  const float* mod = (const float*)(p.ws + WS_MOD) + (l + 1) * 5 * 3072;
  u16* H = (u16*)(p.ws + WS_H);
  const int lane = threadIdx.x & 63, wave = threadIdx.x >> 6;
  for (int row = bid * NW + wave; row < TOK; row += nb * NW) {
    float* xr = X + (size_t)row * 1024;
    f32x4 v[4];
    float s = 0;
#pragma unroll
    for (int i = 0; i < 4; ++i) { v[i] = *(const f32x4*)&xr[i * 256 + lane * 4]; s += v[i][0] + v[i][1] + v[i][2] + v[i][3]; }
    const float mu = wave_sum(s) * (1.0f / 1024.0f);
    float q = 0;
#pragma unroll
    for (int i = 0; i < 4; ++i)
#pragma unroll
      for (int j = 0; j < 4; ++j) { float dd = v[i][j] - mu; q += dd * dd; }
    const float rs = rsqrtf(wave_sum(q) * (1.0f / 1024.0f) + 1e-5f);
    const float* m = mod + cond_of(row) * 3072;
#pragma unroll
    for (int i = 0; i < 4; ++i) {
      const int c = i * 256 + lane * 4;
      f32x4 gg = *(const f32x4*)&g[c], bb = *(const f32x4*)&b[c];
      f32x4 y;
#pragma unroll
      for (int j = 0; j < 4; ++j) y[j] = (v[i][j] - mu) * rs * gg[j] + bb[j];
      *(f32x4*)&xr[c] = y;
      if (l < 3) {
        f32x4 sh = *(const f32x4*)&m[c], sc = *(const f32x4*)&m[1024 + c];
        *(uint2*)&H[(size_t)row * 1024 + c] = pack4(y[0] * (1 + sc[0]) + sh[0], y[1] * (1 + sc[1]) + sh[1], y[2] * (1 + sc[2]) + sh[2], y[3] * (1 + sc[3]) + sh[3]);
      }
    }
  }
}

__device__ __forceinline__ void phase_gla(const Params& p, unsigned char* smem_raw) {
  u16* s_qrel = (u16*)smem_raw;
  u16* s_krel = s_qrel + 32 * 136;
  u16* s_qcum = s_krel + 32 * 136;
  u16* s_kdT = s_qcum + 32 * 136;
  u16* s_vT = s_kdT + 128 * 40;
  u16* s_att = s_vT + 128 * 40;
  u16* s_S = s_att + 32 * 40;
  float* s_dec = (float*)(s_S + 128 * 136);
  float* s_part = s_dec + 128;
  int* s_u = (int*)(s_part + 512);
  int* counter = (int*)(p.ws + WS_CNT);
  const u16* qg = (const u16*)(p.ws + WS_B(0));
  const u16* vg = (const u16*)(p.ws + WS_B(1));
  const _Float16* lfg = (const _Float16*)(p.ws + WS_B(3));
  u16* og = (u16*)(p.ws + WS_B(5));
  const int tid = threadIdx.x, lane = tid & 63, w = tid >> 6, fr = lane & 15, fq = lane >> 4;
  const int kk = tid & 127, th = tid >> 7;
  const int ti = w >> 2, vi = w & 3;
  const int wk = w & 3, wv = w >> 2;
  while (true) {
    if (tid == 0) *s_u = atomicAdd(counter, 1);
    __syncthreads();
    const int u = *s_u;
    __syncthreads();
    if (u >= 576) break;
    int b, rem, start, N, sample;
    if (u < 64) { sample = 1; b = u >> 4; rem = u & 15; start = NPROMPT + b * 1024; N = 1024; }
    else { sample = 0; b = (u - 64) >> 4; rem = (u - 64) & 15; start = b * 256; N = 256; }
    const int h = rem >> 1, d = rem & 1;
    const int nc = N >> 5;
    f32x4 S[2][4];
#pragma unroll
    for (int mi = 0; mi < 2; ++mi)
#pragma unroll
      for (int ni = 0; ni < 4; ++ni) {
        f32x4 s4 = f32x4{0.f, 0.f, 0.f, 0.f};
        if (sample) {
          const float* s0 = p.in[2] + ((size_t)((b * 2 + d) * 8 + h)) * 16384;
#pragma unroll
          for (int j = 0; j < 4; ++j) s4[j] = s0[(wk * 32 + mi * 16 + fq * 4 + j) * 128 + wv * 64 + ni * 16 + fr];
        }
        S[mi][ni] = s4;
        *(uint2*)&s_S[(wv * 64 + ni * 16 + fr) * 136 + wk * 32 + mi * 16 + fq * 4] = pack4(s4[0], s4[1], s4[2], s4[3]);
      }
    _Float16 lfraw[8]; u16 qraw[8]; uint4 vraw;
#define GLA_LOAD(cc) do { _Pragma("unroll") for (int i = 0; i < 8; ++i) { const int tt = (cc) * 32 + th * 8 + i; const size_t tok = start + (d ? (N - 1 - tt) : tt); \
      lfraw[i] = lfg[tok * 2048 + d * 1024 + h * 128 + kk]; qraw[i] = qg[tok * 1024 + h * 128 + kk]; } \
      { const int tt = (cc) * 32 + (tid >> 4); const size_t tok = start + (d ? (N - 1 - tt) : tt); vraw = *(const uint4*)&vg[tok * 1024 + h * 128 + (tid & 15) * 8]; } } while (0)
    GLA_LOAD(0);
    for (int c = 0; c < nc; ++c) {
      {
        float lfv[8], qv[8];
#pragma unroll
        for (int i = 0; i < 8; ++i) { lfv[i] = (float)lfraw[i]; qv[i] = bf2f(qraw[i]); }
        const uint4 vv = vraw;
        if (c + 1 < nc) GLA_LOAD(c + 1);
        float run = 0;
        float cs[8];
#pragma unroll
        for (int i = 0; i < 8; ++i) { run += lfv[i]; cs[i] = run; }
        s_part[th * 128 + kk] = run;
        {
          const int s = tid >> 4, v8 = (tid & 15) * 8;
          const unsigned vw[4] = {vv.x, vv.y, vv.z, vv.w};
#pragma unroll
          for (int i = 0; i < 4; ++i) { s_vT[(v8 + 2 * i) * 40 + s] = (u16)(vw[i] & 0xffff); s_vT[(v8 + 2 * i + 1) * 40 + s] = (u16)(vw[i] >> 16); }
        }
        __syncthreads();
        const float p0 = s_part[kk], p1 = s_part[128 + kk], p2 = s_part[256 + kk], p3 = s_part[384 + kk];
        const float off = (th > 0 ? p0 : 0.f) + (th > 1 ? p1 : 0.f) + (th > 2 ? p2 : 0.f);
        const float ref = p0 + p1, total = p0 + p1 + p2 + p3;
        unsigned kd[4];
        const float eref = __builtin_amdgcn_exp2f(ref), etr = __builtin_amdgcn_exp2f(total - ref);
#pragma unroll
        for (int i = 0; i < 8; ++i) {
          const int t = th * 8 + i;
          const float cum = off + cs[i];
          const float kf = 1.0f - __builtin_amdgcn_exp2f(lfv[i]);
          const float e1 = __builtin_amdgcn_exp2f(cum - ref), e2 = __builtin_amdgcn_rcpf(e1);
          const float qe = qv[i] * e1, ke = kf * e2;
          s_qrel[t * 136 + kk] = f2bf(qe);
          s_krel[t * 136 + kk] = f2bf(ke);
          s_qcum[t * 136 + kk] = f2bf(qe * eref);
          const u16 kdv = f2bf(ke * etr);
          if (i & 1) kd[i >> 1] |= ((unsigned)kdv) << 16; else kd[i >> 1] = kdv;
        }
        *(uint4*)&s_kdT[kk * 40 + th * 8] = make_uint4(kd[0], kd[1], kd[2], kd[3]);
        if (th == 0) s_dec[kk] = eref * etr;
      }
      __syncthreads();
      f32x4 oacc[2] = {f32x4{0.f, 0.f, 0.f, 0.f}, f32x4{0.f, 0.f, 0.f, 0.f}};
      {
        f32x4 att = f32x4{0.f, 0.f, 0.f, 0.f};
        const int ati = w >> 1, asi = w & 1;
#pragma unroll
        for (int ks = 0; ks < 4; ++ks) {
          if (w < 4) {
            bf16x8 a = *(const bf16x8*)&s_qrel[(ati * 16 + fr) * 136 + ks * 32 + fq * 8];
            bf16x8 bb = *(const bf16x8*)&s_krel[(asi * 16 + fr) * 136 + ks * 32 + fq * 8];
            att = __builtin_amdgcn_mfma_f32_16x16x32_bf16(a, bb, att, 0, 0, 0);
          }
          bf16x8 a2 = *(const bf16x8*)&s_qcum[(ti * 16 + fr) * 136 + ks * 32 + fq * 8];
#pragma unroll
          for (int e = 0; e < 2; ++e) {
            bf16x8 b2 = *(const bf16x8*)&s_S[((vi * 2 + e) * 16 + fr) * 136 + ks * 32 + fq * 8];
            oacc[e] = __builtin_amdgcn_mfma_f32_16x16x32_bf16(b2, a2, oacc[e], 0, 0, 0);
          }
        }
        if (w < 4) {
#pragma unroll
          for (int j = 0; j < 4; ++j) {
            const int t = ati * 16 + fq * 4 + j, s = asi * 16 + fr;
            s_att[t * 40 + s] = (s <= t) ? f2bf(att[j]) : (u16)0;
          }
        }
      }
      __syncthreads();
      {
        bf16x8 a = *(const bf16x8*)&s_att[(ti * 16 + fr) * 40 + fq * 8];
        const int tt = c * 32 + ti * 16 + fr;
        const size_t tok = start + (d ? (N - 1 - tt) : tt);
#pragma unroll
        for (int e = 0; e < 2; ++e) {
          bf16x8 bb = *(const bf16x8*)&s_vT[((vi * 2 + e) * 16 + fr) * 40 + fq * 8];
          oacc[e] = __builtin_amdgcn_mfma_f32_16x16x32_bf16(bb, a, oacc[e], 0, 0, 0);
          *(uint2*)&og[((size_t)d * TOK + tok) * 1024 + h * 128 + (vi * 2 + e) * 16 + fq * 4] = pack4(oacc[e][0], oacc[e][1], oacc[e][2], oacc[e][3]);
        }
        bf16x8 vf[4];
#pragma unroll
        for (int ni = 0; ni < 4; ++ni) vf[ni] = *(const bf16x8*)&s_vT[(wv * 64 + ni * 16 + fr) * 40 + fq * 8];
#pragma unroll
        for (int mi = 0; mi < 2; ++mi) {
          bf16x8 kf = *(const bf16x8*)&s_kdT[(wk * 32 + mi * 16 + fr) * 40 + fq * 8];
          f32x4 dc = *(const f32x4*)&s_dec[wk * 32 + mi * 16 + fq * 4];
#pragma unroll
          for (int ni = 0; ni < 4; ++ni) {
            f32x4 s4 = S[mi][ni];
#pragma unroll
            for (int j = 0; j < 4; ++j) s4[j] *= dc[j];
            s4 = __builtin_amdgcn_mfma_f32_16x16x32_bf16(kf, vf[ni], s4, 0, 0, 0);
            S[mi][ni] = s4;
            *(uint2*)&s_S[(wv * 64 + ni * 16 + fr) * 136 + wk * 32 + mi * 16 + fq * 4] = pack4(s4[0], s4[1], s4[2], s4[3]);
          }
        }
      }
      __syncthreads();
    }
    if (!sample) {
      float* so = p.out + OUT_HG + ((size_t)((b * 2 + d) * 8 + h)) * 16384;
#pragma unroll
      for (int mi = 0; mi < 2; ++mi)
#pragma unroll
        for (int ni = 0; ni < 4; ++ni)
#pragma unroll
          for (int j = 0; j < 4; ++j) so[(wk * 32 + mi * 16 + fq * 4 + j) * 128 + wv * 64 + ni * 16 + fr] = S[mi][ni][j];
    }
  }
#undef GLA_LOAD
}

__device__ __forceinline__ void phase_hg_post(const Params& p, int bid, int nb) {
  const u16* og = (const u16*)(p.ws + WS_B(5));
  const u16* sg = (const u16*)(p.ws + WS_B(2));
  u16* a = (u16*)(p.ws + WS_B(0));
  const float* ng = p.in[14];
  const int lane = threadIdx.x & 63, wave = threadIdx.x >> 6;
  float ngv[16];
#pragma unroll
  for (int k = 0; k < 4; ++k) { const f32x4 t = *(const f32x4*)&ng[lane * 16 + 4 * k]; ngv[4 * k] = t[0]; ngv[4 * k + 1] = t[1]; ngv[4 * k + 2] = t[2]; ngv[4 * k + 3] = t[3]; }
  for (int row0 = (bid * NW + wave) * 2; row0 < TOK; row0 += nb * NW * 2) {
    uint4 f[2][2], bw[2][2], sv[2][2];
#pragma unroll
    for (int r = 0; r < 2; ++r)
#pragma unroll
      for (int hh = 0; hh < 2; ++hh) {
        const size_t base = (size_t)(row0 + r) * 1024 + lane * 16 + hh * 8;
        f[r][hh] = *(const uint4*)&og[base];
        bw[r][hh] = *(const uint4*)&og[(size_t)TOK * 1024 + base];
        sv[r][hh] = *(const uint4*)&sg[base];
      }
#pragma unroll
    for (int r = 0; r < 2; ++r) {
      float o[16];
      float ss = 0;
#pragma unroll
      for (int hh = 0; hh < 2; ++hh) {
        const unsigned fa[4] = {f[r][hh].x, f[r][hh].y, f[r][hh].z, f[r][hh].w}, ba[4] = {bw[r][hh].x, bw[r][hh].y, bw[r][hh].z, bw[r][hh].w};
#pragma unroll
        for (int i = 0; i < 4; ++i) {
          o[hh * 8 + 2 * i] = lo16(fa[i]) + lo16(ba[i]);
          o[hh * 8 + 2 * i + 1] = hi16(fa[i]) + hi16(ba[i]);
        }
      }
#pragma unroll
      for (int i = 0; i < 16; ++i) ss += o[i] * o[i];
      ss += __shfl_xor(ss, 1); ss += __shfl_xor(ss, 2); ss += __shfl_xor(ss, 4);
      const float rs = rsqrtf(ss * (1.0f / 128.0f) + 1e-6f);
#pragma unroll
      for (int hh = 0; hh < 2; ++hh) {
        const unsigned sa[4] = {sv[r][hh].x, sv[r][hh].y, sv[r][hh].z, sv[r][hh].w};
        unsigned rr[4];
#pragma unroll
        for (int i = 0; i < 4; ++i)
          rr[i] = pack2(o[hh * 8 + 2 * i] * rs * ngv[hh * 8 + 2 * i] * siluf_(lo16(sa[i])), o[hh * 8 + 2 * i + 1] * rs * ngv[hh * 8 + 2 * i + 1] * siluf_(hi16(sa[i])));
        *(uint4*)&a[(size_t)(row0 + r) * 1024 + lane * 16 + hh * 8] = make_uint4(rr[0], rr[1], rr[2], rr[3]);
      }
    }
  }
}

__device__ __forceinline__ void seq_pos(int tok, int& n, int& L) {
  if (tok < NPROMPT) { n = tok & 255; L = 256; } else { n = (tok - NPROMPT) & 1023; L = 1024; }
}
__device__ __forceinline__ void phase_sc_conv(const Params& p, int bid, int nb) {
  const u16* pb = (const u16*)(p.ws + WS_B(0));
  const u16* sb = (const u16*)(p.ws + WS_B(1));
  u16* a = (u16*)(p.ws + WS_B(2));
  const float* cw = p.in[17]; const float* cbias = p.in[18];
  const size_t total = (size_t)TOK * 128;
  const size_t i0 = (size_t)bid * NT + threadIdx.x;
  const int c = ((int)i0 & 127) * 8;
  float w0[8], w1[8], w2[8], wb[8];
#pragma unroll
  for (int k = 0; k < 2; ++k) {
    const f32x4 t0 = *(const f32x4*)&cw[c + 4 * k], t1 = *(const f32x4*)&cw[1024 + c + 4 * k], t2 = *(const f32x4*)&cw[2048 + c + 4 * k], tb = *(const f32x4*)&cbias[c + 4 * k];
#pragma unroll
    for (int j = 0; j < 4; ++j) { w0[4 * k + j] = t0[j]; w1[4 * k + j] = t1[j]; w2[4 * k + j] = t2[j]; wb[4 * k + j] = tb[j]; }
  }
  const uint4 z = make_uint4(0, 0, 0, 0);
  for (size_t i = i0; i < total / 4; i += (size_t)nb * NT) {
    const int tok = (int)(i >> 7) * 4;
    int n, L; seq_pos(tok, n, L);
    const size_t base = (size_t)tok * 1024 + c;
    uint4 q[6], sv[4];
    q[0] = n > 0 ? *(const uint4*)&pb[base - 1024] : z;
#pragma unroll
    for (int t = 0; t < 4; ++t) { q[1 + t] = *(const uint4*)&pb[base + t * 1024]; sv[t] = *(const uint4*)&sb[base + t * 1024]; }
    q[5] = n + 4 < L ? *(const uint4*)&pb[base + 4096] : z;
#pragma unroll
    for (int t = 0; t < 4; ++t) {
      const unsigned am[4] = {q[t].x, q[t].y, q[t].z, q[t].w}, a0[4] = {q[t + 1].x, q[t + 1].y, q[t + 1].z, q[t + 1].w};
      const unsigned ap[4] = {q[t + 2].x, q[t + 2].y, q[t + 2].z, q[t + 2].w}, as[4] = {sv[t].x, sv[t].y, sv[t].z, sv[t].w};
      unsigned r[4];
#pragma unroll
      for (int k = 0; k < 4; ++k) {
        float z0 = w0[2 * k] * lo16(am[k]) + w1[2 * k] * lo16(a0[k]) + w2[2 * k] * lo16(ap[k]) + wb[2 * k];
        float z1 = w0[2 * k + 1] * hi16(am[k]) + w1[2 * k + 1] * hi16(a0[k]) + w2[2 * k + 1] * hi16(ap[k]) + wb[2 * k + 1];
        r[k] = pack2(lo16(as[k]) * z0, hi16(as[k]) * z1);
      }
      *(uint4*)&a[base + t * 1024] = make_uint4(r[0], r[1], r[2], r[3]);
    }
  }
}
__device__ __forceinline__ void phase_rg_conv(const Params& p, int bid, int nb) {
  const u16* ub = (const u16*)(p.ws + WS_B(0));
  u16* uc = (u16*)(p.ws + WS_B(2));
  const float* cw = p.in[21]; const float* cbias = p.in[22];
  const size_t total = (size_t)TOK * 128;
  const size_t i0 = (size_t)bid * NT + threadIdx.x;
  const int c = ((int)i0 & 127) * 8;
  float w0[8], w1[8], w2[8], w3[8], wb[8];
#pragma unroll
  for (int k = 0; k < 2; ++k) {
    const f32x4 t0 = *(const f32x4*)&cw[c + 4 * k], t1 = *(const f32x4*)&cw[1024 + c + 4 * k], t2 = *(const f32x4*)&cw[2048 + c + 4 * k], t3 = *(const f32x4*)&cw[3072 + c + 4 * k], tb = *(const f32x4*)&cbias[c + 4 * k];
#pragma unroll
    for (int j = 0; j < 4; ++j) { w0[4 * k + j] = t0[j]; w1[4 * k + j] = t1[j]; w2[4 * k + j] = t2[j]; w3[4 * k + j] = t3[j]; wb[4 * k + j] = tb[j]; }
  }
  const uint4 z = make_uint4(0, 0, 0, 0);
  for (size_t i = i0; i < total / 4; i += (size_t)nb * NT) {
    const int tok = (int)(i >> 7) * 4;
    int n, L; seq_pos(tok, n, L);
    const size_t base = (size_t)tok * 1024 + c;
    uint4 q[7];
    q[0] = n > 1 ? *(const uint4*)&ub[base - 2048] : z;
    q[1] = n > 0 ? *(const uint4*)&ub[base - 1024] : z;
#pragma unroll
    for (int t = 0; t < 4; ++t) q[2 + t] = *(const uint4*)&ub[base + t * 1024];
    q[6] = n + 4 < L ? *(const uint4*)&ub[base + 4096] : z;
#pragma unroll
    for (int t = 0; t < 4; ++t) {
      const unsigned a0[4] = {q[t].x, q[t].y, q[t].z, q[t].w}, a1[4] = {q[t + 1].x, q[t + 1].y, q[t + 1].z, q[t + 1].w};
      const unsigned a2[4] = {q[t + 2].x, q[t + 2].y, q[t + 2].z, q[t + 2].w}, a3[4] = {q[t + 3].x, q[t + 3].y, q[t + 3].z, q[t + 3].w};
      unsigned r[4];
#pragma unroll
      for (int k = 0; k < 4; ++k) {
        float z0 = w0[2 * k] * lo16(a0[k]) + w1[2 * k] * lo16(a1[k]) + w2[2 * k] * lo16(a2[k]) + w3[2 * k] * lo16(a3[k]) + wb[2 * k];
        float z1 = w0[2 * k + 1] * hi16(a0[k]) + w1[2 * k + 1] * hi16(a1[k]) + w2[2 * k + 1] * hi16(a2[k]) + w3[2 * k + 1] * hi16(a3[k]) + wb[2 * k + 1];
        r[k] = pack2(z0, z1);
      }
      *(uint4*)&uc[((size_t)(c >> 6) * TOK + tok + t) * 64 + (c & 63)] = make_uint4(r[0], r[1], r[2], r[3]);
    }
  }
}

__device__ __forceinline__ void phase_rg_scan(const Params& p, unsigned char* smem_raw, int bid, int nb) {
  float* sA = (float*)smem_raw;
  float* sB = sA + 2048;
  const u16* rb = (const u16*)(p.ws + WS_B(3));
  const u16* ib = (const u16*)(p.ws + WS_B(5));
  const u16* uc = (const u16*)(p.ws + WS_B(2));
  const u16* sg = (const u16*)(p.ws + WS_B(1));
  u16* hfw = (u16*)(p.ws + WS_H);
  u16* yp = (u16*)(p.ws + WS_B(0));
  const int tid = threadIdx.x;
  for (int u = bid; u < 768; u += nb) {
    int sample, b, c, seg, nseg, start, chs, slot;
    if (u < 256) {
      const int xq = u & 7, yq = u >> 3, gid = (yq >> 2) * 8 + xq, sub = yq & 3;
      sample = 1; b = gid >> 4; slot = (tid & 3) * 4; c = (gid & 15) * 64 + sub * 16 + slot; seg = tid >> 2; nseg = 128; start = NPROMPT + b * 1024; chs = 16; }
    else { sample = 0; b = (u - 256) >> 4; slot = (tid & 15) * 4; c = ((u - 256) & 15) * 64 + slot; seg = tid >> 4; nseg = 32; start = b * 256; chs = 64; }
    const int L = nseg * 8;
#pragma unroll 1
    for (int d = 0; d < 2; ++d) {
      const f32x4 lam = *(const f32x4*)&p.in[25][d * 1024 + c];
      float cl[4];
#pragma unroll
      for (int j = 0; j < 4; ++j) cl[j] = 8.0f * 1.4426950408889634f * log1pf(__expf(-lam[j]))    ;
      const u16* rp = rb + (size_t)d * TOK * 1024;
      const u16* ip = ib + (size_t)d * TOK * 1024;
      const int tok0 = start + (d ? L - 1 - seg * 8 : seg * 8);
      const size_t o0 = (size_t)tok0 * 1024 + c;
      const long ostep = d ? -1024 : 1024;
      const size_t g0 = ((size_t)(c >> 6) * TOK + tok0) * 64 + (c & 63);
      const long gstep = d ? -64 : 64;
      uint2 rr[8], ii[8], uu[8];
#pragma unroll
      for (int s8 = 0; s8 < 8; ++s8) { rr[s8] = *(const uint2*)&rp[g0 + s8 * gstep]; ii[s8] = *(const uint2*)&ip[g0 + s8 * gstep]; uu[s8] = *(const uint2*)&uc[g0 + s8 * gstep]; }
      uint2 hf[8], sgv[8];
      if (d == 1) {
#pragma unroll
        for (int s8 = 0; s8 < 8; ++s8) { hf[s8] = *(const uint2*)&hfw[g0 + s8 * gstep]; sgv[s8] = *(const uint2*)&sg[g0 + s8 * gstep]; }
      }
      float av[8][4], xv[8][4];
      float A[4] = {1.f, 1.f, 1.f, 1.f}, B[4] = {0.f, 0.f, 0.f, 0.f};
#pragma unroll
      for (int s8 = 0; s8 < 8; ++s8) {
        const float r4[4] = {lo16(rr[s8].x), hi16(rr[s8].x), lo16(rr[s8].y), hi16(rr[s8].y)};
        const float i4[4] = {lo16(ii[s8].x), hi16(ii[s8].x), lo16(ii[s8].y), hi16(ii[s8].y)};
        const float u4[4] = {lo16(uu[s8].x), hi16(uu[s8].x), lo16(uu[s8].y), hi16(uu[s8].y)};
#pragma unroll
        for (int j = 0; j < 4; ++j) {
          const float la = -cl[j] * r4[j];
          const float a = __builtin_amdgcn_exp2f(la);
          const float xin = __builtin_amdgcn_sqrtf(fmaxf(1.0f - __builtin_amdgcn_exp2f(2.0f * la), 0.f)) * (i4[j] * u4[j]);
          av[s8][j] = a; xv[s8][j] = xin;
          A[j] *= a; B[j] = a * B[j] + xin;
        }
      }
      *(f32x4*)&sA[seg * chs + slot] = f32x4{A[0], A[1], A[2], A[3]};
      *(f32x4*)&sB[seg * chs + slot] = f32x4{B[0], B[1], B[2], B[3]};
      for (int k = 1; k < nseg; k <<= 1) {
        __syncthreads();
        f32x4 pa = f32x4{1.f, 1.f, 1.f, 1.f}, pb2 = f32x4{0.f, 0.f, 0.f, 0.f};
        if (seg >= k) { pa = *(const f32x4*)&sA[(seg - k) * chs + slot]; pb2 = *(const f32x4*)&sB[(seg - k) * chs + slot]; }
        __syncthreads();
        if (seg >= k) {
#pragma unroll
          for (int j = 0; j < 4; ++j) { B[j] = A[j] * pb2[j] + B[j]; A[j] = A[j] * pa[j]; }
          *(f32x4*)&sA[seg * chs + slot] = f32x4{A[0], A[1], A[2], A[3]};
          *(f32x4*)&sB[seg * chs + slot] = f32x4{B[0], B[1], B[2], B[3]};
        }
      }
      __syncthreads();
      float h[4];
      {
        f32x4 h0v = f32x4{0.f, 0.f, 0.f, 0.f};
        if (sample) h0v = *(const f32x4*)&p.in[3][(b * 2 + d) * 1024 + c];
        if (seg > 0) {
          const f32x4 pa = *(const f32x4*)&sA[(seg - 1) * chs + slot], pb2 = *(const f32x4*)&sB[(seg - 1) * chs + slot];
#pragma unroll
          for (int j = 0; j < 4; ++j) h[j] = pa[j] * h0v[j] + pb2[j];
        } else {
#pragma unroll
          for (int j = 0; j < 4; ++j) h[j] = h0v[j];
        }
      }
#pragma unroll
      for (int s8 = 0; s8 < 8; ++s8) {
#pragma unroll
        for (int j = 0; j < 4; ++j) h[j] = av[s8][j] * h[j] + xv[s8][j];
        const size_t o = o0 + s8 * ostep;
        if (d == 0) *(uint2*)&hfw[g0 + s8 * gstep] = pack4(h[0], h[1], h[2], h[3]);
        else *(uint2*)&yp[g0 + s8 * gstep] = pack4((lo16(hf[s8].x) + h[0]) * lo16(sgv[s8].x), (hi16(hf[s8].x) + h[1]) * hi16(sgv[s8].x),
                                     (lo16(hf[s8].y) + h[2]) * lo16(sgv[s8].y), (hi16(hf[s8].y) + h[3]) * hi16(sgv[s8].y));
      }
      if (!sample && seg == nseg - 1) *(f32x4*)&p.out[OUT_RG + (b * 2 + d) * 1024 + c] = f32x4{h[0], h[1], h[2], h[3]};
      __syncthreads();
    }
  }
}

__device__ __forceinline__ void phase_mla_norm(const Params& p, int bid, int nb) {
  u16* cq = (u16*)(p.ws + WS3_CQ);
  u16* ckvall = (u16*)(p.ws + WS3_CKVALL);
  const float* ckvraw = (const float*)(p.ws + WS3_CKVRAW);
  const float* kperaw = (const float*)(p.ws + WS3_KPERAW);
  u16* Kb = (u16*)(p.ws + WS3_K);
  const float* qn = p.in[28]; const float* kvn = p.in[29];
  const int lane = threadIdx.x & 63, wave = threadIdx.x >> 6;
  float qnv[6];
#pragma unroll
  for (int i = 0; i < 3; ++i) { qnv[2 * i] = qn[(i * 64 + lane) * 2]; qnv[2 * i + 1] = qn[(i * 64 + lane) * 2 + 1]; }
  const f32x4 g4 = *(const f32x4*)&kvn[lane * 4];
  unsigned cvn[3] = {0u, 0u, 0u}; f32x4 kvnx = f32x4{0.f, 0.f, 0.f, 0.f}; float vnx = 0.f;
  {
    const int r0 = bid * NW + wave;
    if (r0 < TOK) {
#pragma unroll
      for (int i = 0; i < 3; ++i) cvn[i] = ((const unsigned*)&cq[(size_t)r0 * 384])[i * 64 + lane];
      kvnx = *(const f32x4*)&ckvraw[(size_t)r0 * 256 + lane * 4]; vnx = kperaw[(size_t)r0 * 32 + (lane & 31)];
    }
  }
  for (int row = bid * NW + wave; row < TOK + 2048; row += nb * NW) {
    if (row < TOK) {
      const int tok = row;
      const bool sample = tok >= NPROMPT;
      unsigned cv[3] = {cvn[0], cvn[1], cvn[2]}; const f32x4 kv = kvnx; float v = vnx;
      {
        const int rn = row + nb * NW;
        if (rn < TOK) {
#pragma unroll
          for (int i = 0; i < 3; ++i) cvn[i] = ((const unsigned*)&cq[(size_t)rn * 384])[i * 64 + lane];
          kvnx = *(const f32x4*)&ckvraw[(size_t)rn * 256 + lane * 4]; vnx = kperaw[(size_t)rn * 32 + (lane & 31)];
        }
      }
      const int bs = (tok - NPROMPT) >> 10, n = (tok - NPROMPT) & 1023;
      const size_t kvrow = sample ? (size_t)(NPROMPT + bs * 1536 + 512 + n) : (size_t)tok;
      unsigned* cqr = (unsigned*)&cq[(size_t)tok * 384];
      float ss = 0;
#pragma unroll
      for (int i = 0; i < 3; ++i) { float a = lo16(cv[i]), b2 = hi16(cv[i]); ss += a * a + b2 * b2; }
      const float rsq = rsqrtf(wave_sum(ss) * (1.0f / 384.0f) + 1e-6f);
#pragma unroll
      for (int i = 0; i < 3; ++i) {
        cqr[i * 64 + lane] = pack2(lo16(cv[i]) * rsq * qnv[2 * i], hi16(cv[i]) * rsq * qnv[2 * i + 1]);
      }
      const float rsk = rsqrtf(wave_sum(kv[0] * kv[0] + kv[1] * kv[1] + kv[2] * kv[2] + kv[3] * kv[3]) * (1.0f / 256.0f) + 1e-6f);
      f32x4 o4;
#pragma unroll
      for (int j = 0; j < 4; ++j) o4[j] = kv[j] * rsk * g4[j];
      *(uint2*)&ckvall[kvrow * 256 + lane * 4] = pack4(o4[0], o4[1], o4[2], o4[3]);
      if (!sample) *(f32x4*)&p.out[OUT_CKV + (size_t)tok * 256 + lane * 4] = o4;
      if (!sample) { if (lane < 32) p.out[OUT_KPE + (size_t)tok * 32 + lane] = v; }
      else {
        const float partner = __shfl_xor(v, 8);
        const int i16 = lane & 15;
        const float pos = (lane & 16) ? (float)(n & 63) : (float)(n >> 6);
        float sn, cs; rope_sincos(pos, i16 & 7, sn, cs);
        v = (i16 < 8) ? (v * cs - partner * sn) : (partner * sn + v * cs);
      }
      const u16 vb = f2bf(v);
#pragma unroll
      for (int i = 0; i < 8; ++i) Kb[(kvrow * 16 + (lane >> 5) + 2 * i) * 96 + 64 + (lane & 31)] = vb;
    } else {
      const int r = row - TOK, bs = r >> 9, j = r & 511;
      const size_t kvrow = (size_t)(NPROMPT + bs * 1536 + j);
      f32x4 kv = *(const f32x4*)&p.in[4][(size_t)r * 256 + lane * 4];
      *(uint2*)&ckvall[kvrow * 256 + lane * 4] = pack4(kv[0], kv[1], kv[2], kv[3]);
      const u16 vb = f2bf(p.in[5][(size_t)r * 32 + (lane & 31)]);
#pragma unroll
      for (int i = 0; i < 8; ++i) Kb[(kvrow * 16 + (lane >> 5) + 2 * i) * 96 + 64 + (lane & 31)] = vb;
    }
  }
}

__device__ __forceinline__ void phase_attn(const Params& p, unsigned char* smem_raw, int bid, int nb) {
  u16* sK = (u16*)smem_raw;
  u16* sV = sK + 128 * 104;
  const u16* qg = (const u16*)(p.ws + WS3_Q);
  const u16* Kg = (const u16*)(p.ws + WS3_K);
  const u16* Vg = (const u16*)(p.ws + WS3_VT);
  const u16* sg = (const u16*)(p.ws + WS3_SG);
  u16* ao = (u16*)(p.ws + WS_H);
  const int tid = threadIdx.x, lane = tid & 63, w = tid >> 6, fr = lane & 15, fq = lane >> 4;
  for (int u = bid; u < 1536; u += nb) {
    int tok0, kvbase, nkeys, h;
    if (u < 512) { const int b = u >> 7, r = u & 127; h = r >> 3; const int qb = r & 7; tok0 = NPROMPT + b * 1024 + qb * 128; kvbase = NPROMPT + b * 1536; nkeys = 1536; }
    else { const int uu = u - 512; const int b = uu >> 5, r = uu & 31; h = r >> 1; const int qb = r & 1; tok0 = b * 256 + qb * 128; kvbase = b * 256; nkeys = 256; }
    const int tokq = tok0 + w * 16 + fr;
    bf16x8 qf[3];
#pragma unroll
    for (int ks = 0; ks < 3; ++ks) qf[ks] = *(const bf16x8*)&qg[(size_t)tokq * 1536 + h * 96 + ks * 32 + fq * 8];
    if (u < 512) {
      const int npos = (tokq - NPROMPT) & 1023;
      const float pos = (fq & 2) ? (float)(npos & 63) : (float)(npos >> 6);
      uint4 raw = *(uint4*)&qf[2];
      unsigned rw[4] = {raw.x, raw.y, raw.z, raw.w};
#pragma unroll
      for (int i = 0; i < 4; ++i) {
        float v0 = lo16(rw[i]), v1 = hi16(rw[i]);
        const float p0 = __shfl_xor(v0, 16), p1 = __shfl_xor(v1, 16);
        float sn0, cs0, sn1, cs1;
        rope_sincos(pos, 2 * i, sn0, cs0); rope_sincos(pos, 2 * i + 1, sn1, cs1);
        v0 = (fq & 1) ? (p0 * sn0 + v0 * cs0) : (v0 * cs0 - p0 * sn0);
        v1 = (fq & 1) ? (p1 * sn1 + v1 * cs1) : (v1 * cs1 - p1 * sn1);
        rw[i] = pack2(v0, v1);
      }
      raw = make_uint4(rw[0], rw[1], rw[2], rw[3]);
      qf[2] = *(bf16x8*)&raw;
    }
    float m = -1e30f, l = 0.f;
    f32x4 oacc[4];
#pragma unroll
    for (int i = 0; i < 4; ++i) oacc[i] = f32x4{0.f, 0.f, 0.f, 0.f};
    const int kk0 = tid / 12, kc0 = tid - kk0 * 12;
    const int kk1 = (tid + NT) / 12, kc1 = (tid + NT) - kk1 * 12;
    const int kk2_ = (tid + 2 * NT) / 12, kc2 = (tid + 2 * NT) - kk2_ * 12;
    const u16* Kp0 = &Kg[((size_t)(kvbase + kk0) * 16 + h) * 96 + kc0 * 8];
    const u16* Kp1 = &Kg[((size_t)(kvbase + kk1) * 16 + h) * 96 + kc1 * 8];
    const u16* Kp2 = &Kg[((size_t)(kvbase + kk2_) * 16 + h) * 96 + kc2 * 8];
    const int vd0 = tid >> 4, vc0 = tid & 15, vd1 = (tid + NT) >> 4;
    const u16* Vp0 = &Vg[(size_t)(h * 64 + vd0) * KVROWS + kvbase + vc0 * 8];
    const u16* Vp1 = &Vg[(size_t)(h * 64 + vd1) * KVROWS + kvbase + vc0 * 8];
    uint4 kr0 = *(const uint4*)Kp0, kr1 = *(const uint4*)Kp1, kr2 = *(const uint4*)Kp2, vr0 = *(const uint4*)Vp0, vr1 = *(const uint4*)Vp1;
    const int ntile2 = nkeys >> 7;
    for (int kt = 0; kt < ntile2; ++kt) {
      __syncthreads();
      *(uint4*)&sK[kk0 * 104 + kc0 * 8] = kr0; *(uint4*)&sK[kk1 * 104 + kc1 * 8] = kr1; *(uint4*)&sK[kk2_ * 104 + kc2 * 8] = kr2;
      *(uint4*)&sV[vd0 * 136 + vc0 * 8] = vr0; *(uint4*)&sV[vd1 * 136 + vc0 * 8] = vr1;
      if (kt + 1 < ntile2) {
        const size_t ko = (size_t)(kt + 1) * 128 * 1536; const int vo = (kt + 1) * 128;
        kr0 = *(const uint4*)(Kp0 + ko); kr1 = *(const uint4*)(Kp1 + ko); kr2 = *(const uint4*)(Kp2 + ko);
        vr0 = *(const uint4*)(Vp0 + vo); vr1 = *(const uint4*)(Vp1 + vo);
      }
      __syncthreads();
      f32x4 sacc[8];
#pragma unroll
      for (int ni = 0; ni < 8; ++ni) {
        sacc[ni] = f32x4{0.f, 0.f, 0.f, 0.f};
#pragma unroll
        for (int ks = 0; ks < 3; ++ks) {
          bf16x8 kf = *(const bf16x8*)&sK[(ni * 16 + fr) * 104 + ks * 32 + fq * 8];
          sacc[ni] = __builtin_amdgcn_mfma_f32_16x16x32_bf16(kf, qf[ks], sacc[ni], 0, 0, 0);
        }
      }
      float mx = -1e30f;
#pragma unroll
      for (int ni = 0; ni < 8; ++ni)
#pragma unroll
        for (int j = 0; j < 4; ++j) mx = fmaxf(mx, sacc[ni][j]);
      mx = fmaxf(mx, __shfl_xor(mx, 16));
      mx = fmaxf(mx, __shfl_xor(mx, 32));
      const float mnew = fmaxf(m, mx);
      const float alpha = __builtin_amdgcn_exp2f(m - mnew);
      m = mnew;
      float ls = 0.f;
#pragma unroll
      for (int ni = 0; ni < 8; ++ni)
#pragma unroll
        for (int j = 0; j < 4; ++j) { float e = __builtin_amdgcn_exp2f(sacc[ni][j] - mnew); sacc[ni][j] = e; ls += e; }
      l = l * alpha + ls;
      bf16x8 pf[4];
#pragma unroll
      for (int kk2 = 0; kk2 < 4; ++kk2) {
        uint2 lo = pack4(sacc[2 * kk2][0], sacc[2 * kk2][1], sacc[2 * kk2][2], sacc[2 * kk2][3]);
        uint2 hi = pack4(sacc[2 * kk2 + 1][0], sacc[2 * kk2 + 1][1], sacc[2 * kk2 + 1][2], sacc[2 * kk2 + 1][3]);
        uint4 pk = make_uint4(lo.x, lo.y, hi.x, hi.y);
        pf[kk2] = *(bf16x8*)&pk;
      }
#pragma unroll
      for (int di = 0; di < 4; ++di) {
#pragma unroll
        for (int j = 0; j < 4; ++j) oacc[di][j] *= alpha;
#pragma unroll
        for (int kk2 = 0; kk2 < 4; ++kk2) {
          uint2 v0 = *(const uint2*)&sV[(di * 16 + fr) * 136 + kk2 * 32 + fq * 4];
          uint2 v1 = *(const uint2*)&sV[(di * 16 + fr) * 136 + kk2 * 32 + 16 + fq * 4];
          uint4 vk = make_uint4(v0.x, v0.y, v1.x, v1.y);
          oacc[di] = __builtin_amdgcn_mfma_f32_16x16x32_bf16(*(bf16x8*)&vk, pf[kk2], oacc[di], 0, 0, 0);
        }
      }
    }
    l += __shfl_xor(l, 16);
    l += __shfl_xor(l, 32);
    const float inv = 1.0f / l;
#pragma unroll
    for (int di = 0; di < 4; ++di) {
      const size_t o = (size_t)tokq * 1024 + h * 64 + di * 16 + fq * 4;
      uint2 s = *(const uint2*)&sg[o];
      *(uint2*)&ao[o] = pack4(oacc[di][0] * inv * siluf_(lo16(s.x)), oacc[di][1] * inv * siluf_(hi16(s.x)), oacc[di][2] * inv * siluf_(lo16(s.y)), oacc[di][3] * inv * siluf_(hi16(s.y)));
    }
  }
}

#define XB_TMO      128
#define XB_XCNT(j)  (256  + 64 * (j))
#define XB_XSUB(j)  (1280 + 64 * (j))
#define XB_XGEN(j)  (2304 + 64 * (j))
#define XB_TOP      3328
#define XB_TOPGEN   3392
#define XCD_BAR_WORDS 3456
#define XB_SPIN_CAP (1u << 22)
__device__ __forceinline__ unsigned xb_ld(unsigned* p)              { return __hip_atomic_load(p, __ATOMIC_RELAXED, __HIP_MEMORY_SCOPE_AGENT); }
__device__ __forceinline__ unsigned xb_add(unsigned* p, unsigned v) { return __hip_atomic_fetch_add(p, v, __ATOMIC_RELAXED, __HIP_MEMORY_SCOPE_AGENT); }
__device__ __forceinline__ unsigned xb_xcc_id() { return (unsigned)__builtin_amdgcn_s_getreg((3 << 11) | 20) & 0xFu; }
#define XB_SPIN(cond, bar) do { unsigned _sp = 0; while (cond) { __builtin_amdgcn_s_sleep(1); \
    if ((++_sp & 255u) == 0u) { if (xb_ld(&(bar)[XB_TMO])) break; if (_sp > XB_SPIN_CAP) { atomicAdd(&(bar)[XB_TMO], 1u); break; } } } } while (0)
struct XcdBarrier { unsigned* bar; unsigned x; volatile LAS unsigned* st; };
__device__ __forceinline__ XcdBarrier xcd_barrier_post(unsigned* bar, volatile LAS unsigned* st) {
  XcdBarrier b; b.bar = bar; b.x = xb_xcc_id(); b.st = st;
  if (threadIdx.x == 0) (void)xb_add(&bar[XB_XCNT(b.x)], 1u);
  return b;
}
__device__ __forceinline__ void xcd_barrier_complete(unsigned* bar, unsigned x, unsigned& nloc, unsigned& nx) {
  const unsigned G = gridDim.x * gridDim.y * gridDim.z;
  unsigned sum, cnt, mine, sp = 0u;
  for (;;) {
    sum = 0u; cnt = 0u; mine = 0u;
#pragma unroll
    for (unsigned j = 0; j < 16; ++j) { const unsigned c = xb_ld(&bar[XB_XCNT(j)]); sum += c; cnt += (c > 0u) ? 1u : 0u; mine = (j == x) ? c : mine; }
    if (sum == G) break;
    __builtin_amdgcn_s_sleep(1);
    if ((++sp & 255u) == 0u) { if (xb_ld(&bar[XB_TMO])) break; if (sp > XB_SPIN_CAP) { atomicAdd(&bar[XB_TMO], 1u); break; } }
  }
  nloc = mine > 0u ? mine : 1u; nx = cnt > 0u ? cnt : 1u;
}
__device__ __forceinline__ void xcd_barrier(const XcdBarrier& b) {
  asm volatile("s_waitcnt vmcnt(0)" ::: "memory");
  __syncthreads();
  if (threadIdx.x == 0) {
    unsigned* bar = b.bar;
    __builtin_amdgcn_s_waitcnt(0);
    unsigned nloc = b.st[0], nx = b.st[1];
    if (nloc == 0u) { xcd_barrier_complete(bar, b.x, nloc, nx); b.st[0] = nloc; b.st[1] = nx; }
    const unsigned old = xb_add(&bar[XB_XSUB(b.x)], 1u);
    const unsigned gen = old / nloc;
    if (old + 1u == (gen + 1u) * nloc) {
      __builtin_amdgcn_fence(__ATOMIC_RELEASE, "agent");
      asm volatile("s_waitcnt vmcnt(0)" ::: "memory");
      const unsigned og = xb_add(&bar[XB_TOP], 1u);
      const unsigned tg = og / nx;
      if (og + 1u == (tg + 1u) * nx) xb_add(&bar[XB_TOPGEN], 1u);
      else XB_SPIN(xb_ld(&bar[XB_TOPGEN]) == tg, bar);
      __builtin_amdgcn_fence(__ATOMIC_ACQUIRE, "agent");
      xb_add(&bar[XB_XGEN(b.x)], 1u);
      asm volatile("s_waitcnt vmcnt(0)" ::: "memory");
    } else {
      XB_SPIN(xb_ld(&bar[XB_XGEN(b.x)]) == gen, bar);
      __builtin_amdgcn_fence(__ATOMIC_ACQUIRE, "agent");
      asm volatile("s_waitcnt vmcnt(0)" ::: "memory");
    }
  }
  __syncthreads();
}

#define GEMM_LDS 131072
#define DYN_LDS (GEMM_LDS + 16)
#define WS_BAR (WS_CNT + 4096ull)

#define RUN_GEMM(Aptr, LDA, Bptr, MM, NN, KK, GATE, EPI, CID) RUN_GEMM_G(Aptr, LDA, Bptr, MM, NN, KK, GATE, EPI, nb, CID)
#define RUN_GEMM_G(Aptr, LDA, Bptr, MM, NN, KK, GATE, EPI, GG, CID) RUN_GEMM_X(Aptr, LDA, (size_t)128, (size_t)0, Bptr, MM, NN, KK, GATE, EPI, GG, CID)
#define GM_KSTEP ((size_t)TOK * 128)
#define RUN_GEMM_X(Aptr, LDA, KSA, GST, Bptr, MM, NN, KK, GATE, EPI, GG, CID) do { pg8::Gemm g_{(const u16*)(Aptr), (const u16*)(Bptr), MM, NN, KK, LDA, GATE, p.flags, KSA, GST}; \
    pg8::StaticOrder S_; S_.init(MM, NN, GG, CID); pg8::gemm_phase((LAS unsigned char*)smem_raw, g_, S_, EPI); } while (0)
#define RUN_GEMM_R(Aptr, LDA, Bptr, MM, NN, KK, EPI, GG, CID, UBEG, UEND) do { pg8::Gemm g_{(const u16*)(Aptr), (const u16*)(Bptr), MM, NN, KK, LDA, 0, p.flags, (size_t)128, (size_t)0}; \
    pg8::StaticOrder S_; S_.init(MM, NN, GG, CID); S_.ubeg = UBEG; S_.uend = UEND; pg8::gemm_phase((LAS unsigned char*)smem_raw, g_, S_, EPI); } while (0)

__global__ void __launch_bounds__(NT, 2) mega(Params p) {
  extern __shared__ __attribute__((aligned(16))) unsigned char smem_raw[];
  const int bid = blockIdx.x, nb = gridDim.x;
  unsigned char* ws = p.ws;
  const float* mod = (const float*)(ws + WS_MOD);
  volatile LAS unsigned* xst = (volatile LAS unsigned*)((LAS unsigned char*)smem_raw + GEMM_LDS);
  XcdBarrier xb;
  if (p.phase_hi - p.phase_lo > 1) {
    if (threadIdx.x == 0) { xst[0] = 0u; xst[1] = 0u; }
    __syncthreads();
    xb = xcd_barrier_post((unsigned*)(ws + WS_BAR), xst);
  }
#define PH_BEGIN(n) if ((PHMASK & (1u << n)) && p.phase_lo <= n && n < p.phase_hi) { const int ph = n;
#define PH_FIN if (ph + 1 < p.phase_hi) { if (p.phase_lo < 0) cg::this_grid().sync(); else xcd_barrier(xb); } }
  PH_BEGIN(0) phase_prologue(p, smem_raw, bid, nb); PH_FIN
  PH_BEGIN(1) phase_h0(p, bid, nb); PH_FIN
  PH_BEGIN(2) {
    EpiHgIn e{(u16*)(ws + WS_B(0)), (u16*)(ws + WS_B(1)), (u16*)(ws + WS_B(2)), (_Float16*)(ws + WS_B(3)), (const float*)(ws + WS_LB)};
    RUN_GEMM(ws + WS_H, 1024, ws + WS_W_HG_IN, TOK, 5120, 1024, 0, e, bid);
  } PH_FIN
  PH_BEGIN(3) phase_gla(p, smem_raw); PH_FIN
  PH_BEGIN(4) phase_hg_post(p, bid, nb); PH_FIN
  PH_BEGIN(5) {
    EpiResLn<false, true> e{p.in[0], p.in[1], (const u16*)nullptr, p.out, (u16*)(ws + WS_XB), mod + 0 * 15360 + 2048, p.in[10] + 0 * 1024, p.in[11] + 0 * 1024, mod + 1 * 15360, (u16*)(ws + WS_H),
               (unsigned long long*)(ws + WS_SLOT) + 0 * 49152, (unsigned*)(ws + WS_CNT + 256) + 0 * 48};
    RUN_GEMM(ws + WS_B(0), 1024, ws + WS_W_HG_OUT, TOK, 1024, 1024, 0, e, bid);
    wconv_idle(p, smem_raw, bid, nb, 1536, 2816);
  } PH_FIN
  PH_BEGIN(7) {
    EpiScIn e{(u16*)(ws + WS_B(0)), (u16*)(ws + WS_B(1))};
    RUN_GEMM(ws + WS_H, 1024, ws + WS_W_SC_IN, TOK, 4096, 1024, 0, e, bid);
  } PH_FIN
  PH_BEGIN(8) phase_sc_conv(p, bid, nb); PH_FIN
  PH_BEGIN(9) {
    EpiResLn<true, true> e{p.out, p.out, (const u16*)(ws + WS_XB), p.out, (u16*)(ws + WS_XB), mod + 1 * 15360 + 2048, p.in[10] + 1 * 1024, p.in[11] + 1 * 1024, mod + 2 * 15360, (u16*)(ws + WS_H),
               (unsigned long long*)(ws + WS_SLOT) + 1 * 49152, (unsigned*)(ws + WS_CNT + 256) + 1 * 48};
    RUN_GEMM(ws + WS_B(2), 1024, ws + WS_W_SC_OUT, TOK, 1024, 1024, 0, e, bid);
    wconv_idle(p, smem_raw, bid, nb, 2816, 3840);
  } PH_FIN
  PH_BEGIN(11) {
    EpiRgIn e{(u16*)(ws + WS_B(0)), (u16*)(ws + WS_B(1))};
    RUN_GEMM(ws + WS_H, 1024, ws + WS_W_RG_IN, TOK, 2048, 1024, 0, e, bid);
  } PH_FIN
  PH_BEGIN(12) phase_rg_conv(p, bid, nb); PH_FIN
  PH_BEGIN(13) {
    EpiRgGate e{(u16*)(ws + WS_B(3)), (u16*)(ws + WS_B(5)), p.in[24]};
    RUN_GEMM_X(ws + WS_B(2), 64, GM_KSTEP, 4 * GM_KSTEP, ws + WS_W_RG_GATE, TOK, 4096, 256, 1, e, nb, bid);
  } PH_FIN
  PH_BEGIN(14) phase_rg_scan(p, smem_raw, bid, nb); PH_FIN
  PH_BEGIN(15) {
    EpiResLn<true, true> e{p.out, p.out, (const u16*)(ws + WS_XB), p.out, (u16*)(ws + WS_XB), mod + 2 * 15360 + 2048, p.in[10] + 2 * 1024, p.in[11] + 2 * 1024, mod + 3 * 15360, (u16*)(ws + WS_H),
               (unsigned long long*)(ws + WS_SLOT) + 2 * 49152, (unsigned*)(ws + WS_CNT + 256) + 2 * 48};
    RUN_GEMM_X(ws + WS_B(0), 64, GM_KSTEP, (size_t)0, ws + WS_W_RG_OUT, TOK, 1024, 1024, 0, e, nb, bid);
    wconv_idle(p, smem_raw, bid, nb, 3840, 4800);
  } PH_FIN
  PH_BEGIN(17) {
    EpiMlaIn e{(u16*)(ws + WS3_CQ), (float*)(ws + WS3_CKVRAW), (float*)(ws + WS3_KPERAW), (u16*)(ws + WS3_SG)};
    RUN_GEMM(ws + WS_H, 1024, ws + WS_W_MLA_IN, TOK, 768, 1024, 0, e, bid);
    if (nb == 256) {
      EpiSg eg{(u16*)(ws + WS3_SG)};
      RUN_GEMM_R(ws + WS_H, 1024, ws + WS_W_MLA_IN + 672 * 1024 * 2, TOK, 1024, 1024, eg, 256, bid >= 144 ? bid - 144 : (1 << 20), 0, 112);
    }
  } PH_FIN
  PH_BEGIN(18) phase_mla_norm(p, bid, nb); PH_FIN
  PH_BEGIN(19) {
    const bool bal = (nb == 256);
    const int none = 1 << 20;
    EpiSg eg{(u16*)(ws + WS3_SG)};
    RUN_GEMM_R(ws + WS_H, 1024, ws + WS_W_MLA_IN + 672 * 1024 * 2, TOK, 1024, 1024, eg, nb, bid, bal ? 112 : 0, 192);
    EpiQ eq{(u16*)(ws + WS3_Q)};
    RUN_GEMM_G(ws + WS3_CQ, 384, ws + WS_W_QB, TOK, 1536, 384, 0, eq, bal ? 176 : nb, bal ? (bid >= 80 ? bid - 80 : none) : bid);
    EpiK ek{(u16*)(ws + WS3_K)};
    RUN_GEMM(ws + WS3_CKVALL, 256, ws + WS_W_KVB, KVROWS, 1024, 256, 0, ek, bid);
    EpiV ev{(u16*)(ws + WS3_VT)};
    RUN_GEMM_G(ws + WS_W_KVB + 1024 * 256 * 2, 256, ws + WS3_CKVALL, 1024, KVROWS, 256, 0, ev, bal ? 176 : nb, bal ? (bid >= 80 ? (bid + 160) % 176 : none) : bid);
  } PH_FIN
  PH_BEGIN(20) phase_attn(p, smem_raw, bid, nb); PH_FIN
  PH_BEGIN(21) {
    EpiResLn<true, false> e{p.out, p.out, (const u16*)(ws + WS_XB), p.out, (u16*)nullptr, mod + 3 * 15360 + 2048, p.in[10] + 3 * 1024, p.in[11] + 3 * 1024, mod + 3 * 15360, (u16*)nullptr,
               (unsigned long long*)(ws + WS_SLOT) + 3 * 49152, (unsigned*)(ws + WS_CNT + 256) + 3 * 48};
    RUN_GEMM(ws + WS_H, 1024, ws + WS_W_MLA_OUT, TOK, 1024, 1024, 0, e, bid);
  } PH_FIN
}

extern "C" void kernel_launch(void* const* d_in, const int* in_sizes, int n_in, void* d_out, int out_size, void* d_ws, size_t ws_size,
                              hipStream_t stream) {
  static int grid_blocks = 0;
  if (!grid_blocks) {
    int dev = 0, cus = 0, per_cu = 0;
    (void)hipGetDevice(&dev);
    (void)hipDeviceGetAttribute(&cus, hipDeviceAttributeMultiprocessorCount, dev);
    (void)hipFuncSetAttribute((const void*)mega, hipFuncAttributeMaxDynamicSharedMemorySize, DYN_LDS);
    (void)hipOccupancyMaxActiveBlocksPerMultiprocessor(&per_cu, (const void*)mega, NT, DYN_LDS);
    if (per_cu < 1) per_cu = 1;
    if (per_cu > 1) per_cu = 1;
    grid_blocks = cus * per_cu;
  }
  Params p{};
  for (int i = 0; i < 33; ++i) p.in[i] = (const float*)d_in[i];
  p.out = (float*)d_out;
  p.ws = (unsigned char*)d_ws;
#if MULTI_LAUNCH
  (void)hipMemsetAsync((unsigned char*)d_ws + WS_CNT, 0, 4096 + XCD_BAR_WORDS * 4, stream);
  for (int ph = 0; ph < NPHASES; ++ph) {
    p.phase_lo = ph; p.phase_hi = ph + 1;
    hipLaunchKernelGGL(mega, dim3(grid_blocks), dim3(NT), DYN_LDS, stream, p);
#ifdef PROBE_MASK
    if ((PROBE_MASK >> ph) & 1) { p.flags = PROBE_FLAGS; for (int r = 0; r < 2; ++r) {
      if (ph == 3) (void)hipMemsetAsync((unsigned char*)d_ws + WS_CNT, 0, 64, stream);
      hipLaunchKernelGGL(mega, dim3(grid_blocks), dim3(NT), DYN_LDS, stream, p);
    } p.flags = 0; }
#endif
  }
#else
  p.phase_lo = 0; p.phase_hi = NPHASES;
  (void)hipMemsetAsync((unsigned char*)d_ws + WS_CNT, 0, 4096 + XCD_BAR_WORDS * 4, stream);
  void* args[] = {&p};
  hipError_t e = hipLaunchCooperativeKernel((const void*)mega, dim3(grid_blocks), dim3(NT), args, DYN_LDS, stream);
  if (e != hipSuccess) fprintf(stderr, "cooperative launch failed: %s (grid %d)\n", hipGetErrorString(e), grid_blocks);
#endif
}
```

```cpp
#include <hip/hip_runtime.h>
#include <hip/hip_cooperative_groups.h>
#include <cstdio>
namespace cg = cooperative_groups;

#ifndef MULTI_LAUNCH
#define MULTI_LAUNCH 0
#endif

typedef unsigned short u16;
using bf16x8 = __attribute__((ext_vector_type(8))) short;
using f32x4 = __attribute__((ext_vector_type(4))) float;
typedef _Float16 h4 __attribute__((ext_vector_type(4)));

#define TOK 12288
#define NPROMPT 8192
#define KVROWS 14336
#define NPHASES 23
#ifndef PHMASK
#define PHMASK 0x7fffff
#endif
#define DN_ALPHA 1.6817928305074290f

#define WS_W_HG_IN 0ull
#define WS_W_HG_OUT (WS_W_HG_IN + 10485760ull)
#define WS_W_SC_IN (WS_W_HG_OUT + 2097152ull)
#define WS_W_SC_OUT (WS_W_SC_IN + 8388608ull)
#define WS_W_RG_IN (WS_W_SC_OUT + 2097152ull)
#define WS_W_RG_GATE (WS_W_RG_IN + 4194304ull)
#define WS_W_RG_OUT (WS_W_RG_GATE + 2097152ull)
#define WS_W_MLA_IN (WS_W_RG_OUT + 2097152ull)
#define WS_W_QB (WS_W_MLA_IN + 3670016ull)
#define WS_W_KVB (WS_W_QB + 1179648ull)
#define WS_W_MLA_OUT (WS_W_KVB + 1048576ull)
#define WS_MOD (WS_W_MLA_OUT + 2097152ull)
#define WS_LB (WS_MOD + 245760ull)
#define WS_CNT (WS_LB + 8192ull)
#define WS_R (WS_CNT + 4096ull + 16384ull)
#define BSZ 25165824ull
#define WS_H (WS_R)
#define WS_B(i) (WS_R + BSZ * (1 + (i)))
#define WS_SLOT (WS_R + 201326592ull)
#define WS_XB (WS_SLOT + 1572864ull)
#define WS3_CQ (WS_R + 25165824ull)
#define WS3_CKVALL (WS_R + 34603008ull)
#define WS3_CKVRAW (WS_R + 41943040ull)
#define WS3_KPERAW (WS_R + 54525952ull)
#define WS3_SG (WS_R + 56098816ull)
#define WS3_Q (WS_R + 81264640ull)
#define WS3_K (WS_R + 119013376ull)
#define WS3_VT (WS_R + 163053568ull)

#define OUT_HG 12582912
#define OUT_RG 20971520
#define OUT_CKV 21037056
#define OUT_KPE 23134208

struct Params {
  const float* in[33];
  float* out;
  unsigned char* ws;
  int phase_lo, phase_hi, flags, pad_;
};

__device__ __forceinline__ u16 f2bf(float f) { __bf16 r = (__bf16)f; return *(u16*)&r; }
__device__ __forceinline__ float bf2f(u16 h) { return __uint_as_float(((unsigned)h) << 16); }
typedef float f2v_ __attribute__((ext_vector_type(2)));
typedef __bf16 b2v_ __attribute__((ext_vector_type(2)));
__device__ __forceinline__ unsigned pack2(float a, float b) { f2v_ f = {a, b}; b2v_ r = __builtin_convertvector(f, b2v_); return *(unsigned*)&r; }
__device__ __forceinline__ uint2 pack4(float a, float b, float c, float d) { return make_uint2(pack2(a, b), pack2(c, d)); }
__device__ __forceinline__ float lo16(unsigned u) { return __uint_as_float(u << 16); }
__device__ __forceinline__ float hi16(unsigned u) { return __uint_as_float(u & 0xffff0000u); }
__device__ __forceinline__ float sigmoidf_(float x) { return __builtin_amdgcn_rcpf(1.0f + __expf(-x)); }
__device__ __forceinline__ float siluf_(float x) { return x * __builtin_amdgcn_rcpf(1.0f + __expf(-x)); }
__device__ __forceinline__ int cond_of(int tok) { return tok < NPROMPT ? 0 : 1 + ((tok - NPROMPT) >> 10); }
__device__ __forceinline__ float wave_sum(float v) {
#pragma unroll
  for (int o = 32; o > 0; o >>= 1) v += __shfl_xor(v, o);
  return v;
}
__device__ __forceinline__ void rope_sincos(float pos, int fi, float& sn, float& cs) {
  float inv = exp2f(-(float)fi * 1.6609640474436813f);
  float ang = pos * inv;
  float k = rintf(ang * 0.15915494309189535f);
  float r = fmaf(-k, 6.2831854820251465f, ang);
  r = fmaf(-k, -1.7484555e-7f, r);
  sn = __sinf(r); cs = __cosf(r);
}

#define NT 512
#define NW 8
#define LAS __attribute__((address_space(3)))

namespace pg8 {
constexpr int BM = 256, BK = 64, HALF = 128, HTB = HALF * BK * 2, STAGE_BYTES = 8 * HTB, NXCD = 8, WGM = 8;
__device__ __forceinline__ int lds_byte(int r, int c) { const int st = (r >> 4) * 2 + (c >> 5), rr = r & 15, cc = c & 31, ob = rr * 64 + cc * 2; return st * 1024 + (ob ^ (((ob >> 9) & 1) << 5)); }
__device__ __forceinline__ void stage_rc(int b, int& R, int& C) { const int st = b / 1024, sb = b % 1024, swz = sb ^ (((sb >> 9) & 1) << 5); R = (st >> 1) * 16 + swz / 64; C = (st & 1) * 32 + (swz % 64) / 2; }
struct Unit { int pm, pn; };
struct Gemm { const u16* A; const u16* Bt; int M, N, K, lda, gate, noepi; size_t kstepA, gstride; };
struct StaticOrder {
  int nM, nN, nwg, G, c, ubeg, uend;
  __device__ void init(int M, int N, int G_, int c_) { nM = M / BM; nN = N / BM; nwg = nM * nN; G = G_; c = c_; ubeg = 0; uend = nwg; }
  __device__ bool next(int i, Unit& u) const {
    const long L = (long)ubeg + (long)i * G + c; if (L >= uend) return false;
    int wgid = (int)L; { const int q = nwg / NXCD, r = nwg % NXCD, xcd = wgid % NXCD, off = wgid / NXCD; wgid = (xcd < r ? xcd * (q + 1) : r * (q + 1) + (xcd - r) * q) + off; }
    const int nig = WGM * nN, gid = wgid / nig, fm = gid * WGM, gsz = (nM - fm) < WGM ? (nM - fm) : WGM;
    u.pm = fm + ((wgid % nig) % gsz); u.pn = (wgid % nig) / gsz; return true;
  }
};
template <class Epi>
__device__ __forceinline__ void gemm_phase(LAS unsigned char* lds, const Gemm g, const StaticOrder& S, const Epi& E) {
  const int tid = threadIdx.x, wid = __builtin_amdgcn_readfirstlane(tid >> 6), lane = tid & 63, wr = wid >> 2, wc = wid & 3, fr = lane & 15, fq = lane >> 4;
  const int K = g.K, nt = K / BK;
  unsigned voffA[2], voffB[2];
#pragma unroll
  for (int i = 0; i < 2; ++i) { int R, C; stage_rc(tid * 16 + i * 8192, R, C); voffA[i] = (unsigned)(R * g.lda + C) * 2u; voffB[i] = (unsigned)(R * K + C) * 2u; }
  const size_t kstep = (size_t)(BK * 2);
  const size_t kstepA = g.kstepA;
  const size_t hstepA = (size_t)HALF * g.lda * 2, hstepB = (size_t)HALF * K * 2;
  const size_t tstepA = 2 * hstepA, tstepB = 2 * hstepB;
  const unsigned ldsw = (unsigned)wid * 1024u;
  const int aoff = lds_byte(wr * 64 + fr, fq * 8), boff = lds_byte(wc * 32 + fr, fq * 8);
#define PG8_AOFF(pn) (g.gate ? (size_t)(((pn) >> 1) & 3) * g.gstride : (size_t)0)
#define PG8_SA(b, h) (((b) * 2 + (h)) * HTB)
#define PG8_SB(b, h) ((4 + (b) * 2 + (h)) * HTB)
#define PG8_STAGE(bufoff, gbase, voff) do { _Pragma("unroll") for (int _i = 0; _i < 2; ++_i) \
    __builtin_amdgcn_global_load_lds((const unsigned*)((const char*)(gbase) + (voff)[_i]), (LAS unsigned*)(lds + (bufoff) + ldsw + _i * 8192), 16, 0, 0); } while (0)
#define PG8_LDA(dst, b, h) do { _Pragma("unroll") for (int m = 0; m < 4; ++m) _Pragma("unroll") for (int k = 0; k < 2; ++k) dst[m][k] = *(const LAS bf16x8*)(lds + PG8_SA(b, h) + aoff + m * 2048 + k * 1024); } while (0)
#define PG8_LDB(dst, b, h) do { _Pragma("unroll") for (int n = 0; n < 2; ++n) _Pragma("unroll") for (int k = 0; k < 2; ++k) dst[n][k] = *(const LAS bf16x8*)(lds + PG8_SB(b, h) + boff + n * 2048 + k * 1024); } while (0)
#define PG8_MMA(ai, bj, At, Bt) do { __builtin_amdgcn_s_setprio(1); _Pragma("unroll") for (int m = 0; m < 4; ++m) _Pragma("unroll") for (int n = 0; n < 2; ++n) _Pragma("unroll") for (int k = 0; k < 2; ++k) \
    acc[ai][bj][m][n] = __builtin_amdgcn_mfma_f32_16x16x32_bf16(Bt[n][k], At[m][k], acc[ai][bj][m][n], 0, 0, 0); __builtin_amdgcn_s_setprio(0); } while (0)
#define PG8_WAIT_V(n) asm volatile("s_waitcnt vmcnt(" #n ")" ::: "memory")
#define PG8_WAIT_L(n) asm volatile("s_waitcnt lgkmcnt(" #n ")" ::: "memory")
#define PG8_BAR __builtin_amdgcn_s_barrier()
#define PG8_SCHED __builtin_amdgcn_sched_barrier(0)
  Unit cur, nxt; int ui = 0;
  if (!S.next(0, cur)) return;
  f32x4 acc[2][2][4][2];
#pragma unroll
  for (int a = 0; a < 2; ++a)
#pragma unroll
    for (int b = 0; b < 2; ++b)
#pragma unroll
      for (int m = 0; m < 4; ++m)
#pragma unroll
        for (int n = 0; n < 2; ++n) acc[a][b][m][n] = (f32x4){0.f, 0.f, 0.f, 0.f};
  bf16x8 At[4][2], B0[2][2], B1[2][2];
  const char* cA = (const char*)g.A + (size_t)cur.pm * tstepA + PG8_AOFF(cur.pn); const char* cB = (const char*)g.Bt + (size_t)cur.pn * tstepB;
  PG8_STAGE(PG8_SB(0, 0), cB, voffB); PG8_STAGE(PG8_SA(0, 0), cA, voffA); PG8_STAGE(PG8_SB(0, 1), cB + hstepB, voffB); PG8_STAGE(PG8_SA(0, 1), cA + hstepA, voffA);
  if (wr == 1) PG8_BAR;
  PG8_WAIT_V(4); PG8_BAR;
  PG8_STAGE(PG8_SB(1, 0), cB + kstep, voffB); PG8_STAGE(PG8_SA(1, 0), cA + kstepA, voffA); PG8_STAGE(PG8_SB(1, 1), cB + hstepB + kstep, voffB);
  PG8_WAIT_V(6); PG8_BAR;
  for (;;) {
    const bool has_next = S.next(ui + 1, nxt);
    const char* nA = has_next ? (const char*)g.A + (size_t)nxt.pm * tstepA + PG8_AOFF(nxt.pn) : cA; const char* nB = has_next ? (const char*)g.Bt + (size_t)nxt.pn * tstepB : cB;
#pragma unroll 1
    for (int t = 0; t < nt; t += 2) {
      const bool last = (t == nt - 2);
      const char* a1 = cA + (size_t)(t + 1) * kstepA;
      const char* a2 = last ? nA : cA + (size_t)(t + 2) * kstepA; const char* b2 = last ? nB : cB + (size_t)(t + 2) * kstep;
      const char* a3 = a2 + kstepA; const char* b3 = b2 + kstep;
      PG8_LDB(B0, 0, 0); PG8_SCHED; PG8_LDA(At, 0, 0); PG8_STAGE(PG8_SA(1, 1), a1 + hstepA, voffA);
      PG8_WAIT_L(8); PG8_BAR; PG8_WAIT_L(0); PG8_MMA(0, 0, At, B0); PG8_BAR; PG8_SCHED;
      PG8_LDB(B1, 0, 1); PG8_STAGE(PG8_SB(0, 0), b2, voffB);
      PG8_BAR; PG8_WAIT_L(0); PG8_MMA(0, 1, At, B1); PG8_BAR;
      PG8_LDA(At, 0, 1); PG8_STAGE(PG8_SA(0, 0), a2, voffA);
      PG8_BAR; PG8_WAIT_L(0); PG8_MMA(1, 0, At, B0); PG8_BAR; PG8_SCHED;
      PG8_STAGE(PG8_SB(0, 1), b2 + hstepB, voffB);
      PG8_WAIT_V(6); PG8_BAR; PG8_MMA(1, 1, At, B1); PG8_BAR;
      PG8_LDB(B0, 1, 0); PG8_SCHED; PG8_LDA(At, 1, 0); PG8_STAGE(PG8_SA(0, 1), a2 + hstepA, voffA);
      PG8_WAIT_L(8); PG8_BAR; PG8_WAIT_L(0); PG8_MMA(0, 0, At, B0); PG8_BAR; PG8_SCHED;
      PG8_LDB(B1, 1, 1); PG8_STAGE(PG8_SB(1, 0), b3, voffB);
      PG8_BAR; PG8_WAIT_L(0); PG8_MMA(0, 1, At, B1); PG8_BAR;
      PG8_LDA(At, 1, 1); PG8_STAGE(PG8_SA(1, 0), a3, voffA);
      PG8_BAR; PG8_WAIT_L(0); PG8_MMA(1, 0, At, B0); PG8_BAR; PG8_SCHED;
      PG8_STAGE(PG8_SB(1, 1), b3 + hstepB, voffB);
      PG8_WAIT_V(6); PG8_BAR; PG8_MMA(1, 1, At, B1); PG8_BAR;
    }
    if constexpr (!Epi::AFTER_DRAIN) { if (!g.noepi) E(acc, cur, wr, wc, fr, fq); }
    if (!has_next) break;
#pragma unroll
    for (int a = 0; a < 2; ++a)
#pragma unroll
      for (int b = 0; b < 2; ++b)
#pragma unroll
        for (int m = 0; m < 4; ++m)
#pragma unroll
          for (int n = 0; n < 2; ++n) acc[a][b][m][n] = (f32x4){0.f, 0.f, 0.f, 0.f};
    cur = nxt; cA = nA; cB = nB; ++ui;
  }
  PG8_WAIT_V(0);
  if (wr == 0) PG8_BAR;
  PG8_BAR;
  if constexpr (Epi::AFTER_DRAIN) { if (!g.noepi) E.fused(acc, cur, wr, wc, fr, fq, lds); }
#undef PG8_AOFF
#undef PG8_SA
#undef PG8_SB
#undef PG8_STAGE
#undef PG8_LDA
#undef PG8_LDB
#undef PG8_MMA
#undef PG8_WAIT_V
#undef PG8_WAIT_L
#undef PG8_BAR
#undef PG8_SCHED
}
}
using pg8::Unit;
typedef const f32x4 (&AccRef)[2][2][4][2];

#define EPI_ROWS(...) _Pragma("unroll") for (int ai = 0; ai < 2; ++ai) _Pragma("unroll") for (int m = 0; m < 4; ++m) { const int row = u.pm * 256 + ai * 128 + wr * 64 + m * 16 + fr; __VA_ARGS__ }
#define EPI_COLS(...) _Pragma("unroll") for (int bj = 0; bj < 2; ++bj) _Pragma("unroll") for (int n = 0; n < 2; ++n) { const int cb = u.pn * 256 + bj * 128 + wc * 32 + n * 16; const f32x4 a = acc[ai][bj][m][n]; __VA_ARGS__ }

struct EpiHgIn {
  static constexpr bool AFTER_DRAIN = false;
  u16 *q, *v, *sg; _Float16* lf; const float* lb;
  __device__ __forceinline__ void operator()(AccRef acc, const Unit& u, int wr, int wc, int fr, int fq) const {
    const int region = u.pn >> 2;
    f32x4 l4[2][2];
    if (region == 1 || region == 2) {
#pragma unroll
      for (int bj = 0; bj < 2; ++bj)
#pragma unroll
        for (int n = 0; n < 2; ++n) l4[bj][n] = *(const f32x4*)&lb[(region - 1) * 1024 + ((u.pn * 256 + bj * 128 + wc * 32 + n * 16) & 1023) + fq * 4];
    }
    EPI_ROWS( EPI_COLS(
      const int c = (cb & 1023) + fq * 4;
      if (region == 0) {
        const float s = 0.08838834764831845f;
        *(uint2*)&q[(size_t)row * 1024 + c] = pack4(siluf_(a[0]) * s, siluf_(a[1]) * s, siluf_(a[2]) * s, siluf_(a[3]) * s);
      } else if (region <= 2) {
        const int d = region - 1;
        h4 o;
        _Pragma("unroll") for (int j = 0; j < 4; ++j) { float f = l4[bj][n][j] + (1.0f - l4[bj][n][j]) * sigmoidf_(a[j]); o[j] = (_Float16)__builtin_amdgcn_logf(f); }
        *(h4*)&lf[(size_t)row * 2048 + d * 1024 + c] = o;
      } else if (region == 3) {
        *(uint2*)&v[(size_t)row * 1024 + c] = pack4(a[0], a[1], a[2], a[3]);
      } else {
        *(uint2*)&sg[(size_t)row * 1024 + c] = pack4(a[0], a[1], a[2], a[3]);
      }
    ) )
  }
};

struct EpiRes {
  static constexpr bool AFTER_DRAIN = false;
  const float* xin_p; const float* xin_s; float* Y; const float* gate;
  __device__ __forceinline__ void operator()(AccRef acc, const Unit& u, int wr, int wc, int fr, int fq) const {
    EPI_ROWS(
      const float* xr = row < NPROMPT ? xin_p + (size_t)row * 1024 : xin_s + (size_t)(row - NPROMPT) * 1024;
      const float* g = gate + cond_of(row) * 3072;
      EPI_COLS(
        const int c = cb + fq * 4;
        f32x4 x = *(const f32x4*)&xr[c];
        f32x4 gg = *(const f32x4*)&g[c];
        f32x4 y;
        _Pragma("unroll") for (int j = 0; j < 4; ++j) y[j] = DN_ALPHA * x[j] + gg[j] * a[j];
        *(f32x4*)&Y[(size_t)row * 1024 + c] = y;
      ) )
  }
};

template <bool XIN_BF, bool XOUT_BF>
struct EpiResLn {
  static constexpr bool AFTER_DRAIN = true;
  const float* xin_p; const float* xin_s; const u16* xin_b; float* X; u16* XB; const float* gate; const float* lg; const float* lbias; const float* modn; u16* H;
  unsigned long long* slots; unsigned* cnt;
  __device__ __forceinline__ void fused(f32x4 (&acc)[2][2][4][2], const Unit& u, int wr, int wc, int fr, int fq, LAS unsigned char* lds) const {
    LAS float* part = (LAS float*)lds;
    LAS float* stat = part + 2048;
    const int tid = threadIdx.x;
    const int cnd = cond_of(u.pm * 256);
    f32x4 gv[2][2];
#pragma unroll
    for (int bj = 0; bj < 2; ++bj)
#pragma unroll
      for (int n = 0; n < 2; ++n) gv[bj][n] = *(const f32x4*)&gate[cnd * 3072 + u.pn * 256 + bj * 128 + wc * 32 + n * 16 + fq * 4];
#pragma unroll
    for (int ai = 0; ai < 2; ++ai)
#pragma unroll
      for (int m = 0; m < 4; ++m) {
        const int rl = ai * 128 + wr * 64 + m * 16 + fr;
        const int row = u.pm * 256 + rl;
        const float* xr = row < NPROMPT ? xin_p + (size_t)row * 1024 : xin_s + (size_t)(row - NPROMPT) * 1024;
        float s1 = 0.f, s2 = 0.f;
#pragma unroll
        for (int bj = 0; bj < 2; ++bj)
#pragma unroll
          for (int n = 0; n < 2; ++n) {
            const int c = u.pn * 256 + bj * 128 + wc * 32 + n * 16 + fq * 4;
            f32x4 x;
            if constexpr (XIN_BF) { const uint2 xb2 = *(const uint2*)&xin_b[(size_t)row * 1024 + c]; x = f32x4{lo16(xb2.x), hi16(xb2.x), lo16(xb2.y), hi16(xb2.y)}; }
            else x = *(const f32x4*)&xr[c];
            const f32x4 gg = gv[bj][n];
            f32x4 y;
#pragma unroll
            for (int j = 0; j < 4; ++j) { y[j] = DN_ALPHA * x[j] + gg[j] * acc[ai][bj][m][n][j]; s1 += y[j]; s2 += y[j] * y[j]; }
            acc[ai][bj][m][n] = y;
          }
        s1 += __shfl_xor(s1, 16); s1 += __shfl_xor(s1, 32);
        s2 += __shfl_xor(s2, 16); s2 += __shfl_xor(s2, 32);
        if (fq == 0) { part[(rl * 4 + wc) * 2] = s1; part[(rl * 4 + wc) * 2 + 1] = s2; }
      }
    __syncthreads();
    if (tid < 256) {
      float S1 = 0.f, S2 = 0.f;
#pragma unroll
      for (int w2 = 0; w2 < 4; ++w2) { S1 += part[(tid * 4 + w2) * 2]; S2 += part[(tid * 4 + w2) * 2 + 1]; }
      const unsigned long long v = (unsigned long long)__float_as_uint(S1) | ((unsigned long long)__float_as_uint(S2) << 32);
      __hip_atomic_store(&slots[(size_t)(u.pm * 4 + u.pn) * 256 + tid], v, __ATOMIC_RELAXED, __HIP_MEMORY_SCOPE_AGENT);
    }
    asm volatile("s_waitcnt vmcnt(0)" ::: "memory");
    __syncthreads();
    if (tid == 0) {
      __hip_atomic_fetch_add(&cnt[u.pm], 1u, __ATOMIC_RELAXED, __HIP_MEMORY_SCOPE_AGENT);
      unsigned sp = 0;
      while (__hip_atomic_load(&cnt[u.pm], __ATOMIC_RELAXED, __HIP_MEMORY_SCOPE_AGENT) < 4u) { __builtin_amdgcn_s_sleep(1); if (++sp > (1u << 24)) break; }
    }
    __syncthreads();
    if (tid < 256) {
      float T1 = 0.f, T2 = 0.f;
#pragma unroll
      for (int o = 0; o < 4; ++o) {
        const unsigned long long v = __hip_atomic_load(&slots[(size_t)(u.pm * 4 + o) * 256 + tid], __ATOMIC_RELAXED, __HIP_MEMORY_SCOPE_AGENT);
        T1 += __uint_as_float((unsigned)(v & 0xffffffffull)); T2 += __uint_as_float((unsigned)(v >> 32));
      }
      const float mu = T1 * (1.0f / 1024.0f);
      const float var = fmaxf(T2 * (1.0f / 1024.0f) - mu * mu, 0.f);
      stat[tid * 2] = mu; stat[tid * 2 + 1] = rsqrtf(var + 1e-5f);
    }
    __syncthreads();
#pragma unroll
    for (int bj = 0; bj < 2; ++bj) {
      f32x4 lgv[2], lbv[2], shv[2], scv[2];
#pragma unroll
      for (int n = 0; n < 2; ++n) {
        const int c = u.pn * 256 + bj * 128 + wc * 32 + n * 16 + fq * 4;
        lgv[n] = *(const f32x4*)&lg[c]; lbv[n] = *(const f32x4*)&lbias[c];
        shv[n] = *(const f32x4*)&modn[cnd * 3072 + c]; scv[n] = *(const f32x4*)&modn[cnd * 3072 + 1024 + c];
      }
#pragma unroll
      for (int ai = 0; ai < 2; ++ai)
#pragma unroll
        for (int m = 0; m < 4; ++m) {
          const int rl = ai * 128 + wr * 64 + m * 16 + fr;
          const int row = u.pm * 256 + rl;
          const float mu = stat[rl * 2], rs = stat[rl * 2 + 1];
#pragma unroll
          for (int n = 0; n < 2; ++n) {
            const int c = u.pn * 256 + bj * 128 + wc * 32 + n * 16 + fq * 4;
            const f32x4 y = acc[ai][bj][m][n];
            f32x4 xo;
#pragma unroll
            for (int j = 0; j < 4; ++j) xo[j] = (y[j] - mu) * rs * lgv[n][j] + lbv[n][j];
            if constexpr (XOUT_BF) *(uint2*)&XB[(size_t)row * 1024 + c] = pack4(xo[0], xo[1], xo[2], xo[3]);
            else *(f32x4*)&X[(size_t)row * 1024 + c] = xo;
            if (H) {
              *(uint2*)&H[(size_t)row * 1024 + c] = pack4(xo[0] * (1 + scv[n][0]) + shv[n][0], xo[1] * (1 + scv[n][1]) + shv[n][1], xo[2] * (1 + scv[n][2]) + shv[n][2], xo[3] * (1 + scv[n][3]) + shv[n][3]);
            }
          }
        }
    }
  }
};

struct EpiScIn {
  static constexpr bool AFTER_DRAIN = false;
  u16 *pb, *sb;
  __device__ __forceinline__ void operator()(AccRef acc, const Unit& u, int wr, int wc, int fr, int fq) const {
    const int c = u.pn * 64 + wc * 16 + fq * 4;
    EPI_ROWS(
      const f32x4 bg = acc[ai][0][m][0], cgv = acc[ai][0][m][1], v = acc[ai][1][m][0], g = acc[ai][1][m][1];
      *(uint2*)&pb[(size_t)row * 1024 + c] = pack4(cgv[0] * v[0], cgv[1] * v[1], cgv[2] * v[2], cgv[3] * v[3]);
      *(uint2*)&sb[(size_t)row * 1024 + c] = pack4(siluf_(g[0]) * bg[0], siluf_(g[1]) * bg[1], siluf_(g[2]) * bg[2], siluf_(g[3]) * bg[3]);
    )
  }
};

struct EpiRgIn {
  static constexpr bool AFTER_DRAIN = false;
  u16 *ub, *sg;
  __device__ __forceinline__ void operator()(AccRef acc, const Unit& u, int wr, int wc, int fr, int fq) const {
    const int region = u.pn >> 2;
    EPI_ROWS( EPI_COLS(
      const int c = (cb & 1023) + fq * 4;
      if (region == 0) *(uint2*)&ub[(size_t)row * 1024 + c] = pack4(a[0], a[1], a[2], a[3]);
      else *(uint2*)&sg[((size_t)(c >> 6) * TOK + row) * 64 + (c & 63)] = pack4(siluf_(a[0]), siluf_(a[1]), siluf_(a[2]), siluf_(a[3]));
    ) )
  }
};

struct EpiRgGate {
  static constexpr bool AFTER_DRAIN = false;
  u16 *rb, *ib; const float* bgate;
  __device__ __forceinline__ void operator()(AccRef acc, const Unit& u, int wr, int wc, int fr, int fq) const {
    const int mat = u.pn >> 1, d = mat >> 2, hd = mat & 3;
    f32x4 br[2], bi[2]; int ccs[2];
#pragma unroll
    for (int bj = 0; bj < 2; ++bj) {
      const int off = ((u.pn & 1) * 256 + bj * 128 + wc * 32);
      ccs[bj] = (off >> 5) * 16 + fq * 4;
      br[bj] = *(const f32x4*)&bgate[mat * 512 + ccs[bj]];
      bi[bj] = *(const f32x4*)&bgate[mat * 512 + 256 + ccs[bj]];
    }
    EPI_ROWS(
      _Pragma("unroll") for (int bj = 0; bj < 2; ++bj) {
        const f32x4 r = acc[ai][bj][m][0], ii = acc[ai][bj][m][1];
        const int cch = hd * 256 + ccs[bj];
        const size_t o = (size_t)d * TOK * 1024 + ((size_t)(cch >> 6) * TOK + row) * 64 + (cch & 63);
        *(uint2*)&rb[o] = pack4(sigmoidf_(r[0] + br[bj][0]), sigmoidf_(r[1] + br[bj][1]), sigmoidf_(r[2] + br[bj][2]), sigmoidf_(r[3] + br[bj][3]));
        *(uint2*)&ib[o] = pack4(sigmoidf_(ii[0] + bi[bj][0]), sigmoidf_(ii[1] + bi[bj][1]), sigmoidf_(ii[2] + bi[bj][2]), sigmoidf_(ii[3] + bi[bj][3]));
      } )
  }
};

struct EpiMlaIn {
  static constexpr bool AFTER_DRAIN = false;
  u16* cq; float* ckvraw; float* kperaw; u16* sg;
  __device__ __forceinline__ void operator()(AccRef acc, const Unit& u, int wr, int wc, int fr, int fq) const {
    EPI_ROWS( EPI_COLS(
      const int c = cb + fq * 4;
      if (cb < 384) *(uint2*)&cq[(size_t)row * 384 + c] = pack4(a[0], a[1], a[2], a[3]);
      else if (cb < 640) *(f32x4*)&ckvraw[(size_t)row * 256 + (c - 384)] = a;
      else if (cb < 672) *(f32x4*)&kperaw[(size_t)row * 32 + (c - 640)] = a;
    ) )
  }
};

struct EpiSg {
  static constexpr bool AFTER_DRAIN = false;
  u16* sg;
  __device__ __forceinline__ void operator()(AccRef acc, const Unit& u, int wr, int wc, int fr, int fq) const {
    EPI_ROWS( EPI_COLS(
      *(uint2*)&sg[(size_t)row * 1024 + cb + fq * 4] = pack4(a[0], a[1], a[2], a[3]);
    ) )
  }
};

struct EpiQ {
  static constexpr bool AFTER_DRAIN = false;
  u16* q;
  __device__ __forceinline__ void operator()(AccRef acc, const Unit& u, int wr, int wc, int fr, int fq) const {
    const float sc = 0.14724444500602648f;
    EPI_ROWS( EPI_COLS(
      *(uint2*)&q[(size_t)row * 1536 + cb + fq * 4] = pack4(a[0] * sc, a[1] * sc, a[2] * sc, a[3] * sc);
    ) )
  }
};

struct EpiK {
  static constexpr bool AFTER_DRAIN = false;
  u16* Kb;
  __device__ __forceinline__ void operator()(AccRef acc, const Unit& u, int wr, int wc, int fr, int fq) const {
    EPI_ROWS( EPI_COLS(
      const int h = cb >> 6, dd = (cb & 63) + fq * 4;
      *(uint2*)&Kb[((size_t)row * 16 + h) * 96 + dd] = pack4(a[0], a[1], a[2], a[3]);
    ) )
  }
};
struct EpiV {
  static constexpr bool AFTER_DRAIN = false;
  u16* Vt;
  __device__ __forceinline__ void operator()(AccRef acc, const Unit& u, int wr, int wc, int fr, int fq) const {
    EPI_ROWS( EPI_COLS(
      *(uint2*)&Vt[(size_t)row * KVROWS + cb + fq * 4] = pack4(a[0], a[1], a[2], a[3]);
    ) )
  }
};

__device__ __forceinline__ void wconv_tile(const float* __restrict__ src, int N, int K, u16* __restrict__ dst, int k0, int n0,
                                           int perm, int mat, float* tile) {
  const int tid = threadIdx.x;
  {
    const int r = tid >> 4, c4 = (tid & 15) * 4;
#pragma unroll
    for (int i = 0; i < 2; ++i) {
      const int k = r + i * 32;
      f32x4 v = f32x4{0.f, 0.f, 0.f, 0.f};
      if (n0 + c4 < N) v = *(const f32x4*)&src[(size_t)(k0 + k) * N + n0 + c4];
      tile[k * 65 + c4 + 0] = v[0]; tile[k * 65 + c4 + 1] = v[1]; tile[k * 65 + c4 + 2] = v[2]; tile[k * 65 + c4 + 3] = v[3];
    }
  }
  __syncthreads();
  {
    const int nl = tid >> 3, kq = (tid & 7) * 8;
    const int n = n0 + nl;
    int np = n;
    if (perm == 1) { const int part = n >> 10, c = n & 1023; np = (c >> 6) * 256 + (part >> 1) * 128 + ((c >> 4) & 3) * 32 + (part & 1) * 16 + (c & 15); }
    else if (perm == 2) { const int type = n >> 8, cc = n & 255; np = mat * 512 + (cc >> 4) * 32 + type * 16 + (cc & 15); }
    else if (perm == 3) { const int hh = n >> 7, dd = n & 127; np = (dd >= 64 ? 1024 : 0) + hh * 64 + (dd & 63); }
    if (n < N) {
      unsigned w[4];
#pragma unroll
      for (int i = 0; i < 4; ++i) w[i] = pack2(tile[(kq + 2 * i) * 65 + nl], tile[(kq + 2 * i + 1) * 65 + nl]);
      *(uint4*)&dst[(size_t)np * K + k0 + kq] = make_uint4(w[0], w[1], w[2], w[3]);
    }
  }
  __syncthreads();
}

__device__ __forceinline__ void wconv_item(const Params& p, int t, float* fs) {
  const float* src; u16* dst; int N, K, perm = 0, mat = 0, ntn;
  if (t < 1280) { src = p.in[12]; dst = (u16*)(p.ws + WS_W_HG_IN); N = 5120; K = 1024; }
  else if ((t -= 1280) < 256) { src = p.in[15]; dst = (u16*)(p.ws + WS_W_HG_OUT); N = 1024; K = 1024; }
  else if ((t -= 256) < 1024) { src = p.in[16]; dst = (u16*)(p.ws + WS_W_SC_IN); N = 4096; K = 1024; perm = 1; }
  else if ((t -= 1024) < 256) { src = p.in[19]; dst = (u16*)(p.ws + WS_W_SC_OUT); N = 1024; K = 1024; }
  else if ((t -= 256) < 512) { src = p.in[20]; dst = (u16*)(p.ws + WS_W_RG_IN); N = 2048; K = 1024; }
  else if ((t -= 512) < 256) { mat = t >> 5; t &= 31; src = p.in[23] + (size_t)mat * 256 * 512; dst = (u16*)(p.ws + WS_W_RG_GATE); N = 512; K = 256; perm = 2; }
  else if ((t -= 256) < 256) { src = p.in[26]; dst = (u16*)(p.ws + WS_W_RG_OUT); N = 1024; K = 1024; }
  else if ((t -= 256) < 432) { src = p.in[27]; dst = (u16*)(p.ws + WS_W_MLA_IN); N = 1696; K = 1024; }
  else if ((t -= 432) < 144) { src = p.in[30]; dst = (u16*)(p.ws + WS_W_QB); N = 1536; K = 384; }
  else if ((t -= 144) < 128) { src = p.in[31]; dst = (u16*)(p.ws + WS_W_KVB); N = 2048; K = 256; perm = 3; }
  else { t -= 128; src = p.in[32]; dst = (u16*)(p.ws + WS_W_MLA_OUT); N = 1024; K = 1024; }
  ntn = (N + 63) >> 6;
  const int kt = t / ntn, ntl = t - kt * ntn;
  wconv_tile(src, N, K, dst, kt * 64, ntl * 64, perm, mat, fs);
}
__device__ __forceinline__ void wconv_idle(const Params& p, unsigned char* smem_raw, int bid, int nb, int t0, int t1) {
  if (nb == 256 && bid >= 192) for (int t = t0 + (bid - 192); t < t1; t += 64) wconv_item(p, t, (float*)smem_raw);
}

__device__ __forceinline__ void phase_prologue(const Params& p, unsigned char* smem_raw, int bid, int nb) {
  float* fs = (float*)smem_raw;
  const int tid = threadIdx.x;
  const int NMOD = 192, NWT = (nb == 256) ? 1536 : 4800;
  for (int it = bid; it < NMOD + 1 + NWT; it += nb) {
    if (it < NMOD) {
      const int l = it / 48, n0 = (it % 48) * 64;
      float* scond = fs;
      float* sred = fs + 5120;
      for (int i = tid; i < 5120; i += NT) {
        const int ci = i >> 10, k = i & 1023;
        float cv = ci == 0 ? p.in[7][k] : p.in[6][(ci - 1) * 1024 + k];
        scond[i] = siluf_(cv);
      }
      __syncthreads();
      const int col = tid & 63, kg = tid >> 6;
      const float* w = p.in[8] + (size_t)l * 1024 * 3072 + n0 + col;
      float a0 = 0, a1 = 0, a2 = 0, a3 = 0, a4 = 0;
#pragma unroll 16
      for (int k = kg * 128; k < kg * 128 + 128; ++k) {
        float wv = w[(size_t)k * 3072];
        a0 += scond[k] * wv; a1 += scond[1024 + k] * wv; a2 += scond[2048 + k] * wv; a3 += scond[3072 + k] * wv; a4 += scond[4096 + k] * wv;
      }
      sred[(kg * 5 + 0) * 64 + col] = a0; sred[(kg * 5 + 1) * 64 + col] = a1; sred[(kg * 5 + 2) * 64 + col] = a2;
      sred[(kg * 5 + 3) * 64 + col] = a3; sred[(kg * 5 + 4) * 64 + col] = a4;
      __syncthreads();
      float* mod = (float*)(p.ws + WS_MOD);
      if (tid < 320) {
        const int ci = tid >> 6, cc = tid & 63;
        float s = 0;
#pragma unroll
        for (int g = 0; g < 8; ++g) s += sred[(g * 5 + ci) * 64 + cc];
        mod[(l * 5 + ci) * 3072 + n0 + cc] = s + p.in[9][l * 3072 + n0 + cc];
      }
      __syncthreads();
    } else if (it == NMOD) {
      float* lb = (float*)(p.ws + WS_LB);
      for (int i = tid; i < 2048; i += NT) {
        const int d = i >> 10, c = i & 1023;
        const float* lg = p.in[13] + d * 5 * 1024 + c;
        float m = lg[0];
        for (int j = 1; j < 5; ++j) m = fmaxf(m, lg[j * 1024]);
        float s = 0;
        for (int j = 0; j < 5; ++j) s += expf(lg[j * 1024] - m);
        lb[i] = expf(lg[0] - m) / s;
      }
      int* cnt = (int*)(p.ws + WS_CNT);
      if (tid < 16) cnt[tid] = 0;
    } else {
      wconv_item(p, it - NMOD - 1, fs);
    }
  }
}

__device__ __forceinline__ void phase_h0(const Params& p, int bid, int nb) {
  const float* mod = (const float*)(p.ws + WS_MOD);
  u16* H = (u16*)(p.ws + WS_H);
  const size_t total = (size_t)(TOK / 4) * 256;
  for (size_t i = (size_t)bid * NT + threadIdx.x; i < total; i += (size_t)nb * NT) {
    const int row = (int)(i >> 8) * 4, c = ((int)i & 255) * 4;
    const float* xr = row < NPROMPT ? p.in[0] + (size_t)row * 1024 : p.in[1] + (size_t)(row - NPROMPT) * 1024;
    const float* m = mod + cond_of(row) * 3072;
    f32x4 x[4];
#pragma unroll
    for (int t = 0; t < 4; ++t) x[t] = *(const f32x4*)&xr[t * 1024 + c];
    const f32x4 sh = *(const f32x4*)&m[c];
    const f32x4 sc = *(const f32x4*)&m[1024 + c];
#pragma unroll
    for (int t = 0; t < 4; ++t)
      *(uint2*)&H[(size_t)(row + t) * 1024 + c] = pack4(x[t][0] * (1 + sc[0]) + sh[0], x[t][1] * (1 + sc[1]) + sh[1], x[t][2] * (1 + sc[2]) + sh[2], x[t][3] * (1 + sc[3]) + sh[3]);
  }
}

__device__ __forceinline__ void phase_ln(const Params& p, int l, int bid, int nb) {
  float* X = p.out;
  const float* g = p.in[10] + l * 1024;
  const float* b = p.in[11] + l * 1024;
  const float* mod = (const float*)(p.ws + WS_MOD) + (l + 1) * 5 * 3072;
  u16* H = (u16*)(p.ws + WS_H);
  const int lane = threadIdx.x & 63, wave = threadIdx.x >> 6;
  for (int row = bid * NW + wave; row < TOK; row += nb * NW) {
    float* xr = X + (size_t)row * 1024;
    f32x4 v[4];
    float s = 0;
#pragma unroll
    for (int i = 0; i < 4; ++i) { v[i] = *(const f32x4*)&xr[i * 256 + lane * 4]; s += v[i][0] + v[i][1] + v[i][2] + v[i][3]; }
    const float mu = wave_sum(s) * (1.0f / 1024.0f);
    float q = 0;
#pragma unroll
    for (int i = 0; i < 4; ++i)
#pragma unroll
      for (int j = 0; j < 4; ++j) { float dd = v[i][j] - mu; q += dd * dd; }
    const float rs = rsqrtf(wave_sum(q) * (1.0f / 1024.0f) + 1e-5f);
    const float* m = mod + cond_of(row) * 3072;
#pragma unroll
    for (int i = 0; i < 4; ++i) {
      const int c = i * 256 + lane * 4;
      f32x4 gg = *(const f32x4*)&g[c], bb = *(const f32x4*)&b[c];
      f32x4 y;
#pragma unroll
      for (int j = 0; j < 4; ++j) y[j] = (v[i][j] - mu) * rs * gg[j] + bb[j];
      *(f32x4*)&xr[c] = y;
      if (l < 3) {
        f32x4 sh = *(const f32x4*)&m[c], sc = *(const f32x4*)&m[1024 + c];
        *(uint2*)&H[(size_t)row * 1024 + c] = pack4(y[0] * (1 + sc[0]) + sh[0], y[1] * (1 + sc[1]) + sh[1], y[2] * (1 + sc[2]) + sh[2], y[3] * (1 + sc[3]) + sh[3]);
      }
    }
  }
}

__device__ __forceinline__ void phase_gla(const Params& p, unsigned char* smem_raw) {
  u16* s_qrel = (u16*)smem_raw;
  u16* s_krel = s_qrel + 32 * 136;
  u16* s_qcum = s_krel + 32 * 136;
  u16* s_kdT = s_qcum + 32 * 136;
  u16* s_vT = s_kdT + 128 * 40;
  u16* s_att = s_vT + 128 * 40;
  u16* s_S = s_att + 32 * 40;
  float* s_dec = (float*)(s_S + 128 * 136);
  float* s_part = s_dec + 128;
  int* s_u = (int*)(s_part + 512);
  int* counter = (int*)(p.ws + WS_CNT);
  const u16* qg = (const u16*)(p.ws + WS_B(0));
  const u16* vg = (const u16*)(p.ws + WS_B(1));
  const _Float16* lfg = (const _Float16*)(p.ws + WS_B(3));
  u16* og = (u16*)(p.ws + WS_B(5));
  const int tid = threadIdx.x, lane = tid & 63, w = tid >> 6, fr = lane & 15, fq = lane >> 4;
  const int kk = tid & 127, th = tid >> 7;
  const int ti = w >> 2, vi = w & 3;
  const int wk = w & 3, wv = w >> 2;
  bool first = true;
  while (true) {
    if (tid == 0) *s_u = (first && blockIdx.x < 64) ? (int)blockIdx.x : 64 + atomicAdd(counter, 1);
    first = false;
    __syncthreads();
    const int u = *s_u;
    __syncthreads();
    if (u >= 576) break;
    int b, rem, start, N, sample;
    if (u < 64) { sample = 1; b = u >> 4; rem = u & 15; start = NPROMPT + b * 1024; N = 1024; }
    else { sample = 0; b = (u - 64) >> 4; rem = (u - 64) & 15; start = b * 256; N = 256; }
    const int h = rem >> 1, d = rem & 1;
    const int nc = N >> 5;
    f32x4 S[2][4];
#pragma unroll
    for (int mi = 0; mi < 2; ++mi)
#pragma unroll
      for (int ni = 0; ni < 4; ++ni) {
        f32x4 s4 = f32x4{0.f, 0.f, 0.f, 0.f};
        if (sample) {
          const float* s0 = p.in[2] + ((size_t)((b * 2 + d) * 8 + h)) * 16384;
#pragma unroll
          for (int j = 0; j < 4; ++j) s4[j] = s0[(wk * 32 + mi * 16 + fq * 4 + j) * 128 + wv * 64 + ni * 16 + fr];
        }
        S[mi][ni] = s4;
        *(uint2*)&s_S[(wv * 64 + ni * 16 + fr) * 136 + wk * 32 + mi * 16 + fq * 4] = pack4(s4[0], s4[1], s4[2], s4[3]);
      }
    _Float16 lfraw[8]; u16 qraw[8]; uint4 vraw;
#define GLA_LOAD(cc) do { _Pragma("unroll") for (int i = 0; i < 8; ++i) { const int tt = (cc) * 32 + th * 8 + i; const size_t tok = start + (d ? (N - 1 - tt) : tt); \
      lfraw[i] = lfg[tok * 2048 + d * 1024 + h * 128 + kk]; qraw[i] = qg[tok * 1024 + h * 128 + kk]; } \
      { const int tt = (cc) * 32 + (tid >> 4); const size_t tok = start + (d ? (N - 1 - tt) : tt); vraw = *(const uint4*)&vg[tok * 1024 + h * 128 + (tid & 15) * 8]; } } while (0)
    GLA_LOAD(0);
    for (int c = 0; c < nc; ++c) {
      {
        float lfv[8], qv[8];
#pragma unroll
        for (int i = 0; i < 8; ++i) { lfv[i] = (float)lfraw[i]; qv[i] = bf2f(qraw[i]); }
        const uint4 vv = vraw;
        if (c + 1 < nc) GLA_LOAD(c + 1);
        float run = 0;
        float cs[8];
#pragma unroll
        for (int i = 0; i < 8; ++i) { run += lfv[i]; cs[i] = run; }
        s_part[th * 128 + kk] = run;
        {
          const int s = tid >> 4, v8 = (tid & 15) * 8;
          const unsigned vw[4] = {vv.x, vv.y, vv.z, vv.w};
#pragma unroll
          for (int i = 0; i < 4; ++i) { s_vT[(v8 + 2 * i) * 40 + s] = (u16)(vw[i] & 0xffff); s_vT[(v8 + 2 * i + 1) * 40 + s] = (u16)(vw[i] >> 16); }
        }
        __syncthreads();
        const float p0 = s_part[kk], p1 = s_part[128 + kk], p2 = s_part[256 + kk], p3 = s_part[384 + kk];
        const float off = (th > 0 ? p0 : 0.f) + (th > 1 ? p1 : 0.f) + (th > 2 ? p2 : 0.f);
        const float ref = p0 + p1, total = p0 + p1 + p2 + p3;
        unsigned kd[4];
        const float eref = __builtin_amdgcn_exp2f(ref), etr = __builtin_amdgcn_exp2f(total - ref);
#pragma unroll
        for (int i = 0; i < 8; ++i) {
          const int t = th * 8 + i;
          const float cum = off + cs[i];
          const float kf = 1.0f - __builtin_amdgcn_exp2f(lfv[i]);
          const float e1 = __builtin_amdgcn_exp2f(cum - ref), e2 = __builtin_amdgcn_rcpf(e1);
          const float qe = qv[i] * e1, ke = kf * e2;
          s_qrel[t * 136 + kk] = f2bf(qe);
          s_krel[t * 136 + kk] = f2bf(ke);
          s_qcum[t * 136 + kk] = f2bf(qe * eref);
          const u16 kdv = f2bf(ke * etr);
          if (i & 1) kd[i >> 1] |= ((unsigned)kdv) << 16; else kd[i >> 1] = kdv;
        }
        *(uint4*)&s_kdT[kk * 40 + th * 8] = make_uint4(kd[0], kd[1], kd[2], kd[3]);
        if (th == 0) s_dec[kk] = eref * etr;
      }
      __syncthreads();
      f32x4 oacc[2] = {f32x4{0.f, 0.f, 0.f, 0.f}, f32x4{0.f, 0.f, 0.f, 0.f}};
      {
        f32x4 att = f32x4{0.f, 0.f, 0.f, 0.f};
        const int ati = w >> 1, asi = w & 1;
#pragma unroll
        for (int ks = 0; ks < 4; ++ks) {
          if (w < 4) {
            bf16x8 a = *(const bf16x8*)&s_qrel[(ati * 16 + fr) * 136 + ks * 32 + fq * 8];
            bf16x8 bb = *(const bf16x8*)&s_krel[(asi * 16 + fr) * 136 + ks * 32 + fq * 8];
            att = __builtin_amdgcn_mfma_f32_16x16x32_bf16(a, bb, att, 0, 0, 0);
          }
          bf16x8 a2 = *(const bf16x8*)&s_qcum[(ti * 16 + fr) * 136 + ks * 32 + fq * 8];
#pragma unroll
          for (int e = 0; e < 2; ++e) {
            bf16x8 b2 = *(const bf16x8*)&s_S[((vi * 2 + e) * 16 + fr) * 136 + ks * 32 + fq * 8];
            oacc[e] = __builtin_amdgcn_mfma_f32_16x16x32_bf16(b2, a2, oacc[e], 0, 0, 0);
          }
        }
        if (w < 4) {
#pragma unroll
          for (int j = 0; j < 4; ++j) {
            const int t = ati * 16 + fq * 4 + j, s = asi * 16 + fr;
            s_att[t * 40 + s] = (s <= t) ? f2bf(att[j]) : (u16)0;
          }
        }
      }
      __syncthreads();
      {
        bf16x8 a = *(const bf16x8*)&s_att[(ti * 16 + fr) * 40 + fq * 8];
        const int tt = c * 32 + ti * 16 + fr;
        const size_t tok = start + (d ? (N - 1 - tt) : tt);
#pragma unroll
        for (int e = 0; e < 2; ++e) {
          bf16x8 bb = *(const bf16x8*)&s_vT[((vi * 2 + e) * 16 + fr) * 40 + fq * 8];
          oacc[e] = __builtin_amdgcn_mfma_f32_16x16x32_bf16(bb, a, oacc[e], 0, 0, 0);
          *(uint2*)&og[((size_t)d * TOK + tok) * 1024 + h * 128 + (vi * 2 + e) * 16 + fq * 4] = pack4(oacc[e][0], oacc[e][1], oacc[e][2], oacc[e][3]);
        }
        bf16x8 vf[4];
#pragma unroll
        for (int ni = 0; ni < 4; ++ni) vf[ni] = *(const bf16x8*)&s_vT[(wv * 64 + ni * 16 + fr) * 40 + fq * 8];
#pragma unroll
        for (int mi = 0; mi < 2; ++mi) {
          bf16x8 kf = *(const bf16x8*)&s_kdT[(wk * 32 + mi * 16 + fr) * 40 + fq * 8];
          f32x4 dc = *(const f32x4*)&s_dec[wk * 32 + mi * 16 + fq * 4];
#pragma unroll
          for (int ni = 0; ni < 4; ++ni) {
            f32x4 s4 = S[mi][ni];
#pragma unroll
            for (int j = 0; j < 4; ++j) s4[j] *= dc[j];
            s4 = __builtin_amdgcn_mfma_f32_16x16x32_bf16(kf, vf[ni], s4, 0, 0, 0);
            S[mi][ni] = s4;
            *(uint2*)&s_S[(wv * 64 + ni * 16 + fr) * 136 + wk * 32 + mi * 16 + fq * 4] = pack4(s4[0], s4[1], s4[2], s4[3]);
          }
        }
      }
      __syncthreads();
    }
    if (!sample) {
      float* so = p.out + OUT_HG + ((size_t)((b * 2 + d) * 8 + h)) * 16384;
#pragma unroll
      for (int mi = 0; mi < 2; ++mi)
#pragma unroll
        for (int ni = 0; ni < 4; ++ni)
#pragma unroll
          for (int j = 0; j < 4; ++j) so[(wk * 32 + mi * 16 + fq * 4 + j) * 128 + wv * 64 + ni * 16 + fr] = S[mi][ni][j];
    }
  }
#undef GLA_LOAD
}

__device__ __forceinline__ void phase_hg_post(const Params& p, int bid, int nb) {
  const u16* og = (const u16*)(p.ws + WS_B(5));
  const u16* sg = (const u16*)(p.ws + WS_B(2));
  u16* a = (u16*)(p.ws + WS_B(0));
  const float* ng = p.in[14];
  const int lane = threadIdx.x & 63, wave = threadIdx.x >> 6;
  float ngv[16];
#pragma unroll
  for (int k = 0; k < 4; ++k) { const f32x4 t = *(const f32x4*)&ng[lane * 16 + 4 * k]; ngv[4 * k] = t[0]; ngv[4 * k + 1] = t[1]; ngv[4 * k + 2] = t[2]; ngv[4 * k + 3] = t[3]; }
  for (int row0 = (bid * NW + wave) * 2; row0 < TOK; row0 += nb * NW * 2) {
    uint4 f[2][2], bw[2][2], sv[2][2];
#pragma unroll
    for (int r = 0; r < 2; ++r)
#pragma unroll
      for (int hh = 0; hh < 2; ++hh) {
        const size_t base = (size_t)(row0 + r) * 1024 + lane * 16 + hh * 8;
        f[r][hh] = *(const uint4*)&og[base];
        bw[r][hh] = *(const uint4*)&og[(size_t)TOK * 1024 + base];
        sv[r][hh] = *(const uint4*)&sg[base];
      }
#pragma unroll
    for (int r = 0; r < 2; ++r) {
      float o[16];
      float ss = 0;
#pragma unroll
      for (int hh = 0; hh < 2; ++hh) {
        const unsigned fa[4] = {f[r][hh].x, f[r][hh].y, f[r][hh].z, f[r][hh].w}, ba[4] = {bw[r][hh].x, bw[r][hh].y, bw[r][hh].z, bw[r][hh].w};
#pragma unroll
        for (int i = 0; i < 4; ++i) {
          o[hh * 8 + 2 * i] = lo16(fa[i]) + lo16(ba[i]);
          o[hh * 8 + 2 * i + 1] = hi16(fa[i]) + hi16(ba[i]);
        }
      }
#pragma unroll
      for (int i = 0; i < 16; ++i) ss += o[i] * o[i];
      ss += __shfl_xor(ss, 1); ss += __shfl_xor(ss, 2); ss += __shfl_xor(ss, 4);
      const float rs = rsqrtf(ss * (1.0f / 128.0f) + 1e-6f);
#pragma unroll
      for (int hh = 0; hh < 2; ++hh) {
        const unsigned sa[4] = {sv[r][hh].x, sv[r][hh].y, sv[r][hh].z, sv[r][hh].w};
        unsigned rr[4];
#pragma unroll
        for (int i = 0; i < 4; ++i)
          rr[i] = pack2(o[hh * 8 + 2 * i] * rs * ngv[hh * 8 + 2 * i] * siluf_(lo16(sa[i])), o[hh * 8 + 2 * i + 1] * rs * ngv[hh * 8 + 2 * i + 1] * siluf_(hi16(sa[i])));
        *(uint4*)&a[(size_t)(row0 + r) * 1024 + lane * 16 + hh * 8] = make_uint4(rr[0], rr[1], rr[2], rr[3]);
      }
    }
  }
}

__device__ __forceinline__ void seq_pos(int tok, int& n, int& L) {
  if (tok < NPROMPT) { n = tok & 255; L = 256; } else { n = (tok - NPROMPT) & 1023; L = 1024; }
}
__device__ __forceinline__ void phase_sc_conv(const Params& p, int bid, int nb) {
  const u16* pb = (const u16*)(p.ws + WS_B(0));
  const u16* sb = (const u16*)(p.ws + WS_B(1));
  u16* a = (u16*)(p.ws + WS_B(2));
  const float* cw = p.in[17]; const float* cbias = p.in[18];
  const size_t total = (size_t)TOK * 128;
  const size_t i0 = (size_t)bid * NT + threadIdx.x;
  const int c = ((int)i0 & 127) * 8;
  float w0[8], w1[8], w2[8], wb[8];
#pragma unroll
  for (int k = 0; k < 2; ++k) {
    const f32x4 t0 = *(const f32x4*)&cw[c + 4 * k], t1 = *(const f32x4*)&cw[1024 + c + 4 * k], t2 = *(const f32x4*)&cw[2048 + c + 4 * k], tb = *(const f32x4*)&cbias[c + 4 * k];
#pragma unroll
    for (int j = 0; j < 4; ++j) { w0[4 * k + j] = t0[j]; w1[4 * k + j] = t1[j]; w2[4 * k + j] = t2[j]; wb[4 * k + j] = tb[j]; }
  }
  const uint4 z = make_uint4(0, 0, 0, 0);
  for (size_t i = i0; i < total / 4; i += (size_t)nb * NT) {
    const int tok = (int)(i >> 7) * 4;
    int n, L; seq_pos(tok, n, L);
    const size_t base = (size_t)tok * 1024 + c;
    uint4 q[6], sv[4];
    q[0] = n > 0 ? *(const uint4*)&pb[base - 1024] : z;
#pragma unroll
    for (int t = 0; t < 4; ++t) { q[1 + t] = *(const uint4*)&pb[base + t * 1024]; sv[t] = *(const uint4*)&sb[base + t * 1024]; }
    q[5] = n + 4 < L ? *(const uint4*)&pb[base + 4096] : z;
#pragma unroll
    for (int t = 0; t < 4; ++t) {
      const unsigned am[4] = {q[t].x, q[t].y, q[t].z, q[t].w}, a0[4] = {q[t + 1].x, q[t + 1].y, q[t + 1].z, q[t + 1].w};
      const unsigned ap[4] = {q[t + 2].x, q[t + 2].y, q[t + 2].z, q[t + 2].w}, as[4] = {sv[t].x, sv[t].y, sv[t].z, sv[t].w};
      unsigned r[4];
#pragma unroll
      for (int k = 0; k < 4; ++k) {
        float z0 = w0[2 * k] * lo16(am[k]) + w1[2 * k] * lo16(a0[k]) + w2[2 * k] * lo16(ap[k]) + wb[2 * k];
        float z1 = w0[2 * k + 1] * hi16(am[k]) + w1[2 * k + 1] * hi16(a0[k]) + w2[2 * k + 1] * hi16(ap[k]) + wb[2 * k + 1];
        r[k] = pack2(lo16(as[k]) * z0, hi16(as[k]) * z1);
      }
      *(uint4*)&a[base + t * 1024] = make_uint4(r[0], r[1], r[2], r[3]);
    }
  }
}
__device__ __forceinline__ void phase_rg_conv(const Params& p, int bid, int nb) {
  const u16* ub = (const u16*)(p.ws + WS_B(0));
  u16* uc = (u16*)(p.ws + WS_B(2));
  const float* cw = p.in[21]; const float* cbias = p.in[22];
  const size_t total = (size_t)TOK * 128;
  const size_t i0 = (size_t)bid * NT + threadIdx.x;
  const int c = ((int)i0 & 127) * 8;
  float w0[8], w1[8], w2[8], w3[8], wb[8];
#pragma unroll
  for (int k = 0; k < 2; ++k) {
    const f32x4 t0 = *(const f32x4*)&cw[c + 4 * k], t1 = *(const f32x4*)&cw[1024 + c + 4 * k], t2 = *(const f32x4*)&cw[2048 + c + 4 * k], t3 = *(const f32x4*)&cw[3072 + c + 4 * k], tb = *(const f32x4*)&cbias[c + 4 * k];
#pragma unroll
    for (int j = 0; j < 4; ++j) { w0[4 * k + j] = t0[j]; w1[4 * k + j] = t1[j]; w2[4 * k + j] = t2[j]; w3[4 * k + j] = t3[j]; wb[4 * k + j] = tb[j]; }
  }
  const uint4 z = make_uint4(0, 0, 0, 0);
  for (size_t i = i0; i < total / 4; i += (size_t)nb * NT) {
    const int tok = (int)(i >> 7) * 4;
    int n, L; seq_pos(tok, n, L);
    const size_t base = (size_t)tok * 1024 + c;
    uint4 q[7];
    q[0] = n > 1 ? *(const uint4*)&ub[base - 2048] : z;
    q[1] = n > 0 ? *(const uint4*)&ub[base - 1024] : z;
#pragma unroll
    for (int t = 0; t < 4; ++t) q[2 + t] = *(const uint4*)&ub[base + t * 1024];
    q[6] = n + 4 < L ? *(const uint4*)&ub[base + 4096] : z;
#pragma unroll
    for (int t = 0; t < 4; ++t) {
      const unsigned a0[4] = {q[t].x, q[t].y, q[t].z, q[t].w}, a1[4] = {q[t + 1].x, q[t + 1].y, q[t + 1].z, q[t + 1].w};
      const unsigned a2[4] = {q[t + 2].x, q[t + 2].y, q[t + 2].z, q[t + 2].w}, a3[4] = {q[t + 3].x, q[t + 3].y, q[t + 3].z, q[t + 3].w};
      unsigned r[4];
#pragma unroll
      for (int k = 0; k < 4; ++k) {
        float z0 = w0[2 * k] * lo16(a0[k]) + w1[2 * k] * lo16(a1[k]) + w2[2 * k] * lo16(a2[k]) + w3[2 * k] * lo16(a3[k]) + wb[2 * k];
        float z1 = w0[2 * k + 1] * hi16(a0[k]) + w1[2 * k + 1] * hi16(a1[k]) + w2[2 * k + 1] * hi16(a2[k]) + w3[2 * k + 1] * hi16(a3[k]) + wb[2 * k + 1];
        r[k] = pack2(z0, z1);
      }
      *(uint4*)&uc[((size_t)(c >> 6) * TOK + tok + t) * 64 + (c & 63)] = make_uint4(r[0], r[1], r[2], r[3]);
    }
  }
}

__device__ __forceinline__ void phase_rg_scan(const Params& p, unsigned char* smem_raw, int bid, int nb) {
  float* sA = (float*)smem_raw;
  float* sB = sA + 2048;
  const u16* rb = (const u16*)(p.ws + WS_B(3));
  const u16* ib = (const u16*)(p.ws + WS_B(5));
  const u16* uc = (const u16*)(p.ws + WS_B(2));
  const u16* sg = (const u16*)(p.ws + WS_B(1));
  u16* hfw = (u16*)(p.ws + WS_H);
  u16* yp = (u16*)(p.ws + WS_B(0));
  const int tid = threadIdx.x;
  for (int u = bid; u < 768; u += nb) {
    int sample, b, c, seg, nseg, start, chs, slot;
    if (u < 256) {
      const int xq = u & 7, yq = u >> 3, gid = (yq >> 2) * 8 + xq, sub = yq & 3;
      sample = 1; b = gid >> 4; slot = (tid & 3) * 4; c = (gid & 15) * 64 + sub * 16 + slot; seg = tid >> 2; nseg = 128; start = NPROMPT + b * 1024; chs = 16; }
    else { sample = 0; b = (u - 256) >> 4; slot = (tid & 15) * 4; c = ((u - 256) & 15) * 64 + slot; seg = tid >> 4; nseg = 32; start = b * 256; chs = 64; }
    const int L = nseg * 8;
#pragma unroll 1
    for (int d = 0; d < 2; ++d) {
      const f32x4 lam = *(const f32x4*)&p.in[25][d * 1024 + c];
      float cl[4];
#pragma unroll
      for (int j = 0; j < 4; ++j) cl[j] = 8.0f * 1.4426950408889634f * log1pf(__expf(-lam[j]))    ;
      const u16* rp = rb + (size_t)d * TOK * 1024;
      const u16* ip = ib + (size_t)d * TOK * 1024;
      const int tok0 = start + (d ? L - 1 - seg * 8 : seg * 8);
      const size_t o0 = (size_t)tok0 * 1024 + c;
      const long ostep = d ? -1024 : 1024;
      const size_t g0 = ((size_t)(c >> 6) * TOK + tok0) * 64 + (c & 63);
      const long gstep = d ? -64 : 64;
      uint2 rr[8], ii[8], uu[8];
#pragma unroll
      for (int s8 = 0; s8 < 8; ++s8) { rr[s8] = *(const uint2*)&rp[g0 + s8 * gstep]; ii[s8] = *(const uint2*)&ip[g0 + s8 * gstep]; uu[s8] = *(const uint2*)&uc[g0 + s8 * gstep]; }
      uint2 hf[8], sgv[8];
      if (d == 1) {
#pragma unroll
        for (int s8 = 0; s8 < 8; ++s8) { hf[s8] = *(const uint2*)&hfw[g0 + s8 * gstep]; sgv[s8] = *(const uint2*)&sg[g0 + s8 * gstep]; }
      }
      float av[8][4], xv[8][4];
      float A[4] = {1.f, 1.f, 1.f, 1.f}, B[4] = {0.f, 0.f, 0.f, 0.f};
#pragma unroll
      for (int s8 = 0; s8 < 8; ++s8) {
        const float r4[4] = {lo16(rr[s8].x), hi16(rr[s8].x), lo16(rr[s8].y), hi16(rr[s8].y)};
        const float i4[4] = {lo16(ii[s8].x), hi16(ii[s8].x), lo16(ii[s8].y), hi16(ii[s8].y)};
        const float u4[4] = {lo16(uu[s8].x), hi16(uu[s8].x), lo16(uu[s8].y), hi16(uu[s8].y)};
#pragma unroll
        for (int j = 0; j < 4; ++j) {
          const float la = -cl[j] * r4[j];
          const float a = __builtin_amdgcn_exp2f(la);
          const float xin = __builtin_amdgcn_sqrtf(fmaxf(1.0f - __builtin_amdgcn_exp2f(2.0f * la), 0.f)) * (i4[j] * u4[j]);
          av[s8][j] = a; xv[s8][j] = xin;
          A[j] *= a; B[j] = a * B[j] + xin;
        }
      }
      *(f32x4*)&sA[seg * chs + slot] = f32x4{A[0], A[1], A[2], A[3]};
      *(f32x4*)&sB[seg * chs + slot] = f32x4{B[0], B[1], B[2], B[3]};
      for (int k = 1; k < nseg; k <<= 1) {
        __syncthreads();
        f32x4 pa = f32x4{1.f, 1.f, 1.f, 1.f}, pb2 = f32x4{0.f, 0.f, 0.f, 0.f};
        if (seg >= k) { pa = *(const f32x4*)&sA[(seg - k) * chs + slot]; pb2 = *(const f32x4*)&sB[(seg - k) * chs + slot]; }
        __syncthreads();
        if (seg >= k) {
#pragma unroll
          for (int j = 0; j < 4; ++j) { B[j] = A[j] * pb2[j] + B[j]; A[j] = A[j] * pa[j]; }
          *(f32x4*)&sA[seg * chs + slot] = f32x4{A[0], A[1], A[2], A[3]};
          *(f32x4*)&sB[seg * chs + slot] = f32x4{B[0], B[1], B[2], B[3]};
        }
      }
      __syncthreads();
      float h[4];
      {
        f32x4 h0v = f32x4{0.f, 0.f, 0.f, 0.f};
        if (sample) h0v = *(const f32x4*)&p.in[3][(b * 2 + d) * 1024 + c];
        if (seg > 0) {
          const f32x4 pa = *(const f32x4*)&sA[(seg - 1) * chs + slot], pb2 = *(const f32x4*)&sB[(seg - 1) * chs + slot];
#pragma unroll
          for (int j = 0; j < 4; ++j) h[j] = pa[j] * h0v[j] + pb2[j];
        } else {
#pragma unroll
          for (int j = 0; j < 4; ++j) h[j] = h0v[j];
        }
      }
#pragma unroll
      for (int s8 = 0; s8 < 8; ++s8) {
#pragma unroll
        for (int j = 0; j < 4; ++j) h[j] = av[s8][j] * h[j] + xv[s8][j];
        const size_t o = o0 + s8 * ostep;
        if (d == 0) *(uint2*)&hfw[g0 + s8 * gstep] = pack4(h[0], h[1], h[2], h[3]);
        else *(uint2*)&yp[g0 + s8 * gstep] = pack4((lo16(hf[s8].x) + h[0]) * lo16(sgv[s8].x), (hi16(hf[s8].x) + h[1]) * hi16(sgv[s8].x),
                                     (lo16(hf[s8].y) + h[2]) * lo16(sgv[s8].y), (hi16(hf[s8].y) + h[3]) * hi16(sgv[s8].y));
      }
      if (!sample && seg == nseg - 1) *(f32x4*)&p.out[OUT_RG + (b * 2 + d) * 1024 + c] = f32x4{h[0], h[1], h[2], h[3]};
      __syncthreads();
    }
  }
}

__device__ __forceinline__ void phase_mla_norm(const Params& p, int bid, int nb) {
  u16* cq = (u16*)(p.ws + WS3_CQ);
  u16* ckvall = (u16*)(p.ws + WS3_CKVALL);
  const float* ckvraw = (const float*)(p.ws + WS3_CKVRAW);
  const float* kperaw = (const float*)(p.ws + WS3_KPERAW);
  u16* Kb = (u16*)(p.ws + WS3_K);
  const float* qn = p.in[28]; const float* kvn = p.in[29];
  const int lane = threadIdx.x & 63, wave = threadIdx.x >> 6;
  float qnv[6];
#pragma unroll
  for (int i = 0; i < 3; ++i) { qnv[2 * i] = qn[(i * 64 + lane) * 2]; qnv[2 * i + 1] = qn[(i * 64 + lane) * 2 + 1]; }
  const f32x4 g4 = *(const f32x4*)&kvn[lane * 4];
  unsigned cvn[3] = {0u, 0u, 0u}; f32x4 kvnx = f32x4{0.f, 0.f, 0.f, 0.f}; float vnx = 0.f;
  {
    const int r0 = bid * NW + wave;
    if (r0 < TOK) {
#pragma unroll
      for (int i = 0; i < 3; ++i) cvn[i] = ((const unsigned*)&cq[(size_t)r0 * 384])[i * 64 + lane];
      kvnx = *(const f32x4*)&ckvraw[(size_t)r0 * 256 + lane * 4]; vnx = kperaw[(size_t)r0 * 32 + (lane & 31)];
    }
  }
  for (int row = bid * NW + wave; row < TOK + 2048; row += nb * NW) {
    if (row < TOK) {
      const int tok = row;
      const bool sample = tok >= NPROMPT;
      unsigned cv[3] = {cvn[0], cvn[1], cvn[2]}; const f32x4 kv = kvnx; float v = vnx;
      {
        const int rn = row + nb * NW;
        if (rn < TOK) {
#pragma unroll
          for (int i = 0; i < 3; ++i) cvn[i] = ((const unsigned*)&cq[(size_t)rn * 384])[i * 64 + lane];
          kvnx = *(const f32x4*)&ckvraw[(size_t)rn * 256 + lane * 4]; vnx = kperaw[(size_t)rn * 32 + (lane & 31)];
        }
      }
      const int bs = (tok - NPROMPT) >> 10, n = (tok - NPROMPT) & 1023;
      const size_t kvrow = sample ? (size_t)(NPROMPT + bs * 1536 + 512 + n) : (size_t)tok;
      unsigned* cqr = (unsigned*)&cq[(size_t)tok * 384];
      float ss = 0;
#pragma unroll
      for (int i = 0; i < 3; ++i) { float a = lo16(cv[i]), b2 = hi16(cv[i]); ss += a * a + b2 * b2; }
      const float rsq = rsqrtf(wave_sum(ss) * (1.0f / 384.0f) + 1e-6f);
#pragma unroll
      for (int i = 0; i < 3; ++i) {
        cqr[i * 64 + lane] = pack2(lo16(cv[i]) * rsq * qnv[2 * i], hi16(cv[i]) * rsq * qnv[2 * i + 1]);
      }
      const float rsk = rsqrtf(wave_sum(kv[0] * kv[0] + kv[1] * kv[1] + kv[2] * kv[2] + kv[3] * kv[3]) * (1.0f / 256.0f) + 1e-6f);
      f32x4 o4;
#pragma unroll
      for (int j = 0; j < 4; ++j) o4[j] = kv[j] * rsk * g4[j];
      *(uint2*)&ckvall[kvrow * 256 + lane * 4] = pack4(o4[0], o4[1], o4[2], o4[3]);
      if (!sample) *(f32x4*)&p.out[OUT_CKV + (size_t)tok * 256 + lane * 4] = o4;
      if (!sample) { if (lane < 32) p.out[OUT_KPE + (size_t)tok * 32 + lane] = v; }
      else {
        const float partner = __shfl_xor(v, 8);
        const int i16 = lane & 15;
        const float pos = (lane & 16) ? (float)(n & 63) : (float)(n >> 6);
        float sn, cs; rope_sincos(pos, i16 & 7, sn, cs);
        v = (i16 < 8) ? (v * cs - partner * sn) : (partner * sn + v * cs);
      }
      const u16 vb = f2bf(v);
#pragma unroll
      for (int i = 0; i < 8; ++i) Kb[(kvrow * 16 + (lane >> 5) + 2 * i) * 96 + 64 + (lane & 31)] = vb;
    } else {
      const int r = row - TOK, bs = r >> 9, j = r & 511;
      const size_t kvrow = (size_t)(NPROMPT + bs * 1536 + j);
      f32x4 kv = *(const f32x4*)&p.in[4][(size_t)r * 256 + lane * 4];
      *(uint2*)&ckvall[kvrow * 256 + lane * 4] = pack4(kv[0], kv[1], kv[2], kv[3]);
      const u16 vb = f2bf(p.in[5][(size_t)r * 32 + (lane & 31)]);
#pragma unroll
      for (int i = 0; i < 8; ++i) Kb[(kvrow * 16 + (lane >> 5) + 2 * i) * 96 + 64 + (lane & 31)] = vb;
    }
  }
}

__device__ __forceinline__ void phase_attn(const Params& p, unsigned char* smem_raw, int bid, int nb) {
  u16* sK = (u16*)smem_raw;
  u16* sV = sK + 128 * 104;
  const u16* qg = (const u16*)(p.ws + WS3_Q);
  const u16* Kg = (const u16*)(p.ws + WS3_K);
  const u16* Vg = (const u16*)(p.ws + WS3_VT);
  const u16* sg = (const u16*)(p.ws + WS3_SG);
  u16* ao = (u16*)(p.ws + WS_H);
  const int tid = threadIdx.x, lane = tid & 63, w = tid >> 6, fr = lane & 15, fq = lane >> 4;
  for (int u = bid; u < 1536; u += nb) {
    int tok0, kvbase, nkeys, h;
    if (u < 512) { const int b = u >> 7, r = u & 127; h = r >> 3; const int qb = r & 7; tok0 = NPROMPT + b * 1024 + qb * 128; kvbase = NPROMPT + b * 1536; nkeys = 1536; }
    else { const int uu = u - 512; const int b = uu >> 5, r = uu & 31; h = r >> 1; const int qb = r & 1; tok0 = b * 256 + qb * 128; kvbase = b * 256; nkeys = 256; }
    const int tokq = tok0 + w * 16 + fr;
    bf16x8 qf[3];
#pragma unroll
    for (int ks = 0; ks < 3; ++ks) qf[ks] = *(const bf16x8*)&qg[(size_t)tokq * 1536 + h * 96 + ks * 32 + fq * 8];
    if (u < 512) {
      const int npos = (tokq - NPROMPT) & 1023;
      const float pos = (fq & 2) ? (float)(npos & 63) : (float)(npos >> 6);
      uint4 raw = *(uint4*)&qf[2];
      unsigned rw[4] = {raw.x, raw.y, raw.z, raw.w};
#pragma unroll
      for (int i = 0; i < 4; ++i) {
        float v0 = lo16(rw[i]), v1 = hi16(rw[i]);
        const float p0 = __shfl_xor(v0, 16), p1 = __shfl_xor(v1, 16);
        float sn0, cs0, sn1, cs1;
        rope_sincos(pos, 2 * i, sn0, cs0); rope_sincos(pos, 2 * i + 1, sn1, cs1);
        v0 = (fq & 1) ? (p0 * sn0 + v0 * cs0) : (v0 * cs0 - p0 * sn0);
        v1 = (fq & 1) ? (p1 * sn1 + v1 * cs1) : (v1 * cs1 - p1 * sn1);
        rw[i] = pack2(v0, v1);
      }
      raw = make_uint4(rw[0], rw[1], rw[2], rw[3]);
      qf[2] = *(bf16x8*)&raw;
    }
    float m = -1e30f, l = 0.f;
    f32x4 oacc[4];
#pragma unroll
    for (int i = 0; i < 4; ++i) oacc[i] = f32x4{0.f, 0.f, 0.f, 0.f};
    const int kk0 = tid / 12, kc0 = tid - kk0 * 12;
    const int kk1 = (tid + NT) / 12, kc1 = (tid + NT) - kk1 * 12;
    const int kk2_ = (tid + 2 * NT) / 12, kc2 = (tid + 2 * NT) - kk2_ * 12;
    const u16* Kp0 = &Kg[((size_t)(kvbase + kk0) * 16 + h) * 96 + kc0 * 8];
    const u16* Kp1 = &Kg[((size_t)(kvbase + kk1) * 16 + h) * 96 + kc1 * 8];
    const u16* Kp2 = &Kg[((size_t)(kvbase + kk2_) * 16 + h) * 96 + kc2 * 8];
    const int vd0 = tid >> 4, vc0 = tid & 15, vd1 = (tid + NT) >> 4;
    const u16* Vp0 = &Vg[(size_t)(h * 64 + vd0) * KVROWS + kvbase + vc0 * 8];
    const u16* Vp1 = &Vg[(size_t)(h * 64 + vd1) * KVROWS + kvbase + vc0 * 8];
    uint4 kr0 = *(const uint4*)Kp0, kr1 = *(const uint4*)Kp1, kr2 = *(const uint4*)Kp2, vr0 = *(const uint4*)Vp0, vr1 = *(const uint4*)Vp1;
    const int ntile2 = nkeys >> 7;
    for (int kt = 0; kt < ntile2; ++kt) {
      __syncthreads();
      *(uint4*)&sK[kk0 * 104 + kc0 * 8] = kr0; *(uint4*)&sK[kk1 * 104 + kc1 * 8] = kr1; *(uint4*)&sK[kk2_ * 104 + kc2 * 8] = kr2;
      *(uint4*)&sV[vd0 * 136 + vc0 * 8] = vr0; *(uint4*)&sV[vd1 * 136 + vc0 * 8] = vr1;
      if (kt + 1 < ntile2) {
        const size_t ko = (size_t)(kt + 1) * 128 * 1536; const int vo = (kt + 1) * 128;
        kr0 = *(const uint4*)(Kp0 + ko); kr1 = *(const uint4*)(Kp1 + ko); kr2 = *(const uint4*)(Kp2 + ko);
        vr0 = *(const uint4*)(Vp0 + vo); vr1 = *(const uint4*)(Vp1 + vo);
      }
      __syncthreads();
      f32x4 sacc[8];
#pragma unroll
      for (int ni = 0; ni < 8; ++ni) {
        sacc[ni] = f32x4{0.f, 0.f, 0.f, 0.f};
#pragma unroll
        for (int ks = 0; ks < 3; ++ks) {
          bf16x8 kf = *(const bf16x8*)&sK[(ni * 16 + fr) * 104 + ks * 32 + fq * 8];
          sacc[ni] = __builtin_amdgcn_mfma_f32_16x16x32_bf16(kf, qf[ks], sacc[ni], 0, 0, 0);
        }
      }
      float mx = -1e30f;
#pragma unroll
      for (int ni = 0; ni < 8; ++ni)
#pragma unroll
        for (int j = 0; j < 4; ++j) mx = fmaxf(mx, sacc[ni][j]);
      mx = fmaxf(mx, __shfl_xor(mx, 16));
      mx = fmaxf(mx, __shfl_xor(mx, 32));
      const float mnew = fmaxf(m, mx);
      const float alpha = __builtin_amdgcn_exp2f(m - mnew);
      m = mnew;
      float ls = 0.f;
#pragma unroll
      for (int ni = 0; ni < 8; ++ni)
#pragma unroll
        for (int j = 0; j < 4; ++j) { float e = __builtin_amdgcn_exp2f(sacc[ni][j] - mnew); sacc[ni][j] = e; ls += e; }
      l = l * alpha + ls;
      bf16x8 pf[4];
#pragma unroll
      for (int kk2 = 0; kk2 < 4; ++kk2) {
        uint2 lo = pack4(sacc[2 * kk2][0], sacc[2 * kk2][1], sacc[2 * kk2][2], sacc[2 * kk2][3]);
        uint2 hi = pack4(sacc[2 * kk2 + 1][0], sacc[2 * kk2 + 1][1], sacc[2 * kk2 + 1][2], sacc[2 * kk2 + 1][3]);
        uint4 pk = make_uint4(lo.x, lo.y, hi.x, hi.y);
        pf[kk2] = *(bf16x8*)&pk;
      }
#pragma unroll
      for (int di = 0; di < 4; ++di) {
#pragma unroll
        for (int j = 0; j < 4; ++j) oacc[di][j] *= alpha;
#pragma unroll
        for (int kk2 = 0; kk2 < 4; ++kk2) {
          uint2 v0 = *(const uint2*)&sV[(di * 16 + fr) * 136 + kk2 * 32 + fq * 4];
          uint2 v1 = *(const uint2*)&sV[(di * 16 + fr) * 136 + kk2 * 32 + 16 + fq * 4];
          uint4 vk = make_uint4(v0.x, v0.y, v1.x, v1.y);
          oacc[di] = __builtin_amdgcn_mfma_f32_16x16x32_bf16(*(bf16x8*)&vk, pf[kk2], oacc[di], 0, 0, 0);
        }
      }
    }
    l += __shfl_xor(l, 16);
    l += __shfl_xor(l, 32);
    const float inv = 1.0f / l;
#pragma unroll
    for (int di = 0; di < 4; ++di) {
      const size_t o = (size_t)tokq * 1024 + h * 64 + di * 16 + fq * 4;
      uint2 s = *(const uint2*)&sg[o];
      *(uint2*)&ao[o] = pack4(oacc[di][0] * inv * siluf_(lo16(s.x)), oacc[di][1] * inv * siluf_(hi16(s.x)), oacc[di][2] * inv * siluf_(lo16(s.y)), oacc[di][3] * inv * siluf_(hi16(s.y)));
    }
  }
}

#define XB_TMO      128
#define XB_XCNT(j)  (256  + 64 * (j))
#define XB_XSUB(j)  (1280 + 64 * (j))
#define XB_XGEN(j)  (2304 + 64 * (j))
#define XB_TOP      3328
#define XB_TOPGEN   3392
#define XCD_BAR_WORDS 3456
#define XB_SPIN_CAP (1u << 22)
__device__ __forceinline__ unsigned xb_ld(unsigned* p)              { return __hip_atomic_load(p, __ATOMIC_RELAXED, __HIP_MEMORY_SCOPE_AGENT); }
__device__ __forceinline__ unsigned xb_add(unsigned* p, unsigned v) { return __hip_atomic_fetch_add(p, v, __ATOMIC_RELAXED, __HIP_MEMORY_SCOPE_AGENT); }
__device__ __forceinline__ unsigned xb_xcc_id() { return (unsigned)__builtin_amdgcn_s_getreg((3 << 11) | 20) & 0xFu; }
#define XB_SPIN(cond, bar) do { unsigned _sp = 0; while (cond) { __builtin_amdgcn_s_sleep(1); \
    if ((++_sp & 255u) == 0u) { if (xb_ld(&(bar)[XB_TMO])) break; if (_sp > XB_SPIN_CAP) { atomicAdd(&(bar)[XB_TMO], 1u); break; } } } } while (0)
struct XcdBarrier { unsigned* bar; unsigned x; volatile LAS unsigned* st; };
__device__ __forceinline__ XcdBarrier xcd_barrier_post(unsigned* bar, volatile LAS unsigned* st) {
  XcdBarrier b; b.bar = bar; b.x = xb_xcc_id(); b.st = st;
  if (threadIdx.x == 0) (void)xb_add(&bar[XB_XCNT(b.x)], 1u);
  return b;
}
__device__ __forceinline__ void xcd_barrier_complete(unsigned* bar, unsigned x, unsigned& nloc, unsigned& nx) {
  const unsigned G = gridDim.x * gridDim.y * gridDim.z;
  unsigned sum, cnt, mine, sp = 0u;
  for (;;) {
    sum = 0u; cnt = 0u; mine = 0u;
#pragma unroll
    for (unsigned j = 0; j < 16; ++j) { const unsigned c = xb_ld(&bar[XB_XCNT(j)]); sum += c; cnt += (c > 0u) ? 1u : 0u; mine = (j == x) ? c : mine; }
    if (sum == G) break;
    __builtin_amdgcn_s_sleep(1);
    if ((++sp & 255u) == 0u) { if (xb_ld(&bar[XB_TMO])) break; if (sp > XB_SPIN_CAP) { atomicAdd(&bar[XB_TMO], 1u); break; } }
  }
  nloc = mine > 0u ? mine : 1u; nx = cnt > 0u ? cnt : 1u;
}
__device__ __forceinline__ void xcd_barrier(const XcdBarrier& b) {
  asm volatile("s_waitcnt vmcnt(0)" ::: "memory");
  __syncthreads();
  if (threadIdx.x == 0) {
    unsigned* bar = b.bar;
    __builtin_amdgcn_s_waitcnt(0);
    unsigned nloc = b.st[0], nx = b.st[1];
    if (nloc == 0u) { xcd_barrier_complete(bar, b.x, nloc, nx); b.st[0] = nloc; b.st[1] = nx; }
    const unsigned old = xb_add(&bar[XB_XSUB(b.x)], 1u);
    const unsigned gen = old / nloc;
    if (old + 1u == (gen + 1u) * nloc) {
      __builtin_amdgcn_fence(__ATOMIC_RELEASE, "agent");
      asm volatile("s_waitcnt vmcnt(0)" ::: "memory");
      const unsigned og = xb_add(&bar[XB_TOP], 1u);
      const unsigned tg = og / nx;
      if (og + 1u == (tg + 1u) * nx) xb_add(&bar[XB_TOPGEN], 1u);
      else XB_SPIN(xb_ld(&bar[XB_TOPGEN]) == tg, bar);
      __builtin_amdgcn_fence(__ATOMIC_ACQUIRE, "agent");
      xb_add(&bar[XB_XGEN(b.x)], 1u);
      asm volatile("s_waitcnt vmcnt(0)" ::: "memory");
    } else {
      XB_SPIN(xb_ld(&bar[XB_XGEN(b.x)]) == gen, bar);
      __builtin_amdgcn_fence(__ATOMIC_ACQUIRE, "agent");
      asm volatile("s_waitcnt vmcnt(0)" ::: "memory");
    }
  }
  __syncthreads();
}

#define GEMM_LDS 131072
#define DYN_LDS (GEMM_LDS + 16)
#define WS_BAR (WS_CNT + 4096ull)

#define RUN_GEMM(Aptr, LDA, Bptr, MM, NN, KK, GATE, EPI, CID) RUN_GEMM_G(Aptr, LDA, Bptr, MM, NN, KK, GATE, EPI, nb, CID)
#define RUN_GEMM_G(Aptr, LDA, Bptr, MM, NN, KK, GATE, EPI, GG, CID) RUN_GEMM_X(Aptr, LDA, (size_t)128, (size_t)0, Bptr, MM, NN, KK, GATE, EPI, GG, CID)
#define GM_KSTEP ((size_t)TOK * 128)
#define RUN_GEMM_X(Aptr, LDA, KSA, GST, Bptr, MM, NN, KK, GATE, EPI, GG, CID) do { pg8::Gemm g_{(const u16*)(Aptr), (const u16*)(Bptr), MM, NN, KK, LDA, GATE, p.flags, KSA, GST}; \
    pg8::StaticOrder S_; S_.init(MM, NN, GG, CID); pg8::gemm_phase((LAS unsigned char*)smem_raw, g_, S_, EPI); } while (0)
#define RUN_GEMM_R(Aptr, LDA, Bptr, MM, NN, KK, EPI, GG, CID, UBEG, UEND) do { pg8::Gemm g_{(const u16*)(Aptr), (const u16*)(Bptr), MM, NN, KK, LDA, 0, p.flags, (size_t)128, (size_t)0}; \
    pg8::StaticOrder S_; S_.init(MM, NN, GG, CID); S_.ubeg = UBEG; S_.uend = UEND; pg8::gemm_phase((LAS unsigned char*)smem_raw, g_, S_, EPI); } while (0)

__global__ void __launch_bounds__(NT, 2) mega(Params p) {
  extern __shared__ __attribute__((aligned(16))) unsigned char smem_raw[];
  const int bid = blockIdx.x, nb = gridDim.x;
  unsigned char* ws = p.ws;
  const float* mod = (const float*)(ws + WS_MOD);
  volatile LAS unsigned* xst = (volatile LAS unsigned*)((LAS unsigned char*)smem_raw + GEMM_LDS);
  XcdBarrier xb;
  if (p.phase_hi - p.phase_lo > 1) {
    if (threadIdx.x == 0) { xst[0] = 0u; xst[1] = 0u; }
    __syncthreads();
    xb = xcd_barrier_post((unsigned*)(ws + WS_BAR), xst);
  }
#define PH_BEGIN(n) if ((PHMASK & (1u << n)) && p.phase_lo <= n && n < p.phase_hi) { const int ph = n;
#define PH_FIN if (ph + 1 < p.phase_hi) { if (p.phase_lo < 0) cg::this_grid().sync(); else xcd_barrier(xb); } }
  PH_BEGIN(0) phase_prologue(p, smem_raw, bid, nb); PH_FIN
  PH_BEGIN(1) phase_h0(p, bid, nb); PH_FIN
  PH_BEGIN(2) {
    EpiHgIn e{(u16*)(ws + WS_B(0)), (u16*)(ws + WS_B(1)), (u16*)(ws + WS_B(2)), (_Float16*)(ws + WS_B(3)), (const float*)(ws + WS_LB)};
    RUN_GEMM(ws + WS_H, 1024, ws + WS_W_HG_IN, TOK, (nb == 256 ? 4096 : 5120), 1024, 0, e, bid);
  } PH_FIN
  PH_BEGIN(3) {
    phase_gla(p, smem_raw);
    if (nb == 256) {
      __syncthreads();
      EpiSg eg{(u16*)(ws + WS_B(2))};
      RUN_GEMM_R(ws + WS_H, 1024, ws + WS_W_HG_IN + (size_t)4096 * 1024 * 2, TOK, 1024, 1024, eg, 256, bid >= 64 ? bid - 64 : (1 << 20), 0, 192);
    }
  } PH_FIN
  PH_BEGIN(4) phase_hg_post(p, bid, nb); PH_FIN
  PH_BEGIN(5) {
    EpiResLn<false, true> e{p.in[0], p.in[1], (const u16*)nullptr, p.out, (u16*)(ws + WS_XB), mod + 0 * 15360 + 2048, p.in[10] + 0 * 1024, p.in[11] + 0 * 1024, mod + 1 * 15360, (u16*)(ws + WS_H),
               (unsigned long long*)(ws + WS_SLOT) + 0 * 49152, (unsigned*)(ws + WS_CNT + 256) + 0 * 48};
    RUN_GEMM(ws + WS_B(0), 1024, ws + WS_W_HG_OUT, TOK, 1024, 1024, 0, e, bid);
    wconv_idle(p, smem_raw, bid, nb, 1536, 2816);
  } PH_FIN
  PH_BEGIN(7) {
    EpiScIn e{(u16*)(ws + WS_B(0)), (u16*)(ws + WS_B(1))};
    RUN_GEMM(ws + WS_H, 1024, ws + WS_W_SC_IN, TOK, 4096, 1024, 0, e, bid);
  } PH_FIN
  PH_BEGIN(8) phase_sc_conv(p, bid, nb); PH_FIN
  PH_BEGIN(9) {
    EpiResLn<true, true> e{p.out, p.out, (const u16*)(ws + WS_XB), p.out, (u16*)(ws + WS_XB), mod + 1 * 15360 + 2048, p.in[10] + 1 * 1024, p.in[11] + 1 * 1024, mod + 2 * 15360, (u16*)(ws + WS_H),
               (unsigned long long*)(ws + WS_SLOT) + 1 * 49152, (unsigned*)(ws + WS_CNT + 256) + 1 * 48};
    RUN_GEMM(ws + WS_B(2), 1024, ws + WS_W_SC_OUT, TOK, 1024, 1024, 0, e, bid);
    wconv_idle(p, smem_raw, bid, nb, 2816, 3840);
  } PH_FIN
  PH_BEGIN(11) {
    EpiRgIn e{(u16*)(ws + WS_B(0)), (u16*)(ws + WS_B(1))};
    RUN_GEMM(ws + WS_H, 1024, ws + WS_W_RG_IN, TOK, 2048, 1024, 0, e, bid);
  } PH_FIN
  PH_BEGIN(12) phase_rg_conv(p, bid, nb); PH_FIN
  PH_BEGIN(13) {
    EpiRgGate e{(u16*)(ws + WS_B(3)), (u16*)(ws + WS_B(5)), p.in[24]};
    RUN_GEMM_X(ws + WS_B(2), 64, GM_KSTEP, 4 * GM_KSTEP, ws + WS_W_RG_GATE, TOK, 4096, 256, 1, e, nb, bid);
  } PH_FIN
  PH_BEGIN(14) phase_rg_scan(p, smem_raw, bid, nb); PH_FIN
  PH_BEGIN(15) {
    EpiResLn<true, true> e{p.out, p.out, (const u16*)(ws + WS_XB), p.out, (u16*)(ws + WS_XB), mod + 2 * 15360 + 2048, p.in[10] + 2 * 1024, p.in[11] + 2 * 1024, mod + 3 * 15360, (u16*)(ws + WS_H),
               (unsigned long long*)(ws + WS_SLOT) + 2 * 49152, (unsigned*)(ws + WS_CNT + 256) + 2 * 48};
    RUN_GEMM_X(ws + WS_B(0), 64, GM_KSTEP, (size_t)0, ws + WS_W_RG_OUT, TOK, 1024, 1024, 0, e, nb, bid);
    wconv_idle(p, smem_raw, bid, nb, 3840, 4800);
  } PH_FIN
  PH_BEGIN(17) {
    EpiMlaIn e{(u16*)(ws + WS3_CQ), (float*)(ws + WS3_CKVRAW), (float*)(ws + WS3_KPERAW), (u16*)(ws + WS3_SG)};
    RUN_GEMM(ws + WS_H, 1024, ws + WS_W_MLA_IN, TOK, 768, 1024, 0, e, bid);
    if (nb == 256) {
      EpiSg eg{(u16*)(ws + WS3_SG)};
      RUN_GEMM_R(ws + WS_H, 1024, ws + WS_W_MLA_IN + 672 * 1024 * 2, TOK, 1024, 1024, eg, 256, bid >= 144 ? bid - 144 : (1 << 20), 0, 112);
    }
  } PH_FIN
  PH_BEGIN(18) phase_mla_norm(p, bid, nb); PH_FIN
  PH_BEGIN(19) {
    const bool bal = (nb == 256);
    const int none = 1 << 20;
    EpiSg eg{(u16*)(ws + WS3_SG)};
    RUN_GEMM_R(ws + WS_H, 1024, ws + WS_W_MLA_IN + 672 * 1024 * 2, TOK, 1024, 1024, eg, nb, bid, bal ? 112 : 0, 192);
    EpiQ eq{(u16*)(ws + WS3_Q)};
    RUN_GEMM_G(ws + WS3_CQ, 384, ws + WS_W_QB, TOK, 1536, 384, 0, eq, bal ? 176 : nb, bal ? (bid >= 80 ? bid - 80 : none) : bid);
    EpiK ek{(u16*)(ws + WS3_K)};
    RUN_GEMM(ws + WS3_CKVALL, 256, ws + WS_W_KVB, KVROWS, 1024, 256, 0, ek, bid);
    EpiV ev{(u16*)(ws + WS3_VT)};
    RUN_GEMM_G(ws + WS_W_KVB + 1024 * 256 * 2, 256, ws + WS3_CKVALL, 1024, KVROWS, 256, 0, ev, bal ? 176 : nb, bal ? (bid >= 80 ? (bid + 160) % 176 : none) : bid);
  } PH_FIN
  PH_BEGIN(20) phase_attn(p, smem_raw, bid, nb); PH_FIN
  PH_BEGIN(21) {
    EpiResLn<true, false> e{p.out, p.out, (const u16*)(ws + WS_XB), p.out, (u16*)nullptr, mod + 3 * 15360 + 2048, p.in[10] + 3 * 1024, p.in[11] + 3 * 1024, mod + 3 * 15360, (u16*)nullptr,
               (unsigned long long*)(ws + WS_SLOT) + 3 * 49152, (unsigned*)(ws + WS_CNT + 256) + 3 * 48};
    RUN_GEMM(ws + WS_H, 1024, ws + WS_W_MLA_OUT, TOK, 1024, 1024, 0, e, bid);
  } PH_FIN
}

extern "C" void kernel_launch(void* const* d_in, const int* in_sizes, int n_in, void* d_out, int out_size, void* d_ws, size_t ws_size,
                              hipStream_t stream) {
  static int grid_blocks = 0;
  if (!grid_blocks) {
    int dev = 0, cus = 0, per_cu = 0;
    (void)hipGetDevice(&dev);
    (void)hipDeviceGetAttribute(&cus, hipDeviceAttributeMultiprocessorCount, dev);
    (void)hipFuncSetAttribute((const void*)mega, hipFuncAttributeMaxDynamicSharedMemorySize, DYN_LDS);
    (void)hipOccupancyMaxActiveBlocksPerMultiprocessor(&per_cu, (const void*)mega, NT, DYN_LDS);
    if (per_cu < 1) per_cu = 1;
    if (per_cu > 1) per_cu = 1;
    grid_blocks = cus * per_cu;
  }
  Params p{};
  for (int i = 0; i < 33; ++i) p.in[i] = (const float*)d_in[i];
  p.out = (float*)d_out;
  p.ws = (unsigned char*)d_ws;
#if MULTI_LAUNCH
  (void)hipMemsetAsync((unsigned char*)d_ws + WS_CNT, 0, 4096 + XCD_BAR_WORDS * 4, stream);
  for (int ph = 0; ph < NPHASES; ++ph) {
    p.phase_lo = ph; p.phase_hi = ph + 1;
    hipLaunchKernelGGL(mega, dim3(grid_blocks), dim3(NT), DYN_LDS, stream, p);
#ifdef PROBE_MASK
    if ((PROBE_MASK >> ph) & 1) { p.flags = PROBE_FLAGS; for (int r = 0; r < 2; ++r) {
      if (ph == 3) (void)hipMemsetAsync((unsigned char*)d_ws + WS_CNT, 0, 64, stream);
      hipLaunchKernelGGL(mega, dim3(grid_blocks), dim3(NT), DYN_LDS, stream, p);
    } p.flags = 0; }
#endif
  }
#else
  p.phase_lo = 0; p.phase_hi = NPHASES;
  (void)hipMemsetAsync((unsigned char*)d_ws + WS_CNT, 0, 4096 + XCD_BAR_WORDS * 4, stream);
  void* args[] = {&p};
  hipError_t e = hipLaunchCooperativeKernel((const void*)mega, dim3(grid_blocks), dim3(NT), args, DYN_LDS, stream);
  if (e != hipSuccess) fprintf(stderr, "cooperative launch failed: %s (grid %d)\n", hipGetErrorString(e), grid_blocks);
#endif
}
```

```cpp
#include <hip/hip_runtime.h>
#include <hip/hip_cooperative_groups.h>
#include <cstdio>
namespace cg = cooperative_groups;

#ifndef MULTI_LAUNCH
#define MULTI_LAUNCH 0
#endif

typedef unsigned short u16;
using bf16x8 = __attribute__((ext_vector_type(8))) short;
using f32x4 = __attribute__((ext_vector_type(4))) float;
typedef _Float16 h4 __attribute__((ext_vector_type(4)));

#define TOK 12288
#define NPROMPT 8192
#define KVROWS 14336
#define NPHASES 23
#ifndef PHMASK
#define PHMASK 0x7fffff
#endif
#define DN_ALPHA 1.6817928305074290f

#define WS_W_HG_IN 0ull
#define WS_W_HG_OUT (WS_W_HG_IN + 10485760ull)
#define WS_W_SC_IN (WS_W_HG_OUT + 2097152ull)
#define WS_W_SC_OUT (WS_W_SC_IN + 8388608ull)
#define WS_W_RG_IN (WS_W_SC_OUT + 2097152ull)
#define WS_W_RG_GATE (WS_W_RG_IN + 4194304ull)
#define WS_W_RG_OUT (WS_W_RG_GATE + 2097152ull)
#define WS_W_MLA_IN (WS_W_RG_OUT + 2097152ull)
#define WS_W_QB (WS_W_MLA_IN + 3670016ull)
#define WS_W_KVB (WS_W_QB + 1179648ull)
#define WS_W_MLA_OUT (WS_W_KVB + 1048576ull)
#define WS_MOD (WS_W_MLA_OUT + 2097152ull)
#define WS_LB (WS_MOD + 245760ull)
#define WS_CNT (WS_LB + 8192ull)
#define WS_R (WS_CNT + 4096ull + 16384ull)
#define BSZ 25165824ull
#define WS_H (WS_R)
#define WS_B(i) (WS_R + BSZ * (1 + (i)))
#define WS_SLOT (WS_R + 201326592ull)
#define WS_XB (WS_SLOT + 1572864ull)
#define WS3_CQ (WS_R + 25165824ull)
#define WS3_CKVALL (WS_R + 34603008ull)
#define WS3_CKVRAW (WS_R + 41943040ull)
#define WS3_KPERAW (WS_R + 54525952ull)
#define WS3_SG (WS_R + 56098816ull)
#define WS3_Q (WS_R + 81264640ull)
#define WS3_K (WS_R + 119013376ull)
#define WS3_VT (WS_R + 163053568ull)

#define OUT_HG 12582912
#define OUT_RG 20971520
#define OUT_CKV 21037056
#define OUT_KPE 23134208

struct Params {
  const float* in[33];
  float* out;
  unsigned char* ws;
  int phase_lo, phase_hi, flags, pad_;
};

__device__ __forceinline__ u16 f2bf(float f) { __bf16 r = (__bf16)f; return *(u16*)&r; }
__device__ __forceinline__ float bf2f(u16 h) { return __uint_as_float(((unsigned)h) << 16); }
typedef float f2v_ __attribute__((ext_vector_type(2)));
typedef __bf16 b2v_ __attribute__((ext_vector_type(2)));
__device__ __forceinline__ unsigned pack2(float a, float b) { f2v_ f = {a, b}; b2v_ r = __builtin_convertvector(f, b2v_); return *(unsigned*)&r; }
__device__ __forceinline__ uint2 pack4(float a, float b, float c, float d) { return make_uint2(pack2(a, b), pack2(c, d)); }
__device__ __forceinline__ float lo16(unsigned u) { return __uint_as_float(u << 16); }
__device__ __forceinline__ float hi16(unsigned u) { return __uint_as_float(u & 0xffff0000u); }
__device__ __forceinline__ float sigmoidf_(float x) { return __builtin_amdgcn_rcpf(1.0f + __expf(-x)); }
__device__ __forceinline__ float siluf_(float x) { return x * __builtin_amdgcn_rcpf(1.0f + __expf(-x)); }
__device__ __forceinline__ int cond_of(int tok) { return tok < NPROMPT ? 0 : 1 + ((tok - NPROMPT) >> 10); }
__device__ __forceinline__ float wave_sum(float v) {
#pragma unroll
  for (int o = 32; o > 0; o >>= 1) v += __shfl_xor(v, o);
  return v;
}
__device__ __forceinline__ void rope_sincos(float pos, int fi, float& sn, float& cs) {
  float inv = exp2f(-(float)fi * 1.6609640474436813f);
  float ang = pos * inv;
  float k = rintf(ang * 0.15915494309189535f);
  float r = fmaf(-k, 6.2831854820251465f, ang);
  r = fmaf(-k, -1.7484555e-7f, r);
  sn = __sinf(r); cs = __cosf(r);
}

#define NT 512
#define NW 8
#define LAS __attribute__((address_space(3)))

namespace pg8 {
constexpr int BM = 256, BK = 64, HALF = 128, HTB = HALF * BK * 2, STAGE_BYTES = 8 * HTB, NXCD = 8, WGM = 8;
__device__ __forceinline__ int lds_byte(int r, int c) { const int st = (r >> 4) * 2 + (c >> 5), rr = r & 15, cc = c & 31, ob = rr * 64 + cc * 2; return st * 1024 + (ob ^ (((ob >> 9) & 1) << 5)); }
__device__ __forceinline__ void stage_rc(int b, int& R, int& C) { const int st = b / 1024, sb = b % 1024, swz = sb ^ (((sb >> 9) & 1) << 5); R = (st >> 1) * 16 + swz / 64; C = (st & 1) * 32 + (swz % 64) / 2; }
struct Unit { int pm, pn; };
struct Gemm { const u16* A; const u16* Bt; int M, N, K, lda, gate, noepi; size_t kstepA, gstride; };
struct StaticOrder {
  int nM, nN, nwg, G, c, ubeg, uend;
  __device__ void init(int M, int N, int G_, int c_) { nM = M / BM; nN = N / BM; nwg = nM * nN; G = G_; c = c_; ubeg = 0; uend = nwg; }
  __device__ bool next(int i, Unit& u) const {
    const long L = (long)ubeg + (long)i * G + c; if (L >= uend) return false;
    int wgid = (int)L; { const int q = nwg / NXCD, r = nwg % NXCD, xcd = wgid % NXCD, off = wgid / NXCD; wgid = (xcd < r ? xcd * (q + 1) : r * (q + 1) + (xcd - r) * q) + off; }
    const int nig = WGM * nN, gid = wgid / nig, fm = gid * WGM, gsz = (nM - fm) < WGM ? (nM - fm) : WGM;
    u.pm = fm + ((wgid % nig) % gsz); u.pn = (wgid % nig) / gsz; return true;
  }
};
template <class Epi>
__device__ __forceinline__ void gemm_phase(LAS unsigned char* lds, const Gemm g, const StaticOrder& S, const Epi& E) {
  const int tid = threadIdx.x, wid = __builtin_amdgcn_readfirstlane(tid >> 6), lane = tid & 63, wr = wid >> 2, wc = wid & 3, fr = lane & 15, fq = lane >> 4;
  const int K = g.K, nt = K / BK;
  unsigned voffA[2], voffB[2];
#pragma unroll
  for (int i = 0; i < 2; ++i) { int R, C; stage_rc(tid * 16 + i * 8192, R, C); voffA[i] = (unsigned)(R * g.lda + C) * 2u; voffB[i] = (unsigned)(R * K + C) * 2u; }
  const size_t kstep = (size_t)(BK * 2);
  const size_t kstepA = g.kstepA;
  const size_t hstepA = (size_t)HALF * g.lda * 2, hstepB = (size_t)HALF * K * 2;
  const size_t tstepA = 2 * hstepA, tstepB = 2 * hstepB;
  const unsigned ldsw = (unsigned)wid * 1024u;
  const int aoff = lds_byte(wr * 64 + fr, fq * 8), boff = lds_byte(wc * 32 + fr, fq * 8);
#define PG8_AOFF(pn) (g.gate ? (size_t)(((pn) >> 1) & 3) * g.gstride : (size_t)0)
#define PG8_SA(b, h) (((b) * 2 + (h)) * HTB)
#define PG8_SB(b, h) ((4 + (b) * 2 + (h)) * HTB)
#define PG8_STAGE(bufoff, gbase, voff) do { _Pragma("unroll") for (int _i = 0; _i < 2; ++_i) \
    __builtin_amdgcn_global_load_lds((const unsigned*)((const char*)(gbase) + (voff)[_i]), (LAS unsigned*)(lds + (bufoff) + ldsw + _i * 8192), 16, 0, 0); } while (0)
#define PG8_LDA(dst, b, h) do { _Pragma("unroll") for (int m = 0; m < 4; ++m) _Pragma("unroll") for (int k = 0; k < 2; ++k) dst[m][k] = *(const LAS bf16x8*)(lds + PG8_SA(b, h) + aoff + m * 2048 + k * 1024); } while (0)
#define PG8_LDB(dst, b, h) do { _Pragma("unroll") for (int n = 0; n < 2; ++n) _Pragma("unroll") for (int k = 0; k < 2; ++k) dst[n][k] = *(const LAS bf16x8*)(lds + PG8_SB(b, h) + boff + n * 2048 + k * 1024); } while (0)
#define PG8_MMA(ai, bj, At, Bt) do { __builtin_amdgcn_s_setprio(1); _Pragma("unroll") for (int m = 0; m < 4; ++m) _Pragma("unroll") for (int n = 0; n < 2; ++n) _Pragma("unroll") for (int k = 0; k < 2; ++k) \
    acc[ai][bj][m][n] = __builtin_amdgcn_mfma_f32_16x16x32_bf16(Bt[n][k], At[m][k], acc[ai][bj][m][n], 0, 0, 0); __builtin_amdgcn_s_setprio(0); } while (0)
#define PG8_WAIT_V(n) asm volatile("s_waitcnt vmcnt(" #n ")" ::: "memory")
#define PG8_WAIT_L(n) asm volatile("s_waitcnt lgkmcnt(" #n ")" ::: "memory")
#define PG8_BAR __builtin_amdgcn_s_barrier()
#define PG8_SCHED __builtin_amdgcn_sched_barrier(0)
  Unit cur, nxt; int ui = 0;
  if (!S.next(0, cur)) return;
  f32x4 acc[2][2][4][2];
#pragma unroll
  for (int a = 0; a < 2; ++a)
#pragma unroll
    for (int b = 0; b < 2; ++b)
#pragma unroll
      for (int m = 0; m < 4; ++m)
#pragma unroll
        for (int n = 0; n < 2; ++n) acc[a][b][m][n] = (f32x4){0.f, 0.f, 0.f, 0.f};
  bf16x8 At[4][2], B0[2][2], B1[2][2];
  const char* cA = (const char*)g.A + (size_t)cur.pm * tstepA + PG8_AOFF(cur.pn); const char* cB = (const char*)g.Bt + (size_t)cur.pn * tstepB;
  PG8_STAGE(PG8_SB(0, 0), cB, voffB); PG8_STAGE(PG8_SA(0, 0), cA, voffA); PG8_STAGE(PG8_SB(0, 1), cB + hstepB, voffB); PG8_STAGE(PG8_SA(0, 1), cA + hstepA, voffA);
  if (wr == 1) PG8_BAR;
  PG8_WAIT_V(4); PG8_BAR;
  PG8_STAGE(PG8_SB(1, 0), cB + kstep, voffB); PG8_STAGE(PG8_SA(1, 0), cA + kstepA, voffA); PG8_STAGE(PG8_SB(1, 1), cB + hstepB + kstep, voffB);
  PG8_WAIT_V(6); PG8_BAR;
  for (;;) {
    const bool has_next = S.next(ui + 1, nxt);
    const char* nA = has_next ? (const char*)g.A + (size_t)nxt.pm * tstepA + PG8_AOFF(nxt.pn) : cA; const char* nB = has_next ? (const char*)g.Bt + (size_t)nxt.pn * tstepB : cB;
#pragma unroll 1
    for (int t = 0; t < nt; t += 2) {
      const bool last = (t == nt - 2);
      const char* a1 = cA + (size_t)(t + 1) * kstepA;
      const char* a2 = last ? nA : cA + (size_t)(t + 2) * kstepA; const char* b2 = last ? nB : cB + (size_t)(t + 2) * kstep;
      const char* a3 = a2 + kstepA; const char* b3 = b2 + kstep;
      PG8_LDB(B0, 0, 0); PG8_SCHED; PG8_LDA(At, 0, 0); PG8_STAGE(PG8_SA(1, 1), a1 + hstepA, voffA);
      PG8_WAIT_L(8); PG8_BAR; PG8_WAIT_L(0); PG8_MMA(0, 0, At, B0); PG8_BAR; PG8_SCHED;
      PG8_LDB(B1, 0, 1); PG8_STAGE(PG8_SB(0, 0), b2, voffB);
      PG8_BAR; PG8_WAIT_L(0); PG8_MMA(0, 1, At, B1); PG8_BAR;
      PG8_LDA(At, 0, 1); PG8_STAGE(PG8_SA(0, 0), a2, voffA);
      PG8_BAR; PG8_WAIT_L(0); PG8_MMA(1, 0, At, B0); PG8_BAR; PG8_SCHED;
      PG8_STAGE(PG8_SB(0, 1), b2 + hstepB, voffB);
      PG8_WAIT_V(6); PG8_BAR; PG8_MMA(1, 1, At, B1); PG8_BAR;
      PG8_LDB(B0, 1, 0); PG8_SCHED; PG8_LDA(At, 1, 0); PG8_STAGE(PG8_SA(0, 1), a2 + hstepA, voffA);
      PG8_WAIT_L(8); PG8_BAR; PG8_WAIT_L(0); PG8_MMA(0, 0, At, B0); PG8_BAR; PG8_SCHED;
      PG8_LDB(B1, 1, 1); PG8_STAGE(PG8_SB(1, 0), b3, voffB);
      PG8_BAR; PG8_WAIT_L(0); PG8_MMA(0, 1, At, B1); PG8_BAR;
      PG8_LDA(At, 1, 1); PG8_STAGE(PG8_SA(1, 0), a3, voffA);
      PG8_BAR; PG8_WAIT_L(0); PG8_MMA(1, 0, At, B0); PG8_BAR; PG8_SCHED;
      PG8_STAGE(PG8_SB(1, 1), b3 + hstepB, voffB);
      PG8_WAIT_V(6); PG8_BAR; PG8_MMA(1, 1, At, B1); PG8_BAR;
    }
    if constexpr (!Epi::AFTER_DRAIN) { if (!g.noepi) E(acc, cur, wr, wc, fr, fq); }
    if (!has_next) break;
#pragma unroll
    for (int a = 0; a < 2; ++a)
#pragma unroll
      for (int b = 0; b < 2; ++b)
#pragma unroll
        for (int m = 0; m < 4; ++m)
#pragma unroll
          for (int n = 0; n < 2; ++n) acc[a][b][m][n] = (f32x4){0.f, 0.f, 0.f, 0.f};
    cur = nxt; cA = nA; cB = nB; ++ui;
  }
  PG8_WAIT_V(0);
  if (wr == 0) PG8_BAR;
  PG8_BAR;
  if constexpr (Epi::AFTER_DRAIN) { if (!g.noepi) E.fused(acc, cur, wr, wc, fr, fq, lds); }
#undef PG8_AOFF
#undef PG8_SA
#undef PG8_SB
#undef PG8_STAGE
#undef PG8_LDA
#undef PG8_LDB
#undef PG8_MMA
#undef PG8_WAIT_V
#undef PG8_WAIT_L
#undef PG8_BAR
#undef PG8_SCHED
}
}
using pg8::Unit;
typedef const f32x4 (&AccRef)[2][2][4][2];

#define EPI_ROWS(...) _Pragma("unroll") for (int ai = 0; ai < 2; ++ai) _Pragma("unroll") for (int m = 0; m < 4; ++m) { const int row = u.pm * 256 + ai * 128 + wr * 64 + m * 16 + fr; __VA_ARGS__ }
#define EPI_COLS(...) _Pragma("unroll") for (int bj = 0; bj < 2; ++bj) _Pragma("unroll") for (int n = 0; n < 2; ++n) { const int cb = u.pn * 256 + bj * 128 + wc * 32 + n * 16; const f32x4 a = acc[ai][bj][m][n]; __VA_ARGS__ }

struct EpiHgIn {
  static constexpr bool AFTER_DRAIN = false;
  u16 *q, *v, *sg; _Float16* lf; const float* lb;
  __device__ __forceinline__ void operator()(AccRef acc, const Unit& u, int wr, int wc, int fr, int fq) const {
    const int region = u.pn >> 2;
    f32x4 l4[2][2];
    if (region == 1 || region == 2) {
#pragma unroll
      for (int bj = 0; bj < 2; ++bj)
#pragma unroll
        for (int n = 0; n < 2; ++n) l4[bj][n] = *(const f32x4*)&lb[(region - 1) * 1024 + ((u.pn * 256 + bj * 128 + wc * 32 + n * 16) & 1023) + fq * 4];
    }
    EPI_ROWS( EPI_COLS(
      const int c = (cb & 1023) + fq * 4;
      if (region == 0) {
        const float s = 0.08838834764831845f;
        *(uint2*)&q[(size_t)row * 1024 + c] = pack4(siluf_(a[0]) * s, siluf_(a[1]) * s, siluf_(a[2]) * s, siluf_(a[3]) * s);
      } else if (region <= 2) {
        const int d = region - 1;
        h4 o;
        _Pragma("unroll") for (int j = 0; j < 4; ++j) { float f = l4[bj][n][j] + (1.0f - l4[bj][n][j]) * sigmoidf_(a[j]); o[j] = (_Float16)__builtin_amdgcn_logf(f); }
        *(h4*)&lf[(size_t)row * 2048 + d * 1024 + c] = o;
      } else if (region == 3) {
        *(uint2*)&v[(size_t)row * 1024 + c] = pack4(a[0], a[1], a[2], a[3]);
      } else {
        *(uint2*)&sg[(size_t)row * 1024 + c] = pack4(a[0], a[1], a[2], a[3]);
      }
    ) )
  }
};

struct EpiRes {
  static constexpr bool AFTER_DRAIN = false;
  const float* xin_p; const float* xin_s; float* Y; const float* gate;
  __device__ __forceinline__ void operator()(AccRef acc, const Unit& u, int wr, int wc, int fr, int fq) const {
    EPI_ROWS(
      const float* xr = row < NPROMPT ? xin_p + (size_t)row * 1024 : xin_s + (size_t)(row - NPROMPT) * 1024;
      const float* g = gate + cond_of(row) * 3072;
      EPI_COLS(
        const int c = cb + fq * 4;
        f32x4 x = *(const f32x4*)&xr[c];
        f32x4 gg = *(const f32x4*)&g[c];
        f32x4 y;
        _Pragma("unroll") for (int j = 0; j < 4; ++j) y[j] = DN_ALPHA * x[j] + gg[j] * a[j];
        *(f32x4*)&Y[(size_t)row * 1024 + c] = y;
      ) )
  }
};

template <bool XIN_BF, bool XOUT_BF>
struct EpiResLn {
  static constexpr bool AFTER_DRAIN = true;
  const float* xin_p; const float* xin_s; const u16* xin_b; float* X; u16* XB; const float* gate; const float* lg; const float* lbias; const float* modn; u16* H;
  unsigned long long* slots; unsigned* cnt;
  __device__ __forceinline__ void fused(f32x4 (&acc)[2][2][4][2], const Unit& u, int wr, int wc, int fr, int fq, LAS unsigned char* lds) const {
    LAS float* part = (LAS float*)lds;
    LAS float* stat = part + 2048;
    const int tid = threadIdx.x;
    const int cnd = cond_of(u.pm * 256);
    f32x4 gv[2][2];
#pragma unroll
    for (int bj = 0; bj < 2; ++bj)
#pragma unroll
      for (int n = 0; n < 2; ++n) gv[bj][n] = *(const f32x4*)&gate[cnd * 3072 + u.pn * 256 + bj * 128 + wc * 32 + n * 16 + fq * 4];
#pragma unroll
    for (int ai = 0; ai < 2; ++ai)
#pragma unroll
      for (int m = 0; m < 4; ++m) {
        const int rl = ai * 128 + wr * 64 + m * 16 + fr;
        const int row = u.pm * 256 + rl;
        const float* xr = row < NPROMPT ? xin_p + (size_t)row * 1024 : xin_s + (size_t)(row - NPROMPT) * 1024;
        float s1 = 0.f, s2 = 0.f;
#pragma unroll
        for (int bj = 0; bj < 2; ++bj)
#pragma unroll
          for (int n = 0; n < 2; ++n) {
            const int c = u.pn * 256 + bj * 128 + wc * 32 + n * 16 + fq * 4;
            f32x4 x;
            if constexpr (XIN_BF) { const uint2 xb2 = *(const uint2*)&xin_b[(size_t)row * 1024 + c]; x = f32x4{lo16(xb2.x), hi16(xb2.x), lo16(xb2.y), hi16(xb2.y)}; }
            else x = *(const f32x4*)&xr[c];
            const f32x4 gg = gv[bj][n];
            f32x4 y;
#pragma unroll
            for (int j = 0; j < 4; ++j) { y[j] = DN_ALPHA * x[j] + gg[j] * acc[ai][bj][m][n][j]; s1 += y[j]; s2 += y[j] * y[j]; }
            acc[ai][bj][m][n] = y;
          }
        s1 += __shfl_xor(s1, 16); s1 += __shfl_xor(s1, 32);
        s2 += __shfl_xor(s2, 16); s2 += __shfl_xor(s2, 32);
        if (fq == 0) { part[(rl * 4 + wc) * 2] = s1; part[(rl * 4 + wc) * 2 + 1] = s2; }
      }
    __syncthreads();
    if (tid < 256) {
      float S1 = 0.f, S2 = 0.f;
#pragma unroll
      for (int w2 = 0; w2 < 4; ++w2) { S1 += part[(tid * 4 + w2) * 2]; S2 += part[(tid * 4 + w2) * 2 + 1]; }
      const unsigned long long v = (unsigned long long)__float_as_uint(S1) | ((unsigned long long)__float_as_uint(S2) << 32);
      __hip_atomic_store(&slots[(size_t)(u.pm * 4 + u.pn) * 256 + tid], v, __ATOMIC_RELAXED, __HIP_MEMORY_SCOPE_AGENT);
    }
    asm volatile("s_waitcnt vmcnt(0)" ::: "memory");
    __syncthreads();
    if (tid == 0) {
      __hip_atomic_fetch_add(&cnt[u.pm], 1u, __ATOMIC_RELAXED, __HIP_MEMORY_SCOPE_AGENT);
      unsigned sp = 0;
      while (__hip_atomic_load(&cnt[u.pm], __ATOMIC_RELAXED, __HIP_MEMORY_SCOPE_AGENT) < 4u) { __builtin_amdgcn_s_sleep(1); if (++sp > (1u << 24)) break; }
    }
    __syncthreads();
    if (tid < 256) {
      float T1 = 0.f, T2 = 0.f;
#pragma unroll
      for (int o = 0; o < 4; ++o) {
        const unsigned long long v = __hip_atomic_load(&slots[(size_t)(u.pm * 4 + o) * 256 + tid], __ATOMIC_RELAXED, __HIP_MEMORY_SCOPE_AGENT);
        T1 += __uint_as_float((unsigned)(v & 0xffffffffull)); T2 += __uint_as_float((unsigned)(v >> 32));
      }
      const float mu = T1 * (1.0f / 1024.0f);
      const float var = fmaxf(T2 * (1.0f / 1024.0f) - mu * mu, 0.f);
      stat[tid * 2] = mu; stat[tid * 2 + 1] = rsqrtf(var + 1e-5f);
    }
    __syncthreads();
#pragma unroll
    for (int bj = 0; bj < 2; ++bj) {
      f32x4 lgv[2], lbv[2], shv[2], scv[2];
#pragma unroll
      for (int n = 0; n < 2; ++n) {
        const int c = u.pn * 256 + bj * 128 + wc * 32 + n * 16 + fq * 4;
        lgv[n] = *(const f32x4*)&lg[c]; lbv[n] = *(const f32x4*)&lbias[c];
        shv[n] = *(const f32x4*)&modn[cnd * 3072 + c]; scv[n] = *(const f32x4*)&modn[cnd * 3072 + 1024 + c];
      }
#pragma unroll
      for (int ai = 0; ai < 2; ++ai)
#pragma unroll
        for (int m = 0; m < 4; ++m) {
          const int rl = ai * 128 + wr * 64 + m * 16 + fr;
          const int row = u.pm * 256 + rl;
          const float mu = stat[rl * 2], rs = stat[rl * 2 + 1];
#pragma unroll
          for (int n = 0; n < 2; ++n) {
            const int c = u.pn * 256 + bj * 128 + wc * 32 + n * 16 + fq * 4;
            const f32x4 y = acc[ai][bj][m][n];
            f32x4 xo;
#pragma unroll
            for (int j = 0; j < 4; ++j) xo[j] = (y[j] - mu) * rs * lgv[n][j] + lbv[n][j];
            if constexpr (XOUT_BF) *(uint2*)&XB[(size_t)row * 1024 + c] = pack4(xo[0], xo[1], xo[2], xo[3]);
            else *(f32x4*)&X[(size_t)row * 1024 + c] = xo;
            if (H) {
              *(uint2*)&H[(size_t)row * 1024 + c] = pack4(xo[0] * (1 + scv[n][0]) + shv[n][0], xo[1] * (1 + scv[n][1]) + shv[n][1], xo[2] * (1 + scv[n][2]) + shv[n][2], xo[3] * (1 + scv[n][3]) + shv[n][3]);
            }
          }
        }
    }
  }
};

struct EpiScIn {
  static constexpr bool AFTER_DRAIN = false;
  u16 *pb, *sb;
  __device__ __forceinline__ void operator()(AccRef acc, const Unit& u, int wr, int wc, int fr, int fq) const {
    const int c = u.pn * 64 + wc * 16 + fq * 4;
    EPI_ROWS(
      const f32x4 bg = acc[ai][0][m][0], cgv = acc[ai][0][m][1], v = acc[ai][1][m][0], g = acc[ai][1][m][1];
      *(uint2*)&pb[(size_t)row * 1024 + c] = pack4(cgv[0] * v[0], cgv[1] * v[1], cgv[2] * v[2], cgv[3] * v[3]);
      *(uint2*)&sb[(size_t)row * 1024 + c] = pack4(siluf_(g[0]) * bg[0], siluf_(g[1]) * bg[1], siluf_(g[2]) * bg[2], siluf_(g[3]) * bg[3]);
    )
  }
};

struct EpiRgIn {
  static constexpr bool AFTER_DRAIN = false;
  u16 *ub, *sg;
  __device__ __forceinline__ void operator()(AccRef acc, const Unit& u, int wr, int wc, int fr, int fq) const {
    const int region = u.pn >> 2;
    EPI_ROWS( EPI_COLS(
      const int c = (cb & 1023) + fq * 4;
      if (region == 0) *(uint2*)&ub[(size_t)row * 1024 + c] = pack4(a[0], a[1], a[2], a[3]);
      else *(uint2*)&sg[((size_t)(c >> 6) * TOK + row) * 64 + (c & 63)] = pack4(siluf_(a[0]), siluf_(a[1]), siluf_(a[2]), siluf_(a[3]));
    ) )
  }
};

struct EpiSgGM {
  static constexpr bool AFTER_DRAIN = false;
  u16* sg;
  __device__ __forceinline__ void operator()(AccRef acc, const Unit& u, int wr, int wc, int fr, int fq) const {
    EPI_ROWS( EPI_COLS(
      const int c = cb + fq * 4;
      *(uint2*)&sg[((size_t)(c >> 6) * TOK + row) * 64 + (c & 63)] = pack4(siluf_(a[0]), siluf_(a[1]), siluf_(a[2]), siluf_(a[3]));
    ) )
  }
};

struct EpiRgGate {
  static constexpr bool AFTER_DRAIN = false;
  u16 *rb, *ib; const float* bgate;
  __device__ __forceinline__ void operator()(AccRef acc, const Unit& u, int wr, int wc, int fr, int fq) const {
    const int mat = u.pn >> 1, d = mat >> 2, hd = mat & 3;
    f32x4 br[2], bi[2]; int ccs[2];
#pragma unroll
    for (int bj = 0; bj < 2; ++bj) {
      const int off = ((u.pn & 1) * 256 + bj * 128 + wc * 32);
      ccs[bj] = (off >> 5) * 16 + fq * 4;
      br[bj] = *(const f32x4*)&bgate[mat * 512 + ccs[bj]];
      bi[bj] = *(const f32x4*)&bgate[mat * 512 + 256 + ccs[bj]];
    }
    EPI_ROWS(
      _Pragma("unroll") for (int bj = 0; bj < 2; ++bj) {
        const f32x4 r = acc[ai][bj][m][0], ii = acc[ai][bj][m][1];
        const int cch = hd * 256 + ccs[bj];
        const size_t o = (size_t)d * TOK * 1024 + ((size_t)(cch >> 6) * TOK + row) * 64 + (cch & 63);
        *(uint2*)&rb[o] = pack4(sigmoidf_(r[0] + br[bj][0]), sigmoidf_(r[1] + br[bj][1]), sigmoidf_(r[2] + br[bj][2]), sigmoidf_(r[3] + br[bj][3]));
        *(uint2*)&ib[o] = pack4(sigmoidf_(ii[0] + bi[bj][0]), sigmoidf_(ii[1] + bi[bj][1]), sigmoidf_(ii[2] + bi[bj][2]), sigmoidf_(ii[3] + bi[bj][3]));
      } )
  }
};

struct EpiMlaIn {
  static constexpr bool AFTER_DRAIN = false;
  u16* cq; float* ckvraw; float* kperaw; u16* sg;
  __device__ __forceinline__ void operator()(AccRef acc, const Unit& u, int wr, int wc, int fr, int fq) const {
    EPI_ROWS( EPI_COLS(
      const int c = cb + fq * 4;
      if (cb < 384) *(uint2*)&cq[(size_t)row * 384 + c] = pack4(a[0], a[1], a[2], a[3]);
      else if (cb < 640) *(f32x4*)&ckvraw[(size_t)row * 256 + (c - 384)] = a;
      else if (cb < 672) *(f32x4*)&kperaw[(size_t)row * 32 + (c - 640)] = a;
    ) )
  }
};

struct EpiSg {
  static constexpr bool AFTER_DRAIN = false;
  u16* sg;
  __device__ __forceinline__ void operator()(AccRef acc, const Unit& u, int wr, int wc, int fr, int fq) const {
    EPI_ROWS( EPI_COLS(
      *(uint2*)&sg[(size_t)row * 1024 + cb + fq * 4] = pack4(a[0], a[1], a[2], a[3]);
    ) )
  }
};

struct EpiQ {
  static constexpr bool AFTER_DRAIN = false;
  u16* q;
  __device__ __forceinline__ void operator()(AccRef acc, const Unit& u, int wr, int wc, int fr, int fq) const {
    const float sc = 0.14724444500602648f;
    EPI_ROWS( EPI_COLS(
      *(uint2*)&q[(size_t)row * 1536 + cb + fq * 4] = pack4(a[0] * sc, a[1] * sc, a[2] * sc, a[3] * sc);
    ) )
  }
};

struct EpiK {
  static constexpr bool AFTER_DRAIN = false;
  u16* Kb;
  __device__ __forceinline__ void operator()(AccRef acc, const Unit& u, int wr, int wc, int fr, int fq) const {
    EPI_ROWS( EPI_COLS(
      const int h = cb >> 6, dd = (cb & 63) + fq * 4;
      *(uint2*)&Kb[((size_t)row * 16 + h) * 96 + dd] = pack4(a[0], a[1], a[2], a[3]);
    ) )
  }
};
struct EpiV {
  static constexpr bool AFTER_DRAIN = false;
  u16* Vt;
  __device__ __forceinline__ void operator()(AccRef acc, const Unit& u, int wr, int wc, int fr, int fq) const {
    EPI_ROWS( EPI_COLS(
      *(uint2*)&Vt[(size_t)row * KVROWS + cb + fq * 4] = pack4(a[0], a[1], a[2], a[3]);
    ) )
  }
};

__device__ __forceinline__ void wconv_tile(const float* __restrict__ src, int N, int K, u16* __restrict__ dst, int k0, int n0,
                                           int perm, int mat, float* tile) {
  const int tid = threadIdx.x;
  {
    const int r = tid >> 4, c4 = (tid & 15) * 4;
#pragma unroll
    for (int i = 0; i < 2; ++i) {
      const int k = r + i * 32;
      f32x4 v = f32x4{0.f, 0.f, 0.f, 0.f};
      if (n0 + c4 < N) v = *(const f32x4*)&src[(size_t)(k0 + k) * N + n0 + c4];
      tile[k * 65 + c4 + 0] = v[0]; tile[k * 65 + c4 + 1] = v[1]; tile[k * 65 + c4 + 2] = v[2]; tile[k * 65 + c4 + 3] = v[3];
    }
  }
  __syncthreads();
  {
    const int nl = tid >> 3, kq = (tid & 7) * 8;
    const int n = n0 + nl;
    int np = n;
    if (perm == 1) { const int part = n >> 10, c = n & 1023; np = (c >> 6) * 256 + (part >> 1) * 128 + ((c >> 4) & 3) * 32 + (part & 1) * 16 + (c & 15); }
    else if (perm == 2) { const int type = n >> 8, cc = n & 255; np = mat * 512 + (cc >> 4) * 32 + type * 16 + (cc & 15); }
    else if (perm == 3) { const int hh = n >> 7, dd = n & 127; np = (dd >= 64 ? 1024 : 0) + hh * 64 + (dd & 63); }
    if (n < N) {
      unsigned w[4];
#pragma unroll
      for (int i = 0; i < 4; ++i) w[i] = pack2(tile[(kq + 2 * i) * 65 + nl], tile[(kq + 2 * i + 1) * 65 + nl]);
      *(uint4*)&dst[(size_t)np * K + k0 + kq] = make_uint4(w[0], w[1], w[2], w[3]);
    }
  }
  __syncthreads();
}

__device__ __forceinline__ void wconv_item(const Params& p, int t, float* fs) {
  const float* src; u16* dst; int N, K, perm = 0, mat = 0, ntn;
  if (t < 1280) { src = p.in[12]; dst = (u16*)(p.ws + WS_W_HG_IN); N = 5120; K = 1024; }
  else if ((t -= 1280) < 256) { src = p.in[15]; dst = (u16*)(p.ws + WS_W_HG_OUT); N = 1024; K = 1024; }
  else if ((t -= 256) < 1024) { src = p.in[16]; dst = (u16*)(p.ws + WS_W_SC_IN); N = 4096; K = 1024; perm = 1; }
  else if ((t -= 1024) < 256) { src = p.in[19]; dst = (u16*)(p.ws + WS_W_SC_OUT); N = 1024; K = 1024; }
  else if ((t -= 256) < 512) { src = p.in[20]; dst = (u16*)(p.ws + WS_W_RG_IN); N = 2048; K = 1024; }
  else if ((t -= 512) < 256) { mat = t >> 5; t &= 31; src = p.in[23] + (size_t)mat * 256 * 512; dst = (u16*)(p.ws + WS_W_RG_GATE); N = 512; K = 256; perm = 2; }
  else if ((t -= 256) < 256) { src = p.in[26]; dst = (u16*)(p.ws + WS_W_RG_OUT); N = 1024; K = 1024; }
  else if ((t -= 256) < 432) { src = p.in[27]; dst = (u16*)(p.ws + WS_W_MLA_IN); N = 1696; K = 1024; }
  else if ((t -= 432) < 144) { src = p.in[30]; dst = (u16*)(p.ws + WS_W_QB); N = 1536; K = 384; }
  else if ((t -= 144) < 128) { src = p.in[31]; dst = (u16*)(p.ws + WS_W_KVB); N = 2048; K = 256; perm = 3; }
  else { t -= 128; src = p.in[32]; dst = (u16*)(p.ws + WS_W_MLA_OUT); N = 1024; K = 1024; }
  ntn = (N + 63) >> 6;
  const int kt = t / ntn, ntl = t - kt * ntn;
  wconv_tile(src, N, K, dst, kt * 64, ntl * 64, perm, mat, fs);
}
__device__ __forceinline__ void wconv_idle(const Params& p, unsigned char* smem_raw, int bid, int nb, int t0, int t1) {
  if (nb == 256 && bid >= 192) for (int t = t0 + (bid - 192); t < t1; t += 64) wconv_item(p, t, (float*)smem_raw);
}

__device__ __forceinline__ void phase_prologue(const Params& p, unsigned char* smem_raw, int bid, int nb) {
  float* fs = (float*)smem_raw;
  const int tid = threadIdx.x;
  const int NMOD = 192, NWT = (nb == 256) ? 1536 : 4800;
  for (int it = bid; it < NMOD + 1 + NWT; it += nb) {
    if (it < NMOD) {
      const int l = it / 48, n0 = (it % 48) * 64;
      float* scond = fs;
      float* sred = fs + 5120;
      for (int i = tid; i < 5120; i += NT) {
        const int ci = i >> 10, k = i & 1023;
        float cv = ci == 0 ? p.in[7][k] : p.in[6][(ci - 1) * 1024 + k];
        scond[i] = siluf_(cv);
      }
      __syncthreads();
      const int col = tid & 63, kg = tid >> 6;
      const float* w = p.in[8] + (size_t)l * 1024 * 3072 + n0 + col;
      float a0 = 0, a1 = 0, a2 = 0, a3 = 0, a4 = 0;
#pragma unroll 16
      for (int k = kg * 128; k < kg * 128 + 128; ++k) {
        float wv = w[(size_t)k * 3072];
        a0 += scond[k] * wv; a1 += scond[1024 + k] * wv; a2 += scond[2048 + k] * wv; a3 += scond[3072 + k] * wv; a4 += scond[4096 + k] * wv;
      }
      sred[(kg * 5 + 0) * 64 + col] = a0; sred[(kg * 5 + 1) * 64 + col] = a1; sred[(kg * 5 + 2) * 64 + col] = a2;
      sred[(kg * 5 + 3) * 64 + col] = a3; sred[(kg * 5 + 4) * 64 + col] = a4;
      __syncthreads();
      float* mod = (float*)(p.ws + WS_MOD);
      if (tid < 320) {
        const int ci = tid >> 6, cc = tid & 63;
        float s = 0;
#pragma unroll
        for (int g = 0; g < 8; ++g) s += sred[(g * 5 + ci) * 64 + cc];
        mod[(l * 5 + ci) * 3072 + n0 + cc] = s + p.in[9][l * 3072 + n0 + cc];
      }
      __syncthreads();
    } else if (it == NMOD) {
      float* lb = (float*)(p.ws + WS_LB);
      for (int i = tid; i < 2048; i += NT) {
        const int d = i >> 10, c = i & 1023;
        const float* lg = p.in[13] + d * 5 * 1024 + c;
        float m = lg[0];
        for (int j = 1; j < 5; ++j) m = fmaxf(m, lg[j * 1024]);
        float s = 0;
        for (int j = 0; j < 5; ++j) s += expf(lg[j * 1024] - m);
        lb[i] = expf(lg[0] - m) / s;
      }
      int* cnt = (int*)(p.ws + WS_CNT);
      if (tid < 16) cnt[tid] = 0;
    } else {
      wconv_item(p, it - NMOD - 1, fs);
    }
  }
}

__device__ __forceinline__ void phase_h0(const Params& p, int bid, int nb) {
  const float* mod = (const float*)(p.ws + WS_MOD);
  u16* H = (u16*)(p.ws + WS_H);
  const size_t total = (size_t)(TOK / 4) * 256;
  for (size_t i = (size_t)bid * NT + threadIdx.x; i < total; i += (size_t)nb * NT) {
    const int row = (int)(i >> 8) * 4, c = ((int)i & 255) * 4;
    const float* xr = row < NPROMPT ? p.in[0] + (size_t)row * 1024 : p.in[1] + (size_t)(row - NPROMPT) * 1024;
    const float* m = mod + cond_of(row) * 3072;
    f32x4 x[4];
#pragma unroll
    for (int t = 0; t < 4; ++t) x[t] = *(const f32x4*)&xr[t * 1024 + c];
    const f32x4 sh = *(const f32x4*)&m[c];
    const f32x4 sc = *(const f32x4*)&m[1024 + c];
#pragma unroll
    for (int t = 0; t < 4; ++t)
      *(uint2*)&H[(size_t)(row + t) * 1024 + c] = pack4(x[t][0] * (1 + sc[0]) + sh[0], x[t][1] * (1 + sc[1]) + sh[1], x[t][2] * (1 + sc[2]) + sh[2], x[t][3] * (1 + sc[3]) + sh[3]);
  }
}

__device__ __forceinline__ void phase_ln(const Params& p, int l, int bid, int nb) {
  float* X = p.out;
  const float* g = p.in[10] + l * 1024;
  const float* b = p.in[11] + l * 1024;
  const float* mod = (const float*)(p.ws + WS_MOD) + (l + 1) * 5 * 3072;
  u16* H = (u16*)(p.ws + WS_H);
  const int lane = threadIdx.x & 63, wave = threadIdx.x >> 6;
  for (int row = bid * NW + wave; row < TOK; row += nb * NW) {
    float* xr = X + (size_t)row * 1024;
    f32x4 v[4];
    float s = 0;
#pragma unroll
    for (int i = 0; i < 4; ++i) { v[i] = *(const f32x4*)&xr[i * 256 + lane * 4]; s += v[i][0] + v[i][1] + v[i][2] + v[i][3]; }
    const float mu = wave_sum(s) * (1.0f / 1024.0f);
    float q = 0;
#pragma unroll
    for (int i = 0; i < 4; ++i)
#pragma unroll
      for (int j = 0; j < 4; ++j) { float dd = v[i][j] - mu; q += dd * dd; }
    const float rs = rsqrtf(wave_sum(q) * (1.0f / 1024.0f) + 1e-5f);
    const float* m = mod + cond_of(row) * 3072;
#pragma unroll
    for (int i = 0; i < 4; ++i) {
      const int c = i * 256 + lane * 4;
      f32x4 gg = *(const f32x4*)&g[c], bb = *(const f32x4*)&b[c];
      f32x4 y;
#pragma unroll
      for (int j = 0; j < 4; ++j) y[j] = (v[i][j] - mu) * rs * gg[j] + bb[j];
      *(f32x4*)&xr[c] = y;
      if (l < 3) {
        f32x4 sh = *(const f32x4*)&m[c], sc = *(const f32x4*)&m[1024 + c];
        *(uint2*)&H[(size_t)row * 1024 + c] = pack4(y[0] * (1 + sc[0]) + sh[0], y[1] * (1 + sc[1]) + sh[1], y[2] * (1 + sc[2]) + sh[2], y[3] * (1 + sc[3]) + sh[3]);
      }
    }
  }
}

__device__ __forceinline__ void phase_gla(const Params& p, unsigned char* smem_raw) {
  u16* s_qrel = (u16*)smem_raw;
  u16* s_krel = s_qrel + 32 * 136;
  u16* s_qcum = s_krel + 32 * 136;
  u16* s_kdT = s_qcum + 32 * 136;
  u16* s_vT = s_kdT + 128 * 40;
  u16* s_att = s_vT + 128 * 40;
  u16* s_S = s_att + 32 * 40;
  float* s_dec = (float*)(s_S + 128 * 136);
  float* s_part = s_dec + 128;
  int* s_u = (int*)(s_part + 512);
  int* counter = (int*)(p.ws + WS_CNT);
  const u16* qg = (const u16*)(p.ws + WS_B(0));
  const u16* vg = (const u16*)(p.ws + WS_B(1));
  const _Float16* lfg = (const _Float16*)(p.ws + WS_B(3));
  u16* og = (u16*)(p.ws + WS_B(5));
  const int tid = threadIdx.x, lane = tid & 63, w = tid >> 6, fr = lane & 15, fq = lane >> 4;
  const int kk = tid & 127, th = tid >> 7;
  const int ti = w >> 2, vi = w & 3;
  const int wk = w & 3, wv = w >> 2;
  bool first = true;
  while (true) {
    if (tid == 0) *s_u = (first && blockIdx.x < 64) ? (int)blockIdx.x : 64 + atomicAdd(counter, 1);
    first = false;
    __syncthreads();
    const int u = *s_u;
    __syncthreads();
    if (u >= 576) break;
    int b, rem, start, N, sample;
    if (u < 64) { sample = 1; b = u >> 4; rem = u & 15; start = NPROMPT + b * 1024; N = 1024; }
    else { sample = 0; b = (u - 64) >> 4; rem = (u - 64) & 15; start = b * 256; N = 256; }
    const int h = rem >> 1, d = rem & 1;
    const int nc = N >> 5;
    f32x4 S[2][4];
#pragma unroll
    for (int mi = 0; mi < 2; ++mi)
#pragma unroll
      for (int ni = 0; ni < 4; ++ni) {
        f32x4 s4 = f32x4{0.f, 0.f, 0.f, 0.f};
        if (sample) {
          const float* s0 = p.in[2] + ((size_t)((b * 2 + d) * 8 + h)) * 16384;
#pragma unroll
          for (int j = 0; j < 4; ++j) s4[j] = s0[(wk * 32 + mi * 16 + fq * 4 + j) * 128 + wv * 64 + ni * 16 + fr];
        }
        S[mi][ni] = s4;
        *(uint2*)&s_S[(wv * 64 + ni * 16 + fr) * 136 + wk * 32 + mi * 16 + fq * 4] = pack4(s4[0], s4[1], s4[2], s4[3]);
      }
    _Float16 lfraw[8]; u16 qraw[8]; uint4 vraw;
#define GLA_LOAD(cc) do { _Pragma("unroll") for (int i = 0; i < 8; ++i) { const int tt = (cc) * 32 + th * 8 + i; const size_t tok = start + (d ? (N - 1 - tt) : tt); \
      lfraw[i] = lfg[tok * 2048 + d * 1024 + h * 128 + kk]; qraw[i] = qg[tok * 1024 + h * 128 + kk]; } \
      { const int tt = (cc) * 32 + (tid >> 4); const size_t tok = start + (d ? (N - 1 - tt) : tt); vraw = *(const uint4*)&vg[tok * 1024 + h * 128 + (tid & 15) * 8]; } } while (0)
    GLA_LOAD(0);
    for (int c = 0; c < nc; ++c) {
      {
        float lfv[8], qv[8];
#pragma unroll
        for (int i = 0; i < 8; ++i) { lfv[i] = (float)lfraw[i]; qv[i] = bf2f(qraw[i]); }
        const uint4 vv = vraw;
        if (c + 1 < nc) GLA_LOAD(c + 1);
        float run = 0;
        float cs[8];
#pragma unroll
        for (int i = 0; i < 8; ++i) { run += lfv[i]; cs[i] = run; }
        s_part[th * 128 + kk] = run;
        {
          const int s = tid >> 4, v8 = (tid & 15) * 8;
          const unsigned vw[4] = {vv.x, vv.y, vv.z, vv.w};
#pragma unroll
          for (int i = 0; i < 4; ++i) { s_vT[(v8 + 2 * i) * 40 + s] = (u16)(vw[i] & 0xffff); s_vT[(v8 + 2 * i + 1) * 40 + s] = (u16)(vw[i] >> 16); }
        }
        __syncthreads();
        const float p0 = s_part[kk], p1 = s_part[128 + kk], p2 = s_part[256 + kk], p3 = s_part[384 + kk];
        const float off = (th > 0 ? p0 : 0.f) + (th > 1 ? p1 : 0.f) + (th > 2 ? p2 : 0.f);
        const float ref = p0 + p1, total = p0 + p1 + p2 + p3;
        unsigned kd[4];
        const float eref = __builtin_amdgcn_exp2f(ref), etr = __builtin_amdgcn_exp2f(total - ref);
#pragma unroll
        for (int i = 0; i < 8; ++i) {
          const int t = th * 8 + i;
          const float cum = off + cs[i];
          const float kf = 1.0f - __builtin_amdgcn_exp2f(lfv[i]);
          const float e1 = __builtin_amdgcn_exp2f(cum - ref), e2 = __builtin_amdgcn_rcpf(e1);
          const float qe = qv[i] * e1, ke = kf * e2;
          s_qrel[t * 136 + kk] = f2bf(qe);
          s_krel[t * 136 + kk] = f2bf(ke);
          s_qcum[t * 136 + kk] = f2bf(qe * eref);
          const u16 kdv = f2bf(ke * etr);
          if (i & 1) kd[i >> 1] |= ((unsigned)kdv) << 16; else kd[i >> 1] = kdv;
        }
        *(uint4*)&s_kdT[kk * 40 + th * 8] = make_uint4(kd[0], kd[1], kd[2], kd[3]);
        if (th == 0) s_dec[kk] = eref * etr;
      }
      __syncthreads();
      f32x4 oacc[2] = {f32x4{0.f, 0.f, 0.f, 0.f}, f32x4{0.f, 0.f, 0.f, 0.f}};
      {
        f32x4 att = f32x4{0.f, 0.f, 0.f, 0.f};
        const int ati = w >> 1, asi = w & 1;
#pragma unroll
        for (int ks = 0; ks < 4; ++ks) {
          if (w < 4) {
            bf16x8 a = *(const bf16x8*)&s_qrel[(ati * 16 + fr) * 136 + ks * 32 + fq * 8];
            bf16x8 bb = *(const bf16x8*)&s_krel[(asi * 16 + fr) * 136 + ks * 32 + fq * 8];
            att = __builtin_amdgcn_mfma_f32_16x16x32_bf16(a, bb, att, 0, 0, 0);
          }
          bf16x8 a2 = *(const bf16x8*)&s_qcum[(ti * 16 + fr) * 136 + ks * 32 + fq * 8];
#pragma unroll
          for (int e = 0; e < 2; ++e) {
            bf16x8 b2 = *(const bf16x8*)&s_S[((vi * 2 + e) * 16 + fr) * 136 + ks * 32 + fq * 8];
            oacc[e] = __builtin_amdgcn_mfma_f32_16x16x32_bf16(b2, a2, oacc[e], 0, 0, 0);
          }
        }
        if (w < 4) {
#pragma unroll
          for (int j = 0; j < 4; ++j) {
            const int t = ati * 16 + fq * 4 + j, s = asi * 16 + fr;
            s_att[t * 40 + s] = (s <= t) ? f2bf(att[j]) : (u16)0;
          }
        }
      }
      __syncthreads();
      {
        bf16x8 a = *(const bf16x8*)&s_att[(ti * 16 + fr) * 40 + fq * 8];
        const int tt = c * 32 + ti * 16 + fr;
        const size_t tok = start + (d ? (N - 1 - tt) : tt);
#pragma unroll
        for (int e = 0; e < 2; ++e) {
          bf16x8 bb = *(const bf16x8*)&s_vT[((vi * 2 + e) * 16 + fr) * 40 + fq * 8];
          oacc[e] = __builtin_amdgcn_mfma_f32_16x16x32_bf16(bb, a, oacc[e], 0, 0, 0);
          *(uint2*)&og[((size_t)d * TOK + tok) * 1024 + h * 128 + (vi * 2 + e) * 16 + fq * 4] = pack4(oacc[e][0], oacc[e][1], oacc[e][2], oacc[e][3]);
        }
        bf16x8 vf[4];
#pragma unroll
        for (int ni = 0; ni < 4; ++ni) vf[ni] = *(const bf16x8*)&s_vT[(wv * 64 + ni * 16 + fr) * 40 + fq * 8];
#pragma unroll
        for (int mi = 0; mi < 2; ++mi) {
          bf16x8 kf = *(const bf16x8*)&s_kdT[(wk * 32 + mi * 16 + fr) * 40 + fq * 8];
          f32x4 dc = *(const f32x4*)&s_dec[wk * 32 + mi * 16 + fq * 4];
#pragma unroll
          for (int ni = 0; ni < 4; ++ni) {
            f32x4 s4 = S[mi][ni];
#pragma unroll
            for (int j = 0; j < 4; ++j) s4[j] *= dc[j];
            s4 = __builtin_amdgcn_mfma_f32_16x16x32_bf16(kf, vf[ni], s4, 0, 0, 0);
            S[mi][ni] = s4;
            *(uint2*)&s_S[(wv * 64 + ni * 16 + fr) * 136 + wk * 32 + mi * 16 + fq * 4] = pack4(s4[0], s4[1], s4[2], s4[3]);
          }
        }
      }
      __syncthreads();
    }
    if (!sample) {
      float* so = p.out + OUT_HG + ((size_t)((b * 2 + d) * 8 + h)) * 16384;
#pragma unroll
      for (int mi = 0; mi < 2; ++mi)
#pragma unroll
        for (int ni = 0; ni < 4; ++ni)
#pragma unroll
          for (int j = 0; j < 4; ++j) so[(wk * 32 + mi * 16 + fq * 4 + j) * 128 + wv * 64 + ni * 16 + fr] = S[mi][ni][j];
    }
  }
#undef GLA_LOAD
}

__device__ __forceinline__ void phase_hg_post(const Params& p, int bid, int nb) {
  const u16* og = (const u16*)(p.ws + WS_B(5));
  const u16* sg = (const u16*)(p.ws + WS_B(2));
  u16* a = (u16*)(p.ws + WS_B(0));
  const float* ng = p.in[14];
  const int lane = threadIdx.x & 63, wave = threadIdx.x >> 6;
  float ngv[16];
#pragma unroll
  for (int k = 0; k < 4; ++k) { const f32x4 t = *(const f32x4*)&ng[lane * 16 + 4 * k]; ngv[4 * k] = t[0]; ngv[4 * k + 1] = t[1]; ngv[4 * k + 2] = t[2]; ngv[4 * k + 3] = t[3]; }
  for (int row0 = (bid * NW + wave) * 2; row0 < TOK; row0 += nb * NW * 2) {
    uint4 f[2][2], bw[2][2], sv[2][2];
#pragma unroll
    for (int r = 0; r < 2; ++r)
#pragma unroll
      for (int hh = 0; hh < 2; ++hh) {
        const size_t base = (size_t)(row0 + r) * 1024 + lane * 16 + hh * 8;
        f[r][hh] = *(const uint4*)&og[base];
        bw[r][hh] = *(const uint4*)&og[(size_t)TOK * 1024 + base];
        sv[r][hh] = *(const uint4*)&sg[base];
      }
#pragma unroll
    for (int r = 0; r < 2; ++r) {
      float o[16];
      float ss = 0;
#pragma unroll
      for (int hh = 0; hh < 2; ++hh) {
        const unsigned fa[4] = {f[r][hh].x, f[r][hh].y, f[r][hh].z, f[r][hh].w}, ba[4] = {bw[r][hh].x, bw[r][hh].y, bw[r][hh].z, bw[r][hh].w};
#pragma unroll
        for (int i = 0; i < 4; ++i) {
          o[hh * 8 + 2 * i] = lo16(fa[i]) + lo16(ba[i]);
          o[hh * 8 + 2 * i + 1] = hi16(fa[i]) + hi16(ba[i]);
        }
      }
#pragma unroll
      for (int i = 0; i < 16; ++i) ss += o[i] * o[i];
      ss += __shfl_xor(ss, 1); ss += __shfl_xor(ss, 2); ss += __shfl_xor(ss, 4);
      const float rs = rsqrtf(ss * (1.0f / 128.0f) + 1e-6f);
#pragma unroll
      for (int hh = 0; hh < 2; ++hh) {
        const unsigned sa[4] = {sv[r][hh].x, sv[r][hh].y, sv[r][hh].z, sv[r][hh].w};
        unsigned rr[4];
#pragma unroll
        for (int i = 0; i < 4; ++i)
          rr[i] = pack2(o[hh * 8 + 2 * i] * rs * ngv[hh * 8 + 2 * i] * siluf_(lo16(sa[i])), o[hh * 8 + 2 * i + 1] * rs * ngv[hh * 8 + 2 * i + 1] * siluf_(hi16(sa[i])));
        *(uint4*)&a[(size_t)(row0 + r) * 1024 + lane * 16 + hh * 8] = make_uint4(rr[0], rr[1], rr[2], rr[3]);
      }
    }
  }
}

__device__ __forceinline__ void seq_pos(int tok, int& n, int& L) {
  if (tok < NPROMPT) { n = tok & 255; L = 256; } else { n = (tok - NPROMPT) & 1023; L = 1024; }
}
__device__ __forceinline__ void phase_sc_conv(const Params& p, int bid, int nb) {
  const u16* pb = (const u16*)(p.ws + WS_B(0));
  const u16* sb = (const u16*)(p.ws + WS_B(1));
  u16* a = (u16*)(p.ws + WS_B(2));
  const float* cw = p.in[17]; const float* cbias = p.in[18];
  const size_t total = (size_t)TOK * 128;
  const size_t i0 = (size_t)bid * NT + threadIdx.x;
  const int c = ((int)i0 & 127) * 8;
  float w0[8], w1[8], w2[8], wb[8];
#pragma unroll
  for (int k = 0; k < 2; ++k) {
    const f32x4 t0 = *(const f32x4*)&cw[c + 4 * k], t1 = *(const f32x4*)&cw[1024 + c + 4 * k], t2 = *(const f32x4*)&cw[2048 + c + 4 * k], tb = *(const f32x4*)&cbias[c + 4 * k];
#pragma unroll
    for (int j = 0; j < 4; ++j) { w0[4 * k + j] = t0[j]; w1[4 * k + j] = t1[j]; w2[4 * k + j] = t2[j]; wb[4 * k + j] = tb[j]; }
  }
  const uint4 z = make_uint4(0, 0, 0, 0);
  for (size_t i = i0; i < total / 4; i += (size_t)nb * NT) {
    const int tok = (int)(i >> 7) * 4;
    int n, L; seq_pos(tok, n, L);
    const size_t base = (size_t)tok * 1024 + c;
    uint4 q[6], sv[4];
    q[0] = n > 0 ? *(const uint4*)&pb[base - 1024] : z;
#pragma unroll
    for (int t = 0; t < 4; ++t) { q[1 + t] = *(const uint4*)&pb[base + t * 1024]; sv[t] = *(const uint4*)&sb[base + t * 1024]; }
    q[5] = n + 4 < L ? *(const uint4*)&pb[base + 4096] : z;
#pragma unroll
    for (int t = 0; t < 4; ++t) {
      const unsigned am[4] = {q[t].x, q[t].y, q[t].z, q[t].w}, a0[4] = {q[t + 1].x, q[t + 1].y, q[t + 1].z, q[t + 1].w};
      const unsigned ap[4] = {q[t + 2].x, q[t + 2].y, q[t + 2].z, q[t + 2].w}, as[4] = {sv[t].x, sv[t].y, sv[t].z, sv[t].w};
      unsigned r[4];
#pragma unroll
      for (int k = 0; k < 4; ++k) {
        float z0 = w0[2 * k] * lo16(am[k]) + w1[2 * k] * lo16(a0[k]) + w2[2 * k] * lo16(ap[k]) + wb[2 * k];
        float z1 = w0[2 * k + 1] * hi16(am[k]) + w1[2 * k + 1] * hi16(a0[k]) + w2[2 * k + 1] * hi16(ap[k]) + wb[2 * k + 1];
        r[k] = pack2(lo16(as[k]) * z0, hi16(as[k]) * z1);
      }
      *(uint4*)&a[base + t * 1024] = make_uint4(r[0], r[1], r[2], r[3]);
    }
  }
}
__device__ __forceinline__ void phase_rg_conv(const Params& p, int bid, int nb) {
  const u16* ub = (const u16*)(p.ws + WS_B(0));
  u16* uc = (u16*)(p.ws + WS_B(2));
  const float* cw = p.in[21]; const float* cbias = p.in[22];
  const size_t total = (size_t)TOK * 128;
  const size_t i0 = (size_t)bid * NT + threadIdx.x;
  const int c = ((int)i0 & 127) * 8;
  float w0[8], w1[8], w2[8], w3[8], wb[8];
#pragma unroll
  for (int k = 0; k < 2; ++k) {
    const f32x4 t0 = *(const f32x4*)&cw[c + 4 * k], t1 = *(const f32x4*)&cw[1024 + c + 4 * k], t2 = *(const f32x4*)&cw[2048 + c + 4 * k], t3 = *(const f32x4*)&cw[3072 + c + 4 * k], tb = *(const f32x4*)&cbias[c + 4 * k];
#pragma unroll
    for (int j = 0; j < 4; ++j) { w0[4 * k + j] = t0[j]; w1[4 * k + j] = t1[j]; w2[4 * k + j] = t2[j]; w3[4 * k + j] = t3[j]; wb[4 * k + j] = tb[j]; }
  }
  const uint4 z = make_uint4(0, 0, 0, 0);
  for (size_t i = i0; i < total / 4; i += (size_t)nb * NT) {
    const int tok = (int)(i >> 7) * 4;
    int n, L; seq_pos(tok, n, L);
    const size_t base = (size_t)tok * 1024 + c;
    uint4 q[7];
    q[0] = n > 1 ? *(const uint4*)&ub[base - 2048] : z;
    q[1] = n > 0 ? *(const uint4*)&ub[base - 1024] : z;
#pragma unroll
    for (int t = 0; t < 4; ++t) q[2 + t] = *(const uint4*)&ub[base + t * 1024];
    q[6] = n + 4 < L ? *(const uint4*)&ub[base + 4096] : z;
#pragma unroll
    for (int t = 0; t < 4; ++t) {
      const unsigned a0[4] = {q[t].x, q[t].y, q[t].z, q[t].w}, a1[4] = {q[t + 1].x, q[t + 1].y, q[t + 1].z, q[t + 1].w};
      const unsigned a2[4] = {q[t + 2].x, q[t + 2].y, q[t + 2].z, q[t + 2].w}, a3[4] = {q[t + 3].x, q[t + 3].y, q[t + 3].z, q[t + 3].w};
      unsigned r[4];
#pragma unroll
      for (int k = 0; k < 4; ++k) {
        float z0 = w0[2 * k] * lo16(a0[k]) + w1[2 * k] * lo16(a1[k]) + w2[2 * k] * lo16(a2[k]) + w3[2 * k] * lo16(a3[k]) + wb[2 * k];
        float z1 = w0[2 * k + 1] * hi16(a0[k]) + w1[2 * k + 1] * hi16(a1[k]) + w2[2 * k + 1] * hi16(a2[k]) + w3[2 * k + 1] * hi16(a3[k]) + wb[2 * k + 1];
        r[k] = pack2(z0, z1);
      }
      *(uint4*)&uc[((size_t)(c >> 6) * TOK + tok + t) * 64 + (c & 63)] = make_uint4(r[0], r[1], r[2], r[3]);
    }
  }
}

__device__ __forceinline__ void phase_rg_scan(const Params& p, unsigned char* smem_raw, int bid, int nb) {
  float* sA = (float*)smem_raw;
  float* sB = sA + 2048;
  const u16* rb = (const u16*)(p.ws + WS_B(3));
  const u16* ib = (const u16*)(p.ws + WS_B(5));
  const u16* uc = (const u16*)(p.ws + WS_B(2));
  const u16* sg = (const u16*)(p.ws + WS_B(1));
  u16* hfw = (u16*)(p.ws + WS_H);
  u16* yp = (u16*)(p.ws + WS_B(0));
  const int tid = threadIdx.x;
  for (int u = bid; u < 768; u += nb) {
    int sample, b, c, seg, nseg, start, chs, slot;
    if (u < 256) {
      const int xq = u & 7, yq = u >> 3, gid = (yq >> 2) * 8 + xq, sub = yq & 3;
      sample = 1; b = gid >> 4; slot = (tid & 3) * 4; c = (gid & 15) * 64 + sub * 16 + slot; seg = tid >> 2; nseg = 128; start = NPROMPT + b * 1024; chs = 16; }
    else { sample = 0; b = (u - 256) >> 4; slot = (tid & 15) * 4; c = ((u - 256) & 15) * 64 + slot; seg = tid >> 4; nseg = 32; start = b * 256; chs = 64; }
    const int L = nseg * 8;
#pragma unroll 1
    for (int d = 0; d < 2; ++d) {
      const f32x4 lam = *(const f32x4*)&p.in[25][d * 1024 + c];
      float cl[4];
#pragma unroll
      for (int j = 0; j < 4; ++j) cl[j] = 8.0f * 1.4426950408889634f * log1pf(__expf(-lam[j]))    ;
      const u16* rp = rb + (size_t)d * TOK * 1024;
      const u16* ip = ib + (size_t)d * TOK * 1024;
      const int tok0 = start + (d ? L - 1 - seg * 8 : seg * 8);
      const size_t o0 = (size_t)tok0 * 1024 + c;
      const long ostep = d ? -1024 : 1024;
      const size_t g0 = ((size_t)(c >> 6) * TOK + tok0) * 64 + (c & 63);
      const long gstep = d ? -64 : 64;
      uint2 rr[8], ii[8], uu[8];
#pragma unroll
      for (int s8 = 0; s8 < 8; ++s8) { rr[s8] = *(const uint2*)&rp[g0 + s8 * gstep]; ii[s8] = *(const uint2*)&ip[g0 + s8 * gstep]; uu[s8] = *(const uint2*)&uc[g0 + s8 * gstep]; }
      uint2 hf[8], sgv[8];
      if (d == 1) {
#pragma unroll
        for (int s8 = 0; s8 < 8; ++s8) { hf[s8] = *(const uint2*)&hfw[g0 + s8 * gstep]; sgv[s8] = *(const uint2*)&sg[g0 + s8 * gstep]; }
      }
      float av[8][4], xv[8][4];
      float A[4] = {1.f, 1.f, 1.f, 1.f}, B[4] = {0.f, 0.f, 0.f, 0.f};
#pragma unroll
      for (int s8 = 0; s8 < 8; ++s8) {
        const float r4[4] = {lo16(rr[s8].x), hi16(rr[s8].x), lo16(rr[s8].y), hi16(rr[s8].y)};
        const float i4[4] = {lo16(ii[s8].x), hi16(ii[s8].x), lo16(ii[s8].y), hi16(ii[s8].y)};
        const float u4[4] = {lo16(uu[s8].x), hi16(uu[s8].x), lo16(uu[s8].y), hi16(uu[s8].y)};
#pragma unroll
        for (int j = 0; j < 4; ++j) {
          const float la = -cl[j] * r4[j];
          const float a = __builtin_amdgcn_exp2f(la);
          const float xin = __builtin_amdgcn_sqrtf(fmaxf(1.0f - __builtin_amdgcn_exp2f(2.0f * la), 0.f)) * (i4[j] * u4[j]);
          av[s8][j] = a; xv[s8][j] = xin;
          A[j] *= a; B[j] = a * B[j] + xin;
        }
      }
      *(f32x4*)&sA[seg * chs + slot] = f32x4{A[0], A[1], A[2], A[3]};
      *(f32x4*)&sB[seg * chs + slot] = f32x4{B[0], B[1], B[2], B[3]};
      for (int k = 1; k < nseg; k <<= 1) {
        __syncthreads();
        f32x4 pa = f32x4{1.f, 1.f, 1.f, 1.f}, pb2 = f32x4{0.f, 0.f, 0.f, 0.f};
        if (seg >= k) { pa = *(const f32x4*)&sA[(seg - k) * chs + slot]; pb2 = *(const f32x4*)&sB[(seg - k) * chs + slot]; }
        __syncthreads();
        if (seg >= k) {
#pragma unroll
          for (int j = 0; j < 4; ++j) { B[j] = A[j] * pb2[j] + B[j]; A[j] = A[j] * pa[j]; }
          *(f32x4*)&sA[seg * chs + slot] = f32x4{A[0], A[1], A[2], A[3]};
          *(f32x4*)&sB[seg * chs + slot] = f32x4{B[0], B[1], B[2], B[3]};
        }
      }
      __syncthreads();
      float h[4];
      {
        f32x4 h0v = f32x4{0.f, 0.f, 0.f, 0.f};
        if (sample) h0v = *(const f32x4*)&p.in[3][(b * 2 + d) * 1024 + c];
        if (seg > 0) {
          const f32x4 pa = *(const f32x4*)&sA[(seg - 1) * chs + slot], pb2 = *(const f32x4*)&sB[(seg - 1) * chs + slot];
#pragma unroll
          for (int j = 0; j < 4; ++j) h[j] = pa[j] * h0v[j] + pb2[j];
        } else {
#pragma unroll
          for (int j = 0; j < 4; ++j) h[j] = h0v[j];
        }
      }
#pragma unroll
      for (int s8 = 0; s8 < 8; ++s8) {
#pragma unroll
        for (int j = 0; j < 4; ++j) h[j] = av[s8][j] * h[j] + xv[s8][j];
        const size_t o = o0 + s8 * ostep;
        if (d == 0) *(uint2*)&hfw[g0 + s8 * gstep] = pack4(h[0], h[1], h[2], h[3]);
        else *(uint2*)&yp[g0 + s8 * gstep] = pack4((lo16(hf[s8].x) + h[0]) * lo16(sgv[s8].x), (hi16(hf[s8].x) + h[1]) * hi16(sgv[s8].x),
                                     (lo16(hf[s8].y) + h[2]) * lo16(sgv[s8].y), (hi16(hf[s8].y) + h[3]) * hi16(sgv[s8].y));
      }
      if (!sample && seg == nseg - 1) *(f32x4*)&p.out[OUT_RG + (b * 2 + d) * 1024 + c] = f32x4{h[0], h[1], h[2], h[3]};
      __syncthreads();
    }
  }
}

__device__ __forceinline__ void phase_mla_norm(const Params& p, int bid, int nb) {
  u16* cq = (u16*)(p.ws + WS3_CQ);
  u16* ckvall = (u16*)(p.ws + WS3_CKVALL);
  const float* ckvraw = (const float*)(p.ws + WS3_CKVRAW);
  const float* kperaw = (const float*)(p.ws + WS3_KPERAW);
  u16* Kb = (u16*)(p.ws + WS3_K);
  const float* qn = p.in[28]; const float* kvn = p.in[29];
  const int lane = threadIdx.x & 63, wave = threadIdx.x >> 6;
  float qnv[6];
#pragma unroll
  for (int i = 0; i < 3; ++i) { qnv[2 * i] = qn[(i * 64 + lane) * 2]; qnv[2 * i + 1] = qn[(i * 64 + lane) * 2 + 1]; }
  const f32x4 g4 = *(const f32x4*)&kvn[lane * 4];
  unsigned cvn[3] = {0u, 0u, 0u}; f32x4 kvnx = f32x4{0.f, 0.f, 0.f, 0.f}; float vnx = 0.f;
  {
    const int r0 = bid * NW + wave;
    if (r0 < TOK) {
#pragma unroll
      for (int i = 0; i < 3; ++i) cvn[i] = ((const unsigned*)&cq[(size_t)r0 * 384])[i * 64 + lane];
      kvnx = *(const f32x4*)&ckvraw[(size_t)r0 * 256 + lane * 4]; vnx = kperaw[(size_t)r0 * 32 + (lane & 31)];
    }
  }
  for (int row = bid * NW + wave; row < TOK + 2048; row += nb * NW) {
    if (row < TOK) {
      const int tok = row;
      const bool sample = tok >= NPROMPT;
      unsigned cv[3] = {cvn[0], cvn[1], cvn[2]}; const f32x4 kv = kvnx; float v = vnx;
      {
        const int rn = row + nb * NW;
        if (rn < TOK) {
#pragma unroll
          for (int i = 0; i < 3; ++i) cvn[i] = ((const unsigned*)&cq[(size_t)rn * 384])[i * 64 + lane];
          kvnx = *(const f32x4*)&ckvraw[(size_t)rn * 256 + lane * 4]; vnx = kperaw[(size_t)rn * 32 + (lane & 31)];
        }
      }
      const int bs = (tok - NPROMPT) >> 10, n = (tok - NPROMPT) & 1023;
      const size_t kvrow = sample ? (size_t)(NPROMPT + bs * 1536 + 512 + n) : (size_t)tok;
      unsigned* cqr = (unsigned*)&cq[(size_t)tok * 384];
      float ss = 0;
#pragma unroll
      for (int i = 0; i < 3; ++i) { float a = lo16(cv[i]), b2 = hi16(cv[i]); ss += a * a + b2 * b2; }
      const float rsq = rsqrtf(wave_sum(ss) * (1.0f / 384.0f) + 1e-6f);
#pragma unroll
      for (int i = 0; i < 3; ++i) {
        cqr[i * 64 + lane] = pack2(lo16(cv[i]) * rsq * qnv[2 * i], hi16(cv[i]) * rsq * qnv[2 * i + 1]);
      }
      const float rsk = rsqrtf(wave_sum(kv[0] * kv[0] + kv[1] * kv[1] + kv[2] * kv[2] + kv[3] * kv[3]) * (1.0f / 256.0f) + 1e-6f);
      f32x4 o4;
#pragma unroll
      for (int j = 0; j < 4; ++j) o4[j] = kv[j] * rsk * g4[j];
      *(uint2*)&ckvall[kvrow * 256 + lane * 4] = pack4(o4[0], o4[1], o4[2], o4[3]);
      if (!sample) *(f32x4*)&p.out[OUT_CKV + (size_t)tok * 256 + lane * 4] = o4;
      if (!sample) { if (lane < 32) p.out[OUT_KPE + (size_t)tok * 32 + lane] = v; }
      else {
        const float partner = __shfl_xor(v, 8);
        const int i16 = lane & 15;
        const float pos = (lane & 16) ? (float)(n & 63) : (float)(n >> 6);
        float sn, cs; rope_sincos(pos, i16 & 7, sn, cs);
        v = (i16 < 8) ? (v * cs - partner * sn) : (partner * sn + v * cs);
      }
      const u16 vb = f2bf(v);
#pragma unroll
      for (int i = 0; i < 8; ++i) Kb[(kvrow * 16 + (lane >> 5) + 2 * i) * 96 + 64 + (lane & 31)] = vb;
    } else {
      const int r = row - TOK, bs = r >> 9, j = r & 511;
      const size_t kvrow = (size_t)(NPROMPT + bs * 1536 + j);
      f32x4 kv = *(const f32x4*)&p.in[4][(size_t)r * 256 + lane * 4];
      *(uint2*)&ckvall[kvrow * 256 + lane * 4] = pack4(kv[0], kv[1], kv[2], kv[3]);
      const u16 vb = f2bf(p.in[5][(size_t)r * 32 + (lane & 31)]);
#pragma unroll
      for (int i = 0; i < 8; ++i) Kb[(kvrow * 16 + (lane >> 5) + 2 * i) * 96 + 64 + (lane & 31)] = vb;
    }
  }
}

__device__ __forceinline__ void phase_attn(const Params& p, unsigned char* smem_raw, int bid, int nb) {
  u16* sK = (u16*)smem_raw;
  u16* sV = sK + 128 * 104;
  const u16* qg = (const u16*)(p.ws + WS3_Q);
  const u16* Kg = (const u16*)(p.ws + WS3_K);
  const u16* Vg = (const u16*)(p.ws + WS3_VT);
  const u16* sg = (const u16*)(p.ws + WS3_SG);
  u16* ao = (u16*)(p.ws + WS_H);
  const int tid = threadIdx.x, lane = tid & 63, w = tid >> 6, fr = lane & 15, fq = lane >> 4;
  for (int u = bid; u < 1536; u += nb) {
    int tok0, kvbase, nkeys, h;
    if (u < 512) { const int b = u >> 7, r = u & 127; h = r >> 3; const int qb = r & 7; tok0 = NPROMPT + b * 1024 + qb * 128; kvbase = NPROMPT + b * 1536; nkeys = 1536; }
    else { const int uu = u - 512; const int b = uu >> 5, r = uu & 31; h = r >> 1; const int qb = r & 1; tok0 = b * 256 + qb * 128; kvbase = b * 256; nkeys = 256; }
    const int tokq = tok0 + w * 16 + fr;
    bf16x8 qf[3];
#pragma unroll
    for (int ks = 0; ks < 3; ++ks) qf[ks] = *(const bf16x8*)&qg[(size_t)tokq * 1536 + h * 96 + ks * 32 + fq * 8];
    if (u < 512) {
      const int npos = (tokq - NPROMPT) & 1023;
      const float pos = (fq & 2) ? (float)(npos & 63) : (float)(npos >> 6);
      uint4 raw = *(uint4*)&qf[2];
      unsigned rw[4] = {raw.x, raw.y, raw.z, raw.w};
#pragma unroll
      for (int i = 0; i < 4; ++i) {
        float v0 = lo16(rw[i]), v1 = hi16(rw[i]);
        const float p0 = __shfl_xor(v0, 16), p1 = __shfl_xor(v1, 16);
        float sn0, cs0, sn1, cs1;
        rope_sincos(pos, 2 * i, sn0, cs0); rope_sincos(pos, 2 * i + 1, sn1, cs1);
        v0 = (fq & 1) ? (p0 * sn0 + v0 * cs0) : (v0 * cs0 - p0 * sn0);
        v1 = (fq & 1) ? (p1 * sn1 + v1 * cs1) : (v1 * cs1 - p1 * sn1);
        rw[i] = pack2(v0, v1);
      }
      raw = make_uint4(rw[0], rw[1], rw[2], rw[3]);
      qf[2] = *(bf16x8*)&raw;
    }
    float m = -1e30f, l = 0.f;
    f32x4 oacc[4];
#pragma unroll
    for (int i = 0; i < 4; ++i) oacc[i] = f32x4{0.f, 0.f, 0.f, 0.f};
    const int kk0 = tid / 12, kc0 = tid - kk0 * 12;
    const int kk1 = (tid + NT) / 12, kc1 = (tid + NT) - kk1 * 12;
    const int kk2_ = (tid + 2 * NT) / 12, kc2 = (tid + 2 * NT) - kk2_ * 12;
    const u16* Kp0 = &Kg[((size_t)(kvbase + kk0) * 16 + h) * 96 + kc0 * 8];
    const u16* Kp1 = &Kg[((size_t)(kvbase + kk1) * 16 + h) * 96 + kc1 * 8];
    const u16* Kp2 = &Kg[((size_t)(kvbase + kk2_) * 16 + h) * 96 + kc2 * 8];
    const int vd0 = tid >> 4, vc0 = tid & 15, vd1 = (tid + NT) >> 4;
    const u16* Vp0 = &Vg[(size_t)(h * 64 + vd0) * KVROWS + kvbase + vc0 * 8];
    const u16* Vp1 = &Vg[(size_t)(h * 64 + vd1) * KVROWS + kvbase + vc0 * 8];
    uint4 kr0 = *(const uint4*)Kp0, kr1 = *(const uint4*)Kp1, kr2 = *(const uint4*)Kp2, vr0 = *(const uint4*)Vp0, vr1 = *(const uint4*)Vp1;
    const int ntile2 = nkeys >> 7;
    for (int kt = 0; kt < ntile2; ++kt) {
      __syncthreads();
      *(uint4*)&sK[kk0 * 104 + kc0 * 8] = kr0; *(uint4*)&sK[kk1 * 104 + kc1 * 8] = kr1; *(uint4*)&sK[kk2_ * 104 + kc2 * 8] = kr2;
      *(uint4*)&sV[vd0 * 136 + vc0 * 8] = vr0; *(uint4*)&sV[vd1 * 136 + vc0 * 8] = vr1;
      if (kt + 1 < ntile2) {
        const size_t ko = (size_t)(kt + 1) * 128 * 1536; const int vo = (kt + 1) * 128;
        kr0 = *(const uint4*)(Kp0 + ko); kr1 = *(const uint4*)(Kp1 + ko); kr2 = *(const uint4*)(Kp2 + ko);
        vr0 = *(const uint4*)(Vp0 + vo); vr1 = *(const uint4*)(Vp1 + vo);
      }
      __syncthreads();
      f32x4 sacc[8];
#pragma unroll
      for (int ni = 0; ni < 8; ++ni) {
        sacc[ni] = f32x4{0.f, 0.f, 0.f, 0.f};
#pragma unroll
        for (int ks = 0; ks < 3; ++ks) {
          bf16x8 kf = *(const bf16x8*)&sK[(ni * 16 + fr) * 104 + ks * 32 + fq * 8];
          sacc[ni] = __builtin_amdgcn_mfma_f32_16x16x32_bf16(kf, qf[ks], sacc[ni], 0, 0, 0);
        }
      }
      float mx = -1e30f;
#pragma unroll
      for (int ni = 0; ni < 8; ++ni)
#pragma unroll
        for (int j = 0; j < 4; ++j) mx = fmaxf(mx, sacc[ni][j]);
      mx = fmaxf(mx, __shfl_xor(mx, 16));
      mx = fmaxf(mx, __shfl_xor(mx, 32));
      const float mnew = fmaxf(m, mx);
      const float alpha = __builtin_amdgcn_exp2f(m - mnew);
      m = mnew;
      float ls = 0.f;
#pragma unroll
      for (int ni = 0; ni < 8; ++ni)
#pragma unroll
        for (int j = 0; j < 4; ++j) { float e = __builtin_amdgcn_exp2f(sacc[ni][j] - mnew); sacc[ni][j] = e; ls += e; }
      l = l * alpha + ls;
      bf16x8 pf[4];
#pragma unroll
      for (int kk2 = 0; kk2 < 4; ++kk2) {
        uint2 lo = pack4(sacc[2 * kk2][0], sacc[2 * kk2][1], sacc[2 * kk2][2], sacc[2 * kk2][3]);
        uint2 hi = pack4(sacc[2 * kk2 + 1][0], sacc[2 * kk2 + 1][1], sacc[2 * kk2 + 1][2], sacc[2 * kk2 + 1][3]);
        uint4 pk = make_uint4(lo.x, lo.y, hi.x, hi.y);
        pf[kk2] = *(bf16x8*)&pk;
      }
#pragma unroll
      for (int di = 0; di < 4; ++di) {
#pragma unroll
        for (int j = 0; j < 4; ++j) oacc[di][j] *= alpha;
#pragma unroll
        for (int kk2 = 0; kk2 < 4; ++kk2) {
          uint2 v0 = *(const uint2*)&sV[(di * 16 + fr) * 136 + kk2 * 32 + fq * 4];
          uint2 v1 = *(const uint2*)&sV[(di * 16 + fr) * 136 + kk2 * 32 + 16 + fq * 4];
          uint4 vk = make_uint4(v0.x, v0.y, v1.x, v1.y);
          oacc[di] = __builtin_amdgcn_mfma_f32_16x16x32_bf16(*(bf16x8*)&vk, pf[kk2], oacc[di], 0, 0, 0);
        }
      }
    }
    l += __shfl_xor(l, 16);
    l += __shfl_xor(l, 32);
    const float inv = 1.0f / l;
#pragma unroll
    for (int di = 0; di < 4; ++di) {
      const size_t o = (size_t)tokq * 1024 + h * 64 + di * 16 + fq * 4;
      uint2 s = *(const uint2*)&sg[o];
      *(uint2*)&ao[o] = pack4(oacc[di][0] * inv * siluf_(lo16(s.x)), oacc[di][1] * inv * siluf_(hi16(s.x)), oacc[di][2] * inv * siluf_(lo16(s.y)), oacc[di][3] * inv * siluf_(hi16(s.y)));
    }
  }
}

#define XB_TMO      128
#define XB_XCNT(j)  (256  + 64 * (j))
#define XB_XSUB(j)  (1280 + 64 * (j))
#define XB_XGEN(j)  (2304 + 64 * (j))
#define XB_TOP      3328
#define XB_TOPGEN   3392
#define XCD_BAR_WORDS 3456
#define XB_SPIN_CAP (1u << 22)
__device__ __forceinline__ unsigned xb_ld(unsigned* p)              { return __hip_atomic_load(p, __ATOMIC_RELAXED, __HIP_MEMORY_SCOPE_AGENT); }
__device__ __forceinline__ unsigned xb_add(unsigned* p, unsigned v) { return __hip_atomic_fetch_add(p, v, __ATOMIC_RELAXED, __HIP_MEMORY_SCOPE_AGENT); }
__device__ __forceinline__ unsigned xb_xcc_id() { return (unsigned)__builtin_amdgcn_s_getreg((3 << 11) | 20) & 0xFu; }
#define XB_SPIN(cond, bar) do { unsigned _sp = 0; while (cond) { __builtin_amdgcn_s_sleep(1); \
    if ((++_sp & 255u) == 0u) { if (xb_ld(&(bar)[XB_TMO])) break; if (_sp > XB_SPIN_CAP) { atomicAdd(&(bar)[XB_TMO], 1u); break; } } } } while (0)
struct XcdBarrier { unsigned* bar; unsigned x; volatile LAS unsigned* st; };
__device__ __forceinline__ XcdBarrier xcd_barrier_post(unsigned* bar, volatile LAS unsigned* st) {
  XcdBarrier b; b.bar = bar; b.x = xb_xcc_id(); b.st = st;
  if (threadIdx.x == 0) (void)xb_add(&bar[XB_XCNT(b.x)], 1u);
  return b;
}
__device__ __forceinline__ void xcd_barrier_complete(unsigned* bar, unsigned x, unsigned& nloc, unsigned& nx) {
  const unsigned G = gridDim.x * gridDim.y * gridDim.z;
  unsigned sum, cnt, mine, sp = 0u;
  for (;;) {
    sum = 0u; cnt = 0u; mine = 0u;
#pragma unroll
    for (unsigned j = 0; j < 16; ++j) { const unsigned c = xb_ld(&bar[XB_XCNT(j)]); sum += c; cnt += (c > 0u) ? 1u : 0u; mine = (j == x) ? c : mine; }
    if (sum == G) break;
    __builtin_amdgcn_s_sleep(1);
    if ((++sp & 255u) == 0u) { if (xb_ld(&bar[XB_TMO])) break; if (sp > XB_SPIN_CAP) { atomicAdd(&bar[XB_TMO], 1u); break; } }
  }
  nloc = mine > 0u ? mine : 1u; nx = cnt > 0u ? cnt : 1u;
}
__device__ __forceinline__ void xcd_barrier(const XcdBarrier& b) {
  asm volatile("s_waitcnt vmcnt(0)" ::: "memory");
  __syncthreads();
  if (threadIdx.x == 0) {
    unsigned* bar = b.bar;
    __builtin_amdgcn_s_waitcnt(0);
    unsigned nloc = b.st[0], nx = b.st[1];
    if (nloc == 0u) { xcd_barrier_complete(bar, b.x, nloc, nx); b.st[0] = nloc; b.st[1] = nx; }
    const unsigned old = xb_add(&bar[XB_XSUB(b.x)], 1u);
    const unsigned gen = old / nloc;
    if (old + 1u == (gen + 1u) * nloc) {
      __builtin_amdgcn_fence(__ATOMIC_RELEASE, "agent");
      asm volatile("s_waitcnt vmcnt(0)" ::: "memory");
      const unsigned og = xb_add(&bar[XB_TOP], 1u);
      const unsigned tg = og / nx;
      if (og + 1u == (tg + 1u) * nx) xb_add(&bar[XB_TOPGEN], 1u);
      else XB_SPIN(xb_ld(&bar[XB_TOPGEN]) == tg, bar);
      __builtin_amdgcn_fence(__ATOMIC_ACQUIRE, "agent");
      xb_add(&bar[XB_XGEN(b.x)], 1u);
      asm volatile("s_waitcnt vmcnt(0)" ::: "memory");
    } else {
      XB_SPIN(xb_ld(&bar[XB_XGEN(b.x)]) == gen, bar);
      __builtin_amdgcn_fence(__ATOMIC_ACQUIRE, "agent");
      asm volatile("s_waitcnt vmcnt(0)" ::: "memory");
    }
  }
  __syncthreads();
}

#define GEMM_LDS 131072
#define DYN_LDS (GEMM_LDS + 16)
#define WS_BAR (WS_CNT + 4096ull)

#define RUN_GEMM(Aptr, LDA, Bptr, MM, NN, KK, GATE, EPI, CID) RUN_GEMM_G(Aptr, LDA, Bptr, MM, NN, KK, GATE, EPI, nb, CID)
#define RUN_GEMM_G(Aptr, LDA, Bptr, MM, NN, KK, GATE, EPI, GG, CID) RUN_GEMM_X(Aptr, LDA, (size_t)128, (size_t)0, Bptr, MM, NN, KK, GATE, EPI, GG, CID)
#define GM_KSTEP ((size_t)TOK * 128)
#define RUN_GEMM_X(Aptr, LDA, KSA, GST, Bptr, MM, NN, KK, GATE, EPI, GG, CID) do { pg8::Gemm g_{(const u16*)(Aptr), (const u16*)(Bptr), MM, NN, KK, LDA, GATE, p.flags, KSA, GST}; \
    pg8::StaticOrder S_; S_.init(MM, NN, GG, CID); pg8::gemm_phase((LAS unsigned char*)smem_raw, g_, S_, EPI); } while (0)
#define RUN_GEMM_RX(Aptr, LDA, KSA, GST, Bptr, MM, NN, KK, GATE, EPI, GG, CID, UBEG, UEND) do { pg8::Gemm g_{(const u16*)(Aptr), (const u16*)(Bptr), MM, NN, KK, LDA, GATE, p.flags, KSA, GST}; \
    pg8::StaticOrder S_; S_.init(MM, NN, GG, CID); S_.ubeg = UBEG; S_.uend = UEND; pg8::gemm_phase((LAS unsigned char*)smem_raw, g_, S_, EPI); } while (0)
#define RUN_GEMM_R(Aptr, LDA, Bptr, MM, NN, KK, EPI, GG, CID, UBEG, UEND) do { pg8::Gemm g_{(const u16*)(Aptr), (const u16*)(Bptr), MM, NN, KK, LDA, 0, p.flags, (size_t)128, (size_t)0}; \
    pg8::StaticOrder S_; S_.init(MM, NN, GG, CID); S_.ubeg = UBEG; S_.uend = UEND; pg8::gemm_phase((LAS unsigned char*)smem_raw, g_, S_, EPI); } while (0)

__global__ void __launch_bounds__(NT, 2) mega(Params p) {
  extern __shared__ __attribute__((aligned(16))) unsigned char smem_raw[];
  const int bid = blockIdx.x, nb = gridDim.x;
  unsigned char* ws = p.ws;
  const float* mod = (const float*)(ws + WS_MOD);
  volatile LAS unsigned* xst = (volatile LAS unsigned*)((LAS unsigned char*)smem_raw + GEMM_LDS);
  XcdBarrier xb;
  if (p.phase_hi - p.phase_lo > 1) {
    if (threadIdx.x == 0) { xst[0] = 0u; xst[1] = 0u; }
    __syncthreads();
    xb = xcd_barrier_post((unsigned*)(ws + WS_BAR), xst);
  }
#define PH_BEGIN(n) if ((PHMASK & (1u << n)) && p.phase_lo <= n && n < p.phase_hi) { const int ph = n;
#define PH_FIN if (ph + 1 < p.phase_hi) { if (p.phase_lo < 0) cg::this_grid().sync(); else xcd_barrier(xb); } }
  PH_BEGIN(0) phase_prologue(p, smem_raw, bid, nb); PH_FIN
  PH_BEGIN(1) phase_h0(p, bid, nb); PH_FIN
  PH_BEGIN(2) {
    EpiHgIn e{(u16*)(ws + WS_B(0)), (u16*)(ws + WS_B(1)), (u16*)(ws + WS_B(2)), (_Float16*)(ws + WS_B(3)), (const float*)(ws + WS_LB)};
    RUN_GEMM(ws + WS_H, 1024, ws + WS_W_HG_IN, TOK, (nb == 256 ? 4096 : 5120), 1024, 0, e, bid);
  } PH_FIN
  PH_BEGIN(3) {
    phase_gla(p, smem_raw);
    if (nb == 256) {
      __syncthreads();
      EpiSg eg{(u16*)(ws + WS_B(2))};
      RUN_GEMM_R(ws + WS_H, 1024, ws + WS_W_HG_IN + (size_t)4096 * 1024 * 2, TOK, 1024, 1024, eg, 256, bid >= 64 ? bid - 64 : (1 << 20), 0, 192);
    }
  } PH_FIN
  PH_BEGIN(4) phase_hg_post(p, bid, nb); PH_FIN
  PH_BEGIN(5) {
    EpiResLn<false, true> e{p.in[0], p.in[1], (const u16*)nullptr, p.out, (u16*)(ws + WS_XB), mod + 0 * 15360 + 2048, p.in[10] + 0 * 1024, p.in[11] + 0 * 1024, mod + 1 * 15360, (u16*)(ws + WS_H),
               (unsigned long long*)(ws + WS_SLOT) + 0 * 49152, (unsigned*)(ws + WS_CNT + 256) + 0 * 48};
    RUN_GEMM(ws + WS_B(0), 1024, ws + WS_W_HG_OUT, TOK, 1024, 1024, 0, e, bid);
    wconv_idle(p, smem_raw, bid, nb, 1536, 2816);
  } PH_FIN
  PH_BEGIN(7) {
    EpiScIn e{(u16*)(ws + WS_B(0)), (u16*)(ws + WS_B(1))};
    RUN_GEMM(ws + WS_H, 1024, ws + WS_W_SC_IN, TOK, 4096, 1024, 0, e, bid);
  } PH_FIN
  PH_BEGIN(8) phase_sc_conv(p, bid, nb); PH_FIN
  PH_BEGIN(9) {
    EpiResLn<true, true> e{p.out, p.out, (const u16*)(ws + WS_XB), p.out, (u16*)(ws + WS_XB), mod + 1 * 15360 + 2048, p.in[10] + 1 * 1024, p.in[11] + 1 * 1024, mod + 2 * 15360, (u16*)(ws + WS_H),
               (unsigned long long*)(ws + WS_SLOT) + 1 * 49152, (unsigned*)(ws + WS_CNT + 256) + 1 * 48};
    RUN_GEMM(ws + WS_B(2), 1024, ws + WS_W_SC_OUT, TOK, 1024, 1024, 0, e, bid);
    wconv_idle(p, smem_raw, bid, nb, 2816, 3840);
  } PH_FIN
  PH_BEGIN(11) {
    EpiRgIn e{(u16*)(ws + WS_B(0)), (u16*)(ws + WS_B(1))};
    if (nb == 256) {
      RUN_GEMM(ws + WS_H, 1024, ws + WS_W_RG_IN, TOK, 1024, 1024, 0, e, bid);
      EpiSgGM eg{(u16*)(ws + WS_B(1))};
      RUN_GEMM_R(ws + WS_H, 1024, ws + WS_W_RG_IN + (size_t)1024 * 1024 * 2, TOK, 1024, 1024, eg, 256, bid >= 192 ? bid - 192 : (1 << 20), 0, 64);
    } else {
      RUN_GEMM(ws + WS_H, 1024, ws + WS_W_RG_IN, TOK, 2048, 1024, 0, e, bid);
    }
  } PH_FIN
  PH_BEGIN(12) phase_rg_conv(p, bid, nb); PH_FIN
  PH_BEGIN(13) {
    EpiRgGate e{(u16*)(ws + WS_B(3)), (u16*)(ws + WS_B(5)), p.in[24]};
    if (nb == 256) {
      EpiSgGM eg{(u16*)(ws + WS_B(1))};
      RUN_GEMM_R(ws + WS_H, 1024, ws + WS_W_RG_IN + (size_t)1024 * 1024 * 2, TOK, 1024, 1024, eg, 256, bid < 128 ? bid : (1 << 20), 64, 192);
      RUN_GEMM_RX(ws + WS_B(2), 64, GM_KSTEP, 4 * GM_KSTEP, ws + WS_W_RG_GATE, TOK, 4096, 256, 1, e, 256, bid < 128 ? bid : (1 << 20), 0, 128);
      RUN_GEMM_RX(ws + WS_B(2), 64, GM_KSTEP, 4 * GM_KSTEP, ws + WS_W_RG_GATE, TOK, 4096, 256, 1, e, 128, bid >= 128 ? bid - 128 : (1 << 20), 128, 768);
    } else {
      RUN_GEMM_X(ws + WS_B(2), 64, GM_KSTEP, 4 * GM_KSTEP, ws + WS_W_RG_GATE, TOK, 4096, 256, 1, e, nb, bid);
    }
  } PH_FIN
  PH_BEGIN(14) phase_rg_scan(p, smem_raw, bid, nb); PH_FIN
  PH_BEGIN(15) {
    EpiResLn<true, true> e{p.out, p.out, (const u16*)(ws + WS_XB), p.out, (u16*)(ws + WS_XB), mod + 2 * 15360 + 2048, p.in[10] + 2 * 1024, p.in[11] + 2 * 1024, mod + 3 * 15360, (u16*)(ws + WS_H),
               (unsigned long long*)(ws + WS_SLOT) + 2 * 49152, (unsigned*)(ws + WS_CNT + 256) + 2 * 48};
    RUN_GEMM_X(ws + WS_B(0), 64, GM_KSTEP, (size_t)0, ws + WS_W_RG_OUT, TOK, 1024, 1024, 0, e, nb, bid);
    wconv_idle(p, smem_raw, bid, nb, 3840, 4800);
  } PH_FIN
  PH_BEGIN(17) {
    EpiMlaIn e{(u16*)(ws + WS3_CQ), (float*)(ws + WS3_CKVRAW), (float*)(ws + WS3_KPERAW), (u16*)(ws + WS3_SG)};
    RUN_GEMM(ws + WS_H, 1024, ws + WS_W_MLA_IN, TOK, 768, 1024, 0, e, bid);
    if (nb == 256) {
      EpiSg eg{(u16*)(ws + WS3_SG)};
      RUN_GEMM_R(ws + WS_H, 1024, ws + WS_W_MLA_IN + 672 * 1024 * 2, TOK, 1024, 1024, eg, 256, bid >= 144 ? bid - 144 : (1 << 20), 0, 112);
    }
  } PH_FIN
  PH_BEGIN(18) phase_mla_norm(p, bid, nb); PH_FIN
  PH_BEGIN(19) {
    const bool bal = (nb == 256);
    const int none = 1 << 20;
    EpiSg eg{(u16*)(ws + WS3_SG)};
    RUN_GEMM_R(ws + WS_H, 1024, ws + WS_W_MLA_IN + 672 * 1024 * 2, TOK, 1024, 1024, eg, nb, bid, bal ? 112 : 0, 192);
    EpiQ eq{(u16*)(ws + WS3_Q)};
    RUN_GEMM_G(ws + WS3_CQ, 384, ws + WS_W_QB, TOK, 1536, 384, 0, eq, bal ? 176 : nb, bal ? (bid >= 80 ? bid - 80 : none) : bid);
    EpiK ek{(u16*)(ws + WS3_K)};
    RUN_GEMM(ws + WS3_CKVALL, 256, ws + WS_W_KVB, KVROWS, 1024, 256, 0, ek, bid);
    EpiV ev{(u16*)(ws + WS3_VT)};
    RUN_GEMM_G(ws + WS_W_KVB + 1024 * 256 * 2, 256, ws + WS3_CKVALL, 1024, KVROWS, 256, 0, ev, bal ? 176 : nb, bal ? (bid >= 80 ? (bid + 160) % 176 : none) : bid);
  } PH_FIN
  PH_BEGIN(20) phase_attn(p, smem_raw, bid, nb); PH_FIN
  PH_BEGIN(21) {
    EpiResLn<true, false> e{p.out, p.out, (const u16*)(ws + WS_XB), p.out, (u16*)nullptr, mod + 3 * 15360 + 2048, p.in[10] + 3 * 1024, p.in[11] + 3 * 1024, mod + 3 * 15360, (u16*)nullptr,
               (unsigned long long*)(ws + WS_SLOT) + 3 * 49152, (unsigned*)(ws + WS_CNT + 256) + 3 * 48};
    RUN_GEMM(ws + WS_H, 1024, ws + WS_W_MLA_OUT, TOK, 1024, 1024, 0, e, bid);
  } PH_FIN
}

extern "C" void kernel_launch(void* const* d_in, const int* in_sizes, int n_in, void* d_out, int out_size, void* d_ws, size_t ws_size,
                              hipStream_t stream) {
  static int grid_blocks = 0;
  if (!grid_blocks) {
    int dev = 0, cus = 0, per_cu = 0;
    (void)hipGetDevice(&dev);
    (void)hipDeviceGetAttribute(&cus, hipDeviceAttributeMultiprocessorCount, dev);
    (void)hipFuncSetAttribute((const void*)mega, hipFuncAttributeMaxDynamicSharedMemorySize, DYN_LDS);
    (void)hipOccupancyMaxActiveBlocksPerMultiprocessor(&per_cu, (const void*)mega, NT, DYN_LDS);
    if (per_cu < 1) per_cu = 1;
    if (per_cu > 1) per_cu = 1;
    grid_blocks = cus * per_cu;
  }
  Params p{};
  for (int i = 0; i < 33; ++i) p.in[i] = (const float*)d_in[i];
  p.out = (float*)d_out;
  p.ws = (unsigned char*)d_ws;
#if MULTI_LAUNCH
  (void)hipMemsetAsync((unsigned char*)d_ws + WS_CNT, 0, 4096 + XCD_BAR_WORDS * 4, stream);
  for (int ph = 0; ph < NPHASES; ++ph) {
    p.phase_lo = ph; p.phase_hi = ph + 1;
    hipLaunchKernelGGL(mega, dim3(grid_blocks), dim3(NT), DYN_LDS, stream, p);
#ifdef PROBE_MASK
    if ((PROBE_MASK >> ph) & 1) { p.flags = PROBE_FLAGS; for (int r = 0; r < 2; ++r) {
      if (ph == 3) (void)hipMemsetAsync((unsigned char*)d_ws + WS_CNT, 0, 64, stream);
      hipLaunchKernelGGL(mega, dim3(grid_blocks), dim3(NT), DYN_LDS, stream, p);
    } p.flags = 0; }
#endif
  }
#else
  p.phase_lo = 0; p.phase_hi = NPHASES;
  (void)hipMemsetAsync((unsigned char*)d_ws + WS_CNT, 0, 4096 + XCD_BAR_WORDS * 4, stream);
  void* args[] = {&p};
  hipError_t e = hipLaunchCooperativeKernel((const void*)mega, dim3(grid_blocks), dim3(NT), args, DYN_LDS, stream);
  if (e != hipSuccess) fprintf(stderr, "cooperative launch failed: %s (grid %d)\n", hipGetErrorString(e), grid_blocks);
#endif
}
```

```cpp
#include <hip/hip_runtime.h>
#include <hip/hip_cooperative_groups.h>
#include <cstdio>
namespace cg = cooperative_groups;

#ifndef MULTI_LAUNCH
#define MULTI_LAUNCH 0
#endif

typedef unsigned short u16;
using bf16x8 = __attribute__((ext_vector_type(8))) short;
using f32x4 = __attribute__((ext_vector_type(4))) float;
typedef _Float16 h4 __attribute__((ext_vector_type(4)));

#define TOK 12288
#define NPROMPT 8192
#define KVROWS 14336
#define NPHASES 23
#ifndef PHMASK
#define PHMASK 0x7fffff
#endif
#define DN_ALPHA 1.6817928305074290f

#define WS_W_HG_IN 0ull
#define WS_W_HG_OUT (WS_W_HG_IN + 10485760ull)
#define WS_W_SC_IN (WS_W_HG_OUT + 2097152ull)
#define WS_W_SC_OUT (WS_W_SC_IN + 8388608ull)
#define WS_W_RG_IN (WS_W_SC_OUT + 2097152ull)
#define WS_W_RG_GATE (WS_W_RG_IN + 4194304ull)
#define WS_W_RG_OUT (WS_W_RG_GATE + 2097152ull)
#define WS_W_MLA_IN (WS_W_RG_OUT + 2097152ull)
#define WS_W_QB (WS_W_MLA_IN + 3670016ull)
#define WS_W_KVB (WS_W_QB + 1179648ull)
#define WS_W_MLA_OUT (WS_W_KVB + 1048576ull)
#define WS_MOD (WS_W_MLA_OUT + 2097152ull)
#define WS_LB (WS_MOD + 245760ull)
#define WS_CNT (WS_LB + 8192ull)
#define WS_R (WS_CNT + 4096ull + 16384ull)
#define BSZ 25165824ull
#define WS_H (WS_R)
#define WS_B(i) (WS_R + BSZ * (1 + (i)))
#define WS_SLOT (WS_R + 201326592ull)
#define WS_XB (WS_SLOT + 1572864ull)
#define WS3_CQ (WS_R + 25165824ull)
#define WS3_CKVALL (WS_R + 34603008ull)
#define WS3_CKVRAW (WS_R + 41943040ull)
#define WS3_KPERAW (WS_R + 54525952ull)
#define WS3_SG (WS_R + 56098816ull)
#define WS3_Q (WS_R + 81264640ull)
#define WS3_K (WS_R + 119013376ull)
#define WS3_VT (WS_R + 163053568ull)

#define OUT_HG 12582912
#define OUT_RG 20971520
#define OUT_CKV 21037056
#define OUT_KPE 23134208

struct Params {
  const float* in[33];
  float* out;
  unsigned char* ws;
  int phase_lo, phase_hi, flags, pad_;
};

__device__ __forceinline__ u16 f2bf(float f) { __bf16 r = (__bf16)f; return *(u16*)&r; }
__device__ __forceinline__ float bf2f(u16 h) { return __uint_as_float(((unsigned)h) << 16); }
typedef float f2v_ __attribute__((ext_vector_type(2)));
typedef __bf16 b2v_ __attribute__((ext_vector_type(2)));
__device__ __forceinline__ unsigned pack2(float a, float b) { f2v_ f = {a, b}; b2v_ r = __builtin_convertvector(f, b2v_); return *(unsigned*)&r; }
__device__ __forceinline__ uint2 pack4(float a, float b, float c, float d) { return make_uint2(pack2(a, b), pack2(c, d)); }
__device__ __forceinline__ float lo16(unsigned u) { return __uint_as_float(u << 16); }
__device__ __forceinline__ float hi16(unsigned u) { return __uint_as_float(u & 0xffff0000u); }
__device__ __forceinline__ float sigmoidf_(float x) { return __builtin_amdgcn_rcpf(1.0f + __expf(-x)); }
__device__ __forceinline__ float siluf_(float x) { return x * __builtin_amdgcn_rcpf(1.0f + __expf(-x)); }
__device__ __forceinline__ int cond_of(int tok) { return tok < NPROMPT ? 0 : 1 + ((tok - NPROMPT) >> 10); }
__device__ __forceinline__ float wave_sum(float v) {
#pragma unroll
  for (int o = 32; o > 0; o >>= 1) v += __shfl_xor(v, o);
  return v;
}
__device__ __forceinline__ void rope_sincos(float pos, int fi, float& sn, float& cs) {
  float inv = exp2f(-(float)fi * 1.6609640474436813f);
  float ang = pos * inv;
  float k = rintf(ang * 0.15915494309189535f);
  float r = fmaf(-k, 6.2831854820251465f, ang);
  r = fmaf(-k, -1.7484555e-7f, r);
  sn = __sinf(r); cs = __cosf(r);
}

#define NT 512
#define NW 8
#define LAS __attribute__((address_space(3)))

namespace pg8 {
constexpr int BM = 256, BK = 64, HALF = 128, HTB = HALF * BK * 2, STAGE_BYTES = 8 * HTB, NXCD = 8, WGM = 8;
__device__ __forceinline__ int lds_byte(int r, int c) { const int st = (r >> 4) * 2 + (c >> 5), rr = r & 15, cc = c & 31, ob = rr * 64 + cc * 2; return st * 1024 + (ob ^ (((ob >> 9) & 1) << 5)); }
__device__ __forceinline__ void stage_rc(int b, int& R, int& C) { const int st = b / 1024, sb = b % 1024, swz = sb ^ (((sb >> 9) & 1) << 5); R = (st >> 1) * 16 + swz / 64; C = (st & 1) * 32 + (swz % 64) / 2; }
struct Unit { int pm, pn; };
struct Gemm { const u16* A; const u16* Bt; int M, N, K, lda, gate, noepi; size_t kstepA, gstride; };
struct StaticOrder {
  int nM, nN, nwg, G, c, ubeg, uend;
  __device__ void init(int M, int N, int G_, int c_) { nM = M / BM; nN = N / BM; nwg = nM * nN; G = G_; c = c_; ubeg = 0; uend = nwg; }
  __device__ bool next(int i, Unit& u) const {
    const long L = (long)ubeg + (long)i * G + c; if (L >= uend) return false;
    int wgid = (int)L; { const int q = nwg / NXCD, r = nwg % NXCD, xcd = wgid % NXCD, off = wgid / NXCD; wgid = (xcd < r ? xcd * (q + 1) : r * (q + 1) + (xcd - r) * q) + off; }
    const int nig = WGM * nN, gid = wgid / nig, fm = gid * WGM, gsz = (nM - fm) < WGM ? (nM - fm) : WGM;
    u.pm = fm + ((wgid % nig) % gsz); u.pn = (wgid % nig) / gsz; return true;
  }
};
template <class Epi>
__device__ __forceinline__ void gemm_phase(LAS unsigned char* lds, const Gemm g, const StaticOrder& S, const Epi& E) {
  const int tid = threadIdx.x, wid = __builtin_amdgcn_readfirstlane(tid >> 6), lane = tid & 63, wr = wid >> 2, wc = wid & 3, fr = lane & 15, fq = lane >> 4;
  const int K = g.K, nt = K / BK;
  unsigned voffA[2], voffB[2];
#pragma unroll
  for (int i = 0; i < 2; ++i) { int R, C; stage_rc(tid * 16 + i * 8192, R, C); voffA[i] = (unsigned)(R * g.lda + C) * 2u; voffB[i] = (unsigned)(R * K + C) * 2u; }
  const size_t kstep = (size_t)(BK * 2);
  const size_t kstepA = g.kstepA;
  const size_t hstepA = (size_t)HALF * g.lda * 2, hstepB = (size_t)HALF * K * 2;
  const size_t tstepA = 2 * hstepA, tstepB = 2 * hstepB;
  const unsigned ldsw = (unsigned)wid * 1024u;
  const int aoff = lds_byte(wr * 64 + fr, fq * 8), boff = lds_byte(wc * 32 + fr, fq * 8);
#define PG8_AOFF(pn) (g.gate ? (size_t)(((pn) >> 1) & 3) * g.gstride : (size_t)0)
#define PG8_SA(b, h) (((b) * 2 + (h)) * HTB)
#define PG8_SB(b, h) ((4 + (b) * 2 + (h)) * HTB)
#define PG8_STAGE(bufoff, gbase, voff) do { _Pragma("unroll") for (int _i = 0; _i < 2; ++_i) \
    __builtin_amdgcn_global_load_lds((const unsigned*)((const char*)(gbase) + (voff)[_i]), (LAS unsigned*)(lds + (bufoff) + ldsw + _i * 8192), 16, 0, 0); } while (0)
#define PG8_LDA(dst, b, h) do { _Pragma("unroll") for (int m = 0; m < 4; ++m) _Pragma("unroll") for (int k = 0; k < 2; ++k) dst[m][k] = *(const LAS bf16x8*)(lds + PG8_SA(b, h) + aoff + m * 2048 + k * 1024); } while (0)
#define PG8_LDB(dst, b, h) do { _Pragma("unroll") for (int n = 0; n < 2; ++n) _Pragma("unroll") for (int k = 0; k < 2; ++k) dst[n][k] = *(const LAS bf16x8*)(lds + PG8_SB(b, h) + boff + n * 2048 + k * 1024); } while (0)
#define PG8_MMA(ai, bj, At, Bt) do { __builtin_amdgcn_s_setprio(1); _Pragma("unroll") for (int m = 0; m < 4; ++m) _Pragma("unroll") for (int n = 0; n < 2; ++n) _Pragma("unroll") for (int k = 0; k < 2; ++k) \
    acc[ai][bj][m][n] = __builtin_amdgcn_mfma_f32_16x16x32_bf16(Bt[n][k], At[m][k], acc[ai][bj][m][n], 0, 0, 0); __builtin_amdgcn_s_setprio(0); } while (0)
#define PG8_WAIT_V(n) asm volatile("s_waitcnt vmcnt(" #n ")" ::: "memory")
#define PG8_WAIT_L(n) asm volatile("s_waitcnt lgkmcnt(" #n ")" ::: "memory")
#define PG8_BAR __builtin_amdgcn_s_barrier()
#define PG8_SCHED __builtin_amdgcn_sched_barrier(0)
  Unit cur, nxt; int ui = 0;
  if (!S.next(0, cur)) return;
  f32x4 acc[2][2][4][2];
#pragma unroll
  for (int a = 0; a < 2; ++a)
#pragma unroll
    for (int b = 0; b < 2; ++b)
#pragma unroll
      for (int m = 0; m < 4; ++m)
#pragma unroll
        for (int n = 0; n < 2; ++n) acc[a][b][m][n] = (f32x4){0.f, 0.f, 0.f, 0.f};
  bf16x8 At[4][2], B0[2][2], B1[2][2];
  const char* cA = (const char*)g.A + (size_t)cur.pm * tstepA + PG8_AOFF(cur.pn); const char* cB = (const char*)g.Bt + (size_t)cur.pn * tstepB;
  PG8_STAGE(PG8_SB(0, 0), cB, voffB); PG8_STAGE(PG8_SA(0, 0), cA, voffA); PG8_STAGE(PG8_SB(0, 1), cB + hstepB, voffB); PG8_STAGE(PG8_SA(0, 1), cA + hstepA, voffA);
  if (wr == 1) PG8_BAR;
  PG8_WAIT_V(4); PG8_BAR;
  PG8_STAGE(PG8_SB(1, 0), cB + kstep, voffB); PG8_STAGE(PG8_SA(1, 0), cA + kstepA, voffA); PG8_STAGE(PG8_SB(1, 1), cB + hstepB + kstep, voffB);
  PG8_WAIT_V(6); PG8_BAR;
  for (;;) {
    const bool has_next = S.next(ui + 1, nxt);
    const char* nA = has_next ? (const char*)g.A + (size_t)nxt.pm * tstepA + PG8_AOFF(nxt.pn) : cA; const char* nB = has_next ? (const char*)g.Bt + (size_t)nxt.pn * tstepB : cB;
#pragma unroll 1
    for (int t = 0; t < nt; t += 2) {
      const bool last = (t == nt - 2);
      const char* a1 = cA + (size_t)(t + 1) * kstepA;
      const char* a2 = last ? nA : cA + (size_t)(t + 2) * kstepA; const char* b2 = last ? nB : cB + (size_t)(t + 2) * kstep;
      const char* a3 = a2 + kstepA; const char* b3 = b2 + kstep;
      PG8_LDB(B0, 0, 0); PG8_SCHED; PG8_LDA(At, 0, 0); PG8_STAGE(PG8_SA(1, 1), a1 + hstepA, voffA);
      PG8_WAIT_L(8); PG8_BAR; PG8_WAIT_L(0); PG8_MMA(0, 0, At, B0); PG8_BAR; PG8_SCHED;
      PG8_LDB(B1, 0, 1); PG8_STAGE(PG8_SB(0, 0), b2, voffB);
      PG8_BAR; PG8_WAIT_L(0); PG8_MMA(0, 1, At, B1); PG8_BAR;
      PG8_LDA(At, 0, 1); PG8_STAGE(PG8_SA(0, 0), a2, voffA);
      PG8_BAR; PG8_WAIT_L(0); PG8_MMA(1, 0, At, B0); PG8_BAR; PG8_SCHED;
      PG8_STAGE(PG8_SB(0, 1), b2 + hstepB, voffB);
      PG8_WAIT_V(6); PG8_BAR; PG8_MMA(1, 1, At, B1); PG8_BAR;
      PG8_LDB(B0, 1, 0); PG8_SCHED; PG8_LDA(At, 1, 0); PG8_STAGE(PG8_SA(0, 1), a2 + hstepA, voffA);
      PG8_WAIT_L(8); PG8_BAR; PG8_WAIT_L(0); PG8_MMA(0, 0, At, B0); PG8_BAR; PG8_SCHED;
      PG8_LDB(B1, 1, 1); PG8_STAGE(PG8_SB(1, 0), b3, voffB);
      PG8_BAR; PG8_WAIT_L(0); PG8_MMA(0, 1, At, B1); PG8_BAR;
      PG8_LDA(At, 1, 1); PG8_STAGE(PG8_SA(1, 0), a3, voffA);
      PG8_BAR; PG8_WAIT_L(0); PG8_MMA(1, 0, At, B0); PG8_BAR; PG8_SCHED;
      PG8_STAGE(PG8_SB(1, 1), b3 + hstepB, voffB);
      PG8_WAIT_V(6); PG8_BAR; PG8_MMA(1, 1, At, B1); PG8_BAR;
    }
    if constexpr (!Epi::AFTER_DRAIN) { if (!g.noepi) E(acc, cur, wr, wc, fr, fq); }
    if (!has_next) break;
#pragma unroll
    for (int a = 0; a < 2; ++a)
#pragma unroll
      for (int b = 0; b < 2; ++b)
#pragma unroll
        for (int m = 0; m < 4; ++m)
#pragma unroll
          for (int n = 0; n < 2; ++n) acc[a][b][m][n] = (f32x4){0.f, 0.f, 0.f, 0.f};
    cur = nxt; cA = nA; cB = nB; ++ui;
  }
  PG8_WAIT_V(0);
  if (wr == 0) PG8_BAR;
  PG8_BAR;
  if constexpr (Epi::AFTER_DRAIN) { if (!g.noepi) E.fused(acc, cur, wr, wc, fr, fq, lds); }
#undef PG8_AOFF
#undef PG8_SA
#undef PG8_SB
#undef PG8_STAGE
#undef PG8_LDA
#undef PG8_LDB
#undef PG8_MMA
#undef PG8_WAIT_V
#undef PG8_WAIT_L
#undef PG8_BAR
#undef PG8_SCHED
}
}
using pg8::Unit;
typedef const f32x4 (&AccRef)[2][2][4][2];

#define EPI_ROWS(...) _Pragma("unroll") for (int ai = 0; ai < 2; ++ai) _Pragma("unroll") for (int m = 0; m < 4; ++m) { const int row = u.pm * 256 + ai * 128 + wr * 64 + m * 16 + fr; __VA_ARGS__ }
#define EPI_COLS(...) _Pragma("unroll") for (int bj = 0; bj < 2; ++bj) _Pragma("unroll") for (int n = 0; n < 2; ++n) { const int cb = u.pn * 256 + bj * 128 + wc * 32 + n * 16; const f32x4 a = acc[ai][bj][m][n]; __VA_ARGS__ }

struct EpiHgIn {
  static constexpr bool AFTER_DRAIN = false;
  u16 *q, *v, *sg; _Float16* lf; const float* lb;
  __device__ __forceinline__ void operator()(AccRef acc, const Unit& u, int wr, int wc, int fr, int fq) const {
    const int region = u.pn >> 2;
    f32x4 l4[2][2];
    if (region == 1 || region == 2) {
#pragma unroll
      for (int bj = 0; bj < 2; ++bj)
#pragma unroll
        for (int n = 0; n < 2; ++n) l4[bj][n] = *(const f32x4*)&lb[(region - 1) * 1024 + ((u.pn * 256 + bj * 128 + wc * 32 + n * 16) & 1023) + fq * 4];
    }
    EPI_ROWS( EPI_COLS(
      const int c = (cb & 1023) + fq * 4;
      if (region == 0) {
        const float s = 0.08838834764831845f;
        *(uint2*)&q[(size_t)row * 1024 + c] = pack4(siluf_(a[0]) * s, siluf_(a[1]) * s, siluf_(a[2]) * s, siluf_(a[3]) * s);
      } else if (region <= 2) {
        const int d = region - 1;
        h4 o;
        _Pragma("unroll") for (int j = 0; j < 4; ++j) { float f = l4[bj][n][j] + (1.0f - l4[bj][n][j]) * sigmoidf_(a[j]); o[j] = (_Float16)__builtin_amdgcn_logf(f); }
        *(h4*)&lf[(size_t)row * 2048 + d * 1024 + c] = o;
      } else if (region == 3) {
        *(uint2*)&v[(size_t)row * 1024 + c] = pack4(a[0], a[1], a[2], a[3]);
      } else {
        *(uint2*)&sg[(size_t)row * 1024 + c] = pack4(a[0], a[1], a[2], a[3]);
      }
    ) )
  }
};

struct EpiRes {
  static constexpr bool AFTER_DRAIN = false;
  const float* xin_p; const float* xin_s; float* Y; const float* gate;
  __device__ __forceinline__ void operator()(AccRef acc, const Unit& u, int wr, int wc, int fr, int fq) const {
    EPI_ROWS(
      const float* xr = row < NPROMPT ? xin_p + (size_t)row * 1024 : xin_s + (size_t)(row - NPROMPT) * 1024;
      const float* g = gate + cond_of(row) * 3072;
      EPI_COLS(
        const int c = cb + fq * 4;
        f32x4 x = *(const f32x4*)&xr[c];
        f32x4 gg = *(const f32x4*)&g[c];
        f32x4 y;
        _Pragma("unroll") for (int j = 0; j < 4; ++j) y[j] = DN_ALPHA * x[j] + gg[j] * a[j];
        *(f32x4*)&Y[(size_t)row * 1024 + c] = y;
      ) )
  }
};

template <bool XIN_BF, bool XOUT_BF>
struct EpiResLn {
  static constexpr bool AFTER_DRAIN = true;
  const float* xin_p; const float* xin_s; const u16* xin_b; float* X; u16* XB; const float* gate; const float* lg; const float* lbias; const float* modn; u16* H;
  unsigned long long* slots; unsigned* cnt;
  __device__ __forceinline__ void fused(f32x4 (&acc)[2][2][4][2], const Unit& u, int wr, int wc, int fr, int fq, LAS unsigned char* lds) const {
    LAS float* part = (LAS float*)lds;
    LAS float* stat = part + 2048;
    const int tid = threadIdx.x;
    const int cnd = cond_of(u.pm * 256);
    f32x4 gv[2][2];
#pragma unroll
    for (int bj = 0; bj < 2; ++bj)
#pragma unroll
      for (int n = 0; n < 2; ++n) gv[bj][n] = *(const f32x4*)&gate[cnd * 3072 + u.pn * 256 + bj * 128 + wc * 32 + n * 16 + fq * 4];
#pragma unroll
    for (int ai = 0; ai < 2; ++ai)
#pragma unroll
      for (int m = 0; m < 4; ++m) {
        const int rl = ai * 128 + wr * 64 + m * 16 + fr;
        const int row = u.pm * 256 + rl;
        const float* xr = row < NPROMPT ? xin_p + (size_t)row * 1024 : xin_s + (size_t)(row - NPROMPT) * 1024;
        float s1 = 0.f, s2 = 0.f;
#pragma unroll
        for (int bj = 0; bj < 2; ++bj)
#pragma unroll
          for (int n = 0; n < 2; ++n) {
            const int c = u.pn * 256 + bj * 128 + wc * 32 + n * 16 + fq * 4;
            f32x4 x;
            if constexpr (XIN_BF) { const uint2 xb2 = *(const uint2*)&xin_b[(size_t)row * 1024 + c]; x = f32x4{lo16(xb2.x), hi16(xb2.x), lo16(xb2.y), hi16(xb2.y)}; }
            else x = *(const f32x4*)&xr[c];
            const f32x4 gg = gv[bj][n];
            f32x4 y;
#pragma unroll
            for (int j = 0; j < 4; ++j) { y[j] = DN_ALPHA * x[j] + gg[j] * acc[ai][bj][m][n][j]; s1 += y[j]; s2 += y[j] * y[j]; }
            acc[ai][bj][m][n] = y;
          }
        s1 += __shfl_xor(s1, 16); s1 += __shfl_xor(s1, 32);
        s2 += __shfl_xor(s2, 16); s2 += __shfl_xor(s2, 32);
        if (fq == 0) { part[(rl * 4 + wc) * 2] = s1; part[(rl * 4 + wc) * 2 + 1] = s2; }
      }
    __syncthreads();
    if (tid < 256) {
      float S1 = 0.f, S2 = 0.f;
#pragma unroll
      for (int w2 = 0; w2 < 4; ++w2) { S1 += part[(tid * 4 + w2) * 2]; S2 += part[(tid * 4 + w2) * 2 + 1]; }
      const unsigned long long v = (unsigned long long)__float_as_uint(S1) | ((unsigned long long)__float_as_uint(S2) << 32);
      __hip_atomic_store(&slots[(size_t)(u.pm * 4 + u.pn) * 256 + tid], v, __ATOMIC_RELAXED, __HIP_MEMORY_SCOPE_AGENT);
    }
    asm volatile("s_waitcnt vmcnt(0)" ::: "memory");
    __syncthreads();
    if (tid == 0) {
      __hip_atomic_fetch_add(&cnt[u.pm], 1u, __ATOMIC_RELAXED, __HIP_MEMORY_SCOPE_AGENT);
      unsigned sp = 0;
      while (__hip_atomic_load(&cnt[u.pm], __ATOMIC_RELAXED, __HIP_MEMORY_SCOPE_AGENT) < 4u) { __builtin_amdgcn_s_sleep(1); if (++sp > (1u << 24)) break; }
    }
    __syncthreads();
    if (tid < 256) {
      float T1 = 0.f, T2 = 0.f;
#pragma unroll
      for (int o = 0; o < 4; ++o) {
        const unsigned long long v = __hip_atomic_load(&slots[(size_t)(u.pm * 4 + o) * 256 + tid], __ATOMIC_RELAXED, __HIP_MEMORY_SCOPE_AGENT);
        T1 += __uint_as_float((unsigned)(v & 0xffffffffull)); T2 += __uint_as_float((unsigned)(v >> 32));
      }
      const float mu = T1 * (1.0f / 1024.0f);
      const float var = fmaxf(T2 * (1.0f / 1024.0f) - mu * mu, 0.f);
      stat[tid * 2] = mu; stat[tid * 2 + 1] = rsqrtf(var + 1e-5f);
    }
    __syncthreads();
#pragma unroll
    for (int bj = 0; bj < 2; ++bj) {
      f32x4 lgv[2], lbv[2], shv[2], scv[2];
#pragma unroll
      for (int n = 0; n < 2; ++n) {
        const int c = u.pn * 256 + bj * 128 + wc * 32 + n * 16 + fq * 4;
        lgv[n] = *(const f32x4*)&lg[c]; lbv[n] = *(const f32x4*)&lbias[c];
        shv[n] = *(const f32x4*)&modn[cnd * 3072 + c]; scv[n] = *(const f32x4*)&modn[cnd * 3072 + 1024 + c];
      }
#pragma unroll
      for (int ai = 0; ai < 2; ++ai)
#pragma unroll
        for (int m = 0; m < 4; ++m) {
          const int rl = ai * 128 + wr * 64 + m * 16 + fr;
          const int row = u.pm * 256 + rl;
          const float mu = stat[rl * 2], rs = stat[rl * 2 + 1];
#pragma unroll
          for (int n = 0; n < 2; ++n) {
            const int c = u.pn * 256 + bj * 128 + wc * 32 + n * 16 + fq * 4;
            const f32x4 y = acc[ai][bj][m][n];
            f32x4 xo;
#pragma unroll
            for (int j = 0; j < 4; ++j) xo[j] = (y[j] - mu) * rs * lgv[n][j] + lbv[n][j];
            if constexpr (XOUT_BF) *(uint2*)&XB[(size_t)row * 1024 + c] = pack4(xo[0], xo[1], xo[2], xo[3]);
            else *(f32x4*)&X[(size_t)row * 1024 + c] = xo;
            if (H) {
              *(uint2*)&H[(size_t)row * 1024 + c] = pack4(xo[0] * (1 + scv[n][0]) + shv[n][0], xo[1] * (1 + scv[n][1]) + shv[n][1], xo[2] * (1 + scv[n][2]) + shv[n][2], xo[3] * (1 + scv[n][3]) + shv[n][3]);
            }
          }
        }
    }
  }
};

struct EpiScIn {
  static constexpr bool AFTER_DRAIN = false;
  u16 *pb, *sb;
  __device__ __forceinline__ void operator()(AccRef acc, const Unit& u, int wr, int wc, int fr, int fq) const {
    const int c = u.pn * 64 + wc * 16 + fq * 4;
    EPI_ROWS(
      const f32x4 bg = acc[ai][0][m][0], cgv = acc[ai][0][m][1], v = acc[ai][1][m][0], g = acc[ai][1][m][1];
      *(uint2*)&pb[(size_t)row * 1024 + c] = pack4(cgv[0] * v[0], cgv[1] * v[1], cgv[2] * v[2], cgv[3] * v[3]);
      *(uint2*)&sb[(size_t)row * 1024 + c] = pack4(siluf_(g[0]) * bg[0], siluf_(g[1]) * bg[1], siluf_(g[2]) * bg[2], siluf_(g[3]) * bg[3]);
    )
  }
};

struct EpiRgIn {
  static constexpr bool AFTER_DRAIN = false;
  u16 *ub, *sg;
  __device__ __forceinline__ void operator()(AccRef acc, const Unit& u, int wr, int wc, int fr, int fq) const {
    const int region = u.pn >> 2;
    EPI_ROWS( EPI_COLS(
      const int c = (cb & 1023) + fq * 4;
      if (region == 0) *(uint2*)&ub[(size_t)row * 1024 + c] = pack4(a[0], a[1], a[2], a[3]);
      else *(uint2*)&sg[((size_t)(c >> 6) * TOK + row) * 64 + (c & 63)] = pack4(siluf_(a[0]), siluf_(a[1]), siluf_(a[2]), siluf_(a[3]));
    ) )
  }
};

struct EpiSgGM {
  static constexpr bool AFTER_DRAIN = false;
  u16* sg;
  __device__ __forceinline__ void operator()(AccRef acc, const Unit& u, int wr, int wc, int fr, int fq) const {
    EPI_ROWS( EPI_COLS(
      const int c = cb + fq * 4;
      *(uint2*)&sg[((size_t)(c >> 6) * TOK + row) * 64 + (c & 63)] = pack4(siluf_(a[0]), siluf_(a[1]), siluf_(a[2]), siluf_(a[3]));
    ) )
  }
};

struct EpiRgGate {
  static constexpr bool AFTER_DRAIN = false;
  u16 *rb, *ib; const float* bgate;
  __device__ __forceinline__ void operator()(AccRef acc, const Unit& u, int wr, int wc, int fr, int fq) const {
    const int mat = u.pn >> 1, d = mat >> 2, hd = mat & 3;
    f32x4 br[2], bi[2]; int ccs[2];
#pragma unroll
    for (int bj = 0; bj < 2; ++bj) {
      const int off = ((u.pn & 1) * 256 + bj * 128 + wc * 32);
      ccs[bj] = (off >> 5) * 16 + fq * 4;
      br[bj] = *(const f32x4*)&bgate[mat * 512 + ccs[bj]];
      bi[bj] = *(const f32x4*)&bgate[mat * 512 + 256 + ccs[bj]];
    }
    EPI_ROWS(
      _Pragma("unroll") for (int bj = 0; bj < 2; ++bj) {
        const f32x4 r = acc[ai][bj][m][0], ii = acc[ai][bj][m][1];
        const int cch = hd * 256 + ccs[bj];
        const size_t o = (size_t)d * TOK * 1024 + ((size_t)(cch >> 6) * TOK + row) * 64 + (cch & 63);
        *(uint2*)&rb[o] = pack4(sigmoidf_(r[0] + br[bj][0]), sigmoidf_(r[1] + br[bj][1]), sigmoidf_(r[2] + br[bj][2]), sigmoidf_(r[3] + br[bj][3]));
        *(uint2*)&ib[o] = pack4(sigmoidf_(ii[0] + bi[bj][0]), sigmoidf_(ii[1] + bi[bj][1]), sigmoidf_(ii[2] + bi[bj][2]), sigmoidf_(ii[3] + bi[bj][3]));
      } )
  }
};

struct EpiMlaIn {
  static constexpr bool AFTER_DRAIN = false;
  u16* cq; float* ckvraw; float* kperaw; u16* sg;
  __device__ __forceinline__ void operator()(AccRef acc, const Unit& u, int wr, int wc, int fr, int fq) const {
    EPI_ROWS( EPI_COLS(
      const int c = cb + fq * 4;
      if (cb < 384) *(uint2*)&cq[(size_t)row * 384 + c] = pack4(a[0], a[1], a[2], a[3]);
      else if (cb < 640) *(f32x4*)&ckvraw[(size_t)row * 256 + (c - 384)] = a;
      else if (cb < 672) *(f32x4*)&kperaw[(size_t)row * 32 + (c - 640)] = a;
    ) )
  }
};

struct EpiSg {
  static constexpr bool AFTER_DRAIN = false;
  u16* sg;
  __device__ __forceinline__ void operator()(AccRef acc, const Unit& u, int wr, int wc, int fr, int fq) const {
    EPI_ROWS( EPI_COLS(
      *(uint2*)&sg[(size_t)row * 1024 + cb + fq * 4] = pack4(a[0], a[1], a[2], a[3]);
    ) )
  }
};

struct EpiQ {
  static constexpr bool AFTER_DRAIN = false;
  u16* q;
  __device__ __forceinline__ void operator()(AccRef acc, const Unit& u, int wr, int wc, int fr, int fq) const {
    const float sc = 0.14724444500602648f;
    EPI_ROWS( EPI_COLS(
      *(uint2*)&q[(size_t)row * 1536 + cb + fq * 4] = pack4(a[0] * sc, a[1] * sc, a[2] * sc, a[3] * sc);
    ) )
  }
};

struct EpiK {
  static constexpr bool AFTER_DRAIN = false;
  u16* Kb;
  __device__ __forceinline__ void operator()(AccRef acc, const Unit& u, int wr, int wc, int fr, int fq) const {
    EPI_ROWS( EPI_COLS(
      const int h = cb >> 6, dd = (cb & 63) + fq * 4;
      *(uint2*)&Kb[((size_t)row * 16 + h) * 96 + dd] = pack4(a[0], a[1], a[2], a[3]);
    ) )
  }
};
struct EpiV {
  static constexpr bool AFTER_DRAIN = false;
  u16* Vt;
  __device__ __forceinline__ void operator()(AccRef acc, const Unit& u, int wr, int wc, int fr, int fq) const {
    EPI_ROWS( EPI_COLS(
      *(uint2*)&Vt[(size_t)row * KVROWS + cb + fq * 4] = pack4(a[0], a[1], a[2], a[3]);
    ) )
  }
};

__device__ __forceinline__ void wconv_tile(const float* __restrict__ src, int N, int K, u16* __restrict__ dst, int k0, int n0,
                                           int perm, int mat, float* tile) {
  const int tid = threadIdx.x;
  {
    const int r = tid >> 4, c4 = (tid & 15) * 4;
#pragma unroll
    for (int i = 0; i < 2; ++i) {
      const int k = r + i * 32;
      f32x4 v = f32x4{0.f, 0.f, 0.f, 0.f};
      if (n0 + c4 < N) v = *(const f32x4*)&src[(size_t)(k0 + k) * N + n0 + c4];
      tile[k * 65 + c4 + 0] = v[0]; tile[k * 65 + c4 + 1] = v[1]; tile[k * 65 + c4 + 2] = v[2]; tile[k * 65 + c4 + 3] = v[3];
    }
  }
  __syncthreads();
  {
    const int nl = tid >> 3, kq = (tid & 7) * 8;
    const int n = n0 + nl;
    int np = n;
    if (perm == 1) { const int part = n >> 10, c = n & 1023; np = (c >> 6) * 256 + (part >> 1) * 128 + ((c >> 4) & 3) * 32 + (part & 1) * 16 + (c & 15); }
    else if (perm == 2) { const int type = n >> 8, cc = n & 255; np = mat * 512 + (cc >> 4) * 32 + type * 16 + (cc & 15); }
    else if (perm == 3) { const int hh = n >> 7, dd = n & 127; np = (dd >= 64 ? 1024 : 0) + hh * 64 + (dd & 63); }
    if (n < N) {
      unsigned w[4];
#pragma unroll
      for (int i = 0; i < 4; ++i) w[i] = pack2(tile[(kq + 2 * i) * 65 + nl], tile[(kq + 2 * i + 1) * 65 + nl]);
      *(uint4*)&dst[(size_t)np * K + k0 + kq] = make_uint4(w[0], w[1], w[2], w[3]);
    }
  }
  __syncthreads();
}

__device__ __forceinline__ void wconv_item(const Params& p, int t, float* fs) {
  const float* src; u16* dst; int N, K, perm = 0, mat = 0, ntn;
  if (t < 1280) { src = p.in[12]; dst = (u16*)(p.ws + WS_W_HG_IN); N = 5120; K = 1024; }
  else if ((t -= 1280) < 256) { src = p.in[15]; dst = (u16*)(p.ws + WS_W_HG_OUT); N = 1024; K = 1024; }
  else if ((t -= 256) < 1024) { src = p.in[16]; dst = (u16*)(p.ws + WS_W_SC_IN); N = 4096; K = 1024; perm = 1; }
  else if ((t -= 1024) < 256) { src = p.in[19]; dst = (u16*)(p.ws + WS_W_SC_OUT); N = 1024; K = 1024; }
  else if ((t -= 256) < 512) { src = p.in[20]; dst = (u16*)(p.ws + WS_W_RG_IN); N = 2048; K = 1024; }
  else if ((t -= 512) < 256) { mat = t >> 5; t &= 31; src = p.in[23] + (size_t)mat * 256 * 512; dst = (u16*)(p.ws + WS_W_RG_GATE); N = 512; K = 256; perm = 2; }
  else if ((t -= 256) < 256) { src = p.in[26]; dst = (u16*)(p.ws + WS_W_RG_OUT); N = 1024; K = 1024; }
  else if ((t -= 256) < 432) { src = p.in[27]; dst = (u16*)(p.ws + WS_W_MLA_IN); N = 1696; K = 1024; }
  else if ((t -= 432) < 144) { src = p.in[30]; dst = (u16*)(p.ws + WS_W_QB); N = 1536; K = 384; }
  else if ((t -= 144) < 128) { src = p.in[31]; dst = (u16*)(p.ws + WS_W_KVB); N = 2048; K = 256; perm = 3; }
  else { t -= 128; src = p.in[32]; dst = (u16*)(p.ws + WS_W_MLA_OUT); N = 1024; K = 1024; }
  ntn = (N + 63) >> 6;
  const int kt = t / ntn, ntl = t - kt * ntn;
  wconv_tile(src, N, K, dst, kt * 64, ntl * 64, perm, mat, fs);
}
__device__ __forceinline__ void wconv_idle(const Params& p, unsigned char* smem_raw, int bid, int nb, int t0, int t1) {
  if (nb == 256 && bid >= 192) for (int t = t0 + (bid - 192); t < t1; t += 64) wconv_item(p, t, (float*)smem_raw);
}

__device__ __forceinline__ void phase_prologue(const Params& p, unsigned char* smem_raw, int bid, int nb) {
  float* fs = (float*)smem_raw;
  const int tid = threadIdx.x;
  const int NMOD = 192, NWT = (nb == 256) ? 1536 : 4800;
  for (int it = bid; it < NMOD + 1 + NWT; it += nb) {
    if (it < NMOD) {
      const int l = it / 48, n0 = (it % 48) * 64;
      float* scond = fs;
      float* sred = fs + 5120;
      for (int i = tid; i < 5120; i += NT) {
        const int ci = i >> 10, k = i & 1023;
        float cv = ci == 0 ? p.in[7][k] : p.in[6][(ci - 1) * 1024 + k];
        scond[i] = siluf_(cv);
      }
      __syncthreads();
      const int col = tid & 63, kg = tid >> 6;
      const float* w = p.in[8] + (size_t)l * 1024 * 3072 + n0 + col;
      float a0 = 0, a1 = 0, a2 = 0, a3 = 0, a4 = 0;
#pragma unroll 16
      for (int k = kg * 128; k < kg * 128 + 128; ++k) {
        float wv = w[(size_t)k * 3072];
        a0 += scond[k] * wv; a1 += scond[1024 + k] * wv; a2 += scond[2048 + k] * wv; a3 += scond[3072 + k] * wv; a4 += scond[4096 + k] * wv;
      }
      sred[(kg * 5 + 0) * 64 + col] = a0; sred[(kg * 5 + 1) * 64 + col] = a1; sred[(kg * 5 + 2) * 64 + col] = a2;
      sred[(kg * 5 + 3) * 64 + col] = a3; sred[(kg * 5 + 4) * 64 + col] = a4;
      __syncthreads();
      float* mod = (float*)(p.ws + WS_MOD);
      if (tid < 320) {
        const int ci = tid >> 6, cc = tid & 63;
        float s = 0;
#pragma unroll
        for (int g = 0; g < 8; ++g) s += sred[(g * 5 + ci) * 64 + cc];
        mod[(l * 5 + ci) * 3072 + n0 + cc] = s + p.in[9][l * 3072 + n0 + cc];
      }
      __syncthreads();
    } else if (it == NMOD) {
      float* lb = (float*)(p.ws + WS_LB);
      for (int i = tid; i < 2048; i += NT) {
        const int d = i >> 10, c = i & 1023;
        const float* lg = p.in[13] + d * 5 * 1024 + c;
        float m = lg[0];
        for (int j = 1; j < 5; ++j) m = fmaxf(m, lg[j * 1024]);
        float s = 0;
        for (int j = 0; j < 5; ++j) s += expf(lg[j * 1024] - m);
        lb[i] = expf(lg[0] - m) / s;
      }
      int* cnt = (int*)(p.ws + WS_CNT);
      if (tid < 16) cnt[tid] = 0;
    } else {
      wconv_item(p, it - NMOD - 1, fs);
    }
  }
}

__device__ __forceinline__ void phase_h0(const Params& p, int bid, int nb) {
  const float* mod = (const float*)(p.ws + WS_MOD);
  u16* H = (u16*)(p.ws + WS_H);
  const size_t total = (size_t)(TOK / 4) * 256;
  for (size_t i = (size_t)bid * NT + threadIdx.x; i < total; i += (size_t)nb * NT) {
    const int row = (int)(i >> 8) * 4, c = ((int)i & 255) * 4;
    const float* xr = row < NPROMPT ? p.in[0] + (size_t)row * 1024 : p.in[1] + (size_t)(row - NPROMPT) * 1024;
    const float* m = mod + cond_of(row) * 3072;
    f32x4 x[4];
#pragma unroll
    for (int t = 0; t < 4; ++t) x[t] = *(const f32x4*)&xr[t * 1024 + c];
    const f32x4 sh = *(const f32x4*)&m[c];
    const f32x4 sc = *(const f32x4*)&m[1024 + c];
#pragma unroll
    for (int t = 0; t < 4; ++t)
      *(uint2*)&H[(size_t)(row + t) * 1024 + c] = pack4(x[t][0] * (1 + sc[0]) + sh[0], x[t][1] * (1 + sc[1]) + sh[1], x[t][2] * (1 + sc[2]) + sh[2], x[t][3] * (1 + sc[3]) + sh[3]);
  }
}

__device__ __forceinline__ void phase_ln(const Params& p, int l, int bid, int nb) {
  float* X = p.out;
  const float* g = p.in[10] + l * 1024;
  const float* b = p.in[11] + l * 1024;
  const float* mod = (const float*)(p.ws + WS_MOD) + (l + 1) * 5 * 3072;
  u16* H = (u16*)(p.ws + WS_H);
  const int lane = threadIdx.x & 63, wave = threadIdx.x >> 6;
  for (int row = bid * NW + wave; row < TOK; row += nb * NW) {
    float* xr = X + (size_t)row * 1024;
    f32x4 v[4];
    float s = 0;
#pragma unroll
    for (int i = 0; i < 4; ++i) { v[i] = *(const f32x4*)&xr[i * 256 + lane * 4]; s += v[i][0] + v[i][1] + v[i][2] + v[i][3]; }
    const float mu = wave_sum(s) * (1.0f / 1024.0f);
    float q = 0;
#pragma unroll
    for (int i = 0; i < 4; ++i)
#pragma unroll
      for (int j = 0; j < 4; ++j) { float dd = v[i][j] - mu; q += dd * dd; }
    const float rs = rsqrtf(wave_sum(q) * (1.0f / 1024.0f) + 1e-5f);
    const float* m = mod + cond_of(row) * 3072;
#pragma unroll
    for (int i = 0; i < 4; ++i) {
      const int c = i * 256 + lane * 4;
      f32x4 gg = *(const f32x4*)&g[c], bb = *(const f32x4*)&b[c];
      f32x4 y;
#pragma unroll
      for (int j = 0; j < 4; ++j) y[j] = (v[i][j] - mu) * rs * gg[j] + bb[j];
      *(f32x4*)&xr[c] = y;
      if (l < 3) {
        f32x4 sh = *(const f32x4*)&m[c], sc = *(const f32x4*)&m[1024 + c];
        *(uint2*)&H[(size_t)row * 1024 + c] = pack4(y[0] * (1 + sc[0]) + sh[0], y[1] * (1 + sc[1]) + sh[1], y[2] * (1 + sc[2]) + sh[2], y[3] * (1 + sc[3]) + sh[3]);
      }
    }
  }
}

__device__ __forceinline__ void phase_gla(const Params& p, unsigned char* smem_raw) {
  u16* s_qrel = (u16*)smem_raw;
  u16* s_krel = s_qrel + 32 * 136;
  u16* s_qcum = s_krel + 32 * 136;
  u16* s_kdT = s_qcum + 32 * 136;
  u16* s_vT = s_kdT + 128 * 40;
  u16* s_att = s_vT + 128 * 40;
  u16* s_S = s_att + 32 * 40;
  float* s_dec = (float*)(s_S + 128 * 136);
  float* s_part = s_dec + 128;
  int* s_u = (int*)(s_part + 512);
  int* counter = (int*)(p.ws + WS_CNT);
  const u16* qg = (const u16*)(p.ws + WS_B(0));
  const u16* vg = (const u16*)(p.ws + WS_B(1));
  const _Float16* lfg = (const _Float16*)(p.ws + WS_B(3));
  u16* og = (u16*)(p.ws + WS_B(5));
  const int tid = threadIdx.x, lane = tid & 63, w = tid >> 6, fr = lane & 15, fq = lane >> 4;
  const int kk = tid & 127, th = tid >> 7;
  const int ti = w >> 2, vi = w & 3;
  const int wk = w & 3, wv = w >> 2;
  bool first = true;
  while (true) {
    if (tid == 0) *s_u = (first && blockIdx.x < 64) ? (int)blockIdx.x : 64 + atomicAdd(counter, 1);
    first = false;
    __syncthreads();
    const int u = *s_u;
    __syncthreads();
    if (u >= 576) break;
    int b, rem, start, N, sample;
    if (u < 64) { sample = 1; b = u >> 4; rem = u & 15; start = NPROMPT + b * 1024; N = 1024; }
    else { sample = 0; b = (u - 64) >> 4; rem = (u - 64) & 15; start = b * 256; N = 256; }
    const int h = rem >> 1, d = rem & 1;
    const int nc = N >> 5;
    f32x4 S[2][4];
#pragma unroll
    for (int mi = 0; mi < 2; ++mi)
#pragma unroll
      for (int ni = 0; ni < 4; ++ni) {
        f32x4 s4 = f32x4{0.f, 0.f, 0.f, 0.f};
        if (sample) {
          const float* s0 = p.in[2] + ((size_t)((b * 2 + d) * 8 + h)) * 16384;
#pragma unroll
          for (int j = 0; j < 4; ++j) s4[j] = s0[(wk * 32 + mi * 16 + fq * 4 + j) * 128 + wv * 64 + ni * 16 + fr];
        }
        S[mi][ni] = s4;
        *(uint2*)&s_S[(wv * 64 + ni * 16 + fr) * 136 + wk * 32 + mi * 16 + fq * 4] = pack4(s4[0], s4[1], s4[2], s4[3]);
      }
    _Float16 lfraw[8]; u16 qraw[8]; uint4 vraw;
#define GLA_LOAD(cc) do { _Pragma("unroll") for (int i = 0; i < 8; ++i) { const int tt = (cc) * 32 + th * 8 + i; const size_t tok = start + (d ? (N - 1 - tt) : tt); \
      lfraw[i] = lfg[tok * 2048 + d * 1024 + h * 128 + kk]; qraw[i] = qg[tok * 1024 + h * 128 + kk]; } \
      { const int tt = (cc) * 32 + (tid & 31); const size_t tok = start + (d ? (N - 1 - tt) : tt); vraw = *(const uint4*)&vg[tok * 1024 + h * 128 + (tid >> 5) * 8]; } } while (0)
    GLA_LOAD(0);
    for (int c = 0; c < nc; ++c) {
      {
        float lfv[8], qv[8];
#pragma unroll
        for (int i = 0; i < 8; ++i) { lfv[i] = (float)lfraw[i]; qv[i] = bf2f(qraw[i]); }
        const uint4 vv = vraw;
        if (c + 1 < nc) GLA_LOAD(c + 1);
        float run = 0;
        float cs[8];
#pragma unroll
        for (int i = 0; i < 8; ++i) { run += lfv[i]; cs[i] = run; }
        s_part[th * 128 + kk] = run;
        {
          const int s = tid & 31, v8 = (tid >> 5) * 8;
          const unsigned vw[4] = {vv.x, vv.y, vv.z, vv.w};
#pragma unroll
          for (int i = 0; i < 4; ++i) { s_vT[(v8 + 2 * i) * 40 + s] = (u16)(vw[i] & 0xffff); s_vT[(v8 + 2 * i + 1) * 40 + s] = (u16)(vw[i] >> 16); }
        }
        __syncthreads();
        const float p0 = s_part[kk], p1 = s_part[128 + kk], p2 = s_part[256 + kk], p3 = s_part[384 + kk];
        const float off = (th > 0 ? p0 : 0.f) + (th > 1 ? p1 : 0.f) + (th > 2 ? p2 : 0.f);
        const float ref = p0 + p1, total = p0 + p1 + p2 + p3;
        unsigned kd[4];
        const float eref = __builtin_amdgcn_exp2f(ref), etr = __builtin_amdgcn_exp2f(total - ref);
#pragma unroll
        for (int i = 0; i < 8; ++i) {
          const int t = th * 8 + i;
          const float cum = off + cs[i];
          const float kf = 1.0f - __builtin_amdgcn_exp2f(lfv[i]);
          const float e1 = __builtin_amdgcn_exp2f(cum - ref), e2 = __builtin_amdgcn_rcpf(e1);
          const float qe = qv[i] * e1, ke = kf * e2;
          s_qrel[t * 136 + kk] = f2bf(qe);
          s_krel[t * 136 + kk] = f2bf(ke);
          s_qcum[t * 136 + kk] = f2bf(qe * eref);
          const u16 kdv = f2bf(ke * etr);
          if (i & 1) kd[i >> 1] |= ((unsigned)kdv) << 16; else kd[i >> 1] = kdv;
        }
        *(uint4*)&s_kdT[kk * 40 + th * 8] = make_uint4(kd[0], kd[1], kd[2], kd[3]);
        if (th == 0) s_dec[kk] = eref * etr;
      }
      __syncthreads();
      f32x4 oacc[2] = {f32x4{0.f, 0.f, 0.f, 0.f}, f32x4{0.f, 0.f, 0.f, 0.f}};
      {
        f32x4 att = f32x4{0.f, 0.f, 0.f, 0.f};
        const int ati = w >> 1, asi = w & 1;
#pragma unroll
        for (int ks = 0; ks < 4; ++ks) {
          if (w < 4) {
            bf16x8 a = *(const bf16x8*)&s_qrel[(ati * 16 + fr) * 136 + ks * 32 + fq * 8];
            bf16x8 bb = *(const bf16x8*)&s_krel[(asi * 16 + fr) * 136 + ks * 32 + fq * 8];
            att = __builtin_amdgcn_mfma_f32_16x16x32_bf16(a, bb, att, 0, 0, 0);
          }
          bf16x8 a2 = *(const bf16x8*)&s_qcum[(ti * 16 + fr) * 136 + ks * 32 + fq * 8];
#pragma unroll
          for (int e = 0; e < 2; ++e) {
            bf16x8 b2 = *(const bf16x8*)&s_S[((vi * 2 + e) * 16 + fr) * 136 + ks * 32 + fq * 8];
            oacc[e] = __builtin_amdgcn_mfma_f32_16x16x32_bf16(b2, a2, oacc[e], 0, 0, 0);
          }
        }
        if (w < 4) {
#pragma unroll
          for (int j = 0; j < 4; ++j) {
            const int t = ati * 16 + fq * 4 + j, s = asi * 16 + fr;
            s_att[t * 40 + s] = (s <= t) ? f2bf(att[j]) : (u16)0;
          }
        }
      }
      __syncthreads();
      {
        bf16x8 a = *(const bf16x8*)&s_att[(ti * 16 + fr) * 40 + fq * 8];
        const int tt = c * 32 + ti * 16 + fr;
        const size_t tok = start + (d ? (N - 1 - tt) : tt);
#pragma unroll
        for (int e = 0; e < 2; ++e) {
          bf16x8 bb = *(const bf16x8*)&s_vT[((vi * 2 + e) * 16 + fr) * 40 + fq * 8];
          oacc[e] = __builtin_amdgcn_mfma_f32_16x16x32_bf16(bb, a, oacc[e], 0, 0, 0);
          *(uint2*)&og[((size_t)d * TOK + tok) * 1024 + h * 128 + (vi * 2 + e) * 16 + fq * 4] = pack4(oacc[e][0], oacc[e][1], oacc[e][2], oacc[e][3]);
        }
        bf16x8 vf[4];
#pragma unroll
        for (int ni = 0; ni < 4; ++ni) vf[ni] = *(const bf16x8*)&s_vT[(wv * 64 + ni * 16 + fr) * 40 + fq * 8];
#pragma unroll
        for (int mi = 0; mi < 2; ++mi) {
          bf16x8 kf = *(const bf16x8*)&s_kdT[(wk * 32 + mi * 16 + fr) * 40 + fq * 8];
          f32x4 dc = *(const f32x4*)&s_dec[wk * 32 + mi * 16 + fq * 4];
#pragma unroll
          for (int ni = 0; ni < 4; ++ni) {
            f32x4 s4 = S[mi][ni];
#pragma unroll
            for (int j = 0; j < 4; ++j) s4[j] *= dc[j];
            s4 = __builtin_amdgcn_mfma_f32_16x16x32_bf16(kf, vf[ni], s4, 0, 0, 0);
            S[mi][ni] = s4;
            *(uint2*)&s_S[(wv * 64 + ni * 16 + fr) * 136 + wk * 32 + mi * 16 + fq * 4] = pack4(s4[0], s4[1], s4[2], s4[3]);
          }
        }
      }
      __syncthreads();
    }
    if (!sample) {
      float* so = p.out + OUT_HG + ((size_t)((b * 2 + d) * 8 + h)) * 16384;
#pragma unroll
      for (int mi = 0; mi < 2; ++mi)
#pragma unroll
        for (int ni = 0; ni < 4; ++ni)
#pragma unroll
          for (int j = 0; j < 4; ++j) so[(wk * 32 + mi * 16 + fq * 4 + j) * 128 + wv * 64 + ni * 16 + fr] = S[mi][ni][j];
    }
  }
#undef GLA_LOAD
}

__device__ __forceinline__ void phase_hg_post(const Params& p, int bid, int nb) {
  const u16* og = (const u16*)(p.ws + WS_B(5));
  const u16* sg = (const u16*)(p.ws + WS_B(2));
  u16* a = (u16*)(p.ws + WS_B(0));
  const float* ng = p.in[14];
  const int lane = threadIdx.x & 63, wave = threadIdx.x >> 6;
  float ngv[16];
#pragma unroll
  for (int k = 0; k < 4; ++k) { const f32x4 t = *(const f32x4*)&ng[lane * 16 + 4 * k]; ngv[4 * k] = t[0]; ngv[4 * k + 1] = t[1]; ngv[4 * k + 2] = t[2]; ngv[4 * k + 3] = t[3]; }
  for (int row0 = (bid * NW + wave) * 2; row0 < TOK; row0 += nb * NW * 2) {
    uint4 f[2][2], bw[2][2], sv[2][2];
#pragma unroll
    for (int r = 0; r < 2; ++r)
#pragma unroll
      for (int hh = 0; hh < 2; ++hh) {
        const size_t base = (size_t)(row0 + r) * 1024 + lane * 16 + hh * 8;
        f[r][hh] = *(const uint4*)&og[base];
        bw[r][hh] = *(const uint4*)&og[(size_t)TOK * 1024 + base];
        sv[r][hh] = *(const uint4*)&sg[base];
      }
#pragma unroll
    for (int r = 0; r < 2; ++r) {
      float o[16];
      float ss = 0;
#pragma unroll
      for (int hh = 0; hh < 2; ++hh) {
        const unsigned fa[4] = {f[r][hh].x, f[r][hh].y, f[r][hh].z, f[r][hh].w}, ba[4] = {bw[r][hh].x, bw[r][hh].y, bw[r][hh].z, bw[r][hh].w};
#pragma unroll
        for (int i = 0; i < 4; ++i) {
          o[hh * 8 + 2 * i] = lo16(fa[i]) + lo16(ba[i]);
          o[hh * 8 + 2 * i + 1] = hi16(fa[i]) + hi16(ba[i]);
        }
      }
#pragma unroll
      for (int i = 0; i < 16; ++i) ss += o[i] * o[i];
      ss += __shfl_xor(ss, 1); ss += __shfl_xor(ss, 2); ss += __shfl_xor(ss, 4);
      const float rs = rsqrtf(ss * (1.0f / 128.0f) + 1e-6f);
#pragma unroll
      for (int hh = 0; hh < 2; ++hh) {
        const unsigned sa[4] = {sv[r][hh].x, sv[r][hh].y, sv[r][hh].z, sv[r][hh].w};
        unsigned rr[4];
#pragma unroll
        for (int i = 0; i < 4; ++i)
          rr[i] = pack2(o[hh * 8 + 2 * i] * rs * ngv[hh * 8 + 2 * i] * siluf_(lo16(sa[i])), o[hh * 8 + 2 * i + 1] * rs * ngv[hh * 8 + 2 * i + 1] * siluf_(hi16(sa[i])));
        *(uint4*)&a[(size_t)(row0 + r) * 1024 + lane * 16 + hh * 8] = make_uint4(rr[0], rr[1], rr[2], rr[3]);
      }
    }
  }
}

__device__ __forceinline__ void seq_pos(int tok, int& n, int& L) {
  if (tok < NPROMPT) { n = tok & 255; L = 256; } else { n = (tok - NPROMPT) & 1023; L = 1024; }
}
__device__ __forceinline__ void phase_sc_conv(const Params& p, int bid, int nb) {
  const u16* pb = (const u16*)(p.ws + WS_B(0));
  const u16* sb = (const u16*)(p.ws + WS_B(1));
  u16* a = (u16*)(p.ws + WS_B(2));
  const float* cw = p.in[17]; const float* cbias = p.in[18];
  const size_t total = (size_t)TOK * 128;
  const size_t i0 = (size_t)bid * NT + threadIdx.x;
  const int c = ((int)i0 & 127) * 8;
  float w0[8], w1[8], w2[8], wb[8];
#pragma unroll
  for (int k = 0; k < 2; ++k) {
    const f32x4 t0 = *(const f32x4*)&cw[c + 4 * k], t1 = *(const f32x4*)&cw[1024 + c + 4 * k], t2 = *(const f32x4*)&cw[2048 + c + 4 * k], tb = *(const f32x4*)&cbias[c + 4 * k];
#pragma unroll
    for (int j = 0; j < 4; ++j) { w0[4 * k + j] = t0[j]; w1[4 * k + j] = t1[j]; w2[4 * k + j] = t2[j]; wb[4 * k + j] = tb[j]; }
  }
  const uint4 z = make_uint4(0, 0, 0, 0);
  for (size_t i = i0; i < total / 4; i += (size_t)nb * NT) {
    const int tok = (int)(i >> 7) * 4;
    int n, L; seq_pos(tok, n, L);
    const size_t base = (size_t)tok * 1024 + c;
    uint4 q[6], sv[4];
    q[0] = n > 0 ? *(const uint4*)&pb[base - 1024] : z;
#pragma unroll
    for (int t = 0; t < 4; ++t) { q[1 + t] = *(const uint4*)&pb[base + t * 1024]; sv[t] = *(const uint4*)&sb[base + t * 1024]; }
    q[5] = n + 4 < L ? *(const uint4*)&pb[base + 4096] : z;
#pragma unroll
    for (int t = 0; t < 4; ++t) {
      const unsigned am[4] = {q[t].x, q[t].y, q[t].z, q[t].w}, a0[4] = {q[t + 1].x, q[t + 1].y, q[t + 1].z, q[t + 1].w};
      const unsigned ap[4] = {q[t + 2].x, q[t + 2].y, q[t + 2].z, q[t + 2].w}, as[4] = {sv[t].x, sv[t].y, sv[t].z, sv[t].w};
      unsigned r[4];
#pragma unroll
      for (int k = 0; k < 4; ++k) {
        float z0 = w0[2 * k] * lo16(am[k]) + w1[2 * k] * lo16(a0[k]) + w2[2 * k] * lo16(ap[k]) + wb[2 * k];
        float z1 = w0[2 * k + 1] * hi16(am[k]) + w1[2 * k + 1] * hi16(a0[k]) + w2[2 * k + 1] * hi16(ap[k]) + wb[2 * k + 1];
        r[k] = pack2(lo16(as[k]) * z0, hi16(as[k]) * z1);
      }
      *(uint4*)&a[base + t * 1024] = make_uint4(r[0], r[1], r[2], r[3]);
    }
  }
}
__device__ __forceinline__ void phase_rg_conv(const Params& p, int bid, int nb) {
  const u16* ub = (const u16*)(p.ws + WS_B(0));
  u16* uc = (u16*)(p.ws + WS_B(2));
  const float* cw = p.in[21]; const float* cbias = p.in[22];
  const size_t total = (size_t)TOK * 128;
  const size_t i0 = (size_t)bid * NT + threadIdx.x;
  const int c = ((int)i0 & 127) * 8;
  float w0[8], w1[8], w2[8], w3[8], wb[8];
#pragma unroll
  for (int k = 0; k < 2; ++k) {
    const f32x4 t0 = *(const f32x4*)&cw[c + 4 * k], t1 = *(const f32x4*)&cw[1024 + c + 4 * k], t2 = *(const f32x4*)&cw[2048 + c + 4 * k], t3 = *(const f32x4*)&cw[3072 + c + 4 * k], tb = *(const f32x4*)&cbias[c + 4 * k];
#pragma unroll
    for (int j = 0; j < 4; ++j) { w0[4 * k + j] = t0[j]; w1[4 * k + j] = t1[j]; w2[4 * k + j] = t2[j]; w3[4 * k + j] = t3[j]; wb[4 * k + j] = tb[j]; }
  }
  const uint4 z = make_uint4(0, 0, 0, 0);
  for (size_t i = i0; i < total / 4; i += (size_t)nb * NT) {
    const int tok = (int)(i >> 7) * 4;
    int n, L; seq_pos(tok, n, L);
    const size_t base = (size_t)tok * 1024 + c;
    uint4 q[7];
    q[0] = n > 1 ? *(const uint4*)&ub[base - 2048] : z;
    q[1] = n > 0 ? *(const uint4*)&ub[base - 1024] : z;
#pragma unroll
    for (int t = 0; t < 4; ++t) q[2 + t] = *(const uint4*)&ub[base + t * 1024];
    q[6] = n + 4 < L ? *(const uint4*)&ub[base + 4096] : z;
#pragma unroll
    for (int t = 0; t < 4; ++t) {
      const unsigned a0[4] = {q[t].x, q[t].y, q[t].z, q[t].w}, a1[4] = {q[t + 1].x, q[t + 1].y, q[t + 1].z, q[t + 1].w};
      const unsigned a2[4] = {q[t + 2].x, q[t + 2].y, q[t + 2].z, q[t + 2].w}, a3[4] = {q[t + 3].x, q[t + 3].y, q[t + 3].z, q[t + 3].w};
      unsigned r[4];
#pragma unroll
      for (int k = 0; k < 4; ++k) {
        float z0 = w0[2 * k] * lo16(a0[k]) + w1[2 * k] * lo16(a1[k]) + w2[2 * k] * lo16(a2[k]) + w3[2 * k] * lo16(a3[k]) + wb[2 * k];
        float z1 = w0[2 * k + 1] * hi16(a0[k]) + w1[2 * k + 1] * hi16(a1[k]) + w2[2 * k + 1] * hi16(a2[k]) + w3[2 * k + 1] * hi16(a3[k]) + wb[2 * k + 1];
        r[k] = pack2(z0, z1);
      }
      *(uint4*)&uc[((size_t)(c >> 6) * TOK + tok + t) * 64 + (c & 63)] = make_uint4(r[0], r[1], r[2], r[3]);
    }
  }
}

__device__ __forceinline__ void phase_rg_scan(const Params& p, unsigned char* smem_raw, int bid, int nb) {
  float* sA = (float*)smem_raw;
  float* sB = sA + 2048;
  const u16* rb = (const u16*)(p.ws + WS_B(3));
  const u16* ib = (const u16*)(p.ws + WS_B(5));
  const u16* uc = (const u16*)(p.ws + WS_B(2));
  const u16* sg = (const u16*)(p.ws + WS_B(1));
  u16* hfw = (u16*)(p.ws + WS_H);
  u16* yp = (u16*)(p.ws + WS_B(0));
  const int tid = threadIdx.x;
  for (int u = bid; u < 768; u += nb) {
    int sample, b, c, seg, nseg, start, chs, slot;
    if (u < 256) {
      const int xq = u & 7, yq = u >> 3, gid = (yq >> 2) * 8 + xq, sub = yq & 3;
      sample = 1; b = gid >> 4; slot = (tid & 3) * 4; c = (gid & 15) * 64 + sub * 16 + slot; seg = tid >> 2; nseg = 128; start = NPROMPT + b * 1024; chs = 16; }
    else { sample = 0; b = (u - 256) >> 4; slot = (tid & 15) * 4; c = ((u - 256) & 15) * 64 + slot; seg = tid >> 4; nseg = 32; start = b * 256; chs = 64; }
    const int L = nseg * 8;
#pragma unroll 1
    for (int d = 0; d < 2; ++d) {
      const f32x4 lam = *(const f32x4*)&p.in[25][d * 1024 + c];
      float cl[4];
#pragma unroll
      for (int j = 0; j < 4; ++j) cl[j] = 8.0f * 1.4426950408889634f * log1pf(__expf(-lam[j]))    ;
      const u16* rp = rb + (size_t)d * TOK * 1024;
      const u16* ip = ib + (size_t)d * TOK * 1024;
      const int tok0 = start + (d ? L - 1 - seg * 8 : seg * 8);
      const size_t o0 = (size_t)tok0 * 1024 + c;
      const long ostep = d ? -1024 : 1024;
      const size_t g0 = ((size_t)(c >> 6) * TOK + tok0) * 64 + (c & 63);
      const long gstep = d ? -64 : 64;
      uint2 rr[8], ii[8], uu[8];
#pragma unroll
      for (int s8 = 0; s8 < 8; ++s8) { rr[s8] = *(const uint2*)&rp[g0 + s8 * gstep]; ii[s8] = *(const uint2*)&ip[g0 + s8 * gstep]; uu[s8] = *(const uint2*)&uc[g0 + s8 * gstep]; }
      uint2 hf[8], sgv[8];
      if (d == 1) {
#pragma unroll
        for (int s8 = 0; s8 < 8; ++s8) { hf[s8] = *(const uint2*)&hfw[g0 + s8 * gstep]; sgv[s8] = *(const uint2*)&sg[g0 + s8 * gstep]; }
      }
      float av[8][4], xv[8][4];
      float A[4] = {1.f, 1.f, 1.f, 1.f}, B[4] = {0.f, 0.f, 0.f, 0.f};
#pragma unroll
      for (int s8 = 0; s8 < 8; ++s8) {
        const float r4[4] = {lo16(rr[s8].x), hi16(rr[s8].x), lo16(rr[s8].y), hi16(rr[s8].y)};
        const float i4[4] = {lo16(ii[s8].x), hi16(ii[s8].x), lo16(ii[s8].y), hi16(ii[s8].y)};
        const float u4[4] = {lo16(uu[s8].x), hi16(uu[s8].x), lo16(uu[s8].y), hi16(uu[s8].y)};
#pragma unroll
        for (int j = 0; j < 4; ++j) {
          const float la = -cl[j] * r4[j];
          const float a = __builtin_amdgcn_exp2f(la);
          const float xin = __builtin_amdgcn_sqrtf(fmaxf(1.0f - __builtin_amdgcn_exp2f(2.0f * la), 0.f)) * (i4[j] * u4[j]);
          av[s8][j] = a; xv[s8][j] = xin;
          A[j] *= a; B[j] = a * B[j] + xin;
        }
      }
      *(f32x4*)&sA[seg * chs + slot] = f32x4{A[0], A[1], A[2], A[3]};
      *(f32x4*)&sB[seg * chs + slot] = f32x4{B[0], B[1], B[2], B[3]};
      for (int k = 1; k < nseg; k <<= 1) {
        __syncthreads();
        f32x4 pa = f32x4{1.f, 1.f, 1.f, 1.f}, pb2 = f32x4{0.f, 0.f, 0.f, 0.f};
        if (seg >= k) { pa = *(const f32x4*)&sA[(seg - k) * chs + slot]; pb2 = *(const f32x4*)&sB[(seg - k) * chs + slot]; }
        __syncthreads();
        if (seg >= k) {
#pragma unroll
          for (int j = 0; j < 4; ++j) { B[j] = A[j] * pb2[j] + B[j]; A[j] = A[j] * pa[j]; }
          *(f32x4*)&sA[seg * chs + slot] = f32x4{A[0], A[1], A[2], A[3]};
          *(f32x4*)&sB[seg * chs + slot] = f32x4{B[0], B[1], B[2], B[3]};
        }
      }
      __syncthreads();
      float h[4];
      {
        f32x4 h0v = f32x4{0.f, 0.f, 0.f, 0.f};
        if (sample) h0v = *(const f32x4*)&p.in[3][(b * 2 + d) * 1024 + c];
        if (seg > 0) {
          const f32x4 pa = *(const f32x4*)&sA[(seg - 1) * chs + slot], pb2 = *(const f32x4*)&sB[(seg - 1) * chs + slot];
#pragma unroll
          for (int j = 0; j < 4; ++j) h[j] = pa[j] * h0v[j] + pb2[j];
        } else {
#pragma unroll
          for (int j = 0; j < 4; ++j) h[j] = h0v[j];
        }
      }
#pragma unroll
      for (int s8 = 0; s8 < 8; ++s8) {
#pragma unroll
        for (int j = 0; j < 4; ++j) h[j] = av[s8][j] * h[j] + xv[s8][j];
        const size_t o = o0 + s8 * ostep;
        if (d == 0) *(uint2*)&hfw[g0 + s8 * gstep] = pack4(h[0], h[1], h[2], h[3]);
        else *(uint2*)&yp[g0 + s8 * gstep] = pack4((lo16(hf[s8].x) + h[0]) * lo16(sgv[s8].x), (hi16(hf[s8].x) + h[1]) * hi16(sgv[s8].x),
                                     (lo16(hf[s8].y) + h[2]) * lo16(sgv[s8].y), (hi16(hf[s8].y) + h[3]) * hi16(sgv[s8].y));
      }
      if (!sample && seg == nseg - 1) *(f32x4*)&p.out[OUT_RG + (b * 2 + d) * 1024 + c] = f32x4{h[0], h[1], h[2], h[3]};
      __syncthreads();
    }
  }
}

__device__ __forceinline__ void phase_mla_norm(const Params& p, int bid, int nb) {
  u16* cq = (u16*)(p.ws + WS3_CQ);
  u16* ckvall = (u16*)(p.ws + WS3_CKVALL);
  const float* ckvraw = (const float*)(p.ws + WS3_CKVRAW);
  const float* kperaw = (const float*)(p.ws + WS3_KPERAW);
  u16* Kb = (u16*)(p.ws + WS3_K);
  const float* qn = p.in[28]; const float* kvn = p.in[29];
  const int lane = threadIdx.x & 63, wave = threadIdx.x >> 6;
  float qnv[6];
#pragma unroll
  for (int i = 0; i < 3; ++i) { qnv[2 * i] = qn[(i * 64 + lane) * 2]; qnv[2 * i + 1] = qn[(i * 64 + lane) * 2 + 1]; }
  const f32x4 g4 = *(const f32x4*)&kvn[lane * 4];
  unsigned cvn[3] = {0u, 0u, 0u}; f32x4 kvnx = f32x4{0.f, 0.f, 0.f, 0.f}; float vnx = 0.f;
  {
    const int r0 = bid * NW + wave;
    if (r0 < TOK) {
#pragma unroll
      for (int i = 0; i < 3; ++i) cvn[i] = ((const unsigned*)&cq[(size_t)r0 * 384])[i * 64 + lane];
      kvnx = *(const f32x4*)&ckvraw[(size_t)r0 * 256 + lane * 4]; vnx = kperaw[(size_t)r0 * 32 + (lane & 31)];
    }
  }
  for (int row = bid * NW + wave; row < TOK + 2048; row += nb * NW) {
    if (row < TOK) {
      const int tok = row;
      const bool sample = tok >= NPROMPT;
      unsigned cv[3] = {cvn[0], cvn[1], cvn[2]}; const f32x4 kv = kvnx; float v = vnx;
      {
        const int rn = row + nb * NW;
        if (rn < TOK) {
#pragma unroll
          for (int i = 0; i < 3; ++i) cvn[i] = ((const unsigned*)&cq[(size_t)rn * 384])[i * 64 + lane];
          kvnx = *(const f32x4*)&ckvraw[(size_t)rn * 256 + lane * 4]; vnx = kperaw[(size_t)rn * 32 + (lane & 31)];
        }
      }
      const int bs = (tok - NPROMPT) >> 10, n = (tok - NPROMPT) & 1023;
      const size_t kvrow = sample ? (size_t)(NPROMPT + bs * 1536 + 512 + n) : (size_t)tok;
      unsigned* cqr = (unsigned*)&cq[(size_t)tok * 384];
      float ss = 0;
#pragma unroll
      for (int i = 0; i < 3; ++i) { float a = lo16(cv[i]), b2 = hi16(cv[i]); ss += a * a + b2 * b2; }
      const float rsq = rsqrtf(wave_sum(ss) * (1.0f / 384.0f) + 1e-6f);
#pragma unroll
      for (int i = 0; i < 3; ++i) {
        cqr[i * 64 + lane] = pack2(lo16(cv[i]) * rsq * qnv[2 * i], hi16(cv[i]) * rsq * qnv[2 * i + 1]);
      }
      const float rsk = rsqrtf(wave_sum(kv[0] * kv[0] + kv[1] * kv[1] + kv[2] * kv[2] + kv[3] * kv[3]) * (1.0f / 256.0f) + 1e-6f);
      f32x4 o4;
#pragma unroll
      for (int j = 0; j < 4; ++j) o4[j] = kv[j] * rsk * g4[j];
      *(uint2*)&ckvall[kvrow * 256 + lane * 4] = pack4(o4[0], o4[1], o4[2], o4[3]);
      if (!sample) *(f32x4*)&p.out[OUT_CKV + (size_t)tok * 256 + lane * 4] = o4;
      if (!sample) { if (lane < 32) p.out[OUT_KPE + (size_t)tok * 32 + lane] = v; }
      else {
        const float partner = __shfl_xor(v, 8);
        const int i16 = lane & 15;
        const float pos = (lane & 16) ? (float)(n & 63) : (float)(n >> 6);
        float sn, cs; rope_sincos(pos, i16 & 7, sn, cs);
        v = (i16 < 8) ? (v * cs - partner * sn) : (partner * sn + v * cs);
      }
      const u16 vb = f2bf(v);
#pragma unroll
      for (int i = 0; i < 8; ++i) Kb[(kvrow * 16 + (lane >> 5) + 2 * i) * 96 + 64 + (lane & 31)] = vb;
    } else {
      const int r = row - TOK, bs = r >> 9, j = r & 511;
      const size_t kvrow = (size_t)(NPROMPT + bs * 1536 + j);
      f32x4 kv = *(const f32x4*)&p.in[4][(size_t)r * 256 + lane * 4];
      *(uint2*)&ckvall[kvrow * 256 + lane * 4] = pack4(kv[0], kv[1], kv[2], kv[3]);
      const u16 vb = f2bf(p.in[5][(size_t)r * 32 + (lane & 31)]);
#pragma unroll
      for (int i = 0; i < 8; ++i) Kb[(kvrow * 16 + (lane >> 5) + 2 * i) * 96 + 64 + (lane & 31)] = vb;
    }
  }
}

__device__ __forceinline__ void phase_attn(const Params& p, unsigned char* smem_raw, int bid, int nb) {
  u16* sK = (u16*)smem_raw;
  u16* sV = sK + 128 * 104;
  const u16* qg = (const u16*)(p.ws + WS3_Q);
  const u16* Kg = (const u16*)(p.ws + WS3_K);
  const u16* Vg = (const u16*)(p.ws + WS3_VT);
  const u16* sg = (const u16*)(p.ws + WS3_SG);
  u16* ao = (u16*)(p.ws + WS_H);
  const int tid = threadIdx.x, lane = tid & 63, w = tid >> 6, fr = lane & 15, fq = lane >> 4;
  for (int u = bid; u < 1536; u += nb) {
    int tok0, kvbase, nkeys, h;
    if (u < 512) { const int b = u >> 7, r = u & 127; h = r >> 3; const int qb = r & 7; tok0 = NPROMPT + b * 1024 + qb * 128; kvbase = NPROMPT + b * 1536; nkeys = 1536; }
    else { const int uu = u - 512; const int b = uu >> 5, r = uu & 31; h = r >> 1; const int qb = r & 1; tok0 = b * 256 + qb * 128; kvbase = b * 256; nkeys = 256; }
    const int tokq = tok0 + w * 16 + fr;
    bf16x8 qf[3];
#pragma unroll
    for (int ks = 0; ks < 3; ++ks) qf[ks] = *(const bf16x8*)&qg[(size_t)tokq * 1536 + h * 96 + ks * 32 + fq * 8];
    if (u < 512) {
      const int npos = (tokq - NPROMPT) & 1023;
      const float pos = (fq & 2) ? (float)(npos & 63) : (float)(npos >> 6);
      uint4 raw = *(uint4*)&qf[2];
      unsigned rw[4] = {raw.x, raw.y, raw.z, raw.w};
#pragma unroll
      for (int i = 0; i < 4; ++i) {
        float v0 = lo16(rw[i]), v1 = hi16(rw[i]);
        const float p0 = __shfl_xor(v0, 16), p1 = __shfl_xor(v1, 16);
        float sn0, cs0, sn1, cs1;
        rope_sincos(pos, 2 * i, sn0, cs0); rope_sincos(pos, 2 * i + 1, sn1, cs1);
        v0 = (fq & 1) ? (p0 * sn0 + v0 * cs0) : (v0 * cs0 - p0 * sn0);
        v1 = (fq & 1) ? (p1 * sn1 + v1 * cs1) : (v1 * cs1 - p1 * sn1);
        rw[i] = pack2(v0, v1);
      }
      raw = make_uint4(rw[0], rw[1], rw[2], rw[3]);
      qf[2] = *(bf16x8*)&raw;
    }
    float m = -1e30f, l = 0.f;
    f32x4 oacc[4];
#pragma unroll
    for (int i = 0; i < 4; ++i) oacc[i] = f32x4{0.f, 0.f, 0.f, 0.f};
    const int kk0 = tid / 12, kc0 = tid - kk0 * 12;
    const int kk1 = (tid + NT) / 12, kc1 = (tid + NT) - kk1 * 12;
    const int kk2_ = (tid + 2 * NT) / 12, kc2 = (tid + 2 * NT) - kk2_ * 12;
    const u16* Kp0 = &Kg[((size_t)(kvbase + kk0) * 16 + h) * 96 + kc0 * 8];
    const u16* Kp1 = &Kg[((size_t)(kvbase + kk1) * 16 + h) * 96 + kc1 * 8];
    const u16* Kp2 = &Kg[((size_t)(kvbase + kk2_) * 16 + h) * 96 + kc2 * 8];
    const int vd0 = tid >> 4, vc0 = tid & 15, vd1 = (tid + NT) >> 4;
    const u16* Vp0 = &Vg[(size_t)(h * 64 + vd0) * KVROWS + kvbase + vc0 * 8];
    const u16* Vp1 = &Vg[(size_t)(h * 64 + vd1) * KVROWS + kvbase + vc0 * 8];
    uint4 kr0 = *(const uint4*)Kp0, kr1 = *(const uint4*)Kp1, kr2 = *(const uint4*)Kp2, vr0 = *(const uint4*)Vp0, vr1 = *(const uint4*)Vp1;
    const int ntile2 = nkeys >> 7;
    for (int kt = 0; kt < ntile2; ++kt) {
      __syncthreads();
      *(uint4*)&sK[kk0 * 104 + kc0 * 8] = kr0; *(uint4*)&sK[kk1 * 104 + kc1 * 8] = kr1; *(uint4*)&sK[kk2_ * 104 + kc2 * 8] = kr2;
      *(uint4*)&sV[vd0 * 136 + vc0 * 8] = vr0; *(uint4*)&sV[vd1 * 136 + vc0 * 8] = vr1;
      if (kt + 1 < ntile2) {
        const size_t ko = (size_t)(kt + 1) * 128 * 1536; const int vo = (kt + 1) * 128;
        kr0 = *(const uint4*)(Kp0 + ko); kr1 = *(const uint4*)(Kp1 + ko); kr2 = *(const uint4*)(Kp2 + ko);
        vr0 = *(const uint4*)(Vp0 + vo); vr1 = *(const uint4*)(Vp1 + vo);
      }
      __syncthreads();
      f32x4 sacc[8];
#pragma unroll
      for (int ni = 0; ni < 8; ++ni) {
        sacc[ni] = f32x4{0.f, 0.f, 0.f, 0.f};
#pragma unroll
        for (int ks = 0; ks < 3; ++ks) {
          bf16x8 kf = *(const bf16x8*)&sK[(ni * 16 + fr) * 104 + ks * 32 + fq * 8];
          sacc[ni] = __builtin_amdgcn_mfma_f32_16x16x32_bf16(kf, qf[ks], sacc[ni], 0, 0, 0);
        }
      }
      float mx = -1e30f;
#pragma unroll
      for (int ni = 0; ni < 8; ++ni)
#pragma unroll
        for (int j = 0; j < 4; ++j) mx = fmaxf(mx, sacc[ni][j]);
      mx = fmaxf(mx, __shfl_xor(mx, 16));
      mx = fmaxf(mx, __shfl_xor(mx, 32));
      const float mnew = fmaxf(m, mx);
      const float alpha = __builtin_amdgcn_exp2f(m - mnew);
      m = mnew;
      float ls = 0.f;
#pragma unroll
      for (int ni = 0; ni < 8; ++ni)
#pragma unroll
        for (int j = 0; j < 4; ++j) { float e = __builtin_amdgcn_exp2f(sacc[ni][j] - mnew); sacc[ni][j] = e; ls += e; }
      l = l * alpha + ls;
      bf16x8 pf[4];
#pragma unroll
      for (int kk2 = 0; kk2 < 4; ++kk2) {
        uint2 lo = pack4(sacc[2 * kk2][0], sacc[2 * kk2][1], sacc[2 * kk2][2], sacc[2 * kk2][3]);
        uint2 hi = pack4(sacc[2 * kk2 + 1][0], sacc[2 * kk2 + 1][1], sacc[2 * kk2 + 1][2], sacc[2 * kk2 + 1][3]);
        uint4 pk = make_uint4(lo.x, lo.y, hi.x, hi.y);
        pf[kk2] = *(bf16x8*)&pk;
      }
#pragma unroll
      for (int di = 0; di < 4; ++di) {
#pragma unroll
        for (int j = 0; j < 4; ++j) oacc[di][j] *= alpha;
#pragma unroll
        for (int kk2 = 0; kk2 < 4; ++kk2) {
          uint2 v0 = *(const uint2*)&sV[(di * 16 + fr) * 136 + kk2 * 32 + fq * 4];
          uint2 v1 = *(const uint2*)&sV[(di * 16 + fr) * 136 + kk2 * 32 + 16 + fq * 4];
          uint4 vk = make_uint4(v0.x, v0.y, v1.x, v1.y);
          oacc[di] = __builtin_amdgcn_mfma_f32_16x16x32_bf16(*(bf16x8*)&vk, pf[kk2], oacc[di], 0, 0, 0);
        }
      }
    }
    l += __shfl_xor(l, 16);
    l += __shfl_xor(l, 32);
    const float inv = 1.0f / l;
#pragma unroll
    for (int di = 0; di < 4; ++di) {
      const size_t o = (size_t)tokq * 1024 + h * 64 + di * 16 + fq * 4;
      uint2 s = *(const uint2*)&sg[o];
      *(uint2*)&ao[o] = pack4(oacc[di][0] * inv * siluf_(lo16(s.x)), oacc[di][1] * inv * siluf_(hi16(s.x)), oacc[di][2] * inv * siluf_(lo16(s.y)), oacc[di][3] * inv * siluf_(hi16(s.y)));
    }
  }
}

#define XB_TMO      128
#define XB_XCNT(j)  (256  + 64 * (j))
#define XB_XSUB(j)  (1280 + 64 * (j))
#define XB_XGEN(j)  (2304 + 64 * (j))
#define XB_TOP      3328
#define XB_TOPGEN   3392
#define XCD_BAR_WORDS 3456
#define XB_SPIN_CAP (1u << 22)
__device__ __forceinline__ unsigned xb_ld(unsigned* p)              { return __hip_atomic_load(p, __ATOMIC_RELAXED, __HIP_MEMORY_SCOPE_AGENT); }
__device__ __forceinline__ unsigned xb_add(unsigned* p, unsigned v) { return __hip_atomic_fetch_add(p, v, __ATOMIC_RELAXED, __HIP_MEMORY_SCOPE_AGENT); }
__device__ __forceinline__ unsigned xb_xcc_id() { return (unsigned)__builtin_amdgcn_s_getreg((3 << 11) | 20) & 0xFu; }
#define XB_SPIN(cond, bar) do { unsigned _sp = 0; while (cond) { __builtin_amdgcn_s_sleep(1); \
    if ((++_sp & 255u) == 0u) { if (xb_ld(&(bar)[XB_TMO])) break; if (_sp > XB_SPIN_CAP) { atomicAdd(&(bar)[XB_TMO], 1u); break; } } } } while (0)
struct XcdBarrier { unsigned* bar; unsigned x; volatile LAS unsigned* st; };
__device__ __forceinline__ XcdBarrier xcd_barrier_post(unsigned* bar, volatile LAS unsigned* st) {
  XcdBarrier b; b.bar = bar; b.x = xb_xcc_id(); b.st = st;
  if (threadIdx.x == 0) (void)xb_add(&bar[XB_XCNT(b.x)], 1u);
  return b;
}
__device__ __forceinline__ void xcd_barrier_complete(unsigned* bar, unsigned x, unsigned& nloc, unsigned& nx) {
  const unsigned G = gridDim.x * gridDim.y * gridDim.z;
  unsigned sum, cnt, mine, sp = 0u;
  for (;;) {
    sum = 0u; cnt = 0u; mine = 0u;
#pragma unroll
    for (unsigned j = 0; j < 16; ++j) { const unsigned c = xb_ld(&bar[XB_XCNT(j)]); sum += c; cnt += (c > 0u) ? 1u : 0u; mine = (j == x) ? c : mine; }
    if (sum == G) break;
    __builtin_amdgcn_s_sleep(1);
    if ((++sp & 255u) == 0u) { if (xb_ld(&bar[XB_TMO])) break; if (sp > XB_SPIN_CAP) { atomicAdd(&bar[XB_TMO], 1u); break; } }
  }
  nloc = mine > 0u ? mine : 1u; nx = cnt > 0u ? cnt : 1u;
}
__device__ __forceinline__ void xcd_barrier(const XcdBarrier& b) {
  asm volatile("s_waitcnt vmcnt(0)" ::: "memory");
  __syncthreads();
  if (threadIdx.x == 0) {
    unsigned* bar = b.bar;
    __builtin_amdgcn_s_waitcnt(0);
    unsigned nloc = b.st[0], nx = b.st[1];
    if (nloc == 0u) { xcd_barrier_complete(bar, b.x, nloc, nx); b.st[0] = nloc; b.st[1] = nx; }
    const unsigned old = xb_add(&bar[XB_XSUB(b.x)], 1u);
    const unsigned gen = old / nloc;
    if (old + 1u == (gen + 1u) * nloc) {
      __builtin_amdgcn_fence(__ATOMIC_RELEASE, "agent");
      asm volatile("s_waitcnt vmcnt(0)" ::: "memory");
      const unsigned og = xb_add(&bar[XB_TOP], 1u);
      const unsigned tg = og / nx;
      if (og + 1u == (tg + 1u) * nx) xb_add(&bar[XB_TOPGEN], 1u);
      else XB_SPIN(xb_ld(&bar[XB_TOPGEN]) == tg, bar);
      __builtin_amdgcn_fence(__ATOMIC_ACQUIRE, "agent");
      xb_add(&bar[XB_XGEN(b.x)], 1u);
      asm volatile("s_waitcnt vmcnt(0)" ::: "memory");
    } else {
      XB_SPIN(xb_ld(&bar[XB_XGEN(b.x)]) == gen, bar);
      __builtin_amdgcn_fence(__ATOMIC_ACQUIRE, "agent");
      asm volatile("s_waitcnt vmcnt(0)" ::: "memory");
    }
  }
  __syncthreads();
}

#define GEMM_LDS 131072
#define DYN_LDS (GEMM_LDS + 16)
#define WS_BAR (WS_CNT + 4096ull)

#define RUN_GEMM(Aptr, LDA, Bptr, MM, NN, KK, GATE, EPI, CID) RUN_GEMM_G(Aptr, LDA, Bptr, MM, NN, KK, GATE, EPI, nb, CID)
#define RUN_GEMM_G(Aptr, LDA, Bptr, MM, NN, KK, GATE, EPI, GG, CID) RUN_GEMM_X(Aptr, LDA, (size_t)128, (size_t)0, Bptr, MM, NN, KK, GATE, EPI, GG, CID)
#define GM_KSTEP ((size_t)TOK * 128)
#define RUN_GEMM_X(Aptr, LDA, KSA, GST, Bptr, MM, NN, KK, GATE, EPI, GG, CID) do { pg8::Gemm g_{(const u16*)(Aptr), (const u16*)(Bptr), MM, NN, KK, LDA, GATE, p.flags, KSA, GST}; \
    pg8::StaticOrder S_; S_.init(MM, NN, GG, CID); pg8::gemm_phase((LAS unsigned char*)smem_raw, g_, S_, EPI); } while (0)
#define RUN_GEMM_RX(Aptr, LDA, KSA, GST, Bptr, MM, NN, KK, GATE, EPI, GG, CID, UBEG, UEND) do { pg8::Gemm g_{(const u16*)(Aptr), (const u16*)(Bptr), MM, NN, KK, LDA, GATE, p.flags, KSA, GST}; \
    pg8::StaticOrder S_; S_.init(MM, NN, GG, CID); S_.ubeg = UBEG; S_.uend = UEND; pg8::gemm_phase((LAS unsigned char*)smem_raw, g_, S_, EPI); } while (0)
#define RUN_GEMM_R(Aptr, LDA, Bptr, MM, NN, KK, EPI, GG, CID, UBEG, UEND) do { pg8::Gemm g_{(const u16*)(Aptr), (const u16*)(Bptr), MM, NN, KK, LDA, 0, p.flags, (size_t)128, (size_t)0}; \
    pg8::StaticOrder S_; S_.init(MM, NN, GG, CID); S_.ubeg = UBEG; S_.uend = UEND; pg8::gemm_phase((LAS unsigned char*)smem_raw, g_, S_, EPI); } while (0)

__global__ void __launch_bounds__(NT, 2) mega(Params p) {
  extern __shared__ __attribute__((aligned(16))) unsigned char smem_raw[];
  const int bid = blockIdx.x, nb = gridDim.x;
  unsigned char* ws = p.ws;
  const float* mod = (const float*)(ws + WS_MOD);
  volatile LAS unsigned* xst = (volatile LAS unsigned*)((LAS unsigned char*)smem_raw + GEMM_LDS);
  XcdBarrier xb;
  if (p.phase_hi - p.phase_lo > 1) {
    if (threadIdx.x == 0) { xst[0] = 0u; xst[1] = 0u; }
    __syncthreads();
    xb = xcd_barrier_post((unsigned*)(ws + WS_BAR), xst);
  }
#define PH_BEGIN(n) if ((PHMASK & (1u << n)) && p.phase_lo <= n && n < p.phase_hi) { const int ph = n;
#define PH_FIN if (ph + 1 < p.phase_hi) { if (p.phase_lo < 0) cg::this_grid().sync(); else xcd_barrier(xb); } }
  PH_BEGIN(0) phase_prologue(p, smem_raw, bid, nb); PH_FIN
  PH_BEGIN(1) phase_h0(p, bid, nb); PH_FIN
  PH_BEGIN(2) {
    EpiHgIn e{(u16*)(ws + WS_B(0)), (u16*)(ws + WS_B(1)), (u16*)(ws + WS_B(2)), (_Float16*)(ws + WS_B(3)), (const float*)(ws + WS_LB)};
    RUN_GEMM(ws + WS_H, 1024, ws + WS_W_HG_IN, TOK, (nb == 256 ? 4096 : 5120), 1024, 0, e, bid);
  } PH_FIN
  PH_BEGIN(3) {
    phase_gla(p, smem_raw);
    if (nb == 256) {
      __syncthreads();
      EpiSg eg{(u16*)(ws + WS_B(2))};
      RUN_GEMM_R(ws + WS_H, 1024, ws + WS_W_HG_IN + (size_t)4096 * 1024 * 2, TOK, 1024, 1024, eg, 256, bid >= 64 ? bid - 64 : (1 << 20), 0, 192);
    }
  } PH_FIN
  PH_BEGIN(4) phase_hg_post(p, bid, nb); PH_FIN
  PH_BEGIN(5) {
    EpiResLn<false, true> e{p.in[0], p.in[1], (const u16*)nullptr, p.out, (u16*)(ws + WS_XB), mod + 0 * 15360 + 2048, p.in[10] + 0 * 1024, p.in[11] + 0 * 1024, mod + 1 * 15360, (u16*)(ws + WS_H),
               (unsigned long long*)(ws + WS_SLOT) + 0 * 49152, (unsigned*)(ws + WS_CNT + 256) + 0 * 48};
    RUN_GEMM(ws + WS_B(0), 1024, ws + WS_W_HG_OUT, TOK, 1024, 1024, 0, e, bid);
    wconv_idle(p, smem_raw, bid, nb, 1536, 2816);
  } PH_FIN
  PH_BEGIN(7) {
    EpiScIn e{(u16*)(ws + WS_B(0)), (u16*)(ws + WS_B(1))};
    RUN_GEMM(ws + WS_H, 1024, ws + WS_W_SC_IN, TOK, 4096, 1024, 0, e, bid);
  } PH_FIN
  PH_BEGIN(8) phase_sc_conv(p, bid, nb); PH_FIN
  PH_BEGIN(9) {
    EpiResLn<true, true> e{p.out, p.out, (const u16*)(ws + WS_XB), p.out, (u16*)(ws + WS_XB), mod + 1 * 15360 + 2048, p.in[10] + 1 * 1024, p.in[11] + 1 * 1024, mod + 2 * 15360, (u16*)(ws + WS_H),
               (unsigned long long*)(ws + WS_SLOT) + 1 * 49152, (unsigned*)(ws + WS_CNT + 256) + 1 * 48};
    RUN_GEMM(ws + WS_B(2), 1024, ws + WS_W_SC_OUT, TOK, 1024, 1024, 0, e, bid);
    wconv_idle(p, smem_raw, bid, nb, 2816, 3840);
  } PH_FIN
  PH_BEGIN(11) {
    EpiRgIn e{(u16*)(ws + WS_B(0)), (u16*)(ws + WS_B(1))};
    if (nb == 256) {
      RUN_GEMM(ws + WS_H, 1024, ws + WS_W_RG_IN, TOK, 1024, 1024, 0, e, bid);
      EpiSgGM eg{(u16*)(ws + WS_B(1))};
      RUN_GEMM_R(ws + WS_H, 1024, ws + WS_W_RG_IN + (size_t)1024 * 1024 * 2, TOK, 1024, 1024, eg, 256, bid >= 192 ? bid - 192 : (1 << 20), 0, 64);
    } else {
      RUN_GEMM(ws + WS_H, 1024, ws + WS_W_RG_IN, TOK, 2048, 1024, 0, e, bid);
    }
  } PH_FIN
  PH_BEGIN(12) phase_rg_conv(p, bid, nb); PH_FIN
  PH_BEGIN(13) {
    EpiRgGate e{(u16*)(ws + WS_B(3)), (u16*)(ws + WS_B(5)), p.in[24]};
    if (nb == 256) {
      EpiSgGM eg{(u16*)(ws + WS_B(1))};
      RUN_GEMM_R(ws + WS_H, 1024, ws + WS_W_RG_IN + (size_t)1024 * 1024 * 2, TOK, 1024, 1024, eg, 256, bid < 128 ? bid : (1 << 20), 64, 192);
      RUN_GEMM_RX(ws + WS_B(2), 64, GM_KSTEP, 4 * GM_KSTEP, ws + WS_W_RG_GATE, TOK, 4096, 256, 1, e, 256, bid < 128 ? bid : (1 << 20), 0, 128);
      RUN_GEMM_RX(ws + WS_B(2), 64, GM_KSTEP, 4 * GM_KSTEP, ws + WS_W_RG_GATE, TOK, 4096, 256, 1, e, 128, bid >= 128 ? bid - 128 : (1 << 20), 128, 768);
    } else {
      RUN_GEMM_X(ws + WS_B(2), 64, GM_KSTEP, 4 * GM_KSTEP, ws + WS_W_RG_GATE, TOK, 4096, 256, 1, e, nb, bid);
    }
  } PH_FIN
  PH_BEGIN(14) phase_rg_scan(p, smem_raw, bid, nb); PH_FIN
  PH_BEGIN(15) {
    EpiResLn<true, true> e{p.out, p.out, (const u16*)(ws + WS_XB), p.out, (u16*)(ws + WS_XB), mod + 2 * 15360 + 2048, p.in[10] + 2 * 1024, p.in[11] + 2 * 1024, mod + 3 * 15360, (u16*)(ws + WS_H),
               (unsigned long long*)(ws + WS_SLOT) + 2 * 49152, (unsigned*)(ws + WS_CNT + 256) + 2 * 48};
    RUN_GEMM_X(ws + WS_B(0), 64, GM_KSTEP, (size_t)0, ws + WS_W_RG_OUT, TOK, 1024, 1024, 0, e, nb, bid);
    wconv_idle(p, smem_raw, bid, nb, 3840, 4800);
  } PH_FIN
  PH_BEGIN(17) {
    EpiMlaIn e{(u16*)(ws + WS3_CQ), (float*)(ws + WS3_CKVRAW), (float*)(ws + WS3_KPERAW), (u16*)(ws + WS3_SG)};
    RUN_GEMM(ws + WS_H, 1024, ws + WS_W_MLA_IN, TOK, 768, 1024, 0, e, bid);
    if (nb == 256) {
      EpiSg eg{(u16*)(ws + WS3_SG)};
      RUN_GEMM_R(ws + WS_H, 1024, ws + WS_W_MLA_IN + 672 * 1024 * 2, TOK, 1024, 1024, eg, 256, bid >= 144 ? bid - 144 : (1 << 20), 0, 112);
    }
  } PH_FIN
  PH_BEGIN(18) phase_mla_norm(p, bid, nb); PH_FIN
  PH_BEGIN(19) {
    const bool bal = (nb == 256);
    const int none = 1 << 20;
    EpiSg eg{(u16*)(ws + WS3_SG)};
    RUN_GEMM_R(ws + WS_H, 1024, ws + WS_W_MLA_IN + 672 * 1024 * 2, TOK, 1024, 1024, eg, nb, bid, bal ? 112 : 0, 192);
    EpiQ eq{(u16*)(ws + WS3_Q)};
    RUN_GEMM_G(ws + WS3_CQ, 384, ws + WS_W_QB, TOK, 1536, 384, 0, eq, bal ? 176 : nb, bal ? (bid >= 80 ? bid - 80 : none) : bid);
    EpiK ek{(u16*)(ws + WS3_K)};
    RUN_GEMM(ws + WS3_CKVALL, 256, ws + WS_W_KVB, KVROWS, 1024, 256, 0, ek, bid);
    EpiV ev{(u16*)(ws + WS3_VT)};
    RUN_GEMM_G(ws + WS_W_KVB + 1024 * 256 * 2, 256, ws + WS3_CKVALL, 1024, KVROWS, 256, 0, ev, bal ? 176 : nb, bal ? (bid >= 80 ? (bid + 160) % 176 : none) : bid);
  } PH_FIN
  PH_BEGIN(20) phase_attn(p, smem_raw, bid, nb); PH_FIN
  PH_BEGIN(21) {
    EpiResLn<true, false> e{p.out, p.out, (const u16*)(ws + WS_XB), p.out, (u16*)nullptr, mod + 3 * 15360 + 2048, p.in[10] + 3 * 1024, p.in[11] + 3 * 1024, mod + 3 * 15360, (u16*)nullptr,
               (unsigned long long*)(ws + WS_SLOT) + 3 * 49152, (unsigned*)(ws + WS_CNT + 256) + 3 * 48};
    RUN_GEMM(ws + WS_H, 1024, ws + WS_W_MLA_OUT, TOK, 1024, 1024, 0, e, bid);
  } PH_FIN
}

extern "C" void kernel_launch(void* const* d_in, const int* in_sizes, int n_in, void* d_out, int out_size, void* d_ws, size_t ws_size,
                              hipStream_t stream) {
  static int grid_blocks = 0;
  if (!grid_blocks) {
    int dev = 0, cus = 0, per_cu = 0;
    (void)hipGetDevice(&dev);
    (void)hipDeviceGetAttribute(&cus, hipDeviceAttributeMultiprocessorCount, dev);
    (void)hipFuncSetAttribute((const void*)mega, hipFuncAttributeMaxDynamicSharedMemorySize, DYN_LDS);
    (void)hipOccupancyMaxActiveBlocksPerMultiprocessor(&per_cu, (const void*)mega, NT, DYN_LDS);
    if (per_cu < 1) per_cu = 1;
    if (per_cu > 1) per_cu = 1;
    grid_blocks = cus * per_cu;
  }
  Params p{};
  for (int i = 0; i < 33; ++i) p.in[i] = (const float*)d_in[i];
  p.out = (float*)d_out;
  p.ws = (unsigned char*)d_ws;
#if MULTI_LAUNCH
  (void)hipMemsetAsync((unsigned char*)d_ws + WS_CNT, 0, 4096 + XCD_BAR_WORDS * 4, stream);
  for (int ph = 0; ph < NPHASES; ++ph) {
    p.phase_lo = ph; p.phase_hi = ph + 1;
    hipLaunchKernelGGL(mega, dim3(grid_blocks), dim3(NT), DYN_LDS, stream, p);
#ifdef PROBE_MASK
    if ((PROBE_MASK >> ph) & 1) { p.flags = PROBE_FLAGS; for (int r = 0; r < 2; ++r) {
      if (ph == 3) (void)hipMemsetAsync((unsigned char*)d_ws + WS_CNT, 0, 64, stream);
      hipLaunchKernelGGL(mega, dim3(grid_blocks), dim3(NT), DYN_LDS, stream, p);
    } p.flags = 0; }
#endif
  }
#else
  p.phase_lo = 0; p.phase_hi = NPHASES;
  (void)hipMemsetAsync((unsigned char*)d_ws + WS_CNT, 0, 4096 + XCD_BAR_WORDS * 4, stream);
  void* args[] = {&p};
  hipError_t e = hipLaunchCooperativeKernel((const void*)mega, dim3(grid_blocks), dim3(NT), args, DYN_LDS, stream);
  if (e != hipSuccess) fprintf(stderr, "cooperative launch failed: %s (grid %d)\n", hipGetErrorString(e), grid_blocks);
#endif
}
```

```cpp
#include <hip/hip_runtime.h>
#include <hip/hip_cooperative_groups.h>
#include <cstdio>
namespace cg = cooperative_groups;

#ifndef MULTI_LAUNCH
#define MULTI_LAUNCH 0
#endif

typedef unsigned short u16;
using bf16x8 = __attribute__((ext_vector_type(8))) short;
using f32x4 = __attribute__((ext_vector_type(4))) float;
typedef _Float16 h4 __attribute__((ext_vector_type(4)));

#define TOK 12288
#define NPROMPT 8192
#define KVROWS 14336
#define NPHASES 23
#ifndef PHMASK
#define PHMASK 0x7fffff
#endif
#define DN_ALPHA 1.6817928305074290f

#define WS_W_HG_IN 0ull
#define WS_W_HG_OUT (WS_W_HG_IN + 10485760ull)
#define WS_W_SC_IN (WS_W_HG_OUT + 2097152ull)
#define WS_W_SC_OUT (WS_W_SC_IN + 8388608ull)
#define WS_W_RG_IN (WS_W_SC_OUT + 2097152ull)
#define WS_W_RG_GATE (WS_W_RG_IN + 4194304ull)
#define WS_W_RG_OUT (WS_W_RG_GATE + 2097152ull)
#define WS_W_MLA_IN (WS_W_RG_OUT + 2097152ull)
#define WS_W_QB (WS_W_MLA_IN + 3670016ull)
#define WS_W_KVB (WS_W_QB + 1179648ull)
#define WS_W_MLA_OUT (WS_W_KVB + 1048576ull)
#define WS_MOD (WS_W_MLA_OUT + 2097152ull)
#define WS_LB (WS_MOD + 245760ull)
#define WS_CNT (WS_LB + 8192ull)
#define WS_R (WS_CNT + 4096ull + 16384ull)
#define BSZ 25165824ull
#define WS_H (WS_R)
#define WS_B(i) (WS_R + BSZ * (1 + (i)))
#define WS_SLOT (WS_R + 201326592ull)
#define WS_XB (WS_SLOT + 1572864ull)
#define WS3_CQ (WS_R + 25165824ull)
#define WS3_CKVALL (WS_R + 34603008ull)
#define WS3_CKVRAW (WS_R + 41943040ull)
#define WS3_KPERAW (WS_R + 54525952ull)
#define WS3_SG (WS_R + 56098816ull)
#define WS3_Q (WS_R + 81264640ull)
#define WS3_K (WS_R + 119013376ull)
#define WS3_VT (WS_R + 163053568ull)

#define OUT_HG 12582912
#define OUT_RG 20971520
#define OUT_CKV 21037056
#define OUT_KPE 23134208

struct Params {
  const float* in[33];
  float* out;
  unsigned char* ws;
  int phase_lo, phase_hi, flags, pad_;
};

__device__ __forceinline__ u16 f2bf(float f) { __bf16 r = (__bf16)f; return *(u16*)&r; }
__device__ __forceinline__ float bf2f(u16 h) { return __uint_as_float(((unsigned)h) << 16); }
typedef float f2v_ __attribute__((ext_vector_type(2)));
typedef __bf16 b2v_ __attribute__((ext_vector_type(2)));
__device__ __forceinline__ unsigned pack2(float a, float b) { f2v_ f = {a, b}; b2v_ r = __builtin_convertvector(f, b2v_); return *(unsigned*)&r; }
__device__ __forceinline__ uint2 pack4(float a, float b, float c, float d) { return make_uint2(pack2(a, b), pack2(c, d)); }
__device__ __forceinline__ float lo16(unsigned u) { return __uint_as_float(u << 16); }
__device__ __forceinline__ float hi16(unsigned u) { return __uint_as_float(u & 0xffff0000u); }
__device__ __forceinline__ float sigmoidf_(float x) { return __builtin_amdgcn_rcpf(1.0f + __expf(-x)); }
__device__ __forceinline__ float siluf_(float x) { return x * __builtin_amdgcn_rcpf(1.0f + __expf(-x)); }
__device__ __forceinline__ int cond_of(int tok) { return tok < NPROMPT ? 0 : 1 + ((tok - NPROMPT) >> 10); }
__device__ __forceinline__ float wave_sum(float v) {
#pragma unroll
  for (int o = 32; o > 0; o >>= 1) v += __shfl_xor(v, o);
  return v;
}
__device__ __forceinline__ void rope_sincos(float pos, int fi, float& sn, float& cs) {
  float inv = exp2f(-(float)fi * 1.6609640474436813f);
  float ang = pos * inv;
  float k = rintf(ang * 0.15915494309189535f);
  float r = fmaf(-k, 6.2831854820251465f, ang);
  r = fmaf(-k, -1.7484555e-7f, r);
  sn = __sinf(r); cs = __cosf(r);
}

#define NT 512
#define NW 8
#define LAS __attribute__((address_space(3)))

namespace pg8 {
constexpr int BM = 256, BK = 64, HALF = 128, HTB = HALF * BK * 2, STAGE_BYTES = 8 * HTB, NXCD = 8, WGM = 8;
__device__ __forceinline__ int lds_byte(int r, int c) { const int st = (r >> 4) * 2 + (c >> 5), rr = r & 15, cc = c & 31, ob = rr * 64 + cc * 2; return st * 1024 + (ob ^ (((ob >> 9) & 1) << 5)); }
__device__ __forceinline__ void stage_rc(int b, int& R, int& C) { const int st = b / 1024, sb = b % 1024, swz = sb ^ (((sb >> 9) & 1) << 5); R = (st >> 1) * 16 + swz / 64; C = (st & 1) * 32 + (swz % 64) / 2; }
struct Unit { int pm, pn; };
struct Gemm { const u16* A; const u16* Bt; int M, N, K, lda, gate, noepi; size_t kstepA, gstride; };
struct StaticOrder {
  int nM, nN, nwg, G, c, ubeg, uend;
  __device__ void init(int M, int N, int G_, int c_) { nM = M / BM; nN = N / BM; nwg = nM * nN; G = G_; c = c_; ubeg = 0; uend = nwg; }
  __device__ bool next(int i, Unit& u) const {
    const long L = (long)ubeg + (long)i * G + c; if (L >= uend) return false;
    int wgid = (int)L; { const int q = nwg / NXCD, r = nwg % NXCD, xcd = wgid % NXCD, off = wgid / NXCD; wgid = (xcd < r ? xcd * (q + 1) : r * (q + 1) + (xcd - r) * q) + off; }
    const int nig = WGM * nN, gid = wgid / nig, fm = gid * WGM, gsz = (nM - fm) < WGM ? (nM - fm) : WGM;
    u.pm = fm + ((wgid % nig) % gsz); u.pn = (wgid % nig) / gsz; return true;
  }
};
template <class Epi>
__device__ __forceinline__ void gemm_phase(LAS unsigned char* lds, const Gemm g, const StaticOrder& S, const Epi& E) {
  const int tid = threadIdx.x, wid = __builtin_amdgcn_readfirstlane(tid >> 6), lane = tid & 63, wr = wid >> 2, wc = wid & 3, fr = lane & 15, fq = lane >> 4;
  const int K = g.K, nt = K / BK;
  unsigned voffA[2], voffB[2];
#pragma unroll
  for (int i = 0; i < 2; ++i) { int R, C; stage_rc(tid * 16 + i * 8192, R, C); voffA[i] = (unsigned)(R * g.lda + C) * 2u; voffB[i] = (unsigned)(R * K + C) * 2u; }
  const size_t kstep = (size_t)(BK * 2);
  const size_t kstepA = g.kstepA;
  const size_t hstepA = (size_t)HALF * g.lda * 2, hstepB = (size_t)HALF * K * 2;
  const size_t tstepA = 2 * hstepA, tstepB = 2 * hstepB;
  const unsigned ldsw = (unsigned)wid * 1024u;
  const int aoff = lds_byte(wr * 64 + fr, fq * 8), boff = lds_byte(wc * 32 + fr, fq * 8);
#define PG8_AOFF(pn) (g.gate ? (size_t)(((pn) >> 1) & 3) * g.gstride : (size_t)0)
#define PG8_SA(b, h) (((b) * 2 + (h)) * HTB)
#define PG8_SB(b, h) ((4 + (b) * 2 + (h)) * HTB)
#define PG8_STAGE(bufoff, gbase, voff) do { _Pragma("unroll") for (int _i = 0; _i < 2; ++_i) \
    __builtin_amdgcn_global_load_lds((const unsigned*)((const char*)(gbase) + (voff)[_i]), (LAS unsigned*)(lds + (bufoff) + ldsw + _i * 8192), 16, 0, 0); } while (0)
#define PG8_LDA(dst, b, h) do { _Pragma("unroll") for (int m = 0; m < 4; ++m) _Pragma("unroll") for (int k = 0; k < 2; ++k) dst[m][k] = *(const LAS bf16x8*)(lds + PG8_SA(b, h) + aoff + m * 2048 + k * 1024); } while (0)
#define PG8_LDB(dst, b, h) do { _Pragma("unroll") for (int n = 0; n < 2; ++n) _Pragma("unroll") for (int k = 0; k < 2; ++k) dst[n][k] = *(const LAS bf16x8*)(lds + PG8_SB(b, h) + boff + n * 2048 + k * 1024); } while (0)
#define PG8_MMA(ai, bj, At, Bt) do { __builtin_amdgcn_s_setprio(1); _Pragma("unroll") for (int m = 0; m < 4; ++m) _Pragma("unroll") for (int n = 0; n < 2; ++n) _Pragma("unroll") for (int k = 0; k < 2; ++k) \
    acc[ai][bj][m][n] = __builtin_amdgcn_mfma_f32_16x16x32_bf16(Bt[n][k], At[m][k], acc[ai][bj][m][n], 0, 0, 0); __builtin_amdgcn_s_setprio(0); } while (0)
#define PG8_WAIT_V(n) asm volatile("s_waitcnt vmcnt(" #n ")" ::: "memory")
#define PG8_WAIT_L(n) asm volatile("s_waitcnt lgkmcnt(" #n ")" ::: "memory")
#define PG8_BAR __builtin_amdgcn_s_barrier()
#define PG8_SCHED __builtin_amdgcn_sched_barrier(0)
  Unit cur, nxt; int ui = 0;
  if (!S.next(0, cur)) return;
  f32x4 acc[2][2][4][2];
#pragma unroll
  for (int a = 0; a < 2; ++a)
#pragma unroll
    for (int b = 0; b < 2; ++b)
#pragma unroll
      for (int m = 0; m < 4; ++m)
#pragma unroll
        for (int n = 0; n < 2; ++n) acc[a][b][m][n] = (f32x4){0.f, 0.f, 0.f, 0.f};
  bf16x8 At[4][2], B0[2][2], B1[2][2];
  const char* cA = (const char*)g.A + (size_t)cur.pm * tstepA + PG8_AOFF(cur.pn); const char* cB = (const char*)g.Bt + (size_t)cur.pn * tstepB;
  PG8_STAGE(PG8_SB(0, 0), cB, voffB); PG8_STAGE(PG8_SA(0, 0), cA, voffA); PG8_STAGE(PG8_SB(0, 1), cB + hstepB, voffB); PG8_STAGE(PG8_SA(0, 1), cA + hstepA, voffA);
  if (wr == 1) PG8_BAR;
  PG8_WAIT_V(4); PG8_BAR;
  PG8_STAGE(PG8_SB(1, 0), cB + kstep, voffB); PG8_STAGE(PG8_SA(1, 0), cA + kstepA, voffA); PG8_STAGE(PG8_SB(1, 1), cB + hstepB + kstep, voffB);
  PG8_WAIT_V(6); PG8_BAR;
  for (;;) {
    const bool has_next = S.next(ui + 1, nxt);
    const char* nA = has_next ? (const char*)g.A + (size_t)nxt.pm * tstepA + PG8_AOFF(nxt.pn) : cA; const char* nB = has_next ? (const char*)g.Bt + (size_t)nxt.pn * tstepB : cB;
#pragma unroll 1
    for (int t = 0; t < nt; t += 2) {
      const bool last = (t == nt - 2);
      const char* a1 = cA + (size_t)(t + 1) * kstepA;
      const char* a2 = last ? nA : cA + (size_t)(t + 2) * kstepA; const char* b2 = last ? nB : cB + (size_t)(t + 2) * kstep;
      const char* a3 = a2 + kstepA; const char* b3 = b2 + kstep;
      PG8_LDB(B0, 0, 0); PG8_SCHED; PG8_LDA(At, 0, 0); PG8_STAGE(PG8_SA(1, 1), a1 + hstepA, voffA);
      PG8_WAIT_L(8); PG8_BAR; PG8_WAIT_L(0); PG8_MMA(0, 0, At, B0); PG8_BAR; PG8_SCHED;
      PG8_LDB(B1, 0, 1); PG8_STAGE(PG8_SB(0, 0), b2, voffB);
      PG8_BAR; PG8_WAIT_L(0); PG8_MMA(0, 1, At, B1); PG8_BAR;
      PG8_LDA(At, 0, 1); PG8_STAGE(PG8_SA(0, 0), a2, voffA);
      PG8_BAR; PG8_WAIT_L(0); PG8_MMA(1, 0, At, B0); PG8_BAR; PG8_SCHED;
      PG8_STAGE(PG8_SB(0, 1), b2 + hstepB, voffB);
      PG8_WAIT_V(6); PG8_BAR; PG8_MMA(1, 1, At, B1); PG8_BAR;
      PG8_LDB(B0, 1, 0); PG8_SCHED; PG8_LDA(At, 1, 0); PG8_STAGE(PG8_SA(0, 1), a2 + hstepA, voffA);
      PG8_WAIT_L(8); PG8_BAR; PG8_WAIT_L(0); PG8_MMA(0, 0, At, B0); PG8_BAR; PG8_SCHED;
      PG8_LDB(B1, 1, 1); PG8_STAGE(PG8_SB(1, 0), b3, voffB);
      PG8_BAR; PG8_WAIT_L(0); PG8_MMA(0, 1, At, B1); PG8_BAR;
      PG8_LDA(At, 1, 1); PG8_STAGE(PG8_SA(1, 0), a3, voffA);
      PG8_BAR; PG8_WAIT_L(0); PG8_MMA(1, 0, At, B0); PG8_BAR; PG8_SCHED;
      PG8_STAGE(PG8_SB(1, 1), b3 + hstepB, voffB);
      PG8_WAIT_V(6); PG8_BAR; PG8_MMA(1, 1, At, B1); PG8_BAR;
    }
    if constexpr (!Epi::AFTER_DRAIN) { if (!g.noepi) E(acc, cur, wr, wc, fr, fq); }
    if (!has_next) break;
#pragma unroll
    for (int a = 0; a < 2; ++a)
#pragma unroll
      for (int b = 0; b < 2; ++b)
#pragma unroll
        for (int m = 0; m < 4; ++m)
#pragma unroll
          for (int n = 0; n < 2; ++n) acc[a][b][m][n] = (f32x4){0.f, 0.f, 0.f, 0.f};
    cur = nxt; cA = nA; cB = nB; ++ui;
  }
  PG8_WAIT_V(0);
  if (wr == 0) PG8_BAR;
  PG8_BAR;
  if constexpr (Epi::AFTER_DRAIN) { if (!g.noepi) E.fused(acc, cur, wr, wc, fr, fq, lds); }
#undef PG8_AOFF
#undef PG8_SA
#undef PG8_SB
#undef PG8_STAGE
#undef PG8_LDA
#undef PG8_LDB
#undef PG8_MMA
#undef PG8_WAIT_V
#undef PG8_WAIT_L
#undef PG8_BAR
#undef PG8_SCHED
}
}
using pg8::Unit;
typedef const f32x4 (&AccRef)[2][2][4][2];

#define EPI_ROWS(...) _Pragma("unroll") for (int ai = 0; ai < 2; ++ai) _Pragma("unroll") for (int m = 0; m < 4; ++m) { const int row = u.pm * 256 + ai * 128 + wr * 64 + m * 16 + fr; __VA_ARGS__ }
#define EPI_COLS(...) _Pragma("unroll") for (int bj = 0; bj < 2; ++bj) _Pragma("unroll") for (int n = 0; n < 2; ++n) { const int cb = u.pn * 256 + bj * 128 + wc * 32 + n * 16; const f32x4 a = acc[ai][bj][m][n]; __VA_ARGS__ }

struct EpiHgIn {
  static constexpr bool AFTER_DRAIN = false;
  u16 *q, *v, *sg; _Float16* lf; const float* lb;
  __device__ __forceinline__ void operator()(AccRef acc, const Unit& u, int wr, int wc, int fr, int fq) const {
    const int region = u.pn >> 2;
    f32x4 l4[2][2];
    if (region == 1 || region == 2) {
#pragma unroll
      for (int bj = 0; bj < 2; ++bj)
#pragma unroll
        for (int n = 0; n < 2; ++n) l4[bj][n] = *(const f32x4*)&lb[(region - 1) * 1024 + ((u.pn * 256 + bj * 128 + wc * 32 + n * 16) & 1023) + fq * 4];
    }
    EPI_ROWS( EPI_COLS(
      const int c = (cb & 1023) + fq * 4;
      if (region == 0) {
        const float s = 0.08838834764831845f;
        *(uint2*)&q[(size_t)row * 1024 + c] = pack4(siluf_(a[0]) * s, siluf_(a[1]) * s, siluf_(a[2]) * s, siluf_(a[3]) * s);
      } else if (region <= 2) {
        const int d = region - 1;
        h4 o;
        _Pragma("unroll") for (int j = 0; j < 4; ++j) { float f = l4[bj][n][j] + (1.0f - l4[bj][n][j]) * sigmoidf_(a[j]); o[j] = (_Float16)__builtin_amdgcn_logf(f); }
        *(h4*)&lf[(size_t)row * 2048 + d * 1024 + c] = o;
      } else if (region == 3) {
        *(uint2*)&v[(size_t)row * 1024 + c] = pack4(a[0], a[1], a[2], a[3]);
      } else {
        *(uint2*)&sg[(size_t)row * 1024 + c] = pack4(a[0], a[1], a[2], a[3]);
      }
    ) )
  }
};

struct EpiRes {
  static constexpr bool AFTER_DRAIN = false;
  const float* xin_p; const float* xin_s; float* Y; const float* gate;
  __device__ __forceinline__ void operator()(AccRef acc, const Unit& u, int wr, int wc, int fr, int fq) const {
    EPI_ROWS(
      const float* xr = row < NPROMPT ? xin_p + (size_t)row * 1024 : xin_s + (size_t)(row - NPROMPT) * 1024;
      const float* g = gate + cond_of(row) * 3072;
      EPI_COLS(
        const int c = cb + fq * 4;
        f32x4 x = *(const f32x4*)&xr[c];
        f32x4 gg = *(const f32x4*)&g[c];
        f32x4 y;
        _Pragma("unroll") for (int j = 0; j < 4; ++j) y[j] = DN_ALPHA * x[j] + gg[j] * a[j];
        *(f32x4*)&Y[(size_t)row * 1024 + c] = y;
      ) )
  }
};

template <bool XIN_BF, bool XOUT_BF>
struct EpiResLn {
  static constexpr bool AFTER_DRAIN = true;
  const float* xin_p; const float* xin_s; const u16* xin_b; float* X; u16* XB; const float* gate; const float* lg; const float* lbias; const float* modn; u16* H;
  unsigned long long* slots; unsigned* cnt;
  __device__ __forceinline__ void fused(f32x4 (&acc)[2][2][4][2], const Unit& u, int wr, int wc, int fr, int fq, LAS unsigned char* lds) const {
    LAS float* part = (LAS float*)lds;
    LAS float* stat = part + 2048;
    const int tid = threadIdx.x;
    const int cnd = cond_of(u.pm * 256);
    f32x4 gv[2][2];
#pragma unroll
    for (int bj = 0; bj < 2; ++bj)
#pragma unroll
      for (int n = 0; n < 2; ++n) gv[bj][n] = *(const f32x4*)&gate[cnd * 3072 + u.pn * 256 + bj * 128 + wc * 32 + n * 16 + fq * 4];
#pragma unroll
    for (int ai = 0; ai < 2; ++ai)
#pragma unroll
      for (int m = 0; m < 4; ++m) {
        const int rl = ai * 128 + wr * 64 + m * 16 + fr;
        const int row = u.pm * 256 + rl;
        const float* xr = row < NPROMPT ? xin_p + (size_t)row * 1024 : xin_s + (size_t)(row - NPROMPT) * 1024;
        float s1 = 0.f, s2 = 0.f;
#pragma unroll
        for (int bj = 0; bj < 2; ++bj)
#pragma unroll
          for (int n = 0; n < 2; ++n) {
            const int c = u.pn * 256 + bj * 128 + wc * 32 + n * 16 + fq * 4;
            f32x4 x;
            if constexpr (XIN_BF) { const uint2 xb2 = *(const uint2*)&xin_b[(size_t)row * 1024 + c]; x = f32x4{lo16(xb2.x), hi16(xb2.x), lo16(xb2.y), hi16(xb2.y)}; }
            else x = *(const f32x4*)&xr[c];
            const f32x4 gg = gv[bj][n];
            f32x4 y;
#pragma unroll
            for (int j = 0; j < 4; ++j) { y[j] = DN_ALPHA * x[j] + gg[j] * acc[ai][bj][m][n][j]; s1 += y[j]; s2 += y[j] * y[j]; }
            acc[ai][bj][m][n] = y;
          }
        s1 += __shfl_xor(s1, 16); s1 += __shfl_xor(s1, 32);
        s2 += __shfl_xor(s2, 16); s2 += __shfl_xor(s2, 32);
        if (fq == 0) { part[(rl * 4 + wc) * 2] = s1; part[(rl * 4 + wc) * 2 + 1] = s2; }
      }
    __syncthreads();
    if (tid < 256) {
      float S1 = 0.f, S2 = 0.f;
#pragma unroll
      for (int w2 = 0; w2 < 4; ++w2) { S1 += part[(tid * 4 + w2) * 2]; S2 += part[(tid * 4 + w2) * 2 + 1]; }
      const unsigned long long v = (unsigned long long)__float_as_uint(S1) | ((unsigned long long)__float_as_uint(S2) << 32);
      __hip_atomic_store(&slots[(size_t)(u.pm * 4 + u.pn) * 256 + tid], v, __ATOMIC_RELAXED, __HIP_MEMORY_SCOPE_AGENT);
    }
    asm volatile("s_waitcnt vmcnt(0)" ::: "memory");
    __syncthreads();
    if (tid == 0) {
      __hip_atomic_fetch_add(&cnt[u.pm], 1u, __ATOMIC_RELAXED, __HIP_MEMORY_SCOPE_AGENT);
      unsigned sp = 0;
      while (__hip_atomic_load(&cnt[u.pm], __ATOMIC_RELAXED, __HIP_MEMORY_SCOPE_AGENT) < 4u) { __builtin_amdgcn_s_sleep(1); if (++sp > (1u << 24)) break; }
    }
    __syncthreads();
    if (tid < 256) {
      float T1 = 0.f, T2 = 0.f;
#pragma unroll
      for (int o = 0; o < 4; ++o) {
        const unsigned long long v = __hip_atomic_load(&slots[(size_t)(u.pm * 4 + o) * 256 + tid], __ATOMIC_RELAXED, __HIP_MEMORY_SCOPE_AGENT);
        T1 += __uint_as_float((unsigned)(v & 0xffffffffull)); T2 += __uint_as_float((unsigned)(v >> 32));
      }
      const float mu = T1 * (1.0f / 1024.0f);
      const float var = fmaxf(T2 * (1.0f / 1024.0f) - mu * mu, 0.f);
      stat[tid * 2] = mu; stat[tid * 2 + 1] = rsqrtf(var + 1e-5f);
    }
    __syncthreads();
#pragma unroll
    for (int bj = 0; bj < 2; ++bj) {
      f32x4 lgv[2], lbv[2], shv[2], scv[2];
#pragma unroll
      for (int n = 0; n < 2; ++n) {
        const int c = u.pn * 256 + bj * 128 + wc * 32 + n * 16 + fq * 4;
        lgv[n] = *(const f32x4*)&lg[c]; lbv[n] = *(const f32x4*)&lbias[c];
        shv[n] = *(const f32x4*)&modn[cnd * 3072 + c]; scv[n] = *(const f32x4*)&modn[cnd * 3072 + 1024 + c];
      }
#pragma unroll
      for (int ai = 0; ai < 2; ++ai)
#pragma unroll
        for (int m = 0; m < 4; ++m) {
          const int rl = ai * 128 + wr * 64 + m * 16 + fr;
          const int row = u.pm * 256 + rl;
          const float mu = stat[rl * 2], rs = stat[rl * 2 + 1];
#pragma unroll
          for (int n = 0; n < 2; ++n) {
            const int c = u.pn * 256 + bj * 128 + wc * 32 + n * 16 + fq * 4;
            const f32x4 y = acc[ai][bj][m][n];
            f32x4 xo;
#pragma unroll
            for (int j = 0; j < 4; ++j) xo[j] = (y[j] - mu) * rs * lgv[n][j] + lbv[n][j];
            if constexpr (XOUT_BF) *(uint2*)&XB[(size_t)row * 1024 + c] = pack4(xo[0], xo[1], xo[2], xo[3]);
            else *(f32x4*)&X[(size_t)row * 1024 + c] = xo;
            if (H) {
              *(uint2*)&H[(size_t)row * 1024 + c] = pack4(xo[0] * (1 + scv[n][0]) + shv[n][0], xo[1] * (1 + scv[n][1]) + shv[n][1], xo[2] * (1 + scv[n][2]) + shv[n][2], xo[3] * (1 + scv[n][3]) + shv[n][3]);
            }
          }
        }
    }
  }
};

struct EpiScIn {
  static constexpr bool AFTER_DRAIN = false;
  u16 *pb, *sb;
  __device__ __forceinline__ void operator()(AccRef acc, const Unit& u, int wr, int wc, int fr, int fq) const {
    const int c = u.pn * 64 + wc * 16 + fq * 4;
    EPI_ROWS(
      const f32x4 bg = acc[ai][0][m][0], cgv = acc[ai][0][m][1], v = acc[ai][1][m][0], g = acc[ai][1][m][1];
      *(uint2*)&pb[(size_t)row * 1024 + c] = pack4(cgv[0] * v[0], cgv[1] * v[1], cgv[2] * v[2], cgv[3] * v[3]);
      *(uint2*)&sb[(size_t)row * 1024 + c] = pack4(siluf_(g[0]) * bg[0], siluf_(g[1]) * bg[1], siluf_(g[2]) * bg[2], siluf_(g[3]) * bg[3]);
    )
  }
};

struct EpiRgIn {
  static constexpr bool AFTER_DRAIN = false;
  u16 *ub, *sg;
  __device__ __forceinline__ void operator()(AccRef acc, const Unit& u, int wr, int wc, int fr, int fq) const {
    const int region = u.pn >> 2;
    EPI_ROWS( EPI_COLS(
      const int c = (cb & 1023) + fq * 4;
      if (region == 0) *(uint2*)&ub[(size_t)row * 1024 + c] = pack4(a[0], a[1], a[2], a[3]);
      else *(uint2*)&sg[((size_t)(c >> 6) * TOK + row) * 64 + (c & 63)] = pack4(siluf_(a[0]), siluf_(a[1]), siluf_(a[2]), siluf_(a[3]));
    ) )
  }
};

struct EpiSgGM {
  static constexpr bool AFTER_DRAIN = false;
  u16* sg;
  __device__ __forceinline__ void operator()(AccRef acc, const Unit& u, int wr, int wc, int fr, int fq) const {
    EPI_ROWS( EPI_COLS(
      const int c = cb + fq * 4;
      *(uint2*)&sg[((size_t)(c >> 6) * TOK + row) * 64 + (c & 63)] = pack4(siluf_(a[0]), siluf_(a[1]), siluf_(a[2]), siluf_(a[3]));
    ) )
  }
};

struct EpiRgGate {
  static constexpr bool AFTER_DRAIN = false;
  u16 *rb, *ib; const float* bgate;
  __device__ __forceinline__ void operator()(AccRef acc, const Unit& u, int wr, int wc, int fr, int fq) const {
    const int mat = u.pn >> 1, d = mat >> 2, hd = mat & 3;
    f32x4 br[2], bi[2]; int ccs[2];
#pragma unroll
    for (int bj = 0; bj < 2; ++bj) {
      const int off = ((u.pn & 1) * 256 + bj * 128 + wc * 32);
      ccs[bj] = (off >> 5) * 16 + fq * 4;
      br[bj] = *(const f32x4*)&bgate[mat * 512 + ccs[bj]];
      bi[bj] = *(const f32x4*)&bgate[mat * 512 + 256 + ccs[bj]];
    }
    EPI_ROWS(
      _Pragma("unroll") for (int bj = 0; bj < 2; ++bj) {
        const f32x4 r = acc[ai][bj][m][0], ii = acc[ai][bj][m][1];
        const int cch = hd * 256 + ccs[bj];
        const size_t o = (size_t)d * TOK * 1024 + ((size_t)(cch >> 6) * TOK + row) * 64 + (cch & 63);
        *(uint2*)&rb[o] = pack4(sigmoidf_(r[0] + br[bj][0]), sigmoidf_(r[1] + br[bj][1]), sigmoidf_(r[2] + br[bj][2]), sigmoidf_(r[3] + br[bj][3]));
        *(uint2*)&ib[o] = pack4(sigmoidf_(ii[0] + bi[bj][0]), sigmoidf_(ii[1] + bi[bj][1]), sigmoidf_(ii[2] + bi[bj][2]), sigmoidf_(ii[3] + bi[bj][3]));
      } )
  }
};

struct EpiMlaIn {
  static constexpr bool AFTER_DRAIN = false;
  u16* cq; float* ckvraw; float* kperaw; u16* sg;
  __device__ __forceinline__ void operator()(AccRef acc, const Unit& u, int wr, int wc, int fr, int fq) const {
    EPI_ROWS( EPI_COLS(
      const int c = cb + fq * 4;
      if (cb < 384) *(uint2*)&cq[(size_t)row * 384 + c] = pack4(a[0], a[1], a[2], a[3]);
      else if (cb < 640) *(f32x4*)&ckvraw[(size_t)row * 256 + (c - 384)] = a;
      else if (cb < 672) *(f32x4*)&kperaw[(size_t)row * 32 + (c - 640)] = a;
    ) )
  }
};

struct EpiSg {
  static constexpr bool AFTER_DRAIN = false;
  u16* sg;
  __device__ __forceinline__ void operator()(AccRef acc, const Unit& u, int wr, int wc, int fr, int fq) const {
    EPI_ROWS( EPI_COLS(
      *(uint2*)&sg[(size_t)row * 1024 + cb + fq * 4] = pack4(a[0], a[1], a[2], a[3]);
    ) )
  }
};

struct EpiQ {
  static constexpr bool AFTER_DRAIN = false;
  u16* q;
  __device__ __forceinline__ void operator()(AccRef acc, const Unit& u, int wr, int wc, int fr, int fq) const {
    const float sc = 0.14724444500602648f;
    EPI_ROWS( EPI_COLS(
      *(uint2*)&q[(size_t)row * 1536 + cb + fq * 4] = pack4(a[0] * sc, a[1] * sc, a[2] * sc, a[3] * sc);
    ) )
  }
};

struct EpiK {
  static constexpr bool AFTER_DRAIN = false;
  u16* Kb;
  __device__ __forceinline__ void operator()(AccRef acc, const Unit& u, int wr, int wc, int fr, int fq) const {
    EPI_ROWS( EPI_COLS(
      const int h = cb >> 6, dd = (cb & 63) + fq * 4;
      *(uint2*)&Kb[((size_t)row * 16 + h) * 96 + dd] = pack4(a[0], a[1], a[2], a[3]);
    ) )
  }
};
struct EpiV {
  static constexpr bool AFTER_DRAIN = false;
  u16* Vt;
  __device__ __forceinline__ void operator()(AccRef acc, const Unit& u, int wr, int wc, int fr, int fq) const {
    EPI_ROWS( EPI_COLS(
      *(uint2*)&Vt[(size_t)row * KVROWS + cb + fq * 4] = pack4(a[0], a[1], a[2], a[3]);
    ) )
  }
};

__device__ __forceinline__ void wconv_tile(const float* __restrict__ src, int N, int K, u16* __restrict__ dst, int k0, int n0,
                                           int perm, int mat, float* tile) {
  const int tid = threadIdx.x;
  {
    const int r = tid >> 4, c4 = (tid & 15) * 4;
#pragma unroll
    for (int i = 0; i < 2; ++i) {
      const int k = r + i * 32;
      f32x4 v = f32x4{0.f, 0.f, 0.f, 0.f};
      if (n0 + c4 < N) v = *(const f32x4*)&src[(size_t)(k0 + k) * N + n0 + c4];
      tile[k * 65 + c4 + 0] = v[0]; tile[k * 65 + c4 + 1] = v[1]; tile[k * 65 + c4 + 2] = v[2]; tile[k * 65 + c4 + 3] = v[3];
    }
  }
  __syncthreads();
  {
    const int nl = tid >> 3, kq = (tid & 7) * 8;
    const int n = n0 + nl;
    int np = n;
    if (perm == 1) { const int part = n >> 10, c = n & 1023; np = (c >> 6) * 256 + (part >> 1) * 128 + ((c >> 4) & 3) * 32 + (part & 1) * 16 + (c & 15); }
    else if (perm == 2) { const int type = n >> 8, cc = n & 255; np = mat * 512 + (cc >> 4) * 32 + type * 16 + (cc & 15); }
    else if (perm == 3) { const int hh = n >> 7, dd = n & 127; np = (dd >= 64 ? 1024 : 0) + hh * 64 + (dd & 63); }
    if (n < N) {
      unsigned w[4];
#pragma unroll
      for (int i = 0; i < 4; ++i) w[i] = pack2(tile[(kq + 2 * i) * 65 + nl], tile[(kq + 2 * i + 1) * 65 + nl]);
      *(uint4*)&dst[(size_t)np * K + k0 + kq] = make_uint4(w[0], w[1], w[2], w[3]);
    }
  }
  __syncthreads();
}

__device__ __forceinline__ void wconv_item(const Params& p, int t, float* fs) {
  const float* src; u16* dst; int N, K, perm = 0, mat = 0, ntn;
  if (t < 1280) { src = p.in[12]; dst = (u16*)(p.ws + WS_W_HG_IN); N = 5120; K = 1024; }
  else if ((t -= 1280) < 256) { src = p.in[15]; dst = (u16*)(p.ws + WS_W_HG_OUT); N = 1024; K = 1024; }
  else if ((t -= 256) < 1024) { src = p.in[16]; dst = (u16*)(p.ws + WS_W_SC_IN); N = 4096; K = 1024; perm = 1; }
  else if ((t -= 1024) < 256) { src = p.in[19]; dst = (u16*)(p.ws + WS_W_SC_OUT); N = 1024; K = 1024; }
  else if ((t -= 256) < 512) { src = p.in[20]; dst = (u16*)(p.ws + WS_W_RG_IN); N = 2048; K = 1024; }
  else if ((t -= 512) < 256) { mat = t >> 5; t &= 31; src = p.in[23] + (size_t)mat * 256 * 512; dst = (u16*)(p.ws + WS_W_RG_GATE); N = 512; K = 256; perm = 2; }
  else if ((t -= 256) < 256) { src = p.in[26]; dst = (u16*)(p.ws + WS_W_RG_OUT); N = 1024; K = 1024; }
  else if ((t -= 256) < 432) { src = p.in[27]; dst = (u16*)(p.ws + WS_W_MLA_IN); N = 1696; K = 1024; }
  else if ((t -= 432) < 144) { src = p.in[30]; dst = (u16*)(p.ws + WS_W_QB); N = 1536; K = 384; }
  else if ((t -= 144) < 128) { src = p.in[31]; dst = (u16*)(p.ws + WS_W_KVB); N = 2048; K = 256; perm = 3; }
  else { t -= 128; src = p.in[32]; dst = (u16*)(p.ws + WS_W_MLA_OUT); N = 1024; K = 1024; }
  ntn = (N + 63) >> 6;
  const int kt = t / ntn, ntl = t - kt * ntn;
  wconv_tile(src, N, K, dst, kt * 64, ntl * 64, perm, mat, fs);
}
__device__ __forceinline__ void wconv_idle(const Params& p, unsigned char* smem_raw, int bid, int nb, int t0, int t1) {
  if (nb == 256 && bid >= 192) for (int t = t0 + (bid - 192); t < t1; t += 64) wconv_item(p, t, (float*)smem_raw);
}

__device__ __forceinline__ void phase_prologue(const Params& p, unsigned char* smem_raw, int bid, int nb) {
  float* fs = (float*)smem_raw;
  const int tid = threadIdx.x;
  const int NMOD = 192, NWT = (nb == 256) ? 1536 : 4800;
  for (int it = bid; it < NMOD + 1 + NWT; it += nb) {
    if (it < NMOD) {
      const int l = it / 48, n0 = (it % 48) * 64;
      float* scond = fs;
      float* sred = fs + 5120;
      for (int i = tid; i < 5120; i += NT) {
        const int ci = i >> 10, k = i & 1023;
        float cv = ci == 0 ? p.in[7][k] : p.in[6][(ci - 1) * 1024 + k];
        scond[i] = siluf_(cv);
      }
      __syncthreads();
      const int col = tid & 63, kg = tid >> 6;
      const float* w = p.in[8] + (size_t)l * 1024 * 3072 + n0 + col;
      float a0 = 0, a1 = 0, a2 = 0, a3 = 0, a4 = 0;
#pragma unroll 16
      for (int k = kg * 128; k < kg * 128 + 128; ++k) {
        float wv = w[(size_t)k * 3072];
        a0 += scond[k] * wv; a1 += scond[1024 + k] * wv; a2 += scond[2048 + k] * wv; a3 += scond[3072 + k] * wv; a4 += scond[4096 + k] * wv;
      }
      sred[(kg * 5 + 0) * 64 + col] = a0; sred[(kg * 5 + 1) * 64 + col] = a1; sred[(kg * 5 + 2) * 64 + col] = a2;
      sred[(kg * 5 + 3) * 64 + col] = a3; sred[(kg * 5 + 4) * 64 + col] = a4;
      __syncthreads();
      float* mod = (float*)(p.ws + WS_MOD);
      if (tid < 320) {
        const int ci = tid >> 6, cc = tid & 63;
        float s = 0;
#pragma unroll
        for (int g = 0; g < 8; ++g) s += sred[(g * 5 + ci) * 64 + cc];
        mod[(l * 5 + ci) * 3072 + n0 + cc] = s + p.in[9][l * 3072 + n0 + cc];
      }
      __syncthreads();
    } else if (it == NMOD) {
      float* lb = (float*)(p.ws + WS_LB);
      for (int i = tid; i < 2048; i += NT) {
        const int d = i >> 10, c = i & 1023;
        const float* lg = p.in[13] + d * 5 * 1024 + c;
        float m = lg[0];
        for (int j = 1; j < 5; ++j) m = fmaxf(m, lg[j * 1024]);
        float s = 0;
        for (int j = 0; j < 5; ++j) s += expf(lg[j * 1024] - m);
        lb[i] = expf(lg[0] - m) / s;
      }
      int* cnt = (int*)(p.ws + WS_CNT);
      if (tid < 16) cnt[tid] = 0;
    } else {
      wconv_item(p, it - NMOD - 1, fs);
    }
  }
}

__device__ __forceinline__ void phase_h0(const Params& p, int bid, int nb) {
  const float* mod = (const float*)(p.ws + WS_MOD);
  u16* H = (u16*)(p.ws + WS_H);
  const size_t total = (size_t)(TOK / 4) * 256;
  for (size_t i = (size_t)bid * NT + threadIdx.x; i < total; i += (size_t)nb * NT) {
    const int row = (int)(i >> 8) * 4, c = ((int)i & 255) * 4;
    const float* xr = row < NPROMPT ? p.in[0] + (size_t)row * 1024 : p.in[1] + (size_t)(row - NPROMPT) * 1024;
    const float* m = mod + cond_of(row) * 3072;
    f32x4 x[4];
#pragma unroll
    for (int t = 0; t < 4; ++t) x[t] = *(const f32x4*)&xr[t * 1024 + c];
    const f32x4 sh = *(const f32x4*)&m[c];
    const f32x4 sc = *(const f32x4*)&m[1024 + c];
#pragma unroll
    for (int t = 0; t < 4; ++t)
      *(uint2*)&H[(size_t)(row + t) * 1024 + c] = pack4(x[t][0] * (1 + sc[0]) + sh[0], x[t][1] * (1 + sc[1]) + sh[1], x[t][2] * (1 + sc[2]) + sh[2], x[t][3] * (1 + sc[3]) + sh[3]);
  }
}

__device__ __forceinline__ void phase_ln(const Params& p, int l, int bid, int nb) {
  float* X = p.out;
  const float* g = p.in[10] + l * 1024;
  const float* b = p.in[11] + l * 1024;
  const float* mod = (const float*)(p.ws + WS_MOD) + (l + 1) * 5 * 3072;
  u16* H = (u16*)(p.ws + WS_H);
  const int lane = threadIdx.x & 63, wave = threadIdx.x >> 6;
  for (int row = bid * NW + wave; row < TOK; row += nb * NW) {
    float* xr = X + (size_t)row * 1024;
    f32x4 v[4];
    float s = 0;
#pragma unroll
    for (int i = 0; i < 4; ++i) { v[i] = *(const f32x4*)&xr[i * 256 + lane * 4]; s += v[i][0] + v[i][1] + v[i][2] + v[i][3]; }
    const float mu = wave_sum(s) * (1.0f / 1024.0f);
    float q = 0;
#pragma unroll
    for (int i = 0; i < 4; ++i)
#pragma unroll
      for (int j = 0; j < 4; ++j) { float dd = v[i][j] - mu; q += dd * dd; }
    const float rs = rsqrtf(wave_sum(q) * (1.0f / 1024.0f) + 1e-5f);
    const float* m = mod + cond_of(row) * 3072;
#pragma unroll
    for (int i = 0; i < 4; ++i) {
      const int c = i * 256 + lane * 4;
      f32x4 gg = *(const f32x4*)&g[c], bb = *(const f32x4*)&b[c];
      f32x4 y;
#pragma unroll
      for (int j = 0; j < 4; ++j) y[j] = (v[i][j] - mu) * rs * gg[j] + bb[j];
      *(f32x4*)&xr[c] = y;
      if (l < 3) {
        f32x4 sh = *(const f32x4*)&m[c], sc = *(const f32x4*)&m[1024 + c];
        *(uint2*)&H[(size_t)row * 1024 + c] = pack4(y[0] * (1 + sc[0]) + sh[0], y[1] * (1 + sc[1]) + sh[1], y[2] * (1 + sc[2]) + sh[2], y[3] * (1 + sc[3]) + sh[3]);
      }
    }
  }
}

__device__ __forceinline__ void phase_gla(const Params& p, unsigned char* smem_raw) {
  u16* s_qrel = (u16*)smem_raw;
  u16* s_krel = s_qrel + 32 * 136;
  u16* s_qcum = s_krel + 32 * 136;
  u16* s_kdT = s_qcum + 32 * 136;
  u16* s_vT = s_kdT + 128 * 40;
  u16* s_att = s_vT + 128 * 40;
  u16* s_S = s_att + 32 * 40;
  float* s_dec = (float*)(s_S + 128 * 136);
  float* s_part = s_dec + 128;
  int* s_u = (int*)(s_part + 512);
  int* counter = (int*)(p.ws + WS_CNT);
  const u16* qg = (const u16*)(p.ws + WS_B(0));
  const u16* vg = (const u16*)(p.ws + WS_B(1));
  const _Float16* lfg = (const _Float16*)(p.ws + WS_B(3));
  u16* og = (u16*)(p.ws + WS_B(5));
  const int tid = threadIdx.x, lane = tid & 63, w = tid >> 6, fr = lane & 15, fq = lane >> 4;
  const int kk = tid & 127, th = tid >> 7;
  const int ti = w >> 2, vi = w & 3;
  const int wk = w & 3, wv = w >> 2;
  bool first = true;
  while (true) {
    if (tid == 0) *s_u = (first && blockIdx.x < 64) ? (int)blockIdx.x : 64 + atomicAdd(counter, 1);
    first = false;
    __syncthreads();
    const int u = *s_u;
    __syncthreads();
    if (u >= 576) break;
    int b, rem, start, N, sample;
    if (u < 64) { sample = 1; b = u >> 4; rem = u & 15; start = NPROMPT + b * 1024; N = 1024; }
    else { sample = 0; b = (u - 64) >> 4; rem = (u - 64) & 15; start = b * 256; N = 256; }
    const int h = rem >> 1, d = rem & 1;
    const int nc = N >> 5;
    f32x4 S[2][4];
#pragma unroll
    for (int mi = 0; mi < 2; ++mi)
#pragma unroll
      for (int ni = 0; ni < 4; ++ni) {
        f32x4 s4 = f32x4{0.f, 0.f, 0.f, 0.f};
        if (sample) {
          const float* s0 = p.in[2] + ((size_t)((b * 2 + d) * 8 + h)) * 16384;
#pragma unroll
          for (int j = 0; j < 4; ++j) s4[j] = s0[(wk * 32 + mi * 16 + fq * 4 + j) * 128 + wv * 64 + ni * 16 + fr];
        }
        S[mi][ni] = s4;
        *(uint2*)&s_S[(wv * 64 + ni * 16 + fr) * 136 + wk * 32 + mi * 16 + fq * 4] = pack4(s4[0], s4[1], s4[2], s4[3]);
      }
    _Float16 lfraw[8]; u16 qraw[8]; uint4 vraw;
#define GLA_LOAD(cc) do { _Pragma("unroll") for (int i = 0; i < 8; ++i) { const int tt = (cc) * 32 + th * 8 + i; const size_t tok = start + (d ? (N - 1 - tt) : tt); \
      lfraw[i] = lfg[tok * 2048 + d * 1024 + h * 128 + kk]; qraw[i] = qg[tok * 1024 + h * 128 + kk]; } \
      { const int tt = (cc) * 32 + (tid & 31); const size_t tok = start + (d ? (N - 1 - tt) : tt); vraw = *(const uint4*)&vg[tok * 1024 + h * 128 + (tid >> 5) * 8]; } } while (0)
    GLA_LOAD(0);
    for (int c = 0; c < nc; ++c) {
      {
        float lfv[8], qv[8];
#pragma unroll
        for (int i = 0; i < 8; ++i) { lfv[i] = (float)lfraw[i]; qv[i] = bf2f(qraw[i]); }
        const uint4 vv = vraw;
        if (c + 1 < nc) GLA_LOAD(c + 1);
        float run = 0;
        float cs[8];
#pragma unroll
        for (int i = 0; i < 8; ++i) { run += lfv[i]; cs[i] = run; }
        s_part[th * 128 + kk] = run;
        {
          const int s = tid & 31, v8 = (tid >> 5) * 8;
          const unsigned vw[4] = {vv.x, vv.y, vv.z, vv.w};
#pragma unroll
          for (int i = 0; i < 4; ++i) { s_vT[(v8 + 2 * i) * 40 + s] = (u16)(vw[i] & 0xffff); s_vT[(v8 + 2 * i + 1) * 40 + s] = (u16)(vw[i] >> 16); }
        }
        __syncthreads();
        const float p0 = s_part[kk], p1 = s_part[128 + kk], p2 = s_part[256 + kk], p3 = s_part[384 + kk];
        const float off = (th > 0 ? p0 : 0.f) + (th > 1 ? p1 : 0.f) + (th > 2 ? p2 : 0.f);
        const float ref = p0 + p1, total = p0 + p1 + p2 + p3;
        unsigned kd[4];
        const float eref = __builtin_amdgcn_exp2f(ref), etr = __builtin_amdgcn_exp2f(total - ref);
#pragma unroll
        for (int i = 0; i < 8; ++i) {
          const int t = th * 8 + i;
          const float cum = off + cs[i];
          const float kf = 1.0f - __builtin_amdgcn_exp2f(lfv[i]);
          const float e1 = __builtin_amdgcn_exp2f(cum - ref), e2 = __builtin_amdgcn_rcpf(e1);
          const float qe = qv[i] * e1, ke = kf * e2;
          s_qrel[t * 136 + kk] = f2bf(qe);
          s_krel[t * 136 + kk] = f2bf(ke);
          s_qcum[t * 136 + kk] = f2bf(qe * eref);
          const u16 kdv = f2bf(ke * etr);
          if (i & 1) kd[i >> 1] |= ((unsigned)kdv) << 16; else kd[i >> 1] = kdv;
        }
        *(uint4*)&s_kdT[kk * 40 + th * 8] = make_uint4(kd[0], kd[1], kd[2], kd[3]);
        if (th == 0) s_dec[kk] = eref * etr;
      }
      __syncthreads();
      f32x4 oacc[2] = {f32x4{0.f, 0.f, 0.f, 0.f}, f32x4{0.f, 0.f, 0.f, 0.f}};
      {
        f32x4 att = f32x4{0.f, 0.f, 0.f, 0.f};
        const int ati = w >> 1, asi = w & 1;
#pragma unroll
        for (int ks = 0; ks < 4; ++ks) {
          if (w < 4) {
            bf16x8 a = *(const bf16x8*)&s_qrel[(ati * 16 + fr) * 136 + ks * 32 + fq * 8];
            bf16x8 bb = *(const bf16x8*)&s_krel[(asi * 16 + fr) * 136 + ks * 32 + fq * 8];
            att = __builtin_amdgcn_mfma_f32_16x16x32_bf16(a, bb, att, 0, 0, 0);
          }
          bf16x8 a2 = *(const bf16x8*)&s_qcum[(ti * 16 + fr) * 136 + ks * 32 + fq * 8];
#pragma unroll
          for (int e = 0; e < 2; ++e) {
            bf16x8 b2 = *(const bf16x8*)&s_S[((vi * 2 + e) * 16 + fr) * 136 + ks * 32 + fq * 8];
            oacc[e] = __builtin_amdgcn_mfma_f32_16x16x32_bf16(b2, a2, oacc[e], 0, 0, 0);
          }
        }
        if (w < 4) {
#pragma unroll
          for (int j = 0; j < 4; ++j) {
            const int t = ati * 16 + fq * 4 + j, s = asi * 16 + fr;
            s_att[t * 40 + s] = (s <= t) ? f2bf(att[j]) : (u16)0;
          }
        }
      }
      __syncthreads();
      {
        bf16x8 a = *(const bf16x8*)&s_att[(ti * 16 + fr) * 40 + fq * 8];
        const int tt = c * 32 + ti * 16 + fr;
        const size_t tok = start + (d ? (N - 1 - tt) : tt);
#pragma unroll
        for (int e = 0; e < 2; ++e) {
          bf16x8 bb = *(const bf16x8*)&s_vT[((vi * 2 + e) * 16 + fr) * 40 + fq * 8];
          oacc[e] = __builtin_amdgcn_mfma_f32_16x16x32_bf16(bb, a, oacc[e], 0, 0, 0);
          *(uint2*)&og[((size_t)d * TOK + tok) * 1024 + h * 128 + (vi * 2 + e) * 16 + fq * 4] = pack4(oacc[e][0], oacc[e][1], oacc[e][2], oacc[e][3]);
        }
        bf16x8 vf[4];
#pragma unroll
        for (int ni = 0; ni < 4; ++ni) vf[ni] = *(const bf16x8*)&s_vT[(wv * 64 + ni * 16 + fr) * 40 + fq * 8];
#pragma unroll
        for (int mi = 0; mi < 2; ++mi) {
          bf16x8 kf = *(const bf16x8*)&s_kdT[(wk * 32 + mi * 16 + fr) * 40 + fq * 8];
          f32x4 dc = *(const f32x4*)&s_dec[wk * 32 + mi * 16 + fq * 4];
#pragma unroll
          for (int ni = 0; ni < 4; ++ni) {
            f32x4 s4 = S[mi][ni];
#pragma unroll
            for (int j = 0; j < 4; ++j) s4[j] *= dc[j];
            s4 = __builtin_amdgcn_mfma_f32_16x16x32_bf16(kf, vf[ni], s4, 0, 0, 0);
            S[mi][ni] = s4;
            *(uint2*)&s_S[(wv * 64 + ni * 16 + fr) * 136 + wk * 32 + mi * 16 + fq * 4] = pack4(s4[0], s4[1], s4[2], s4[3]);
          }
        }
      }
      __syncthreads();
    }
    if (!sample) {
      float* so = p.out + OUT_HG + ((size_t)((b * 2 + d) * 8 + h)) * 16384;
#pragma unroll
      for (int mi = 0; mi < 2; ++mi)
#pragma unroll
        for (int ni = 0; ni < 4; ++ni)
#pragma unroll
          for (int j = 0; j < 4; ++j) so[(wk * 32 + mi * 16 + fq * 4 + j) * 128 + wv * 64 + ni * 16 + fr] = S[mi][ni][j];
    }
  }
#undef GLA_LOAD
}

__device__ __forceinline__ void phase_hg_post(const Params& p, int bid, int nb) {
  const u16* og = (const u16*)(p.ws + WS_B(5));
  const u16* sg = (const u16*)(p.ws + WS_B(2));
  u16* a = (u16*)(p.ws + WS_B(0));
  const float* ng = p.in[14];
  const int lane = threadIdx.x & 63, wave = threadIdx.x >> 6;
  float ngv[16];
#pragma unroll
  for (int k = 0; k < 4; ++k) { const f32x4 t = *(const f32x4*)&ng[lane * 16 + 4 * k]; ngv[4 * k] = t[0]; ngv[4 * k + 1] = t[1]; ngv[4 * k + 2] = t[2]; ngv[4 * k + 3] = t[3]; }
  for (int row0 = (bid * NW + wave) * 2; row0 < TOK; row0 += nb * NW * 2) {
    uint4 f[2][2], bw[2][2], sv[2][2];
#pragma unroll
    for (int r = 0; r < 2; ++r)
#pragma unroll
      for (int hh = 0; hh < 2; ++hh) {
        const size_t base = (size_t)(row0 + r) * 1024 + lane * 16 + hh * 8;
        f[r][hh] = *(const uint4*)&og[base];
        bw[r][hh] = *(const uint4*)&og[(size_t)TOK * 1024 + base];
        sv[r][hh] = *(const uint4*)&sg[base];
      }
#pragma unroll
    for (int r = 0; r < 2; ++r) {
      float o[16];
      float ss = 0;
#pragma unroll
      for (int hh = 0; hh < 2; ++hh) {
        const unsigned fa[4] = {f[r][hh].x, f[r][hh].y, f[r][hh].z, f[r][hh].w}, ba[4] = {bw[r][hh].x, bw[r][hh].y, bw[r][hh].z, bw[r][hh].w};
#pragma unroll
        for (int i = 0; i < 4; ++i) {
          o[hh * 8 + 2 * i] = lo16(fa[i]) + lo16(ba[i]);
          o[hh * 8 + 2 * i + 1] = hi16(fa[i]) + hi16(ba[i]);
        }
      }
#pragma unroll
      for (int i = 0; i < 16; ++i) ss += o[i] * o[i];
      ss += __shfl_xor(ss, 1); ss += __shfl_xor(ss, 2); ss += __shfl_xor(ss, 4);
      const float rs = rsqrtf(ss * (1.0f / 128.0f) + 1e-6f);
#pragma unroll
      for (int hh = 0; hh < 2; ++hh) {
        const unsigned sa[4] = {sv[r][hh].x, sv[r][hh].y, sv[r][hh].z, sv[r][hh].w};
        unsigned rr[4];
#pragma unroll
        for (int i = 0; i < 4; ++i)
          rr[i] = pack2(o[hh * 8 + 2 * i] * rs * ngv[hh * 8 + 2 * i] * siluf_(lo16(sa[i])), o[hh * 8 + 2 * i + 1] * rs * ngv[hh * 8 + 2 * i + 1] * siluf_(hi16(sa[i])));
        *(uint4*)&a[(size_t)(row0 + r) * 1024 + lane * 16 + hh * 8] = make_uint4(rr[0], rr[1], rr[2], rr[3]);
      }
    }
  }
}

__device__ __forceinline__ void seq_pos(int tok, int& n, int& L) {
  if (tok < NPROMPT) { n = tok & 255; L = 256; } else { n = (tok - NPROMPT) & 1023; L = 1024; }
}
__device__ __forceinline__ void phase_sc_conv(const Params& p, int bid, int nb) {
  const u16* pb = (const u16*)(p.ws + WS_B(0));
  const u16* sb = (const u16*)(p.ws + WS_B(1));
  u16* a = (u16*)(p.ws + WS_B(2));
  const float* cw = p.in[17]; const float* cbias = p.in[18];
  const size_t total = (size_t)TOK * 128;
  const size_t i0 = (size_t)bid * NT + threadIdx.x;
  const int c = ((int)i0 & 127) * 8;
  float w0[8], w1[8], w2[8], wb[8];
#pragma unroll
  for (int k = 0; k < 2; ++k) {
    const f32x4 t0 = *(const f32x4*)&cw[c + 4 * k], t1 = *(const f32x4*)&cw[1024 + c + 4 * k], t2 = *(const f32x4*)&cw[2048 + c + 4 * k], tb = *(const f32x4*)&cbias[c + 4 * k];
#pragma unroll
    for (int j = 0; j < 4; ++j) { w0[4 * k + j] = t0[j]; w1[4 * k + j] = t1[j]; w2[4 * k + j] = t2[j]; wb[4 * k + j] = tb[j]; }
  }
  const uint4 z = make_uint4(0, 0, 0, 0);
  for (size_t i = i0; i < total / 4; i += (size_t)nb * NT) {
    const int tok = (int)(i >> 7) * 4;
    int n, L; seq_pos(tok, n, L);
    const size_t base = (size_t)tok * 1024 + c;
    uint4 q[6], sv[4];
    q[0] = n > 0 ? *(const uint4*)&pb[base - 1024] : z;
#pragma unroll
    for (int t = 0; t < 4; ++t) { q[1 + t] = *(const uint4*)&pb[base + t * 1024]; sv[t] = *(const uint4*)&sb[base + t * 1024]; }
    q[5] = n + 4 < L ? *(const uint4*)&pb[base + 4096] : z;
#pragma unroll
    for (int t = 0; t < 4; ++t) {
      const unsigned am[4] = {q[t].x, q[t].y, q[t].z, q[t].w}, a0[4] = {q[t + 1].x, q[t + 1].y, q[t + 1].z, q[t + 1].w};
      const unsigned ap[4] = {q[t + 2].x, q[t + 2].y, q[t + 2].z, q[t + 2].w}, as[4] = {sv[t].x, sv[t].y, sv[t].z, sv[t].w};
      unsigned r[4];
#pragma unroll
      for (int k = 0; k < 4; ++k) {
        float z0 = w0[2 * k] * lo16(am[k]) + w1[2 * k] * lo16(a0[k]) + w2[2 * k] * lo16(ap[k]) + wb[2 * k];
        float z1 = w0[2 * k + 1] * hi16(am[k]) + w1[2 * k + 1] * hi16(a0[k]) + w2[2 * k + 1] * hi16(ap[k]) + wb[2 * k + 1];
        r[k] = pack2(lo16(as[k]) * z0, hi16(as[k]) * z1);
      }
      *(uint4*)&a[base + t * 1024] = make_uint4(r[0], r[1], r[2], r[3]);
    }
  }
}
__device__ __forceinline__ void phase_rg_conv(const Params& p, int bid, int nb) {
  const u16* ub = (const u16*)(p.ws + WS_B(0));
  u16* uc = (u16*)(p.ws + WS_B(2));
  const float* cw = p.in[21]; const float* cbias = p.in[22];
  const size_t total = (size_t)TOK * 128;
  const size_t i0 = (size_t)bid * NT + threadIdx.x;
  const int c = ((int)i0 & 127) * 8;
  float w0[8], w1[8], w2[8], w3[8], wb[8];
#pragma unroll
  for (int k = 0; k < 2; ++k) {
    const f32x4 t0 = *(const f32x4*)&cw[c + 4 * k], t1 = *(const f32x4*)&cw[1024 + c + 4 * k], t2 = *(const f32x4*)&cw[2048 + c + 4 * k], t3 = *(const f32x4*)&cw[3072 + c + 4 * k], tb = *(const f32x4*)&cbias[c + 4 * k];
#pragma unroll
    for (int j = 0; j < 4; ++j) { w0[4 * k + j] = t0[j]; w1[4 * k + j] = t1[j]; w2[4 * k + j] = t2[j]; w3[4 * k + j] = t3[j]; wb[4 * k + j] = tb[j]; }
  }
  const uint4 z = make_uint4(0, 0, 0, 0);
  for (size_t i = i0; i < total / 4; i += (size_t)nb * NT) {
    const int tok = (int)(i >> 7) * 4;
    int n, L; seq_pos(tok, n, L);
    const size_t base = (size_t)tok * 1024 + c;
    uint4 q[7];
    q[0] = n > 1 ? *(const uint4*)&ub[base - 2048] : z;
    q[1] = n > 0 ? *(const uint4*)&ub[base - 1024] : z;
#pragma unroll
    for (int t = 0; t < 4; ++t) q[2 + t] = *(const uint4*)&ub[base + t * 1024];
    q[6] = n + 4 < L ? *(const uint4*)&ub[base + 4096] : z;
#pragma unroll
    for (int t = 0; t < 4; ++t) {
      const unsigned a0[4] = {q[t].x, q[t].y, q[t].z, q[t].w}, a1[4] = {q[t + 1].x, q[t + 1].y, q[t + 1].z, q[t + 1].w};
      const unsigned a2[4] = {q[t + 2].x, q[t + 2].y, q[t + 2].z, q[t + 2].w}, a3[4] = {q[t + 3].x, q[t + 3].y, q[t + 3].z, q[t + 3].w};
      unsigned r[4];
#pragma unroll
      for (int k = 0; k < 4; ++k) {
        float z0 = w0[2 * k] * lo16(a0[k]) + w1[2 * k] * lo16(a1[k]) + w2[2 * k] * lo16(a2[k]) + w3[2 * k] * lo16(a3[k]) + wb[2 * k];
        float z1 = w0[2 * k + 1] * hi16(a0[k]) + w1[2 * k + 1] * hi16(a1[k]) + w2[2 * k + 1] * hi16(a2[k]) + w3[2 * k + 1] * hi16(a3[k]) + wb[2 * k + 1];
        r[k] = pack2(z0, z1);
      }
      *(uint4*)&uc[((size_t)(c >> 6) * TOK + tok + t) * 64 + (c & 63)] = make_uint4(r[0], r[1], r[2], r[3]);
    }
  }
}

__device__ __forceinline__ void phase_rg_scan(const Params& p, unsigned char* smem_raw, int bid, int nb) {
  float* sA = (float*)smem_raw;
  float* sB = sA + 2048;
  const u16* rb = (const u16*)(p.ws + WS_B(3));
  const u16* ib = (const u16*)(p.ws + WS_B(5));
  const u16* uc = (const u16*)(p.ws + WS_B(2));
  const u16* sg = (const u16*)(p.ws + WS_B(1));
  u16* hfw = (u16*)(p.ws + WS_H);
  u16* yp = (u16*)(p.ws + WS_B(0));
  const int tid = threadIdx.x;
  for (int u = bid; u < 768; u += nb) {
    int sample, b, c, seg, nseg, start, chs, slot;
    if (u < 256) {
      const int xq = u & 7, yq = u >> 3, gid = (yq >> 2) * 8 + xq, sub = yq & 3;
      sample = 1; b = gid >> 4; slot = (tid & 3) * 4; c = (gid & 15) * 64 + sub * 16 + slot; seg = tid >> 2; nseg = 128; start = NPROMPT + b * 1024; chs = 16; }
    else { sample = 0; b = (u - 256) >> 4; slot = (tid & 15) * 4; c = ((u - 256) & 15) * 64 + slot; seg = tid >> 4; nseg = 32; start = b * 256; chs = 64; }
    const int L = nseg * 8;
#pragma unroll 1
    for (int d = 0; d < 2; ++d) {
      const f32x4 lam = *(const f32x4*)&p.in[25][d * 1024 + c];
      float cl[4];
#pragma unroll
      for (int j = 0; j < 4; ++j) cl[j] = 8.0f * 1.4426950408889634f * log1pf(__expf(-lam[j]))    ;
      const u16* rp = rb + (size_t)d * TOK * 1024;
      const u16* ip = ib + (size_t)d * TOK * 1024;
      const int tok0 = start + (d ? L - 1 - seg * 8 : seg * 8);
      const size_t o0 = (size_t)tok0 * 1024 + c;
      const long ostep = d ? -1024 : 1024;
      const size_t g0 = ((size_t)(c >> 6) * TOK + tok0) * 64 + (c & 63);
      const long gstep = d ? -64 : 64;
      uint2 rr[8], ii[8], uu[8];
#pragma unroll
      for (int s8 = 0; s8 < 8; ++s8) { rr[s8] = *(const uint2*)&rp[g0 + s8 * gstep]; ii[s8] = *(const uint2*)&ip[g0 + s8 * gstep]; uu[s8] = *(const uint2*)&uc[g0 + s8 * gstep]; }
      uint2 hf[8], sgv[8];
      if (d == 1) {
#pragma unroll
        for (int s8 = 0; s8 < 8; ++s8) { hf[s8] = *(const uint2*)&hfw[g0 + s8 * gstep]; sgv[s8] = *(const uint2*)&sg[g0 + s8 * gstep]; }
      }
      float av[8][4], xv[8][4];
      float A[4] = {1.f, 1.f, 1.f, 1.f}, B[4] = {0.f, 0.f, 0.f, 0.f};
#pragma unroll
      for (int s8 = 0; s8 < 8; ++s8) {
        const float r4[4] = {lo16(rr[s8].x), hi16(rr[s8].x), lo16(rr[s8].y), hi16(rr[s8].y)};
        const float i4[4] = {lo16(ii[s8].x), hi16(ii[s8].x), lo16(ii[s8].y), hi16(ii[s8].y)};
        const float u4[4] = {lo16(uu[s8].x), hi16(uu[s8].x), lo16(uu[s8].y), hi16(uu[s8].y)};
#pragma unroll
        for (int j = 0; j < 4; ++j) {
          const float la = -cl[j] * r4[j];
          const float a = __builtin_amdgcn_exp2f(la);
          const float xin = __builtin_amdgcn_sqrtf(fmaxf(1.0f - __builtin_amdgcn_exp2f(2.0f * la), 0.f)) * (i4[j] * u4[j]);
          av[s8][j] = a; xv[s8][j] = xin;
          A[j] *= a; B[j] = a * B[j] + xin;
        }
      }
      const int lane = tid & 63, wv_ = tid >> 6;
      const int shstep = chs >> 2;
      const int nsw = 64 / shstep;
      const int segl = lane / shstep, qd = lane & (shstep - 1);
      for (int k = 1; k < nsw; k <<= 1) {
        float pa[4], pb2[4];
#pragma unroll
        for (int j = 0; j < 4; ++j) { pa[j] = __shfl_up(A[j], k * shstep); pb2[j] = __shfl_up(B[j], k * shstep); }
        if (segl >= k) {
#pragma unroll
          for (int j = 0; j < 4; ++j) { B[j] = A[j] * pb2[j] + B[j]; A[j] = A[j] * pa[j]; }
        }
      }
      float EA[4], EB[4];
#pragma unroll
      for (int j = 0; j < 4; ++j) { EA[j] = __shfl_up(A[j], shstep); EB[j] = __shfl_up(B[j], shstep); }
      if (segl == nsw - 1) {
        *(f32x4*)&sA[(wv_ * 16 + qd) * 4] = f32x4{A[0], A[1], A[2], A[3]};
        *(f32x4*)&sB[(wv_ * 16 + qd) * 4] = f32x4{B[0], B[1], B[2], B[3]};
      }
      __syncthreads();
      float h[4];
      {
        f32x4 h0v = f32x4{0.f, 0.f, 0.f, 0.f};
        if (sample) h0v = *(const f32x4*)&p.in[3][(b * 2 + d) * 1024 + c];
#pragma unroll
        for (int j = 0; j < 4; ++j) h[j] = h0v[j];
        for (int w2 = 0; w2 < wv_; ++w2) {
          const f32x4 ta = *(const f32x4*)&sA[(w2 * 16 + qd) * 4], tb = *(const f32x4*)&sB[(w2 * 16 + qd) * 4];
#pragma unroll
          for (int j = 0; j < 4; ++j) h[j] = ta[j] * h[j] + tb[j];
        }
        if (segl > 0) {
#pragma unroll
          for (int j = 0; j < 4; ++j) h[j] = EA[j] * h[j] + EB[j];
        }
      }
#pragma unroll
      for (int s8 = 0; s8 < 8; ++s8) {
#pragma unroll
        for (int j = 0; j < 4; ++j) h[j] = av[s8][j] * h[j] + xv[s8][j];
        const size_t o = o0 + s8 * ostep;
        if (d == 0) *(uint2*)&hfw[g0 + s8 * gstep] = pack4(h[0], h[1], h[2], h[3]);
        else *(uint2*)&yp[g0 + s8 * gstep] = pack4((lo16(hf[s8].x) + h[0]) * lo16(sgv[s8].x), (hi16(hf[s8].x) + h[1]) * hi16(sgv[s8].x),
                                     (lo16(hf[s8].y) + h[2]) * lo16(sgv[s8].y), (hi16(hf[s8].y) + h[3]) * hi16(sgv[s8].y));
      }
      if (!sample && seg == nseg - 1) *(f32x4*)&p.out[OUT_RG + (b * 2 + d) * 1024 + c] = f32x4{h[0], h[1], h[2], h[3]};
      __syncthreads();
    }
  }
}

__device__ __forceinline__ void phase_mla_norm(const Params& p, int bid, int nb) {
  u16* cq = (u16*)(p.ws + WS3_CQ);
  u16* ckvall = (u16*)(p.ws + WS3_CKVALL);
  const float* ckvraw = (const float*)(p.ws + WS3_CKVRAW);
  const float* kperaw = (const float*)(p.ws + WS3_KPERAW);
  u16* Kb = (u16*)(p.ws + WS3_K);
  const float* qn = p.in[28]; const float* kvn = p.in[29];
  const int lane = threadIdx.x & 63, wave = threadIdx.x >> 6;
  float qnv[6];
#pragma unroll
  for (int i = 0; i < 3; ++i) { qnv[2 * i] = qn[(i * 64 + lane) * 2]; qnv[2 * i + 1] = qn[(i * 64 + lane) * 2 + 1]; }
  const f32x4 g4 = *(const f32x4*)&kvn[lane * 4];
  unsigned cvn[3] = {0u, 0u, 0u}; f32x4 kvnx = f32x4{0.f, 0.f, 0.f, 0.f}; float vnx = 0.f;
  {
    const int r0 = bid * NW + wave;
    if (r0 < TOK) {
#pragma unroll
      for (int i = 0; i < 3; ++i) cvn[i] = ((const unsigned*)&cq[(size_t)r0 * 384])[i * 64 + lane];
      kvnx = *(const f32x4*)&ckvraw[(size_t)r0 * 256 + lane * 4]; vnx = kperaw[(size_t)r0 * 32 + (lane & 31)];
    }
  }
  for (int row = bid * NW + wave; row < TOK + 2048; row += nb * NW) {
    if (row < TOK) {
      const int tok = row;
      const bool sample = tok >= NPROMPT;
      unsigned cv[3] = {cvn[0], cvn[1], cvn[2]}; const f32x4 kv = kvnx; float v = vnx;
      {
        const int rn = row + nb * NW;
        if (rn < TOK) {
#pragma unroll
          for (int i = 0; i < 3; ++i) cvn[i] = ((const unsigned*)&cq[(size_t)rn * 384])[i * 64 + lane];
          kvnx = *(const f32x4*)&ckvraw[(size_t)rn * 256 + lane * 4]; vnx = kperaw[(size_t)rn * 32 + (lane & 31)];
        }
      }
      const int bs = (tok - NPROMPT) >> 10, n = (tok - NPROMPT) & 1023;
      const size_t kvrow = sample ? (size_t)(NPROMPT + bs * 1536 + 512 + n) : (size_t)tok;
      unsigned* cqr = (unsigned*)&cq[(size_t)tok * 384];
      float ss = 0;
#pragma unroll
      for (int i = 0; i < 3; ++i) { float a = lo16(cv[i]), b2 = hi16(cv[i]); ss += a * a + b2 * b2; }
      const float rsq = rsqrtf(wave_sum(ss) * (1.0f / 384.0f) + 1e-6f);
#pragma unroll
      for (int i = 0; i < 3; ++i) {
        cqr[i * 64 + lane] = pack2(lo16(cv[i]) * rsq * qnv[2 * i], hi16(cv[i]) * rsq * qnv[2 * i + 1]);
      }
      const float rsk = rsqrtf(wave_sum(kv[0] * kv[0] + kv[1] * kv[1] + kv[2] * kv[2] + kv[3] * kv[3]) * (1.0f / 256.0f) + 1e-6f);
      f32x4 o4;
#pragma unroll
      for (int j = 0; j < 4; ++j) o4[j] = kv[j] * rsk * g4[j];
      *(uint2*)&ckvall[kvrow * 256 + lane * 4] = pack4(o4[0], o4[1], o4[2], o4[3]);
      if (!sample) *(f32x4*)&p.out[OUT_CKV + (size_t)tok * 256 + lane * 4] = o4;
      if (!sample) { if (lane < 32) p.out[OUT_KPE + (size_t)tok * 32 + lane] = v; }
      else {
        const float partner = __shfl_xor(v, 8);
        const int i16 = lane & 15;
        const float pos = (lane & 16) ? (float)(n & 63) : (float)(n >> 6);
        float sn, cs; rope_sincos(pos, i16 & 7, sn, cs);
        v = (i16 < 8) ? (v * cs - partner * sn) : (partner * sn + v * cs);
      }
      const u16 vb = f2bf(v);
#pragma unroll
      for (int i = 0; i < 8; ++i) Kb[(kvrow * 16 + (lane >> 5) + 2 * i) * 96 + 64 + (lane & 31)] = vb;
    } else {
      const int r = row - TOK, bs = r >> 9, j = r & 511;
      const size_t kvrow = (size_t)(NPROMPT + bs * 1536 + j);
      f32x4 kv = *(const f32x4*)&p.in[4][(size_t)r * 256 + lane * 4];
      *(uint2*)&ckvall[kvrow * 256 + lane * 4] = pack4(kv[0], kv[1], kv[2], kv[3]);
      const u16 vb = f2bf(p.in[5][(size_t)r * 32 + (lane & 31)]);
#pragma unroll
      for (int i = 0; i < 8; ++i) Kb[(kvrow * 16 + (lane >> 5) + 2 * i) * 96 + 64 + (lane & 31)] = vb;
    }
  }
}

__device__ __forceinline__ void phase_attn(const Params& p, unsigned char* smem_raw, int bid, int nb) {
  u16* sK = (u16*)smem_raw;
  u16* sV = sK + 128 * 104;
  const u16* qg = (const u16*)(p.ws + WS3_Q);
  const u16* Kg = (const u16*)(p.ws + WS3_K);
  const u16* Vg = (const u16*)(p.ws + WS3_VT);
  const u16* sg = (const u16*)(p.ws + WS3_SG);
  u16* ao = (u16*)(p.ws + WS_H);
  const int tid = threadIdx.x, lane = tid & 63, w = tid >> 6, fr = lane & 15, fq = lane >> 4;
  for (int u = bid; u < 1536; u += nb) {
    int tok0, kvbase, nkeys, h;
    if (u < 512) { const int b = u >> 7, r = u & 127; h = r >> 3; const int qb = r & 7; tok0 = NPROMPT + b * 1024 + qb * 128; kvbase = NPROMPT + b * 1536; nkeys = 1536; }
    else { const int uu = u - 512; const int b = uu >> 5, r = uu & 31; h = r >> 1; const int qb = r & 1; tok0 = b * 256 + qb * 128; kvbase = b * 256; nkeys = 256; }
    const int tokq = tok0 + w * 16 + fr;
    bf16x8 qf[3];
#pragma unroll
    for (int ks = 0; ks < 3; ++ks) qf[ks] = *(const bf16x8*)&qg[(size_t)tokq * 1536 + h * 96 + ks * 32 + fq * 8];
    if (u < 512) {
      const int npos = (tokq - NPROMPT) & 1023;
      const float pos = (fq & 2) ? (float)(npos & 63) : (float)(npos >> 6);
      uint4 raw = *(uint4*)&qf[2];
      unsigned rw[4] = {raw.x, raw.y, raw.z, raw.w};
#pragma unroll
      for (int i = 0; i < 4; ++i) {
        float v0 = lo16(rw[i]), v1 = hi16(rw[i]);
        const float p0 = __shfl_xor(v0, 16), p1 = __shfl_xor(v1, 16);
        float sn0, cs0, sn1, cs1;
        rope_sincos(pos, 2 * i, sn0, cs0); rope_sincos(pos, 2 * i + 1, sn1, cs1);
        v0 = (fq & 1) ? (p0 * sn0 + v0 * cs0) : (v0 * cs0 - p0 * sn0);
        v1 = (fq & 1) ? (p1 * sn1 + v1 * cs1) : (v1 * cs1 - p1 * sn1);
        rw[i] = pack2(v0, v1);
      }
      raw = make_uint4(rw[0], rw[1], rw[2], rw[3]);
      qf[2] = *(bf16x8*)&raw;
    }
    float m = -1e30f, l = 0.f;
    f32x4 oacc[4];
#pragma unroll
    for (int i = 0; i < 4; ++i) oacc[i] = f32x4{0.f, 0.f, 0.f, 0.f};
    const int kk0 = tid / 12, kc0 = tid - kk0 * 12;
    const int kk1 = (tid + NT) / 12, kc1 = (tid + NT) - kk1 * 12;
    const int kk2_ = (tid + 2 * NT) / 12, kc2 = (tid + 2 * NT) - kk2_ * 12;
    const u16* Kp0 = &Kg[((size_t)(kvbase + kk0) * 16 + h) * 96 + kc0 * 8];
    const u16* Kp1 = &Kg[((size_t)(kvbase + kk1) * 16 + h) * 96 + kc1 * 8];
    const u16* Kp2 = &Kg[((size_t)(kvbase + kk2_) * 16 + h) * 96 + kc2 * 8];
    const int vd0 = tid >> 4, vc0 = tid & 15, vd1 = (tid + NT) >> 4;
    const u16* Vp0 = &Vg[(size_t)(h * 64 + vd0) * KVROWS + kvbase + vc0 * 8];
    const u16* Vp1 = &Vg[(size_t)(h * 64 + vd1) * KVROWS + kvbase + vc0 * 8];
    uint4 kr0 = *(const uint4*)Kp0, kr1 = *(const uint4*)Kp1, kr2 = *(const uint4*)Kp2, vr0 = *(const uint4*)Vp0, vr1 = *(const uint4*)Vp1;
    const int ntile2 = nkeys >> 7;
    for (int kt = 0; kt < ntile2; ++kt) {
      __syncthreads();
      *(uint4*)&sK[kk0 * 104 + kc0 * 8] = kr0; *(uint4*)&sK[kk1 * 104 + kc1 * 8] = kr1; *(uint4*)&sK[kk2_ * 104 + kc2 * 8] = kr2;
      *(uint4*)&sV[vd0 * 136 + vc0 * 8] = vr0; *(uint4*)&sV[vd1 * 136 + vc0 * 8] = vr1;
      if (kt + 1 < ntile2) {
        const size_t ko = (size_t)(kt + 1) * 128 * 1536; const int vo = (kt + 1) * 128;
        kr0 = *(const uint4*)(Kp0 + ko); kr1 = *(const uint4*)(Kp1 + ko); kr2 = *(const uint4*)(Kp2 + ko);
        vr0 = *(const uint4*)(Vp0 + vo); vr1 = *(const uint4*)(Vp1 + vo);
      }
      __syncthreads();
      f32x4 sacc[8];
#pragma unroll
      for (int ni = 0; ni < 8; ++ni) {
        sacc[ni] = f32x4{0.f, 0.f, 0.f, 0.f};
#pragma unroll
        for (int ks = 0; ks < 3; ++ks) {
          bf16x8 kf = *(const bf16x8*)&sK[(ni * 16 + fr) * 104 + ks * 32 + fq * 8];
          sacc[ni] = __builtin_amdgcn_mfma_f32_16x16x32_bf16(kf, qf[ks], sacc[ni], 0, 0, 0);
        }
      }
      float mx = -1e30f;
#pragma unroll
      for (int ni = 0; ni < 8; ++ni)
#pragma unroll
        for (int j = 0; j < 4; ++j) mx = fmaxf(mx, sacc[ni][j]);
      mx = fmaxf(mx, __shfl_xor(mx, 16));
      mx = fmaxf(mx, __shfl_xor(mx, 32));
      const float mnew = fmaxf(m, mx);
      const float alpha = __builtin_amdgcn_exp2f(m - mnew);
      m = mnew;
      float ls = 0.f;
#pragma unroll
      for (int ni = 0; ni < 8; ++ni)
#pragma unroll
        for (int j = 0; j < 4; ++j) { float e = __builtin_amdgcn_exp2f(sacc[ni][j] - mnew); sacc[ni][j] = e; ls += e; }
      l = l * alpha + ls;
      bf16x8 pf[4];
#pragma unroll
      for (int kk2 = 0; kk2 < 4; ++kk2) {
        uint2 lo = pack4(sacc[2 * kk2][0], sacc[2 * kk2][1], sacc[2 * kk2][2], sacc[2 * kk2][3]);
        uint2 hi = pack4(sacc[2 * kk2 + 1][0], sacc[2 * kk2 + 1][1], sacc[2 * kk2 + 1][2], sacc[2 * kk2 + 1][3]);
        uint4 pk = make_uint4(lo.x, lo.y, hi.x, hi.y);
        pf[kk2] = *(bf16x8*)&pk;
      }
#pragma unroll
      for (int di = 0; di < 4; ++di) {
#pragma unroll
        for (int j = 0; j < 4; ++j) oacc[di][j] *= alpha;
#pragma unroll
        for (int kk2 = 0; kk2 < 4; ++kk2) {
          uint2 v0 = *(const uint2*)&sV[(di * 16 + fr) * 136 + kk2 * 32 + fq * 4];
          uint2 v1 = *(const uint2*)&sV[(di * 16 + fr) * 136 + kk2 * 32 + 16 + fq * 4];
          uint4 vk = make_uint4(v0.x, v0.y, v1.x, v1.y);
          oacc[di] = __builtin_amdgcn_mfma_f32_16x16x32_bf16(*(bf16x8*)&vk, pf[kk2], oacc[di], 0, 0, 0);
        }
      }
    }
    l += __shfl_xor(l, 16);
    l += __shfl_xor(l, 32);
    const float inv = 1.0f / l;
#pragma unroll
    for (int di = 0; di < 4; ++di) {
      const size_t o = (size_t)tokq * 1024 + h * 64 + di * 16 + fq * 4;
      uint2 s = *(const uint2*)&sg[o];
      *(uint2*)&ao[o] = pack4(oacc[di][0] * inv * siluf_(lo16(s.x)), oacc[di][1] * inv * siluf_(hi16(s.x)), oacc[di][2] * inv * siluf_(lo16(s.y)), oacc[di][3] * inv * siluf_(hi16(s.y)));
    }
  }
}

#define XB_TMO      128
#define XB_XCNT(j)  (256  + 64 * (j))
#define XB_XSUB(j)  (1280 + 64 * (j))
#define XB_XGEN(j)  (2304 + 64 * (j))
#define XB_TOP      3328
#define XB_TOPGEN   3392
#define XCD_BAR_WORDS 3456
#define XB_SPIN_CAP (1u << 22)
__device__ __forceinline__ unsigned xb_ld(unsigned* p)              { return __hip_atomic_load(p, __ATOMIC_RELAXED, __HIP_MEMORY_SCOPE_AGENT); }
__device__ __forceinline__ unsigned xb_add(unsigned* p, unsigned v) { return __hip_atomic_fetch_add(p, v, __ATOMIC_RELAXED, __HIP_MEMORY_SCOPE_AGENT); }
__device__ __forceinline__ unsigned xb_xcc_id() { return (unsigned)__builtin_amdgcn_s_getreg((3 << 11) | 20) & 0xFu; }
#define XB_SPIN(cond, bar) do { unsigned _sp = 0; while (cond) { __builtin_amdgcn_s_sleep(1); \
    if ((++_sp & 255u) == 0u) { if (xb_ld(&(bar)[XB_TMO])) break; if (_sp > XB_SPIN_CAP) { atomicAdd(&(bar)[XB_TMO], 1u); break; } } } } while (0)
struct XcdBarrier { unsigned* bar; unsigned x; volatile LAS unsigned* st; };
__device__ __forceinline__ XcdBarrier xcd_barrier_post(unsigned* bar, volatile LAS unsigned* st) {
  XcdBarrier b; b.bar = bar; b.x = xb_xcc_id(); b.st = st;
  if (threadIdx.x == 0) (void)xb_add(&bar[XB_XCNT(b.x)], 1u);
  return b;
}
__device__ __forceinline__ void xcd_barrier_complete(unsigned* bar, unsigned x, unsigned& nloc, unsigned& nx) {
  const unsigned G = gridDim.x * gridDim.y * gridDim.z;
  unsigned sum, cnt, mine, sp = 0u;
  for (;;) {
    sum = 0u; cnt = 0u; mine = 0u;
#pragma unroll
    for (unsigned j = 0; j < 16; ++j) { const unsigned c = xb_ld(&bar[XB_XCNT(j)]); sum += c; cnt += (c > 0u) ? 1u : 0u; mine = (j == x) ? c : mine; }
    if (sum == G) break;
    __builtin_amdgcn_s_sleep(1);
    if ((++sp & 255u) == 0u) { if (xb_ld(&bar[XB_TMO])) break; if (sp > XB_SPIN_CAP) { atomicAdd(&bar[XB_TMO], 1u); break; } }
  }
  nloc = mine > 0u ? mine : 1u; nx = cnt > 0u ? cnt : 1u;
}
__device__ __forceinline__ void xcd_barrier(const XcdBarrier& b) {
  asm volatile("s_waitcnt vmcnt(0)" ::: "memory");
  __syncthreads();
  if (threadIdx.x == 0) {
    unsigned* bar = b.bar;
    __builtin_amdgcn_s_waitcnt(0);
    unsigned nloc = b.st[0], nx = b.st[1];
    if (nloc == 0u) { xcd_barrier_complete(bar, b.x, nloc, nx); b.st[0] = nloc; b.st[1] = nx; }
    const unsigned old = xb_add(&bar[XB_XSUB(b.x)], 1u);
    const unsigned gen = old / nloc;
    if (old + 1u == (gen + 1u) * nloc) {
      __builtin_amdgcn_fence(__ATOMIC_RELEASE, "agent");
      asm volatile("s_waitcnt vmcnt(0)" ::: "memory");
      const unsigned og = xb_add(&bar[XB_TOP], 1u);
      const unsigned tg = og / nx;
      if (og + 1u == (tg + 1u) * nx) xb_add(&bar[XB_TOPGEN], 1u);
      else XB_SPIN(xb_ld(&bar[XB_TOPGEN]) == tg, bar);
      __builtin_amdgcn_fence(__ATOMIC_ACQUIRE, "agent");
      xb_add(&bar[XB_XGEN(b.x)], 1u);
      asm volatile("s_waitcnt vmcnt(0)" ::: "memory");
    } else {
      XB_SPIN(xb_ld(&bar[XB_XGEN(b.x)]) == gen, bar);
      __builtin_amdgcn_fence(__ATOMIC_ACQUIRE, "agent");
      asm volatile("s_waitcnt vmcnt(0)" ::: "memory");
    }
  }
  __syncthreads();
}

#define GEMM_LDS 131072
#define DYN_LDS (GEMM_LDS + 16)
#define WS_BAR (WS_CNT + 4096ull)

#define RUN_GEMM(Aptr, LDA, Bptr, MM, NN, KK, GATE, EPI, CID) RUN_GEMM_G(Aptr, LDA, Bptr, MM, NN, KK, GATE, EPI, nb, CID)
#define RUN_GEMM_G(Aptr, LDA, Bptr, MM, NN, KK, GATE, EPI, GG, CID) RUN_GEMM_X(Aptr, LDA, (size_t)128, (size_t)0, Bptr, MM, NN, KK, GATE, EPI, GG, CID)
#define GM_KSTEP ((size_t)TOK * 128)
#define RUN_GEMM_X(Aptr, LDA, KSA, GST, Bptr, MM, NN, KK, GATE, EPI, GG, CID) do { pg8::Gemm g_{(const u16*)(Aptr), (const u16*)(Bptr), MM, NN, KK, LDA, GATE, p.flags, KSA, GST}; \
    pg8::StaticOrder S_; S_.init(MM, NN, GG, CID); pg8::gemm_phase((LAS unsigned char*)smem_raw, g_, S_, EPI); } while (0)
#define RUN_GEMM_RX(Aptr, LDA, KSA, GST, Bptr, MM, NN, KK, GATE, EPI, GG, CID, UBEG, UEND) do { pg8::Gemm g_{(const u16*)(Aptr), (const u16*)(Bptr), MM, NN, KK, LDA, GATE, p.flags, KSA, GST}; \
    pg8::StaticOrder S_; S_.init(MM, NN, GG, CID); S_.ubeg = UBEG; S_.uend = UEND; pg8::gemm_phase((LAS unsigned char*)smem_raw, g_, S_, EPI); } while (0)
#define RUN_GEMM_R(Aptr, LDA, Bptr, MM, NN, KK, EPI, GG, CID, UBEG, UEND) do { pg8::Gemm g_{(const u16*)(Aptr), (const u16*)(Bptr), MM, NN, KK, LDA, 0, p.flags, (size_t)128, (size_t)0}; \
    pg8::StaticOrder S_; S_.init(MM, NN, GG, CID); S_.ubeg = UBEG; S_.uend = UEND; pg8::gemm_phase((LAS unsigned char*)smem_raw, g_, S_, EPI); } while (0)

__global__ void __launch_bounds__(NT, 2) mega(Params p) {
  extern __shared__ __attribute__((aligned(16))) unsigned char smem_raw[];
  const int bid = blockIdx.x, nb = gridDim.x;
  unsigned char* ws = p.ws;
  const float* mod = (const float*)(ws + WS_MOD);
  volatile LAS unsigned* xst = (volatile LAS unsigned*)((LAS unsigned char*)smem_raw + GEMM_LDS);
  XcdBarrier xb;
  if (p.phase_hi - p.phase_lo > 1) {
    if (threadIdx.x == 0) { xst[0] = 0u; xst[1] = 0u; }
    __syncthreads();
    xb = xcd_barrier_post((unsigned*)(ws + WS_BAR), xst);
  }
#define PH_BEGIN(n) if ((PHMASK & (1u << n)) && p.phase_lo <= n && n < p.phase_hi) { const int ph = n;
#define PH_FIN if (ph + 1 < p.phase_hi) { if (p.phase_lo < 0) cg::this_grid().sync(); else xcd_barrier(xb); } }
  PH_BEGIN(0) phase_prologue(p, smem_raw, bid, nb); PH_FIN
  PH_BEGIN(1) phase_h0(p, bid, nb); PH_FIN
  PH_BEGIN(2) {
    EpiHgIn e{(u16*)(ws + WS_B(0)), (u16*)(ws + WS_B(1)), (u16*)(ws + WS_B(2)), (_Float16*)(ws + WS_B(3)), (const float*)(ws + WS_LB)};
    RUN_GEMM(ws + WS_H, 1024, ws + WS_W_HG_IN, TOK, (nb == 256 ? 4096 : 5120), 1024, 0, e, bid);
  } PH_FIN
  PH_BEGIN(3) {
    phase_gla(p, smem_raw);
    if (nb == 256) {
      __syncthreads();
      EpiSg eg{(u16*)(ws + WS_B(2))};
      RUN_GEMM_R(ws + WS_H, 1024, ws + WS_W_HG_IN + (size_t)4096 * 1024 * 2, TOK, 1024, 1024, eg, 256, bid >= 64 ? bid - 64 : (1 << 20), 0, 192);
    }
  } PH_FIN
  PH_BEGIN(4) phase_hg_post(p, bid, nb); PH_FIN
  PH_BEGIN(5) {
    EpiResLn<false, true> e{p.in[0], p.in[1], (const u16*)nullptr, p.out, (u16*)(ws + WS_XB), mod + 0 * 15360 + 2048, p.in[10] + 0 * 1024, p.in[11] + 0 * 1024, mod + 1 * 15360, (u16*)(ws + WS_H),
               (unsigned long long*)(ws + WS_SLOT) + 0 * 49152, (unsigned*)(ws + WS_CNT + 256) + 0 * 48};
    RUN_GEMM(ws + WS_B(0), 1024, ws + WS_W_HG_OUT, TOK, 1024, 1024, 0, e, bid);
    wconv_idle(p, smem_raw, bid, nb, 1536, 2816);
  } PH_FIN
  PH_BEGIN(7) {
    EpiScIn e{(u16*)(ws + WS_B(0)), (u16*)(ws + WS_B(1))};
    RUN_GEMM(ws + WS_H, 1024, ws + WS_W_SC_IN, TOK, 4096, 1024, 0, e, bid);
  } PH_FIN
  PH_BEGIN(8) phase_sc_conv(p, bid, nb); PH_FIN
  PH_BEGIN(9) {
    EpiResLn<true, true> e{p.out, p.out, (const u16*)(ws + WS_XB), p.out, (u16*)(ws + WS_XB), mod + 1 * 15360 + 2048, p.in[10] + 1 * 1024, p.in[11] + 1 * 1024, mod + 2 * 15360, (u16*)(ws + WS_H),
               (unsigned long long*)(ws + WS_SLOT) + 1 * 49152, (unsigned*)(ws + WS_CNT + 256) + 1 * 48};
    RUN_GEMM(ws + WS_B(2), 1024, ws + WS_W_SC_OUT, TOK, 1024, 1024, 0, e, bid);
    wconv_idle(p, smem_raw, bid, nb, 2816, 3840);
  } PH_FIN
  PH_BEGIN(11) {
    EpiRgIn e{(u16*)(ws + WS_B(0)), (u16*)(ws + WS_B(1))};
    if (nb == 256) {
      RUN_GEMM(ws + WS_H, 1024, ws + WS_W_RG_IN, TOK, 1024, 1024, 0, e, bid);
      EpiSgGM eg{(u16*)(ws + WS_B(1))};
      RUN_GEMM_R(ws + WS_H, 1024, ws + WS_W_RG_IN + (size_t)1024 * 1024 * 2, TOK, 1024, 1024, eg, 256, bid >= 192 ? bid - 192 : (1 << 20), 0, 64);
    } else {
      RUN_GEMM(ws + WS_H, 1024, ws + WS_W_RG_IN, TOK, 2048, 1024, 0, e, bid);
    }
  } PH_FIN
  PH_BEGIN(12) phase_rg_conv(p, bid, nb); PH_FIN
  PH_BEGIN(13) {
    EpiRgGate e{(u16*)(ws + WS_B(3)), (u16*)(ws + WS_B(5)), p.in[24]};
    if (nb == 256) {
      EpiSgGM eg{(u16*)(ws + WS_B(1))};
      RUN_GEMM_R(ws + WS_H, 1024, ws + WS_W_RG_IN + (size_t)1024 * 1024 * 2, TOK, 1024, 1024, eg, 256, bid < 128 ? bid : (1 << 20), 64, 192);
      RUN_GEMM_RX(ws + WS_B(2), 64, GM_KSTEP, 4 * GM_KSTEP, ws + WS_W_RG_GATE, TOK, 4096, 256, 1, e, 256, bid < 128 ? bid : (1 << 20), 0, 128);
      RUN_GEMM_RX(ws + WS_B(2), 64, GM_KSTEP, 4 * GM_KSTEP, ws + WS_W_RG_GATE, TOK, 4096, 256, 1, e, 128, bid >= 128 ? bid - 128 : (1 << 20), 128, 768);
    } else {
      RUN_GEMM_X(ws + WS_B(2), 64, GM_KSTEP, 4 * GM_KSTEP, ws + WS_W_RG_GATE, TOK, 4096, 256, 1, e, nb, bid);
    }
  } PH_FIN
  PH_BEGIN(14) phase_rg_scan(p, smem_raw, bid, nb); PH_FIN
  PH_BEGIN(15) {
    EpiResLn<true, true> e{p.out, p.out, (const u16*)(ws + WS_XB), p.out, (u16*)(ws + WS_XB), mod + 2 * 15360 + 2048, p.in[10] + 2 * 1024, p.in[11] + 2 * 1024, mod + 3 * 15360, (u16*)(ws + WS_H),
               (unsigned long long*)(ws + WS_SLOT) + 2 * 49152, (unsigned*)(ws + WS_CNT + 256) + 2 * 48};
    RUN_GEMM_X(ws + WS_B(0), 64, GM_KSTEP, (size_t)0, ws + WS_W_RG_OUT, TOK, 1024, 1024, 0, e, nb, bid);
    wconv_idle(p, smem_raw, bid, nb, 3840, 4800);
  } PH_FIN
  PH_BEGIN(17) {
    EpiMlaIn e{(u16*)(ws + WS3_CQ), (float*)(ws + WS3_CKVRAW), (float*)(ws + WS3_KPERAW), (u16*)(ws + WS3_SG)};
    RUN_GEMM(ws + WS_H, 1024, ws + WS_W_MLA_IN, TOK, 768, 1024, 0, e, bid);
    if (nb == 256) {
      EpiSg eg{(u16*)(ws + WS3_SG)};
      RUN_GEMM_R(ws + WS_H, 1024, ws + WS_W_MLA_IN + 672 * 1024 * 2, TOK, 1024, 1024, eg, 256, bid >= 144 ? bid - 144 : (1 << 20), 0, 112);
    }
  } PH_FIN
  PH_BEGIN(18) phase_mla_norm(p, bid, nb); PH_FIN
  PH_BEGIN(19) {
    const bool bal = (nb == 256);
    const int none = 1 << 20;
    EpiSg eg{(u16*)(ws + WS3_SG)};
    RUN_GEMM_R(ws + WS_H, 1024, ws + WS_W_MLA_IN + 672 * 1024 * 2, TOK, 1024, 1024, eg, nb, bid, bal ? 112 : 0, 192);
    EpiQ eq{(u16*)(ws + WS3_Q)};
    RUN_GEMM_G(ws + WS3_CQ, 384, ws + WS_W_QB, TOK, 1536, 384, 0, eq, bal ? 176 : nb, bal ? (bid >= 80 ? bid - 80 : none) : bid);
    EpiK ek{(u16*)(ws + WS3_K)};
    RUN_GEMM(ws + WS3_CKVALL, 256, ws + WS_W_KVB, KVROWS, 1024, 256, 0, ek, bid);
    EpiV ev{(u16*)(ws + WS3_VT)};
    RUN_GEMM_G(ws + WS_W_KVB + 1024 * 256 * 2, 256, ws + WS3_CKVALL, 1024, KVROWS, 256, 0, ev, bal ? 176 : nb, bal ? (bid >= 80 ? (bid + 160) % 176 : none) : bid);
  } PH_FIN
  PH_BEGIN(20) phase_attn(p, smem_raw, bid, nb); PH_FIN
  PH_BEGIN(21) {
    EpiResLn<true, false> e{p.out, p.out, (const u16*)(ws + WS_XB), p.out, (u16*)nullptr, mod + 3 * 15360 + 2048, p.in[10] + 3 * 1024, p.in[11] + 3 * 1024, mod + 3 * 15360, (u16*)nullptr,
               (unsigned long long*)(ws + WS_SLOT) + 3 * 49152, (unsigned*)(ws + WS_CNT + 256) + 3 * 48};
    RUN_GEMM(ws + WS_H, 1024, ws + WS_W_MLA_OUT, TOK, 1024, 1024, 0, e, bid);
  } PH_FIN
}

extern "C" void kernel_launch(void* const* d_in, const int* in_sizes, int n_in, void* d_out, int out_size, void* d_ws, size_t ws_size,
                              hipStream_t stream) {
  static int grid_blocks = 0;
  if (!grid_blocks) {
    int dev = 0, cus = 0, per_cu = 0;
    (void)hipGetDevice(&dev);
    (void)hipDeviceGetAttribute(&cus, hipDeviceAttributeMultiprocessorCount, dev);
    (void)hipFuncSetAttribute((const void*)mega, hipFuncAttributeMaxDynamicSharedMemorySize, DYN_LDS);
    (void)hipOccupancyMaxActiveBlocksPerMultiprocessor(&per_cu, (const void*)mega, NT, DYN_LDS);
    if (per_cu < 1) per_cu = 1;
    if (per_cu > 1) per_cu = 1;
    grid_blocks = cus * per_cu;
  }
  Params p{};
  for (int i = 0; i < 33; ++i) p.in[i] = (const float*)d_in[i];
  p.out = (float*)d_out;
  p.ws = (unsigned char*)d_ws;
#if MULTI_LAUNCH
  (void)hipMemsetAsync((unsigned char*)d_ws + WS_CNT, 0, 4096 + XCD_BAR_WORDS * 4, stream);
  for (int ph = 0; ph < NPHASES; ++ph) {
    p.phase_lo = ph; p.phase_hi = ph + 1;
    hipLaunchKernelGGL(mega, dim3(grid_blocks), dim3(NT), DYN_LDS, stream, p);
#ifdef PROBE_MASK
    if ((PROBE_MASK >> ph) & 1) { p.flags = PROBE_FLAGS; for (int r = 0; r < 2; ++r) {
      if (ph == 3) (void)hipMemsetAsync((unsigned char*)d_ws + WS_CNT, 0, 64, stream);
      hipLaunchKernelGGL(mega, dim3(grid_blocks), dim3(NT), DYN_LDS, stream, p);
    } p.flags = 0; }
#endif
  }
#else
  p.phase_lo = 0; p.phase_hi = NPHASES;
  (void)hipMemsetAsync((unsigned char*)d_ws + WS_CNT, 0, 4096 + XCD_BAR_WORDS * 4, stream);
  void* args[] = {&p};
  hipError_t e = hipLaunchCooperativeKernel((const void*)mega, dim3(grid_blocks), dim3(NT), args, DYN_LDS, stream);
  if (e != hipSuccess) fprintf(stderr, "cooperative launch failed: %s (grid %d)\n", hipGetErrorString(e), grid_blocks);
#endif
}
```

```cpp
#include <hip/hip_runtime.h>
#include <hip/hip_cooperative_groups.h>
#include <cstdio>
namespace cg = cooperative_groups;

#ifndef MULTI_LAUNCH
#define MULTI_LAUNCH 0
#endif

typedef unsigned short u16;
using bf16x8 = __attribute__((ext_vector_type(8))) short;
using f32x4 = __attribute__((ext_vector_type(4))) float;
typedef _Float16 h4 __attribute__((ext_vector_type(4)));

#define TOK 12288
#define NPROMPT 8192
#define KVROWS 14336
#define NPHASES 23
#ifndef PHMASK
#define PHMASK 0x7fffff
#endif
#define DN_ALPHA 1.6817928305074290f

#define WS_W_HG_IN 0ull
#define WS_W_HG_OUT (WS_W_HG_IN + 10485760ull)
#define WS_W_SC_IN (WS_W_HG_OUT + 2097152ull)
#define WS_W_SC_OUT (WS_W_SC_IN + 8388608ull)
#define WS_W_RG_IN (WS_W_SC_OUT + 2097152ull)
#define WS_W_RG_GATE (WS_W_RG_IN + 4194304ull)
#define WS_W_RG_OUT (WS_W_RG_GATE + 2097152ull)
#define WS_W_MLA_IN (WS_W_RG_OUT + 2097152ull)
#define WS_W_QB (WS_W_MLA_IN + 3670016ull)
#define WS_W_KVB (WS_W_QB + 1179648ull)
#define WS_W_MLA_OUT (WS_W_KVB + 1048576ull)
#define WS_MOD (WS_W_MLA_OUT + 2097152ull)
#define WS_LB (WS_MOD + 245760ull)
#define WS_CNT (WS_LB + 8192ull)
#define WS_R (WS_CNT + 4096ull + 16384ull)
#define BSZ 25165824ull
#define WS_H (WS_R)
#define WS_B(i) (WS_R + BSZ * (1 + (i)))
#define WS_SLOT (WS_R + 201326592ull)
#define WS_XB (WS_SLOT + 1572864ull)
#define WS3_CQ (WS_R + 25165824ull)
#define WS3_CKVALL (WS_R + 34603008ull)
#define WS3_CKVRAW (WS_R + 41943040ull)
#define WS3_KPERAW (WS_R + 54525952ull)
#define WS3_SG (WS_R + 56098816ull)
#define WS3_Q (WS_R + 81264640ull)
#define WS3_K (WS_R + 119013376ull)
#define WS3_VT (WS_R + 163053568ull)

#define OUT_HG 12582912
#define OUT_RG 20971520
#define OUT_CKV 21037056
#define OUT_KPE 23134208

struct Params {
  const float* in[33];
  float* out;
  unsigned char* ws;
  int phase_lo, phase_hi, flags, pad_;
};

__device__ __forceinline__ u16 f2bf(float f) { __bf16 r = (__bf16)f; return *(u16*)&r; }
__device__ __forceinline__ float bf2f(u16 h) { return __uint_as_float(((unsigned)h) << 16); }
typedef float f2v_ __attribute__((ext_vector_type(2)));
typedef __bf16 b2v_ __attribute__((ext_vector_type(2)));
__device__ __forceinline__ unsigned pack2(float a, float b) { f2v_ f = {a, b}; b2v_ r = __builtin_convertvector(f, b2v_); return *(unsigned*)&r; }
__device__ __forceinline__ uint2 pack4(float a, float b, float c, float d) { return make_uint2(pack2(a, b), pack2(c, d)); }
__device__ __forceinline__ float lo16(unsigned u) { return __uint_as_float(u << 16); }
__device__ __forceinline__ float hi16(unsigned u) { return __uint_as_float(u & 0xffff0000u); }
__device__ __forceinline__ float sigmoidf_(float x) { return __builtin_amdgcn_rcpf(1.0f + __expf(-x)); }
__device__ __forceinline__ float siluf_(float x) { return x * __builtin_amdgcn_rcpf(1.0f + __expf(-x)); }
__device__ __forceinline__ int cond_of(int tok) { return tok < NPROMPT ? 0 : 1 + ((tok - NPROMPT) >> 10); }
__device__ __forceinline__ float wave_sum(float v) {
#pragma unroll
  for (int o = 32; o > 0; o >>= 1) v += __shfl_xor(v, o);
  return v;
}
__device__ __forceinline__ void rope_sincos(float pos, int fi, float& sn, float& cs) {
  float inv = exp2f(-(float)fi * 1.6609640474436813f);
  float ang = pos * inv;
  float k = rintf(ang * 0.15915494309189535f);
  float r = fmaf(-k, 6.2831854820251465f, ang);
  r = fmaf(-k, -1.7484555e-7f, r);
  sn = __sinf(r); cs = __cosf(r);
}

#define NT 512
#define NW 8
#define LAS __attribute__((address_space(3)))

namespace pg8 {
constexpr int BM = 256, BK = 64, HALF = 128, HTB = HALF * BK * 2, STAGE_BYTES = 8 * HTB, NXCD = 8, WGM = 8;
__device__ __forceinline__ int lds_byte(int r, int c) { const int st = (r >> 4) * 2 + (c >> 5), rr = r & 15, cc = c & 31, ob = rr * 64 + cc * 2; return st * 1024 + (ob ^ (((ob >> 9) & 1) << 5)); }
__device__ __forceinline__ void stage_rc(int b, int& R, int& C) { const int st = b / 1024, sb = b % 1024, swz = sb ^ (((sb >> 9) & 1) << 5); R = (st >> 1) * 16 + swz / 64; C = (st & 1) * 32 + (swz % 64) / 2; }
struct Unit { int pm, pn; };
struct Gemm { const u16* A; const u16* Bt; int M, N, K, lda, gate, noepi; size_t kstepA, gstride; };
struct StaticOrder {
  int nM, nN, nwg, G, c, ubeg, uend;
  __device__ void init(int M, int N, int G_, int c_) { nM = M / BM; nN = N / BM; nwg = nM * nN; G = G_; c = c_; ubeg = 0; uend = nwg; }
  __device__ bool next(int i, Unit& u) const {
    const long L = (long)ubeg + (long)i * G + c; if (L >= uend) return false;
    int wgid = (int)L; { const int q = nwg / NXCD, r = nwg % NXCD, xcd = wgid % NXCD, off = wgid / NXCD; wgid = (xcd < r ? xcd * (q + 1) : r * (q + 1) + (xcd - r) * q) + off; }
    const int nig = WGM * nN, gid = wgid / nig, fm = gid * WGM, gsz = (nM - fm) < WGM ? (nM - fm) : WGM;
    u.pm = fm + ((wgid % nig) % gsz); u.pn = (wgid % nig) / gsz; return true;
  }
};
template <class Epi>
__device__ __forceinline__ void gemm_phase(LAS unsigned char* lds, const Gemm g, const StaticOrder& S, const Epi& E) {
  const int tid = threadIdx.x, wid = __builtin_amdgcn_readfirstlane(tid >> 6), lane = tid & 63, wr = wid >> 2, wc = wid & 3, fr = lane & 15, fq = lane >> 4;
  const int K = g.K, nt = K / BK;
  unsigned voffA[2], voffB[2];
#pragma unroll
  for (int i = 0; i < 2; ++i) { int R, C; stage_rc(tid * 16 + i * 8192, R, C); voffA[i] = (unsigned)(R * g.lda + C) * 2u; voffB[i] = (unsigned)(R * K + C) * 2u; }
  const size_t kstep = (size_t)(BK * 2);
  const size_t kstepA = g.kstepA;
  const size_t hstepA = (size_t)HALF * g.lda * 2, hstepB = (size_t)HALF * K * 2;
  const size_t tstepA = 2 * hstepA, tstepB = 2 * hstepB;
  const unsigned ldsw = (unsigned)wid * 1024u;
  const int aoff = lds_byte(wr * 64 + fr, fq * 8), boff = lds_byte(wc * 32 + fr, fq * 8);
#define PG8_AOFF(pn) (g.gate ? (size_t)(((pn) >> 1) & 3) * g.gstride : (size_t)0)
#define PG8_SA(b, h) (((b) * 2 + (h)) * HTB)
#define PG8_SB(b, h) ((4 + (b) * 2 + (h)) * HTB)
#define PG8_STAGE(bufoff, gbase, voff) do { _Pragma("unroll") for (int _i = 0; _i < 2; ++_i) \
    __builtin_amdgcn_global_load_lds((const unsigned*)((const char*)(gbase) + (voff)[_i]), (LAS unsigned*)(lds + (bufoff) + ldsw + _i * 8192), 16, 0, 0); } while (0)
#define PG8_LDA(dst, b, h) do { _Pragma("unroll") for (int m = 0; m < 4; ++m) _Pragma("unroll") for (int k = 0; k < 2; ++k) dst[m][k] = *(const LAS bf16x8*)(lds + PG8_SA(b, h) + aoff + m * 2048 + k * 1024); } while (0)
#define PG8_LDB(dst, b, h) do { _Pragma("unroll") for (int n = 0; n < 2; ++n) _Pragma("unroll") for (int k = 0; k < 2; ++k) dst[n][k] = *(const LAS bf16x8*)(lds + PG8_SB(b, h) + boff + n * 2048 + k * 1024); } while (0)
#define PG8_MMA(ai, bj, At, Bt) do { __builtin_amdgcn_s_setprio(1); _Pragma("unroll") for (int m = 0; m < 4; ++m) _Pragma("unroll") for (int n = 0; n < 2; ++n) _Pragma("unroll") for (int k = 0; k < 2; ++k) \
    acc[ai][bj][m][n] = __builtin_amdgcn_mfma_f32_16x16x32_bf16(Bt[n][k], At[m][k], acc[ai][bj][m][n], 0, 0, 0); __builtin_amdgcn_s_setprio(0); } while (0)
#define PG8_WAIT_V(n) asm volatile("s_waitcnt vmcnt(" #n ")" ::: "memory")
#define PG8_WAIT_L(n) asm volatile("s_waitcnt lgkmcnt(" #n ")" ::: "memory")
#define PG8_BAR __builtin_amdgcn_s_barrier()
#define PG8_SCHED __builtin_amdgcn_sched_barrier(0)
  Unit cur, nxt; int ui = 0;
  if (!S.next(0, cur)) return;
  f32x4 acc[2][2][4][2];
#pragma unroll
  for (int a = 0; a < 2; ++a)
#pragma unroll
    for (int b = 0; b < 2; ++b)
#pragma unroll
      for (int m = 0; m < 4; ++m)
#pragma unroll
        for (int n = 0; n < 2; ++n) acc[a][b][m][n] = (f32x4){0.f, 0.f, 0.f, 0.f};
  bf16x8 At[4][2], B0[2][2], B1[2][2];
  const char* cA = (const char*)g.A + (size_t)cur.pm * tstepA + PG8_AOFF(cur.pn); const char* cB = (const char*)g.Bt + (size_t)cur.pn * tstepB;
  PG8_STAGE(PG8_SB(0, 0), cB, voffB); PG8_STAGE(PG8_SA(0, 0), cA, voffA); PG8_STAGE(PG8_SB(0, 1), cB + hstepB, voffB); PG8_STAGE(PG8_SA(0, 1), cA + hstepA, voffA);
  if (wr == 1) PG8_BAR;
  PG8_WAIT_V(4); PG8_BAR;
  PG8_STAGE(PG8_SB(1, 0), cB + kstep, voffB); PG8_STAGE(PG8_SA(1, 0), cA + kstepA, voffA); PG8_STAGE(PG8_SB(1, 1), cB + hstepB + kstep, voffB);
  PG8_WAIT_V(6); PG8_BAR;
  for (;;) {
    const bool has_next = S.next(ui + 1, nxt);
    const char* nA = has_next ? (const char*)g.A + (size_t)nxt.pm * tstepA + PG8_AOFF(nxt.pn) : cA; const char* nB = has_next ? (const char*)g.Bt + (size_t)nxt.pn * tstepB : cB;
#pragma unroll 1
    for (int t = 0; t < nt; t += 2) {
      const bool last = (t == nt - 2);
      const char* a1 = cA + (size_t)(t + 1) * kstepA;
      const char* a2 = last ? nA : cA + (size_t)(t + 2) * kstepA; const char* b2 = last ? nB : cB + (size_t)(t + 2) * kstep;
      const char* a3 = a2 + kstepA; const char* b3 = b2 + kstep;
      PG8_LDB(B0, 0, 0); PG8_SCHED; PG8_LDA(At, 0, 0); PG8_STAGE(PG8_SA(1, 1), a1 + hstepA, voffA);
      PG8_WAIT_L(8); PG8_BAR; PG8_WAIT_L(0); PG8_MMA(0, 0, At, B0); PG8_BAR; PG8_SCHED;
      PG8_LDB(B1, 0, 1); PG8_STAGE(PG8_SB(0, 0), b2, voffB);
      PG8_BAR; PG8_WAIT_L(0); PG8_MMA(0, 1, At, B1); PG8_BAR;
      PG8_LDA(At, 0, 1); PG8_STAGE(PG8_SA(0, 0), a2, voffA);
      PG8_BAR; PG8_WAIT_L(0); PG8_MMA(1, 0, At, B0); PG8_BAR; PG8_SCHED;
      PG8_STAGE(PG8_SB(0, 1), b2 + hstepB, voffB);
      PG8_WAIT_V(6); PG8_BAR; PG8_MMA(1, 1, At, B1); PG8_BAR;
      PG8_LDB(B0, 1, 0); PG8_SCHED; PG8_LDA(At, 1, 0); PG8_STAGE(PG8_SA(0, 1), a2 + hstepA, voffA);
      PG8_WAIT_L(8); PG8_BAR; PG8_WAIT_L(0); PG8_MMA(0, 0, At, B0); PG8_BAR; PG8_SCHED;
      PG8_LDB(B1, 1, 1); PG8_STAGE(PG8_SB(1, 0), b3, voffB);
      PG8_BAR; PG8_WAIT_L(0); PG8_MMA(0, 1, At, B1); PG8_BAR;
      PG8_LDA(At, 1, 1); PG8_STAGE(PG8_SA(1, 0), a3, voffA);
      PG8_BAR; PG8_WAIT_L(0); PG8_MMA(1, 0, At, B0); PG8_BAR; PG8_SCHED;
      PG8_STAGE(PG8_SB(1, 1), b3 + hstepB, voffB);
      PG8_WAIT_V(6); PG8_BAR; PG8_MMA(1, 1, At, B1); PG8_BAR;
    }
    if constexpr (!Epi::AFTER_DRAIN) { if (!g.noepi) E(acc, cur, wr, wc, fr, fq); }
    if (!has_next) break;
#pragma unroll
    for (int a = 0; a < 2; ++a)
#pragma unroll
      for (int b = 0; b < 2; ++b)
#pragma unroll
        for (int m = 0; m < 4; ++m)
#pragma unroll
          for (int n = 0; n < 2; ++n) acc[a][b][m][n] = (f32x4){0.f, 0.f, 0.f, 0.f};
    cur = nxt; cA = nA; cB = nB; ++ui;
  }
  PG8_WAIT_V(0);
  if (wr == 0) PG8_BAR;
  PG8_BAR;
  if constexpr (Epi::AFTER_DRAIN) { if (!g.noepi) E.fused(acc, cur, wr, wc, fr, fq, lds); }
#undef PG8_AOFF
#undef PG8_SA
#undef PG8_SB
#undef PG8_STAGE
#undef PG8_LDA
#undef PG8_LDB
#undef PG8_MMA
#undef PG8_WAIT_V
#undef PG8_WAIT_L
#undef PG8_BAR
#undef PG8_SCHED
}
}
using pg8::Unit;
typedef const f32x4 (&AccRef)[2][2][4][2];

#define EPI_ROWS(...) _Pragma("unroll") for (int ai = 0; ai < 2; ++ai) _Pragma("unroll") for (int m = 0; m < 4; ++m) { const int row = u.pm * 256 + ai * 128 + wr * 64 + m * 16 + fr; __VA_ARGS__ }
#define EPI_COLS(...) _Pragma("unroll") for (int bj = 0; bj < 2; ++bj) _Pragma("unroll") for (int n = 0; n < 2; ++n) { const int cb = u.pn * 256 + bj * 128 + wc * 32 + n * 16; const f32x4 a = acc[ai][bj][m][n]; __VA_ARGS__ }

struct EpiHgIn {
  static constexpr bool AFTER_DRAIN = false;
  u16 *q, *v, *sg; _Float16* lf; const float* lb;
  __device__ __forceinline__ void operator()(AccRef acc, const Unit& u, int wr, int wc, int fr, int fq) const {
    const int region = u.pn >> 2;
    f32x4 l4[2][2];
    if (region == 1 || region == 2) {
#pragma unroll
      for (int bj = 0; bj < 2; ++bj)
#pragma unroll
        for (int n = 0; n < 2; ++n) l4[bj][n] = *(const f32x4*)&lb[(region - 1) * 1024 + ((u.pn * 256 + bj * 128 + wc * 32 + n * 16) & 1023) + fq * 4];
    }
    EPI_ROWS( EPI_COLS(
      const int c = (cb & 1023) + fq * 4;
      if (region == 0) {
        const float s = 0.08838834764831845f;
        *(uint2*)&q[(size_t)row * 1024 + c] = pack4(siluf_(a[0]) * s, siluf_(a[1]) * s, siluf_(a[2]) * s, siluf_(a[3]) * s);
      } else if (region <= 2) {
        const int d = region - 1;
        h4 o;
        _Pragma("unroll") for (int j = 0; j < 4; ++j) { float f = l4[bj][n][j] + (1.0f - l4[bj][n][j]) * sigmoidf_(a[j]); o[j] = (_Float16)__builtin_amdgcn_logf(f); }
        *(h4*)&lf[(size_t)row * 2048 + d * 1024 + c] = o;
      } else if (region == 3) {
        *(uint2*)&v[(size_t)row * 1024 + c] = pack4(a[0], a[1], a[2], a[3]);
      } else {
        *(uint2*)&sg[(size_t)row * 1024 + c] = pack4(a[0], a[1], a[2], a[3]);
      }
    ) )
  }
};

struct EpiRes {
  static constexpr bool AFTER_DRAIN = false;
  const float* xin_p; const float* xin_s; float* Y; const float* gate;
  __device__ __forceinline__ void operator()(AccRef acc, const Unit& u, int wr, int wc, int fr, int fq) const {
    EPI_ROWS(
      const float* xr = row < NPROMPT ? xin_p + (size_t)row * 1024 : xin_s + (size_t)(row - NPROMPT) * 1024;
      const float* g = gate + cond_of(row) * 3072;
      EPI_COLS(
        const int c = cb + fq * 4;
        f32x4 x = *(const f32x4*)&xr[c];
        f32x4 gg = *(const f32x4*)&g[c];
        f32x4 y;
        _Pragma("unroll") for (int j = 0; j < 4; ++j) y[j] = DN_ALPHA * x[j] + gg[j] * a[j];
        *(f32x4*)&Y[(size_t)row * 1024 + c] = y;
      ) )
  }
};

template <bool XIN_BF, bool XOUT_BF>
struct EpiResLn {
  static constexpr bool AFTER_DRAIN = true;
  const float* xin_p; const float* xin_s; const u16* xin_b; float* X; u16* XB; const float* gate; const float* lg; const float* lbias; const float* modn; u16* H;
  unsigned long long* slots; unsigned* cnt;
  __device__ __forceinline__ void fused(f32x4 (&acc)[2][2][4][2], const Unit& u, int wr, int wc, int fr, int fq, LAS unsigned char* lds) const {
    LAS float* part = (LAS float*)lds;
    LAS float* stat = part + 2048;
    const int tid = threadIdx.x;
    const int cnd = cond_of(u.pm * 256);
    f32x4 gv[2][2];
#pragma unroll
    for (int bj = 0; bj < 2; ++bj)
#pragma unroll
      for (int n = 0; n < 2; ++n) gv[bj][n] = *(const f32x4*)&gate[cnd * 3072 + u.pn * 256 + bj * 128 + wc * 32 + n * 16 + fq * 4];
#pragma unroll
    for (int ai = 0; ai < 2; ++ai)
#pragma unroll
      for (int m = 0; m < 4; ++m) {
        const int rl = ai * 128 + wr * 64 + m * 16 + fr;
        const int row = u.pm * 256 + rl;
        const float* xr = row < NPROMPT ? xin_p + (size_t)row * 1024 : xin_s + (size_t)(row - NPROMPT) * 1024;
        float s1 = 0.f, s2 = 0.f;
#pragma unroll
        for (int bj = 0; bj < 2; ++bj)
#pragma unroll
          for (int n = 0; n < 2; ++n) {
            const int c = u.pn * 256 + bj * 128 + wc * 32 + n * 16 + fq * 4;
            f32x4 x;
            if constexpr (XIN_BF) { const uint2 xb2 = *(const uint2*)&xin_b[(size_t)row * 1024 + c]; x = f32x4{lo16(xb2.x), hi16(xb2.x), lo16(xb2.y), hi16(xb2.y)}; }
            else x = *(const f32x4*)&xr[c];
            const f32x4 gg = gv[bj][n];
            f32x4 y;
#pragma unroll
            for (int j = 0; j < 4; ++j) { y[j] = DN_ALPHA * x[j] + gg[j] * acc[ai][bj][m][n][j]; s1 += y[j]; s2 += y[j] * y[j]; }
            acc[ai][bj][m][n] = y;
          }
        s1 += __shfl_xor(s1, 16); s1 += __shfl_xor(s1, 32);
        s2 += __shfl_xor(s2, 16); s2 += __shfl_xor(s2, 32);
        if (fq == 0) { part[(rl * 4 + wc) * 2] = s1; part[(rl * 4 + wc) * 2 + 1] = s2; }
      }
    __syncthreads();
    if (tid < 256) {
      float S1 = 0.f, S2 = 0.f;
#pragma unroll
      for (int w2 = 0; w2 < 4; ++w2) { S1 += part[(tid * 4 + w2) * 2]; S2 += part[(tid * 4 + w2) * 2 + 1]; }
      const unsigned long long v = (unsigned long long)__float_as_uint(S1) | ((unsigned long long)__float_as_uint(S2) << 32);
      __hip_atomic_store(&slots[(size_t)(u.pm * 4 + u.pn) * 256 + tid], v, __ATOMIC_RELAXED, __HIP_MEMORY_SCOPE_AGENT);
    }
    asm volatile("s_waitcnt vmcnt(0)" ::: "memory");
    __syncthreads();
    if (tid == 0) {
      __hip_atomic_fetch_add(&cnt[u.pm], 1u, __ATOMIC_RELAXED, __HIP_MEMORY_SCOPE_AGENT);
      unsigned sp = 0;
      while (__hip_atomic_load(&cnt[u.pm], __ATOMIC_RELAXED, __HIP_MEMORY_SCOPE_AGENT) < 4u) { __builtin_amdgcn_s_sleep(1); if (++sp > (1u << 24)) break; }
    }
    __syncthreads();
    if (tid < 256) {
      float T1 = 0.f, T2 = 0.f;
#pragma unroll
      for (int o = 0; o < 4; ++o) {
        const unsigned long long v = __hip_atomic_load(&slots[(size_t)(u.pm * 4 + o) * 256 + tid], __ATOMIC_RELAXED, __HIP_MEMORY_SCOPE_AGENT);
        T1 += __uint_as_float((unsigned)(v & 0xffffffffull)); T2 += __uint_as_float((unsigned)(v >> 32));
      }
      const float mu = T1 * (1.0f / 1024.0f);
      const float var = fmaxf(T2 * (1.0f / 1024.0f) - mu * mu, 0.f);
      stat[tid * 2] = mu; stat[tid * 2 + 1] = rsqrtf(var + 1e-5f);
    }
    __syncthreads();
#pragma unroll
    for (int bj = 0; bj < 2; ++bj) {
      f32x4 lgv[2], lbv[2], shv[2], scv[2];
#pragma unroll
      for (int n = 0; n < 2; ++n) {
        const int c = u.pn * 256 + bj * 128 + wc * 32 + n * 16 + fq * 4;
        lgv[n] = *(const f32x4*)&lg[c]; lbv[n] = *(const f32x4*)&lbias[c];
        shv[n] = *(const f32x4*)&modn[cnd * 3072 + c]; scv[n] = *(const f32x4*)&modn[cnd * 3072 + 1024 + c];
      }
#pragma unroll
      for (int ai = 0; ai < 2; ++ai)
#pragma unroll
        for (int m = 0; m < 4; ++m) {
          const int rl = ai * 128 + wr * 64 + m * 16 + fr;
          const int row = u.pm * 256 + rl;
          const float mu = stat[rl * 2], rs = stat[rl * 2 + 1];
#pragma unroll
          for (int n = 0; n < 2; ++n) {
            const int c = u.pn * 256 + bj * 128 + wc * 32 + n * 16 + fq * 4;
            const f32x4 y = acc[ai][bj][m][n];
            f32x4 xo;
#pragma unroll
            for (int j = 0; j < 4; ++j) xo[j] = (y[j] - mu) * rs * lgv[n][j] + lbv[n][j];
            if constexpr (XOUT_BF) *(uint2*)&XB[(size_t)row * 1024 + c] = pack4(xo[0], xo[1], xo[2], xo[3]);
            else *(f32x4*)&X[(size_t)row * 1024 + c] = xo;
            if (H) {
              *(uint2*)&H[(size_t)row * 1024 + c] = pack4(xo[0] * (1 + scv[n][0]) + shv[n][0], xo[1] * (1 + scv[n][1]) + shv[n][1], xo[2] * (1 + scv[n][2]) + shv[n][2], xo[3] * (1 + scv[n][3]) + shv[n][3]);
            }
          }
        }
    }
  }
};

struct EpiScIn {
  static constexpr bool AFTER_DRAIN = false;
  u16 *pb, *sb;
  __device__ __forceinline__ void operator()(AccRef acc, const Unit& u, int wr, int wc, int fr, int fq) const {
    const int c = u.pn * 64 + wc * 16 + fq * 4;
    EPI_ROWS(
      const f32x4 bg = acc[ai][0][m][0], cgv = acc[ai][0][m][1], v = acc[ai][1][m][0], g = acc[ai][1][m][1];
      *(uint2*)&pb[(size_t)row * 1024 + c] = pack4(cgv[0] * v[0], cgv[1] * v[1], cgv[2] * v[2], cgv[3] * v[3]);
      *(uint2*)&sb[(size_t)row * 1024 + c] = pack4(siluf_(g[0]) * bg[0], siluf_(g[1]) * bg[1], siluf_(g[2]) * bg[2], siluf_(g[3]) * bg[3]);
    )
  }
};

struct EpiRgIn {
  static constexpr bool AFTER_DRAIN = false;
  u16 *ub, *sg;
  __device__ __forceinline__ void operator()(AccRef acc, const Unit& u, int wr, int wc, int fr, int fq) const {
    const int region = u.pn >> 2;
    EPI_ROWS( EPI_COLS(
      const int c = (cb & 1023) + fq * 4;
      if (region == 0) *(uint2*)&ub[(size_t)row * 1024 + c] = pack4(a[0], a[1], a[2], a[3]);
      else *(uint2*)&sg[((size_t)(c >> 6) * TOK + row) * 64 + (c & 63)] = pack4(siluf_(a[0]), siluf_(a[1]), siluf_(a[2]), siluf_(a[3]));
    ) )
  }
};

struct EpiSgGM {
  static constexpr bool AFTER_DRAIN = false;
  u16* sg;
  __device__ __forceinline__ void operator()(AccRef acc, const Unit& u, int wr, int wc, int fr, int fq) const {
    EPI_ROWS( EPI_COLS(
      const int c = cb + fq * 4;
      *(uint2*)&sg[((size_t)(c >> 6) * TOK + row) * 64 + (c & 63)] = pack4(siluf_(a[0]), siluf_(a[1]), siluf_(a[2]), siluf_(a[3]));
    ) )
  }
};

struct EpiRgGate {
  static constexpr bool AFTER_DRAIN = false;
  u16 *rb, *ib; const float* bgate;
  __device__ __forceinline__ void operator()(AccRef acc, const Unit& u, int wr, int wc, int fr, int fq) const {
    const int mat = u.pn >> 1, d = mat >> 2, hd = mat & 3;
    f32x4 br[2], bi[2]; int ccs[2];
#pragma unroll
    for (int bj = 0; bj < 2; ++bj) {
      const int off = ((u.pn & 1) * 256 + bj * 128 + wc * 32);
      ccs[bj] = (off >> 5) * 16 + fq * 4;
      br[bj] = *(const f32x4*)&bgate[mat * 512 + ccs[bj]];
      bi[bj] = *(const f32x4*)&bgate[mat * 512 + 256 + ccs[bj]];
    }
    EPI_ROWS(
      _Pragma("unroll") for (int bj = 0; bj < 2; ++bj) {
        const f32x4 r = acc[ai][bj][m][0], ii = acc[ai][bj][m][1];
        const int cch = hd * 256 + ccs[bj];
        const size_t o = (size_t)d * TOK * 1024 + ((size_t)(cch >> 6) * TOK + row) * 64 + (cch & 63);
        *(uint2*)&rb[o] = pack4(sigmoidf_(r[0] + br[bj][0]), sigmoidf_(r[1] + br[bj][1]), sigmoidf_(r[2] + br[bj][2]), sigmoidf_(r[3] + br[bj][3]));
        *(uint2*)&ib[o] = pack4(sigmoidf_(ii[0] + bi[bj][0]), sigmoidf_(ii[1] + bi[bj][1]), sigmoidf_(ii[2] + bi[bj][2]), sigmoidf_(ii[3] + bi[bj][3]));
      } )
  }
};

struct EpiMlaIn {
  static constexpr bool AFTER_DRAIN = false;
  u16* cq; float* ckvraw; float* kperaw; u16* sg;
  __device__ __forceinline__ void operator()(AccRef acc, const Unit& u, int wr, int wc, int fr, int fq) const {
    EPI_ROWS( EPI_COLS(
      const int c = cb + fq * 4;
      if (cb < 384) *(uint2*)&cq[(size_t)row * 384 + c] = pack4(a[0], a[1], a[2], a[3]);
      else if (cb < 640) *(f32x4*)&ckvraw[(size_t)row * 256 + (c - 384)] = a;
      else if (cb < 672) *(f32x4*)&kperaw[(size_t)row * 32 + (c - 640)] = a;
    ) )
  }
};

struct EpiSg {
  static constexpr bool AFTER_DRAIN = false;
  u16* sg;
  __device__ __forceinline__ void operator()(AccRef acc, const Unit& u, int wr, int wc, int fr, int fq) const {
    EPI_ROWS( EPI_COLS(
      *(uint2*)&sg[(size_t)row * 1024 + cb + fq * 4] = pack4(a[0], a[1], a[2], a[3]);
    ) )
  }
};

struct EpiQ {
  static constexpr bool AFTER_DRAIN = false;
  u16* q;
  __device__ __forceinline__ void operator()(AccRef acc, const Unit& u, int wr, int wc, int fr, int fq) const {
    const float sc = 0.14724444500602648f;
    EPI_ROWS( EPI_COLS(
      *(uint2*)&q[(size_t)row * 1536 + cb + fq * 4] = pack4(a[0] * sc, a[1] * sc, a[2] * sc, a[3] * sc);
    ) )
  }
};

struct EpiK {
  static constexpr bool AFTER_DRAIN = false;
  u16* Kb;
  __device__ __forceinline__ void operator()(AccRef acc, const Unit& u, int wr, int wc, int fr, int fq) const {
    EPI_ROWS( EPI_COLS(
      const int h = cb >> 6, dd = (cb & 63) + fq * 4;
      *(uint2*)&Kb[((size_t)row * 16 + h) * 96 + dd] = pack4(a[0], a[1], a[2], a[3]);
    ) )
  }
};
struct EpiV {
  static constexpr bool AFTER_DRAIN = false;
  u16* Vt;
  __device__ __forceinline__ void operator()(AccRef acc, const Unit& u, int wr, int wc, int fr, int fq) const {
    EPI_ROWS( EPI_COLS(
      *(uint2*)&Vt[(size_t)row * KVROWS + cb + fq * 4] = pack4(a[0], a[1], a[2], a[3]);
    ) )
  }
};

__device__ __forceinline__ void wconv_tile(const float* __restrict__ src, int N, int K, u16* __restrict__ dst, int k0, int n0,
                                           int perm, int mat, float* tile) {
  const int tid = threadIdx.x;
  {
    const int r = tid >> 4, c4 = (tid & 15) * 4;
#pragma unroll
    for (int i = 0; i < 2; ++i) {
      const int k = r + i * 32;
      f32x4 v = f32x4{0.f, 0.f, 0.f, 0.f};
      if (n0 + c4 < N) v = __builtin_nontemporal_load((const f32x4*)&src[(size_t)(k0 + k) * N + n0 + c4]);
      tile[k * 65 + c4 + 0] = v[0]; tile[k * 65 + c4 + 1] = v[1]; tile[k * 65 + c4 + 2] = v[2]; tile[k * 65 + c4 + 3] = v[3];
    }
  }
  __syncthreads();
  {
    const int nl = tid >> 3, kq = (tid & 7) * 8;
    const int n = n0 + nl;
    int np = n;
    if (perm == 1) { const int part = n >> 10, c = n & 1023; np = (c >> 6) * 256 + (part >> 1) * 128 + ((c >> 4) & 3) * 32 + (part & 1) * 16 + (c & 15); }
    else if (perm == 2) { const int type = n >> 8, cc = n & 255; np = mat * 512 + (cc >> 4) * 32 + type * 16 + (cc & 15); }
    else if (perm == 3) { const int hh = n >> 7, dd = n & 127; np = (dd >= 64 ? 1024 : 0) + hh * 64 + (dd & 63); }
    if (n < N) {
      unsigned w[4];
#pragma unroll
      for (int i = 0; i < 4; ++i) w[i] = pack2(tile[(kq + 2 * i) * 65 + nl], tile[(kq + 2 * i + 1) * 65 + nl]);
      *(uint4*)&dst[(size_t)np * K + k0 + kq] = make_uint4(w[0], w[1], w[2], w[3]);
    }
  }
  __syncthreads();
}

__device__ __forceinline__ void wconv_item(const Params& p, int t, float* fs) {
  const float* src; u16* dst; int N, K, perm = 0, mat = 0, ntn;
  if (t < 1280) { src = p.in[12]; dst = (u16*)(p.ws + WS_W_HG_IN); N = 5120; K = 1024; }
  else if ((t -= 1280) < 256) { src = p.in[15]; dst = (u16*)(p.ws + WS_W_HG_OUT); N = 1024; K = 1024; }
  else if ((t -= 256) < 1024) { src = p.in[16]; dst = (u16*)(p.ws + WS_W_SC_IN); N = 4096; K = 1024; perm = 1; }
  else if ((t -= 1024) < 256) { src = p.in[19]; dst = (u16*)(p.ws + WS_W_SC_OUT); N = 1024; K = 1024; }
  else if ((t -= 256) < 512) { src = p.in[20]; dst = (u16*)(p.ws + WS_W_RG_IN); N = 2048; K = 1024; }
  else if ((t -= 512) < 256) { mat = t >> 5; t &= 31; src = p.in[23] + (size_t)mat * 256 * 512; dst = (u16*)(p.ws + WS_W_RG_GATE); N = 512; K = 256; perm = 2; }
  else if ((t -= 256) < 256) { src = p.in[26]; dst = (u16*)(p.ws + WS_W_RG_OUT); N = 1024; K = 1024; }
  else if ((t -= 256) < 432) { src = p.in[27]; dst = (u16*)(p.ws + WS_W_MLA_IN); N = 1696; K = 1024; }
  else if ((t -= 432) < 144) { src = p.in[30]; dst = (u16*)(p.ws + WS_W_QB); N = 1536; K = 384; }
  else if ((t -= 144) < 128) { src = p.in[31]; dst = (u16*)(p.ws + WS_W_KVB); N = 2048; K = 256; perm = 3; }
  else { t -= 128; src = p.in[32]; dst = (u16*)(p.ws + WS_W_MLA_OUT); N = 1024; K = 1024; }
  ntn = (N + 63) >> 6;
  const int kt = t / ntn, ntl = t - kt * ntn;
  wconv_tile(src, N, K, dst, kt * 64, ntl * 64, perm, mat, fs);
}
__device__ __forceinline__ void wconv_idle(const Params& p, unsigned char* smem_raw, int bid, int nb, int t0, int t1) {
  if (nb == 256 && bid >= 192) for (int t = t0 + (bid - 192); t < t1; t += 64) wconv_item(p, t, (float*)smem_raw);
}

__device__ __forceinline__ void phase_prologue(const Params& p, unsigned char* smem_raw, int bid, int nb) {
  float* fs = (float*)smem_raw;
  const int tid = threadIdx.x;
  const int NMOD = 192, NWT = (nb == 256) ? 1536 : 4800;
  for (int it = bid; it < NMOD + 1 + NWT; it += nb) {
    if (it < NMOD) {
      const int l = it / 48, n0 = (it % 48) * 64;
      float* scond = fs;
      float* sred = fs + 5120;
      for (int i = tid; i < 5120; i += NT) {
        const int ci = i >> 10, k = i & 1023;
        float cv = ci == 0 ? p.in[7][k] : p.in[6][(ci - 1) * 1024 + k];
        scond[i] = siluf_(cv);
      }
      __syncthreads();
      const int col = tid & 63, kg = tid >> 6;
      const float* w = p.in[8] + (size_t)l * 1024 * 3072 + n0 + col;
      float a0 = 0, a1 = 0, a2 = 0, a3 = 0, a4 = 0;
#pragma unroll 16
      for (int k = kg * 128; k < kg * 128 + 128; ++k) {
        float wv = __builtin_nontemporal_load(&w[(size_t)k * 3072]);
        a0 += scond[k] * wv; a1 += scond[1024 + k] * wv; a2 += scond[2048 + k] * wv; a3 += scond[3072 + k] * wv; a4 += scond[4096 + k] * wv;
      }
      sred[(kg * 5 + 0) * 64 + col] = a0; sred[(kg * 5 + 1) * 64 + col] = a1; sred[(kg * 5 + 2) * 64 + col] = a2;
      sred[(kg * 5 + 3) * 64 + col] = a3; sred[(kg * 5 + 4) * 64 + col] = a4;
      __syncthreads();
      float* mod = (float*)(p.ws + WS_MOD);
      if (tid < 320) {
        const int ci = tid >> 6, cc = tid & 63;
        float s = 0;
#pragma unroll
        for (int g = 0; g < 8; ++g) s += sred[(g * 5 + ci) * 64 + cc];
        mod[(l * 5 + ci) * 3072 + n0 + cc] = s + p.in[9][l * 3072 + n0 + cc];
      }
      __syncthreads();
    } else if (it == NMOD) {
      float* lb = (float*)(p.ws + WS_LB);
      for (int i = tid; i < 2048; i += NT) {
        const int d = i >> 10, c = i & 1023;
        const float* lg = p.in[13] + d * 5 * 1024 + c;
        float m = lg[0];
        for (int j = 1; j < 5; ++j) m = fmaxf(m, lg[j * 1024]);
        float s = 0;
        for (int j = 0; j < 5; ++j) s += expf(lg[j * 1024] - m);
        lb[i] = expf(lg[0] - m) / s;
      }
      int* cnt = (int*)(p.ws + WS_CNT);
      if (tid < 16) cnt[tid] = 0;
    } else {
      wconv_item(p, it - NMOD - 1, fs);
    }
  }
}

__device__ __forceinline__ void phase_h0(const Params& p, int bid, int nb) {
  const float* mod = (const float*)(p.ws + WS_MOD);
  u16* H = (u16*)(p.ws + WS_H);
  const size_t total = (size_t)(TOK / 4) * 256;
  for (size_t i = (size_t)bid * NT + threadIdx.x; i < total; i += (size_t)nb * NT) {
    const int row = (int)(i >> 8) * 4, c = ((int)i & 255) * 4;
    const float* xr = row < NPROMPT ? p.in[0] + (size_t)row * 1024 : p.in[1] + (size_t)(row - NPROMPT) * 1024;
    const float* m = mod + cond_of(row) * 3072;
    f32x4 x[4];
#pragma unroll
    for (int t = 0; t < 4; ++t) x[t] = *(const f32x4*)&xr[t * 1024 + c];
    const f32x4 sh = *(const f32x4*)&m[c];
    const f32x4 sc = *(const f32x4*)&m[1024 + c];
#pragma unroll
    for (int t = 0; t < 4; ++t)
      *(uint2*)&H[(size_t)(row + t) * 1024 + c] = pack4(x[t][0] * (1 + sc[0]) + sh[0], x[t][1] * (1 + sc[1]) + sh[1], x[t][2] * (1 + sc[2]) + sh[2], x[t][3] * (1 + sc[3]) + sh[3]);
  }
}

__device__ __forceinline__ void phase_ln(const Params& p, int l, int bid, int nb) {
  float* X = p.out;
  const float* g = p.in[10] + l * 1024;
  const float* b = p.in[11] + l * 1024;
  const float* mod = (const float*)(p.ws + WS_MOD) + (l + 1) * 5 * 3072;
  u16* H = (u16*)(p.ws + WS_H);
  const int lane = threadIdx.x & 63, wave = threadIdx.x >> 6;
  for (int row = bid * NW + wave; row < TOK; row += nb * NW) {
    float* xr = X + (size_t)row * 1024;
    f32x4 v[4];
    float s = 0;
#pragma unroll
    for (int i = 0; i < 4; ++i) { v[i] = *(const f32x4*)&xr[i * 256 + lane * 4]; s += v[i][0] + v[i][1] + v[i][2] + v[i][3]; }
    const float mu = wave_sum(s) * (1.0f / 1024.0f);
    float q = 0;
#pragma unroll
    for (int i = 0; i < 4; ++i)
#pragma unroll
      for (int j = 0; j < 4; ++j) { float dd = v[i][j] - mu; q += dd * dd; }
    const float rs = rsqrtf(wave_sum(q) * (1.0f / 1024.0f) + 1e-5f);
    const float* m = mod + cond_of(row) * 3072;
#pragma unroll
    for (int i = 0; i < 4; ++i) {
      const int c = i * 256 + lane * 4;
      f32x4 gg = *(const f32x4*)&g[c], bb = *(const f32x4*)&b[c];
      f32x4 y;
#pragma unroll
      for (int j = 0; j < 4; ++j) y[j] = (v[i][j] - mu) * rs * gg[j] + bb[j];
      *(f32x4*)&xr[c] = y;
      if (l < 3) {
        f32x4 sh = *(const f32x4*)&m[c], sc = *(const f32x4*)&m[1024 + c];
        *(uint2*)&H[(size_t)row * 1024 + c] = pack4(y[0] * (1 + sc[0]) + sh[0], y[1] * (1 + sc[1]) + sh[1], y[2] * (1 + sc[2]) + sh[2], y[3] * (1 + sc[3]) + sh[3]);
      }
    }
  }
}

__device__ __forceinline__ void phase_gla(const Params& p, unsigned char* smem_raw) {
  u16* s_qrel = (u16*)smem_raw;
  u16* s_krel = s_qrel + 32 * 136;
  u16* s_qcum = s_krel + 32 * 136;
  u16* s_kdT = s_qcum + 32 * 136;
  u16* s_vT = s_kdT + 128 * 40;
  u16* s_att = s_vT + 128 * 40;
  u16* s_S = s_att + 32 * 40;
  float* s_dec = (float*)(s_S + 128 * 136);
  float* s_part = s_dec + 128;
  int* s_u = (int*)(s_part + 512);
  int* counter = (int*)(p.ws + WS_CNT);
  const u16* qg = (const u16*)(p.ws + WS_B(0));
  const u16* vg = (const u16*)(p.ws + WS_B(1));
  const _Float16* lfg = (const _Float16*)(p.ws + WS_B(3));
  u16* og = (u16*)(p.ws + WS_B(5));
  const int tid = threadIdx.x, lane = tid & 63, w = tid >> 6, fr = lane & 15, fq = lane >> 4;
  const int kk = tid & 127, th = tid >> 7;
  const int ti = w >> 2, vi = w & 3;
  const int wk = w & 3, wv = w >> 2;
  bool first = true;
  while (true) {
    if (tid == 0) *s_u = (first && blockIdx.x < 64) ? (int)blockIdx.x : 64 + atomicAdd(counter, 1);
    first = false;
    __syncthreads();
    const int u = *s_u;
    __syncthreads();
    if (u >= 576) break;
    int b, rem, start, N, sample;
    if (u < 64) { sample = 1; b = u >> 4; rem = u & 15; start = NPROMPT + b * 1024; N = 1024; }
    else { sample = 0; b = (u - 64) >> 4; rem = (u - 64) & 15; start = b * 256; N = 256; }
    const int h = rem >> 1, d = rem & 1;
    const int nc = N >> 5;
    f32x4 S[2][4];
#pragma unroll
    for (int mi = 0; mi < 2; ++mi)
#pragma unroll
      for (int ni = 0; ni < 4; ++ni) {
        f32x4 s4 = f32x4{0.f, 0.f, 0.f, 0.f};
        if (sample) {
          const float* s0 = p.in[2] + ((size_t)((b * 2 + d) * 8 + h)) * 16384;
#pragma unroll
          for (int j = 0; j < 4; ++j) s4[j] = s0[(wk * 32 + mi * 16 + fq * 4 + j) * 128 + wv * 64 + ni * 16 + fr];
        }
        S[mi][ni] = s4;
        *(uint2*)&s_S[(wv * 64 + ni * 16 + fr) * 136 + wk * 32 + mi * 16 + fq * 4] = pack4(s4[0], s4[1], s4[2], s4[3]);
      }
    _Float16 lfraw[8]; u16 qraw[8]; uint4 vraw;
#define GLA_LOAD(cc) do { _Pragma("unroll") for (int i = 0; i < 8; ++i) { const int tt = (cc) * 32 + th * 8 + i; const size_t tok = start + (d ? (N - 1 - tt) : tt); \
      lfraw[i] = lfg[tok * 2048 + d * 1024 + h * 128 + kk]; qraw[i] = qg[tok * 1024 + h * 128 + kk]; } \
      { const int tt = (cc) * 32 + (tid & 31); const size_t tok = start + (d ? (N - 1 - tt) : tt); vraw = *(const uint4*)&vg[tok * 1024 + h * 128 + (tid >> 5) * 8]; } } while (0)
    GLA_LOAD(0);
    for (int c = 0; c < nc; ++c) {
      {
        float lfv[8], qv[8];
#pragma unroll
        for (int i = 0; i < 8; ++i) { lfv[i] = (float)lfraw[i]; qv[i] = bf2f(qraw[i]); }
        const uint4 vv = vraw;
        if (c + 1 < nc) GLA_LOAD(c + 1);
        float run = 0;
        float cs[8];
#pragma unroll
        for (int i = 0; i < 8; ++i) { run += lfv[i]; cs[i] = run; }
        s_part[th * 128 + kk] = run;
        {
          const int s = tid & 31, v8 = (tid >> 5) * 8;
          const unsigned vw[4] = {vv.x, vv.y, vv.z, vv.w};
#pragma unroll
          for (int i = 0; i < 4; ++i) { s_vT[(v8 + 2 * i) * 40 + s] = (u16)(vw[i] & 0xffff); s_vT[(v8 + 2 * i + 1) * 40 + s] = (u16)(vw[i] >> 16); }
        }
        __syncthreads();
        const float p0 = s_part[kk], p1 = s_part[128 + kk], p2 = s_part[256 + kk], p3 = s_part[384 + kk];
        const float off = (th > 0 ? p0 : 0.f) + (th > 1 ? p1 : 0.f) + (th > 2 ? p2 : 0.f);
        const float ref = p0 + p1, total = p0 + p1 + p2 + p3;
        unsigned kd[4];
        const float eref = __builtin_amdgcn_exp2f(ref), etr = __builtin_amdgcn_exp2f(total - ref);
#pragma unroll
        for (int i = 0; i < 8; ++i) {
          const int t = th * 8 + i;
          const float cum = off + cs[i];
          const float kf = 1.0f - __builtin_amdgcn_exp2f(lfv[i]);
          const float e1 = __builtin_amdgcn_exp2f(cum - ref), e2 = __builtin_amdgcn_rcpf(e1);
          const float qe = qv[i] * e1, ke = kf * e2;
          s_qrel[t * 136 + kk] = f2bf(qe);
          s_krel[t * 136 + kk] = f2bf(ke);
          s_qcum[t * 136 + kk] = f2bf(qe * eref);
          const u16 kdv = f2bf(ke * etr);
          if (i & 1) kd[i >> 1] |= ((unsigned)kdv) << 16; else kd[i >> 1] = kdv;
        }
        *(uint4*)&s_kdT[kk * 40 + th * 8] = make_uint4(kd[0], kd[1], kd[2], kd[3]);
        if (th == 0) s_dec[kk] = eref * etr;
      }
      __syncthreads();
      f32x4 oacc[2] = {f32x4{0.f, 0.f, 0.f, 0.f}, f32x4{0.f, 0.f, 0.f, 0.f}};
      {
        f32x4 att = f32x4{0.f, 0.f, 0.f, 0.f};
        const int ati = w >> 1, asi = w & 1;
#pragma unroll
        for (int ks = 0; ks < 4; ++ks) {
          if (w < 4) {
            bf16x8 a = *(const bf16x8*)&s_qrel[(ati * 16 + fr) * 136 + ks * 32 + fq * 8];
            bf16x8 bb = *(const bf16x8*)&s_krel[(asi * 16 + fr) * 136 + ks * 32 + fq * 8];
            att = __builtin_amdgcn_mfma_f32_16x16x32_bf16(a, bb, att, 0, 0, 0);
          }
          bf16x8 a2 = *(const bf16x8*)&s_qcum[(ti * 16 + fr) * 136 + ks * 32 + fq * 8];
#pragma unroll
          for (int e = 0; e < 2; ++e) {
            bf16x8 b2 = *(const bf16x8*)&s_S[((vi * 2 + e) * 16 + fr) * 136 + ks * 32 + fq * 8];
            oacc[e] = __builtin_amdgcn_mfma_f32_16x16x32_bf16(b2, a2, oacc[e], 0, 0, 0);
          }
        }
        if (w < 4) {
#pragma unroll
          for (int j = 0; j < 4; ++j) {
            const int t = ati * 16 + fq * 4 + j, s = asi * 16 + fr;
            s_att[t * 40 + s] = (s <= t) ? f2bf(att[j]) : (u16)0;
          }
        }
      }
      __syncthreads();
      {
        bf16x8 a = *(const bf16x8*)&s_att[(ti * 16 + fr) * 40 + fq * 8];
        const int tt = c * 32 + ti * 16 + fr;
        const size_t tok = start + (d ? (N - 1 - tt) : tt);
#pragma unroll
        for (int e = 0; e < 2; ++e) {
          bf16x8 bb = *(const bf16x8*)&s_vT[((vi * 2 + e) * 16 + fr) * 40 + fq * 8];
          oacc[e] = __builtin_amdgcn_mfma_f32_16x16x32_bf16(bb, a, oacc[e], 0, 0, 0);
          *(uint2*)&og[((size_t)d * TOK + tok) * 1024 + h * 128 + (vi * 2 + e) * 16 + fq * 4] = pack4(oacc[e][0], oacc[e][1], oacc[e][2], oacc[e][3]);
        }
        bf16x8 vf[4];
#pragma unroll
        for (int ni = 0; ni < 4; ++ni) vf[ni] = *(const bf16x8*)&s_vT[(wv * 64 + ni * 16 + fr) * 40 + fq * 8];
#pragma unroll
        for (int mi = 0; mi < 2; ++mi) {
          bf16x8 kf = *(const bf16x8*)&s_kdT[(wk * 32 + mi * 16 + fr) * 40 + fq * 8];
          f32x4 dc = *(const f32x4*)&s_dec[wk * 32 + mi * 16 + fq * 4];
#pragma unroll
          for (int ni = 0; ni < 4; ++ni) {
            f32x4 s4 = S[mi][ni];
#pragma unroll
            for (int j = 0; j < 4; ++j) s4[j] *= dc[j];
            s4 = __builtin_amdgcn_mfma_f32_16x16x32_bf16(kf, vf[ni], s4, 0, 0, 0);
            S[mi][ni] = s4;
            *(uint2*)&s_S[(wv * 64 + ni * 16 + fr) * 136 + wk * 32 + mi * 16 + fq * 4] = pack4(s4[0], s4[1], s4[2], s4[3]);
          }
        }
      }
      __syncthreads();
    }
    if (!sample) {
      float* so = p.out + OUT_HG + ((size_t)((b * 2 + d) * 8 + h)) * 16384;
#pragma unroll
      for (int mi = 0; mi < 2; ++mi)
#pragma unroll
        for (int ni = 0; ni < 4; ++ni)
#pragma unroll
          for (int j = 0; j < 4; ++j) so[(wk * 32 + mi * 16 + fq * 4 + j) * 128 + wv * 64 + ni * 16 + fr] = S[mi][ni][j];
    }
  }
#undef GLA_LOAD
}

__device__ __forceinline__ void phase_hg_post(const Params& p, int bid, int nb) {
  const u16* og = (const u16*)(p.ws + WS_B(5));
  const u16* sg = (const u16*)(p.ws + WS_B(2));
  u16* a = (u16*)(p.ws + WS_B(0));
  const float* ng = p.in[14];
  const int lane = threadIdx.x & 63, wave = threadIdx.x >> 6;
  float ngv[16];
#pragma unroll
  for (int k = 0; k < 4; ++k) { const f32x4 t = *(const f32x4*)&ng[lane * 16 + 4 * k]; ngv[4 * k] = t[0]; ngv[4 * k + 1] = t[1]; ngv[4 * k + 2] = t[2]; ngv[4 * k + 3] = t[3]; }
  for (int row0 = (bid * NW + wave) * 2; row0 < TOK; row0 += nb * NW * 2) {
    uint4 f[2][2], bw[2][2], sv[2][2];
#pragma unroll
    for (int r = 0; r < 2; ++r)
#pragma unroll
      for (int hh = 0; hh < 2; ++hh) {
        const size_t base = (size_t)(row0 + r) * 1024 + lane * 16 + hh * 8;
        f[r][hh] = *(const uint4*)&og[base];
        bw[r][hh] = *(const uint4*)&og[(size_t)TOK * 1024 + base];
        sv[r][hh] = *(const uint4*)&sg[base];
      }
#pragma unroll
    for (int r = 0; r < 2; ++r) {
      float o[16];
      float ss = 0;
#pragma unroll
      for (int hh = 0; hh < 2; ++hh) {
        const unsigned fa[4] = {f[r][hh].x, f[r][hh].y, f[r][hh].z, f[r][hh].w}, ba[4] = {bw[r][hh].x, bw[r][hh].y, bw[r][hh].z, bw[r][hh].w};
#pragma unroll
        for (int i = 0; i < 4; ++i) {
          o[hh * 8 + 2 * i] = lo16(fa[i]) + lo16(ba[i]);
          o[hh * 8 + 2 * i + 1] = hi16(fa[i]) + hi16(ba[i]);
        }
      }
#pragma unroll
      for (int i = 0; i < 16; ++i) ss += o[i] * o[i];
      ss += __shfl_xor(ss, 1); ss += __shfl_xor(ss, 2); ss += __shfl_xor(ss, 4);
      const float rs = rsqrtf(ss * (1.0f / 128.0f) + 1e-6f);
#pragma unroll
      for (int hh = 0; hh < 2; ++hh) {
        const unsigned sa[4] = {sv[r][hh].x, sv[r][hh].y, sv[r][hh].z, sv[r][hh].w};
        unsigned rr[4];
#pragma unroll
        for (int i = 0; i < 4; ++i)
          rr[i] = pack2(o[hh * 8 + 2 * i] * rs * ngv[hh * 8 + 2 * i] * siluf_(lo16(sa[i])), o[hh * 8 + 2 * i + 1] * rs * ngv[hh * 8 + 2 * i + 1] * siluf_(hi16(sa[i])));
        *(uint4*)&a[(size_t)(row0 + r) * 1024 + lane * 16 + hh * 8] = make_uint4(rr[0], rr[1], rr[2], rr[3]);
      }
    }
  }
}

__device__ __forceinline__ void seq_pos(int tok, int& n, int& L) {
  if (tok < NPROMPT) { n = tok & 255; L = 256; } else { n = (tok - NPROMPT) & 1023; L = 1024; }
}
__device__ __forceinline__ void phase_sc_conv(const Params& p, int bid, int nb) {
  const u16* pb = (const u16*)(p.ws + WS_B(0));
  const u16* sb = (const u16*)(p.ws + WS_B(1));
  u16* a = (u16*)(p.ws + WS_B(2));
  const float* cw = p.in[17]; const float* cbias = p.in[18];
  const size_t total = (size_t)TOK * 128;
  const size_t i0 = (size_t)bid * NT + threadIdx.x;
  const int c = ((int)i0 & 127) * 8;
  float w0[8], w1[8], w2[8], wb[8];
#pragma unroll
  for (int k = 0; k < 2; ++k) {
    const f32x4 t0 = *(const f32x4*)&cw[c + 4 * k], t1 = *(const f32x4*)&cw[1024 + c + 4 * k], t2 = *(const f32x4*)&cw[2048 + c + 4 * k], tb = *(const f32x4*)&cbias[c + 4 * k];
#pragma unroll
    for (int j = 0; j < 4; ++j) { w0[4 * k + j] = t0[j]; w1[4 * k + j] = t1[j]; w2[4 * k + j] = t2[j]; wb[4 * k + j] = tb[j]; }
  }
  const uint4 z = make_uint4(0, 0, 0, 0);
  for (size_t i = i0; i < total / 4; i += (size_t)nb * NT) {
    const int tok = (int)(i >> 7) * 4;
    int n, L; seq_pos(tok, n, L);
    const size_t base = (size_t)tok * 1024 + c;
    uint4 q[6], sv[4];
    q[0] = n > 0 ? *(const uint4*)&pb[base - 1024] : z;
#pragma unroll
    for (int t = 0; t < 4; ++t) { q[1 + t] = *(const uint4*)&pb[base + t * 1024]; sv[t] = *(const uint4*)&sb[base + t * 1024]; }
    q[5] = n + 4 < L ? *(const uint4*)&pb[base + 4096] : z;
#pragma unroll
    for (int t = 0; t < 4; ++t) {
      const unsigned am[4] = {q[t].x, q[t].y, q[t].z, q[t].w}, a0[4] = {q[t + 1].x, q[t + 1].y, q[t + 1].z, q[t + 1].w};
      const unsigned ap[4] = {q[t + 2].x, q[t + 2].y, q[t + 2].z, q[t + 2].w}, as[4] = {sv[t].x, sv[t].y, sv[t].z, sv[t].w};
      unsigned r[4];
#pragma unroll
      for (int k = 0; k < 4; ++k) {
        float z0 = w0[2 * k] * lo16(am[k]) + w1[2 * k] * lo16(a0[k]) + w2[2 * k] * lo16(ap[k]) + wb[2 * k];
        float z1 = w0[2 * k + 1] * hi16(am[k]) + w1[2 * k + 1] * hi16(a0[k]) + w2[2 * k + 1] * hi16(ap[k]) + wb[2 * k + 1];
        r[k] = pack2(lo16(as[k]) * z0, hi16(as[k]) * z1);
      }
      *(uint4*)&a[base + t * 1024] = make_uint4(r[0], r[1], r[2], r[3]);
    }
  }
}
__device__ __forceinline__ void phase_rg_conv(const Params& p, int bid, int nb) {
  const u16* ub = (const u16*)(p.ws + WS_B(0));
  u16* uc = (u16*)(p.ws + WS_B(2));
  const float* cw = p.in[21]; const float* cbias = p.in[22];
  const size_t total = (size_t)TOK * 128;
  const size_t i0 = (size_t)bid * NT + threadIdx.x;
  const int c = ((int)i0 & 127) * 8;
  float w0[8], w1[8], w2[8], w3[8], wb[8];
#pragma unroll
  for (int k = 0; k < 2; ++k) {
    const f32x4 t0 = *(const f32x4*)&cw[c + 4 * k], t1 = *(const f32x4*)&cw[1024 + c + 4 * k], t2 = *(const f32x4*)&cw[2048 + c + 4 * k], t3 = *(const f32x4*)&cw[3072 + c + 4 * k], tb = *(const f32x4*)&cbias[c + 4 * k];
#pragma unroll
    for (int j = 0; j < 4; ++j) { w0[4 * k + j] = t0[j]; w1[4 * k + j] = t1[j]; w2[4 * k + j] = t2[j]; w3[4 * k + j] = t3[j]; wb[4 * k + j] = tb[j]; }
  }
  const uint4 z = make_uint4(0, 0, 0, 0);
  for (size_t i = i0; i < total / 4; i += (size_t)nb * NT) {
    const int tok = (int)(i >> 7) * 4;
    int n, L; seq_pos(tok, n, L);
    const size_t base = (size_t)tok * 1024 + c;
    uint4 q[7];
    q[0] = n > 1 ? *(const uint4*)&ub[base - 2048] : z;
    q[1] = n > 0 ? *(const uint4*)&ub[base - 1024] : z;
#pragma unroll
    for (int t = 0; t < 4; ++t) q[2 + t] = *(const uint4*)&ub[base + t * 1024];
    q[6] = n + 4 < L ? *(const uint4*)&ub[base + 4096] : z;
#pragma unroll
    for (int t = 0; t < 4; ++t) {
      const unsigned a0[4] = {q[t].x, q[t].y, q[t].z, q[t].w}, a1[4] = {q[t + 1].x, q[t + 1].y, q[t + 1].z, q[t + 1].w};
      const unsigned a2[4] = {q[t + 2].x, q[t + 2].y, q[t + 2].z, q[t + 2].w}, a3[4] = {q[t + 3].x, q[t + 3].y, q[t + 3].z, q[t + 3].w};
      unsigned r[4];
#pragma unroll
      for (int k = 0; k < 4; ++k) {
        float z0 = w0[2 * k] * lo16(a0[k]) + w1[2 * k] * lo16(a1[k]) + w2[2 * k] * lo16(a2[k]) + w3[2 * k] * lo16(a3[k]) + wb[2 * k];
        float z1 = w0[2 * k + 1] * hi16(a0[k]) + w1[2 * k + 1] * hi16(a1[k]) + w2[2 * k + 1] * hi16(a2[k]) + w3[2 * k + 1] * hi16(a3[k]) + wb[2 * k + 1];
        r[k] = pack2(z0, z1);
      }
      *(uint4*)&uc[((size_t)(c >> 6) * TOK + tok + t) * 64 + (c & 63)] = make_uint4(r[0], r[1], r[2], r[3]);
    }
  }
}

__device__ __forceinline__ void phase_rg_scan(const Params& p, unsigned char* smem_raw, int bid, int nb) {
  float* sA = (float*)smem_raw;
  float* sB = sA + 2048;
  const u16* rb = (const u16*)(p.ws + WS_B(3));
  const u16* ib = (const u16*)(p.ws + WS_B(5));
  const u16* uc = (const u16*)(p.ws + WS_B(2));
  const u16* sg = (const u16*)(p.ws + WS_B(1));
  u16* hfw = (u16*)(p.ws + WS_H);
  u16* yp = (u16*)(p.ws + WS_B(0));
  const int tid = threadIdx.x;
  for (int u = bid; u < 768; u += nb) {
    int sample, b, c, seg, nseg, start, chs, slot;
    if (u < 256) {
      const int xq = u & 7, yq = u >> 3, gid = (yq >> 2) * 8 + xq, sub = yq & 3;
      sample = 1; b = gid >> 4; slot = (tid & 3) * 4; c = (gid & 15) * 64 + sub * 16 + slot; seg = tid >> 2; nseg = 128; start = NPROMPT + b * 1024; chs = 16; }
    else { sample = 0; b = (u - 256) >> 4; slot = (tid & 15) * 4; c = ((u - 256) & 15) * 64 + slot; seg = tid >> 4; nseg = 32; start = b * 256; chs = 64; }
    const int L = nseg * 8;
#pragma unroll 1
    for (int d = 0; d < 2; ++d) {
      const f32x4 lam = *(const f32x4*)&p.in[25][d * 1024 + c];
      float cl[4];
#pragma unroll
      for (int j = 0; j < 4; ++j) cl[j] = 8.0f * 1.4426950408889634f * log1pf(__expf(-lam[j]))    ;
      const u16* rp = rb + (size_t)d * TOK * 1024;
      const u16* ip = ib + (size_t)d * TOK * 1024;
      const int tok0 = start + (d ? L - 1 - seg * 8 : seg * 8);
      const size_t o0 = (size_t)tok0 * 1024 + c;
      const long ostep = d ? -1024 : 1024;
      const size_t g0 = ((size_t)(c >> 6) * TOK + tok0) * 64 + (c & 63);
      const long gstep = d ? -64 : 64;
      uint2 rr[8], ii[8], uu[8];
#pragma unroll
      for (int s8 = 0; s8 < 8; ++s8) { rr[s8] = *(const uint2*)&rp[g0 + s8 * gstep]; ii[s8] = *(const uint2*)&ip[g0 + s8 * gstep]; uu[s8] = *(const uint2*)&uc[g0 + s8 * gstep]; }
      uint2 hf[8], sgv[8];
      if (d == 1) {
#pragma unroll
        for (int s8 = 0; s8 < 8; ++s8) { hf[s8] = *(const uint2*)&hfw[g0 + s8 * gstep]; sgv[s8] = *(const uint2*)&sg[g0 + s8 * gstep]; }
      }
      float av[8][4], xv[8][4];
      float A[4] = {1.f, 1.f, 1.f, 1.f}, B[4] = {0.f, 0.f, 0.f, 0.f};
#pragma unroll
      for (int s8 = 0; s8 < 8; ++s8) {
        const float r4[4] = {lo16(rr[s8].x), hi16(rr[s8].x), lo16(rr[s8].y), hi16(rr[s8].y)};
        const float i4[4] = {lo16(ii[s8].x), hi16(ii[s8].x), lo16(ii[s8].y), hi16(ii[s8].y)};
        const float u4[4] = {lo16(uu[s8].x), hi16(uu[s8].x), lo16(uu[s8].y), hi16(uu[s8].y)};
#pragma unroll
        for (int j = 0; j < 4; ++j) {
          const float la = -cl[j] * r4[j];
          const float a = __builtin_amdgcn_exp2f(la);
          const float xin = __builtin_amdgcn_sqrtf(fmaxf(1.0f - __builtin_amdgcn_exp2f(2.0f * la), 0.f)) * (i4[j] * u4[j]);
          av[s8][j] = a; xv[s8][j] = xin;
          A[j] *= a; B[j] = a * B[j] + xin;
        }
      }
      const int lane = tid & 63, wv_ = tid >> 6;
      const int shstep = chs >> 2;
      const int nsw = 64 / shstep;
      const int segl = lane / shstep, qd = lane & (shstep - 1);
      for (int k = 1; k < nsw; k <<= 1) {
        float pa[4], pb2[4];
#pragma unroll
        for (int j = 0; j < 4; ++j) { pa[j] = __shfl_up(A[j], k * shstep); pb2[j] = __shfl_up(B[j], k * shstep); }
        if (segl >= k) {
#pragma unroll
          for (int j = 0; j < 4; ++j) { B[j] = A[j] * pb2[j] + B[j]; A[j] = A[j] * pa[j]; }
        }
      }
      float EA[4], EB[4];
#pragma unroll
      for (int j = 0; j < 4; ++j) { EA[j] = __shfl_up(A[j], shstep); EB[j] = __shfl_up(B[j], shstep); }
      if (segl == nsw - 1) {
        *(f32x4*)&sA[(wv_ * 16 + qd) * 4] = f32x4{A[0], A[1], A[2], A[3]};
        *(f32x4*)&sB[(wv_ * 16 + qd) * 4] = f32x4{B[0], B[1], B[2], B[3]};
      }
      __syncthreads();
      float h[4];
      {
        f32x4 h0v = f32x4{0.f, 0.f, 0.f, 0.f};
        if (sample) h0v = *(const f32x4*)&p.in[3][(b * 2 + d) * 1024 + c];
#pragma unroll
        for (int j = 0; j < 4; ++j) h[j] = h0v[j];
        for (int w2 = 0; w2 < wv_; ++w2) {
          const f32x4 ta = *(const f32x4*)&sA[(w2 * 16 + qd) * 4], tb = *(const f32x4*)&sB[(w2 * 16 + qd) * 4];
#pragma unroll
          for (int j = 0; j < 4; ++j) h[j] = ta[j] * h[j] + tb[j];
        }
        if (segl > 0) {
#pragma unroll
          for (int j = 0; j < 4; ++j) h[j] = EA[j] * h[j] + EB[j];
        }
      }
#pragma unroll
      for (int s8 = 0; s8 < 8; ++s8) {
#pragma unroll
        for (int j = 0; j < 4; ++j) h[j] = av[s8][j] * h[j] + xv[s8][j];
        const size_t o = o0 + s8 * ostep;
        if (d == 0) *(uint2*)&hfw[g0 + s8 * gstep] = pack4(h[0], h[1], h[2], h[3]);
        else *(uint2*)&yp[g0 + s8 * gstep] = pack4((lo16(hf[s8].x) + h[0]) * lo16(sgv[s8].x), (hi16(hf[s8].x) + h[1]) * hi16(sgv[s8].x),
                                     (lo16(hf[s8].y) + h[2]) * lo16(sgv[s8].y), (hi16(hf[s8].y) + h[3]) * hi16(sgv[s8].y));
      }
      if (!sample && seg == nseg - 1) *(f32x4*)&p.out[OUT_RG + (b * 2 + d) * 1024 + c] = f32x4{h[0], h[1], h[2], h[3]};
      __syncthreads();
    }
  }
}

__device__ __forceinline__ void phase_mla_norm(const Params& p, int bid, int nb) {
  u16* cq = (u16*)(p.ws + WS3_CQ);
  u16* ckvall = (u16*)(p.ws + WS3_CKVALL);
  const float* ckvraw = (const float*)(p.ws + WS3_CKVRAW);
  const float* kperaw = (const float*)(p.ws + WS3_KPERAW);
  u16* Kb = (u16*)(p.ws + WS3_K);
  const float* qn = p.in[28]; const float* kvn = p.in[29];
  const int lane = threadIdx.x & 63, wave = threadIdx.x >> 6;
  float qnv[6];
#pragma unroll
  for (int i = 0; i < 3; ++i) { qnv[2 * i] = qn[(i * 64 + lane) * 2]; qnv[2 * i + 1] = qn[(i * 64 + lane) * 2 + 1]; }
  const f32x4 g4 = *(const f32x4*)&kvn[lane * 4];
  unsigned cvn[3] = {0u, 0u, 0u}; f32x4 kvnx = f32x4{0.f, 0.f, 0.f, 0.f}; float vnx = 0.f;
  {
    const int r0 = bid * NW + wave;
    if (r0 < TOK) {
#pragma unroll
      for (int i = 0; i < 3; ++i) cvn[i] = ((const unsigned*)&cq[(size_t)r0 * 384])[i * 64 + lane];
      kvnx = *(const f32x4*)&ckvraw[(size_t)r0 * 256 + lane * 4]; vnx = kperaw[(size_t)r0 * 32 + (lane & 31)];
    }
  }
  for (int row = bid * NW + wave; row < TOK + 2048; row += nb * NW) {
    if (row < TOK) {
      const int tok = row;
      const bool sample = tok >= NPROMPT;
      unsigned cv[3] = {cvn[0], cvn[1], cvn[2]}; const f32x4 kv = kvnx; float v = vnx;
      {
        const int rn = row + nb * NW;
        if (rn < TOK) {
#pragma unroll
          for (int i = 0; i < 3; ++i) cvn[i] = ((const unsigned*)&cq[(size_t)rn * 384])[i * 64 + lane];
          kvnx = *(const f32x4*)&ckvraw[(size_t)rn * 256 + lane * 4]; vnx = kperaw[(size_t)rn * 32 + (lane & 31)];
        }
      }
      const int bs = (tok - NPROMPT) >> 10, n = (tok - NPROMPT) & 1023;
      const size_t kvrow = sample ? (size_t)(NPROMPT + bs * 1536 + 512 + n) : (size_t)tok;
      unsigned* cqr = (unsigned*)&cq[(size_t)tok * 384];
      float ss = 0;
#pragma unroll
      for (int i = 0; i < 3; ++i) { float a = lo16(cv[i]), b2 = hi16(cv[i]); ss += a * a + b2 * b2; }
      const float rsq = rsqrtf(wave_sum(ss) * (1.0f / 384.0f) + 1e-6f);
#pragma unroll
      for (int i = 0; i < 3; ++i) {
        cqr[i * 64 + lane] = pack2(lo16(cv[i]) * rsq * qnv[2 * i], hi16(cv[i]) * rsq * qnv[2 * i + 1]);
      }
      const float rsk = rsqrtf(wave_sum(kv[0] * kv[0] + kv[1] * kv[1] + kv[2] * kv[2] + kv[3] * kv[3]) * (1.0f / 256.0f) + 1e-6f);
      f32x4 o4;
#pragma unroll
      for (int j = 0; j < 4; ++j) o4[j] = kv[j] * rsk * g4[j];
      *(uint2*)&ckvall[kvrow * 256 + lane * 4] = pack4(o4[0], o4[1], o4[2], o4[3]);
      if (!sample) *(f32x4*)&p.out[OUT_CKV + (size_t)tok * 256 + lane * 4] = o4;
      if (!sample) { if (lane < 32) p.out[OUT_KPE + (size_t)tok * 32 + lane] = v; }
      else {
        const float partner = __shfl_xor(v, 8);
        const int i16 = lane & 15;
        const float pos = (lane & 16) ? (float)(n & 63) : (float)(n >> 6);
        float sn, cs; rope_sincos(pos, i16 & 7, sn, cs);
        v = (i16 < 8) ? (v * cs - partner * sn) : (partner * sn + v * cs);
      }
      const u16 vb = f2bf(v);
#pragma unroll
      for (int i = 0; i < 8; ++i) Kb[(kvrow * 16 + (lane >> 5) + 2 * i) * 96 + 64 + (lane & 31)] = vb;
    } else {
      const int r = row - TOK, bs = r >> 9, j = r & 511;
      const size_t kvrow = (size_t)(NPROMPT + bs * 1536 + j);
      f32x4 kv = *(const f32x4*)&p.in[4][(size_t)r * 256 + lane * 4];
      *(uint2*)&ckvall[kvrow * 256 + lane * 4] = pack4(kv[0], kv[1], kv[2], kv[3]);
      const u16 vb = f2bf(p.in[5][(size_t)r * 32 + (lane & 31)]);
#pragma unroll
      for (int i = 0; i < 8; ++i) Kb[(kvrow * 16 + (lane >> 5) + 2 * i) * 96 + 64 + (lane & 31)] = vb;
    }
  }
}

__device__ __forceinline__ void phase_attn(const Params& p, unsigned char* smem_raw, int bid, int nb) {
  u16* sK = (u16*)smem_raw;
  u16* sV = sK + 128 * 104;
  const u16* qg = (const u16*)(p.ws + WS3_Q);
  const u16* Kg = (const u16*)(p.ws + WS3_K);
  const u16* Vg = (const u16*)(p.ws + WS3_VT);
  const u16* sg = (const u16*)(p.ws + WS3_SG);
  u16* ao = (u16*)(p.ws + WS_H);
  const int tid = threadIdx.x, lane = tid & 63, w = tid >> 6, fr = lane & 15, fq = lane >> 4;
  for (int u = bid; u < 1536; u += nb) {
    int tok0, kvbase, nkeys, h;
    if (u < 512) { const int b = u >> 7, r = u & 127; h = r >> 3; const int qb = r & 7; tok0 = NPROMPT + b * 1024 + qb * 128; kvbase = NPROMPT + b * 1536; nkeys = 1536; }
    else { const int uu = u - 512; const int b = uu >> 5, r = uu & 31; h = r >> 1; const int qb = r & 1; tok0 = b * 256 + qb * 128; kvbase = b * 256; nkeys = 256; }
    const int tokq = tok0 + w * 16 + fr;
    bf16x8 qf[3];
#pragma unroll
    for (int ks = 0; ks < 3; ++ks) qf[ks] = *(const bf16x8*)&qg[(size_t)tokq * 1536 + h * 96 + ks * 32 + fq * 8];
    if (u < 512) {
      const int npos = (tokq - NPROMPT) & 1023;
      const float pos = (fq & 2) ? (float)(npos & 63) : (float)(npos >> 6);
      uint4 raw = *(uint4*)&qf[2];
      unsigned rw[4] = {raw.x, raw.y, raw.z, raw.w};
#pragma unroll
      for (int i = 0; i < 4; ++i) {
        float v0 = lo16(rw[i]), v1 = hi16(rw[i]);
        const float p0 = __shfl_xor(v0, 16), p1 = __shfl_xor(v1, 16);
        float sn0, cs0, sn1, cs1;
        rope_sincos(pos, 2 * i, sn0, cs0); rope_sincos(pos, 2 * i + 1, sn1, cs1);
        v0 = (fq & 1) ? (p0 * sn0 + v0 * cs0) : (v0 * cs0 - p0 * sn0);
        v1 = (fq & 1) ? (p1 * sn1 + v1 * cs1) : (v1 * cs1 - p1 * sn1);
        rw[i] = pack2(v0, v1);
      }
      raw = make_uint4(rw[0], rw[1], rw[2], rw[3]);
      qf[2] = *(bf16x8*)&raw;
    }
    float m = -1e30f, l = 0.f;
    f32x4 oacc[4];
#pragma unroll
    for (int i = 0; i < 4; ++i) oacc[i] = f32x4{0.f, 0.f, 0.f, 0.f};
    const int kk0 = tid / 12, kc0 = tid - kk0 * 12;
    const int kk1 = (tid + NT) / 12, kc1 = (tid + NT) - kk1 * 12;
    const int kk2_ = (tid + 2 * NT) / 12, kc2 = (tid + 2 * NT) - kk2_ * 12;
    const u16* Kp0 = &Kg[((size_t)(kvbase + kk0) * 16 + h) * 96 + kc0 * 8];
    const u16* Kp1 = &Kg[((size_t)(kvbase + kk1) * 16 + h) * 96 + kc1 * 8];
    const u16* Kp2 = &Kg[((size_t)(kvbase + kk2_) * 16 + h) * 96 + kc2 * 8];
    const int vd0 = tid >> 4, vc0 = tid & 15, vd1 = (tid + NT) >> 4;
    const u16* Vp0 = &Vg[(size_t)(h * 64 + vd0) * KVROWS + kvbase + vc0 * 8];
    const u16* Vp1 = &Vg[(size_t)(h * 64 + vd1) * KVROWS + kvbase + vc0 * 8];
    uint4 kr0 = *(const uint4*)Kp0, kr1 = *(const uint4*)Kp1, kr2 = *(const uint4*)Kp2, vr0 = *(const uint4*)Vp0, vr1 = *(const uint4*)Vp1;
    const int ntile2 = nkeys >> 7;
    for (int kt = 0; kt < ntile2; ++kt) {
      __syncthreads();
      *(uint4*)&sK[kk0 * 104 + kc0 * 8] = kr0; *(uint4*)&sK[kk1 * 104 + kc1 * 8] = kr1; *(uint4*)&sK[kk2_ * 104 + kc2 * 8] = kr2;
      *(uint4*)&sV[vd0 * 136 + vc0 * 8] = vr0; *(uint4*)&sV[vd1 * 136 + vc0 * 8] = vr1;
      if (kt + 1 < ntile2) {
        const size_t ko = (size_t)(kt + 1) * 128 * 1536; const int vo = (kt + 1) * 128;
        kr0 = *(const uint4*)(Kp0 + ko); kr1 = *(const uint4*)(Kp1 + ko); kr2 = *(const uint4*)(Kp2 + ko);
        vr0 = *(const uint4*)(Vp0 + vo); vr1 = *(const uint4*)(Vp1 + vo);
      }
      __syncthreads();
      f32x4 sacc[8];
#pragma unroll
      for (int ni = 0; ni < 8; ++ni) {
        sacc[ni] = f32x4{0.f, 0.f, 0.f, 0.f};
#pragma unroll
        for (int ks = 0; ks < 3; ++ks) {
          bf16x8 kf = *(const bf16x8*)&sK[(ni * 16 + fr) * 104 + ks * 32 + fq * 8];
          sacc[ni] = __builtin_amdgcn_mfma_f32_16x16x32_bf16(kf, qf[ks], sacc[ni], 0, 0, 0);
        }
      }
      float mx = -1e30f;
#pragma unroll
      for (int ni = 0; ni < 8; ++ni)
#pragma unroll
        for (int j = 0; j < 4; ++j) mx = fmaxf(mx, sacc[ni][j]);
      mx = fmaxf(mx, __shfl_xor(mx, 16));
      mx = fmaxf(mx, __shfl_xor(mx, 32));
      const float mnew = fmaxf(m, mx);
      const float alpha = __builtin_amdgcn_exp2f(m - mnew);
      m = mnew;
      float ls = 0.f;
#pragma unroll
      for (int ni = 0; ni < 8; ++ni)
#pragma unroll
        for (int j = 0; j < 4; ++j) { float e = __builtin_amdgcn_exp2f(sacc[ni][j] - mnew); sacc[ni][j] = e; ls += e; }
      l = l * alpha + ls;
      bf16x8 pf[4];
#pragma unroll
      for (int kk2 = 0; kk2 < 4; ++kk2) {
        uint2 lo = pack4(sacc[2 * kk2][0], sacc[2 * kk2][1], sacc[2 * kk2][2], sacc[2 * kk2][3]);
        uint2 hi = pack4(sacc[2 * kk2 + 1][0], sacc[2 * kk2 + 1][1], sacc[2 * kk2 + 1][2], sacc[2 * kk2 + 1][3]);
        uint4 pk = make_uint4(lo.x, lo.y, hi.x, hi.y);
        pf[kk2] = *(bf16x8*)&pk;
      }
#pragma unroll
      for (int di = 0; di < 4; ++di) {
#pragma unroll
        for (int j = 0; j < 4; ++j) oacc[di][j] *= alpha;
#pragma unroll
        for (int kk2 = 0; kk2 < 4; ++kk2) {
          uint2 v0 = *(const uint2*)&sV[(di * 16 + fr) * 136 + kk2 * 32 + fq * 4];
          uint2 v1 = *(const uint2*)&sV[(di * 16 + fr) * 136 + kk2 * 32 + 16 + fq * 4];
          uint4 vk = make_uint4(v0.x, v0.y, v1.x, v1.y);
          oacc[di] = __builtin_amdgcn_mfma_f32_16x16x32_bf16(*(bf16x8*)&vk, pf[kk2], oacc[di], 0, 0, 0);
        }
      }
    }
    l += __shfl_xor(l, 16);
    l += __shfl_xor(l, 32);
    const float inv = 1.0f / l;
#pragma unroll
    for (int di = 0; di < 4; ++di) {
      const size_t o = (size_t)tokq * 1024 + h * 64 + di * 16 + fq * 4;
      uint2 s = *(const uint2*)&sg[o];
      *(uint2*)&ao[o] = pack4(oacc[di][0] * inv * siluf_(lo16(s.x)), oacc[di][1] * inv * siluf_(hi16(s.x)), oacc[di][2] * inv * siluf_(lo16(s.y)), oacc[di][3] * inv * siluf_(hi16(s.y)));
    }
  }
}

#define XB_TMO      128
#define XB_XCNT(j)  (256  + 64 * (j))
#define XB_XSUB(j)  (1280 + 64 * (j))
#define XB_XGEN(j)  (2304 + 64 * (j))
#define XB_TOP      3328
#define XB_TOPGEN   3392
#define XCD_BAR_WORDS 3456
#define XB_SPIN_CAP (1u << 22)
__device__ __forceinline__ unsigned xb_ld(unsigned* p)              { return __hip_atomic_load(p, __ATOMIC_RELAXED, __HIP_MEMORY_SCOPE_AGENT); }
__device__ __forceinline__ unsigned xb_add(unsigned* p, unsigned v) { return __hip_atomic_fetch_add(p, v, __ATOMIC_RELAXED, __HIP_MEMORY_SCOPE_AGENT); }
__device__ __forceinline__ unsigned xb_xcc_id() { return (unsigned)__builtin_amdgcn_s_getreg((3 << 11) | 20) & 0xFu; }
#define XB_SPIN(cond, bar) do { unsigned _sp = 0; while (cond) { __builtin_amdgcn_s_sleep(1); \
    if ((++_sp & 255u) == 0u) { if (xb_ld(&(bar)[XB_TMO])) break; if (_sp > XB_SPIN_CAP) { atomicAdd(&(bar)[XB_TMO], 1u); break; } } } } while (0)
struct XcdBarrier { unsigned* bar; unsigned x; volatile LAS unsigned* st; };
__device__ __forceinline__ XcdBarrier xcd_barrier_post(unsigned* bar, volatile LAS unsigned* st) {
  XcdBarrier b; b.bar = bar; b.x = xb_xcc_id(); b.st = st;
  if (threadIdx.x == 0) (void)xb_add(&bar[XB_XCNT(b.x)], 1u);
  return b;
}
__device__ __forceinline__ void xcd_barrier_complete(unsigned* bar, unsigned x, unsigned& nloc, unsigned& nx) {
  const unsigned G = gridDim.x * gridDim.y * gridDim.z;
  unsigned sum, cnt, mine, sp = 0u;
  for (;;) {
    sum = 0u; cnt = 0u; mine = 0u;
#pragma unroll
    for (unsigned j = 0; j < 16; ++j) { const unsigned c = xb_ld(&bar[XB_XCNT(j)]); sum += c; cnt += (c > 0u) ? 1u : 0u; mine = (j == x) ? c : mine; }
    if (sum == G) break;
    __builtin_amdgcn_s_sleep(1);
    if ((++sp & 255u) == 0u) { if (xb_ld(&bar[XB_TMO])) break; if (sp > XB_SPIN_CAP) { atomicAdd(&bar[XB_TMO], 1u); break; } }
  }
  nloc = mine > 0u ? mine : 1u; nx = cnt > 0u ? cnt : 1u;
}
__device__ __forceinline__ void xcd_barrier(const XcdBarrier& b) {
  asm volatile("s_waitcnt vmcnt(0)" ::: "memory");
  __syncthreads();
  if (threadIdx.x == 0) {
    unsigned* bar = b.bar;
    __builtin_amdgcn_s_waitcnt(0);
    unsigned nloc = b.st[0], nx = b.st[1];
    if (nloc == 0u) { xcd_barrier_complete(bar, b.x, nloc, nx); b.st[0] = nloc; b.st[1] = nx; }
    const unsigned old = xb_add(&bar[XB_XSUB(b.x)], 1u);
    const unsigned gen = old / nloc;
    if (old + 1u == (gen + 1u) * nloc) {
      __builtin_amdgcn_fence(__ATOMIC_RELEASE, "agent");
      asm volatile("s_waitcnt vmcnt(0)" ::: "memory");
      const unsigned og = xb_add(&bar[XB_TOP], 1u);
      const unsigned tg = og / nx;
      if (og + 1u == (tg + 1u) * nx) xb_add(&bar[XB_TOPGEN], 1u);
      else XB_SPIN(xb_ld(&bar[XB_TOPGEN]) == tg, bar);
      __builtin_amdgcn_fence(__ATOMIC_ACQUIRE, "agent");
      xb_add(&bar[XB_XGEN(b.x)], 1u);
      asm volatile("s_waitcnt vmcnt(0)" ::: "memory");
    } else {
      XB_SPIN(xb_ld(&bar[XB_XGEN(b.x)]) == gen, bar);
      __builtin_amdgcn_fence(__ATOMIC_ACQUIRE, "agent");
      asm volatile("s_waitcnt vmcnt(0)" ::: "memory");
    }
  }
  __syncthreads();
}

#define GEMM_LDS 131072
#define DYN_LDS (GEMM_LDS + 16)
#define WS_BAR (WS_CNT + 4096ull)

#define RUN_GEMM(Aptr, LDA, Bptr, MM, NN, KK, GATE, EPI, CID) RUN_GEMM_G(Aptr, LDA, Bptr, MM, NN, KK, GATE, EPI, nb, CID)
#define RUN_GEMM_G(Aptr, LDA, Bptr, MM, NN, KK, GATE, EPI, GG, CID) RUN_GEMM_X(Aptr, LDA, (size_t)128, (size_t)0, Bptr, MM, NN, KK, GATE, EPI, GG, CID)
#define GM_KSTEP ((size_t)TOK * 128)
#define RUN_GEMM_X(Aptr, LDA, KSA, GST, Bptr, MM, NN, KK, GATE, EPI, GG, CID) do { pg8::Gemm g_{(const u16*)(Aptr), (const u16*)(Bptr), MM, NN, KK, LDA, GATE, p.flags, KSA, GST}; \
    pg8::StaticOrder S_; S_.init(MM, NN, GG, CID); pg8::gemm_phase((LAS unsigned char*)smem_raw, g_, S_, EPI); } while (0)
#define RUN_GEMM_RX(Aptr, LDA, KSA, GST, Bptr, MM, NN, KK, GATE, EPI, GG, CID, UBEG, UEND) do { pg8::Gemm g_{(const u16*)(Aptr), (const u16*)(Bptr), MM, NN, KK, LDA, GATE, p.flags, KSA, GST}; \
    pg8::StaticOrder S_; S_.init(MM, NN, GG, CID); S_.ubeg = UBEG; S_.uend = UEND; pg8::gemm_phase((LAS unsigned char*)smem_raw, g_, S_, EPI); } while (0)
#define RUN_GEMM_R(Aptr, LDA, Bptr, MM, NN, KK, EPI, GG, CID, UBEG, UEND) do { pg8::Gemm g_{(const u16*)(Aptr), (const u16*)(Bptr), MM, NN, KK, LDA, 0, p.flags, (size_t)128, (size_t)0}; \
    pg8::StaticOrder S_; S_.init(MM, NN, GG, CID); S_.ubeg = UBEG; S_.uend = UEND; pg8::gemm_phase((LAS unsigned char*)smem_raw, g_, S_, EPI); } while (0)

__global__ void __launch_bounds__(NT, 2) mega(Params p) {
  extern __shared__ __attribute__((aligned(16))) unsigned char smem_raw[];
  const int bid = blockIdx.x, nb = gridDim.x;
  unsigned char* ws = p.ws;
  const float* mod = (const float*)(ws + WS_MOD);
  volatile LAS unsigned* xst = (volatile LAS unsigned*)((LAS unsigned char*)smem_raw + GEMM_LDS);
  XcdBarrier xb;
  if (p.phase_hi - p.phase_lo > 1) {
    if (threadIdx.x == 0) { xst[0] = 0u; xst[1] = 0u; }
    __syncthreads();
    xb = xcd_barrier_post((unsigned*)(ws + WS_BAR), xst);
  }
#define PH_BEGIN(n) if ((PHMASK & (1u << n)) && p.phase_lo <= n && n < p.phase_hi) { const int ph = n;
#define PH_FIN if (ph + 1 < p.phase_hi) { if (p.phase_lo < 0) cg::this_grid().sync(); else xcd_barrier(xb); } }
  PH_BEGIN(0) phase_prologue(p, smem_raw, bid, nb); PH_FIN
  PH_BEGIN(1) phase_h0(p, bid, nb); PH_FIN
  PH_BEGIN(2) {
    EpiHgIn e{(u16*)(ws + WS_B(0)), (u16*)(ws + WS_B(1)), (u16*)(ws + WS_B(2)), (_Float16*)(ws + WS_B(3)), (const float*)(ws + WS_LB)};
    RUN_GEMM(ws + WS_H, 1024, ws + WS_W_HG_IN, TOK, (nb == 256 ? 4096 : 5120), 1024, 0, e, bid);
  } PH_FIN
  PH_BEGIN(3) {
    phase_gla(p, smem_raw);
    if (nb == 256) {
      __syncthreads();
      EpiSg eg{(u16*)(ws + WS_B(2))};
      RUN_GEMM_R(ws + WS_H, 1024, ws + WS_W_HG_IN + (size_t)4096 * 1024 * 2, TOK, 1024, 1024, eg, 256, bid >= 64 ? bid - 64 : (1 << 20), 0, 192);
    }
  } PH_FIN
  PH_BEGIN(4) phase_hg_post(p, bid, nb); PH_FIN
  PH_BEGIN(5) {
    EpiResLn<false, true> e{p.in[0], p.in[1], (const u16*)nullptr, p.out, (u16*)(ws + WS_XB), mod + 0 * 15360 + 2048, p.in[10] + 0 * 1024, p.in[11] + 0 * 1024, mod + 1 * 15360, (u16*)(ws + WS_H),
               (unsigned long long*)(ws + WS_SLOT) + 0 * 49152, (unsigned*)(ws + WS_CNT + 256) + 0 * 48};
    RUN_GEMM(ws + WS_B(0), 1024, ws + WS_W_HG_OUT, TOK, 1024, 1024, 0, e, bid);
    wconv_idle(p, smem_raw, bid, nb, 1536, 2816);
  } PH_FIN
  PH_BEGIN(7) {
    EpiScIn e{(u16*)(ws + WS_B(0)), (u16*)(ws + WS_B(1))};
    RUN_GEMM(ws + WS_H, 1024, ws + WS_W_SC_IN, TOK, 4096, 1024, 0, e, bid);
  } PH_FIN
  PH_BEGIN(8) phase_sc_conv(p, bid, nb); PH_FIN
  PH_BEGIN(9) {
    EpiResLn<true, true> e{p.out, p.out, (const u16*)(ws + WS_XB), p.out, (u16*)(ws + WS_XB), mod + 1 * 15360 + 2048, p.in[10] + 1 * 1024, p.in[11] + 1 * 1024, mod + 2 * 15360, (u16*)(ws + WS_H),
               (unsigned long long*)(ws + WS_SLOT) + 1 * 49152, (unsigned*)(ws + WS_CNT + 256) + 1 * 48};
    RUN_GEMM(ws + WS_B(2), 1024, ws + WS_W_SC_OUT, TOK, 1024, 1024, 0, e, bid);
    wconv_idle(p, smem_raw, bid, nb, 2816, 3840);
  } PH_FIN
  PH_BEGIN(11) {
    EpiRgIn e{(u16*)(ws + WS_B(0)), (u16*)(ws + WS_B(1))};
    if (nb == 256) {
      RUN_GEMM(ws + WS_H, 1024, ws + WS_W_RG_IN, TOK, 1024, 1024, 0, e, bid);
      EpiSgGM eg{(u16*)(ws + WS_B(1))};
      RUN_GEMM_R(ws + WS_H, 1024, ws + WS_W_RG_IN + (size_t)1024 * 1024 * 2, TOK, 1024, 1024, eg, 256, bid >= 192 ? bid - 192 : (1 << 20), 0, 64);
    } else {
      RUN_GEMM(ws + WS_H, 1024, ws + WS_W_RG_IN, TOK, 2048, 1024, 0, e, bid);
    }
  } PH_FIN
  PH_BEGIN(12) phase_rg_conv(p, bid, nb); PH_FIN
  PH_BEGIN(13) {
    EpiRgGate e{(u16*)(ws + WS_B(3)), (u16*)(ws + WS_B(5)), p.in[24]};
    if (nb == 256) {
      EpiSgGM eg{(u16*)(ws + WS_B(1))};
      RUN_GEMM_R(ws + WS_H, 1024, ws + WS_W_RG_IN + (size_t)1024 * 1024 * 2, TOK, 1024, 1024, eg, 256, bid < 128 ? bid : (1 << 20), 64, 192);
      RUN_GEMM_RX(ws + WS_B(2), 64, GM_KSTEP, 4 * GM_KSTEP, ws + WS_W_RG_GATE, TOK, 4096, 256, 1, e, 256, bid < 128 ? bid : (1 << 20), 0, 128);
      RUN_GEMM_RX(ws + WS_B(2), 64, GM_KSTEP, 4 * GM_KSTEP, ws + WS_W_RG_GATE, TOK, 4096, 256, 1, e, 128, bid >= 128 ? bid - 128 : (1 << 20), 128, 768);
    } else {
      RUN_GEMM_X(ws + WS_B(2), 64, GM_KSTEP, 4 * GM_KSTEP, ws + WS_W_RG_GATE, TOK, 4096, 256, 1, e, nb, bid);
    }
  } PH_FIN
  PH_BEGIN(14) phase_rg_scan(p, smem_raw, bid, nb); PH_FIN
  PH_BEGIN(15) {
    EpiResLn<true, true> e{p.out, p.out, (const u16*)(ws + WS_XB), p.out, (u16*)(ws + WS_XB), mod + 2 * 15360 + 2048, p.in[10] + 2 * 1024, p.in[11] + 2 * 1024, mod + 3 * 15360, (u16*)(ws + WS_H),
               (unsigned long long*)(ws + WS_SLOT) + 2 * 49152, (unsigned*)(ws + WS_CNT + 256) + 2 * 48};
    RUN_GEMM_X(ws + WS_B(0), 64, GM_KSTEP, (size_t)0, ws + WS_W_RG_OUT, TOK, 1024, 1024, 0, e, nb, bid);
    wconv_idle(p, smem_raw, bid, nb, 3840, 4800);
  } PH_FIN
  PH_BEGIN(17) {
    EpiMlaIn e{(u16*)(ws + WS3_CQ), (float*)(ws + WS3_CKVRAW), (float*)(ws + WS3_KPERAW), (u16*)(ws + WS3_SG)};
    RUN_GEMM(ws + WS_H, 1024, ws + WS_W_MLA_IN, TOK, 768, 1024, 0, e, bid);
    if (nb == 256) {
      EpiSg eg{(u16*)(ws + WS3_SG)};
      RUN_GEMM_R(ws + WS_H, 1024, ws + WS_W_MLA_IN + 672 * 1024 * 2, TOK, 1024, 1024, eg, 256, bid >= 144 ? bid - 144 : (1 << 20), 0, 112);
    }
  } PH_FIN
  PH_BEGIN(18) phase_mla_norm(p, bid, nb); PH_FIN
  PH_BEGIN(19) {
    const bool bal = (nb == 256);
    const int none = 1 << 20;
    EpiSg eg{(u16*)(ws + WS3_SG)};
    RUN_GEMM_R(ws + WS_H, 1024, ws + WS_W_MLA_IN + 672 * 1024 * 2, TOK, 1024, 1024, eg, nb, bid, bal ? 112 : 0, 192);
    EpiQ eq{(u16*)(ws + WS3_Q)};
    RUN_GEMM_G(ws + WS3_CQ, 384, ws + WS_W_QB, TOK, 1536, 384, 0, eq, bal ? 176 : nb, bal ? (bid >= 80 ? bid - 80 : none) : bid);
    EpiK ek{(u16*)(ws + WS3_K)};
    RUN_GEMM(ws + WS3_CKVALL, 256, ws + WS_W_KVB, KVROWS, 1024, 256, 0, ek, bid);
    EpiV ev{(u16*)(ws + WS3_VT)};
    RUN_GEMM_G(ws + WS_W_KVB + 1024 * 256 * 2, 256, ws + WS3_CKVALL, 1024, KVROWS, 256, 0, ev, bal ? 176 : nb, bal ? (bid >= 80 ? (bid + 160) % 176 : none) : bid);
  } PH_FIN
  PH_BEGIN(20) phase_attn(p, smem_raw, bid, nb); PH_FIN
  PH_BEGIN(21) {
    EpiResLn<true, false> e{p.out, p.out, (const u16*)(ws + WS_XB), p.out, (u16*)nullptr, mod + 3 * 15360 + 2048, p.in[10] + 3 * 1024, p.in[11] + 3 * 1024, mod + 3 * 15360, (u16*)nullptr,
               (unsigned long long*)(ws + WS_SLOT) + 3 * 49152, (unsigned*)(ws + WS_CNT + 256) + 3 * 48};
    RUN_GEMM(ws + WS_H, 1024, ws + WS_W_MLA_OUT, TOK, 1024, 1024, 0, e, bid);
  } PH_FIN
}

extern "C" void kernel_launch(void* const* d_in, const int* in_sizes, int n_in, void* d_out, int out_size, void* d_ws, size_t ws_size,
                              hipStream_t stream) {
  static int grid_blocks = 0;
  if (!grid_blocks) {
    int dev = 0, cus = 0, per_cu = 0;
    (void)hipGetDevice(&dev);
    (void)hipDeviceGetAttribute(&cus, hipDeviceAttributeMultiprocessorCount, dev);
    (void)hipFuncSetAttribute((const void*)mega, hipFuncAttributeMaxDynamicSharedMemorySize, DYN_LDS);
    (void)hipOccupancyMaxActiveBlocksPerMultiprocessor(&per_cu, (const void*)mega, NT, DYN_LDS);
    if (per_cu < 1) per_cu = 1;
    if (per_cu > 1) per_cu = 1;
    grid_blocks = cus * per_cu;
  }
  Params p{};
  for (int i = 0; i < 33; ++i) p.in[i] = (const float*)d_in[i];
  p.out = (float*)d_out;
  p.ws = (unsigned char*)d_ws;
#if MULTI_LAUNCH
  (void)hipMemsetAsync((unsigned char*)d_ws + WS_CNT, 0, 4096 + XCD_BAR_WORDS * 4, stream);
  for (int ph = 0; ph < NPHASES; ++ph) {
    p.phase_lo = ph; p.phase_hi = ph + 1;
    hipLaunchKernelGGL(mega, dim3(grid_blocks), dim3(NT), DYN_LDS, stream, p);
#ifdef PROBE_MASK
    if ((PROBE_MASK >> ph) & 1) { p.flags = PROBE_FLAGS; for (int r = 0; r < 2; ++r) {
      if (ph == 3) (void)hipMemsetAsync((unsigned char*)d_ws + WS_CNT, 0, 64, stream);
      hipLaunchKernelGGL(mega, dim3(grid_blocks), dim3(NT), DYN_LDS, stream, p);
    } p.flags = 0; }
#endif
  }
#else
  p.phase_lo = 0; p.phase_hi = NPHASES;
  (void)hipMemsetAsync((unsigned char*)d_ws + WS_CNT, 0, 4096 + XCD_BAR_WORDS * 4, stream);
  void* args[] = {&p};
  hipError_t e = hipLaunchCooperativeKernel((const void*)mega, dim3(grid_blocks), dim3(NT), args, DYN_LDS, stream);
  if (e != hipSuccess) fprintf(stderr, "cooperative launch failed: %s (grid %d)\n", hipGetErrorString(e), grid_blocks);
#endif
}
```

```cpp
#include <hip/hip_runtime.h>
#include <hip/hip_cooperative_groups.h>
#include <cstdio>
namespace cg = cooperative_groups;

#ifndef MULTI_LAUNCH
#define MULTI_LAUNCH 0
#endif

typedef unsigned short u16;
using bf16x8 = __attribute__((ext_vector_type(8))) short;
using f32x4 = __attribute__((ext_vector_type(4))) float;
typedef _Float16 h4 __attribute__((ext_vector_type(4)));

#define TOK 12288
#define NPROMPT 8192
#define KVROWS 14336
#define NPHASES 23
#ifndef PHMASK
#define PHMASK 0x7fffff
#endif
#define DN_ALPHA 1.6817928305074290f

#define WS_W_HG_IN 0ull
#define WS_W_HG_OUT (WS_W_HG_IN + 10485760ull)
#define WS_W_SC_IN (WS_W_HG_OUT + 2097152ull)
#define WS_W_SC_OUT (WS_W_SC_IN + 8388608ull)
#define WS_W_RG_IN (WS_W_SC_OUT + 2097152ull)
#define WS_W_RG_GATE (WS_W_RG_IN + 4194304ull)
#define WS_W_RG_OUT (WS_W_RG_GATE + 2097152ull)
#define WS_W_MLA_IN (WS_W_RG_OUT + 2097152ull)
#define WS_W_QB (WS_W_MLA_IN + 3670016ull)
#define WS_W_KVB (WS_W_QB + 1179648ull)
#define WS_W_MLA_OUT (WS_W_KVB + 1048576ull)
#define WS_MOD (WS_W_MLA_OUT + 2097152ull)
#define WS_LB (WS_MOD + 245760ull)
#define WS_CNT (WS_LB + 8192ull)
#define WS_R (WS_CNT + 4096ull + 16384ull)
#define BSZ 25165824ull
#define WS_H (WS_R)
#define WS_B(i) (WS_R + BSZ * (1 + (i)))
#define WS_SLOT (WS_R + 201326592ull)
#define WS_XB (WS_SLOT + 1572864ull)
#define WS3_CQ (WS_R + 25165824ull)
#define WS3_CKVALL (WS_R + 34603008ull)
#define WS3_CKVRAW (WS_R + 41943040ull)
#define WS3_KPERAW (WS_R + 54525952ull)
#define WS3_SG (WS_R + 56098816ull)
#define WS3_Q (WS_R + 81264640ull)
#define WS3_K (WS_R + 119013376ull)
#define WS3_VT (WS_R + 163053568ull)

#define OUT_HG 12582912
#define OUT_RG 20971520
#define OUT_CKV 21037056
#define OUT_KPE 23134208

struct Params {
  const float* in[33];
  float* out;
  unsigned char* ws;
  int phase_lo, phase_hi, flags, pad_;
};

__device__ __forceinline__ u16 f2bf(float f) { __bf16 r = (__bf16)f; return *(u16*)&r; }
__device__ __forceinline__ float bf2f(u16 h) { return __uint_as_float(((unsigned)h) << 16); }
typedef float f2v_ __attribute__((ext_vector_type(2)));
typedef __bf16 b2v_ __attribute__((ext_vector_type(2)));
__device__ __forceinline__ unsigned pack2(float a, float b) { f2v_ f = {a, b}; b2v_ r = __builtin_convertvector(f, b2v_); return *(unsigned*)&r; }
__device__ __forceinline__ uint2 pack4(float a, float b, float c, float d) { return make_uint2(pack2(a, b), pack2(c, d)); }
typedef unsigned u32x2_ __attribute__((ext_vector_type(2)));
typedef unsigned u32x4_ __attribute__((ext_vector_type(4)));
__device__ __forceinline__ uint2 ldnt2(const void* p) { const u32x2_ v = __builtin_nontemporal_load((const u32x2_*)p); return make_uint2(v.x, v.y); }
__device__ __forceinline__ uint4 ldnt4(const void* p) { const u32x4_ v = __builtin_nontemporal_load((const u32x4_*)p); return make_uint4(v.x, v.y, v.z, v.w); }
__device__ __forceinline__ float lo16(unsigned u) { return __uint_as_float(u << 16); }
__device__ __forceinline__ float hi16(unsigned u) { return __uint_as_float(u & 0xffff0000u); }
__device__ __forceinline__ float sigmoidf_(float x) { return __builtin_amdgcn_rcpf(1.0f + __expf(-x)); }
__device__ __forceinline__ float siluf_(float x) { return x * __builtin_amdgcn_rcpf(1.0f + __expf(-x)); }
__device__ __forceinline__ int cond_of(int tok) { return tok < NPROMPT ? 0 : 1 + ((tok - NPROMPT) >> 10); }
__device__ __forceinline__ float wave_sum(float v) {
#pragma unroll
  for (int o = 32; o > 0; o >>= 1) v += __shfl_xor(v, o);
  return v;
}
__device__ __forceinline__ void rope_sincos(float pos, int fi, float& sn, float& cs) {
  float inv = exp2f(-(float)fi * 1.6609640474436813f);
  float ang = pos * inv;
  float k = rintf(ang * 0.15915494309189535f);
  float r = fmaf(-k, 6.2831854820251465f, ang);
  r = fmaf(-k, -1.7484555e-7f, r);
  sn = __sinf(r); cs = __cosf(r);
}

#define NT 512
#define NW 8
#define LAS __attribute__((address_space(3)))

namespace pg8 {
constexpr int BM = 256, BK = 64, HALF = 128, HTB = HALF * BK * 2, STAGE_BYTES = 8 * HTB, NXCD = 8, WGM = 8;
__device__ __forceinline__ int lds_byte(int r, int c) { const int st = (r >> 4) * 2 + (c >> 5), rr = r & 15, cc = c & 31, ob = rr * 64 + cc * 2; return st * 1024 + (ob ^ (((ob >> 9) & 1) << 5)); }
__device__ __forceinline__ void stage_rc(int b, int& R, int& C) { const int st = b / 1024, sb = b % 1024, swz = sb ^ (((sb >> 9) & 1) << 5); R = (st >> 1) * 16 + swz / 64; C = (st & 1) * 32 + (swz % 64) / 2; }
struct Unit { int pm, pn; };
struct Gemm { const u16* A; const u16* Bt; int M, N, K, lda, gate, noepi; size_t kstepA, gstride; };
struct StaticOrder {
  int nM, nN, nwg, G, c, ubeg, uend;
  __device__ void init(int M, int N, int G_, int c_) { nM = M / BM; nN = N / BM; nwg = nM * nN; G = G_; c = c_; ubeg = 0; uend = nwg; }
  __device__ bool next(int i, Unit& u) const {
    const long L = (long)ubeg + (long)i * G + c; if (L >= uend) return false;
    int wgid = (int)L; { const int q = nwg / NXCD, r = nwg % NXCD, xcd = wgid % NXCD, off = wgid / NXCD; wgid = (xcd < r ? xcd * (q + 1) : r * (q + 1) + (xcd - r) * q) + off; }
    const int nig = WGM * nN, gid = wgid / nig, fm = gid * WGM, gsz = (nM - fm) < WGM ? (nM - fm) : WGM;
    u.pm = fm + ((wgid % nig) % gsz); u.pn = (wgid % nig) / gsz; return true;
  }
};
template <class Epi>
__device__ __forceinline__ void gemm_phase(LAS unsigned char* lds, const Gemm g, const StaticOrder& S, const Epi& E) {
  const int tid = threadIdx.x, wid = __builtin_amdgcn_readfirstlane(tid >> 6), lane = tid & 63, wr = wid >> 2, wc = wid & 3, fr = lane & 15, fq = lane >> 4;
  const int K = g.K, nt = K / BK;
  unsigned voffA[2], voffB[2];
#pragma unroll
  for (int i = 0; i < 2; ++i) { int R, C; stage_rc(tid * 16 + i * 8192, R, C); voffA[i] = (unsigned)(R * g.lda + C) * 2u; voffB[i] = (unsigned)(R * K + C) * 2u; }
  const size_t kstep = (size_t)(BK * 2);
  const size_t kstepA = g.kstepA;
  const size_t hstepA = (size_t)HALF * g.lda * 2, hstepB = (size_t)HALF * K * 2;
  const size_t tstepA = 2 * hstepA, tstepB = 2 * hstepB;
  const unsigned ldsw = (unsigned)wid * 1024u;
  const int aoff = lds_byte(wr * 64 + fr, fq * 8), boff = lds_byte(wc * 32 + fr, fq * 8);
#define PG8_AOFF(pn) (g.gate ? (size_t)(((pn) >> 1) & 3) * g.gstride : (size_t)0)
#define PG8_SA(b, h) (((b) * 2 + (h)) * HTB)
#define PG8_SB(b, h) ((4 + (b) * 2 + (h)) * HTB)
#define PG8_STAGE(bufoff, gbase, voff) do { _Pragma("unroll") for (int _i = 0; _i < 2; ++_i) \
    __builtin_amdgcn_global_load_lds((const unsigned*)((const char*)(gbase) + (voff)[_i]), (LAS unsigned*)(lds + (bufoff) + ldsw + _i * 8192), 16, 0, 0); } while (0)
#define PG8_LDA(dst, b, h) do { _Pragma("unroll") for (int m = 0; m < 4; ++m) _Pragma("unroll") for (int k = 0; k < 2; ++k) dst[m][k] = *(const LAS bf16x8*)(lds + PG8_SA(b, h) + aoff + m * 2048 + k * 1024); } while (0)
#define PG8_LDB(dst, b, h) do { _Pragma("unroll") for (int n = 0; n < 2; ++n) _Pragma("unroll") for (int k = 0; k < 2; ++k) dst[n][k] = *(const LAS bf16x8*)(lds + PG8_SB(b, h) + boff + n * 2048 + k * 1024); } while (0)
#define PG8_MMA(ai, bj, At, Bt) do { __builtin_amdgcn_s_setprio(1); _Pragma("unroll") for (int m = 0; m < 4; ++m) _Pragma("unroll") for (int n = 0; n < 2; ++n) _Pragma("unroll") for (int k = 0; k < 2; ++k) \
    acc[ai][bj][m][n] = __builtin_amdgcn_mfma_f32_16x16x32_bf16(Bt[n][k], At[m][k], acc[ai][bj][m][n], 0, 0, 0); __builtin_amdgcn_s_setprio(0); } while (0)
#define PG8_WAIT_V(n) asm volatile("s_waitcnt vmcnt(" #n ")" ::: "memory")
#define PG8_WAIT_L(n) asm volatile("s_waitcnt lgkmcnt(" #n ")" ::: "memory")
#define PG8_BAR __builtin_amdgcn_s_barrier()
#define PG8_SCHED __builtin_amdgcn_sched_barrier(0)
  Unit cur, nxt; int ui = 0;
  if (!S.next(0, cur)) return;
  f32x4 acc[2][2][4][2];
#pragma unroll
  for (int a = 0; a < 2; ++a)
#pragma unroll
    for (int b = 0; b < 2; ++b)
#pragma unroll
      for (int m = 0; m < 4; ++m)
#pragma unroll
        for (int n = 0; n < 2; ++n) acc[a][b][m][n] = (f32x4){0.f, 0.f, 0.f, 0.f};
  bf16x8 At[4][2], B0[2][2], B1[2][2];
  const char* cA = (const char*)g.A + (size_t)cur.pm * tstepA + PG8_AOFF(cur.pn); const char* cB = (const char*)g.Bt + (size_t)cur.pn * tstepB;
  PG8_STAGE(PG8_SB(0, 0), cB, voffB); PG8_STAGE(PG8_SA(0, 0), cA, voffA); PG8_STAGE(PG8_SB(0, 1), cB + hstepB, voffB); PG8_STAGE(PG8_SA(0, 1), cA + hstepA, voffA);
  if (wr == 1) PG8_BAR;
  PG8_WAIT_V(4); PG8_BAR;
  PG8_STAGE(PG8_SB(1, 0), cB + kstep, voffB); PG8_STAGE(PG8_SA(1, 0), cA + kstepA, voffA); PG8_STAGE(PG8_SB(1, 1), cB + hstepB + kstep, voffB);
  PG8_WAIT_V(6); PG8_BAR;
  for (;;) {
    const bool has_next = S.next(ui + 1, nxt);
    const char* nA = has_next ? (const char*)g.A + (size_t)nxt.pm * tstepA + PG8_AOFF(nxt.pn) : cA; const char* nB = has_next ? (const char*)g.Bt + (size_t)nxt.pn * tstepB : cB;
#pragma unroll 1
    for (int t = 0; t < nt; t += 2) {
      const bool last = (t == nt - 2);
      const char* a1 = cA + (size_t)(t + 1) * kstepA;
      const char* a2 = last ? nA : cA + (size_t)(t + 2) * kstepA; const char* b2 = last ? nB : cB + (size_t)(t + 2) * kstep;
      const char* a3 = a2 + kstepA; const char* b3 = b2 + kstep;
      PG8_LDB(B0, 0, 0); PG8_SCHED; PG8_LDA(At, 0, 0); PG8_STAGE(PG8_SA(1, 1), a1 + hstepA, voffA);
      PG8_WAIT_L(8); PG8_BAR; PG8_WAIT_L(0); PG8_MMA(0, 0, At, B0); PG8_BAR; PG8_SCHED;
      PG8_LDB(B1, 0, 1); PG8_STAGE(PG8_SB(0, 0), b2, voffB);
      PG8_BAR; PG8_WAIT_L(0); PG8_MMA(0, 1, At, B1); PG8_BAR;
      PG8_LDA(At, 0, 1); PG8_STAGE(PG8_SA(0, 0), a2, voffA);
      PG8_BAR; PG8_WAIT_L(0); PG8_MMA(1, 0, At, B0); PG8_BAR; PG8_SCHED;
      PG8_STAGE(PG8_SB(0, 1), b2 + hstepB, voffB);
      PG8_WAIT_V(6); PG8_BAR; PG8_MMA(1, 1, At, B1); PG8_BAR;
      PG8_LDB(B0, 1, 0); PG8_SCHED; PG8_LDA(At, 1, 0); PG8_STAGE(PG8_SA(0, 1), a2 + hstepA, voffA);
      PG8_WAIT_L(8); PG8_BAR; PG8_WAIT_L(0); PG8_MMA(0, 0, At, B0); PG8_BAR; PG8_SCHED;
      PG8_LDB(B1, 1, 1); PG8_STAGE(PG8_SB(1, 0), b3, voffB);
      PG8_BAR; PG8_WAIT_L(0); PG8_MMA(0, 1, At, B1); PG8_BAR;
      PG8_LDA(At, 1, 1); PG8_STAGE(PG8_SA(1, 0), a3, voffA);
      PG8_BAR; PG8_WAIT_L(0); PG8_MMA(1, 0, At, B0); PG8_BAR; PG8_SCHED;
      PG8_STAGE(PG8_SB(1, 1), b3 + hstepB, voffB);
      PG8_WAIT_V(6); PG8_BAR; PG8_MMA(1, 1, At, B1); PG8_BAR;
    }
    if constexpr (!Epi::AFTER_DRAIN) { if (!g.noepi) E(acc, cur, wr, wc, fr, fq); }
    if (!has_next) break;
#pragma unroll
    for (int a = 0; a < 2; ++a)
#pragma unroll
      for (int b = 0; b < 2; ++b)
#pragma unroll
        for (int m = 0; m < 4; ++m)
#pragma unroll
          for (int n = 0; n < 2; ++n) acc[a][b][m][n] = (f32x4){0.f, 0.f, 0.f, 0.f};
    cur = nxt; cA = nA; cB = nB; ++ui;
  }
  PG8_WAIT_V(0);
  if (wr == 0) PG8_BAR;
  PG8_BAR;
  if constexpr (Epi::AFTER_DRAIN) { if (!g.noepi) E.fused(acc, cur, wr, wc, fr, fq, lds); }
#undef PG8_AOFF
#undef PG8_SA
#undef PG8_SB
#undef PG8_STAGE
#undef PG8_LDA
#undef PG8_LDB
#undef PG8_MMA
#undef PG8_WAIT_V
#undef PG8_WAIT_L
#undef PG8_BAR
#undef PG8_SCHED
}
}
using pg8::Unit;
typedef const f32x4 (&AccRef)[2][2][4][2];

#define EPI_ROWS(...) _Pragma("unroll") for (int ai = 0; ai < 2; ++ai) _Pragma("unroll") for (int m = 0; m < 4; ++m) { const int row = u.pm * 256 + ai * 128 + wr * 64 + m * 16 + fr; __VA_ARGS__ }
#define EPI_COLS(...) _Pragma("unroll") for (int bj = 0; bj < 2; ++bj) _Pragma("unroll") for (int n = 0; n < 2; ++n) { const int cb = u.pn * 256 + bj * 128 + wc * 32 + n * 16; const f32x4 a = acc[ai][bj][m][n]; __VA_ARGS__ }

struct EpiHgIn {
  static constexpr bool AFTER_DRAIN = false;
  u16 *q, *v, *sg; _Float16* lf; const float* lb;
  __device__ __forceinline__ void operator()(AccRef acc, const Unit& u, int wr, int wc, int fr, int fq) const {
    const int region = u.pn >> 2;
    f32x4 l4[2][2];
    if (region == 1 || region == 2) {
#pragma unroll
      for (int bj = 0; bj < 2; ++bj)
#pragma unroll
        for (int n = 0; n < 2; ++n) l4[bj][n] = *(const f32x4*)&lb[(region - 1) * 1024 + ((u.pn * 256 + bj * 128 + wc * 32 + n * 16) & 1023) + fq * 4];
    }
    EPI_ROWS( EPI_COLS(
      const int c = (cb & 1023) + fq * 4;
      if (region == 0) {
        const float s = 0.08838834764831845f;
        *(uint2*)&q[(size_t)row * 1024 + c] = pack4(siluf_(a[0]) * s, siluf_(a[1]) * s, siluf_(a[2]) * s, siluf_(a[3]) * s);
      } else if (region <= 2) {
        const int d = region - 1;
        h4 o;
        _Pragma("unroll") for (int j = 0; j < 4; ++j) { float f = l4[bj][n][j] + (1.0f - l4[bj][n][j]) * sigmoidf_(a[j]); o[j] = (_Float16)__builtin_amdgcn_logf(f); }
        *(h4*)&lf[(size_t)row * 2048 + d * 1024 + c] = o;
      } else if (region == 3) {
        *(uint2*)&v[(size_t)row * 1024 + c] = pack4(a[0], a[1], a[2], a[3]);
      } else {
        *(uint2*)&sg[(size_t)row * 1024 + c] = pack4(a[0], a[1], a[2], a[3]);
      }
    ) )
  }
};

struct EpiRes {
  static constexpr bool AFTER_DRAIN = false;
  const float* xin_p; const float* xin_s; float* Y; const float* gate;
  __device__ __forceinline__ void operator()(AccRef acc, const Unit& u, int wr, int wc, int fr, int fq) const {
    EPI_ROWS(
      const float* xr = row < NPROMPT ? xin_p + (size_t)row * 1024 : xin_s + (size_t)(row - NPROMPT) * 1024;
      const float* g = gate + cond_of(row) * 3072;
      EPI_COLS(
        const int c = cb + fq * 4;
        f32x4 x = *(const f32x4*)&xr[c];
        f32x4 gg = *(const f32x4*)&g[c];
        f32x4 y;
        _Pragma("unroll") for (int j = 0; j < 4; ++j) y[j] = DN_ALPHA * x[j] + gg[j] * a[j];
        *(f32x4*)&Y[(size_t)row * 1024 + c] = y;
      ) )
  }
};

template <bool XIN_BF, bool XOUT_BF>
struct EpiResLn {
  static constexpr bool AFTER_DRAIN = true;
  const float* xin_p; const float* xin_s; const u16* xin_b; float* X; u16* XB; const float* gate; const float* lg; const float* lbias; const float* modn; u16* H;
  unsigned long long* slots; unsigned* cnt;
  __device__ __forceinline__ void fused(f32x4 (&acc)[2][2][4][2], const Unit& u, int wr, int wc, int fr, int fq, LAS unsigned char* lds) const {
    LAS float* part = (LAS float*)lds;
    LAS float* stat = part + 2048;
    const int tid = threadIdx.x;
    const int cnd = cond_of(u.pm * 256);
    f32x4 gv[2][2];
#pragma unroll
    for (int bj = 0; bj < 2; ++bj)
#pragma unroll
      for (int n = 0; n < 2; ++n) gv[bj][n] = *(const f32x4*)&gate[cnd * 3072 + u.pn * 256 + bj * 128 + wc * 32 + n * 16 + fq * 4];
#pragma unroll
    for (int ai = 0; ai < 2; ++ai)
#pragma unroll
      for (int m = 0; m < 4; ++m) {
        const int rl = ai * 128 + wr * 64 + m * 16 + fr;
        const int row = u.pm * 256 + rl;
        const float* xr = row < NPROMPT ? xin_p + (size_t)row * 1024 : xin_s + (size_t)(row - NPROMPT) * 1024;
        float s1 = 0.f, s2 = 0.f;
#pragma unroll
        for (int bj = 0; bj < 2; ++bj)
#pragma unroll
          for (int n = 0; n < 2; ++n) {
            const int c = u.pn * 256 + bj * 128 + wc * 32 + n * 16 + fq * 4;
            f32x4 x;
            if constexpr (XIN_BF) { const uint2 xb2 = *(const uint2*)&xin_b[(size_t)row * 1024 + c]; x = f32x4{lo16(xb2.x), hi16(xb2.x), lo16(xb2.y), hi16(xb2.y)}; }
            else x = *(const f32x4*)&xr[c];
            const f32x4 gg = gv[bj][n];
            f32x4 y;
#pragma unroll
            for (int j = 0; j < 4; ++j) { y[j] = DN_ALPHA * x[j] + gg[j] * acc[ai][bj][m][n][j]; s1 += y[j]; s2 += y[j] * y[j]; }
            acc[ai][bj][m][n] = y;
          }
        s1 += __shfl_xor(s1, 16); s1 += __shfl_xor(s1, 32);
        s2 += __shfl_xor(s2, 16); s2 += __shfl_xor(s2, 32);
        if (fq == 0) { part[(rl * 4 + wc) * 2] = s1; part[(rl * 4 + wc) * 2 + 1] = s2; }
      }
    __syncthreads();
    if (tid < 256) {
      float S1 = 0.f, S2 = 0.f;
#pragma unroll
      for (int w2 = 0; w2 < 4; ++w2) { S1 += part[(tid * 4 + w2) * 2]; S2 += part[(tid * 4 + w2) * 2 + 1]; }
      const unsigned long long v = (unsigned long long)__float_as_uint(S1) | ((unsigned long long)__float_as_uint(S2) << 32);
      __hip_atomic_store(&slots[(size_t)(u.pm * 4 + u.pn) * 256 + tid], v, __ATOMIC_RELAXED, __HIP_MEMORY_SCOPE_AGENT);
    }
    asm volatile("s_waitcnt vmcnt(0)" ::: "memory");
    __syncthreads();
    if (tid == 0) {
      __hip_atomic_fetch_add(&cnt[u.pm], 1u, __ATOMIC_RELAXED, __HIP_MEMORY_SCOPE_AGENT);
      unsigned sp = 0;
      while (__hip_atomic_load(&cnt[u.pm], __ATOMIC_RELAXED, __HIP_MEMORY_SCOPE_AGENT) < 4u) { __builtin_amdgcn_s_sleep(1); if (++sp > (1u << 24)) break; }
    }
    __syncthreads();
    if (tid < 256) {
      float T1 = 0.f, T2 = 0.f;
#pragma unroll
      for (int o = 0; o < 4; ++o) {
        const unsigned long long v = __hip_atomic_load(&slots[(size_t)(u.pm * 4 + o) * 256 + tid], __ATOMIC_RELAXED, __HIP_MEMORY_SCOPE_AGENT);
        T1 += __uint_as_float((unsigned)(v & 0xffffffffull)); T2 += __uint_as_float((unsigned)(v >> 32));
      }
      const float mu = T1 * (1.0f / 1024.0f);
      const float var = fmaxf(T2 * (1.0f / 1024.0f) - mu * mu, 0.f);
      stat[tid * 2] = mu; stat[tid * 2 + 1] = rsqrtf(var + 1e-5f);
    }
    __syncthreads();
#pragma unroll
    for (int bj = 0; bj < 2; ++bj) {
      f32x4 lgv[2], lbv[2], shv[2], scv[2];
#pragma unroll
      for (int n = 0; n < 2; ++n) {
        const int c = u.pn * 256 + bj * 128 + wc * 32 + n * 16 + fq * 4;
        lgv[n] = *(const f32x4*)&lg[c]; lbv[n] = *(const f32x4*)&lbias[c];
        shv[n] = *(const f32x4*)&modn[cnd * 3072 + c]; scv[n] = *(const f32x4*)&modn[cnd * 3072 + 1024 + c];
      }
#pragma unroll
      for (int ai = 0; ai < 2; ++ai)
#pragma unroll
        for (int m = 0; m < 4; ++m) {
          const int rl = ai * 128 + wr * 64 + m * 16 + fr;
          const int row = u.pm * 256 + rl;
          const float mu = stat[rl * 2], rs = stat[rl * 2 + 1];
#pragma unroll
          for (int n = 0; n < 2; ++n) {
            const int c = u.pn * 256 + bj * 128 + wc * 32 + n * 16 + fq * 4;
            const f32x4 y = acc[ai][bj][m][n];
            f32x4 xo;
#pragma unroll
            for (int j = 0; j < 4; ++j) xo[j] = (y[j] - mu) * rs * lgv[n][j] + lbv[n][j];
            if constexpr (XOUT_BF) *(uint2*)&XB[(size_t)row * 1024 + c] = pack4(xo[0], xo[1], xo[2], xo[3]);
            else __builtin_nontemporal_store(xo, (f32x4*)&X[(size_t)row * 1024 + c]);
            if (H) {
              *(uint2*)&H[(size_t)row * 1024 + c] = pack4(xo[0] * (1 + scv[n][0]) + shv[n][0], xo[1] * (1 + scv[n][1]) + shv[n][1], xo[2] * (1 + scv[n][2]) + shv[n][2], xo[3] * (1 + scv[n][3]) + shv[n][3]);
            }
          }
        }
    }
  }
};

struct EpiScIn {
  static constexpr bool AFTER_DRAIN = false;
  u16 *pb, *sb;
  __device__ __forceinline__ void operator()(AccRef acc, const Unit& u, int wr, int wc, int fr, int fq) const {
    const int c = u.pn * 64 + wc * 16 + fq * 4;
    EPI_ROWS(
      const f32x4 bg = acc[ai][0][m][0], cgv = acc[ai][0][m][1], v = acc[ai][1][m][0], g = acc[ai][1][m][1];
      *(uint2*)&pb[(size_t)row * 1024 + c] = pack4(cgv[0] * v[0], cgv[1] * v[1], cgv[2] * v[2], cgv[3] * v[3]);
      *(uint2*)&sb[(size_t)row * 1024 + c] = pack4(siluf_(g[0]) * bg[0], siluf_(g[1]) * bg[1], siluf_(g[2]) * bg[2], siluf_(g[3]) * bg[3]);
    )
  }
};

struct EpiRgIn {
  static constexpr bool AFTER_DRAIN = false;
  u16 *ub, *sg;
  __device__ __forceinline__ void operator()(AccRef acc, const Unit& u, int wr, int wc, int fr, int fq) const {
    const int region = u.pn >> 2;
    EPI_ROWS( EPI_COLS(
      const int c = (cb & 1023) + fq * 4;
      if (region == 0) *(uint2*)&ub[(size_t)row * 1024 + c] = pack4(a[0], a[1], a[2], a[3]);
      else *(uint2*)&sg[((size_t)(c >> 6) * TOK + row) * 64 + (c & 63)] = pack4(siluf_(a[0]), siluf_(a[1]), siluf_(a[2]), siluf_(a[3]));
    ) )
  }
};

struct EpiSgGM {
  static constexpr bool AFTER_DRAIN = false;
  u16* sg;
  __device__ __forceinline__ void operator()(AccRef acc, const Unit& u, int wr, int wc, int fr, int fq) const {
    EPI_ROWS( EPI_COLS(
      const int c = cb + fq * 4;
      *(uint2*)&sg[((size_t)(c >> 6) * TOK + row) * 64 + (c & 63)] = pack4(siluf_(a[0]), siluf_(a[1]), siluf_(a[2]), siluf_(a[3]));
    ) )
  }
};

struct EpiRgGate {
  static constexpr bool AFTER_DRAIN = false;
  u16 *rb, *ib; const float* bgate;
  __device__ __forceinline__ void operator()(AccRef acc, const Unit& u, int wr, int wc, int fr, int fq) const {
    const int mat = u.pn >> 1, d = mat >> 2, hd = mat & 3;
    f32x4 br[2], bi[2]; int ccs[2];
#pragma unroll
    for (int bj = 0; bj < 2; ++bj) {
      const int off = ((u.pn & 1) * 256 + bj * 128 + wc * 32);
      ccs[bj] = (off >> 5) * 16 + fq * 4;
      br[bj] = *(const f32x4*)&bgate[mat * 512 + ccs[bj]];
      bi[bj] = *(const f32x4*)&bgate[mat * 512 + 256 + ccs[bj]];
    }
    EPI_ROWS(
      _Pragma("unroll") for (int bj = 0; bj < 2; ++bj) {
        const f32x4 r = acc[ai][bj][m][0], ii = acc[ai][bj][m][1];
        const int cch = hd * 256 + ccs[bj];
        const size_t o = (size_t)d * TOK * 1024 + ((size_t)(cch >> 6) * TOK + row) * 64 + (cch & 63);
        *(uint2*)&rb[o] = pack4(sigmoidf_(r[0] + br[bj][0]), sigmoidf_(r[1] + br[bj][1]), sigmoidf_(r[2] + br[bj][2]), sigmoidf_(r[3] + br[bj][3]));
        *(uint2*)&ib[o] = pack4(sigmoidf_(ii[0] + bi[bj][0]), sigmoidf_(ii[1] + bi[bj][1]), sigmoidf_(ii[2] + bi[bj][2]), sigmoidf_(ii[3] + bi[bj][3]));
      } )
  }
};

struct EpiMlaIn {
  static constexpr bool AFTER_DRAIN = false;
  u16* cq; float* ckvraw; float* kperaw; u16* sg;
  __device__ __forceinline__ void operator()(AccRef acc, const Unit& u, int wr, int wc, int fr, int fq) const {
    EPI_ROWS( EPI_COLS(
      const int c = cb + fq * 4;
      if (cb < 384) *(uint2*)&cq[(size_t)row * 384 + c] = pack4(a[0], a[1], a[2], a[3]);
      else if (cb < 640) *(f32x4*)&ckvraw[(size_t)row * 256 + (c - 384)] = a;
      else if (cb < 672) *(f32x4*)&kperaw[(size_t)row * 32 + (c - 640)] = a;
    ) )
  }
};

struct EpiSg {
  static constexpr bool AFTER_DRAIN = false;
  u16* sg;
  __device__ __forceinline__ void operator()(AccRef acc, const Unit& u, int wr, int wc, int fr, int fq) const {
    EPI_ROWS( EPI_COLS(
      *(uint2*)&sg[(size_t)row * 1024 + cb + fq * 4] = pack4(a[0], a[1], a[2], a[3]);
    ) )
  }
};

struct EpiQ {
  static constexpr bool AFTER_DRAIN = false;
  u16* q;
  __device__ __forceinline__ void operator()(AccRef acc, const Unit& u, int wr, int wc, int fr, int fq) const {
    const float sc = 0.14724444500602648f;
    EPI_ROWS( EPI_COLS(
      *(uint2*)&q[(size_t)row * 1536 + cb + fq * 4] = pack4(a[0] * sc, a[1] * sc, a[2] * sc, a[3] * sc);
    ) )
  }
};

struct EpiK {
  static constexpr bool AFTER_DRAIN = false;
  u16* Kb;
  __device__ __forceinline__ void operator()(AccRef acc, const Unit& u, int wr, int wc, int fr, int fq) const {
    EPI_ROWS( EPI_COLS(
      const int h = cb >> 6, dd = (cb & 63) + fq * 4;
      *(uint2*)&Kb[((size_t)row * 16 + h) * 96 + dd] = pack4(a[0], a[1], a[2], a[3]);
    ) )
  }
};
struct EpiV {
  static constexpr bool AFTER_DRAIN = false;
  u16* Vt;
  __device__ __forceinline__ void operator()(AccRef acc, const Unit& u, int wr, int wc, int fr, int fq) const {
    EPI_ROWS( EPI_COLS(
      *(uint2*)&Vt[(size_t)row * KVROWS + cb + fq * 4] = pack4(a[0], a[1], a[2], a[3]);
    ) )
  }
};

__device__ __forceinline__ void wconv_tile(const float* __restrict__ src, int N, int K, u16* __restrict__ dst, int k0, int n0,
                                           int perm, int mat, float* tile) {
  const int tid = threadIdx.x;
  {
    const int r = tid >> 4, c4 = (tid & 15) * 4;
#pragma unroll
    for (int i = 0; i < 2; ++i) {
      const int k = r + i * 32;
      f32x4 v = f32x4{0.f, 0.f, 0.f, 0.f};
      if (n0 + c4 < N) v = __builtin_nontemporal_load((const f32x4*)&src[(size_t)(k0 + k) * N + n0 + c4]);
      tile[k * 65 + c4 + 0] = v[0]; tile[k * 65 + c4 + 1] = v[1]; tile[k * 65 + c4 + 2] = v[2]; tile[k * 65 + c4 + 3] = v[3];
    }
  }
  __syncthreads();
  {
    const int nl = tid >> 3, kq = (tid & 7) * 8;
    const int n = n0 + nl;
    int np = n;
    if (perm == 1) { const int part = n >> 10, c = n & 1023; np = (c >> 6) * 256 + (part >> 1) * 128 + ((c >> 4) & 3) * 32 + (part & 1) * 16 + (c & 15); }
    else if (perm == 2) { const int type = n >> 8, cc = n & 255; np = mat * 512 + (cc >> 4) * 32 + type * 16 + (cc & 15); }
    else if (perm == 3) { const int hh = n >> 7, dd = n & 127; np = (dd >= 64 ? 1024 : 0) + hh * 64 + (dd & 63); }
    if (n < N) {
      unsigned w[4];
#pragma unroll
      for (int i = 0; i < 4; ++i) w[i] = pack2(tile[(kq + 2 * i) * 65 + nl], tile[(kq + 2 * i + 1) * 65 + nl]);
      *(uint4*)&dst[(size_t)np * K + k0 + kq] = make_uint4(w[0], w[1], w[2], w[3]);
    }
  }
  __syncthreads();
}

__device__ __forceinline__ void wconv_item(const Params& p, int t, float* fs) {
  const float* src; u16* dst; int N, K, perm = 0, mat = 0, ntn;
  if (t < 1280) { src = p.in[12]; dst = (u16*)(p.ws + WS_W_HG_IN); N = 5120; K = 1024; }
  else if ((t -= 1280) < 256) { src = p.in[15]; dst = (u16*)(p.ws + WS_W_HG_OUT); N = 1024; K = 1024; }
  else if ((t -= 256) < 1024) { src = p.in[16]; dst = (u16*)(p.ws + WS_W_SC_IN); N = 4096; K = 1024; perm = 1; }
  else if ((t -= 1024) < 256) { src = p.in[19]; dst = (u16*)(p.ws + WS_W_SC_OUT); N = 1024; K = 1024; }
  else if ((t -= 256) < 512) { src = p.in[20]; dst = (u16*)(p.ws + WS_W_RG_IN); N = 2048; K = 1024; }
  else if ((t -= 512) < 256) { mat = t >> 5; t &= 31; src = p.in[23] + (size_t)mat * 256 * 512; dst = (u16*)(p.ws + WS_W_RG_GATE); N = 512; K = 256; perm = 2; }
  else if ((t -= 256) < 256) { src = p.in[26]; dst = (u16*)(p.ws + WS_W_RG_OUT); N = 1024; K = 1024; }
  else if ((t -= 256) < 432) { src = p.in[27]; dst = (u16*)(p.ws + WS_W_MLA_IN); N = 1696; K = 1024; }
  else if ((t -= 432) < 144) { src = p.in[30]; dst = (u16*)(p.ws + WS_W_QB); N = 1536; K = 384; }
  else if ((t -= 144) < 128) { src = p.in[31]; dst = (u16*)(p.ws + WS_W_KVB); N = 2048; K = 256; perm = 3; }
  else { t -= 128; src = p.in[32]; dst = (u16*)(p.ws + WS_W_MLA_OUT); N = 1024; K = 1024; }
  ntn = (N + 63) >> 6;
  const int kt = t / ntn, ntl = t - kt * ntn;
  wconv_tile(src, N, K, dst, kt * 64, ntl * 64, perm, mat, fs);
}
__device__ __forceinline__ void wconv_idle(const Params& p, unsigned char* smem_raw, int bid, int nb, int t0, int t1) {
  if (nb == 256 && bid >= 192) for (int t = t0 + (bid - 192); t < t1; t += 64) wconv_item(p, t, (float*)smem_raw);
}

__device__ __forceinline__ void phase_prologue(const Params& p, unsigned char* smem_raw, int bid, int nb) {
  float* fs = (float*)smem_raw;
  const int tid = threadIdx.x;
  const int NMOD = 192, NWT = (nb == 256) ? 1536 : 4800;
  for (int it = bid; it < NMOD + 1 + NWT; it += nb) {
    if (it < NMOD) {
      const int l = it / 48, n0 = (it % 48) * 64;
      float* scond = fs;
      float* sred = fs + 5120;
      for (int i = tid; i < 5120; i += NT) {
        const int ci = i >> 10, k = i & 1023;
        float cv = ci == 0 ? p.in[7][k] : p.in[6][(ci - 1) * 1024 + k];
        scond[i] = siluf_(cv);
      }
      __syncthreads();
      const int col = tid & 63, kg = tid >> 6;
      const float* w = p.in[8] + (size_t)l * 1024 * 3072 + n0 + col;
      float a0 = 0, a1 = 0, a2 = 0, a3 = 0, a4 = 0;
#pragma unroll 16
      for (int k = kg * 128; k < kg * 128 + 128; ++k) {
        float wv = __builtin_nontemporal_load(&w[(size_t)k * 3072]);
        a0 += scond[k] * wv; a1 += scond[1024 + k] * wv; a2 += scond[2048 + k] * wv; a3 += scond[3072 + k] * wv; a4 += scond[4096 + k] * wv;
      }
      sred[(kg * 5 + 0) * 64 + col] = a0; sred[(kg * 5 + 1) * 64 + col] = a1; sred[(kg * 5 + 2) * 64 + col] = a2;
      sred[(kg * 5 + 3) * 64 + col] = a3; sred[(kg * 5 + 4) * 64 + col] = a4;
      __syncthreads();
      float* mod = (float*)(p.ws + WS_MOD);
      if (tid < 320) {
        const int ci = tid >> 6, cc = tid & 63;
        float s = 0;
#pragma unroll
        for (int g = 0; g < 8; ++g) s += sred[(g * 5 + ci) * 64 + cc];
        mod[(l * 5 + ci) * 3072 + n0 + cc] = s + p.in[9][l * 3072 + n0 + cc];
      }
      __syncthreads();
    } else if (it == NMOD) {
      float* lb = (float*)(p.ws + WS_LB);
      for (int i = tid; i < 2048; i += NT) {
        const int d = i >> 10, c = i & 1023;
        const float* lg = p.in[13] + d * 5 * 1024 + c;
        float m = lg[0];
        for (int j = 1; j < 5; ++j) m = fmaxf(m, lg[j * 1024]);
        float s = 0;
        for (int j = 0; j < 5; ++j) s += expf(lg[j * 1024] - m);
        lb[i] = expf(lg[0] - m) / s;
      }
      int* cnt = (int*)(p.ws + WS_CNT);
      if (tid < 16) cnt[tid] = 0;
    } else {
      wconv_item(p, it - NMOD - 1, fs);
    }
  }
}

__device__ __forceinline__ void phase_h0(const Params& p, int bid, int nb) {
  const float* mod = (const float*)(p.ws + WS_MOD);
  u16* H = (u16*)(p.ws + WS_H);
  const size_t total = (size_t)(TOK / 4) * 256;
  for (size_t i = (size_t)bid * NT + threadIdx.x; i < total; i += (size_t)nb * NT) {
    const int row = (int)(i >> 8) * 4, c = ((int)i & 255) * 4;
    const float* xr = row < NPROMPT ? p.in[0] + (size_t)row * 1024 : p.in[1] + (size_t)(row - NPROMPT) * 1024;
    const float* m = mod + cond_of(row) * 3072;
    f32x4 x[4];
#pragma unroll
    for (int t = 0; t < 4; ++t) x[t] = __builtin_nontemporal_load((const f32x4*)&xr[t * 1024 + c]);
    const f32x4 sh = *(const f32x4*)&m[c];
    const f32x4 sc = *(const f32x4*)&m[1024 + c];
#pragma unroll
    for (int t = 0; t < 4; ++t)
      *(uint2*)&H[(size_t)(row + t) * 1024 + c] = pack4(x[t][0] * (1 + sc[0]) + sh[0], x[t][1] * (1 + sc[1]) + sh[1], x[t][2] * (1 + sc[2]) + sh[2], x[t][3] * (1 + sc[3]) + sh[3]);
  }
}

__device__ __forceinline__ void phase_ln(const Params& p, int l, int bid, int nb) {
  float* X = p.out;
  const float* g = p.in[10] + l * 1024;
  const float* b = p.in[11] + l * 1024;
  const float* mod = (const float*)(p.ws + WS_MOD) + (l + 1) * 5 * 3072;
  u16* H = (u16*)(p.ws + WS_H);
  const int lane = threadIdx.x & 63, wave = threadIdx.x >> 6;
  for (int row = bid * NW + wave; row < TOK; row += nb * NW) {
    float* xr = X + (size_t)row * 1024;
    f32x4 v[4];
    float s = 0;
#pragma unroll
    for (int i = 0; i < 4; ++i) { v[i] = *(const f32x4*)&xr[i * 256 + lane * 4]; s += v[i][0] + v[i][1] + v[i][2] + v[i][3]; }
    const float mu = wave_sum(s) * (1.0f / 1024.0f);
    float q = 0;
#pragma unroll
    for (int i = 0; i < 4; ++i)
#pragma unroll
      for (int j = 0; j < 4; ++j) { float dd = v[i][j] - mu; q += dd * dd; }
    const float rs = rsqrtf(wave_sum(q) * (1.0f / 1024.0f) + 1e-5f);
    const float* m = mod + cond_of(row) * 3072;
#pragma unroll
    for (int i = 0; i < 4; ++i) {
      const int c = i * 256 + lane * 4;
      f32x4 gg = *(const f32x4*)&g[c], bb = *(const f32x4*)&b[c];
      f32x4 y;
#pragma unroll
      for (int j = 0; j < 4; ++j) y[j] = (v[i][j] - mu) * rs * gg[j] + bb[j];
      *(f32x4*)&xr[c] = y;
      if (l < 3) {
        f32x4 sh = *(const f32x4*)&m[c], sc = *(const f32x4*)&m[1024 + c];
        *(uint2*)&H[(size_t)row * 1024 + c] = pack4(y[0] * (1 + sc[0]) + sh[0], y[1] * (1 + sc[1]) + sh[1], y[2] * (1 + sc[2]) + sh[2], y[3] * (1 + sc[3]) + sh[3]);
      }
    }
  }
}

__device__ __forceinline__ void phase_gla(const Params& p, unsigned char* smem_raw) {
  u16* s_qrel = (u16*)smem_raw;
  u16* s_krel = s_qrel + 32 * 136;
  u16* s_qcum = s_krel + 32 * 136;
  u16* s_kdT = s_qcum + 32 * 136;
  u16* s_vT = s_kdT + 128 * 40;
  u16* s_att = s_vT + 128 * 40;
  u16* s_S = s_att + 32 * 40;
  float* s_dec = (float*)(s_S + 128 * 136);
  float* s_part = s_dec + 128;
  int* s_u = (int*)(s_part + 512);
  int* counter = (int*)(p.ws + WS_CNT);
  const u16* qg = (const u16*)(p.ws + WS_B(0));
  const u16* vg = (const u16*)(p.ws + WS_B(1));
  const _Float16* lfg = (const _Float16*)(p.ws + WS_B(3));
  u16* og = (u16*)(p.ws + WS_B(5));
  const int tid = threadIdx.x, lane = tid & 63, w = tid >> 6, fr = lane & 15, fq = lane >> 4;
  const int kk = tid & 127, th = tid >> 7;
  const int ti = w >> 2, vi = w & 3;
  const int wk = w & 3, wv = w >> 2;
  bool first = true;
  while (true) {
    if (tid == 0) *s_u = (first && blockIdx.x < 64) ? (int)blockIdx.x : 64 + atomicAdd(counter, 1);
    first = false;
    __syncthreads();
    const int u = *s_u;
    __syncthreads();
    if (u >= 576) break;
    int b, rem, start, N, sample;
    if (u < 64) { sample = 1; b = u >> 4; rem = u & 15; start = NPROMPT + b * 1024; N = 1024; }
    else { sample = 0; b = (u - 64) >> 4; rem = (u - 64) & 15; start = b * 256; N = 256; }
    const int h = rem >> 1, d = rem & 1;
    const int nc = N >> 5;
    f32x4 S[2][4];
#pragma unroll
    for (int mi = 0; mi < 2; ++mi)
#pragma unroll
      for (int ni = 0; ni < 4; ++ni) {
        f32x4 s4 = f32x4{0.f, 0.f, 0.f, 0.f};
        if (sample) {
          const float* s0 = p.in[2] + ((size_t)((b * 2 + d) * 8 + h)) * 16384;
#pragma unroll
          for (int j = 0; j < 4; ++j) s4[j] = s0[(wk * 32 + mi * 16 + fq * 4 + j) * 128 + wv * 64 + ni * 16 + fr];
        }
        S[mi][ni] = s4;
        *(uint2*)&s_S[(wv * 64 + ni * 16 + fr) * 136 + wk * 32 + mi * 16 + fq * 4] = pack4(s4[0], s4[1], s4[2], s4[3]);
      }
    _Float16 lfraw[8]; u16 qraw[8]; uint4 vraw;
#define GLA_LOAD(cc) do { _Pragma("unroll") for (int i = 0; i < 8; ++i) { const int tt = (cc) * 32 + th * 8 + i; const size_t tok = start + (d ? (N - 1 - tt) : tt); \
      lfraw[i] = lfg[tok * 2048 + d * 1024 + h * 128 + kk]; qraw[i] = qg[tok * 1024 + h * 128 + kk]; } \
      { const int tt = (cc) * 32 + (tid & 31); const size_t tok = start + (d ? (N - 1 - tt) : tt); vraw = *(const uint4*)&vg[tok * 1024 + h * 128 + (tid >> 5) * 8]; } } while (0)
    GLA_LOAD(0);
    for (int c = 0; c < nc; ++c) {
      {
        float lfv[8], qv[8];
#pragma unroll
        for (int i = 0; i < 8; ++i) { lfv[i] = (float)lfraw[i]; qv[i] = bf2f(qraw[i]); }
        const uint4 vv = vraw;
        if (c + 1 < nc) GLA_LOAD(c + 1);
        float run = 0;
        float cs[8];
#pragma unroll
        for (int i = 0; i < 8; ++i) { run += lfv[i]; cs[i] = run; }
        s_part[th * 128 + kk] = run;
        {
          const int s = tid & 31, v8 = (tid >> 5) * 8;
          const unsigned vw[4] = {vv.x, vv.y, vv.z, vv.w};
#pragma unroll
          for (int i = 0; i < 4; ++i) { s_vT[(v8 + 2 * i) * 40 + s] = (u16)(vw[i] & 0xffff); s_vT[(v8 + 2 * i + 1) * 40 + s] = (u16)(vw[i] >> 16); }
        }
        __syncthreads();
        const float p0 = s_part[kk], p1 = s_part[128 + kk], p2 = s_part[256 + kk], p3 = s_part[384 + kk];
        const float off = (th > 0 ? p0 : 0.f) + (th > 1 ? p1 : 0.f) + (th > 2 ? p2 : 0.f);
        const float ref = p0 + p1, total = p0 + p1 + p2 + p3;
        unsigned kd[4];
        const float eref = __builtin_amdgcn_exp2f(ref), etr = __builtin_amdgcn_exp2f(total - ref);
#pragma unroll
        for (int i = 0; i < 8; ++i) {
          const int t = th * 8 + i;
          const float cum = off + cs[i];
          const float kf = 1.0f - __builtin_amdgcn_exp2f(lfv[i]);
          const float e1 = __builtin_amdgcn_exp2f(cum - ref), e2 = __builtin_amdgcn_rcpf(e1);
          const float qe = qv[i] * e1, ke = kf * e2;
          s_qrel[t * 136 + kk] = f2bf(qe);
          s_krel[t * 136 + kk] = f2bf(ke);
          s_qcum[t * 136 + kk] = f2bf(qe * eref);
          const u16 kdv = f2bf(ke * etr);
          if (i & 1) kd[i >> 1] |= ((unsigned)kdv) << 16; else kd[i >> 1] = kdv;
        }
        *(uint4*)&s_kdT[kk * 40 + th * 8] = make_uint4(kd[0], kd[1], kd[2], kd[3]);
        if (th == 0) s_dec[kk] = eref * etr;
      }
      __syncthreads();
      f32x4 oacc[2] = {f32x4{0.f, 0.f, 0.f, 0.f}, f32x4{0.f, 0.f, 0.f, 0.f}};
      {
        f32x4 att = f32x4{0.f, 0.f, 0.f, 0.f};
        const int ati = w >> 1, asi = w & 1;
#pragma unroll
        for (int ks = 0; ks < 4; ++ks) {
          if (w < 4) {
            bf16x8 a = *(const bf16x8*)&s_qrel[(ati * 16 + fr) * 136 + ks * 32 + fq * 8];
            bf16x8 bb = *(const bf16x8*)&s_krel[(asi * 16 + fr) * 136 + ks * 32 + fq * 8];
            att = __builtin_amdgcn_mfma_f32_16x16x32_bf16(a, bb, att, 0, 0, 0);
          }
          bf16x8 a2 = *(const bf16x8*)&s_qcum[(ti * 16 + fr) * 136 + ks * 32 + fq * 8];
#pragma unroll
          for (int e = 0; e < 2; ++e) {
            bf16x8 b2 = *(const bf16x8*)&s_S[((vi * 2 + e) * 16 + fr) * 136 + ks * 32 + fq * 8];
            oacc[e] = __builtin_amdgcn_mfma_f32_16x16x32_bf16(b2, a2, oacc[e], 0, 0, 0);
          }
        }
        if (w < 4) {
#pragma unroll
          for (int j = 0; j < 4; ++j) {
            const int t = ati * 16 + fq * 4 + j, s = asi * 16 + fr;
            s_att[t * 40 + s] = (s <= t) ? f2bf(att[j]) : (u16)0;
          }
        }
      }
      __syncthreads();
      {
        bf16x8 a = *(const bf16x8*)&s_att[(ti * 16 + fr) * 40 + fq * 8];
        const int tt = c * 32 + ti * 16 + fr;
        const size_t tok = start + (d ? (N - 1 - tt) : tt);
#pragma unroll
        for (int e = 0; e < 2; ++e) {
          bf16x8 bb = *(const bf16x8*)&s_vT[((vi * 2 + e) * 16 + fr) * 40 + fq * 8];
          oacc[e] = __builtin_amdgcn_mfma_f32_16x16x32_bf16(bb, a, oacc[e], 0, 0, 0);
          *(uint2*)&og[((size_t)d * TOK + tok) * 1024 + h * 128 + (vi * 2 + e) * 16 + fq * 4] = pack4(oacc[e][0], oacc[e][1], oacc[e][2], oacc[e][3]);
        }
        bf16x8 vf[4];
#pragma unroll
        for (int ni = 0; ni < 4; ++ni) vf[ni] = *(const bf16x8*)&s_vT[(wv * 64 + ni * 16 + fr) * 40 + fq * 8];
#pragma unroll
        for (int mi = 0; mi < 2; ++mi) {
          bf16x8 kf = *(const bf16x8*)&s_kdT[(wk * 32 + mi * 16 + fr) * 40 + fq * 8];
          f32x4 dc = *(const f32x4*)&s_dec[wk * 32 + mi * 16 + fq * 4];
#pragma unroll
          for (int ni = 0; ni < 4; ++ni) {
            f32x4 s4 = S[mi][ni];
#pragma unroll
            for (int j = 0; j < 4; ++j) s4[j] *= dc[j];
            s4 = __builtin_amdgcn_mfma_f32_16x16x32_bf16(kf, vf[ni], s4, 0, 0, 0);
            S[mi][ni] = s4;
            *(uint2*)&s_S[(wv * 64 + ni * 16 + fr) * 136 + wk * 32 + mi * 16 + fq * 4] = pack4(s4[0], s4[1], s4[2], s4[3]);
          }
        }
      }
      __syncthreads();
    }
    if (!sample) {
      float* so = p.out + OUT_HG + ((size_t)((b * 2 + d) * 8 + h)) * 16384;
#pragma unroll
      for (int mi = 0; mi < 2; ++mi)
#pragma unroll
        for (int ni = 0; ni < 4; ++ni)
#pragma unroll
          for (int j = 0; j < 4; ++j) __builtin_nontemporal_store(S[mi][ni][j], &so[(wk * 32 + mi * 16 + fq * 4 + j) * 128 + wv * 64 + ni * 16 + fr]);
    }
  }
#undef GLA_LOAD
}

__device__ __forceinline__ void phase_hg_post(const Params& p, int bid, int nb) {
  const u16* og = (const u16*)(p.ws + WS_B(5));
  const u16* sg = (const u16*)(p.ws + WS_B(2));
  u16* a = (u16*)(p.ws + WS_B(0));
  const float* ng = p.in[14];
  const int lane = threadIdx.x & 63, wave = threadIdx.x >> 6;
  float ngv[16];
#pragma unroll
  for (int k = 0; k < 4; ++k) { const f32x4 t = *(const f32x4*)&ng[lane * 16 + 4 * k]; ngv[4 * k] = t[0]; ngv[4 * k + 1] = t[1]; ngv[4 * k + 2] = t[2]; ngv[4 * k + 3] = t[3]; }
  for (int row0 = (bid * NW + wave) * 2; row0 < TOK; row0 += nb * NW * 2) {
    uint4 f[2][2], bw[2][2], sv[2][2];
#pragma unroll
    for (int r = 0; r < 2; ++r)
#pragma unroll
      for (int hh = 0; hh < 2; ++hh) {
        const size_t base = (size_t)(row0 + r) * 1024 + lane * 16 + hh * 8;
        f[r][hh] = ldnt4(&og[base]);
        bw[r][hh] = ldnt4(&og[(size_t)TOK * 1024 + base]);
        sv[r][hh] = ldnt4(&sg[base]);
      }
#pragma unroll
    for (int r = 0; r < 2; ++r) {
      float o[16];
      float ss = 0;
#pragma unroll
      for (int hh = 0; hh < 2; ++hh) {
        const unsigned fa[4] = {f[r][hh].x, f[r][hh].y, f[r][hh].z, f[r][hh].w}, ba[4] = {bw[r][hh].x, bw[r][hh].y, bw[r][hh].z, bw[r][hh].w};
#pragma unroll
        for (int i = 0; i < 4; ++i) {
          o[hh * 8 + 2 * i] = lo16(fa[i]) + lo16(ba[i]);
          o[hh * 8 + 2 * i + 1] = hi16(fa[i]) + hi16(ba[i]);
        }
      }
#pragma unroll
      for (int i = 0; i < 16; ++i) ss += o[i] * o[i];
      ss += __shfl_xor(ss, 1); ss += __shfl_xor(ss, 2); ss += __shfl_xor(ss, 4);
      const float rs = rsqrtf(ss * (1.0f / 128.0f) + 1e-6f);
#pragma unroll
      for (int hh = 0; hh < 2; ++hh) {
        const unsigned sa[4] = {sv[r][hh].x, sv[r][hh].y, sv[r][hh].z, sv[r][hh].w};
        unsigned rr[4];
#pragma unroll
        for (int i = 0; i < 4; ++i)
          rr[i] = pack2(o[hh * 8 + 2 * i] * rs * ngv[hh * 8 + 2 * i] * siluf_(lo16(sa[i])), o[hh * 8 + 2 * i + 1] * rs * ngv[hh * 8 + 2 * i + 1] * siluf_(hi16(sa[i])));
        *(uint4*)&a[(size_t)(row0 + r) * 1024 + lane * 16 + hh * 8] = make_uint4(rr[0], rr[1], rr[2], rr[3]);
      }
    }
  }
}

__device__ __forceinline__ void seq_pos(int tok, int& n, int& L) {
  if (tok < NPROMPT) { n = tok & 255; L = 256; } else { n = (tok - NPROMPT) & 1023; L = 1024; }
}
__device__ __forceinline__ void phase_sc_conv(const Params& p, int bid, int nb) {
  const u16* pb = (const u16*)(p.ws + WS_B(0));
  const u16* sb = (const u16*)(p.ws + WS_B(1));
  u16* a = (u16*)(p.ws + WS_B(2));
  const float* cw = p.in[17]; const float* cbias = p.in[18];
  const size_t total = (size_t)TOK * 128;
  const size_t i0 = (size_t)bid * NT + threadIdx.x;
  const int c = ((int)i0 & 127) * 8;
  float w0[8], w1[8], w2[8], wb[8];
#pragma unroll
  for (int k = 0; k < 2; ++k) {
    const f32x4 t0 = *(const f32x4*)&cw[c + 4 * k], t1 = *(const f32x4*)&cw[1024 + c + 4 * k], t2 = *(const f32x4*)&cw[2048 + c + 4 * k], tb = *(const f32x4*)&cbias[c + 4 * k];
#pragma unroll
    for (int j = 0; j < 4; ++j) { w0[4 * k + j] = t0[j]; w1[4 * k + j] = t1[j]; w2[4 * k + j] = t2[j]; wb[4 * k + j] = tb[j]; }
  }
  const uint4 z = make_uint4(0, 0, 0, 0);
  for (size_t i = i0; i < total / 4; i += (size_t)nb * NT) {
    const int tok = (int)(i >> 7) * 4;
    int n, L; seq_pos(tok, n, L);
    const size_t base = (size_t)tok * 1024 + c;
    uint4 q[6], sv[4];
    q[0] = n > 0 ? *(const uint4*)&pb[base - 1024] : z;
#pragma unroll
    for (int t = 0; t < 4; ++t) { q[1 + t] = *(const uint4*)&pb[base + t * 1024]; sv[t] = *(const uint4*)&sb[base + t * 1024]; }
    q[5] = n + 4 < L ? *(const uint4*)&pb[base + 4096] : z;
#pragma unroll
    for (int t = 0; t < 4; ++t) {
      const unsigned am[4] = {q[t].x, q[t].y, q[t].z, q[t].w}, a0[4] = {q[t + 1].x, q[t + 1].y, q[t + 1].z, q[t + 1].w};
      const unsigned ap[4] = {q[t + 2].x, q[t + 2].y, q[t + 2].z, q[t + 2].w}, as[4] = {sv[t].x, sv[t].y, sv[t].z, sv[t].w};
      unsigned r[4];
#pragma unroll
      for (int k = 0; k < 4; ++k) {
        float z0 = w0[2 * k] * lo16(am[k]) + w1[2 * k] * lo16(a0[k]) + w2[2 * k] * lo16(ap[k]) + wb[2 * k];
        float z1 = w0[2 * k + 1] * hi16(am[k]) + w1[2 * k + 1] * hi16(a0[k]) + w2[2 * k + 1] * hi16(ap[k]) + wb[2 * k + 1];
        r[k] = pack2(lo16(as[k]) * z0, hi16(as[k]) * z1);
      }
      *(uint4*)&a[base + t * 1024] = make_uint4(r[0], r[1], r[2], r[3]);
    }
  }
}
__device__ __forceinline__ void phase_rg_conv(const Params& p, int bid, int nb) {
  const u16* ub = (const u16*)(p.ws + WS_B(0));
  u16* uc = (u16*)(p.ws + WS_B(2));
  const float* cw = p.in[21]; const float* cbias = p.in[22];
  const size_t total = (size_t)TOK * 128;
  const size_t i0 = (size_t)bid * NT + threadIdx.x;
  const int c = ((int)i0 & 127) * 8;
  float w0[8], w1[8], w2[8], w3[8], wb[8];
#pragma unroll
  for (int k = 0; k < 2; ++k) {
    const f32x4 t0 = *(const f32x4*)&cw[c + 4 * k], t1 = *(const f32x4*)&cw[1024 + c + 4 * k], t2 = *(const f32x4*)&cw[2048 + c + 4 * k], t3 = *(const f32x4*)&cw[3072 + c + 4 * k], tb = *(const f32x4*)&cbias[c + 4 * k];
#pragma unroll
    for (int j = 0; j < 4; ++j) { w0[4 * k + j] = t0[j]; w1[4 * k + j] = t1[j]; w2[4 * k + j] = t2[j]; w3[4 * k + j] = t3[j]; wb[4 * k + j] = tb[j]; }
  }
  const uint4 z = make_uint4(0, 0, 0, 0);
  for (size_t i = i0; i < total / 4; i += (size_t)nb * NT) {
    const int tok = (int)(i >> 7) * 4;
    int n, L; seq_pos(tok, n, L);
    const size_t base = (size_t)tok * 1024 + c;
    uint4 q[7];
    q[0] = n > 1 ? *(const uint4*)&ub[base - 2048] : z;
    q[1] = n > 0 ? *(const uint4*)&ub[base - 1024] : z;
#pragma unroll
    for (int t = 0; t < 4; ++t) q[2 + t] = *(const uint4*)&ub[base + t * 1024];
    q[6] = n + 4 < L ? *(const uint4*)&ub[base + 4096] : z;
#pragma unroll
    for (int t = 0; t < 4; ++t) {
      const unsigned a0[4] = {q[t].x, q[t].y, q[t].z, q[t].w}, a1[4] = {q[t + 1].x, q[t + 1].y, q[t + 1].z, q[t + 1].w};
      const unsigned a2[4] = {q[t + 2].x, q[t + 2].y, q[t + 2].z, q[t + 2].w}, a3[4] = {q[t + 3].x, q[t + 3].y, q[t + 3].z, q[t + 3].w};
      unsigned r[4];
#pragma unroll
      for (int k = 0; k < 4; ++k) {
        float z0 = w0[2 * k] * lo16(a0[k]) + w1[2 * k] * lo16(a1[k]) + w2[2 * k] * lo16(a2[k]) + w3[2 * k] * lo16(a3[k]) + wb[2 * k];
        float z1 = w0[2 * k + 1] * hi16(a0[k]) + w1[2 * k + 1] * hi16(a1[k]) + w2[2 * k + 1] * hi16(a2[k]) + w3[2 * k + 1] * hi16(a3[k]) + wb[2 * k + 1];
        r[k] = pack2(z0, z1);
      }
      *(uint4*)&uc[((size_t)(c >> 6) * TOK + tok + t) * 64 + (c & 63)] = make_uint4(r[0], r[1], r[2], r[3]);
    }
  }
}

__device__ __forceinline__ void phase_rg_scan(const Params& p, unsigned char* smem_raw, int bid, int nb) {
  float* sA = (float*)smem_raw;
  float* sB = sA + 2048;
  const u16* rb = (const u16*)(p.ws + WS_B(3));
  const u16* ib = (const u16*)(p.ws + WS_B(5));
  const u16* uc = (const u16*)(p.ws + WS_B(2));
  const u16* sg = (const u16*)(p.ws + WS_B(1));
  u16* hfw = (u16*)(p.ws + WS_H);
  u16* yp = (u16*)(p.ws + WS_B(0));
  const int tid = threadIdx.x;
  for (int u = bid; u < 768; u += nb) {
    int sample, b, c, seg, nseg, start, chs, slot;
    if (u < 256) {
      const int xq = u & 7, yq = u >> 3, gid = (yq >> 2) * 8 + xq, sub = yq & 3;
      sample = 1; b = gid >> 4; slot = (tid & 3) * 4; c = (gid & 15) * 64 + sub * 16 + slot; seg = tid >> 2; nseg = 128; start = NPROMPT + b * 1024; chs = 16; }
    else { sample = 0; b = (u - 256) >> 4; slot = (tid & 15) * 4; c = ((u - 256) & 15) * 64 + slot; seg = tid >> 4; nseg = 32; start = b * 256; chs = 64; }
    const int L = nseg * 8;
#pragma unroll 1
    for (int d = 0; d < 2; ++d) {
      const f32x4 lam = *(const f32x4*)&p.in[25][d * 1024 + c];
      float cl[4];
#pragma unroll
      for (int j = 0; j < 4; ++j) cl[j] = 8.0f * 1.4426950408889634f * log1pf(__expf(-lam[j]))    ;
      const u16* rp = rb + (size_t)d * TOK * 1024;
      const u16* ip = ib + (size_t)d * TOK * 1024;
      const int tok0 = start + (d ? L - 1 - seg * 8 : seg * 8);
      const size_t o0 = (size_t)tok0 * 1024 + c;
      const long ostep = d ? -1024 : 1024;
      const size_t g0 = ((size_t)(c >> 6) * TOK + tok0) * 64 + (c & 63);
      const long gstep = d ? -64 : 64;
      uint2 rr[8], ii[8], uu[8];
#pragma unroll
      for (int s8 = 0; s8 < 8; ++s8) { rr[s8] = ldnt2(&rp[g0 + s8 * gstep]); ii[s8] = ldnt2(&ip[g0 + s8 * gstep]); uu[s8] = *(const uint2*)&uc[g0 + s8 * gstep]; }
      uint2 hf[8], sgv[8];
      if (d == 1) {
#pragma unroll
        for (int s8 = 0; s8 < 8; ++s8) { hf[s8] = *(const uint2*)&hfw[g0 + s8 * gstep]; sgv[s8] = *(const uint2*)&sg[g0 + s8 * gstep]; }
      }
      float av[8][4], xv[8][4];
      float A[4] = {1.f, 1.f, 1.f, 1.f}, B[4] = {0.f, 0.f, 0.f, 0.f};
#pragma unroll
      for (int s8 = 0; s8 < 8; ++s8) {
        const float r4[4] = {lo16(rr[s8].x), hi16(rr[s8].x), lo16(rr[s8].y), hi16(rr[s8].y)};
        const float i4[4] = {lo16(ii[s8].x), hi16(ii[s8].x), lo16(ii[s8].y), hi16(ii[s8].y)};
        const float u4[4] = {lo16(uu[s8].x), hi16(uu[s8].x), lo16(uu[s8].y), hi16(uu[s8].y)};
#pragma unroll
        for (int j = 0; j < 4; ++j) {
          const float la = -cl[j] * r4[j];
          const float a = __builtin_amdgcn_exp2f(la);
          const float xin = __builtin_amdgcn_sqrtf(fmaxf(1.0f - __builtin_amdgcn_exp2f(2.0f * la), 0.f)) * (i4[j] * u4[j]);
          av[s8][j] = a; xv[s8][j] = xin;
          A[j] *= a; B[j] = a * B[j] + xin;
        }
      }
      const int lane = tid & 63, wv_ = tid >> 6;
      const int shstep = chs >> 2;
      const int nsw = 64 / shstep;
      const int segl = lane / shstep, qd = lane & (shstep - 1);
      for (int k = 1; k < nsw; k <<= 1) {
        float pa[4], pb2[4];
#pragma unroll
        for (int j = 0; j < 4; ++j) { pa[j] = __shfl_up(A[j], k * shstep); pb2[j] = __shfl_up(B[j], k * shstep); }
        if (segl >= k) {
#pragma unroll
          for (int j = 0; j < 4; ++j) { B[j] = A[j] * pb2[j] + B[j]; A[j] = A[j] * pa[j]; }
        }
      }
      float EA[4], EB[4];
#pragma unroll
      for (int j = 0; j < 4; ++j) { EA[j] = __shfl_up(A[j], shstep); EB[j] = __shfl_up(B[j], shstep); }
      if (segl == nsw - 1) {
        *(f32x4*)&sA[(wv_ * 16 + qd) * 4] = f32x4{A[0], A[1], A[2], A[3]};
        *(f32x4*)&sB[(wv_ * 16 + qd) * 4] = f32x4{B[0], B[1], B[2], B[3]};
      }
      __syncthreads();
      float h[4];
      {
        f32x4 h0v = f32x4{0.f, 0.f, 0.f, 0.f};
        if (sample) h0v = *(const f32x4*)&p.in[3][(b * 2 + d) * 1024 + c];
#pragma unroll
        for (int j = 0; j < 4; ++j) h[j] = h0v[j];
        for (int w2 = 0; w2 < wv_; ++w2) {
          const f32x4 ta = *(const f32x4*)&sA[(w2 * 16 + qd) * 4], tb = *(const f32x4*)&sB[(w2 * 16 + qd) * 4];
#pragma unroll
          for (int j = 0; j < 4; ++j) h[j] = ta[j] * h[j] + tb[j];
        }
        if (segl > 0) {
#pragma unroll
          for (int j = 0; j < 4; ++j) h[j] = EA[j] * h[j] + EB[j];
        }
      }
#pragma unroll
      for (int s8 = 0; s8 < 8; ++s8) {
#pragma unroll
        for (int j = 0; j < 4; ++j) h[j] = av[s8][j] * h[j] + xv[s8][j];
        const size_t o = o0 + s8 * ostep;
        if (d == 0) *(uint2*)&hfw[g0 + s8 * gstep] = pack4(h[0], h[1], h[2], h[3]);
        else *(uint2*)&yp[g0 + s8 * gstep] = pack4((lo16(hf[s8].x) + h[0]) * lo16(sgv[s8].x), (hi16(hf[s8].x) + h[1]) * hi16(sgv[s8].x),
                                     (lo16(hf[s8].y) + h[2]) * lo16(sgv[s8].y), (hi16(hf[s8].y) + h[3]) * hi16(sgv[s8].y));
      }
      if (!sample && seg == nseg - 1) *(f32x4*)&p.out[OUT_RG + (b * 2 + d) * 1024 + c] = f32x4{h[0], h[1], h[2], h[3]};
      __syncthreads();
    }
  }
}

__device__ __forceinline__ void phase_mla_norm(const Params& p, int bid, int nb) {
  u16* cq = (u16*)(p.ws + WS3_CQ);
  u16* ckvall = (u16*)(p.ws + WS3_CKVALL);
  const float* ckvraw = (const float*)(p.ws + WS3_CKVRAW);
  const float* kperaw = (const float*)(p.ws + WS3_KPERAW);
  u16* Kb = (u16*)(p.ws + WS3_K);
  const float* qn = p.in[28]; const float* kvn = p.in[29];
  const int lane = threadIdx.x & 63, wave = threadIdx.x >> 6;
  float qnv[6];
#pragma unroll
  for (int i = 0; i < 3; ++i) { qnv[2 * i] = qn[(i * 64 + lane) * 2]; qnv[2 * i + 1] = qn[(i * 64 + lane) * 2 + 1]; }
  const f32x4 g4 = *(const f32x4*)&kvn[lane * 4];
  unsigned cvn[3] = {0u, 0u, 0u}; f32x4 kvnx = f32x4{0.f, 0.f, 0.f, 0.f}; float vnx = 0.f;
  {
    const int r0 = bid * NW + wave;
    if (r0 < TOK) {
#pragma unroll
      for (int i = 0; i < 3; ++i) cvn[i] = ((const unsigned*)&cq[(size_t)r0 * 384])[i * 64 + lane];
      kvnx = *(const f32x4*)&ckvraw[(size_t)r0 * 256 + lane * 4]; vnx = kperaw[(size_t)r0 * 32 + (lane & 31)];
    }
  }
  for (int row = bid * NW + wave; row < TOK + 2048; row += nb * NW) {
    if (row < TOK) {
      const int tok = row;
      const bool sample = tok >= NPROMPT;
      unsigned cv[3] = {cvn[0], cvn[1], cvn[2]}; const f32x4 kv = kvnx; float v = vnx;
      {
        const int rn = row + nb * NW;
        if (rn < TOK) {
#pragma unroll
          for (int i = 0; i < 3; ++i) cvn[i] = ((const unsigned*)&cq[(size_t)rn * 384])[i * 64 + lane];
          kvnx = *(const f32x4*)&ckvraw[(size_t)rn * 256 + lane * 4]; vnx = kperaw[(size_t)rn * 32 + (lane & 31)];
        }
      }
      const int bs = (tok - NPROMPT) >> 10, n = (tok - NPROMPT) & 1023;
      const size_t kvrow = sample ? (size_t)(NPROMPT + bs * 1536 + 512 + n) : (size_t)tok;
      unsigned* cqr = (unsigned*)&cq[(size_t)tok * 384];
      float ss = 0;
#pragma unroll
      for (int i = 0; i < 3; ++i) { float a = lo16(cv[i]), b2 = hi16(cv[i]); ss += a * a + b2 * b2; }
      const float rsq = rsqrtf(wave_sum(ss) * (1.0f / 384.0f) + 1e-6f);
#pragma unroll
      for (int i = 0; i < 3; ++i) {
        cqr[i * 64 + lane] = pack2(lo16(cv[i]) * rsq * qnv[2 * i], hi16(cv[i]) * rsq * qnv[2 * i + 1]);
      }
      const float rsk = rsqrtf(wave_sum(kv[0] * kv[0] + kv[1] * kv[1] + kv[2] * kv[2] + kv[3] * kv[3]) * (1.0f / 256.0f) + 1e-6f);
      f32x4 o4;
#pragma unroll
      for (int j = 0; j < 4; ++j) o4[j] = kv[j] * rsk * g4[j];
      *(uint2*)&ckvall[kvrow * 256 + lane * 4] = pack4(o4[0], o4[1], o4[2], o4[3]);
      if (!sample) *(f32x4*)&p.out[OUT_CKV + (size_t)tok * 256 + lane * 4] = o4;
      if (!sample) { if (lane < 32) p.out[OUT_KPE + (size_t)tok * 32 + lane] = v; }
      else {
        const float partner = __shfl_xor(v, 8);
        const int i16 = lane & 15;
        const float pos = (lane & 16) ? (float)(n & 63) : (float)(n >> 6);
        float sn, cs; rope_sincos(pos, i16 & 7, sn, cs);
        v = (i16 < 8) ? (v * cs - partner * sn) : (partner * sn + v * cs);
      }
      const u16 vb = f2bf(v);
#pragma unroll
      for (int i = 0; i < 8; ++i) Kb[(kvrow * 16 + (lane >> 5) + 2 * i) * 96 + 64 + (lane & 31)] = vb;
    } else {
      const int r = row - TOK, bs = r >> 9, j = r & 511;
      const size_t kvrow = (size_t)(NPROMPT + bs * 1536 + j);
      f32x4 kv = *(const f32x4*)&p.in[4][(size_t)r * 256 + lane * 4];
      *(uint2*)&ckvall[kvrow * 256 + lane * 4] = pack4(kv[0], kv[1], kv[2], kv[3]);
      const u16 vb = f2bf(p.in[5][(size_t)r * 32 + (lane & 31)]);
#pragma unroll
      for (int i = 0; i < 8; ++i) Kb[(kvrow * 16 + (lane >> 5) + 2 * i) * 96 + 64 + (lane & 31)] = vb;
    }
  }
}

__device__ __forceinline__ void phase_attn(const Params& p, unsigned char* smem_raw, int bid, int nb) {
  u16* sK = (u16*)smem_raw;
  u16* sV = sK + 128 * 104;
  const u16* qg = (const u16*)(p.ws + WS3_Q);
  const u16* Kg = (const u16*)(p.ws + WS3_K);
  const u16* Vg = (const u16*)(p.ws + WS3_VT);
  const u16* sg = (const u16*)(p.ws + WS3_SG);
  u16* ao = (u16*)(p.ws + WS_H);
  const int tid = threadIdx.x, lane = tid & 63, w = tid >> 6, fr = lane & 15, fq = lane >> 4;
  for (int u = bid; u < 1536; u += nb) {
    int tok0, kvbase, nkeys, h;
    if (u < 512) { const int b = u >> 7, r = u & 127; h = r >> 3; const int qb = r & 7; tok0 = NPROMPT + b * 1024 + qb * 128; kvbase = NPROMPT + b * 1536; nkeys = 1536; }
    else { const int uu = u - 512; const int b = uu >> 5, r = uu & 31; h = r >> 1; const int qb = r & 1; tok0 = b * 256 + qb * 128; kvbase = b * 256; nkeys = 256; }
    const int tokq = tok0 + w * 16 + fr;
    bf16x8 qf[3];
#pragma unroll
    for (int ks = 0; ks < 3; ++ks) qf[ks] = *(const bf16x8*)&qg[(size_t)tokq * 1536 + h * 96 + ks * 32 + fq * 8];
    if (u < 512) {
      const int npos = (tokq - NPROMPT) & 1023;
      const float pos = (fq & 2) ? (float)(npos & 63) : (float)(npos >> 6);
      uint4 raw = *(uint4*)&qf[2];
      unsigned rw[4] = {raw.x, raw.y, raw.z, raw.w};
#pragma unroll
      for (int i = 0; i < 4; ++i) {
        float v0 = lo16(rw[i]), v1 = hi16(rw[i]);
        const float p0 = __shfl_xor(v0, 16), p1 = __shfl_xor(v1, 16);
        float sn0, cs0, sn1, cs1;
        rope_sincos(pos, 2 * i, sn0, cs0); rope_sincos(pos, 2 * i + 1, sn1, cs1);
        v0 = (fq & 1) ? (p0 * sn0 + v0 * cs0) : (v0 * cs0 - p0 * sn0);
        v1 = (fq & 1) ? (p1 * sn1 + v1 * cs1) : (v1 * cs1 - p1 * sn1);
        rw[i] = pack2(v0, v1);
      }
      raw = make_uint4(rw[0], rw[1], rw[2], rw[3]);
      qf[2] = *(bf16x8*)&raw;
    }
    float m = -1e30f, l = 0.f;
    f32x4 oacc[4];
#pragma unroll
    for (int i = 0; i < 4; ++i) oacc[i] = f32x4{0.f, 0.f, 0.f, 0.f};
    const int kk0 = tid / 12, kc0 = tid - kk0 * 12;
    const int kk1 = (tid + NT) / 12, kc1 = (tid + NT) - kk1 * 12;
    const int kk2_ = (tid + 2 * NT) / 12, kc2 = (tid + 2 * NT) - kk2_ * 12;
    const u16* Kp0 = &Kg[((size_t)(kvbase + kk0) * 16 + h) * 96 + kc0 * 8];
    const u16* Kp1 = &Kg[((size_t)(kvbase + kk1) * 16 + h) * 96 + kc1 * 8];
    const u16* Kp2 = &Kg[((size_t)(kvbase + kk2_) * 16 + h) * 96 + kc2 * 8];
    const int vd0 = tid >> 4, vc0 = tid & 15, vd1 = (tid + NT) >> 4;
    const u16* Vp0 = &Vg[(size_t)(h * 64 + vd0) * KVROWS + kvbase + vc0 * 8];
    const u16* Vp1 = &Vg[(size_t)(h * 64 + vd1) * KVROWS + kvbase + vc0 * 8];
    uint4 kr0 = *(const uint4*)Kp0, kr1 = *(const uint4*)Kp1, kr2 = *(const uint4*)Kp2, vr0 = *(const uint4*)Vp0, vr1 = *(const uint4*)Vp1;
    const int ntile2 = nkeys >> 7;
    for (int kt = 0; kt < ntile2; ++kt) {
      __syncthreads();
      *(uint4*)&sK[kk0 * 104 + kc0 * 8] = kr0; *(uint4*)&sK[kk1 * 104 + kc1 * 8] = kr1; *(uint4*)&sK[kk2_ * 104 + kc2 * 8] = kr2;
      *(uint4*)&sV[vd0 * 136 + vc0 * 8] = vr0; *(uint4*)&sV[vd1 * 136 + vc0 * 8] = vr1;
      if (kt + 1 < ntile2) {
        const size_t ko = (size_t)(kt + 1) * 128 * 1536; const int vo = (kt + 1) * 128;
        kr0 = *(const uint4*)(Kp0 + ko); kr1 = *(const uint4*)(Kp1 + ko); kr2 = *(const uint4*)(Kp2 + ko);
        vr0 = *(const uint4*)(Vp0 + vo); vr1 = *(const uint4*)(Vp1 + vo);
      }
      __syncthreads();
      f32x4 sacc[8];
#pragma unroll
      for (int ni = 0; ni < 8; ++ni) {
        sacc[ni] = f32x4{0.f, 0.f, 0.f, 0.f};
#pragma unroll
        for (int ks = 0; ks < 3; ++ks) {
          bf16x8 kf = *(const bf16x8*)&sK[(ni * 16 + fr) * 104 + ks * 32 + fq * 8];
          sacc[ni] = __builtin_amdgcn_mfma_f32_16x16x32_bf16(kf, qf[ks], sacc[ni], 0, 0, 0);
        }
      }
      float mx = -1e30f;
#pragma unroll
      for (int ni = 0; ni < 8; ++ni)
#pragma unroll
        for (int j = 0; j < 4; ++j) mx = fmaxf(mx, sacc[ni][j]);
      mx = fmaxf(mx, __shfl_xor(mx, 16));
      mx = fmaxf(mx, __shfl_xor(mx, 32));
      const float mnew = fmaxf(m, mx);
      const float alpha = __builtin_amdgcn_exp2f(m - mnew);
      m = mnew;
      float ls = 0.f;
#pragma unroll
      for (int ni = 0; ni < 8; ++ni)
#pragma unroll
        for (int j = 0; j < 4; ++j) { float e = __builtin_amdgcn_exp2f(sacc[ni][j] - mnew); sacc[ni][j] = e; ls += e; }
      l = l * alpha + ls;
      bf16x8 pf[4];
#pragma unroll
      for (int kk2 = 0; kk2 < 4; ++kk2) {
        uint2 lo = pack4(sacc[2 * kk2][0], sacc[2 * kk2][1], sacc[2 * kk2][2], sacc[2 * kk2][3]);
        uint2 hi = pack4(sacc[2 * kk2 + 1][0], sacc[2 * kk2 + 1][1], sacc[2 * kk2 + 1][2], sacc[2 * kk2 + 1][3]);
        uint4 pk = make_uint4(lo.x, lo.y, hi.x, hi.y);
        pf[kk2] = *(bf16x8*)&pk;
      }
#pragma unroll
      for (int di = 0; di < 4; ++di) {
#pragma unroll
        for (int j = 0; j < 4; ++j) oacc[di][j] *= alpha;
#pragma unroll
        for (int kk2 = 0; kk2 < 4; ++kk2) {
          uint2 v0 = *(const uint2*)&sV[(di * 16 + fr) * 136 + kk2 * 32 + fq * 4];
          uint2 v1 = *(const uint2*)&sV[(di * 16 + fr) * 136 + kk2 * 32 + 16 + fq * 4];
          uint4 vk = make_uint4(v0.x, v0.y, v1.x, v1.y);
          oacc[di] = __builtin_amdgcn_mfma_f32_16x16x32_bf16(*(bf16x8*)&vk, pf[kk2], oacc[di], 0, 0, 0);
        }
      }
    }
    l += __shfl_xor(l, 16);
    l += __shfl_xor(l, 32);
    const float inv = 1.0f / l;
#pragma unroll
    for (int di = 0; di < 4; ++di) {
      const size_t o = (size_t)tokq * 1024 + h * 64 + di * 16 + fq * 4;
      uint2 s = *(const uint2*)&sg[o];
      *(uint2*)&ao[o] = pack4(oacc[di][0] * inv * siluf_(lo16(s.x)), oacc[di][1] * inv * siluf_(hi16(s.x)), oacc[di][2] * inv * siluf_(lo16(s.y)), oacc[di][3] * inv * siluf_(hi16(s.y)));
    }
  }
}

#define XB_TMO      128
#define XB_XCNT(j)  (256  + 64 * (j))
#define XB_XSUB(j)  (1280 + 64 * (j))
#define XB_XGEN(j)  (2304 + 64 * (j))
#define XB_TOP      3328
#define XB_TOPGEN   3392
#define XCD_BAR_WORDS 3456
#define XB_SPIN_CAP (1u << 22)
__device__ __forceinline__ unsigned xb_ld(unsigned* p)              { return __hip_atomic_load(p, __ATOMIC_RELAXED, __HIP_MEMORY_SCOPE_AGENT); }
__device__ __forceinline__ unsigned xb_add(unsigned* p, unsigned v) { return __hip_atomic_fetch_add(p, v, __ATOMIC_RELAXED, __HIP_MEMORY_SCOPE_AGENT); }
__device__ __forceinline__ unsigned xb_xcc_id() { return (unsigned)__builtin_amdgcn_s_getreg((3 << 11) | 20) & 0xFu; }
#define XB_SPIN(cond, bar) do { unsigned _sp = 0; while (cond) { __builtin_amdgcn_s_sleep(1); \
    if ((++_sp & 255u) == 0u) { if (xb_ld(&(bar)[XB_TMO])) break; if (_sp > XB_SPIN_CAP) { atomicAdd(&(bar)[XB_TMO], 1u); break; } } } } while (0)
struct XcdBarrier { unsigned* bar; unsigned x; volatile LAS unsigned* st; };
__device__ __forceinline__ XcdBarrier xcd_barrier_post(unsigned* bar, volatile LAS unsigned* st) {
  XcdBarrier b; b.bar = bar; b.x = xb_xcc_id(); b.st = st;
  if (threadIdx.x == 0) (void)xb_add(&bar[XB_XCNT(b.x)], 1u);
  return b;
}
__device__ __forceinline__ void xcd_barrier_complete(unsigned* bar, unsigned x, unsigned& nloc, unsigned& nx) {
  const unsigned G = gridDim.x * gridDim.y * gridDim.z;
  unsigned sum, cnt, mine, sp = 0u;
  for (;;) {
    sum = 0u; cnt = 0u; mine = 0u;
#pragma unroll
    for (unsigned j = 0; j < 16; ++j) { const unsigned c = xb_ld(&bar[XB_XCNT(j)]); sum += c; cnt += (c > 0u) ? 1u : 0u; mine = (j == x) ? c : mine; }
    if (sum == G) break;
    __builtin_amdgcn_s_sleep(1);
    if ((++sp & 255u) == 0u) { if (xb_ld(&bar[XB_TMO])) break; if (sp > XB_SPIN_CAP) { atomicAdd(&bar[XB_TMO], 1u); break; } }
  }
  nloc = mine > 0u ? mine : 1u; nx = cnt > 0u ? cnt : 1u;
}
__device__ __forceinline__ void xcd_barrier(const XcdBarrier& b) {
  asm volatile("s_waitcnt vmcnt(0)" ::: "memory");
  __syncthreads();
  if (threadIdx.x == 0) {
    unsigned* bar = b.bar;
    __builtin_amdgcn_s_waitcnt(0);
    unsigned nloc = b.st[0], nx = b.st[1];
    if (nloc == 0u) { xcd_barrier_complete(bar, b.x, nloc, nx); b.st[0] = nloc; b.st[1] = nx; }
    const unsigned old = xb_add(&bar[XB_XSUB(b.x)], 1u);
    const unsigned gen = old / nloc;
    if (old + 1u == (gen + 1u) * nloc) {
      __builtin_amdgcn_fence(__ATOMIC_RELEASE, "agent");
      asm volatile("s_waitcnt vmcnt(0)" ::: "memory");
      const unsigned og = xb_add(&bar[XB_TOP], 1u);
      const unsigned tg = og / nx;
      if (og + 1u == (tg + 1u) * nx) xb_add(&bar[XB_TOPGEN], 1u);
      else XB_SPIN(xb_ld(&bar[XB_TOPGEN]) == tg, bar);
      __builtin_amdgcn_fence(__ATOMIC_ACQUIRE, "agent");
      xb_add(&bar[XB_XGEN(b.x)], 1u);
      asm volatile("s_waitcnt vmcnt(0)" ::: "memory");
    } else {
      XB_SPIN(xb_ld(&bar[XB_XGEN(b.x)]) == gen, bar);
      __builtin_amdgcn_fence(__ATOMIC_ACQUIRE, "agent");
      asm volatile("s_waitcnt vmcnt(0)" ::: "memory");
    }
  }
  __syncthreads();
}

#define GEMM_LDS 131072
#define DYN_LDS (GEMM_LDS + 16)
#define WS_BAR (WS_CNT + 4096ull)

#define RUN_GEMM(Aptr, LDA, Bptr, MM, NN, KK, GATE, EPI, CID) RUN_GEMM_G(Aptr, LDA, Bptr, MM, NN, KK, GATE, EPI, nb, CID)
#define RUN_GEMM_G(Aptr, LDA, Bptr, MM, NN, KK, GATE, EPI, GG, CID) RUN_GEMM_X(Aptr, LDA, (size_t)128, (size_t)0, Bptr, MM, NN, KK, GATE, EPI, GG, CID)
#define GM_KSTEP ((size_t)TOK * 128)
#define RUN_GEMM_X(Aptr, LDA, KSA, GST, Bptr, MM, NN, KK, GATE, EPI, GG, CID) do { pg8::Gemm g_{(const u16*)(Aptr), (const u16*)(Bptr), MM, NN, KK, LDA, GATE, p.flags, KSA, GST}; \
    pg8::StaticOrder S_; S_.init(MM, NN, GG, CID); pg8::gemm_phase((LAS unsigned char*)smem_raw, g_, S_, EPI); } while (0)
#define RUN_GEMM_RX(Aptr, LDA, KSA, GST, Bptr, MM, NN, KK, GATE, EPI, GG, CID, UBEG, UEND) do { pg8::Gemm g_{(const u16*)(Aptr), (const u16*)(Bptr), MM, NN, KK, LDA, GATE, p.flags, KSA, GST}; \
    pg8::StaticOrder S_; S_.init(MM, NN, GG, CID); S_.ubeg = UBEG; S_.uend = UEND; pg8::gemm_phase((LAS unsigned char*)smem_raw, g_, S_, EPI); } while (0)
#define RUN_GEMM_R(Aptr, LDA, Bptr, MM, NN, KK, EPI, GG, CID, UBEG, UEND) do { pg8::Gemm g_{(const u16*)(Aptr), (const u16*)(Bptr), MM, NN, KK, LDA, 0, p.flags, (size_t)128, (size_t)0}; \
    pg8::StaticOrder S_; S_.init(MM, NN, GG, CID); S_.ubeg = UBEG; S_.uend = UEND; pg8::gemm_phase((LAS unsigned char*)smem_raw, g_, S_, EPI); } while (0)

__global__ void __launch_bounds__(NT, 2) mega(Params p) {
  extern __shared__ __attribute__((aligned(16))) unsigned char smem_raw[];
  const int bid = blockIdx.x, nb = gridDim.x;
  unsigned char* ws = p.ws;
  const float* mod = (const float*)(ws + WS_MOD);
  volatile LAS unsigned* xst = (volatile LAS unsigned*)((LAS unsigned char*)smem_raw + GEMM_LDS);
  XcdBarrier xb;
  if (p.phase_hi - p.phase_lo > 1) {
    if (threadIdx.x == 0) { xst[0] = 0u; xst[1] = 0u; }
    __syncthreads();
    xb = xcd_barrier_post((unsigned*)(ws + WS_BAR), xst);
  }
#define PH_BEGIN(n) if ((PHMASK & (1u << n)) && p.phase_lo <= n && n < p.phase_hi) { const int ph = n;
#define PH_FIN if (ph + 1 < p.phase_hi) { if (p.phase_lo < 0) cg::this_grid().sync(); else xcd_barrier(xb); } }
  PH_BEGIN(0) phase_prologue(p, smem_raw, bid, nb); PH_FIN
  PH_BEGIN(1) phase_h0(p, bid, nb); PH_FIN
  PH_BEGIN(2) {
    EpiHgIn e{(u16*)(ws + WS_B(0)), (u16*)(ws + WS_B(1)), (u16*)(ws + WS_B(2)), (_Float16*)(ws + WS_B(3)), (const float*)(ws + WS_LB)};
    RUN_GEMM(ws + WS_H, 1024, ws + WS_W_HG_IN, TOK, (nb == 256 ? 4096 : 5120), 1024, 0, e, bid);
  } PH_FIN
  PH_BEGIN(3) {
    phase_gla(p, smem_raw);
    if (nb == 256) {
      __syncthreads();
      EpiSg eg{(u16*)(ws + WS_B(2))};
      RUN_GEMM_R(ws + WS_H, 1024, ws + WS_W_HG_IN + (size_t)4096 * 1024 * 2, TOK, 1024, 1024, eg, 256, bid >= 64 ? bid - 64 : (1 << 20), 0, 192);
    }
  } PH_FIN
  PH_BEGIN(4) phase_hg_post(p, bid, nb); PH_FIN
  PH_BEGIN(5) {
    EpiResLn<false, true> e{p.in[0], p.in[1], (const u16*)nullptr, p.out, (u16*)(ws + WS_XB), mod + 0 * 15360 + 2048, p.in[10] + 0 * 1024, p.in[11] + 0 * 1024, mod + 1 * 15360, (u16*)(ws + WS_H),
               (unsigned long long*)(ws + WS_SLOT) + 0 * 49152, (unsigned*)(ws + WS_CNT + 256) + 0 * 48};
    RUN_GEMM(ws + WS_B(0), 1024, ws + WS_W_HG_OUT, TOK, 1024, 1024, 0, e, bid);
    wconv_idle(p, smem_raw, bid, nb, 1536, 2816);
  } PH_FIN
  PH_BEGIN(7) {
    EpiScIn e{(u16*)(ws + WS_B(0)), (u16*)(ws + WS_B(1))};
    RUN_GEMM(ws + WS_H, 1024, ws + WS_W_SC_IN, TOK, 4096, 1024, 0, e, bid);
  } PH_FIN
  PH_BEGIN(8) phase_sc_conv(p, bid, nb); PH_FIN
  PH_BEGIN(9) {
    EpiResLn<true, true> e{p.out, p.out, (const u16*)(ws + WS_XB), p.out, (u16*)(ws + WS_XB), mod + 1 * 15360 + 2048, p.in[10] + 1 * 1024, p.in[11] + 1 * 1024, mod + 2 * 15360, (u16*)(ws + WS_H),
               (unsigned long long*)(ws + WS_SLOT) + 1 * 49152, (unsigned*)(ws + WS_CNT + 256) + 1 * 48};
    RUN_GEMM(ws + WS_B(2), 1024, ws + WS_W_SC_OUT, TOK, 1024, 1024, 0, e, bid);
    wconv_idle(p, smem_raw, bid, nb, 2816, 3840);
  } PH_FIN
  PH_BEGIN(11) {
    EpiRgIn e{(u16*)(ws + WS_B(0)), (u16*)(ws + WS_B(1))};
    if (nb == 256) {
      RUN_GEMM(ws + WS_H, 1024, ws + WS_W_RG_IN, TOK, 1024, 1024, 0, e, bid);
      EpiSgGM eg{(u16*)(ws + WS_B(1))};
      RUN_GEMM_R(ws + WS_H, 1024, ws + WS_W_RG_IN + (size_t)1024 * 1024 * 2, TOK, 1024, 1024, eg, 256, bid >= 192 ? bid - 192 : (1 << 20), 0, 64);
    } else {
      RUN_GEMM(ws + WS_H, 1024, ws + WS_W_RG_IN, TOK, 2048, 1024, 0, e, bid);
    }
  } PH_FIN
  PH_BEGIN(12) phase_rg_conv(p, bid, nb); PH_FIN
  PH_BEGIN(13) {
    EpiRgGate e{(u16*)(ws + WS_B(3)), (u16*)(ws + WS_B(5)), p.in[24]};
    if (nb == 256) {
      EpiSgGM eg{(u16*)(ws + WS_B(1))};
      RUN_GEMM_R(ws + WS_H, 1024, ws + WS_W_RG_IN + (size_t)1024 * 1024 * 2, TOK, 1024, 1024, eg, 256, bid < 128 ? bid : (1 << 20), 64, 192);
      RUN_GEMM_RX(ws + WS_B(2), 64, GM_KSTEP, 4 * GM_KSTEP, ws + WS_W_RG_GATE, TOK, 4096, 256, 1, e, 256, bid < 128 ? bid : (1 << 20), 0, 128);
      RUN_GEMM_RX(ws + WS_B(2), 64, GM_KSTEP, 4 * GM_KSTEP, ws + WS_W_RG_GATE, TOK, 4096, 256, 1, e, 128, bid >= 128 ? bid - 128 : (1 << 20), 128, 768);
    } else {
      RUN_GEMM_X(ws + WS_B(2), 64, GM_KSTEP, 4 * GM_KSTEP, ws + WS_W_RG_GATE, TOK, 4096, 256, 1, e, nb, bid);
    }
  } PH_FIN
  PH_BEGIN(14) phase_rg_scan(p, smem_raw, bid, nb); PH_FIN
  PH_BEGIN(15) {
    EpiResLn<true, true> e{p.out, p.out, (const u16*)(ws + WS_XB), p.out, (u16*)(ws + WS_XB), mod + 2 * 15360 + 2048, p.in[10] + 2 * 1024, p.in[11] + 2 * 1024, mod + 3 * 15360, (u16*)(ws + WS_H),
               (unsigned long long*)(ws + WS_SLOT) + 2 * 49152, (unsigned*)(ws + WS_CNT + 256) + 2 * 48};
    RUN_GEMM_X(ws + WS_B(0), 64, GM_KSTEP, (size_t)0, ws + WS_W_RG_OUT, TOK, 1024, 1024, 0, e, nb, bid);
    wconv_idle(p, smem_raw, bid, nb, 3840, 4800);
  } PH_FIN
  PH_BEGIN(17) {
    EpiMlaIn e{(u16*)(ws + WS3_CQ), (float*)(ws + WS3_CKVRAW), (float*)(ws + WS3_KPERAW), (u16*)(ws + WS3_SG)};
    RUN_GEMM(ws + WS_H, 1024, ws + WS_W_MLA_IN, TOK, 768, 1024, 0, e, bid);
    if (nb == 256) {
      EpiSg eg{(u16*)(ws + WS3_SG)};
      RUN_GEMM_R(ws + WS_H, 1024, ws + WS_W_MLA_IN + 672 * 1024 * 2, TOK, 1024, 1024, eg, 256, bid >= 144 ? bid - 144 : (1 << 20), 0, 112);
    }
  } PH_FIN
  PH_BEGIN(18) phase_mla_norm(p, bid, nb); PH_FIN
  PH_BEGIN(19) {
    const bool bal = (nb == 256);
    const int none = 1 << 20;
    EpiSg eg{(u16*)(ws + WS3_SG)};
    RUN_GEMM_R(ws + WS_H, 1024, ws + WS_W_MLA_IN + 672 * 1024 * 2, TOK, 1024, 1024, eg, nb, bid, bal ? 112 : 0, 192);
    EpiQ eq{(u16*)(ws + WS3_Q)};
    RUN_GEMM_G(ws + WS3_CQ, 384, ws + WS_W_QB, TOK, 1536, 384, 0, eq, bal ? 176 : nb, bal ? (bid >= 80 ? bid - 80 : none) : bid);
    EpiK ek{(u16*)(ws + WS3_K)};
    RUN_GEMM(ws + WS3_CKVALL, 256, ws + WS_W_KVB, KVROWS, 1024, 256, 0, ek, bid);
    EpiV ev{(u16*)(ws + WS3_VT)};
    RUN_GEMM_G(ws + WS_W_KVB + 1024 * 256 * 2, 256, ws + WS3_CKVALL, 1024, KVROWS, 256, 0, ev, bal ? 176 : nb, bal ? (bid >= 80 ? (bid + 160) % 176 : none) : bid);
  } PH_FIN
  PH_BEGIN(20) phase_attn(p, smem_raw, bid, nb); PH_FIN
  PH_BEGIN(21) {
    EpiResLn<true, false> e{p.out, p.out, (const u16*)(ws + WS_XB), p.out, (u16*)nullptr, mod + 3 * 15360 + 2048, p.in[10] + 3 * 1024, p.in[11] + 3 * 1024, mod + 3 * 15360, (u16*)nullptr,
               (unsigned long long*)(ws + WS_SLOT) + 3 * 49152, (unsigned*)(ws + WS_CNT + 256) + 3 * 48};
    RUN_GEMM(ws + WS_H, 1024, ws + WS_W_MLA_OUT, TOK, 1024, 1024, 0, e, bid);
  } PH_FIN
}

extern "C" void kernel_launch(void* const* d_in, const int* in_sizes, int n_in, void* d_out, int out_size, void* d_ws, size_t ws_size,
                              hipStream_t stream) {
  static int grid_blocks = 0;
  if (!grid_blocks) {
    int dev = 0, cus = 0, per_cu = 0;
    (void)hipGetDevice(&dev);
    (void)hipDeviceGetAttribute(&cus, hipDeviceAttributeMultiprocessorCount, dev);
    (void)hipFuncSetAttribute((const void*)mega, hipFuncAttributeMaxDynamicSharedMemorySize, DYN_LDS);
    (void)hipOccupancyMaxActiveBlocksPerMultiprocessor(&per_cu, (const void*)mega, NT, DYN_LDS);
    if (per_cu < 1) per_cu = 1;
    if (per_cu > 1) per_cu = 1;
    grid_blocks = cus * per_cu;
  }
  Params p{};
  for (int i = 0; i < 33; ++i) p.in[i] = (const float*)d_in[i];
  p.out = (float*)d_out;
  p.ws = (unsigned char*)d_ws;
#if MULTI_LAUNCH
  (void)hipMemsetAsync((unsigned char*)d_ws + WS_CNT, 0, 4096 + XCD_BAR_WORDS * 4, stream);
  for (int ph = 0; ph < NPHASES; ++ph) {
    p.phase_lo = ph; p.phase_hi = ph + 1;
    hipLaunchKernelGGL(mega, dim3(grid_blocks), dim3(NT), DYN_LDS, stream, p);
#ifdef PROBE_MASK
    if ((PROBE_MASK >> ph) & 1) { p.flags = PROBE_FLAGS; for (int r = 0; r < 2; ++r) {
      if (ph == 3) (void)hipMemsetAsync((unsigned char*)d_ws + WS_CNT, 0, 64, stream);
      hipLaunchKernelGGL(mega, dim3(grid_blocks), dim3(NT), DYN_LDS, stream, p);
    } p.flags = 0; }
#endif
  }
#else
  p.phase_lo = 0; p.phase_hi = NPHASES;
  (void)hipMemsetAsync((unsigned char*)d_ws + WS_CNT, 0, 4096 + XCD_BAR_WORDS * 4, stream);
  void* args[] = {&p};
  hipError_t e = hipLaunchCooperativeKernel((const void*)mega, dim3(grid_blocks), dim3(NT), args, DYN_LDS, stream);
  if (e != hipSuccess) fprintf(stderr, "cooperative launch failed: %s (grid %d)\n", hipGetErrorString(e), grid_blocks);
#endif
}
```

```cpp
#include <hip/hip_runtime.h>
#include <hip/hip_cooperative_groups.h>
#include <cstdio>
namespace cg = cooperative_groups;

#ifndef MULTI_LAUNCH
#define MULTI_LAUNCH 0
#endif

typedef unsigned short u16;
using bf16x8 = __attribute__((ext_vector_type(8))) short;
using f32x4 = __attribute__((ext_vector_type(4))) float;
typedef _Float16 h4 __attribute__((ext_vector_type(4)));

#define TOK 12288
#define NPROMPT 8192
#define KVROWS 14336
#define NPHASES 23
#ifndef PHMASK
#define PHMASK 0x7fffff
#endif
#define DN_ALPHA 1.6817928305074290f

#define WS_W_HG_IN 0ull
#define WS_W_HG_OUT (WS_W_HG_IN + 10485760ull)
#define WS_W_SC_IN (WS_W_HG_OUT + 2097152ull)
#define WS_W_SC_OUT (WS_W_SC_IN + 8388608ull)
#define WS_W_RG_IN (WS_W_SC_OUT + 2097152ull)
#define WS_W_RG_GATE (WS_W_RG_IN + 4194304ull)
#define WS_W_RG_OUT (WS_W_RG_GATE + 2097152ull)
#define WS_W_MLA_IN (WS_W_RG_OUT + 2097152ull)
#define WS_W_QB (WS_W_MLA_IN + 3670016ull)
#define WS_W_KVB (WS_W_QB + 1179648ull)
#define WS_W_MLA_OUT (WS_W_KVB + 1048576ull)
#define WS_MOD (WS_W_MLA_OUT + 2097152ull)
#define WS_LB (WS_MOD + 245760ull)
#define WS_CNT (WS_LB + 8192ull)
#define WS_R (WS_CNT + 4096ull + 16384ull)
#define BSZ 25165824ull
#define WS_H (WS_R)
#define WS_B(i) (WS_R + BSZ * (1 + (i)))
#define WS_SLOT (WS_R + 201326592ull)
#define WS_XB (WS_SLOT + 1572864ull)
#define WS3_CQ (WS_R + 25165824ull)
#define WS3_CKVALL (WS_R + 34603008ull)
#define WS3_CKVRAW (WS_R + 41943040ull)
#define WS3_KPERAW (WS_R + 54525952ull)
#define WS3_SG (WS_R + 56098816ull)
#define WS3_Q (WS_R + 81264640ull)
#define WS3_K (WS_R + 119013376ull)
#define WS3_VT (WS_R + 163053568ull)

#define OUT_HG 12582912
#define OUT_RG 20971520
#define OUT_CKV 21037056
#define OUT_KPE 23134208

struct Params {
  const float* in[33];
  float* out;
  unsigned char* ws;
  int phase_lo, phase_hi, flags, pad_;
};

__device__ __forceinline__ u16 f2bf(float f) { __bf16 r = (__bf16)f; return *(u16*)&r; }
__device__ __forceinline__ float bf2f(u16 h) { return __uint_as_float(((unsigned)h) << 16); }
typedef float f2v_ __attribute__((ext_vector_type(2)));
typedef __bf16 b2v_ __attribute__((ext_vector_type(2)));
__device__ __forceinline__ unsigned pack2(float a, float b) { f2v_ f = {a, b}; b2v_ r = __builtin_convertvector(f, b2v_); return *(unsigned*)&r; }
__device__ __forceinline__ uint2 pack4(float a, float b, float c, float d) { return make_uint2(pack2(a, b), pack2(c, d)); }
typedef unsigned u32x2_ __attribute__((ext_vector_type(2)));
typedef unsigned u32x4_ __attribute__((ext_vector_type(4)));
__device__ __forceinline__ uint2 ldnt2(const void* p) { const u32x2_ v = __builtin_nontemporal_load((const u32x2_*)p); return make_uint2(v.x, v.y); }
__device__ __forceinline__ uint4 ldnt4(const void* p) { const u32x4_ v = __builtin_nontemporal_load((const u32x4_*)p); return make_uint4(v.x, v.y, v.z, v.w); }
__device__ __forceinline__ float lo16(unsigned u) { return __uint_as_float(u << 16); }
__device__ __forceinline__ float hi16(unsigned u) { return __uint_as_float(u & 0xffff0000u); }
__device__ __forceinline__ float sigmoidf_(float x) { return __builtin_amdgcn_rcpf(1.0f + __expf(-x)); }
__device__ __forceinline__ float siluf_(float x) { return x * __builtin_amdgcn_rcpf(1.0f + __expf(-x)); }
__device__ __forceinline__ int cond_of(int tok) { return tok < NPROMPT ? 0 : 1 + ((tok - NPROMPT) >> 10); }
__device__ __forceinline__ float wave_sum(float v) {
#pragma unroll
  for (int o = 32; o > 0; o >>= 1) v += __shfl_xor(v, o);
  return v;
}
__device__ __forceinline__ void rope_sincos(float pos, int fi, float& sn, float& cs) {
  float inv = exp2f(-(float)fi * 1.6609640474436813f);
  float ang = pos * inv;
  float k = rintf(ang * 0.15915494309189535f);
  float r = fmaf(-k, 6.2831854820251465f, ang);
  r = fmaf(-k, -1.7484555e-7f, r);
  sn = __sinf(r); cs = __cosf(r);
}

#define NT 512
#define NW 8
#define LAS __attribute__((address_space(3)))

namespace pg8 {
constexpr int BM = 256, BK = 64, HALF = 128, HTB = HALF * BK * 2, STAGE_BYTES = 8 * HTB, NXCD = 8, WGM = 8;
__device__ __forceinline__ int lds_byte(int r, int c) { const int st = (r >> 4) * 2 + (c >> 5), rr = r & 15, cc = c & 31, ob = rr * 64 + cc * 2; return st * 1024 + (ob ^ (((ob >> 9) & 1) << 5)); }
__device__ __forceinline__ void stage_rc(int b, int& R, int& C) { const int st = b / 1024, sb = b % 1024, swz = sb ^ (((sb >> 9) & 1) << 5); R = (st >> 1) * 16 + swz / 64; C = (st & 1) * 32 + (swz % 64) / 2; }
struct Unit { int pm, pn; };
struct Gemm { const u16* A; const u16* Bt; int M, N, K, lda, gate, noepi; size_t kstepA, gstride; };
struct StaticOrder {
  int nM, nN, nwg, G, c, ubeg, uend;
  __device__ void init(int M, int N, int G_, int c_) { nM = M / BM; nN = N / BM; nwg = nM * nN; G = G_; c = c_; ubeg = 0; uend = nwg; }
  __device__ bool next(int i, Unit& u) const {
    const long L = (long)ubeg + (long)i * G + c; if (L >= uend) return false;
    int wgid = (int)L; { const int q = nwg / NXCD, r = nwg % NXCD, xcd = wgid % NXCD, off = wgid / NXCD; wgid = (xcd < r ? xcd * (q + 1) : r * (q + 1) + (xcd - r) * q) + off; }
    const int nig = WGM * nN, gid = wgid / nig, fm = gid * WGM, gsz = (nM - fm) < WGM ? (nM - fm) : WGM;
    u.pm = fm + ((wgid % nig) % gsz); u.pn = (wgid % nig) / gsz; return true;
  }
};
template <class Epi>
__device__ __forceinline__ void gemm_phase(LAS unsigned char* lds, const Gemm g, const StaticOrder& S, const Epi& E) {
  const int tid = threadIdx.x, wid = __builtin_amdgcn_readfirstlane(tid >> 6), lane = tid & 63, wr = wid >> 2, wc = wid & 3, fr = lane & 15, fq = lane >> 4;
  const int K = g.K, nt = K / BK;
  unsigned voffA[2], voffB[2];
#pragma unroll
  for (int i = 0; i < 2; ++i) { int R, C; stage_rc(tid * 16 + i * 8192, R, C); voffA[i] = (unsigned)(R * g.lda + C) * 2u; voffB[i] = (unsigned)(R * K + C) * 2u; }
  const size_t kstep = (size_t)(BK * 2);
  const size_t kstepA = g.kstepA;
  const size_t hstepA = (size_t)HALF * g.lda * 2, hstepB = (size_t)HALF * K * 2;
  const size_t tstepA = 2 * hstepA, tstepB = 2 * hstepB;
  const unsigned ldsw = (unsigned)wid * 1024u;
  const int aoff = lds_byte(wr * 64 + fr, fq * 8), boff = lds_byte(wc * 32 + fr, fq * 8);
#define PG8_AOFF(pn) (g.gate ? (size_t)(((pn) >> 1) & 3) * g.gstride : (size_t)0)
#define PG8_SA(b, h) (((b) * 2 + (h)) * HTB)
#define PG8_SB(b, h) ((4 + (b) * 2 + (h)) * HTB)
#define PG8_STAGE(bufoff, gbase, voff) do { _Pragma("unroll") for (int _i = 0; _i < 2; ++_i) \
    __builtin_amdgcn_global_load_lds((const unsigned*)((const char*)(gbase) + (voff)[_i]), (LAS unsigned*)(lds + (bufoff) + ldsw + _i * 8192), 16, 0, 0); } while (0)
#define PG8_LDA(dst, b, h) do { _Pragma("unroll") for (int m = 0; m < 4; ++m) _Pragma("unroll") for (int k = 0; k < 2; ++k) dst[m][k] = *(const LAS bf16x8*)(lds + PG8_SA(b, h) + aoff + m * 2048 + k * 1024); } while (0)
#define PG8_LDB(dst, b, h) do { _Pragma("unroll") for (int n = 0; n < 2; ++n) _Pragma("unroll") for (int k = 0; k < 2; ++k) dst[n][k] = *(const LAS bf16x8*)(lds + PG8_SB(b, h) + boff + n * 2048 + k * 1024); } while (0)
#define PG8_MMA(ai, bj, At, Bt) do { __builtin_amdgcn_s_setprio(1); _Pragma("unroll") for (int m = 0; m < 4; ++m) _Pragma("unroll") for (int n = 0; n < 2; ++n) _Pragma("unroll") for (int k = 0; k < 2; ++k) \
    acc[ai][bj][m][n] = __builtin_amdgcn_mfma_f32_16x16x32_bf16(Bt[n][k], At[m][k], acc[ai][bj][m][n], 0, 0, 0); __builtin_amdgcn_s_setprio(0); } while (0)
#define PG8_WAIT_V(n) asm volatile("s_waitcnt vmcnt(" #n ")" ::: "memory")
#define PG8_WAIT_L(n) asm volatile("s_waitcnt lgkmcnt(" #n ")" ::: "memory")
#define PG8_BAR __builtin_amdgcn_s_barrier()
#define PG8_SCHED __builtin_amdgcn_sched_barrier(0)
  Unit cur, nxt; int ui = 0;
  if (!S.next(0, cur)) return;
  f32x4 acc[2][2][4][2];
#pragma unroll
  for (int a = 0; a < 2; ++a)
#pragma unroll
    for (int b = 0; b < 2; ++b)
#pragma unroll
      for (int m = 0; m < 4; ++m)
#pragma unroll
        for (int n = 0; n < 2; ++n) acc[a][b][m][n] = (f32x4){0.f, 0.f, 0.f, 0.f};
  bf16x8 At[4][2], B0[2][2], B1[2][2];
  const char* cA = (const char*)g.A + (size_t)cur.pm * tstepA + PG8_AOFF(cur.pn); const char* cB = (const char*)g.Bt + (size_t)cur.pn * tstepB;
  PG8_STAGE(PG8_SB(0, 0), cB, voffB); PG8_STAGE(PG8_SA(0, 0), cA, voffA); PG8_STAGE(PG8_SB(0, 1), cB + hstepB, voffB); PG8_STAGE(PG8_SA(0, 1), cA + hstepA, voffA);
  if (wr == 1) PG8_BAR;
  PG8_WAIT_V(4); PG8_BAR;
  PG8_STAGE(PG8_SB(1, 0), cB + kstep, voffB); PG8_STAGE(PG8_SA(1, 0), cA + kstepA, voffA); PG8_STAGE(PG8_SB(1, 1), cB + hstepB + kstep, voffB);
  PG8_WAIT_V(6); PG8_BAR;
  for (;;) {
    const bool has_next = S.next(ui + 1, nxt);
    const char* nA = has_next ? (const char*)g.A + (size_t)nxt.pm * tstepA + PG8_AOFF(nxt.pn) : cA; const char* nB = has_next ? (const char*)g.Bt + (size_t)nxt.pn * tstepB : cB;
#pragma unroll 1
    for (int t = 0; t < nt; t += 2) {
      const bool last = (t == nt - 2);
      const char* a1 = cA + (size_t)(t + 1) * kstepA;
      const char* a2 = last ? nA : cA + (size_t)(t + 2) * kstepA; const char* b2 = last ? nB : cB + (size_t)(t + 2) * kstep;
      const char* a3 = a2 + kstepA; const char* b3 = b2 + kstep;
      PG8_LDB(B0, 0, 0); PG8_SCHED; PG8_LDA(At, 0, 0); PG8_STAGE(PG8_SA(1, 1), a1 + hstepA, voffA);
      PG8_WAIT_L(8); PG8_BAR; PG8_WAIT_L(0); PG8_MMA(0, 0, At, B0); PG8_BAR; PG8_SCHED;
      PG8_LDB(B1, 0, 1); PG8_STAGE(PG8_SB(0, 0), b2, voffB);
      PG8_BAR; PG8_WAIT_L(0); PG8_MMA(0, 1, At, B1); PG8_BAR;
      PG8_LDA(At, 0, 1); PG8_STAGE(PG8_SA(0, 0), a2, voffA);
      PG8_BAR; PG8_WAIT_L(0); PG8_MMA(1, 0, At, B0); PG8_BAR; PG8_SCHED;
      PG8_STAGE(PG8_SB(0, 1), b2 + hstepB, voffB);
      PG8_WAIT_V(6); PG8_BAR; PG8_MMA(1, 1, At, B1); PG8_BAR;
      PG8_LDB(B0, 1, 0); PG8_SCHED; PG8_LDA(At, 1, 0); PG8_STAGE(PG8_SA(0, 1), a2 + hstepA, voffA);
      PG8_WAIT_L(8); PG8_BAR; PG8_WAIT_L(0); PG8_MMA(0, 0, At, B0); PG8_BAR; PG8_SCHED;
      PG8_LDB(B1, 1, 1); PG8_STAGE(PG8_SB(1, 0), b3, voffB);
      PG8_BAR; PG8_WAIT_L(0); PG8_MMA(0, 1, At, B1); PG8_BAR;
      PG8_LDA(At, 1, 1); PG8_STAGE(PG8_SA(1, 0), a3, voffA);
      PG8_BAR; PG8_WAIT_L(0); PG8_MMA(1, 0, At, B0); PG8_BAR; PG8_SCHED;
      PG8_STAGE(PG8_SB(1, 1), b3 + hstepB, voffB);
      PG8_WAIT_V(6); PG8_BAR; PG8_MMA(1, 1, At, B1); PG8_BAR;
    }
    if constexpr (!Epi::AFTER_DRAIN) { if (!g.noepi) E(acc, cur, wr, wc, fr, fq); }
    if (!has_next) break;
#pragma unroll
    for (int a = 0; a < 2; ++a)
#pragma unroll
      for (int b = 0; b < 2; ++b)
#pragma unroll
        for (int m = 0; m < 4; ++m)
#pragma unroll
          for (int n = 0; n < 2; ++n) acc[a][b][m][n] = (f32x4){0.f, 0.f, 0.f, 0.f};
    cur = nxt; cA = nA; cB = nB; ++ui;
  }
  PG8_WAIT_V(0);
  if (wr == 0) PG8_BAR;
  PG8_BAR;
  if constexpr (Epi::AFTER_DRAIN) { if (!g.noepi) E.fused(acc, cur, wr, wc, fr, fq, lds); }
#undef PG8_AOFF
#undef PG8_SA
#undef PG8_SB
#undef PG8_STAGE
#undef PG8_LDA
#undef PG8_LDB
#undef PG8_MMA
#undef PG8_WAIT_V
#undef PG8_WAIT_L
#undef PG8_BAR
#undef PG8_SCHED
}
}
using pg8::Unit;
typedef const f32x4 (&AccRef)[2][2][4][2];

#define EPI_ROWS(...) _Pragma("unroll") for (int ai = 0; ai < 2; ++ai) _Pragma("unroll") for (int m = 0; m < 4; ++m) { const int row = u.pm * 256 + ai * 128 + wr * 64 + m * 16 + fr; __VA_ARGS__ }
#define EPI_COLS(...) _Pragma("unroll") for (int bj = 0; bj < 2; ++bj) _Pragma("unroll") for (int n = 0; n < 2; ++n) { const int cb = u.pn * 256 + bj * 128 + wc * 32 + n * 16; const f32x4 a = acc[ai][bj][m][n]; __VA_ARGS__ }

struct EpiHgIn {
  static constexpr bool AFTER_DRAIN = false;
  u16 *q, *v, *sg; _Float16* lf; const float* lb;
  __device__ __forceinline__ void operator()(AccRef acc, const Unit& u, int wr, int wc, int fr, int fq) const {
    const int region = u.pn >> 2;
    f32x4 l4[2][2];
    if (region == 1 || region == 2) {
#pragma unroll
      for (int bj = 0; bj < 2; ++bj)
#pragma unroll
        for (int n = 0; n < 2; ++n) l4[bj][n] = *(const f32x4*)&lb[(region - 1) * 1024 + ((u.pn * 256 + bj * 128 + wc * 32 + n * 16) & 1023) + fq * 4];
    }
    EPI_ROWS( EPI_COLS(
      const int c = (cb & 1023) + fq * 4;
      if (region == 0) {
        const float s = 0.08838834764831845f;
        *(uint2*)&q[(size_t)row * 1024 + c] = pack4(siluf_(a[0]) * s, siluf_(a[1]) * s, siluf_(a[2]) * s, siluf_(a[3]) * s);
      } else if (region <= 2) {
        const int d = region - 1;
        h4 o;
        _Pragma("unroll") for (int j = 0; j < 4; ++j) { float f = l4[bj][n][j] + (1.0f - l4[bj][n][j]) * sigmoidf_(a[j]); o[j] = (_Float16)__builtin_amdgcn_logf(f); }
        *(h4*)&lf[(size_t)row * 2048 + d * 1024 + c] = o;
      } else if (region == 3) {
        *(uint2*)&v[(size_t)row * 1024 + c] = pack4(a[0], a[1], a[2], a[3]);
      } else {
        *(uint2*)&sg[(size_t)row * 1024 + c] = pack4(a[0], a[1], a[2], a[3]);
      }
    ) )
  }
};

struct EpiRes {
  static constexpr bool AFTER_DRAIN = false;
  const float* xin_p; const float* xin_s; float* Y; const float* gate;
  __device__ __forceinline__ void operator()(AccRef acc, const Unit& u, int wr, int wc, int fr, int fq) const {
    EPI_ROWS(
      const float* xr = row < NPROMPT ? xin_p + (size_t)row * 1024 : xin_s + (size_t)(row - NPROMPT) * 1024;
      const float* g = gate + cond_of(row) * 3072;
      EPI_COLS(
        const int c = cb + fq * 4;
        f32x4 x = *(const f32x4*)&xr[c];
        f32x4 gg = *(const f32x4*)&g[c];
        f32x4 y;
        _Pragma("unroll") for (int j = 0; j < 4; ++j) y[j] = DN_ALPHA * x[j] + gg[j] * a[j];
        *(f32x4*)&Y[(size_t)row * 1024 + c] = y;
      ) )
  }
};

template <bool XIN_BF, bool XOUT_BF>
struct EpiResLn {
  static constexpr bool AFTER_DRAIN = true;
  const float* xin_p; const float* xin_s; const u16* xin_b; float* X; u16* XB; const float* gate; const float* lg; const float* lbias; const float* modn; u16* H;
  unsigned long long* slots; unsigned* cnt;
  __device__ __forceinline__ void fused(f32x4 (&acc)[2][2][4][2], const Unit& u, int wr, int wc, int fr, int fq, LAS unsigned char* lds) const {
    LAS float* part = (LAS float*)lds;
    LAS float* stat = part + 2048;
    const int tid = threadIdx.x;
    const int cnd = cond_of(u.pm * 256);
    f32x4 gv[2][2];
#pragma unroll
    for (int bj = 0; bj < 2; ++bj)
#pragma unroll
      for (int n = 0; n < 2; ++n) gv[bj][n] = *(const f32x4*)&gate[cnd * 3072 + u.pn * 256 + bj * 128 + wc * 32 + n * 16 + fq * 4];
#pragma unroll
    for (int ai = 0; ai < 2; ++ai)
#pragma unroll
      for (int m = 0; m < 4; ++m) {
        const int rl = ai * 128 + wr * 64 + m * 16 + fr;
        const int row = u.pm * 256 + rl;
        const float* xr = row < NPROMPT ? xin_p + (size_t)row * 1024 : xin_s + (size_t)(row - NPROMPT) * 1024;
        float s1 = 0.f, s2 = 0.f;
#pragma unroll
        for (int bj = 0; bj < 2; ++bj)
#pragma unroll
          for (int n = 0; n < 2; ++n) {
            const int c = u.pn * 256 + bj * 128 + wc * 32 + n * 16 + fq * 4;
            f32x4 x;
            if constexpr (XIN_BF) { const uint2 xb2 = *(const uint2*)&xin_b[(size_t)row * 1024 + c]; x = f32x4{lo16(xb2.x), hi16(xb2.x), lo16(xb2.y), hi16(xb2.y)}; }
            else x = *(const f32x4*)&xr[c];
            const f32x4 gg = gv[bj][n];
            f32x4 y;
#pragma unroll
            for (int j = 0; j < 4; ++j) { y[j] = DN_ALPHA * x[j] + gg[j] * acc[ai][bj][m][n][j]; s1 += y[j]; s2 += y[j] * y[j]; }
            acc[ai][bj][m][n] = y;
          }
        s1 += __shfl_xor(s1, 16); s1 += __shfl_xor(s1, 32);
        s2 += __shfl_xor(s2, 16); s2 += __shfl_xor(s2, 32);
        if (fq == 0) { part[(rl * 4 + wc) * 2] = s1; part[(rl * 4 + wc) * 2 + 1] = s2; }
      }
    __syncthreads();
    if (tid < 256) {
      float S1 = 0.f, S2 = 0.f;
#pragma unroll
      for (int w2 = 0; w2 < 4; ++w2) { S1 += part[(tid * 4 + w2) * 2]; S2 += part[(tid * 4 + w2) * 2 + 1]; }
      const unsigned long long v = (unsigned long long)__float_as_uint(S1) | ((unsigned long long)__float_as_uint(S2) << 32);
      __hip_atomic_store(&slots[(size_t)(u.pm * 4 + u.pn) * 256 + tid], v, __ATOMIC_RELAXED, __HIP_MEMORY_SCOPE_AGENT);
    }
    asm volatile("s_waitcnt vmcnt(0)" ::: "memory");
    __syncthreads();
    if (tid == 0) {
      __hip_atomic_fetch_add(&cnt[u.pm], 1u, __ATOMIC_RELAXED, __HIP_MEMORY_SCOPE_AGENT);
      unsigned sp = 0;
      while (__hip_atomic_load(&cnt[u.pm], __ATOMIC_RELAXED, __HIP_MEMORY_SCOPE_AGENT) < 4u) { __builtin_amdgcn_s_sleep(1); if (++sp > (1u << 24)) break; }
    }
    __syncthreads();
    if (tid < 256) {
      float T1 = 0.f, T2 = 0.f;
#pragma unroll
      for (int o = 0; o < 4; ++o) {
        const unsigned long long v = __hip_atomic_load(&slots[(size_t)(u.pm * 4 + o) * 256 + tid], __ATOMIC_RELAXED, __HIP_MEMORY_SCOPE_AGENT);
        T1 += __uint_as_float((unsigned)(v & 0xffffffffull)); T2 += __uint_as_float((unsigned)(v >> 32));
      }
      const float mu = T1 * (1.0f / 1024.0f);
      const float var = fmaxf(T2 * (1.0f / 1024.0f) - mu * mu, 0.f);
      stat[tid * 2] = mu; stat[tid * 2 + 1] = rsqrtf(var + 1e-5f);
    }
    __syncthreads();
#pragma unroll
    for (int bj = 0; bj < 2; ++bj) {
      f32x4 lgv[2], lbv[2], shv[2], scv[2];
#pragma unroll
      for (int n = 0; n < 2; ++n) {
        const int c = u.pn * 256 + bj * 128 + wc * 32 + n * 16 + fq * 4;
        lgv[n] = *(const f32x4*)&lg[c]; lbv[n] = *(const f32x4*)&lbias[c];
        shv[n] = *(const f32x4*)&modn[cnd * 3072 + c]; scv[n] = *(const f32x4*)&modn[cnd * 3072 + 1024 + c];
      }
#pragma unroll
      for (int ai = 0; ai < 2; ++ai)
#pragma unroll
        for (int m = 0; m < 4; ++m) {
          const int rl = ai * 128 + wr * 64 + m * 16 + fr;
          const int row = u.pm * 256 + rl;
          const float mu = stat[rl * 2], rs = stat[rl * 2 + 1];
#pragma unroll
          for (int n = 0; n < 2; ++n) {
            const int c = u.pn * 256 + bj * 128 + wc * 32 + n * 16 + fq * 4;
            const f32x4 y = acc[ai][bj][m][n];
            f32x4 xo;
#pragma unroll
            for (int j = 0; j < 4; ++j) xo[j] = (y[j] - mu) * rs * lgv[n][j] + lbv[n][j];
            if constexpr (XOUT_BF) *(uint2*)&XB[(size_t)row * 1024 + c] = pack4(xo[0], xo[1], xo[2], xo[3]);
            else __builtin_nontemporal_store(xo, (f32x4*)&X[(size_t)row * 1024 + c]);
            if (H) {
              *(uint2*)&H[(size_t)row * 1024 + c] = pack4(xo[0] * (1 + scv[n][0]) + shv[n][0], xo[1] * (1 + scv[n][1]) + shv[n][1], xo[2] * (1 + scv[n][2]) + shv[n][2], xo[3] * (1 + scv[n][3]) + shv[n][3]);
            }
          }
        }
    }
  }
};

struct EpiScIn {
  static constexpr bool AFTER_DRAIN = false;
  u16 *pb, *sb;
  __device__ __forceinline__ void operator()(AccRef acc, const Unit& u, int wr, int wc, int fr, int fq) const {
    const int c = u.pn * 64 + wc * 16 + fq * 4;
    EPI_ROWS(
      const f32x4 bg = acc[ai][0][m][0], cgv = acc[ai][0][m][1], v = acc[ai][1][m][0], g = acc[ai][1][m][1];
      *(uint2*)&pb[(size_t)row * 1024 + c] = pack4(cgv[0] * v[0], cgv[1] * v[1], cgv[2] * v[2], cgv[3] * v[3]);
      *(uint2*)&sb[(size_t)row * 1024 + c] = pack4(siluf_(g[0]) * bg[0], siluf_(g[1]) * bg[1], siluf_(g[2]) * bg[2], siluf_(g[3]) * bg[3]);
    )
  }
};

struct EpiRgIn {
  static constexpr bool AFTER_DRAIN = false;
  u16 *ub, *sg;
  __device__ __forceinline__ void operator()(AccRef acc, const Unit& u, int wr, int wc, int fr, int fq) const {
    const int region = u.pn >> 2;
    EPI_ROWS( EPI_COLS(
      const int c = (cb & 1023) + fq * 4;
      if (region == 0) *(uint2*)&ub[(size_t)row * 1024 + c] = pack4(a[0], a[1], a[2], a[3]);
      else *(uint2*)&sg[((size_t)(c >> 6) * TOK + row) * 64 + (c & 63)] = pack4(siluf_(a[0]), siluf_(a[1]), siluf_(a[2]), siluf_(a[3]));
    ) )
  }
};

struct EpiSgGM {
  static constexpr bool AFTER_DRAIN = false;
  u16* sg;
  __device__ __forceinline__ void operator()(AccRef acc, const Unit& u, int wr, int wc, int fr, int fq) const {
    EPI_ROWS( EPI_COLS(
      const int c = cb + fq * 4;
      *(uint2*)&sg[((size_t)(c >> 6) * TOK + row) * 64 + (c & 63)] = pack4(siluf_(a[0]), siluf_(a[1]), siluf_(a[2]), siluf_(a[3]));
    ) )
  }
};

struct EpiRgGate {
  static constexpr bool AFTER_DRAIN = false;
  u16 *rb, *ib; const float* bgate;
  __device__ __forceinline__ void operator()(AccRef acc, const Unit& u, int wr, int wc, int fr, int fq) const {
    const int mat = u.pn >> 1, d = mat >> 2, hd = mat & 3;
    f32x4 br[2], bi[2]; int ccs[2];
#pragma unroll
    for (int bj = 0; bj < 2; ++bj) {
      const int off = ((u.pn & 1) * 256 + bj * 128 + wc * 32);
      ccs[bj] = (off >> 5) * 16 + fq * 4;
      br[bj] = *(const f32x4*)&bgate[mat * 512 + ccs[bj]];
      bi[bj] = *(const f32x4*)&bgate[mat * 512 + 256 + ccs[bj]];
    }
    EPI_ROWS(
      _Pragma("unroll") for (int bj = 0; bj < 2; ++bj) {
        const f32x4 r = acc[ai][bj][m][0], ii = acc[ai][bj][m][1];
        const int cch = hd * 256 + ccs[bj];
        const size_t o = (size_t)d * TOK * 1024 + ((size_t)(cch >> 6) * TOK + row) * 64 + (cch & 63);
        *(uint2*)&rb[o] = pack4(sigmoidf_(r[0] + br[bj][0]), sigmoidf_(r[1] + br[bj][1]), sigmoidf_(r[2] + br[bj][2]), sigmoidf_(r[3] + br[bj][3]));
        *(uint2*)&ib[o] = pack4(sigmoidf_(ii[0] + bi[bj][0]), sigmoidf_(ii[1] + bi[bj][1]), sigmoidf_(ii[2] + bi[bj][2]), sigmoidf_(ii[3] + bi[bj][3]));
      } )
  }
};

struct EpiMlaIn {
  static constexpr bool AFTER_DRAIN = false;
  u16* cq; float* ckvraw; float* kperaw; u16* sg;
  __device__ __forceinline__ void operator()(AccRef acc, const Unit& u, int wr, int wc, int fr, int fq) const {
    EPI_ROWS( EPI_COLS(
      const int c = cb + fq * 4;
      if (cb < 384) *(uint2*)&cq[(size_t)row * 384 + c] = pack4(a[0], a[1], a[2], a[3]);
      else if (cb < 640) *(f32x4*)&ckvraw[(size_t)row * 256 + (c - 384)] = a;
      else if (cb < 672) *(f32x4*)&kperaw[(size_t)row * 32 + (c - 640)] = a;
    ) )
  }
};

struct EpiSg {
  static constexpr bool AFTER_DRAIN = false;
  u16* sg;
  __device__ __forceinline__ void operator()(AccRef acc, const Unit& u, int wr, int wc, int fr, int fq) const {
    EPI_ROWS( EPI_COLS(
      *(uint2*)&sg[(size_t)row * 1024 + cb + fq * 4] = pack4(a[0], a[1], a[2], a[3]);
    ) )
  }
};

struct EpiQ {
  static constexpr bool AFTER_DRAIN = false;
  u16* q;
  __device__ __forceinline__ void operator()(AccRef acc, const Unit& u, int wr, int wc, int fr, int fq) const {
    const float sc = 0.14724444500602648f;
    EPI_ROWS( EPI_COLS(
      *(uint2*)&q[(size_t)row * 1536 + cb + fq * 4] = pack4(a[0] * sc, a[1] * sc, a[2] * sc, a[3] * sc);
    ) )
  }
};

struct EpiK {
  static constexpr bool AFTER_DRAIN = false;
  u16* Kb;
  __device__ __forceinline__ void operator()(AccRef acc, const Unit& u, int wr, int wc, int fr, int fq) const {
    EPI_ROWS( EPI_COLS(
      const int h = cb >> 6, dd = (cb & 63) + fq * 4;
      *(uint2*)&Kb[((size_t)row * 16 + h) * 96 + dd] = pack4(a[0], a[1], a[2], a[3]);
    ) )
  }
};
struct EpiV {
  static constexpr bool AFTER_DRAIN = false;
  u16* Vt;
  __device__ __forceinline__ void operator()(AccRef acc, const Unit& u, int wr, int wc, int fr, int fq) const {
    EPI_ROWS( EPI_COLS(
      *(uint2*)&Vt[(size_t)row * KVROWS + cb + fq * 4] = pack4(a[0], a[1], a[2], a[3]);
    ) )
  }
};

__device__ __forceinline__ void wconv_tile(const float* __restrict__ src, int N, int K, u16* __restrict__ dst, int k0, int n0,
                                           int perm, int mat, float* tile) {
  const int tid = threadIdx.x;
  {
    const int r = tid >> 4, c4 = (tid & 15) * 4;
#pragma unroll
    for (int i = 0; i < 2; ++i) {
      const int k = r + i * 32;
      f32x4 v = f32x4{0.f, 0.f, 0.f, 0.f};
      if (n0 + c4 < N) v = __builtin_nontemporal_load((const f32x4*)&src[(size_t)(k0 + k) * N + n0 + c4]);
      tile[k * 65 + c4 + 0] = v[0]; tile[k * 65 + c4 + 1] = v[1]; tile[k * 65 + c4 + 2] = v[2]; tile[k * 65 + c4 + 3] = v[3];
    }
  }
  __syncthreads();
  {
    const int nl = tid >> 3, kq = (tid & 7) * 8;
    const int n = n0 + nl;
    int np = n;
    if (perm == 1) { const int part = n >> 10, c = n & 1023; np = (c >> 6) * 256 + (part >> 1) * 128 + ((c >> 4) & 3) * 32 + (part & 1) * 16 + (c & 15); }
    else if (perm == 2) { const int type = n >> 8, cc = n & 255; np = mat * 512 + (cc >> 4) * 32 + type * 16 + (cc & 15); }
    else if (perm == 3) { const int hh = n >> 7, dd = n & 127; np = (dd >= 64 ? 1024 : 0) + hh * 64 + (dd & 63); }
    if (n < N) {
      unsigned w[4];
#pragma unroll
      for (int i = 0; i < 4; ++i) w[i] = pack2(tile[(kq + 2 * i) * 65 + nl], tile[(kq + 2 * i + 1) * 65 + nl]);
      *(uint4*)&dst[(size_t)np * K + k0 + kq] = make_uint4(w[0], w[1], w[2], w[3]);
    }
  }
  __syncthreads();
}

__device__ __forceinline__ void wconv_item(const Params& p, int t, float* fs) {
  const float* src; u16* dst; int N, K, perm = 0, mat = 0, ntn;
  if (t < 1280) { src = p.in[12]; dst = (u16*)(p.ws + WS_W_HG_IN); N = 5120; K = 1024; }
  else if ((t -= 1280) < 256) { src = p.in[15]; dst = (u16*)(p.ws + WS_W_HG_OUT); N = 1024; K = 1024; }
  else if ((t -= 256) < 1024) { src = p.in[16]; dst = (u16*)(p.ws + WS_W_SC_IN); N = 4096; K = 1024; perm = 1; }
  else if ((t -= 1024) < 256) { src = p.in[19]; dst = (u16*)(p.ws + WS_W_SC_OUT); N = 1024; K = 1024; }
  else if ((t -= 256) < 512) { src = p.in[20]; dst = (u16*)(p.ws + WS_W_RG_IN); N = 2048; K = 1024; }
  else if ((t -= 512) < 256) { mat = t >> 5; t &= 31; src = p.in[23] + (size_t)mat * 256 * 512; dst = (u16*)(p.ws + WS_W_RG_GATE); N = 512; K = 256; perm = 2; }
  else if ((t -= 256) < 256) { src = p.in[26]; dst = (u16*)(p.ws + WS_W_RG_OUT); N = 1024; K = 1024; }
  else if ((t -= 256) < 432) { src = p.in[27]; dst = (u16*)(p.ws + WS_W_MLA_IN); N = 1696; K = 1024; }
  else if ((t -= 432) < 144) { src = p.in[30]; dst = (u16*)(p.ws + WS_W_QB); N = 1536; K = 384; }
  else if ((t -= 144) < 128) { src = p.in[31]; dst = (u16*)(p.ws + WS_W_KVB); N = 2048; K = 256; perm = 3; }
  else { t -= 128; src = p.in[32]; dst = (u16*)(p.ws + WS_W_MLA_OUT); N = 1024; K = 1024; }
  ntn = (N + 63) >> 6;
  const int kt = t / ntn, ntl = t - kt * ntn;
  wconv_tile(src, N, K, dst, kt * 64, ntl * 64, perm, mat, fs);
}
__device__ __forceinline__ void wconv_idle(const Params& p, unsigned char* smem_raw, int bid, int nb, int t0, int t1) {
  if (nb == 256 && bid >= 192) for (int t = t0 + (bid - 192); t < t1; t += 64) wconv_item(p, t, (float*)smem_raw);
}

__device__ __forceinline__ void phase_prologue(const Params& p, unsigned char* smem_raw, int bid, int nb) {
  float* fs = (float*)smem_raw;
  const int tid = threadIdx.x;
  const int NMOD = 192, NWT = (nb == 256) ? 1536 : 4800;
  for (int it = bid; it < NMOD + 1 + NWT; it += nb) {
    if (it < NMOD) {
      const int l = it / 48, n0 = (it % 48) * 64;
      float* scond = fs;
      float* sred = fs + 5120;
      for (int i = tid; i < 5120; i += NT) {
        const int ci = i >> 10, k = i & 1023;
        float cv = ci == 0 ? p.in[7][k] : p.in[6][(ci - 1) * 1024 + k];
        scond[i] = siluf_(cv);
      }
      __syncthreads();
      const int col = tid & 63, kg = tid >> 6;
      const float* w = p.in[8] + (size_t)l * 1024 * 3072 + n0 + col;
      float a0 = 0, a1 = 0, a2 = 0, a3 = 0, a4 = 0;
#pragma unroll 16
      for (int k = kg * 128; k < kg * 128 + 128; ++k) {
        float wv = __builtin_nontemporal_load(&w[(size_t)k * 3072]);
        a0 += scond[k] * wv; a1 += scond[1024 + k] * wv; a2 += scond[2048 + k] * wv; a3 += scond[3072 + k] * wv; a4 += scond[4096 + k] * wv;
      }
      sred[(kg * 5 + 0) * 64 + col] = a0; sred[(kg * 5 + 1) * 64 + col] = a1; sred[(kg * 5 + 2) * 64 + col] = a2;
      sred[(kg * 5 + 3) * 64 + col] = a3; sred[(kg * 5 + 4) * 64 + col] = a4;
      __syncthreads();
      float* mod = (float*)(p.ws + WS_MOD);
      if (tid < 320) {
        const int ci = tid >> 6, cc = tid & 63;
        float s = 0;
#pragma unroll
        for (int g = 0; g < 8; ++g) s += sred[(g * 5 + ci) * 64 + cc];
        mod[(l * 5 + ci) * 3072 + n0 + cc] = s + p.in[9][l * 3072 + n0 + cc];
      }
      __syncthreads();
    } else if (it == NMOD) {
      float* lb = (float*)(p.ws + WS_LB);
      for (int i = tid; i < 2048; i += NT) {
        const int d = i >> 10, c = i & 1023;
        const float* lg = p.in[13] + d * 5 * 1024 + c;
        float m = lg[0];
        for (int j = 1; j < 5; ++j) m = fmaxf(m, lg[j * 1024]);
        float s = 0;
        for (int j = 0; j < 5; ++j) s += expf(lg[j * 1024] - m);
        lb[i] = expf(lg[0] - m) / s;
      }
      int* cnt = (int*)(p.ws + WS_CNT);
      if (tid < 16) cnt[tid] = 0;
    } else {
      wconv_item(p, it - NMOD - 1, fs);
    }
  }
}

__device__ __forceinline__ void phase_h0(const Params& p, int bid, int nb) {
  const float* mod = (const float*)(p.ws + WS_MOD);
  u16* H = (u16*)(p.ws + WS_H);
  const size_t total = (size_t)(TOK / 4) * 256;
  for (size_t i = (size_t)bid * NT + threadIdx.x; i < total; i += (size_t)nb * NT) {
    const int row = (int)(i >> 8) * 4, c = ((int)i & 255) * 4;
    const float* xr = row < NPROMPT ? p.in[0] + (size_t)row * 1024 : p.in[1] + (size_t)(row - NPROMPT) * 1024;
    const float* m = mod + cond_of(row) * 3072;
    f32x4 x[4];
#pragma unroll
    for (int t = 0; t < 4; ++t) x[t] = __builtin_nontemporal_load((const f32x4*)&xr[t * 1024 + c]);
    const f32x4 sh = *(const f32x4*)&m[c];
    const f32x4 sc = *(const f32x4*)&m[1024 + c];
#pragma unroll
    for (int t = 0; t < 4; ++t)
      *(uint2*)&H[(size_t)(row + t) * 1024 + c] = pack4(x[t][0] * (1 + sc[0]) + sh[0], x[t][1] * (1 + sc[1]) + sh[1], x[t][2] * (1 + sc[2]) + sh[2], x[t][3] * (1 + sc[3]) + sh[3]);
  }
}

__device__ __forceinline__ void phase_ln(const Params& p, int l, int bid, int nb) {
  float* X = p.out;
  const float* g = p.in[10] + l * 1024;
  const float* b = p.in[11] + l * 1024;
  const float* mod = (const float*)(p.ws + WS_MOD) + (l + 1) * 5 * 3072;
  u16* H = (u16*)(p.ws + WS_H);
  const int lane = threadIdx.x & 63, wave = threadIdx.x >> 6;
  for (int row = bid * NW + wave; row < TOK; row += nb * NW) {
    float* xr = X + (size_t)row * 1024;
    f32x4 v[4];
    float s = 0;
#pragma unroll
    for (int i = 0; i < 4; ++i) { v[i] = *(const f32x4*)&xr[i * 256 + lane * 4]; s += v[i][0] + v[i][1] + v[i][2] + v[i][3]; }
    const float mu = wave_sum(s) * (1.0f / 1024.0f);
    float q = 0;
#pragma unroll
    for (int i = 0; i < 4; ++i)
#pragma unroll
      for (int j = 0; j < 4; ++j) { float dd = v[i][j] - mu; q += dd * dd; }
    const float rs = rsqrtf(wave_sum(q) * (1.0f / 1024.0f) + 1e-5f);
    const float* m = mod + cond_of(row) * 3072;
#pragma unroll
    for (int i = 0; i < 4; ++i) {
      const int c = i * 256 + lane * 4;
      f32x4 gg = *(const f32x4*)&g[c], bb = *(const f32x4*)&b[c];
      f32x4 y;
#pragma unroll
      for (int j = 0; j < 4; ++j) y[j] = (v[i][j] - mu) * rs * gg[j] + bb[j];
      *(f32x4*)&xr[c] = y;
      if (l < 3) {
        f32x4 sh = *(const f32x4*)&m[c], sc = *(const f32x4*)&m[1024 + c];
        *(uint2*)&H[(size_t)row * 1024 + c] = pack4(y[0] * (1 + sc[0]) + sh[0], y[1] * (1 + sc[1]) + sh[1], y[2] * (1 + sc[2]) + sh[2], y[3] * (1 + sc[3]) + sh[3]);
      }
    }
  }
}

__device__ __forceinline__ void phase_gla(const Params& p, unsigned char* smem_raw) {
  u16* s_qrel = (u16*)smem_raw;
  u16* s_krel = s_qrel + 32 * 136;
  u16* s_qcum = s_krel + 32 * 136;
  u16* s_kdT = s_qcum + 32 * 136;
  u16* s_vT = s_kdT + 128 * 40;
  u16* s_att = s_vT + 128 * 40;
  u16* s_S = s_att + 32 * 40;
  float* s_dec = (float*)(s_S + 128 * 136);
  float* s_part = s_dec + 128;
  int* s_u = (int*)(s_part + 512);
  int* counter = (int*)(p.ws + WS_CNT);
  const u16* qg = (const u16*)(p.ws + WS_B(0));
  const u16* vg = (const u16*)(p.ws + WS_B(1));
  const _Float16* lfg = (const _Float16*)(p.ws + WS_B(3));
  u16* og = (u16*)(p.ws + WS_B(5));
  const int tid = threadIdx.x, lane = tid & 63, w = tid >> 6, fr = lane & 15, fq = lane >> 4;
  const int kk = tid & 127, th = tid >> 7;
  const int ti = w >> 2, vi = w & 3;
  const int wk = w & 3, wv = w >> 2;
  bool first = true;
  while (true) {
    if (tid == 0) *s_u = (first && blockIdx.x < 64) ? (int)blockIdx.x : 64 + atomicAdd(counter, 1);
    first = false;
    __syncthreads();
    const int u = *s_u;
    __syncthreads();
    if (u >= 576) break;
    int b, rem, start, N, sample;
    if (u < 64) { sample = 1; b = u >> 4; rem = u & 15; start = NPROMPT + b * 1024; N = 1024; }
    else { sample = 0; b = (u - 64) >> 4; rem = (u - 64) & 15; start = b * 256; N = 256; }
    const int h = rem >> 1, d = rem & 1;
    const int nc = N >> 5;
    f32x4 S[2][4];
#pragma unroll
    for (int mi = 0; mi < 2; ++mi)
#pragma unroll
      for (int ni = 0; ni < 4; ++ni) {
        f32x4 s4 = f32x4{0.f, 0.f, 0.f, 0.f};
        if (sample) {
          const float* s0 = p.in[2] + ((size_t)((b * 2 + d) * 8 + h)) * 16384;
#pragma unroll
          for (int j = 0; j < 4; ++j) s4[j] = s0[(wk * 32 + mi * 16 + fq * 4 + j) * 128 + wv * 64 + ni * 16 + fr];
        }
        S[mi][ni] = s4;
        *(uint2*)&s_S[(wv * 64 + ni * 16 + fr) * 136 + wk * 32 + mi * 16 + fq * 4] = pack4(s4[0], s4[1], s4[2], s4[3]);
      }
    _Float16 lfraw[8]; u16 qraw[8]; uint4 vraw;
#define GLA_LOAD(cc) do { _Pragma("unroll") for (int i = 0; i < 8; ++i) { const int tt = (cc) * 32 + th * 8 + i; const size_t tok = start + (d ? (N - 1 - tt) : tt); \
      lfraw[i] = lfg[tok * 2048 + d * 1024 + h * 128 + kk]; qraw[i] = qg[tok * 1024 + h * 128 + kk]; } \
      { const int tt = (cc) * 32 + (tid & 31); const size_t tok = start + (d ? (N - 1 - tt) : tt); vraw = *(const uint4*)&vg[tok * 1024 + h * 128 + (tid >> 5) * 8]; } } while (0)
    GLA_LOAD(0);
    for (int c = 0; c < nc; ++c) {
      {
        float lfv[8], qv[8];
#pragma unroll
        for (int i = 0; i < 8; ++i) { lfv[i] = (float)lfraw[i]; qv[i] = bf2f(qraw[i]); }
        const uint4 vv = vraw;
        if (c + 1 < nc) GLA_LOAD(c + 1);
        float run = 0;
        float cs[8];
#pragma unroll
        for (int i = 0; i < 8; ++i) { run += lfv[i]; cs[i] = run; }
        s_part[th * 128 + kk] = run;
        {
          const int s = tid & 31, v8 = (tid >> 5) * 8;
          const unsigned vw[4] = {vv.x, vv.y, vv.z, vv.w};
#pragma unroll
          for (int i = 0; i < 4; ++i) { s_vT[(v8 + 2 * i) * 40 + s] = (u16)(vw[i] & 0xffff); s_vT[(v8 + 2 * i + 1) * 40 + s] = (u16)(vw[i] >> 16); }
        }
        __syncthreads();
        const float p0 = s_part[kk], p1 = s_part[128 + kk], p2 = s_part[256 + kk], p3 = s_part[384 + kk];
        const float off = (th > 0 ? p0 : 0.f) + (th > 1 ? p1 : 0.f) + (th > 2 ? p2 : 0.f);
        const float ref = p0 + p1, total = p0 + p1 + p2 + p3;
        unsigned kd[4];
        const float eref = __builtin_amdgcn_exp2f(ref), etr = __builtin_amdgcn_exp2f(total - ref);
#pragma unroll
        for (int i = 0; i < 8; ++i) {
          const int t = th * 8 + i;
          const float cum = off + cs[i];
          const float kf = 1.0f - __builtin_amdgcn_exp2f(lfv[i]);
          const float e1 = __builtin_amdgcn_exp2f(cum - ref), e2 = __builtin_amdgcn_rcpf(e1);
          const float qe = qv[i] * e1, ke = kf * e2;
          s_qrel[t * 136 + kk] = f2bf(qe);
          s_krel[t * 136 + kk] = f2bf(ke);
          s_qcum[t * 136 + kk] = f2bf(qe * eref);
          const u16 kdv = f2bf(ke * etr);
          if (i & 1) kd[i >> 1] |= ((unsigned)kdv) << 16; else kd[i >> 1] = kdv;
        }
        *(uint4*)&s_kdT[kk * 40 + th * 8] = make_uint4(kd[0], kd[1], kd[2], kd[3]);
        if (th == 0) s_dec[kk] = eref * etr;
      }
      __syncthreads();
      f32x4 oacc[2] = {f32x4{0.f, 0.f, 0.f, 0.f}, f32x4{0.f, 0.f, 0.f, 0.f}};
      {
        f32x4 att = f32x4{0.f, 0.f, 0.f, 0.f};
        const int ati = w >> 1, asi = w & 1;
#pragma unroll
        for (int ks = 0; ks < 4; ++ks) {
          if (w < 4) {
            bf16x8 a = *(const bf16x8*)&s_qrel[(ati * 16 + fr) * 136 + ks * 32 + fq * 8];
            bf16x8 bb = *(const bf16x8*)&s_krel[(asi * 16 + fr) * 136 + ks * 32 + fq * 8];
            att = __builtin_amdgcn_mfma_f32_16x16x32_bf16(a, bb, att, 0, 0, 0);
          }
          bf16x8 a2 = *(const bf16x8*)&s_qcum[(ti * 16 + fr) * 136 + ks * 32 + fq * 8];
#pragma unroll
          for (int e = 0; e < 2; ++e) {
            bf16x8 b2 = *(const bf16x8*)&s_S[((vi * 2 + e) * 16 + fr) * 136 + ks * 32 + fq * 8];
            oacc[e] = __builtin_amdgcn_mfma_f32_16x16x32_bf16(b2, a2, oacc[e], 0, 0, 0);
          }
        }
        if (w < 4) {
#pragma unroll
          for (int j = 0; j < 4; ++j) {
            const int t = ati * 16 + fq * 4 + j, s = asi * 16 + fr;
            s_att[t * 40 + s] = (s <= t) ? f2bf(att[j]) : (u16)0;
          }
        }
      }
      __syncthreads();
      {
        bf16x8 a = *(const bf16x8*)&s_att[(ti * 16 + fr) * 40 + fq * 8];
        const int tt = c * 32 + ti * 16 + fr;
        const size_t tok = start + (d ? (N - 1 - tt) : tt);
#pragma unroll
        for (int e = 0; e < 2; ++e) {
          bf16x8 bb = *(const bf16x8*)&s_vT[((vi * 2 + e) * 16 + fr) * 40 + fq * 8];
          oacc[e] = __builtin_amdgcn_mfma_f32_16x16x32_bf16(bb, a, oacc[e], 0, 0, 0);
          *(uint2*)&og[((size_t)d * TOK + tok) * 1024 + h * 128 + (vi * 2 + e) * 16 + fq * 4] = pack4(oacc[e][0], oacc[e][1], oacc[e][2], oacc[e][3]);
        }
        bf16x8 vf[4];
#pragma unroll
        for (int ni = 0; ni < 4; ++ni) vf[ni] = *(const bf16x8*)&s_vT[(wv * 64 + ni * 16 + fr) * 40 + fq * 8];
#pragma unroll
        for (int mi = 0; mi < 2; ++mi) {
          bf16x8 kf = *(const bf16x8*)&s_kdT[(wk * 32 + mi * 16 + fr) * 40 + fq * 8];
          f32x4 dc = *(const f32x4*)&s_dec[wk * 32 + mi * 16 + fq * 4];
#pragma unroll
          for (int ni = 0; ni < 4; ++ni) {
            f32x4 s4 = S[mi][ni];
#pragma unroll
            for (int j = 0; j < 4; ++j) s4[j] *= dc[j];
            s4 = __builtin_amdgcn_mfma_f32_16x16x32_bf16(kf, vf[ni], s4, 0, 0, 0);
            S[mi][ni] = s4;
            *(uint2*)&s_S[(wv * 64 + ni * 16 + fr) * 136 + wk * 32 + mi * 16 + fq * 4] = pack4(s4[0], s4[1], s4[2], s4[3]);
          }
        }
      }
      __syncthreads();
    }
    if (!sample) {
      float* so = p.out + OUT_HG + ((size_t)((b * 2 + d) * 8 + h)) * 16384;
#pragma unroll
      for (int mi = 0; mi < 2; ++mi)
#pragma unroll
        for (int ni = 0; ni < 4; ++ni)
#pragma unroll
          for (int j = 0; j < 4; ++j) __builtin_nontemporal_store(S[mi][ni][j], &so[(wk * 32 + mi * 16 + fq * 4 + j) * 128 + wv * 64 + ni * 16 + fr]);
    }
  }
#undef GLA_LOAD
}

__device__ __forceinline__ void phase_hg_post(const Params& p, int bid, int nb) {
  const u16* og = (const u16*)(p.ws + WS_B(5));
  const u16* sg = (const u16*)(p.ws + WS_B(2));
  u16* a = (u16*)(p.ws + WS_B(0));
  const float* ng = p.in[14];
  const int lane = threadIdx.x & 63, wave = threadIdx.x >> 6;
  float ngv[16];
#pragma unroll
  for (int k = 0; k < 4; ++k) { const f32x4 t = *(const f32x4*)&ng[lane * 16 + 4 * k]; ngv[4 * k] = t[0]; ngv[4 * k + 1] = t[1]; ngv[4 * k + 2] = t[2]; ngv[4 * k + 3] = t[3]; }
  for (int row0 = (bid * NW + wave) * 2; row0 < TOK; row0 += nb * NW * 2) {
    uint4 f[2][2], bw[2][2], sv[2][2];
#pragma unroll
    for (int r = 0; r < 2; ++r)
#pragma unroll
      for (int hh = 0; hh < 2; ++hh) {
        const size_t base = (size_t)(row0 + r) * 1024 + lane * 16 + hh * 8;
        f[r][hh] = ldnt4(&og[base]);
        bw[r][hh] = ldnt4(&og[(size_t)TOK * 1024 + base]);
        sv[r][hh] = ldnt4(&sg[base]);
      }
#pragma unroll
    for (int r = 0; r < 2; ++r) {
      float o[16];
      float ss = 0;
#pragma unroll
      for (int hh = 0; hh < 2; ++hh) {
        const unsigned fa[4] = {f[r][hh].x, f[r][hh].y, f[r][hh].z, f[r][hh].w}, ba[4] = {bw[r][hh].x, bw[r][hh].y, bw[r][hh].z, bw[r][hh].w};
#pragma unroll
        for (int i = 0; i < 4; ++i) {
          o[hh * 8 + 2 * i] = lo16(fa[i]) + lo16(ba[i]);
          o[hh * 8 + 2 * i + 1] = hi16(fa[i]) + hi16(ba[i]);
        }
      }
#pragma unroll
      for (int i = 0; i < 16; ++i) ss += o[i] * o[i];
      ss += __shfl_xor(ss, 1); ss += __shfl_xor(ss, 2); ss += __shfl_xor(ss, 4);
      const float rs = rsqrtf(ss * (1.0f / 128.0f) + 1e-6f);
#pragma unroll
      for (int hh = 0; hh < 2; ++hh) {
        const unsigned sa[4] = {sv[r][hh].x, sv[r][hh].y, sv[r][hh].z, sv[r][hh].w};
        unsigned rr[4];
#pragma unroll
        for (int i = 0; i < 4; ++i)
          rr[i] = pack2(o[hh * 8 + 2 * i] * rs * ngv[hh * 8 + 2 * i] * siluf_(lo16(sa[i])), o[hh * 8 + 2 * i + 1] * rs * ngv[hh * 8 + 2 * i + 1] * siluf_(hi16(sa[i])));
        *(uint4*)&a[(size_t)(row0 + r) * 1024 + lane * 16 + hh * 8] = make_uint4(rr[0], rr[1], rr[2], rr[3]);
      }
    }
  }
}

__device__ __forceinline__ void seq_pos(int tok, int& n, int& L) {
  if (tok < NPROMPT) { n = tok & 255; L = 256; } else { n = (tok - NPROMPT) & 1023; L = 1024; }
}
__device__ __forceinline__ void phase_sc_conv(const Params& p, int bid, int nb) {
  const u16* pb = (const u16*)(p.ws + WS_B(0));
  const u16* sb = (const u16*)(p.ws + WS_B(1));
  u16* a = (u16*)(p.ws + WS_B(2));
  const float* cw = p.in[17]; const float* cbias = p.in[18];
  const size_t total = (size_t)TOK * 128;
  const size_t i0 = (size_t)bid * NT + threadIdx.x;
  const int c = ((int)i0 & 127) * 8;
  float w0[8], w1[8], w2[8], wb[8];
#pragma unroll
  for (int k = 0; k < 2; ++k) {
    const f32x4 t0 = *(const f32x4*)&cw[c + 4 * k], t1 = *(const f32x4*)&cw[1024 + c + 4 * k], t2 = *(const f32x4*)&cw[2048 + c + 4 * k], tb = *(const f32x4*)&cbias[c + 4 * k];
#pragma unroll
    for (int j = 0; j < 4; ++j) { w0[4 * k + j] = t0[j]; w1[4 * k + j] = t1[j]; w2[4 * k + j] = t2[j]; wb[4 * k + j] = tb[j]; }
  }
  const uint4 z = make_uint4(0, 0, 0, 0);
  for (size_t i = i0; i < total / 4; i += (size_t)nb * NT) {
    const int tok = (int)(i >> 7) * 4;
    int n, L; seq_pos(tok, n, L);
    const size_t base = (size_t)tok * 1024 + c;
    uint4 q[6], sv[4];
    q[0] = n > 0 ? *(const uint4*)&pb[base - 1024] : z;
#pragma unroll
    for (int t = 0; t < 4; ++t) { q[1 + t] = *(const uint4*)&pb[base + t * 1024]; sv[t] = *(const uint4*)&sb[base + t * 1024]; }
    q[5] = n + 4 < L ? *(const uint4*)&pb[base + 4096] : z;
#pragma unroll
    for (int t = 0; t < 4; ++t) {
      const unsigned am[4] = {q[t].x, q[t].y, q[t].z, q[t].w}, a0[4] = {q[t + 1].x, q[t + 1].y, q[t + 1].z, q[t + 1].w};
      const unsigned ap[4] = {q[t + 2].x, q[t + 2].y, q[t + 2].z, q[t + 2].w}, as[4] = {sv[t].x, sv[t].y, sv[t].z, sv[t].w};
      unsigned r[4];
#pragma unroll
      for (int k = 0; k < 4; ++k) {
        float z0 = w0[2 * k] * lo16(am[k]) + w1[2 * k] * lo16(a0[k]) + w2[2 * k] * lo16(ap[k]) + wb[2 * k];
        float z1 = w0[2 * k + 1] * hi16(am[k]) + w1[2 * k + 1] * hi16(a0[k]) + w2[2 * k + 1] * hi16(ap[k]) + wb[2 * k + 1];
        r[k] = pack2(lo16(as[k]) * z0, hi16(as[k]) * z1);
      }
      *(uint4*)&a[base + t * 1024] = make_uint4(r[0], r[1], r[2], r[3]);
    }
  }
}
__device__ __forceinline__ void phase_rg_conv(const Params& p, int bid, int nb) {
  const u16* ub = (const u16*)(p.ws + WS_B(0));
  u16* uc = (u16*)(p.ws + WS_B(2));
  const float* cw = p.in[21]; const float* cbias = p.in[22];
  const size_t total = (size_t)TOK * 128;
  const size_t i0 = (size_t)bid * NT + threadIdx.x;
  const int c = ((int)i0 & 127) * 8;
  float w0[8], w1[8], w2[8], w3[8], wb[8];
#pragma unroll
  for (int k = 0; k < 2; ++k) {
    const f32x4 t0 = *(const f32x4*)&cw[c + 4 * k], t1 = *(const f32x4*)&cw[1024 + c + 4 * k], t2 = *(const f32x4*)&cw[2048 + c + 4 * k], t3 = *(const f32x4*)&cw[3072 + c + 4 * k], tb = *(const f32x4*)&cbias[c + 4 * k];
#pragma unroll
    for (int j = 0; j < 4; ++j) { w0[4 * k + j] = t0[j]; w1[4 * k + j] = t1[j]; w2[4 * k + j] = t2[j]; w3[4 * k + j] = t3[j]; wb[4 * k + j] = tb[j]; }
  }
  const uint4 z = make_uint4(0, 0, 0, 0);
  for (size_t i = i0; i < total / 4; i += (size_t)nb * NT) {
    const int tok = (int)(i >> 7) * 4;
    int n, L; seq_pos(tok, n, L);
    const size_t base = (size_t)tok * 1024 + c;
    uint4 q[7];
    q[0] = n > 1 ? *(const uint4*)&ub[base - 2048] : z;
    q[1] = n > 0 ? *(const uint4*)&ub[base - 1024] : z;
#pragma unroll
    for (int t = 0; t < 4; ++t) q[2 + t] = *(const uint4*)&ub[base + t * 1024];
    q[6] = n + 4 < L ? *(const uint4*)&ub[base + 4096] : z;
#pragma unroll
    for (int t = 0; t < 4; ++t) {
      const unsigned a0[4] = {q[t].x, q[t].y, q[t].z, q[t].w}, a1[4] = {q[t + 1].x, q[t + 1].y, q[t + 1].z, q[t + 1].w};
      const unsigned a2[4] = {q[t + 2].x, q[t + 2].y, q[t + 2].z, q[t + 2].w}, a3[4] = {q[t + 3].x, q[t + 3].y, q[t + 3].z, q[t + 3].w};
      unsigned r[4];
#pragma unroll
      for (int k = 0; k < 4; ++k) {
        float z0 = w0[2 * k] * lo16(a0[k]) + w1[2 * k] * lo16(a1[k]) + w2[2 * k] * lo16(a2[k]) + w3[2 * k] * lo16(a3[k]) + wb[2 * k];
        float z1 = w0[2 * k + 1] * hi16(a0[k]) + w1[2 * k + 1] * hi16(a1[k]) + w2[2 * k + 1] * hi16(a2[k]) + w3[2 * k + 1] * hi16(a3[k]) + wb[2 * k + 1];
        r[k] = pack2(z0, z1);
      }
      *(uint4*)&uc[((size_t)(c >> 6) * TOK + tok + t) * 64 + (c & 63)] = make_uint4(r[0], r[1], r[2], r[3]);
    }
  }
}

__device__ __forceinline__ void phase_rg_scan(const Params& p, unsigned char* smem_raw, int bid, int nb) {
  float* sA = (float*)smem_raw;
  float* sB = sA + 2048;
  const u16* rb = (const u16*)(p.ws + WS_B(3));
  const u16* ib = (const u16*)(p.ws + WS_B(5));
  const u16* uc = (const u16*)(p.ws + WS_B(2));
  const u16* sg = (const u16*)(p.ws + WS_B(1));
  u16* hfw = (u16*)(p.ws + WS_H);
  u16* yp = (u16*)(p.ws + WS_B(0));
  const int tid = threadIdx.x;
  for (int u = bid; u < 768; u += nb) {
    int sample, b, c, seg, nseg, start, chs, slot;
    if (u < 256) {
      const int xq = u & 7, yq = u >> 3, gid = (yq >> 2) * 8 + xq, sub = yq & 3;
      sample = 1; b = gid >> 4; slot = (tid & 3) * 4; c = (gid & 15) * 64 + sub * 16 + slot; seg = tid >> 2; nseg = 128; start = NPROMPT + b * 1024; chs = 16; }
    else { sample = 0; b = (u - 256) >> 4; slot = (tid & 15) * 4; c = ((u - 256) & 15) * 64 + slot; seg = tid >> 4; nseg = 32; start = b * 256; chs = 64; }
    const int L = nseg * 8;
#pragma unroll 1
    for (int d = 0; d < 2; ++d) {
      const f32x4 lam = *(const f32x4*)&p.in[25][d * 1024 + c];
      float cl[4];
#pragma unroll
      for (int j = 0; j < 4; ++j) cl[j] = 8.0f * 1.4426950408889634f * log1pf(__expf(-lam[j]))    ;
      const u16* rp = rb + (size_t)d * TOK * 1024;
      const u16* ip = ib + (size_t)d * TOK * 1024;
      const int tok0 = start + (d ? L - 1 - seg * 8 : seg * 8);
      const size_t o0 = (size_t)tok0 * 1024 + c;
      const long ostep = d ? -1024 : 1024;
      const size_t g0 = ((size_t)(c >> 6) * TOK + tok0) * 64 + (c & 63);
      const long gstep = d ? -64 : 64;
      uint2 rr[8], ii[8], uu[8];
#pragma unroll
      for (int s8 = 0; s8 < 8; ++s8) { rr[s8] = ldnt2(&rp[g0 + s8 * gstep]); ii[s8] = ldnt2(&ip[g0 + s8 * gstep]); uu[s8] = *(const uint2*)&uc[g0 + s8 * gstep]; }
      uint2 hf[8], sgv[8];
      if (d == 1) {
#pragma unroll
        for (int s8 = 0; s8 < 8; ++s8) { hf[s8] = *(const uint2*)&hfw[g0 + s8 * gstep]; sgv[s8] = *(const uint2*)&sg[g0 + s8 * gstep]; }
      }
      float av[8][4], xv[8][4];
      float A[4] = {1.f, 1.f, 1.f, 1.f}, B[4] = {0.f, 0.f, 0.f, 0.f};
#pragma unroll
      for (int s8 = 0; s8 < 8; ++s8) {
        const float r4[4] = {lo16(rr[s8].x), hi16(rr[s8].x), lo16(rr[s8].y), hi16(rr[s8].y)};
        const float i4[4] = {lo16(ii[s8].x), hi16(ii[s8].x), lo16(ii[s8].y), hi16(ii[s8].y)};
        const float u4[4] = {lo16(uu[s8].x), hi16(uu[s8].x), lo16(uu[s8].y), hi16(uu[s8].y)};
#pragma unroll
        for (int j = 0; j < 4; ++j) {
          const float la = -cl[j] * r4[j];
          const float a = __builtin_amdgcn_exp2f(la);
          const float xin = __builtin_amdgcn_sqrtf(fmaxf(1.0f - __builtin_amdgcn_exp2f(2.0f * la), 0.f)) * (i4[j] * u4[j]);
          av[s8][j] = a; xv[s8][j] = xin;
          A[j] *= a; B[j] = a * B[j] + xin;
        }
      }
      const int lane = tid & 63, wv_ = tid >> 6;
      const int shstep = chs >> 2;
      const int nsw = 64 / shstep;
      const int segl = lane / shstep, qd = lane & (shstep - 1);
      for (int k = 1; k < nsw; k <<= 1) {
        float pa[4], pb2[4];
#pragma unroll
        for (int j = 0; j < 4; ++j) { pa[j] = __shfl_up(A[j], k * shstep); pb2[j] = __shfl_up(B[j], k * shstep); }
        if (segl >= k) {
#pragma unroll
          for (int j = 0; j < 4; ++j) { B[j] = A[j] * pb2[j] + B[j]; A[j] = A[j] * pa[j]; }
        }
      }
      float EA[4], EB[4];
#pragma unroll
      for (int j = 0; j < 4; ++j) { EA[j] = __shfl_up(A[j], shstep); EB[j] = __shfl_up(B[j], shstep); }
      if (segl == nsw - 1) {
        *(f32x4*)&sA[(wv_ * 16 + qd) * 4] = f32x4{A[0], A[1], A[2], A[3]};
        *(f32x4*)&sB[(wv_ * 16 + qd) * 4] = f32x4{B[0], B[1], B[2], B[3]};
      }
      __syncthreads();
      float h[4];
      {
        f32x4 h0v = f32x4{0.f, 0.f, 0.f, 0.f};
        if (sample) h0v = *(const f32x4*)&p.in[3][(b * 2 + d) * 1024 + c];
#pragma unroll
        for (int j = 0; j < 4; ++j) h[j] = h0v[j];
        for (int w2 = 0; w2 < wv_; ++w2) {
          const f32x4 ta = *(const f32x4*)&sA[(w2 * 16 + qd) * 4], tb = *(const f32x4*)&sB[(w2 * 16 + qd) * 4];
#pragma unroll
          for (int j = 0; j < 4; ++j) h[j] = ta[j] * h[j] + tb[j];
        }
        if (segl > 0) {
#pragma unroll
          for (int j = 0; j < 4; ++j) h[j] = EA[j] * h[j] + EB[j];
        }
      }
#pragma unroll
      for (int s8 = 0; s8 < 8; ++s8) {
#pragma unroll
        for (int j = 0; j < 4; ++j) h[j] = av[s8][j] * h[j] + xv[s8][j];
        const size_t o = o0 + s8 * ostep;
        if (d == 0) *(uint2*)&hfw[g0 + s8 * gstep] = pack4(h[0], h[1], h[2], h[3]);
        else *(uint2*)&yp[g0 + s8 * gstep] = pack4((lo16(hf[s8].x) + h[0]) * lo16(sgv[s8].x), (hi16(hf[s8].x) + h[1]) * hi16(sgv[s8].x),
                                     (lo16(hf[s8].y) + h[2]) * lo16(sgv[s8].y), (hi16(hf[s8].y) + h[3]) * hi16(sgv[s8].y));
      }
      if (!sample && seg == nseg - 1) *(f32x4*)&p.out[OUT_RG + (b * 2 + d) * 1024 + c] = f32x4{h[0], h[1], h[2], h[3]};
      __syncthreads();
    }
  }
}

__device__ __forceinline__ void phase_mla_norm(const Params& p, int bid, int nb) {
  u16* cq = (u16*)(p.ws + WS3_CQ);
  u16* ckvall = (u16*)(p.ws + WS3_CKVALL);
  const float* ckvraw = (const float*)(p.ws + WS3_CKVRAW);
  const float* kperaw = (const float*)(p.ws + WS3_KPERAW);
  u16* Kb = (u16*)(p.ws + WS3_K);
  const float* qn = p.in[28]; const float* kvn = p.in[29];
  const int lane = threadIdx.x & 63, wave = threadIdx.x >> 6;
  float qnv[6];
#pragma unroll
  for (int i = 0; i < 3; ++i) { qnv[2 * i] = qn[(i * 64 + lane) * 2]; qnv[2 * i + 1] = qn[(i * 64 + lane) * 2 + 1]; }
  const f32x4 g4 = *(const f32x4*)&kvn[lane * 4];
  unsigned cvn[3] = {0u, 0u, 0u}; f32x4 kvnx = f32x4{0.f, 0.f, 0.f, 0.f}; float vnx = 0.f;
  {
    const int r0 = bid * NW + wave;
    if (r0 < TOK) {
#pragma unroll
      for (int i = 0; i < 3; ++i) cvn[i] = ((const unsigned*)&cq[(size_t)r0 * 384])[i * 64 + lane];
      kvnx = __builtin_nontemporal_load((const f32x4*)&ckvraw[(size_t)r0 * 256 + lane * 4]); vnx = kperaw[(size_t)r0 * 32 + (lane & 31)];
    }
  }
  for (int row = bid * NW + wave; row < TOK + 2048; row += nb * NW) {
    if (row < TOK) {
      const int tok = row;
      const bool sample = tok >= NPROMPT;
      unsigned cv[3] = {cvn[0], cvn[1], cvn[2]}; const f32x4 kv = kvnx; float v = vnx;
      {
        const int rn = row + nb * NW;
        if (rn < TOK) {
#pragma unroll
          for (int i = 0; i < 3; ++i) cvn[i] = ((const unsigned*)&cq[(size_t)rn * 384])[i * 64 + lane];
          kvnx = __builtin_nontemporal_load((const f32x4*)&ckvraw[(size_t)rn * 256 + lane * 4]); vnx = kperaw[(size_t)rn * 32 + (lane & 31)];
        }
      }
      const int bs = (tok - NPROMPT) >> 10, n = (tok - NPROMPT) & 1023;
      const size_t kvrow = sample ? (size_t)(NPROMPT + bs * 1536 + 512 + n) : (size_t)tok;
      unsigned* cqr = (unsigned*)&cq[(size_t)tok * 384];
      float ss = 0;
#pragma unroll
      for (int i = 0; i < 3; ++i) { float a = lo16(cv[i]), b2 = hi16(cv[i]); ss += a * a + b2 * b2; }
      const float rsq = rsqrtf(wave_sum(ss) * (1.0f / 384.0f) + 1e-6f);
#pragma unroll
      for (int i = 0; i < 3; ++i) {
        cqr[i * 64 + lane] = pack2(lo16(cv[i]) * rsq * qnv[2 * i], hi16(cv[i]) * rsq * qnv[2 * i + 1]);
      }
      const float rsk = rsqrtf(wave_sum(kv[0] * kv[0] + kv[1] * kv[1] + kv[2] * kv[2] + kv[3] * kv[3]) * (1.0f / 256.0f) + 1e-6f);
      f32x4 o4;
#pragma unroll
      for (int j = 0; j < 4; ++j) o4[j] = kv[j] * rsk * g4[j];
      *(uint2*)&ckvall[kvrow * 256 + lane * 4] = pack4(o4[0], o4[1], o4[2], o4[3]);
      if (!sample) *(f32x4*)&p.out[OUT_CKV + (size_t)tok * 256 + lane * 4] = o4;
      if (!sample) { if (lane < 32) p.out[OUT_KPE + (size_t)tok * 32 + lane] = v; }
      else {
        const float partner = __shfl_xor(v, 8);
        const int i16 = lane & 15;
        const float pos = (lane & 16) ? (float)(n & 63) : (float)(n >> 6);
        float sn, cs; rope_sincos(pos, i16 & 7, sn, cs);
        v = (i16 < 8) ? (v * cs - partner * sn) : (partner * sn + v * cs);
      }
      const u16 vb = f2bf(v);
#pragma unroll
      for (int i = 0; i < 8; ++i) Kb[(kvrow * 16 + (lane >> 5) + 2 * i) * 96 + 64 + (lane & 31)] = vb;
    } else {
      const int r = row - TOK, bs = r >> 9, j = r & 511;
      const size_t kvrow = (size_t)(NPROMPT + bs * 1536 + j);
      f32x4 kv = *(const f32x4*)&p.in[4][(size_t)r * 256 + lane * 4];
      *(uint2*)&ckvall[kvrow * 256 + lane * 4] = pack4(kv[0], kv[1], kv[2], kv[3]);
      const u16 vb = f2bf(p.in[5][(size_t)r * 32 + (lane & 31)]);
#pragma unroll
      for (int i = 0; i < 8; ++i) Kb[(kvrow * 16 + (lane >> 5) + 2 * i) * 96 + 64 + (lane & 31)] = vb;
    }
  }
}

__device__ __forceinline__ void phase_attn(const Params& p, unsigned char* smem_raw, int bid, int nb) {
  u16* sK = (u16*)smem_raw;
  u16* sV = sK + 128 * 104;
  const u16* qg = (const u16*)(p.ws + WS3_Q);
  const u16* Kg = (const u16*)(p.ws + WS3_K);
  const u16* Vg = (const u16*)(p.ws + WS3_VT);
  const u16* sg = (const u16*)(p.ws + WS3_SG);
  u16* ao = (u16*)(p.ws + WS_H);
  const int tid = threadIdx.x, lane = tid & 63, w = tid >> 6, fr = lane & 15, fq = lane >> 4;
  for (int u = bid; u < 1536; u += nb) {
    int tok0, kvbase, nkeys, h;
    if (u < 512) { const int b = u >> 7, r = u & 127; h = r >> 3; const int qb = r & 7; tok0 = NPROMPT + b * 1024 + qb * 128; kvbase = NPROMPT + b * 1536; nkeys = 1536; }
    else { const int uu = u - 512; const int b = uu >> 5, r = uu & 31; h = r >> 1; const int qb = r & 1; tok0 = b * 256 + qb * 128; kvbase = b * 256; nkeys = 256; }
    const int tokq = tok0 + w * 16 + fr;
    bf16x8 qf[3];
#pragma unroll
    for (int ks = 0; ks < 3; ++ks) qf[ks] = *(const bf16x8*)&qg[(size_t)tokq * 1536 + h * 96 + ks * 32 + fq * 8];
    if (u < 512) {
      const int npos = (tokq - NPROMPT) & 1023;
      const float pos = (fq & 2) ? (float)(npos & 63) : (float)(npos >> 6);
      uint4 raw = *(uint4*)&qf[2];
      unsigned rw[4] = {raw.x, raw.y, raw.z, raw.w};
#pragma unroll
      for (int i = 0; i < 4; ++i) {
        float v0 = lo16(rw[i]), v1 = hi16(rw[i]);
        const float p0 = __shfl_xor(v0, 16), p1 = __shfl_xor(v1, 16);
        float sn0, cs0, sn1, cs1;
        rope_sincos(pos, 2 * i, sn0, cs0); rope_sincos(pos, 2 * i + 1, sn1, cs1);
        v0 = (fq & 1) ? (p0 * sn0 + v0 * cs0) : (v0 * cs0 - p0 * sn0);
        v1 = (fq & 1) ? (p1 * sn1 + v1 * cs1) : (v1 * cs1 - p1 * sn1);
        rw[i] = pack2(v0, v1);
      }
      raw = make_uint4(rw[0], rw[1], rw[2], rw[3]);
      qf[2] = *(bf16x8*)&raw;
    }
    float m = -1e30f, l = 0.f;
    f32x4 oacc[4];
#pragma unroll
    for (int i = 0; i < 4; ++i) oacc[i] = f32x4{0.f, 0.f, 0.f, 0.f};
    const int kk0 = tid / 12, kc0 = tid - kk0 * 12;
    const int kk1 = (tid + NT) / 12, kc1 = (tid + NT) - kk1 * 12;
    const int kk2_ = (tid + 2 * NT) / 12, kc2 = (tid + 2 * NT) - kk2_ * 12;
    const u16* Kp0 = &Kg[((size_t)(kvbase + kk0) * 16 + h) * 96 + kc0 * 8];
    const u16* Kp1 = &Kg[((size_t)(kvbase + kk1) * 16 + h) * 96 + kc1 * 8];
    const u16* Kp2 = &Kg[((size_t)(kvbase + kk2_) * 16 + h) * 96 + kc2 * 8];
    const int vd0 = tid >> 4, vc0 = tid & 15, vd1 = (tid + NT) >> 4;
    const u16* Vp0 = &Vg[(size_t)(h * 64 + vd0) * KVROWS + kvbase + vc0 * 8];
    const u16* Vp1 = &Vg[(size_t)(h * 64 + vd1) * KVROWS + kvbase + vc0 * 8];
    uint4 kr0 = *(const uint4*)Kp0, kr1 = *(const uint4*)Kp1, kr2 = *(const uint4*)Kp2, vr0 = *(const uint4*)Vp0, vr1 = *(const uint4*)Vp1;
    const int ntile2 = nkeys >> 7;
    for (int kt = 0; kt < ntile2; ++kt) {
      __syncthreads();
      *(uint4*)&sK[kk0 * 104 + kc0 * 8] = kr0; *(uint4*)&sK[kk1 * 104 + kc1 * 8] = kr1; *(uint4*)&sK[kk2_ * 104 + kc2 * 8] = kr2;
      *(uint4*)&sV[vd0 * 136 + vc0 * 8] = vr0; *(uint4*)&sV[vd1 * 136 + vc0 * 8] = vr1;
      if (kt + 1 < ntile2) {
        const size_t ko = (size_t)(kt + 1) * 128 * 1536; const int vo = (kt + 1) * 128;
        kr0 = *(const uint4*)(Kp0 + ko); kr1 = *(const uint4*)(Kp1 + ko); kr2 = *(const uint4*)(Kp2 + ko);
        vr0 = *(const uint4*)(Vp0 + vo); vr1 = *(const uint4*)(Vp1 + vo);
      }
      __syncthreads();
      f32x4 sacc[8];
#pragma unroll
      for (int ni = 0; ni < 8; ++ni) {
        sacc[ni] = f32x4{0.f, 0.f, 0.f, 0.f};
#pragma unroll
        for (int ks = 0; ks < 3; ++ks) {
          bf16x8 kf = *(const bf16x8*)&sK[(ni * 16 + fr) * 104 + ks * 32 + fq * 8];
          sacc[ni] = __builtin_amdgcn_mfma_f32_16x16x32_bf16(kf, qf[ks], sacc[ni], 0, 0, 0);
        }
      }
      float mx = -1e30f;
#pragma unroll
      for (int ni = 0; ni < 8; ++ni)
#pragma unroll
        for (int j = 0; j < 4; ++j) mx = fmaxf(mx, sacc[ni][j]);
      mx = fmaxf(mx, __shfl_xor(mx, 16));
      mx = fmaxf(mx, __shfl_xor(mx, 32));
      const float mnew = fmaxf(m, mx);
      const float alpha = __builtin_amdgcn_exp2f(m - mnew);
      m = mnew;
      float ls = 0.f;
#pragma unroll
      for (int ni = 0; ni < 8; ++ni)
#pragma unroll
        for (int j = 0; j < 4; ++j) { float e = __builtin_amdgcn_exp2f(sacc[ni][j] - mnew); sacc[ni][j] = e; ls += e; }
      l = l * alpha + ls;
      bf16x8 pf[4];
#pragma unroll
      for (int kk2 = 0; kk2 < 4; ++kk2) {
        uint2 lo = pack4(sacc[2 * kk2][0], sacc[2 * kk2][1], sacc[2 * kk2][2], sacc[2 * kk2][3]);
        uint2 hi = pack4(sacc[2 * kk2 + 1][0], sacc[2 * kk2 + 1][1], sacc[2 * kk2 + 1][2], sacc[2 * kk2 + 1][3]);
        uint4 pk = make_uint4(lo.x, lo.y, hi.x, hi.y);
        pf[kk2] = *(bf16x8*)&pk;
      }
#pragma unroll
      for (int di = 0; di < 4; ++di) {
#pragma unroll
        for (int j = 0; j < 4; ++j) oacc[di][j] *= alpha;
#pragma unroll
        for (int kk2 = 0; kk2 < 4; ++kk2) {
          uint2 v0 = *(const uint2*)&sV[(di * 16 + fr) * 136 + kk2 * 32 + fq * 4];
          uint2 v1 = *(const uint2*)&sV[(di * 16 + fr) * 136 + kk2 * 32 + 16 + fq * 4];
          uint4 vk = make_uint4(v0.x, v0.y, v1.x, v1.y);
          oacc[di] = __builtin_amdgcn_mfma_f32_16x16x32_bf16(*(bf16x8*)&vk, pf[kk2], oacc[di], 0, 0, 0);
        }
      }
    }
    l += __shfl_xor(l, 16);
    l += __shfl_xor(l, 32);
    const float inv = 1.0f / l;
#pragma unroll
    for (int di = 0; di < 4; ++di) {
      const size_t o = (size_t)tokq * 1024 + h * 64 + di * 16 + fq * 4;
      uint2 s = ldnt2(&sg[o]);
      *(uint2*)&ao[o] = pack4(oacc[di][0] * inv * siluf_(lo16(s.x)), oacc[di][1] * inv * siluf_(hi16(s.x)), oacc[di][2] * inv * siluf_(lo16(s.y)), oacc[di][3] * inv * siluf_(hi16(s.y)));
    }
  }
}

#define XB_TMO      128
#define XB_XCNT(j)  (256  + 64 * (j))
#define XB_XSUB(j)  (1280 + 64 * (j))
#define XB_XGEN(j)  (2304 + 64 * (j))
#define XB_TOP      3328
#define XB_TOPGEN   3392
#define XCD_BAR_WORDS 3456
#define XB_SPIN_CAP (1u << 22)
__device__ __forceinline__ unsigned xb_ld(unsigned* p)              { return __hip_atomic_load(p, __ATOMIC_RELAXED, __HIP_MEMORY_SCOPE_AGENT); }
__device__ __forceinline__ unsigned xb_add(unsigned* p, unsigned v) { return __hip_atomic_fetch_add(p, v, __ATOMIC_RELAXED, __HIP_MEMORY_SCOPE_AGENT); }
__device__ __forceinline__ unsigned xb_xcc_id() { return (unsigned)__builtin_amdgcn_s_getreg((3 << 11) | 20) & 0xFu; }
#define XB_SPIN(cond, bar) do { unsigned _sp = 0; while (cond) { __builtin_amdgcn_s_sleep(1); \
    if ((++_sp & 255u) == 0u) { if (xb_ld(&(bar)[XB_TMO])) break; if (_sp > XB_SPIN_CAP) { atomicAdd(&(bar)[XB_TMO], 1u); break; } } } } while (0)
struct XcdBarrier { unsigned* bar; unsigned x; volatile LAS unsigned* st; };
__device__ __forceinline__ XcdBarrier xcd_barrier_post(unsigned* bar, volatile LAS unsigned* st) {
  XcdBarrier b; b.bar = bar; b.x = xb_xcc_id(); b.st = st;
  if (threadIdx.x == 0) (void)xb_add(&bar[XB_XCNT(b.x)], 1u);
  return b;
}
__device__ __forceinline__ void xcd_barrier_complete(unsigned* bar, unsigned x, unsigned& nloc, unsigned& nx) {
  const unsigned G = gridDim.x * gridDim.y * gridDim.z;
  unsigned sum, cnt, mine, sp = 0u;
  for (;;) {
    sum = 0u; cnt = 0u; mine = 0u;
#pragma unroll
    for (unsigned j = 0; j < 16; ++j) { const unsigned c = xb_ld(&bar[XB_XCNT(j)]); sum += c; cnt += (c > 0u) ? 1u : 0u; mine = (j == x) ? c : mine; }
    if (sum == G) break;
    __builtin_amdgcn_s_sleep(1);
    if ((++sp & 255u) == 0u) { if (xb_ld(&bar[XB_TMO])) break; if (sp > XB_SPIN_CAP) { atomicAdd(&bar[XB_TMO], 1u); break; } }
  }
  nloc = mine > 0u ? mine : 1u; nx = cnt > 0u ? cnt : 1u;
}
__device__ __forceinline__ void xcd_barrier(const XcdBarrier& b) {
  asm volatile("s_waitcnt vmcnt(0)" ::: "memory");
  __syncthreads();
  if (threadIdx.x == 0) {
    unsigned* bar = b.bar;
    __builtin_amdgcn_s_waitcnt(0);
    unsigned nloc = b.st[0], nx = b.st[1];
    if (nloc == 0u) { xcd_barrier_complete(bar, b.x, nloc, nx); b.st[0] = nloc; b.st[1] = nx; }
    const unsigned old = xb_add(&bar[XB_XSUB(b.x)], 1u);
    const unsigned gen = old / nloc;
    if (old + 1u == (gen + 1u) * nloc) {
      __builtin_amdgcn_fence(__ATOMIC_RELEASE, "agent");
      asm volatile("s_waitcnt vmcnt(0)" ::: "memory");
      const unsigned og = xb_add(&bar[XB_TOP], 1u);
      const unsigned tg = og / nx;
      if (og + 1u == (tg + 1u) * nx) xb_add(&bar[XB_TOPGEN], 1u);
      else XB_SPIN(xb_ld(&bar[XB_TOPGEN]) == tg, bar);
      __builtin_amdgcn_fence(__ATOMIC_ACQUIRE, "agent");
      xb_add(&bar[XB_XGEN(b.x)], 1u);
      asm volatile("s_waitcnt vmcnt(0)" ::: "memory");
    } else {
      XB_SPIN(xb_ld(&bar[XB_XGEN(b.x)]) == gen, bar);
      __builtin_amdgcn_fence(__ATOMIC_ACQUIRE, "agent");
      asm volatile("s_waitcnt vmcnt(0)" ::: "memory");
    }
  }
  __syncthreads();
}

#define GEMM_LDS 131072
#define DYN_LDS (GEMM_LDS + 16)
#define WS_BAR (WS_CNT + 4096ull)

#define RUN_GEMM(Aptr, LDA, Bptr, MM, NN, KK, GATE, EPI, CID) RUN_GEMM_G(Aptr, LDA, Bptr, MM, NN, KK, GATE, EPI, nb, CID)
#define RUN_GEMM_G(Aptr, LDA, Bptr, MM, NN, KK, GATE, EPI, GG, CID) RUN_GEMM_X(Aptr, LDA, (size_t)128, (size_t)0, Bptr, MM, NN, KK, GATE, EPI, GG, CID)
#define GM_KSTEP ((size_t)TOK * 128)
#define RUN_GEMM_X(Aptr, LDA, KSA, GST, Bptr, MM, NN, KK, GATE, EPI, GG, CID) do { pg8::Gemm g_{(const u16*)(Aptr), (const u16*)(Bptr), MM, NN, KK, LDA, GATE, p.flags, KSA, GST}; \
    pg8::StaticOrder S_; S_.init(MM, NN, GG, CID); pg8::gemm_phase((LAS unsigned char*)smem_raw, g_, S_, EPI); } while (0)
#define RUN_GEMM_RX(Aptr, LDA, KSA, GST, Bptr, MM, NN, KK, GATE, EPI, GG, CID, UBEG, UEND) do { pg8::Gemm g_{(const u16*)(Aptr), (const u16*)(Bptr), MM, NN, KK, LDA, GATE, p.flags, KSA, GST}; \
    pg8::StaticOrder S_; S_.init(MM, NN, GG, CID); S_.ubeg = UBEG; S_.uend = UEND; pg8::gemm_phase((LAS unsigned char*)smem_raw, g_, S_, EPI); } while (0)
#define RUN_GEMM_R(Aptr, LDA, Bptr, MM, NN, KK, EPI, GG, CID, UBEG, UEND) do { pg8::Gemm g_{(const u16*)(Aptr), (const u16*)(Bptr), MM, NN, KK, LDA, 0, p.flags, (size_t)128, (size_t)0}; \
    pg8::StaticOrder S_; S_.init(MM, NN, GG, CID); S_.ubeg = UBEG; S_.uend = UEND; pg8::gemm_phase((LAS unsigned char*)smem_raw, g_, S_, EPI); } while (0)

__global__ void __launch_bounds__(NT, 2) mega(Params p) {
  extern __shared__ __attribute__((aligned(16))) unsigned char smem_raw[];
  const int bid = blockIdx.x, nb = gridDim.x;
  unsigned char* ws = p.ws;
  const float* mod = (const float*)(ws + WS_MOD);
  volatile LAS unsigned* xst = (volatile LAS unsigned*)((LAS unsigned char*)smem_raw + GEMM_LDS);
  XcdBarrier xb;
  if (p.phase_hi - p.phase_lo > 1) {
    if (threadIdx.x == 0) { xst[0] = 0u; xst[1] = 0u; }
    __syncthreads();
    xb = xcd_barrier_post((unsigned*)(ws + WS_BAR), xst);
  }
#define PH_BEGIN(n) if ((PHMASK & (1u << n)) && p.phase_lo <= n && n < p.phase_hi) { const int ph = n;
#define PH_FIN if (ph + 1 < p.phase_hi) { if (p.phase_lo < 0) cg::this_grid().sync(); else xcd_barrier(xb); } }
  PH_BEGIN(0) phase_prologue(p, smem_raw, bid, nb); PH_FIN
  PH_BEGIN(1) phase_h0(p, bid, nb); PH_FIN
  PH_BEGIN(2) {
    EpiHgIn e{(u16*)(ws + WS_B(0)), (u16*)(ws + WS_B(1)), (u16*)(ws + WS_B(2)), (_Float16*)(ws + WS_B(3)), (const float*)(ws + WS_LB)};
    RUN_GEMM(ws + WS_H, 1024, ws + WS_W_HG_IN, TOK, (nb == 256 ? 4096 : 5120), 1024, 0, e, bid);
  } PH_FIN
  PH_BEGIN(3) {
    phase_gla(p, smem_raw);
    if (nb == 256) {
      __syncthreads();
      EpiSg eg{(u16*)(ws + WS_B(2))};
      RUN_GEMM_R(ws + WS_H, 1024, ws + WS_W_HG_IN + (size_t)4096 * 1024 * 2, TOK, 1024, 1024, eg, 256, bid >= 64 ? bid - 64 : (1 << 20), 0, 192);
    }
  } PH_FIN
  PH_BEGIN(4) phase_hg_post(p, bid, nb); PH_FIN
  PH_BEGIN(5) {
    EpiResLn<false, true> e{p.in[0], p.in[1], (const u16*)nullptr, p.out, (u16*)(ws + WS_XB), mod + 0 * 15360 + 2048, p.in[10] + 0 * 1024, p.in[11] + 0 * 1024, mod + 1 * 15360, (u16*)(ws + WS_H),
               (unsigned long long*)(ws + WS_SLOT) + 0 * 49152, (unsigned*)(ws + WS_CNT + 256) + 0 * 48};
    RUN_GEMM(ws + WS_B(0), 1024, ws + WS_W_HG_OUT, TOK, 1024, 1024, 0, e, bid);
    wconv_idle(p, smem_raw, bid, nb, 1536, 2816);
  } PH_FIN
  PH_BEGIN(7) {
    EpiScIn e{(u16*)(ws + WS_B(0)), (u16*)(ws + WS_B(1))};
    RUN_GEMM(ws + WS_H, 1024, ws + WS_W_SC_IN, TOK, 4096, 1024, 0, e, bid);
  } PH_FIN
  PH_BEGIN(8) phase_sc_conv(p, bid, nb); PH_FIN
  PH_BEGIN(9) {
    EpiResLn<true, true> e{p.out, p.out, (const u16*)(ws + WS_XB), p.out, (u16*)(ws + WS_XB), mod + 1 * 15360 + 2048, p.in[10] + 1 * 1024, p.in[11] + 1 * 1024, mod + 2 * 15360, (u16*)(ws + WS_H),
               (unsigned long long*)(ws + WS_SLOT) + 1 * 49152, (unsigned*)(ws + WS_CNT + 256) + 1 * 48};
    RUN_GEMM(ws + WS_B(2), 1024, ws + WS_W_SC_OUT, TOK, 1024, 1024, 0, e, bid);
    wconv_idle(p, smem_raw, bid, nb, 2816, 3840);
  } PH_FIN
  PH_BEGIN(11) {
    EpiRgIn e{(u16*)(ws + WS_B(0)), (u16*)(ws + WS_B(1))};
    if (nb == 256) {
      RUN_GEMM(ws + WS_H, 1024, ws + WS_W_RG_IN, TOK, 1024, 1024, 0, e, bid);
      EpiSgGM eg{(u16*)(ws + WS_B(1))};
      RUN_GEMM_R(ws + WS_H, 1024, ws + WS_W_RG_IN + (size_t)1024 * 1024 * 2, TOK, 1024, 1024, eg, 256, bid >= 192 ? bid - 192 : (1 << 20), 0, 64);
    } else {
      RUN_GEMM(ws + WS_H, 1024, ws + WS_W_RG_IN, TOK, 2048, 1024, 0, e, bid);
    }
  } PH_FIN
  PH_BEGIN(12) phase_rg_conv(p, bid, nb); PH_FIN
  PH_BEGIN(13) {
    EpiRgGate e{(u16*)(ws + WS_B(3)), (u16*)(ws + WS_B(5)), p.in[24]};
    if (nb == 256) {
      EpiSgGM eg{(u16*)(ws + WS_B(1))};
      RUN_GEMM_R(ws + WS_H, 1024, ws + WS_W_RG_IN + (size_t)1024 * 1024 * 2, TOK, 1024, 1024, eg, 256, bid < 128 ? bid : (1 << 20), 64, 192);
      RUN_GEMM_RX(ws + WS_B(2), 64, GM_KSTEP, 4 * GM_KSTEP, ws + WS_W_RG_GATE, TOK, 4096, 256, 1, e, 256, bid < 128 ? bid : (1 << 20), 0, 128);
      RUN_GEMM_RX(ws + WS_B(2), 64, GM_KSTEP, 4 * GM_KSTEP, ws + WS_W_RG_GATE, TOK, 4096, 256, 1, e, 128, bid >= 128 ? bid - 128 : (1 << 20), 128, 768);
    } else {
      RUN_GEMM_X(ws + WS_B(2), 64, GM_KSTEP, 4 * GM_KSTEP, ws + WS_W_RG_GATE, TOK, 4096, 256, 1, e, nb, bid);
    }
  } PH_FIN
  PH_BEGIN(14) phase_rg_scan(p, smem_raw, bid, nb); PH_FIN
  PH_BEGIN(15) {
    EpiResLn<true, true> e{p.out, p.out, (const u16*)(ws + WS_XB), p.out, (u16*)(ws + WS_XB), mod + 2 * 15360 + 2048, p.in[10] + 2 * 1024, p.in[11] + 2 * 1024, mod + 3 * 15360, (u16*)(ws + WS_H),
               (unsigned long long*)(ws + WS_SLOT) + 2 * 49152, (unsigned*)(ws + WS_CNT + 256) + 2 * 48};
    RUN_GEMM_X(ws + WS_B(0), 64, GM_KSTEP, (size_t)0, ws + WS_W_RG_OUT, TOK, 1024, 1024, 0, e, nb, bid);
    wconv_idle(p, smem_raw, bid, nb, 3840, 4800);
  } PH_FIN
  PH_BEGIN(17) {
    EpiMlaIn e{(u16*)(ws + WS3_CQ), (float*)(ws + WS3_CKVRAW), (float*)(ws + WS3_KPERAW), (u16*)(ws + WS3_SG)};
    RUN_GEMM(ws + WS_H, 1024, ws + WS_W_MLA_IN, TOK, 768, 1024, 0, e, bid);
    if (nb == 256) {
      EpiSg eg{(u16*)(ws + WS3_SG)};
      RUN_GEMM_R(ws + WS_H, 1024, ws + WS_W_MLA_IN + 672 * 1024 * 2, TOK, 1024, 1024, eg, 256, bid >= 144 ? bid - 144 : (1 << 20), 0, 112);
    }
  } PH_FIN
  PH_BEGIN(18) phase_mla_norm(p, bid, nb); PH_FIN
  PH_BEGIN(19) {
    const bool bal = (nb == 256);
    const int none = 1 << 20;
    EpiSg eg{(u16*)(ws + WS3_SG)};
    RUN_GEMM_R(ws + WS_H, 1024, ws + WS_W_MLA_IN + 672 * 1024 * 2, TOK, 1024, 1024, eg, nb, bid, bal ? 112 : 0, 192);
    EpiQ eq{(u16*)(ws + WS3_Q)};
    RUN_GEMM_G(ws + WS3_CQ, 384, ws + WS_W_QB, TOK, 1536, 384, 0, eq, bal ? 176 : nb, bal ? (bid >= 80 ? bid - 80 : none) : bid);
    EpiK ek{(u16*)(ws + WS3_K)};
    RUN_GEMM(ws + WS3_CKVALL, 256, ws + WS_W_KVB, KVROWS, 1024, 256, 0, ek, bid);
    EpiV ev{(u16*)(ws + WS3_VT)};
    RUN_GEMM_G(ws + WS_W_KVB + 1024 * 256 * 2, 256, ws + WS3_CKVALL, 1024, KVROWS, 256, 0, ev, bal ? 176 : nb, bal ? (bid >= 80 ? (bid + 160) % 176 : none) : bid);
  } PH_FIN
  PH_BEGIN(20) phase_attn(p, smem_raw, bid, nb); PH_FIN
  PH_BEGIN(21) {
    EpiResLn<true, false> e{p.out, p.out, (const u16*)(ws + WS_XB), p.out, (u16*)nullptr, mod + 3 * 15360 + 2048, p.in[10] + 3 * 1024, p.in[11] + 3 * 1024, mod + 3 * 15360, (u16*)nullptr,
               (unsigned long long*)(ws + WS_SLOT) + 3 * 49152, (unsigned*)(ws + WS_CNT + 256) + 3 * 48};
    RUN_GEMM(ws + WS_H, 1024, ws + WS_W_MLA_OUT, TOK, 1024, 1024, 0, e, bid);
  } PH_FIN
}

extern "C" void kernel_launch(void* const* d_in, const int* in_sizes, int n_in, void* d_out, int out_size, void* d_ws, size_t ws_size,
                              hipStream_t stream) {
  static int grid_blocks = 0;
  if (!grid_blocks) {
    int dev = 0, cus = 0, per_cu = 0;
    (void)hipGetDevice(&dev);
    (void)hipDeviceGetAttribute(&cus, hipDeviceAttributeMultiprocessorCount, dev);
    (void)hipFuncSetAttribute((const void*)mega, hipFuncAttributeMaxDynamicSharedMemorySize, DYN_LDS);
    (void)hipOccupancyMaxActiveBlocksPerMultiprocessor(&per_cu, (const void*)mega, NT, DYN_LDS);
    if (per_cu < 1) per_cu = 1;
    if (per_cu > 1) per_cu = 1;
    grid_blocks = cus * per_cu;
  }
  Params p{};
  for (int i = 0; i < 33; ++i) p.in[i] = (const float*)d_in[i];
  p.out = (float*)d_out;
  p.ws = (unsigned char*)d_ws;
#if MULTI_LAUNCH
  (void)hipMemsetAsync((unsigned char*)d_ws + WS_CNT, 0, 4096 + XCD_BAR_WORDS * 4, stream);
  for (int ph = 0; ph < NPHASES; ++ph) {
    p.phase_lo = ph; p.phase_hi = ph + 1;
    hipLaunchKernelGGL(mega, dim3(grid_blocks), dim3(NT), DYN_LDS, stream, p);
#ifdef PROBE_MASK
    if ((PROBE_MASK >> ph) & 1) { p.flags = PROBE_FLAGS; for (int r = 0; r < 2; ++r) {
      if (ph == 3) (void)hipMemsetAsync((unsigned char*)d_ws + WS_CNT, 0, 64, stream);
      hipLaunchKernelGGL(mega, dim3(grid_blocks), dim3(NT), DYN_LDS, stream, p);
    } p.flags = 0; }
#endif
  }
#else
  p.phase_lo = 0; p.phase_hi = NPHASES;
  (void)hipMemsetAsync((unsigned char*)d_ws + WS_CNT, 0, 4096 + XCD_BAR_WORDS * 4, stream);
  void* args[] = {&p};
  hipError_t e = hipLaunchCooperativeKernel((const void*)mega, dim3(grid_blocks), dim3(NT), args, DYN_LDS, stream);
  if (e != hipSuccess) fprintf(stderr, "cooperative launch failed: %s (grid %d)\n", hipGetErrorString(e), grid_blocks);
#endif
}
```
